# Optimizing an MI355X kernel written in HIP

```python
import math
import jax, jax.numpy as jnp
from jax import lax
import numpy as np

D_MODEL = 1024
BATCH = 2
SEQ = 8192
DEPTH = 4

N_MIXERS = 3
N_ATTN_LAYERS = (DEPTH + 2) // 3
N_RET_LAYERS = (DEPTH + 1) // 3
N_SSM_LAYERS = DEPTH // 3

ATTN_GROUPS = ((128, 1), (512, 4), (2048, 16))
ATTN_HEADS = 8
ATTN_HEAD_DIM = D_MODEL // ATTN_HEADS
ATTN_BLOCK = 128
RET_HEADS = 4
RET_KEY_DIM = D_MODEL // RET_HEADS
RET_VAL_DIM = 2 * RET_KEY_DIM
RET_CHUNK = 128
SSM_GROUP = 16
SSM_GROUPS = D_MODEL // SSM_GROUP
SSM_STATE = 64
N_EXPERTS = 64
TOP_K = 8
N_EXPERT_GROUPS = 8
TOPK_GROUPS = 4
EXPERT_DIM = 256
SHARED_DIM = 256
ROUTED_SCALE = 2.5
MOE_BLOCK = 128
DEEPNORM_ALPHA = (2 * DEPTH) ** 0.25
DEEPNORM_BETA = (8 * DEPTH) ** -0.25
LN_EPS = 1e-5

kernel_name = "hybrid_dilated_retention_s5_moe_deepnorm"

F32 = jnp.float32


def layer_norm(x, g, b):
    xf = x.astype(F32)
    mu = jnp.mean(xf, axis=-1, keepdims=True)
    var = jnp.mean(jnp.square(xf - mu), axis=-1, keepdims=True)
    y = (xf - mu) * lax.rsqrt(var + LN_EPS) * g.astype(F32) + b.astype(F32)
    return y.astype(x.dtype)


def alibi_slopes(n):
    return 2.0 ** (-8.0 * (jnp.arange(n, dtype=F32) + 1.0) / n)


def dilated_window_attention(q, k, v, window, dilation, slopes):
    b, s, h, e = q.shape
    steps = window // dilation
    blk = ATTN_BLOCK
    ls = -(-s // (dilation * blk)) * blk
    sp = ls * dilation
    nb = ls // blk

    def to_blocks(t):
        t = jnp.pad(t, ((0, 0), (0, sp - s), (0, 0), (0, 0)))
        t = t.reshape(b, ls, dilation, h, e).transpose(0, 2, 3, 1, 4)
        return t.reshape(b, dilation, h, nb, blk, e)

    def with_prev(t):
        prev = jnp.pad(t[:, :, :, :-1], ((0, 0), (0, 0), (0, 0), (1, 0), (0, 0), (0, 0)))
        return jnp.concatenate([prev, t], axis=-2)

    qb = to_blocks(q)
    kk = with_prev(to_blocks(k))
    vv = with_prev(to_blocks(v))
    qi = jnp.arange(blk)[:, None]
    kj = jnp.arange(2 * blk)[None, :]
    step = qi - kj + blk
    not_before_start = (jnp.arange(nb) > 0)[:, None, None] | (kj >= blk)[None]
    valid = (step >= 0) & (step <= steps) & not_before_start
    dist = (step * dilation).astype(F32)
    scores = jnp.einsum('bdhnqe,bdhnke->bdhnqk', qb, kk)
    scores = scores - slopes[:, None, None, None] * dist
    scores = jnp.where(valid, scores, -jnp.inf)
    m = jnp.max(scores, axis=-1, keepdims=True)
    p = jnp.exp(scores - m)
    l = jnp.sum(p, axis=-1, keepdims=True)
    o = jnp.einsum('bdhnqk,bdhnke->bdhnqe', p, vv) / l
    lse = (m + jnp.log(l))[..., 0]
    o = o.reshape(b, dilation, h, ls, e).transpose(0, 3, 1, 2, 4).reshape(b, sp, h, e)[:, :s]
    lse = lse.reshape(b, dilation, h, ls).transpose(0, 3, 1, 2).reshape(b, sp, h)[:, :s]
    return o, lse


def dilated_attention_mixer(x, w_in, w_out):
    b, s, _ = x.shape
    n_g = len(ATTN_GROUPS)
    qkv = (x @ w_in).astype(F32).reshape(b, s, n_g, 3, ATTN_HEADS, ATTN_HEAD_DIM)
    slopes = alibi_slopes(ATTN_HEADS)
    outs, lses = [], []
    for g, (window, dil) in enumerate(ATTN_GROUPS):
        q = qkv[:, :, g, 0] * ATTN_HEAD_DIM ** -0.5
        o, lse = dilated_window_attention(q, qkv[:, :, g, 1], qkv[:, :, g, 2], window, dil, slopes)
        outs.append(o)
        lses.append(lse)
    w = jax.nn.softmax(jnp.stack(lses, axis=0), axis=0)
    o = jnp.sum(w[..., None] * jnp.stack(outs, axis=0), axis=0)
    return o.reshape(b, s, ATTN_HEADS * ATTN_HEAD_DIM).astype(x.dtype) @ w_out


def retention_mixer(x, w_in, gn_g, gn_b, w_out):
    b, s, _ = x.shape
    h, dk, dv, c = RET_HEADS, RET_KEY_DIM, RET_VAL_DIM, RET_CHUNK
    nc = s // c
    proj = x @ w_in
    q, k, v, g = jnp.split(proj, [h * dk, 2 * h * dk, 2 * h * dk + h * dv], axis=-1)
    q = q.astype(F32).reshape(b, nc, c, h, dk)
    k = (k.astype(F32) * dk ** -0.5).reshape(b, nc, c, h, dk)
    v = v.astype(F32).reshape(b, nc, c, h, dv)
    log_gamma = jnp.log(1.0 - 2.0 ** (-5.0 - jnp.arange(h, dtype=F32)))
    pos = jnp.arange(c, dtype=F32)
    rel = pos[:, None] - pos[None, :]
    decay = jnp.where(rel >= 0, jnp.exp(log_gamma[:, None, None] * jnp.maximum(rel, 0.0)), 0.0)
    scores = jnp.einsum('bnihd,bnjhd->bnhij', q, k) * decay
    inner = jnp.einsum('bnhij,bnjhe->bnihe', scores, v)
    xi = jnp.exp(log_gamma[None, :] * (pos[:, None] + 1.0))
    zeta = jnp.exp(log_gamma[None, :] * (c - 1.0 - pos[:, None]))
    chunk_decay = jnp.exp(log_gamma * c)

    def chunk_step(state, inp):
        qc, kc, vc = inp
        cross = jnp.einsum('bihd,bhde->bihe', qc * xi[:, :, None], state)
        state = chunk_decay[None, :, None, None] * state + jnp.einsum('bjhd,bjhe->bhde', kc * zeta[:, :, None], vc)
        return state, cross

    state0 = jnp.zeros((b, h, dk, dv), F32)
    _, cross = lax.scan(chunk_step, state0, (q.transpose(1, 0, 2, 3, 4), k.transpose(1, 0, 2, 3, 4), v.transpose(1, 0, 2, 3, 4)))
    y = (inner + cross.transpose(1, 0, 2, 3, 4)).reshape(b, s, h, dv)
    mu = jnp.mean(y, axis=-1, keepdims=True)
    var = jnp.mean(jnp.square(y - mu), axis=-1, keepdims=True)
    y = ((y - mu) * lax.rsqrt(var + LN_EPS)).reshape(b, s, h * dv) * gn_g.astype(F32) + gn_b.astype(F32)
    y = jax.nn.silu(g.astype(F32)) * y
    return y.astype(x.dtype) @ w_out


def s5_mixer(x, a_re, a_im, b_re, b_im, c_re, c_im, d_skip, log_dt, w_glu):
    bsz, s, _ = x.shape
    u = x.astype(F32).reshape(bsz, s, SSM_GROUPS, SSM_GROUP)
    a_re, a_im = a_re.astype(F32), a_im.astype(F32)
    b_re, b_im = b_re.astype(F32), b_im.astype(F32)
    dt = jnp.exp(log_dt.astype(F32))[:, None]
    mag = jnp.exp(dt * a_re)
    ab_re = mag * jnp.cos(dt * a_im)
    ab_im = mag * jnp.sin(dt * a_im)
    den = a_re * a_re + a_im * a_im
    f_re = ((ab_re - 1.0) * a_re + ab_im * a_im) / den
    f_im = (ab_im * a_re - (ab_re - 1.0) * a_im) / den
    bb_re = f_re[..., None] * b_re - f_im[..., None] * b_im
    bb_im = f_re[..., None] * b_im + f_im[..., None] * b_re
    bu_re = jnp.einsum('bsgc,gpc->bsgp', u, bb_re)
    bu_im = jnp.einsum('bsgc,gpc->bsgp', u, bb_im)
    aa_re = jnp.broadcast_to(ab_re, bu_re.shape)
    aa_im = jnp.broadcast_to(ab_im, bu_im.shape)

    def combine(e1, e2):
        ar1, ai1, br1, bi1 = e1
        ar2, ai2, br2, bi2 = e2
        return (ar2 * ar1 - ai2 * ai1, ar2 * ai1 + ai2 * ar1,
                ar2 * br1 - ai2 * bi1 + br2, ar2 * bi1 + ai2 * br1 + bi2)

    _, _, h_re, h_im = lax.associative_scan(combine, (aa_re, aa_im, bu_re, bu_im), axis=1)
    y = (jnp.einsum('bsgp,gcp->bsgc', h_re, c_re.astype(F32))
         - jnp.einsum('bsgp,gcp->bsgc', h_im, c_im.astype(F32))
         + d_skip.astype(F32) * u)
    y = jax.nn.gelu(y).reshape(bsz, s, D_MODEL).astype(x.dtype)
    val, gate = jnp.split(y @ w_glu, 2, axis=-1)
    return val * jax.nn.sigmoid(gate)


def moe_ffn(x, w_router, router_bias, w_gate, w_up, w_down, sw_gate, sw_up, sw_down):
    bsz, s, d = x.shape
    t = bsz * s
    xf = x.reshape(t, d)
    scores = jax.nn.sigmoid((xf @ w_router).astype(F32))
    sel = scores + router_bias.astype(F32)
    grp = sel.reshape(t, N_EXPERT_GROUPS, N_EXPERTS // N_EXPERT_GROUPS)
    grp_score = jnp.sum(lax.top_k(grp, 2)[0], axis=-1)
    _, grp_idx = lax.top_k(grp_score, TOPK_GROUPS)
    grp_mask = jnp.sum(jax.nn.one_hot(grp_idx, N_EXPERT_GROUPS, dtype=F32), axis=1) > 0
    exp_mask = jnp.repeat(grp_mask, N_EXPERTS // N_EXPERT_GROUPS, axis=1)
    _, top_idx = lax.top_k(jnp.where(exp_mask, sel, -jnp.inf), TOP_K)
    top_w = jnp.take_along_axis(scores, top_idx, axis=1)
    gates = top_w / jnp.sum(top_w, axis=-1, keepdims=True) * ROUTED_SCALE
    tk = t * TOP_K
    flat_e = top_idx.reshape(-1).astype(jnp.int32)
    flat_tok = jnp.arange(tk, dtype=jnp.int32) // TOP_K
    flat_g = gates.reshape(-1)
    order = jnp.argsort(flat_e, stable=True)
    sorted_e = flat_e[order]
    counts = jnp.bincount(flat_e, length=N_EXPERTS)
    starts = jnp.cumsum(counts) - counts
    padded = (counts + MOE_BLOCK - 1) // MOE_BLOCK * MOE_BLOCK
    pad_ends = jnp.cumsum(padded)
    pad_starts = pad_ends - padded
    dest = pad_starts[sorted_e] + jnp.arange(tk, dtype=jnp.int32) - starts[sorted_e]
    cap = tk + N_EXPERTS * MOE_BLOCK
    n_blocks = cap // MOE_BLOCK
    buf_tok = jnp.full((cap,), t, jnp.int32).at[dest].set(flat_tok[order])
    buf_gate = jnp.zeros((cap,), F32).at[dest].set(flat_g[order])
    block_e = jnp.minimum(jnp.searchsorted(pad_ends, jnp.arange(n_blocks) * MOE_BLOCK, side='right'), N_EXPERTS - 1)
    xpad = jnp.concatenate([xf, jnp.zeros((1, d), xf.dtype)], axis=0)

    def block_step(acc, inp):
        e, tok, gate = inp
        xb = xpad[tok]
        hb = jax.nn.silu(xb @ w_gate[e]) * (xb @ w_up[e])
        yb = (hb @ w_down[e]).astype(F32) * gate[:, None]
        return acc.at[tok].add(yb), None

    acc, _ = lax.scan(block_step, jnp.zeros((t + 1, d), F32),
                      (block_e, buf_tok.reshape(n_blocks, MOE_BLOCK), buf_gate.reshape(n_blocks, MOE_BLOCK)))
    shared = (jax.nn.silu(xf @ sw_gate) * (xf @ sw_up)) @ sw_down
    return (acc[:t] + shared.astype(F32)).astype(x.dtype).reshape(bsz, s, d)


def setup_inputs(seed: int = 0) -> dict:
    key = jax.random.key(seed)
    ks = jax.random.split(key, 32)
    d = D_MODEL
    nrm = lambda k, shape, scale: jax.random.normal(k, shape, F32) * scale
    beta = DEEPNORM_BETA
    attn_in = 3 * len(ATTN_GROUPS) * ATTN_HEADS * ATTN_HEAD_DIM
    ret_in = 2 * RET_HEADS * RET_KEY_DIM + 2 * RET_HEADS * RET_VAL_DIM
    ret_v = RET_HEADS * RET_VAL_DIM
    ns, g, p, c = N_SSM_LAYERS, SSM_GROUPS, SSM_STATE, SSM_GROUP
    a_im0 = math.pi * jnp.arange(p, dtype=F32)
    return {
        'x': nrm(ks[0], (BATCH, SEQ, d), 1.0),
        'attn_w_in': nrm(ks[1], (N_ATTN_LAYERS, d, attn_in), d ** -0.5),
        'attn_w_out': nrm(ks[2], (N_ATTN_LAYERS, ATTN_HEADS * ATTN_HEAD_DIM, d), beta * (ATTN_HEADS * ATTN_HEAD_DIM) ** -0.5),
        'ret_w_in': nrm(ks[3], (N_RET_LAYERS, d, ret_in), d ** -0.5),
        'ret_gn_g': 1.0 + nrm(ks[4], (N_RET_LAYERS, ret_v), 0.01),
        'ret_gn_b': nrm(ks[5], (N_RET_LAYERS, ret_v), 0.01),
        'ret_w_out': nrm(ks[6], (N_RET_LAYERS, ret_v, d), beta * ret_v ** -0.5),
        'ssm_a_re': -0.5 + nrm(ks[7], (ns, g, p), 0.01),
        'ssm_a_im': a_im0 + nrm(ks[8], (ns, g, p), 0.01),
        'ssm_b_re': nrm(ks[9], (ns, g, p, c), (2.0 * c) ** -0.5),
        'ssm_b_im': nrm(ks[10], (ns, g, p, c), (2.0 * c) ** -0.5),
        'ssm_c_re': nrm(ks[11], (ns, g, c, p), (2.0 * p) ** -0.5),
        'ssm_c_im': nrm(ks[12], (ns, g, c, p), (2.0 * p) ** -0.5),
        'ssm_d': nrm(ks[13], (ns, g, c), 1.0),
        'ssm_log_dt': jax.random.uniform(ks[14], (ns, g), F32, math.log(1e-3), math.log(1e-1)),
        'ssm_w_glu': nrm(ks[15], (ns, d, 2 * d), beta * d ** -0.5),
        'moe_w_router': nrm(ks[16], (DEPTH, d, N_EXPERTS), d ** -0.5),
        'moe_router_bias': nrm(ks[17], (DEPTH, N_EXPERTS), 0.01),
        'moe_w_gate': nrm(ks[18], (DEPTH, N_EXPERTS, d, EXPERT_DIM), d ** -0.5),
        'moe_w_up': nrm(ks[19], (DEPTH, N_EXPERTS, d, EXPERT_DIM), d ** -0.5),
        'moe_w_down': nrm(ks[20], (DEPTH, N_EXPERTS, EXPERT_DIM, d), beta * EXPERT_DIM ** -0.5),
        'shared_w_gate': nrm(ks[21], (DEPTH, d, SHARED_DIM), d ** -0.5),
        'shared_w_up': nrm(ks[22], (DEPTH, d, SHARED_DIM), d ** -0.5),
        'shared_w_down': nrm(ks[23], (DEPTH, SHARED_DIM, d), beta * SHARED_DIM ** -0.5),
        'ln_g': 1.0 + nrm(ks[24], (DEPTH, 2, d), 0.01),
        'ln_b': nrm(ks[25], (DEPTH, 2, d), 0.01),
    }


def reference(x, attn_w_in, attn_w_out, ret_w_in, ret_gn_g, ret_gn_b, ret_w_out,
              ssm_a_re, ssm_a_im, ssm_b_re, ssm_b_im, ssm_c_re, ssm_c_im, ssm_d, ssm_log_dt, ssm_w_glu,
              moe_w_router, moe_router_bias, moe_w_gate, moe_w_up, moe_w_down,
              shared_w_gate, shared_w_up, shared_w_down, ln_g, ln_b):
    for i in range(DEPTH):
        j = i // N_MIXERS
        kind = i % N_MIXERS
        if kind == 0:
            h = dilated_attention_mixer(x, attn_w_in[j], attn_w_out[j])
        elif kind == 1:
            h = retention_mixer(x, ret_w_in[j], ret_gn_g[j], ret_gn_b[j], ret_w_out[j])
        else:
            h = s5_mixer(x, ssm_a_re[j], ssm_a_im[j], ssm_b_re[j], ssm_b_im[j], ssm_c_re[j], ssm_c_im[j],
                         ssm_d[j], ssm_log_dt[j], ssm_w_glu[j])
        x = layer_norm(DEEPNORM_ALPHA * x + h, ln_g[i, 0], ln_b[i, 0])
        h = moe_ffn(x, moe_w_router[i], moe_router_bias[i], moe_w_gate[i], moe_w_up[i], moe_w_down[i],
                    shared_w_gate[i], shared_w_up[i], shared_w_down[i])
        x = layer_norm(DEEPNORM_ALPHA * x + h, ln_g[i, 1], ln_b[i, 1])
    return x
```

```cpp
#include <hip/hip_runtime.h>
#include <cstdio>
#include <cstdint>

#define LAS __attribute__((address_space(3)))
#define GAS __attribute__((address_space(1)))
typedef unsigned short bf16;
typedef short bf16x8 __attribute__((ext_vector_type(8)));
typedef short bf16x4 __attribute__((ext_vector_type(4)));
typedef float f32x4 __attribute__((ext_vector_type(4)));
typedef float f32x2 __attribute__((ext_vector_type(2)));
typedef unsigned u32x4 __attribute__((ext_vector_type(4)));
typedef unsigned u32x2 __attribute__((ext_vector_type(2)));
typedef GAS unsigned gu32;

constexpr int D = 1024, BATCH = 2, SEQ = 8192, T = BATCH * SEQ, DEPTH = 4;
constexpr int AH = 8, AHD = 128, ATT_IN = 9216;
constexpr int RH = 4, RDK = 256, RDV = 512, RET_IN = 6144, RET_V = 2048, RC = 128, RNC = SEQ / RC;
constexpr int SG = 64, SGC = 16, SP = 64;
constexpr int NE = 64, TOPK = 8, NEG = 8, ED = 256, NSLOT = 9;
constexpr float LN_EPS = 1e-5f;
constexpr float ALPHA = 1.6817928305074292f;
constexpr int NWAVES = 8, NTHREADS = 512;

__device__ __forceinline__ unsigned f2bf(float f) { unsigned u = __builtin_bit_cast(unsigned, f); return (u + 0x7fffu + ((u >> 16) & 1u)) >> 16; }
__device__ __forceinline__ unsigned pk2(float lo, float hi) { return f2bf(lo) | (f2bf(hi) << 16); }
__device__ __forceinline__ float bf2f(unsigned b) { return __builtin_bit_cast(float, b << 16); }
__device__ __forceinline__ float bflo(unsigned w) { return __builtin_bit_cast(float, w << 16); }
__device__ __forceinline__ float bfhi(unsigned w) { return __builtin_bit_cast(float, w & 0xffff0000u); }
__device__ __forceinline__ float shx(float v, int m, int lane) { return __builtin_bit_cast(float, __builtin_amdgcn_ds_bpermute((lane ^ m) << 2, __builtin_bit_cast(int, v))); }
__device__ __forceinline__ int shx_i(int v, int m, int lane) { return __builtin_amdgcn_ds_bpermute((lane ^ m) << 2, v); }
__device__ __forceinline__ float rdl(float v, int src) { return __builtin_bit_cast(float, __builtin_amdgcn_readlane(__builtin_bit_cast(int, v), src)); }
__device__ __forceinline__ float wave_sum(float v, int lane) {
#pragma unroll
    for (int o = 1; o < 64; o <<= 1) v += shx(v, o, lane);
    return v;
}
#define LDS_WAIT() asm volatile("s_waitcnt lgkmcnt(0)" ::: "memory")
#define VM_WAIT() asm volatile("s_waitcnt vmcnt(0)" ::: "memory")
__device__ __forceinline__ const char* rfl_ptr(const char* p) {
    unsigned long long v = (unsigned long long)p; unsigned lo = __builtin_amdgcn_readfirstlane((unsigned)v), hi = __builtin_amdgcn_readfirstlane((unsigned)(v >> 32));
    return (const char*)(((unsigned long long)hi << 32) | lo);
}
__device__ __forceinline__ bf16x8 row_frag(const LAS bf16* base, int ld, int row0, int col0, int lane) {
    return *(const LAS bf16x8*)(base + (row0 + (lane & 15)) * ld + col0 + 8 * (lane >> 4));
}
__device__ __forceinline__ bf16x4 tr4(const LAS bf16* addr) { return __builtin_amdgcn_ds_read_tr16_b64_v4i16((LAS bf16x4*)addr); }
__device__ __forceinline__ bf16x8 cat8(bf16x4 a, bf16x4 b) { bf16x8 r; r[0] = a[0]; r[1] = a[1]; r[2] = a[2]; r[3] = a[3]; r[4] = b[0]; r[5] = b[1]; r[6] = b[2]; r[7] = b[3]; return r; }
#define MFMA16(a, b, c) __builtin_amdgcn_mfma_f32_16x16x32_bf16((a), (b), (c), 0, 0, 0)
__device__ __forceinline__ bf16x8 pack8(f32x4 a, f32x4 b) {
    u32x4 w; w.x = pk2(a[0], a[1]); w.y = pk2(a[2], a[3]); w.z = pk2(b[0], b[1]); w.w = pk2(b[2], b[3]); return __builtin_bit_cast(bf16x8, w);
}

namespace pg8 {
constexpr int BM = 256, BK = 64, HALF = 128, HTB = HALF * BK * 2, STAGE_BYTES = 8 * HTB;
__device__ __forceinline__ int lds_byte(int r, int c) { const int st = (r >> 4) * 2 + (c >> 5), rr = r & 15, cc = c & 31, ob = rr * 64 + cc * 2; return st * 1024 + (ob ^ (((ob >> 9) & 1) << 5)); }
__device__ __forceinline__ void stage_rc(int b, int& R, int& C) { const int st = b / 1024, sb = b % 1024, swz = sb ^ (((sb >> 9) & 1) << 5); R = (st >> 1) * 16 + swz / 64; C = (st & 1) * 32 + (swz % 64) / 2; }
__device__ __forceinline__ int perm32(int rho) { const int n = rho >> 4, i = rho & 15; return 8 * (i >> 2) + 4 * n + (i & 3); }

struct UnitG {
    const char* A;
    const char* B;
    const int* gidx;
    int gcnt, gshift;
    int row0, col0;
    int aux;
};

__device__ __forceinline__ void uniformize(UnitG& u) { u.A = rfl_ptr(u.A); u.B = rfl_ptr(u.B); u.gidx = (const int*)rfl_ptr((const char*)u.gidx); u.gcnt = __builtin_amdgcn_readfirstlane(u.gcnt); u.gshift = __builtin_amdgcn_readfirstlane(u.gshift);
    u.row0 = __builtin_amdgcn_readfirstlane(u.row0); u.col0 = __builtin_amdgcn_readfirstlane(u.col0); u.aux = __builtin_amdgcn_readfirstlane(u.aux); }
template <class Epi, class Sched>
__device__ __forceinline__ void gemm_phase(LAS unsigned char* lds, const int tid, const int K, const Sched& S, const Epi& E) {
    constexpr bool GATHER = Sched::GATHER;
    const int wid = __builtin_amdgcn_readfirstlane(tid >> 6), lane = tid & 63, wr = wid >> 2, wc = wid & 3, fr = lane & 15, fq = lane >> 4;
    const int nt = K / BK;
    unsigned voffB[2], vA[2][2];
#pragma unroll
    for (int i = 0; i < 2; ++i) { int R, C; stage_rc(tid * 16 + i * 8192, R, C); const int Rb = Epi::PERM ? ((R & ~31) + perm32(R & 31)) : R; voffB[i] = (unsigned)(Rb * K + C) * 2u; vA[0][i] = (unsigned)(R * K + C) * 2u; vA[1][i] = vA[0][i]; }
    const size_t kstep = (size_t)(BK * 2);
    const size_t hstep = (size_t)HALF * K * 2;
    const size_t hstepA = GATHER ? 0 : hstep;
    const unsigned ldsw = (unsigned)wid * 1024u;
    const int aoff = lds_byte(wr * 64 + fr, fq * 8), boff = lds_byte(wc * 32 + fr, fq * 8);
    LAS u32x4* park = (LAS u32x4*)(lds + STAGE_BYTES) + tid;
#define PG8_SA(b, h) (((b) * 2 + (h)) * HTB)
#define PG8_SB(b, h) ((4 + (b) * 2 + (h)) * HTB)
#define PG8_STAGE(bufoff, gbase, voff) do { _Pragma("unroll") for (int _i = 0; _i < 2; ++_i) { asm volatile("" : "+v"((voff)[_i]));   \
        __builtin_amdgcn_global_load_lds((const unsigned*)((const char*)(gbase) + (voff)[_i]), (LAS unsigned*)(lds + (bufoff) + ldsw + _i * 8192), 16, 0, 0); } } while (0)
#define PG8_LDA(dst, b, h) do { _Pragma("unroll") for (int m = 0; m < 4; ++m) _Pragma("unroll") for (int k = 0; k < 2; ++k) dst[m][k] = *(const LAS bf16x8*)(lds + PG8_SA(b, h) + aoff + m * 2048 + k * 1024); } while (0)
#define PG8_LDB(dst, b, h) do { _Pragma("unroll") for (int n = 0; n < 2; ++n) _Pragma("unroll") for (int k = 0; k < 2; ++k) dst[n][k] = *(const LAS bf16x8*)(lds + PG8_SB(b, h) + boff + n * 2048 + k * 1024); } while (0)
#define PG8_MMA(ai, bj, At, Bt) do { __builtin_amdgcn_s_setprio(1); _Pragma("unroll") for (int m = 0; m < 4; ++m) _Pragma("unroll") for (int n = 0; n < 2; ++n) _Pragma("unroll") for (int k = 0; k < 2; ++k) \
        acc[ai][bj][m][n] = __builtin_amdgcn_mfma_f32_16x16x32_bf16(Bt[n][k], At[m][k], acc[ai][bj][m][n], 0, 0, 0); __builtin_amdgcn_s_setprio(0); } while (0)
#define PG8_WAIT_V(n) asm volatile("s_waitcnt vmcnt(" #n ")" ::: "memory")
#define PG8_WAIT_L(n) asm volatile("s_waitcnt lgkmcnt(" #n ")" ::: "memory")
#define PG8_BAR __builtin_amdgcn_s_barrier()
#define PG8_SCHED __builtin_amdgcn_sched_barrier(0)
#define PG8_VOFF(u, v00, v01, v10, v11) do { int _R0, _C0, _R1, _C1; stage_rc(tid * 16, _R0, _C0); stage_rc(tid * 16 + 8192, _R1, _C1); int _r00 = _R0, _r01 = _R1, _r10 = HALF + _R0, _r11 = HALF + _R1; \
        if ((u).gidx) { const int _a = _r00 < (u).gcnt ? (u).gidx[_r00] >> (u).gshift : 0, _b = _r01 < (u).gcnt ? (u).gidx[_r01] >> (u).gshift : 0, _c = _r10 < (u).gcnt ? (u).gidx[_r10] >> (u).gshift : 0, _d = _r11 < (u).gcnt ? (u).gidx[_r11] >> (u).gshift : 0; \
            _r00 = _a; _r01 = _b; _r10 = _c; _r11 = _d; } \
        v00 = (unsigned)(_r00 * K + _C0) * 2u; v01 = (unsigned)(_r01 * K + _C1) * 2u; v10 = (unsigned)(_r10 * K + _C0) * 2u; v11 = (unsigned)(_r11 * K + _C1) * 2u; } while (0)
    UnitG cur, nxt; int ui = 0;
    if (!S.next(0, cur)) return;
    if constexpr (Sched::UNIFORMIZE) uniformize(cur);
    f32x4 acc[2][2][4][2];
#pragma unroll
    for (int a = 0; a < 2; ++a)
#pragma unroll
        for (int b = 0; b < 2; ++b)
#pragma unroll
            for (int m = 0; m < 4; ++m)
#pragma unroll
                for (int n = 0; n < 2; ++n) acc[a][b][m][n] = (f32x4){0.f, 0.f, 0.f, 0.f};
    bf16x8 At[4][2], B0[2][2], B1[2][2];
    if constexpr (GATHER) PG8_VOFF(cur, vA[0][0], vA[0][1], vA[1][0], vA[1][1]);
    const char* cA = cur.A; const char* cB = cur.B;
    PG8_STAGE(PG8_SB(0, 0), cB, voffB); PG8_STAGE(PG8_SB(0, 1), cB + hstep, voffB); PG8_STAGE(PG8_SA(0, 0), cA, vA[0]); PG8_STAGE(PG8_SA(0, 1), cA + hstepA, vA[1]);
    if (wr == 1) PG8_BAR;
    PG8_WAIT_V(2); PG8_BAR;
    PG8_STAGE(PG8_SB(1, 0), cB + kstep, voffB); PG8_STAGE(PG8_SA(1, 0), cA + kstep, vA[0]); PG8_STAGE(PG8_SB(1, 1), cB + hstep + kstep, voffB);
    PG8_WAIT_V(6); PG8_BAR;
    for (;;) {
        const bool has_next = S.next(ui + 1, nxt);
        if constexpr (Sched::UNIFORMIZE) { if (has_next) uniformize(nxt); }
        const char* nA = cA; const char* nB = cB;
        if (has_next) { nA = nxt.A; nB = nxt.B; }
        if constexpr (GATHER) { u32x4 pv; pv.x = vA[0][0]; pv.y = vA[0][1]; pv.z = vA[1][0]; pv.w = vA[1][1];
            if (has_next) PG8_VOFF(nxt, pv.x, pv.y, pv.z, pv.w);
            *park = pv; }
#pragma unroll 1
        for (int t = 0; t < nt; t += 2) {
            const bool last = (t == nt - 2);
            const char* a1 = cA + (size_t)(t + 1) * kstep;
            const char* a2 = last ? nA : cA + (size_t)(t + 2) * kstep; const char* b2 = last ? nB : cB + (size_t)(t + 2) * kstep;
            const char* a3 = a2 + kstep; const char* b3 = b2 + kstep;
            PG8_LDB(B0, 0, 0); PG8_LDB(B1, 0, 1); PG8_SCHED; PG8_LDA(At, 0, 0); PG8_STAGE(PG8_SA(1, 1), a1 + hstepA, vA[1]);
            PG8_WAIT_V(8); PG8_WAIT_L(0); PG8_BAR; PG8_MMA(0, 0, At, B0); PG8_MMA(0, 1, At, B1); PG8_BAR; PG8_SCHED;
            if constexpr (GATHER) { if (last) { const u32x4 pv = *park; vA[0][0] = pv.x; vA[0][1] = pv.y; vA[1][0] = pv.z; vA[1][1] = pv.w; } }
            PG8_LDA(At, 0, 1); PG8_STAGE(PG8_SB(0, 0), b2, voffB); PG8_STAGE(PG8_SB(0, 1), b2 + hstep, voffB); PG8_STAGE(PG8_SA(0, 0), a2, vA[0]);
            PG8_WAIT_V(8); PG8_WAIT_L(0); PG8_BAR; PG8_MMA(1, 0, At, B0); PG8_MMA(1, 1, At, B1); PG8_BAR; PG8_SCHED;
            PG8_LDB(B0, 1, 0); PG8_LDB(B1, 1, 1); PG8_SCHED; PG8_LDA(At, 1, 0); PG8_STAGE(PG8_SA(0, 1), a2 + hstepA, vA[1]);
            PG8_WAIT_V(8); PG8_WAIT_L(0); PG8_BAR; PG8_MMA(0, 0, At, B0); PG8_MMA(0, 1, At, B1); PG8_BAR; PG8_SCHED;
            PG8_LDA(At, 1, 1); PG8_STAGE(PG8_SB(1, 0), b3, voffB); PG8_STAGE(PG8_SB(1, 1), b3 + hstep, voffB); PG8_STAGE(PG8_SA(1, 0), a3, vA[0]);
            PG8_WAIT_V(8); PG8_WAIT_L(0); PG8_BAR; PG8_MMA(1, 0, At, B0); PG8_MMA(1, 1, At, B1); PG8_BAR; PG8_SCHED;
        }
        if (wr == 0) PG8_BAR;
        E(acc, cur, wr, wc, fr, fq);
        if (!has_next) break;
#pragma unroll
        for (int a = 0; a < 2; ++a)
#pragma unroll
            for (int b = 0; b < 2; ++b)
#pragma unroll
                for (int m = 0; m < 4; ++m)
#pragma unroll
                    for (int n = 0; n < 2; ++n) acc[a][b][m][n] = (f32x4){0.f, 0.f, 0.f, 0.f};
        cur = nxt; cA = nA; cB = nB; ++ui;
        if (wr == 1) PG8_BAR;
    }
    PG8_WAIT_V(0);
    PG8_BAR;
#undef PG8_SA
#undef PG8_SB
#undef PG8_STAGE
#undef PG8_LDA
#undef PG8_LDB
#undef PG8_MMA
#undef PG8_WAIT_V
#undef PG8_WAIT_L
#undef PG8_BAR
#undef PG8_SCHED
#undef PG8_VOFF
}
}

constexpr size_t MiB = 1u << 20;
constexpr size_t WS_CTL = 0, CTL_ZERO_BYTES = 1 * MiB;
constexpr size_t WS_ATT_IN_T = 1 * MiB;
constexpr size_t WS_ATT_OUT_T = WS_ATT_IN_T + 36 * MiB;
constexpr size_t WS_RET_IN_T = WS_ATT_OUT_T + 4 * MiB;
constexpr size_t WS_RET_OUT_T = WS_RET_IN_T + 12 * MiB;
constexpr size_t WS_GLU_T = WS_RET_OUT_T + 4 * MiB;
constexpr size_t WS_RT_HI = WS_GLU_T + 4 * MiB;
constexpr size_t WS_RT_LO = WS_RT_HI + 512 * 1024;
constexpr size_t WS_WMOE = WS_RT_HI + 1 * MiB;
constexpr size_t WMOE_E_BYTES = (size_t)(512 * 1024 + 1024 * 256) * 2;
constexpr size_t WS_X = WS_WMOE + 98 * MiB;
constexpr size_t WS_Y = WS_X + 64 * MiB;
constexpr size_t WS_XB = WS_Y + 64 * MiB;
constexpr size_t WS_BIG = WS_XB + 32 * MiB;
constexpr size_t WS_AUX = WS_BIG + 288 * MiB;
constexpr size_t WS_H = WS_AUX + 160 * MiB;
constexpr size_t WS_LIST = WS_H + 80 * MiB;
constexpr size_t WS_TRASH = WS_LIST + 8 * MiB;
constexpr size_t WS_END = WS_TRASH + 1 * MiB;
static_assert(WS_END <= 1024 * MiB, "workspace map");
constexpr int CW_BAR = 4096;
constexpr int CW_CNT = 16384;
constexpr int CW_CHK = 65536;
constexpr int HROWS = 163840;

#define XB_TMO      128
#define XB_XCNT(j)  (256  + 64 * (j))
#define XB_XSUB(j)  (1280 + 64 * (j))
#define XB_XGEN(j)  (2304 + 64 * (j))
#define XB_TOP      3328
#define XB_TOPGEN   3392
#define XCD_BAR_WORDS 3456
#define XB_SPIN_CAP (1u << 20)
__device__ __forceinline__ unsigned xb_ld(unsigned* p)              { return __hip_atomic_load(p, __ATOMIC_RELAXED, __HIP_MEMORY_SCOPE_AGENT); }
__device__ __forceinline__ unsigned xb_add(unsigned* p, unsigned v) { return __hip_atomic_fetch_add(p, v, __ATOMIC_RELAXED, __HIP_MEMORY_SCOPE_AGENT); }
__device__ __forceinline__ unsigned xb_xcc_id() { return (unsigned)__builtin_amdgcn_s_getreg((3 << 11) | 20) & 0xFu; }
#define XB_SPIN(cond, bar) do { unsigned _sp = 0; while (cond) { __builtin_amdgcn_s_sleep(1); \
    if ((++_sp & 255u) == 0u) { if (xb_ld(&(bar)[XB_TMO])) break; if (_sp > XB_SPIN_CAP) { atomicAdd(&(bar)[XB_TMO], 1u); break; } } } } while (0)
struct XcdBarrier { unsigned* bar; unsigned x; volatile LAS unsigned* st; };
__device__ __forceinline__ XcdBarrier xcd_barrier_post(unsigned* bar, volatile LAS unsigned* st) {
    XcdBarrier b; b.bar = bar; b.x = xb_xcc_id(); b.st = st;
    if (threadIdx.x == 0) (void)xb_add(&bar[XB_XCNT(b.x)], 1u);
    return b;
}
__device__ __forceinline__ void xcd_barrier_complete(unsigned* bar, unsigned x, unsigned& nloc, unsigned& nx) {
    const unsigned G = gridDim.x * gridDim.y * gridDim.z;
    unsigned sum, cnt, mine, sp = 0u;
    for (;;) {
        sum = 0u; cnt = 0u; mine = 0u;
#pragma unroll
        for (unsigned j = 0; j < 16; ++j) { const unsigned c = xb_ld(&bar[XB_XCNT(j)]); sum += c; cnt += (c > 0u) ? 1u : 0u; mine = (j == x) ? c : mine; }
        if (sum == G) break;
        __builtin_amdgcn_s_sleep(1);
        if ((++sp & 255u) == 0u) { if (xb_ld(&bar[XB_TMO])) break; if (sp > XB_SPIN_CAP) { atomicAdd(&bar[XB_TMO], 1u); break; } }
    }
    nloc = mine > 0u ? mine : 1u; nx = cnt > 0u ? cnt : 1u;
}
__device__ __forceinline__ void xcd_barrier(const XcdBarrier& b) {
    asm volatile("s_waitcnt vmcnt(0)" ::: "memory");
    __syncthreads();
    if (threadIdx.x == 0) {
        unsigned* bar = b.bar;
        __builtin_amdgcn_s_waitcnt(0);
        unsigned nloc = b.st[0], nx = b.st[1];
        if (nloc == 0u) { xcd_barrier_complete(bar, b.x, nloc, nx); b.st[0] = nloc; b.st[1] = nx; }
        const unsigned old = xb_add(&bar[XB_XSUB(b.x)], 1u);
        const unsigned gen = old / nloc;
        if (old + 1u == (gen + 1u) * nloc) {
            __builtin_amdgcn_fence(__ATOMIC_RELEASE, "agent");
            asm volatile("s_waitcnt vmcnt(0)" ::: "memory");
            const unsigned og = xb_add(&bar[XB_TOP], 1u);
            const unsigned tg = og / nx;
            if (og + 1u == (tg + 1u) * nx) xb_add(&bar[XB_TOPGEN], 1u);
            else XB_SPIN(xb_ld(&bar[XB_TOPGEN]) == tg, bar);
            __builtin_amdgcn_fence(__ATOMIC_ACQUIRE, "agent");
            xb_add(&bar[XB_XGEN(b.x)], 1u);
            asm volatile("s_waitcnt vmcnt(0)" ::: "memory");
        } else {
            XB_SPIN(xb_ld(&bar[XB_XGEN(b.x)]) == gen, bar);
            __builtin_amdgcn_fence(__ATOMIC_ACQUIRE, "agent");
            asm volatile("s_waitcnt vmcnt(0)" ::: "memory");
        }
    }
    __syncthreads();
}

constexpr int RING_BYTES = 139264;
constexpr int MISC_OFF = RING_BYTES;
constexpr int LDS_BYTES = 147456;
struct Params {
    const float* in[26]; float* out; unsigned char* ws; int ph_lo, ph_hi; int use_bar, pad;
};
typedef const __attribute__((address_space(4))) Params* KP;
struct Frame {
    LAS unsigned char* lds; volatile LAS unsigned* MISC;
    int tid, lane, wave, vcu, G;
    unsigned char* ws;
};

struct DenseSched {
    static constexpr bool GATHER = false, UNIFORMIZE = false;
    const char* A; const char* Bt; int K, nM, nN, nwg, G, c;
    __device__ __forceinline__ void init(const void* A_, const void* Bt_, int M, int N, int K_, int G_, int c_) { A = (const char*)A_; Bt = (const char*)Bt_; K = K_; nM = M / 256; nN = N / 256; nwg = nM * nN; G = G_; c = c_; }
    __device__ __forceinline__ bool next(int i, pg8::UnitG& u) const {
        const long L = (long)i * G + c; if (L >= nwg) return false;
        int wgid = (int)L; { const int q = nwg / 8, r = nwg % 8, xcd = wgid % 8, off = wgid / 8; wgid = (xcd < r ? xcd * (q + 1) : r * (q + 1) + (xcd - r) * q) + off; }
        const int nig = 8 * nN, gid = wgid / nig, fm = gid * 8, gsz = (nM - fm) < 8 ? (nM - fm) : 8;
        const int pm = fm + ((wgid % nig) % gsz), pn = (wgid % nig) / gsz;
        u.A = A + (size_t)pm * 256 * K * 2; u.B = Bt + (size_t)pn * 256 * K * 2; u.gidx = nullptr; u.gcnt = 0; u.gshift = 0; u.row0 = pm * 256; u.col0 = pn * 256; u.aux = 0; return true;
    }
};
__device__ __forceinline__ u32x4 pack_bf16x8(const f32x4& v0, const f32x4& v1) { u32x4 w; w.x = pk2(v0[0], v0[1]); w.y = pk2(v0[2], v0[3]); w.z = pk2(v1[0], v1[1]); w.w = pk2(v1[2], v1[3]); return w; }

struct EpiStoreBf16 {
    static constexpr bool PERM = true;
    bf16* O; int ldc;
    __device__ __forceinline__ void operator()(const f32x4 (&acc)[2][2][4][2], const pg8::UnitG& u, int wr, int wc, int fr, int fq) const {
#pragma unroll
        for (int ai = 0; ai < 2; ++ai)
#pragma unroll
            for (int m = 0; m < 4; ++m) { bf16* rowp = O + (size_t)(u.row0 + ai * 128 + wr * 64 + m * 16 + fr) * ldc + u.col0 + wc * 32 + 8 * fq;
#pragma unroll
                for (int bj = 0; bj < 2; ++bj) *(u32x4*)(rowp + bj * 128) = pack_bf16x8(acc[ai][bj][m][0], acc[ai][bj][m][1]); }
    }
};
struct EpiRetIn {
    static constexpr bool PERM = true;
    bf16* O; int ldc;
    __device__ __forceinline__ void operator()(const f32x4 (&acc)[2][2][4][2], const pg8::UnitG& u, int wr, int wc, int fr, int fq) const {
        float l2g = 0.f;
        if (u.col0 < 2048) { const int h = (u.col0 & 1023) >> 8; const float g = 1.0f - exp2f(-5.0f - (float)h); l2g = log2f(g); if (u.col0 >= 1024) l2g = -l2g; }
#pragma unroll
        for (int ai = 0; ai < 2; ++ai)
#pragma unroll
            for (int m = 0; m < 4; ++m) { const int row = u.row0 + ai * 128 + wr * 64 + m * 16 + fr; const float sc = exp2f(l2g * (float)(row & 127));
                bf16* rowp = O + (size_t)row * ldc + u.col0 + wc * 32 + 8 * fq;
#pragma unroll
                for (int bj = 0; bj < 2; ++bj) *(u32x4*)(rowp + bj * 128) = pack_bf16x8(acc[ai][bj][m][0] * sc, acc[ai][bj][m][1] * sc); }
    }
};
struct EpiResid {
    static constexpr bool PERM = false;
    const float* X; float* Y;
    __device__ __forceinline__ void operator()(const f32x4 (&acc)[2][2][4][2], const pg8::UnitG& u, int wr, int wc, int fr, int fq) const {
#pragma unroll
        for (int ai = 0; ai < 2; ++ai)
#pragma unroll
            for (int m = 0; m < 4; ++m) { const size_t off = (size_t)(u.row0 + ai * 128 + wr * 64 + m * 16 + fr) * D + u.col0 + wc * 32 + 4 * fq;
#pragma unroll
                for (int bj = 0; bj < 2; ++bj)
#pragma unroll
                    for (int n = 0; n < 2; ++n) { const f32x4 xv = *(const f32x4*)(X + off + bj * 128 + n * 16); *(f32x4*)(Y + off + bj * 128 + n * 16) = xv * ALPHA + acc[ai][bj][m][n]; }
                asm volatile("" ::: "memory"); }
    }
};
struct EpiGluResid {
    static constexpr bool PERM = false;
    const float* X; float* Y;
    __device__ __forceinline__ void operator()(const f32x4 (&acc)[2][2][4][2], const pg8::UnitG& u, int wr, int wc, int fr, int fq) const {
#pragma unroll
        for (int ai = 0; ai < 2; ++ai)
#pragma unroll
            for (int m = 0; m < 4; ++m) { const size_t off = (size_t)(u.row0 + ai * 128 + wr * 64 + m * 16 + fr) * D + (u.col0 >> 1) + wc * 32 + 4 * fq;
#pragma unroll
                for (int n = 0; n < 2; ++n) { const f32x4 xv = *(const f32x4*)(X + off + n * 16); const f32x4 v = acc[ai][0][m][n], g = acc[ai][1][m][n]; f32x4 o;
#pragma unroll
                    for (int j = 0; j < 4; ++j) o[j] = xv[j] * ALPHA + v[j] / (1.0f + __expf(-g[j]));
                    *(f32x4*)(Y + off + n * 16) = o; }
                asm volatile("" ::: "memory"); }
    }
};
struct EpiMoeUp {
    static constexpr bool PERM = true;
    bf16* H;
    __device__ __forceinline__ void operator()(const f32x4 (&acc)[2][2][4][2], const pg8::UnitG& u, int wr, int wc, int fr, int fq) const {
#pragma unroll
        for (int ai = 0; ai < 2; ++ai)
#pragma unroll
            for (int m = 0; m < 4; ++m) { bf16* rowp = H + (size_t)(u.row0 + ai * 128 + wr * 64 + m * 16 + fr) * ED + u.col0 + wc * 32 + 8 * fq; f32x4 o[2];
#pragma unroll
                for (int n = 0; n < 2; ++n)
#pragma unroll
                    for (int j = 0; j < 4; ++j) { const float g = acc[ai][0][m][n][j], up = acc[ai][1][m][n][j]; o[n][j] = g / (1.0f + __expf(-g)) * up; }
                *(u32x4*)rowp = pack_bf16x8(o[0], o[1]); }
    }
};
struct EpiMoeDown {
    static constexpr bool PERM = true;
    bf16* slots; const int* lists; const float* gates; bf16* trash;
    __device__ __forceinline__ void operator()(const f32x4 (&acc)[2][2][4][2], const pg8::UnitG& u, int wr, int wc, int fr, int fq) const {
        const int e = u.aux; const int* le = lists + (size_t)(e < 64 ? e : 0) * T + u.row0; const float* ge = gates + (size_t)(e < 64 ? e : 0) * T + u.row0;
#pragma unroll
        for (int ai = 0; ai < 2; ++ai)
#pragma unroll
            for (int m = 0; m < 4; ++m) { const int r = ai * 128 + wr * 64 + m * 16 + fr; const bool ok = r < u.gcnt; const int rc = ok ? r : 0;
                int id = le[rc]; float gt = ge[rc];
                if (e >= 64) { id = (u.row0 + rc) * 16 + 8; gt = 1.0f; }
                bf16* rowp = slots + (size_t)((id >> 4) * NSLOT + (id & 15)) * D + u.col0;
                rowp = ok ? rowp : trash; rowp += wc * 32 + 8 * fq;
#pragma unroll
                for (int bj = 0; bj < 2; ++bj) *(u32x4*)(rowp + bj * 128) = pack_bf16x8(acc[ai][bj][m][0] * gt, acc[ai][bj][m][1] * gt);
                asm volatile("" ::: "memory"); }
    }
};

template <bool HILO>
__device__ __forceinline__ void conv_item(const float* W, int ldw, bf16* WT, bf16* WTlo, int ldk, int k0, int n0, int drow0, float scale, LAS float* scr, int lane) {
#pragma unroll 8
    for (int i = 0; i < 32; ++i) { const int kk = 2 * i + (lane >> 5); scr[kk * 33 + (lane & 31)] = W[(size_t)(k0 + kk) * ldw + n0 + (lane & 31)] * scale; }
    LDS_WAIT(); asm volatile("" ::: "memory");
    const int c = lane & 7;
#pragma unroll
    for (int j = 0; j < 4; ++j) { const int n = (lane >> 3) + 8 * j; const LAS float* s = scr + (8 * c) * 33 + n;
        float v[8];
#pragma unroll
        for (int q = 0; q < 8; ++q) v[q] = s[q * 33];
        u32x4 o; o.x = pk2(v[0], v[1]); o.y = pk2(v[2], v[3]); o.z = pk2(v[4], v[5]); o.w = pk2(v[6], v[7]);
        *(u32x4*)(WT + (size_t)(drow0 + n) * ldk + k0 + 8 * c) = o;
        if (HILO) { float r[8];
#pragma unroll
            for (int q = 0; q < 8; ++q) r[q] = v[q] - bf2f(f2bf(v[q]));
            u32x4 o2; o2.x = pk2(r[0], r[1]); o2.y = pk2(r[2], r[3]); o2.z = pk2(r[4], r[5]); o2.w = pk2(r[6], r[7]);
            *(u32x4*)(WTlo + (size_t)(drow0 + n) * ldk + k0 + 8 * c) = o2; } }
    LDS_WAIT(); asm volatile("" ::: "memory");
}
__device__ __forceinline__ void phase_conv_mixers(const Frame& F, KP p) {
    LAS float* scr = (LAS float*)(F.lds + F.wave * 16384);
    const int gw = F.vcu * NWAVES + F.wave, NGW = F.G * NWAVES;
    constexpr int I_AIN = 16 * 288, I_AOUT = 16 * 32, I_RIN = 16 * 192, I_ROUT = 32 * 32, I_GLU = 16 * 64, I_RT = 16 * 2;
    constexpr int NITEMS = 2 * I_AIN + 2 * I_AOUT + I_RIN + I_ROUT + I_GLU + 4 * I_RT;
    unsigned char* ws = F.ws;
    for (int it = gw; it < NITEMS; it += NGW) {
        int r = it;
        if (r < 2 * I_AIN) { const int j = r / I_AIN; r %= I_AIN; const int kb = r / 288, nb = r % 288, n0 = nb * 32;
            conv_item<false>(p->in[1] + (size_t)j * D * ATT_IN, ATT_IN, (bf16*)(ws + WS_ATT_IN_T) + (size_t)j * ATT_IN * D, nullptr, D, kb * 64, n0, n0, ((n0 % 3072) < 1024) ? 0.08838834764831845f : 1.0f, scr, F.lane); continue; }
        r -= 2 * I_AIN;
        if (r < 2 * I_AOUT) { const int j = r / I_AOUT; r %= I_AOUT; const int kb = r / 32, nb = r % 32, n0 = nb * 32;
            conv_item<false>(p->in[2] + (size_t)j * D * D, D, (bf16*)(ws + WS_ATT_OUT_T) + (size_t)j * D * D, nullptr, D, kb * 64, n0, n0, 1.0f, scr, F.lane); continue; }
        r -= 2 * I_AOUT;
        if (r < I_RIN) { const int kb = r / 192, nb = r % 192, n0 = nb * 32;
            conv_item<false>(p->in[3], RET_IN, (bf16*)(ws + WS_RET_IN_T), nullptr, D, kb * 64, n0, n0, (n0 >= 1024 && n0 < 2048) ? 0.0625f : 1.0f, scr, F.lane); continue; }
        r -= I_RIN;
        if (r < I_ROUT) { const int kb = r / 32, nb = r % 32, n0 = nb * 32;
            conv_item<false>(p->in[6], D, (bf16*)(ws + WS_RET_OUT_T), nullptr, RET_V, kb * 64, n0, n0, 1.0f, scr, F.lane); continue; }
        r -= I_ROUT;
        if (r < I_GLU) { const int kb = r / 64, nb = r % 64, n0 = nb * 32; const int c = n0 & 1023, drow = (c >> 7) * 256 + (n0 >> 10) * 128 + (c & 127);
            conv_item<false>(p->in[15], 2 * D, (bf16*)(ws + WS_GLU_T), nullptr, D, kb * 64, n0, drow, 1.0f, scr, F.lane); continue; }
        r -= I_GLU;
        { const int l = r / I_RT; r %= I_RT; const int kb = r / 2, nb = r % 2, n0 = nb * 32;
            conv_item<true>(p->in[16] + (size_t)l * D * NE, NE, (bf16*)(ws + WS_RT_HI) + (size_t)l * NE * D, (bf16*)(ws + WS_RT_LO) + (size_t)l * NE * D, D, kb * 64, n0, n0, 1.0f, scr, F.lane); }
    }
}
__device__ __forceinline__ void phase_conv_moe(const Frame& F, KP p, int l) {
    LAS float* scr = (LAS float*)(F.lds + F.wave * 16384);
    const int gw = F.vcu * NWAVES + F.wave, NGW = F.G * NWAVES;
    for (int it = gw; it < 65 * 384; it += NGW) {
        const int e = it / 384, r = it % 384, which = r >> 7, rr = r & 127;
        bf16* We = (bf16*)(F.ws + WS_WMOE + (size_t)e * WMOE_E_BYTES);
        if (which < 2) { const float* src = (e < 64) ? p->in[18 + which] + ((size_t)l * NE + e) * D * ED : p->in[21 + which] + (size_t)l * D * ED;
            const int kb = rr >> 3, nb = rr & 7, n0 = nb * 32; const int drow = (n0 >> 7) * 256 + which * 128 + (n0 & 127);
            conv_item<false>(src, ED, We, nullptr, D, kb * 64, n0, drow, 1.0f, scr, F.lane);
        } else { const float* src = (e < 64) ? p->in[20] + ((size_t)l * NE + e) * ED * D : p->in[23] + (size_t)l * ED * D;
            const int kb = rr >> 5, nb = rr & 31, n0 = nb * 32;
            conv_item<false>(src, D, We + 512 * 1024, nullptr, ED, kb * 64, n0, n0, 1.0f, scr, F.lane); }
    }
}

__device__ __forceinline__ void phase_lnr(const Frame& F, KP p, int layer) {
    const float* Y = (const float*)(F.ws + WS_Y); float* X = (float*)(F.ws + WS_X); bf16* XB = (bf16*)(F.ws + WS_XB);
    const float* lng = p->in[24] + (size_t)(layer * 2) * D; const float* lnb = p->in[25] + (size_t)(layer * 2) * D;
    const bf16* rthi = (const bf16*)(F.ws + WS_RT_HI) + (size_t)layer * NE * D; const bf16* rtlo = (const bf16*)(F.ws + WS_RT_LO) + (size_t)layer * NE * D;
    const float* rbias = p->in[17] + layer * NE;
    unsigned* cnt = (unsigned*)(F.ws + WS_CTL) + CW_CNT + layer * NE * 64;
    int* lists = (int*)(F.ws + WS_LIST); float* gates = (float*)(F.ws + WS_LIST + 4 * MiB);
    constexpr int XLD = 1032;
    LAS bf16* Xhi = (LAS bf16*)F.lds; LAS bf16* Xlo = Xhi + 16 * XLD;
    LAS float* part = (LAS float*)(F.lds + 2 * 16 * XLD * 2); LAS float* logit = part + 8 * 16 * 64;
    const int lane = F.lane, w = F.wave, g4 = lane >> 4, l15 = lane & 15;
    f32x4 gv[4], bv[4];
#pragma unroll
    for (int j = 0; j < 4; ++j) { gv[j] = *(const f32x4*)(lng + 4 * lane + 256 * j); bv[j] = *(const f32x4*)(lnb + 4 * lane + 256 * j); }
    for (int tile = F.vcu; tile < T / 16; tile += F.G) {
        const int t0 = tile * 16;
#pragma unroll
        for (int rr = 0; rr < 2; ++rr) {
            const int lr = 2 * w + rr; const size_t row = (size_t)(t0 + lr);
            f32x4 v[4]; float s = 0.f;
#pragma unroll
            for (int j = 0; j < 4; ++j) { v[j] = *(const f32x4*)(Y + row * D + 4 * lane + 256 * j); s += (v[j][0] + v[j][1]) + (v[j][2] + v[j][3]); }
            const float mean = wave_sum(s, lane) * (1.f / D); float s2 = 0.f;
#pragma unroll
            for (int j = 0; j < 4; ++j) { v[j] = v[j] - mean; s2 += (v[j][0] * v[j][0] + v[j][1] * v[j][1]) + (v[j][2] * v[j][2] + v[j][3] * v[j][3]); }
            const float rstd = 1.0f / sqrtf(wave_sum(s2, lane) * (1.f / D) + LN_EPS);
#pragma unroll
            for (int j = 0; j < 4; ++j) { const f32x4 o = v[j] * rstd * gv[j] + bv[j];
                *(f32x4*)(X + row * D + 4 * lane + 256 * j) = o;
                u32x2 hi; hi.x = pk2(o[0], o[1]); hi.y = pk2(o[2], o[3]);
                *(u32x2*)(XB + row * D + 4 * lane + 256 * j) = hi;
                u32x2 lo; lo.x = pk2(o[0] - bflo(hi.x), o[1] - bfhi(hi.x)); lo.y = pk2(o[2] - bflo(hi.y), o[3] - bfhi(hi.y));
                *(LAS u32x2*)(Xhi + lr * XLD + 4 * lane + 256 * j) = hi; *(LAS u32x2*)(Xlo + lr * XLD + 4 * lane + 256 * j) = lo; }
        }
        __syncthreads();
        { f32x4 acc[4];
#pragma unroll
            for (int nt = 0; nt < 4; ++nt) acc[nt] = (f32x4){0.f, 0.f, 0.f, 0.f};
#pragma unroll
            for (int ks = 0; ks < 4; ++ks) { const int k0 = 128 * w + 32 * ks;
                const bf16x8 ahi = row_frag(Xhi, XLD, 0, k0, lane), alo = row_frag(Xlo, XLD, 0, k0, lane);
#pragma unroll
                for (int nt = 0; nt < 4; ++nt) { const size_t bo = (size_t)(16 * nt + l15) * D + k0 + 8 * g4;
                    const bf16x8 bhi = *(const bf16x8*)(rthi + bo), blo = *(const bf16x8*)(rtlo + bo);
                    acc[nt] = MFMA16(ahi, bhi, acc[nt]); acc[nt] = MFMA16(alo, bhi, acc[nt]); acc[nt] = MFMA16(ahi, blo, acc[nt]); } }
#pragma unroll
            for (int nt = 0; nt < 4; ++nt)
#pragma unroll
                for (int i = 0; i < 4; ++i) part[(w * 16 + 4 * g4 + i) * 64 + 16 * nt + l15] = acc[nt][i];
        }
        __syncthreads();
#pragma unroll
        for (int o = F.tid; o < 1024; o += NTHREADS) { float s = 0.f;
#pragma unroll
            for (int ww = 0; ww < 8; ++ww) s += part[ww * 1024 + o];
            logit[o] = s; }
        __syncthreads();
#pragma unroll
        for (int rr = 0; rr < 2; ++rr) {
            const int tok = t0 + 2 * w + rr;
            const float sc = 1.0f / (1.0f + expf(-logit[(2 * w + rr) * 64 + lane]));
            const float sel = sc + rbias[lane];
            float m1 = sel; m1 = fmaxf(m1, shx(m1, 1, lane)); m1 = fmaxf(m1, shx(m1, 2, lane)); m1 = fmaxf(m1, shx(m1, 4, lane));
            const unsigned long long eq = __ballot(sel == m1);
            const unsigned gm = (unsigned)(eq >> (lane & 56)) & 0xffu;
            const int first = (lane & 56) + __builtin_ctz(gm);
            float m2 = (lane == first) ? -INFINITY : sel; m2 = fmaxf(m2, shx(m2, 1, lane)); m2 = fmaxf(m2, shx(m2, 2, lane)); m2 = fmaxf(m2, shx(m2, 4, lane));
            const float gs = m1 + m2; const int mygrp = lane >> 3; int grank = 0;
#pragma unroll
            for (int gg = 0; gg < 8; ++gg) { const float o = rdl(gs, 8 * gg); grank += (o > gs || (o == gs && gg < mygrp)) ? 1 : 0; }
            const float mv = (grank < 4) ? sel : -INFINITY; int rank = 0;
#pragma unroll
            for (int e2 = 0; e2 < 64; ++e2) { const float o = rdl(mv, e2); rank += (o > mv || (o == mv && e2 < lane)) ? 1 : 0; }
            const bool chosen = rank < TOPK;
            const float wsum = wave_sum(chosen ? sc : 0.f, lane);
            if (chosen) { const unsigned pos = atomicAdd(cnt + lane * 64, 1u);
                lists[(size_t)lane * T + pos] = tok * 16 + rank; gates[(size_t)lane * T + pos] = sc / wsum * 2.5f; }
        }
    }
}

__device__ __forceinline__ void phase_combine(const Frame& F, KP p, int layer) {
    float* X = (float*)(F.ws + WS_X); bf16* XB = (bf16*)(F.ws + WS_XB); const bf16* slots = (const bf16*)(F.ws + WS_BIG);
    const float* lng = p->in[24] + (size_t)(layer * 2 + 1) * D; const float* lnb = p->in[25] + (size_t)(layer * 2 + 1) * D;
    float* outp = (layer == DEPTH - 1) ? p->out : X;
    const int lane = F.lane, gw = F.vcu * NWAVES + F.wave, NGW = F.G * NWAVES;
    f32x4 gv[4], bv[4];
#pragma unroll
    for (int j = 0; j < 2; ++j) { gv[2 * j] = *(const f32x4*)(lng + 8 * lane + 512 * j); gv[2 * j + 1] = *(const f32x4*)(lng + 8 * lane + 512 * j + 4);
        bv[2 * j] = *(const f32x4*)(lnb + 8 * lane + 512 * j); bv[2 * j + 1] = *(const f32x4*)(lnb + 8 * lane + 512 * j + 4); }
    for (int row = gw; row < T; row += NGW) {
        f32x4 v[4];
#pragma unroll
        for (int j = 0; j < 2; ++j) { v[2 * j] = *(const f32x4*)(X + (size_t)row * D + 8 * lane + 512 * j) * ALPHA; v[2 * j + 1] = *(const f32x4*)(X + (size_t)row * D + 8 * lane + 512 * j + 4) * ALPHA; }
#pragma unroll
        for (int k = 0; k < NSLOT; ++k)
#pragma unroll
            for (int j = 0; j < 2; ++j) { const u32x4 s = *(const u32x4*)(slots + ((size_t)row * NSLOT + k) * D + 8 * lane + 512 * j);
                v[2 * j][0] += bflo(s.x); v[2 * j][1] += bfhi(s.x); v[2 * j][2] += bflo(s.y); v[2 * j][3] += bfhi(s.y);
                v[2 * j + 1][0] += bflo(s.z); v[2 * j + 1][1] += bfhi(s.z); v[2 * j + 1][2] += bflo(s.w); v[2 * j + 1][3] += bfhi(s.w); }
        float s = 0.f;
#pragma unroll
        for (int j = 0; j < 4; ++j) s += (v[j][0] + v[j][1]) + (v[j][2] + v[j][3]);
        const float mean = wave_sum(s, lane) * (1.f / D); float s2 = 0.f;
#pragma unroll
        for (int j = 0; j < 4; ++j) { v[j] = v[j] - mean; s2 += (v[j][0] * v[j][0] + v[j][1] * v[j][1]) + (v[j][2] * v[j][2] + v[j][3] * v[j][3]); }
        const float rstd = 1.0f / sqrtf(wave_sum(s2, lane) * (1.f / D) + LN_EPS);
#pragma unroll
        for (int j = 0; j < 2; ++j) { const f32x4 o0 = v[2 * j] * rstd * gv[2 * j] + bv[2 * j], o1 = v[2 * j + 1] * rstd * gv[2 * j + 1] + bv[2 * j + 1];
            *(f32x4*)(outp + (size_t)row * D + 8 * lane + 512 * j) = o0; *(f32x4*)(outp + (size_t)row * D + 8 * lane + 512 * j + 4) = o1;
            if (layer != DEPTH - 1) *(u32x4*)(XB + (size_t)row * D + 8 * lane + 512 * j) = pack_bf16x8(o0, o1); }
    }
}

constexpr size_t AUX_OB = 96 * MiB, AUX_LSE = 128 * MiB;
__device__ __forceinline__ void phase_attn(const Frame& F, int bx) {
    const bf16* qkv = (const bf16*)(F.ws + WS_BIG); bf16* og = (bf16*)(F.ws + WS_AUX); float* lse = (float*)(F.ws + WS_AUX + AUX_LSE);
    constexpr int KLD = 136;
    LAS bf16* Ks = (LAS bf16*)F.lds; LAS bf16* Vs = Ks + 256 * KLD;
    const int lane = F.lane, w = F.wave, g4 = lane >> 4, l15 = lane & 15, qq = l15 >> 2, pp = lane & 3;
    for (int L = bx; L < 3072; L += F.G) {
        const int h = L & 7, sb = L >> 3, g = sb >> 7, rem = sb & 127, b = rem >> 6, rn = rem & 63;
        const int dsh = 2 * g, d = 1 << dsh, nbs = 6 - dsh, r = rn >> nbs, n = rn & ((1 << nbs) - 1);
        const size_t rowbase = (size_t)b * SEQ;
#pragma unroll 4
        for (int it = 0; it < 8; ++it) { const int idx = F.tid + 512 * it, c = idx >> 4, ch = idx & 15; int pos = 128 * (n - 1) + c; pos = pos < 0 ? 0 : pos;
            const bf16* src = qkv + (rowbase + (size_t)pos * d + r) * ATT_IN + g * 3072 + 1024 + h * 128 + ch * 8;
            const u32x4 kv = *(const u32x4*)src, vv = *(const u32x4*)(src + 1024);
            *(LAS u32x4*)(Ks + c * KLD + ch * 8) = kv; *(LAS u32x4*)(Vs + c * KLD + ch * 8) = vv; }
        const int qi = 16 * w + l15; const size_t qrow = rowbase + (size_t)(128 * n + qi) * d + r;
        bf16x8 qf[4];
#pragma unroll
        for (int s = 0; s < 4; ++s) qf[s] = *(const bf16x8*)(qkv + qrow * ATT_IN + g * 3072 + h * 128 + 32 * s + 8 * g4);
        __syncthreads();
        const int ws0 = (16 * w < 96) ? 16 * w : 96;
        f32x4 sacc[10];
#pragma unroll
        for (int t = 0; t < 10; ++t) { sacc[t] = (f32x4){0.f, 0.f, 0.f, 0.f};
#pragma unroll
            for (int s = 0; s < 4; ++s) sacc[t] = MFMA16(row_frag(Ks, KLD, ws0 + 16 * t, 32 * s, lane), qf[s], sacc[t]); }
        const float slope = exp2f(-(float)(h + 1)) * (float)d;
        float mx = -INFINITY;
#pragma unroll
        for (int t = 0; t < 10; ++t)
#pragma unroll
            for (int i = 0; i < 4; ++i) { const int c = ws0 + 16 * t + 4 * g4 + i, step = 128 + qi - c;
                const bool valid = (step >= 0) && (step <= 128) && (n > 0 || c >= 128);
                const float v = valid ? sacc[t][i] - slope * (float)step : -INFINITY; sacc[t][i] = v; mx = fmaxf(mx, v); }
        mx = fmaxf(mx, shx(mx, 16, lane)); mx = fmaxf(mx, shx(mx, 32, lane));
        float lsum = 0.f;
#pragma unroll
        for (int t = 0; t < 10; ++t)
#pragma unroll
            for (int i = 0; i < 4; ++i) { const float pv = __expf(sacc[t][i] - mx); sacc[t][i] = pv; lsum += pv; }
        lsum += shx(lsum, 16, lane); lsum += shx(lsum, 32, lane);
        bf16x8 pf[5];
#pragma unroll
        for (int kt = 0; kt < 5; ++kt) pf[kt] = pack8(sacc[2 * kt], sacc[2 * kt + 1]);
        f32x4 o[8];
#pragma unroll
        for (int et = 0; et < 8; ++et) { o[et] = (f32x4){0.f, 0.f, 0.f, 0.f};
#pragma unroll
            for (int kt = 0; kt < 5; ++kt) { const LAS bf16* a0 = Vs + (ws0 + 32 * kt + 4 * g4 + qq) * KLD + 32 * pp + 4 * et;
                o[et] = MFMA16(cat8(tr4(a0), tr4(a0 + 16 * KLD)), pf[kt], o[et]); } }
        const float inv = 1.0f / lsum;
        bf16* orow = og + ((size_t)g * T + qrow) * D + h * 128 + 32 * g4;
#pragma unroll
        for (int e2 = 0; e2 < 4; ++e2) *(u32x4*)(orow + 8 * e2) = pack_bf16x8(o[2 * e2] * inv, o[2 * e2 + 1] * inv);
        if (g4 == 0) lse[((size_t)g * T + qrow) * AH + h] = mx + __logf(lsum);
        __syncthreads();
    }
}
__device__ __forceinline__ void phase_attn_combine(const Frame& F) {
    const bf16* og = (const bf16*)(F.ws + WS_AUX); const float* lse = (const float*)(F.ws + WS_AUX + AUX_LSE); bf16* ob = (bf16*)(F.ws + WS_AUX + AUX_OB);
    const int lane = F.lane, gw = F.vcu * NWAVES + F.wave, NGW = F.G * NWAVES, h = lane >> 3;
    for (int row = gw; row < T; row += NGW) {
        const float l0 = lse[((size_t)0 * T + row) * AH + h], l1 = lse[((size_t)1 * T + row) * AH + h], l2 = lse[((size_t)2 * T + row) * AH + h];
        const float m = fmaxf(l0, fmaxf(l1, l2)); float w0 = __expf(l0 - m), w1 = __expf(l1 - m), w2 = __expf(l2 - m); const float inv = 1.0f / (w0 + w1 + w2); w0 *= inv; w1 *= inv; w2 *= inv;
        float a[16];
#pragma unroll
        for (int j = 0; j < 16; ++j) a[j] = 0.f;
#pragma unroll
        for (int g = 0; g < 3; ++g) { const float wg = (g == 0) ? w0 : (g == 1 ? w1 : w2);
#pragma unroll
            for (int q = 0; q < 2; ++q) { const u32x4 s = *(const u32x4*)(og + ((size_t)g * T + row) * D + 16 * lane + 8 * q);
                a[8 * q + 0] += wg * bflo(s.x); a[8 * q + 1] += wg * bfhi(s.x); a[8 * q + 2] += wg * bflo(s.y); a[8 * q + 3] += wg * bfhi(s.y);
                a[8 * q + 4] += wg * bflo(s.z); a[8 * q + 5] += wg * bfhi(s.z); a[8 * q + 6] += wg * bflo(s.w); a[8 * q + 7] += wg * bfhi(s.w); } }
#pragma unroll
        for (int q = 0; q < 2; ++q) { u32x4 o; o.x = pk2(a[8 * q], a[8 * q + 1]); o.y = pk2(a[8 * q + 2], a[8 * q + 3]); o.z = pk2(a[8 * q + 4], a[8 * q + 5]); o.w = pk2(a[8 * q + 6], a[8 * q + 7]);
            *(u32x4*)(ob + (size_t)row * D + 16 * lane + 8 * q) = o; }
    }
}

constexpr size_t BIG_YRET = 192 * MiB;
__device__ __forceinline__ void phase_ret_u(const Frame& F) {
    const bf16* proj = (const bf16*)(F.ws + WS_BIG); bf16* St = (bf16*)(F.ws + WS_AUX);
    constexpr int LD = 264;
    LAS bf16* Kt = (LAS bf16*)F.lds; LAS bf16* Vt = Kt + 128 * LD;
    const int lane = F.lane, w = F.wave, g4 = lane >> 4, l15 = lane & 15, qq = l15 >> 2, pp = lane & 3;
    for (int u = F.vcu; u < 1024; u += F.G) {
        const int eh = u & 1, h = (u >> 1) & 3, n = (u >> 3) & 63, b = u >> 9;
        const size_t row0 = (size_t)b * SEQ + (size_t)n * RC;
#pragma unroll 4
        for (int it = 0; it < 8; ++it) { const int idx = F.tid + 512 * it, j = idx >> 5, ch = idx & 31;
            const bf16* src = proj + (row0 + j) * RET_IN;
            const u32x4 kv = *(const u32x4*)(src + 1024 + h * 256 + ch * 8), vv = *(const u32x4*)(src + 2048 + h * 512 + eh * 256 + ch * 8);
            *(LAS u32x4*)(Kt + j * LD + ch * 8) = kv; *(LAS u32x4*)(Vt + j * LD + ch * 8) = vv; }
        __syncthreads();
        f32x4 acc[16][2];
#pragma unroll
        for (int mt = 0; mt < 16; ++mt) { acc[mt][0] = (f32x4){0.f, 0.f, 0.f, 0.f}; acc[mt][1] = (f32x4){0.f, 0.f, 0.f, 0.f}; }
#pragma unroll
        for (int ks = 0; ks < 4; ++ks) {
            bf16x8 bfr[2];
#pragma unroll
            for (int nt = 0; nt < 2; ++nt) { const LAS bf16* a0 = Vt + (32 * ks + 8 * g4 + qq) * LD + 32 * w + 16 * nt + 4 * pp; bfr[nt] = cat8(tr4(a0), tr4(a0 + 4 * LD)); }
#pragma unroll
            for (int mt = 0; mt < 16; ++mt) { const LAS bf16* a0 = Kt + (32 * ks + 8 * g4 + qq) * LD + 128 * (mt >> 3) + 32 * pp + 4 * (mt & 7);
                const bf16x8 afr = cat8(tr4(a0), tr4(a0 + 4 * LD));
                acc[mt][0] = MFMA16(afr, bfr[0], acc[mt][0]); acc[mt][1] = MFMA16(afr, bfr[1], acc[mt][1]); }
        }
        bf16* outb = St + ((size_t)((b * RH + h) * RNC + n)) * (RDV * RDK);
#pragma unroll
        for (int nt = 0; nt < 2; ++nt) { bf16* orow = outb + (size_t)(eh * 256 + 32 * w + 16 * nt + l15) * RDK + 32 * g4;
#pragma unroll
            for (int mh = 0; mh < 2; ++mh)
#pragma unroll
                for (int q = 0; q < 4; ++q) *(u32x4*)(orow + 128 * mh + 8 * q) = pack_bf16x8(acc[mh * 8 + 2 * q][nt], acc[mh * 8 + 2 * q + 1][nt]); }
        __syncthreads();
    }
}
__device__ __forceinline__ void phase_ret_scan(const Frame& F) {
    bf16* St = (bf16*)(F.ws + WS_AUX);
    for (int gt = F.vcu * NTHREADS + F.tid; gt < 8 * 16384; gt += F.G * NTHREADS) {
        const int bh = gt >> 14, chunk = gt & 16383, h = bh & 3;
        const float g128 = exp2f(128.0f * log2f(1.0f - exp2f(-5.0f - (float)h)));
        bf16* base = St + (size_t)bh * RNC * (RDV * RDK) + (size_t)chunk * 8;
        float c[8];
#pragma unroll
        for (int j = 0; j < 8; ++j) c[j] = 0.f;
#pragma unroll 8
        for (int n = 0; n < RNC; ++n) { bf16* pn = base + (size_t)n * (RDV * RDK); const u32x4 uv = *(const u32x4*)pn;
            u32x4 o; o.x = pk2(c[0], c[1]); o.y = pk2(c[2], c[3]); o.z = pk2(c[4], c[5]); o.w = pk2(c[6], c[7]); *(u32x4*)pn = o;
            c[0] = g128 * (c[0] + bflo(uv.x)); c[1] = g128 * (c[1] + bfhi(uv.x)); c[2] = g128 * (c[2] + bflo(uv.y)); c[3] = g128 * (c[3] + bfhi(uv.y));
            c[4] = g128 * (c[4] + bflo(uv.z)); c[5] = g128 * (c[5] + bfhi(uv.z)); c[6] = g128 * (c[6] + bflo(uv.w)); c[7] = g128 * (c[7] + bfhi(uv.w)); }
    }
}
__device__ __forceinline__ void phase_ret_out(const Frame& F, KP p) {
    const bf16* proj = (const bf16*)(F.ws + WS_BIG); const bf16* St = (const bf16*)(F.ws + WS_AUX); bf16* yret = (bf16*)(F.ws + WS_BIG + BIG_YRET);
    const float* gng = p->in[4]; const float* gnb = p->in[5];
    constexpr int LD = 264, VLD = 136;
    LAS bf16* Rs = (LAS bf16*)F.lds; LAS bf16* Vs = Rs + 128 * LD;
    const int lane = F.lane, w = F.wave, g4 = lane >> 4, l15 = lane & 15, qq = l15 >> 2, pp = lane & 3;
    for (int u = F.vcu; u < 512; u += F.G) {
        const int h = u & 3, n = (u >> 2) & 63, b = u >> 8;
        const size_t row0 = (size_t)b * SEQ + (size_t)n * RC;
#pragma unroll 4
        for (int it = 0; it < 8; ++it) { const int idx = F.tid + 512 * it, j = idx >> 5, ch = idx & 31;
            *(LAS u32x4*)(Rs + j * LD + ch * 8) = *(const u32x4*)(proj + (row0 + j) * RET_IN + 1024 + h * 256 + ch * 8); }
        const int irow = 16 * w + l15; const size_t qrow = row0 + irow;
        bf16x8 qf[8];
#pragma unroll
        for (int s = 0; s < 8; ++s) qf[s] = *(const bf16x8*)(proj + qrow * RET_IN + h * 256 + 32 * s + 8 * g4);
        __syncthreads();
        bf16x8 pf[4];
        { f32x4 sacc[8];
#pragma unroll
            for (int jt = 0; jt < 8; ++jt) { sacc[jt] = (f32x4){0.f, 0.f, 0.f, 0.f};
                if (jt <= w) {
#pragma unroll
                    for (int s = 0; s < 8; ++s) sacc[jt] = MFMA16(row_frag(Rs, LD, 16 * jt, 32 * s, lane), qf[s], sacc[jt]);
#pragma unroll
                    for (int i = 0; i < 4; ++i) if (16 * jt + 4 * g4 + i > irow) sacc[jt][i] = 0.f; } }
#pragma unroll
            for (int kt = 0; kt < 4; ++kt) pf[kt] = pack8(sacc[2 * kt], sacc[2 * kt + 1]); }
        __syncthreads();
        f32x4 acc[4][8];
        const bf16* Sn = St + ((size_t)((b * RH + h) * RNC + n)) * (RDV * RDK);
#pragma unroll
        for (int sl = 0; sl < 4; ++sl) {
#pragma unroll 4
            for (int it = 0; it < 4; ++it) { const int idx = F.tid + 512 * it, j = idx >> 4, ch = idx & 15;
                *(LAS u32x4*)(Vs + j * VLD + ch * 8) = *(const u32x4*)(proj + (row0 + j) * RET_IN + 2048 + h * 512 + sl * 128 + ch * 8); }
#pragma unroll 4
            for (int it = 0; it < 8; ++it) { const int idx = F.tid + 512 * it, e = idx >> 5, ch = idx & 31;
                *(LAS u32x4*)(Rs + e * LD + ch * 8) = *(const u32x4*)(Sn + (size_t)(sl * 128 + e) * RDK + ch * 8); }
            __syncthreads();
#pragma unroll
            for (int et = 0; et < 8; ++et) { f32x4 a = (f32x4){0.f, 0.f, 0.f, 0.f};
#pragma unroll
                for (int kt = 0; kt < 4; ++kt) if (2 * kt <= w) { const LAS bf16* a0 = Vs + (32 * kt + 4 * g4 + qq) * VLD + 32 * pp + 4 * et;
                    a = MFMA16(cat8(tr4(a0), tr4(a0 + 16 * VLD)), pf[kt], a); }
                const LAS bf16* srow = Rs + (32 * qq + 4 * et + pp) * LD + 8 * g4;
#pragma unroll
                for (int s = 0; s < 8; ++s) a = MFMA16(*(const LAS bf16x8*)(srow + 32 * s), qf[s], a);
                acc[sl][et] = a; }
            __syncthreads();
        }
        float s = 0.f;
#pragma unroll
        for (int sl = 0; sl < 4; ++sl)
#pragma unroll
            for (int et = 0; et < 8; ++et) s += (acc[sl][et][0] + acc[sl][et][1]) + (acc[sl][et][2] + acc[sl][et][3]);
        s += shx(s, 16, lane); s += shx(s, 32, lane);
        const float mean = s * (1.0f / RDV); float s2 = 0.f;
#pragma unroll
        for (int sl = 0; sl < 4; ++sl)
#pragma unroll
            for (int et = 0; et < 8; ++et) { acc[sl][et] = acc[sl][et] - mean; s2 += (acc[sl][et][0] * acc[sl][et][0] + acc[sl][et][1] * acc[sl][et][1]) + (acc[sl][et][2] * acc[sl][et][2] + acc[sl][et][3] * acc[sl][et][3]); }
        s2 += shx(s2, 16, lane); s2 += shx(s2, 32, lane);
        const float rstd = 1.0f / sqrtf(s2 * (1.0f / RDV) + LN_EPS);
#pragma unroll
        for (int sl = 0; sl < 4; ++sl) { const int c0 = h * RDV + sl * 128 + 32 * g4;
#pragma unroll
            for (int q = 0; q < 4; ++q) { const u32x4 gw = *(const u32x4*)(proj + qrow * RET_IN + 4096 + c0 + 8 * q);
                const f32x4 gg0 = *(const f32x4*)(gng + c0 + 8 * q), gg1 = *(const f32x4*)(gng + c0 + 8 * q + 4), gb0 = *(const f32x4*)(gnb + c0 + 8 * q), gb1 = *(const f32x4*)(gnb + c0 + 8 * q + 4);
                f32x4 y0 = acc[sl][2 * q] * rstd * gg0 + gb0, y1 = acc[sl][2 * q + 1] * rstd * gg1 + gb1;
                const float gv[8] = {bflo(gw.x), bfhi(gw.x), bflo(gw.y), bfhi(gw.y), bflo(gw.z), bfhi(gw.z), bflo(gw.w), bfhi(gw.w)};
#pragma unroll
                for (int j = 0; j < 4; ++j) { y0[j] *= gv[j] / (1.0f + __expf(-gv[j])); y1[j] *= gv[4 + j] / (1.0f + __expf(-gv[4 + j])); }
                *(u32x4*)(yret + qrow * RET_V + c0 + 8 * q) = pack_bf16x8(y0, y1); } }
    }
}

constexpr size_t AUX_S5E = 64 * MiB;
constexpr int S5L = 256, S5NC = SEQ / S5L;
struct S5Const { float abr, abi; float bbr[16], bbi[16]; };
__device__ __forceinline__ void s5_consts(KP p, int g, int lane, float& abr, float& abi, float (&bbr)[16], float (&bbi)[16]) {
    const float dt = expf(p->in[14][g]); const float are = p->in[7][g * SP + lane], aim = p->in[8][g * SP + lane];
    const float mag = expf(dt * are); abr = mag * cosf(dt * aim); abi = mag * sinf(dt * aim);
    const float den = are * are + aim * aim;
    const float fre = ((abr - 1.0f) * are + abi * aim) / den, fim = (abi * are - (abr - 1.0f) * aim) / den;
    const float* br = p->in[9] + ((size_t)g * SP + lane) * SGC; const float* bi = p->in[10] + ((size_t)g * SP + lane) * SGC;
#pragma unroll
    for (int q = 0; q < 4; ++q) { const f32x4 r4 = *(const f32x4*)(br + 4 * q), i4 = *(const f32x4*)(bi + 4 * q);
#pragma unroll
        for (int j = 0; j < 4; ++j) { bbr[4 * q + j] = fre * r4[j] - fim * i4[j]; bbi[4 * q + j] = fre * i4[j] + fim * r4[j]; } }
}
template <bool OUT>
__device__ __forceinline__ void phase_s5_scan(const Frame& F, KP p) {
    const float* X = (const float*)(F.ws + WS_X); float* E = (float*)(F.ws + WS_AUX + AUX_S5E); bf16* ybuf = (bf16*)(F.ws + WS_AUX);
    const int lane = F.lane, w = F.wave, g4 = lane >> 4, l15 = lane & 15;
    LAS float* ut = (LAS float*)(F.lds + w * 12288);
    LAS bf16* Hb = (LAS bf16*)(F.lds + w * 12288 + 4096);
    constexpr int HLD = 136;
    const int gw = F.vcu * NWAVES + w, NGW = F.G * NWAVES;
    for (int unit = gw; unit < BATCH * SG * S5NC; unit += NGW) {
        const int n = unit & (S5NC - 1), g = (unit >> 5) & 63, b = unit >> 11;
        float abr, abi, bbr[16], bbi[16];
        s5_consts(p, g, lane, abr, abi, bbr, bbi);
        float hr = 0.f, hi = 0.f;
        float* Eu = E + ((size_t)(b * SG + g) * S5NC + n) * 128;
        bf16x8 cf[4]; f32x4 dsk = (f32x4){0.f, 0.f, 0.f, 0.f};
        if (OUT) { hr = Eu[lane]; hi = Eu[64 + lane];
#pragma unroll
            for (int s = 0; s < 4; ++s) { const float* cp = (s < 2 ? p->in[11] : p->in[12]) + ((size_t)g * SGC + l15) * SP + 32 * (s & 1) + 8 * g4; const float sg = s < 2 ? 1.0f : -1.0f;
                const f32x4 c0 = *(const f32x4*)cp * sg, c1 = *(const f32x4*)(cp + 4) * sg; cf[s] = pack8(c0, c1); }
            dsk = *(const f32x4*)(p->in[13] + g * SGC + 4 * g4); }
        const size_t tok0 = (size_t)b * SEQ + (size_t)n * S5L;
        for (int sub = 0; sub < S5L / 64; ++sub) {
            { const float* src = X + (tok0 + sub * 64 + lane) * D + g * SGC;
#pragma unroll
                for (int q = 0; q < 4; ++q) *(LAS f32x4*)(ut + lane * 16 + 4 * q) = *(const f32x4*)(src + 4 * q); }
            LDS_WAIT(); asm volatile("" ::: "memory");
            for (int blk = 0; blk < 4; ++blk) {
#pragma unroll 4
                for (int tt = 0; tt < 16; ++tt) { const LAS float* up = ut + (blk * 16 + tt) * 16;
                    float bur = 0.f, bui = 0.f;
#pragma unroll
                    for (int q = 0; q < 4; ++q) { const f32x4 u4 = *(const LAS f32x4*)(up + 4 * q);
#pragma unroll
                        for (int j = 0; j < 4; ++j) { bur += bbr[4 * q + j] * u4[j]; bui += bbi[4 * q + j] * u4[j]; } }
                    const float nr = abr * hr - abi * hi + bur, ni = abr * hi + abi * hr + bui; hr = nr; hi = ni;
                    if (OUT) { Hb[tt * HLD + lane] = (bf16)f2bf(hr); Hb[tt * HLD + 64 + lane] = (bf16)f2bf(hi); } }
                if (OUT) {
                    LDS_WAIT(); asm volatile("" ::: "memory");
                    f32x4 ya = (f32x4){0.f, 0.f, 0.f, 0.f};
#pragma unroll
                    for (int s = 0; s < 4; ++s) ya = MFMA16(cf[s], row_frag(Hb, HLD, 0, 32 * s, lane), ya);
                    const f32x4 u4 = *(const LAS f32x4*)(ut + (blk * 16 + l15) * 16 + 4 * g4);
                    f32x4 y = ya + dsk * u4;
#pragma unroll
                    for (int j = 0; j < 4; ++j) { const float v = y[j]; y[j] = 0.5f * v * (1.0f + tanhf(0.7978845608028654f * (v + 0.044715f * v * v * v))); }
                    u32x2 o; o.x = pk2(y[0], y[1]); o.y = pk2(y[2], y[3]);
                    *(u32x2*)(ybuf + (tok0 + sub * 64 + blk * 16 + l15) * D + g * SGC + 4 * g4) = o;
                    asm volatile("" ::: "memory"); }
            }
            LDS_WAIT(); asm volatile("" ::: "memory");
        }
        if (!OUT) { Eu[lane] = hr; Eu[64 + lane] = hi; }
    }
}
__device__ __forceinline__ void phase_s5_carry(const Frame& F, KP p) {
    float* E = (float*)(F.ws + WS_AUX + AUX_S5E);
    for (int gt = F.vcu * NTHREADS + F.tid; gt < BATCH * SG * SP; gt += F.G * NTHREADS) {
        const int pl = gt & 63, bg = gt >> 6, g = bg & 63;
        const float dt = expf(p->in[14][g]); const float are = p->in[7][g * SP + pl], aim = p->in[8][g * SP + pl];
        const float mag = expf(dt * are); float ar = mag * cosf(dt * aim), ai = mag * sinf(dt * aim);
#pragma unroll
        for (int q = 0; q < 8; ++q) { const float nr = ar * ar - ai * ai, ni = 2.0f * ar * ai; ar = nr; ai = ni; }
        float cr = 0.f, ci = 0.f;
        for (int n = 0; n < S5NC; ++n) { float* Eu = E + ((size_t)bg * S5NC + n) * 128; const float er = Eu[pl], ei = Eu[64 + pl];
            Eu[pl] = cr; Eu[64 + pl] = ci;
            const float nr = ar * cr - ai * ci + er, ni = ar * ci + ai * cr + ei; cr = nr; ci = ni; }
    }
}

constexpr int NPHASES = 34;
#ifndef PH_MASK
#define PH_MASK 0xFFFFFFFFu
#endif
#define PHT(t) ((PH_MASK >> (t)) & 1u)
constexpr int PLAN_OFF = 64;
__device__ __forceinline__ void moe_plan(const Frame& F, int layer) {
    volatile LAS int* tstart = (volatile LAS int*)(F.MISC + PLAN_OFF); volatile LAS int* cnts = tstart + 72;
    __syncthreads();
    if (F.wave == 0) {
        const unsigned* cnt = (const unsigned*)(F.ws + WS_CTL) + CW_CNT + layer * NE * 64;
        const int c = (int)__hip_atomic_load(cnt + F.lane * 64, __ATOMIC_RELAXED, __HIP_MEMORY_SCOPE_AGENT);
        int v = (c + 255) >> 8;
#pragma unroll
        for (int o = 1; o < 64; o <<= 1) { const int nb = __builtin_amdgcn_ds_bpermute((F.lane - o) << 2, v); if (F.lane >= o) v += nb; }
        tstart[F.lane + 1] = v; cnts[F.lane] = c;
        if (F.lane == 0) tstart[0] = 0;
        if (F.lane == 63) { tstart[65] = v + T / 256; cnts[64] = T; }
    }
    __syncthreads();
}
template <bool GATH> struct MoeSched2 {
    static constexpr bool GATHER = GATH, UNIFORMIZE = true;
    static constexpr int ncol = GATH ? 2 : 4, K = GATH ? D : ED;
    const volatile LAS int* tstart; const volatile LAS int* cnts; int ntiles, G, c, lane;
    const char* Abase; const char* Wbase; const int* lists;
    __device__ __forceinline__ bool next(int i, pg8::UnitG& u) const {
        const int nwg = ntiles * ncol; const long L = (long)i * G + c; if (L >= nwg) return false;
        int wgid = (int)L; { const int q = nwg / 8, r = nwg % 8, xcd = wgid % 8, off = wgid / 8; wgid = (xcd < r ? xcd * (q + 1) : r * (q + 1) + (xcd - r) * q) + off; }
        const int tile = wgid / ncol, pn = wgid % ncol;
        const int ta = tstart[lane], tb = tstart[lane + 1];
        const unsigned long long mm = __ballot(ta <= tile && tile < tb);
        const int e = mm ? (int)__builtin_ctzll(mm) : 64;
        const int ts = __builtin_amdgcn_readfirstlane((int)tstart[e]), ce = __builtin_amdgcn_readfirstlane((int)cnts[e]);
        const int lt = tile - ts; int valid = ce - lt * 256; valid = valid > 256 ? 256 : valid;
        u.gshift = 4; u.aux = e;
        if (GATH) {
            u.B = Wbase + (size_t)e * WMOE_E_BYTES + (size_t)pn * 256 * K * 2;
            if (e < 64) { u.A = Abase; u.gidx = lists + (size_t)e * T + lt * 256; u.gcnt = valid; }
            else { u.A = Abase + (size_t)lt * 256 * K * 2; u.gidx = nullptr; u.gcnt = 0; }
            u.row0 = tile * 256; u.col0 = pn * 128;
        } else {
            u.B = Wbase + (size_t)e * WMOE_E_BYTES + (size_t)512 * 1024 * 2 + (size_t)pn * 256 * K * 2;
            u.A = Abase + (size_t)tile * 256 * K * 2; u.gidx = nullptr; u.gcnt = valid;
            u.row0 = lt * 256; u.col0 = pn * 256;
        }
        return true;
    }
};
__device__ __forceinline__ void phase_load_x(const Frame& F, KP p) {
    const float* xin = p->in[0]; float* X = (float*)(F.ws + WS_X); bf16* XB = (bf16*)(F.ws + WS_XB);
    for (size_t i = (size_t)F.vcu * NTHREADS + F.tid; i < (size_t)T * D / 8; i += (size_t)F.G * NTHREADS) {
        const f32x4 a = *(const f32x4*)(xin + i * 8), b = *(const f32x4*)(xin + i * 8 + 4);
        *(f32x4*)(X + i * 8) = a; *(f32x4*)(X + i * 8 + 4) = b; *(u32x4*)(XB + i * 8) = pack_bf16x8(a, b); }
}

__global__ void __launch_bounds__(NTHREADS, 2) fwd_kernel(Params p_unused) {
    KP p0 = (KP)__builtin_amdgcn_kernarg_segment_ptr();
    extern __shared__ __attribute__((aligned(16))) unsigned char lds_raw[];
    Frame F0;
    F0.lds = (LAS unsigned char*)lds_raw; F0.MISC = (volatile LAS unsigned*)(F0.lds + MISC_OFF);
    F0.tid = threadIdx.x; F0.lane = F0.tid & 63; F0.wave = __builtin_amdgcn_readfirstlane(F0.tid >> 6);
    F0.G = gridDim.x; { const int bq = blockIdx.x; F0.vcu = (F0.G % 8 == 0) ? (bq % 8) * (F0.G / 8) + bq / 8 : bq; }
    F0.ws = p0->ws;
    const int bx0 = blockIdx.x;
    for (int u = F0.tid; u < (LDS_BYTES - MISC_OFF) / 4; u += NTHREADS) ((LAS unsigned*)(F0.lds + MISC_OFF))[u] = 0u;
    __syncthreads();
    XcdBarrier bar; bar.bar = (unsigned*)(p0->ws + WS_CTL) + CW_BAR; bar.x = 0; bar.st = nullptr;
    const int use_bar = p0->use_bar;
    if (use_bar) bar = xcd_barrier_post((unsigned*)(p0->ws + WS_CTL) + CW_BAR, F0.MISC + 8);
    const int lo = p0->ph_lo, hi = p0->ph_hi;
#define PHASE_BEGIN Frame F = F0; KP p = p0; asm volatile("" : "+v"(F.tid), "+v"(F.lane)); asm volatile("" : "+s"(F.wave), "+s"(F.vcu), "+s"(F.G), "+s"(F.ws), "+s"(p)); \
    int bx = bx0; asm volatile("" : "+s"(bx)); unsigned char* ws = F.ws; (void)ws; (void)bx;
#pragma unroll 1
    for (int ph = lo; ph < hi; ++ph) {
        int layer = 0, type = 0;
        if (ph > 0) { layer = ph >= 26 ? 3 : (ph >= 18 ? 2 : (ph >= 9 ? 1 : 0)); const int q = ph - (layer == 3 ? 26 : (layer == 2 ? 18 : (layer == 1 ? 9 : 1))); const int kind = layer % 3;
            if (kind == 0) type = q < 4 ? 1 + q : 14 + (q - 4); else if (kind == 1) type = q < 5 ? 5 + q : 14 + (q - 5); else type = q < 4 ? 10 + q : 14 + (q - 4); }
        const int j = layer / 3;
        if (PHT(0) && type == 0) { PHASE_BEGIN; phase_conv_mixers(F, p); phase_conv_moe(F, p, 0); phase_load_x(F, p); }
        else if (PHT(1) && type == 1) { PHASE_BEGIN; DenseSched S; S.init(ws + WS_XB, ws + WS_ATT_IN_T + (size_t)j * ATT_IN * D * 2, T, ATT_IN, D, F.G, bx); EpiStoreBf16 E{(bf16*)(ws + WS_BIG), ATT_IN};
            pg8::gemm_phase(F.lds, F.tid, D, S, E); }
        else if (PHT(2) && type == 2) { PHASE_BEGIN; phase_attn(F, bx); }
        else if (PHT(3) && type == 3) { PHASE_BEGIN; phase_attn_combine(F); }
        else if (PHT(4) && type == 4) { PHASE_BEGIN; DenseSched S; S.init(ws + WS_AUX + AUX_OB, ws + WS_ATT_OUT_T + (size_t)j * D * D * 2, T, D, D, F.G, bx); EpiResid E{(const float*)(ws + WS_X), (float*)(ws + WS_Y)};
            pg8::gemm_phase(F.lds, F.tid, D, S, E); }
        else if (PHT(5) && type == 5) { PHASE_BEGIN; DenseSched S; S.init(ws + WS_XB, ws + WS_RET_IN_T, T, RET_IN, D, F.G, bx); EpiRetIn E{(bf16*)(ws + WS_BIG), RET_IN};
            pg8::gemm_phase(F.lds, F.tid, D, S, E); }
        else if (PHT(6) && type == 6) { PHASE_BEGIN; phase_ret_u(F); }
        else if (PHT(7) && type == 7) { PHASE_BEGIN; phase_ret_scan(F); }
        else if (PHT(8) && type == 8) { PHASE_BEGIN; phase_ret_out(F, p); }
        else if (PHT(9) && type == 9) { PHASE_BEGIN; DenseSched S; S.init(ws + WS_BIG + BIG_YRET, ws + WS_RET_OUT_T, T, D, RET_V, F.G, bx); EpiResid E{(const float*)(ws + WS_X), (float*)(ws + WS_Y)};
            pg8::gemm_phase(F.lds, F.tid, RET_V, S, E); }
        else if (PHT(10) && type == 10) { PHASE_BEGIN; phase_s5_scan<false>(F, p); }
        else if (PHT(11) && type == 11) { PHASE_BEGIN; phase_s5_carry(F, p); }
        else if (PHT(12) && type == 12) { PHASE_BEGIN; phase_s5_scan<true>(F, p); }
        else if (PHT(13) && type == 13) { PHASE_BEGIN; DenseSched S; S.init(ws + WS_AUX, ws + WS_GLU_T, T, 2 * D, D, F.G, bx); EpiGluResid E{(const float*)(ws + WS_X), (float*)(ws + WS_Y)};
            pg8::gemm_phase(F.lds, F.tid, D, S, E); }
        else if (PHT(14) && type == 14) { PHASE_BEGIN; phase_lnr(F, p, layer); }
        else if (PHT(15) && type == 15) { PHASE_BEGIN; moe_plan(F, layer);
            MoeSched2<true> S; S.tstart = (const volatile LAS int*)(F.MISC + PLAN_OFF); S.cnts = S.tstart + 72; S.ntiles = __builtin_amdgcn_readfirstlane((int)S.tstart[65]); S.G = F.G; S.c = bx; S.lane = F.lane;
            S.Abase = (const char*)(ws + WS_XB); S.Wbase = (const char*)(ws + WS_WMOE); S.lists = (const int*)(ws + WS_LIST);
            EpiMoeUp E{(bf16*)(ws + WS_H)};
            pg8::gemm_phase(F.lds, F.tid, D, S, E); }
        else if (PHT(16) && type == 16) { PHASE_BEGIN; moe_plan(F, layer);
            MoeSched2<false> S; S.tstart = (const volatile LAS int*)(F.MISC + PLAN_OFF); S.cnts = S.tstart + 72; S.ntiles = __builtin_amdgcn_readfirstlane((int)S.tstart[65]); S.G = F.G; S.c = bx; S.lane = F.lane;
            S.Abase = (const char*)(ws + WS_H); S.Wbase = (const char*)(ws + WS_WMOE); S.lists = (const int*)(ws + WS_LIST);
            EpiMoeDown E{(bf16*)(ws + WS_BIG), (const int*)(ws + WS_LIST), (const float*)(ws + WS_LIST + 4 * MiB), (bf16*)(ws + WS_TRASH)};
            pg8::gemm_phase(F.lds, F.tid, ED, S, E); }
        else if (PHT(17) && type == 17) { PHASE_BEGIN; phase_combine(F, p, layer); if (layer + 1 < DEPTH) phase_conv_moe(F, p, layer + 1); }
        if (use_bar && ph + 1 < hi) xcd_barrier(bar);
    }
}

#ifndef MK_PER_PHASE
#define MK_PER_PHASE 0
#endif
extern "C" void kernel_launch(void* const* d_in, const int* in_sizes, int n_in, void* d_out, int out_size, void* d_ws, size_t ws_size, hipStream_t stream) {
    static int grid = 0;
    if (grid == 0) {
        if (n_in != 26 || in_sizes[0] != T * D || out_size != T * D || ws_size < WS_END) { fprintf(stderr, "kernel_launch: unexpected shapes / workspace (n_in %d, in0 %d, out %d, ws %zu < %zu)\n", n_in, n_in > 0 ? in_sizes[0] : -1, out_size, ws_size, (size_t)WS_END); grid = -1; return; }
        int dev = 0, cus = 0, per_cu = 0;
        if (hipGetDevice(&dev) != hipSuccess || hipDeviceGetAttribute(&cus, hipDeviceAttributeMultiprocessorCount, dev) != hipSuccess) { grid = -1; return; }
        if (hipFuncSetAttribute((const void*)fwd_kernel, hipFuncAttributeMaxDynamicSharedMemorySize, LDS_BYTES) != hipSuccess) { fprintf(stderr, "kernel_launch: hipFuncSetAttribute failed\n"); grid = -1; return; }
        if (hipOccupancyMaxActiveBlocksPerMultiprocessor(&per_cu, (const void*)fwd_kernel, NTHREADS, LDS_BYTES) != hipSuccess || per_cu < 1) { fprintf(stderr, "kernel_launch: occupancy query says %d blocks per CU\n", per_cu); per_cu = 1; }
        (void)hipGetLastError();
        grid = cus;
    }
    if (grid < 0) return;
    (void)hipMemsetAsync((char*)d_ws + WS_CTL, 0, CTL_ZERO_BYTES, stream);
    Params p{};
    for (int i = 0; i < 26; ++i) p.in[i] = (const float*)d_in[i];
    p.out = (float*)d_out; p.ws = (unsigned char*)d_ws;
#if MK_PER_PHASE
    for (int k = 0; k < NPHASES; ++k) { p.ph_lo = k; p.ph_hi = k + 1; p.use_bar = 0; hipLaunchKernelGGL(fwd_kernel, dim3(grid), dim3(NTHREADS), LDS_BYTES, stream, p); }
#else
    p.ph_lo = 0; p.ph_hi = NPHASES; p.use_bar = 1;
    hipLaunchKernelGGL(fwd_kernel, dim3(grid), dim3(NTHREADS), LDS_BYTES, stream, p);
#endif
}
```

```cpp
#include <hip/hip_runtime.h>
#include <cstdio>
#include <cstdint>

#define LAS __attribute__((address_space(3)))
#define GAS __attribute__((address_space(1)))
typedef unsigned short bf16;
typedef short bf16x8 __attribute__((ext_vector_type(8)));
typedef short bf16x4 __attribute__((ext_vector_type(4)));
typedef float f32x4 __attribute__((ext_vector_type(4)));
typedef float f32x2 __attribute__((ext_vector_type(2)));
typedef unsigned u32x4 __attribute__((ext_vector_type(4)));
typedef unsigned u32x2 __attribute__((ext_vector_type(2)));
typedef GAS unsigned gu32;

constexpr int D = 1024, BATCH = 2, SEQ = 8192, T = BATCH * SEQ, DEPTH = 4;
constexpr int AH = 8, AHD = 128, ATT_IN = 9216;
constexpr int RH = 4, RDK = 256, RDV = 512, RET_IN = 6144, RET_V = 2048, RC = 128, RNC = SEQ / RC;
constexpr int SG = 64, SGC = 16, SP = 64;
constexpr int NE = 64, TOPK = 8, NEG = 8, ED = 256, NSLOT = 9;
constexpr float LN_EPS = 1e-5f;
constexpr float ALPHA = 1.6817928305074292f;
constexpr int NWAVES = 8, NTHREADS = 512;

__device__ __forceinline__ unsigned f2bf(float f) { unsigned u = __builtin_bit_cast(unsigned, f); return (u + 0x7fffu + ((u >> 16) & 1u)) >> 16; }
__device__ __forceinline__ unsigned pk2(float lo, float hi) { return f2bf(lo) | (f2bf(hi) << 16); }
__device__ __forceinline__ unsigned pk2hw(float lo, float hi) { unsigned r; asm volatile("v_cvt_pk_bf16_f32 %0, %1, %2" : "=v"(r) : "v"(lo), "v"(hi)); return r; }
__device__ __forceinline__ float bf2f(unsigned b) { return __builtin_bit_cast(float, b << 16); }
__device__ __forceinline__ float bflo(unsigned w) { return __builtin_bit_cast(float, w << 16); }
__device__ __forceinline__ float bfhi(unsigned w) { return __builtin_bit_cast(float, w & 0xffff0000u); }
__device__ __forceinline__ float shx(float v, int m, int lane) { return __builtin_bit_cast(float, __builtin_amdgcn_ds_bpermute((lane ^ m) << 2, __builtin_bit_cast(int, v))); }
__device__ __forceinline__ int shx_i(int v, int m, int lane) { return __builtin_amdgcn_ds_bpermute((lane ^ m) << 2, v); }
__device__ __forceinline__ float rdl(float v, int src) { return __builtin_bit_cast(float, __builtin_amdgcn_readlane(__builtin_bit_cast(int, v), src)); }
__device__ __forceinline__ float wave_sum(float v, int lane) {
#pragma unroll
    for (int o = 1; o < 64; o <<= 1) v += shx(v, o, lane);
    return v;
}
#define LDS_WAIT() asm volatile("s_waitcnt lgkmcnt(0)" ::: "memory")
#define VM_WAIT() asm volatile("s_waitcnt vmcnt(0)" ::: "memory")
__device__ __forceinline__ const char* rfl_ptr(const char* p) {
    unsigned long long v = (unsigned long long)p; unsigned lo = __builtin_amdgcn_readfirstlane((unsigned)v), hi = __builtin_amdgcn_readfirstlane((unsigned)(v >> 32));
    return (const char*)(((unsigned long long)hi << 32) | lo);
}
__device__ __forceinline__ bf16x8 row_frag(const LAS bf16* base, int ld, int row0, int col0, int lane) {
    return *(const LAS bf16x8*)(base + (row0 + (lane & 15)) * ld + col0 + 8 * (lane >> 4));
}
__device__ __forceinline__ bf16x4 tr4(const LAS bf16* addr) { return __builtin_amdgcn_ds_read_tr16_b64_v4i16((LAS bf16x4*)addr); }
__device__ __forceinline__ bf16x8 cat8(bf16x4 a, bf16x4 b) { bf16x8 r; r[0] = a[0]; r[1] = a[1]; r[2] = a[2]; r[3] = a[3]; r[4] = b[0]; r[5] = b[1]; r[6] = b[2]; r[7] = b[3]; return r; }
#define MFMA16(a, b, c) __builtin_amdgcn_mfma_f32_16x16x32_bf16((a), (b), (c), 0, 0, 0)
__device__ __forceinline__ bf16x8 pack8(f32x4 a, f32x4 b) {
    u32x4 w; w.x = pk2(a[0], a[1]); w.y = pk2(a[2], a[3]); w.z = pk2(b[0], b[1]); w.w = pk2(b[2], b[3]); return __builtin_bit_cast(bf16x8, w);
}

namespace pg8 {
constexpr int BM = 256, BK = 64, HALF = 128, HTB = HALF * BK * 2, STAGE_BYTES = 8 * HTB;
__device__ __forceinline__ int lds_byte(int r, int c) { const int st = (r >> 4) * 2 + (c >> 5), rr = r & 15, cc = c & 31, ob = rr * 64 + cc * 2; return st * 1024 + (ob ^ (((ob >> 9) & 1) << 5)); }
__device__ __forceinline__ void stage_rc(int b, int& R, int& C) { const int st = b / 1024, sb = b % 1024, swz = sb ^ (((sb >> 9) & 1) << 5); R = (st >> 1) * 16 + swz / 64; C = (st & 1) * 32 + (swz % 64) / 2; }
__device__ __forceinline__ int perm32(int rho) { const int n = rho >> 4, i = rho & 15; return 8 * (i >> 2) + 4 * n + (i & 3); }

struct UnitG {
    const char* A;
    const char* B;
    const int* gidx;
    int gcnt, gshift;
    int row0, col0;
    int aux;
};

__device__ __forceinline__ void uniformize(UnitG& u) { u.A = rfl_ptr(u.A); u.B = rfl_ptr(u.B); u.gidx = (const int*)rfl_ptr((const char*)u.gidx); u.gcnt = __builtin_amdgcn_readfirstlane(u.gcnt); u.gshift = __builtin_amdgcn_readfirstlane(u.gshift);
    u.row0 = __builtin_amdgcn_readfirstlane(u.row0); u.col0 = __builtin_amdgcn_readfirstlane(u.col0); u.aux = __builtin_amdgcn_readfirstlane(u.aux); }
template <class Epi, class Sched>
__device__ __forceinline__ void gemm_phase(LAS unsigned char* lds, const int tid, const int K, const Sched& S, const Epi& E) {
    constexpr bool GATHER = Sched::GATHER;
    const int wid = __builtin_amdgcn_readfirstlane(tid >> 6), lane = tid & 63, wr = wid >> 2, wc = wid & 3, fr = lane & 15, fq = lane >> 4;
    const int nt = K / BK;
    unsigned voffB[2], vA[2][2];
#pragma unroll
    for (int i = 0; i < 2; ++i) { int R, C; stage_rc(tid * 16 + i * 8192, R, C); const int Rb = Epi::PERM ? ((R & ~31) + perm32(R & 31)) : R; voffB[i] = (unsigned)(Rb * K + C) * 2u; vA[0][i] = (unsigned)(R * K + C) * 2u; vA[1][i] = vA[0][i]; }
    const size_t kstep = (size_t)(BK * 2);
    const size_t hstep = (size_t)HALF * K * 2;
    const size_t hstepA = GATHER ? 0 : hstep;
    const unsigned ldsw = (unsigned)wid * 1024u;
    const int aoff = lds_byte(wr * 64 + fr, fq * 8), boff = lds_byte(wc * 32 + fr, fq * 8);
    LAS u32x4* park = (LAS u32x4*)(lds + STAGE_BYTES) + tid;
#define PG8_SA(b, h) (((b) * 2 + (h)) * HTB)
#define PG8_SB(b, h) ((4 + (b) * 2 + (h)) * HTB)
#define PG8_STAGE(bufoff, gbase, voff) do { _Pragma("unroll") for (int _i = 0; _i < 2; ++_i) { asm volatile("" : "+v"((voff)[_i]));   \
        __builtin_amdgcn_global_load_lds((const unsigned*)((const char*)(gbase) + (voff)[_i]), (LAS unsigned*)(lds + (bufoff) + ldsw + _i * 8192), 16, 0, 0); } } while (0)
#define PG8_LDA(dst, b, h) do { _Pragma("unroll") for (int m = 0; m < 4; ++m) _Pragma("unroll") for (int k = 0; k < 2; ++k) dst[m][k] = *(const LAS bf16x8*)(lds + PG8_SA(b, h) + aoff + m * 2048 + k * 1024); } while (0)
#define PG8_LDB(dst, b, h) do { _Pragma("unroll") for (int n = 0; n < 2; ++n) _Pragma("unroll") for (int k = 0; k < 2; ++k) dst[n][k] = *(const LAS bf16x8*)(lds + PG8_SB(b, h) + boff + n * 2048 + k * 1024); } while (0)
#define PG8_MMA(ai, bj, At, Bt) do { __builtin_amdgcn_s_setprio(1); _Pragma("unroll") for (int m = 0; m < 4; ++m) _Pragma("unroll") for (int n = 0; n < 2; ++n) _Pragma("unroll") for (int k = 0; k < 2; ++k) \
        acc[ai][bj][m][n] = __builtin_amdgcn_mfma_f32_16x16x32_bf16(Bt[n][k], At[m][k], acc[ai][bj][m][n], 0, 0, 0); __builtin_amdgcn_s_setprio(0); } while (0)
#define PG8_WAIT_V(n) asm volatile("s_waitcnt vmcnt(" #n ")" ::: "memory")
#define PG8_WAIT_L(n) asm volatile("s_waitcnt lgkmcnt(" #n ")" ::: "memory")
#define PG8_BAR __builtin_amdgcn_s_barrier()
#define PG8_SCHED __builtin_amdgcn_sched_barrier(0)
#define PG8_VOFF(u, v00, v01, v10, v11) do { int _R0, _C0, _R1, _C1; stage_rc(tid * 16, _R0, _C0); stage_rc(tid * 16 + 8192, _R1, _C1); int _r00 = _R0, _r01 = _R1, _r10 = HALF + _R0, _r11 = HALF + _R1; \
        if ((u).gidx) { const int _a = _r00 < (u).gcnt ? (u).gidx[_r00] >> (u).gshift : 0, _b = _r01 < (u).gcnt ? (u).gidx[_r01] >> (u).gshift : 0, _c = _r10 < (u).gcnt ? (u).gidx[_r10] >> (u).gshift : 0, _d = _r11 < (u).gcnt ? (u).gidx[_r11] >> (u).gshift : 0; \
            _r00 = _a; _r01 = _b; _r10 = _c; _r11 = _d; } \
        v00 = (unsigned)(_r00 * K + _C0) * 2u; v01 = (unsigned)(_r01 * K + _C1) * 2u; v10 = (unsigned)(_r10 * K + _C0) * 2u; v11 = (unsigned)(_r11 * K + _C1) * 2u; } while (0)
    UnitG cur, nxt; int ui = 0;
    if (!S.next(0, cur)) return;
    if constexpr (Sched::UNIFORMIZE) uniformize(cur);
    f32x4 acc[2][2][4][2];
#pragma unroll
    for (int a = 0; a < 2; ++a)
#pragma unroll
        for (int b = 0; b < 2; ++b)
#pragma unroll
            for (int m = 0; m < 4; ++m)
#pragma unroll
                for (int n = 0; n < 2; ++n) acc[a][b][m][n] = (f32x4){0.f, 0.f, 0.f, 0.f};
    bf16x8 At[4][2], B0[2][2], B1[2][2];
    if constexpr (GATHER) PG8_VOFF(cur, vA[0][0], vA[0][1], vA[1][0], vA[1][1]);
    const char* cA = cur.A; const char* cB = cur.B;
    PG8_STAGE(PG8_SB(0, 0), cB, voffB); PG8_STAGE(PG8_SB(0, 1), cB + hstep, voffB); PG8_STAGE(PG8_SA(0, 0), cA, vA[0]); PG8_STAGE(PG8_SA(0, 1), cA + hstepA, vA[1]);
    if (wr == 1) PG8_BAR;
    PG8_WAIT_V(2); PG8_BAR;
    PG8_STAGE(PG8_SB(1, 0), cB + kstep, voffB); PG8_STAGE(PG8_SA(1, 0), cA + kstep, vA[0]); PG8_STAGE(PG8_SB(1, 1), cB + hstep + kstep, voffB);
    PG8_WAIT_V(6); PG8_BAR;
    for (;;) {
        const bool has_next = S.next(ui + 1, nxt);
        if constexpr (Sched::UNIFORMIZE) { if (has_next) uniformize(nxt); }
        const char* nA = cA; const char* nB = cB;
        if (has_next) { nA = nxt.A; nB = nxt.B; }
        if constexpr (GATHER) { u32x4 pv; pv.x = vA[0][0]; pv.y = vA[0][1]; pv.z = vA[1][0]; pv.w = vA[1][1];
            if (has_next) PG8_VOFF(nxt, pv.x, pv.y, pv.z, pv.w);
            *park = pv; }
#pragma unroll 1
        for (int t = 0; t < nt; t += 2) {
            const bool last = (t == nt - 2);
            const char* a1 = cA + (size_t)(t + 1) * kstep;
            const char* a2 = last ? nA : cA + (size_t)(t + 2) * kstep; const char* b2 = last ? nB : cB + (size_t)(t + 2) * kstep;
            const char* a3 = a2 + kstep; const char* b3 = b2 + kstep;
            PG8_LDB(B0, 0, 0); PG8_LDB(B1, 0, 1); PG8_SCHED; PG8_LDA(At, 0, 0); PG8_STAGE(PG8_SA(1, 1), a1 + hstepA, vA[1]);
            PG8_WAIT_V(8); PG8_WAIT_L(0); PG8_BAR; PG8_MMA(0, 0, At, B0); PG8_MMA(0, 1, At, B1); PG8_BAR; PG8_SCHED;
            if constexpr (GATHER) { if (last) { const u32x4 pv = *park; vA[0][0] = pv.x; vA[0][1] = pv.y; vA[1][0] = pv.z; vA[1][1] = pv.w; } }
            PG8_LDA(At, 0, 1); PG8_STAGE(PG8_SB(0, 0), b2, voffB); PG8_STAGE(PG8_SB(0, 1), b2 + hstep, voffB); PG8_STAGE(PG8_SA(0, 0), a2, vA[0]);
            PG8_WAIT_V(8); PG8_WAIT_L(0); PG8_BAR; PG8_MMA(1, 0, At, B0); PG8_MMA(1, 1, At, B1); PG8_BAR; PG8_SCHED;
            PG8_LDB(B0, 1, 0); PG8_LDB(B1, 1, 1); PG8_SCHED; PG8_LDA(At, 1, 0); PG8_STAGE(PG8_SA(0, 1), a2 + hstepA, vA[1]);
            PG8_WAIT_V(8); PG8_WAIT_L(0); PG8_BAR; PG8_MMA(0, 0, At, B0); PG8_MMA(0, 1, At, B1); PG8_BAR; PG8_SCHED;
            PG8_LDA(At, 1, 1); PG8_STAGE(PG8_SB(1, 0), b3, voffB); PG8_STAGE(PG8_SB(1, 1), b3 + hstep, voffB); PG8_STAGE(PG8_SA(1, 0), a3, vA[0]);
            PG8_WAIT_V(8); PG8_WAIT_L(0); PG8_BAR; PG8_MMA(1, 0, At, B0); PG8_MMA(1, 1, At, B1); PG8_BAR; PG8_SCHED;
        }
        if (wr == 0) PG8_BAR;
        E(acc, cur, wr, wc, fr, fq);
        if (!has_next) break;
#pragma unroll
        for (int a = 0; a < 2; ++a)
#pragma unroll
            for (int b = 0; b < 2; ++b)
#pragma unroll
                for (int m = 0; m < 4; ++m)
#pragma unroll
                    for (int n = 0; n < 2; ++n) acc[a][b][m][n] = (f32x4){0.f, 0.f, 0.f, 0.f};
        cur = nxt; cA = nA; cB = nB; ++ui;
        if (wr == 1) PG8_BAR;
    }
    PG8_WAIT_V(0);
    PG8_BAR;
#undef PG8_SA
#undef PG8_SB
#undef PG8_STAGE
#undef PG8_LDA
#undef PG8_LDB
#undef PG8_MMA
#undef PG8_WAIT_V
#undef PG8_WAIT_L
#undef PG8_BAR
#undef PG8_SCHED
#undef PG8_VOFF
}
}

constexpr size_t MiB = 1u << 20;
constexpr size_t WS_CTL = 0, CTL_ZERO_BYTES = 1 * MiB;
constexpr size_t WS_ATT_IN_T = 1 * MiB;
constexpr size_t WS_ATT_OUT_T = WS_ATT_IN_T + 36 * MiB;
constexpr size_t WS_RET_IN_T = WS_ATT_OUT_T + 4 * MiB;
constexpr size_t WS_RET_OUT_T = WS_RET_IN_T + 12 * MiB;
constexpr size_t WS_GLU_T = WS_RET_OUT_T + 4 * MiB;
constexpr size_t WS_RT_HI = WS_GLU_T + 4 * MiB;
constexpr size_t WS_RT_LO = WS_RT_HI + 512 * 1024;
constexpr size_t WS_WMOE = WS_RT_HI + 1 * MiB;
constexpr size_t WMOE_E_BYTES = (size_t)(512 * 1024 + 1024 * 256) * 2;
constexpr size_t WS_X = WS_WMOE + 98 * MiB;
constexpr size_t WS_Y = WS_X + 64 * MiB;
constexpr size_t WS_XB = WS_Y + 64 * MiB;
constexpr size_t WS_BIG = WS_XB + 32 * MiB;
constexpr size_t WS_AUX = WS_BIG + 288 * MiB;
constexpr size_t WS_H = WS_AUX + 160 * MiB;
constexpr size_t WS_LIST = WS_H + 80 * MiB;
constexpr size_t WS_TRASH = WS_LIST + 8 * MiB;
constexpr size_t WS_END = WS_TRASH + 1 * MiB;
static_assert(WS_END <= 1024 * MiB, "workspace map");
constexpr int CW_BAR = 4096;
constexpr int CW_CNT = 16384;
constexpr int CW_CHK = 65536;
constexpr int HROWS = 163840;

#define XB_TMO      128
#define XB_XCNT(j)  (256  + 64 * (j))
#define XB_XSUB(j)  (1280 + 64 * (j))
#define XB_XGEN(j)  (2304 + 64 * (j))
#define XB_TOP      3328
#define XB_TOPGEN   3392
#define XCD_BAR_WORDS 3456
#define XB_SPIN_CAP (1u << 20)
__device__ __forceinline__ unsigned xb_ld(unsigned* p)              { return __hip_atomic_load(p, __ATOMIC_RELAXED, __HIP_MEMORY_SCOPE_AGENT); }
__device__ __forceinline__ unsigned xb_add(unsigned* p, unsigned v) { return __hip_atomic_fetch_add(p, v, __ATOMIC_RELAXED, __HIP_MEMORY_SCOPE_AGENT); }
__device__ __forceinline__ unsigned xb_xcc_id() { return (unsigned)__builtin_amdgcn_s_getreg((3 << 11) | 20) & 0xFu; }
#define XB_SPIN(cond, bar) do { unsigned _sp = 0; while (cond) { __builtin_amdgcn_s_sleep(1); \
    if ((++_sp & 255u) == 0u) { if (xb_ld(&(bar)[XB_TMO])) break; if (_sp > XB_SPIN_CAP) { atomicAdd(&(bar)[XB_TMO], 1u); break; } } } } while (0)
struct XcdBarrier { unsigned* bar; unsigned x; volatile LAS unsigned* st; };
__device__ __forceinline__ XcdBarrier xcd_barrier_post(unsigned* bar, volatile LAS unsigned* st) {
    XcdBarrier b; b.bar = bar; b.x = xb_xcc_id(); b.st = st;
    if (threadIdx.x == 0) (void)xb_add(&bar[XB_XCNT(b.x)], 1u);
    return b;
}
__device__ __forceinline__ void xcd_barrier_complete(unsigned* bar, unsigned x, unsigned& nloc, unsigned& nx) {
    const unsigned G = gridDim.x * gridDim.y * gridDim.z;
    unsigned sum, cnt, mine, sp = 0u;
    for (;;) {
        sum = 0u; cnt = 0u; mine = 0u;
#pragma unroll
        for (unsigned j = 0; j < 16; ++j) { const unsigned c = xb_ld(&bar[XB_XCNT(j)]); sum += c; cnt += (c > 0u) ? 1u : 0u; mine = (j == x) ? c : mine; }
        if (sum == G) break;
        __builtin_amdgcn_s_sleep(1);
        if ((++sp & 255u) == 0u) { if (xb_ld(&bar[XB_TMO])) break; if (sp > XB_SPIN_CAP) { atomicAdd(&bar[XB_TMO], 1u); break; } }
    }
    nloc = mine > 0u ? mine : 1u; nx = cnt > 0u ? cnt : 1u;
}
__device__ __forceinline__ void xcd_barrier(const XcdBarrier& b) {
    asm volatile("s_waitcnt vmcnt(0)" ::: "memory");
    __syncthreads();
    if (threadIdx.x == 0) {
        unsigned* bar = b.bar;
        __builtin_amdgcn_s_waitcnt(0);
        unsigned nloc = b.st[0], nx = b.st[1];
        if (nloc == 0u) { xcd_barrier_complete(bar, b.x, nloc, nx); b.st[0] = nloc; b.st[1] = nx; }
        const unsigned old = xb_add(&bar[XB_XSUB(b.x)], 1u);
        const unsigned gen = old / nloc;
        if (old + 1u == (gen + 1u) * nloc) {
            __builtin_amdgcn_fence(__ATOMIC_RELEASE, "agent");
            asm volatile("s_waitcnt vmcnt(0)" ::: "memory");
            const unsigned og = xb_add(&bar[XB_TOP], 1u);
            const unsigned tg = og / nx;
            if (og + 1u == (tg + 1u) * nx) xb_add(&bar[XB_TOPGEN], 1u);
            else XB_SPIN(xb_ld(&bar[XB_TOPGEN]) == tg, bar);
            __builtin_amdgcn_fence(__ATOMIC_ACQUIRE, "agent");
            xb_add(&bar[XB_XGEN(b.x)], 1u);
            asm volatile("s_waitcnt vmcnt(0)" ::: "memory");
        } else {
            XB_SPIN(xb_ld(&bar[XB_XGEN(b.x)]) == gen, bar);
            __builtin_amdgcn_fence(__ATOMIC_ACQUIRE, "agent");
            asm volatile("s_waitcnt vmcnt(0)" ::: "memory");
        }
    }
    __syncthreads();
}

constexpr int RING_BYTES = 139264;
constexpr int MISC_OFF = RING_BYTES;
constexpr int LDS_BYTES = 147456;
struct Params {
    const float* in[26]; float* out; unsigned char* ws; int ph_lo, ph_hi; int use_bar, pad;
};
typedef const __attribute__((address_space(4))) Params* KP;
struct Frame {
    LAS unsigned char* lds; volatile LAS unsigned* MISC;
    int tid, lane, wave, vcu, G;
    unsigned char* ws;
};

struct DenseSched {
    static constexpr bool GATHER = false, UNIFORMIZE = false;
    const char* A; const char* Bt; int K, nM, nN, nwg, G, c;
    __device__ __forceinline__ void init(const void* A_, const void* Bt_, int M, int N, int K_, int G_, int c_) { A = (const char*)A_; Bt = (const char*)Bt_; K = K_; nM = M / 256; nN = N / 256; nwg = nM * nN; G = G_; c = c_; }
    __device__ __forceinline__ bool next(int i, pg8::UnitG& u) const {
        const long L = (long)i * G + c; if (L >= nwg) return false;
        int wgid = (int)L; { const int q = nwg / 8, r = nwg % 8, xcd = wgid % 8, off = wgid / 8; wgid = (xcd < r ? xcd * (q + 1) : r * (q + 1) + (xcd - r) * q) + off; }
        const int nig = 8 * nN, gid = wgid / nig, fm = gid * 8, gsz = (nM - fm) < 8 ? (nM - fm) : 8;
        const int pm = fm + ((wgid % nig) % gsz), pn = (wgid % nig) / gsz;
        u.A = A + (size_t)pm * 256 * K * 2; u.B = Bt + (size_t)pn * 256 * K * 2; u.gidx = nullptr; u.gcnt = 0; u.gshift = 0; u.row0 = pm * 256; u.col0 = pn * 256; u.aux = 0; return true;
    }
};
__device__ __forceinline__ u32x4 pack_bf16x8(const f32x4& v0, const f32x4& v1) { u32x4 w; w.x = pk2hw(v0[0], v0[1]); w.y = pk2hw(v0[2], v0[3]); w.z = pk2hw(v1[0], v1[1]); w.w = pk2hw(v1[2], v1[3]); return w; }

struct EpiStoreBf16 {
    static constexpr bool PERM = true;
    bf16* O; int ldc;
    __device__ __forceinline__ void operator()(const f32x4 (&acc)[2][2][4][2], const pg8::UnitG& u, int wr, int wc, int fr, int fq) const {
#pragma unroll
        for (int ai = 0; ai < 2; ++ai)
#pragma unroll
            for (int m = 0; m < 4; ++m) { bf16* rowp = O + (size_t)(u.row0 + ai * 128 + wr * 64 + m * 16 + fr) * ldc + u.col0 + wc * 32 + 8 * fq;
#pragma unroll
                for (int bj = 0; bj < 2; ++bj) *(u32x4*)(rowp + bj * 128) = pack_bf16x8(acc[ai][bj][m][0], acc[ai][bj][m][1]); }
    }
};
struct EpiRetIn {
    static constexpr bool PERM = true;
    bf16* O; int ldc;
    __device__ __forceinline__ void operator()(const f32x4 (&acc)[2][2][4][2], const pg8::UnitG& u, int wr, int wc, int fr, int fq) const {
        float l2g = 0.f;
        if (u.col0 < 2048) { const int h = (u.col0 & 1023) >> 8; const float g = 1.0f - exp2f(-5.0f - (float)h); l2g = log2f(g); if (u.col0 >= 1024) l2g = -l2g; }
#pragma unroll
        for (int ai = 0; ai < 2; ++ai)
#pragma unroll
            for (int m = 0; m < 4; ++m) { const int row = u.row0 + ai * 128 + wr * 64 + m * 16 + fr; const float sc = exp2f(l2g * (float)(row & 127));
                bf16* rowp = O + (size_t)row * ldc + u.col0 + wc * 32 + 8 * fq;
#pragma unroll
                for (int bj = 0; bj < 2; ++bj) *(u32x4*)(rowp + bj * 128) = pack_bf16x8(acc[ai][bj][m][0] * sc, acc[ai][bj][m][1] * sc); }
    }
};
struct EpiResid {
    static constexpr bool PERM = false;
    const float* X; float* Y;
    __device__ __forceinline__ void operator()(const f32x4 (&acc)[2][2][4][2], const pg8::UnitG& u, int wr, int wc, int fr, int fq) const {
#pragma unroll
        for (int ai = 0; ai < 2; ++ai)
#pragma unroll
            for (int m = 0; m < 4; ++m) { const size_t off = (size_t)(u.row0 + ai * 128 + wr * 64 + m * 16 + fr) * D + u.col0 + wc * 32 + 4 * fq;
#pragma unroll
                for (int bj = 0; bj < 2; ++bj)
#pragma unroll
                    for (int n = 0; n < 2; ++n) { const f32x4 xv = *(const f32x4*)(X + off + bj * 128 + n * 16); *(f32x4*)(Y + off + bj * 128 + n * 16) = xv * ALPHA + acc[ai][bj][m][n]; }
                if (m == 3) asm volatile("" ::: "memory"); }
    }
};
struct EpiGluResid {
    static constexpr bool PERM = false;
    const float* X; float* Y;
    __device__ __forceinline__ void operator()(const f32x4 (&acc)[2][2][4][2], const pg8::UnitG& u, int wr, int wc, int fr, int fq) const {
#pragma unroll
        for (int ai = 0; ai < 2; ++ai)
#pragma unroll
            for (int m = 0; m < 4; ++m) { const size_t off = (size_t)(u.row0 + ai * 128 + wr * 64 + m * 16 + fr) * D + (u.col0 >> 1) + wc * 32 + 4 * fq;
#pragma unroll
                for (int n = 0; n < 2; ++n) { const f32x4 xv = *(const f32x4*)(X + off + n * 16); const f32x4 v = acc[ai][0][m][n], g = acc[ai][1][m][n]; f32x4 o;
#pragma unroll
                    for (int j = 0; j < 4; ++j) o[j] = xv[j] * ALPHA + v[j] / (1.0f + __expf(-g[j]));
                    *(f32x4*)(Y + off + n * 16) = o; }
                if (m == 3) asm volatile("" ::: "memory"); }
    }
};
struct EpiMoeUp {
    static constexpr bool PERM = true;
    bf16* H;
    __device__ __forceinline__ void operator()(const f32x4 (&acc)[2][2][4][2], const pg8::UnitG& u, int wr, int wc, int fr, int fq) const {
#pragma unroll
        for (int ai = 0; ai < 2; ++ai)
#pragma unroll
            for (int m = 0; m < 4; ++m) { bf16* rowp = H + (size_t)(u.row0 + ai * 128 + wr * 64 + m * 16 + fr) * ED + u.col0 + wc * 32 + 8 * fq; f32x4 o[2];
#pragma unroll
                for (int n = 0; n < 2; ++n)
#pragma unroll
                    for (int j = 0; j < 4; ++j) { const float g = acc[ai][0][m][n][j], up = acc[ai][1][m][n][j]; o[n][j] = g / (1.0f + __expf(-g)) * up; }
                *(u32x4*)rowp = pack_bf16x8(o[0], o[1]); }
    }
};

template <bool HILO>
__device__ __forceinline__ void conv_item(const float* W, int ldw, bf16* WT, bf16* WTlo, int ldk, int k0, int n0, int drow0, float scale, LAS float* scr, int lane) {
#pragma unroll 8
    for (int i = 0; i < 32; ++i) { const int kk = 2 * i + (lane >> 5); scr[kk * 33 + (lane & 31)] = W[(size_t)(k0 + kk) * ldw + n0 + (lane & 31)] * scale; }
    LDS_WAIT(); asm volatile("" ::: "memory");
    const int c = lane & 7;
#pragma unroll
    for (int j = 0; j < 4; ++j) { const int n = (lane >> 3) + 8 * j; const LAS float* s = scr + (8 * c) * 33 + n;
        float v[8];
#pragma unroll
        for (int q = 0; q < 8; ++q) v[q] = s[q * 33];
        u32x4 o; o.x = pk2(v[0], v[1]); o.y = pk2(v[2], v[3]); o.z = pk2(v[4], v[5]); o.w = pk2(v[6], v[7]);
        *(u32x4*)(WT + (size_t)(drow0 + n) * ldk + k0 + 8 * c) = o;
        if (HILO) { float r[8];
#pragma unroll
            for (int q = 0; q < 8; ++q) r[q] = v[q] - bf2f(f2bf(v[q]));
            u32x4 o2; o2.x = pk2(r[0], r[1]); o2.y = pk2(r[2], r[3]); o2.z = pk2(r[4], r[5]); o2.w = pk2(r[6], r[7]);
            *(u32x4*)(WTlo + (size_t)(drow0 + n) * ldk + k0 + 8 * c) = o2; } }
    LDS_WAIT(); asm volatile("" ::: "memory");
}
__device__ __forceinline__ void phase_conv_mixers(const Frame& F, KP p) {
    LAS float* scr = (LAS float*)(F.lds + F.wave * 16384);
    const int gw = F.vcu * NWAVES + F.wave, NGW = F.G * NWAVES;
    constexpr int I_AIN = 16 * 288, I_AOUT = 16 * 32, I_RIN = 16 * 192, I_ROUT = 32 * 32, I_GLU = 16 * 64, I_RT = 16 * 2;
    constexpr int NITEMS = 2 * I_AIN + 2 * I_AOUT + I_RIN + I_ROUT + I_GLU + 4 * I_RT;
    unsigned char* ws = F.ws;
    for (int it = gw; it < NITEMS; it += NGW) {
        int r = it;
        if (r < 2 * I_AIN) { const int j = r / I_AIN; r %= I_AIN; const int kb = r / 288, nb = r % 288, n0 = nb * 32;
            conv_item<false>(p->in[1] + (size_t)j * D * ATT_IN, ATT_IN, (bf16*)(ws + WS_ATT_IN_T) + (size_t)j * ATT_IN * D, nullptr, D, kb * 64, n0, n0, ((n0 % 3072) < 1024) ? 0.08838834764831845f : 1.0f, scr, F.lane); continue; }
        r -= 2 * I_AIN;
        if (r < 2 * I_AOUT) { const int j = r / I_AOUT; r %= I_AOUT; const int kb = r / 32, nb = r % 32, n0 = nb * 32;
            conv_item<false>(p->in[2] + (size_t)j * D * D, D, (bf16*)(ws + WS_ATT_OUT_T) + (size_t)j * D * D, nullptr, D, kb * 64, n0, n0, 1.0f, scr, F.lane); continue; }
        r -= 2 * I_AOUT;
        if (r < I_RIN) { const int kb = r / 192, nb = r % 192, n0 = nb * 32;
            conv_item<false>(p->in[3], RET_IN, (bf16*)(ws + WS_RET_IN_T), nullptr, D, kb * 64, n0, n0, (n0 >= 1024 && n0 < 2048) ? 0.0625f : 1.0f, scr, F.lane); continue; }
        r -= I_RIN;
        if (r < I_ROUT) { const int kb = r / 32, nb = r % 32, n0 = nb * 32;
            conv_item<false>(p->in[6], D, (bf16*)(ws + WS_RET_OUT_T), nullptr, RET_V, kb * 64, n0, n0, 1.0f, scr, F.lane); continue; }
        r -= I_ROUT;
        if (r < I_GLU) { const int kb = r / 64, nb = r % 64, n0 = nb * 32; const int c = n0 & 1023, drow = (c >> 7) * 256 + (n0 >> 10) * 128 + (c & 127);
            conv_item<false>(p->in[15], 2 * D, (bf16*)(ws + WS_GLU_T), nullptr, D, kb * 64, n0, drow, 1.0f, scr, F.lane); continue; }
        r -= I_GLU;
        { const int l = r / I_RT; r %= I_RT; const int kb = r / 2, nb = r % 2, n0 = nb * 32;
            conv_item<true>(p->in[16] + (size_t)l * D * NE, NE, (bf16*)(ws + WS_RT_HI) + (size_t)l * NE * D, (bf16*)(ws + WS_RT_LO) + (size_t)l * NE * D, D, kb * 64, n0, n0, 1.0f, scr, F.lane); }
    }
}
__device__ __forceinline__ void phase_conv_moe(const Frame& F, KP p, int l) {
    LAS float* scr = (LAS float*)(F.lds + F.wave * 16384);
    const int gw = F.vcu * NWAVES + F.wave, NGW = F.G * NWAVES;
    for (int it = gw; it < 65 * 384; it += NGW) {
        const int e = it / 384, r = it % 384, which = r >> 7, rr = r & 127;
        bf16* We = (bf16*)(F.ws + WS_WMOE + (size_t)e * WMOE_E_BYTES);
        if (which < 2) { const float* src = (e < 64) ? p->in[18 + which] + ((size_t)l * NE + e) * D * ED : p->in[21 + which] + (size_t)l * D * ED;
            const int kb = rr >> 3, nb = rr & 7, n0 = nb * 32; const int drow = (n0 >> 7) * 256 + which * 128 + (n0 & 127);
            conv_item<false>(src, ED, We, nullptr, D, kb * 64, n0, drow, 1.0f, scr, F.lane);
        } else { const float* src = (e < 64) ? p->in[20] + ((size_t)l * NE + e) * ED * D : p->in[23] + (size_t)l * ED * D;
            const int kb = rr >> 5, nb = rr & 31, n0 = nb * 32;
            conv_item<false>(src, D, We + 512 * 1024, nullptr, ED, kb * 64, n0, n0, 1.0f, scr, F.lane); }
    }
}

__device__ __forceinline__ void phase_lnr(const Frame& F, KP p, int layer) {
    const float* Y = (const float*)(F.ws + WS_Y); float* X = (float*)(F.ws + WS_X); bf16* XB = (bf16*)(F.ws + WS_XB);
    const float* lng = p->in[24] + (size_t)(layer * 2) * D; const float* lnb = p->in[25] + (size_t)(layer * 2) * D;
    const bf16* rthi = (const bf16*)(F.ws + WS_RT_HI) + (size_t)layer * NE * D; const bf16* rtlo = (const bf16*)(F.ws + WS_RT_LO) + (size_t)layer * NE * D;
    const float* rbias = p->in[17] + layer * NE;
    unsigned* cnt = (unsigned*)(F.ws + WS_CTL) + CW_CNT + layer * NE * 64;
    int* lists = (int*)(F.ws + WS_LIST); int* tokmap = (int*)(F.ws + WS_LIST + 4 * MiB); float* tokgate = (float*)(F.ws + WS_LIST + 5 * MiB);
    constexpr int XLD = 1032;
    LAS bf16* Xhi = (LAS bf16*)F.lds; LAS bf16* Xlo = Xhi + 16 * XLD;
    LAS float* part = (LAS float*)(F.lds + 2 * 16 * XLD * 2); LAS float* logit = part + 8 * 16 * 64;
    const int lane = F.lane, w = F.wave, g4 = lane >> 4, l15 = lane & 15;
    f32x4 gv[4], bv[4];
#pragma unroll
    for (int j = 0; j < 4; ++j) { gv[j] = *(const f32x4*)(lng + 4 * lane + 256 * j); bv[j] = *(const f32x4*)(lnb + 4 * lane + 256 * j); }
    for (int tile = F.vcu; tile < T / 16; tile += F.G) {
        const int t0 = tile * 16;
#pragma unroll
        for (int rr = 0; rr < 2; ++rr) {
            const int lr = 2 * w + rr; const size_t row = (size_t)(t0 + lr);
            f32x4 v[4]; float s = 0.f;
#pragma unroll
            for (int j = 0; j < 4; ++j) { v[j] = *(const f32x4*)(Y + row * D + 4 * lane + 256 * j); s += (v[j][0] + v[j][1]) + (v[j][2] + v[j][3]); }
            const float mean = wave_sum(s, lane) * (1.f / D); float s2 = 0.f;
#pragma unroll
            for (int j = 0; j < 4; ++j) { v[j] = v[j] - mean; s2 += (v[j][0] * v[j][0] + v[j][1] * v[j][1]) + (v[j][2] * v[j][2] + v[j][3] * v[j][3]); }
            const float rstd = 1.0f / sqrtf(wave_sum(s2, lane) * (1.f / D) + LN_EPS);
#pragma unroll
            for (int j = 0; j < 4; ++j) { const f32x4 o = v[j] * rstd * gv[j] + bv[j];
                *(f32x4*)(X + row * D + 4 * lane + 256 * j) = o;
                u32x2 hi; hi.x = pk2(o[0], o[1]); hi.y = pk2(o[2], o[3]);
                *(u32x2*)(XB + row * D + 4 * lane + 256 * j) = hi;
                u32x2 lo; lo.x = pk2(o[0] - bflo(hi.x), o[1] - bfhi(hi.x)); lo.y = pk2(o[2] - bflo(hi.y), o[3] - bfhi(hi.y));
                *(LAS u32x2*)(Xhi + lr * XLD + 4 * lane + 256 * j) = hi; *(LAS u32x2*)(Xlo + lr * XLD + 4 * lane + 256 * j) = lo; }
        }
        __syncthreads();
        { f32x4 acc[4];
#pragma unroll
            for (int nt = 0; nt < 4; ++nt) acc[nt] = (f32x4){0.f, 0.f, 0.f, 0.f};
#pragma unroll
            for (int ks = 0; ks < 4; ++ks) { const int k0 = 128 * w + 32 * ks;
                const bf16x8 ahi = row_frag(Xhi, XLD, 0, k0, lane), alo = row_frag(Xlo, XLD, 0, k0, lane);
#pragma unroll
                for (int nt = 0; nt < 4; ++nt) { const size_t bo = (size_t)(16 * nt + l15) * D + k0 + 8 * g4;
                    const bf16x8 bhi = *(const bf16x8*)(rthi + bo), blo = *(const bf16x8*)(rtlo + bo);
                    acc[nt] = MFMA16(ahi, bhi, acc[nt]); acc[nt] = MFMA16(alo, bhi, acc[nt]); acc[nt] = MFMA16(ahi, blo, acc[nt]); } }
#pragma unroll
            for (int nt = 0; nt < 4; ++nt)
#pragma unroll
                for (int i = 0; i < 4; ++i) part[(w * 16 + 4 * g4 + i) * 64 + 16 * nt + l15] = acc[nt][i];
        }
        __syncthreads();
#pragma unroll
        for (int o = F.tid; o < 1024; o += NTHREADS) { float s = 0.f;
#pragma unroll
            for (int ww = 0; ww < 8; ++ww) s += part[ww * 1024 + o];
            logit[o] = s; }
        __syncthreads();
#pragma unroll
        for (int rr = 0; rr < 2; ++rr) {
            const int tok = t0 + 2 * w + rr;
            const float sc = 1.0f / (1.0f + expf(-logit[(2 * w + rr) * 64 + lane]));
            const float sel = sc + rbias[lane];
            float m1 = sel; m1 = fmaxf(m1, shx(m1, 1, lane)); m1 = fmaxf(m1, shx(m1, 2, lane)); m1 = fmaxf(m1, shx(m1, 4, lane));
            const unsigned long long eq = __ballot(sel == m1);
            const unsigned gm = (unsigned)(eq >> (lane & 56)) & 0xffu;
            const int first = (lane & 56) + __builtin_ctz(gm);
            float m2 = (lane == first) ? -INFINITY : sel; m2 = fmaxf(m2, shx(m2, 1, lane)); m2 = fmaxf(m2, shx(m2, 2, lane)); m2 = fmaxf(m2, shx(m2, 4, lane));
            const float gs = m1 + m2; const int mygrp = lane >> 3; int grank = 0;
#pragma unroll
            for (int gg = 0; gg < 8; ++gg) { const float o = rdl(gs, 8 * gg); grank += (o > gs || (o == gs && gg < mygrp)) ? 1 : 0; }
            const float mv = (grank < 4) ? sel : -INFINITY; int rank = 0;
#pragma unroll
            for (int e2 = 0; e2 < 64; ++e2) { const float o = rdl(mv, e2); rank += (o > mv || (o == mv && e2 < lane)) ? 1 : 0; }
            const bool chosen = rank < TOPK;
            const float wsum = wave_sum(chosen ? sc : 0.f, lane);
            if (chosen) { const unsigned pos = atomicAdd(cnt + lane * 64, 1u);
                lists[(size_t)lane * T + pos] = tok; tokmap[tok * 8 + rank] = (lane << 16) | (int)pos; tokgate[tok * 8 + rank] = sc / wsum * 2.5f; }
        }
    }
}

__device__ __forceinline__ void phase_combine(const Frame& F, KP p, int layer) {
    float* X = (float*)(F.ws + WS_X); bf16* XB = (bf16*)(F.ws + WS_XB); const bf16* yexp = (const bf16*)(F.ws + WS_BIG);
    const int* tokmap = (const int*)(F.ws + WS_LIST + 4 * MiB); const float* tokgate = (const float*)(F.ws + WS_LIST + 5 * MiB);
    const volatile LAS int* tstart = (const volatile LAS int*)(F.MISC + 64);
    const float* lng = p->in[24] + (size_t)(layer * 2 + 1) * D; const float* lnb = p->in[25] + (size_t)(layer * 2 + 1) * D;
    float* outp = (layer == DEPTH - 1) ? p->out : X;
    const int lane = F.lane, gw = F.vcu * NWAVES + F.wave, NGW = F.G * NWAVES;
    const int shrow0 = __builtin_amdgcn_readfirstlane((int)tstart[64]) * 256;
    f32x4 gv[4], bv[4];
#pragma unroll
    for (int j = 0; j < 2; ++j) { gv[2 * j] = *(const f32x4*)(lng + 8 * lane + 512 * j); gv[2 * j + 1] = *(const f32x4*)(lng + 8 * lane + 512 * j + 4);
        bv[2 * j] = *(const f32x4*)(lnb + 8 * lane + 512 * j); bv[2 * j + 1] = *(const f32x4*)(lnb + 8 * lane + 512 * j + 4); }
    for (int row = gw; row < T; row += NGW) {
        const int mk = tokmap[row * 8 + (lane & 7)]; const float gk = tokgate[row * 8 + (lane & 7)];
        const int rk = (int)tstart[mk >> 16] * 256 + (mk & 0xffff);
        f32x4 v[4];
#pragma unroll
        for (int j = 0; j < 2; ++j) { v[2 * j] = *(const f32x4*)(X + (size_t)row * D + 8 * lane + 512 * j) * ALPHA; v[2 * j + 1] = *(const f32x4*)(X + (size_t)row * D + 8 * lane + 512 * j + 4) * ALPHA; }
#pragma unroll
        for (int k = 0; k < NSLOT; ++k) { const int r = (k < 8) ? __builtin_amdgcn_readlane(rk, k) : shrow0 + row; const float g = (k < 8) ? rdl(gk, k) : 1.0f;
#pragma unroll
            for (int j = 0; j < 2; ++j) { const u32x4 s = *(const u32x4*)(yexp + (size_t)r * D + 8 * lane + 512 * j);
                v[2 * j][0] += g * bflo(s.x); v[2 * j][1] += g * bfhi(s.x); v[2 * j][2] += g * bflo(s.y); v[2 * j][3] += g * bfhi(s.y);
                v[2 * j + 1][0] += g * bflo(s.z); v[2 * j + 1][1] += g * bfhi(s.z); v[2 * j + 1][2] += g * bflo(s.w); v[2 * j + 1][3] += g * bfhi(s.w); } }
        float s = 0.f;
#pragma unroll
        for (int j = 0; j < 4; ++j) s += (v[j][0] + v[j][1]) + (v[j][2] + v[j][3]);
        const float mean = wave_sum(s, lane) * (1.f / D); float s2 = 0.f;
#pragma unroll
        for (int j = 0; j < 4; ++j) { v[j] = v[j] - mean; s2 += (v[j][0] * v[j][0] + v[j][1] * v[j][1]) + (v[j][2] * v[j][2] + v[j][3] * v[j][3]); }
        const float rstd = 1.0f / sqrtf(wave_sum(s2, lane) * (1.f / D) + LN_EPS);
#pragma unroll
        for (int j = 0; j < 2; ++j) { const f32x4 o0 = v[2 * j] * rstd * gv[2 * j] + bv[2 * j], o1 = v[2 * j + 1] * rstd * gv[2 * j + 1] + bv[2 * j + 1];
            *(f32x4*)(outp + (size_t)row * D + 8 * lane + 512 * j) = o0; *(f32x4*)(outp + (size_t)row * D + 8 * lane + 512 * j + 4) = o1;
            if (layer != DEPTH - 1) *(u32x4*)(XB + (size_t)row * D + 8 * lane + 512 * j) = pack_bf16x8(o0, o1); }
    }
}

constexpr size_t AUX_OB = 96 * MiB, AUX_LSE = 128 * MiB;
__device__ __forceinline__ void phase_attn(const Frame& F, int bx) {
    const bf16* qkv = (const bf16*)(F.ws + WS_BIG); bf16* og = (bf16*)(F.ws + WS_AUX); float* lse = (float*)(F.ws + WS_AUX + AUX_LSE);
    constexpr int KLD = 136;
    LAS bf16* Ks = (LAS bf16*)F.lds; LAS bf16* Vs = Ks + 256 * KLD;
    const int lane = F.lane, w = F.wave, g4 = lane >> 4, l15 = lane & 15, qq = l15 >> 2, pp = lane & 3;
    for (int L = bx; L < 3072; L += F.G) {
        const int h = L & 7, sb = L >> 3, g = sb >> 7, rem = sb & 127, b = rem >> 6, rn = rem & 63;
        const int dsh = 2 * g, d = 1 << dsh, nbs = 6 - dsh, r = rn >> nbs, n = rn & ((1 << nbs) - 1);
        const size_t rowbase = (size_t)b * SEQ;
#pragma unroll 4
        for (int it = 0; it < 8; ++it) { const int idx = F.tid + 512 * it, c = idx >> 4, ch = idx & 15; int pos = 128 * (n - 1) + c; pos = pos < 0 ? 0 : pos;
            const bf16* src = qkv + (rowbase + (size_t)pos * d + r) * ATT_IN + g * 3072 + 1024 + h * 128 + ch * 8;
            const u32x4 kv = *(const u32x4*)src, vv = *(const u32x4*)(src + 1024);
            *(LAS u32x4*)(Ks + c * KLD + ch * 8) = kv; *(LAS u32x4*)(Vs + c * KLD + ch * 8) = vv; }
        const int qi = 16 * w + l15; const size_t qrow = rowbase + (size_t)(128 * n + qi) * d + r;
        bf16x8 qf[4];
#pragma unroll
        for (int s = 0; s < 4; ++s) qf[s] = *(const bf16x8*)(qkv + qrow * ATT_IN + g * 3072 + h * 128 + 32 * s + 8 * g4);
        __syncthreads();
        const int ws0 = (16 * w < 96) ? 16 * w : 96;
        f32x4 sacc[10];
#pragma unroll
        for (int t = 0; t < 10; ++t) { sacc[t] = (f32x4){0.f, 0.f, 0.f, 0.f};
#pragma unroll
            for (int s = 0; s < 4; ++s) sacc[t] = MFMA16(row_frag(Ks, KLD, ws0 + 16 * t, 32 * s, lane), qf[s], sacc[t]); }
        const float slope = exp2f(-(float)(h + 1)) * (float)d;
        float mx = -INFINITY;
#pragma unroll
        for (int t = 0; t < 10; ++t)
#pragma unroll
            for (int i = 0; i < 4; ++i) { const int c = ws0 + 16 * t + 4 * g4 + i, step = 128 + qi - c;
                const bool valid = (step >= 0) && (step <= 128) && (n > 0 || c >= 128);
                const float v = valid ? sacc[t][i] - slope * (float)step : -INFINITY; sacc[t][i] = v; mx = fmaxf(mx, v); }
        mx = fmaxf(mx, shx(mx, 16, lane)); mx = fmaxf(mx, shx(mx, 32, lane));
        float lsum = 0.f;
#pragma unroll
        for (int t = 0; t < 10; ++t)
#pragma unroll
            for (int i = 0; i < 4; ++i) { const float pv = __expf(sacc[t][i] - mx); sacc[t][i] = pv; lsum += pv; }
        lsum += shx(lsum, 16, lane); lsum += shx(lsum, 32, lane);
        bf16x8 pf[5];
#pragma unroll
        for (int kt = 0; kt < 5; ++kt) pf[kt] = pack8(sacc[2 * kt], sacc[2 * kt + 1]);
        f32x4 o[8];
#pragma unroll
        for (int et = 0; et < 8; ++et) { o[et] = (f32x4){0.f, 0.f, 0.f, 0.f};
#pragma unroll
            for (int kt = 0; kt < 5; ++kt) { const LAS bf16* a0 = Vs + (ws0 + 32 * kt + 4 * g4 + qq) * KLD + 32 * pp + 4 * et;
                o[et] = MFMA16(cat8(tr4(a0), tr4(a0 + 16 * KLD)), pf[kt], o[et]); } }
        const float inv = 1.0f / lsum;
        bf16* orow = og + ((size_t)g * T + qrow) * D + h * 128 + 32 * g4;
#pragma unroll
        for (int e2 = 0; e2 < 4; ++e2) *(u32x4*)(orow + 8 * e2) = pack_bf16x8(o[2 * e2] * inv, o[2 * e2 + 1] * inv);
        if (g4 == 0) lse[((size_t)g * T + qrow) * AH + h] = mx + __logf(lsum);
        __syncthreads();
    }
}
__device__ __forceinline__ void phase_attn_combine(const Frame& F) {
    const bf16* og = (const bf16*)(F.ws + WS_AUX); const float* lse = (const float*)(F.ws + WS_AUX + AUX_LSE); bf16* ob = (bf16*)(F.ws + WS_AUX + AUX_OB);
    const int lane = F.lane, gw = F.vcu * NWAVES + F.wave, NGW = F.G * NWAVES, h = lane >> 3;
    for (int row = gw; row < T; row += NGW) {
        const float l0 = lse[((size_t)0 * T + row) * AH + h], l1 = lse[((size_t)1 * T + row) * AH + h], l2 = lse[((size_t)2 * T + row) * AH + h];
        const float m = fmaxf(l0, fmaxf(l1, l2)); float w0 = __expf(l0 - m), w1 = __expf(l1 - m), w2 = __expf(l2 - m); const float inv = 1.0f / (w0 + w1 + w2); w0 *= inv; w1 *= inv; w2 *= inv;
        float a[16];
#pragma unroll
        for (int j = 0; j < 16; ++j) a[j] = 0.f;
#pragma unroll
        for (int g = 0; g < 3; ++g) { const float wg = (g == 0) ? w0 : (g == 1 ? w1 : w2);
#pragma unroll
            for (int q = 0; q < 2; ++q) { const u32x4 s = *(const u32x4*)(og + ((size_t)g * T + row) * D + 16 * lane + 8 * q);
                a[8 * q + 0] += wg * bflo(s.x); a[8 * q + 1] += wg * bfhi(s.x); a[8 * q + 2] += wg * bflo(s.y); a[8 * q + 3] += wg * bfhi(s.y);
                a[8 * q + 4] += wg * bflo(s.z); a[8 * q + 5] += wg * bfhi(s.z); a[8 * q + 6] += wg * bflo(s.w); a[8 * q + 7] += wg * bfhi(s.w); } }
#pragma unroll
        for (int q = 0; q < 2; ++q) { u32x4 o; o.x = pk2(a[8 * q], a[8 * q + 1]); o.y = pk2(a[8 * q + 2], a[8 * q + 3]); o.z = pk2(a[8 * q + 4], a[8 * q + 5]); o.w = pk2(a[8 * q + 6], a[8 * q + 7]);
            *(u32x4*)(ob + (size_t)row * D + 16 * lane + 8 * q) = o; }
    }
}

constexpr size_t BIG_YRET = 192 * MiB;
__device__ __forceinline__ void phase_ret_u(const Frame& F) {
    const bf16* proj = (const bf16*)(F.ws + WS_BIG); bf16* St = (bf16*)(F.ws + WS_AUX);
    constexpr int LD = 264;
    LAS bf16* Kt = (LAS bf16*)F.lds; LAS bf16* Vt = Kt + 128 * LD;
    const int lane = F.lane, w = F.wave, g4 = lane >> 4, l15 = lane & 15, qq = l15 >> 2, pp = lane & 3;
    for (int u = F.vcu; u < 1024; u += F.G) {
        const int eh = u & 1, h = (u >> 1) & 3, n = (u >> 3) & 63, b = u >> 9;
        const size_t row0 = (size_t)b * SEQ + (size_t)n * RC;
#pragma unroll 4
        for (int it = 0; it < 8; ++it) { const int idx = F.tid + 512 * it, j = idx >> 5, ch = idx & 31;
            const bf16* src = proj + (row0 + j) * RET_IN;
            const u32x4 kv = *(const u32x4*)(src + 1024 + h * 256 + ch * 8), vv = *(const u32x4*)(src + 2048 + h * 512 + eh * 256 + ch * 8);
            *(LAS u32x4*)(Kt + j * LD + ch * 8) = kv; *(LAS u32x4*)(Vt + j * LD + ch * 8) = vv; }
        __syncthreads();
        f32x4 acc[16][2];
#pragma unroll
        for (int mt = 0; mt < 16; ++mt) { acc[mt][0] = (f32x4){0.f, 0.f, 0.f, 0.f}; acc[mt][1] = (f32x4){0.f, 0.f, 0.f, 0.f}; }
#pragma unroll
        for (int ks = 0; ks < 4; ++ks) {
            bf16x8 bfr[2];
#pragma unroll
            for (int nt = 0; nt < 2; ++nt) { const LAS bf16* a0 = Vt + (32 * ks + 8 * g4 + qq) * LD + 32 * w + 16 * nt + 4 * pp; bfr[nt] = cat8(tr4(a0), tr4(a0 + 4 * LD)); }
#pragma unroll
            for (int mt = 0; mt < 16; ++mt) { const LAS bf16* a0 = Kt + (32 * ks + 8 * g4 + qq) * LD + 128 * (mt >> 3) + 32 * pp + 4 * (mt & 7);
                const bf16x8 afr = cat8(tr4(a0), tr4(a0 + 4 * LD));
                acc[mt][0] = MFMA16(afr, bfr[0], acc[mt][0]); acc[mt][1] = MFMA16(afr, bfr[1], acc[mt][1]); }
        }
        bf16* outb = St + ((size_t)((b * RH + h) * RNC + n)) * (RDV * RDK);
#pragma unroll
        for (int nt = 0; nt < 2; ++nt) { bf16* orow = outb + (size_t)(eh * 256 + 32 * w + 16 * nt + l15) * RDK + 32 * g4;
#pragma unroll
            for (int mh = 0; mh < 2; ++mh)
#pragma unroll
                for (int q = 0; q < 4; ++q) *(u32x4*)(orow + 128 * mh + 8 * q) = pack_bf16x8(acc[mh * 8 + 2 * q][nt], acc[mh * 8 + 2 * q + 1][nt]); }
        __syncthreads();
    }
}
__device__ __forceinline__ void phase_ret_scan(const Frame& F) {
    bf16* St = (bf16*)(F.ws + WS_AUX);
    for (int gt = F.vcu * NTHREADS + F.tid; gt < 8 * 16384; gt += F.G * NTHREADS) {
        const int bh = gt >> 14, chunk = gt & 16383, h = bh & 3;
        const float g128 = exp2f(128.0f * log2f(1.0f - exp2f(-5.0f - (float)h)));
        bf16* base = St + (size_t)bh * RNC * (RDV * RDK) + (size_t)chunk * 8;
        float c[8];
#pragma unroll
        for (int j = 0; j < 8; ++j) c[j] = 0.f;
#pragma unroll 8
        for (int n = 0; n < RNC; ++n) { bf16* pn = base + (size_t)n * (RDV * RDK); const u32x4 uv = *(const u32x4*)pn;
            u32x4 o; o.x = pk2(c[0], c[1]); o.y = pk2(c[2], c[3]); o.z = pk2(c[4], c[5]); o.w = pk2(c[6], c[7]); *(u32x4*)pn = o;
            c[0] = g128 * (c[0] + bflo(uv.x)); c[1] = g128 * (c[1] + bfhi(uv.x)); c[2] = g128 * (c[2] + bflo(uv.y)); c[3] = g128 * (c[3] + bfhi(uv.y));
            c[4] = g128 * (c[4] + bflo(uv.z)); c[5] = g128 * (c[5] + bfhi(uv.z)); c[6] = g128 * (c[6] + bflo(uv.w)); c[7] = g128 * (c[7] + bfhi(uv.w)); }
    }
}
__device__ __forceinline__ void phase_ret_out(const Frame& F, KP p) {
    const bf16* proj = (const bf16*)(F.ws + WS_BIG); const bf16* St = (const bf16*)(F.ws + WS_AUX); bf16* yret = (bf16*)(F.ws + WS_BIG + BIG_YRET);
    const float* gng = p->in[4]; const float* gnb = p->in[5];
    constexpr int LD = 264, VLD = 136;
    LAS bf16* Rs = (LAS bf16*)F.lds; LAS bf16* Vs = Rs + 128 * LD;
    const int lane = F.lane, w = F.wave, g4 = lane >> 4, l15 = lane & 15, qq = l15 >> 2, pp = lane & 3;
    for (int u = F.vcu; u < 512; u += F.G) {
        const int h = u & 3, n = (u >> 2) & 63, b = u >> 8;
        const size_t row0 = (size_t)b * SEQ + (size_t)n * RC;
#pragma unroll 4
        for (int it = 0; it < 8; ++it) { const int idx = F.tid + 512 * it, j = idx >> 5, ch = idx & 31;
            *(LAS u32x4*)(Rs + j * LD + ch * 8) = *(const u32x4*)(proj + (row0 + j) * RET_IN + 1024 + h * 256 + ch * 8); }
        const int irow = 16 * w + l15; const size_t qrow = row0 + irow;
        bf16x8 qf[8];
#pragma unroll
        for (int s = 0; s < 8; ++s) qf[s] = *(const bf16x8*)(proj + qrow * RET_IN + h * 256 + 32 * s + 8 * g4);
        __syncthreads();
        bf16x8 pf[4];
        { f32x4 sacc[8];
#pragma unroll
            for (int jt = 0; jt < 8; ++jt) { sacc[jt] = (f32x4){0.f, 0.f, 0.f, 0.f};
                if (jt <= w) {
#pragma unroll
                    for (int s = 0; s < 8; ++s) sacc[jt] = MFMA16(row_frag(Rs, LD, 16 * jt, 32 * s, lane), qf[s], sacc[jt]);
#pragma unroll
                    for (int i = 0; i < 4; ++i) if (16 * jt + 4 * g4 + i > irow) sacc[jt][i] = 0.f; } }
#pragma unroll
            for (int kt = 0; kt < 4; ++kt) pf[kt] = pack8(sacc[2 * kt], sacc[2 * kt + 1]); }
        __syncthreads();
        f32x4 acc[4][8];
        const bf16* Sn = St + ((size_t)((b * RH + h) * RNC + n)) * (RDV * RDK);
#pragma unroll
        for (int sl = 0; sl < 4; ++sl) {
#pragma unroll 4
            for (int it = 0; it < 4; ++it) { const int idx = F.tid + 512 * it, j = idx >> 4, ch = idx & 15;
                *(LAS u32x4*)(Vs + j * VLD + ch * 8) = *(const u32x4*)(proj + (row0 + j) * RET_IN + 2048 + h * 512 + sl * 128 + ch * 8); }
#pragma unroll 4
            for (int it = 0; it < 8; ++it) { const int idx = F.tid + 512 * it, e = idx >> 5, ch = idx & 31;
                *(LAS u32x4*)(Rs + e * LD + ch * 8) = *(const u32x4*)(Sn + (size_t)(sl * 128 + e) * RDK + ch * 8); }
            __syncthreads();
#pragma unroll
            for (int et = 0; et < 8; ++et) { f32x4 a = (f32x4){0.f, 0.f, 0.f, 0.f};
#pragma unroll
                for (int kt = 0; kt < 4; ++kt) if (2 * kt <= w) { const LAS bf16* a0 = Vs + (32 * kt + 4 * g4 + qq) * VLD + 32 * pp + 4 * et;
                    a = MFMA16(cat8(tr4(a0), tr4(a0 + 16 * VLD)), pf[kt], a); }
                const LAS bf16* srow = Rs + (32 * qq + 4 * et + pp) * LD + 8 * g4;
#pragma unroll
                for (int s = 0; s < 8; ++s) a = MFMA16(*(const LAS bf16x8*)(srow + 32 * s), qf[s], a);
                acc[sl][et] = a; }
            __syncthreads();
        }
        float s = 0.f;
#pragma unroll
        for (int sl = 0; sl < 4; ++sl)
#pragma unroll
            for (int et = 0; et < 8; ++et) s += (acc[sl][et][0] + acc[sl][et][1]) + (acc[sl][et][2] + acc[sl][et][3]);
        s += shx(s, 16, lane); s += shx(s, 32, lane);
        const float mean = s * (1.0f / RDV); float s2 = 0.f;
#pragma unroll
        for (int sl = 0; sl < 4; ++sl)
#pragma unroll
            for (int et = 0; et < 8; ++et) { acc[sl][et] = acc[sl][et] - mean; s2 += (acc[sl][et][0] * acc[sl][et][0] + acc[sl][et][1] * acc[sl][et][1]) + (acc[sl][et][2] * acc[sl][et][2] + acc[sl][et][3] * acc[sl][et][3]); }
        s2 += shx(s2, 16, lane); s2 += shx(s2, 32, lane);
        const float rstd = 1.0f / sqrtf(s2 * (1.0f / RDV) + LN_EPS);
#pragma unroll
        for (int sl = 0; sl < 4; ++sl) { const int c0 = h * RDV + sl * 128 + 32 * g4;
#pragma unroll
            for (int q = 0; q < 4; ++q) { const u32x4 gw = *(const u32x4*)(proj + qrow * RET_IN + 4096 + c0 + 8 * q);
                const f32x4 gg0 = *(const f32x4*)(gng + c0 + 8 * q), gg1 = *(const f32x4*)(gng + c0 + 8 * q + 4), gb0 = *(const f32x4*)(gnb + c0 + 8 * q), gb1 = *(const f32x4*)(gnb + c0 + 8 * q + 4);
                f32x4 y0 = acc[sl][2 * q] * rstd * gg0 + gb0, y1 = acc[sl][2 * q + 1] * rstd * gg1 + gb1;
                const float gv[8] = {bflo(gw.x), bfhi(gw.x), bflo(gw.y), bfhi(gw.y), bflo(gw.z), bfhi(gw.z), bflo(gw.w), bfhi(gw.w)};
#pragma unroll
                for (int j = 0; j < 4; ++j) { y0[j] *= gv[j] / (1.0f + __expf(-gv[j])); y1[j] *= gv[4 + j] / (1.0f + __expf(-gv[4 + j])); }
                *(u32x4*)(yret + qrow * RET_V + c0 + 8 * q) = pack_bf16x8(y0, y1); } }
    }
}

constexpr size_t AUX_S5E = 64 * MiB;
constexpr int S5L = 256, S5NC = SEQ / S5L;
struct S5Const { float abr, abi; float bbr[16], bbi[16]; };
__device__ __forceinline__ void s5_consts(KP p, int g, int lane, float& abr, float& abi, float (&bbr)[16], float (&bbi)[16]) {
    const float dt = expf(p->in[14][g]); const float are = p->in[7][g * SP + lane], aim = p->in[8][g * SP + lane];
    const float mag = expf(dt * are); abr = mag * cosf(dt * aim); abi = mag * sinf(dt * aim);
    const float den = are * are + aim * aim;
    const float fre = ((abr - 1.0f) * are + abi * aim) / den, fim = (abi * are - (abr - 1.0f) * aim) / den;
    const float* br = p->in[9] + ((size_t)g * SP + lane) * SGC; const float* bi = p->in[10] + ((size_t)g * SP + lane) * SGC;
#pragma unroll
    for (int q = 0; q < 4; ++q) { const f32x4 r4 = *(const f32x4*)(br + 4 * q), i4 = *(const f32x4*)(bi + 4 * q);
#pragma unroll
        for (int j = 0; j < 4; ++j) { bbr[4 * q + j] = fre * r4[j] - fim * i4[j]; bbi[4 * q + j] = fre * i4[j] + fim * r4[j]; } }
}
template <bool OUT>
__device__ __forceinline__ void phase_s5_scan(const Frame& F, KP p) {
    const float* X = (const float*)(F.ws + WS_X); float* E = (float*)(F.ws + WS_AUX + AUX_S5E); bf16* ybuf = (bf16*)(F.ws + WS_AUX);
    const int lane = F.lane, w = F.wave, g4 = lane >> 4, l15 = lane & 15;
    LAS float* ut = (LAS float*)(F.lds + w * 12288);
    LAS bf16* Hb = (LAS bf16*)(F.lds + w * 12288 + 4096);
    constexpr int HLD = 136;
    const int gw = F.vcu * NWAVES + w, NGW = F.G * NWAVES;
    for (int unit = gw; unit < BATCH * SG * S5NC; unit += NGW) {
        const int n = unit & (S5NC - 1), g = (unit >> 5) & 63, b = unit >> 11;
        float abr, abi, bbr[16], bbi[16];
        s5_consts(p, g, lane, abr, abi, bbr, bbi);
        float hr = 0.f, hi = 0.f;
        float* Eu = E + ((size_t)(b * SG + g) * S5NC + n) * 128;
        bf16x8 cf[4]; f32x4 dsk = (f32x4){0.f, 0.f, 0.f, 0.f};
        if (OUT) { hr = Eu[lane]; hi = Eu[64 + lane];
#pragma unroll
            for (int s = 0; s < 4; ++s) { const float* cp = (s < 2 ? p->in[11] : p->in[12]) + ((size_t)g * SGC + l15) * SP + 32 * (s & 1) + 8 * g4; const float sg = s < 2 ? 1.0f : -1.0f;
                const f32x4 c0 = *(const f32x4*)cp * sg, c1 = *(const f32x4*)(cp + 4) * sg; cf[s] = pack8(c0, c1); }
            dsk = *(const f32x4*)(p->in[13] + g * SGC + 4 * g4); }
        const size_t tok0 = (size_t)b * SEQ + (size_t)n * S5L;
        for (int sub = 0; sub < S5L / 64; ++sub) {
            { const float* src = X + (tok0 + sub * 64 + lane) * D + g * SGC;
#pragma unroll
                for (int q = 0; q < 4; ++q) *(LAS f32x4*)(ut + lane * 16 + 4 * q) = *(const f32x4*)(src + 4 * q); }
            LDS_WAIT(); asm volatile("" ::: "memory");
            for (int blk = 0; blk < 4; ++blk) {
#pragma unroll 4
                for (int tt = 0; tt < 16; ++tt) { const LAS float* up = ut + (blk * 16 + tt) * 16;
                    float bur = 0.f, bui = 0.f;
#pragma unroll
                    for (int q = 0; q < 4; ++q) { const f32x4 u4 = *(const LAS f32x4*)(up + 4 * q);
#pragma unroll
                        for (int j = 0; j < 4; ++j) { bur += bbr[4 * q + j] * u4[j]; bui += bbi[4 * q + j] * u4[j]; } }
                    const float nr = abr * hr - abi * hi + bur, ni = abr * hi + abi * hr + bui; hr = nr; hi = ni;
                    if (OUT) { Hb[tt * HLD + lane] = (bf16)f2bf(hr); Hb[tt * HLD + 64 + lane] = (bf16)f2bf(hi); } }
                if (OUT) {
                    LDS_WAIT(); asm volatile("" ::: "memory");
                    f32x4 ya = (f32x4){0.f, 0.f, 0.f, 0.f};
#pragma unroll
                    for (int s = 0; s < 4; ++s) ya = MFMA16(cf[s], row_frag(Hb, HLD, 0, 32 * s, lane), ya);
                    const f32x4 u4 = *(const LAS f32x4*)(ut + (blk * 16 + l15) * 16 + 4 * g4);
                    f32x4 y = ya + dsk * u4;
#pragma unroll
                    for (int j = 0; j < 4; ++j) { const float v = y[j]; y[j] = 0.5f * v * (1.0f + tanhf(0.7978845608028654f * (v + 0.044715f * v * v * v))); }
                    u32x2 o; o.x = pk2(y[0], y[1]); o.y = pk2(y[2], y[3]);
                    *(u32x2*)(ybuf + (tok0 + sub * 64 + blk * 16 + l15) * D + g * SGC + 4 * g4) = o;
                    asm volatile("" ::: "memory"); }
            }
            LDS_WAIT(); asm volatile("" ::: "memory");
        }
        if (!OUT) { Eu[lane] = hr; Eu[64 + lane] = hi; }
    }
}
__device__ __forceinline__ void phase_s5_carry(const Frame& F, KP p) {
    float* E = (float*)(F.ws + WS_AUX + AUX_S5E);
    for (int gt = F.vcu * NTHREADS + F.tid; gt < BATCH * SG * SP; gt += F.G * NTHREADS) {
        const int pl = gt & 63, bg = gt >> 6, g = bg & 63;
        const float dt = expf(p->in[14][g]); const float are = p->in[7][g * SP + pl], aim = p->in[8][g * SP + pl];
        const float mag = expf(dt * are); float ar = mag * cosf(dt * aim), ai = mag * sinf(dt * aim);
#pragma unroll
        for (int q = 0; q < 8; ++q) { const float nr = ar * ar - ai * ai, ni = 2.0f * ar * ai; ar = nr; ai = ni; }
        float cr = 0.f, ci = 0.f;
        for (int n = 0; n < S5NC; ++n) { float* Eu = E + ((size_t)bg * S5NC + n) * 128; const float er = Eu[pl], ei = Eu[64 + pl];
            Eu[pl] = cr; Eu[64 + pl] = ci;
            const float nr = ar * cr - ai * ci + er, ni = ar * ci + ai * cr + ei; cr = nr; ci = ni; }
    }
}

constexpr int NPHASES = 34;
#ifndef PH_MASK
#define PH_MASK 0xFFFFFFFFu
#endif
#define PHT(t) ((PH_MASK >> (t)) & 1u)
constexpr int PLAN_OFF = 64;
__device__ __forceinline__ void moe_plan(const Frame& F, int layer) {
    volatile LAS int* tstart = (volatile LAS int*)(F.MISC + PLAN_OFF); volatile LAS int* cnts = tstart + 72;
    __syncthreads();
    if (F.wave == 0) {
        const unsigned* cnt = (const unsigned*)(F.ws + WS_CTL) + CW_CNT + layer * NE * 64;
        const int c = (int)__hip_atomic_load(cnt + F.lane * 64, __ATOMIC_RELAXED, __HIP_MEMORY_SCOPE_AGENT);
        int v = (c + 255) >> 8;
#pragma unroll
        for (int o = 1; o < 64; o <<= 1) { const int nb = __builtin_amdgcn_ds_bpermute((F.lane - o) << 2, v); if (F.lane >= o) v += nb; }
        tstart[F.lane + 1] = v; cnts[F.lane] = c;
        if (F.lane == 0) tstart[0] = 0;
        if (F.lane == 63) { tstart[65] = v + T / 256; cnts[64] = T; }
    }
    __syncthreads();
}
template <bool GATH> struct MoeSched2 {
    static constexpr bool GATHER = GATH, UNIFORMIZE = true;
    static constexpr int ncol = GATH ? 2 : 4, K = GATH ? D : ED;
    const volatile LAS int* tstart; const volatile LAS int* cnts; int ntiles, G, c, lane;
    const char* Abase; const char* Wbase; const int* lists;
    __device__ __forceinline__ bool next(int i, pg8::UnitG& u) const {
        const int nwg = ntiles * ncol; const long L = (long)i * G + c; if (L >= nwg) return false;
        int wgid = (int)L; { const int q = nwg / 8, r = nwg % 8, xcd = wgid % 8, off = wgid / 8; wgid = (xcd < r ? xcd * (q + 1) : r * (q + 1) + (xcd - r) * q) + off; }
        const int tile = wgid / ncol, pn = wgid % ncol;
        const int ta = tstart[lane], tb = tstart[lane + 1];
        const unsigned long long mm = __ballot(ta <= tile && tile < tb);
        const int e = mm ? (int)__builtin_ctzll(mm) : 64;
        const int ts = __builtin_amdgcn_readfirstlane((int)tstart[e]), ce = __builtin_amdgcn_readfirstlane((int)cnts[e]);
        const int lt = tile - ts; int valid = ce - lt * 256; valid = valid > 256 ? 256 : valid;
        u.gshift = 0; u.aux = e;
        if (GATH) {
            u.B = Wbase + (size_t)e * WMOE_E_BYTES + (size_t)pn * 256 * K * 2;
            if (e < 64) { u.A = Abase; u.gidx = lists + (size_t)e * T + lt * 256; u.gcnt = valid; }
            else { u.A = Abase + (size_t)lt * 256 * K * 2; u.gidx = nullptr; u.gcnt = 0; }
            u.row0 = tile * 256; u.col0 = pn * 128;
        } else {
            u.B = Wbase + (size_t)e * WMOE_E_BYTES + (size_t)512 * 1024 * 2 + (size_t)pn * 256 * K * 2;
            u.A = Abase + (size_t)tile * 256 * K * 2; u.gidx = nullptr; u.gcnt = valid;
            u.row0 = tile * 256; u.col0 = pn * 256;
        }
        return true;
    }
};
__device__ __forceinline__ void phase_load_x(const Frame& F, KP p) {
    const float* xin = p->in[0]; float* X = (float*)(F.ws + WS_X); bf16* XB = (bf16*)(F.ws + WS_XB);
    for (size_t i = (size_t)F.vcu * NTHREADS + F.tid; i < (size_t)T * D / 8; i += (size_t)F.G * NTHREADS) {
        const f32x4 a = *(const f32x4*)(xin + i * 8), b = *(const f32x4*)(xin + i * 8 + 4);
        *(f32x4*)(X + i * 8) = a; *(f32x4*)(X + i * 8 + 4) = b; *(u32x4*)(XB + i * 8) = pack_bf16x8(a, b); }
}

__global__ void __launch_bounds__(NTHREADS, 2) fwd_kernel(Params p_unused) {
    KP p0 = (KP)__builtin_amdgcn_kernarg_segment_ptr();
    extern __shared__ __attribute__((aligned(16))) unsigned char lds_raw[];
    Frame F0;
    F0.lds = (LAS unsigned char*)lds_raw; F0.MISC = (volatile LAS unsigned*)(F0.lds + MISC_OFF);
    F0.tid = threadIdx.x; F0.lane = F0.tid & 63; F0.wave = __builtin_amdgcn_readfirstlane(F0.tid >> 6);
    F0.G = gridDim.x; { const int bq = blockIdx.x; F0.vcu = (F0.G % 8 == 0) ? (bq % 8) * (F0.G / 8) + bq / 8 : bq; }
    F0.ws = p0->ws;
    const int bx0 = blockIdx.x;
    for (int u = F0.tid; u < (LDS_BYTES - MISC_OFF) / 4; u += NTHREADS) ((LAS unsigned*)(F0.lds + MISC_OFF))[u] = 0u;
    __syncthreads();
    XcdBarrier bar; bar.bar = (unsigned*)(p0->ws + WS_CTL) + CW_BAR; bar.x = 0; bar.st = nullptr;
    const int use_bar = p0->use_bar;
    if (use_bar) bar = xcd_barrier_post((unsigned*)(p0->ws + WS_CTL) + CW_BAR, F0.MISC + 8);
    const int lo = p0->ph_lo, hi = p0->ph_hi;
#define PHASE_BEGIN Frame F = F0; KP p = p0; asm volatile("" : "+v"(F.tid), "+v"(F.lane)); asm volatile("" : "+s"(F.wave), "+s"(F.vcu), "+s"(F.G), "+s"(F.ws), "+s"(p)); \
    int bx = bx0; asm volatile("" : "+s"(bx)); unsigned char* ws = F.ws; (void)ws; (void)bx;
#pragma unroll 1
    for (int ph = lo; ph < hi; ++ph) {
        int layer = 0, type = 0;
        if (ph > 0) { layer = ph >= 26 ? 3 : (ph >= 18 ? 2 : (ph >= 9 ? 1 : 0)); const int q = ph - (layer == 3 ? 26 : (layer == 2 ? 18 : (layer == 1 ? 9 : 1))); const int kind = layer % 3;
            if (kind == 0) type = q < 4 ? 1 + q : 14 + (q - 4); else if (kind == 1) type = q < 5 ? 5 + q : 14 + (q - 5); else type = q < 4 ? 10 + q : 14 + (q - 4); }
        const int j = layer / 3;
#ifdef REPEAT_MASK
        const int nrep = ((REPEAT_MASK >> type) & 1u) ? 2 : 1;
#else
        const int nrep = 1;
#endif
#pragma unroll 1
        for (int rep = 0; rep < nrep; ++rep) {
        if (rep > 0 && use_bar) xcd_barrier(bar);
        if (PHT(0) && type == 0) { PHASE_BEGIN; phase_conv_mixers(F, p); phase_conv_moe(F, p, 0); phase_load_x(F, p); }
        else if (PHT(1) && type == 1) { PHASE_BEGIN; DenseSched S; S.init(ws + WS_XB, ws + WS_ATT_IN_T + (size_t)j * ATT_IN * D * 2, T, ATT_IN, D, F.G, bx); EpiStoreBf16 E{(bf16*)(ws + WS_BIG), ATT_IN};
            pg8::gemm_phase(F.lds, F.tid, D, S, E); }
        else if (PHT(2) && type == 2) { PHASE_BEGIN; phase_attn(F, bx); }
        else if (PHT(3) && type == 3) { PHASE_BEGIN; phase_attn_combine(F); }
        else if (PHT(4) && type == 4) { PHASE_BEGIN; DenseSched S; S.init(ws + WS_AUX + AUX_OB, ws + WS_ATT_OUT_T + (size_t)j * D * D * 2, T, D, D, F.G, bx); EpiResid E{(const float*)(ws + WS_X), (float*)(ws + WS_Y)};
            pg8::gemm_phase(F.lds, F.tid, D, S, E); }
        else if (PHT(5) && type == 5) { PHASE_BEGIN; DenseSched S; S.init(ws + WS_XB, ws + WS_RET_IN_T, T, RET_IN, D, F.G, bx); EpiRetIn E{(bf16*)(ws + WS_BIG), RET_IN};
            pg8::gemm_phase(F.lds, F.tid, D, S, E); }
        else if (PHT(6) && type == 6) { PHASE_BEGIN; phase_ret_u(F); }
        else if (PHT(7) && type == 7) { PHASE_BEGIN; phase_ret_scan(F); }
        else if (PHT(8) && type == 8) { PHASE_BEGIN; phase_ret_out(F, p); }
        else if (PHT(9) && type == 9) { PHASE_BEGIN; DenseSched S; S.init(ws + WS_BIG + BIG_YRET, ws + WS_RET_OUT_T, T, D, RET_V, F.G, bx); EpiResid E{(const float*)(ws + WS_X), (float*)(ws + WS_Y)};
            pg8::gemm_phase(F.lds, F.tid, RET_V, S, E); }
        else if (PHT(10) && type == 10) { PHASE_BEGIN; phase_s5_scan<false>(F, p); }
        else if (PHT(11) && type == 11) { PHASE_BEGIN; phase_s5_carry(F, p); }
        else if (PHT(12) && type == 12) { PHASE_BEGIN; phase_s5_scan<true>(F, p); }
        else if (PHT(13) && type == 13) { PHASE_BEGIN; DenseSched S; S.init(ws + WS_AUX, ws + WS_GLU_T, T, 2 * D, D, F.G, bx); EpiGluResid E{(const float*)(ws + WS_X), (float*)(ws + WS_Y)};
            pg8::gemm_phase(F.lds, F.tid, D, S, E); }
        else if (PHT(14) && type == 14) { PHASE_BEGIN; phase_lnr(F, p, layer); }
        else if (PHT(15) && type == 15) { PHASE_BEGIN; moe_plan(F, layer);
            MoeSched2<true> S; S.tstart = (const volatile LAS int*)(F.MISC + PLAN_OFF); S.cnts = S.tstart + 72; S.ntiles = __builtin_amdgcn_readfirstlane((int)S.tstart[65]); S.G = F.G; S.c = bx; S.lane = F.lane;
            S.Abase = (const char*)(ws + WS_XB); S.Wbase = (const char*)(ws + WS_WMOE); S.lists = (const int*)(ws + WS_LIST);
            EpiMoeUp E{(bf16*)(ws + WS_H)};
            pg8::gemm_phase(F.lds, F.tid, D, S, E); }
        else if (PHT(16) && type == 16) { PHASE_BEGIN; moe_plan(F, layer);
            MoeSched2<false> S; S.tstart = (const volatile LAS int*)(F.MISC + PLAN_OFF); S.cnts = S.tstart + 72; S.ntiles = __builtin_amdgcn_readfirstlane((int)S.tstart[65]); S.G = F.G; S.c = bx; S.lane = F.lane;
            S.Abase = (const char*)(ws + WS_H); S.Wbase = (const char*)(ws + WS_WMOE); S.lists = (const int*)(ws + WS_LIST);
            EpiStoreBf16 E{(bf16*)(ws + WS_BIG), D};
            pg8::gemm_phase(F.lds, F.tid, ED, S, E); }
        else if (PHT(17) && type == 17) { PHASE_BEGIN; moe_plan(F, layer); phase_combine(F, p, layer); if (layer + 1 < DEPTH) phase_conv_moe(F, p, layer + 1); }
        }
        if (use_bar && ph + 1 < hi) xcd_barrier(bar);
    }
}

#ifndef MK_PER_PHASE
#define MK_PER_PHASE 0
#endif
extern "C" void kernel_launch(void* const* d_in, const int* in_sizes, int n_in, void* d_out, int out_size, void* d_ws, size_t ws_size, hipStream_t stream) {
    static int grid = 0;
    if (grid == 0) {
        if (n_in != 26 || in_sizes[0] != T * D || out_size != T * D || ws_size < WS_END) { fprintf(stderr, "kernel_launch: unexpected shapes / workspace (n_in %d, in0 %d, out %d, ws %zu < %zu)\n", n_in, n_in > 0 ? in_sizes[0] : -1, out_size, ws_size, (size_t)WS_END); grid = -1; return; }
        int dev = 0, cus = 0, per_cu = 0;
        if (hipGetDevice(&dev) != hipSuccess || hipDeviceGetAttribute(&cus, hipDeviceAttributeMultiprocessorCount, dev) != hipSuccess) { grid = -1; return; }
        if (hipFuncSetAttribute((const void*)fwd_kernel, hipFuncAttributeMaxDynamicSharedMemorySize, LDS_BYTES) != hipSuccess) { fprintf(stderr, "kernel_launch: hipFuncSetAttribute failed\n"); grid = -1; return; }
        if (hipOccupancyMaxActiveBlocksPerMultiprocessor(&per_cu, (const void*)fwd_kernel, NTHREADS, LDS_BYTES) != hipSuccess || per_cu < 1) { fprintf(stderr, "kernel_launch: occupancy query says %d blocks per CU\n", per_cu); per_cu = 1; }
        (void)hipGetLastError();
        grid = cus;
    }
    if (grid < 0) return;
    (void)hipMemsetAsync((char*)d_ws + WS_CTL, 0, CTL_ZERO_BYTES, stream);
    Params p{};
    for (int i = 0; i < 26; ++i) p.in[i] = (const float*)d_in[i];
    p.out = (float*)d_out; p.ws = (unsigned char*)d_ws;
#if MK_PER_PHASE
    for (int k = 0; k < NPHASES; ++k) { p.ph_lo = k; p.ph_hi = k + 1; p.use_bar = 0; hipLaunchKernelGGL(fwd_kernel, dim3(grid), dim3(NTHREADS), LDS_BYTES, stream, p); }
#else
    p.ph_lo = 0; p.ph_hi = NPHASES; p.use_bar = 1;
    hipLaunchKernelGGL(fwd_kernel, dim3(grid), dim3(NTHREADS), LDS_BYTES, stream, p);
#endif
}
```

```cpp
#include <hip/hip_runtime.h>
#include <cstdio>
#include <cstdint>

#define LAS __attribute__((address_space(3)))
#define GAS __attribute__((address_space(1)))
typedef unsigned short bf16;
typedef short bf16x8 __attribute__((ext_vector_type(8)));
typedef short bf16x4 __attribute__((ext_vector_type(4)));
typedef float f32x4 __attribute__((ext_vector_type(4)));
typedef float f32x2 __attribute__((ext_vector_type(2)));
typedef unsigned u32x4 __attribute__((ext_vector_type(4)));
typedef unsigned u32x2 __attribute__((ext_vector_type(2)));
typedef GAS unsigned gu32;

constexpr int D = 1024, BATCH = 2, SEQ = 8192, T = BATCH * SEQ, DEPTH = 4;
constexpr int AH = 8, AHD = 128, ATT_IN = 9216;
constexpr int RH = 4, RDK = 256, RDV = 512, RET_IN = 6144, RET_V = 2048, RC = 128, RNC = SEQ / RC;
constexpr int SG = 64, SGC = 16, SP = 64;
constexpr int NE = 64, TOPK = 8, NEG = 8, ED = 256, NSLOT = 9;
constexpr float LN_EPS = 1e-5f;
constexpr float ALPHA = 1.6817928305074292f;
constexpr int NWAVES = 8, NTHREADS = 512;

__device__ __forceinline__ unsigned f2bf(float f) { unsigned u = __builtin_bit_cast(unsigned, f); return (u + 0x7fffu + ((u >> 16) & 1u)) >> 16; }
__device__ __forceinline__ unsigned pk2(float lo, float hi) { unsigned r; asm("s_nop 1\n\tv_cvt_pk_bf16_f32 %0, %1, %2" : "=v"(r) : "v"(lo), "v"(hi)); return r; }
__device__ __forceinline__ unsigned pk2sw(float lo, float hi) { return f2bf(lo) | (f2bf(hi) << 16); }
__device__ __forceinline__ unsigned pk2hw(float lo, float hi) { unsigned r; asm volatile("v_cvt_pk_bf16_f32 %0, %1, %2" : "=v"(r) : "v"(lo), "v"(hi)); return r; }
__device__ __forceinline__ float bf2f(unsigned b) { return __builtin_bit_cast(float, b << 16); }
__device__ __forceinline__ float bflo(unsigned w) { return __builtin_bit_cast(float, w << 16); }
__device__ __forceinline__ float bfhi(unsigned w) { return __builtin_bit_cast(float, w & 0xffff0000u); }
__device__ __forceinline__ float shx(float v, int m, int lane) { return __builtin_bit_cast(float, __builtin_amdgcn_ds_bpermute((lane ^ m) << 2, __builtin_bit_cast(int, v))); }
__device__ __forceinline__ int shx_i(int v, int m, int lane) { return __builtin_amdgcn_ds_bpermute((lane ^ m) << 2, v); }
__device__ __forceinline__ float rdl(float v, int src) { return __builtin_bit_cast(float, __builtin_amdgcn_readlane(__builtin_bit_cast(int, v), src)); }
__device__ __forceinline__ float wave_sum(float v, int lane) {
#pragma unroll
    for (int o = 1; o < 64; o <<= 1) v += shx(v, o, lane);
    return v;
}
#define LDS_WAIT() asm volatile("s_waitcnt lgkmcnt(0)" ::: "memory")
#define VM_WAIT() asm volatile("s_waitcnt vmcnt(0)" ::: "memory")
__device__ __forceinline__ const char* rfl_ptr(const char* p) {
    unsigned long long v = (unsigned long long)p; unsigned lo = __builtin_amdgcn_readfirstlane((unsigned)v), hi = __builtin_amdgcn_readfirstlane((unsigned)(v >> 32));
    return (const char*)(((unsigned long long)hi << 32) | lo);
}
__device__ __forceinline__ bf16x8 row_frag(const LAS bf16* base, int ld, int row0, int col0, int lane) {
    return *(const LAS bf16x8*)(base + (row0 + (lane & 15)) * ld + col0 + 8 * (lane >> 4));
}
__device__ __forceinline__ bf16x4 tr4(const LAS bf16* addr) { return __builtin_amdgcn_ds_read_tr16_b64_v4i16((LAS bf16x4*)addr); }
__device__ __forceinline__ bf16x8 cat8(bf16x4 a, bf16x4 b) { bf16x8 r; r[0] = a[0]; r[1] = a[1]; r[2] = a[2]; r[3] = a[3]; r[4] = b[0]; r[5] = b[1]; r[6] = b[2]; r[7] = b[3]; return r; }
#define MFMA16(a, b, c) __builtin_amdgcn_mfma_f32_16x16x32_bf16((a), (b), (c), 0, 0, 0)
__device__ __forceinline__ bf16x8 pack8(f32x4 a, f32x4 b) {
    u32x4 w; w.x = pk2(a[0], a[1]); w.y = pk2(a[2], a[3]); w.z = pk2(b[0], b[1]); w.w = pk2(b[2], b[3]); return __builtin_bit_cast(bf16x8, w);
}

namespace pg8 {
constexpr int BM = 256, BK = 64, HALF = 128, HTB = HALF * BK * 2, STAGE_BYTES = 8 * HTB;
__device__ __forceinline__ int lds_byte(int r, int c) { const int st = (r >> 4) * 2 + (c >> 5), rr = r & 15, cc = c & 31, ob = rr * 64 + cc * 2; return st * 1024 + (ob ^ (((ob >> 9) & 1) << 5)); }
__device__ __forceinline__ void stage_rc(int b, int& R, int& C) { const int st = b / 1024, sb = b % 1024, swz = sb ^ (((sb >> 9) & 1) << 5); R = (st >> 1) * 16 + swz / 64; C = (st & 1) * 32 + (swz % 64) / 2; }
__device__ __forceinline__ int perm32(int rho) { const int n = rho >> 4, i = rho & 15; return 8 * (i >> 2) + 4 * n + (i & 3); }

struct UnitG {
    const char* A;
    const char* B;
    const int* gidx;
    int gcnt, gshift;
    int row0, col0;
    int aux;
};

__device__ __forceinline__ void uniformize(UnitG& u) { u.A = rfl_ptr(u.A); u.B = rfl_ptr(u.B); u.gidx = (const int*)rfl_ptr((const char*)u.gidx); u.gcnt = __builtin_amdgcn_readfirstlane(u.gcnt); u.gshift = __builtin_amdgcn_readfirstlane(u.gshift);
    u.row0 = __builtin_amdgcn_readfirstlane(u.row0); u.col0 = __builtin_amdgcn_readfirstlane(u.col0); u.aux = __builtin_amdgcn_readfirstlane(u.aux); }
template <class Epi, class Sched>
__device__ __forceinline__ void gemm_phase(LAS unsigned char* lds, const int tid, const int K, const Sched& S, const Epi& E) {
    constexpr bool GATHER = Sched::GATHER;
    const int wid = __builtin_amdgcn_readfirstlane(tid >> 6), lane = tid & 63, wr = wid >> 2, wc = wid & 3, fr = lane & 15, fq = lane >> 4;
    const int nt = K / BK;
    unsigned voffB[2], vA[2][2];
#pragma unroll
    for (int i = 0; i < 2; ++i) { int R, C; stage_rc(tid * 16 + i * 8192, R, C); const int Rb = Epi::PERM ? ((R & ~31) + perm32(R & 31)) : R; voffB[i] = (unsigned)(Rb * K + C) * 2u; vA[0][i] = (unsigned)(R * K + C) * 2u; vA[1][i] = vA[0][i]; }
    const size_t kstep = (size_t)(BK * 2);
    const size_t hstep = (size_t)HALF * K * 2;
    const size_t hstepA = GATHER ? 0 : hstep;
    const unsigned ldsw = (unsigned)wid * 1024u;
    const int aoff = lds_byte(wr * 64 + fr, fq * 8), boff = lds_byte(wc * 32 + fr, fq * 8);
    LAS u32x4* park = (LAS u32x4*)(lds + STAGE_BYTES) + tid;
#define PG8_SA(b, h) (((b) * 2 + (h)) * HTB)
#define PG8_SB(b, h) ((4 + (b) * 2 + (h)) * HTB)
#define PG8_STAGE(bufoff, gbase, voff) do { _Pragma("unroll") for (int _i = 0; _i < 2; ++_i) { asm volatile("" : "+v"((voff)[_i]));   \
        __builtin_amdgcn_global_load_lds((const unsigned*)((const char*)(gbase) + (voff)[_i]), (LAS unsigned*)(lds + (bufoff) + ldsw + _i * 8192), 16, 0, 0); } } while (0)
#define PG8_LDA(dst, b, h) do { _Pragma("unroll") for (int m = 0; m < 4; ++m) _Pragma("unroll") for (int k = 0; k < 2; ++k) dst[m][k] = *(const LAS bf16x8*)(lds + PG8_SA(b, h) + aoff + m * 2048 + k * 1024); } while (0)
#define PG8_LDB(dst, b, h) do { _Pragma("unroll") for (int n = 0; n < 2; ++n) _Pragma("unroll") for (int k = 0; k < 2; ++k) dst[n][k] = *(const LAS bf16x8*)(lds + PG8_SB(b, h) + boff + n * 2048 + k * 1024); } while (0)
#define PG8_MMA(ai, bj, At, Bt) do { __builtin_amdgcn_s_setprio(1); _Pragma("unroll") for (int m = 0; m < 4; ++m) _Pragma("unroll") for (int n = 0; n < 2; ++n) _Pragma("unroll") for (int k = 0; k < 2; ++k) \
        acc[ai][bj][m][n] = __builtin_amdgcn_mfma_f32_16x16x32_bf16(Bt[n][k], At[m][k], acc[ai][bj][m][n], 0, 0, 0); __builtin_amdgcn_s_setprio(0); } while (0)
#define PG8_WAIT_V(n) asm volatile("s_waitcnt vmcnt(" #n ")" ::: "memory")
#define PG8_WAIT_L(n) asm volatile("s_waitcnt lgkmcnt(" #n ")" ::: "memory")
#define PG8_BAR __builtin_amdgcn_s_barrier()
#define PG8_SCHED __builtin_amdgcn_sched_barrier(0)
#define PG8_VOFF(u, v00, v01, v10, v11) do { int _R0, _C0, _R1, _C1; stage_rc(tid * 16, _R0, _C0); stage_rc(tid * 16 + 8192, _R1, _C1); int _r00 = _R0, _r01 = _R1, _r10 = HALF + _R0, _r11 = HALF + _R1; \
        if ((u).gidx) { const int _a = _r00 < (u).gcnt ? ((const GAS int*)(u).gidx)[_r00] >> (u).gshift : 0, _b = _r01 < (u).gcnt ? ((const GAS int*)(u).gidx)[_r01] >> (u).gshift : 0, _c = _r10 < (u).gcnt ? ((const GAS int*)(u).gidx)[_r10] >> (u).gshift : 0, _d = _r11 < (u).gcnt ? ((const GAS int*)(u).gidx)[_r11] >> (u).gshift : 0; \
            _r00 = _a; _r01 = _b; _r10 = _c; _r11 = _d; } \
        v00 = (unsigned)(_r00 * K + _C0) * 2u; v01 = (unsigned)(_r01 * K + _C1) * 2u; v10 = (unsigned)(_r10 * K + _C0) * 2u; v11 = (unsigned)(_r11 * K + _C1) * 2u; } while (0)
    UnitG cur, nxt; int ui = 0;
    if (!S.next(0, cur)) return;
    if constexpr (Sched::UNIFORMIZE) uniformize(cur);
    f32x4 acc[2][2][4][2];
#pragma unroll
    for (int a = 0; a < 2; ++a)
#pragma unroll
        for (int b = 0; b < 2; ++b)
#pragma unroll
            for (int m = 0; m < 4; ++m)
#pragma unroll
                for (int n = 0; n < 2; ++n) acc[a][b][m][n] = (f32x4){0.f, 0.f, 0.f, 0.f};
    bf16x8 At[4][2], B0[2][2], B1[2][2];
    if constexpr (GATHER) PG8_VOFF(cur, vA[0][0], vA[0][1], vA[1][0], vA[1][1]);
    const char* cA = cur.A; const char* cB = cur.B;
    PG8_STAGE(PG8_SB(0, 0), cB, voffB); PG8_STAGE(PG8_SB(0, 1), cB + hstep, voffB); PG8_STAGE(PG8_SA(0, 0), cA, vA[0]); PG8_STAGE(PG8_SA(0, 1), cA + hstepA, vA[1]);
    if (wr == 1) PG8_BAR;
    PG8_WAIT_V(2); PG8_BAR;
    PG8_STAGE(PG8_SB(1, 0), cB + kstep, voffB); PG8_STAGE(PG8_SA(1, 0), cA + kstep, vA[0]); PG8_STAGE(PG8_SB(1, 1), cB + hstep + kstep, voffB);
    PG8_WAIT_V(6); PG8_BAR;
    for (;;) {
        const bool has_next = S.next(ui + 1, nxt);
        if constexpr (Sched::UNIFORMIZE) { if (has_next) uniformize(nxt); }
        const char* nA = cA; const char* nB = cB;
        if (has_next) { nA = nxt.A; nB = nxt.B; }
        if constexpr (GATHER) { u32x4 pv; pv.x = vA[0][0]; pv.y = vA[0][1]; pv.z = vA[1][0]; pv.w = vA[1][1];
            if (has_next) PG8_VOFF(nxt, pv.x, pv.y, pv.z, pv.w);
            *park = pv; }
#pragma unroll 1
        for (int t = 0; t < nt; t += 2) {
            const bool last = (t == nt - 2);
            const char* a1 = cA + (size_t)(t + 1) * kstep;
            const char* a2 = last ? nA : cA + (size_t)(t + 2) * kstep; const char* b2 = last ? nB : cB + (size_t)(t + 2) * kstep;
            const char* a3 = a2 + kstep; const char* b3 = b2 + kstep;
            PG8_LDB(B0, 0, 0); PG8_LDB(B1, 0, 1); PG8_SCHED; PG8_LDA(At, 0, 0); PG8_STAGE(PG8_SA(1, 1), a1 + hstepA, vA[1]);
            PG8_WAIT_V(8); PG8_WAIT_L(0); PG8_BAR; PG8_MMA(0, 0, At, B0); PG8_MMA(0, 1, At, B1); PG8_BAR; PG8_SCHED;
            if constexpr (GATHER) { if (last) { const u32x4 pv = *park; vA[0][0] = pv.x; vA[0][1] = pv.y; vA[1][0] = pv.z; vA[1][1] = pv.w; } }
            PG8_LDA(At, 0, 1); PG8_STAGE(PG8_SB(0, 0), b2, voffB); PG8_STAGE(PG8_SB(0, 1), b2 + hstep, voffB); PG8_STAGE(PG8_SA(0, 0), a2, vA[0]);
            PG8_WAIT_V(8); PG8_WAIT_L(0); PG8_BAR; PG8_MMA(1, 0, At, B0); PG8_MMA(1, 1, At, B1); PG8_BAR; PG8_SCHED;
            PG8_LDB(B0, 1, 0); PG8_LDB(B1, 1, 1); PG8_SCHED; PG8_LDA(At, 1, 0); PG8_STAGE(PG8_SA(0, 1), a2 + hstepA, vA[1]);
            PG8_WAIT_V(8); PG8_WAIT_L(0); PG8_BAR; PG8_MMA(0, 0, At, B0); PG8_MMA(0, 1, At, B1); PG8_BAR; PG8_SCHED;
            PG8_LDA(At, 1, 1); PG8_STAGE(PG8_SB(1, 0), b3, voffB); PG8_STAGE(PG8_SB(1, 1), b3 + hstep, voffB); PG8_STAGE(PG8_SA(1, 0), a3, vA[0]);
            PG8_WAIT_V(8); PG8_WAIT_L(0); PG8_BAR; PG8_MMA(1, 0, At, B0); PG8_MMA(1, 1, At, B1); PG8_BAR; PG8_SCHED;
        }
        if (wr == 0) PG8_BAR;
        E(acc, cur, wr, wc, fr, fq);
        if (!has_next) break;
#pragma unroll
        for (int a = 0; a < 2; ++a)
#pragma unroll
            for (int b = 0; b < 2; ++b)
#pragma unroll
                for (int m = 0; m < 4; ++m)
#pragma unroll
                    for (int n = 0; n < 2; ++n) acc[a][b][m][n] = (f32x4){0.f, 0.f, 0.f, 0.f};
        cur = nxt; cA = nA; cB = nB; ++ui;
        if (wr == 1) PG8_BAR;
    }
    PG8_WAIT_V(0);
    PG8_BAR;
#undef PG8_SA
#undef PG8_SB
#undef PG8_STAGE
#undef PG8_LDA
#undef PG8_LDB
#undef PG8_MMA
#undef PG8_WAIT_V
#undef PG8_WAIT_L
#undef PG8_BAR
#undef PG8_SCHED
#undef PG8_VOFF
}
}

constexpr size_t MiB = 1u << 20;
constexpr size_t WS_CTL = 0, CTL_ZERO_BYTES = 1 * MiB;
constexpr size_t WS_ATT_IN_T = 1 * MiB;
constexpr size_t WS_ATT_OUT_T = WS_ATT_IN_T + 36 * MiB;
constexpr size_t WS_RET_IN_T = WS_ATT_OUT_T + 4 * MiB;
constexpr size_t WS_RET_OUT_T = WS_RET_IN_T + 12 * MiB;
constexpr size_t WS_GLU_T = WS_RET_OUT_T + 4 * MiB;
constexpr size_t WS_RT_HI = WS_GLU_T + 4 * MiB;
constexpr size_t WS_RT_LO = WS_RT_HI + 512 * 1024;
constexpr size_t WS_WMOE = WS_RT_HI + 1 * MiB;
constexpr size_t WMOE_E_BYTES = (size_t)(512 * 1024 + 1024 * 256) * 2;
constexpr size_t WS_X = WS_WMOE + 98 * MiB;
constexpr size_t WS_Y = WS_X + 64 * MiB;
constexpr size_t WS_XB = WS_Y + 64 * MiB;
constexpr size_t WS_BIG = WS_XB + 32 * MiB;
constexpr size_t WS_AUX = WS_BIG + 288 * MiB;
constexpr size_t WS_H = WS_AUX + 160 * MiB;
constexpr size_t WS_LIST = WS_H + 80 * MiB;
constexpr size_t WS_TRASH = WS_LIST + 8 * MiB;
constexpr size_t WS_END = WS_TRASH + 1 * MiB;
static_assert(WS_END <= 1024 * MiB, "workspace map");
constexpr int CW_BAR = 4096;
constexpr int CW_CNT = 16384;
constexpr int CW_CHK = 65536;
constexpr int HROWS = 163840;

#define XB_TMO      128
#define XB_XCNT(j)  (256  + 64 * (j))
#define XB_XSUB(j)  (1280 + 64 * (j))
#define XB_XGEN(j)  (2304 + 64 * (j))
#define XB_TOP      3328
#define XB_TOPGEN   3392
#define XCD_BAR_WORDS 3456
#define XB_SPIN_CAP (1u << 20)
__device__ __forceinline__ unsigned xb_ld(unsigned* p)              { return __hip_atomic_load(p, __ATOMIC_RELAXED, __HIP_MEMORY_SCOPE_AGENT); }
__device__ __forceinline__ unsigned xb_add(unsigned* p, unsigned v) { return __hip_atomic_fetch_add(p, v, __ATOMIC_RELAXED, __HIP_MEMORY_SCOPE_AGENT); }
__device__ __forceinline__ unsigned xb_xcc_id() { return (unsigned)__builtin_amdgcn_s_getreg((3 << 11) | 20) & 0xFu; }
#define XB_SPIN(cond, bar) do { unsigned _sp = 0; while (cond) { __builtin_amdgcn_s_sleep(1); \
    if ((++_sp & 255u) == 0u) { if (xb_ld(&(bar)[XB_TMO])) break; if (_sp > XB_SPIN_CAP) { atomicAdd(&(bar)[XB_TMO], 1u); break; } } } } while (0)
struct XcdBarrier { unsigned* bar; unsigned x; volatile LAS unsigned* st; };
__device__ __forceinline__ XcdBarrier xcd_barrier_post(unsigned* bar, volatile LAS unsigned* st) {
    XcdBarrier b; b.bar = bar; b.x = xb_xcc_id(); b.st = st;
    if (threadIdx.x == 0) (void)xb_add(&bar[XB_XCNT(b.x)], 1u);
    return b;
}
__device__ __forceinline__ void xcd_barrier_complete(unsigned* bar, unsigned x, unsigned& nloc, unsigned& nx) {
    const unsigned G = gridDim.x * gridDim.y * gridDim.z;
    unsigned sum, cnt, mine, sp = 0u;
    for (;;) {
        sum = 0u; cnt = 0u; mine = 0u;
#pragma unroll
        for (unsigned j = 0; j < 16; ++j) { const unsigned c = xb_ld(&bar[XB_XCNT(j)]); sum += c; cnt += (c > 0u) ? 1u : 0u; mine = (j == x) ? c : mine; }
        if (sum == G) break;
        __builtin_amdgcn_s_sleep(1);
        if ((++sp & 255u) == 0u) { if (xb_ld(&bar[XB_TMO])) break; if (sp > XB_SPIN_CAP) { atomicAdd(&bar[XB_TMO], 1u); break; } }
    }
    nloc = mine > 0u ? mine : 1u; nx = cnt > 0u ? cnt : 1u;
}
__device__ __forceinline__ void xcd_barrier(const XcdBarrier& b) {
    asm volatile("s_waitcnt vmcnt(0)" ::: "memory");
    __syncthreads();
    if (threadIdx.x == 0) {
        unsigned* bar = b.bar;
        __builtin_amdgcn_s_waitcnt(0);
        unsigned nloc = b.st[0], nx = b.st[1];
        if (nloc == 0u) { xcd_barrier_complete(bar, b.x, nloc, nx); b.st[0] = nloc; b.st[1] = nx; }
        const unsigned old = xb_add(&bar[XB_XSUB(b.x)], 1u);
        const unsigned gen = old / nloc;
        if (old + 1u == (gen + 1u) * nloc) {
            __builtin_amdgcn_fence(__ATOMIC_RELEASE, "agent");
            asm volatile("s_waitcnt vmcnt(0)" ::: "memory");
            const unsigned og = xb_add(&bar[XB_TOP], 1u);
            const unsigned tg = og / nx;
            if (og + 1u == (tg + 1u) * nx) xb_add(&bar[XB_TOPGEN], 1u);
            else XB_SPIN(xb_ld(&bar[XB_TOPGEN]) == tg, bar);
            __builtin_amdgcn_fence(__ATOMIC_ACQUIRE, "agent");
            xb_add(&bar[XB_XGEN(b.x)], 1u);
            asm volatile("s_waitcnt vmcnt(0)" ::: "memory");
        } else {
            XB_SPIN(xb_ld(&bar[XB_XGEN(b.x)]) == gen, bar);
            __builtin_amdgcn_fence(__ATOMIC_ACQUIRE, "agent");
            asm volatile("s_waitcnt vmcnt(0)" ::: "memory");
        }
    }
    __syncthreads();
}

constexpr int RING_BYTES = 139264;
constexpr int MISC_OFF = RING_BYTES;
constexpr int LDS_BYTES = 147456;
struct Params {
    const float* in[26]; float* out; unsigned char* ws; int ph_lo, ph_hi; int use_bar, pad;
};
typedef const __attribute__((address_space(4))) Params* KP;
__device__ __forceinline__ const float* gin(KP p, int i) { return (const float*)(const GAS float*)p->in[i]; }
__device__ __forceinline__ float* gout(KP p) { return (float*)(GAS float*)p->out; }
struct Frame {
    LAS unsigned char* lds; volatile LAS unsigned* MISC;
    int tid, lane, wave, vcu, G;
    unsigned char* ws;
};

struct DenseSched {
    static constexpr bool GATHER = false, UNIFORMIZE = false;
    const char* A; const char* Bt; int K, nM, nN, nwg, G, c;
    __device__ __forceinline__ void init(const void* A_, const void* Bt_, int M, int N, int K_, int G_, int c_) { A = (const char*)A_; Bt = (const char*)Bt_; K = K_; nM = M / 256; nN = N / 256; nwg = nM * nN; G = G_; c = c_; }
    __device__ __forceinline__ bool next(int i, pg8::UnitG& u) const {
        const long L = (long)i * G + c; if (L >= nwg) return false;
        int wgid = (int)L; { const int q = nwg / 8, r = nwg % 8, xcd = wgid % 8, off = wgid / 8; wgid = (xcd < r ? xcd * (q + 1) : r * (q + 1) + (xcd - r) * q) + off; }
        const int nig = 8 * nN, gid = wgid / nig, fm = gid * 8, gsz = (nM - fm) < 8 ? (nM - fm) : 8;
        const int pm = fm + ((wgid % nig) % gsz), pn = (wgid % nig) / gsz;
        u.A = A + (size_t)pm * 256 * K * 2; u.B = Bt + (size_t)pn * 256 * K * 2; u.gidx = nullptr; u.gcnt = 0; u.gshift = 0; u.row0 = pm * 256; u.col0 = pn * 256; u.aux = 0; return true;
    }
};
__device__ __forceinline__ u32x4 pack_bf16x8(const f32x4& v0, const f32x4& v1) { u32x4 w; w.x = pk2hw(v0[0], v0[1]); w.y = pk2hw(v0[2], v0[3]); w.z = pk2hw(v1[0], v1[1]); w.w = pk2hw(v1[2], v1[3]); return w; }

struct EpiStoreBf16 {
    static constexpr bool PERM = true;
    bf16* O; int ldc;
    __device__ __forceinline__ void operator()(const f32x4 (&acc)[2][2][4][2], const pg8::UnitG& u, int wr, int wc, int fr, int fq) const {
#pragma unroll
        for (int ai = 0; ai < 2; ++ai)
#pragma unroll
            for (int m = 0; m < 4; ++m) { bf16* rowp = O + (size_t)(u.row0 + ai * 128 + wr * 64 + m * 16 + fr) * ldc + u.col0 + wc * 32 + 8 * fq;
#pragma unroll
                for (int bj = 0; bj < 2; ++bj) *(u32x4*)(rowp + bj * 128) = pack_bf16x8(acc[ai][bj][m][0], acc[ai][bj][m][1]); }
    }
};
struct EpiRetIn {
    static constexpr bool PERM = true;
    bf16* O; int ldc;
    __device__ __forceinline__ void operator()(const f32x4 (&acc)[2][2][4][2], const pg8::UnitG& u, int wr, int wc, int fr, int fq) const {
        float l2g = 0.f;
        if (u.col0 < 2048) { const int h = (u.col0 & 1023) >> 8; const float g = 1.0f - exp2f(-5.0f - (float)h); l2g = log2f(g); if (u.col0 >= 1024) l2g = -l2g; }
#pragma unroll
        for (int ai = 0; ai < 2; ++ai)
#pragma unroll
            for (int m = 0; m < 4; ++m) { const int row = u.row0 + ai * 128 + wr * 64 + m * 16 + fr; const float sc = exp2f(l2g * (float)(row & 127));
                bf16* rowp = O + (size_t)row * ldc + u.col0 + wc * 32 + 8 * fq;
#pragma unroll
                for (int bj = 0; bj < 2; ++bj) *(u32x4*)(rowp + bj * 128) = pack_bf16x8(acc[ai][bj][m][0] * sc, acc[ai][bj][m][1] * sc); }
    }
};
__device__ __forceinline__ void unpack_bf16x8(const u32x4& w, f32x4& a, f32x4& b) { a[0] = bflo(w.x); a[1] = bfhi(w.x); a[2] = bflo(w.y); a[3] = bfhi(w.y); b[0] = bflo(w.z); b[1] = bfhi(w.z); b[2] = bflo(w.w); b[3] = bfhi(w.w); }
struct EpiResid {
    static constexpr bool PERM = true;
    const bf16* X; bf16* Y;
    __device__ __forceinline__ void operator()(const f32x4 (&acc)[2][2][4][2], const pg8::UnitG& u, int wr, int wc, int fr, int fq) const {
#pragma unroll
        for (int ai = 0; ai < 2; ++ai)
#pragma unroll
            for (int m = 0; m < 4; ++m) { const size_t off = (size_t)(u.row0 + ai * 128 + wr * 64 + m * 16 + fr) * D + u.col0 + wc * 32 + 8 * fq;
#pragma unroll
                for (int bj = 0; bj < 2; ++bj) { const u32x4 xw = *(const u32x4*)(X + off + bj * 128); f32x4 x0, x1; unpack_bf16x8(xw, x0, x1);
                    *(u32x4*)(Y + off + bj * 128) = pack_bf16x8(x0 * ALPHA + acc[ai][bj][m][0], x1 * ALPHA + acc[ai][bj][m][1]); }
                if (m == 3) asm volatile("" ::: "memory"); }
    }
};
struct EpiGluResid {
    static constexpr bool PERM = true;
    const bf16* X; bf16* Y;
    __device__ __forceinline__ void operator()(const f32x4 (&acc)[2][2][4][2], const pg8::UnitG& u, int wr, int wc, int fr, int fq) const {
#pragma unroll
        for (int ai = 0; ai < 2; ++ai)
#pragma unroll
            for (int m = 0; m < 4; ++m) { const size_t off = (size_t)(u.row0 + ai * 128 + wr * 64 + m * 16 + fr) * D + (u.col0 >> 1) + wc * 32 + 8 * fq;
                const u32x4 xw = *(const u32x4*)(X + off); f32x4 x0, x1; unpack_bf16x8(xw, x0, x1); f32x4 o0, o1;
#pragma unroll
                for (int j = 0; j < 4; ++j) { o0[j] = x0[j] * ALPHA + acc[ai][0][m][0][j] / (1.0f + __expf(-acc[ai][1][m][0][j])); o1[j] = x1[j] * ALPHA + acc[ai][0][m][1][j] / (1.0f + __expf(-acc[ai][1][m][1][j])); }
                *(u32x4*)(Y + off) = pack_bf16x8(o0, o1);
                if (m == 3) asm volatile("" ::: "memory"); }
    }
};
struct EpiMoeUp {
    static constexpr bool PERM = true;
    bf16* H;
    __device__ __forceinline__ void operator()(const f32x4 (&acc)[2][2][4][2], const pg8::UnitG& u, int wr, int wc, int fr, int fq) const {
#pragma unroll
        for (int ai = 0; ai < 2; ++ai)
#pragma unroll
            for (int m = 0; m < 4; ++m) { bf16* rowp = H + (size_t)(u.row0 + ai * 128 + wr * 64 + m * 16 + fr) * ED + u.col0 + wc * 32 + 8 * fq; f32x4 o[2];
#pragma unroll
                for (int n = 0; n < 2; ++n)
#pragma unroll
                    for (int j = 0; j < 4; ++j) { const float g = acc[ai][0][m][n][j], up = acc[ai][1][m][n][j]; o[n][j] = g / (1.0f + __expf(-g)) * up; }
                *(u32x4*)rowp = pack_bf16x8(o[0], o[1]); }
    }
};

template <bool HILO>
__device__ __forceinline__ void conv_item(const float* W, int ldw, bf16* WT, bf16* WTlo, int ldk, int k0, int n0, int drow0, float scale, LAS float* scr, int lane) {
#pragma unroll 8
    for (int i = 0; i < 32; ++i) { const int kk = 2 * i + (lane >> 5); scr[kk * 33 + (lane & 31)] = W[(size_t)(k0 + kk) * ldw + n0 + (lane & 31)] * scale; }
    LDS_WAIT(); asm volatile("" ::: "memory");
    const int c = lane & 7;
#pragma unroll
    for (int j = 0; j < 4; ++j) { const int n = (lane >> 3) + 8 * j; const LAS float* s = scr + (8 * c) * 33 + n;
        float v[8];
#pragma unroll
        for (int q = 0; q < 8; ++q) v[q] = s[q * 33];
        u32x4 o; o.x = pk2(v[0], v[1]); o.y = pk2(v[2], v[3]); o.z = pk2(v[4], v[5]); o.w = pk2(v[6], v[7]);
        *(u32x4*)(WT + (size_t)(drow0 + n) * ldk + k0 + 8 * c) = o;
        if (HILO) { float r[8];
#pragma unroll
            for (int q = 0; q < 8; ++q) r[q] = v[q] - bf2f(f2bf(v[q]));
            u32x4 o2; o2.x = pk2(r[0], r[1]); o2.y = pk2(r[2], r[3]); o2.z = pk2(r[4], r[5]); o2.w = pk2(r[6], r[7]);
            *(u32x4*)(WTlo + (size_t)(drow0 + n) * ldk + k0 + 8 * c) = o2; } }
    LDS_WAIT(); asm volatile("" ::: "memory");
}
__device__ __forceinline__ void phase_conv_mixers(const Frame& F, KP p) {
    LAS float* scr = (LAS float*)(F.lds + F.wave * 16384);
    const int gw = F.vcu * NWAVES + F.wave, NGW = F.G * NWAVES;
    constexpr int I_AIN = 16 * 288, I_AOUT = 16 * 32, I_RIN = 16 * 192, I_ROUT = 32 * 32, I_GLU = 16 * 64, I_RT = 16 * 2;
    constexpr int NITEMS = 2 * I_AIN + 2 * I_AOUT + I_RIN + I_ROUT + I_GLU + 4 * I_RT;
    unsigned char* ws = F.ws;
    for (int it = gw; it < NITEMS; it += NGW) {
        int r = it;
        if (r < 2 * I_AIN) { const int j = r / I_AIN; r %= I_AIN; const int kb = r / 288, nb = r % 288, n0 = nb * 32;
            conv_item<false>(gin(p, 1) + (size_t)j * D * ATT_IN, ATT_IN, (bf16*)(ws + WS_ATT_IN_T) + (size_t)j * ATT_IN * D, nullptr, D, kb * 64, n0, n0, ((n0 % 3072) < 1024) ? 0.08838834764831845f : 1.0f, scr, F.lane); continue; }
        r -= 2 * I_AIN;
        if (r < 2 * I_AOUT) { const int j = r / I_AOUT; r %= I_AOUT; const int kb = r / 32, nb = r % 32, n0 = nb * 32;
            conv_item<false>(gin(p, 2) + (size_t)j * D * D, D, (bf16*)(ws + WS_ATT_OUT_T) + (size_t)j * D * D, nullptr, D, kb * 64, n0, n0, 1.0f, scr, F.lane); continue; }
        r -= 2 * I_AOUT;
        if (r < I_RIN) { const int kb = r / 192, nb = r % 192, n0 = nb * 32;
            conv_item<false>(gin(p, 3), RET_IN, (bf16*)(ws + WS_RET_IN_T), nullptr, D, kb * 64, n0, n0, (n0 >= 1024 && n0 < 2048) ? 0.0625f : 1.0f, scr, F.lane); continue; }
        r -= I_RIN;
        if (r < I_ROUT) { const int kb = r / 32, nb = r % 32, n0 = nb * 32;
            conv_item<false>(gin(p, 6), D, (bf16*)(ws + WS_RET_OUT_T), nullptr, RET_V, kb * 64, n0, n0, 1.0f, scr, F.lane); continue; }
        r -= I_ROUT;
        if (r < I_GLU) { const int kb = r / 64, nb = r % 64, n0 = nb * 32; const int c = n0 & 1023, drow = (c >> 7) * 256 + (n0 >> 10) * 128 + (c & 127);
            conv_item<false>(gin(p, 15), 2 * D, (bf16*)(ws + WS_GLU_T), nullptr, D, kb * 64, n0, drow, 1.0f, scr, F.lane); continue; }
        r -= I_GLU;
        { const int l = r / I_RT; r %= I_RT; const int kb = r / 2, nb = r % 2, n0 = nb * 32;
            conv_item<true>(gin(p, 16) + (size_t)l * D * NE, NE, (bf16*)(ws + WS_RT_HI) + (size_t)l * NE * D, (bf16*)(ws + WS_RT_LO) + (size_t)l * NE * D, D, kb * 64, n0, n0, 1.0f, scr, F.lane); }
    }
}
__device__ __forceinline__ void phase_conv_moe(const Frame& F, KP p, int l) {
    LAS float* scr = (LAS float*)(F.lds + F.wave * 16384);
    const int gw = F.vcu * NWAVES + F.wave, NGW = F.G * NWAVES;
    for (int it = gw; it < 65 * 384; it += NGW) {
        const int e = it / 384, r = it % 384, which = r >> 7, rr = r & 127;
        bf16* We = (bf16*)(F.ws + WS_WMOE + (size_t)e * WMOE_E_BYTES);
        if (which < 2) { const float* src = (e < 64) ? gin(p, 18 + which) + ((size_t)l * NE + e) * D * ED : gin(p, 21 + which) + (size_t)l * D * ED;
            const int kb = rr >> 3, nb = rr & 7, n0 = nb * 32; const int drow = (n0 >> 7) * 256 + which * 128 + (n0 & 127);
            conv_item<false>(src, ED, We, nullptr, D, kb * 64, n0, drow, 1.0f, scr, F.lane);
        } else { const float* src = (e < 64) ? gin(p, 20) + ((size_t)l * NE + e) * ED * D : gin(p, 23) + (size_t)l * ED * D;
            const int kb = rr >> 5, nb = rr & 31, n0 = nb * 32;
            conv_item<false>(src, D, We + 512 * 1024, nullptr, ED, kb * 64, n0, n0, 1.0f, scr, F.lane); }
    }
}

__device__ __forceinline__ void phase_lnr(const Frame& F, KP p, int layer, bool dry = false) {
    const bf16* Y = (const bf16*)(F.ws + WS_Y); bf16* XB = (bf16*)(F.ws + WS_XB);
    const float* lng = gin(p, 24) + (size_t)(layer * 2) * D; const float* lnb = gin(p, 25) + (size_t)(layer * 2) * D;
    const bf16* rthi = (const bf16*)(F.ws + WS_RT_HI) + (size_t)layer * NE * D; const bf16* rtlo = (const bf16*)(F.ws + WS_RT_LO) + (size_t)layer * NE * D;
    const float* rbias = gin(p, 17) + layer * NE;
    unsigned* cnt = (unsigned*)(F.ws + WS_CTL) + CW_CNT + layer * NE * 64;
    int* lists = (int*)(F.ws + WS_LIST); int* tokmap = (int*)(F.ws + WS_LIST + 4 * MiB); float* tokgate = (float*)(F.ws + WS_LIST + 5 * MiB);
    constexpr int XLD = 1032, MAXT = 8;
    LAS bf16* Xhi = (LAS bf16*)F.lds; LAS bf16* Xlo = Xhi + 16 * XLD;
    LAS float* part = (LAS float*)(F.lds + 2 * 16 * XLD * 2);
    LAS int* ent = (LAS int*)(part + 2 * 16 * 64);
    LAS int* hist = ent + MAXT * 16 * 8 * 2; LAS int* base = hist + 64;
    const int lane = F.lane, w = F.wave, g4 = lane >> 4, l15 = lane & 15;
    if (F.tid < 64) hist[F.tid] = 0;
    f32x4 gv[4], bv[4];
#pragma unroll
    for (int j = 0; j < 2; ++j) { gv[2 * j] = *(const f32x4*)(lng + 8 * lane + 512 * j); gv[2 * j + 1] = *(const f32x4*)(lng + 8 * lane + 512 * j + 4);
        bv[2 * j] = *(const f32x4*)(lnb + 8 * lane + 512 * j); bv[2 * j + 1] = *(const f32x4*)(lnb + 8 * lane + 512 * j + 4); }
    int ntile = 0;
    for (int tile = F.vcu; tile < T / 16 && ntile < MAXT; tile += F.G, ++ntile) {
        const int t0 = tile * 16;
#pragma unroll
        for (int rr = 0; rr < 2; ++rr) {
            const int lr = 2 * w + rr; const size_t row = (size_t)(t0 + lr);
            f32x4 v[4]; float s = 0.f;
#pragma unroll
            for (int j = 0; j < 2; ++j) { const u32x4 yw = *(const u32x4*)(Y + row * D + 8 * lane + 512 * j); unpack_bf16x8(yw, v[2 * j], v[2 * j + 1]); }
#pragma unroll
            for (int j = 0; j < 4; ++j) s += (v[j][0] + v[j][1]) + (v[j][2] + v[j][3]);
            const float mean = wave_sum(s, lane) * (1.f / D); float s2 = 0.f;
#pragma unroll
            for (int j = 0; j < 4; ++j) { v[j] = v[j] - mean; s2 += (v[j][0] * v[j][0] + v[j][1] * v[j][1]) + (v[j][2] * v[j][2] + v[j][3] * v[j][3]); }
            const float rstd = 1.0f / sqrtf(wave_sum(s2, lane) * (1.f / D) + LN_EPS);
#pragma unroll
            for (int j = 0; j < 2; ++j) { const f32x4 o0 = v[2 * j] * rstd * gv[2 * j] + bv[2 * j], o1 = v[2 * j + 1] * rstd * gv[2 * j + 1] + bv[2 * j + 1];
                const u32x4 hi = pack_bf16x8(o0, o1);
                *(u32x4*)(XB + row * D + 8 * lane + 512 * j) = hi;
                f32x4 h0, h1; unpack_bf16x8(hi, h0, h1); const u32x4 lo = pack_bf16x8(o0 - h0, o1 - h1);
                *(LAS u32x4*)(Xhi + lr * XLD + 8 * lane + 512 * j) = hi; *(LAS u32x4*)(Xlo + lr * XLD + 8 * lane + 512 * j) = lo; }
        }
        __syncthreads();
        { const int nt = w & 3, kh = w >> 2; f32x4 acc = (f32x4){0.f, 0.f, 0.f, 0.f};
            const bf16* bh = rthi + (size_t)(16 * nt + l15) * D + 512 * kh + 8 * g4; const bf16* bl = rtlo + (size_t)(16 * nt + l15) * D + 512 * kh + 8 * g4;
#pragma unroll 8
            for (int ks = 0; ks < 16; ++ks) { const int k0 = 512 * kh + 32 * ks;
                const bf16x8 ahi = row_frag(Xhi, XLD, 0, k0, lane), alo = row_frag(Xlo, XLD, 0, k0, lane);
                const bf16x8 bhi = *(const bf16x8*)(bh + 32 * ks), blo = *(const bf16x8*)(bl + 32 * ks);
                acc = MFMA16(ahi, bhi, acc); acc = MFMA16(alo, bhi, acc); acc = MFMA16(ahi, blo, acc); }
#pragma unroll
            for (int i = 0; i < 4; ++i) part[(kh * 16 + 4 * g4 + i) * 64 + 16 * nt + l15] = acc[i];
        }
        __syncthreads();
#pragma unroll
        for (int rr = 0; rr < 2; ++rr) {
            const int lt = ntile * 16 + 2 * w + rr;
            const float lg = part[(2 * w + rr) * 64 + lane] + part[(16 + 2 * w + rr) * 64 + lane];
            float sc = 1.0f / (1.0f + expf(-lg)); sc = (sc == sc) ? sc : 0.5f;
            const float sel = sc + rbias[lane];
            float m1 = sel; m1 = fmaxf(m1, shx(m1, 1, lane)); m1 = fmaxf(m1, shx(m1, 2, lane)); m1 = fmaxf(m1, shx(m1, 4, lane));
            const unsigned long long eq = __ballot(sel == m1);
            const unsigned gm = (unsigned)(eq >> (lane & 56)) & 0xffu;
            const int first = (lane & 56) + __builtin_ctz(gm | 0x100u);
            float m2 = (lane == first) ? -INFINITY : sel; m2 = fmaxf(m2, shx(m2, 1, lane)); m2 = fmaxf(m2, shx(m2, 2, lane)); m2 = fmaxf(m2, shx(m2, 4, lane));
            const float gs = m1 + m2; const int mygrp = lane >> 3; int grank = 0;
#pragma unroll
            for (int gg = 0; gg < 8; ++gg) { const float o = rdl(gs, 8 * gg); grank += (o > gs || (o == gs && gg < mygrp)) ? 1 : 0; }
            const float mv = (grank < 4) ? sel : -INFINITY; int rank = 0;
#pragma unroll
            for (int e2 = 0; e2 < 64; ++e2) { const float o = rdl(mv, e2); rank += (o > mv || (o == mv && e2 < lane)) ? 1 : 0; }
            const bool chosen = rank < TOPK;
            const float wsum = wave_sum(chosen ? sc : 0.f, lane);
            if (chosen) { const int lpos = __hip_atomic_fetch_add(hist + lane, 1, __ATOMIC_RELAXED, __HIP_MEMORY_SCOPE_WORKGROUP);
                ent[(lt * 8 + rank) * 2] = (lane << 16) | lpos; ent[(lt * 8 + rank) * 2 + 1] = __builtin_bit_cast(int, sc / wsum * 2.5f); }
        }
    }
    __syncthreads();
    if (dry) return;
    if (F.tid < 64) { const int hcount = hist[F.tid]; base[F.tid] = hcount ? (int)atomicAdd(cnt + F.tid * 64, (unsigned)hcount) : 0; }
    __syncthreads();
    for (int idx = F.tid; idx < ntile * 16 * 8; idx += NTHREADS) {
        const int ev = ent[idx * 2], gb = ent[idx * 2 + 1]; const int e = ev >> 16, pos = base[e] + (ev & 0xffff);
        const int lt = idx >> 3, rank = idx & 7, tok = (F.vcu + (lt >> 4) * F.G) * 16 + (lt & 15);
        lists[(size_t)e * T + pos] = tok; tokmap[tok * 8 + rank] = (e << 16) | pos; tokgate[tok * 8 + rank] = __builtin_bit_cast(float, gb);
    }
}

__device__ __forceinline__ void phase_combine(const Frame& F, KP p, int layer, bool dry = false) {
    bf16* XB = (bf16*)(F.ws + WS_XB); const bf16* yexp = (const bf16*)(F.ws + WS_BIG);
    const int* tokmap = (const int*)(F.ws + WS_LIST + 4 * MiB); const float* tokgate = (const float*)(F.ws + WS_LIST + 5 * MiB);
    const volatile LAS int* tstart = (const volatile LAS int*)(F.MISC + 64);
    const float* lng = gin(p, 24) + (size_t)(layer * 2 + 1) * D; const float* lnb = gin(p, 25) + (size_t)(layer * 2 + 1) * D;
    float* outp = gout(p); bf16* xbo = XB; if (dry) { outp = (float*)(F.ws + WS_X); xbo = (bf16*)(F.ws + WS_H); }
    const int lane = F.lane, gw = F.vcu * NWAVES + F.wave, NGW = F.G * NWAVES;
    const int shrow0 = __builtin_amdgcn_readfirstlane((int)tstart[64]) * 256;
    f32x4 gv[4], bv[4];
#pragma unroll
    for (int j = 0; j < 2; ++j) { gv[2 * j] = *(const f32x4*)(lng + 8 * lane + 512 * j); gv[2 * j + 1] = *(const f32x4*)(lng + 8 * lane + 512 * j + 4);
        bv[2 * j] = *(const f32x4*)(lnb + 8 * lane + 512 * j); bv[2 * j + 1] = *(const f32x4*)(lnb + 8 * lane + 512 * j + 4); }
    for (int row = gw; row < T; row += NGW) {
        const int mk = tokmap[row * 8 + (lane & 7)]; const float gk = tokgate[row * 8 + (lane & 7)];
        const int rk = (int)tstart[mk >> 16] * 256 + (mk & 0xffff);
        f32x4 v[4];
#pragma unroll
        for (int j = 0; j < 2; ++j) { const u32x4 xw = *(const u32x4*)(XB + (size_t)row * D + 8 * lane + 512 * j); unpack_bf16x8(xw, v[2 * j], v[2 * j + 1]); v[2 * j] = v[2 * j] * ALPHA; v[2 * j + 1] = v[2 * j + 1] * ALPHA; }
#pragma unroll
        for (int k = 0; k < NSLOT; ++k) { const int r = (k < 8) ? __builtin_amdgcn_readlane(rk, k) : shrow0 + row; const float g = (k < 8) ? rdl(gk, k) : 1.0f;
#pragma unroll
            for (int j = 0; j < 2; ++j) { const u32x4 s = *(const u32x4*)(yexp + (size_t)r * D + 8 * lane + 512 * j);
                v[2 * j][0] += g * bflo(s.x); v[2 * j][1] += g * bfhi(s.x); v[2 * j][2] += g * bflo(s.y); v[2 * j][3] += g * bfhi(s.y);
                v[2 * j + 1][0] += g * bflo(s.z); v[2 * j + 1][1] += g * bfhi(s.z); v[2 * j + 1][2] += g * bflo(s.w); v[2 * j + 1][3] += g * bfhi(s.w); } }
        float s = 0.f;
#pragma unroll
        for (int j = 0; j < 4; ++j) s += (v[j][0] + v[j][1]) + (v[j][2] + v[j][3]);
        const float mean = wave_sum(s, lane) * (1.f / D); float s2 = 0.f;
#pragma unroll
        for (int j = 0; j < 4; ++j) { v[j] = v[j] - mean; s2 += (v[j][0] * v[j][0] + v[j][1] * v[j][1]) + (v[j][2] * v[j][2] + v[j][3] * v[j][3]); }
        const float rstd = 1.0f / sqrtf(wave_sum(s2, lane) * (1.f / D) + LN_EPS);
#pragma unroll
        for (int j = 0; j < 2; ++j) { const f32x4 o0 = v[2 * j] * rstd * gv[2 * j] + bv[2 * j], o1 = v[2 * j + 1] * rstd * gv[2 * j + 1] + bv[2 * j + 1];
            if (layer == DEPTH - 1 || dry) { *(f32x4*)(outp + (size_t)row * D + 8 * lane + 512 * j) = o0; *(f32x4*)(outp + (size_t)row * D + 8 * lane + 512 * j + 4) = o1; }
            if (layer != DEPTH - 1) *(u32x4*)(xbo + (size_t)row * D + 8 * lane + 512 * j) = pack_bf16x8(o0, o1); }
    }
}

constexpr size_t AUX_OB = 96 * MiB, AUX_LSE = 128 * MiB;
__device__ __forceinline__ void phase_attn(const Frame& F, int bx) {
    const bf16* qkv = (const bf16*)(F.ws + WS_BIG); bf16* og = (bf16*)(F.ws + WS_AUX); float* lse = (float*)(F.ws + WS_AUX + AUX_LSE);
    constexpr int KLD = 136;
    LAS bf16* Ks = (LAS bf16*)F.lds; LAS bf16* Vs = Ks + 256 * KLD;
    const int lane = F.lane, w = F.wave, g4 = lane >> 4, l15 = lane & 15, qq = l15 >> 2, pp = lane & 3;
    u32x4 kreg[8], vreg[8];
#define ATT_DECODE(L_) const int h = (L_) & 7, sb = (L_) >> 3, g = sb >> 7, rem = sb & 127, b = rem >> 6, rn = rem & 63; \
        const int dsh = 2 * g, d = 1 << dsh, nbs = 6 - dsh, r = rn >> nbs, n = rn & ((1 << nbs) - 1); const size_t rowbase = (size_t)b * SEQ;
#define ATT_ISSUE(L_) do { ATT_DECODE(L_) _Pragma("unroll") for (int it = 0; it < 8; ++it) { const int idx = F.tid + 512 * it, c = idx >> 4, ch = idx & 15; int pos = 128 * (n - 1) + c; pos = pos < 0 ? 0 : pos; \
            const bf16* src = qkv + (rowbase + (size_t)pos * d + r) * ATT_IN + g * 3072 + 1024 + h * 128 + ch * 8; kreg[it] = *(const u32x4*)src; vreg[it] = *(const u32x4*)(src + 1024); } } while (0)
    if (bx < 3072) ATT_ISSUE(bx);
    for (int L = bx; L < 3072; L += F.G) {
        ATT_DECODE(L)
#pragma unroll
        for (int it = 0; it < 8; ++it) { const int idx = F.tid + 512 * it, c = idx >> 4, ch = idx & 15;
            *(LAS u32x4*)(Ks + c * KLD + ch * 8) = kreg[it]; *(LAS u32x4*)(Vs + c * KLD + ch * 8) = vreg[it]; }
        const int qi = 16 * w + l15; const size_t qrow = rowbase + (size_t)(128 * n + qi) * d + r;
        bf16x8 qf[4];
#pragma unroll
        for (int s = 0; s < 4; ++s) qf[s] = *(const bf16x8*)(qkv + qrow * ATT_IN + g * 3072 + h * 128 + 32 * s + 8 * g4);
        __syncthreads();
        if (L + F.G < 3072) { ATT_ISSUE(L + F.G); }
        __builtin_amdgcn_sched_barrier(0);
        const int ws0 = (16 * w < 96) ? 16 * w : 96;
        f32x4 sacc[10];
        {
            bf16x8 kfa[4], kfb[4];
#pragma unroll
            for (int s = 0; s < 4; ++s) kfa[s] = row_frag(Ks, KLD, ws0, 32 * s, lane);
#pragma unroll
            for (int t = 0; t < 10; t += 2) {
#pragma unroll
                for (int s = 0; s < 4; ++s) kfb[s] = row_frag(Ks, KLD, ws0 + 16 * (t + 1), 32 * s, lane);
                __builtin_amdgcn_sched_barrier(0);
                sacc[t] = (f32x4){0.f, 0.f, 0.f, 0.f};
#pragma unroll
                for (int s = 0; s < 4; ++s) sacc[t] = MFMA16(kfa[s], qf[s], sacc[t]);
                if (t + 2 < 10) {
#pragma unroll
                    for (int s = 0; s < 4; ++s) kfa[s] = row_frag(Ks, KLD, ws0 + 16 * (t + 2), 32 * s, lane); }
                __builtin_amdgcn_sched_barrier(0);
                sacc[t + 1] = (f32x4){0.f, 0.f, 0.f, 0.f};
#pragma unroll
                for (int s = 0; s < 4; ++s) sacc[t + 1] = MFMA16(kfb[s], qf[s], sacc[t + 1]);
            }
        }
        const float slope = exp2f(-(float)(h + 1)) * (float)d;
        float mx = -INFINITY;
#pragma unroll
        for (int t = 0; t < 10; ++t)
#pragma unroll
            for (int i = 0; i < 4; ++i) { const int c = ws0 + 16 * t + 4 * g4 + i, step = 128 + qi - c;
                const bool valid = (step >= 0) && (step <= 128) && (n > 0 || c >= 128);
                const float v = valid ? sacc[t][i] - slope * (float)step : -INFINITY; sacc[t][i] = v; mx = fmaxf(mx, v); }
        mx = fmaxf(mx, shx(mx, 16, lane)); mx = fmaxf(mx, shx(mx, 32, lane));
        float lsum = 0.f;
#pragma unroll
        for (int t = 0; t < 10; ++t)
#pragma unroll
            for (int i = 0; i < 4; ++i) { const float pv = __expf(sacc[t][i] - mx); sacc[t][i] = pv; lsum += pv; }
        lsum += shx(lsum, 16, lane); lsum += shx(lsum, 32, lane);
        bf16x8 pf[5];
#pragma unroll
        for (int kt = 0; kt < 5; ++kt) pf[kt] = pack8(sacc[2 * kt], sacc[2 * kt + 1]);
        f32x4 o[8];
        {
            const LAS bf16* vb = Vs + (ws0 + 4 * g4 + qq) * KLD + 32 * pp;
            bf16x4 va[10], vc[10];
#pragma unroll
            for (int kt = 0; kt < 5; ++kt) { va[2 * kt] = tr4(vb + 32 * kt * KLD); va[2 * kt + 1] = tr4(vb + (32 * kt + 16) * KLD); }
#pragma unroll
            for (int et = 0; et < 8; et += 2) {
#pragma unroll
                for (int kt = 0; kt < 5; ++kt) { vc[2 * kt] = tr4(vb + 32 * kt * KLD + 4 * (et + 1)); vc[2 * kt + 1] = tr4(vb + (32 * kt + 16) * KLD + 4 * (et + 1)); }
                __builtin_amdgcn_sched_barrier(0);
                o[et] = (f32x4){0.f, 0.f, 0.f, 0.f};
#pragma unroll
                for (int kt = 0; kt < 5; ++kt) o[et] = MFMA16(cat8(va[2 * kt], va[2 * kt + 1]), pf[kt], o[et]);
                if (et + 2 < 8) {
#pragma unroll
                    for (int kt = 0; kt < 5; ++kt) { va[2 * kt] = tr4(vb + 32 * kt * KLD + 4 * (et + 2)); va[2 * kt + 1] = tr4(vb + (32 * kt + 16) * KLD + 4 * (et + 2)); } }
                __builtin_amdgcn_sched_barrier(0);
                o[et + 1] = (f32x4){0.f, 0.f, 0.f, 0.f};
#pragma unroll
                for (int kt = 0; kt < 5; ++kt) o[et + 1] = MFMA16(cat8(vc[2 * kt], vc[2 * kt + 1]), pf[kt], o[et + 1]);
            }
        }
        const float inv = 1.0f / lsum;
        bf16* orow = og + ((size_t)g * T + qrow) * D + h * 128 + 32 * g4;
#pragma unroll
        for (int e2 = 0; e2 < 4; ++e2) *(u32x4*)(orow + 8 * e2) = pack_bf16x8(o[2 * e2] * inv, o[2 * e2 + 1] * inv);
        if (g4 == 0) lse[((size_t)g * T + qrow) * AH + h] = mx + __logf(lsum);
        __syncthreads();
    }
#undef ATT_DECODE
#undef ATT_ISSUE
}
__device__ __forceinline__ void phase_attn_combine(const Frame& F) {
    const bf16* og = (const bf16*)(F.ws + WS_AUX); const float* lse = (const float*)(F.ws + WS_AUX + AUX_LSE); bf16* ob = (bf16*)(F.ws + WS_AUX + AUX_OB);
    const int lane = F.lane, gw = F.vcu * NWAVES + F.wave, NGW = F.G * NWAVES, h = lane >> 3;
    for (int row = gw; row < T; row += NGW) {
        const float l0 = lse[((size_t)0 * T + row) * AH + h], l1 = lse[((size_t)1 * T + row) * AH + h], l2 = lse[((size_t)2 * T + row) * AH + h];
        const float m = fmaxf(l0, fmaxf(l1, l2)); float w0 = __expf(l0 - m), w1 = __expf(l1 - m), w2 = __expf(l2 - m); const float inv = 1.0f / (w0 + w1 + w2); w0 *= inv; w1 *= inv; w2 *= inv;
        float a[16];
#pragma unroll
        for (int j = 0; j < 16; ++j) a[j] = 0.f;
#pragma unroll
        for (int g = 0; g < 3; ++g) { const float wg = (g == 0) ? w0 : (g == 1 ? w1 : w2);
#pragma unroll
            for (int q = 0; q < 2; ++q) { const u32x4 s = *(const u32x4*)(og + ((size_t)g * T + row) * D + 16 * lane + 8 * q);
                a[8 * q + 0] += wg * bflo(s.x); a[8 * q + 1] += wg * bfhi(s.x); a[8 * q + 2] += wg * bflo(s.y); a[8 * q + 3] += wg * bfhi(s.y);
                a[8 * q + 4] += wg * bflo(s.z); a[8 * q + 5] += wg * bfhi(s.z); a[8 * q + 6] += wg * bflo(s.w); a[8 * q + 7] += wg * bfhi(s.w); } }
#pragma unroll
        for (int q = 0; q < 2; ++q) { u32x4 o; o.x = pk2(a[8 * q], a[8 * q + 1]); o.y = pk2(a[8 * q + 2], a[8 * q + 3]); o.z = pk2(a[8 * q + 4], a[8 * q + 5]); o.w = pk2(a[8 * q + 6], a[8 * q + 7]);
            *(u32x4*)(ob + (size_t)row * D + 16 * lane + 8 * q) = o; }
    }
}

constexpr size_t BIG_YRET = 192 * MiB;
__device__ __forceinline__ void phase_ret_u(const Frame& F) {
    const bf16* proj = (const bf16*)(F.ws + WS_BIG); bf16* St = (bf16*)(F.ws + WS_AUX);
    constexpr int LD = 264;
    LAS bf16* Kt = (LAS bf16*)F.lds; LAS bf16* Vt = Kt + 128 * LD;
    const int lane = F.lane, w = F.wave, g4 = lane >> 4, l15 = lane & 15, qq = l15 >> 2, pp = lane & 3;
    for (int u = F.vcu; u < 1024; u += F.G) {
        const int eh = u & 1, h = (u >> 1) & 3, n = (u >> 3) & 63, b = u >> 9;
        const size_t row0 = (size_t)b * SEQ + (size_t)n * RC;
#pragma unroll 4
        for (int it = 0; it < 8; ++it) { const int idx = F.tid + 512 * it, j = idx >> 5, ch = idx & 31;
            const bf16* src = proj + (row0 + j) * RET_IN;
            const u32x4 kv = *(const u32x4*)(src + 1024 + h * 256 + ch * 8), vv = *(const u32x4*)(src + 2048 + h * 512 + eh * 256 + ch * 8);
            *(LAS u32x4*)(Kt + j * LD + ch * 8) = kv; *(LAS u32x4*)(Vt + j * LD + ch * 8) = vv; }
        __syncthreads();
        f32x4 acc[16][2];
#pragma unroll
        for (int mt = 0; mt < 16; ++mt) { acc[mt][0] = (f32x4){0.f, 0.f, 0.f, 0.f}; acc[mt][1] = (f32x4){0.f, 0.f, 0.f, 0.f}; }
#pragma unroll
        for (int ks = 0; ks < 4; ++ks) {
            bf16x8 bfr[2];
#pragma unroll
            for (int nt = 0; nt < 2; ++nt) { const LAS bf16* a0 = Vt + (32 * ks + 8 * g4 + qq) * LD + 32 * w + 16 * nt + 4 * pp; bfr[nt] = cat8(tr4(a0), tr4(a0 + 4 * LD)); }
#pragma unroll
            for (int mt = 0; mt < 16; ++mt) { const LAS bf16* a0 = Kt + (32 * ks + 8 * g4 + qq) * LD + 128 * (mt >> 3) + 32 * pp + 4 * (mt & 7);
                const bf16x8 afr = cat8(tr4(a0), tr4(a0 + 4 * LD));
                acc[mt][0] = MFMA16(afr, bfr[0], acc[mt][0]); acc[mt][1] = MFMA16(afr, bfr[1], acc[mt][1]); }
        }
        bf16* outb = St + ((size_t)((b * RH + h) * RNC + n)) * (RDV * RDK);
#pragma unroll
        for (int nt = 0; nt < 2; ++nt) { bf16* orow = outb + (size_t)(eh * 256 + 32 * w + 16 * nt + l15) * RDK + 32 * g4;
#pragma unroll
            for (int mh = 0; mh < 2; ++mh)
#pragma unroll
                for (int q = 0; q < 4; ++q) *(u32x4*)(orow + 128 * mh + 8 * q) = pack_bf16x8(acc[mh * 8 + 2 * q][nt], acc[mh * 8 + 2 * q + 1][nt]); }
        __syncthreads();
    }
}
__device__ __forceinline__ void phase_ret_scan(const Frame& F) {
    bf16* St = (bf16*)(F.ws + WS_AUX);
    for (int gt = F.vcu * NTHREADS + F.tid; gt < 8 * 16384; gt += F.G * NTHREADS) {
        const int bh = gt >> 14, chunk = gt & 16383, h = bh & 3;
        const float g128 = exp2f(128.0f * log2f(1.0f - exp2f(-5.0f - (float)h)));
        bf16* base = St + (size_t)bh * RNC * (RDV * RDK) + (size_t)chunk * 8;
        float c[8];
#pragma unroll
        for (int j = 0; j < 8; ++j) c[j] = 0.f;
#pragma unroll 8
        for (int n = 0; n < RNC; ++n) { bf16* pn = base + (size_t)n * (RDV * RDK); const u32x4 uv = *(const u32x4*)pn;
            u32x4 o; o.x = pk2(c[0], c[1]); o.y = pk2(c[2], c[3]); o.z = pk2(c[4], c[5]); o.w = pk2(c[6], c[7]); *(u32x4*)pn = o;
            c[0] = g128 * (c[0] + bflo(uv.x)); c[1] = g128 * (c[1] + bfhi(uv.x)); c[2] = g128 * (c[2] + bflo(uv.y)); c[3] = g128 * (c[3] + bfhi(uv.y));
            c[4] = g128 * (c[4] + bflo(uv.z)); c[5] = g128 * (c[5] + bfhi(uv.z)); c[6] = g128 * (c[6] + bflo(uv.w)); c[7] = g128 * (c[7] + bfhi(uv.w)); }
    }
}
__device__ __forceinline__ void phase_ret_out(const Frame& F, KP p) {
    const bf16* proj = (const bf16*)(F.ws + WS_BIG); const bf16* St = (const bf16*)(F.ws + WS_AUX); bf16* yret = (bf16*)(F.ws + WS_BIG + BIG_YRET);
    const float* gng = gin(p, 4); const float* gnb = gin(p, 5);
    constexpr int LD = 264, VLD = 136;
    LAS bf16* Rs = (LAS bf16*)F.lds; LAS bf16* Vs = Rs + 128 * LD;
    const int lane = F.lane, w = F.wave, g4 = lane >> 4, l15 = lane & 15, qq = l15 >> 2, pp = lane & 3;
    for (int u = F.vcu; u < 512; u += F.G) {
        const int h = u & 3, n = (u >> 2) & 63, b = u >> 8;
        const size_t row0 = (size_t)b * SEQ + (size_t)n * RC;
#pragma unroll 4
        for (int it = 0; it < 8; ++it) { const int idx = F.tid + 512 * it, j = idx >> 5, ch = idx & 31;
            *(LAS u32x4*)(Rs + j * LD + ch * 8) = *(const u32x4*)(proj + (row0 + j) * RET_IN + 1024 + h * 256 + ch * 8); }
        const int irow = 16 * w + l15; const size_t qrow = row0 + irow;
        bf16x8 qf[8];
#pragma unroll
        for (int s = 0; s < 8; ++s) qf[s] = *(const bf16x8*)(proj + qrow * RET_IN + h * 256 + 32 * s + 8 * g4);
        __syncthreads();
        bf16x8 pf[4];
        { f32x4 sacc[8];
#pragma unroll
            for (int jt = 0; jt < 8; ++jt) { sacc[jt] = (f32x4){0.f, 0.f, 0.f, 0.f};
                if (jt <= w) {
#pragma unroll
                    for (int s = 0; s < 8; ++s) sacc[jt] = MFMA16(row_frag(Rs, LD, 16 * jt, 32 * s, lane), qf[s], sacc[jt]);
#pragma unroll
                    for (int i = 0; i < 4; ++i) if (16 * jt + 4 * g4 + i > irow) sacc[jt][i] = 0.f; } }
#pragma unroll
            for (int kt = 0; kt < 4; ++kt) pf[kt] = pack8(sacc[2 * kt], sacc[2 * kt + 1]); }
        __syncthreads();
        f32x4 acc[4][8];
        const bf16* Sn = St + ((size_t)((b * RH + h) * RNC + n)) * (RDV * RDK);
#pragma unroll
        for (int sl = 0; sl < 4; ++sl) {
#pragma unroll 4
            for (int it = 0; it < 4; ++it) { const int idx = F.tid + 512 * it, j = idx >> 4, ch = idx & 15;
                *(LAS u32x4*)(Vs + j * VLD + ch * 8) = *(const u32x4*)(proj + (row0 + j) * RET_IN + 2048 + h * 512 + sl * 128 + ch * 8); }
#pragma unroll 4
            for (int it = 0; it < 8; ++it) { const int idx = F.tid + 512 * it, e = idx >> 5, ch = idx & 31;
                *(LAS u32x4*)(Rs + e * LD + ch * 8) = *(const u32x4*)(Sn + (size_t)(sl * 128 + e) * RDK + ch * 8); }
            __syncthreads();
#pragma unroll
            for (int et = 0; et < 8; ++et) { f32x4 a = (f32x4){0.f, 0.f, 0.f, 0.f};
#pragma unroll
                for (int kt = 0; kt < 4; ++kt) if (2 * kt <= w) { const LAS bf16* a0 = Vs + (32 * kt + 4 * g4 + qq) * VLD + 32 * pp + 4 * et;
                    a = MFMA16(cat8(tr4(a0), tr4(a0 + 16 * VLD)), pf[kt], a); }
                const LAS bf16* srow = Rs + (32 * qq + 4 * et + pp) * LD + 8 * g4;
#pragma unroll
                for (int s = 0; s < 8; ++s) a = MFMA16(*(const LAS bf16x8*)(srow + 32 * s), qf[s], a);
                acc[sl][et] = a; }
            __syncthreads();
        }
        float s = 0.f;
#pragma unroll
        for (int sl = 0; sl < 4; ++sl)
#pragma unroll
            for (int et = 0; et < 8; ++et) s += (acc[sl][et][0] + acc[sl][et][1]) + (acc[sl][et][2] + acc[sl][et][3]);
        s += shx(s, 16, lane); s += shx(s, 32, lane);
        const float mean = s * (1.0f / RDV); float s2 = 0.f;
#pragma unroll
        for (int sl = 0; sl < 4; ++sl)
#pragma unroll
            for (int et = 0; et < 8; ++et) { acc[sl][et] = acc[sl][et] - mean; s2 += (acc[sl][et][0] * acc[sl][et][0] + acc[sl][et][1] * acc[sl][et][1]) + (acc[sl][et][2] * acc[sl][et][2] + acc[sl][et][3] * acc[sl][et][3]); }
        s2 += shx(s2, 16, lane); s2 += shx(s2, 32, lane);
        const float rstd = 1.0f / sqrtf(s2 * (1.0f / RDV) + LN_EPS);
#pragma unroll
        for (int sl = 0; sl < 4; ++sl) { const int c0 = h * RDV + sl * 128 + 32 * g4;
#pragma unroll
            for (int q = 0; q < 4; ++q) { const u32x4 gw = *(const u32x4*)(proj + qrow * RET_IN + 4096 + c0 + 8 * q);
                const f32x4 gg0 = *(const f32x4*)(gng + c0 + 8 * q), gg1 = *(const f32x4*)(gng + c0 + 8 * q + 4), gb0 = *(const f32x4*)(gnb + c0 + 8 * q), gb1 = *(const f32x4*)(gnb + c0 + 8 * q + 4);
                f32x4 y0 = acc[sl][2 * q] * rstd * gg0 + gb0, y1 = acc[sl][2 * q + 1] * rstd * gg1 + gb1;
                const float gv[8] = {bflo(gw.x), bfhi(gw.x), bflo(gw.y), bfhi(gw.y), bflo(gw.z), bfhi(gw.z), bflo(gw.w), bfhi(gw.w)};
#pragma unroll
                for (int j = 0; j < 4; ++j) { y0[j] *= gv[j] / (1.0f + __expf(-gv[j])); y1[j] *= gv[4 + j] / (1.0f + __expf(-gv[4 + j])); }
                *(u32x4*)(yret + qrow * RET_V + c0 + 8 * q) = pack_bf16x8(y0, y1); } }
    }
}

constexpr size_t AUX_S5E = 64 * MiB;
constexpr int S5L = 256, S5NC = SEQ / S5L;
__device__ __forceinline__ void cmul_add(float& rr, float& ri, float ar, float ai, float xr, float xi, float cr, float ci) { rr = ar * xr - ai * xi + cr; ri = ar * xi + ai * xr + ci; }
template <bool OUT>
__device__ __forceinline__ void phase_s5_scan(const Frame& F, KP p) {
    const bf16* X = (const bf16*)(F.ws + WS_XB); float* E = (float*)(F.ws + WS_AUX + AUX_S5E); bf16* ybuf = (bf16*)(F.ws + WS_AUX);
    const int lane = F.lane, w = F.wave, g4 = lane >> 4, l15 = lane & 15;
    LAS bf16* ut = (LAS bf16*)(F.lds + w * 12288);
    LAS bf16* Hb = (LAS bf16*)(F.lds + w * 12288 + 4096);
    constexpr int HLD = 136;
    const int gw = F.vcu * NWAVES + w, NGW = F.G * NWAVES;
    const int up16 = (lane - 16) << 2, up32 = (lane - 32) << 2, last16 = (48 + l15) << 2;
    for (int unit = gw; unit < BATCH * SG * S5NC; unit += NGW) {
        const int n = unit & (S5NC - 1), g = (unit >> 5) & 63, b = unit >> 11;
        float a1r[4], a1i[4], a4r[4], a4i[4], a8r[4], a8i[4], pwr[4], pwi[4];
        bf16x8 bfrag[8];
        const float dt = expf(gin(p, 14)[g]);
#pragma unroll
        for (int st = 0; st < 4; ++st) { const int ps = 16 * st + l15;
            const float are = gin(p, 7)[g * SP + ps], aim = gin(p, 8)[g * SP + ps];
            const float mag = expf(dt * are); const float abr = mag * cosf(dt * aim), abi = mag * sinf(dt * aim);
            const float den = are * are + aim * aim;
            const float fre = ((abr - 1.0f) * are + abi * aim) / den, fim = (abi * are - (abr - 1.0f) * aim) / den;
            a1r[st] = abr; a1i[st] = abi; { float t2r, t2i; cmul_add(t2r, t2i, abr, abi, abr, abi, 0.f, 0.f); cmul_add(a4r[st], a4i[st], t2r, t2i, t2r, t2i, 0.f, 0.f); }
            cmul_add(a8r[st], a8i[st], a4r[st], a4i[st], a4r[st], a4i[st], 0.f, 0.f);
            float qr = 1.f, qi = 0.f;
            if (g4 & 1) { qr = a4r[st]; qi = a4i[st]; }
            if (g4 & 2) { float tr, ti; cmul_add(tr, ti, qr, qi, a8r[st], a8i[st], 0.f, 0.f); qr = tr; qi = ti; }
            pwr[st] = qr; pwi[st] = qi;
            const float* br = gin(p, 9) + ((size_t)g * SP + ps) * SGC + 8 * (g4 & 1); const float* bi = gin(p, 10) + ((size_t)g * SP + ps) * SGC + 8 * (g4 & 1);
            const f32x4 r0 = *(const f32x4*)br, r1 = *(const f32x4*)(br + 4), i0 = *(const f32x4*)bi, i1 = *(const f32x4*)(bi + 4);
            const float z = (g4 < 2) ? 1.0f : 0.0f; const float fr2 = fre * z, fi2 = fim * z;
            bfrag[st] = pack8(r0 * fr2 - i0 * fi2, r1 * fr2 - i1 * fi2); bfrag[st + 4] = pack8(i0 * fr2 + r0 * fi2, i1 * fr2 + r1 * fi2);
        }
        float sr[4], si[4];
        float* Eu = E + ((size_t)(b * SG + g) * S5NC + n) * 128;
        bf16x8 cf[4]; f32x4 dsk = (f32x4){0.f, 0.f, 0.f, 0.f};
#pragma unroll
        for (int st = 0; st < 4; ++st) { sr[st] = 0.f; si[st] = 0.f; }
        if (OUT) {
#pragma unroll
            for (int st = 0; st < 4; ++st) { sr[st] = Eu[16 * st + l15]; si[st] = Eu[64 + 16 * st + l15]; }
#pragma unroll
            for (int s = 0; s < 4; ++s) { const float* cp = (s < 2 ? gin(p, 11) : gin(p, 12)) + ((size_t)g * SGC + l15) * SP + 32 * (s & 1) + 8 * g4; const float sg = s < 2 ? 1.0f : -1.0f;
                const f32x4 c0 = *(const f32x4*)cp * sg, c1 = *(const f32x4*)(cp + 4) * sg; cf[s] = pack8(c0, c1); }
            dsk = *(const f32x4*)(gin(p, 13) + g * SGC + 4 * g4); }
        const size_t tok0 = (size_t)b * SEQ + (size_t)n * S5L;
        u32x4 pre[2];
        { const bf16* src = X + (tok0 + lane) * D + g * SGC; pre[0] = *(const u32x4*)src; pre[1] = *(const u32x4*)(src + 8); }
        for (int sub = 0; sub < S5L / 64; ++sub) {
            *(LAS u32x4*)(ut + lane * 16) = pre[0]; *(LAS u32x4*)(ut + lane * 16 + 8) = pre[1];
            if (sub + 1 < S5L / 64) { const bf16* src = X + (tok0 + (sub + 1) * 64 + lane) * D + g * SGC; pre[0] = *(const u32x4*)src; pre[1] = *(const u32x4*)(src + 8); }
            LDS_WAIT(); asm volatile("" ::: "memory");
#pragma unroll 1
            for (int blk = 0; blk < 4; ++blk) {
                u32x4 uw = *(const LAS u32x4*)(ut + (blk * 16 + l15) * 16 + 8 * (g4 & 1));
                if (g4 >= 2) uw = (u32x4){0u, 0u, 0u, 0u};
                const bf16x8 ufr = __builtin_bit_cast(bf16x8, uw);
                f32x4 dr[4], di[4];
#pragma unroll
                for (int st = 0; st < 4; ++st) { dr[st] = MFMA16(ufr, bfrag[st], ((f32x4){0.f, 0.f, 0.f, 0.f})); di[st] = MFMA16(ufr, bfrag[st + 4], ((f32x4){0.f, 0.f, 0.f, 0.f})); }
                float vr[4], vi[4];
#pragma unroll
                for (int st = 0; st < 4; ++st) {
                    float hr = 0.f, hi = 0.f;
#pragma unroll
                    for (int i = 0; i < 4; ++i) { float nr, ni; cmul_add(nr, ni, a1r[st], a1i[st], hr, hi, dr[st][i], di[st][i]); hr = nr; hi = ni; dr[st][i] = hr; di[st][i] = hi; }
                    vr[st] = hr; vi[st] = hi; }
#define BPF(idx, v) __builtin_bit_cast(float, __builtin_amdgcn_ds_bpermute((idx), __builtin_bit_cast(int, (v))))
                { float xr[4], xi[4];
#pragma unroll
                  for (int st = 0; st < 4; ++st) { xr[st] = BPF(up16, vr[st]); xi[st] = BPF(up16, vi[st]); }
#pragma unroll
                  for (int st = 0; st < 4; ++st) { float tr, ti; cmul_add(tr, ti, a4r[st], a4i[st], xr[st], xi[st], vr[st], vi[st]); if (g4 >= 1) { vr[st] = tr; vi[st] = ti; } }
#pragma unroll
                  for (int st = 0; st < 4; ++st) { xr[st] = BPF(up32, vr[st]); xi[st] = BPF(up32, vi[st]); }
#pragma unroll
                  for (int st = 0; st < 4; ++st) { float tr, ti; cmul_add(tr, ti, a8r[st], a8i[st], xr[st], xi[st], vr[st], vi[st]); if (g4 >= 2) { vr[st] = tr; vi[st] = ti; } } }
                float er[4], ei[4], lr[4], li[4];
#pragma unroll
                for (int st = 0; st < 4; ++st) { er[st] = BPF(up16, vr[st]); ei[st] = BPF(up16, vi[st]); lr[st] = BPF(last16, vr[st]); li[st] = BPF(last16, vi[st]); }
#undef BPF
#pragma unroll
                for (int st = 0; st < 4; ++st) {
                    if (g4 == 0) { er[st] = 0.f; ei[st] = 0.f; }
                    float s0r, s0i; cmul_add(s0r, s0i, pwr[st], pwi[st], sr[st], si[st], er[st], ei[st]);
#pragma unroll
                    for (int i = 0; i < 4; ++i) { float tr, ti; cmul_add(tr, ti, a1r[st], a1i[st], s0r, s0i, 0.f, 0.f); s0r = tr; s0i = ti; dr[st][i] += s0r; di[st][i] += s0i; }
                    { float a16r, a16i; cmul_add(a16r, a16i, a8r[st], a8i[st], a8r[st], a8i[st], 0.f, 0.f); float tr, ti; cmul_add(tr, ti, a16r, a16i, sr[st], si[st], lr[st], li[st]); sr[st] = tr; si[st] = ti; }
                    if (OUT) {
#pragma unroll
                        for (int i = 0; i < 4; ++i) { const unsigned hw = pk2(dr[st][i], di[st][i]); Hb[(4 * g4 + i) * HLD + 16 * st + l15] = (bf16)hw; Hb[(4 * g4 + i) * HLD + 64 + 16 * st + l15] = (bf16)(hw >> 16); } }
                }
                if (OUT) {
                    LDS_WAIT(); asm volatile("" ::: "memory");
                    f32x4 ya = (f32x4){0.f, 0.f, 0.f, 0.f};
#pragma unroll
                    for (int s = 0; s < 4; ++s) ya = MFMA16(cf[s], row_frag(Hb, HLD, 0, 32 * s, lane), ya);
                    const u32x2 u2 = *(const LAS u32x2*)(ut + (blk * 16 + l15) * 16 + 4 * g4);
                    const f32x4 u4 = (f32x4){bflo(u2.x), bfhi(u2.x), bflo(u2.y), bfhi(u2.y)};
                    f32x4 y = ya + dsk * u4;
#pragma unroll
                    for (int j = 0; j < 4; ++j) { const float v = y[j]; y[j] = v / (1.0f + __expf(-1.5957691216057308f * (v + 0.044715f * v * v * v))); }
                    u32x2 o; o.x = pk2(y[0], y[1]); o.y = pk2(y[2], y[3]);
                    *(u32x2*)(ybuf + (tok0 + sub * 64 + blk * 16 + l15) * D + g * SGC + 4 * g4) = o;
                    asm volatile("" ::: "memory"); }
            }
            LDS_WAIT(); asm volatile("" ::: "memory");
        }
        if (!OUT && g4 == 0) {
#pragma unroll
            for (int st = 0; st < 4; ++st) { Eu[16 * st + l15] = sr[st]; Eu[64 + 16 * st + l15] = si[st]; } }
    }
}
__device__ __forceinline__ void phase_s5_carry(const Frame& F, KP p) {
    float* E = (float*)(F.ws + WS_AUX + AUX_S5E);
    for (int gt = F.vcu * NTHREADS + F.tid; gt < BATCH * SG * SP; gt += F.G * NTHREADS) {
        const int pl = gt & 63, bg = gt >> 6, g = bg & 63;
        const float dt = expf(gin(p, 14)[g]); const float are = gin(p, 7)[g * SP + pl], aim = gin(p, 8)[g * SP + pl];
        const float mag = expf(dt * are); float ar = mag * cosf(dt * aim), ai = mag * sinf(dt * aim);
#pragma unroll
        for (int q = 0; q < 8; ++q) { const float nr = ar * ar - ai * ai, ni = 2.0f * ar * ai; ar = nr; ai = ni; }
        float cr = 0.f, ci = 0.f;
        for (int n = 0; n < S5NC; ++n) { float* Eu = E + ((size_t)bg * S5NC + n) * 128; const float er = Eu[pl], ei = Eu[64 + pl];
            Eu[pl] = cr; Eu[64 + pl] = ci;
            const float nr = ar * cr - ai * ci + er, ni = ar * ci + ai * cr + ei; cr = nr; ci = ni; }
    }
}

constexpr int NPHASES = 34;
#ifndef PROBE_DRY14
#define PROBE_DRY14 0
#endif
#ifndef PROBE_DRY17
#define PROBE_DRY17 0
#endif
#ifndef PH_MASK
#define PH_MASK 0xFFFFFFFFu
#endif
#define PHT(t) ((PH_MASK >> (t)) & 1u)
constexpr int PLAN_OFF = 64;
__device__ __forceinline__ void moe_plan(const Frame& F, int layer) {
    volatile LAS int* tstart = (volatile LAS int*)(F.MISC + PLAN_OFF); volatile LAS int* cnts = tstart + 72;
    __syncthreads();
    if (F.wave == 0) {
        const unsigned* cnt = (const unsigned*)(F.ws + WS_CTL) + CW_CNT + layer * NE * 64;
        const int c = (int)__hip_atomic_load(cnt + F.lane * 64, __ATOMIC_RELAXED, __HIP_MEMORY_SCOPE_AGENT);
        int v = (c + 255) >> 8;
#pragma unroll
        for (int o = 1; o < 64; o <<= 1) { const int nb = __builtin_amdgcn_ds_bpermute((F.lane - o) << 2, v); if (F.lane >= o) v += nb; }
        tstart[F.lane + 1] = v; cnts[F.lane] = c;
        if (F.lane == 0) tstart[0] = 0;
        if (F.lane == 63) { tstart[65] = v + T / 256; cnts[64] = T; }
    }
    __syncthreads();
}
template <bool GATH> struct MoeSched2 {
    static constexpr bool GATHER = GATH, UNIFORMIZE = true;
    static constexpr int ncol = GATH ? 2 : 4, K = GATH ? D : ED;
    const volatile LAS int* tstart; const volatile LAS int* cnts; int ntiles, G, c, lane;
    const char* Abase; const char* Wbase; const int* lists;
    __device__ __forceinline__ bool next(int i, pg8::UnitG& u) const {
        const int nwg = ntiles * ncol; const long L = (long)i * G + c; if (L >= nwg) return false;
        int wgid = (int)L; { const int q = nwg / 8, r = nwg % 8, xcd = wgid % 8, off = wgid / 8; wgid = (xcd < r ? xcd * (q + 1) : r * (q + 1) + (xcd - r) * q) + off; }
        const int tile = wgid / ncol, pn = wgid % ncol;
        const int ta = tstart[lane], tb = tstart[lane + 1];
        const unsigned long long mm = __ballot(ta <= tile && tile < tb);
        const int e = mm ? (int)__builtin_ctzll(mm) : 64;
        const int ts = __builtin_amdgcn_readfirstlane((int)tstart[e]), ce = __builtin_amdgcn_readfirstlane((int)cnts[e]);
        const int lt = tile - ts; int valid = ce - lt * 256; valid = valid > 256 ? 256 : valid;
        u.gshift = 0; u.aux = e;
        if (GATH) {
            u.B = Wbase + (size_t)e * WMOE_E_BYTES + (size_t)pn * 256 * K * 2;
            if (e < 64) { u.A = Abase; u.gidx = lists + (size_t)e * T + lt * 256; u.gcnt = valid; }
            else { u.A = Abase + (size_t)lt * 256 * K * 2; u.gidx = nullptr; u.gcnt = 0; }
            u.row0 = tile * 256; u.col0 = pn * 128;
        } else {
            u.B = Wbase + (size_t)e * WMOE_E_BYTES + (size_t)512 * 1024 * 2 + (size_t)pn * 256 * K * 2;
            u.A = Abase + (size_t)tile * 256 * K * 2; u.gidx = nullptr; u.gcnt = valid;
            u.row0 = tile * 256; u.col0 = pn * 256;
        }
        return true;
    }
};
__device__ __forceinline__ void phase_load_x(const Frame& F, KP p) {
    const float* xin = gin(p, 0); bf16* XB = (bf16*)(F.ws + WS_XB);
    for (size_t i = (size_t)F.vcu * NTHREADS + F.tid; i < (size_t)T * D / 8; i += (size_t)F.G * NTHREADS) {
        const f32x4 a = *(const f32x4*)(xin + i * 8), b = *(const f32x4*)(xin + i * 8 + 4);
        *(u32x4*)(XB + i * 8) = pack_bf16x8(a, b); }
}

__global__ void __launch_bounds__(NTHREADS, 2) fwd_kernel(Params p_unused) {
    KP p0 = (KP)__builtin_amdgcn_kernarg_segment_ptr();
    extern __shared__ __attribute__((aligned(16))) unsigned char lds_raw[];
    Frame F0;
    F0.lds = (LAS unsigned char*)lds_raw; F0.MISC = (volatile LAS unsigned*)(F0.lds + MISC_OFF);
    F0.tid = threadIdx.x; F0.lane = F0.tid & 63; F0.wave = __builtin_amdgcn_readfirstlane(F0.tid >> 6);
    F0.G = gridDim.x; { const int bq = blockIdx.x; F0.vcu = (F0.G % 8 == 0) ? (bq % 8) * (F0.G / 8) + bq / 8 : bq; }
    F0.ws = p0->ws;
    const int bx0 = blockIdx.x;
    for (int u = F0.tid; u < (LDS_BYTES - MISC_OFF) / 4; u += NTHREADS) ((LAS unsigned*)(F0.lds + MISC_OFF))[u] = 0u;
    __syncthreads();
    XcdBarrier bar; bar.bar = (unsigned*)(p0->ws + WS_CTL) + CW_BAR; bar.x = 0; bar.st = nullptr;
    const int use_bar = p0->use_bar;
    if (use_bar) bar = xcd_barrier_post((unsigned*)(p0->ws + WS_CTL) + CW_BAR, F0.MISC + 8);
    const int lo = p0->ph_lo, hi = p0->ph_hi;
#define PHASE_BEGIN Frame F = F0; KP p = p0; asm volatile("" : "+v"(F.tid), "+v"(F.lane)); GAS unsigned char* wsg_ = (GAS unsigned char*)F0.ws; asm volatile("" : "+s"(F.wave), "+s"(F.vcu), "+s"(F.G), "+s"(wsg_), "+s"(p)); \
    F.ws = (unsigned char*)wsg_; int bx = bx0; asm volatile("" : "+s"(bx)); unsigned char* ws = F.ws; (void)ws; (void)bx;
#pragma unroll 1
    for (int ph = lo; ph < hi; ++ph) {
        int layer = 0, type = 0;
        if (ph > 0) { layer = ph >= 26 ? 3 : (ph >= 18 ? 2 : (ph >= 9 ? 1 : 0)); const int q = ph - (layer == 3 ? 26 : (layer == 2 ? 18 : (layer == 1 ? 9 : 1))); const int kind = layer % 3;
            if (kind == 0) type = q < 4 ? 1 + q : 14 + (q - 4); else if (kind == 1) type = q < 5 ? 5 + q : 14 + (q - 5); else type = q < 4 ? 10 + q : 14 + (q - 4); }
        const int j = layer / 3;
#ifdef REPEAT_MASK
        const int nrep = ((REPEAT_MASK >> type) & 1u) ? 2 : 1;
#else
        const int nrep = 1;
#endif
#pragma unroll 1
        for (int rep = 0; rep < nrep; ++rep) {
        if (rep > 0 && use_bar) xcd_barrier(bar);
        if (PHT(0) && type == 0) { PHASE_BEGIN; phase_conv_mixers(F, p); phase_conv_moe(F, p, 0); phase_load_x(F, p); }
        else if (PHT(1) && type == 1) { PHASE_BEGIN; DenseSched S; S.init(ws + WS_XB, ws + WS_ATT_IN_T + (size_t)j * ATT_IN * D * 2, T, ATT_IN, D, F.G, bx); EpiStoreBf16 E{(bf16*)(ws + WS_BIG), ATT_IN};
            pg8::gemm_phase(F.lds, F.tid, D, S, E); }
        else if (PHT(2) && type == 2) { PHASE_BEGIN; phase_attn(F, bx); }
        else if (PHT(3) && type == 3) { PHASE_BEGIN; phase_attn_combine(F); }
        else if (PHT(4) && type == 4) { PHASE_BEGIN; DenseSched S; S.init(ws + WS_AUX + AUX_OB, ws + WS_ATT_OUT_T + (size_t)j * D * D * 2, T, D, D, F.G, bx); EpiResid E{(const bf16*)(ws + WS_XB), (bf16*)(ws + WS_Y)};
            pg8::gemm_phase(F.lds, F.tid, D, S, E); }
        else if (PHT(5) && type == 5) { PHASE_BEGIN; DenseSched S; S.init(ws + WS_XB, ws + WS_RET_IN_T, T, RET_IN, D, F.G, bx); EpiRetIn E{(bf16*)(ws + WS_BIG), RET_IN};
            pg8::gemm_phase(F.lds, F.tid, D, S, E); }
        else if (PHT(6) && type == 6) { PHASE_BEGIN; phase_ret_u(F); }
        else if (PHT(7) && type == 7) { PHASE_BEGIN; phase_ret_scan(F); }
        else if (PHT(8) && type == 8) { PHASE_BEGIN; phase_ret_out(F, p); }
        else if (PHT(9) && type == 9) { PHASE_BEGIN; DenseSched S; S.init(ws + WS_BIG + BIG_YRET, ws + WS_RET_OUT_T, T, D, RET_V, F.G, bx); EpiResid E{(const bf16*)(ws + WS_XB), (bf16*)(ws + WS_Y)};
            pg8::gemm_phase(F.lds, F.tid, RET_V, S, E); }
        else if (PHT(10) && type == 10) { PHASE_BEGIN; phase_s5_scan<false>(F, p); }
        else if (PHT(11) && type == 11) { PHASE_BEGIN; phase_s5_carry(F, p); }
        else if (PHT(12) && type == 12) { PHASE_BEGIN; phase_s5_scan<true>(F, p); }
        else if (PHT(13) && type == 13) { PHASE_BEGIN; DenseSched S; S.init(ws + WS_AUX, ws + WS_GLU_T, T, 2 * D, D, F.G, bx); EpiGluResid E{(const bf16*)(ws + WS_XB), (bf16*)(ws + WS_Y)};
            pg8::gemm_phase(F.lds, F.tid, D, S, E); }
        else if (PHT(14) && type == 14) { PHASE_BEGIN; phase_lnr(F, p, layer, PROBE_DRY14 && true); if (PROBE_DRY14) { if (use_bar) xcd_barrier(bar); phase_lnr(F, p, layer, false); } }
        else if (PHT(15) && type == 15) { PHASE_BEGIN; moe_plan(F, layer);
            MoeSched2<true> S; S.tstart = (const volatile LAS int*)(F.MISC + PLAN_OFF); S.cnts = S.tstart + 72; S.ntiles = __builtin_amdgcn_readfirstlane((int)S.tstart[65]); S.G = F.G; S.c = bx; S.lane = F.lane;
            S.Abase = (const char*)(ws + WS_XB); S.Wbase = (const char*)(ws + WS_WMOE); S.lists = (const int*)(ws + WS_LIST);
            EpiMoeUp E{(bf16*)(ws + WS_H)};
            pg8::gemm_phase(F.lds, F.tid, D, S, E); }
        else if (PHT(16) && type == 16) { PHASE_BEGIN; moe_plan(F, layer);
            MoeSched2<false> S; S.tstart = (const volatile LAS int*)(F.MISC + PLAN_OFF); S.cnts = S.tstart + 72; S.ntiles = __builtin_amdgcn_readfirstlane((int)S.tstart[65]); S.G = F.G; S.c = bx; S.lane = F.lane;
            S.Abase = (const char*)(ws + WS_H); S.Wbase = (const char*)(ws + WS_WMOE); S.lists = (const int*)(ws + WS_LIST);
            EpiStoreBf16 E{(bf16*)(ws + WS_BIG), D};
            pg8::gemm_phase(F.lds, F.tid, ED, S, E); }
        else if (PHT(17) && type == 17) { PHASE_BEGIN; moe_plan(F, layer); if (PROBE_DRY17) { phase_combine(F, p, layer, true); if (use_bar) xcd_barrier(bar); } phase_combine(F, p, layer); if (layer + 1 < DEPTH) phase_conv_moe(F, p, layer + 1); }
        }
        if (use_bar && ph + 1 < hi) xcd_barrier(bar);
    }
}

#ifndef MK_PER_PHASE
#define MK_PER_PHASE 0
#endif
extern "C" void kernel_launch(void* const* d_in, const int* in_sizes, int n_in, void* d_out, int out_size, void* d_ws, size_t ws_size, hipStream_t stream) {
    static int grid = 0;
    if (grid == 0) {
        if (n_in != 26 || in_sizes[0] != T * D || out_size != T * D || ws_size < WS_END) { fprintf(stderr, "kernel_launch: unexpected shapes / workspace (n_in %d, in0 %d, out %d, ws %zu < %zu)\n", n_in, n_in > 0 ? in_sizes[0] : -1, out_size, ws_size, (size_t)WS_END); grid = -1; return; }
        int dev = 0, cus = 0, per_cu = 0;
        if (hipGetDevice(&dev) != hipSuccess || hipDeviceGetAttribute(&cus, hipDeviceAttributeMultiprocessorCount, dev) != hipSuccess) { grid = -1; return; }
        if (hipFuncSetAttribute((const void*)fwd_kernel, hipFuncAttributeMaxDynamicSharedMemorySize, LDS_BYTES) != hipSuccess) { fprintf(stderr, "kernel_launch: hipFuncSetAttribute failed\n"); grid = -1; return; }
        if (hipOccupancyMaxActiveBlocksPerMultiprocessor(&per_cu, (const void*)fwd_kernel, NTHREADS, LDS_BYTES) != hipSuccess || per_cu < 1) { fprintf(stderr, "kernel_launch: occupancy query says %d blocks per CU\n", per_cu); per_cu = 1; }
        (void)hipGetLastError();
        grid = cus;
    }
    if (grid < 0) return;
    (void)hipMemsetAsync((char*)d_ws + WS_CTL, 0, CTL_ZERO_BYTES, stream);
    Params p{};
    for (int i = 0; i < 26; ++i) p.in[i] = (const float*)d_in[i];
    p.out = (float*)d_out; p.ws = (unsigned char*)d_ws;
#if MK_PER_PHASE
    for (int k = 0; k < NPHASES; ++k) { p.ph_lo = k; p.ph_hi = k + 1; p.use_bar = 0; hipLaunchKernelGGL(fwd_kernel, dim3(grid), dim3(NTHREADS), LDS_BYTES, stream, p); }
#else
    p.ph_lo = 0; p.ph_hi = NPHASES; p.use_bar = 1;
    hipLaunchKernelGGL(fwd_kernel, dim3(grid), dim3(NTHREADS), LDS_BYTES, stream, p);
#endif
}
```

```cpp
#include <hip/hip_runtime.h>
#include <cstdio>
#include <cstdint>

#define LAS __attribute__((address_space(3)))
#define GAS __attribute__((address_space(1)))
typedef unsigned short bf16;
typedef short bf16x8 __attribute__((ext_vector_type(8)));
typedef short bf16x4 __attribute__((ext_vector_type(4)));
typedef float f32x4 __attribute__((ext_vector_type(4)));
typedef float f32x2 __attribute__((ext_vector_type(2)));
typedef unsigned u32x4 __attribute__((ext_vector_type(4)));
typedef unsigned u32x2 __attribute__((ext_vector_type(2)));
typedef GAS unsigned gu32;

constexpr int D = 1024, BATCH = 2, SEQ = 8192, T = BATCH * SEQ, DEPTH = 4;
constexpr int AH = 8, AHD = 128, ATT_IN = 9216;
constexpr int RH = 4, RDK = 256, RDV = 512, RET_IN = 6144, RET_V = 2048, RC = 128, RNC = SEQ / RC;
constexpr int SG = 64, SGC = 16, SP = 64;
constexpr int NE = 64, TOPK = 8, NEG = 8, ED = 256, NSLOT = 9;
constexpr float LN_EPS = 1e-5f;
constexpr float ALPHA = 1.6817928305074292f;
constexpr int NWAVES = 8, NTHREADS = 512;

__device__ __forceinline__ unsigned f2bf(float f) { unsigned u = __builtin_bit_cast(unsigned, f); return (u + 0x7fffu + ((u >> 16) & 1u)) >> 16; }
__device__ __forceinline__ unsigned pk2(float lo, float hi) { unsigned r; asm("s_nop 1\n\tv_cvt_pk_bf16_f32 %0, %1, %2" : "=v"(r) : "v"(lo), "v"(hi)); return r; }
__device__ __forceinline__ unsigned pk2sw(float lo, float hi) { return f2bf(lo) | (f2bf(hi) << 16); }
__device__ __forceinline__ unsigned pk2hw(float lo, float hi) { unsigned r; asm volatile("v_cvt_pk_bf16_f32 %0, %1, %2" : "=v"(r) : "v"(lo), "v"(hi)); return r; }
__device__ __forceinline__ float bf2f(unsigned b) { return __builtin_bit_cast(float, b << 16); }
__device__ __forceinline__ float bflo(unsigned w) { return __builtin_bit_cast(float, w << 16); }
__device__ __forceinline__ float bfhi(unsigned w) { return __builtin_bit_cast(float, w & 0xffff0000u); }
__device__ __forceinline__ float shx(float v, int m, int lane) { return __builtin_bit_cast(float, __builtin_amdgcn_ds_bpermute((lane ^ m) << 2, __builtin_bit_cast(int, v))); }
__device__ __forceinline__ int shx_i(int v, int m, int lane) { return __builtin_amdgcn_ds_bpermute((lane ^ m) << 2, v); }
__device__ __forceinline__ float rdl(float v, int src) { return __builtin_bit_cast(float, __builtin_amdgcn_readlane(__builtin_bit_cast(int, v), src)); }
__device__ __forceinline__ float wave_sum(float v, int lane) {
#pragma unroll
    for (int o = 1; o < 64; o <<= 1) v += shx(v, o, lane);
    return v;
}
#define LDS_WAIT() asm volatile("s_waitcnt lgkmcnt(0)" ::: "memory")
#define VM_WAIT() asm volatile("s_waitcnt vmcnt(0)" ::: "memory")
__device__ __forceinline__ const char* rfl_ptr(const char* p) {
    unsigned long long v = (unsigned long long)p; unsigned lo = __builtin_amdgcn_readfirstlane((unsigned)v), hi = __builtin_amdgcn_readfirstlane((unsigned)(v >> 32));
    return (const char*)(((unsigned long long)hi << 32) | lo);
}
__device__ __forceinline__ bf16x8 row_frag(const LAS bf16* base, int ld, int row0, int col0, int lane) {
    return *(const LAS bf16x8*)(base + (row0 + (lane & 15)) * ld + col0 + 8 * (lane >> 4));
}
__device__ __forceinline__ bf16x4 tr4(const LAS bf16* addr) { return __builtin_amdgcn_ds_read_tr16_b64_v4i16((LAS bf16x4*)addr); }
__device__ __forceinline__ bf16x8 cat8(bf16x4 a, bf16x4 b) { bf16x8 r; r[0] = a[0]; r[1] = a[1]; r[2] = a[2]; r[3] = a[3]; r[4] = b[0]; r[5] = b[1]; r[6] = b[2]; r[7] = b[3]; return r; }
#define MFMA16(a, b, c) __builtin_amdgcn_mfma_f32_16x16x32_bf16((a), (b), (c), 0, 0, 0)
__device__ __forceinline__ bf16x8 pack8(f32x4 a, f32x4 b) {
    u32x4 w; w.x = pk2(a[0], a[1]); w.y = pk2(a[2], a[3]); w.z = pk2(b[0], b[1]); w.w = pk2(b[2], b[3]); return __builtin_bit_cast(bf16x8, w);
}

namespace pg8 {
constexpr int BM = 256, BK = 64, HALF = 128, HTB = HALF * BK * 2, STAGE_BYTES = 8 * HTB;
__device__ __forceinline__ int lds_byte(int r, int c) { const int st = (r >> 4) * 2 + (c >> 5), rr = r & 15, cc = c & 31, ob = rr * 64 + cc * 2; return st * 1024 + (ob ^ (((ob >> 9) & 1) << 5)); }
__device__ __forceinline__ void stage_rc(int b, int& R, int& C) { const int st = b / 1024, sb = b % 1024, swz = sb ^ (((sb >> 9) & 1) << 5); R = (st >> 1) * 16 + swz / 64; C = (st & 1) * 32 + (swz % 64) / 2; }
__device__ __forceinline__ int perm32(int rho) { const int n = rho >> 4, i = rho & 15; return 8 * (i >> 2) + 4 * n + (i & 3); }

struct UnitG {
    const char* A;
    const char* B;
    const int* gidx;
    int gcnt, gshift;
    int row0, col0;
    int aux;
};

__device__ __forceinline__ void uniformize(UnitG& u) { u.A = rfl_ptr(u.A); u.B = rfl_ptr(u.B); u.gidx = (const int*)rfl_ptr((const char*)u.gidx); u.gcnt = __builtin_amdgcn_readfirstlane(u.gcnt); u.gshift = __builtin_amdgcn_readfirstlane(u.gshift);
    u.row0 = __builtin_amdgcn_readfirstlane(u.row0); u.col0 = __builtin_amdgcn_readfirstlane(u.col0); u.aux = __builtin_amdgcn_readfirstlane(u.aux); }
template <class Epi, class Sched>
__device__ __forceinline__ void gemm_phase(LAS unsigned char* lds, const int tid, const int K, const Sched& S, const Epi& E) {
    constexpr bool GATHER = Sched::GATHER;
    const int wid = __builtin_amdgcn_readfirstlane(tid >> 6), lane = tid & 63, wr = wid >> 2, wc = wid & 3, fr = lane & 15, fq = lane >> 4;
    const int nt = K / BK;
    constexpr bool P16 = Epi::PERM16;
    unsigned voffB[2], voffB1[2], vA[2][2];
#pragma unroll
    for (int i = 0; i < 2; ++i) { int R, C; stage_rc(tid * 16 + i * 8192, R, C); const int Rb = Epi::PERM ? ((R & ~31) + perm32(R & 31)) : R; voffB[i] = (unsigned)(Rb * K + C) * 2u; voffB1[i] = voffB[i]; vA[0][i] = (unsigned)(R * K + C) * 2u; vA[1][i] = vA[0][i];
        if constexpr (P16) { const int x = R & 31, src = 64 * (R >> 5) + 16 * ((x >> 2) & 3) + 4 * (x >> 4) + (x & 3); voffB[i] = (unsigned)(src * K + C) * 2u; voffB1[i] = (unsigned)((src + 8) * K + C) * 2u; } }
    const size_t kstep = (size_t)(BK * 2);
    const size_t hstep = (size_t)HALF * K * 2;
    const size_t hstepB = P16 ? 0 : hstep;
    const size_t hstepA = GATHER ? 0 : hstep;
    const unsigned ldsw = (unsigned)wid * 1024u;
    const int aoff = lds_byte(wr * 64 + fr, fq * 8), boff = lds_byte(wc * 32 + fr, fq * 8);
    LAS u32x4* park = (LAS u32x4*)(lds + STAGE_BYTES) + tid;
#define PG8_SA(b, h) (((b) * 2 + (h)) * HTB)
#define PG8_SB(b, h) ((4 + (b) * 2 + (h)) * HTB)
#define PG8_STAGE(bufoff, gbase, voff) do { _Pragma("unroll") for (int _i = 0; _i < 2; ++_i) { asm volatile("" : "+v"((voff)[_i]));   \
        __builtin_amdgcn_global_load_lds((const unsigned*)((const char*)(gbase) + (voff)[_i]), (LAS unsigned*)(lds + (bufoff) + ldsw + _i * 8192), 16, 0, 0); } } while (0)
#define PG8_LDA(dst, b, h) do { _Pragma("unroll") for (int m = 0; m < 4; ++m) _Pragma("unroll") for (int k = 0; k < 2; ++k) dst[m][k] = *(const LAS bf16x8*)(lds + PG8_SA(b, h) + aoff + m * 2048 + k * 1024); } while (0)
#define PG8_LDB(dst, b, h) do { _Pragma("unroll") for (int n = 0; n < 2; ++n) _Pragma("unroll") for (int k = 0; k < 2; ++k) dst[n][k] = *(const LAS bf16x8*)(lds + PG8_SB(b, h) + boff + n * 2048 + k * 1024); } while (0)
#define PG8_MMA(ai, bj, At, Bt) do { __builtin_amdgcn_s_setprio(1); _Pragma("unroll") for (int m = 0; m < 4; ++m) _Pragma("unroll") for (int n = 0; n < 2; ++n) _Pragma("unroll") for (int k = 0; k < 2; ++k) \
        acc[ai][bj][m][n] = __builtin_amdgcn_mfma_f32_16x16x32_bf16(Bt[n][k], At[m][k], acc[ai][bj][m][n], 0, 0, 0); __builtin_amdgcn_s_setprio(0); } while (0)
#define PG8_WAIT_V(n) asm volatile("s_waitcnt vmcnt(" #n ")" ::: "memory")
#define PG8_WAIT_L(n) asm volatile("s_waitcnt lgkmcnt(" #n ")" ::: "memory")
#define PG8_BAR __builtin_amdgcn_s_barrier()
#define PG8_SCHED __builtin_amdgcn_sched_barrier(0)
#define PG8_VOFF(u, v00, v01, v10, v11) do { int _R0, _C0, _R1, _C1; stage_rc(tid * 16, _R0, _C0); stage_rc(tid * 16 + 8192, _R1, _C1); int _r00 = _R0, _r01 = _R1, _r10 = HALF + _R0, _r11 = HALF + _R1; \
        if ((u).gidx) { const int _a = _r00 < (u).gcnt ? ((const GAS int*)(u).gidx)[_r00] >> (u).gshift : 0, _b = _r01 < (u).gcnt ? ((const GAS int*)(u).gidx)[_r01] >> (u).gshift : 0, _c = _r10 < (u).gcnt ? ((const GAS int*)(u).gidx)[_r10] >> (u).gshift : 0, _d = _r11 < (u).gcnt ? ((const GAS int*)(u).gidx)[_r11] >> (u).gshift : 0; \
            _r00 = _a; _r01 = _b; _r10 = _c; _r11 = _d; } \
        v00 = (unsigned)(_r00 * K + _C0) * 2u; v01 = (unsigned)(_r01 * K + _C1) * 2u; v10 = (unsigned)(_r10 * K + _C0) * 2u; v11 = (unsigned)(_r11 * K + _C1) * 2u; } while (0)
    UnitG cur, nxt; int ui = 0;
    if (!S.next(0, cur)) return;
    if constexpr (Sched::UNIFORMIZE) uniformize(cur);
    f32x4 acc[2][2][4][2];
#pragma unroll
    for (int a = 0; a < 2; ++a)
#pragma unroll
        for (int b = 0; b < 2; ++b)
#pragma unroll
            for (int m = 0; m < 4; ++m)
#pragma unroll
                for (int n = 0; n < 2; ++n) acc[a][b][m][n] = (f32x4){0.f, 0.f, 0.f, 0.f};
    bf16x8 At[4][2], B0[2][2], B1[2][2];
    if constexpr (GATHER) PG8_VOFF(cur, vA[0][0], vA[0][1], vA[1][0], vA[1][1]);
    const char* cA = cur.A; const char* cB = cur.B;
    PG8_STAGE(PG8_SB(0, 0), cB, voffB); PG8_STAGE(PG8_SB(0, 1), cB + hstepB, voffB1); PG8_STAGE(PG8_SA(0, 0), cA, vA[0]); PG8_STAGE(PG8_SA(0, 1), cA + hstepA, vA[1]);
    if (wr == 1) PG8_BAR;
    PG8_WAIT_V(2); PG8_BAR;
    PG8_STAGE(PG8_SB(1, 0), cB + kstep, voffB); PG8_STAGE(PG8_SA(1, 0), cA + kstep, vA[0]); PG8_STAGE(PG8_SB(1, 1), cB + hstepB + kstep, voffB1);
    PG8_WAIT_V(6); PG8_BAR;
    for (;;) {
        const bool has_next = S.next(ui + 1, nxt);
        if constexpr (Sched::UNIFORMIZE) { if (has_next) uniformize(nxt); }
        const char* nA = cA; const char* nB = cB;
        if (has_next) { nA = nxt.A; nB = nxt.B; }
        if constexpr (GATHER) { u32x4 pv; pv.x = vA[0][0]; pv.y = vA[0][1]; pv.z = vA[1][0]; pv.w = vA[1][1];
            if (has_next) PG8_VOFF(nxt, pv.x, pv.y, pv.z, pv.w);
            *park = pv; }
#pragma unroll 1
        for (int t = 0; t < nt; t += 2) {
            const bool last = (t == nt - 2);
            const char* a1 = cA + (size_t)(t + 1) * kstep;
            const char* a2 = last ? nA : cA + (size_t)(t + 2) * kstep; const char* b2 = last ? nB : cB + (size_t)(t + 2) * kstep;
            const char* a3 = a2 + kstep; const char* b3 = b2 + kstep;
            PG8_LDB(B0, 0, 0); PG8_LDB(B1, 0, 1); PG8_SCHED; PG8_LDA(At, 0, 0); PG8_STAGE(PG8_SA(1, 1), a1 + hstepA, vA[1]);
            PG8_WAIT_V(8); PG8_WAIT_L(0); PG8_BAR; PG8_MMA(0, 0, At, B0); PG8_MMA(0, 1, At, B1); PG8_BAR; PG8_SCHED;
            if constexpr (GATHER) { if (last) { const u32x4 pv = *park; vA[0][0] = pv.x; vA[0][1] = pv.y; vA[1][0] = pv.z; vA[1][1] = pv.w; } }
            PG8_LDA(At, 0, 1); PG8_STAGE(PG8_SB(0, 0), b2, voffB); PG8_STAGE(PG8_SB(0, 1), b2 + hstepB, voffB1); PG8_STAGE(PG8_SA(0, 0), a2, vA[0]);
            PG8_WAIT_V(8); PG8_WAIT_L(0); PG8_BAR; PG8_MMA(1, 0, At, B0); PG8_MMA(1, 1, At, B1); PG8_BAR; PG8_SCHED;
            PG8_LDB(B0, 1, 0); PG8_LDB(B1, 1, 1); PG8_SCHED; PG8_LDA(At, 1, 0); PG8_STAGE(PG8_SA(0, 1), a2 + hstepA, vA[1]);
            PG8_WAIT_V(8); PG8_WAIT_L(0); PG8_BAR; PG8_MMA(0, 0, At, B0); PG8_MMA(0, 1, At, B1); PG8_BAR; PG8_SCHED;
            PG8_LDA(At, 1, 1); PG8_STAGE(PG8_SB(1, 0), b3, voffB); PG8_STAGE(PG8_SB(1, 1), b3 + hstepB, voffB1); PG8_STAGE(PG8_SA(1, 0), a3, vA[0]);
            PG8_WAIT_V(8); PG8_WAIT_L(0); PG8_BAR; PG8_MMA(1, 0, At, B0); PG8_MMA(1, 1, At, B1); PG8_BAR; PG8_SCHED;
        }
        if (wr == 0) PG8_BAR;
        E(acc, cur, wr, wc, fr, fq);
        if (!has_next) break;
#pragma unroll
        for (int a = 0; a < 2; ++a)
#pragma unroll
            for (int b = 0; b < 2; ++b)
#pragma unroll
                for (int m = 0; m < 4; ++m)
#pragma unroll
                    for (int n = 0; n < 2; ++n) acc[a][b][m][n] = (f32x4){0.f, 0.f, 0.f, 0.f};
        cur = nxt; cA = nA; cB = nB; ++ui;
        if (wr == 1) PG8_BAR;
    }
    PG8_WAIT_V(0);
    PG8_BAR;
#undef PG8_SA
#undef PG8_SB
#undef PG8_STAGE
#undef PG8_LDA
#undef PG8_LDB
#undef PG8_MMA
#undef PG8_WAIT_V
#undef PG8_WAIT_L
#undef PG8_BAR
#undef PG8_SCHED
#undef PG8_VOFF
}
}

constexpr size_t MiB = 1u << 20;
constexpr size_t WS_CTL = 0, CTL_ZERO_BYTES = 1 * MiB;
constexpr size_t WS_ATT_IN_T = 1 * MiB;
constexpr size_t WS_ATT_OUT_T = WS_ATT_IN_T + 36 * MiB;
constexpr size_t WS_RET_IN_T = WS_ATT_OUT_T + 4 * MiB;
constexpr size_t WS_RET_OUT_T = WS_RET_IN_T + 12 * MiB;
constexpr size_t WS_GLU_T = WS_RET_OUT_T + 4 * MiB;
constexpr size_t WS_RT_HI = WS_GLU_T + 4 * MiB;
constexpr size_t WS_RT_LO = WS_RT_HI + 512 * 1024;
constexpr size_t WS_WMOE = WS_RT_HI + 1 * MiB;
constexpr size_t WMOE_E_BYTES = (size_t)(512 * 1024 + 1024 * 256) * 2;
constexpr size_t WS_X = WS_WMOE + 98 * MiB;
constexpr size_t WS_Y = WS_X + 64 * MiB;
constexpr size_t WS_XB = WS_Y + 64 * MiB;
constexpr size_t WS_BIG = WS_XB + 32 * MiB;
constexpr size_t WS_AUX = WS_BIG + 288 * MiB;
constexpr size_t WS_H = WS_AUX + 160 * MiB;
constexpr size_t WS_LIST = WS_H + 80 * MiB;
constexpr size_t WS_TRASH = WS_LIST + 8 * MiB;
constexpr size_t WS_END = WS_TRASH + 1 * MiB;
static_assert(WS_END <= 1024 * MiB, "workspace map");
constexpr int CW_BAR = 4096;
constexpr int CW_CNT = 16384;
constexpr int CW_CHK = 65536;
constexpr int HROWS = 163840;

#define XB_TMO      128
#define XB_XCNT(j)  (256  + 64 * (j))
#define XB_XSUB(j)  (1280 + 64 * (j))
#define XB_XGEN(j)  (2304 + 64 * (j))
#define XB_TOP      3328
#define XB_TOPGEN   3392
#define XCD_BAR_WORDS 3456
#define XB_SPIN_CAP (1u << 20)
__device__ __forceinline__ unsigned xb_ld(unsigned* p)              { return __hip_atomic_load(p, __ATOMIC_RELAXED, __HIP_MEMORY_SCOPE_AGENT); }
__device__ __forceinline__ unsigned xb_add(unsigned* p, unsigned v) { return __hip_atomic_fetch_add(p, v, __ATOMIC_RELAXED, __HIP_MEMORY_SCOPE_AGENT); }
__device__ __forceinline__ unsigned xb_xcc_id() { return (unsigned)__builtin_amdgcn_s_getreg((3 << 11) | 20) & 0xFu; }
#define XB_SPIN(cond, bar) do { unsigned _sp = 0; while (cond) { __builtin_amdgcn_s_sleep(1); \
    if ((++_sp & 255u) == 0u) { if (xb_ld(&(bar)[XB_TMO])) break; if (_sp > XB_SPIN_CAP) { atomicAdd(&(bar)[XB_TMO], 1u); break; } } } } while (0)
struct XcdBarrier { unsigned* bar; unsigned x; volatile LAS unsigned* st; };
__device__ __forceinline__ XcdBarrier xcd_barrier_post(unsigned* bar, volatile LAS unsigned* st) {
    XcdBarrier b; b.bar = bar; b.x = xb_xcc_id(); b.st = st;
    if (threadIdx.x == 0) (void)xb_add(&bar[XB_XCNT(b.x)], 1u);
    return b;
}
__device__ __forceinline__ void xcd_barrier_complete(unsigned* bar, unsigned x, unsigned& nloc, unsigned& nx) {
    const unsigned G = gridDim.x * gridDim.y * gridDim.z;
    unsigned sum, cnt, mine, sp = 0u;
    for (;;) {
        sum = 0u; cnt = 0u; mine = 0u;
#pragma unroll
        for (unsigned j = 0; j < 16; ++j) { const unsigned c = xb_ld(&bar[XB_XCNT(j)]); sum += c; cnt += (c > 0u) ? 1u : 0u; mine = (j == x) ? c : mine; }
        if (sum == G) break;
        __builtin_amdgcn_s_sleep(1);
        if ((++sp & 255u) == 0u) { if (xb_ld(&bar[XB_TMO])) break; if (sp > XB_SPIN_CAP) { atomicAdd(&bar[XB_TMO], 1u); break; } }
    }
    nloc = mine > 0u ? mine : 1u; nx = cnt > 0u ? cnt : 1u;
}
__device__ __forceinline__ void xcd_barrier(const XcdBarrier& b) {
    asm volatile("s_waitcnt vmcnt(0)" ::: "memory");
    __syncthreads();
    if (threadIdx.x == 0) {
        unsigned* bar = b.bar;
        __builtin_amdgcn_s_waitcnt(0);
        unsigned nloc = b.st[0], nx = b.st[1];
        if (nloc == 0u) { xcd_barrier_complete(bar, b.x, nloc, nx); b.st[0] = nloc; b.st[1] = nx; }
        const unsigned old = xb_add(&bar[XB_XSUB(b.x)], 1u);
        const unsigned gen = old / nloc;
        if (old + 1u == (gen + 1u) * nloc) {
            __builtin_amdgcn_fence(__ATOMIC_RELEASE, "agent");
            asm volatile("s_waitcnt vmcnt(0)" ::: "memory");
            const unsigned og = xb_add(&bar[XB_TOP], 1u);
            const unsigned tg = og / nx;
            if (og + 1u == (tg + 1u) * nx) xb_add(&bar[XB_TOPGEN], 1u);
            else XB_SPIN(xb_ld(&bar[XB_TOPGEN]) == tg, bar);
            __builtin_amdgcn_fence(__ATOMIC_ACQUIRE, "agent");
            xb_add(&bar[XB_XGEN(b.x)], 1u);
            asm volatile("s_waitcnt vmcnt(0)" ::: "memory");
        } else {
            XB_SPIN(xb_ld(&bar[XB_XGEN(b.x)]) == gen, bar);
            __builtin_amdgcn_fence(__ATOMIC_ACQUIRE, "agent");
            asm volatile("s_waitcnt vmcnt(0)" ::: "memory");
        }
    }
    __syncthreads();
}

constexpr int RING_BYTES = 139264;
constexpr int MISC_OFF = RING_BYTES;
constexpr int LDS_BYTES = 147456;
struct Params {
    const float* in[26]; float* out; unsigned char* ws; int ph_lo, ph_hi; int use_bar, pad;
};
typedef const __attribute__((address_space(4))) Params* KP;
__device__ __forceinline__ const float* gin(KP p, int i) { return (const float*)(const GAS float*)p->in[i]; }
__device__ __forceinline__ float* gout(KP p) { return (float*)(GAS float*)p->out; }
struct Frame {
    LAS unsigned char* lds; volatile LAS unsigned* MISC;
    int tid, lane, wave, vcu, G;
    unsigned char* ws;
};

struct DenseSched {
    static constexpr bool GATHER = false, UNIFORMIZE = false;
    const char* A; const char* Bt; int K, nM, nN, nwg, G, c;
    __device__ __forceinline__ void init(const void* A_, const void* Bt_, int M, int N, int K_, int G_, int c_) { A = (const char*)A_; Bt = (const char*)Bt_; K = K_; nM = M / 256; nN = N / 256; nwg = nM * nN; G = G_; c = c_; }
    __device__ __forceinline__ bool next(int i, pg8::UnitG& u) const {
        const long L = (long)i * G + c; if (L >= nwg) return false;
        int wgid = (int)L; { const int q = nwg / 8, r = nwg % 8, xcd = wgid % 8, off = wgid / 8; wgid = (xcd < r ? xcd * (q + 1) : r * (q + 1) + (xcd - r) * q) + off; }
        const int nig = 8 * nN, gid = wgid / nig, fm = gid * 8, gsz = (nM - fm) < 8 ? (nM - fm) : 8;
        const int pm = fm + ((wgid % nig) % gsz), pn = (wgid % nig) / gsz;
        u.A = A + (size_t)pm * 256 * K * 2; u.B = Bt + (size_t)pn * 256 * K * 2; u.gidx = nullptr; u.gcnt = 0; u.gshift = 0; u.row0 = pm * 256; u.col0 = pn * 256; u.aux = 0; return true;
    }
};
__device__ __forceinline__ u32x4 pack_bf16x8(const f32x4& v0, const f32x4& v1) { u32x4 w; w.x = pk2hw(v0[0], v0[1]); w.y = pk2hw(v0[2], v0[3]); w.z = pk2hw(v1[0], v1[1]); w.w = pk2hw(v1[2], v1[3]); return w; }

struct EpiStoreBf16 {
    static constexpr bool PERM = true, PERM16 = false;
    bf16* O; int ldc;
    __device__ __forceinline__ void operator()(const f32x4 (&acc)[2][2][4][2], const pg8::UnitG& u, int wr, int wc, int fr, int fq) const {
#pragma unroll
        for (int ai = 0; ai < 2; ++ai)
#pragma unroll
            for (int m = 0; m < 4; ++m) { bf16* rowp = O + (size_t)(u.row0 + ai * 128 + wr * 64 + m * 16 + fr) * ldc + u.col0 + wc * 32 + 8 * fq;
#pragma unroll
                for (int bj = 0; bj < 2; ++bj) *(u32x4*)(rowp + bj * 128) = pack_bf16x8(acc[ai][bj][m][0], acc[ai][bj][m][1]); }
    }
};
constexpr float YEXP_SCALE = 32.0f, YEXP_INV = 1.0f / 32.0f;
struct EpiStoreFp8 {
    static constexpr bool PERM = false, PERM16 = true;
    unsigned char* O; int ldc;
    __device__ __forceinline__ void operator()(const f32x4 (&acc)[2][2][4][2], const pg8::UnitG& u, int wr, int wc, int fr, int fq) const {
#pragma unroll
        for (int ai = 0; ai < 2; ++ai)
#pragma unroll
            for (int m = 0; m < 4; ++m) { unsigned char* rowp = O + (size_t)(u.row0 + ai * 128 + wr * 64 + m * 16 + fr) * ldc + u.col0 + wc * 64 + 16 * fq;
                u32x4 w;
#pragma unroll
                for (int q = 0; q < 4; ++q) { f32x4 v = acc[ai][q >> 1][m][q & 1] * YEXP_SCALE;
#pragma unroll
                    for (int j = 0; j < 4; ++j) v[j] = fminf(fmaxf(v[j], -448.0f), 448.0f);
                    int d = 0; d = __builtin_amdgcn_cvt_pk_fp8_f32(v[0], v[1], d, false); d = __builtin_amdgcn_cvt_pk_fp8_f32(v[2], v[3], d, true); w[q] = (unsigned)d; }
                *(u32x4*)rowp = w; }
    }
};
struct EpiRetIn {
    static constexpr bool PERM = true, PERM16 = false;
    bf16* O; int ldc;
    __device__ __forceinline__ void operator()(const f32x4 (&acc)[2][2][4][2], const pg8::UnitG& u, int wr, int wc, int fr, int fq) const {
        float l2g = 0.f;
        if (u.col0 < 2048) { const int h = (u.col0 & 1023) >> 8; const float g = 1.0f - exp2f(-5.0f - (float)h); l2g = log2f(g); if (u.col0 >= 1024) l2g = -l2g; }
#pragma unroll
        for (int ai = 0; ai < 2; ++ai)
#pragma unroll
            for (int m = 0; m < 4; ++m) { const int row = u.row0 + ai * 128 + wr * 64 + m * 16 + fr; const float sc = exp2f(l2g * (float)(row & 127));
                bf16* rowp = O + (size_t)row * ldc + u.col0 + wc * 32 + 8 * fq;
#pragma unroll
                for (int bj = 0; bj < 2; ++bj) *(u32x4*)(rowp + bj * 128) = pack_bf16x8(acc[ai][bj][m][0] * sc, acc[ai][bj][m][1] * sc); }
    }
};
__device__ __forceinline__ void unpack_bf16x8(const u32x4& w, f32x4& a, f32x4& b) { a[0] = bflo(w.x); a[1] = bfhi(w.x); a[2] = bflo(w.y); a[3] = bfhi(w.y); b[0] = bflo(w.z); b[1] = bfhi(w.z); b[2] = bflo(w.w); b[3] = bfhi(w.w); }
struct EpiResid {
    static constexpr bool PERM = true, PERM16 = false;
    const bf16* X; bf16* Y;
    __device__ __forceinline__ void operator()(const f32x4 (&acc)[2][2][4][2], const pg8::UnitG& u, int wr, int wc, int fr, int fq) const {
#pragma unroll
        for (int ai = 0; ai < 2; ++ai)
#pragma unroll
            for (int m = 0; m < 4; ++m) { const size_t off = (size_t)(u.row0 + ai * 128 + wr * 64 + m * 16 + fr) * D + u.col0 + wc * 32 + 8 * fq;
#pragma unroll
                for (int bj = 0; bj < 2; ++bj) { const u32x4 xw = *(const u32x4*)(X + off + bj * 128); f32x4 x0, x1; unpack_bf16x8(xw, x0, x1);
                    *(u32x4*)(Y + off + bj * 128) = pack_bf16x8(x0 * ALPHA + acc[ai][bj][m][0], x1 * ALPHA + acc[ai][bj][m][1]); }
                if (m == 3) asm volatile("" ::: "memory"); }
    }
};
struct EpiGluResid {
    static constexpr bool PERM = true, PERM16 = false;
    const bf16* X; bf16* Y;
    __device__ __forceinline__ void operator()(const f32x4 (&acc)[2][2][4][2], const pg8::UnitG& u, int wr, int wc, int fr, int fq) const {
#pragma unroll
        for (int ai = 0; ai < 2; ++ai)
#pragma unroll
            for (int m = 0; m < 4; ++m) { const size_t off = (size_t)(u.row0 + ai * 128 + wr * 64 + m * 16 + fr) * D + (u.col0 >> 1) + wc * 32 + 8 * fq;
                const u32x4 xw = *(const u32x4*)(X + off); f32x4 x0, x1; unpack_bf16x8(xw, x0, x1); f32x4 o0, o1;
#pragma unroll
                for (int j = 0; j < 4; ++j) { o0[j] = x0[j] * ALPHA + acc[ai][0][m][0][j] / (1.0f + __expf(-acc[ai][1][m][0][j])); o1[j] = x1[j] * ALPHA + acc[ai][0][m][1][j] / (1.0f + __expf(-acc[ai][1][m][1][j])); }
                *(u32x4*)(Y + off) = pack_bf16x8(o0, o1);
                if (m == 3) asm volatile("" ::: "memory"); }
    }
};
struct EpiMoeUp {
    static constexpr bool PERM = true, PERM16 = false;
    bf16* H;
    __device__ __forceinline__ void operator()(const f32x4 (&acc)[2][2][4][2], const pg8::UnitG& u, int wr, int wc, int fr, int fq) const {
#pragma unroll
        for (int ai = 0; ai < 2; ++ai)
#pragma unroll
            for (int m = 0; m < 4; ++m) { bf16* rowp = H + (size_t)(u.row0 + ai * 128 + wr * 64 + m * 16 + fr) * ED + u.col0 + wc * 32 + 8 * fq; f32x4 o[2];
#pragma unroll
                for (int n = 0; n < 2; ++n)
#pragma unroll
                    for (int j = 0; j < 4; ++j) { const float g = acc[ai][0][m][n][j], up = acc[ai][1][m][n][j]; o[n][j] = g / (1.0f + __expf(-g)) * up; }
                *(u32x4*)rowp = pack_bf16x8(o[0], o[1]); }
    }
};

template <bool HILO>
__device__ __forceinline__ void conv_item(const float* W, int ldw, bf16* WT, bf16* WTlo, int ldk, int k0, int n0, int drow0, float scale, LAS float* scr, int lane) {
#pragma unroll 8
    for (int i = 0; i < 32; ++i) { const int kk = 2 * i + (lane >> 5); scr[kk * 33 + (lane & 31)] = W[(size_t)(k0 + kk) * ldw + n0 + (lane & 31)] * scale; }
    LDS_WAIT(); asm volatile("" ::: "memory");
    const int c = lane & 7;
#pragma unroll
    for (int j = 0; j < 4; ++j) { const int n = (lane >> 3) + 8 * j; const LAS float* s = scr + (8 * c) * 33 + n;
        float v[8];
#pragma unroll
        for (int q = 0; q < 8; ++q) v[q] = s[q * 33];
        u32x4 o; o.x = pk2(v[0], v[1]); o.y = pk2(v[2], v[3]); o.z = pk2(v[4], v[5]); o.w = pk2(v[6], v[7]);
        *(u32x4*)(WT + (size_t)(drow0 + n) * ldk + k0 + 8 * c) = o;
        if (HILO) { float r[8];
#pragma unroll
            for (int q = 0; q < 8; ++q) r[q] = v[q] - bf2f(f2bf(v[q]));
            u32x4 o2; o2.x = pk2(r[0], r[1]); o2.y = pk2(r[2], r[3]); o2.z = pk2(r[4], r[5]); o2.w = pk2(r[6], r[7]);
            *(u32x4*)(WTlo + (size_t)(drow0 + n) * ldk + k0 + 8 * c) = o2; } }
    LDS_WAIT(); asm volatile("" ::: "memory");
}
__device__ __forceinline__ void phase_conv_mixers(const Frame& F, KP p) {
    LAS float* scr = (LAS float*)(F.lds + F.wave * 16384);
    const int gw = F.vcu * NWAVES + F.wave, NGW = F.G * NWAVES;
    constexpr int I_AIN = 16 * 288, I_AOUT = 16 * 32, I_RIN = 16 * 192, I_ROUT = 32 * 32, I_GLU = 16 * 64, I_RT = 16 * 2;
    constexpr int NITEMS = 2 * I_AIN + 2 * I_AOUT + I_RIN + I_ROUT + I_GLU + 4 * I_RT;
    unsigned char* ws = F.ws;
    for (int it = gw; it < NITEMS; it += NGW) {
        int r = it;
        if (r < 2 * I_AIN) { const int j = r / I_AIN; r %= I_AIN; const int kb = r / 288, nb = r % 288, n0 = nb * 32;
            conv_item<false>(gin(p, 1) + (size_t)j * D * ATT_IN, ATT_IN, (bf16*)(ws + WS_ATT_IN_T) + (size_t)j * ATT_IN * D, nullptr, D, kb * 64, n0, n0, ((n0 % 3072) < 1024) ? 0.08838834764831845f : 1.0f, scr, F.lane); continue; }
        r -= 2 * I_AIN;
        if (r < 2 * I_AOUT) { const int j = r / I_AOUT; r %= I_AOUT; const int kb = r / 32, nb = r % 32, n0 = nb * 32;
            conv_item<false>(gin(p, 2) + (size_t)j * D * D, D, (bf16*)(ws + WS_ATT_OUT_T) + (size_t)j * D * D, nullptr, D, kb * 64, n0, n0, 1.0f, scr, F.lane); continue; }
        r -= 2 * I_AOUT;
        if (r < I_RIN) { const int kb = r / 192, nb = r % 192, n0 = nb * 32;
            conv_item<false>(gin(p, 3), RET_IN, (bf16*)(ws + WS_RET_IN_T), nullptr, D, kb * 64, n0, n0, (n0 >= 1024 && n0 < 2048) ? 0.0625f : 1.0f, scr, F.lane); continue; }
        r -= I_RIN;
        if (r < I_ROUT) { const int kb = r / 32, nb = r % 32, n0 = nb * 32;
            conv_item<false>(gin(p, 6), D, (bf16*)(ws + WS_RET_OUT_T), nullptr, RET_V, kb * 64, n0, n0, 1.0f, scr, F.lane); continue; }
        r -= I_ROUT;
        if (r < I_GLU) { const int kb = r / 64, nb = r % 64, n0 = nb * 32; const int c = n0 & 1023, drow = (c >> 7) * 256 + (n0 >> 10) * 128 + (c & 127);
            conv_item<false>(gin(p, 15), 2 * D, (bf16*)(ws + WS_GLU_T), nullptr, D, kb * 64, n0, drow, 1.0f, scr, F.lane); continue; }
        r -= I_GLU;
        { const int l = r / I_RT; r %= I_RT; const int kb = r / 2, nb = r % 2, n0 = nb * 32;
            conv_item<true>(gin(p, 16) + (size_t)l * D * NE, NE, (bf16*)(ws + WS_RT_HI) + (size_t)l * NE * D, (bf16*)(ws + WS_RT_LO) + (size_t)l * NE * D, D, kb * 64, n0, n0, 1.0f, scr, F.lane); }
    }
}
__device__ __forceinline__ void phase_conv_moe(const Frame& F, KP p, int l) {
    LAS float* scr = (LAS float*)(F.lds + F.wave * 16384);
    const int gw = F.vcu * NWAVES + F.wave, NGW = F.G * NWAVES;
    for (int it = gw; it < 65 * 384; it += NGW) {
        const int e = it / 384, r = it % 384, which = r >> 7, rr = r & 127;
        bf16* We = (bf16*)(F.ws + WS_WMOE + (size_t)e * WMOE_E_BYTES);
        if (which < 2) { const float* src = (e < 64) ? gin(p, 18 + which) + ((size_t)l * NE + e) * D * ED : gin(p, 21 + which) + (size_t)l * D * ED;
            const int kb = rr >> 3, nb = rr & 7, n0 = nb * 32; const int drow = (n0 >> 7) * 256 + which * 128 + (n0 & 127);
            conv_item<false>(src, ED, We, nullptr, D, kb * 64, n0, drow, 1.0f, scr, F.lane);
        } else { const float* src = (e < 64) ? gin(p, 20) + ((size_t)l * NE + e) * ED * D : gin(p, 23) + (size_t)l * ED * D;
            const int kb = rr >> 5, nb = rr & 31, n0 = nb * 32;
            conv_item<false>(src, D, We + 512 * 1024, nullptr, ED, kb * 64, n0, n0, 1.0f, scr, F.lane); }
    }
}

__device__ __forceinline__ void phase_lnr(const Frame& F, KP p, int layer, bool dry = false) {
    const bf16* Y = (const bf16*)(F.ws + WS_Y); bf16* XB = (bf16*)(F.ws + WS_XB);
    const float* lng = gin(p, 24) + (size_t)(layer * 2) * D; const float* lnb = gin(p, 25) + (size_t)(layer * 2) * D;
    const bf16* rthi = (const bf16*)(F.ws + WS_RT_HI) + (size_t)layer * NE * D; const bf16* rtlo = (const bf16*)(F.ws + WS_RT_LO) + (size_t)layer * NE * D;
    const float* rbias = gin(p, 17) + layer * NE;
    unsigned* cnt = (unsigned*)(F.ws + WS_CTL) + CW_CNT + layer * NE * 64;
    int* lists = (int*)(F.ws + WS_LIST); int* tokmap = (int*)(F.ws + WS_LIST + 4 * MiB); float* tokgate = (float*)(F.ws + WS_LIST + 5 * MiB);
    constexpr int XLD = 1032, MAXT = 8;
    LAS bf16* Xhi = (LAS bf16*)F.lds; LAS bf16* Xlo = Xhi + 16 * XLD;
    LAS float* part = (LAS float*)(F.lds + 2 * 16 * XLD * 2);
    LAS int* ent = (LAS int*)(part + 2 * 16 * 64);
    LAS int* hist = ent + MAXT * 16 * 8 * 2; LAS int* base = hist + 64;
    const int lane = F.lane, w = F.wave, g4 = lane >> 4, l15 = lane & 15;
    if (F.tid < 64) hist[F.tid] = 0;
    f32x4 gv[4], bv[4];
#pragma unroll
    for (int j = 0; j < 2; ++j) { gv[2 * j] = *(const f32x4*)(lng + 8 * lane + 512 * j); gv[2 * j + 1] = *(const f32x4*)(lng + 8 * lane + 512 * j + 4);
        bv[2 * j] = *(const f32x4*)(lnb + 8 * lane + 512 * j); bv[2 * j + 1] = *(const f32x4*)(lnb + 8 * lane + 512 * j + 4); }
    int ntile = 0;
    for (int tile = F.vcu; tile < T / 16 && ntile < MAXT; tile += F.G, ++ntile) {
        const int t0 = tile * 16;
#pragma unroll
        for (int rr = 0; rr < 2; ++rr) {
            const int lr = 2 * w + rr; const size_t row = (size_t)(t0 + lr);
            f32x4 v[4]; float s = 0.f;
#pragma unroll
            for (int j = 0; j < 2; ++j) { const u32x4 yw = *(const u32x4*)(Y + row * D + 8 * lane + 512 * j); unpack_bf16x8(yw, v[2 * j], v[2 * j + 1]); }
#pragma unroll
            for (int j = 0; j < 4; ++j) s += (v[j][0] + v[j][1]) + (v[j][2] + v[j][3]);
            const float mean = wave_sum(s, lane) * (1.f / D); float s2 = 0.f;
#pragma unroll
            for (int j = 0; j < 4; ++j) { v[j] = v[j] - mean; s2 += (v[j][0] * v[j][0] + v[j][1] * v[j][1]) + (v[j][2] * v[j][2] + v[j][3] * v[j][3]); }
            const float rstd = 1.0f / sqrtf(wave_sum(s2, lane) * (1.f / D) + LN_EPS);
#pragma unroll
            for (int j = 0; j < 2; ++j) { const f32x4 o0 = v[2 * j] * rstd * gv[2 * j] + bv[2 * j], o1 = v[2 * j + 1] * rstd * gv[2 * j + 1] + bv[2 * j + 1];
                const u32x4 hi = pack_bf16x8(o0, o1);
                *(u32x4*)(XB + row * D + 8 * lane + 512 * j) = hi;
                f32x4 h0, h1; unpack_bf16x8(hi, h0, h1); const u32x4 lo = pack_bf16x8(o0 - h0, o1 - h1);
                *(LAS u32x4*)(Xhi + lr * XLD + 8 * lane + 512 * j) = hi; *(LAS u32x4*)(Xlo + lr * XLD + 8 * lane + 512 * j) = lo; }
        }
        __syncthreads();
        { const int nt = w & 3, kh = w >> 2; f32x4 acc = (f32x4){0.f, 0.f, 0.f, 0.f};
            const bf16* bh = rthi + (size_t)(16 * nt + l15) * D + 512 * kh + 8 * g4; const bf16* bl = rtlo + (size_t)(16 * nt + l15) * D + 512 * kh + 8 * g4;
#pragma unroll 8
            for (int ks = 0; ks < 16; ++ks) { const int k0 = 512 * kh + 32 * ks;
                const bf16x8 ahi = row_frag(Xhi, XLD, 0, k0, lane), alo = row_frag(Xlo, XLD, 0, k0, lane);
                const bf16x8 bhi = *(const bf16x8*)(bh + 32 * ks), blo = *(const bf16x8*)(bl + 32 * ks);
                acc = MFMA16(ahi, bhi, acc); acc = MFMA16(alo, bhi, acc); acc = MFMA16(ahi, blo, acc); }
#pragma unroll
            for (int i = 0; i < 4; ++i) part[(kh * 16 + 4 * g4 + i) * 64 + 16 * nt + l15] = acc[i];
        }
        __syncthreads();
#pragma unroll
        for (int rr = 0; rr < 2; ++rr) {
            const int lt = ntile * 16 + 2 * w + rr;
            const float lg = part[(2 * w + rr) * 64 + lane] + part[(16 + 2 * w + rr) * 64 + lane];
            float sc = 1.0f / (1.0f + expf(-lg)); sc = (sc == sc) ? sc : 0.5f;
            const float sel = sc + rbias[lane];
            float m1 = sel; m1 = fmaxf(m1, shx(m1, 1, lane)); m1 = fmaxf(m1, shx(m1, 2, lane)); m1 = fmaxf(m1, shx(m1, 4, lane));
            const unsigned long long eq = __ballot(sel == m1);
            const unsigned gm = (unsigned)(eq >> (lane & 56)) & 0xffu;
            const int first = (lane & 56) + __builtin_ctz(gm | 0x100u);
            float m2 = (lane == first) ? -INFINITY : sel; m2 = fmaxf(m2, shx(m2, 1, lane)); m2 = fmaxf(m2, shx(m2, 2, lane)); m2 = fmaxf(m2, shx(m2, 4, lane));
            const float gs = m1 + m2; const int mygrp = lane >> 3; int grank = 0;
#pragma unroll
            for (int gg = 0; gg < 8; ++gg) { const float o = rdl(gs, 8 * gg); grank += (o > gs || (o == gs && gg < mygrp)) ? 1 : 0; }
            const float mv = (grank < 4) ? sel : -INFINITY; int rank = 0;
#pragma unroll
            for (int e2 = 0; e2 < 64; ++e2) { const float o = rdl(mv, e2); rank += (o > mv || (o == mv && e2 < lane)) ? 1 : 0; }
            const bool chosen = rank < TOPK;
            const float wsum = wave_sum(chosen ? sc : 0.f, lane);
            if (chosen) { const int lpos = __hip_atomic_fetch_add(hist + lane, 1, __ATOMIC_RELAXED, __HIP_MEMORY_SCOPE_WORKGROUP);
                ent[(lt * 8 + rank) * 2] = (lane << 16) | lpos; ent[(lt * 8 + rank) * 2 + 1] = __builtin_bit_cast(int, sc / wsum * 2.5f); }
        }
    }
    __syncthreads();
    if (dry) return;
    if (F.tid < 64) { const int hcount = hist[F.tid]; base[F.tid] = hcount ? (int)atomicAdd(cnt + F.tid * 64, (unsigned)hcount) : 0; }
    __syncthreads();
    for (int idx = F.tid; idx < ntile * 16 * 8; idx += NTHREADS) {
        const int ev = ent[idx * 2], gb = ent[idx * 2 + 1]; const int e = ev >> 16, pos = base[e] + (ev & 0xffff);
        const int lt = idx >> 3, rank = idx & 7, tok = (F.vcu + (lt >> 4) * F.G) * 16 + (lt & 15);
        lists[(size_t)e * T + pos] = tok; tokmap[tok * 8 + rank] = (e << 16) | pos; tokgate[tok * 8 + rank] = __builtin_bit_cast(float, gb);
    }
}

__device__ __forceinline__ void phase_combine(const Frame& F, KP p, int layer, bool dry = false) {
    bf16* XB = (bf16*)(F.ws + WS_XB); const unsigned char* yexp = (const unsigned char*)(F.ws + WS_BIG);
    const int* tokmap = (const int*)(F.ws + WS_LIST + 4 * MiB); const float* tokgate = (const float*)(F.ws + WS_LIST + 5 * MiB);
    const volatile LAS int* tstart = (const volatile LAS int*)(F.MISC + 64);
    const float* lng = gin(p, 24) + (size_t)(layer * 2 + 1) * D; const float* lnb = gin(p, 25) + (size_t)(layer * 2 + 1) * D;
    float* outp = gout(p); bf16* xbo = XB; if (dry) { outp = (float*)(F.ws + WS_X); xbo = (bf16*)(F.ws + WS_H); }
    const int lane = F.lane, gw = F.vcu * NWAVES + F.wave, NGW = F.G * NWAVES;
    const int shrow0 = __builtin_amdgcn_readfirstlane((int)tstart[64]) * 256;
    f32x4 gv[4], bv[4];
#pragma unroll
    for (int j = 0; j < 4; ++j) { gv[j] = *(const f32x4*)(lng + 16 * lane + 4 * j); bv[j] = *(const f32x4*)(lnb + 16 * lane + 4 * j); }
    for (int row = gw; row < T; row += NGW) {
        const int mk = tokmap[row * 8 + (lane & 7)]; const float gk = tokgate[row * 8 + (lane & 7)] * YEXP_INV;
        const int rk = (int)tstart[mk >> 16] * 256 + (mk & 0xffff);
        f32x4 v[4];
#pragma unroll
        for (int j = 0; j < 2; ++j) { const u32x4 xw = *(const u32x4*)(XB + (size_t)row * D + 16 * lane + 8 * j); unpack_bf16x8(xw, v[2 * j], v[2 * j + 1]); v[2 * j] = v[2 * j] * ALPHA; v[2 * j + 1] = v[2 * j + 1] * ALPHA; }
#pragma unroll
        for (int k = 0; k < NSLOT; ++k) { const int r = (k < 8) ? __builtin_amdgcn_readlane(rk, k) : shrow0 + row; const float g = (k < 8) ? rdl(gk, k) : YEXP_INV;
            const u32x4 s = *(const u32x4*)(yexp + (size_t)r * D + 16 * lane);
#pragma unroll
            for (int j = 0; j < 4; ++j) { const f32x2 lo = __builtin_amdgcn_cvt_pk_f32_fp8((int)s[j], false), hi = __builtin_amdgcn_cvt_pk_f32_fp8((int)s[j], true);
                v[j][0] += g * lo[0]; v[j][1] += g * lo[1]; v[j][2] += g * hi[0]; v[j][3] += g * hi[1]; } }
        float s = 0.f;
#pragma unroll
        for (int j = 0; j < 4; ++j) s += (v[j][0] + v[j][1]) + (v[j][2] + v[j][3]);
        const float mean = wave_sum(s, lane) * (1.f / D); float s2 = 0.f;
#pragma unroll
        for (int j = 0; j < 4; ++j) { v[j] = v[j] - mean; s2 += (v[j][0] * v[j][0] + v[j][1] * v[j][1]) + (v[j][2] * v[j][2] + v[j][3] * v[j][3]); }
        const float rstd = 1.0f / sqrtf(wave_sum(s2, lane) * (1.f / D) + LN_EPS);
        f32x4 o[4];
#pragma unroll
        for (int j = 0; j < 4; ++j) o[j] = v[j] * rstd * gv[j] + bv[j];
        if (layer == DEPTH - 1 || dry) {
#pragma unroll
            for (int j = 0; j < 4; ++j) *(f32x4*)(outp + (size_t)row * D + 16 * lane + 4 * j) = o[j]; }
        if (layer != DEPTH - 1) { *(u32x4*)(xbo + (size_t)row * D + 16 * lane) = pack_bf16x8(o[0], o[1]); *(u32x4*)(xbo + (size_t)row * D + 16 * lane + 8) = pack_bf16x8(o[2], o[3]); }
    }
}

constexpr size_t AUX_OB = 96 * MiB, AUX_LSE = 128 * MiB;
__device__ __forceinline__ void phase_attn(const Frame& F, int bx) {
    const bf16* qkv = (const bf16*)(F.ws + WS_BIG); bf16* og = (bf16*)(F.ws + WS_AUX); float* lse = (float*)(F.ws + WS_AUX + AUX_LSE);
    constexpr int KLD = 136;
    LAS bf16* Ks = (LAS bf16*)F.lds; LAS bf16* Vs = Ks + 256 * KLD;
    const int lane = F.lane, w = F.wave, g4 = lane >> 4, l15 = lane & 15, qq = l15 >> 2, pp = lane & 3;
    u32x4 kreg[8], vreg[8];
#define ATT_DECODE(L_) const int h = (L_) & 7, sb = (L_) >> 3, g = sb >> 7, rem = sb & 127, b = rem >> 6, rn = rem & 63; \
        const int dsh = 2 * g, d = 1 << dsh, nbs = 6 - dsh, r = rn >> nbs, n = rn & ((1 << nbs) - 1); const size_t rowbase = (size_t)b * SEQ;
#define ATT_ISSUE(L_) do { ATT_DECODE(L_) _Pragma("unroll") for (int it = 0; it < 8; ++it) { const int idx = F.tid + 512 * it, c = idx >> 4, ch = idx & 15; int pos = 128 * (n - 1) + c; pos = pos < 0 ? 0 : pos; \
            const bf16* src = qkv + (rowbase + (size_t)pos * d + r) * ATT_IN + g * 3072 + 1024 + h * 128 + ch * 8; kreg[it] = *(const u32x4*)src; vreg[it] = *(const u32x4*)(src + 1024); } } while (0)
    if (bx < 3072) ATT_ISSUE(bx);
    for (int L = bx; L < 3072; L += F.G) {
        ATT_DECODE(L)
#pragma unroll
        for (int it = 0; it < 8; ++it) { const int idx = F.tid + 512 * it, c = idx >> 4, ch = idx & 15;
            *(LAS u32x4*)(Ks + c * KLD + ch * 8) = kreg[it]; *(LAS u32x4*)(Vs + c * KLD + ch * 8) = vreg[it]; }
        const int qi = 16 * w + l15; const size_t qrow = rowbase + (size_t)(128 * n + qi) * d + r;
        bf16x8 qf[4];
#pragma unroll
        for (int s = 0; s < 4; ++s) qf[s] = *(const bf16x8*)(qkv + qrow * ATT_IN + g * 3072 + h * 128 + 32 * s + 8 * g4);
        __syncthreads();
        if (L + F.G < 3072) { ATT_ISSUE(L + F.G); }
        __builtin_amdgcn_sched_barrier(0);
        const int ws0 = (16 * w < 96) ? 16 * w : 96;
        f32x4 sacc[10];
        {
            bf16x8 kfa[4], kfb[4];
#pragma unroll
            for (int s = 0; s < 4; ++s) kfa[s] = row_frag(Ks, KLD, ws0, 32 * s, lane);
#pragma unroll
            for (int t = 0; t < 10; t += 2) {
#pragma unroll
                for (int s = 0; s < 4; ++s) kfb[s] = row_frag(Ks, KLD, ws0 + 16 * (t + 1), 32 * s, lane);
                __builtin_amdgcn_sched_barrier(0);
                sacc[t] = (f32x4){0.f, 0.f, 0.f, 0.f};
#pragma unroll
                for (int s = 0; s < 4; ++s) sacc[t] = MFMA16(kfa[s], qf[s], sacc[t]);
                if (t + 2 < 10) {
#pragma unroll
                    for (int s = 0; s < 4; ++s) kfa[s] = row_frag(Ks, KLD, ws0 + 16 * (t + 2), 32 * s, lane); }
                __builtin_amdgcn_sched_barrier(0);
                sacc[t + 1] = (f32x4){0.f, 0.f, 0.f, 0.f};
#pragma unroll
                for (int s = 0; s < 4; ++s) sacc[t + 1] = MFMA16(kfb[s], qf[s], sacc[t + 1]);
            }
        }
        const float slope = exp2f(-(float)(h + 1)) * (float)d;
        float mx = -INFINITY;
#pragma unroll
        for (int t = 0; t < 10; ++t)
#pragma unroll
            for (int i = 0; i < 4; ++i) { const int c = ws0 + 16 * t + 4 * g4 + i, step = 128 + qi - c;
                const bool valid = (step >= 0) && (step <= 128) && (n > 0 || c >= 128);
                const float v = valid ? sacc[t][i] - slope * (float)step : -INFINITY; sacc[t][i] = v; mx = fmaxf(mx, v); }
        mx = fmaxf(mx, shx(mx, 16, lane)); mx = fmaxf(mx, shx(mx, 32, lane));
        float lsum = 0.f;
#pragma unroll
        for (int t = 0; t < 10; ++t)
#pragma unroll
            for (int i = 0; i < 4; ++i) { const float pv = __expf(sacc[t][i] - mx); sacc[t][i] = pv; lsum += pv; }
        lsum += shx(lsum, 16, lane); lsum += shx(lsum, 32, lane);
        bf16x8 pf[5];
#pragma unroll
        for (int kt = 0; kt < 5; ++kt) pf[kt] = pack8(sacc[2 * kt], sacc[2 * kt + 1]);
        f32x4 o[8];
        {
            const LAS bf16* vb = Vs + (ws0 + 4 * g4 + qq) * KLD + 32 * pp;
            bf16x4 va[10], vc[10];
#pragma unroll
            for (int kt = 0; kt < 5; ++kt) { va[2 * kt] = tr4(vb + 32 * kt * KLD); va[2 * kt + 1] = tr4(vb + (32 * kt + 16) * KLD); }
#pragma unroll
            for (int et = 0; et < 8; et += 2) {
#pragma unroll
                for (int kt = 0; kt < 5; ++kt) { vc[2 * kt] = tr4(vb + 32 * kt * KLD + 4 * (et + 1)); vc[2 * kt + 1] = tr4(vb + (32 * kt + 16) * KLD + 4 * (et + 1)); }
                __builtin_amdgcn_sched_barrier(0);
                o[et] = (f32x4){0.f, 0.f, 0.f, 0.f};
#pragma unroll
                for (int kt = 0; kt < 5; ++kt) o[et] = MFMA16(cat8(va[2 * kt], va[2 * kt + 1]), pf[kt], o[et]);
                if (et + 2 < 8) {
#pragma unroll
                    for (int kt = 0; kt < 5; ++kt) { va[2 * kt] = tr4(vb + 32 * kt * KLD + 4 * (et + 2)); va[2 * kt + 1] = tr4(vb + (32 * kt + 16) * KLD + 4 * (et + 2)); } }
                __builtin_amdgcn_sched_barrier(0);
                o[et + 1] = (f32x4){0.f, 0.f, 0.f, 0.f};
#pragma unroll
                for (int kt = 0; kt < 5; ++kt) o[et + 1] = MFMA16(cat8(vc[2 * kt], vc[2 * kt + 1]), pf[kt], o[et + 1]);
            }
        }
        const float inv = 1.0f / lsum;
        bf16* orow = og + ((size_t)g * T + qrow) * D + h * 128 + 32 * g4;
#pragma unroll
        for (int e2 = 0; e2 < 4; ++e2) *(u32x4*)(orow + 8 * e2) = pack_bf16x8(o[2 * e2] * inv, o[2 * e2 + 1] * inv);
        if (g4 == 0) lse[((size_t)g * T + qrow) * AH + h] = mx + __logf(lsum);
        __syncthreads();
    }
#undef ATT_DECODE
#undef ATT_ISSUE
}
__device__ __forceinline__ void phase_attn_combine(const Frame& F) {
    const bf16* og = (const bf16*)(F.ws + WS_AUX); const float* lse = (const float*)(F.ws + WS_AUX + AUX_LSE); bf16* ob = (bf16*)(F.ws + WS_AUX + AUX_OB);
    const int lane = F.lane, gw = F.vcu * NWAVES + F.wave, NGW = F.G * NWAVES, h = lane >> 3;
    for (int row = gw; row < T; row += NGW) {
        const float l0 = lse[((size_t)0 * T + row) * AH + h], l1 = lse[((size_t)1 * T + row) * AH + h], l2 = lse[((size_t)2 * T + row) * AH + h];
        const float m = fmaxf(l0, fmaxf(l1, l2)); float w0 = __expf(l0 - m), w1 = __expf(l1 - m), w2 = __expf(l2 - m); const float inv = 1.0f / (w0 + w1 + w2); w0 *= inv; w1 *= inv; w2 *= inv;
        float a[16];
#pragma unroll
        for (int j = 0; j < 16; ++j) a[j] = 0.f;
#pragma unroll
        for (int g = 0; g < 3; ++g) { const float wg = (g == 0) ? w0 : (g == 1 ? w1 : w2);
#pragma unroll
            for (int q = 0; q < 2; ++q) { const u32x4 s = *(const u32x4*)(og + ((size_t)g * T + row) * D + 16 * lane + 8 * q);
                a[8 * q + 0] += wg * bflo(s.x); a[8 * q + 1] += wg * bfhi(s.x); a[8 * q + 2] += wg * bflo(s.y); a[8 * q + 3] += wg * bfhi(s.y);
                a[8 * q + 4] += wg * bflo(s.z); a[8 * q + 5] += wg * bfhi(s.z); a[8 * q + 6] += wg * bflo(s.w); a[8 * q + 7] += wg * bfhi(s.w); } }
#pragma unroll
        for (int q = 0; q < 2; ++q) { u32x4 o; o.x = pk2(a[8 * q], a[8 * q + 1]); o.y = pk2(a[8 * q + 2], a[8 * q + 3]); o.z = pk2(a[8 * q + 4], a[8 * q + 5]); o.w = pk2(a[8 * q + 6], a[8 * q + 7]);
            *(u32x4*)(ob + (size_t)row * D + 16 * lane + 8 * q) = o; }
    }
}

constexpr size_t BIG_YRET = 192 * MiB;
__device__ __forceinline__ void phase_ret_u(const Frame& F) {
    const bf16* proj = (const bf16*)(F.ws + WS_BIG); bf16* St = (bf16*)(F.ws + WS_AUX);
    constexpr int LD = 264;
    LAS bf16* Kt = (LAS bf16*)F.lds; LAS bf16* Vt = Kt + 128 * LD;
    const int lane = F.lane, w = F.wave, g4 = lane >> 4, l15 = lane & 15, qq = l15 >> 2, pp = lane & 3;
    for (int u = F.vcu; u < 1024; u += F.G) {
        const int eh = u & 1, h = (u >> 1) & 3, n = (u >> 3) & 63, b = u >> 9;
        const size_t row0 = (size_t)b * SEQ + (size_t)n * RC;
#pragma unroll 4
        for (int it = 0; it < 8; ++it) { const int idx = F.tid + 512 * it, j = idx >> 5, ch = idx & 31;
            const bf16* src = proj + (row0 + j) * RET_IN;
            const u32x4 kv = *(const u32x4*)(src + 1024 + h * 256 + ch * 8), vv = *(const u32x4*)(src + 2048 + h * 512 + eh * 256 + ch * 8);
            *(LAS u32x4*)(Kt + j * LD + ch * 8) = kv; *(LAS u32x4*)(Vt + j * LD + ch * 8) = vv; }
        __syncthreads();
        f32x4 acc[16][2];
#pragma unroll
        for (int mt = 0; mt < 16; ++mt) { acc[mt][0] = (f32x4){0.f, 0.f, 0.f, 0.f}; acc[mt][1] = (f32x4){0.f, 0.f, 0.f, 0.f}; }
#pragma unroll
        for (int ks = 0; ks < 4; ++ks) {
            bf16x8 bfr[2];
#pragma unroll
            for (int nt = 0; nt < 2; ++nt) { const LAS bf16* a0 = Vt + (32 * ks + 8 * g4 + qq) * LD + 32 * w + 16 * nt + 4 * pp; bfr[nt] = cat8(tr4(a0), tr4(a0 + 4 * LD)); }
#pragma unroll
            for (int mt = 0; mt < 16; ++mt) { const LAS bf16* a0 = Kt + (32 * ks + 8 * g4 + qq) * LD + 128 * (mt >> 3) + 32 * pp + 4 * (mt & 7);
                const bf16x8 afr = cat8(tr4(a0), tr4(a0 + 4 * LD));
                acc[mt][0] = MFMA16(afr, bfr[0], acc[mt][0]); acc[mt][1] = MFMA16(afr, bfr[1], acc[mt][1]); }
        }
        bf16* outb = St + ((size_t)((b * RH + h) * RNC + n)) * (RDV * RDK);
#pragma unroll
        for (int nt = 0; nt < 2; ++nt) { bf16* orow = outb + (size_t)(eh * 256 + 32 * w + 16 * nt + l15) * RDK + 32 * g4;
#pragma unroll
            for (int mh = 0; mh < 2; ++mh)
#pragma unroll
                for (int q = 0; q < 4; ++q) *(u32x4*)(orow + 128 * mh + 8 * q) = pack_bf16x8(acc[mh * 8 + 2 * q][nt], acc[mh * 8 + 2 * q + 1][nt]); }
        __syncthreads();
    }
}
__device__ __forceinline__ void phase_ret_scan(const Frame& F) {
    bf16* St = (bf16*)(F.ws + WS_AUX);
    for (int gt = F.vcu * NTHREADS + F.tid; gt < 8 * 16384; gt += F.G * NTHREADS) {
        const int bh = gt >> 14, chunk = gt & 16383, h = bh & 3;
        const float g128 = exp2f(128.0f * log2f(1.0f - exp2f(-5.0f - (float)h)));
        bf16* base = St + (size_t)bh * RNC * (RDV * RDK) + (size_t)chunk * 8;
        float c[8];
#pragma unroll
        for (int j = 0; j < 8; ++j) c[j] = 0.f;
#pragma unroll 8
        for (int n = 0; n < RNC; ++n) { bf16* pn = base + (size_t)n * (RDV * RDK); const u32x4 uv = *(const u32x4*)pn;
            u32x4 o; o.x = pk2(c[0], c[1]); o.y = pk2(c[2], c[3]); o.z = pk2(c[4], c[5]); o.w = pk2(c[6], c[7]); *(u32x4*)pn = o;
            c[0] = g128 * (c[0] + bflo(uv.x)); c[1] = g128 * (c[1] + bfhi(uv.x)); c[2] = g128 * (c[2] + bflo(uv.y)); c[3] = g128 * (c[3] + bfhi(uv.y));
            c[4] = g128 * (c[4] + bflo(uv.z)); c[5] = g128 * (c[5] + bfhi(uv.z)); c[6] = g128 * (c[6] + bflo(uv.w)); c[7] = g128 * (c[7] + bfhi(uv.w)); }
    }
}
__device__ __forceinline__ void phase_ret_out(const Frame& F, KP p) {
    const bf16* proj = (const bf16*)(F.ws + WS_BIG); const bf16* St = (const bf16*)(F.ws + WS_AUX); bf16* yret = (bf16*)(F.ws + WS_BIG + BIG_YRET);
    const float* gng = gin(p, 4); const float* gnb = gin(p, 5);
    constexpr int LD = 264, VLD = 136;
    LAS bf16* Rs = (LAS bf16*)F.lds; LAS bf16* Vs = Rs + 128 * LD;
    const int lane = F.lane, w = F.wave, g4 = lane >> 4, l15 = lane & 15, qq = l15 >> 2, pp = lane & 3;
    for (int u = F.vcu; u < 512; u += F.G) {
        const int h = u & 3, n = (u >> 2) & 63, b = u >> 8;
        const size_t row0 = (size_t)b * SEQ + (size_t)n * RC;
#pragma unroll 4
        for (int it = 0; it < 8; ++it) { const int idx = F.tid + 512 * it, j = idx >> 5, ch = idx & 31;
            *(LAS u32x4*)(Rs + j * LD + ch * 8) = *(const u32x4*)(proj + (row0 + j) * RET_IN + 1024 + h * 256 + ch * 8); }
        const int irow = 16 * w + l15; const size_t qrow = row0 + irow;
        bf16x8 qf[8];
#pragma unroll
        for (int s = 0; s < 8; ++s) qf[s] = *(const bf16x8*)(proj + qrow * RET_IN + h * 256 + 32 * s + 8 * g4);
        __syncthreads();
        bf16x8 pf[4];
        { f32x4 sacc[8];
#pragma unroll
            for (int jt = 0; jt < 8; ++jt) { sacc[jt] = (f32x4){0.f, 0.f, 0.f, 0.f};
                if (jt <= w) {
#pragma unroll
                    for (int s = 0; s < 8; ++s) sacc[jt] = MFMA16(row_frag(Rs, LD, 16 * jt, 32 * s, lane), qf[s], sacc[jt]);
#pragma unroll
                    for (int i = 0; i < 4; ++i) if (16 * jt + 4 * g4 + i > irow) sacc[jt][i] = 0.f; } }
#pragma unroll
            for (int kt = 0; kt < 4; ++kt) pf[kt] = pack8(sacc[2 * kt], sacc[2 * kt + 1]); }
        __syncthreads();
        f32x4 acc[4][8];
        const bf16* Sn = St + ((size_t)((b * RH + h) * RNC + n)) * (RDV * RDK);
#pragma unroll
        for (int sl = 0; sl < 4; ++sl) {
#pragma unroll 4
            for (int it = 0; it < 4; ++it) { const int idx = F.tid + 512 * it, j = idx >> 4, ch = idx & 15;
                *(LAS u32x4*)(Vs + j * VLD + ch * 8) = *(const u32x4*)(proj + (row0 + j) * RET_IN + 2048 + h * 512 + sl * 128 + ch * 8); }
#pragma unroll 4
            for (int it = 0; it < 8; ++it) { const int idx = F.tid + 512 * it, e = idx >> 5, ch = idx & 31;
                *(LAS u32x4*)(Rs + e * LD + ch * 8) = *(const u32x4*)(Sn + (size_t)(sl * 128 + e) * RDK + ch * 8); }
            __syncthreads();
#pragma unroll
            for (int et = 0; et < 8; ++et) { f32x4 a = (f32x4){0.f, 0.f, 0.f, 0.f};
#pragma unroll
                for (int kt = 0; kt < 4; ++kt) if (2 * kt <= w) { const LAS bf16* a0 = Vs + (32 * kt + 4 * g4 + qq) * VLD + 32 * pp + 4 * et;
                    a = MFMA16(cat8(tr4(a0), tr4(a0 + 16 * VLD)), pf[kt], a); }
                const LAS bf16* srow = Rs + (32 * qq + 4 * et + pp) * LD + 8 * g4;
#pragma unroll
                for (int s = 0; s < 8; ++s) a = MFMA16(*(const LAS bf16x8*)(srow + 32 * s), qf[s], a);
                acc[sl][et] = a; }
            __syncthreads();
        }
        float s = 0.f;
#pragma unroll
        for (int sl = 0; sl < 4; ++sl)
#pragma unroll
            for (int et = 0; et < 8; ++et) s += (acc[sl][et][0] + acc[sl][et][1]) + (acc[sl][et][2] + acc[sl][et][3]);
        s += shx(s, 16, lane); s += shx(s, 32, lane);
        const float mean = s * (1.0f / RDV); float s2 = 0.f;
#pragma unroll
        for (int sl = 0; sl < 4; ++sl)
#pragma unroll
            for (int et = 0; et < 8; ++et) { acc[sl][et] = acc[sl][et] - mean; s2 += (acc[sl][et][0] * acc[sl][et][0] + acc[sl][et][1] * acc[sl][et][1]) + (acc[sl][et][2] * acc[sl][et][2] + acc[sl][et][3] * acc[sl][et][3]); }
        s2 += shx(s2, 16, lane); s2 += shx(s2, 32, lane);
        const float rstd = 1.0f / sqrtf(s2 * (1.0f / RDV) + LN_EPS);
#pragma unroll
        for (int sl = 0; sl < 4; ++sl) { const int c0 = h * RDV + sl * 128 + 32 * g4;
#pragma unroll
            for (int q = 0; q < 4; ++q) { const u32x4 gw = *(const u32x4*)(proj + qrow * RET_IN + 4096 + c0 + 8 * q);
                const f32x4 gg0 = *(const f32x4*)(gng + c0 + 8 * q), gg1 = *(const f32x4*)(gng + c0 + 8 * q + 4), gb0 = *(const f32x4*)(gnb + c0 + 8 * q), gb1 = *(const f32x4*)(gnb + c0 + 8 * q + 4);
                f32x4 y0 = acc[sl][2 * q] * rstd * gg0 + gb0, y1 = acc[sl][2 * q + 1] * rstd * gg1 + gb1;
                const float gv[8] = {bflo(gw.x), bfhi(gw.x), bflo(gw.y), bfhi(gw.y), bflo(gw.z), bfhi(gw.z), bflo(gw.w), bfhi(gw.w)};
#pragma unroll
                for (int j = 0; j < 4; ++j) { y0[j] *= gv[j] / (1.0f + __expf(-gv[j])); y1[j] *= gv[4 + j] / (1.0f + __expf(-gv[4 + j])); }
                *(u32x4*)(yret + qrow * RET_V + c0 + 8 * q) = pack_bf16x8(y0, y1); } }
    }
}

constexpr size_t AUX_S5E = 64 * MiB;
constexpr int S5L = 256, S5NC = SEQ / S5L;
__device__ __forceinline__ void cmul_add(float& rr, float& ri, float ar, float ai, float xr, float xi, float cr, float ci) { rr = ar * xr - ai * xi + cr; ri = ar * xi + ai * xr + ci; }
template <bool OUT>
__device__ __forceinline__ void phase_s5_scan(const Frame& F, KP p) {
    const bf16* X = (const bf16*)(F.ws + WS_XB); float* E = (float*)(F.ws + WS_AUX + AUX_S5E); bf16* ybuf = (bf16*)(F.ws + WS_AUX);
    const int lane = F.lane, w = F.wave, g4 = lane >> 4, l15 = lane & 15;
    LAS bf16* ut = (LAS bf16*)(F.lds + w * 12288);
    LAS bf16* Hb = (LAS bf16*)(F.lds + w * 12288 + 4096);
    constexpr int HLD = 136;
    const int gw = F.vcu * NWAVES + w, NGW = F.G * NWAVES;
    const int up16 = (lane - 16) << 2, up32 = (lane - 32) << 2, last16 = (48 + l15) << 2;
    for (int unit = gw; unit < BATCH * SG * S5NC; unit += NGW) {
        const int n = unit & (S5NC - 1), g = (unit >> 5) & 63, b = unit >> 11;
        float a1r[4], a1i[4], a4r[4], a4i[4], a8r[4], a8i[4], pwr[4], pwi[4];
        bf16x8 bfrag[8];
        const float dt = expf(gin(p, 14)[g]);
#pragma unroll
        for (int st = 0; st < 4; ++st) { const int ps = 16 * st + l15;
            const float are = gin(p, 7)[g * SP + ps], aim = gin(p, 8)[g * SP + ps];
            const float mag = expf(dt * are); const float abr = mag * cosf(dt * aim), abi = mag * sinf(dt * aim);
            const float den = are * are + aim * aim;
            const float fre = ((abr - 1.0f) * are + abi * aim) / den, fim = (abi * are - (abr - 1.0f) * aim) / den;
            a1r[st] = abr; a1i[st] = abi; { float t2r, t2i; cmul_add(t2r, t2i, abr, abi, abr, abi, 0.f, 0.f); cmul_add(a4r[st], a4i[st], t2r, t2i, t2r, t2i, 0.f, 0.f); }
            cmul_add(a8r[st], a8i[st], a4r[st], a4i[st], a4r[st], a4i[st], 0.f, 0.f);
            float qr = 1.f, qi = 0.f;
            if (g4 & 1) { qr = a4r[st]; qi = a4i[st]; }
            if (g4 & 2) { float tr, ti; cmul_add(tr, ti, qr, qi, a8r[st], a8i[st], 0.f, 0.f); qr = tr; qi = ti; }
            pwr[st] = qr; pwi[st] = qi;
            const float* br = gin(p, 9) + ((size_t)g * SP + ps) * SGC + 8 * (g4 & 1); const float* bi = gin(p, 10) + ((size_t)g * SP + ps) * SGC + 8 * (g4 & 1);
            const f32x4 r0 = *(const f32x4*)br, r1 = *(const f32x4*)(br + 4), i0 = *(const f32x4*)bi, i1 = *(const f32x4*)(bi + 4);
            const float z = (g4 < 2) ? 1.0f : 0.0f; const float fr2 = fre * z, fi2 = fim * z;
            bfrag[st] = pack8(r0 * fr2 - i0 * fi2, r1 * fr2 - i1 * fi2); bfrag[st + 4] = pack8(i0 * fr2 + r0 * fi2, i1 * fr2 + r1 * fi2);
        }
        float sr[4], si[4];
        float* Eu = E + ((size_t)(b * SG + g) * S5NC + n) * 128;
        bf16x8 cf[4]; f32x4 dsk = (f32x4){0.f, 0.f, 0.f, 0.f};
#pragma unroll
        for (int st = 0; st < 4; ++st) { sr[st] = 0.f; si[st] = 0.f; }
        if (OUT) {
#pragma unroll
            for (int st = 0; st < 4; ++st) { sr[st] = Eu[16 * st + l15]; si[st] = Eu[64 + 16 * st + l15]; }
#pragma unroll
            for (int s = 0; s < 4; ++s) { const float* cp = (s < 2 ? gin(p, 11) : gin(p, 12)) + ((size_t)g * SGC + l15) * SP + 32 * (s & 1) + 8 * g4; const float sg = s < 2 ? 1.0f : -1.0f;
                const f32x4 c0 = *(const f32x4*)cp * sg, c1 = *(const f32x4*)(cp + 4) * sg; cf[s] = pack8(c0, c1); }
            dsk = *(const f32x4*)(gin(p, 13) + g * SGC + 4 * g4); }
        const size_t tok0 = (size_t)b * SEQ + (size_t)n * S5L;
        u32x4 pre[2];
        { const bf16* src = X + (tok0 + lane) * D + g * SGC; pre[0] = *(const u32x4*)src; pre[1] = *(const u32x4*)(src + 8); }
        for (int sub = 0; sub < S5L / 64; ++sub) {
            *(LAS u32x4*)(ut + lane * 16) = pre[0]; *(LAS u32x4*)(ut + lane * 16 + 8) = pre[1];
            if (sub + 1 < S5L / 64) { const bf16* src = X + (tok0 + (sub + 1) * 64 + lane) * D + g * SGC; pre[0] = *(const u32x4*)src; pre[1] = *(const u32x4*)(src + 8); }
            LDS_WAIT(); asm volatile("" ::: "memory");
#pragma unroll 1
            for (int blk = 0; blk < 4; ++blk) {
                u32x4 uw = *(const LAS u32x4*)(ut + (blk * 16 + l15) * 16 + 8 * (g4 & 1));
                if (g4 >= 2) uw = (u32x4){0u, 0u, 0u, 0u};
                const bf16x8 ufr = __builtin_bit_cast(bf16x8, uw);
                f32x4 dr[4], di[4];
#pragma unroll
                for (int st = 0; st < 4; ++st) { dr[st] = MFMA16(ufr, bfrag[st], ((f32x4){0.f, 0.f, 0.f, 0.f})); di[st] = MFMA16(ufr, bfrag[st + 4], ((f32x4){0.f, 0.f, 0.f, 0.f})); }
                float vr[4], vi[4];
#pragma unroll
                for (int st = 0; st < 4; ++st) {
                    float hr = 0.f, hi = 0.f;
#pragma unroll
                    for (int i = 0; i < 4; ++i) { float nr, ni; cmul_add(nr, ni, a1r[st], a1i[st], hr, hi, dr[st][i], di[st][i]); hr = nr; hi = ni; dr[st][i] = hr; di[st][i] = hi; }
                    vr[st] = hr; vi[st] = hi; }
#define BPF(idx, v) __builtin_bit_cast(float, __builtin_amdgcn_ds_bpermute((idx), __builtin_bit_cast(int, (v))))
                { float xr[4], xi[4];
#pragma unroll
                  for (int st = 0; st < 4; ++st) { xr[st] = BPF(up16, vr[st]); xi[st] = BPF(up16, vi[st]); }
#pragma unroll
                  for (int st = 0; st < 4; ++st) { float tr, ti; cmul_add(tr, ti, a4r[st], a4i[st], xr[st], xi[st], vr[st], vi[st]); if (g4 >= 1) { vr[st] = tr; vi[st] = ti; } }
#pragma unroll
                  for (int st = 0; st < 4; ++st) { xr[st] = BPF(up32, vr[st]); xi[st] = BPF(up32, vi[st]); }
#pragma unroll
                  for (int st = 0; st < 4; ++st) { float tr, ti; cmul_add(tr, ti, a8r[st], a8i[st], xr[st], xi[st], vr[st], vi[st]); if (g4 >= 2) { vr[st] = tr; vi[st] = ti; } } }
                float er[4], ei[4], lr[4], li[4];
#pragma unroll
                for (int st = 0; st < 4; ++st) { er[st] = BPF(up16, vr[st]); ei[st] = BPF(up16, vi[st]); lr[st] = BPF(last16, vr[st]); li[st] = BPF(last16, vi[st]); }
#undef BPF
#pragma unroll
                for (int st = 0; st < 4; ++st) {
                    if (g4 == 0) { er[st] = 0.f; ei[st] = 0.f; }
                    float s0r, s0i; cmul_add(s0r, s0i, pwr[st], pwi[st], sr[st], si[st], er[st], ei[st]);
#pragma unroll
                    for (int i = 0; i < 4; ++i) { float tr, ti; cmul_add(tr, ti, a1r[st], a1i[st], s0r, s0i, 0.f, 0.f); s0r = tr; s0i = ti; dr[st][i] += s0r; di[st][i] += s0i; }
                    { float a16r, a16i; cmul_add(a16r, a16i, a8r[st], a8i[st], a8r[st], a8i[st], 0.f, 0.f); float tr, ti; cmul_add(tr, ti, a16r, a16i, sr[st], si[st], lr[st], li[st]); sr[st] = tr; si[st] = ti; }
                    if (OUT) {
#pragma unroll
                        for (int i = 0; i < 4; ++i) { const unsigned hw = pk2(dr[st][i], di[st][i]); Hb[(4 * g4 + i) * HLD + 16 * st + l15] = (bf16)hw; Hb[(4 * g4 + i) * HLD + 64 + 16 * st + l15] = (bf16)(hw >> 16); } }
                }
                if (OUT) {
                    LDS_WAIT(); asm volatile("" ::: "memory");
                    f32x4 ya = (f32x4){0.f, 0.f, 0.f, 0.f};
#pragma unroll
                    for (int s = 0; s < 4; ++s) ya = MFMA16(cf[s], row_frag(Hb, HLD, 0, 32 * s, lane), ya);
                    const u32x2 u2 = *(const LAS u32x2*)(ut + (blk * 16 + l15) * 16 + 4 * g4);
                    const f32x4 u4 = (f32x4){bflo(u2.x), bfhi(u2.x), bflo(u2.y), bfhi(u2.y)};
                    f32x4 y = ya + dsk * u4;
#pragma unroll
                    for (int j = 0; j < 4; ++j) { const float v = y[j]; y[j] = v / (1.0f + __expf(-1.5957691216057308f * (v + 0.044715f * v * v * v))); }
                    u32x2 o; o.x = pk2(y[0], y[1]); o.y = pk2(y[2], y[3]);
                    *(u32x2*)(ybuf + (tok0 + sub * 64 + blk * 16 + l15) * D + g * SGC + 4 * g4) = o;
                    asm volatile("" ::: "memory"); }
            }
            LDS_WAIT(); asm volatile("" ::: "memory");
        }
        if (!OUT && g4 == 0) {
#pragma unroll
            for (int st = 0; st < 4; ++st) { Eu[16 * st + l15] = sr[st]; Eu[64 + 16 * st + l15] = si[st]; } }
    }
}
__device__ __forceinline__ void phase_s5_carry(const Frame& F, KP p) {
    float* E = (float*)(F.ws + WS_AUX + AUX_S5E);
    for (int gt = F.vcu * NTHREADS + F.tid; gt < BATCH * SG * SP; gt += F.G * NTHREADS) {
        const int pl = gt & 63, bg = gt >> 6, g = bg & 63;
        const float dt = expf(gin(p, 14)[g]); const float are = gin(p, 7)[g * SP + pl], aim = gin(p, 8)[g * SP + pl];
        const float mag = expf(dt * are); float ar = mag * cosf(dt * aim), ai = mag * sinf(dt * aim);
#pragma unroll
        for (int q = 0; q < 8; ++q) { const float nr = ar * ar - ai * ai, ni = 2.0f * ar * ai; ar = nr; ai = ni; }
        float cr = 0.f, ci = 0.f;
        for (int n = 0; n < S5NC; ++n) { float* Eu = E + ((size_t)bg * S5NC + n) * 128; const float er = Eu[pl], ei = Eu[64 + pl];
            Eu[pl] = cr; Eu[64 + pl] = ci;
            const float nr = ar * cr - ai * ci + er, ni = ar * ci + ai * cr + ei; cr = nr; ci = ni; }
    }
}

constexpr int NPHASES = 34;
#ifndef PROBE_DRY14
#define PROBE_DRY14 0
#endif
#ifndef PROBE_DRY17
#define PROBE_DRY17 0
#endif
#ifndef PH_MASK
#define PH_MASK 0xFFFFFFFFu
#endif
#define PHT(t) ((PH_MASK >> (t)) & 1u)
constexpr int PLAN_OFF = 64;
__device__ __forceinline__ void moe_plan(const Frame& F, int layer) {
    volatile LAS int* tstart = (volatile LAS int*)(F.MISC + PLAN_OFF); volatile LAS int* cnts = tstart + 72;
    __syncthreads();
    if (F.wave == 0) {
        const unsigned* cnt = (const unsigned*)(F.ws + WS_CTL) + CW_CNT + layer * NE * 64;
        const int c = (int)__hip_atomic_load(cnt + F.lane * 64, __ATOMIC_RELAXED, __HIP_MEMORY_SCOPE_AGENT);
        int v = (c + 255) >> 8;
#pragma unroll
        for (int o = 1; o < 64; o <<= 1) { const int nb = __builtin_amdgcn_ds_bpermute((F.lane - o) << 2, v); if (F.lane >= o) v += nb; }
        tstart[F.lane + 1] = v; cnts[F.lane] = c;
        if (F.lane == 0) tstart[0] = 0;
        if (F.lane == 63) { tstart[65] = v + T / 256; cnts[64] = T; }
    }
    __syncthreads();
}
template <bool GATH> struct MoeSched2 {
    static constexpr bool GATHER = GATH, UNIFORMIZE = true;
    static constexpr int ncol = GATH ? 2 : 4, K = GATH ? D : ED;
    const volatile LAS int* tstart; const volatile LAS int* cnts; int ntiles, G, c, lane;
    const char* Abase; const char* Wbase; const int* lists;
    __device__ __forceinline__ bool next(int i, pg8::UnitG& u) const {
        const int nwg = ntiles * ncol; const long L = (long)i * G + c; if (L >= nwg) return false;
        int wgid = (int)L; { const int q = nwg / 8, r = nwg % 8, xcd = wgid % 8, off = wgid / 8; wgid = (xcd < r ? xcd * (q + 1) : r * (q + 1) + (xcd - r) * q) + off; }
        const int tile = wgid / ncol, pn = wgid % ncol;
        const int ta = tstart[lane], tb = tstart[lane + 1];
        const unsigned long long mm = __ballot(ta <= tile && tile < tb);
        const int e = mm ? (int)__builtin_ctzll(mm) : 64;
        const int ts = __builtin_amdgcn_readfirstlane((int)tstart[e]), ce = __builtin_amdgcn_readfirstlane((int)cnts[e]);
        const int lt = tile - ts; int valid = ce - lt * 256; valid = valid > 256 ? 256 : valid;
        u.gshift = 0; u.aux = e;
        if (GATH) {
            u.B = Wbase + (size_t)e * WMOE_E_BYTES + (size_t)pn * 256 * K * 2;
            if (e < 64) { u.A = Abase; u.gidx = lists + (size_t)e * T + lt * 256; u.gcnt = valid; }
            else { u.A = Abase + (size_t)lt * 256 * K * 2; u.gidx = nullptr; u.gcnt = 0; }
            u.row0 = tile * 256; u.col0 = pn * 128;
        } else {
            u.B = Wbase + (size_t)e * WMOE_E_BYTES + (size_t)512 * 1024 * 2 + (size_t)pn * 256 * K * 2;
            u.A = Abase + (size_t)tile * 256 * K * 2; u.gidx = nullptr; u.gcnt = valid;
            u.row0 = tile * 256; u.col0 = pn * 256;
        }
        return true;
    }
};
__device__ __forceinline__ void phase_load_x(const Frame& F, KP p) {
    const float* xin = gin(p, 0); bf16* XB = (bf16*)(F.ws + WS_XB);
    for (size_t i = (size_t)F.vcu * NTHREADS + F.tid; i < (size_t)T * D / 8; i += (size_t)F.G * NTHREADS) {
        const f32x4 a = *(const f32x4*)(xin + i * 8), b = *(const f32x4*)(xin + i * 8 + 4);
        *(u32x4*)(XB + i * 8) = pack_bf16x8(a, b); }
}

__global__ void __launch_bounds__(NTHREADS, 2) fwd_kernel(Params p_unused) {
    KP p0 = (KP)__builtin_amdgcn_kernarg_segment_ptr();
    extern __shared__ __attribute__((aligned(16))) unsigned char lds_raw[];
    Frame F0;
    F0.lds = (LAS unsigned char*)lds_raw; F0.MISC = (volatile LAS unsigned*)(F0.lds + MISC_OFF);
    F0.tid = threadIdx.x; F0.lane = F0.tid & 63; F0.wave = __builtin_amdgcn_readfirstlane(F0.tid >> 6);
    F0.G = gridDim.x; { const int bq = blockIdx.x; F0.vcu = (F0.G % 8 == 0) ? (bq % 8) * (F0.G / 8) + bq / 8 : bq; }
    F0.ws = p0->ws;
    const int bx0 = blockIdx.x;
    for (int u = F0.tid; u < (LDS_BYTES - MISC_OFF) / 4; u += NTHREADS) ((LAS unsigned*)(F0.lds + MISC_OFF))[u] = 0u;
    __syncthreads();
    XcdBarrier bar; bar.bar = (unsigned*)(p0->ws + WS_CTL) + CW_BAR; bar.x = 0; bar.st = nullptr;
    const int use_bar = p0->use_bar;
    if (use_bar) bar = xcd_barrier_post((unsigned*)(p0->ws + WS_CTL) + CW_BAR, F0.MISC + 8);
    const int lo = p0->ph_lo, hi = p0->ph_hi;
#define PHASE_BEGIN Frame F = F0; KP p = p0; asm volatile("" : "+v"(F.tid), "+v"(F.lane)); GAS unsigned char* wsg_ = (GAS unsigned char*)F0.ws; asm volatile("" : "+s"(F.wave), "+s"(F.vcu), "+s"(F.G), "+s"(wsg_), "+s"(p)); \
    F.ws = (unsigned char*)wsg_; int bx = bx0; asm volatile("" : "+s"(bx)); unsigned char* ws = F.ws; (void)ws; (void)bx;
#pragma unroll 1
    for (int ph = lo; ph < hi; ++ph) {
        int layer = 0, type = 0;
        if (ph > 0) { layer = ph >= 26 ? 3 : (ph >= 18 ? 2 : (ph >= 9 ? 1 : 0)); const int q = ph - (layer == 3 ? 26 : (layer == 2 ? 18 : (layer == 1 ? 9 : 1))); const int kind = layer % 3;
            if (kind == 0) type = q < 4 ? 1 + q : 14 + (q - 4); else if (kind == 1) type = q < 5 ? 5 + q : 14 + (q - 5); else type = q < 4 ? 10 + q : 14 + (q - 4); }
        const int j = layer / 3;
#ifdef REPEAT_MASK
        const int nrep = ((REPEAT_MASK >> type) & 1u) ? 2 : 1;
#else
        const int nrep = 1;
#endif
#pragma unroll 1
        for (int rep = 0; rep < nrep; ++rep) {
        if (rep > 0 && use_bar) xcd_barrier(bar);
        if (PHT(0) && type == 0) { PHASE_BEGIN; phase_conv_mixers(F, p); phase_conv_moe(F, p, 0); phase_load_x(F, p); }
        else if (PHT(1) && type == 1) { PHASE_BEGIN; DenseSched S; S.init(ws + WS_XB, ws + WS_ATT_IN_T + (size_t)j * ATT_IN * D * 2, T, ATT_IN, D, F.G, bx); EpiStoreBf16 E{(bf16*)(ws + WS_BIG), ATT_IN};
            pg8::gemm_phase(F.lds, F.tid, D, S, E); }
        else if (PHT(2) && type == 2) { PHASE_BEGIN; phase_attn(F, bx); }
        else if (PHT(3) && type == 3) { PHASE_BEGIN; phase_attn_combine(F); }
        else if (PHT(4) && type == 4) { PHASE_BEGIN; DenseSched S; S.init(ws + WS_AUX + AUX_OB, ws + WS_ATT_OUT_T + (size_t)j * D * D * 2, T, D, D, F.G, bx); EpiResid E{(const bf16*)(ws + WS_XB), (bf16*)(ws + WS_Y)};
            pg8::gemm_phase(F.lds, F.tid, D, S, E); }
        else if (PHT(5) && type == 5) { PHASE_BEGIN; DenseSched S; S.init(ws + WS_XB, ws + WS_RET_IN_T, T, RET_IN, D, F.G, bx); EpiRetIn E{(bf16*)(ws + WS_BIG), RET_IN};
            pg8::gemm_phase(F.lds, F.tid, D, S, E); }
        else if (PHT(6) && type == 6) { PHASE_BEGIN; phase_ret_u(F); }
        else if (PHT(7) && type == 7) { PHASE_BEGIN; phase_ret_scan(F); }
        else if (PHT(8) && type == 8) { PHASE_BEGIN; phase_ret_out(F, p); }
        else if (PHT(9) && type == 9) { PHASE_BEGIN; DenseSched S; S.init(ws + WS_BIG + BIG_YRET, ws + WS_RET_OUT_T, T, D, RET_V, F.G, bx); EpiResid E{(const bf16*)(ws + WS_XB), (bf16*)(ws + WS_Y)};
            pg8::gemm_phase(F.lds, F.tid, RET_V, S, E); }
        else if (PHT(10) && type == 10) { PHASE_BEGIN; phase_s5_scan<false>(F, p); }
        else if (PHT(11) && type == 11) { PHASE_BEGIN; phase_s5_carry(F, p); }
        else if (PHT(12) && type == 12) { PHASE_BEGIN; phase_s5_scan<true>(F, p); }
        else if (PHT(13) && type == 13) { PHASE_BEGIN; DenseSched S; S.init(ws + WS_AUX, ws + WS_GLU_T, T, 2 * D, D, F.G, bx); EpiGluResid E{(const bf16*)(ws + WS_XB), (bf16*)(ws + WS_Y)};
            pg8::gemm_phase(F.lds, F.tid, D, S, E); }
        else if (PHT(14) && type == 14) { PHASE_BEGIN; phase_lnr(F, p, layer, PROBE_DRY14 && true); if (PROBE_DRY14) { if (use_bar) xcd_barrier(bar); phase_lnr(F, p, layer, false); } }
        else if (PHT(15) && type == 15) { PHASE_BEGIN; moe_plan(F, layer);
            MoeSched2<true> S; S.tstart = (const volatile LAS int*)(F.MISC + PLAN_OFF); S.cnts = S.tstart + 72; S.ntiles = __builtin_amdgcn_readfirstlane((int)S.tstart[65]); S.G = F.G; S.c = bx; S.lane = F.lane;
            S.Abase = (const char*)(ws + WS_XB); S.Wbase = (const char*)(ws + WS_WMOE); S.lists = (const int*)(ws + WS_LIST);
            EpiMoeUp E{(bf16*)(ws + WS_H)};
            pg8::gemm_phase(F.lds, F.tid, D, S, E); }
        else if (PHT(16) && type == 16) { PHASE_BEGIN; moe_plan(F, layer);
            MoeSched2<false> S; S.tstart = (const volatile LAS int*)(F.MISC + PLAN_OFF); S.cnts = S.tstart + 72; S.ntiles = __builtin_amdgcn_readfirstlane((int)S.tstart[65]); S.G = F.G; S.c = bx; S.lane = F.lane;
            S.Abase = (const char*)(ws + WS_H); S.Wbase = (const char*)(ws + WS_WMOE); S.lists = (const int*)(ws + WS_LIST);
            EpiStoreFp8 E{(unsigned char*)(ws + WS_BIG), D};
            pg8::gemm_phase(F.lds, F.tid, ED, S, E); }
        else if (PHT(17) && type == 17) { PHASE_BEGIN; moe_plan(F, layer); if (PROBE_DRY17) { phase_combine(F, p, layer, true); if (use_bar) xcd_barrier(bar); } phase_combine(F, p, layer); if (layer + 1 < DEPTH) phase_conv_moe(F, p, layer + 1); }
        }
        if (use_bar && ph + 1 < hi) xcd_barrier(bar);
    }
}

#ifndef MK_PER_PHASE
#define MK_PER_PHASE 0
#endif
extern "C" void kernel_launch(void* const* d_in, const int* in_sizes, int n_in, void* d_out, int out_size, void* d_ws, size_t ws_size, hipStream_t stream) {
    static int grid = 0;
    if (grid == 0) {
        if (n_in != 26 || in_sizes[0] != T * D || out_size != T * D || ws_size < WS_END) { fprintf(stderr, "kernel_launch: unexpected shapes / workspace (n_in %d, in0 %d, out %d, ws %zu < %zu)\n", n_in, n_in > 0 ? in_sizes[0] : -1, out_size, ws_size, (size_t)WS_END); grid = -1; return; }
        int dev = 0, cus = 0, per_cu = 0;
        if (hipGetDevice(&dev) != hipSuccess || hipDeviceGetAttribute(&cus, hipDeviceAttributeMultiprocessorCount, dev) != hipSuccess) { grid = -1; return; }
        if (hipFuncSetAttribute((const void*)fwd_kernel, hipFuncAttributeMaxDynamicSharedMemorySize, LDS_BYTES) != hipSuccess) { fprintf(stderr, "kernel_launch: hipFuncSetAttribute failed\n"); grid = -1; return; }
        if (hipOccupancyMaxActiveBlocksPerMultiprocessor(&per_cu, (const void*)fwd_kernel, NTHREADS, LDS_BYTES) != hipSuccess || per_cu < 1) { fprintf(stderr, "kernel_launch: occupancy query says %d blocks per CU\n", per_cu); per_cu = 1; }
        (void)hipGetLastError();
        grid = cus;
    }
    if (grid < 0) return;
    (void)hipMemsetAsync((char*)d_ws + WS_CTL, 0, CTL_ZERO_BYTES, stream);
    Params p{};
    for (int i = 0; i < 26; ++i) p.in[i] = (const float*)d_in[i];
    p.out = (float*)d_out; p.ws = (unsigned char*)d_ws;
#if MK_PER_PHASE
    for (int k = 0; k < NPHASES; ++k) { p.ph_lo = k; p.ph_hi = k + 1; p.use_bar = 0; hipLaunchKernelGGL(fwd_kernel, dim3(grid), dim3(NTHREADS), LDS_BYTES, stream, p); }
#else
    p.ph_lo = 0; p.ph_hi = NPHASES; p.use_bar = 1;
    hipLaunchKernelGGL(fwd_kernel, dim3(grid), dim3(NTHREADS), LDS_BYTES, stream, p);
#endif
}
```

```cpp
#include <hip/hip_runtime.h>
#include <cstdio>
#include <cstdint>

#define LAS __attribute__((address_space(3)))
#define GAS __attribute__((address_space(1)))
typedef unsigned short bf16;
typedef short bf16x8 __attribute__((ext_vector_type(8)));
typedef short bf16x4 __attribute__((ext_vector_type(4)));
typedef float f32x4 __attribute__((ext_vector_type(4)));
typedef float f32x2 __attribute__((ext_vector_type(2)));
typedef unsigned u32x4 __attribute__((ext_vector_type(4)));
typedef unsigned u32x2 __attribute__((ext_vector_type(2)));
typedef GAS unsigned gu32;

constexpr int D = 1024, BATCH = 2, SEQ = 8192, T = BATCH * SEQ, DEPTH = 4;
constexpr int AH = 8, AHD = 128, ATT_IN = 9216;
constexpr int RH = 4, RDK = 256, RDV = 512, RET_IN = 6144, RET_V = 2048, RC = 128, RNC = SEQ / RC;
constexpr int SG = 64, SGC = 16, SP = 64;
constexpr int NE = 64, TOPK = 8, NEG = 8, ED = 256, NSLOT = 9;
constexpr float LN_EPS = 1e-5f;
constexpr float ALPHA = 1.6817928305074292f;
constexpr int NWAVES = 8, NTHREADS = 512;

__device__ __forceinline__ unsigned f2bf(float f) { unsigned u = __builtin_bit_cast(unsigned, f); return (u + 0x7fffu + ((u >> 16) & 1u)) >> 16; }
__device__ __forceinline__ unsigned pk2(float lo, float hi) { unsigned r; asm("s_nop 1\n\tv_cvt_pk_bf16_f32 %0, %1, %2" : "=v"(r) : "v"(lo), "v"(hi)); return r; }
__device__ __forceinline__ unsigned pk2sw(float lo, float hi) { return f2bf(lo) | (f2bf(hi) << 16); }
__device__ __forceinline__ unsigned pk2hw(float lo, float hi) { unsigned r; asm volatile("v_cvt_pk_bf16_f32 %0, %1, %2" : "=v"(r) : "v"(lo), "v"(hi)); return r; }
__device__ __forceinline__ float bf2f(unsigned b) { return __builtin_bit_cast(float, b << 16); }
__device__ __forceinline__ float bflo(unsigned w) { return __builtin_bit_cast(float, w << 16); }
__device__ __forceinline__ float bfhi(unsigned w) { return __builtin_bit_cast(float, w & 0xffff0000u); }
__device__ __forceinline__ float shx(float v, int m, int lane) { return __builtin_bit_cast(float, __builtin_amdgcn_ds_bpermute((lane ^ m) << 2, __builtin_bit_cast(int, v))); }
__device__ __forceinline__ int shx_i(int v, int m, int lane) { return __builtin_amdgcn_ds_bpermute((lane ^ m) << 2, v); }
__device__ __forceinline__ float rdl(float v, int src) { return __builtin_bit_cast(float, __builtin_amdgcn_readlane(__builtin_bit_cast(int, v), src)); }
__device__ __forceinline__ float wave_sum(float v, int lane) {
#pragma unroll
    for (int o = 1; o < 64; o <<= 1) v += shx(v, o, lane);
    return v;
}
#define LDS_WAIT() asm volatile("s_waitcnt lgkmcnt(0)" ::: "memory")
#define VM_WAIT() asm volatile("s_waitcnt vmcnt(0)" ::: "memory")
__device__ __forceinline__ const char* rfl_ptr(const char* p) {
    unsigned long long v = (unsigned long long)p; unsigned lo = __builtin_amdgcn_readfirstlane((unsigned)v), hi = __builtin_amdgcn_readfirstlane((unsigned)(v >> 32));
    return (const char*)(((unsigned long long)hi << 32) | lo);
}
__device__ __forceinline__ bf16x8 row_frag(const LAS bf16* base, int ld, int row0, int col0, int lane) {
    return *(const LAS bf16x8*)(base + (row0 + (lane & 15)) * ld + col0 + 8 * (lane >> 4));
}
__device__ __forceinline__ bf16x4 tr4(const LAS bf16* addr) { return __builtin_amdgcn_ds_read_tr16_b64_v4i16((LAS bf16x4*)addr); }
__device__ __forceinline__ bf16x8 cat8(bf16x4 a, bf16x4 b) { bf16x8 r; r[0] = a[0]; r[1] = a[1]; r[2] = a[2]; r[3] = a[3]; r[4] = b[0]; r[5] = b[1]; r[6] = b[2]; r[7] = b[3]; return r; }
#define MFMA16(a, b, c) __builtin_amdgcn_mfma_f32_16x16x32_bf16((a), (b), (c), 0, 0, 0)
__device__ __forceinline__ bf16x8 pack8(f32x4 a, f32x4 b) {
    u32x4 w; w.x = pk2(a[0], a[1]); w.y = pk2(a[2], a[3]); w.z = pk2(b[0], b[1]); w.w = pk2(b[2], b[3]); return __builtin_bit_cast(bf16x8, w);
}

namespace pg8 {
constexpr int BM = 256, BK = 64, HALF = 128, HTB = HALF * BK * 2, STAGE_BYTES = 8 * HTB;
__device__ __forceinline__ int lds_byte(int r, int c) { const int st = (r >> 4) * 2 + (c >> 5), rr = r & 15, cc = c & 31, ob = rr * 64 + cc * 2; return st * 1024 + (ob ^ (((ob >> 9) & 1) << 5)); }
__device__ __forceinline__ void stage_rc(int b, int& R, int& C) { const int st = b / 1024, sb = b % 1024, swz = sb ^ (((sb >> 9) & 1) << 5); R = (st >> 1) * 16 + swz / 64; C = (st & 1) * 32 + (swz % 64) / 2; }
__device__ __forceinline__ int perm32(int rho) { const int n = rho >> 4, i = rho & 15; return 8 * (i >> 2) + 4 * n + (i & 3); }

struct UnitG {
    const char* A;
    const char* B;
    const int* gidx;
    int gcnt, gshift;
    int row0, col0;
    int aux;
};

__device__ __forceinline__ void uniformize(UnitG& u) { u.A = rfl_ptr(u.A); u.B = rfl_ptr(u.B); u.gidx = (const int*)rfl_ptr((const char*)u.gidx); u.gcnt = __builtin_amdgcn_readfirstlane(u.gcnt); u.gshift = __builtin_amdgcn_readfirstlane(u.gshift);
    u.row0 = __builtin_amdgcn_readfirstlane(u.row0); u.col0 = __builtin_amdgcn_readfirstlane(u.col0); u.aux = __builtin_amdgcn_readfirstlane(u.aux); }
template <class Epi, class Sched>
__device__ __forceinline__ void gemm_phase(LAS unsigned char* lds, const int tid, const int K, const Sched& S, const Epi& E) {
    constexpr bool GATHER = Sched::GATHER;
    const int wid = __builtin_amdgcn_readfirstlane(tid >> 6), lane = tid & 63, wr = wid >> 2, wc = wid & 3, fr = lane & 15, fq = lane >> 4;
    const int nt = K / BK;
    constexpr bool P16 = Epi::PERM16;
    unsigned voffB[2], voffB1[2], vA[2][2];
#pragma unroll
    for (int i = 0; i < 2; ++i) { int R, C; stage_rc(tid * 16 + i * 8192, R, C); const int Rb = Epi::PERM ? ((R & ~31) + perm32(R & 31)) : R; voffB[i] = (unsigned)(Rb * K + C) * 2u; voffB1[i] = voffB[i]; vA[0][i] = (unsigned)(R * K + C) * 2u; vA[1][i] = vA[0][i];
        if constexpr (P16) { const int x = R & 31, src = 64 * (R >> 5) + 16 * ((x >> 2) & 3) + 4 * (x >> 4) + (x & 3); voffB[i] = (unsigned)(src * K + C) * 2u; voffB1[i] = (unsigned)((src + 8) * K + C) * 2u; } }
    const size_t kstep = (size_t)(BK * 2);
    const size_t hstep = (size_t)HALF * K * 2;
    const size_t hstepB = P16 ? 0 : hstep;
    const size_t hstepA = GATHER ? 0 : hstep;
    const unsigned ldsw = (unsigned)wid * 1024u;
    const int aoff = lds_byte(wr * 64 + fr, fq * 8), boff = lds_byte(wc * 32 + fr, fq * 8);
    LAS u32x4* park = (LAS u32x4*)(lds + STAGE_BYTES) + tid;
#define PG8_SA(b, h) (((b) * 2 + (h)) * HTB)
#define PG8_SB(b, h) ((4 + (b) * 2 + (h)) * HTB)
#define PG8_STAGE(bufoff, gbase, voff) do { _Pragma("unroll") for (int _i = 0; _i < 2; ++_i) { asm volatile("" : "+v"((voff)[_i]));   \
        __builtin_amdgcn_global_load_lds((const unsigned*)((const char*)(gbase) + (voff)[_i]), (LAS unsigned*)(lds + (bufoff) + ldsw + _i * 8192), 16, 0, 0); } } while (0)
#define PG8_LDA(dst, b, h) do { _Pragma("unroll") for (int m = 0; m < 4; ++m) _Pragma("unroll") for (int k = 0; k < 2; ++k) dst[m][k] = *(const LAS bf16x8*)(lds + PG8_SA(b, h) + aoff + m * 2048 + k * 1024); } while (0)
#define PG8_LDB(dst, b, h) do { _Pragma("unroll") for (int n = 0; n < 2; ++n) _Pragma("unroll") for (int k = 0; k < 2; ++k) dst[n][k] = *(const LAS bf16x8*)(lds + PG8_SB(b, h) + boff + n * 2048 + k * 1024); } while (0)
#define PG8_MMA(ai, bj, At, Bt) do { __builtin_amdgcn_s_setprio(1); _Pragma("unroll") for (int m = 0; m < 4; ++m) _Pragma("unroll") for (int n = 0; n < 2; ++n) _Pragma("unroll") for (int k = 0; k < 2; ++k) \
        acc[ai][bj][m][n] = __builtin_amdgcn_mfma_f32_16x16x32_bf16(Bt[n][k], At[m][k], acc[ai][bj][m][n], 0, 0, 0); __builtin_amdgcn_s_setprio(0); } while (0)
#define PG8_WAIT_V(n) asm volatile("s_waitcnt vmcnt(" #n ")" ::: "memory")
#define PG8_WAIT_L(n) asm volatile("s_waitcnt lgkmcnt(" #n ")" ::: "memory")
#define PG8_BAR __builtin_amdgcn_s_barrier()
#define PG8_SCHED __builtin_amdgcn_sched_barrier(0)
#define PG8_VOFF(u, v00, v01, v10, v11) do { int _R0, _C0, _R1, _C1; stage_rc(tid * 16, _R0, _C0); stage_rc(tid * 16 + 8192, _R1, _C1); int _r00 = _R0, _r01 = _R1, _r10 = HALF + _R0, _r11 = HALF + _R1; \
        if ((u).gidx) { const int _a = _r00 < (u).gcnt ? ((const GAS int*)(u).gidx)[_r00] >> (u).gshift : 0, _b = _r01 < (u).gcnt ? ((const GAS int*)(u).gidx)[_r01] >> (u).gshift : 0, _c = _r10 < (u).gcnt ? ((const GAS int*)(u).gidx)[_r10] >> (u).gshift : 0, _d = _r11 < (u).gcnt ? ((const GAS int*)(u).gidx)[_r11] >> (u).gshift : 0; \
            _r00 = _a; _r01 = _b; _r10 = _c; _r11 = _d; } \
        v00 = (unsigned)(_r00 * K + _C0) * 2u; v01 = (unsigned)(_r01 * K + _C1) * 2u; v10 = (unsigned)(_r10 * K + _C0) * 2u; v11 = (unsigned)(_r11 * K + _C1) * 2u; } while (0)
    UnitG cur, nxt; int ui = 0;
    if (!S.next(0, cur)) return;
    if constexpr (Sched::UNIFORMIZE) uniformize(cur);
    f32x4 acc[2][2][4][2];
#pragma unroll
    for (int a = 0; a < 2; ++a)
#pragma unroll
        for (int b = 0; b < 2; ++b)
#pragma unroll
            for (int m = 0; m < 4; ++m)
#pragma unroll
                for (int n = 0; n < 2; ++n) acc[a][b][m][n] = (f32x4){0.f, 0.f, 0.f, 0.f};
    bf16x8 At[4][2], B0[2][2], B1[2][2];
    if constexpr (GATHER) PG8_VOFF(cur, vA[0][0], vA[0][1], vA[1][0], vA[1][1]);
    const char* cA = cur.A; const char* cB = cur.B;
    PG8_STAGE(PG8_SB(0, 0), cB, voffB); PG8_STAGE(PG8_SB(0, 1), cB + hstepB, voffB1); PG8_STAGE(PG8_SA(0, 0), cA, vA[0]); PG8_STAGE(PG8_SA(0, 1), cA + hstepA, vA[1]);
    if (wr == 1) PG8_BAR;
    PG8_WAIT_V(2); PG8_BAR;
    PG8_STAGE(PG8_SB(1, 0), cB + kstep, voffB); PG8_STAGE(PG8_SA(1, 0), cA + kstep, vA[0]); PG8_STAGE(PG8_SB(1, 1), cB + hstepB + kstep, voffB1);
    PG8_WAIT_V(6); PG8_BAR;
    for (;;) {
        const bool has_next = S.next(ui + 1, nxt);
        if constexpr (Sched::UNIFORMIZE) { if (has_next) uniformize(nxt); }
        const char* nA = cA; const char* nB = cB;
        if (has_next) { nA = nxt.A; nB = nxt.B; }
        if constexpr (GATHER) { u32x4 pv; pv.x = vA[0][0]; pv.y = vA[0][1]; pv.z = vA[1][0]; pv.w = vA[1][1];
            if (has_next) PG8_VOFF(nxt, pv.x, pv.y, pv.z, pv.w);
            *park = pv; }
#pragma unroll 1
        for (int t = 0; t < nt; t += 2) {
            const bool last = (t == nt - 2);
            const char* a1 = cA + (size_t)(t + 1) * kstep;
            const char* a2 = last ? nA : cA + (size_t)(t + 2) * kstep; const char* b2 = last ? nB : cB + (size_t)(t + 2) * kstep;
            const char* a3 = a2 + kstep; const char* b3 = b2 + kstep;
            PG8_LDB(B0, 0, 0); PG8_LDB(B1, 0, 1); PG8_SCHED; PG8_LDA(At, 0, 0); PG8_STAGE(PG8_SA(1, 1), a1 + hstepA, vA[1]);
            PG8_WAIT_V(8); PG8_WAIT_L(0); PG8_BAR; PG8_MMA(0, 0, At, B0); PG8_MMA(0, 1, At, B1); PG8_BAR; PG8_SCHED;
            if constexpr (GATHER) { if (last) { const u32x4 pv = *park; vA[0][0] = pv.x; vA[0][1] = pv.y; vA[1][0] = pv.z; vA[1][1] = pv.w; } }
            PG8_LDA(At, 0, 1); PG8_STAGE(PG8_SB(0, 0), b2, voffB); PG8_STAGE(PG8_SB(0, 1), b2 + hstepB, voffB1); PG8_STAGE(PG8_SA(0, 0), a2, vA[0]);
            PG8_WAIT_V(8); PG8_WAIT_L(0); PG8_BAR; PG8_MMA(1, 0, At, B0); PG8_MMA(1, 1, At, B1); PG8_BAR; PG8_SCHED;
            PG8_LDB(B0, 1, 0); PG8_LDB(B1, 1, 1); PG8_SCHED; PG8_LDA(At, 1, 0); PG8_STAGE(PG8_SA(0, 1), a2 + hstepA, vA[1]);
            PG8_WAIT_V(8); PG8_WAIT_L(0); PG8_BAR; PG8_MMA(0, 0, At, B0); PG8_MMA(0, 1, At, B1); PG8_BAR; PG8_SCHED;
            PG8_LDA(At, 1, 1); PG8_STAGE(PG8_SB(1, 0), b3, voffB); PG8_STAGE(PG8_SB(1, 1), b3 + hstepB, voffB1); PG8_STAGE(PG8_SA(1, 0), a3, vA[0]);
            PG8_WAIT_V(8); PG8_WAIT_L(0); PG8_BAR; PG8_MMA(1, 0, At, B0); PG8_MMA(1, 1, At, B1); PG8_BAR; PG8_SCHED;
        }
        if (wr == 0) PG8_BAR;
        E(acc, cur, wr, wc, fr, fq);
        if (!has_next) break;
#pragma unroll
        for (int a = 0; a < 2; ++a)
#pragma unroll
            for (int b = 0; b < 2; ++b)
#pragma unroll
                for (int m = 0; m < 4; ++m)
#pragma unroll
                    for (int n = 0; n < 2; ++n) acc[a][b][m][n] = (f32x4){0.f, 0.f, 0.f, 0.f};
        cur = nxt; cA = nA; cB = nB; ++ui;
        if (wr == 1) PG8_BAR;
    }
    PG8_WAIT_V(0);
    PG8_BAR;
#undef PG8_SA
#undef PG8_SB
#undef PG8_STAGE
#undef PG8_LDA
#undef PG8_LDB
#undef PG8_MMA
#undef PG8_WAIT_V
#undef PG8_WAIT_L
#undef PG8_BAR
#undef PG8_SCHED
#undef PG8_VOFF
}
}

constexpr size_t MiB = 1u << 20;
constexpr size_t WS_CTL = 0, CTL_ZERO_BYTES = 1 * MiB;
constexpr size_t WS_ATT_IN_T = 1 * MiB;
constexpr size_t WS_ATT_OUT_T = WS_ATT_IN_T + 36 * MiB;
constexpr size_t WS_RET_IN_T = WS_ATT_OUT_T + 4 * MiB;
constexpr size_t WS_RET_OUT_T = WS_RET_IN_T + 12 * MiB;
constexpr size_t WS_GLU_T = WS_RET_OUT_T + 4 * MiB;
constexpr size_t WS_RT_HI = WS_GLU_T + 4 * MiB;
constexpr size_t WS_RT_LO = WS_RT_HI + 512 * 1024;
constexpr size_t WS_WMOE = WS_RT_HI + 1 * MiB;
constexpr size_t WMOE_E_BYTES = (size_t)(512 * 1024 + 1024 * 256) * 2;
constexpr size_t WS_X = WS_WMOE + 98 * MiB;
constexpr size_t WS_Y = WS_X + 64 * MiB;
constexpr size_t WS_XB = WS_Y + 64 * MiB;
constexpr size_t WS_BIG = WS_XB + 32 * MiB;
constexpr size_t WS_AUX = WS_BIG + 288 * MiB;
constexpr size_t WS_H = WS_AUX + 160 * MiB;
constexpr size_t WS_LIST = WS_H + 80 * MiB;
constexpr size_t WS_TRASH = WS_LIST + 8 * MiB;
constexpr size_t WS_END = WS_TRASH + 1 * MiB;
static_assert(WS_END <= 1024 * MiB, "workspace map");
constexpr int CW_BAR = 4096;
constexpr int CW_CNT = 16384;
constexpr int CW_CHK = 65536;
constexpr int HROWS = 163840;

#define XB_TMO      128
#define XB_XCNT(j)  (256  + 64 * (j))
#define XB_XSUB(j)  (1280 + 64 * (j))
#define XB_XGEN(j)  (2304 + 64 * (j))
#define XB_TOP      3328
#define XB_TOPGEN   3392
#define XCD_BAR_WORDS 3456
#define XB_SPIN_CAP (1u << 20)
__device__ __forceinline__ unsigned xb_ld(unsigned* p)              { return __hip_atomic_load(p, __ATOMIC_RELAXED, __HIP_MEMORY_SCOPE_AGENT); }
__device__ __forceinline__ unsigned xb_add(unsigned* p, unsigned v) { return __hip_atomic_fetch_add(p, v, __ATOMIC_RELAXED, __HIP_MEMORY_SCOPE_AGENT); }
__device__ __forceinline__ unsigned xb_xcc_id() { return (unsigned)__builtin_amdgcn_s_getreg((3 << 11) | 20) & 0xFu; }
#define XB_SPIN(cond, bar) do { unsigned _sp = 0; while (cond) { __builtin_amdgcn_s_sleep(1); \
    if ((++_sp & 255u) == 0u) { if (xb_ld(&(bar)[XB_TMO])) break; if (_sp > XB_SPIN_CAP) { atomicAdd(&(bar)[XB_TMO], 1u); break; } } } } while (0)
struct XcdBarrier { unsigned* bar; unsigned x; volatile LAS unsigned* st; };
__device__ __forceinline__ XcdBarrier xcd_barrier_post(unsigned* bar, volatile LAS unsigned* st) {
    XcdBarrier b; b.bar = bar; b.x = xb_xcc_id(); b.st = st;
    if (threadIdx.x == 0) (void)xb_add(&bar[XB_XCNT(b.x)], 1u);
    return b;
}
__device__ __forceinline__ void xcd_barrier_complete(unsigned* bar, unsigned x, unsigned& nloc, unsigned& nx) {
    const unsigned G = gridDim.x * gridDim.y * gridDim.z;
    unsigned sum, cnt, mine, sp = 0u;
    for (;;) {
        sum = 0u; cnt = 0u; mine = 0u;
#pragma unroll
        for (unsigned j = 0; j < 16; ++j) { const unsigned c = xb_ld(&bar[XB_XCNT(j)]); sum += c; cnt += (c > 0u) ? 1u : 0u; mine = (j == x) ? c : mine; }
        if (sum == G) break;
        __builtin_amdgcn_s_sleep(1);
        if ((++sp & 255u) == 0u) { if (xb_ld(&bar[XB_TMO])) break; if (sp > XB_SPIN_CAP) { atomicAdd(&bar[XB_TMO], 1u); break; } }
    }
    nloc = mine > 0u ? mine : 1u; nx = cnt > 0u ? cnt : 1u;
}
__device__ __forceinline__ void xcd_barrier(const XcdBarrier& b) {
    asm volatile("s_waitcnt vmcnt(0)" ::: "memory");
    __syncthreads();
    if (threadIdx.x == 0) {
        unsigned* bar = b.bar;
        __builtin_amdgcn_s_waitcnt(0);
        unsigned nloc = b.st[0], nx = b.st[1];
        if (nloc == 0u) { xcd_barrier_complete(bar, b.x, nloc, nx); b.st[0] = nloc; b.st[1] = nx; }
        const unsigned old = xb_add(&bar[XB_XSUB(b.x)], 1u);
        const unsigned gen = old / nloc;
        if (old + 1u == (gen + 1u) * nloc) {
            __builtin_amdgcn_fence(__ATOMIC_RELEASE, "agent");
            asm volatile("s_waitcnt vmcnt(0)" ::: "memory");
            const unsigned og = xb_add(&bar[XB_TOP], 1u);
            const unsigned tg = og / nx;
            if (og + 1u == (tg + 1u) * nx) xb_add(&bar[XB_TOPGEN], 1u);
            else XB_SPIN(xb_ld(&bar[XB_TOPGEN]) == tg, bar);
            __builtin_amdgcn_fence(__ATOMIC_ACQUIRE, "agent");
            xb_add(&bar[XB_XGEN(b.x)], 1u);
            asm volatile("s_waitcnt vmcnt(0)" ::: "memory");
        } else {
            XB_SPIN(xb_ld(&bar[XB_XGEN(b.x)]) == gen, bar);
            __builtin_amdgcn_fence(__ATOMIC_ACQUIRE, "agent");
            asm volatile("s_waitcnt vmcnt(0)" ::: "memory");
        }
    }
    __syncthreads();
}

constexpr int RING_BYTES = 139264;
constexpr int MISC_OFF = RING_BYTES;
constexpr int LDS_BYTES = 147456;
struct Params {
    const float* in[26]; float* out; unsigned char* ws; int ph_lo, ph_hi; int use_bar, pad;
};
typedef const __attribute__((address_space(4))) Params* KP;
__device__ __forceinline__ const float* gin(KP p, int i) { return (const float*)(const GAS float*)p->in[i]; }
__device__ __forceinline__ float* gout(KP p) { return (float*)(GAS float*)p->out; }
struct Frame {
    LAS unsigned char* lds; volatile LAS unsigned* MISC;
    int tid, lane, wave, vcu, G;
    unsigned char* ws;
};

struct DenseSched {
    static constexpr bool GATHER = false, UNIFORMIZE = false;
    const char* A; const char* Bt; int K, nM, nN, nwg, G, c;
    __device__ __forceinline__ void init(const void* A_, const void* Bt_, int M, int N, int K_, int G_, int c_) { A = (const char*)A_; Bt = (const char*)Bt_; K = K_; nM = M / 256; nN = N / 256; nwg = nM * nN; G = G_; c = c_; }
    __device__ __forceinline__ bool next(int i, pg8::UnitG& u) const {
        const long L = (long)i * G + c; if (L >= nwg) return false;
        int wgid = (int)L; { const int q = nwg / 8, r = nwg % 8, xcd = wgid % 8, off = wgid / 8; wgid = (xcd < r ? xcd * (q + 1) : r * (q + 1) + (xcd - r) * q) + off; }
        const int nig = 8 * nN, gid = wgid / nig, fm = gid * 8, gsz = (nM - fm) < 8 ? (nM - fm) : 8;
        const int pm = fm + ((wgid % nig) % gsz), pn = (wgid % nig) / gsz;
        u.A = A + (size_t)pm * 256 * K * 2; u.B = Bt + (size_t)pn * 256 * K * 2; u.gidx = nullptr; u.gcnt = 0; u.gshift = 0; u.row0 = pm * 256; u.col0 = pn * 256; u.aux = 0; return true;
    }
};
__device__ __forceinline__ u32x4 pack_bf16x8(const f32x4& v0, const f32x4& v1) { u32x4 w; w.x = pk2hw(v0[0], v0[1]); w.y = pk2hw(v0[2], v0[3]); w.z = pk2hw(v1[0], v1[1]); w.w = pk2hw(v1[2], v1[3]); return w; }

struct EpiStoreBf16 {
    static constexpr bool PERM = true, PERM16 = false;
    bf16* O; int ldc;
    __device__ __forceinline__ void operator()(const f32x4 (&acc)[2][2][4][2], const pg8::UnitG& u, int wr, int wc, int fr, int fq) const {
#pragma unroll
        for (int ai = 0; ai < 2; ++ai)
#pragma unroll
            for (int m = 0; m < 4; ++m) { bf16* rowp = O + (size_t)(u.row0 + ai * 128 + wr * 64 + m * 16 + fr) * ldc + u.col0 + wc * 32 + 8 * fq;
#pragma unroll
                for (int bj = 0; bj < 2; ++bj) *(u32x4*)(rowp + bj * 128) = pack_bf16x8(acc[ai][bj][m][0], acc[ai][bj][m][1]); }
    }
};
constexpr float YEXP_SCALE = 32.0f, YEXP_INV = 1.0f / 32.0f;
struct EpiStoreFp8 {
    static constexpr bool PERM = false, PERM16 = true;
    unsigned char* O; int ldc;
    __device__ __forceinline__ void operator()(const f32x4 (&acc)[2][2][4][2], const pg8::UnitG& u, int wr, int wc, int fr, int fq) const {
#pragma unroll
        for (int ai = 0; ai < 2; ++ai)
#pragma unroll
            for (int m = 0; m < 4; ++m) { unsigned char* rowp = O + (size_t)(u.row0 + ai * 128 + wr * 64 + m * 16 + fr) * ldc + u.col0 + wc * 64 + 16 * fq;
                u32x4 w;
#pragma unroll
                for (int q = 0; q < 4; ++q) { f32x4 v = acc[ai][q >> 1][m][q & 1] * YEXP_SCALE;
#pragma unroll
                    for (int j = 0; j < 4; ++j) v[j] = fminf(fmaxf(v[j], -448.0f), 448.0f);
                    int d = 0; d = __builtin_amdgcn_cvt_pk_fp8_f32(v[0], v[1], d, false); d = __builtin_amdgcn_cvt_pk_fp8_f32(v[2], v[3], d, true); w[q] = (unsigned)d; }
                *(u32x4*)rowp = w; }
    }
};
struct EpiRetIn {
    static constexpr bool PERM = true, PERM16 = false;
    bf16* O; int ldc;
    __device__ __forceinline__ void operator()(const f32x4 (&acc)[2][2][4][2], const pg8::UnitG& u, int wr, int wc, int fr, int fq) const {
        float l2g = 0.f;
        if (u.col0 < 2048) { const int h = (u.col0 & 1023) >> 8; const float g = 1.0f - exp2f(-5.0f - (float)h); l2g = log2f(g); if (u.col0 >= 1024) l2g = -l2g; }
#pragma unroll
        for (int ai = 0; ai < 2; ++ai)
#pragma unroll
            for (int m = 0; m < 4; ++m) { const int row = u.row0 + ai * 128 + wr * 64 + m * 16 + fr; const float sc = exp2f(l2g * (float)(row & 127));
                bf16* rowp = O + (size_t)row * ldc + u.col0 + wc * 32 + 8 * fq;
#pragma unroll
                for (int bj = 0; bj < 2; ++bj) *(u32x4*)(rowp + bj * 128) = pack_bf16x8(acc[ai][bj][m][0] * sc, acc[ai][bj][m][1] * sc); }
    }
};
__device__ __forceinline__ void unpack_bf16x8(const u32x4& w, f32x4& a, f32x4& b) { a[0] = bflo(w.x); a[1] = bfhi(w.x); a[2] = bflo(w.y); a[3] = bfhi(w.y); b[0] = bflo(w.z); b[1] = bfhi(w.z); b[2] = bflo(w.w); b[3] = bfhi(w.w); }
struct EpiResid {
    static constexpr bool PERM = true, PERM16 = false;
    const bf16* X; bf16* Y;
    __device__ __forceinline__ void operator()(const f32x4 (&acc)[2][2][4][2], const pg8::UnitG& u, int wr, int wc, int fr, int fq) const {
#pragma unroll
        for (int ai = 0; ai < 2; ++ai)
#pragma unroll
            for (int m = 0; m < 4; ++m) { const size_t off = (size_t)(u.row0 + ai * 128 + wr * 64 + m * 16 + fr) * D + u.col0 + wc * 32 + 8 * fq;
#pragma unroll
                for (int bj = 0; bj < 2; ++bj) { const u32x4 xw = *(const u32x4*)(X + off + bj * 128); f32x4 x0, x1; unpack_bf16x8(xw, x0, x1);
                    *(u32x4*)(Y + off + bj * 128) = pack_bf16x8(x0 * ALPHA + acc[ai][bj][m][0], x1 * ALPHA + acc[ai][bj][m][1]); }
                if (m == 3) asm volatile("" ::: "memory"); }
    }
};
struct EpiGluResid {
    static constexpr bool PERM = true, PERM16 = false;
    const bf16* X; bf16* Y;
    __device__ __forceinline__ void operator()(const f32x4 (&acc)[2][2][4][2], const pg8::UnitG& u, int wr, int wc, int fr, int fq) const {
#pragma unroll
        for (int ai = 0; ai < 2; ++ai)
#pragma unroll
            for (int m = 0; m < 4; ++m) { const size_t off = (size_t)(u.row0 + ai * 128 + wr * 64 + m * 16 + fr) * D + (u.col0 >> 1) + wc * 32 + 8 * fq;
                const u32x4 xw = *(const u32x4*)(X + off); f32x4 x0, x1; unpack_bf16x8(xw, x0, x1); f32x4 o0, o1;
#pragma unroll
                for (int j = 0; j < 4; ++j) { o0[j] = x0[j] * ALPHA + acc[ai][0][m][0][j] / (1.0f + __expf(-acc[ai][1][m][0][j])); o1[j] = x1[j] * ALPHA + acc[ai][0][m][1][j] / (1.0f + __expf(-acc[ai][1][m][1][j])); }
                *(u32x4*)(Y + off) = pack_bf16x8(o0, o1);
                if (m == 3) asm volatile("" ::: "memory"); }
    }
};
struct EpiMoeUp {
    static constexpr bool PERM = true, PERM16 = false;
    bf16* H;
    __device__ __forceinline__ void operator()(const f32x4 (&acc)[2][2][4][2], const pg8::UnitG& u, int wr, int wc, int fr, int fq) const {
#pragma unroll
        for (int ai = 0; ai < 2; ++ai)
#pragma unroll
            for (int m = 0; m < 4; ++m) { bf16* rowp = H + (size_t)(u.row0 + ai * 128 + wr * 64 + m * 16 + fr) * ED + u.col0 + wc * 32 + 8 * fq; f32x4 o[2];
#pragma unroll
                for (int n = 0; n < 2; ++n)
#pragma unroll
                    for (int j = 0; j < 4; ++j) { const float g = acc[ai][0][m][n][j], up = acc[ai][1][m][n][j]; o[n][j] = g / (1.0f + __expf(-g)) * up; }
                *(u32x4*)rowp = pack_bf16x8(o[0], o[1]); }
    }
};

template <bool HILO>
__device__ __forceinline__ void conv_item(const float* W, int ldw, bf16* WT, bf16* WTlo, int ldk, int k0, int n0, int drow0, float scale, LAS float* scr, int lane) {
#pragma unroll 8
    for (int i = 0; i < 32; ++i) { const int kk = 2 * i + (lane >> 5); scr[kk * 33 + (lane & 31)] = W[(size_t)(k0 + kk) * ldw + n0 + (lane & 31)] * scale; }
    LDS_WAIT(); asm volatile("" ::: "memory");
    const int c = lane & 7;
#pragma unroll
    for (int j = 0; j < 4; ++j) { const int n = (lane >> 3) + 8 * j; const LAS float* s = scr + (8 * c) * 33 + n;
        float v[8];
#pragma unroll
        for (int q = 0; q < 8; ++q) v[q] = s[q * 33];
        u32x4 o; o.x = pk2(v[0], v[1]); o.y = pk2(v[2], v[3]); o.z = pk2(v[4], v[5]); o.w = pk2(v[6], v[7]);
        *(u32x4*)(WT + (size_t)(drow0 + n) * ldk + k0 + 8 * c) = o;
        if (HILO) { float r[8];
#pragma unroll
            for (int q = 0; q < 8; ++q) r[q] = v[q] - bf2f(f2bf(v[q]));
            u32x4 o2; o2.x = pk2(r[0], r[1]); o2.y = pk2(r[2], r[3]); o2.z = pk2(r[4], r[5]); o2.w = pk2(r[6], r[7]);
            *(u32x4*)(WTlo + (size_t)(drow0 + n) * ldk + k0 + 8 * c) = o2; } }
    LDS_WAIT(); asm volatile("" ::: "memory");
}
__device__ __forceinline__ void phase_conv_mixers(const Frame& F, KP p) {
    LAS float* scr = (LAS float*)(F.lds + F.wave * 16384);
    const int gw = F.vcu * NWAVES + F.wave, NGW = F.G * NWAVES;
    constexpr int I_AIN = 16 * 288, I_AOUT = 16 * 32, I_RIN = 16 * 192, I_ROUT = 32 * 32, I_GLU = 16 * 64, I_RT = 16 * 2;
    constexpr int NITEMS = 2 * I_AIN + 2 * I_AOUT + I_RIN + I_ROUT + I_GLU + 4 * I_RT;
    unsigned char* ws = F.ws;
    for (int it = gw; it < NITEMS; it += NGW) {
        int r = it;
        if (r < 2 * I_AIN) { const int j = r / I_AIN; r %= I_AIN; const int kb = r / 288, nb = r % 288, n0 = nb * 32;
            conv_item<false>(gin(p, 1) + (size_t)j * D * ATT_IN, ATT_IN, (bf16*)(ws + WS_ATT_IN_T) + (size_t)j * ATT_IN * D, nullptr, D, kb * 64, n0, n0, ((n0 % 3072) < 1024) ? 0.08838834764831845f : 1.0f, scr, F.lane); continue; }
        r -= 2 * I_AIN;
        if (r < 2 * I_AOUT) { const int j = r / I_AOUT; r %= I_AOUT; const int kb = r / 32, nb = r % 32, n0 = nb * 32;
            conv_item<false>(gin(p, 2) + (size_t)j * D * D, D, (bf16*)(ws + WS_ATT_OUT_T) + (size_t)j * D * D, nullptr, D, kb * 64, n0, n0, 1.0f, scr, F.lane); continue; }
        r -= 2 * I_AOUT;
        if (r < I_RIN) { const int kb = r / 192, nb = r % 192, n0 = nb * 32;
            conv_item<false>(gin(p, 3), RET_IN, (bf16*)(ws + WS_RET_IN_T), nullptr, D, kb * 64, n0, n0, (n0 >= 1024 && n0 < 2048) ? 0.0625f : 1.0f, scr, F.lane); continue; }
        r -= I_RIN;
        if (r < I_ROUT) { const int kb = r / 32, nb = r % 32, n0 = nb * 32;
            conv_item<false>(gin(p, 6), D, (bf16*)(ws + WS_RET_OUT_T), nullptr, RET_V, kb * 64, n0, n0, 1.0f, scr, F.lane); continue; }
        r -= I_ROUT;
        if (r < I_GLU) { const int kb = r / 64, nb = r % 64, n0 = nb * 32; const int c = n0 & 1023, drow = (c >> 7) * 256 + (n0 >> 10) * 128 + (c & 127);
            conv_item<false>(gin(p, 15), 2 * D, (bf16*)(ws + WS_GLU_T), nullptr, D, kb * 64, n0, drow, 1.0f, scr, F.lane); continue; }
        r -= I_GLU;
        { const int l = r / I_RT; r %= I_RT; const int kb = r / 2, nb = r % 2, n0 = nb * 32;
            conv_item<true>(gin(p, 16) + (size_t)l * D * NE, NE, (bf16*)(ws + WS_RT_HI) + (size_t)l * NE * D, (bf16*)(ws + WS_RT_LO) + (size_t)l * NE * D, D, kb * 64, n0, n0, 1.0f, scr, F.lane); }
    }
}
__device__ __forceinline__ void phase_conv_moe(const Frame& F, KP p, int l) {
    LAS float* scr = (LAS float*)(F.lds + F.wave * 16384);
    const int gw = F.vcu * NWAVES + F.wave, NGW = F.G * NWAVES;
    for (int it = gw; it < 65 * 384; it += NGW) {
        const int e = it / 384, r = it % 384, which = r >> 7, rr = r & 127;
        bf16* We = (bf16*)(F.ws + WS_WMOE + (size_t)e * WMOE_E_BYTES);
        if (which < 2) { const float* src = (e < 64) ? gin(p, 18 + which) + ((size_t)l * NE + e) * D * ED : gin(p, 21 + which) + (size_t)l * D * ED;
            const int kb = rr >> 3, nb = rr & 7, n0 = nb * 32; const int drow = (n0 >> 7) * 256 + which * 128 + (n0 & 127);
            conv_item<false>(src, ED, We, nullptr, D, kb * 64, n0, drow, 1.0f, scr, F.lane);
        } else { const float* src = (e < 64) ? gin(p, 20) + ((size_t)l * NE + e) * ED * D : gin(p, 23) + (size_t)l * ED * D;
            const int kb = rr >> 5, nb = rr & 31, n0 = nb * 32;
            conv_item<false>(src, D, We + 512 * 1024, nullptr, ED, kb * 64, n0, n0, 1.0f, scr, F.lane); }
    }
}

__device__ __forceinline__ void phase_lnr(const Frame& F, KP p, int layer, bool dry = false) {
    const bf16* Y = (const bf16*)(F.ws + WS_Y); bf16* XB = (bf16*)(F.ws + WS_XB);
    const float* lng = gin(p, 24) + (size_t)(layer * 2) * D; const float* lnb = gin(p, 25) + (size_t)(layer * 2) * D;
    const bf16* rthi = (const bf16*)(F.ws + WS_RT_HI) + (size_t)layer * NE * D; const bf16* rtlo = (const bf16*)(F.ws + WS_RT_LO) + (size_t)layer * NE * D;
    const float* rbias = gin(p, 17) + layer * NE;
    unsigned* cnt = (unsigned*)(F.ws + WS_CTL) + CW_CNT + layer * NE * 64;
    int* lists = (int*)(F.ws + WS_LIST); int* tokmap = (int*)(F.ws + WS_LIST + 4 * MiB); float* tokgate = (float*)(F.ws + WS_LIST + 5 * MiB);
    constexpr int XLD = 1032, MAXT = 8;
    LAS bf16* Xhi = (LAS bf16*)F.lds; LAS bf16* Xlo = Xhi + 16 * XLD;
    LAS float* part = (LAS float*)(F.lds + 2 * 16 * XLD * 2);
    LAS int* ent = (LAS int*)(part + 2 * 16 * 64);
    LAS int* hist = ent + MAXT * 16 * 8 * 2; LAS int* base = hist + 64;
    const int lane = F.lane, w = F.wave, g4 = lane >> 4, l15 = lane & 15;
    if (F.tid < 64) hist[F.tid] = 0;
    f32x4 gv[4], bv[4];
#pragma unroll
    for (int j = 0; j < 2; ++j) { gv[2 * j] = *(const f32x4*)(lng + 8 * lane + 512 * j); gv[2 * j + 1] = *(const f32x4*)(lng + 8 * lane + 512 * j + 4);
        bv[2 * j] = *(const f32x4*)(lnb + 8 * lane + 512 * j); bv[2 * j + 1] = *(const f32x4*)(lnb + 8 * lane + 512 * j + 4); }
    int ntile = 0;
    for (int tile = F.vcu; tile < T / 16 && ntile < MAXT; tile += F.G, ++ntile) {
        const int t0 = tile * 16;
#pragma unroll
        for (int rr = 0; rr < 2; ++rr) {
            const int lr = 2 * w + rr; const size_t row = (size_t)(t0 + lr);
            f32x4 v[4]; float s = 0.f;
#pragma unroll
            for (int j = 0; j < 2; ++j) { const u32x4 yw = *(const u32x4*)(Y + row * D + 8 * lane + 512 * j); unpack_bf16x8(yw, v[2 * j], v[2 * j + 1]); }
#pragma unroll
            for (int j = 0; j < 4; ++j) s += (v[j][0] + v[j][1]) + (v[j][2] + v[j][3]);
            const float mean = wave_sum(s, lane) * (1.f / D); float s2 = 0.f;
#pragma unroll
            for (int j = 0; j < 4; ++j) { v[j] = v[j] - mean; s2 += (v[j][0] * v[j][0] + v[j][1] * v[j][1]) + (v[j][2] * v[j][2] + v[j][3] * v[j][3]); }
            const float rstd = 1.0f / sqrtf(wave_sum(s2, lane) * (1.f / D) + LN_EPS);
#pragma unroll
            for (int j = 0; j < 2; ++j) { const f32x4 o0 = v[2 * j] * rstd * gv[2 * j] + bv[2 * j], o1 = v[2 * j + 1] * rstd * gv[2 * j + 1] + bv[2 * j + 1];
                const u32x4 hi = pack_bf16x8(o0, o1);
                *(u32x4*)(XB + row * D + 8 * lane + 512 * j) = hi;
                f32x4 h0, h1; unpack_bf16x8(hi, h0, h1); const u32x4 lo = pack_bf16x8(o0 - h0, o1 - h1);
                *(LAS u32x4*)(Xhi + lr * XLD + 8 * lane + 512 * j) = hi; *(LAS u32x4*)(Xlo + lr * XLD + 8 * lane + 512 * j) = lo; }
        }
        __syncthreads();
        { const int nt = w & 3, kh = w >> 2; f32x4 acc = (f32x4){0.f, 0.f, 0.f, 0.f};
            const bf16* bh = rthi + (size_t)(16 * nt + l15) * D + 512 * kh + 8 * g4; const bf16* bl = rtlo + (size_t)(16 * nt + l15) * D + 512 * kh + 8 * g4;
#pragma unroll 8
            for (int ks = 0; ks < 16; ++ks) { const int k0 = 512 * kh + 32 * ks;
                const bf16x8 ahi = row_frag(Xhi, XLD, 0, k0, lane), alo = row_frag(Xlo, XLD, 0, k0, lane);
                const bf16x8 bhi = *(const bf16x8*)(bh + 32 * ks), blo = *(const bf16x8*)(bl + 32 * ks);
                acc = MFMA16(ahi, bhi, acc); acc = MFMA16(alo, bhi, acc); acc = MFMA16(ahi, blo, acc); }
#pragma unroll
            for (int i = 0; i < 4; ++i) part[(kh * 16 + 4 * g4 + i) * 64 + 16 * nt + l15] = acc[i];
        }
        __syncthreads();
#pragma unroll
        for (int rr = 0; rr < 2; ++rr) {
            const int lt = ntile * 16 + 2 * w + rr;
            const float lg = part[(2 * w + rr) * 64 + lane] + part[(16 + 2 * w + rr) * 64 + lane];
            float sc = 1.0f / (1.0f + expf(-lg)); sc = (sc == sc) ? sc : 0.5f;
            const float sel = sc + rbias[lane];
            float m1 = sel; m1 = fmaxf(m1, shx(m1, 1, lane)); m1 = fmaxf(m1, shx(m1, 2, lane)); m1 = fmaxf(m1, shx(m1, 4, lane));
            const unsigned long long eq = __ballot(sel == m1);
            const unsigned gm = (unsigned)(eq >> (lane & 56)) & 0xffu;
            const int first = (lane & 56) + __builtin_ctz(gm | 0x100u);
            float m2 = (lane == first) ? -INFINITY : sel; m2 = fmaxf(m2, shx(m2, 1, lane)); m2 = fmaxf(m2, shx(m2, 2, lane)); m2 = fmaxf(m2, shx(m2, 4, lane));
            const float gs = m1 + m2; const int mygrp = lane >> 3; int grank = 0;
#pragma unroll
            for (int gg = 0; gg < 8; ++gg) { const float o = rdl(gs, 8 * gg); grank += (o > gs || (o == gs && gg < mygrp)) ? 1 : 0; }
            const float mv = (grank < 4) ? sel : -INFINITY; int rank = 0;
#pragma unroll
            for (int e2 = 0; e2 < 64; ++e2) { const float o = rdl(mv, e2); rank += (o > mv || (o == mv && e2 < lane)) ? 1 : 0; }
            const bool chosen = rank < TOPK;
            const float wsum = wave_sum(chosen ? sc : 0.f, lane);
            if (chosen) { const int lpos = __hip_atomic_fetch_add(hist + lane, 1, __ATOMIC_RELAXED, __HIP_MEMORY_SCOPE_WORKGROUP);
                ent[(lt * 8 + rank) * 2] = (lane << 16) | lpos; ent[(lt * 8 + rank) * 2 + 1] = __builtin_bit_cast(int, sc / wsum * 2.5f); }
        }
    }
    __syncthreads();
    if (dry) return;
    if (F.tid < 64) { const int hcount = hist[F.tid]; base[F.tid] = hcount ? (int)atomicAdd(cnt + F.tid * 64, (unsigned)hcount) : 0; }
    __syncthreads();
    for (int idx = F.tid; idx < ntile * 16 * 8; idx += NTHREADS) {
        const int ev = ent[idx * 2], gb = ent[idx * 2 + 1]; const int e = ev >> 16, pos = base[e] + (ev & 0xffff);
        const int lt = idx >> 3, rank = idx & 7, tok = (F.vcu + (lt >> 4) * F.G) * 16 + (lt & 15);
        lists[(size_t)e * T + pos] = tok; tokmap[tok * 8 + rank] = (e << 16) | pos; tokgate[tok * 8 + rank] = __builtin_bit_cast(float, gb);
    }
}

__device__ __forceinline__ void phase_combine(const Frame& F, KP p, int layer, bool dry = false) {
    bf16* XB = (bf16*)(F.ws + WS_XB); const unsigned char* yexp = (const unsigned char*)(F.ws + WS_BIG);
    const int* tokmap = (const int*)(F.ws + WS_LIST + 4 * MiB); const float* tokgate = (const float*)(F.ws + WS_LIST + 5 * MiB);
    const volatile LAS int* tstart = (const volatile LAS int*)(F.MISC + 64);
    const float* lng = gin(p, 24) + (size_t)(layer * 2 + 1) * D; const float* lnb = gin(p, 25) + (size_t)(layer * 2 + 1) * D;
    float* outp = gout(p); bf16* xbo = XB; if (dry) { outp = (float*)(F.ws + WS_X); xbo = (bf16*)(F.ws + WS_H); }
    const int lane = F.lane, gw = F.vcu * NWAVES + F.wave, NGW = F.G * NWAVES;
    const bf16* ysh = (const bf16*)(F.ws + WS_Y);
    f32x4 gv[4], bv[4];
#pragma unroll
    for (int j = 0; j < 4; ++j) { gv[j] = *(const f32x4*)(lng + 16 * lane + 4 * j); bv[j] = *(const f32x4*)(lnb + 16 * lane + 4 * j); }
    for (int row = gw; row < T; row += NGW) {
        const int mk = tokmap[row * 8 + (lane & 7)]; const float gk = tokgate[row * 8 + (lane & 7)] * YEXP_INV;
        const int rk = (int)tstart[mk >> 16] * 256 + (mk & 0xffff);
        f32x4 v[4];
#pragma unroll
        for (int j = 0; j < 2; ++j) { const u32x4 xw = *(const u32x4*)(ysh + (size_t)row * D + 16 * lane + 8 * j); unpack_bf16x8(xw, v[2 * j], v[2 * j + 1]); }
#pragma unroll
        for (int k = 0; k < TOPK; ++k) { const int r = __builtin_amdgcn_readlane(rk, k); const float g = rdl(gk, k);
            const u32x4 s = *(const u32x4*)(yexp + (size_t)r * D + 16 * lane);
#pragma unroll
            for (int j = 0; j < 4; ++j) { const f32x2 lo = __builtin_amdgcn_cvt_pk_f32_fp8((int)s[j], false), hi = __builtin_amdgcn_cvt_pk_f32_fp8((int)s[j], true);
                v[j][0] += g * lo[0]; v[j][1] += g * lo[1]; v[j][2] += g * hi[0]; v[j][3] += g * hi[1]; } }
        float s = 0.f;
#pragma unroll
        for (int j = 0; j < 4; ++j) s += (v[j][0] + v[j][1]) + (v[j][2] + v[j][3]);
        const float mean = wave_sum(s, lane) * (1.f / D); float s2 = 0.f;
#pragma unroll
        for (int j = 0; j < 4; ++j) { v[j] = v[j] - mean; s2 += (v[j][0] * v[j][0] + v[j][1] * v[j][1]) + (v[j][2] * v[j][2] + v[j][3] * v[j][3]); }
        const float rstd = 1.0f / sqrtf(wave_sum(s2, lane) * (1.f / D) + LN_EPS);
        f32x4 o[4];
#pragma unroll
        for (int j = 0; j < 4; ++j) o[j] = v[j] * rstd * gv[j] + bv[j];
        if (layer == DEPTH - 1 || dry) {
#pragma unroll
            for (int j = 0; j < 4; ++j) *(f32x4*)(outp + (size_t)row * D + 16 * lane + 4 * j) = o[j]; }
        if (layer != DEPTH - 1) { *(u32x4*)(xbo + (size_t)row * D + 16 * lane) = pack_bf16x8(o[0], o[1]); *(u32x4*)(xbo + (size_t)row * D + 16 * lane + 8) = pack_bf16x8(o[2], o[3]); }
    }
}

constexpr size_t AUX_OB = 96 * MiB, AUX_LSE = 128 * MiB;
__device__ __forceinline__ void phase_attn(const Frame& F, int bx) {
    const bf16* qkv = (const bf16*)(F.ws + WS_BIG); bf16* og = (bf16*)(F.ws + WS_AUX); float* lse = (float*)(F.ws + WS_AUX + AUX_LSE);
    constexpr int KLD = 136;
    LAS bf16* Ks = (LAS bf16*)F.lds; LAS bf16* Vs = Ks + 256 * KLD;
    const int lane = F.lane, w = F.wave, g4 = lane >> 4, l15 = lane & 15, qq = l15 >> 2, pp = lane & 3;
    u32x4 kreg[8], vreg[8];
#define ATT_DECODE(L_) const int h = (L_) & 7, sb = (L_) >> 3, g = sb >> 7, rem = sb & 127, b = rem >> 6, rn = rem & 63; \
        const int dsh = 2 * g, d = 1 << dsh, nbs = 6 - dsh, r = rn >> nbs, n = rn & ((1 << nbs) - 1); const size_t rowbase = (size_t)b * SEQ;
#define ATT_ISSUE(L_) do { ATT_DECODE(L_) _Pragma("unroll") for (int it = 0; it < 8; ++it) { const int idx = F.tid + 512 * it, c = idx >> 4, ch = idx & 15; int pos = 128 * (n - 1) + c; pos = pos < 0 ? 0 : pos; \
            const bf16* src = qkv + (rowbase + (size_t)pos * d + r) * ATT_IN + g * 3072 + 1024 + h * 128 + ch * 8; kreg[it] = *(const u32x4*)src; vreg[it] = *(const u32x4*)(src + 1024); } } while (0)
    if (bx < 3072) ATT_ISSUE(bx);
    for (int L = bx; L < 3072; L += F.G) {
        ATT_DECODE(L)
#pragma unroll
        for (int it = 0; it < 8; ++it) { const int idx = F.tid + 512 * it, c = idx >> 4, ch = idx & 15;
            *(LAS u32x4*)(Ks + c * KLD + ch * 8) = kreg[it]; *(LAS u32x4*)(Vs + c * KLD + ch * 8) = vreg[it]; }
        const int qi = 16 * w + l15; const size_t qrow = rowbase + (size_t)(128 * n + qi) * d + r;
        bf16x8 qf[4];
#pragma unroll
        for (int s = 0; s < 4; ++s) qf[s] = *(const bf16x8*)(qkv + qrow * ATT_IN + g * 3072 + h * 128 + 32 * s + 8 * g4);
        __syncthreads();
        if (L + F.G < 3072) { ATT_ISSUE(L + F.G); }
        __builtin_amdgcn_sched_barrier(0);
        const int ws0 = (16 * w < 96) ? 16 * w : 96;
        f32x4 sacc[10];
        {
            bf16x8 kfa[4], kfb[4];
#pragma unroll
            for (int s = 0; s < 4; ++s) kfa[s] = row_frag(Ks, KLD, ws0, 32 * s, lane);
#pragma unroll
            for (int t = 0; t < 10; t += 2) {
#pragma unroll
                for (int s = 0; s < 4; ++s) kfb[s] = row_frag(Ks, KLD, ws0 + 16 * (t + 1), 32 * s, lane);
                __builtin_amdgcn_sched_barrier(0);
                sacc[t] = (f32x4){0.f, 0.f, 0.f, 0.f};
#pragma unroll
                for (int s = 0; s < 4; ++s) sacc[t] = MFMA16(kfa[s], qf[s], sacc[t]);
                if (t + 2 < 10) {
#pragma unroll
                    for (int s = 0; s < 4; ++s) kfa[s] = row_frag(Ks, KLD, ws0 + 16 * (t + 2), 32 * s, lane); }
                __builtin_amdgcn_sched_barrier(0);
                sacc[t + 1] = (f32x4){0.f, 0.f, 0.f, 0.f};
#pragma unroll
                for (int s = 0; s < 4; ++s) sacc[t + 1] = MFMA16(kfb[s], qf[s], sacc[t + 1]);
            }
        }
        const float slope = exp2f(-(float)(h + 1)) * (float)d;
        float mx = -INFINITY;
#pragma unroll
        for (int t = 0; t < 10; ++t)
#pragma unroll
            for (int i = 0; i < 4; ++i) { const int c = ws0 + 16 * t + 4 * g4 + i, step = 128 + qi - c;
                const bool valid = (step >= 0) && (step <= 128) && (n > 0 || c >= 128);
                const float v = valid ? sacc[t][i] - slope * (float)step : -INFINITY; sacc[t][i] = v; mx = fmaxf(mx, v); }
        mx = fmaxf(mx, shx(mx, 16, lane)); mx = fmaxf(mx, shx(mx, 32, lane));
        float lsum = 0.f;
#pragma unroll
        for (int t = 0; t < 10; ++t)
#pragma unroll
            for (int i = 0; i < 4; ++i) { const float pv = __expf(sacc[t][i] - mx); sacc[t][i] = pv; lsum += pv; }
        lsum += shx(lsum, 16, lane); lsum += shx(lsum, 32, lane);
        bf16x8 pf[5];
#pragma unroll
        for (int kt = 0; kt < 5; ++kt) pf[kt] = pack8(sacc[2 * kt], sacc[2 * kt + 1]);
        f32x4 o[8];
        {
            const LAS bf16* vb = Vs + (ws0 + 4 * g4 + qq) * KLD + 32 * pp;
            bf16x4 va[10], vc[10];
#pragma unroll
            for (int kt = 0; kt < 5; ++kt) { va[2 * kt] = tr4(vb + 32 * kt * KLD); va[2 * kt + 1] = tr4(vb + (32 * kt + 16) * KLD); }
#pragma unroll
            for (int et = 0; et < 8; et += 2) {
#pragma unroll
                for (int kt = 0; kt < 5; ++kt) { vc[2 * kt] = tr4(vb + 32 * kt * KLD + 4 * (et + 1)); vc[2 * kt + 1] = tr4(vb + (32 * kt + 16) * KLD + 4 * (et + 1)); }
                __builtin_amdgcn_sched_barrier(0);
                o[et] = (f32x4){0.f, 0.f, 0.f, 0.f};
#pragma unroll
                for (int kt = 0; kt < 5; ++kt) o[et] = MFMA16(cat8(va[2 * kt], va[2 * kt + 1]), pf[kt], o[et]);
                if (et + 2 < 8) {
#pragma unroll
                    for (int kt = 0; kt < 5; ++kt) { va[2 * kt] = tr4(vb + 32 * kt * KLD + 4 * (et + 2)); va[2 * kt + 1] = tr4(vb + (32 * kt + 16) * KLD + 4 * (et + 2)); } }
                __builtin_amdgcn_sched_barrier(0);
                o[et + 1] = (f32x4){0.f, 0.f, 0.f, 0.f};
#pragma unroll
                for (int kt = 0; kt < 5; ++kt) o[et + 1] = MFMA16(cat8(vc[2 * kt], vc[2 * kt + 1]), pf[kt], o[et + 1]);
            }
        }
        const float inv = 1.0f / lsum;
        bf16* orow = og + ((size_t)g * T + qrow) * D + h * 128 + 32 * g4;
#pragma unroll
        for (int e2 = 0; e2 < 4; ++e2) *(u32x4*)(orow + 8 * e2) = pack_bf16x8(o[2 * e2] * inv, o[2 * e2 + 1] * inv);
        if (g4 == 0) lse[((size_t)g * T + qrow) * AH + h] = mx + __logf(lsum);
        __syncthreads();
    }
#undef ATT_DECODE
#undef ATT_ISSUE
}
__device__ __forceinline__ void phase_attn_combine(const Frame& F) {
    const bf16* og = (const bf16*)(F.ws + WS_AUX); const float* lse = (const float*)(F.ws + WS_AUX + AUX_LSE); bf16* ob = (bf16*)(F.ws + WS_AUX + AUX_OB);
    const int lane = F.lane, gw = F.vcu * NWAVES + F.wave, NGW = F.G * NWAVES, h = lane >> 3;
    for (int row = gw; row < T; row += NGW) {
        const float l0 = lse[((size_t)0 * T + row) * AH + h], l1 = lse[((size_t)1 * T + row) * AH + h], l2 = lse[((size_t)2 * T + row) * AH + h];
        const float m = fmaxf(l0, fmaxf(l1, l2)); float w0 = __expf(l0 - m), w1 = __expf(l1 - m), w2 = __expf(l2 - m); const float inv = 1.0f / (w0 + w1 + w2); w0 *= inv; w1 *= inv; w2 *= inv;
        float a[16];
#pragma unroll
        for (int j = 0; j < 16; ++j) a[j] = 0.f;
#pragma unroll
        for (int g = 0; g < 3; ++g) { const float wg = (g == 0) ? w0 : (g == 1 ? w1 : w2);
#pragma unroll
            for (int q = 0; q < 2; ++q) { const u32x4 s = *(const u32x4*)(og + ((size_t)g * T + row) * D + 16 * lane + 8 * q);
                a[8 * q + 0] += wg * bflo(s.x); a[8 * q + 1] += wg * bfhi(s.x); a[8 * q + 2] += wg * bflo(s.y); a[8 * q + 3] += wg * bfhi(s.y);
                a[8 * q + 4] += wg * bflo(s.z); a[8 * q + 5] += wg * bfhi(s.z); a[8 * q + 6] += wg * bflo(s.w); a[8 * q + 7] += wg * bfhi(s.w); } }
#pragma unroll
        for (int q = 0; q < 2; ++q) { u32x4 o; o.x = pk2(a[8 * q], a[8 * q + 1]); o.y = pk2(a[8 * q + 2], a[8 * q + 3]); o.z = pk2(a[8 * q + 4], a[8 * q + 5]); o.w = pk2(a[8 * q + 6], a[8 * q + 7]);
            *(u32x4*)(ob + (size_t)row * D + 16 * lane + 8 * q) = o; }
    }
}

constexpr size_t BIG_YRET = 192 * MiB;
__device__ __forceinline__ void phase_ret_u(const Frame& F) {
    const bf16* proj = (const bf16*)(F.ws + WS_BIG); bf16* St = (bf16*)(F.ws + WS_AUX);
    constexpr int LD = 264;
    LAS bf16* Kt = (LAS bf16*)F.lds; LAS bf16* Vt = Kt + 128 * LD;
    const int lane = F.lane, w = F.wave, g4 = lane >> 4, l15 = lane & 15, qq = l15 >> 2, pp = lane & 3;
    for (int u = F.vcu; u < 1024; u += F.G) {
        const int eh = u & 1, h = (u >> 1) & 3, n = (u >> 3) & 63, b = u >> 9;
        const size_t row0 = (size_t)b * SEQ + (size_t)n * RC;
#pragma unroll 4
        for (int it = 0; it < 8; ++it) { const int idx = F.tid + 512 * it, j = idx >> 5, ch = idx & 31;
            const bf16* src = proj + (row0 + j) * RET_IN;
            const u32x4 kv = *(const u32x4*)(src + 1024 + h * 256 + ch * 8), vv = *(const u32x4*)(src + 2048 + h * 512 + eh * 256 + ch * 8);
            *(LAS u32x4*)(Kt + j * LD + ch * 8) = kv; *(LAS u32x4*)(Vt + j * LD + ch * 8) = vv; }
        __syncthreads();
        f32x4 acc[16][2];
#pragma unroll
        for (int mt = 0; mt < 16; ++mt) { acc[mt][0] = (f32x4){0.f, 0.f, 0.f, 0.f}; acc[mt][1] = (f32x4){0.f, 0.f, 0.f, 0.f}; }
#pragma unroll
        for (int ks = 0; ks < 4; ++ks) {
            bf16x8 bfr[2];
#pragma unroll
            for (int nt = 0; nt < 2; ++nt) { const LAS bf16* a0 = Vt + (32 * ks + 8 * g4 + qq) * LD + 32 * w + 16 * nt + 4 * pp; bfr[nt] = cat8(tr4(a0), tr4(a0 + 4 * LD)); }
#pragma unroll
            for (int mt = 0; mt < 16; ++mt) { const LAS bf16* a0 = Kt + (32 * ks + 8 * g4 + qq) * LD + 128 * (mt >> 3) + 32 * pp + 4 * (mt & 7);
                const bf16x8 afr = cat8(tr4(a0), tr4(a0 + 4 * LD));
                acc[mt][0] = MFMA16(afr, bfr[0], acc[mt][0]); acc[mt][1] = MFMA16(afr, bfr[1], acc[mt][1]); }
        }
        bf16* outb = St + ((size_t)((b * RH + h) * RNC + n)) * (RDV * RDK);
#pragma unroll
        for (int nt = 0; nt < 2; ++nt) { bf16* orow = outb + (size_t)(eh * 256 + 32 * w + 16 * nt + l15) * RDK + 32 * g4;
#pragma unroll
            for (int mh = 0; mh < 2; ++mh)
#pragma unroll
                for (int q = 0; q < 4; ++q) *(u32x4*)(orow + 128 * mh + 8 * q) = pack_bf16x8(acc[mh * 8 + 2 * q][nt], acc[mh * 8 + 2 * q + 1][nt]); }
        __syncthreads();
    }
}
__device__ __forceinline__ void phase_ret_scan(const Frame& F) {
    bf16* St = (bf16*)(F.ws + WS_AUX);
    for (int gt = F.vcu * NTHREADS + F.tid; gt < 8 * 16384; gt += F.G * NTHREADS) {
        const int bh = gt >> 14, chunk = gt & 16383, h = bh & 3;
        const float g128 = exp2f(128.0f * log2f(1.0f - exp2f(-5.0f - (float)h)));
        bf16* base = St + (size_t)bh * RNC * (RDV * RDK) + (size_t)chunk * 8;
        float c[8];
#pragma unroll
        for (int j = 0; j < 8; ++j) c[j] = 0.f;
#pragma unroll 8
        for (int n = 0; n < RNC; ++n) { bf16* pn = base + (size_t)n * (RDV * RDK); const u32x4 uv = *(const u32x4*)pn;
            u32x4 o; o.x = pk2(c[0], c[1]); o.y = pk2(c[2], c[3]); o.z = pk2(c[4], c[5]); o.w = pk2(c[6], c[7]); *(u32x4*)pn = o;
            c[0] = g128 * (c[0] + bflo(uv.x)); c[1] = g128 * (c[1] + bfhi(uv.x)); c[2] = g128 * (c[2] + bflo(uv.y)); c[3] = g128 * (c[3] + bfhi(uv.y));
            c[4] = g128 * (c[4] + bflo(uv.z)); c[5] = g128 * (c[5] + bfhi(uv.z)); c[6] = g128 * (c[6] + bflo(uv.w)); c[7] = g128 * (c[7] + bfhi(uv.w)); }
    }
}
__device__ __forceinline__ void phase_ret_out(const Frame& F, KP p) {
    const bf16* proj = (const bf16*)(F.ws + WS_BIG); const bf16* St = (const bf16*)(F.ws + WS_AUX); bf16* yret = (bf16*)(F.ws + WS_BIG + BIG_YRET);
    const float* gng = gin(p, 4); const float* gnb = gin(p, 5);
    constexpr int LD = 264, VLD = 136;
    LAS bf16* Rs = (LAS bf16*)F.lds; LAS bf16* Vs = Rs + 128 * LD;
    const int lane = F.lane, w = F.wave, g4 = lane >> 4, l15 = lane & 15, qq = l15 >> 2, pp = lane & 3;
    for (int u = F.vcu; u < 512; u += F.G) {
        const int h = u & 3, n = (u >> 2) & 63, b = u >> 8;
        const size_t row0 = (size_t)b * SEQ + (size_t)n * RC;
#pragma unroll 4
        for (int it = 0; it < 8; ++it) { const int idx = F.tid + 512 * it, j = idx >> 5, ch = idx & 31;
            *(LAS u32x4*)(Rs + j * LD + ch * 8) = *(const u32x4*)(proj + (row0 + j) * RET_IN + 1024 + h * 256 + ch * 8); }
        const int irow = 16 * w + l15; const size_t qrow = row0 + irow;
        bf16x8 qf[8];
#pragma unroll
        for (int s = 0; s < 8; ++s) qf[s] = *(const bf16x8*)(proj + qrow * RET_IN + h * 256 + 32 * s + 8 * g4);
        __syncthreads();
        bf16x8 pf[4];
        { f32x4 sacc[8];
#pragma unroll
            for (int jt = 0; jt < 8; ++jt) { sacc[jt] = (f32x4){0.f, 0.f, 0.f, 0.f};
                if (jt <= w) {
#pragma unroll
                    for (int s = 0; s < 8; ++s) sacc[jt] = MFMA16(row_frag(Rs, LD, 16 * jt, 32 * s, lane), qf[s], sacc[jt]);
#pragma unroll
                    for (int i = 0; i < 4; ++i) if (16 * jt + 4 * g4 + i > irow) sacc[jt][i] = 0.f; } }
#pragma unroll
            for (int kt = 0; kt < 4; ++kt) pf[kt] = pack8(sacc[2 * kt], sacc[2 * kt + 1]); }
        __syncthreads();
        f32x4 acc[4][8];
        const bf16* Sn = St + ((size_t)((b * RH + h) * RNC + n)) * (RDV * RDK);
#pragma unroll
        for (int sl = 0; sl < 4; ++sl) {
#pragma unroll 4
            for (int it = 0; it < 4; ++it) { const int idx = F.tid + 512 * it, j = idx >> 4, ch = idx & 15;
                *(LAS u32x4*)(Vs + j * VLD + ch * 8) = *(const u32x4*)(proj + (row0 + j) * RET_IN + 2048 + h * 512 + sl * 128 + ch * 8); }
#pragma unroll 4
            for (int it = 0; it < 8; ++it) { const int idx = F.tid + 512 * it, e = idx >> 5, ch = idx & 31;
                *(LAS u32x4*)(Rs + e * LD + ch * 8) = *(const u32x4*)(Sn + (size_t)(sl * 128 + e) * RDK + ch * 8); }
            __syncthreads();
#pragma unroll
            for (int et = 0; et < 8; ++et) { f32x4 a = (f32x4){0.f, 0.f, 0.f, 0.f};
#pragma unroll
                for (int kt = 0; kt < 4; ++kt) if (2 * kt <= w) { const LAS bf16* a0 = Vs + (32 * kt + 4 * g4 + qq) * VLD + 32 * pp + 4 * et;
                    a = MFMA16(cat8(tr4(a0), tr4(a0 + 16 * VLD)), pf[kt], a); }
                const LAS bf16* srow = Rs + (32 * qq + 4 * et + pp) * LD + 8 * g4;
#pragma unroll
                for (int s = 0; s < 8; ++s) a = MFMA16(*(const LAS bf16x8*)(srow + 32 * s), qf[s], a);
                acc[sl][et] = a; }
            __syncthreads();
        }
        float s = 0.f;
#pragma unroll
        for (int sl = 0; sl < 4; ++sl)
#pragma unroll
            for (int et = 0; et < 8; ++et) s += (acc[sl][et][0] + acc[sl][et][1]) + (acc[sl][et][2] + acc[sl][et][3]);
        s += shx(s, 16, lane); s += shx(s, 32, lane);
        const float mean = s * (1.0f / RDV); float s2 = 0.f;
#pragma unroll
        for (int sl = 0; sl < 4; ++sl)
#pragma unroll
            for (int et = 0; et < 8; ++et) { acc[sl][et] = acc[sl][et] - mean; s2 += (acc[sl][et][0] * acc[sl][et][0] + acc[sl][et][1] * acc[sl][et][1]) + (acc[sl][et][2] * acc[sl][et][2] + acc[sl][et][3] * acc[sl][et][3]); }
        s2 += shx(s2, 16, lane); s2 += shx(s2, 32, lane);
        const float rstd = 1.0f / sqrtf(s2 * (1.0f / RDV) + LN_EPS);
#pragma unroll
        for (int sl = 0; sl < 4; ++sl) { const int c0 = h * RDV + sl * 128 + 32 * g4;
#pragma unroll
            for (int q = 0; q < 4; ++q) { const u32x4 gw = *(const u32x4*)(proj + qrow * RET_IN + 4096 + c0 + 8 * q);
                const f32x4 gg0 = *(const f32x4*)(gng + c0 + 8 * q), gg1 = *(const f32x4*)(gng + c0 + 8 * q + 4), gb0 = *(const f32x4*)(gnb + c0 + 8 * q), gb1 = *(const f32x4*)(gnb + c0 + 8 * q + 4);
                f32x4 y0 = acc[sl][2 * q] * rstd * gg0 + gb0, y1 = acc[sl][2 * q + 1] * rstd * gg1 + gb1;
                const float gv[8] = {bflo(gw.x), bfhi(gw.x), bflo(gw.y), bfhi(gw.y), bflo(gw.z), bfhi(gw.z), bflo(gw.w), bfhi(gw.w)};
#pragma unroll
                for (int j = 0; j < 4; ++j) { y0[j] *= gv[j] / (1.0f + __expf(-gv[j])); y1[j] *= gv[4 + j] / (1.0f + __expf(-gv[4 + j])); }
                *(u32x4*)(yret + qrow * RET_V + c0 + 8 * q) = pack_bf16x8(y0, y1); } }
    }
}

constexpr size_t AUX_S5E = 64 * MiB;
constexpr int S5L = 256, S5NC = SEQ / S5L;
__device__ __forceinline__ void cmul_add(float& rr, float& ri, float ar, float ai, float xr, float xi, float cr, float ci) { rr = ar * xr - ai * xi + cr; ri = ar * xi + ai * xr + ci; }
template <bool OUT>
__device__ __forceinline__ void phase_s5_scan(const Frame& F, KP p) {
    const bf16* X = (const bf16*)(F.ws + WS_XB); float* E = (float*)(F.ws + WS_AUX + AUX_S5E); bf16* ybuf = (bf16*)(F.ws + WS_AUX);
    const int lane = F.lane, w = F.wave, g4 = lane >> 4, l15 = lane & 15;
    LAS bf16* ut = (LAS bf16*)(F.lds + w * 12288);
    LAS bf16* Hb = (LAS bf16*)(F.lds + w * 12288 + 4096);
    constexpr int HLD = 136;
    const int gw = F.vcu * NWAVES + w, NGW = F.G * NWAVES;
    const int up16 = (lane - 16) << 2, up32 = (lane - 32) << 2, last16 = (48 + l15) << 2;
    for (int unit = gw; unit < BATCH * SG * S5NC; unit += NGW) {
        const int n = unit & (S5NC - 1), g = (unit >> 5) & 63, b = unit >> 11;
        float a1r[4], a1i[4], a4r[4], a4i[4], a8r[4], a8i[4], pwr[4], pwi[4];
        bf16x8 bfrag[8];
        const float dt = expf(gin(p, 14)[g]);
#pragma unroll
        for (int st = 0; st < 4; ++st) { const int ps = 16 * st + l15;
            const float are = gin(p, 7)[g * SP + ps], aim = gin(p, 8)[g * SP + ps];
            const float mag = expf(dt * are); const float abr = mag * cosf(dt * aim), abi = mag * sinf(dt * aim);
            const float den = are * are + aim * aim;
            const float fre = ((abr - 1.0f) * are + abi * aim) / den, fim = (abi * are - (abr - 1.0f) * aim) / den;
            a1r[st] = abr; a1i[st] = abi; { float t2r, t2i; cmul_add(t2r, t2i, abr, abi, abr, abi, 0.f, 0.f); cmul_add(a4r[st], a4i[st], t2r, t2i, t2r, t2i, 0.f, 0.f); }
            cmul_add(a8r[st], a8i[st], a4r[st], a4i[st], a4r[st], a4i[st], 0.f, 0.f);
            float qr = 1.f, qi = 0.f;
            if (g4 & 1) { qr = a4r[st]; qi = a4i[st]; }
            if (g4 & 2) { float tr, ti; cmul_add(tr, ti, qr, qi, a8r[st], a8i[st], 0.f, 0.f); qr = tr; qi = ti; }
            pwr[st] = qr; pwi[st] = qi;
            const float* br = gin(p, 9) + ((size_t)g * SP + ps) * SGC + 8 * (g4 & 1); const float* bi = gin(p, 10) + ((size_t)g * SP + ps) * SGC + 8 * (g4 & 1);
            const f32x4 r0 = *(const f32x4*)br, r1 = *(const f32x4*)(br + 4), i0 = *(const f32x4*)bi, i1 = *(const f32x4*)(bi + 4);
            const float z = (g4 < 2) ? 1.0f : 0.0f; const float fr2 = fre * z, fi2 = fim * z;
            bfrag[st] = pack8(r0 * fr2 - i0 * fi2, r1 * fr2 - i1 * fi2); bfrag[st + 4] = pack8(i0 * fr2 + r0 * fi2, i1 * fr2 + r1 * fi2);
        }
        float sr[4], si[4];
        float* Eu = E + ((size_t)(b * SG + g) * S5NC + n) * 128;
        bf16x8 cf[4]; f32x4 dsk = (f32x4){0.f, 0.f, 0.f, 0.f};
#pragma unroll
        for (int st = 0; st < 4; ++st) { sr[st] = 0.f; si[st] = 0.f; }
        if (OUT) {
#pragma unroll
            for (int st = 0; st < 4; ++st) { sr[st] = Eu[16 * st + l15]; si[st] = Eu[64 + 16 * st + l15]; }
#pragma unroll
            for (int s = 0; s < 4; ++s) { const float* cp = (s < 2 ? gin(p, 11) : gin(p, 12)) + ((size_t)g * SGC + l15) * SP + 32 * (s & 1) + 8 * g4; const float sg = s < 2 ? 1.0f : -1.0f;
                const f32x4 c0 = *(const f32x4*)cp * sg, c1 = *(const f32x4*)(cp + 4) * sg; cf[s] = pack8(c0, c1); }
            dsk = *(const f32x4*)(gin(p, 13) + g * SGC + 4 * g4); }
        const size_t tok0 = (size_t)b * SEQ + (size_t)n * S5L;
        u32x4 pre[2];
        { const bf16* src = X + (tok0 + lane) * D + g * SGC; pre[0] = *(const u32x4*)src; pre[1] = *(const u32x4*)(src + 8); }
        for (int sub = 0; sub < S5L / 64; ++sub) {
            *(LAS u32x4*)(ut + lane * 16) = pre[0]; *(LAS u32x4*)(ut + lane * 16 + 8) = pre[1];
            if (sub + 1 < S5L / 64) { const bf16* src = X + (tok0 + (sub + 1) * 64 + lane) * D + g * SGC; pre[0] = *(const u32x4*)src; pre[1] = *(const u32x4*)(src + 8); }
            LDS_WAIT(); asm volatile("" ::: "memory");
#pragma unroll 1
            for (int blk = 0; blk < 4; ++blk) {
                u32x4 uw = *(const LAS u32x4*)(ut + (blk * 16 + l15) * 16 + 8 * (g4 & 1));
                if (g4 >= 2) uw = (u32x4){0u, 0u, 0u, 0u};
                const bf16x8 ufr = __builtin_bit_cast(bf16x8, uw);
                f32x4 dr[4], di[4];
#pragma unroll
                for (int st = 0; st < 4; ++st) { dr[st] = MFMA16(ufr, bfrag[st], ((f32x4){0.f, 0.f, 0.f, 0.f})); di[st] = MFMA16(ufr, bfrag[st + 4], ((f32x4){0.f, 0.f, 0.f, 0.f})); }
                float vr[4], vi[4];
#pragma unroll
                for (int st = 0; st < 4; ++st) {
                    float hr = 0.f, hi = 0.f;
#pragma unroll
                    for (int i = 0; i < 4; ++i) { float nr, ni; cmul_add(nr, ni, a1r[st], a1i[st], hr, hi, dr[st][i], di[st][i]); hr = nr; hi = ni; dr[st][i] = hr; di[st][i] = hi; }
                    vr[st] = hr; vi[st] = hi; }
#define BPF(idx, v) __builtin_bit_cast(float, __builtin_amdgcn_ds_bpermute((idx), __builtin_bit_cast(int, (v))))
                { float xr[4], xi[4];
#pragma unroll
                  for (int st = 0; st < 4; ++st) { xr[st] = BPF(up16, vr[st]); xi[st] = BPF(up16, vi[st]); }
#pragma unroll
                  for (int st = 0; st < 4; ++st) { float tr, ti; cmul_add(tr, ti, a4r[st], a4i[st], xr[st], xi[st], vr[st], vi[st]); if (g4 >= 1) { vr[st] = tr; vi[st] = ti; } }
#pragma unroll
                  for (int st = 0; st < 4; ++st) { xr[st] = BPF(up32, vr[st]); xi[st] = BPF(up32, vi[st]); }
#pragma unroll
                  for (int st = 0; st < 4; ++st) { float tr, ti; cmul_add(tr, ti, a8r[st], a8i[st], xr[st], xi[st], vr[st], vi[st]); if (g4 >= 2) { vr[st] = tr; vi[st] = ti; } } }
                float er[4], ei[4], lr[4], li[4];
#pragma unroll
                for (int st = 0; st < 4; ++st) { er[st] = BPF(up16, vr[st]); ei[st] = BPF(up16, vi[st]); lr[st] = BPF(last16, vr[st]); li[st] = BPF(last16, vi[st]); }
#undef BPF
#pragma unroll
                for (int st = 0; st < 4; ++st) {
                    if (g4 == 0) { er[st] = 0.f; ei[st] = 0.f; }
                    float s0r, s0i; cmul_add(s0r, s0i, pwr[st], pwi[st], sr[st], si[st], er[st], ei[st]);
#pragma unroll
                    for (int i = 0; i < 4; ++i) { float tr, ti; cmul_add(tr, ti, a1r[st], a1i[st], s0r, s0i, 0.f, 0.f); s0r = tr; s0i = ti; dr[st][i] += s0r; di[st][i] += s0i; }
                    { float a16r, a16i; cmul_add(a16r, a16i, a8r[st], a8i[st], a8r[st], a8i[st], 0.f, 0.f); float tr, ti; cmul_add(tr, ti, a16r, a16i, sr[st], si[st], lr[st], li[st]); sr[st] = tr; si[st] = ti; }
                    if (OUT) {
#pragma unroll
                        for (int i = 0; i < 4; ++i) { const unsigned hw = pk2(dr[st][i], di[st][i]); Hb[(4 * g4 + i) * HLD + 16 * st + l15] = (bf16)hw; Hb[(4 * g4 + i) * HLD + 64 + 16 * st + l15] = (bf16)(hw >> 16); } }
                }
                if (OUT) {
                    LDS_WAIT(); asm volatile("" ::: "memory");
                    f32x4 ya = (f32x4){0.f, 0.f, 0.f, 0.f};
#pragma unroll
                    for (int s = 0; s < 4; ++s) ya = MFMA16(cf[s], row_frag(Hb, HLD, 0, 32 * s, lane), ya);
                    const u32x2 u2 = *(const LAS u32x2*)(ut + (blk * 16 + l15) * 16 + 4 * g4);
                    const f32x4 u4 = (f32x4){bflo(u2.x), bfhi(u2.x), bflo(u2.y), bfhi(u2.y)};
                    f32x4 y = ya + dsk * u4;
#pragma unroll
                    for (int j = 0; j < 4; ++j) { const float v = y[j]; y[j] = v / (1.0f + __expf(-1.5957691216057308f * (v + 0.044715f * v * v * v))); }
                    u32x2 o; o.x = pk2(y[0], y[1]); o.y = pk2(y[2], y[3]);
                    *(u32x2*)(ybuf + (tok0 + sub * 64 + blk * 16 + l15) * D + g * SGC + 4 * g4) = o;
                    asm volatile("" ::: "memory"); }
            }
            LDS_WAIT(); asm volatile("" ::: "memory");
        }
        if (!OUT && g4 == 0) {
#pragma unroll
            for (int st = 0; st < 4; ++st) { Eu[16 * st + l15] = sr[st]; Eu[64 + 16 * st + l15] = si[st]; } }
    }
}
__device__ __forceinline__ void phase_s5_carry(const Frame& F, KP p) {
    float* E = (float*)(F.ws + WS_AUX + AUX_S5E);
    for (int gt = F.vcu * NTHREADS + F.tid; gt < BATCH * SG * SP; gt += F.G * NTHREADS) {
        const int pl = gt & 63, bg = gt >> 6, g = bg & 63;
        const float dt = expf(gin(p, 14)[g]); const float are = gin(p, 7)[g * SP + pl], aim = gin(p, 8)[g * SP + pl];
        const float mag = expf(dt * are); float ar = mag * cosf(dt * aim), ai = mag * sinf(dt * aim);
#pragma unroll
        for (int q = 0; q < 8; ++q) { const float nr = ar * ar - ai * ai, ni = 2.0f * ar * ai; ar = nr; ai = ni; }
        float cr = 0.f, ci = 0.f;
        for (int n = 0; n < S5NC; ++n) { float* Eu = E + ((size_t)bg * S5NC + n) * 128; const float er = Eu[pl], ei = Eu[64 + pl];
            Eu[pl] = cr; Eu[64 + pl] = ci;
            const float nr = ar * cr - ai * ci + er, ni = ar * ci + ai * cr + ei; cr = nr; ci = ni; }
    }
}

constexpr int NPHASES = 34;
#ifndef PROBE_DRY14
#define PROBE_DRY14 0
#endif
#ifndef PROBE_DRY17
#define PROBE_DRY17 0
#endif
#ifndef PH_MASK
#define PH_MASK 0xFFFFFFFFu
#endif
#define PHT(t) ((PH_MASK >> (t)) & 1u)
constexpr int PLAN_OFF = 64;
__device__ __forceinline__ void moe_plan(const Frame& F, int layer) {
    volatile LAS int* tstart = (volatile LAS int*)(F.MISC + PLAN_OFF); volatile LAS int* cnts = tstart + 72;
    __syncthreads();
    if (F.wave == 0) {
        const unsigned* cnt = (const unsigned*)(F.ws + WS_CTL) + CW_CNT + layer * NE * 64;
        const int c = (int)__hip_atomic_load(cnt + F.lane * 64, __ATOMIC_RELAXED, __HIP_MEMORY_SCOPE_AGENT);
        int v = (c + 255) >> 8;
#pragma unroll
        for (int o = 1; o < 64; o <<= 1) { const int nb = __builtin_amdgcn_ds_bpermute((F.lane - o) << 2, v); if (F.lane >= o) v += nb; }
        tstart[F.lane + 1] = v; cnts[F.lane] = c;
        if (F.lane == 0) tstart[0] = 0;
        if (F.lane == 63) { tstart[65] = v + T / 256; cnts[64] = T; }
    }
    __syncthreads();
}
template <bool GATH> struct MoeSched2 {
    static constexpr bool GATHER = GATH, UNIFORMIZE = true;
    static constexpr int ncol = GATH ? 2 : 4, K = GATH ? D : ED;
    const volatile LAS int* tstart; const volatile LAS int* cnts; int ntiles, G, c, lane;
    const char* Abase; const char* Wbase; const int* lists;
    __device__ __forceinline__ bool next(int i, pg8::UnitG& u) const {
        const int nwg = ntiles * ncol; const long L = (long)i * G + c; if (L >= nwg) return false;
        int wgid = (int)L; { const int q = nwg / 8, r = nwg % 8, xcd = wgid % 8, off = wgid / 8; wgid = (xcd < r ? xcd * (q + 1) : r * (q + 1) + (xcd - r) * q) + off; }
        const int tile = wgid / ncol, pn = wgid % ncol;
        const int ta = tstart[lane], tb = tstart[lane + 1];
        const unsigned long long mm = __ballot(ta <= tile && tile < tb);
        const int e = mm ? (int)__builtin_ctzll(mm) : 64;
        const int ts = __builtin_amdgcn_readfirstlane((int)tstart[e]), ce = __builtin_amdgcn_readfirstlane((int)cnts[e]);
        const int lt = tile - ts; int valid = ce - lt * 256; valid = valid > 256 ? 256 : valid;
        u.gshift = 0; u.aux = e;
        if (GATH) {
            u.B = Wbase + (size_t)e * WMOE_E_BYTES + (size_t)pn * 256 * K * 2;
            if (e < 64) { u.A = Abase; u.gidx = lists + (size_t)e * T + lt * 256; u.gcnt = valid; }
            else { u.A = Abase + (size_t)lt * 256 * K * 2; u.gidx = nullptr; u.gcnt = 0; }
            u.row0 = tile * 256; u.col0 = pn * 128;
        } else {
            u.B = Wbase + (size_t)e * WMOE_E_BYTES + (size_t)512 * 1024 * 2 + (size_t)pn * 256 * K * 2;
            u.A = Abase + (size_t)tile * 256 * K * 2; u.gidx = nullptr; u.gcnt = valid;
            u.row0 = tile * 256; u.col0 = pn * 256;
        }
        return true;
    }
};
__device__ __forceinline__ void phase_load_x(const Frame& F, KP p) {
    const float* xin = gin(p, 0); bf16* XB = (bf16*)(F.ws + WS_XB);
    for (size_t i = (size_t)F.vcu * NTHREADS + F.tid; i < (size_t)T * D / 8; i += (size_t)F.G * NTHREADS) {
        const f32x4 a = *(const f32x4*)(xin + i * 8), b = *(const f32x4*)(xin + i * 8 + 4);
        *(u32x4*)(XB + i * 8) = pack_bf16x8(a, b); }
}

__global__ void __launch_bounds__(NTHREADS, 2) fwd_kernel(Params p_unused) {
    KP p0 = (KP)__builtin_amdgcn_kernarg_segment_ptr();
    extern __shared__ __attribute__((aligned(16))) unsigned char lds_raw[];
    Frame F0;
    F0.lds = (LAS unsigned char*)lds_raw; F0.MISC = (volatile LAS unsigned*)(F0.lds + MISC_OFF);
    F0.tid = threadIdx.x; F0.lane = F0.tid & 63; F0.wave = __builtin_amdgcn_readfirstlane(F0.tid >> 6);
    F0.G = gridDim.x; { const int bq = blockIdx.x; F0.vcu = (F0.G % 8 == 0) ? (bq % 8) * (F0.G / 8) + bq / 8 : bq; }
    F0.ws = p0->ws;
    const int bx0 = blockIdx.x;
    for (int u = F0.tid; u < (LDS_BYTES - MISC_OFF) / 4; u += NTHREADS) ((LAS unsigned*)(F0.lds + MISC_OFF))[u] = 0u;
    __syncthreads();
    XcdBarrier bar; bar.bar = (unsigned*)(p0->ws + WS_CTL) + CW_BAR; bar.x = 0; bar.st = nullptr;
    const int use_bar = p0->use_bar;
    if (use_bar) bar = xcd_barrier_post((unsigned*)(p0->ws + WS_CTL) + CW_BAR, F0.MISC + 8);
    const int lo = p0->ph_lo, hi = p0->ph_hi;
#define PHASE_BEGIN Frame F = F0; KP p = p0; asm volatile("" : "+v"(F.tid), "+v"(F.lane)); GAS unsigned char* wsg_ = (GAS unsigned char*)F0.ws; asm volatile("" : "+s"(F.wave), "+s"(F.vcu), "+s"(F.G), "+s"(wsg_), "+s"(p)); \
    F.ws = (unsigned char*)wsg_; int bx = bx0; asm volatile("" : "+s"(bx)); unsigned char* ws = F.ws; (void)ws; (void)bx;
#pragma unroll 1
    for (int ph = lo; ph < hi; ++ph) {
        int layer = 0, type = 0;
        if (ph > 0) { layer = ph >= 26 ? 3 : (ph >= 18 ? 2 : (ph >= 9 ? 1 : 0)); const int q = ph - (layer == 3 ? 26 : (layer == 2 ? 18 : (layer == 1 ? 9 : 1))); const int kind = layer % 3;
            if (kind == 0) type = q < 4 ? 1 + q : 14 + (q - 4); else if (kind == 1) type = q < 5 ? 5 + q : 14 + (q - 5); else type = q < 4 ? 10 + q : 14 + (q - 4); }
        const int j = layer / 3;
#ifdef REPEAT_MASK
        const int nrep = ((REPEAT_MASK >> type) & 1u) ? 2 : 1;
#else
        const int nrep = 1;
#endif
#pragma unroll 1
        for (int rep = 0; rep < nrep; ++rep) {
        if (rep > 0 && use_bar) xcd_barrier(bar);
        if (PHT(0) && type == 0) { PHASE_BEGIN; phase_conv_mixers(F, p); phase_conv_moe(F, p, 0); phase_load_x(F, p); }
        else if (PHT(1) && type == 1) { PHASE_BEGIN; DenseSched S; S.init(ws + WS_XB, ws + WS_ATT_IN_T + (size_t)j * ATT_IN * D * 2, T, ATT_IN, D, F.G, bx); EpiStoreBf16 E{(bf16*)(ws + WS_BIG), ATT_IN};
            pg8::gemm_phase(F.lds, F.tid, D, S, E); }
        else if (PHT(2) && type == 2) { PHASE_BEGIN; phase_attn(F, bx); }
        else if (PHT(3) && type == 3) { PHASE_BEGIN; phase_attn_combine(F); }
        else if (PHT(4) && type == 4) { PHASE_BEGIN; DenseSched S; S.init(ws + WS_AUX + AUX_OB, ws + WS_ATT_OUT_T + (size_t)j * D * D * 2, T, D, D, F.G, bx); EpiResid E{(const bf16*)(ws + WS_XB), (bf16*)(ws + WS_Y)};
            pg8::gemm_phase(F.lds, F.tid, D, S, E); }
        else if (PHT(5) && type == 5) { PHASE_BEGIN; DenseSched S; S.init(ws + WS_XB, ws + WS_RET_IN_T, T, RET_IN, D, F.G, bx); EpiRetIn E{(bf16*)(ws + WS_BIG), RET_IN};
            pg8::gemm_phase(F.lds, F.tid, D, S, E); }
        else if (PHT(6) && type == 6) { PHASE_BEGIN; phase_ret_u(F); }
        else if (PHT(7) && type == 7) { PHASE_BEGIN; phase_ret_scan(F); }
        else if (PHT(8) && type == 8) { PHASE_BEGIN; phase_ret_out(F, p); }
        else if (PHT(9) && type == 9) { PHASE_BEGIN; DenseSched S; S.init(ws + WS_BIG + BIG_YRET, ws + WS_RET_OUT_T, T, D, RET_V, F.G, bx); EpiResid E{(const bf16*)(ws + WS_XB), (bf16*)(ws + WS_Y)};
            pg8::gemm_phase(F.lds, F.tid, RET_V, S, E); }
        else if (PHT(10) && type == 10) { PHASE_BEGIN; phase_s5_scan<false>(F, p); }
        else if (PHT(11) && type == 11) { PHASE_BEGIN; phase_s5_carry(F, p); }
        else if (PHT(12) && type == 12) { PHASE_BEGIN; phase_s5_scan<true>(F, p); }
        else if (PHT(13) && type == 13) { PHASE_BEGIN; DenseSched S; S.init(ws + WS_AUX, ws + WS_GLU_T, T, 2 * D, D, F.G, bx); EpiGluResid E{(const bf16*)(ws + WS_XB), (bf16*)(ws + WS_Y)};
            pg8::gemm_phase(F.lds, F.tid, D, S, E); }
        else if (PHT(14) && type == 14) { PHASE_BEGIN; phase_lnr(F, p, layer, PROBE_DRY14 && true); if (PROBE_DRY14) { if (use_bar) xcd_barrier(bar); phase_lnr(F, p, layer, false); } }
        else if (PHT(15) && type == 15) { PHASE_BEGIN; moe_plan(F, layer);
            MoeSched2<true> S; S.tstart = (const volatile LAS int*)(F.MISC + PLAN_OFF); S.cnts = S.tstart + 72; S.ntiles = __builtin_amdgcn_readfirstlane((int)S.tstart[65]); S.G = F.G; S.c = bx; S.lane = F.lane;
            S.Abase = (const char*)(ws + WS_XB); S.Wbase = (const char*)(ws + WS_WMOE); S.lists = (const int*)(ws + WS_LIST);
            EpiMoeUp E{(bf16*)(ws + WS_H)};
            pg8::gemm_phase(F.lds, F.tid, D, S, E); }
        else if (PHT(16) && type == 16) { PHASE_BEGIN; moe_plan(F, layer);
            { MoeSched2<false> S; S.tstart = (const volatile LAS int*)(F.MISC + PLAN_OFF); S.cnts = S.tstart + 72; S.ntiles = __builtin_amdgcn_readfirstlane((int)S.tstart[64]); S.G = F.G; S.c = bx; S.lane = F.lane;
              S.Abase = (const char*)(ws + WS_H); S.Wbase = (const char*)(ws + WS_WMOE); S.lists = (const int*)(ws + WS_LIST);
              EpiStoreFp8 E{(unsigned char*)(ws + WS_BIG), D};
              pg8::gemm_phase(F.lds, F.tid, ED, S, E); }
            { const int sh0 = __builtin_amdgcn_readfirstlane((int)((const volatile LAS int*)(F.MISC + PLAN_OFF))[64]);
              DenseSched S; S.init(ws + WS_H + (size_t)sh0 * 256 * ED * 2, ws + WS_WMOE + (size_t)64 * WMOE_E_BYTES + (size_t)512 * 1024 * 2, T, D, ED, F.G, bx); EpiResid E{(const bf16*)(ws + WS_XB), (bf16*)(ws + WS_Y)};
              pg8::gemm_phase(F.lds, F.tid, ED, S, E); } }
        else if (PHT(17) && type == 17) { PHASE_BEGIN; moe_plan(F, layer); if (PROBE_DRY17) { phase_combine(F, p, layer, true); if (use_bar) xcd_barrier(bar); } phase_combine(F, p, layer); if (layer + 1 < DEPTH) phase_conv_moe(F, p, layer + 1); }
        }
        if (use_bar && ph + 1 < hi) xcd_barrier(bar);
    }
}

#ifndef MK_PER_PHASE
#define MK_PER_PHASE 0
#endif
extern "C" void kernel_launch(void* const* d_in, const int* in_sizes, int n_in, void* d_out, int out_size, void* d_ws, size_t ws_size, hipStream_t stream) {
    static int grid = 0;
    if (grid == 0) {
        if (n_in != 26 || in_sizes[0] != T * D || out_size != T * D || ws_size < WS_END) { fprintf(stderr, "kernel_launch: unexpected shapes / workspace (n_in %d, in0 %d, out %d, ws %zu < %zu)\n", n_in, n_in > 0 ? in_sizes[0] : -1, out_size, ws_size, (size_t)WS_END); grid = -1; return; }
        int dev = 0, cus = 0, per_cu = 0;
        if (hipGetDevice(&dev) != hipSuccess || hipDeviceGetAttribute(&cus, hipDeviceAttributeMultiprocessorCount, dev) != hipSuccess) { grid = -1; return; }
        if (hipFuncSetAttribute((const void*)fwd_kernel, hipFuncAttributeMaxDynamicSharedMemorySize, LDS_BYTES) != hipSuccess) { fprintf(stderr, "kernel_launch: hipFuncSetAttribute failed\n"); grid = -1; return; }
        if (hipOccupancyMaxActiveBlocksPerMultiprocessor(&per_cu, (const void*)fwd_kernel, NTHREADS, LDS_BYTES) != hipSuccess || per_cu < 1) { fprintf(stderr, "kernel_launch: occupancy query says %d blocks per CU\n", per_cu); per_cu = 1; }
        (void)hipGetLastError();
        grid = cus;
    }
    if (grid < 0) return;
    (void)hipMemsetAsync((char*)d_ws + WS_CTL, 0, CTL_ZERO_BYTES, stream);
    Params p{};
    for (int i = 0; i < 26; ++i) p.in[i] = (const float*)d_in[i];
    p.out = (float*)d_out; p.ws = (unsigned char*)d_ws;
#if MK_PER_PHASE
    for (int k = 0; k < NPHASES; ++k) { p.ph_lo = k; p.ph_hi = k + 1; p.use_bar = 0; hipLaunchKernelGGL(fwd_kernel, dim3(grid), dim3(NTHREADS), LDS_BYTES, stream, p); }
#else
    p.ph_lo = 0; p.ph_hi = NPHASES; p.use_bar = 1;
    hipLaunchKernelGGL(fwd_kernel, dim3(grid), dim3(NTHREADS), LDS_BYTES, stream, p);
#endif
}
```

```cpp
#include <hip/hip_runtime.h>
#include <cstdio>
#include <cstdint>

#define LAS __attribute__((address_space(3)))
#define GAS __attribute__((address_space(1)))
typedef unsigned short bf16;
typedef short bf16x8 __attribute__((ext_vector_type(8)));
typedef short bf16x4 __attribute__((ext_vector_type(4)));
typedef float f32x4 __attribute__((ext_vector_type(4)));
typedef float f32x2 __attribute__((ext_vector_type(2)));
typedef unsigned u32x4 __attribute__((ext_vector_type(4)));
typedef unsigned u32x2 __attribute__((ext_vector_type(2)));
typedef GAS unsigned gu32;

constexpr int D = 1024, BATCH = 2, SEQ = 8192, T = BATCH * SEQ, DEPTH = 4;
constexpr int AH = 8, AHD = 128, ATT_IN = 9216;
constexpr int RH = 4, RDK = 256, RDV = 512, RET_IN = 6144, RET_V = 2048, RC = 128, RNC = SEQ / RC;
constexpr int SG = 64, SGC = 16, SP = 64;
constexpr int NE = 64, TOPK = 8, NEG = 8, ED = 256, NSLOT = 9;
constexpr float LN_EPS = 1e-5f;
constexpr float ALPHA = 1.6817928305074292f;
constexpr int NWAVES = 8, NTHREADS = 512;

__device__ __forceinline__ unsigned f2bf(float f) { unsigned u = __builtin_bit_cast(unsigned, f); return (u + 0x7fffu + ((u >> 16) & 1u)) >> 16; }
__device__ __forceinline__ unsigned pk2(float lo, float hi) { unsigned r; asm("s_nop 1\n\tv_cvt_pk_bf16_f32 %0, %1, %2" : "=v"(r) : "v"(lo), "v"(hi)); return r; }
__device__ __forceinline__ unsigned pk2sw(float lo, float hi) { return f2bf(lo) | (f2bf(hi) << 16); }
__device__ __forceinline__ unsigned pk2hw(float lo, float hi) { unsigned r; asm volatile("v_cvt_pk_bf16_f32 %0, %1, %2" : "=v"(r) : "v"(lo), "v"(hi)); return r; }
__device__ __forceinline__ float bf2f(unsigned b) { return __builtin_bit_cast(float, b << 16); }
__device__ __forceinline__ float bflo(unsigned w) { return __builtin_bit_cast(float, w << 16); }
__device__ __forceinline__ float bfhi(unsigned w) { return __builtin_bit_cast(float, w & 0xffff0000u); }
__device__ __forceinline__ float shx(float v, int m, int lane) { return __builtin_bit_cast(float, __builtin_amdgcn_ds_bpermute((lane ^ m) << 2, __builtin_bit_cast(int, v))); }
__device__ __forceinline__ int shx_i(int v, int m, int lane) { return __builtin_amdgcn_ds_bpermute((lane ^ m) << 2, v); }
__device__ __forceinline__ float rdl(float v, int src) { return __builtin_bit_cast(float, __builtin_amdgcn_readlane(__builtin_bit_cast(int, v), src)); }
__device__ __forceinline__ float wave_sum(float v, int lane) {
#pragma unroll
    for (int o = 1; o < 64; o <<= 1) v += shx(v, o, lane);
    return v;
}
#define LDS_WAIT() asm volatile("s_waitcnt lgkmcnt(0)" ::: "memory")
#define VM_WAIT() asm volatile("s_waitcnt vmcnt(0)" ::: "memory")
__device__ __forceinline__ const char* rfl_ptr(const char* p) {
    unsigned long long v = (unsigned long long)p; unsigned lo = __builtin_amdgcn_readfirstlane((unsigned)v), hi = __builtin_amdgcn_readfirstlane((unsigned)(v >> 32));
    return (const char*)(((unsigned long long)hi << 32) | lo);
}
__device__ __forceinline__ bf16x8 row_frag(const LAS bf16* base, int ld, int row0, int col0, int lane) {
    return *(const LAS bf16x8*)(base + (row0 + (lane & 15)) * ld + col0 + 8 * (lane >> 4));
}
__device__ __forceinline__ bf16x4 tr4(const LAS bf16* addr) { return __builtin_amdgcn_ds_read_tr16_b64_v4i16((LAS bf16x4*)addr); }
__device__ __forceinline__ bf16x8 cat8(bf16x4 a, bf16x4 b) { bf16x8 r; r[0] = a[0]; r[1] = a[1]; r[2] = a[2]; r[3] = a[3]; r[4] = b[0]; r[5] = b[1]; r[6] = b[2]; r[7] = b[3]; return r; }
#define MFMA16(a, b, c) __builtin_amdgcn_mfma_f32_16x16x32_bf16((a), (b), (c), 0, 0, 0)
__device__ __forceinline__ bf16x8 pack8(f32x4 a, f32x4 b) {
    u32x4 w; w.x = pk2(a[0], a[1]); w.y = pk2(a[2], a[3]); w.z = pk2(b[0], b[1]); w.w = pk2(b[2], b[3]); return __builtin_bit_cast(bf16x8, w);
}

namespace pg8 {
typedef int v4i_t __attribute__((ext_vector_type(4)));
constexpr int BM = 256, BK = 64, HALF = 128, HTB = HALF * BK * 2, STAGE_BYTES = 8 * HTB;
__device__ __forceinline__ int lds_byte(int r, int c) { const int st = (r >> 4) * 2 + (c >> 5), rr = r & 15, cc = c & 31, ob = rr * 64 + cc * 2; return st * 1024 + (ob ^ (((ob >> 9) & 1) << 5)); }
__device__ __forceinline__ void stage_rc(int b, int& R, int& C) { const int st = b / 1024, sb = b % 1024, swz = sb ^ (((sb >> 9) & 1) << 5); R = (st >> 1) * 16 + swz / 64; C = (st & 1) * 32 + (swz % 64) / 2; }
__device__ __forceinline__ int perm32(int rho) { const int n = rho >> 4, i = rho & 15; return 8 * (i >> 2) + 4 * n + (i & 3); }

struct UnitG {
    const char* A;
    const char* B;
    const int* gidx;
    int gcnt, gshift;
    int row0, col0;
    int aux;
};

__device__ __forceinline__ void uniformize(UnitG& u) { u.A = rfl_ptr(u.A); u.B = rfl_ptr(u.B); u.gidx = (const int*)rfl_ptr((const char*)u.gidx); u.gcnt = __builtin_amdgcn_readfirstlane(u.gcnt); u.gshift = __builtin_amdgcn_readfirstlane(u.gshift);
    u.row0 = __builtin_amdgcn_readfirstlane(u.row0); u.col0 = __builtin_amdgcn_readfirstlane(u.col0); u.aux = __builtin_amdgcn_readfirstlane(u.aux); }
template <class Epi, class Sched>
__device__ __forceinline__ void gemm_phase(LAS unsigned char* lds, const int tid, const int K, const Sched& S, const Epi& E) {
    constexpr bool F8 = Sched::FP8;
    constexpr bool GATHER = Sched::GATHER;
    const int wid = __builtin_amdgcn_readfirstlane(tid >> 6), lane = tid & 63, wr = wid >> 2, wc = wid & 3, fr = lane & 15, fq = lane >> 4;
    const int nt = K / BK;
    constexpr bool P16 = Epi::PERM16;
    unsigned voffB[2], voffB1[2], vA[2][2];
#pragma unroll
    for (int i = 0; i < 2; ++i) { int R, C; stage_rc(tid * 16 + i * 8192, R, C); const int Rb = Epi::PERM ? ((R & ~31) + perm32(R & 31)) : R; voffB[i] = (unsigned)(Rb * K + C) * 2u; voffB1[i] = voffB[i]; vA[0][i] = (unsigned)(R * K + C) * 2u; vA[1][i] = vA[0][i];
        if constexpr (P16) { const int x = R & 31, src = 64 * (R >> 5) + 16 * ((x >> 2) & 3) + 4 * (x >> 4) + (x & 3); voffB[i] = (unsigned)(src * K + C) * 2u; voffB1[i] = (unsigned)((src + 8) * K + C) * 2u; } }
    const size_t kstep = (size_t)(BK * 2);
    const size_t hstep = (size_t)HALF * K * 2;
    const size_t hstepB = P16 ? 0 : hstep;
    const size_t hstepA = GATHER ? 0 : hstep;
    const unsigned ldsw = (unsigned)wid * 1024u;
    const int aoff = F8 ? lds_byte(wr * 64 + fr, fq * 16) : lds_byte(wr * 64 + fr, fq * 8), boff = F8 ? lds_byte(wc * 32 + fr, fq * 16) : lds_byte(wc * 32 + fr, fq * 8);
    LAS u32x4* park = (LAS u32x4*)(lds + STAGE_BYTES) + tid;
#define PG8_SA(b, h) (((b) * 2 + (h)) * HTB)
#define PG8_SB(b, h) ((4 + (b) * 2 + (h)) * HTB)
#define PG8_STAGE(bufoff, gbase, voff) do { _Pragma("unroll") for (int _i = 0; _i < 2; ++_i) { asm volatile("" : "+v"((voff)[_i]));   \
        __builtin_amdgcn_global_load_lds((const unsigned*)((const char*)(gbase) + (voff)[_i]), (LAS unsigned*)(lds + (bufoff) + ldsw + _i * 8192), 16, 0, 0); } } while (0)
    constexpr int FKS = F8 ? 16 : 1024;
#define PG8_LDA(dst, b, h) do { _Pragma("unroll") for (int m = 0; m < 4; ++m) _Pragma("unroll") for (int k = 0; k < 2; ++k) dst[m][k] = *(const LAS bf16x8*)(lds + PG8_SA(b, h) + aoff + m * 2048 + k * FKS); } while (0)
#define PG8_LDB(dst, b, h) do { _Pragma("unroll") for (int n = 0; n < 2; ++n) _Pragma("unroll") for (int k = 0; k < 2; ++k) dst[n][k] = *(const LAS bf16x8*)(lds + PG8_SB(b, h) + boff + n * 2048 + k * FKS); } while (0)
#define PG8_MMA(ai, bj, At, Bt) do { __builtin_amdgcn_s_setprio(1); _Pragma("unroll") for (int m = 0; m < 4; ++m) _Pragma("unroll") for (int n = 0; n < 2; ++n) { \
        if constexpr (F8) { acc[ai][bj][m][n] = __builtin_amdgcn_mfma_scale_f32_16x16x128_f8f6f4(__builtin_shufflevector(__builtin_bit_cast(v4i_t, Bt[n][0]), __builtin_bit_cast(v4i_t, Bt[n][1]), 0, 1, 2, 3, 4, 5, 6, 7), \
                __builtin_shufflevector(__builtin_bit_cast(v4i_t, At[m][0]), __builtin_bit_cast(v4i_t, At[m][1]), 0, 1, 2, 3, 4, 5, 6, 7), acc[ai][bj][m][n], 0, 0, 0, 0x7F7F7F7F, 0, 0x7F7F7F7F); } \
        else { _Pragma("unroll") for (int k = 0; k < 2; ++k) acc[ai][bj][m][n] = __builtin_amdgcn_mfma_f32_16x16x32_bf16(Bt[n][k], At[m][k], acc[ai][bj][m][n], 0, 0, 0); } } __builtin_amdgcn_s_setprio(0); } while (0)
#define PG8_WAIT_V(n) asm volatile("s_waitcnt vmcnt(" #n ")" ::: "memory")
#define PG8_WAIT_L(n) asm volatile("s_waitcnt lgkmcnt(" #n ")" ::: "memory")
#define PG8_BAR __builtin_amdgcn_s_barrier()
#define PG8_SCHED __builtin_amdgcn_sched_barrier(0)
#define PG8_VOFF(u, v00, v01, v10, v11) do { int _R0, _C0, _R1, _C1; stage_rc(tid * 16, _R0, _C0); stage_rc(tid * 16 + 8192, _R1, _C1); int _r00 = _R0, _r01 = _R1, _r10 = HALF + _R0, _r11 = HALF + _R1; \
        if ((u).gidx) { const int _a = _r00 < (u).gcnt ? ((const GAS int*)(u).gidx)[_r00] >> (u).gshift : 0, _b = _r01 < (u).gcnt ? ((const GAS int*)(u).gidx)[_r01] >> (u).gshift : 0, _c = _r10 < (u).gcnt ? ((const GAS int*)(u).gidx)[_r10] >> (u).gshift : 0, _d = _r11 < (u).gcnt ? ((const GAS int*)(u).gidx)[_r11] >> (u).gshift : 0; \
            _r00 = _a; _r01 = _b; _r10 = _c; _r11 = _d; } \
        v00 = (unsigned)(_r00 * K + _C0) * 2u; v01 = (unsigned)(_r01 * K + _C1) * 2u; v10 = (unsigned)(_r10 * K + _C0) * 2u; v11 = (unsigned)(_r11 * K + _C1) * 2u; } while (0)
    UnitG cur, nxt; int ui = 0;
    if (!S.next(0, cur)) return;
    if constexpr (Sched::UNIFORMIZE) uniformize(cur);
    f32x4 acc[2][2][4][2];
#pragma unroll
    for (int a = 0; a < 2; ++a)
#pragma unroll
        for (int b = 0; b < 2; ++b)
#pragma unroll
            for (int m = 0; m < 4; ++m)
#pragma unroll
                for (int n = 0; n < 2; ++n) acc[a][b][m][n] = (f32x4){0.f, 0.f, 0.f, 0.f};
    bf16x8 At[4][2], B0[2][2], B1[2][2];
    if constexpr (GATHER) PG8_VOFF(cur, vA[0][0], vA[0][1], vA[1][0], vA[1][1]);
    const char* cA = cur.A; const char* cB = cur.B;
    PG8_STAGE(PG8_SB(0, 0), cB, voffB); PG8_STAGE(PG8_SB(0, 1), cB + hstepB, voffB1); PG8_STAGE(PG8_SA(0, 0), cA, vA[0]); PG8_STAGE(PG8_SA(0, 1), cA + hstepA, vA[1]);
    if (wr == 1) PG8_BAR;
    PG8_WAIT_V(2); PG8_BAR;
    PG8_STAGE(PG8_SB(1, 0), cB + kstep, voffB); PG8_STAGE(PG8_SA(1, 0), cA + kstep, vA[0]); PG8_STAGE(PG8_SB(1, 1), cB + hstepB + kstep, voffB1);
    PG8_WAIT_V(6); PG8_BAR;
    for (;;) {
        const bool has_next = S.next(ui + 1, nxt);
        if constexpr (Sched::UNIFORMIZE) { if (has_next) uniformize(nxt); }
        const char* nA = cA; const char* nB = cB;
        if (has_next) { nA = nxt.A; nB = nxt.B; }
        if constexpr (GATHER) { u32x4 pv; pv.x = vA[0][0]; pv.y = vA[0][1]; pv.z = vA[1][0]; pv.w = vA[1][1];
            if (has_next) PG8_VOFF(nxt, pv.x, pv.y, pv.z, pv.w);
            *park = pv; }
#pragma unroll 1
        for (int t = 0; t < nt; t += 2) {
            const bool last = (t == nt - 2);
            const char* a1 = cA + (size_t)(t + 1) * kstep;
            const char* a2 = last ? nA : cA + (size_t)(t + 2) * kstep; const char* b2 = last ? nB : cB + (size_t)(t + 2) * kstep;
            const char* a3 = a2 + kstep; const char* b3 = b2 + kstep;
            PG8_LDB(B0, 0, 0); PG8_LDB(B1, 0, 1); PG8_SCHED; PG8_LDA(At, 0, 0); PG8_STAGE(PG8_SA(1, 1), a1 + hstepA, vA[1]);
            PG8_WAIT_V(8); PG8_WAIT_L(0); PG8_BAR; PG8_MMA(0, 0, At, B0); PG8_MMA(0, 1, At, B1); PG8_BAR; PG8_SCHED;
            if constexpr (GATHER) { if (last) { const u32x4 pv = *park; vA[0][0] = pv.x; vA[0][1] = pv.y; vA[1][0] = pv.z; vA[1][1] = pv.w; } }
            PG8_LDA(At, 0, 1); PG8_STAGE(PG8_SB(0, 0), b2, voffB); PG8_STAGE(PG8_SB(0, 1), b2 + hstepB, voffB1); PG8_STAGE(PG8_SA(0, 0), a2, vA[0]);
            PG8_WAIT_V(8); PG8_WAIT_L(0); PG8_BAR; PG8_MMA(1, 0, At, B0); PG8_MMA(1, 1, At, B1); PG8_BAR; PG8_SCHED;
            PG8_LDB(B0, 1, 0); PG8_LDB(B1, 1, 1); PG8_SCHED; PG8_LDA(At, 1, 0); PG8_STAGE(PG8_SA(0, 1), a2 + hstepA, vA[1]);
            PG8_WAIT_V(8); PG8_WAIT_L(0); PG8_BAR; PG8_MMA(0, 0, At, B0); PG8_MMA(0, 1, At, B1); PG8_BAR; PG8_SCHED;
            PG8_LDA(At, 1, 1); PG8_STAGE(PG8_SB(1, 0), b3, voffB); PG8_STAGE(PG8_SB(1, 1), b3 + hstepB, voffB1); PG8_STAGE(PG8_SA(1, 0), a3, vA[0]);
            PG8_WAIT_V(8); PG8_WAIT_L(0); PG8_BAR; PG8_MMA(1, 0, At, B0); PG8_MMA(1, 1, At, B1); PG8_BAR; PG8_SCHED;
        }
        if (wr == 0) PG8_BAR;
        E(acc, cur, wr, wc, fr, fq);
        if (!has_next) break;
#pragma unroll
        for (int a = 0; a < 2; ++a)
#pragma unroll
            for (int b = 0; b < 2; ++b)
#pragma unroll
                for (int m = 0; m < 4; ++m)
#pragma unroll
                    for (int n = 0; n < 2; ++n) acc[a][b][m][n] = (f32x4){0.f, 0.f, 0.f, 0.f};
        cur = nxt; cA = nA; cB = nB; ++ui;
        if (wr == 1) PG8_BAR;
    }
    PG8_WAIT_V(0);
    PG8_BAR;
#undef PG8_SA
#undef PG8_SB
#undef PG8_STAGE
#undef PG8_LDA
#undef PG8_LDB
#undef PG8_MMA
#undef PG8_WAIT_V
#undef PG8_WAIT_L
#undef PG8_BAR
#undef PG8_SCHED
#undef PG8_VOFF
}
}

constexpr size_t MiB = 1u << 20;
constexpr size_t WS_CTL = 0, CTL_ZERO_BYTES = 1 * MiB;
constexpr size_t WS_ATT_IN_T = 1 * MiB;
constexpr size_t WS_ATT_OUT_T = WS_ATT_IN_T + 36 * MiB;
constexpr size_t WS_RET_IN_T = WS_ATT_OUT_T + 4 * MiB;
constexpr size_t WS_RET_OUT_T = WS_RET_IN_T + 12 * MiB;
constexpr size_t WS_GLU_T = WS_RET_OUT_T + 4 * MiB;
constexpr size_t WS_RT_HI = WS_GLU_T + 4 * MiB;
constexpr size_t WS_RT_LO = WS_RT_HI + 512 * 1024;
constexpr size_t WS_WMOE = WS_RT_HI + 1 * MiB;
constexpr size_t WMOE_E_BYTES = (size_t)(512 * 1024 + 1024 * 256) * 2;
constexpr size_t WS_X = WS_WMOE + 98 * MiB;
constexpr size_t WS_Y = WS_X + 64 * MiB;
constexpr size_t WS_XB = WS_Y + 64 * MiB;
constexpr size_t WS_BIG = WS_XB + 32 * MiB;
constexpr size_t WS_AUX = WS_BIG + 288 * MiB;
constexpr size_t WS_H = WS_AUX + 160 * MiB;
constexpr size_t WS_LIST = WS_H + 80 * MiB;
constexpr size_t WS_TRASH = WS_LIST + 8 * MiB;
constexpr size_t WS_END = WS_TRASH + 1 * MiB;
static_assert(WS_END <= 1024 * MiB, "workspace map");
constexpr int CW_BAR = 4096;
constexpr int CW_CNT = 16384;
constexpr int CW_CHK = 65536;
constexpr int HROWS = 163840;

#define XB_TMO      128
#define XB_XCNT(j)  (256  + 64 * (j))
#define XB_XSUB(j)  (1280 + 64 * (j))
#define XB_XGEN(j)  (2304 + 64 * (j))
#define XB_TOP      3328
#define XB_TOPGEN   3392
#define XCD_BAR_WORDS 3456
#define XB_SPIN_CAP (1u << 20)
__device__ __forceinline__ unsigned xb_ld(unsigned* p)              { return __hip_atomic_load(p, __ATOMIC_RELAXED, __HIP_MEMORY_SCOPE_AGENT); }
__device__ __forceinline__ unsigned xb_add(unsigned* p, unsigned v) { return __hip_atomic_fetch_add(p, v, __ATOMIC_RELAXED, __HIP_MEMORY_SCOPE_AGENT); }
__device__ __forceinline__ unsigned xb_xcc_id() { return (unsigned)__builtin_amdgcn_s_getreg((3 << 11) | 20) & 0xFu; }
#define XB_SPIN(cond, bar) do { unsigned _sp = 0; while (cond) { __builtin_amdgcn_s_sleep(1); \
    if ((++_sp & 255u) == 0u) { if (xb_ld(&(bar)[XB_TMO])) break; if (_sp > XB_SPIN_CAP) { atomicAdd(&(bar)[XB_TMO], 1u); break; } } } } while (0)
struct XcdBarrier { unsigned* bar; unsigned x; volatile LAS unsigned* st; };
__device__ __forceinline__ XcdBarrier xcd_barrier_post(unsigned* bar, volatile LAS unsigned* st) {
    XcdBarrier b; b.bar = bar; b.x = xb_xcc_id(); b.st = st;
    if (threadIdx.x == 0) (void)xb_add(&bar[XB_XCNT(b.x)], 1u);
    return b;
}
__device__ __forceinline__ void xcd_barrier_complete(unsigned* bar, unsigned x, unsigned& nloc, unsigned& nx) {
    const unsigned G = gridDim.x * gridDim.y * gridDim.z;
    unsigned sum, cnt, mine, sp = 0u;
    for (;;) {
        sum = 0u; cnt = 0u; mine = 0u;
#pragma unroll
        for (unsigned j = 0; j < 16; ++j) { const unsigned c = xb_ld(&bar[XB_XCNT(j)]); sum += c; cnt += (c > 0u) ? 1u : 0u; mine = (j == x) ? c : mine; }
        if (sum == G) break;
        __builtin_amdgcn_s_sleep(1);
        if ((++sp & 255u) == 0u) { if (xb_ld(&bar[XB_TMO])) break; if (sp > XB_SPIN_CAP) { atomicAdd(&bar[XB_TMO], 1u); break; } }
    }
    nloc = mine > 0u ? mine : 1u; nx = cnt > 0u ? cnt : 1u;
}
__device__ __forceinline__ void xcd_barrier(const XcdBarrier& b) {
    asm volatile("s_waitcnt vmcnt(0)" ::: "memory");
    __syncthreads();
    if (threadIdx.x == 0) {
        unsigned* bar = b.bar;
        __builtin_amdgcn_s_waitcnt(0);
        unsigned nloc = b.st[0], nx = b.st[1];
        if (nloc == 0u) { xcd_barrier_complete(bar, b.x, nloc, nx); b.st[0] = nloc; b.st[1] = nx; }
        const unsigned old = xb_add(&bar[XB_XSUB(b.x)], 1u);
        const unsigned gen = old / nloc;
        if (old + 1u == (gen + 1u) * nloc) {
            __builtin_amdgcn_fence(__ATOMIC_RELEASE, "agent");
            asm volatile("s_waitcnt vmcnt(0)" ::: "memory");
            const unsigned og = xb_add(&bar[XB_TOP], 1u);
            const unsigned tg = og / nx;
            if (og + 1u == (tg + 1u) * nx) xb_add(&bar[XB_TOPGEN], 1u);
            else XB_SPIN(xb_ld(&bar[XB_TOPGEN]) == tg, bar);
            __builtin_amdgcn_fence(__ATOMIC_ACQUIRE, "agent");
            xb_add(&bar[XB_XGEN(b.x)], 1u);
            asm volatile("s_waitcnt vmcnt(0)" ::: "memory");
        } else {
            XB_SPIN(xb_ld(&bar[XB_XGEN(b.x)]) == gen, bar);
            __builtin_amdgcn_fence(__ATOMIC_ACQUIRE, "agent");
            asm volatile("s_waitcnt vmcnt(0)" ::: "memory");
        }
    }
    __syncthreads();
}

constexpr int RING_BYTES = 139264;
constexpr int MISC_OFF = RING_BYTES;
constexpr int LDS_BYTES = 147456;
struct Params {
    const float* in[26]; float* out; unsigned char* ws; int ph_lo, ph_hi; int use_bar, pad;
};
typedef const __attribute__((address_space(4))) Params* KP;
__device__ __forceinline__ const float* gin(KP p, int i) { return (const float*)(const GAS float*)p->in[i]; }
__device__ __forceinline__ float* gout(KP p) { return (float*)(GAS float*)p->out; }
struct Frame {
    LAS unsigned char* lds; volatile LAS unsigned* MISC;
    int tid, lane, wave, vcu, G;
    unsigned char* ws;
};

struct DenseSched {
    static constexpr bool GATHER = false, UNIFORMIZE = false, FP8 = false;
    const char* A; const char* Bt; int K, nM, nN, nwg, G, c;
    __device__ __forceinline__ void init(const void* A_, const void* Bt_, int M, int N, int K_, int G_, int c_) { A = (const char*)A_; Bt = (const char*)Bt_; K = K_; nM = M / 256; nN = N / 256; nwg = nM * nN; G = G_; c = c_; }
    __device__ __forceinline__ bool next(int i, pg8::UnitG& u) const {
        const long L = (long)i * G + c; if (L >= nwg) return false;
        int wgid = (int)L; { const int q = nwg / 8, r = nwg % 8, xcd = wgid % 8, off = wgid / 8; wgid = (xcd < r ? xcd * (q + 1) : r * (q + 1) + (xcd - r) * q) + off; }
        const int nig = 8 * nN, gid = wgid / nig, fm = gid * 8, gsz = (nM - fm) < 8 ? (nM - fm) : 8;
        const int pm = fm + ((wgid % nig) % gsz), pn = (wgid % nig) / gsz;
        u.A = A + (size_t)pm * 256 * K * 2; u.B = Bt + (size_t)pn * 256 * K * 2; u.gidx = nullptr; u.gcnt = 0; u.gshift = 0; u.row0 = pm * 256; u.col0 = pn * 256; u.aux = 0; return true;
    }
};
__device__ __forceinline__ u32x4 pack_bf16x8(const f32x4& v0, const f32x4& v1) { u32x4 w; w.x = pk2hw(v0[0], v0[1]); w.y = pk2hw(v0[2], v0[3]); w.z = pk2hw(v1[0], v1[1]); w.w = pk2hw(v1[2], v1[3]); return w; }

struct EpiStoreBf16 {
    static constexpr bool PERM = true, PERM16 = false;
    bf16* O; int ldc;
    __device__ __forceinline__ void operator()(const f32x4 (&acc)[2][2][4][2], const pg8::UnitG& u, int wr, int wc, int fr, int fq) const {
#pragma unroll
        for (int ai = 0; ai < 2; ++ai)
#pragma unroll
            for (int m = 0; m < 4; ++m) { bf16* rowp = O + (size_t)(u.row0 + ai * 128 + wr * 64 + m * 16 + fr) * ldc + u.col0 + wc * 32 + 8 * fq;
#pragma unroll
                for (int bj = 0; bj < 2; ++bj) *(u32x4*)(rowp + bj * 128) = pack_bf16x8(acc[ai][bj][m][0], acc[ai][bj][m][1]); }
    }
};
constexpr float YEXP_SCALE = 32.0f, YEXP_INV = 1.0f / 32.0f;
struct EpiStoreFp8 {
    static constexpr bool PERM = false, PERM16 = true;
    unsigned char* O; int ldc;
    __device__ __forceinline__ void operator()(const f32x4 (&acc)[2][2][4][2], const pg8::UnitG& u, int wr, int wc, int fr, int fq) const {
#pragma unroll
        for (int ai = 0; ai < 2; ++ai)
#pragma unroll
            for (int m = 0; m < 4; ++m) { unsigned char* rowp = O + (size_t)(u.row0 + ai * 128 + wr * 64 + m * 16 + fr) * ldc + u.col0 + wc * 64 + 16 * fq;
                u32x4 w;
#pragma unroll
                for (int q = 0; q < 4; ++q) { f32x4 v = acc[ai][q >> 1][m][q & 1] * YEXP_SCALE;
#pragma unroll
                    for (int j = 0; j < 4; ++j) v[j] = fminf(fmaxf(v[j], -448.0f), 448.0f);
                    int d = 0; d = __builtin_amdgcn_cvt_pk_fp8_f32(v[0], v[1], d, false); d = __builtin_amdgcn_cvt_pk_fp8_f32(v[2], v[3], d, true); w[q] = (unsigned)d; }
                *(u32x4*)rowp = w; }
    }
};
struct EpiRetIn {
    static constexpr bool PERM = true, PERM16 = false;
    bf16* O; int ldc;
    __device__ __forceinline__ void operator()(const f32x4 (&acc)[2][2][4][2], const pg8::UnitG& u, int wr, int wc, int fr, int fq) const {
        float l2g = 0.f;
        if (u.col0 < 2048) { const int h = (u.col0 & 1023) >> 8; const float g = 1.0f - exp2f(-5.0f - (float)h); l2g = log2f(g); if (u.col0 >= 1024) l2g = -l2g; }
#pragma unroll
        for (int ai = 0; ai < 2; ++ai)
#pragma unroll
            for (int m = 0; m < 4; ++m) { const int row = u.row0 + ai * 128 + wr * 64 + m * 16 + fr; const float sc = exp2f(l2g * (float)(row & 127));
                bf16* rowp = O + (size_t)row * ldc + u.col0 + wc * 32 + 8 * fq;
#pragma unroll
                for (int bj = 0; bj < 2; ++bj) *(u32x4*)(rowp + bj * 128) = pack_bf16x8(acc[ai][bj][m][0] * sc, acc[ai][bj][m][1] * sc); }
    }
};
__device__ __forceinline__ void unpack_bf16x8(const u32x4& w, f32x4& a, f32x4& b) { a[0] = bflo(w.x); a[1] = bfhi(w.x); a[2] = bflo(w.y); a[3] = bfhi(w.y); b[0] = bflo(w.z); b[1] = bfhi(w.z); b[2] = bflo(w.w); b[3] = bfhi(w.w); }
struct EpiResid {
    static constexpr bool PERM = true, PERM16 = false;
    const bf16* X; bf16* Y;
    __device__ __forceinline__ void operator()(const f32x4 (&acc)[2][2][4][2], const pg8::UnitG& u, int wr, int wc, int fr, int fq) const {
#pragma unroll
        for (int ai = 0; ai < 2; ++ai)
#pragma unroll
            for (int m = 0; m < 4; ++m) { const size_t off = (size_t)(u.row0 + ai * 128 + wr * 64 + m * 16 + fr) * D + u.col0 + wc * 32 + 8 * fq;
#pragma unroll
                for (int bj = 0; bj < 2; ++bj) { const u32x4 xw = *(const u32x4*)(X + off + bj * 128); f32x4 x0, x1; unpack_bf16x8(xw, x0, x1);
                    *(u32x4*)(Y + off + bj * 128) = pack_bf16x8(x0 * ALPHA + acc[ai][bj][m][0], x1 * ALPHA + acc[ai][bj][m][1]); }
                if (m == 3) asm volatile("" ::: "memory"); }
    }
};
struct EpiGluResid {
    static constexpr bool PERM = true, PERM16 = false;
    const bf16* X; bf16* Y;
    __device__ __forceinline__ void operator()(const f32x4 (&acc)[2][2][4][2], const pg8::UnitG& u, int wr, int wc, int fr, int fq) const {
#pragma unroll
        for (int ai = 0; ai < 2; ++ai)
#pragma unroll
            for (int m = 0; m < 4; ++m) { const size_t off = (size_t)(u.row0 + ai * 128 + wr * 64 + m * 16 + fr) * D + (u.col0 >> 1) + wc * 32 + 8 * fq;
                const u32x4 xw = *(const u32x4*)(X + off); f32x4 x0, x1; unpack_bf16x8(xw, x0, x1); f32x4 o0, o1;
#pragma unroll
                for (int j = 0; j < 4; ++j) { o0[j] = x0[j] * ALPHA + acc[ai][0][m][0][j] / (1.0f + __expf(-acc[ai][1][m][0][j])); o1[j] = x1[j] * ALPHA + acc[ai][0][m][1][j] / (1.0f + __expf(-acc[ai][1][m][1][j])); }
                *(u32x4*)(Y + off) = pack_bf16x8(o0, o1);
                if (m == 3) asm volatile("" ::: "memory"); }
    }
};
constexpr float WUP_SCALE = 32.0f, WUP_INV = 1.0f / 32.0f;
struct EpiMoeUp {
    static constexpr bool PERM = true, PERM16 = false;
    bf16* H;
    __device__ __forceinline__ void operator()(const f32x4 (&acc)[2][2][4][2], const pg8::UnitG& u, int wr, int wc, int fr, int fq) const {
#pragma unroll
        for (int ai = 0; ai < 2; ++ai)
#pragma unroll
            for (int m = 0; m < 4; ++m) { bf16* rowp = H + (size_t)(u.row0 + ai * 128 + wr * 64 + m * 16 + fr) * ED + u.col0 + wc * 32 + 8 * fq; f32x4 o[2];
#pragma unroll
                for (int n = 0; n < 2; ++n)
#pragma unroll
                    for (int j = 0; j < 4; ++j) { const float g = acc[ai][0][m][n][j] * WUP_INV, up = acc[ai][1][m][n][j] * WUP_INV; o[n][j] = g / (1.0f + __expf(-g)) * up; }
                *(u32x4*)rowp = pack_bf16x8(o[0], o[1]); }
    }
};

__device__ __forceinline__ unsigned pk4_fp8(float a, float b, float c, float d) {
    a = fminf(fmaxf(a, -448.0f), 448.0f); b = fminf(fmaxf(b, -448.0f), 448.0f); c = fminf(fmaxf(c, -448.0f), 448.0f); d = fminf(fmaxf(d, -448.0f), 448.0f);
    int w = 0; w = __builtin_amdgcn_cvt_pk_fp8_f32(a, b, w, false); w = __builtin_amdgcn_cvt_pk_fp8_f32(c, d, w, true); return (unsigned)w; }
template <bool HILO>
__device__ __forceinline__ void conv_item(const float* W, int ldw, bf16* WT, bf16* WTlo, int ldk, int k0, int n0, int drow0, float scale, LAS float* scr, int lane) {
#pragma unroll 8
    for (int i = 0; i < 32; ++i) { const int kk = 2 * i + (lane >> 5); scr[kk * 33 + (lane & 31)] = W[(size_t)(k0 + kk) * ldw + n0 + (lane & 31)] * scale; }
    LDS_WAIT(); asm volatile("" ::: "memory");
    const int c = lane & 7;
#pragma unroll
    for (int j = 0; j < 4; ++j) { const int n = (lane >> 3) + 8 * j; const LAS float* s = scr + (8 * c) * 33 + n;
        float v[8];
#pragma unroll
        for (int q = 0; q < 8; ++q) v[q] = s[q * 33];
        u32x4 o; o.x = pk2(v[0], v[1]); o.y = pk2(v[2], v[3]); o.z = pk2(v[4], v[5]); o.w = pk2(v[6], v[7]);
        *(u32x4*)(WT + (size_t)(drow0 + n) * ldk + k0 + 8 * c) = o;
        if (HILO) { float r[8];
#pragma unroll
            for (int q = 0; q < 8; ++q) r[q] = v[q] - bf2f(f2bf(v[q]));
            u32x4 o2; o2.x = pk2(r[0], r[1]); o2.y = pk2(r[2], r[3]); o2.z = pk2(r[4], r[5]); o2.w = pk2(r[6], r[7]);
            *(u32x4*)(WTlo + (size_t)(drow0 + n) * ldk + k0 + 8 * c) = o2; } }
    LDS_WAIT(); asm volatile("" ::: "memory");
}
__device__ __forceinline__ void conv_item8(const float* W, int ldw, unsigned char* WT, int ldk, int k0, int n0, int drow0, float scale, LAS float* scr, int lane) {
#pragma unroll 8
    for (int i = 0; i < 32; ++i) { const int kk = 2 * i + (lane >> 5); scr[kk * 33 + (lane & 31)] = W[(size_t)(k0 + kk) * ldw + n0 + (lane & 31)] * scale; }
    LDS_WAIT(); asm volatile("" ::: "memory");
    const int c = lane & 7;
#pragma unroll
    for (int j = 0; j < 4; ++j) { const int n = (lane >> 3) + 8 * j; const LAS float* s = scr + (8 * c) * 33 + n;
        float v[8];
#pragma unroll
        for (int q = 0; q < 8; ++q) v[q] = s[q * 33];
        u32x2 o; o.x = pk4_fp8(v[0], v[1], v[2], v[3]); o.y = pk4_fp8(v[4], v[5], v[6], v[7]);
        *(u32x2*)(WT + (size_t)(drow0 + n) * ldk + k0 + 8 * c) = o; }
    LDS_WAIT(); asm volatile("" ::: "memory");
}
__device__ __forceinline__ void phase_conv_mixers(const Frame& F, KP p) {
    LAS float* scr = (LAS float*)(F.lds + F.wave * 16384);
    const int gw = F.vcu * NWAVES + F.wave, NGW = F.G * NWAVES;
    constexpr int I_AIN = 16 * 288, I_AOUT = 16 * 32, I_RIN = 16 * 192, I_ROUT = 32 * 32, I_GLU = 16 * 64, I_RT = 16 * 2;
    constexpr int NITEMS = 2 * I_AIN + 2 * I_AOUT + I_RIN + I_ROUT + I_GLU + 4 * I_RT;
    unsigned char* ws = F.ws;
    for (int it = gw; it < NITEMS; it += NGW) {
        int r = it;
        if (r < 2 * I_AIN) { const int j = r / I_AIN; r %= I_AIN; const int kb = r / 288, nb = r % 288, n0 = nb * 32;
            conv_item<false>(gin(p, 1) + (size_t)j * D * ATT_IN, ATT_IN, (bf16*)(ws + WS_ATT_IN_T) + (size_t)j * ATT_IN * D, nullptr, D, kb * 64, n0, n0, ((n0 % 3072) < 1024) ? 0.08838834764831845f : 1.0f, scr, F.lane); continue; }
        r -= 2 * I_AIN;
        if (r < 2 * I_AOUT) { const int j = r / I_AOUT; r %= I_AOUT; const int kb = r / 32, nb = r % 32, n0 = nb * 32;
            conv_item<false>(gin(p, 2) + (size_t)j * D * D, D, (bf16*)(ws + WS_ATT_OUT_T) + (size_t)j * D * D, nullptr, D, kb * 64, n0, n0, 1.0f, scr, F.lane); continue; }
        r -= 2 * I_AOUT;
        if (r < I_RIN) { const int kb = r / 192, nb = r % 192, n0 = nb * 32;
            conv_item<false>(gin(p, 3), RET_IN, (bf16*)(ws + WS_RET_IN_T), nullptr, D, kb * 64, n0, n0, (n0 >= 1024 && n0 < 2048) ? 0.0625f : 1.0f, scr, F.lane); continue; }
        r -= I_RIN;
        if (r < I_ROUT) { const int kb = r / 32, nb = r % 32, n0 = nb * 32;
            conv_item<false>(gin(p, 6), D, (bf16*)(ws + WS_RET_OUT_T), nullptr, RET_V, kb * 64, n0, n0, 1.0f, scr, F.lane); continue; }
        r -= I_ROUT;
        if (r < I_GLU) { const int kb = r / 64, nb = r % 64, n0 = nb * 32; const int c = n0 & 1023, drow = (c >> 7) * 256 + (n0 >> 10) * 128 + (c & 127);
            conv_item<false>(gin(p, 15), 2 * D, (bf16*)(ws + WS_GLU_T), nullptr, D, kb * 64, n0, drow, 1.0f, scr, F.lane); continue; }
        r -= I_GLU;
        { const int l = r / I_RT; r %= I_RT; const int kb = r / 2, nb = r % 2, n0 = nb * 32;
            conv_item<true>(gin(p, 16) + (size_t)l * D * NE, NE, (bf16*)(ws + WS_RT_HI) + (size_t)l * NE * D, (bf16*)(ws + WS_RT_LO) + (size_t)l * NE * D, D, kb * 64, n0, n0, 1.0f, scr, F.lane); }
    }
}
__device__ __forceinline__ void phase_conv_moe(const Frame& F, KP p, int l) {
    LAS float* scr = (LAS float*)(F.lds + F.wave * 16384);
    const int gw = F.vcu * NWAVES + F.wave, NGW = F.G * NWAVES;
    for (int it = gw; it < 65 * 384; it += NGW) {
        const int e = it / 384, r = it % 384, which = r >> 7, rr = r & 127;
        bf16* We = (bf16*)(F.ws + WS_WMOE + (size_t)e * WMOE_E_BYTES);
        if (which < 2) { const float* src = (e < 64) ? gin(p, 18 + which) + ((size_t)l * NE + e) * D * ED : gin(p, 21 + which) + (size_t)l * D * ED;
            const int kb = rr >> 3, nb = rr & 7, n0 = nb * 32; const int drow = (n0 >> 7) * 256 + which * 128 + (n0 & 127);
            conv_item8(src, ED, (unsigned char*)We, D, kb * 64, n0, drow, WUP_SCALE, scr, F.lane);
        } else { const float* src = (e < 64) ? gin(p, 20) + ((size_t)l * NE + e) * ED * D : gin(p, 23) + (size_t)l * ED * D;
            const int kb = rr >> 5, nb = rr & 31, n0 = nb * 32;
            conv_item<false>(src, D, We + 512 * 1024, nullptr, ED, kb * 64, n0, n0, 1.0f, scr, F.lane); }
    }
}

__device__ __forceinline__ void phase_lnr(const Frame& F, KP p, int layer, bool dry = false) {
    const bf16* Y = (const bf16*)(F.ws + WS_Y); bf16* XB = (bf16*)(F.ws + WS_XB); unsigned char* XB8 = (unsigned char*)(F.ws + WS_X);
    const float* lng = gin(p, 24) + (size_t)(layer * 2) * D; const float* lnb = gin(p, 25) + (size_t)(layer * 2) * D;
    const bf16* rthi = (const bf16*)(F.ws + WS_RT_HI) + (size_t)layer * NE * D; const bf16* rtlo = (const bf16*)(F.ws + WS_RT_LO) + (size_t)layer * NE * D;
    const float* rbias = gin(p, 17) + layer * NE;
    unsigned* cnt = (unsigned*)(F.ws + WS_CTL) + CW_CNT + layer * NE * 64;
    int* lists = (int*)(F.ws + WS_LIST); int* tokmap = (int*)(F.ws + WS_LIST + 4 * MiB); float* tokgate = (float*)(F.ws + WS_LIST + 5 * MiB);
    constexpr int XLD = 1032, MAXT = 8;
    LAS bf16* Xhi = (LAS bf16*)F.lds; LAS bf16* Xlo = Xhi + 16 * XLD;
    LAS float* part = (LAS float*)(F.lds + 2 * 16 * XLD * 2);
    LAS int* ent = (LAS int*)(part + 2 * 16 * 64);
    LAS int* hist = ent + MAXT * 16 * 8 * 2; LAS int* base = hist + 64;
    const int lane = F.lane, w = F.wave, g4 = lane >> 4, l15 = lane & 15;
    if (F.tid < 64) hist[F.tid] = 0;
    f32x4 gv[4], bv[4];
#pragma unroll
    for (int j = 0; j < 2; ++j) { gv[2 * j] = *(const f32x4*)(lng + 8 * lane + 512 * j); gv[2 * j + 1] = *(const f32x4*)(lng + 8 * lane + 512 * j + 4);
        bv[2 * j] = *(const f32x4*)(lnb + 8 * lane + 512 * j); bv[2 * j + 1] = *(const f32x4*)(lnb + 8 * lane + 512 * j + 4); }
    int ntile = 0;
    for (int tile = F.vcu; tile < T / 16 && ntile < MAXT; tile += F.G, ++ntile) {
        const int t0 = tile * 16;
#pragma unroll
        for (int rr = 0; rr < 2; ++rr) {
            const int lr = 2 * w + rr; const size_t row = (size_t)(t0 + lr);
            f32x4 v[4]; float s = 0.f;
#pragma unroll
            for (int j = 0; j < 2; ++j) { const u32x4 yw = *(const u32x4*)(Y + row * D + 8 * lane + 512 * j); unpack_bf16x8(yw, v[2 * j], v[2 * j + 1]); }
#pragma unroll
            for (int j = 0; j < 4; ++j) s += (v[j][0] + v[j][1]) + (v[j][2] + v[j][3]);
            const float mean = wave_sum(s, lane) * (1.f / D); float s2 = 0.f;
#pragma unroll
            for (int j = 0; j < 4; ++j) { v[j] = v[j] - mean; s2 += (v[j][0] * v[j][0] + v[j][1] * v[j][1]) + (v[j][2] * v[j][2] + v[j][3] * v[j][3]); }
            const float rstd = 1.0f / sqrtf(wave_sum(s2, lane) * (1.f / D) + LN_EPS);
#pragma unroll
            for (int j = 0; j < 2; ++j) { const f32x4 o0 = v[2 * j] * rstd * gv[2 * j] + bv[2 * j], o1 = v[2 * j + 1] * rstd * gv[2 * j + 1] + bv[2 * j + 1];
                const u32x4 hi = pack_bf16x8(o0, o1);
                *(u32x4*)(XB + row * D + 8 * lane + 512 * j) = hi;
                { u32x2 q8; q8.x = pk4_fp8(o0[0], o0[1], o0[2], o0[3]); q8.y = pk4_fp8(o1[0], o1[1], o1[2], o1[3]); *(u32x2*)(XB8 + row * D + 8 * lane + 512 * j) = q8; }
                f32x4 h0, h1; unpack_bf16x8(hi, h0, h1); const u32x4 lo = pack_bf16x8(o0 - h0, o1 - h1);
                *(LAS u32x4*)(Xhi + lr * XLD + 8 * lane + 512 * j) = hi; *(LAS u32x4*)(Xlo + lr * XLD + 8 * lane + 512 * j) = lo; }
        }
        __syncthreads();
        { const int nt = w & 3, kh = w >> 2; f32x4 acc = (f32x4){0.f, 0.f, 0.f, 0.f};
            const bf16* bh = rthi + (size_t)(16 * nt + l15) * D + 512 * kh + 8 * g4; const bf16* bl = rtlo + (size_t)(16 * nt + l15) * D + 512 * kh + 8 * g4;
#pragma unroll 8
            for (int ks = 0; ks < 16; ++ks) { const int k0 = 512 * kh + 32 * ks;
                const bf16x8 ahi = row_frag(Xhi, XLD, 0, k0, lane), alo = row_frag(Xlo, XLD, 0, k0, lane);
                const bf16x8 bhi = *(const bf16x8*)(bh + 32 * ks), blo = *(const bf16x8*)(bl + 32 * ks);
                acc = MFMA16(ahi, bhi, acc); acc = MFMA16(alo, bhi, acc); acc = MFMA16(ahi, blo, acc); }
#pragma unroll
            for (int i = 0; i < 4; ++i) part[(kh * 16 + 4 * g4 + i) * 64 + 16 * nt + l15] = acc[i];
        }
        __syncthreads();
#pragma unroll
        for (int rr = 0; rr < 2; ++rr) {
            const int lt = ntile * 16 + 2 * w + rr;
            const float lg = part[(2 * w + rr) * 64 + lane] + part[(16 + 2 * w + rr) * 64 + lane];
            float sc = 1.0f / (1.0f + expf(-lg)); sc = (sc == sc) ? sc : 0.5f;
            const float sel = sc + rbias[lane];
            float m1 = sel; m1 = fmaxf(m1, shx(m1, 1, lane)); m1 = fmaxf(m1, shx(m1, 2, lane)); m1 = fmaxf(m1, shx(m1, 4, lane));
            const unsigned long long eq = __ballot(sel == m1);
            const unsigned gm = (unsigned)(eq >> (lane & 56)) & 0xffu;
            const int first = (lane & 56) + __builtin_ctz(gm | 0x100u);
            float m2 = (lane == first) ? -INFINITY : sel; m2 = fmaxf(m2, shx(m2, 1, lane)); m2 = fmaxf(m2, shx(m2, 2, lane)); m2 = fmaxf(m2, shx(m2, 4, lane));
            const float gs = m1 + m2; const int mygrp = lane >> 3; int grank = 0;
#pragma unroll
            for (int gg = 0; gg < 8; ++gg) { const float o = rdl(gs, 8 * gg); grank += (o > gs || (o == gs && gg < mygrp)) ? 1 : 0; }
            const float mv = (grank < 4) ? sel : -INFINITY; int rank = 0;
#pragma unroll
            for (int e2 = 0; e2 < 64; ++e2) { const float o = rdl(mv, e2); rank += (o > mv || (o == mv && e2 < lane)) ? 1 : 0; }
            const bool chosen = rank < TOPK;
            const float wsum = wave_sum(chosen ? sc : 0.f, lane);
            if (chosen) { const int lpos = __hip_atomic_fetch_add(hist + lane, 1, __ATOMIC_RELAXED, __HIP_MEMORY_SCOPE_WORKGROUP);
                ent[(lt * 8 + rank) * 2] = (lane << 16) | lpos; ent[(lt * 8 + rank) * 2 + 1] = __builtin_bit_cast(int, sc / wsum * 2.5f); }
        }
    }
    __syncthreads();
    if (dry) return;
    if (F.tid < 64) { const int hcount = hist[F.tid]; base[F.tid] = hcount ? (int)atomicAdd(cnt + F.tid * 64, (unsigned)hcount) : 0; }
    __syncthreads();
    for (int idx = F.tid; idx < ntile * 16 * 8; idx += NTHREADS) {
        const int ev = ent[idx * 2], gb = ent[idx * 2 + 1]; const int e = ev >> 16, pos = base[e] + (ev & 0xffff);
        const int lt = idx >> 3, rank = idx & 7, tok = (F.vcu + (lt >> 4) * F.G) * 16 + (lt & 15);
        lists[(size_t)e * T + pos] = tok; tokmap[tok * 8 + rank] = (e << 16) | pos; tokgate[tok * 8 + rank] = __builtin_bit_cast(float, gb);
    }
}

__device__ __forceinline__ void phase_combine(const Frame& F, KP p, int layer, bool dry = false) {
    bf16* XB = (bf16*)(F.ws + WS_XB); const unsigned char* yexp = (const unsigned char*)(F.ws + WS_BIG);
    const int* tokmap = (const int*)(F.ws + WS_LIST + 4 * MiB); const float* tokgate = (const float*)(F.ws + WS_LIST + 5 * MiB);
    const volatile LAS int* tstart = (const volatile LAS int*)(F.MISC + 64);
    const float* lng = gin(p, 24) + (size_t)(layer * 2 + 1) * D; const float* lnb = gin(p, 25) + (size_t)(layer * 2 + 1) * D;
    float* outp = gout(p); bf16* xbo = XB; if (dry) { outp = (float*)(F.ws + WS_X); xbo = (bf16*)(F.ws + WS_H); }
    const int lane = F.lane, gw = F.vcu * NWAVES + F.wave, NGW = F.G * NWAVES;
    const bf16* ysh = (const bf16*)(F.ws + WS_Y);
    f32x4 gv[4], bv[4];
#pragma unroll
    for (int j = 0; j < 4; ++j) { gv[j] = *(const f32x4*)(lng + 16 * lane + 4 * j); bv[j] = *(const f32x4*)(lnb + 16 * lane + 4 * j); }
    for (int row = gw; row < T; row += NGW) {
        const int mk = tokmap[row * 8 + (lane & 7)]; const float gk = tokgate[row * 8 + (lane & 7)] * YEXP_INV;
        const int rk = (int)tstart[mk >> 16] * 256 + (mk & 0xffff);
        f32x4 v[4];
#pragma unroll
        for (int j = 0; j < 2; ++j) { const u32x4 xw = *(const u32x4*)(ysh + (size_t)row * D + 16 * lane + 8 * j); unpack_bf16x8(xw, v[2 * j], v[2 * j + 1]); }
#pragma unroll
        for (int k = 0; k < TOPK; ++k) { const int r = __builtin_amdgcn_readlane(rk, k); const float g = rdl(gk, k);
            const u32x4 s = *(const u32x4*)(yexp + (size_t)r * D + 16 * lane);
#pragma unroll
            for (int j = 0; j < 4; ++j) { const f32x2 lo = __builtin_amdgcn_cvt_pk_f32_fp8((int)s[j], false), hi = __builtin_amdgcn_cvt_pk_f32_fp8((int)s[j], true);
                v[j][0] += g * lo[0]; v[j][1] += g * lo[1]; v[j][2] += g * hi[0]; v[j][3] += g * hi[1]; } }
        float s = 0.f;
#pragma unroll
        for (int j = 0; j < 4; ++j) s += (v[j][0] + v[j][1]) + (v[j][2] + v[j][3]);
        const float mean = wave_sum(s, lane) * (1.f / D); float s2 = 0.f;
#pragma unroll
        for (int j = 0; j < 4; ++j) { v[j] = v[j] - mean; s2 += (v[j][0] * v[j][0] + v[j][1] * v[j][1]) + (v[j][2] * v[j][2] + v[j][3] * v[j][3]); }
        const float rstd = 1.0f / sqrtf(wave_sum(s2, lane) * (1.f / D) + LN_EPS);
        f32x4 o[4];
#pragma unroll
        for (int j = 0; j < 4; ++j) o[j] = v[j] * rstd * gv[j] + bv[j];
        if (layer == DEPTH - 1 || dry) {
#pragma unroll
            for (int j = 0; j < 4; ++j) *(f32x4*)(outp + (size_t)row * D + 16 * lane + 4 * j) = o[j]; }
        if (layer != DEPTH - 1) { *(u32x4*)(xbo + (size_t)row * D + 16 * lane) = pack_bf16x8(o[0], o[1]); *(u32x4*)(xbo + (size_t)row * D + 16 * lane + 8) = pack_bf16x8(o[2], o[3]); }
    }
}

constexpr size_t AUX_OB = 96 * MiB, AUX_LSE = 128 * MiB;
__device__ __forceinline__ void phase_attn(const Frame& F, int bx) {
    const bf16* qkv = (const bf16*)(F.ws + WS_BIG); bf16* og = (bf16*)(F.ws + WS_AUX); float* lse = (float*)(F.ws + WS_AUX + AUX_LSE);
    constexpr int KLD = 136;
    LAS bf16* Ks = (LAS bf16*)F.lds; LAS bf16* Vs = Ks + 256 * KLD;
    const int lane = F.lane, w = F.wave, g4 = lane >> 4, l15 = lane & 15, qq = l15 >> 2, pp = lane & 3;
    u32x4 kreg[8], vreg[8];
#define ATT_DECODE(L_) const int h = (L_) & 7, sb = (L_) >> 3, g = sb >> 7, rem = sb & 127, b = rem >> 6, rn = rem & 63; \
        const int dsh = 2 * g, d = 1 << dsh, nbs = 6 - dsh, r = rn >> nbs, n = rn & ((1 << nbs) - 1); const size_t rowbase = (size_t)b * SEQ;
#define ATT_ISSUE(L_) do { ATT_DECODE(L_) _Pragma("unroll") for (int it = 0; it < 8; ++it) { const int idx = F.tid + 512 * it, c = idx >> 4, ch = idx & 15; int pos = 128 * (n - 1) + c; pos = pos < 0 ? 0 : pos; \
            const bf16* src = qkv + (rowbase + (size_t)pos * d + r) * ATT_IN + g * 3072 + 1024 + h * 128 + ch * 8; kreg[it] = *(const u32x4*)src; vreg[it] = *(const u32x4*)(src + 1024); } } while (0)
    if (bx < 3072) ATT_ISSUE(bx);
    for (int L = bx; L < 3072; L += F.G) {
        ATT_DECODE(L)
#pragma unroll
        for (int it = 0; it < 8; ++it) { const int idx = F.tid + 512 * it, c = idx >> 4, ch = idx & 15;
            *(LAS u32x4*)(Ks + c * KLD + ch * 8) = kreg[it]; *(LAS u32x4*)(Vs + c * KLD + ch * 8) = vreg[it]; }
        const int qi = 16 * w + l15; const size_t qrow = rowbase + (size_t)(128 * n + qi) * d + r;
        bf16x8 qf[4];
#pragma unroll
        for (int s = 0; s < 4; ++s) qf[s] = *(const bf16x8*)(qkv + qrow * ATT_IN + g * 3072 + h * 128 + 32 * s + 8 * g4);
        __syncthreads();
        if (L + F.G < 3072) { ATT_ISSUE(L + F.G); }
        __builtin_amdgcn_sched_barrier(0);
        const int ws0 = (16 * w < 96) ? 16 * w : 96;
        f32x4 sacc[10];
        {
            bf16x8 kfa[4], kfb[4];
#pragma unroll
            for (int s = 0; s < 4; ++s) kfa[s] = row_frag(Ks, KLD, ws0, 32 * s, lane);
#pragma unroll
            for (int t = 0; t < 10; t += 2) {
#pragma unroll
                for (int s = 0; s < 4; ++s) kfb[s] = row_frag(Ks, KLD, ws0 + 16 * (t + 1), 32 * s, lane);
                __builtin_amdgcn_sched_barrier(0);
                sacc[t] = (f32x4){0.f, 0.f, 0.f, 0.f};
#pragma unroll
                for (int s = 0; s < 4; ++s) sacc[t] = MFMA16(kfa[s], qf[s], sacc[t]);
                if (t + 2 < 10) {
#pragma unroll
                    for (int s = 0; s < 4; ++s) kfa[s] = row_frag(Ks, KLD, ws0 + 16 * (t + 2), 32 * s, lane); }
                __builtin_amdgcn_sched_barrier(0);
                sacc[t + 1] = (f32x4){0.f, 0.f, 0.f, 0.f};
#pragma unroll
                for (int s = 0; s < 4; ++s) sacc[t + 1] = MFMA16(kfb[s], qf[s], sacc[t + 1]);
            }
        }
        const float slope = exp2f(-(float)(h + 1)) * (float)d;
        float mx = -INFINITY;
#pragma unroll
        for (int t = 0; t < 10; ++t)
#pragma unroll
            for (int i = 0; i < 4; ++i) { const int c = ws0 + 16 * t + 4 * g4 + i, step = 128 + qi - c;
                const bool valid = (step >= 0) && (step <= 128) && (n > 0 || c >= 128);
                const float v = valid ? sacc[t][i] - slope * (float)step : -INFINITY; sacc[t][i] = v; mx = fmaxf(mx, v); }
        mx = fmaxf(mx, shx(mx, 16, lane)); mx = fmaxf(mx, shx(mx, 32, lane));
        float lsum = 0.f;
#pragma unroll
        for (int t = 0; t < 10; ++t)
#pragma unroll
            for (int i = 0; i < 4; ++i) { const float pv = __expf(sacc[t][i] - mx); sacc[t][i] = pv; lsum += pv; }
        lsum += shx(lsum, 16, lane); lsum += shx(lsum, 32, lane);
        bf16x8 pf[5];
#pragma unroll
        for (int kt = 0; kt < 5; ++kt) pf[kt] = pack8(sacc[2 * kt], sacc[2 * kt + 1]);
        f32x4 o[8];
        {
            const LAS bf16* vb = Vs + (ws0 + 4 * g4 + qq) * KLD + 32 * pp;
            bf16x4 va[10], vc[10];
#pragma unroll
            for (int kt = 0; kt < 5; ++kt) { va[2 * kt] = tr4(vb + 32 * kt * KLD); va[2 * kt + 1] = tr4(vb + (32 * kt + 16) * KLD); }
#pragma unroll
            for (int et = 0; et < 8; et += 2) {
#pragma unroll
                for (int kt = 0; kt < 5; ++kt) { vc[2 * kt] = tr4(vb + 32 * kt * KLD + 4 * (et + 1)); vc[2 * kt + 1] = tr4(vb + (32 * kt + 16) * KLD + 4 * (et + 1)); }
                __builtin_amdgcn_sched_barrier(0);
                o[et] = (f32x4){0.f, 0.f, 0.f, 0.f};
#pragma unroll
                for (int kt = 0; kt < 5; ++kt) o[et] = MFMA16(cat8(va[2 * kt], va[2 * kt + 1]), pf[kt], o[et]);
                if (et + 2 < 8) {
#pragma unroll
                    for (int kt = 0; kt < 5; ++kt) { va[2 * kt] = tr4(vb + 32 * kt * KLD + 4 * (et + 2)); va[2 * kt + 1] = tr4(vb + (32 * kt + 16) * KLD + 4 * (et + 2)); } }
                __builtin_amdgcn_sched_barrier(0);
                o[et + 1] = (f32x4){0.f, 0.f, 0.f, 0.f};
#pragma unroll
                for (int kt = 0; kt < 5; ++kt) o[et + 1] = MFMA16(cat8(vc[2 * kt], vc[2 * kt + 1]), pf[kt], o[et + 1]);
            }
        }
        const float inv = 1.0f / lsum;
        bf16* orow = og + ((size_t)g * T + qrow) * D + h * 128 + 32 * g4;
#pragma unroll
        for (int e2 = 0; e2 < 4; ++e2) *(u32x4*)(orow + 8 * e2) = pack_bf16x8(o[2 * e2] * inv, o[2 * e2 + 1] * inv);
        if (g4 == 0) lse[((size_t)g * T + qrow) * AH + h] = mx + __logf(lsum);
        __syncthreads();
    }
#undef ATT_DECODE
#undef ATT_ISSUE
}
__device__ __forceinline__ void phase_attn_combine(const Frame& F) {
    const bf16* og = (const bf16*)(F.ws + WS_AUX); const float* lse = (const float*)(F.ws + WS_AUX + AUX_LSE); bf16* ob = (bf16*)(F.ws + WS_AUX + AUX_OB);
    const int lane = F.lane, gw = F.vcu * NWAVES + F.wave, NGW = F.G * NWAVES, h = lane >> 3;
    for (int row = gw; row < T; row += NGW) {
        const float l0 = lse[((size_t)0 * T + row) * AH + h], l1 = lse[((size_t)1 * T + row) * AH + h], l2 = lse[((size_t)2 * T + row) * AH + h];
        const float m = fmaxf(l0, fmaxf(l1, l2)); float w0 = __expf(l0 - m), w1 = __expf(l1 - m), w2 = __expf(l2 - m); const float inv = 1.0f / (w0 + w1 + w2); w0 *= inv; w1 *= inv; w2 *= inv;
        float a[16];
#pragma unroll
        for (int j = 0; j < 16; ++j) a[j] = 0.f;
#pragma unroll
        for (int g = 0; g < 3; ++g) { const float wg = (g == 0) ? w0 : (g == 1 ? w1 : w2);
#pragma unroll
            for (int q = 0; q < 2; ++q) { const u32x4 s = *(const u32x4*)(og + ((size_t)g * T + row) * D + 16 * lane + 8 * q);
                a[8 * q + 0] += wg * bflo(s.x); a[8 * q + 1] += wg * bfhi(s.x); a[8 * q + 2] += wg * bflo(s.y); a[8 * q + 3] += wg * bfhi(s.y);
                a[8 * q + 4] += wg * bflo(s.z); a[8 * q + 5] += wg * bfhi(s.z); a[8 * q + 6] += wg * bflo(s.w); a[8 * q + 7] += wg * bfhi(s.w); } }
#pragma unroll
        for (int q = 0; q < 2; ++q) { u32x4 o; o.x = pk2(a[8 * q], a[8 * q + 1]); o.y = pk2(a[8 * q + 2], a[8 * q + 3]); o.z = pk2(a[8 * q + 4], a[8 * q + 5]); o.w = pk2(a[8 * q + 6], a[8 * q + 7]);
            *(u32x4*)(ob + (size_t)row * D + 16 * lane + 8 * q) = o; }
    }
}

constexpr size_t BIG_YRET = 192 * MiB;
__device__ __forceinline__ void phase_ret_u(const Frame& F) {
    const bf16* proj = (const bf16*)(F.ws + WS_BIG); bf16* St = (bf16*)(F.ws + WS_AUX);
    constexpr int LD = 264;
    LAS bf16* Kt = (LAS bf16*)F.lds; LAS bf16* Vt = Kt + 128 * LD;
    const int lane = F.lane, w = F.wave, g4 = lane >> 4, l15 = lane & 15, qq = l15 >> 2, pp = lane & 3;
    for (int u = F.vcu; u < 1024; u += F.G) {
        const int eh = u & 1, h = (u >> 1) & 3, n = (u >> 3) & 63, b = u >> 9;
        const size_t row0 = (size_t)b * SEQ + (size_t)n * RC;
#pragma unroll 4
        for (int it = 0; it < 8; ++it) { const int idx = F.tid + 512 * it, j = idx >> 5, ch = idx & 31;
            const bf16* src = proj + (row0 + j) * RET_IN;
            const u32x4 kv = *(const u32x4*)(src + 1024 + h * 256 + ch * 8), vv = *(const u32x4*)(src + 2048 + h * 512 + eh * 256 + ch * 8);
            *(LAS u32x4*)(Kt + j * LD + ch * 8) = kv; *(LAS u32x4*)(Vt + j * LD + ch * 8) = vv; }
        __syncthreads();
        f32x4 acc[16][2];
#pragma unroll
        for (int mt = 0; mt < 16; ++mt) { acc[mt][0] = (f32x4){0.f, 0.f, 0.f, 0.f}; acc[mt][1] = (f32x4){0.f, 0.f, 0.f, 0.f}; }
#pragma unroll
        for (int ks = 0; ks < 4; ++ks) {
            bf16x8 bfr[2];
#pragma unroll
            for (int nt = 0; nt < 2; ++nt) { const LAS bf16* a0 = Vt + (32 * ks + 8 * g4 + qq) * LD + 32 * w + 16 * nt + 4 * pp; bfr[nt] = cat8(tr4(a0), tr4(a0 + 4 * LD)); }
#pragma unroll
            for (int mt = 0; mt < 16; ++mt) { const LAS bf16* a0 = Kt + (32 * ks + 8 * g4 + qq) * LD + 128 * (mt >> 3) + 32 * pp + 4 * (mt & 7);
                const bf16x8 afr = cat8(tr4(a0), tr4(a0 + 4 * LD));
                acc[mt][0] = MFMA16(afr, bfr[0], acc[mt][0]); acc[mt][1] = MFMA16(afr, bfr[1], acc[mt][1]); }
        }
        bf16* outb = St + ((size_t)((b * RH + h) * RNC + n)) * (RDV * RDK);
#pragma unroll
        for (int nt = 0; nt < 2; ++nt) { bf16* orow = outb + (size_t)(eh * 256 + 32 * w + 16 * nt + l15) * RDK + 32 * g4;
#pragma unroll
            for (int mh = 0; mh < 2; ++mh)
#pragma unroll
                for (int q = 0; q < 4; ++q) *(u32x4*)(orow + 128 * mh + 8 * q) = pack_bf16x8(acc[mh * 8 + 2 * q][nt], acc[mh * 8 + 2 * q + 1][nt]); }
        __syncthreads();
    }
}
__device__ __forceinline__ void phase_ret_scan(const Frame& F) {
    bf16* St = (bf16*)(F.ws + WS_AUX);
    for (int gt = F.vcu * NTHREADS + F.tid; gt < 8 * 16384; gt += F.G * NTHREADS) {
        const int bh = gt >> 14, chunk = gt & 16383, h = bh & 3;
        const float g128 = exp2f(128.0f * log2f(1.0f - exp2f(-5.0f - (float)h)));
        bf16* base = St + (size_t)bh * RNC * (RDV * RDK) + (size_t)chunk * 8;
        float c[8];
#pragma unroll
        for (int j = 0; j < 8; ++j) c[j] = 0.f;
#pragma unroll 8
        for (int n = 0; n < RNC; ++n) { bf16* pn = base + (size_t)n * (RDV * RDK); const u32x4 uv = *(const u32x4*)pn;
            u32x4 o; o.x = pk2(c[0], c[1]); o.y = pk2(c[2], c[3]); o.z = pk2(c[4], c[5]); o.w = pk2(c[6], c[7]); *(u32x4*)pn = o;
            c[0] = g128 * (c[0] + bflo(uv.x)); c[1] = g128 * (c[1] + bfhi(uv.x)); c[2] = g128 * (c[2] + bflo(uv.y)); c[3] = g128 * (c[3] + bfhi(uv.y));
            c[4] = g128 * (c[4] + bflo(uv.z)); c[5] = g128 * (c[5] + bfhi(uv.z)); c[6] = g128 * (c[6] + bflo(uv.w)); c[7] = g128 * (c[7] + bfhi(uv.w)); }
    }
}
__device__ __forceinline__ void phase_ret_out(const Frame& F, KP p) {
    const bf16* proj = (const bf16*)(F.ws + WS_BIG); const bf16* St = (const bf16*)(F.ws + WS_AUX); bf16* yret = (bf16*)(F.ws + WS_BIG + BIG_YRET);
    const float* gng = gin(p, 4); const float* gnb = gin(p, 5);
    constexpr int LD = 264, VLD = 136;
    LAS bf16* Rs = (LAS bf16*)F.lds; LAS bf16* Vs = Rs + 128 * LD;
    const int lane = F.lane, w = F.wave, g4 = lane >> 4, l15 = lane & 15, qq = l15 >> 2, pp = lane & 3;
    for (int u = F.vcu; u < 512; u += F.G) {
        const int h = u & 3, n = (u >> 2) & 63, b = u >> 8;
        const size_t row0 = (size_t)b * SEQ + (size_t)n * RC;
#pragma unroll 4
        for (int it = 0; it < 8; ++it) { const int idx = F.tid + 512 * it, j = idx >> 5, ch = idx & 31;
            *(LAS u32x4*)(Rs + j * LD + ch * 8) = *(const u32x4*)(proj + (row0 + j) * RET_IN + 1024 + h * 256 + ch * 8); }
        const int irow = 16 * w + l15; const size_t qrow = row0 + irow;
        bf16x8 qf[8];
#pragma unroll
        for (int s = 0; s < 8; ++s) qf[s] = *(const bf16x8*)(proj + qrow * RET_IN + h * 256 + 32 * s + 8 * g4);
        __syncthreads();
        bf16x8 pf[4];
        { f32x4 sacc[8];
#pragma unroll
            for (int jt = 0; jt < 8; ++jt) { sacc[jt] = (f32x4){0.f, 0.f, 0.f, 0.f};
                if (jt <= w) {
#pragma unroll
                    for (int s = 0; s < 8; ++s) sacc[jt] = MFMA16(row_frag(Rs, LD, 16 * jt, 32 * s, lane), qf[s], sacc[jt]);
#pragma unroll
                    for (int i = 0; i < 4; ++i) if (16 * jt + 4 * g4 + i > irow) sacc[jt][i] = 0.f; } }
#pragma unroll
            for (int kt = 0; kt < 4; ++kt) pf[kt] = pack8(sacc[2 * kt], sacc[2 * kt + 1]); }
        __syncthreads();
        f32x4 acc[4][8];
        const bf16* Sn = St + ((size_t)((b * RH + h) * RNC + n)) * (RDV * RDK);
#pragma unroll
        for (int sl = 0; sl < 4; ++sl) {
#pragma unroll 4
            for (int it = 0; it < 4; ++it) { const int idx = F.tid + 512 * it, j = idx >> 4, ch = idx & 15;
                *(LAS u32x4*)(Vs + j * VLD + ch * 8) = *(const u32x4*)(proj + (row0 + j) * RET_IN + 2048 + h * 512 + sl * 128 + ch * 8); }
#pragma unroll 4
            for (int it = 0; it < 8; ++it) { const int idx = F.tid + 512 * it, e = idx >> 5, ch = idx & 31;
                *(LAS u32x4*)(Rs + e * LD + ch * 8) = *(const u32x4*)(Sn + (size_t)(sl * 128 + e) * RDK + ch * 8); }
            __syncthreads();
#pragma unroll
            for (int et = 0; et < 8; ++et) { f32x4 a = (f32x4){0.f, 0.f, 0.f, 0.f};
#pragma unroll
                for (int kt = 0; kt < 4; ++kt) if (2 * kt <= w) { const LAS bf16* a0 = Vs + (32 * kt + 4 * g4 + qq) * VLD + 32 * pp + 4 * et;
                    a = MFMA16(cat8(tr4(a0), tr4(a0 + 16 * VLD)), pf[kt], a); }
                const LAS bf16* srow = Rs + (32 * qq + 4 * et + pp) * LD + 8 * g4;
#pragma unroll
                for (int s = 0; s < 8; ++s) a = MFMA16(*(const LAS bf16x8*)(srow + 32 * s), qf[s], a);
                acc[sl][et] = a; }
            __syncthreads();
        }
        float s = 0.f;
#pragma unroll
        for (int sl = 0; sl < 4; ++sl)
#pragma unroll
            for (int et = 0; et < 8; ++et) s += (acc[sl][et][0] + acc[sl][et][1]) + (acc[sl][et][2] + acc[sl][et][3]);
        s += shx(s, 16, lane); s += shx(s, 32, lane);
        const float mean = s * (1.0f / RDV); float s2 = 0.f;
#pragma unroll
        for (int sl = 0; sl < 4; ++sl)
#pragma unroll
            for (int et = 0; et < 8; ++et) { acc[sl][et] = acc[sl][et] - mean; s2 += (acc[sl][et][0] * acc[sl][et][0] + acc[sl][et][1] * acc[sl][et][1]) + (acc[sl][et][2] * acc[sl][et][2] + acc[sl][et][3] * acc[sl][et][3]); }
        s2 += shx(s2, 16, lane); s2 += shx(s2, 32, lane);
        const float rstd = 1.0f / sqrtf(s2 * (1.0f / RDV) + LN_EPS);
#pragma unroll
        for (int sl = 0; sl < 4; ++sl) { const int c0 = h * RDV + sl * 128 + 32 * g4;
#pragma unroll
            for (int q = 0; q < 4; ++q) { const u32x4 gw = *(const u32x4*)(proj + qrow * RET_IN + 4096 + c0 + 8 * q);
                const f32x4 gg0 = *(const f32x4*)(gng + c0 + 8 * q), gg1 = *(const f32x4*)(gng + c0 + 8 * q + 4), gb0 = *(const f32x4*)(gnb + c0 + 8 * q), gb1 = *(const f32x4*)(gnb + c0 + 8 * q + 4);
                f32x4 y0 = acc[sl][2 * q] * rstd * gg0 + gb0, y1 = acc[sl][2 * q + 1] * rstd * gg1 + gb1;
                const float gv[8] = {bflo(gw.x), bfhi(gw.x), bflo(gw.y), bfhi(gw.y), bflo(gw.z), bfhi(gw.z), bflo(gw.w), bfhi(gw.w)};
#pragma unroll
                for (int j = 0; j < 4; ++j) { y0[j] *= gv[j] / (1.0f + __expf(-gv[j])); y1[j] *= gv[4 + j] / (1.0f + __expf(-gv[4 + j])); }
                *(u32x4*)(yret + qrow * RET_V + c0 + 8 * q) = pack_bf16x8(y0, y1); } }
    }
}

constexpr size_t AUX_S5E = 64 * MiB;
constexpr int S5L = 256, S5NC = SEQ / S5L;
__device__ __forceinline__ void cmul_add(float& rr, float& ri, float ar, float ai, float xr, float xi, float cr, float ci) { rr = ar * xr - ai * xi + cr; ri = ar * xi + ai * xr + ci; }
template <bool OUT>
__device__ __forceinline__ void phase_s5_scan(const Frame& F, KP p) {
    const bf16* X = (const bf16*)(F.ws + WS_XB); float* E = (float*)(F.ws + WS_AUX + AUX_S5E); bf16* ybuf = (bf16*)(F.ws + WS_AUX);
    const int lane = F.lane, w = F.wave, g4 = lane >> 4, l15 = lane & 15;
    LAS bf16* ut = (LAS bf16*)(F.lds + w * 12288);
    LAS bf16* Hb = (LAS bf16*)(F.lds + w * 12288 + 4096);
    constexpr int HLD = 136;
    const int gw = F.vcu * NWAVES + w, NGW = F.G * NWAVES;
    const int up16 = (lane - 16) << 2, up32 = (lane - 32) << 2, last16 = (48 + l15) << 2;
    for (int unit = gw; unit < BATCH * SG * S5NC; unit += NGW) {
        const int n = unit & (S5NC - 1), g = (unit >> 5) & 63, b = unit >> 11;
        float a1r[4], a1i[4], a4r[4], a4i[4], a8r[4], a8i[4], pwr[4], pwi[4];
        bf16x8 bfrag[8];
        const float dt = expf(gin(p, 14)[g]);
#pragma unroll
        for (int st = 0; st < 4; ++st) { const int ps = 16 * st + l15;
            const float are = gin(p, 7)[g * SP + ps], aim = gin(p, 8)[g * SP + ps];
            const float mag = expf(dt * are); const float abr = mag * cosf(dt * aim), abi = mag * sinf(dt * aim);
            const float den = are * are + aim * aim;
            const float fre = ((abr - 1.0f) * are + abi * aim) / den, fim = (abi * are - (abr - 1.0f) * aim) / den;
            a1r[st] = abr; a1i[st] = abi; { float t2r, t2i; cmul_add(t2r, t2i, abr, abi, abr, abi, 0.f, 0.f); cmul_add(a4r[st], a4i[st], t2r, t2i, t2r, t2i, 0.f, 0.f); }
            cmul_add(a8r[st], a8i[st], a4r[st], a4i[st], a4r[st], a4i[st], 0.f, 0.f);
            float qr = 1.f, qi = 0.f;
            if (g4 & 1) { qr = a4r[st]; qi = a4i[st]; }
            if (g4 & 2) { float tr, ti; cmul_add(tr, ti, qr, qi, a8r[st], a8i[st], 0.f, 0.f); qr = tr; qi = ti; }
            pwr[st] = qr; pwi[st] = qi;
            const float* br = gin(p, 9) + ((size_t)g * SP + ps) * SGC + 8 * (g4 & 1); const float* bi = gin(p, 10) + ((size_t)g * SP + ps) * SGC + 8 * (g4 & 1);
            const f32x4 r0 = *(const f32x4*)br, r1 = *(const f32x4*)(br + 4), i0 = *(const f32x4*)bi, i1 = *(const f32x4*)(bi + 4);
            const float z = (g4 < 2) ? 1.0f : 0.0f; const float fr2 = fre * z, fi2 = fim * z;
            bfrag[st] = pack8(r0 * fr2 - i0 * fi2, r1 * fr2 - i1 * fi2); bfrag[st + 4] = pack8(i0 * fr2 + r0 * fi2, i1 * fr2 + r1 * fi2);
        }
        float sr[4], si[4];
        float* Eu = E + ((size_t)(b * SG + g) * S5NC + n) * 128;
        bf16x8 cf[4]; f32x4 dsk = (f32x4){0.f, 0.f, 0.f, 0.f};
#pragma unroll
        for (int st = 0; st < 4; ++st) { sr[st] = 0.f; si[st] = 0.f; }
        if (OUT) {
#pragma unroll
            for (int st = 0; st < 4; ++st) { sr[st] = Eu[16 * st + l15]; si[st] = Eu[64 + 16 * st + l15]; }
#pragma unroll
            for (int s = 0; s < 4; ++s) { const float* cp = (s < 2 ? gin(p, 11) : gin(p, 12)) + ((size_t)g * SGC + l15) * SP + 32 * (s & 1) + 8 * g4; const float sg = s < 2 ? 1.0f : -1.0f;
                const f32x4 c0 = *(const f32x4*)cp * sg, c1 = *(const f32x4*)(cp + 4) * sg; cf[s] = pack8(c0, c1); }
            dsk = *(const f32x4*)(gin(p, 13) + g * SGC + 4 * g4); }
        const size_t tok0 = (size_t)b * SEQ + (size_t)n * S5L;
        u32x4 pre[2];
        { const bf16* src = X + (tok0 + lane) * D + g * SGC; pre[0] = *(const u32x4*)src; pre[1] = *(const u32x4*)(src + 8); }
        for (int sub = 0; sub < S5L / 64; ++sub) {
            *(LAS u32x4*)(ut + lane * 16) = pre[0]; *(LAS u32x4*)(ut + lane * 16 + 8) = pre[1];
            if (sub + 1 < S5L / 64) { const bf16* src = X + (tok0 + (sub + 1) * 64 + lane) * D + g * SGC; pre[0] = *(const u32x4*)src; pre[1] = *(const u32x4*)(src + 8); }
            LDS_WAIT(); asm volatile("" ::: "memory");
#pragma unroll 1
            for (int blk = 0; blk < 4; ++blk) {
                u32x4 uw = *(const LAS u32x4*)(ut + (blk * 16 + l15) * 16 + 8 * (g4 & 1));
                if (g4 >= 2) uw = (u32x4){0u, 0u, 0u, 0u};
                const bf16x8 ufr = __builtin_bit_cast(bf16x8, uw);
                f32x4 dr[4], di[4];
#pragma unroll
                for (int st = 0; st < 4; ++st) { dr[st] = MFMA16(ufr, bfrag[st], ((f32x4){0.f, 0.f, 0.f, 0.f})); di[st] = MFMA16(ufr, bfrag[st + 4], ((f32x4){0.f, 0.f, 0.f, 0.f})); }
                float vr[4], vi[4];
#pragma unroll
                for (int st = 0; st < 4; ++st) {
                    float hr = 0.f, hi = 0.f;
#pragma unroll
                    for (int i = 0; i < 4; ++i) { float nr, ni; cmul_add(nr, ni, a1r[st], a1i[st], hr, hi, dr[st][i], di[st][i]); hr = nr; hi = ni; dr[st][i] = hr; di[st][i] = hi; }
                    vr[st] = hr; vi[st] = hi; }
#define BPF(idx, v) __builtin_bit_cast(float, __builtin_amdgcn_ds_bpermute((idx), __builtin_bit_cast(int, (v))))
                { float xr[4], xi[4];
#pragma unroll
                  for (int st = 0; st < 4; ++st) { xr[st] = BPF(up16, vr[st]); xi[st] = BPF(up16, vi[st]); }
#pragma unroll
                  for (int st = 0; st < 4; ++st) { float tr, ti; cmul_add(tr, ti, a4r[st], a4i[st], xr[st], xi[st], vr[st], vi[st]); if (g4 >= 1) { vr[st] = tr; vi[st] = ti; } }
#pragma unroll
                  for (int st = 0; st < 4; ++st) { xr[st] = BPF(up32, vr[st]); xi[st] = BPF(up32, vi[st]); }
#pragma unroll
                  for (int st = 0; st < 4; ++st) { float tr, ti; cmul_add(tr, ti, a8r[st], a8i[st], xr[st], xi[st], vr[st], vi[st]); if (g4 >= 2) { vr[st] = tr; vi[st] = ti; } } }
                float er[4], ei[4], lr[4], li[4];
#pragma unroll
                for (int st = 0; st < 4; ++st) { er[st] = BPF(up16, vr[st]); ei[st] = BPF(up16, vi[st]); lr[st] = BPF(last16, vr[st]); li[st] = BPF(last16, vi[st]); }
#undef BPF
#pragma unroll
                for (int st = 0; st < 4; ++st) {
                    if (g4 == 0) { er[st] = 0.f; ei[st] = 0.f; }
                    float s0r, s0i; cmul_add(s0r, s0i, pwr[st], pwi[st], sr[st], si[st], er[st], ei[st]);
#pragma unroll
                    for (int i = 0; i < 4; ++i) { float tr, ti; cmul_add(tr, ti, a1r[st], a1i[st], s0r, s0i, 0.f, 0.f); s0r = tr; s0i = ti; dr[st][i] += s0r; di[st][i] += s0i; }
                    { float a16r, a16i; cmul_add(a16r, a16i, a8r[st], a8i[st], a8r[st], a8i[st], 0.f, 0.f); float tr, ti; cmul_add(tr, ti, a16r, a16i, sr[st], si[st], lr[st], li[st]); sr[st] = tr; si[st] = ti; }
                    if (OUT) {
#pragma unroll
                        for (int i = 0; i < 4; ++i) { const unsigned hw = pk2(dr[st][i], di[st][i]); Hb[(4 * g4 + i) * HLD + 16 * st + l15] = (bf16)hw; Hb[(4 * g4 + i) * HLD + 64 + 16 * st + l15] = (bf16)(hw >> 16); } }
                }
                if (OUT) {
                    LDS_WAIT(); asm volatile("" ::: "memory");
                    f32x4 ya = (f32x4){0.f, 0.f, 0.f, 0.f};
#pragma unroll
                    for (int s = 0; s < 4; ++s) ya = MFMA16(cf[s], row_frag(Hb, HLD, 0, 32 * s, lane), ya);
                    const u32x2 u2 = *(const LAS u32x2*)(ut + (blk * 16 + l15) * 16 + 4 * g4);
                    const f32x4 u4 = (f32x4){bflo(u2.x), bfhi(u2.x), bflo(u2.y), bfhi(u2.y)};
                    f32x4 y = ya + dsk * u4;
#pragma unroll
                    for (int j = 0; j < 4; ++j) { const float v = y[j]; y[j] = v / (1.0f + __expf(-1.5957691216057308f * (v + 0.044715f * v * v * v))); }
                    u32x2 o; o.x = pk2(y[0], y[1]); o.y = pk2(y[2], y[3]);
                    *(u32x2*)(ybuf + (tok0 + sub * 64 + blk * 16 + l15) * D + g * SGC + 4 * g4) = o;
                    asm volatile("" ::: "memory"); }
            }
            LDS_WAIT(); asm volatile("" ::: "memory");
        }
        if (!OUT && g4 == 0) {
#pragma unroll
            for (int st = 0; st < 4; ++st) { Eu[16 * st + l15] = sr[st]; Eu[64 + 16 * st + l15] = si[st]; } }
    }
}
__device__ __forceinline__ void phase_s5_carry(const Frame& F, KP p) {
    float* E = (float*)(F.ws + WS_AUX + AUX_S5E);
    for (int gt = F.vcu * NTHREADS + F.tid; gt < BATCH * SG * SP; gt += F.G * NTHREADS) {
        const int pl = gt & 63, bg = gt >> 6, g = bg & 63;
        const float dt = expf(gin(p, 14)[g]); const float are = gin(p, 7)[g * SP + pl], aim = gin(p, 8)[g * SP + pl];
        const float mag = expf(dt * are); float ar = mag * cosf(dt * aim), ai = mag * sinf(dt * aim);
#pragma unroll
        for (int q = 0; q < 8; ++q) { const float nr = ar * ar - ai * ai, ni = 2.0f * ar * ai; ar = nr; ai = ni; }
        float cr = 0.f, ci = 0.f;
        for (int n = 0; n < S5NC; ++n) { float* Eu = E + ((size_t)bg * S5NC + n) * 128; const float er = Eu[pl], ei = Eu[64 + pl];
            Eu[pl] = cr; Eu[64 + pl] = ci;
            const float nr = ar * cr - ai * ci + er, ni = ar * ci + ai * cr + ei; cr = nr; ci = ni; }
    }
}

constexpr int NPHASES = 34;
#ifndef PROBE_DRY14
#define PROBE_DRY14 0
#endif
#ifndef PROBE_DRY17
#define PROBE_DRY17 0
#endif
#ifndef PH_MASK
#define PH_MASK 0xFFFFFFFFu
#endif
#define PHT(t) ((PH_MASK >> (t)) & 1u)
constexpr int PLAN_OFF = 64;
__device__ __forceinline__ void moe_plan(const Frame& F, int layer) {
    volatile LAS int* tstart = (volatile LAS int*)(F.MISC + PLAN_OFF); volatile LAS int* cnts = tstart + 72;
    __syncthreads();
    if (F.wave == 0) {
        const unsigned* cnt = (const unsigned*)(F.ws + WS_CTL) + CW_CNT + layer * NE * 64;
        const int c = (int)__hip_atomic_load(cnt + F.lane * 64, __ATOMIC_RELAXED, __HIP_MEMORY_SCOPE_AGENT);
        int v = (c + 255) >> 8;
#pragma unroll
        for (int o = 1; o < 64; o <<= 1) { const int nb = __builtin_amdgcn_ds_bpermute((F.lane - o) << 2, v); if (F.lane >= o) v += nb; }
        tstart[F.lane + 1] = v; cnts[F.lane] = c;
        if (F.lane == 0) tstart[0] = 0;
        if (F.lane == 63) { tstart[65] = v + T / 256; cnts[64] = T; }
    }
    __syncthreads();
}
template <bool GATH> struct MoeSched2 {
    static constexpr bool GATHER = GATH, UNIFORMIZE = true, FP8 = GATH;
    static constexpr int ncol = GATH ? 2 : 4, K = GATH ? D / 2 : ED;
    const volatile LAS int* tstart; const volatile LAS int* cnts; int ntiles, G, c, lane;
    const char* Abase; const char* Wbase; const int* lists;
    __device__ __forceinline__ bool next(int i, pg8::UnitG& u) const {
        const int nwg = ntiles * ncol; const long L = (long)i * G + c; if (L >= nwg) return false;
        int wgid = (int)L; { const int q = nwg / 8, r = nwg % 8, xcd = wgid % 8, off = wgid / 8; wgid = (xcd < r ? xcd * (q + 1) : r * (q + 1) + (xcd - r) * q) + off; }
        const int tile = wgid / ncol, pn = wgid % ncol;
        const int ta = tstart[lane], tb = tstart[lane + 1];
        const unsigned long long mm = __ballot(ta <= tile && tile < tb);
        const int e = mm ? (int)__builtin_ctzll(mm) : 64;
        const int ts = __builtin_amdgcn_readfirstlane((int)tstart[e]), ce = __builtin_amdgcn_readfirstlane((int)cnts[e]);
        const int lt = tile - ts; int valid = ce - lt * 256; valid = valid > 256 ? 256 : valid;
        u.gshift = 0; u.aux = e;
        if (GATH) {
            u.B = Wbase + (size_t)e * WMOE_E_BYTES + (size_t)pn * 256 * K * 2;
            if (e < 64) { u.A = Abase; u.gidx = lists + (size_t)e * T + lt * 256; u.gcnt = valid; }
            else { u.A = Abase + (size_t)lt * 256 * K * 2; u.gidx = nullptr; u.gcnt = 0; }
            u.row0 = tile * 256; u.col0 = pn * 128;
        } else {
            u.B = Wbase + (size_t)e * WMOE_E_BYTES + (size_t)512 * 1024 * 2 + (size_t)pn * 256 * K * 2;
            u.A = Abase + (size_t)tile * 256 * K * 2; u.gidx = nullptr; u.gcnt = valid;
            u.row0 = tile * 256; u.col0 = pn * 256;
        }
        return true;
    }
};
__device__ __forceinline__ void phase_load_x(const Frame& F, KP p) {
    const float* xin = gin(p, 0); bf16* XB = (bf16*)(F.ws + WS_XB);
    for (size_t i = (size_t)F.vcu * NTHREADS + F.tid; i < (size_t)T * D / 8; i += (size_t)F.G * NTHREADS) {
        const f32x4 a = *(const f32x4*)(xin + i * 8), b = *(const f32x4*)(xin + i * 8 + 4);
        *(u32x4*)(XB + i * 8) = pack_bf16x8(a, b); }
}

__global__ void __launch_bounds__(NTHREADS, 2) fwd_kernel(Params p_unused) {
    KP p0 = (KP)__builtin_amdgcn_kernarg_segment_ptr();
    extern __shared__ __attribute__((aligned(16))) unsigned char lds_raw[];
    Frame F0;
    F0.lds = (LAS unsigned char*)lds_raw; F0.MISC = (volatile LAS unsigned*)(F0.lds + MISC_OFF);
    F0.tid = threadIdx.x; F0.lane = F0.tid & 63; F0.wave = __builtin_amdgcn_readfirstlane(F0.tid >> 6);
    F0.G = gridDim.x; { const int bq = blockIdx.x; F0.vcu = (F0.G % 8 == 0) ? (bq % 8) * (F0.G / 8) + bq / 8 : bq; }
    F0.ws = p0->ws;
    const int bx0 = blockIdx.x;
    for (int u = F0.tid; u < (LDS_BYTES - MISC_OFF) / 4; u += NTHREADS) ((LAS unsigned*)(F0.lds + MISC_OFF))[u] = 0u;
    __syncthreads();
    XcdBarrier bar; bar.bar = (unsigned*)(p0->ws + WS_CTL) + CW_BAR; bar.x = 0; bar.st = nullptr;
    const int use_bar = p0->use_bar;
    if (use_bar) bar = xcd_barrier_post((unsigned*)(p0->ws + WS_CTL) + CW_BAR, F0.MISC + 8);
    const int lo = p0->ph_lo, hi = p0->ph_hi;
#define PHASE_BEGIN Frame F = F0; KP p = p0; asm volatile("" : "+v"(F.tid), "+v"(F.lane)); GAS unsigned char* wsg_ = (GAS unsigned char*)F0.ws; asm volatile("" : "+s"(F.wave), "+s"(F.vcu), "+s"(F.G), "+s"(wsg_), "+s"(p)); \
    F.ws = (unsigned char*)wsg_; int bx = bx0; asm volatile("" : "+s"(bx)); unsigned char* ws = F.ws; (void)ws; (void)bx;
#pragma unroll 1
    for (int ph = lo; ph < hi; ++ph) {
        int layer = 0, type = 0;
        if (ph > 0) { layer = ph >= 26 ? 3 : (ph >= 18 ? 2 : (ph >= 9 ? 1 : 0)); const int q = ph - (layer == 3 ? 26 : (layer == 2 ? 18 : (layer == 1 ? 9 : 1))); const int kind = layer % 3;
            if (kind == 0) type = q < 4 ? 1 + q : 14 + (q - 4); else if (kind == 1) type = q < 5 ? 5 + q : 14 + (q - 5); else type = q < 4 ? 10 + q : 14 + (q - 4); }
        const int j = layer / 3;
#ifdef REPEAT_MASK
        const int nrep = ((REPEAT_MASK >> type) & 1u) ? 2 : 1;
#else
        const int nrep = 1;
#endif
#pragma unroll 1
        for (int rep = 0; rep < nrep; ++rep) {
        if (rep > 0 && use_bar) xcd_barrier(bar);
        if (PHT(0) && type == 0) { PHASE_BEGIN; phase_conv_mixers(F, p); phase_conv_moe(F, p, 0); phase_load_x(F, p); }
        else if (PHT(1) && type == 1) { PHASE_BEGIN; DenseSched S; S.init(ws + WS_XB, ws + WS_ATT_IN_T + (size_t)j * ATT_IN * D * 2, T, ATT_IN, D, F.G, bx); EpiStoreBf16 E{(bf16*)(ws + WS_BIG), ATT_IN};
            pg8::gemm_phase(F.lds, F.tid, D, S, E); }
        else if (PHT(2) && type == 2) { PHASE_BEGIN; phase_attn(F, bx); }
        else if (PHT(3) && type == 3) { PHASE_BEGIN; phase_attn_combine(F); }
        else if (PHT(4) && type == 4) { PHASE_BEGIN; DenseSched S; S.init(ws + WS_AUX + AUX_OB, ws + WS_ATT_OUT_T + (size_t)j * D * D * 2, T, D, D, F.G, bx); EpiResid E{(const bf16*)(ws + WS_XB), (bf16*)(ws + WS_Y)};
            pg8::gemm_phase(F.lds, F.tid, D, S, E); }
        else if (PHT(5) && type == 5) { PHASE_BEGIN; DenseSched S; S.init(ws + WS_XB, ws + WS_RET_IN_T, T, RET_IN, D, F.G, bx); EpiRetIn E{(bf16*)(ws + WS_BIG), RET_IN};
            pg8::gemm_phase(F.lds, F.tid, D, S, E); }
        else if (PHT(6) && type == 6) { PHASE_BEGIN; phase_ret_u(F); }
        else if (PHT(7) && type == 7) { PHASE_BEGIN; phase_ret_scan(F); }
        else if (PHT(8) && type == 8) { PHASE_BEGIN; phase_ret_out(F, p); }
        else if (PHT(9) && type == 9) { PHASE_BEGIN; DenseSched S; S.init(ws + WS_BIG + BIG_YRET, ws + WS_RET_OUT_T, T, D, RET_V, F.G, bx); EpiResid E{(const bf16*)(ws + WS_XB), (bf16*)(ws + WS_Y)};
            pg8::gemm_phase(F.lds, F.tid, RET_V, S, E); }
        else if (PHT(10) && type == 10) { PHASE_BEGIN; phase_s5_scan<false>(F, p); }
        else if (PHT(11) && type == 11) { PHASE_BEGIN; phase_s5_carry(F, p); }
        else if (PHT(12) && type == 12) { PHASE_BEGIN; phase_s5_scan<true>(F, p); }
        else if (PHT(13) && type == 13) { PHASE_BEGIN; DenseSched S; S.init(ws + WS_AUX, ws + WS_GLU_T, T, 2 * D, D, F.G, bx); EpiGluResid E{(const bf16*)(ws + WS_XB), (bf16*)(ws + WS_Y)};
            pg8::gemm_phase(F.lds, F.tid, D, S, E); }
        else if (PHT(14) && type == 14) { PHASE_BEGIN; phase_lnr(F, p, layer, PROBE_DRY14 && true); if (PROBE_DRY14) { if (use_bar) xcd_barrier(bar); phase_lnr(F, p, layer, false); } }
        else if (PHT(15) && type == 15) { PHASE_BEGIN; moe_plan(F, layer);
            MoeSched2<true> S; S.tstart = (const volatile LAS int*)(F.MISC + PLAN_OFF); S.cnts = S.tstart + 72; S.ntiles = __builtin_amdgcn_readfirstlane((int)S.tstart[65]); S.G = F.G; S.c = bx; S.lane = F.lane;
            S.Abase = (const char*)(ws + WS_X); S.Wbase = (const char*)(ws + WS_WMOE); S.lists = (const int*)(ws + WS_LIST);
            EpiMoeUp E{(bf16*)(ws + WS_H)};
            pg8::gemm_phase(F.lds, F.tid, D / 2, S, E); }
        else if (PHT(16) && type == 16) { PHASE_BEGIN; moe_plan(F, layer);
            { MoeSched2<false> S; S.tstart = (const volatile LAS int*)(F.MISC + PLAN_OFF); S.cnts = S.tstart + 72; S.ntiles = __builtin_amdgcn_readfirstlane((int)S.tstart[64]); S.G = F.G; S.c = bx; S.lane = F.lane;
              S.Abase = (const char*)(ws + WS_H); S.Wbase = (const char*)(ws + WS_WMOE); S.lists = (const int*)(ws + WS_LIST);
              EpiStoreFp8 E{(unsigned char*)(ws + WS_BIG), D};
              pg8::gemm_phase(F.lds, F.tid, ED, S, E); }
            { const int sh0 = __builtin_amdgcn_readfirstlane((int)((const volatile LAS int*)(F.MISC + PLAN_OFF))[64]);
              DenseSched S; S.init(ws + WS_H + (size_t)sh0 * 256 * ED * 2, ws + WS_WMOE + (size_t)64 * WMOE_E_BYTES + (size_t)512 * 1024 * 2, T, D, ED, F.G, bx); EpiResid E{(const bf16*)(ws + WS_XB), (bf16*)(ws + WS_Y)};
              pg8::gemm_phase(F.lds, F.tid, ED, S, E); } }
        else if (PHT(17) && type == 17) { PHASE_BEGIN; moe_plan(F, layer); if (PROBE_DRY17) { phase_combine(F, p, layer, true); if (use_bar) xcd_barrier(bar); } phase_combine(F, p, layer); if (layer + 1 < DEPTH) phase_conv_moe(F, p, layer + 1); }
        }
        if (use_bar && ph + 1 < hi) xcd_barrier(bar);
    }
}

#ifndef MK_PER_PHASE
#define MK_PER_PHASE 0
#endif
extern "C" void kernel_launch(void* const* d_in, const int* in_sizes, int n_in, void* d_out, int out_size, void* d_ws, size_t ws_size, hipStream_t stream) {
    static int grid = 0;
    if (grid == 0) {
        if (n_in != 26 || in_sizes[0] != T * D || out_size != T * D || ws_size < WS_END) { fprintf(stderr, "kernel_launch: unexpected shapes / workspace (n_in %d, in0 %d, out %d, ws %zu < %zu)\n", n_in, n_in > 0 ? in_sizes[0] : -1, out_size, ws_size, (size_t)WS_END); grid = -1; return; }
        int dev = 0, cus = 0, per_cu = 0;
        if (hipGetDevice(&dev) != hipSuccess || hipDeviceGetAttribute(&cus, hipDeviceAttributeMultiprocessorCount, dev) != hipSuccess) { grid = -1; return; }
        if (hipFuncSetAttribute((const void*)fwd_kernel, hipFuncAttributeMaxDynamicSharedMemorySize, LDS_BYTES) != hipSuccess) { fprintf(stderr, "kernel_launch: hipFuncSetAttribute failed\n"); grid = -1; return; }
        if (hipOccupancyMaxActiveBlocksPerMultiprocessor(&per_cu, (const void*)fwd_kernel, NTHREADS, LDS_BYTES) != hipSuccess || per_cu < 1) { fprintf(stderr, "kernel_launch: occupancy query says %d blocks per CU\n", per_cu); per_cu = 1; }
        (void)hipGetLastError();
        grid = cus;
    }
    if (grid < 0) return;
    (void)hipMemsetAsync((char*)d_ws + WS_CTL, 0, CTL_ZERO_BYTES, stream);
    Params p{};
    for (int i = 0; i < 26; ++i) p.in[i] = (const float*)d_in[i];
    p.out = (float*)d_out; p.ws = (unsigned char*)d_ws;
#if MK_PER_PHASE
    for (int k = 0; k < NPHASES; ++k) { p.ph_lo = k; p.ph_hi = k + 1; p.use_bar = 0; hipLaunchKernelGGL(fwd_kernel, dim3(grid), dim3(NTHREADS), LDS_BYTES, stream, p); }
#else
    p.ph_lo = 0; p.ph_hi = NPHASES; p.use_bar = 1;
    hipLaunchKernelGGL(fwd_kernel, dim3(grid), dim3(NTHREADS), LDS_BYTES, stream, p);
#endif
}
```

```cpp
#include <hip/hip_runtime.h>
#include <cstdio>
#include <cstdint>

#define LAS __attribute__((address_space(3)))
#define GAS __attribute__((address_space(1)))
typedef unsigned short bf16;
typedef short bf16x8 __attribute__((ext_vector_type(8)));
typedef short bf16x4 __attribute__((ext_vector_type(4)));
typedef float f32x4 __attribute__((ext_vector_type(4)));
typedef float f32x2 __attribute__((ext_vector_type(2)));
typedef unsigned u32x4 __attribute__((ext_vector_type(4)));
typedef unsigned u32x2 __attribute__((ext_vector_type(2)));
typedef GAS unsigned gu32;

constexpr int D = 1024, BATCH = 2, SEQ = 8192, T = BATCH * SEQ, DEPTH = 4;
constexpr int AH = 8, AHD = 128, ATT_IN = 9216;
constexpr int RH = 4, RDK = 256, RDV = 512, RET_IN = 6144, RET_V = 2048, RC = 128, RNC = SEQ / RC;
constexpr int SG = 64, SGC = 16, SP = 64;
constexpr int NE = 64, TOPK = 8, NEG = 8, ED = 256, NSLOT = 9;
constexpr float LN_EPS = 1e-5f;
constexpr float ALPHA = 1.6817928305074292f;
constexpr int NWAVES = 8, NTHREADS = 512;

__device__ __forceinline__ unsigned f2bf(float f) { unsigned u = __builtin_bit_cast(unsigned, f); return (u + 0x7fffu + ((u >> 16) & 1u)) >> 16; }
__device__ __forceinline__ unsigned pk2(float lo, float hi) { unsigned r; asm("s_nop 1\n\tv_cvt_pk_bf16_f32 %0, %1, %2" : "=v"(r) : "v"(lo), "v"(hi)); return r; }
__device__ __forceinline__ unsigned pk2sw(float lo, float hi) { return f2bf(lo) | (f2bf(hi) << 16); }
__device__ __forceinline__ unsigned pk2hw(float lo, float hi) { unsigned r; asm volatile("v_cvt_pk_bf16_f32 %0, %1, %2" : "=v"(r) : "v"(lo), "v"(hi)); return r; }
__device__ __forceinline__ float bf2f(unsigned b) { return __builtin_bit_cast(float, b << 16); }
__device__ __forceinline__ float bflo(unsigned w) { return __builtin_bit_cast(float, w << 16); }
__device__ __forceinline__ float bfhi(unsigned w) { return __builtin_bit_cast(float, w & 0xffff0000u); }
__device__ __forceinline__ float shx(float v, int m, int lane) { return __builtin_bit_cast(float, __builtin_amdgcn_ds_bpermute((lane ^ m) << 2, __builtin_bit_cast(int, v))); }
__device__ __forceinline__ int shx_i(int v, int m, int lane) { return __builtin_amdgcn_ds_bpermute((lane ^ m) << 2, v); }
__device__ __forceinline__ float rdl(float v, int src) { return __builtin_bit_cast(float, __builtin_amdgcn_readlane(__builtin_bit_cast(int, v), src)); }
__device__ __forceinline__ float wave_sum(float v, int lane) {
#pragma unroll
    for (int o = 1; o < 64; o <<= 1) v += shx(v, o, lane);
    return v;
}
#define LDS_WAIT() asm volatile("s_waitcnt lgkmcnt(0)" ::: "memory")
#define VM_WAIT() asm volatile("s_waitcnt vmcnt(0)" ::: "memory")
__device__ __forceinline__ const char* rfl_ptr(const char* p) {
    unsigned long long v = (unsigned long long)p; unsigned lo = __builtin_amdgcn_readfirstlane((unsigned)v), hi = __builtin_amdgcn_readfirstlane((unsigned)(v >> 32));
    return (const char*)(((unsigned long long)hi << 32) | lo);
}
__device__ __forceinline__ bf16x8 row_frag(const LAS bf16* base, int ld, int row0, int col0, int lane) {
    return *(const LAS bf16x8*)(base + (row0 + (lane & 15)) * ld + col0 + 8 * (lane >> 4));
}
__device__ __forceinline__ bf16x4 tr4(const LAS bf16* addr) { return __builtin_amdgcn_ds_read_tr16_b64_v4i16((LAS bf16x4*)addr); }
__device__ __forceinline__ bf16x8 cat8(bf16x4 a, bf16x4 b) { bf16x8 r; r[0] = a[0]; r[1] = a[1]; r[2] = a[2]; r[3] = a[3]; r[4] = b[0]; r[5] = b[1]; r[6] = b[2]; r[7] = b[3]; return r; }
#define MFMA16(a, b, c) __builtin_amdgcn_mfma_f32_16x16x32_bf16((a), (b), (c), 0, 0, 0)
__device__ __forceinline__ bf16x8 pack8(f32x4 a, f32x4 b) {
    u32x4 w; w.x = pk2(a[0], a[1]); w.y = pk2(a[2], a[3]); w.z = pk2(b[0], b[1]); w.w = pk2(b[2], b[3]); return __builtin_bit_cast(bf16x8, w);
}

namespace pg8 {
typedef int v4i_t __attribute__((ext_vector_type(4)));
typedef int v8i_t __attribute__((ext_vector_type(8)));
constexpr int BM = 256, BK = 64, HALF = 128, HTB = HALF * BK * 2, STAGE_BYTES = 8 * HTB;
__device__ __forceinline__ int lds_byte(int r, int c) { const int st = (r >> 4) * 2 + (c >> 5), rr = r & 15, cc = c & 31, ob = rr * 64 + cc * 2; return st * 1024 + (ob ^ (((ob >> 9) & 1) << 5)); }
__device__ __forceinline__ void stage_rc(int b, int& R, int& C) { const int st = b / 1024, sb = b % 1024, swz = sb ^ (((sb >> 9) & 1) << 5); R = (st >> 1) * 16 + swz / 64; C = (st & 1) * 32 + (swz % 64) / 2; }
__device__ __forceinline__ int perm32(int rho) { const int n = rho >> 4, i = rho & 15; return 8 * (i >> 2) + 4 * n + (i & 3); }

struct UnitG {
    const char* A;
    const char* B;
    const int* gidx;
    int gcnt, gshift;
    int row0, col0;
    int aux;
};

__device__ __forceinline__ void uniformize(UnitG& u) { u.A = rfl_ptr(u.A); u.B = rfl_ptr(u.B); u.gidx = (const int*)rfl_ptr((const char*)u.gidx); u.gcnt = __builtin_amdgcn_readfirstlane(u.gcnt); u.gshift = __builtin_amdgcn_readfirstlane(u.gshift);
    u.row0 = __builtin_amdgcn_readfirstlane(u.row0); u.col0 = __builtin_amdgcn_readfirstlane(u.col0); u.aux = __builtin_amdgcn_readfirstlane(u.aux); }
template <class Epi, class Sched>
__device__ __forceinline__ void gemm_phase(LAS unsigned char* lds, const int tid, const int K, const Sched& S, const Epi& E) {
    constexpr bool F8 = Sched::FP8;
    constexpr bool GATHER = Sched::GATHER;
    const int wid = __builtin_amdgcn_readfirstlane(tid >> 6), lane = tid & 63, wr = wid >> 2, wc = wid & 3, fr = lane & 15, fq = lane >> 4;
    const int nt = K / BK;
    constexpr bool P16 = Epi::PERM16;
    unsigned voffB[2], voffB1[2], vA[2][2];
#pragma unroll
    for (int i = 0; i < 2; ++i) { int R, C; stage_rc(tid * 16 + i * 8192, R, C); const int Rb = Epi::PERM ? ((R & ~31) + perm32(R & 31)) : R; voffB[i] = (unsigned)(Rb * K + C) * 2u; voffB1[i] = voffB[i]; vA[0][i] = (unsigned)(R * K + C) * 2u; vA[1][i] = vA[0][i];
        if constexpr (P16) { const int x = R & 31, src = 64 * (R >> 5) + 16 * ((x >> 2) & 3) + 4 * (x >> 4) + (x & 3); voffB[i] = (unsigned)(src * K + C) * 2u; voffB1[i] = (unsigned)((src + 8) * K + C) * 2u; } }
    const size_t kstep = (size_t)(BK * 2);
    const size_t hstep = (size_t)HALF * K * 2;
    const size_t hstepB = P16 ? 0 : hstep;
    const size_t hstepA = GATHER ? 0 : hstep;
    const unsigned ldsw = (unsigned)wid * 1024u;
    const int aoff = F8 ? lds_byte(wr * 64 + fr, fq * 16) : lds_byte(wr * 64 + fr, fq * 8), boff = F8 ? lds_byte(wc * 32 + fr, fq * 16) : lds_byte(wc * 32 + fr, fq * 8);
    LAS u32x4* park = (LAS u32x4*)(lds + STAGE_BYTES) + tid;
#define PG8_SA(b, h) (((b) * 2 + (h)) * HTB)
#define PG8_SB(b, h) ((4 + (b) * 2 + (h)) * HTB)
#define PG8_STAGE(bufoff, gbase, voff) do { _Pragma("unroll") for (int _i = 0; _i < 2; ++_i) { asm volatile("" : "+v"((voff)[_i]));   \
        __builtin_amdgcn_global_load_lds((const unsigned*)((const char*)(gbase) + (voff)[_i]), (LAS unsigned*)(lds + (bufoff) + ldsw + _i * 8192), 16, 0, 0); } } while (0)
    constexpr int FKS = F8 ? 16 : 1024;
#define PG8_LD2(p_) __builtin_shufflevector(*(const LAS v4i_t*)(p_), *(const LAS v4i_t*)((p_) + FKS), 0, 1, 2, 3, 4, 5, 6, 7)
#define PG8_LDA(dst, b, h) do { _Pragma("unroll") for (int m = 0; m < 4; ++m) dst[m] = PG8_LD2(lds + PG8_SA(b, h) + aoff + m * 2048); } while (0)
#define PG8_LDB(dst, b, h) do { _Pragma("unroll") for (int n = 0; n < 2; ++n) dst[n] = PG8_LD2(lds + PG8_SB(b, h) + boff + n * 2048); } while (0)
#define PG8_LO(v) __builtin_bit_cast(bf16x8, __builtin_shufflevector((v), (v), 0, 1, 2, 3))
#define PG8_HI(v) __builtin_bit_cast(bf16x8, __builtin_shufflevector((v), (v), 4, 5, 6, 7))
#define PG8_MMA(ai, bj, At, Bt) do { __builtin_amdgcn_s_setprio(1); _Pragma("unroll") for (int m = 0; m < 4; ++m) _Pragma("unroll") for (int n = 0; n < 2; ++n) { \
        if constexpr (F8) { acc[ai][bj][m][n] = __builtin_amdgcn_mfma_scale_f32_16x16x128_f8f6f4(Bt[n], At[m], acc[ai][bj][m][n], 0, 0, 0, 0x7F7F7F7F, 0, 0x7F7F7F7F); } \
        else { acc[ai][bj][m][n] = __builtin_amdgcn_mfma_f32_16x16x32_bf16(PG8_LO(Bt[n]), PG8_LO(At[m]), acc[ai][bj][m][n], 0, 0, 0); \
               acc[ai][bj][m][n] = __builtin_amdgcn_mfma_f32_16x16x32_bf16(PG8_HI(Bt[n]), PG8_HI(At[m]), acc[ai][bj][m][n], 0, 0, 0); } } __builtin_amdgcn_s_setprio(0); } while (0)
#define PG8_WAIT_V(n) asm volatile("s_waitcnt vmcnt(" #n ")" ::: "memory")
#define PG8_WAIT_L(n) asm volatile("s_waitcnt lgkmcnt(" #n ")" ::: "memory")
#define PG8_BAR __builtin_amdgcn_s_barrier()
#define PG8_SCHED __builtin_amdgcn_sched_barrier(0)
#define PG8_VOFF(u, v00, v01, v10, v11) do { int _R0, _C0, _R1, _C1; stage_rc(tid * 16, _R0, _C0); stage_rc(tid * 16 + 8192, _R1, _C1); int _r00 = _R0, _r01 = _R1, _r10 = HALF + _R0, _r11 = HALF + _R1; \
        if ((u).gidx) { const int _a = _r00 < (u).gcnt ? ((const GAS int*)(u).gidx)[_r00] >> (u).gshift : 0, _b = _r01 < (u).gcnt ? ((const GAS int*)(u).gidx)[_r01] >> (u).gshift : 0, _c = _r10 < (u).gcnt ? ((const GAS int*)(u).gidx)[_r10] >> (u).gshift : 0, _d = _r11 < (u).gcnt ? ((const GAS int*)(u).gidx)[_r11] >> (u).gshift : 0; \
            _r00 = _a; _r01 = _b; _r10 = _c; _r11 = _d; } \
        v00 = (unsigned)(_r00 * K + _C0) * 2u; v01 = (unsigned)(_r01 * K + _C1) * 2u; v10 = (unsigned)(_r10 * K + _C0) * 2u; v11 = (unsigned)(_r11 * K + _C1) * 2u; } while (0)
    UnitG cur, nxt; int ui = 0;
    if (!S.next(0, cur)) return;
    if constexpr (Sched::UNIFORMIZE) uniformize(cur);
    f32x4 acc[2][2][4][2];
#pragma unroll
    for (int a = 0; a < 2; ++a)
#pragma unroll
        for (int b = 0; b < 2; ++b)
#pragma unroll
            for (int m = 0; m < 4; ++m)
#pragma unroll
                for (int n = 0; n < 2; ++n) acc[a][b][m][n] = (f32x4){0.f, 0.f, 0.f, 0.f};
    v8i_t At[4], B0[2], B1[2];
    if constexpr (GATHER) PG8_VOFF(cur, vA[0][0], vA[0][1], vA[1][0], vA[1][1]);
    const char* cA = cur.A; const char* cB = cur.B;
    PG8_STAGE(PG8_SB(0, 0), cB, voffB); PG8_STAGE(PG8_SB(0, 1), cB + hstepB, voffB1); PG8_STAGE(PG8_SA(0, 0), cA, vA[0]); PG8_STAGE(PG8_SA(0, 1), cA + hstepA, vA[1]);
    if (wr == 1) PG8_BAR;
    PG8_WAIT_V(2); PG8_BAR;
    PG8_STAGE(PG8_SB(1, 0), cB + kstep, voffB); PG8_STAGE(PG8_SA(1, 0), cA + kstep, vA[0]); PG8_STAGE(PG8_SB(1, 1), cB + hstepB + kstep, voffB1);
    PG8_WAIT_V(6); PG8_BAR;
    for (;;) {
        const bool has_next = S.next(ui + 1, nxt);
        if constexpr (Sched::UNIFORMIZE) { if (has_next) uniformize(nxt); }
        const char* nA = cA; const char* nB = cB;
        if (has_next) { nA = nxt.A; nB = nxt.B; }
        if constexpr (GATHER) { u32x4 pv; pv.x = vA[0][0]; pv.y = vA[0][1]; pv.z = vA[1][0]; pv.w = vA[1][1];
            if (has_next) PG8_VOFF(nxt, pv.x, pv.y, pv.z, pv.w);
            *park = pv; }
#pragma unroll 1
        for (int t = 0; t < nt; t += 2) {
            const bool last = (t == nt - 2);
            const char* a1 = cA + (size_t)(t + 1) * kstep;
            const char* a2 = last ? nA : cA + (size_t)(t + 2) * kstep; const char* b2 = last ? nB : cB + (size_t)(t + 2) * kstep;
            const char* a3 = a2 + kstep; const char* b3 = b2 + kstep;
            PG8_LDB(B0, 0, 0); PG8_LDB(B1, 0, 1); PG8_SCHED; PG8_LDA(At, 0, 0); PG8_STAGE(PG8_SA(1, 1), a1 + hstepA, vA[1]);
            PG8_WAIT_V(8); PG8_WAIT_L(0); PG8_BAR; PG8_MMA(0, 0, At, B0); PG8_MMA(0, 1, At, B1); PG8_BAR; PG8_SCHED;
            if constexpr (GATHER) { if (last) { const u32x4 pv = *park; vA[0][0] = pv.x; vA[0][1] = pv.y; vA[1][0] = pv.z; vA[1][1] = pv.w; } }
            PG8_LDA(At, 0, 1); PG8_STAGE(PG8_SB(0, 0), b2, voffB); PG8_STAGE(PG8_SB(0, 1), b2 + hstepB, voffB1); PG8_STAGE(PG8_SA(0, 0), a2, vA[0]);
            PG8_WAIT_V(8); PG8_WAIT_L(0); PG8_BAR; PG8_MMA(1, 0, At, B0); PG8_MMA(1, 1, At, B1); PG8_BAR; PG8_SCHED;
            PG8_LDB(B0, 1, 0); PG8_LDB(B1, 1, 1); PG8_SCHED; PG8_LDA(At, 1, 0); PG8_STAGE(PG8_SA(0, 1), a2 + hstepA, vA[1]);
            PG8_WAIT_V(8); PG8_WAIT_L(0); PG8_BAR; PG8_MMA(0, 0, At, B0); PG8_MMA(0, 1, At, B1); PG8_BAR; PG8_SCHED;
            PG8_LDA(At, 1, 1); PG8_STAGE(PG8_SB(1, 0), b3, voffB); PG8_STAGE(PG8_SB(1, 1), b3 + hstepB, voffB1); PG8_STAGE(PG8_SA(1, 0), a3, vA[0]);
            PG8_WAIT_V(8); PG8_WAIT_L(0); PG8_BAR; PG8_MMA(1, 0, At, B0); PG8_MMA(1, 1, At, B1); PG8_BAR; PG8_SCHED;
        }
        if (wr == 0) PG8_BAR;
        E(acc, cur, wr, wc, fr, fq);
        if (!has_next) break;
#pragma unroll
        for (int a = 0; a < 2; ++a)
#pragma unroll
            for (int b = 0; b < 2; ++b)
#pragma unroll
                for (int m = 0; m < 4; ++m)
#pragma unroll
                    for (int n = 0; n < 2; ++n) acc[a][b][m][n] = (f32x4){0.f, 0.f, 0.f, 0.f};
        cur = nxt; cA = nA; cB = nB; ++ui;
        if (wr == 1) PG8_BAR;
    }
    PG8_WAIT_V(0);
    PG8_BAR;
#undef PG8_SA
#undef PG8_SB
#undef PG8_STAGE
#undef PG8_LDA
#undef PG8_LDB
#undef PG8_LD2
#undef PG8_LO
#undef PG8_HI
#undef PG8_MMA
#undef PG8_WAIT_V
#undef PG8_WAIT_L
#undef PG8_BAR
#undef PG8_SCHED
#undef PG8_VOFF
}
}

constexpr size_t MiB = 1u << 20;
constexpr size_t WS_CTL = 0, CTL_ZERO_BYTES = 1 * MiB;
constexpr size_t WS_ATT_IN_T = 1 * MiB;
constexpr size_t WS_ATT_OUT_T = WS_ATT_IN_T + 36 * MiB;
constexpr size_t WS_RET_IN_T = WS_ATT_OUT_T + 4 * MiB;
constexpr size_t WS_RET_OUT_T = WS_RET_IN_T + 12 * MiB;
constexpr size_t WS_GLU_T = WS_RET_OUT_T + 4 * MiB;
constexpr size_t WS_RT_HI = WS_GLU_T + 4 * MiB;
constexpr size_t WS_RT_LO = WS_RT_HI + 512 * 1024;
constexpr size_t WS_WMOE = WS_RT_HI + 1 * MiB;
constexpr size_t WMOE_E_BYTES = (size_t)(512 * 1024 + 1024 * 256) * 2;
constexpr size_t WS_X = WS_WMOE + 98 * MiB;
constexpr size_t WS_Y = WS_X + 64 * MiB;
constexpr size_t WS_XB = WS_Y + 64 * MiB;
constexpr size_t WS_BIG = WS_XB + 32 * MiB;
constexpr size_t WS_AUX = WS_BIG + 288 * MiB;
constexpr size_t WS_H = WS_AUX + 160 * MiB;
constexpr size_t WS_LIST = WS_H + 80 * MiB;
constexpr size_t WS_TRASH = WS_LIST + 8 * MiB;
constexpr size_t WS_END = WS_TRASH + 1 * MiB;
static_assert(WS_END <= 1024 * MiB, "workspace map");
constexpr int CW_BAR = 4096;
constexpr int CW_CNT = 16384;
constexpr int CW_CHK = 65536;
constexpr int HROWS = 163840;

#define XB_TMO      128
#define XB_XCNT(j)  (256  + 64 * (j))
#define XB_XSUB(j)  (1280 + 64 * (j))
#define XB_XGEN(j)  (2304 + 64 * (j))
#define XB_TOP      3328
#define XB_TOPGEN   3392
#define XCD_BAR_WORDS 3456
#define XB_SPIN_CAP (1u << 20)
__device__ __forceinline__ unsigned xb_ld(unsigned* p)              { return __hip_atomic_load(p, __ATOMIC_RELAXED, __HIP_MEMORY_SCOPE_AGENT); }
__device__ __forceinline__ unsigned xb_add(unsigned* p, unsigned v) { return __hip_atomic_fetch_add(p, v, __ATOMIC_RELAXED, __HIP_MEMORY_SCOPE_AGENT); }
__device__ __forceinline__ unsigned xb_xcc_id() { return (unsigned)__builtin_amdgcn_s_getreg((3 << 11) | 20) & 0xFu; }
#define XB_SPIN(cond, bar) do { unsigned _sp = 0; while (cond) { __builtin_amdgcn_s_sleep(1); \
    if ((++_sp & 255u) == 0u) { if (xb_ld(&(bar)[XB_TMO])) break; if (_sp > XB_SPIN_CAP) { atomicAdd(&(bar)[XB_TMO], 1u); break; } } } } while (0)
struct XcdBarrier { unsigned* bar; unsigned x; volatile LAS unsigned* st; };
__device__ __forceinline__ XcdBarrier xcd_barrier_post(unsigned* bar, volatile LAS unsigned* st) {
    XcdBarrier b; b.bar = bar; b.x = xb_xcc_id(); b.st = st;
    if (threadIdx.x == 0) (void)xb_add(&bar[XB_XCNT(b.x)], 1u);
    return b;
}
__device__ __forceinline__ void xcd_barrier_complete(unsigned* bar, unsigned x, unsigned& nloc, unsigned& nx) {
    const unsigned G = gridDim.x * gridDim.y * gridDim.z;
    unsigned sum, cnt, mine, sp = 0u;
    for (;;) {
        sum = 0u; cnt = 0u; mine = 0u;
#pragma unroll
        for (unsigned j = 0; j < 16; ++j) { const unsigned c = xb_ld(&bar[XB_XCNT(j)]); sum += c; cnt += (c > 0u) ? 1u : 0u; mine = (j == x) ? c : mine; }
        if (sum == G) break;
        __builtin_amdgcn_s_sleep(1);
        if ((++sp & 255u) == 0u) { if (xb_ld(&bar[XB_TMO])) break; if (sp > XB_SPIN_CAP) { atomicAdd(&bar[XB_TMO], 1u); break; } }
    }
    nloc = mine > 0u ? mine : 1u; nx = cnt > 0u ? cnt : 1u;
}
__device__ __forceinline__ void xcd_barrier(const XcdBarrier& b) {
    asm volatile("s_waitcnt vmcnt(0)" ::: "memory");
    __syncthreads();
    if (threadIdx.x == 0) {
        unsigned* bar = b.bar;
        __builtin_amdgcn_s_waitcnt(0);
        unsigned nloc = b.st[0], nx = b.st[1];
        if (nloc == 0u) { xcd_barrier_complete(bar, b.x, nloc, nx); b.st[0] = nloc; b.st[1] = nx; }
        const unsigned old = xb_add(&bar[XB_XSUB(b.x)], 1u);
        const unsigned gen = old / nloc;
        if (old + 1u == (gen + 1u) * nloc) {
            __builtin_amdgcn_fence(__ATOMIC_RELEASE, "agent");
            asm volatile("s_waitcnt vmcnt(0)" ::: "memory");
            const unsigned og = xb_add(&bar[XB_TOP], 1u);
            const unsigned tg = og / nx;
            if (og + 1u == (tg + 1u) * nx) xb_add(&bar[XB_TOPGEN], 1u);
            else XB_SPIN(xb_ld(&bar[XB_TOPGEN]) == tg, bar);
            __builtin_amdgcn_fence(__ATOMIC_ACQUIRE, "agent");
            xb_add(&bar[XB_XGEN(b.x)], 1u);
            asm volatile("s_waitcnt vmcnt(0)" ::: "memory");
        } else {
            XB_SPIN(xb_ld(&bar[XB_XGEN(b.x)]) == gen, bar);
            __builtin_amdgcn_fence(__ATOMIC_ACQUIRE, "agent");
            asm volatile("s_waitcnt vmcnt(0)" ::: "memory");
        }
    }
    __syncthreads();
}

constexpr int RING_BYTES = 139264;
constexpr int MISC_OFF = RING_BYTES;
constexpr int LDS_BYTES = 147456;
struct Params {
    const float* in[26]; float* out; unsigned char* ws; int ph_lo, ph_hi; int use_bar, pad;
};
typedef const __attribute__((address_space(4))) Params* KP;
__device__ __forceinline__ const float* gin(KP p, int i) { return (const float*)(const GAS float*)p->in[i]; }
__device__ __forceinline__ float* gout(KP p) { return (float*)(GAS float*)p->out; }
struct Frame {
    LAS unsigned char* lds; volatile LAS unsigned* MISC;
    int tid, lane, wave, vcu, G;
    unsigned char* ws;
};

template <bool F8_ = false> struct DenseSchedT {
    static constexpr bool GATHER = false, UNIFORMIZE = false, FP8 = F8_;
    const char* A; const char* Bt; int K, nM, nN, nwg, G, c;
    __device__ __forceinline__ void init(const void* A_, const void* Bt_, int M, int N, int K_, int G_, int c_) { A = (const char*)A_; Bt = (const char*)Bt_; K = K_; nM = M / 256; nN = N / 256; nwg = nM * nN; G = G_; c = c_; }
    __device__ __forceinline__ bool next(int i, pg8::UnitG& u) const {
        const long L = (long)i * G + c; if (L >= nwg) return false;
        int wgid = (int)L; { const int q = nwg / 8, r = nwg % 8, xcd = wgid % 8, off = wgid / 8; wgid = (xcd < r ? xcd * (q + 1) : r * (q + 1) + (xcd - r) * q) + off; }
        const int nig = 8 * nN, gid = wgid / nig, fm = gid * 8, gsz = (nM - fm) < 8 ? (nM - fm) : 8;
        const int pm = fm + ((wgid % nig) % gsz), pn = (wgid % nig) / gsz;
        u.A = A + (size_t)pm * 256 * K * 2; u.B = Bt + (size_t)pn * 256 * K * 2; u.gidx = nullptr; u.gcnt = 0; u.gshift = 0; u.row0 = pm * 256; u.col0 = pn * 256; u.aux = 0; return true;
    }
};
typedef DenseSchedT<false> DenseSched; typedef DenseSchedT<true> DenseSched8;
__device__ __forceinline__ u32x4 pack_bf16x8(const f32x4& v0, const f32x4& v1) { u32x4 w; w.x = pk2hw(v0[0], v0[1]); w.y = pk2hw(v0[2], v0[3]); w.z = pk2hw(v1[0], v1[1]); w.w = pk2hw(v1[2], v1[3]); return w; }

constexpr float WUP_SCALE = 32.0f, WUP_INV = 1.0f / 32.0f;
struct EpiStoreBf16 {
    static constexpr bool PERM = true, PERM16 = false;
    bf16* O; int ldc; float osc, qsc;
    __device__ __forceinline__ void operator()(const f32x4 (&acc)[2][2][4][2], const pg8::UnitG& u, int wr, int wc, int fr, int fq) const {
        const float sc = ((u.col0 % 3072) < 1024) ? osc * qsc : osc;
#pragma unroll
        for (int ai = 0; ai < 2; ++ai)
#pragma unroll
            for (int m = 0; m < 4; ++m) { bf16* rowp = O + (size_t)(u.row0 + ai * 128 + wr * 64 + m * 16 + fr) * ldc + u.col0 + wc * 32 + 8 * fq;
#pragma unroll
                for (int bj = 0; bj < 2; ++bj) *(u32x4*)(rowp + bj * 128) = pack_bf16x8(acc[ai][bj][m][0] * sc, acc[ai][bj][m][1] * sc); }
    }
};
constexpr float YEXP_SCALE = 32.0f, YEXP_INV = 1.0f / 32.0f;
struct EpiStoreFp8 {
    static constexpr bool PERM = false, PERM16 = true;
    unsigned char* O; int ldc;
    __device__ __forceinline__ void operator()(const f32x4 (&acc)[2][2][4][2], const pg8::UnitG& u, int wr, int wc, int fr, int fq) const {
#pragma unroll
        for (int ai = 0; ai < 2; ++ai)
#pragma unroll
            for (int m = 0; m < 4; ++m) { unsigned char* rowp = O + (size_t)(u.row0 + ai * 128 + wr * 64 + m * 16 + fr) * ldc + u.col0 + wc * 64 + 16 * fq;
                u32x4 w;
#pragma unroll
                for (int q = 0; q < 4; ++q) { f32x4 v = acc[ai][q >> 1][m][q & 1] * YEXP_SCALE;
#pragma unroll
                    for (int j = 0; j < 4; ++j) v[j] = fminf(fmaxf(v[j], -448.0f), 448.0f);
                    int d = 0; d = __builtin_amdgcn_cvt_pk_fp8_f32(v[0], v[1], d, false); d = __builtin_amdgcn_cvt_pk_fp8_f32(v[2], v[3], d, true); w[q] = (unsigned)d; }
                *(u32x4*)rowp = w; }
    }
};
struct EpiRetIn {
    static constexpr bool PERM = true, PERM16 = false;
    bf16* O; int ldc;
    __device__ __forceinline__ void operator()(const f32x4 (&acc)[2][2][4][2], const pg8::UnitG& u, int wr, int wc, int fr, int fq) const {
        float l2g = 0.f;
        float cs = WUP_INV;
        if (u.col0 < 2048) { const int h = (u.col0 & 1023) >> 8; const float g = 1.0f - exp2f(-5.0f - (float)h); l2g = log2f(g); if (u.col0 >= 1024) { l2g = -l2g; cs *= 0.0625f; } }
#pragma unroll
        for (int ai = 0; ai < 2; ++ai)
#pragma unroll
            for (int m = 0; m < 4; ++m) { const int row = u.row0 + ai * 128 + wr * 64 + m * 16 + fr; const float sc = exp2f(l2g * (float)(row & 127)) * cs;
                bf16* rowp = O + (size_t)row * ldc + u.col0 + wc * 32 + 8 * fq;
#pragma unroll
                for (int bj = 0; bj < 2; ++bj) *(u32x4*)(rowp + bj * 128) = pack_bf16x8(acc[ai][bj][m][0] * sc, acc[ai][bj][m][1] * sc); }
    }
};
__device__ __forceinline__ void unpack_bf16x8(const u32x4& w, f32x4& a, f32x4& b) { a[0] = bflo(w.x); a[1] = bfhi(w.x); a[2] = bflo(w.y); a[3] = bfhi(w.y); b[0] = bflo(w.z); b[1] = bfhi(w.z); b[2] = bflo(w.w); b[3] = bfhi(w.w); }
struct EpiResid {
    static constexpr bool PERM = true, PERM16 = false;
    const bf16* X; bf16* Y;
    __device__ __forceinline__ void operator()(const f32x4 (&acc)[2][2][4][2], const pg8::UnitG& u, int wr, int wc, int fr, int fq) const {
#pragma unroll
        for (int ai = 0; ai < 2; ++ai)
#pragma unroll
            for (int m = 0; m < 4; ++m) { const size_t off = (size_t)(u.row0 + ai * 128 + wr * 64 + m * 16 + fr) * D + u.col0 + wc * 32 + 8 * fq;
#pragma unroll
                for (int bj = 0; bj < 2; ++bj) { const u32x4 xw = *(const u32x4*)(X + off + bj * 128); f32x4 x0, x1; unpack_bf16x8(xw, x0, x1);
                    *(u32x4*)(Y + off + bj * 128) = pack_bf16x8(x0 * ALPHA + acc[ai][bj][m][0], x1 * ALPHA + acc[ai][bj][m][1]); }
                if (m == 3) asm volatile("" ::: "memory"); }
    }
};
struct EpiGluResid {
    static constexpr bool PERM = true, PERM16 = false;
    const bf16* X; bf16* Y;
    __device__ __forceinline__ void operator()(const f32x4 (&acc)[2][2][4][2], const pg8::UnitG& u, int wr, int wc, int fr, int fq) const {
#pragma unroll
        for (int ai = 0; ai < 2; ++ai)
#pragma unroll
            for (int m = 0; m < 4; ++m) { const size_t off = (size_t)(u.row0 + ai * 128 + wr * 64 + m * 16 + fr) * D + (u.col0 >> 1) + wc * 32 + 8 * fq;
                const u32x4 xw = *(const u32x4*)(X + off); f32x4 x0, x1; unpack_bf16x8(xw, x0, x1); f32x4 o0, o1;
#pragma unroll
                for (int j = 0; j < 4; ++j) { o0[j] = x0[j] * ALPHA + acc[ai][0][m][0][j] / (1.0f + __expf(-acc[ai][1][m][0][j])); o1[j] = x1[j] * ALPHA + acc[ai][0][m][1][j] / (1.0f + __expf(-acc[ai][1][m][1][j])); }
                *(u32x4*)(Y + off) = pack_bf16x8(o0, o1);
                if (m == 3) asm volatile("" ::: "memory"); }
    }
};
struct EpiMoeUp {
    static constexpr bool PERM = true, PERM16 = false;
    bf16* H;
    __device__ __forceinline__ void operator()(const f32x4 (&acc)[2][2][4][2], const pg8::UnitG& u, int wr, int wc, int fr, int fq) const {
#pragma unroll
        for (int ai = 0; ai < 2; ++ai)
#pragma unroll
            for (int m = 0; m < 4; ++m) { bf16* rowp = H + (size_t)(u.row0 + ai * 128 + wr * 64 + m * 16 + fr) * ED + u.col0 + wc * 32 + 8 * fq; f32x4 o[2];
#pragma unroll
                for (int n = 0; n < 2; ++n)
#pragma unroll
                    for (int j = 0; j < 4; ++j) { const float g = acc[ai][0][m][n][j] * WUP_INV, up = acc[ai][1][m][n][j] * WUP_INV; o[n][j] = g / (1.0f + __expf(-g)) * up; }
                *(u32x4*)rowp = pack_bf16x8(o[0], o[1]); }
    }
};

__device__ __forceinline__ unsigned pk4_fp8(float a, float b, float c, float d) {
    a = fminf(fmaxf(a, -448.0f), 448.0f); b = fminf(fmaxf(b, -448.0f), 448.0f); c = fminf(fmaxf(c, -448.0f), 448.0f); d = fminf(fmaxf(d, -448.0f), 448.0f);
    int w = 0; w = __builtin_amdgcn_cvt_pk_fp8_f32(a, b, w, false); w = __builtin_amdgcn_cvt_pk_fp8_f32(c, d, w, true); return (unsigned)w; }
template <bool HILO>
__device__ __forceinline__ void conv_item(const float* W, int ldw, bf16* WT, bf16* WTlo, int ldk, int k0, int n0, int drow0, float scale, LAS float* scr, int lane) {
#pragma unroll 8
    for (int i = 0; i < 32; ++i) { const int kk = 2 * i + (lane >> 5); scr[kk * 33 + (lane & 31)] = W[(size_t)(k0 + kk) * ldw + n0 + (lane & 31)] * scale; }
    LDS_WAIT(); asm volatile("" ::: "memory");
    const int c = lane & 7;
#pragma unroll
    for (int j = 0; j < 4; ++j) { const int n = (lane >> 3) + 8 * j; const LAS float* s = scr + (8 * c) * 33 + n;
        float v[8];
#pragma unroll
        for (int q = 0; q < 8; ++q) v[q] = s[q * 33];
        u32x4 o; o.x = pk2(v[0], v[1]); o.y = pk2(v[2], v[3]); o.z = pk2(v[4], v[5]); o.w = pk2(v[6], v[7]);
        *(u32x4*)(WT + (size_t)(drow0 + n) * ldk + k0 + 8 * c) = o;
        if (HILO) { float r[8];
#pragma unroll
            for (int q = 0; q < 8; ++q) r[q] = v[q] - bf2f(f2bf(v[q]));
            u32x4 o2; o2.x = pk2(r[0], r[1]); o2.y = pk2(r[2], r[3]); o2.z = pk2(r[4], r[5]); o2.w = pk2(r[6], r[7]);
            *(u32x4*)(WTlo + (size_t)(drow0 + n) * ldk + k0 + 8 * c) = o2; } }
    LDS_WAIT(); asm volatile("" ::: "memory");
}
__device__ __forceinline__ void conv_item8(const float* W, int ldw, unsigned char* WT, int ldk, int k0, int n0, int drow0, float scale, LAS float* scr, int lane) {
#pragma unroll 8
    for (int i = 0; i < 32; ++i) { const int kk = 2 * i + (lane >> 5); scr[kk * 33 + (lane & 31)] = W[(size_t)(k0 + kk) * ldw + n0 + (lane & 31)] * scale; }
    LDS_WAIT(); asm volatile("" ::: "memory");
    const int c = lane & 7;
#pragma unroll
    for (int j = 0; j < 4; ++j) { const int n = (lane >> 3) + 8 * j; const LAS float* s = scr + (8 * c) * 33 + n;
        float v[8];
#pragma unroll
        for (int q = 0; q < 8; ++q) v[q] = s[q * 33];
        u32x2 o; o.x = pk4_fp8(v[0], v[1], v[2], v[3]); o.y = pk4_fp8(v[4], v[5], v[6], v[7]);
        *(u32x2*)(WT + (size_t)(drow0 + n) * ldk + k0 + 8 * c) = o; }
    LDS_WAIT(); asm volatile("" ::: "memory");
}
__device__ __forceinline__ void phase_conv_mixers(const Frame& F, KP p) {
    LAS float* scr = (LAS float*)(F.lds + F.wave * 16384);
    const int gw = F.vcu * NWAVES + F.wave, NGW = F.G * NWAVES;
    constexpr int I_AIN = 16 * 288, I_AOUT = 16 * 32, I_RIN = 16 * 192, I_ROUT = 32 * 32, I_GLU = 16 * 64, I_RT = 16 * 2;
    constexpr int NITEMS = 2 * I_AIN + 2 * I_AOUT + I_RIN + I_ROUT + I_GLU + 4 * I_RT;
    unsigned char* ws = F.ws;
    for (int it = gw; it < NITEMS; it += NGW) {
        int r = it;
        if (r < 2 * I_AIN) { const int j = r / I_AIN; r %= I_AIN; const int kb = r / 288, nb = r % 288, n0 = nb * 32;
            conv_item8(gin(p, 1) + (size_t)j * D * ATT_IN, ATT_IN, (unsigned char*)(ws + WS_ATT_IN_T) + (size_t)j * ATT_IN * D, D, kb * 64, n0, n0, WUP_SCALE, scr, F.lane); continue; }
        r -= 2 * I_AIN;
        if (r < 2 * I_AOUT) { const int j = r / I_AOUT; r %= I_AOUT; const int kb = r / 32, nb = r % 32, n0 = nb * 32;
            conv_item<false>(gin(p, 2) + (size_t)j * D * D, D, (bf16*)(ws + WS_ATT_OUT_T) + (size_t)j * D * D, nullptr, D, kb * 64, n0, n0, 1.0f, scr, F.lane); continue; }
        r -= 2 * I_AOUT;
        if (r < I_RIN) { const int kb = r / 192, nb = r % 192, n0 = nb * 32;
            conv_item8(gin(p, 3), RET_IN, (unsigned char*)(ws + WS_RET_IN_T), D, kb * 64, n0, n0, WUP_SCALE, scr, F.lane); continue; }
        r -= I_RIN;
        if (r < I_ROUT) { const int kb = r / 32, nb = r % 32, n0 = nb * 32;
            conv_item<false>(gin(p, 6), D, (bf16*)(ws + WS_RET_OUT_T), nullptr, RET_V, kb * 64, n0, n0, 1.0f, scr, F.lane); continue; }
        r -= I_ROUT;
        if (r < I_GLU) { const int kb = r / 64, nb = r % 64, n0 = nb * 32; const int c = n0 & 1023, drow = (c >> 7) * 256 + (n0 >> 10) * 128 + (c & 127);
            conv_item<false>(gin(p, 15), 2 * D, (bf16*)(ws + WS_GLU_T), nullptr, D, kb * 64, n0, drow, 1.0f, scr, F.lane); continue; }
        r -= I_GLU;
        { const int l = r / I_RT; r %= I_RT; const int kb = r / 2, nb = r % 2, n0 = nb * 32;
            conv_item<true>(gin(p, 16) + (size_t)l * D * NE, NE, (bf16*)(ws + WS_RT_HI) + (size_t)l * NE * D, (bf16*)(ws + WS_RT_LO) + (size_t)l * NE * D, D, kb * 64, n0, n0, 1.0f, scr, F.lane); }
    }
}
__device__ __forceinline__ void phase_conv_moe(const Frame& F, KP p, int l) {
    LAS float* scr = (LAS float*)(F.lds + F.wave * 16384);
    const int gw = F.vcu * NWAVES + F.wave, NGW = F.G * NWAVES;
    for (int it = gw; it < 65 * 384; it += NGW) {
        const int e = it / 384, r = it % 384, which = r >> 7, rr = r & 127;
        bf16* We = (bf16*)(F.ws + WS_WMOE + (size_t)e * WMOE_E_BYTES);
        if (which < 2) { const float* src = (e < 64) ? gin(p, 18 + which) + ((size_t)l * NE + e) * D * ED : gin(p, 21 + which) + (size_t)l * D * ED;
            const int kb = rr >> 3, nb = rr & 7, n0 = nb * 32; const int drow = (n0 >> 7) * 256 + which * 128 + (n0 & 127);
            conv_item8(src, ED, (unsigned char*)We, D, kb * 64, n0, drow, WUP_SCALE, scr, F.lane);
        } else { const float* src = (e < 64) ? gin(p, 20) + ((size_t)l * NE + e) * ED * D : gin(p, 23) + (size_t)l * ED * D;
            const int kb = rr >> 5, nb = rr & 31, n0 = nb * 32;
            conv_item<false>(src, D, We + 512 * 1024, nullptr, ED, kb * 64, n0, n0, 1.0f, scr, F.lane); }
    }
}

__device__ __forceinline__ void phase_lnr(const Frame& F, KP p, int layer, bool dry = false) {
    const bf16* Y = (const bf16*)(F.ws + WS_Y); bf16* XB = (bf16*)(F.ws + WS_XB); unsigned char* XB8 = (unsigned char*)(F.ws + WS_X);
    const float* lng = gin(p, 24) + (size_t)(layer * 2) * D; const float* lnb = gin(p, 25) + (size_t)(layer * 2) * D;
    const bf16* rthi = (const bf16*)(F.ws + WS_RT_HI) + (size_t)layer * NE * D; const bf16* rtlo = (const bf16*)(F.ws + WS_RT_LO) + (size_t)layer * NE * D;
    const float* rbias = gin(p, 17) + layer * NE;
    unsigned* cnt = (unsigned*)(F.ws + WS_CTL) + CW_CNT + layer * NE * 64;
    int* lists = (int*)(F.ws + WS_LIST); int* tokmap = (int*)(F.ws + WS_LIST + 4 * MiB); float* tokgate = (float*)(F.ws + WS_LIST + 5 * MiB);
    constexpr int XLD = 1032, MAXT = 8;
    LAS bf16* Xhi = (LAS bf16*)F.lds; LAS bf16* Xlo = Xhi + 16 * XLD;
    LAS float* part = (LAS float*)(F.lds + 2 * 16 * XLD * 2);
    LAS int* ent = (LAS int*)(part + 2 * 16 * 64);
    LAS int* hist = ent + MAXT * 16 * 8 * 2; LAS int* base = hist + 64;
    const int lane = F.lane, w = F.wave, g4 = lane >> 4, l15 = lane & 15;
    if (F.tid < 64) hist[F.tid] = 0;
    f32x4 gv[4], bv[4];
#pragma unroll
    for (int j = 0; j < 2; ++j) { gv[2 * j] = *(const f32x4*)(lng + 8 * lane + 512 * j); gv[2 * j + 1] = *(const f32x4*)(lng + 8 * lane + 512 * j + 4);
        bv[2 * j] = *(const f32x4*)(lnb + 8 * lane + 512 * j); bv[2 * j + 1] = *(const f32x4*)(lnb + 8 * lane + 512 * j + 4); }
    int ntile = 0;
    for (int tile = F.vcu; tile < T / 16 && ntile < MAXT; tile += F.G, ++ntile) {
        const int t0 = tile * 16;
#pragma unroll
        for (int rr = 0; rr < 2; ++rr) {
            const int lr = 2 * w + rr; const size_t row = (size_t)(t0 + lr);
            f32x4 v[4]; float s = 0.f;
#pragma unroll
            for (int j = 0; j < 2; ++j) { const u32x4 yw = *(const u32x4*)(Y + row * D + 8 * lane + 512 * j); unpack_bf16x8(yw, v[2 * j], v[2 * j + 1]); }
#pragma unroll
            for (int j = 0; j < 4; ++j) s += (v[j][0] + v[j][1]) + (v[j][2] + v[j][3]);
            const float mean = wave_sum(s, lane) * (1.f / D); float s2 = 0.f;
#pragma unroll
            for (int j = 0; j < 4; ++j) { v[j] = v[j] - mean; s2 += (v[j][0] * v[j][0] + v[j][1] * v[j][1]) + (v[j][2] * v[j][2] + v[j][3] * v[j][3]); }
            const float rstd = 1.0f / sqrtf(wave_sum(s2, lane) * (1.f / D) + LN_EPS);
#pragma unroll
            for (int j = 0; j < 2; ++j) { const f32x4 o0 = v[2 * j] * rstd * gv[2 * j] + bv[2 * j], o1 = v[2 * j + 1] * rstd * gv[2 * j + 1] + bv[2 * j + 1];
                const u32x4 hi = pack_bf16x8(o0, o1);
                *(u32x4*)(XB + row * D + 8 * lane + 512 * j) = hi;
                { u32x2 q8; q8.x = pk4_fp8(o0[0], o0[1], o0[2], o0[3]); q8.y = pk4_fp8(o1[0], o1[1], o1[2], o1[3]); *(u32x2*)(XB8 + row * D + 8 * lane + 512 * j) = q8; }
                f32x4 h0, h1; unpack_bf16x8(hi, h0, h1); const u32x4 lo = pack_bf16x8(o0 - h0, o1 - h1);
                *(LAS u32x4*)(Xhi + lr * XLD + 8 * lane + 512 * j) = hi; *(LAS u32x4*)(Xlo + lr * XLD + 8 * lane + 512 * j) = lo; }
        }
        __syncthreads();
        { const int nt = w & 3, kh = w >> 2; f32x4 acc = (f32x4){0.f, 0.f, 0.f, 0.f};
            const bf16* bh = rthi + (size_t)(16 * nt + l15) * D + 512 * kh + 8 * g4; const bf16* bl = rtlo + (size_t)(16 * nt + l15) * D + 512 * kh + 8 * g4;
#pragma unroll 8
            for (int ks = 0; ks < 16; ++ks) { const int k0 = 512 * kh + 32 * ks;
                const bf16x8 ahi = row_frag(Xhi, XLD, 0, k0, lane), alo = row_frag(Xlo, XLD, 0, k0, lane);
                const bf16x8 bhi = *(const bf16x8*)(bh + 32 * ks), blo = *(const bf16x8*)(bl + 32 * ks);
                acc = MFMA16(ahi, bhi, acc); acc = MFMA16(alo, bhi, acc); acc = MFMA16(ahi, blo, acc); }
#pragma unroll
            for (int i = 0; i < 4; ++i) part[(kh * 16 + 4 * g4 + i) * 64 + 16 * nt + l15] = acc[i];
        }
        __syncthreads();
#pragma unroll
        for (int rr = 0; rr < 2; ++rr) {
            const int lt = ntile * 16 + 2 * w + rr;
            const float lg = part[(2 * w + rr) * 64 + lane] + part[(16 + 2 * w + rr) * 64 + lane];
            float sc = 1.0f / (1.0f + expf(-lg)); sc = (sc == sc) ? sc : 0.5f;
            const float sel = sc + rbias[lane];
            float m1 = sel; m1 = fmaxf(m1, shx(m1, 1, lane)); m1 = fmaxf(m1, shx(m1, 2, lane)); m1 = fmaxf(m1, shx(m1, 4, lane));
            const unsigned long long eq = __ballot(sel == m1);
            const unsigned gm = (unsigned)(eq >> (lane & 56)) & 0xffu;
            const int first = (lane & 56) + __builtin_ctz(gm | 0x100u);
            float m2 = (lane == first) ? -INFINITY : sel; m2 = fmaxf(m2, shx(m2, 1, lane)); m2 = fmaxf(m2, shx(m2, 2, lane)); m2 = fmaxf(m2, shx(m2, 4, lane));
            const float gs = m1 + m2; const int mygrp = lane >> 3; int grank = 0;
#pragma unroll
            for (int gg = 0; gg < 8; ++gg) { const float o = rdl(gs, 8 * gg); grank += (o > gs || (o == gs && gg < mygrp)) ? 1 : 0; }
            const float mv = (grank < 4) ? sel : -INFINITY; int rank = 0;
#pragma unroll
            for (int e2 = 0; e2 < 64; ++e2) { const float o = rdl(mv, e2); rank += (o > mv || (o == mv && e2 < lane)) ? 1 : 0; }
            const bool chosen = rank < TOPK;
            const float wsum = wave_sum(chosen ? sc : 0.f, lane);
            if (chosen) { const int lpos = __hip_atomic_fetch_add(hist + lane, 1, __ATOMIC_RELAXED, __HIP_MEMORY_SCOPE_WORKGROUP);
                ent[(lt * 8 + rank) * 2] = (lane << 16) | lpos; ent[(lt * 8 + rank) * 2 + 1] = __builtin_bit_cast(int, sc / wsum * 2.5f); }
        }
    }
    __syncthreads();
    if (dry) return;
    if (F.tid < 64) { const int hcount = hist[F.tid]; base[F.tid] = hcount ? (int)atomicAdd(cnt + F.tid * 64, (unsigned)hcount) : 0; }
    __syncthreads();
    for (int idx = F.tid; idx < ntile * 16 * 8; idx += NTHREADS) {
        const int ev = ent[idx * 2], gb = ent[idx * 2 + 1]; const int e = ev >> 16, pos = base[e] + (ev & 0xffff);
        const int lt = idx >> 3, rank = idx & 7, tok = (F.vcu + (lt >> 4) * F.G) * 16 + (lt & 15);
        lists[(size_t)e * T + pos] = tok; tokmap[tok * 8 + rank] = (e << 16) | pos; tokgate[tok * 8 + rank] = __builtin_bit_cast(float, gb);
    }
}

__device__ __forceinline__ void phase_combine(const Frame& F, KP p, int layer, bool dry = false) {
    bf16* XB = (bf16*)(F.ws + WS_XB); const unsigned char* yexp = (const unsigned char*)(F.ws + WS_BIG);
    const int* tokmap = (const int*)(F.ws + WS_LIST + 4 * MiB); const float* tokgate = (const float*)(F.ws + WS_LIST + 5 * MiB);
    const volatile LAS int* tstart = (const volatile LAS int*)(F.MISC + 64);
    const float* lng = gin(p, 24) + (size_t)(layer * 2 + 1) * D; const float* lnb = gin(p, 25) + (size_t)(layer * 2 + 1) * D;
    float* outp = gout(p); bf16* xbo = XB; if (dry) { outp = (float*)(F.ws + WS_AUX); xbo = (bf16*)(F.ws + WS_H); }
    const int lane = F.lane, gw = F.vcu * NWAVES + F.wave, NGW = F.G * NWAVES;
    const bf16* ysh = (const bf16*)(F.ws + WS_Y);
    f32x4 gv[4], bv[4];
#pragma unroll
    for (int j = 0; j < 4; ++j) { gv[j] = *(const f32x4*)(lng + 16 * lane + 4 * j); bv[j] = *(const f32x4*)(lnb + 16 * lane + 4 * j); }
    for (int row = gw; row < T; row += NGW) {
        const int mk = tokmap[row * 8 + (lane & 7)]; const float gk = tokgate[row * 8 + (lane & 7)] * YEXP_INV;
        const int rk = (int)tstart[mk >> 16] * 256 + (mk & 0xffff);
        f32x4 v[4];
#pragma unroll
        for (int j = 0; j < 2; ++j) { const u32x4 xw = *(const u32x4*)(ysh + (size_t)row * D + 16 * lane + 8 * j); unpack_bf16x8(xw, v[2 * j], v[2 * j + 1]); }
#pragma unroll
        for (int k = 0; k < TOPK; ++k) { const int r = __builtin_amdgcn_readlane(rk, k); const float g = rdl(gk, k);
            const u32x4 s = *(const u32x4*)(yexp + (size_t)r * D + 16 * lane);
#pragma unroll
            for (int j = 0; j < 4; ++j) { const f32x2 lo = __builtin_amdgcn_cvt_pk_f32_fp8((int)s[j], false), hi = __builtin_amdgcn_cvt_pk_f32_fp8((int)s[j], true);
                v[j][0] += g * lo[0]; v[j][1] += g * lo[1]; v[j][2] += g * hi[0]; v[j][3] += g * hi[1]; } }
        float s = 0.f;
#pragma unroll
        for (int j = 0; j < 4; ++j) s += (v[j][0] + v[j][1]) + (v[j][2] + v[j][3]);
        const float mean = wave_sum(s, lane) * (1.f / D); float s2 = 0.f;
#pragma unroll
        for (int j = 0; j < 4; ++j) { v[j] = v[j] - mean; s2 += (v[j][0] * v[j][0] + v[j][1] * v[j][1]) + (v[j][2] * v[j][2] + v[j][3] * v[j][3]); }
        const float rstd = 1.0f / sqrtf(wave_sum(s2, lane) * (1.f / D) + LN_EPS);
        f32x4 o[4];
#pragma unroll
        for (int j = 0; j < 4; ++j) o[j] = v[j] * rstd * gv[j] + bv[j];
        if (layer == DEPTH - 1 || dry) {
#pragma unroll
            for (int j = 0; j < 4; ++j) *(f32x4*)(outp + (size_t)row * D + 16 * lane + 4 * j) = o[j]; }
        if (layer != DEPTH - 1) { *(u32x4*)(xbo + (size_t)row * D + 16 * lane) = pack_bf16x8(o[0], o[1]); *(u32x4*)(xbo + (size_t)row * D + 16 * lane + 8) = pack_bf16x8(o[2], o[3]);
            if (!dry) { u32x4 q8; q8.x = pk4_fp8(o[0][0], o[0][1], o[0][2], o[0][3]); q8.y = pk4_fp8(o[1][0], o[1][1], o[1][2], o[1][3]); q8.z = pk4_fp8(o[2][0], o[2][1], o[2][2], o[2][3]); q8.w = pk4_fp8(o[3][0], o[3][1], o[3][2], o[3][3]);
                *(u32x4*)((unsigned char*)(F.ws + WS_X) + (size_t)row * D + 16 * lane) = q8; } }
    }
}

constexpr size_t AUX_OB = 96 * MiB, AUX_LSE = 128 * MiB;
__device__ __forceinline__ void phase_attn(const Frame& F, int bx) {
    const bf16* qkv = (const bf16*)(F.ws + WS_BIG); bf16* og = (bf16*)(F.ws + WS_AUX); float* lse = (float*)(F.ws + WS_AUX + AUX_LSE);
    constexpr int KLD = 136;
    LAS bf16* Ks = (LAS bf16*)F.lds; LAS bf16* Vs = Ks + 256 * KLD;
    const int lane = F.lane, w = F.wave, g4 = lane >> 4, l15 = lane & 15, qq = l15 >> 2, pp = lane & 3;
    u32x4 kreg[8], vreg[8];
#define ATT_DECODE(L_) const int h = (L_) & 7, sb = (L_) >> 3, g = sb >> 7, rem = sb & 127, b = rem >> 6, rn = rem & 63; \
        const int dsh = 2 * g, d = 1 << dsh, nbs = 6 - dsh, r = rn >> nbs, n = rn & ((1 << nbs) - 1); const size_t rowbase = (size_t)b * SEQ;
#define ATT_ISSUE(L_) do { ATT_DECODE(L_) _Pragma("unroll") for (int it = 0; it < 8; ++it) { const int idx = F.tid + 512 * it, c = idx >> 4, ch = idx & 15; int pos = 128 * (n - 1) + c; pos = pos < 0 ? 0 : pos; \
            const bf16* src = qkv + (rowbase + (size_t)pos * d + r) * ATT_IN + g * 3072 + 1024 + h * 128 + ch * 8; kreg[it] = *(const u32x4*)src; vreg[it] = *(const u32x4*)(src + 1024); } } while (0)
    if (bx < 3072) ATT_ISSUE(bx);
    for (int L = bx; L < 3072; L += F.G) {
        ATT_DECODE(L)
#pragma unroll
        for (int it = 0; it < 8; ++it) { const int idx = F.tid + 512 * it, c = idx >> 4, ch = idx & 15;
            *(LAS u32x4*)(Ks + c * KLD + ch * 8) = kreg[it]; *(LAS u32x4*)(Vs + c * KLD + ch * 8) = vreg[it]; }
        const int qi = 16 * w + l15; const size_t qrow = rowbase + (size_t)(128 * n + qi) * d + r;
        bf16x8 qf[4];
#pragma unroll
        for (int s = 0; s < 4; ++s) qf[s] = *(const bf16x8*)(qkv + qrow * ATT_IN + g * 3072 + h * 128 + 32 * s + 8 * g4);
        __syncthreads();
        if (L + F.G < 3072) { ATT_ISSUE(L + F.G); }
        __builtin_amdgcn_sched_barrier(0);
        const int ws0 = (16 * w < 96) ? 16 * w : 96;
        f32x4 sacc[10];
        {
            bf16x8 kfa[4], kfb[4];
#pragma unroll
            for (int s = 0; s < 4; ++s) kfa[s] = row_frag(Ks, KLD, ws0, 32 * s, lane);
#pragma unroll
            for (int t = 0; t < 10; t += 2) {
#pragma unroll
                for (int s = 0; s < 4; ++s) kfb[s] = row_frag(Ks, KLD, ws0 + 16 * (t + 1), 32 * s, lane);
                __builtin_amdgcn_sched_barrier(0);
                sacc[t] = (f32x4){0.f, 0.f, 0.f, 0.f};
#pragma unroll
                for (int s = 0; s < 4; ++s) sacc[t] = MFMA16(kfa[s], qf[s], sacc[t]);
                if (t + 2 < 10) {
#pragma unroll
                    for (int s = 0; s < 4; ++s) kfa[s] = row_frag(Ks, KLD, ws0 + 16 * (t + 2), 32 * s, lane); }
                __builtin_amdgcn_sched_barrier(0);
                sacc[t + 1] = (f32x4){0.f, 0.f, 0.f, 0.f};
#pragma unroll
                for (int s = 0; s < 4; ++s) sacc[t + 1] = MFMA16(kfb[s], qf[s], sacc[t + 1]);
            }
        }
        const float slope = exp2f(-(float)(h + 1)) * (float)d;
        float mx = -INFINITY;
#pragma unroll
        for (int t = 0; t < 10; ++t)
#pragma unroll
            for (int i = 0; i < 4; ++i) { const int c = ws0 + 16 * t + 4 * g4 + i, step = 128 + qi - c;
                const bool valid = (step >= 0) && (step <= 128) && (n > 0 || c >= 128);
                const float v = valid ? sacc[t][i] - slope * (float)step : -INFINITY; sacc[t][i] = v; mx = fmaxf(mx, v); }
        mx = fmaxf(mx, shx(mx, 16, lane)); mx = fmaxf(mx, shx(mx, 32, lane));
        float lsum = 0.f;
#pragma unroll
        for (int t = 0; t < 10; ++t)
#pragma unroll
            for (int i = 0; i < 4; ++i) { const float pv = __expf(sacc[t][i] - mx); sacc[t][i] = pv; lsum += pv; }
        lsum += shx(lsum, 16, lane); lsum += shx(lsum, 32, lane);
        bf16x8 pf[5];
#pragma unroll
        for (int kt = 0; kt < 5; ++kt) pf[kt] = pack8(sacc[2 * kt], sacc[2 * kt + 1]);
        f32x4 o[8];
        {
            const LAS bf16* vb = Vs + (ws0 + 4 * g4 + qq) * KLD + 32 * pp;
            bf16x4 va[10], vc[10];
#pragma unroll
            for (int kt = 0; kt < 5; ++kt) { va[2 * kt] = tr4(vb + 32 * kt * KLD); va[2 * kt + 1] = tr4(vb + (32 * kt + 16) * KLD); }
#pragma unroll
            for (int et = 0; et < 8; et += 2) {
#pragma unroll
                for (int kt = 0; kt < 5; ++kt) { vc[2 * kt] = tr4(vb + 32 * kt * KLD + 4 * (et + 1)); vc[2 * kt + 1] = tr4(vb + (32 * kt + 16) * KLD + 4 * (et + 1)); }
                __builtin_amdgcn_sched_barrier(0);
                o[et] = (f32x4){0.f, 0.f, 0.f, 0.f};
#pragma unroll
                for (int kt = 0; kt < 5; ++kt) o[et] = MFMA16(cat8(va[2 * kt], va[2 * kt + 1]), pf[kt], o[et]);
                if (et + 2 < 8) {
#pragma unroll
                    for (int kt = 0; kt < 5; ++kt) { va[2 * kt] = tr4(vb + 32 * kt * KLD + 4 * (et + 2)); va[2 * kt + 1] = tr4(vb + (32 * kt + 16) * KLD + 4 * (et + 2)); } }
                __builtin_amdgcn_sched_barrier(0);
                o[et + 1] = (f32x4){0.f, 0.f, 0.f, 0.f};
#pragma unroll
                for (int kt = 0; kt < 5; ++kt) o[et + 1] = MFMA16(cat8(vc[2 * kt], vc[2 * kt + 1]), pf[kt], o[et + 1]);
            }
        }
        const float inv = 1.0f / lsum;
        bf16* orow = og + ((size_t)g * T + qrow) * D + h * 128 + 32 * g4;
#pragma unroll
        for (int e2 = 0; e2 < 4; ++e2) *(u32x4*)(orow + 8 * e2) = pack_bf16x8(o[2 * e2] * inv, o[2 * e2 + 1] * inv);
        if (g4 == 0) lse[((size_t)g * T + qrow) * AH + h] = mx + __logf(lsum);
        __syncthreads();
    }
#undef ATT_DECODE
#undef ATT_ISSUE
}
__device__ __forceinline__ void phase_attn_combine(const Frame& F) {
    const bf16* og = (const bf16*)(F.ws + WS_AUX); const float* lse = (const float*)(F.ws + WS_AUX + AUX_LSE); bf16* ob = (bf16*)(F.ws + WS_AUX + AUX_OB);
    const int lane = F.lane, gw = F.vcu * NWAVES + F.wave, NGW = F.G * NWAVES, h = lane >> 3;
    for (int row = gw; row < T; row += NGW) {
        const float l0 = lse[((size_t)0 * T + row) * AH + h], l1 = lse[((size_t)1 * T + row) * AH + h], l2 = lse[((size_t)2 * T + row) * AH + h];
        const float m = fmaxf(l0, fmaxf(l1, l2)); float w0 = __expf(l0 - m), w1 = __expf(l1 - m), w2 = __expf(l2 - m); const float inv = 1.0f / (w0 + w1 + w2); w0 *= inv; w1 *= inv; w2 *= inv;
        float a[16];
#pragma unroll
        for (int j = 0; j < 16; ++j) a[j] = 0.f;
#pragma unroll
        for (int g = 0; g < 3; ++g) { const float wg = (g == 0) ? w0 : (g == 1 ? w1 : w2);
#pragma unroll
            for (int q = 0; q < 2; ++q) { const u32x4 s = *(const u32x4*)(og + ((size_t)g * T + row) * D + 16 * lane + 8 * q);
                a[8 * q + 0] += wg * bflo(s.x); a[8 * q + 1] += wg * bfhi(s.x); a[8 * q + 2] += wg * bflo(s.y); a[8 * q + 3] += wg * bfhi(s.y);
                a[8 * q + 4] += wg * bflo(s.z); a[8 * q + 5] += wg * bfhi(s.z); a[8 * q + 6] += wg * bflo(s.w); a[8 * q + 7] += wg * bfhi(s.w); } }
#pragma unroll
        for (int q = 0; q < 2; ++q) { u32x4 o; o.x = pk2(a[8 * q], a[8 * q + 1]); o.y = pk2(a[8 * q + 2], a[8 * q + 3]); o.z = pk2(a[8 * q + 4], a[8 * q + 5]); o.w = pk2(a[8 * q + 6], a[8 * q + 7]);
            *(u32x4*)(ob + (size_t)row * D + 16 * lane + 8 * q) = o; }
    }
}

constexpr size_t BIG_YRET = 192 * MiB;
__device__ __forceinline__ void phase_ret_u(const Frame& F) {
    const bf16* proj = (const bf16*)(F.ws + WS_BIG); bf16* St = (bf16*)(F.ws + WS_AUX);
    constexpr int LD = 264;
    LAS bf16* Kt = (LAS bf16*)F.lds; LAS bf16* Vt = Kt + 128 * LD;
    const int lane = F.lane, w = F.wave, g4 = lane >> 4, l15 = lane & 15, qq = l15 >> 2, pp = lane & 3;
    for (int u = F.vcu; u < 1024; u += F.G) {
        const int eh = u & 1, h = (u >> 1) & 3, n = (u >> 3) & 63, b = u >> 9;
        const size_t row0 = (size_t)b * SEQ + (size_t)n * RC;
#pragma unroll 4
        for (int it = 0; it < 8; ++it) { const int idx = F.tid + 512 * it, j = idx >> 5, ch = idx & 31;
            const bf16* src = proj + (row0 + j) * RET_IN;
            const u32x4 kv = *(const u32x4*)(src + 1024 + h * 256 + ch * 8), vv = *(const u32x4*)(src + 2048 + h * 512 + eh * 256 + ch * 8);
            *(LAS u32x4*)(Kt + j * LD + ch * 8) = kv; *(LAS u32x4*)(Vt + j * LD + ch * 8) = vv; }
        __syncthreads();
        f32x4 acc[16][2];
#pragma unroll
        for (int mt = 0; mt < 16; ++mt) { acc[mt][0] = (f32x4){0.f, 0.f, 0.f, 0.f}; acc[mt][1] = (f32x4){0.f, 0.f, 0.f, 0.f}; }
#pragma unroll
        for (int ks = 0; ks < 4; ++ks) {
            bf16x8 bfr[2];
#pragma unroll
            for (int nt = 0; nt < 2; ++nt) { const LAS bf16* a0 = Vt + (32 * ks + 8 * g4 + qq) * LD + 32 * w + 16 * nt + 4 * pp; bfr[nt] = cat8(tr4(a0), tr4(a0 + 4 * LD)); }
#pragma unroll
            for (int mt = 0; mt < 16; ++mt) { const LAS bf16* a0 = Kt + (32 * ks + 8 * g4 + qq) * LD + 128 * (mt >> 3) + 32 * pp + 4 * (mt & 7);
                const bf16x8 afr = cat8(tr4(a0), tr4(a0 + 4 * LD));
                acc[mt][0] = MFMA16(afr, bfr[0], acc[mt][0]); acc[mt][1] = MFMA16(afr, bfr[1], acc[mt][1]); }
        }
        bf16* outb = St + ((size_t)((b * RH + h) * RNC + n)) * (RDV * RDK);
#pragma unroll
        for (int nt = 0; nt < 2; ++nt) { bf16* orow = outb + (size_t)(eh * 256 + 32 * w + 16 * nt + l15) * RDK + 32 * g4;
#pragma unroll
            for (int mh = 0; mh < 2; ++mh)
#pragma unroll
                for (int q = 0; q < 4; ++q) *(u32x4*)(orow + 128 * mh + 8 * q) = pack_bf16x8(acc[mh * 8 + 2 * q][nt], acc[mh * 8 + 2 * q + 1][nt]); }
        __syncthreads();
    }
}
__device__ __forceinline__ void phase_ret_scan(const Frame& F) {
    bf16* St = (bf16*)(F.ws + WS_AUX);
    for (int gt = F.vcu * NTHREADS + F.tid; gt < 8 * 16384; gt += F.G * NTHREADS) {
        const int bh = gt >> 14, chunk = gt & 16383, h = bh & 3;
        const float g128 = exp2f(128.0f * log2f(1.0f - exp2f(-5.0f - (float)h)));
        bf16* base = St + (size_t)bh * RNC * (RDV * RDK) + (size_t)chunk * 8;
        float c[8];
#pragma unroll
        for (int j = 0; j < 8; ++j) c[j] = 0.f;
#pragma unroll 8
        for (int n = 0; n < RNC; ++n) { bf16* pn = base + (size_t)n * (RDV * RDK); const u32x4 uv = *(const u32x4*)pn;
            u32x4 o; o.x = pk2(c[0], c[1]); o.y = pk2(c[2], c[3]); o.z = pk2(c[4], c[5]); o.w = pk2(c[6], c[7]); *(u32x4*)pn = o;
            c[0] = g128 * (c[0] + bflo(uv.x)); c[1] = g128 * (c[1] + bfhi(uv.x)); c[2] = g128 * (c[2] + bflo(uv.y)); c[3] = g128 * (c[3] + bfhi(uv.y));
            c[4] = g128 * (c[4] + bflo(uv.z)); c[5] = g128 * (c[5] + bfhi(uv.z)); c[6] = g128 * (c[6] + bflo(uv.w)); c[7] = g128 * (c[7] + bfhi(uv.w)); }
    }
}
__device__ __forceinline__ void phase_ret_out(const Frame& F, KP p) {
    const bf16* proj = (const bf16*)(F.ws + WS_BIG); const bf16* St = (const bf16*)(F.ws + WS_AUX); bf16* yret = (bf16*)(F.ws + WS_BIG + BIG_YRET);
    const float* gng = gin(p, 4); const float* gnb = gin(p, 5);
    constexpr int LD = 264, VLD = 136;
    LAS bf16* Rs = (LAS bf16*)F.lds; LAS bf16* Vs = Rs + 128 * LD;
    const int lane = F.lane, w = F.wave, g4 = lane >> 4, l15 = lane & 15, qq = l15 >> 2, pp = lane & 3;
    for (int u = F.vcu; u < 512; u += F.G) {
        const int h = u & 3, n = (u >> 2) & 63, b = u >> 8;
        const size_t row0 = (size_t)b * SEQ + (size_t)n * RC;
#pragma unroll 4
        for (int it = 0; it < 8; ++it) { const int idx = F.tid + 512 * it, j = idx >> 5, ch = idx & 31;
            *(LAS u32x4*)(Rs + j * LD + ch * 8) = *(const u32x4*)(proj + (row0 + j) * RET_IN + 1024 + h * 256 + ch * 8); }
        const int irow = 16 * w + l15; const size_t qrow = row0 + irow;
        bf16x8 qf[8];
#pragma unroll
        for (int s = 0; s < 8; ++s) qf[s] = *(const bf16x8*)(proj + qrow * RET_IN + h * 256 + 32 * s + 8 * g4);
        __syncthreads();
        bf16x8 pf[4];
        { f32x4 sacc[8];
#pragma unroll
            for (int jt = 0; jt < 8; ++jt) { sacc[jt] = (f32x4){0.f, 0.f, 0.f, 0.f};
                if (jt <= w) {
#pragma unroll
                    for (int s = 0; s < 8; ++s) sacc[jt] = MFMA16(row_frag(Rs, LD, 16 * jt, 32 * s, lane), qf[s], sacc[jt]);
#pragma unroll
                    for (int i = 0; i < 4; ++i) if (16 * jt + 4 * g4 + i > irow) sacc[jt][i] = 0.f; } }
#pragma unroll
            for (int kt = 0; kt < 4; ++kt) pf[kt] = pack8(sacc[2 * kt], sacc[2 * kt + 1]); }
        __syncthreads();
        f32x4 acc[4][8];
        const bf16* Sn = St + ((size_t)((b * RH + h) * RNC + n)) * (RDV * RDK);
#pragma unroll
        for (int sl = 0; sl < 4; ++sl) {
#pragma unroll 4
            for (int it = 0; it < 4; ++it) { const int idx = F.tid + 512 * it, j = idx >> 4, ch = idx & 15;
                *(LAS u32x4*)(Vs + j * VLD + ch * 8) = *(const u32x4*)(proj + (row0 + j) * RET_IN + 2048 + h * 512 + sl * 128 + ch * 8); }
#pragma unroll 4
            for (int it = 0; it < 8; ++it) { const int idx = F.tid + 512 * it, e = idx >> 5, ch = idx & 31;
                *(LAS u32x4*)(Rs + e * LD + ch * 8) = *(const u32x4*)(Sn + (size_t)(sl * 128 + e) * RDK + ch * 8); }
            __syncthreads();
#pragma unroll
            for (int et = 0; et < 8; ++et) { f32x4 a = (f32x4){0.f, 0.f, 0.f, 0.f};
#pragma unroll
                for (int kt = 0; kt < 4; ++kt) if (2 * kt <= w) { const LAS bf16* a0 = Vs + (32 * kt + 4 * g4 + qq) * VLD + 32 * pp + 4 * et;
                    a = MFMA16(cat8(tr4(a0), tr4(a0 + 16 * VLD)), pf[kt], a); }
                const LAS bf16* srow = Rs + (32 * qq + 4 * et + pp) * LD + 8 * g4;
#pragma unroll
                for (int s = 0; s < 8; ++s) a = MFMA16(*(const LAS bf16x8*)(srow + 32 * s), qf[s], a);
                acc[sl][et] = a; }
            __syncthreads();
        }
        float s = 0.f;
#pragma unroll
        for (int sl = 0; sl < 4; ++sl)
#pragma unroll
            for (int et = 0; et < 8; ++et) s += (acc[sl][et][0] + acc[sl][et][1]) + (acc[sl][et][2] + acc[sl][et][3]);
        s += shx(s, 16, lane); s += shx(s, 32, lane);
        const float mean = s * (1.0f / RDV); float s2 = 0.f;
#pragma unroll
        for (int sl = 0; sl < 4; ++sl)
#pragma unroll
            for (int et = 0; et < 8; ++et) { acc[sl][et] = acc[sl][et] - mean; s2 += (acc[sl][et][0] * acc[sl][et][0] + acc[sl][et][1] * acc[sl][et][1]) + (acc[sl][et][2] * acc[sl][et][2] + acc[sl][et][3] * acc[sl][et][3]); }
        s2 += shx(s2, 16, lane); s2 += shx(s2, 32, lane);
        const float rstd = 1.0f / sqrtf(s2 * (1.0f / RDV) + LN_EPS);
#pragma unroll
        for (int sl = 0; sl < 4; ++sl) { const int c0 = h * RDV + sl * 128 + 32 * g4;
#pragma unroll
            for (int q = 0; q < 4; ++q) { const u32x4 gw = *(const u32x4*)(proj + qrow * RET_IN + 4096 + c0 + 8 * q);
                const f32x4 gg0 = *(const f32x4*)(gng + c0 + 8 * q), gg1 = *(const f32x4*)(gng + c0 + 8 * q + 4), gb0 = *(const f32x4*)(gnb + c0 + 8 * q), gb1 = *(const f32x4*)(gnb + c0 + 8 * q + 4);
                f32x4 y0 = acc[sl][2 * q] * rstd * gg0 + gb0, y1 = acc[sl][2 * q + 1] * rstd * gg1 + gb1;
                const float gv[8] = {bflo(gw.x), bfhi(gw.x), bflo(gw.y), bfhi(gw.y), bflo(gw.z), bfhi(gw.z), bflo(gw.w), bfhi(gw.w)};
#pragma unroll
                for (int j = 0; j < 4; ++j) { y0[j] *= gv[j] / (1.0f + __expf(-gv[j])); y1[j] *= gv[4 + j] / (1.0f + __expf(-gv[4 + j])); }
                *(u32x4*)(yret + qrow * RET_V + c0 + 8 * q) = pack_bf16x8(y0, y1); } }
    }
}

constexpr size_t AUX_S5E = 64 * MiB;
constexpr int S5L = 256, S5NC = SEQ / S5L;
__device__ __forceinline__ void cmul_add(float& rr, float& ri, float ar, float ai, float xr, float xi, float cr, float ci) { rr = ar * xr - ai * xi + cr; ri = ar * xi + ai * xr + ci; }
template <bool OUT>
__device__ __forceinline__ void phase_s5_scan(const Frame& F, KP p) {
    const bf16* X = (const bf16*)(F.ws + WS_XB); float* E = (float*)(F.ws + WS_AUX + AUX_S5E); bf16* ybuf = (bf16*)(F.ws + WS_AUX);
    const int lane = F.lane, w = F.wave, g4 = lane >> 4, l15 = lane & 15;
    LAS bf16* ut = (LAS bf16*)(F.lds + w * 12288);
    LAS bf16* Hb = (LAS bf16*)(F.lds + w * 12288 + 4096);
    constexpr int HLD = 136;
    const int gw = F.vcu * NWAVES + w, NGW = F.G * NWAVES;
    const int up16 = (lane - 16) << 2, up32 = (lane - 32) << 2, last16 = (48 + l15) << 2;
    for (int unit = gw; unit < BATCH * SG * S5NC; unit += NGW) {
        const int n = unit & (S5NC - 1), g = (unit >> 5) & 63, b = unit >> 11;
        float a1r[4], a1i[4], a4r[4], a4i[4], a8r[4], a8i[4], pwr[4], pwi[4];
        bf16x8 bfrag[8];
        const float dt = expf(gin(p, 14)[g]);
#pragma unroll
        for (int st = 0; st < 4; ++st) { const int ps = 16 * st + l15;
            const float are = gin(p, 7)[g * SP + ps], aim = gin(p, 8)[g * SP + ps];
            const float mag = expf(dt * are); const float abr = mag * cosf(dt * aim), abi = mag * sinf(dt * aim);
            const float den = are * are + aim * aim;
            const float fre = ((abr - 1.0f) * are + abi * aim) / den, fim = (abi * are - (abr - 1.0f) * aim) / den;
            a1r[st] = abr; a1i[st] = abi; { float t2r, t2i; cmul_add(t2r, t2i, abr, abi, abr, abi, 0.f, 0.f); cmul_add(a4r[st], a4i[st], t2r, t2i, t2r, t2i, 0.f, 0.f); }
            cmul_add(a8r[st], a8i[st], a4r[st], a4i[st], a4r[st], a4i[st], 0.f, 0.f);
            float qr = 1.f, qi = 0.f;
            if (g4 & 1) { qr = a4r[st]; qi = a4i[st]; }
            if (g4 & 2) { float tr, ti; cmul_add(tr, ti, qr, qi, a8r[st], a8i[st], 0.f, 0.f); qr = tr; qi = ti; }
            pwr[st] = qr; pwi[st] = qi;
            const float* br = gin(p, 9) + ((size_t)g * SP + ps) * SGC + 8 * (g4 & 1); const float* bi = gin(p, 10) + ((size_t)g * SP + ps) * SGC + 8 * (g4 & 1);
            const f32x4 r0 = *(const f32x4*)br, r1 = *(const f32x4*)(br + 4), i0 = *(const f32x4*)bi, i1 = *(const f32x4*)(bi + 4);
            const float z = (g4 < 2) ? 1.0f : 0.0f; const float fr2 = fre * z, fi2 = fim * z;
            bfrag[st] = pack8(r0 * fr2 - i0 * fi2, r1 * fr2 - i1 * fi2); bfrag[st + 4] = pack8(i0 * fr2 + r0 * fi2, i1 * fr2 + r1 * fi2);
        }
        float sr[4], si[4];
        float* Eu = E + ((size_t)(b * SG + g) * S5NC + n) * 128;
        bf16x8 cf[4]; f32x4 dsk = (f32x4){0.f, 0.f, 0.f, 0.f};
#pragma unroll
        for (int st = 0; st < 4; ++st) { sr[st] = 0.f; si[st] = 0.f; }
        if (OUT) {
#pragma unroll
            for (int st = 0; st < 4; ++st) { sr[st] = Eu[16 * st + l15]; si[st] = Eu[64 + 16 * st + l15]; }
#pragma unroll
            for (int s = 0; s < 4; ++s) { const float* cp = (s < 2 ? gin(p, 11) : gin(p, 12)) + ((size_t)g * SGC + l15) * SP + 32 * (s & 1) + 8 * g4; const float sg = s < 2 ? 1.0f : -1.0f;
                const f32x4 c0 = *(const f32x4*)cp * sg, c1 = *(const f32x4*)(cp + 4) * sg; cf[s] = pack8(c0, c1); }
            dsk = *(const f32x4*)(gin(p, 13) + g * SGC + 4 * g4); }
        const size_t tok0 = (size_t)b * SEQ + (size_t)n * S5L;
        u32x4 pre[2];
        { const bf16* src = X + (tok0 + lane) * D + g * SGC; pre[0] = *(const u32x4*)src; pre[1] = *(const u32x4*)(src + 8); }
        for (int sub = 0; sub < S5L / 64; ++sub) {
            *(LAS u32x4*)(ut + lane * 16) = pre[0]; *(LAS u32x4*)(ut + lane * 16 + 8) = pre[1];
            if (sub + 1 < S5L / 64) { const bf16* src = X + (tok0 + (sub + 1) * 64 + lane) * D + g * SGC; pre[0] = *(const u32x4*)src; pre[1] = *(const u32x4*)(src + 8); }
            LDS_WAIT(); asm volatile("" ::: "memory");
#pragma unroll 1
            for (int blk = 0; blk < 4; ++blk) {
                u32x4 uw = *(const LAS u32x4*)(ut + (blk * 16 + l15) * 16 + 8 * (g4 & 1));
                if (g4 >= 2) uw = (u32x4){0u, 0u, 0u, 0u};
                const bf16x8 ufr = __builtin_bit_cast(bf16x8, uw);
                f32x4 dr[4], di[4];
#pragma unroll
                for (int st = 0; st < 4; ++st) { dr[st] = MFMA16(ufr, bfrag[st], ((f32x4){0.f, 0.f, 0.f, 0.f})); di[st] = MFMA16(ufr, bfrag[st + 4], ((f32x4){0.f, 0.f, 0.f, 0.f})); }
                float vr[4], vi[4];
#pragma unroll
                for (int st = 0; st < 4; ++st) {
                    float hr = 0.f, hi = 0.f;
#pragma unroll
                    for (int i = 0; i < 4; ++i) { float nr, ni; cmul_add(nr, ni, a1r[st], a1i[st], hr, hi, dr[st][i], di[st][i]); hr = nr; hi = ni; dr[st][i] = hr; di[st][i] = hi; }
                    vr[st] = hr; vi[st] = hi; }
#define BPF(idx, v) __builtin_bit_cast(float, __builtin_amdgcn_ds_bpermute((idx), __builtin_bit_cast(int, (v))))
                { float xr[4], xi[4];
#pragma unroll
                  for (int st = 0; st < 4; ++st) { xr[st] = BPF(up16, vr[st]); xi[st] = BPF(up16, vi[st]); }
#pragma unroll
                  for (int st = 0; st < 4; ++st) { float tr, ti; cmul_add(tr, ti, a4r[st], a4i[st], xr[st], xi[st], vr[st], vi[st]); if (g4 >= 1) { vr[st] = tr; vi[st] = ti; } }
#pragma unroll
                  for (int st = 0; st < 4; ++st) { xr[st] = BPF(up32, vr[st]); xi[st] = BPF(up32, vi[st]); }
#pragma unroll
                  for (int st = 0; st < 4; ++st) { float tr, ti; cmul_add(tr, ti, a8r[st], a8i[st], xr[st], xi[st], vr[st], vi[st]); if (g4 >= 2) { vr[st] = tr; vi[st] = ti; } } }
                float er[4], ei[4], lr[4], li[4];
#pragma unroll
                for (int st = 0; st < 4; ++st) { er[st] = BPF(up16, vr[st]); ei[st] = BPF(up16, vi[st]); lr[st] = BPF(last16, vr[st]); li[st] = BPF(last16, vi[st]); }
#undef BPF
#pragma unroll
                for (int st = 0; st < 4; ++st) {
                    if (g4 == 0) { er[st] = 0.f; ei[st] = 0.f; }
                    float s0r, s0i; cmul_add(s0r, s0i, pwr[st], pwi[st], sr[st], si[st], er[st], ei[st]);
#pragma unroll
                    for (int i = 0; i < 4; ++i) { float tr, ti; cmul_add(tr, ti, a1r[st], a1i[st], s0r, s0i, 0.f, 0.f); s0r = tr; s0i = ti; dr[st][i] += s0r; di[st][i] += s0i; }
                    { float a16r, a16i; cmul_add(a16r, a16i, a8r[st], a8i[st], a8r[st], a8i[st], 0.f, 0.f); float tr, ti; cmul_add(tr, ti, a16r, a16i, sr[st], si[st], lr[st], li[st]); sr[st] = tr; si[st] = ti; }
                    if (OUT) {
#pragma unroll
                        for (int i = 0; i < 4; ++i) { const unsigned hw = pk2(dr[st][i], di[st][i]); Hb[(4 * g4 + i) * HLD + 16 * st + l15] = (bf16)hw; Hb[(4 * g4 + i) * HLD + 64 + 16 * st + l15] = (bf16)(hw >> 16); } }
                }
                if (OUT) {
                    LDS_WAIT(); asm volatile("" ::: "memory");
                    f32x4 ya = (f32x4){0.f, 0.f, 0.f, 0.f};
#pragma unroll
                    for (int s = 0; s < 4; ++s) ya = MFMA16(cf[s], row_frag(Hb, HLD, 0, 32 * s, lane), ya);
                    const u32x2 u2 = *(const LAS u32x2*)(ut + (blk * 16 + l15) * 16 + 4 * g4);
                    const f32x4 u4 = (f32x4){bflo(u2.x), bfhi(u2.x), bflo(u2.y), bfhi(u2.y)};
                    f32x4 y = ya + dsk * u4;
#pragma unroll
                    for (int j = 0; j < 4; ++j) { const float v = y[j]; y[j] = v / (1.0f + __expf(-1.5957691216057308f * (v + 0.044715f * v * v * v))); }
                    u32x2 o; o.x = pk2(y[0], y[1]); o.y = pk2(y[2], y[3]);
                    *(u32x2*)(ybuf + (tok0 + sub * 64 + blk * 16 + l15) * D + g * SGC + 4 * g4) = o;
                    asm volatile("" ::: "memory"); }
            }
            LDS_WAIT(); asm volatile("" ::: "memory");
        }
        if (!OUT && g4 == 0) {
#pragma unroll
            for (int st = 0; st < 4; ++st) { Eu[16 * st + l15] = sr[st]; Eu[64 + 16 * st + l15] = si[st]; } }
    }
}
__device__ __forceinline__ void phase_s5_carry(const Frame& F, KP p) {
    float* E = (float*)(F.ws + WS_AUX + AUX_S5E);
    for (int gt = F.vcu * NTHREADS + F.tid; gt < BATCH * SG * SP; gt += F.G * NTHREADS) {
        const int pl = gt & 63, bg = gt >> 6, g = bg & 63;
        const float dt = expf(gin(p, 14)[g]); const float are = gin(p, 7)[g * SP + pl], aim = gin(p, 8)[g * SP + pl];
        const float mag = expf(dt * are); float ar = mag * cosf(dt * aim), ai = mag * sinf(dt * aim);
#pragma unroll
        for (int q = 0; q < 8; ++q) { const float nr = ar * ar - ai * ai, ni = 2.0f * ar * ai; ar = nr; ai = ni; }
        float cr = 0.f, ci = 0.f;
        for (int n = 0; n < S5NC; ++n) { float* Eu = E + ((size_t)bg * S5NC + n) * 128; const float er = Eu[pl], ei = Eu[64 + pl];
            Eu[pl] = cr; Eu[64 + pl] = ci;
            const float nr = ar * cr - ai * ci + er, ni = ar * ci + ai * cr + ei; cr = nr; ci = ni; }
    }
}

constexpr int NPHASES = 34;
#ifndef PROBE_DRY14
#define PROBE_DRY14 0
#endif
#ifndef PROBE_DRY17
#define PROBE_DRY17 0
#endif
#ifndef PH_MASK
#define PH_MASK 0xFFFFFFFFu
#endif
#define PHT(t) ((PH_MASK >> (t)) & 1u)
constexpr int PLAN_OFF = 64;
__device__ __forceinline__ void moe_plan(const Frame& F, int layer) {
    volatile LAS int* tstart = (volatile LAS int*)(F.MISC + PLAN_OFF); volatile LAS int* cnts = tstart + 72;
    __syncthreads();
    if (F.wave == 0) {
        const unsigned* cnt = (const unsigned*)(F.ws + WS_CTL) + CW_CNT + layer * NE * 64;
        const int c = (int)__hip_atomic_load(cnt + F.lane * 64, __ATOMIC_RELAXED, __HIP_MEMORY_SCOPE_AGENT);
        int v = (c + 255) >> 8;
#pragma unroll
        for (int o = 1; o < 64; o <<= 1) { const int nb = __builtin_amdgcn_ds_bpermute((F.lane - o) << 2, v); if (F.lane >= o) v += nb; }
        tstart[F.lane + 1] = v; cnts[F.lane] = c;
        if (F.lane == 0) tstart[0] = 0;
        if (F.lane == 63) { tstart[65] = v + T / 256; cnts[64] = T; }
    }
    __syncthreads();
}
template <bool GATH> struct MoeSched2 {
    static constexpr bool GATHER = GATH, UNIFORMIZE = true, FP8 = GATH;
    static constexpr int ncol = GATH ? 2 : 4, K = GATH ? D / 2 : ED;
    const volatile LAS int* tstart; const volatile LAS int* cnts; int ntiles, G, c, lane;
    const char* Abase; const char* Wbase; const int* lists;
    __device__ __forceinline__ bool next(int i, pg8::UnitG& u) const {
        const int nwg = ntiles * ncol; const long L = (long)i * G + c; if (L >= nwg) return false;
        int wgid = (int)L; { const int q = nwg / 8, r = nwg % 8, xcd = wgid % 8, off = wgid / 8; wgid = (xcd < r ? xcd * (q + 1) : r * (q + 1) + (xcd - r) * q) + off; }
        const int tile = wgid / ncol, pn = wgid % ncol;
        const int ta = tstart[lane], tb = tstart[lane + 1];
        const unsigned long long mm = __ballot(ta <= tile && tile < tb);
        const int e = mm ? (int)__builtin_ctzll(mm) : 64;
        const int ts = __builtin_amdgcn_readfirstlane((int)tstart[e]), ce = __builtin_amdgcn_readfirstlane((int)cnts[e]);
        const int lt = tile - ts; int valid = ce - lt * 256; valid = valid > 256 ? 256 : valid;
        u.gshift = 0; u.aux = e;
        if (GATH) {
            u.B = Wbase + (size_t)e * WMOE_E_BYTES + (size_t)pn * 256 * K * 2;
            if (e < 64) { u.A = Abase; u.gidx = lists + (size_t)e * T + lt * 256; u.gcnt = valid; }
            else { u.A = Abase + (size_t)lt * 256 * K * 2; u.gidx = nullptr; u.gcnt = 0; }
            u.row0 = tile * 256; u.col0 = pn * 128;
        } else {
            u.B = Wbase + (size_t)e * WMOE_E_BYTES + (size_t)512 * 1024 * 2 + (size_t)pn * 256 * K * 2;
            u.A = Abase + (size_t)tile * 256 * K * 2; u.gidx = nullptr; u.gcnt = valid;
            u.row0 = tile * 256; u.col0 = pn * 256;
        }
        return true;
    }
};
__device__ __forceinline__ void phase_load_x(const Frame& F, KP p) {
    const float* xin = gin(p, 0); bf16* XB = (bf16*)(F.ws + WS_XB);
    for (size_t i = (size_t)F.vcu * NTHREADS + F.tid; i < (size_t)T * D / 8; i += (size_t)F.G * NTHREADS) {
        const f32x4 a = *(const f32x4*)(xin + i * 8), b = *(const f32x4*)(xin + i * 8 + 4);
        *(u32x4*)(XB + i * 8) = pack_bf16x8(a, b);
        u32x2 q8; q8.x = pk4_fp8(a[0], a[1], a[2], a[3]); q8.y = pk4_fp8(b[0], b[1], b[2], b[3]); *(u32x2*)((unsigned char*)(F.ws + WS_X) + i * 8) = q8; }
}

__global__ void __launch_bounds__(NTHREADS, 2) fwd_kernel(Params p_unused) {
    KP p0 = (KP)__builtin_amdgcn_kernarg_segment_ptr();
    extern __shared__ __attribute__((aligned(16))) unsigned char lds_raw[];
    Frame F0;
    F0.lds = (LAS unsigned char*)lds_raw; F0.MISC = (volatile LAS unsigned*)(F0.lds + MISC_OFF);
    F0.tid = threadIdx.x; F0.lane = F0.tid & 63; F0.wave = __builtin_amdgcn_readfirstlane(F0.tid >> 6);
    F0.G = gridDim.x; { const int bq = blockIdx.x; F0.vcu = (F0.G % 8 == 0) ? (bq % 8) * (F0.G / 8) + bq / 8 : bq; }
    F0.ws = p0->ws;
    const int bx0 = blockIdx.x;
    for (int u = F0.tid; u < (LDS_BYTES - MISC_OFF) / 4; u += NTHREADS) ((LAS unsigned*)(F0.lds + MISC_OFF))[u] = 0u;
    __syncthreads();
    XcdBarrier bar; bar.bar = (unsigned*)(p0->ws + WS_CTL) + CW_BAR; bar.x = 0; bar.st = nullptr;
    const int use_bar = p0->use_bar;
    if (use_bar) bar = xcd_barrier_post((unsigned*)(p0->ws + WS_CTL) + CW_BAR, F0.MISC + 8);
    const int lo = p0->ph_lo, hi = p0->ph_hi;
#define PHASE_BEGIN Frame F = F0; KP p = p0; { unsigned ones_ = ~0u; asm volatile("" : "+s"(ones_)); F.lane = (int)__builtin_amdgcn_mbcnt_hi(ones_, __builtin_amdgcn_mbcnt_lo(ones_, 0u)); } asm volatile("" : "+v"(F.lane)); F.tid = F.wave * 64 + F.lane; asm volatile("" : "+v"(F.tid));   GAS unsigned char* wsg_ = (GAS unsigned char*)F0.ws; asm volatile("" : "+s"(F.wave), "+s"(F.vcu), "+s"(F.G), "+s"(wsg_), "+s"(p)); \
    F.ws = (unsigned char*)wsg_; int bx = bx0; asm volatile("" : "+s"(bx)); unsigned char* ws = F.ws; (void)ws; (void)bx;
#pragma unroll 1
    for (int ph = lo; ph < hi; ++ph) {
        int layer = 0, type = 0;
        if (ph > 0) { layer = ph >= 26 ? 3 : (ph >= 18 ? 2 : (ph >= 9 ? 1 : 0)); const int q = ph - (layer == 3 ? 26 : (layer == 2 ? 18 : (layer == 1 ? 9 : 1))); const int kind = layer % 3;
            if (kind == 0) type = q < 4 ? 1 + q : 14 + (q - 4); else if (kind == 1) type = q < 5 ? 5 + q : 14 + (q - 5); else type = q < 4 ? 10 + q : 14 + (q - 4); }
        const int j = layer / 3;
#ifdef REPEAT_MASK
        const int nrep = ((REPEAT_MASK >> type) & 1u) ? 2 : 1;
#else
        const int nrep = 1;
#endif
#pragma unroll 1
        for (int rep = 0; rep < nrep; ++rep) {
        if (rep > 0 && use_bar) xcd_barrier(bar);
        if (PHT(0) && type == 0) { PHASE_BEGIN; phase_conv_mixers(F, p); phase_conv_moe(F, p, 0); phase_load_x(F, p); }
        else if (PHT(1) && type == 1) { PHASE_BEGIN; DenseSched8 S; S.init(ws + WS_X, ws + WS_ATT_IN_T + (size_t)j * ATT_IN * D, T, ATT_IN, D / 2, F.G, bx); EpiStoreBf16 E{(bf16*)(ws + WS_BIG), ATT_IN, WUP_INV, 0.08838834764831845f};
            pg8::gemm_phase(F.lds, F.tid, D / 2, S, E); }
        else if (PHT(2) && type == 2) { PHASE_BEGIN; phase_attn(F, bx); }
        else if (PHT(3) && type == 3) { PHASE_BEGIN; phase_attn_combine(F); }
        else if (PHT(4) && type == 4) { PHASE_BEGIN; DenseSched S; S.init(ws + WS_AUX + AUX_OB, ws + WS_ATT_OUT_T + (size_t)j * D * D * 2, T, D, D, F.G, bx); EpiResid E{(const bf16*)(ws + WS_XB), (bf16*)(ws + WS_Y)};
            pg8::gemm_phase(F.lds, F.tid, D, S, E); }
        else if (PHT(5) && type == 5) { PHASE_BEGIN; DenseSched8 S; S.init(ws + WS_X, ws + WS_RET_IN_T, T, RET_IN, D / 2, F.G, bx); EpiRetIn E{(bf16*)(ws + WS_BIG), RET_IN};
            pg8::gemm_phase(F.lds, F.tid, D / 2, S, E); }
        else if (PHT(6) && type == 6) { PHASE_BEGIN; phase_ret_u(F); }
        else if (PHT(7) && type == 7) { PHASE_BEGIN; phase_ret_scan(F); }
        else if (PHT(8) && type == 8) { PHASE_BEGIN; phase_ret_out(F, p); }
        else if (PHT(9) && type == 9) { PHASE_BEGIN; DenseSched S; S.init(ws + WS_BIG + BIG_YRET, ws + WS_RET_OUT_T, T, D, RET_V, F.G, bx); EpiResid E{(const bf16*)(ws + WS_XB), (bf16*)(ws + WS_Y)};
            pg8::gemm_phase(F.lds, F.tid, RET_V, S, E); }
        else if (PHT(10) && type == 10) { PHASE_BEGIN; phase_s5_scan<false>(F, p); }
        else if (PHT(11) && type == 11) { PHASE_BEGIN; phase_s5_carry(F, p); }
        else if (PHT(12) && type == 12) { PHASE_BEGIN; phase_s5_scan<true>(F, p); }
        else if (PHT(13) && type == 13) { PHASE_BEGIN; DenseSched S; S.init(ws + WS_AUX, ws + WS_GLU_T, T, 2 * D, D, F.G, bx); EpiGluResid E{(const bf16*)(ws + WS_XB), (bf16*)(ws + WS_Y)};
            pg8::gemm_phase(F.lds, F.tid, D, S, E); }
        else if (PHT(14) && type == 14) { PHASE_BEGIN; phase_lnr(F, p, layer, PROBE_DRY14 && true); if (PROBE_DRY14) { if (use_bar) xcd_barrier(bar); phase_lnr(F, p, layer, false); } }
        else if (PHT(15) && type == 15) { PHASE_BEGIN; moe_plan(F, layer);
            MoeSched2<true> S; S.tstart = (const volatile LAS int*)(F.MISC + PLAN_OFF); S.cnts = S.tstart + 72; S.ntiles = __builtin_amdgcn_readfirstlane((int)S.tstart[65]); S.G = F.G; S.c = bx; S.lane = F.lane;
            S.Abase = (const char*)(ws + WS_X); S.Wbase = (const char*)(ws + WS_WMOE); S.lists = (const int*)(ws + WS_LIST);
            EpiMoeUp E{(bf16*)(ws + WS_H)};
            pg8::gemm_phase(F.lds, F.tid, D / 2, S, E); }
        else if (PHT(16) && type == 16) { PHASE_BEGIN; moe_plan(F, layer);
            { MoeSched2<false> S; S.tstart = (const volatile LAS int*)(F.MISC + PLAN_OFF); S.cnts = S.tstart + 72; S.ntiles = __builtin_amdgcn_readfirstlane((int)S.tstart[64]); S.G = F.G; S.c = bx; S.lane = F.lane;
              S.Abase = (const char*)(ws + WS_H); S.Wbase = (const char*)(ws + WS_WMOE); S.lists = (const int*)(ws + WS_LIST);
              EpiStoreFp8 E{(unsigned char*)(ws + WS_BIG), D};
              pg8::gemm_phase(F.lds, F.tid, ED, S, E); }
            { const int sh0 = __builtin_amdgcn_readfirstlane((int)((const volatile LAS int*)(F.MISC + PLAN_OFF))[64]);
              DenseSched S; S.init(ws + WS_H + (size_t)sh0 * 256 * ED * 2, ws + WS_WMOE + (size_t)64 * WMOE_E_BYTES + (size_t)512 * 1024 * 2, T, D, ED, F.G, bx); EpiResid E{(const bf16*)(ws + WS_XB), (bf16*)(ws + WS_Y)};
              pg8::gemm_phase(F.lds, F.tid, ED, S, E); } }
        else if (PHT(17) && type == 17) { PHASE_BEGIN; moe_plan(F, layer); if (PROBE_DRY17) { phase_combine(F, p, layer, true); if (use_bar) xcd_barrier(bar); } phase_combine(F, p, layer); if (layer + 1 < DEPTH) phase_conv_moe(F, p, layer + 1); }
        }
        if (use_bar && ph + 1 < hi) xcd_barrier(bar);
    }
}

#ifndef MK_PER_PHASE
#define MK_PER_PHASE 0
#endif
extern "C" void kernel_launch(void* const* d_in, const int* in_sizes, int n_in, void* d_out, int out_size, void* d_ws, size_t ws_size, hipStream_t stream) {
    static int grid = 0;
    if (grid == 0) {
        if (n_in != 26 || in_sizes[0] != T * D || out_size != T * D || ws_size < WS_END) { fprintf(stderr, "kernel_launch: unexpected shapes / workspace (n_in %d, in0 %d, out %d, ws %zu < %zu)\n", n_in, n_in > 0 ? in_sizes[0] : -1, out_size, ws_size, (size_t)WS_END); grid = -1; return; }
        int dev = 0, cus = 0, per_cu = 0;
        if (hipGetDevice(&dev) != hipSuccess || hipDeviceGetAttribute(&cus, hipDeviceAttributeMultiprocessorCount, dev) != hipSuccess) { grid = -1; return; }
        if (hipFuncSetAttribute((const void*)fwd_kernel, hipFuncAttributeMaxDynamicSharedMemorySize, LDS_BYTES) != hipSuccess) { fprintf(stderr, "kernel_launch: hipFuncSetAttribute failed\n"); grid = -1; return; }
        if (hipOccupancyMaxActiveBlocksPerMultiprocessor(&per_cu, (const void*)fwd_kernel, NTHREADS, LDS_BYTES) != hipSuccess || per_cu < 1) { fprintf(stderr, "kernel_launch: occupancy query says %d blocks per CU\n", per_cu); per_cu = 1; }
        (void)hipGetLastError();
        grid = cus;
    }
    if (grid < 0) return;
    (void)hipMemsetAsync((char*)d_ws + WS_CTL, 0, CTL_ZERO_BYTES, stream);
    Params p{};
    for (int i = 0; i < 26; ++i) p.in[i] = (const float*)d_in[i];
    p.out = (float*)d_out; p.ws = (unsigned char*)d_ws;
#if MK_PER_PHASE
    for (int k = 0; k < NPHASES; ++k) { p.ph_lo = k; p.ph_hi = k + 1; p.use_bar = 0; hipLaunchKernelGGL(fwd_kernel, dim3(grid), dim3(NTHREADS), LDS_BYTES, stream, p); }
#else
    p.ph_lo = 0; p.ph_hi = NPHASES; p.use_bar = 1;
    hipLaunchKernelGGL(fwd_kernel, dim3(grid), dim3(NTHREADS), LDS_BYTES, stream, p);
#endif
}
```

```cpp
#include <hip/hip_runtime.h>
#include <cstdio>
#include <cstdint>

#define LAS __attribute__((address_space(3)))
#define GAS __attribute__((address_space(1)))
typedef unsigned short bf16;
typedef short bf16x8 __attribute__((ext_vector_type(8)));
typedef short bf16x4 __attribute__((ext_vector_type(4)));
typedef float f32x4 __attribute__((ext_vector_type(4)));
typedef float f32x2 __attribute__((ext_vector_type(2)));
typedef unsigned u32x4 __attribute__((ext_vector_type(4)));
typedef unsigned u32x2 __attribute__((ext_vector_type(2)));
typedef GAS unsigned gu32;

constexpr int D = 1024, BATCH = 2, SEQ = 8192, T = BATCH * SEQ, DEPTH = 4;
constexpr int AH = 8, AHD = 128, ATT_IN = 9216;
constexpr int RH = 4, RDK = 256, RDV = 512, RET_IN = 6144, RET_V = 2048, RC = 128, RNC = SEQ / RC;
constexpr int SG = 64, SGC = 16, SP = 64;
constexpr int NE = 64, TOPK = 8, NEG = 8, ED = 256, NSLOT = 9;
constexpr float LN_EPS = 1e-5f;
constexpr float ALPHA = 1.6817928305074292f;
constexpr int NWAVES = 8, NTHREADS = 512;

__device__ __forceinline__ unsigned f2bf(float f) { unsigned u = __builtin_bit_cast(unsigned, f); return (u + 0x7fffu + ((u >> 16) & 1u)) >> 16; }
__device__ __forceinline__ unsigned pk2(float lo, float hi) { unsigned r; asm("s_nop 1\n\tv_cvt_pk_bf16_f32 %0, %1, %2" : "=v"(r) : "v"(lo), "v"(hi)); return r; }
__device__ __forceinline__ unsigned pk2sw(float lo, float hi) { return f2bf(lo) | (f2bf(hi) << 16); }
__device__ __forceinline__ unsigned pk2hw(float lo, float hi) { unsigned r; asm volatile("v_cvt_pk_bf16_f32 %0, %1, %2" : "=v"(r) : "v"(lo), "v"(hi)); return r; }
__device__ __forceinline__ float bf2f(unsigned b) { return __builtin_bit_cast(float, b << 16); }
__device__ __forceinline__ float bflo(unsigned w) { return __builtin_bit_cast(float, w << 16); }
__device__ __forceinline__ float bfhi(unsigned w) { return __builtin_bit_cast(float, w & 0xffff0000u); }
__device__ __forceinline__ float shx(float v, int m, int lane) { return __builtin_bit_cast(float, __builtin_amdgcn_ds_bpermute((lane ^ m) << 2, __builtin_bit_cast(int, v))); }
__device__ __forceinline__ int shx_i(int v, int m, int lane) { return __builtin_amdgcn_ds_bpermute((lane ^ m) << 2, v); }
__device__ __forceinline__ float rdl(float v, int src) { return __builtin_bit_cast(float, __builtin_amdgcn_readlane(__builtin_bit_cast(int, v), src)); }
__device__ __forceinline__ float wave_sum(float v, int lane) {
#pragma unroll
    for (int o = 1; o < 64; o <<= 1) v += shx(v, o, lane);
    return v;
}
#define LDS_WAIT() asm volatile("s_waitcnt lgkmcnt(0)" ::: "memory")
#define VM_WAIT() asm volatile("s_waitcnt vmcnt(0)" ::: "memory")
__device__ __forceinline__ const char* rfl_ptr(const char* p) {
    unsigned long long v = (unsigned long long)p; unsigned lo = __builtin_amdgcn_readfirstlane((unsigned)v), hi = __builtin_amdgcn_readfirstlane((unsigned)(v >> 32));
    return (const char*)(((unsigned long long)hi << 32) | lo);
}
__device__ __forceinline__ bf16x8 row_frag(const LAS bf16* base, int ld, int row0, int col0, int lane) {
    return *(const LAS bf16x8*)(base + (row0 + (lane & 15)) * ld + col0 + 8 * (lane >> 4));
}
__device__ __forceinline__ bf16x4 tr4(const LAS bf16* addr) { return __builtin_amdgcn_ds_read_tr16_b64_v4i16((LAS bf16x4*)addr); }
__device__ __forceinline__ bf16x8 cat8(bf16x4 a, bf16x4 b) { bf16x8 r; r[0] = a[0]; r[1] = a[1]; r[2] = a[2]; r[3] = a[3]; r[4] = b[0]; r[5] = b[1]; r[6] = b[2]; r[7] = b[3]; return r; }
#define MFMA16(a, b, c) __builtin_amdgcn_mfma_f32_16x16x32_bf16((a), (b), (c), 0, 0, 0)
__device__ __forceinline__ bf16x8 pack8(f32x4 a, f32x4 b) {
    u32x4 w; w.x = pk2(a[0], a[1]); w.y = pk2(a[2], a[3]); w.z = pk2(b[0], b[1]); w.w = pk2(b[2], b[3]); return __builtin_bit_cast(bf16x8, w);
}

namespace pg8 {
typedef int v4i_t __attribute__((ext_vector_type(4)));
typedef int v8i_t __attribute__((ext_vector_type(8)));
constexpr int BM = 256, BK = 64, HALF = 128, HTB = HALF * BK * 2, STAGE_BYTES = 8 * HTB;
__device__ __forceinline__ int lds_byte(int r, int c) { const int st = (r >> 4) * 2 + (c >> 5), rr = r & 15, cc = c & 31, ob = rr * 64 + cc * 2; return st * 1024 + (ob ^ (((ob >> 9) & 1) << 5)); }
__device__ __forceinline__ void stage_rc(int b, int& R, int& C) { const int st = b / 1024, sb = b % 1024, swz = sb ^ (((sb >> 9) & 1) << 5); R = (st >> 1) * 16 + swz / 64; C = (st & 1) * 32 + (swz % 64) / 2; }
__device__ __forceinline__ int perm32(int rho) { const int n = rho >> 4, i = rho & 15; return 8 * (i >> 2) + 4 * n + (i & 3); }

struct UnitG {
    const char* A;
    const char* B;
    const int* gidx;
    int gcnt, gshift;
    int row0, col0;
    int aux;
};

__device__ __forceinline__ void uniformize(UnitG& u) { u.A = rfl_ptr(u.A); u.B = rfl_ptr(u.B); u.gidx = (const int*)rfl_ptr((const char*)u.gidx); u.gcnt = __builtin_amdgcn_readfirstlane(u.gcnt); u.gshift = __builtin_amdgcn_readfirstlane(u.gshift);
    u.row0 = __builtin_amdgcn_readfirstlane(u.row0); u.col0 = __builtin_amdgcn_readfirstlane(u.col0); u.aux = __builtin_amdgcn_readfirstlane(u.aux); }
template <class Epi, class Sched>
__device__ __forceinline__ void gemm_phase(LAS unsigned char* lds, const int tid, const int K, const Sched& S, const Epi& E) {
    constexpr bool F8 = Sched::FP8;
    constexpr bool GATHER = Sched::GATHER;
    const int wid = __builtin_amdgcn_readfirstlane(tid >> 6), lane = tid & 63, wr = wid >> 2, wc = wid & 3, fr = lane & 15, fq = lane >> 4;
    const int nt = K / BK;
    constexpr bool P16 = Epi::PERM16;
    unsigned voffB[2], voffB1[2], vA[2][2];
#pragma unroll
    for (int i = 0; i < 2; ++i) { int R, C; stage_rc(tid * 16 + i * 8192, R, C); const int Rb = Epi::PERM ? ((R & ~31) + perm32(R & 31)) : R; voffB[i] = (unsigned)(Rb * K + C) * 2u; voffB1[i] = voffB[i]; vA[0][i] = (unsigned)(R * K + C) * 2u; vA[1][i] = vA[0][i];
        if constexpr (P16) { const int x = R & 31, src = 64 * (R >> 5) + 16 * ((x >> 2) & 3) + 4 * (x >> 4) + (x & 3); voffB[i] = (unsigned)(src * K + C) * 2u; voffB1[i] = (unsigned)((src + 8) * K + C) * 2u; } }
    const size_t kstep = (size_t)(BK * 2);
    const size_t hstep = (size_t)HALF * K * 2;
    const size_t hstepB = P16 ? 0 : hstep;
    const size_t hstepA = GATHER ? 0 : hstep;
    const unsigned ldsw = (unsigned)wid * 1024u;
    const int aoff = F8 ? lds_byte(wr * 64 + fr, fq * 16) : lds_byte(wr * 64 + fr, fq * 8), boff = F8 ? lds_byte(wc * 32 + fr, fq * 16) : lds_byte(wc * 32 + fr, fq * 8);
    LAS u32x4* park = (LAS u32x4*)(lds + STAGE_BYTES) + tid;
#define PG8_SA(b, h) (((b) * 2 + (h)) * HTB)
#define PG8_SB(b, h) ((4 + (b) * 2 + (h)) * HTB)
#define PG8_STAGE(bufoff, gbase, voff) do { _Pragma("unroll") for (int _i = 0; _i < 2; ++_i) { asm volatile("" : "+v"((voff)[_i]));   \
        __builtin_amdgcn_global_load_lds((const unsigned*)((const char*)(gbase) + (voff)[_i]), (LAS unsigned*)(lds + (bufoff) + ldsw + _i * 8192), 16, 0, 0); } } while (0)
    constexpr int FKS = F8 ? 16 : 1024;
#define PG8_LD2(p_) __builtin_shufflevector(*(const LAS v4i_t*)(p_), *(const LAS v4i_t*)((p_) + FKS), 0, 1, 2, 3, 4, 5, 6, 7)
#define PG8_LDA(dst, b, h) do { _Pragma("unroll") for (int m = 0; m < 4; ++m) dst[m] = PG8_LD2(lds + PG8_SA(b, h) + aoff + m * 2048); } while (0)
#define PG8_LDB(dst, b, h) do { _Pragma("unroll") for (int n = 0; n < 2; ++n) dst[n] = PG8_LD2(lds + PG8_SB(b, h) + boff + n * 2048); } while (0)
#define PG8_LO(v) __builtin_bit_cast(bf16x8, __builtin_shufflevector((v), (v), 0, 1, 2, 3))
#define PG8_HI(v) __builtin_bit_cast(bf16x8, __builtin_shufflevector((v), (v), 4, 5, 6, 7))
#define PG8_MMA(ai, bj, At, Bt) do { __builtin_amdgcn_s_setprio(1); _Pragma("unroll") for (int m = 0; m < 4; ++m) _Pragma("unroll") for (int n = 0; n < 2; ++n) { \
        if constexpr (F8) { acc[ai][bj][m][n] = __builtin_amdgcn_mfma_scale_f32_16x16x128_f8f6f4(Bt[n], At[m], acc[ai][bj][m][n], 0, 0, 0, 0x7F7F7F7F, 0, 0x7F7F7F7F); } \
        else { acc[ai][bj][m][n] = __builtin_amdgcn_mfma_f32_16x16x32_bf16(PG8_LO(Bt[n]), PG8_LO(At[m]), acc[ai][bj][m][n], 0, 0, 0); \
               acc[ai][bj][m][n] = __builtin_amdgcn_mfma_f32_16x16x32_bf16(PG8_HI(Bt[n]), PG8_HI(At[m]), acc[ai][bj][m][n], 0, 0, 0); } } __builtin_amdgcn_s_setprio(0); } while (0)
#define PG8_WAIT_V(n) asm volatile("s_waitcnt vmcnt(" #n ")" ::: "memory")
#define PG8_WAIT_L(n) asm volatile("s_waitcnt lgkmcnt(" #n ")" ::: "memory")
#define PG8_BAR __builtin_amdgcn_s_barrier()
#define PG8_SCHED __builtin_amdgcn_sched_barrier(0)
#define PG8_VOFF(u, v00, v01, v10, v11) do { int _R0, _C0, _R1, _C1; stage_rc(tid * 16, _R0, _C0); stage_rc(tid * 16 + 8192, _R1, _C1); int _r00 = _R0, _r01 = _R1, _r10 = HALF + _R0, _r11 = HALF + _R1; \
        if ((u).gidx) { const int _a = _r00 < (u).gcnt ? ((const GAS int*)(u).gidx)[_r00] >> (u).gshift : 0, _b = _r01 < (u).gcnt ? ((const GAS int*)(u).gidx)[_r01] >> (u).gshift : 0, _c = _r10 < (u).gcnt ? ((const GAS int*)(u).gidx)[_r10] >> (u).gshift : 0, _d = _r11 < (u).gcnt ? ((const GAS int*)(u).gidx)[_r11] >> (u).gshift : 0; \
            _r00 = _a; _r01 = _b; _r10 = _c; _r11 = _d; } \
        v00 = (unsigned)(_r00 * K + _C0) * 2u; v01 = (unsigned)(_r01 * K + _C1) * 2u; v10 = (unsigned)(_r10 * K + _C0) * 2u; v11 = (unsigned)(_r11 * K + _C1) * 2u; } while (0)
    UnitG cur, nxt; int ui = 0;
    if (!S.next(0, cur)) return;
    if constexpr (Sched::UNIFORMIZE) uniformize(cur);
    f32x4 acc[2][2][4][2];
#pragma unroll
    for (int a = 0; a < 2; ++a)
#pragma unroll
        for (int b = 0; b < 2; ++b)
#pragma unroll
            for (int m = 0; m < 4; ++m)
#pragma unroll
                for (int n = 0; n < 2; ++n) acc[a][b][m][n] = (f32x4){0.f, 0.f, 0.f, 0.f};
    v8i_t At[4], B0[2], B1[2];
    if constexpr (GATHER) PG8_VOFF(cur, vA[0][0], vA[0][1], vA[1][0], vA[1][1]);
    const char* cA = cur.A; const char* cB = cur.B;
    PG8_STAGE(PG8_SB(0, 0), cB, voffB); PG8_STAGE(PG8_SB(0, 1), cB + hstepB, voffB1); PG8_STAGE(PG8_SA(0, 0), cA, vA[0]); PG8_STAGE(PG8_SA(0, 1), cA + hstepA, vA[1]);
    if (wr == 1) PG8_BAR;
    PG8_WAIT_V(2); PG8_BAR;
    PG8_STAGE(PG8_SB(1, 0), cB + kstep, voffB); PG8_STAGE(PG8_SA(1, 0), cA + kstep, vA[0]); PG8_STAGE(PG8_SB(1, 1), cB + hstepB + kstep, voffB1);
    PG8_WAIT_V(6); PG8_BAR;
    for (;;) {
        const bool has_next = S.next(ui + 1, nxt);
        if constexpr (Sched::UNIFORMIZE) { if (has_next) uniformize(nxt); }
        const char* nA = cA; const char* nB = cB;
        if (has_next) { nA = nxt.A; nB = nxt.B; }
        if constexpr (GATHER) { u32x4 pv; pv.x = vA[0][0]; pv.y = vA[0][1]; pv.z = vA[1][0]; pv.w = vA[1][1];
            if (has_next) PG8_VOFF(nxt, pv.x, pv.y, pv.z, pv.w);
            *park = pv; }
#pragma unroll 1
        for (int t = 0; t < nt; t += 2) {
            const bool last = (t == nt - 2);
            const char* a1 = cA + (size_t)(t + 1) * kstep;
            const char* a2 = last ? nA : cA + (size_t)(t + 2) * kstep; const char* b2 = last ? nB : cB + (size_t)(t + 2) * kstep;
            const char* a3 = a2 + kstep; const char* b3 = b2 + kstep;
            PG8_LDB(B0, 0, 0); PG8_LDB(B1, 0, 1); PG8_SCHED; PG8_LDA(At, 0, 0); PG8_STAGE(PG8_SA(1, 1), a1 + hstepA, vA[1]);
            PG8_WAIT_V(8); PG8_WAIT_L(0); PG8_BAR; PG8_MMA(0, 0, At, B0); PG8_MMA(0, 1, At, B1); PG8_BAR; PG8_SCHED;
            if constexpr (GATHER) { if (last) { const u32x4 pv = *park; vA[0][0] = pv.x; vA[0][1] = pv.y; vA[1][0] = pv.z; vA[1][1] = pv.w; } }
            PG8_LDA(At, 0, 1); PG8_STAGE(PG8_SB(0, 0), b2, voffB); PG8_STAGE(PG8_SB(0, 1), b2 + hstepB, voffB1); PG8_STAGE(PG8_SA(0, 0), a2, vA[0]);
            PG8_WAIT_V(8); PG8_WAIT_L(0); PG8_BAR; PG8_MMA(1, 0, At, B0); PG8_MMA(1, 1, At, B1); PG8_BAR; PG8_SCHED;
            PG8_LDB(B0, 1, 0); PG8_LDB(B1, 1, 1); PG8_SCHED; PG8_LDA(At, 1, 0); PG8_STAGE(PG8_SA(0, 1), a2 + hstepA, vA[1]);
            PG8_WAIT_V(8); PG8_WAIT_L(0); PG8_BAR; PG8_MMA(0, 0, At, B0); PG8_MMA(0, 1, At, B1); PG8_BAR; PG8_SCHED;
            PG8_LDA(At, 1, 1); PG8_STAGE(PG8_SB(1, 0), b3, voffB); PG8_STAGE(PG8_SB(1, 1), b3 + hstepB, voffB1); PG8_STAGE(PG8_SA(1, 0), a3, vA[0]);
            PG8_WAIT_V(8); PG8_WAIT_L(0); PG8_BAR; PG8_MMA(1, 0, At, B0); PG8_MMA(1, 1, At, B1); PG8_BAR; PG8_SCHED;
        }
        if (wr == 0) PG8_BAR;
        E(acc, cur, wr, wc, fr, fq);
        if (!has_next) break;
#pragma unroll
        for (int a = 0; a < 2; ++a)
#pragma unroll
            for (int b = 0; b < 2; ++b)
#pragma unroll
                for (int m = 0; m < 4; ++m)
#pragma unroll
                    for (int n = 0; n < 2; ++n) acc[a][b][m][n] = (f32x4){0.f, 0.f, 0.f, 0.f};
        cur = nxt; cA = nA; cB = nB; ++ui;
        if (wr == 1) PG8_BAR;
    }
    PG8_WAIT_V(0);
    PG8_BAR;
#undef PG8_SA
#undef PG8_SB
#undef PG8_STAGE
#undef PG8_LDA
#undef PG8_LDB
#undef PG8_LD2
#undef PG8_LO
#undef PG8_HI
#undef PG8_MMA
#undef PG8_WAIT_V
#undef PG8_WAIT_L
#undef PG8_BAR
#undef PG8_SCHED
#undef PG8_VOFF
}
}

constexpr size_t MiB = 1u << 20;
constexpr size_t WS_CTL = 0, CTL_ZERO_BYTES = 1 * MiB;
constexpr size_t WS_ATT_IN_T = 1 * MiB;
constexpr size_t WS_ATT_OUT_T = WS_ATT_IN_T + 36 * MiB;
constexpr size_t WS_RET_IN_T = WS_ATT_OUT_T + 4 * MiB;
constexpr size_t WS_RET_OUT_T = WS_RET_IN_T + 12 * MiB;
constexpr size_t WS_GLU_T = WS_RET_OUT_T + 4 * MiB;
constexpr size_t WS_RT_HI = WS_GLU_T + 4 * MiB;
constexpr size_t WS_RT_LO = WS_RT_HI + 512 * 1024;
constexpr size_t WS_WMOE = WS_RT_HI + 1 * MiB;
constexpr size_t WMOE_E_BYTES = (size_t)(512 * 1024 + 1024 * 256) * 2;
constexpr size_t WS_X = WS_WMOE + 98 * MiB;
constexpr size_t WS_Y = WS_X + 64 * MiB;
constexpr size_t WS_XB = WS_Y + 64 * MiB;
constexpr size_t WS_BIG = WS_XB + 32 * MiB;
constexpr size_t WS_AUX = WS_BIG + 288 * MiB;
constexpr size_t WS_H = WS_AUX + 160 * MiB;
constexpr size_t WS_LIST = WS_H + 80 * MiB;
constexpr size_t WS_TRASH = WS_LIST + 8 * MiB;
constexpr size_t WS_END = WS_TRASH + 1 * MiB;
static_assert(WS_END <= 1024 * MiB, "workspace map");
constexpr int CW_BAR = 4096;
constexpr int CW_CNT = 16384;
constexpr int CW_CHK = 65536;
constexpr int HROWS = 163840;

#define XB_TMO      128
#define XB_XCNT(j)  (256  + 64 * (j))
#define XB_XSUB(j)  (1280 + 64 * (j))
#define XB_XGEN(j)  (2304 + 64 * (j))
#define XB_TOP      3328
#define XB_TOPGEN   3392
#define XCD_BAR_WORDS 3456
#define XB_SPIN_CAP (1u << 20)
__device__ __forceinline__ unsigned xb_ld(unsigned* p)              { return __hip_atomic_load(p, __ATOMIC_RELAXED, __HIP_MEMORY_SCOPE_AGENT); }
__device__ __forceinline__ unsigned xb_add(unsigned* p, unsigned v) { return __hip_atomic_fetch_add(p, v, __ATOMIC_RELAXED, __HIP_MEMORY_SCOPE_AGENT); }
__device__ __forceinline__ unsigned xb_xcc_id() { return (unsigned)__builtin_amdgcn_s_getreg((3 << 11) | 20) & 0xFu; }
#define XB_SPIN(cond, bar) do { unsigned _sp = 0; while (cond) { __builtin_amdgcn_s_sleep(1); \
    if ((++_sp & 255u) == 0u) { if (xb_ld(&(bar)[XB_TMO])) break; if (_sp > XB_SPIN_CAP) { atomicAdd(&(bar)[XB_TMO], 1u); break; } } } } while (0)
struct XcdBarrier { unsigned* bar; unsigned x; volatile LAS unsigned* st; };
__device__ __forceinline__ XcdBarrier xcd_barrier_post(unsigned* bar, volatile LAS unsigned* st) {
    XcdBarrier b; b.bar = bar; b.x = xb_xcc_id(); b.st = st;
    if (threadIdx.x == 0) (void)xb_add(&bar[XB_XCNT(b.x)], 1u);
    return b;
}
__device__ __forceinline__ void xcd_barrier_complete(unsigned* bar, unsigned x, unsigned& nloc, unsigned& nx) {
    const unsigned G = gridDim.x * gridDim.y * gridDim.z;
    unsigned sum, cnt, mine, sp = 0u;
    for (;;) {
        sum = 0u; cnt = 0u; mine = 0u;
#pragma unroll
        for (unsigned j = 0; j < 16; ++j) { const unsigned c = xb_ld(&bar[XB_XCNT(j)]); sum += c; cnt += (c > 0u) ? 1u : 0u; mine = (j == x) ? c : mine; }
        if (sum == G) break;
        __builtin_amdgcn_s_sleep(1);
        if ((++sp & 255u) == 0u) { if (xb_ld(&bar[XB_TMO])) break; if (sp > XB_SPIN_CAP) { atomicAdd(&bar[XB_TMO], 1u); break; } }
    }
    nloc = mine > 0u ? mine : 1u; nx = cnt > 0u ? cnt : 1u;
}
__device__ __forceinline__ void xcd_barrier(const XcdBarrier& b) {
    asm volatile("s_waitcnt vmcnt(0)" ::: "memory");
    __syncthreads();
    if (threadIdx.x == 0) {
        unsigned* bar = b.bar;
        __builtin_amdgcn_s_waitcnt(0);
        unsigned nloc = b.st[0], nx = b.st[1];
        if (nloc == 0u) { xcd_barrier_complete(bar, b.x, nloc, nx); b.st[0] = nloc; b.st[1] = nx; }
        const unsigned old = xb_add(&bar[XB_XSUB(b.x)], 1u);
        const unsigned gen = old / nloc;
        if (old + 1u == (gen + 1u) * nloc) {
            __builtin_amdgcn_fence(__ATOMIC_RELEASE, "agent");
            asm volatile("s_waitcnt vmcnt(0)" ::: "memory");
            const unsigned og = xb_add(&bar[XB_TOP], 1u);
            const unsigned tg = og / nx;
            if (og + 1u == (tg + 1u) * nx) xb_add(&bar[XB_TOPGEN], 1u);
            else XB_SPIN(xb_ld(&bar[XB_TOPGEN]) == tg, bar);
            __builtin_amdgcn_fence(__ATOMIC_ACQUIRE, "agent");
            xb_add(&bar[XB_XGEN(b.x)], 1u);
            asm volatile("s_waitcnt vmcnt(0)" ::: "memory");
        } else {
            XB_SPIN(xb_ld(&bar[XB_XGEN(b.x)]) == gen, bar);
            __builtin_amdgcn_fence(__ATOMIC_ACQUIRE, "agent");
            asm volatile("s_waitcnt vmcnt(0)" ::: "memory");
        }
    }
    __syncthreads();
}

constexpr int RING_BYTES = 139264;
constexpr int MISC_OFF = RING_BYTES;
constexpr int LDS_BYTES = 147456;
struct Params {
    const float* in[26]; float* out; unsigned char* ws; int ph_lo, ph_hi; int use_bar, pad;
};
typedef const __attribute__((address_space(4))) Params* KP;
__device__ __forceinline__ const float* gin(KP p, int i) { return (const float*)(const GAS float*)p->in[i]; }
__device__ __forceinline__ float* gout(KP p) { return (float*)(GAS float*)p->out; }
struct Frame {
    LAS unsigned char* lds; volatile LAS unsigned* MISC;
    int tid, lane, wave, vcu, G;
    unsigned char* ws;
};

template <bool F8_ = false> struct DenseSchedT {
    static constexpr bool GATHER = false, UNIFORMIZE = false, FP8 = F8_;
    const char* A; const char* Bt; int K, nM, nN, nwg, G, c;
    __device__ __forceinline__ void init(const void* A_, const void* Bt_, int M, int N, int K_, int G_, int c_) { A = (const char*)A_; Bt = (const char*)Bt_; K = K_; nM = M / 256; nN = N / 256; nwg = nM * nN; G = G_; c = c_; }
    __device__ __forceinline__ bool next(int i, pg8::UnitG& u) const {
        const long L = (long)i * G + c; if (L >= nwg) return false;
        int wgid = (int)L; { const int q = nwg / 8, r = nwg % 8, xcd = wgid % 8, off = wgid / 8; wgid = (xcd < r ? xcd * (q + 1) : r * (q + 1) + (xcd - r) * q) + off; }
        const int nig = 8 * nN, gid = wgid / nig, fm = gid * 8, gsz = (nM - fm) < 8 ? (nM - fm) : 8;
        const int pm = fm + ((wgid % nig) % gsz), pn = (wgid % nig) / gsz;
        u.A = A + (size_t)pm * 256 * K * 2; u.B = Bt + (size_t)pn * 256 * K * 2; u.gidx = nullptr; u.gcnt = 0; u.gshift = 0; u.row0 = pm * 256; u.col0 = pn * 256; u.aux = 0; return true;
    }
};
typedef DenseSchedT<false> DenseSched; typedef DenseSchedT<true> DenseSched8;
__device__ __forceinline__ u32x4 pack_bf16x8(const f32x4& v0, const f32x4& v1) { u32x4 w; w.x = pk2hw(v0[0], v0[1]); w.y = pk2hw(v0[2], v0[3]); w.z = pk2hw(v1[0], v1[1]); w.w = pk2hw(v1[2], v1[3]); return w; }

constexpr float WUP_SCALE = 32.0f, WUP_INV = 1.0f / 32.0f;
struct EpiStoreBf16 {
    static constexpr bool PERM = true, PERM16 = false;
    bf16* O; int ldc; float osc, qsc;
    __device__ __forceinline__ void operator()(const f32x4 (&acc)[2][2][4][2], const pg8::UnitG& u, int wr, int wc, int fr, int fq) const {
        const float sc = ((u.col0 % 3072) < 1024) ? osc * qsc : osc;
#pragma unroll
        for (int ai = 0; ai < 2; ++ai)
#pragma unroll
            for (int m = 0; m < 4; ++m) { bf16* rowp = O + (size_t)(u.row0 + ai * 128 + wr * 64 + m * 16 + fr) * ldc + u.col0 + wc * 32 + 8 * fq;
#pragma unroll
                for (int bj = 0; bj < 2; ++bj) *(u32x4*)(rowp + bj * 128) = pack_bf16x8(acc[ai][bj][m][0] * sc, acc[ai][bj][m][1] * sc); }
    }
};
constexpr float YEXP_SCALE = 32.0f, YEXP_INV = 1.0f / 32.0f;
struct EpiStoreFp8 {
    static constexpr bool PERM = false, PERM16 = true;
    unsigned char* O; int ldc;
    __device__ __forceinline__ void operator()(const f32x4 (&acc)[2][2][4][2], const pg8::UnitG& u, int wr, int wc, int fr, int fq) const {
#pragma unroll
        for (int ai = 0; ai < 2; ++ai)
#pragma unroll
            for (int m = 0; m < 4; ++m) { unsigned char* rowp = O + (size_t)(u.row0 + ai * 128 + wr * 64 + m * 16 + fr) * ldc + u.col0 + wc * 64 + 16 * fq;
                u32x4 w;
#pragma unroll
                for (int q = 0; q < 4; ++q) { f32x4 v = acc[ai][q >> 1][m][q & 1] * YEXP_SCALE;
#pragma unroll
                    for (int j = 0; j < 4; ++j) v[j] = fminf(fmaxf(v[j], -448.0f), 448.0f);
                    int d = 0; d = __builtin_amdgcn_cvt_pk_fp8_f32(v[0], v[1], d, false); d = __builtin_amdgcn_cvt_pk_fp8_f32(v[2], v[3], d, true); w[q] = (unsigned)d; }
                *(u32x4*)rowp = w; }
    }
};
struct EpiRetIn {
    static constexpr bool PERM = true, PERM16 = false;
    bf16* O; int ldc;
    __device__ __forceinline__ void operator()(const f32x4 (&acc)[2][2][4][2], const pg8::UnitG& u, int wr, int wc, int fr, int fq) const {
        float l2g = 0.f;
        float cs = WUP_INV;
        if (u.col0 < 2048) { const int h = (u.col0 & 1023) >> 8; const float g = 1.0f - exp2f(-5.0f - (float)h); l2g = log2f(g); if (u.col0 >= 1024) { l2g = -l2g; cs *= 0.0625f; } }
#pragma unroll
        for (int ai = 0; ai < 2; ++ai)
#pragma unroll
            for (int m = 0; m < 4; ++m) { const int row = u.row0 + ai * 128 + wr * 64 + m * 16 + fr; const float sc = exp2f(l2g * (float)(row & 127)) * cs;
                bf16* rowp = O + (size_t)row * ldc + u.col0 + wc * 32 + 8 * fq;
#pragma unroll
                for (int bj = 0; bj < 2; ++bj) *(u32x4*)(rowp + bj * 128) = pack_bf16x8(acc[ai][bj][m][0] * sc, acc[ai][bj][m][1] * sc); }
    }
};
__device__ __forceinline__ void unpack_bf16x8(const u32x4& w, f32x4& a, f32x4& b) { a[0] = bflo(w.x); a[1] = bfhi(w.x); a[2] = bflo(w.y); a[3] = bfhi(w.y); b[0] = bflo(w.z); b[1] = bfhi(w.z); b[2] = bflo(w.w); b[3] = bfhi(w.w); }
struct EpiResid {
    static constexpr bool PERM = true, PERM16 = false;
    const bf16* X; bf16* Y;
    __device__ __forceinline__ void operator()(const f32x4 (&acc)[2][2][4][2], const pg8::UnitG& u, int wr, int wc, int fr, int fq) const {
#pragma unroll
        for (int ai = 0; ai < 2; ++ai)
#pragma unroll
            for (int m = 0; m < 4; ++m) { const size_t off = (size_t)(u.row0 + ai * 128 + wr * 64 + m * 16 + fr) * D + u.col0 + wc * 32 + 8 * fq;
#pragma unroll
                for (int bj = 0; bj < 2; ++bj) { const u32x4 xw = *(const u32x4*)(X + off + bj * 128); f32x4 x0, x1; unpack_bf16x8(xw, x0, x1);
                    *(u32x4*)(Y + off + bj * 128) = pack_bf16x8(x0 * ALPHA + acc[ai][bj][m][0], x1 * ALPHA + acc[ai][bj][m][1]); }
                if (m == 3) asm volatile("" ::: "memory"); }
    }
};
struct EpiGluResid {
    static constexpr bool PERM = true, PERM16 = false;
    const bf16* X; bf16* Y;
    __device__ __forceinline__ void operator()(const f32x4 (&acc)[2][2][4][2], const pg8::UnitG& u, int wr, int wc, int fr, int fq) const {
#pragma unroll
        for (int ai = 0; ai < 2; ++ai)
#pragma unroll
            for (int m = 0; m < 4; ++m) { const size_t off = (size_t)(u.row0 + ai * 128 + wr * 64 + m * 16 + fr) * D + (u.col0 >> 1) + wc * 32 + 8 * fq;
                const u32x4 xw = *(const u32x4*)(X + off); f32x4 x0, x1; unpack_bf16x8(xw, x0, x1); f32x4 o0, o1;
#pragma unroll
                for (int j = 0; j < 4; ++j) { o0[j] = x0[j] * ALPHA + acc[ai][0][m][0][j] / (1.0f + __expf(-acc[ai][1][m][0][j])); o1[j] = x1[j] * ALPHA + acc[ai][0][m][1][j] / (1.0f + __expf(-acc[ai][1][m][1][j])); }
                *(u32x4*)(Y + off) = pack_bf16x8(o0, o1);
                if (m == 3) asm volatile("" ::: "memory"); }
    }
};
struct EpiMoeUp {
    static constexpr bool PERM = true, PERM16 = false;
    bf16* H;
    __device__ __forceinline__ void operator()(const f32x4 (&acc)[2][2][4][2], const pg8::UnitG& u, int wr, int wc, int fr, int fq) const {
#pragma unroll
        for (int ai = 0; ai < 2; ++ai)
#pragma unroll
            for (int m = 0; m < 4; ++m) { bf16* rowp = H + (size_t)(u.row0 + ai * 128 + wr * 64 + m * 16 + fr) * ED + u.col0 + wc * 32 + 8 * fq; f32x4 o[2];
#pragma unroll
                for (int n = 0; n < 2; ++n)
#pragma unroll
                    for (int j = 0; j < 4; ++j) { const float g = acc[ai][0][m][n][j] * WUP_INV, up = acc[ai][1][m][n][j] * WUP_INV; o[n][j] = g / (1.0f + __expf(-g)) * up; }
                *(u32x4*)rowp = pack_bf16x8(o[0], o[1]); }
    }
};

__device__ __forceinline__ unsigned pk4_fp8(float a, float b, float c, float d) {
    a = fminf(fmaxf(a, -448.0f), 448.0f); b = fminf(fmaxf(b, -448.0f), 448.0f); c = fminf(fmaxf(c, -448.0f), 448.0f); d = fminf(fmaxf(d, -448.0f), 448.0f);
    int w = 0; w = __builtin_amdgcn_cvt_pk_fp8_f32(a, b, w, false); w = __builtin_amdgcn_cvt_pk_fp8_f32(c, d, w, true); return (unsigned)w; }
template <bool HILO>
__device__ __forceinline__ void conv_item(const float* W, int ldw, bf16* WT, bf16* WTlo, int ldk, int k0, int n0, int drow0, float scale, LAS float* scr, int lane) {
#pragma unroll 8
    for (int i = 0; i < 32; ++i) { const int kk = 2 * i + (lane >> 5); scr[kk * 33 + (lane & 31)] = W[(size_t)(k0 + kk) * ldw + n0 + (lane & 31)] * scale; }
    LDS_WAIT(); asm volatile("" ::: "memory");
    const int c = lane & 7;
#pragma unroll
    for (int j = 0; j < 4; ++j) { const int n = (lane >> 3) + 8 * j; const LAS float* s = scr + (8 * c) * 33 + n;
        float v[8];
#pragma unroll
        for (int q = 0; q < 8; ++q) v[q] = s[q * 33];
        u32x4 o; o.x = pk2(v[0], v[1]); o.y = pk2(v[2], v[3]); o.z = pk2(v[4], v[5]); o.w = pk2(v[6], v[7]);
        *(u32x4*)(WT + (size_t)(drow0 + n) * ldk + k0 + 8 * c) = o;
        if (HILO) { float r[8];
#pragma unroll
            for (int q = 0; q < 8; ++q) r[q] = v[q] - bf2f(f2bf(v[q]));
            u32x4 o2; o2.x = pk2(r[0], r[1]); o2.y = pk2(r[2], r[3]); o2.z = pk2(r[4], r[5]); o2.w = pk2(r[6], r[7]);
            *(u32x4*)(WTlo + (size_t)(drow0 + n) * ldk + k0 + 8 * c) = o2; } }
    LDS_WAIT(); asm volatile("" ::: "memory");
}
__device__ __forceinline__ void conv_item8(const float* W, int ldw, unsigned char* WT, int ldk, int k0, int n0, int drow0, float scale, LAS float* scr, int lane) {
#pragma unroll 8
    for (int i = 0; i < 32; ++i) { const int kk = 2 * i + (lane >> 5); scr[kk * 33 + (lane & 31)] = W[(size_t)(k0 + kk) * ldw + n0 + (lane & 31)] * scale; }
    LDS_WAIT(); asm volatile("" ::: "memory");
    const int c = lane & 7;
#pragma unroll
    for (int j = 0; j < 4; ++j) { const int n = (lane >> 3) + 8 * j; const LAS float* s = scr + (8 * c) * 33 + n;
        float v[8];
#pragma unroll
        for (int q = 0; q < 8; ++q) v[q] = s[q * 33];
        u32x2 o; o.x = pk4_fp8(v[0], v[1], v[2], v[3]); o.y = pk4_fp8(v[4], v[5], v[6], v[7]);
        *(u32x2*)(WT + (size_t)(drow0 + n) * ldk + k0 + 8 * c) = o; }
    LDS_WAIT(); asm volatile("" ::: "memory");
}
__device__ __forceinline__ void phase_conv_mixers(const Frame& F, KP p) {
    LAS float* scr = (LAS float*)(F.lds + F.wave * 16384);
    const int gw = F.vcu * NWAVES + F.wave, NGW = F.G * NWAVES;
    constexpr int I_AIN = 16 * 288, I_AOUT = 16 * 32, I_RIN = 16 * 192, I_ROUT = 32 * 32, I_GLU = 16 * 64, I_RT = 16 * 2;
    constexpr int NITEMS = 2 * I_AIN + 2 * I_AOUT + I_RIN + I_ROUT + I_GLU + 4 * I_RT;
    unsigned char* ws = F.ws;
    for (int it = gw; it < NITEMS; it += NGW) {
        int r = it;
        if (r < 2 * I_AIN) { const int j = r / I_AIN; r %= I_AIN; const int kb = r / 288, nb = r % 288, n0 = nb * 32;
            conv_item8(gin(p, 1) + (size_t)j * D * ATT_IN, ATT_IN, (unsigned char*)(ws + WS_ATT_IN_T) + (size_t)j * ATT_IN * D, D, kb * 64, n0, n0, WUP_SCALE, scr, F.lane); continue; }
        r -= 2 * I_AIN;
        if (r < 2 * I_AOUT) { const int j = r / I_AOUT; r %= I_AOUT; const int kb = r / 32, nb = r % 32, n0 = nb * 32;
            conv_item<false>(gin(p, 2) + (size_t)j * D * D, D, (bf16*)(ws + WS_ATT_OUT_T) + (size_t)j * D * D, nullptr, D, kb * 64, n0, n0, 1.0f, scr, F.lane); continue; }
        r -= 2 * I_AOUT;
        if (r < I_RIN) { const int kb = r / 192, nb = r % 192, n0 = nb * 32;
            conv_item8(gin(p, 3), RET_IN, (unsigned char*)(ws + WS_RET_IN_T), D, kb * 64, n0, n0, WUP_SCALE, scr, F.lane); continue; }
        r -= I_RIN;
        if (r < I_ROUT) { const int kb = r / 32, nb = r % 32, n0 = nb * 32;
            conv_item<false>(gin(p, 6), D, (bf16*)(ws + WS_RET_OUT_T), nullptr, RET_V, kb * 64, n0, n0, 1.0f, scr, F.lane); continue; }
        r -= I_ROUT;
        if (r < I_GLU) { const int kb = r / 64, nb = r % 64, n0 = nb * 32; const int c = n0 & 1023, drow = (c >> 7) * 256 + (n0 >> 10) * 128 + (c & 127);
            conv_item<false>(gin(p, 15), 2 * D, (bf16*)(ws + WS_GLU_T), nullptr, D, kb * 64, n0, drow, 1.0f, scr, F.lane); continue; }
        r -= I_GLU;
        { const int l = r / I_RT; r %= I_RT; const int kb = r / 2, nb = r % 2, n0 = nb * 32;
            conv_item<true>(gin(p, 16) + (size_t)l * D * NE, NE, (bf16*)(ws + WS_RT_HI) + (size_t)l * NE * D, (bf16*)(ws + WS_RT_LO) + (size_t)l * NE * D, D, kb * 64, n0, n0, 1.0f, scr, F.lane); }
    }
}
__device__ __forceinline__ void phase_conv_moe(const Frame& F, KP p, int l) {
    LAS float* scr = (LAS float*)(F.lds + F.wave * 16384);
    const int gw = F.vcu * NWAVES + F.wave, NGW = F.G * NWAVES;
    for (int it = gw; it < 65 * 384; it += NGW) {
        const int e = it / 384, r = it % 384, which = r >> 7, rr = r & 127;
        bf16* We = (bf16*)(F.ws + WS_WMOE + (size_t)e * WMOE_E_BYTES);
        if (which < 2) { const float* src = (e < 64) ? gin(p, 18 + which) + ((size_t)l * NE + e) * D * ED : gin(p, 21 + which) + (size_t)l * D * ED;
            const int kb = rr >> 3, nb = rr & 7, n0 = nb * 32; const int drow = (n0 >> 7) * 256 + which * 128 + (n0 & 127);
            conv_item8(src, ED, (unsigned char*)We, D, kb * 64, n0, drow, WUP_SCALE, scr, F.lane);
        } else { const float* src = (e < 64) ? gin(p, 20) + ((size_t)l * NE + e) * ED * D : gin(p, 23) + (size_t)l * ED * D;
            const int kb = rr >> 5, nb = rr & 31, n0 = nb * 32;
            conv_item<false>(src, D, We + 512 * 1024, nullptr, ED, kb * 64, n0, n0, 1.0f, scr, F.lane); }
    }
}

__device__ __forceinline__ void phase_lnr(const Frame& F, KP p, int layer, bool dry = false) {
    const bf16* Y = (const bf16*)(F.ws + WS_Y); bf16* XB = (bf16*)(F.ws + WS_XB); unsigned char* XB8 = (unsigned char*)(F.ws + WS_X);
    const float* lng = gin(p, 24) + (size_t)(layer * 2) * D; const float* lnb = gin(p, 25) + (size_t)(layer * 2) * D;
    const bf16* rthi = (const bf16*)(F.ws + WS_RT_HI) + (size_t)layer * NE * D; const bf16* rtlo = (const bf16*)(F.ws + WS_RT_LO) + (size_t)layer * NE * D;
    const float* rbias = gin(p, 17) + layer * NE;
    unsigned* cnt = (unsigned*)(F.ws + WS_CTL) + CW_CNT + layer * NE * 64;
    int* lists = (int*)(F.ws + WS_LIST); int* tokmap = (int*)(F.ws + WS_LIST + 4 * MiB); float* tokgate = (float*)(F.ws + WS_LIST + 5 * MiB);
    constexpr int XLD = 1032, MAXT = 8;
    LAS bf16* Xhi = (LAS bf16*)F.lds; LAS bf16* Xlo = Xhi + 16 * XLD;
    LAS float* part = (LAS float*)(F.lds + 2 * 16 * XLD * 2);
    LAS int* ent = (LAS int*)(part + 2 * 16 * 64);
    LAS int* hist = ent + MAXT * 16 * 8 * 2; LAS int* base = hist + 64;
    const int lane = F.lane, w = F.wave, g4 = lane >> 4, l15 = lane & 15;
    if (F.tid < 64) hist[F.tid] = 0;
    f32x4 gv[4], bv[4];
#pragma unroll
    for (int j = 0; j < 2; ++j) { gv[2 * j] = *(const f32x4*)(lng + 8 * lane + 512 * j); gv[2 * j + 1] = *(const f32x4*)(lng + 8 * lane + 512 * j + 4);
        bv[2 * j] = *(const f32x4*)(lnb + 8 * lane + 512 * j); bv[2 * j + 1] = *(const f32x4*)(lnb + 8 * lane + 512 * j + 4); }
    int ntile = 0;
    for (int tile = F.vcu; tile < T / 16 && ntile < MAXT; tile += F.G, ++ntile) {
        const int t0 = tile * 16;
#pragma unroll
        for (int rr = 0; rr < 2; ++rr) {
            const int lr = 2 * w + rr; const size_t row = (size_t)(t0 + lr);
            f32x4 v[4]; float s = 0.f;
#pragma unroll
            for (int j = 0; j < 2; ++j) { const u32x4 yw = *(const u32x4*)(Y + row * D + 8 * lane + 512 * j); unpack_bf16x8(yw, v[2 * j], v[2 * j + 1]); }
#pragma unroll
            for (int j = 0; j < 4; ++j) s += (v[j][0] + v[j][1]) + (v[j][2] + v[j][3]);
            const float mean = wave_sum(s, lane) * (1.f / D); float s2 = 0.f;
#pragma unroll
            for (int j = 0; j < 4; ++j) { v[j] = v[j] - mean; s2 += (v[j][0] * v[j][0] + v[j][1] * v[j][1]) + (v[j][2] * v[j][2] + v[j][3] * v[j][3]); }
            const float rstd = 1.0f / sqrtf(wave_sum(s2, lane) * (1.f / D) + LN_EPS);
#pragma unroll
            for (int j = 0; j < 2; ++j) { const f32x4 o0 = v[2 * j] * rstd * gv[2 * j] + bv[2 * j], o1 = v[2 * j + 1] * rstd * gv[2 * j + 1] + bv[2 * j + 1];
                const u32x4 hi = pack_bf16x8(o0, o1);
                *(u32x4*)(XB + row * D + 8 * lane + 512 * j) = hi;
                { u32x2 q8; q8.x = pk4_fp8(o0[0], o0[1], o0[2], o0[3]); q8.y = pk4_fp8(o1[0], o1[1], o1[2], o1[3]); *(u32x2*)(XB8 + row * D + 8 * lane + 512 * j) = q8; }
                f32x4 h0, h1; unpack_bf16x8(hi, h0, h1); const u32x4 lo = pack_bf16x8(o0 - h0, o1 - h1);
                *(LAS u32x4*)(Xhi + lr * XLD + 8 * lane + 512 * j) = hi; *(LAS u32x4*)(Xlo + lr * XLD + 8 * lane + 512 * j) = lo; }
        }
        __syncthreads();
        { const int nt = w & 3, kh = w >> 2; f32x4 acc = (f32x4){0.f, 0.f, 0.f, 0.f};
            const bf16* bh = rthi + (size_t)(16 * nt + l15) * D + 512 * kh + 8 * g4; const bf16* bl = rtlo + (size_t)(16 * nt + l15) * D + 512 * kh + 8 * g4;
#pragma unroll 8
            for (int ks = 0; ks < 16; ++ks) { const int k0 = 512 * kh + 32 * ks;
                const bf16x8 ahi = row_frag(Xhi, XLD, 0, k0, lane), alo = row_frag(Xlo, XLD, 0, k0, lane);
                const bf16x8 bhi = *(const bf16x8*)(bh + 32 * ks), blo = *(const bf16x8*)(bl + 32 * ks);
                acc = MFMA16(ahi, bhi, acc); acc = MFMA16(alo, bhi, acc); acc = MFMA16(ahi, blo, acc); }
#pragma unroll
            for (int i = 0; i < 4; ++i) part[(kh * 16 + 4 * g4 + i) * 64 + 16 * nt + l15] = acc[i];
        }
        __syncthreads();
#pragma unroll
        for (int rr = 0; rr < 2; ++rr) {
            const int lt = ntile * 16 + 2 * w + rr;
            const float lg = part[(2 * w + rr) * 64 + lane] + part[(16 + 2 * w + rr) * 64 + lane];
            float sc = 1.0f / (1.0f + expf(-lg)); sc = (sc == sc) ? sc : 0.5f;
            const float sel = sc + rbias[lane];
            float m1 = sel; m1 = fmaxf(m1, shx(m1, 1, lane)); m1 = fmaxf(m1, shx(m1, 2, lane)); m1 = fmaxf(m1, shx(m1, 4, lane));
            const unsigned long long eq = __ballot(sel == m1);
            const unsigned gm = (unsigned)(eq >> (lane & 56)) & 0xffu;
            const int first = (lane & 56) + __builtin_ctz(gm | 0x100u);
            float m2 = (lane == first) ? -INFINITY : sel; m2 = fmaxf(m2, shx(m2, 1, lane)); m2 = fmaxf(m2, shx(m2, 2, lane)); m2 = fmaxf(m2, shx(m2, 4, lane));
            const float gs = m1 + m2; const int mygrp = lane >> 3; int grank = 0;
#pragma unroll
            for (int gg = 0; gg < 8; ++gg) { const float o = rdl(gs, 8 * gg); grank += (o > gs || (o == gs && gg < mygrp)) ? 1 : 0; }
            const float mv = (grank < 4) ? sel : -INFINITY; int rank = 0;
#pragma unroll
            for (int e2 = 0; e2 < 64; ++e2) { const float o = rdl(mv, e2); rank += (o > mv || (o == mv && e2 < lane)) ? 1 : 0; }
            const bool chosen = rank < TOPK;
            const float wsum = wave_sum(chosen ? sc : 0.f, lane);
            if (chosen) { const int lpos = __hip_atomic_fetch_add(hist + lane, 1, __ATOMIC_RELAXED, __HIP_MEMORY_SCOPE_WORKGROUP);
                ent[(lt * 8 + rank) * 2] = (lane << 16) | lpos; ent[(lt * 8 + rank) * 2 + 1] = __builtin_bit_cast(int, sc / wsum * 2.5f); }
        }
    }
    __syncthreads();
    if (dry) return;
    if (F.tid < 64) { const int hcount = hist[F.tid]; base[F.tid] = hcount ? (int)atomicAdd(cnt + F.tid * 64, (unsigned)hcount) : 0; }
    __syncthreads();
    for (int idx = F.tid; idx < ntile * 16 * 8; idx += NTHREADS) {
        const int ev = ent[idx * 2], gb = ent[idx * 2 + 1]; const int e = ev >> 16, pos = base[e] + (ev & 0xffff);
        const int lt = idx >> 3, rank = idx & 7, tok = (F.vcu + (lt >> 4) * F.G) * 16 + (lt & 15);
        lists[(size_t)e * T + pos] = tok; tokmap[tok * 8 + rank] = (e << 16) | pos; tokgate[tok * 8 + rank] = __builtin_bit_cast(float, gb);
    }
}

__device__ __forceinline__ void phase_combine(const Frame& F, KP p, int layer, bool dry = false) {
    bf16* XB = (bf16*)(F.ws + WS_XB); const unsigned char* yexp = (const unsigned char*)(F.ws + WS_BIG);
    const int* tokmap = (const int*)(F.ws + WS_LIST + 4 * MiB); const float* tokgate = (const float*)(F.ws + WS_LIST + 5 * MiB);
    const volatile LAS int* tstart = (const volatile LAS int*)(F.MISC + 64);
    const float* lng = gin(p, 24) + (size_t)(layer * 2 + 1) * D; const float* lnb = gin(p, 25) + (size_t)(layer * 2 + 1) * D;
    float* outp = gout(p); bf16* xbo = XB; if (dry) { outp = (float*)(F.ws + WS_AUX); xbo = (bf16*)(F.ws + WS_H); }
    const int lane = F.lane, gw = F.vcu * NWAVES + F.wave, NGW = F.G * NWAVES;
    const bf16* ysh = (const bf16*)(F.ws + WS_Y);
    f32x4 gv[4], bv[4];
#pragma unroll
    for (int j = 0; j < 4; ++j) { gv[j] = *(const f32x4*)(lng + 16 * lane + 4 * j); bv[j] = *(const f32x4*)(lnb + 16 * lane + 4 * j); }
    for (int row = gw; row < T; row += NGW) {
        const int mk = tokmap[row * 8 + (lane & 7)]; const float gk = tokgate[row * 8 + (lane & 7)] * YEXP_INV;
        const int rk = (int)tstart[mk >> 16] * 256 + (mk & 0xffff);
        f32x4 v[4];
#pragma unroll
        for (int j = 0; j < 2; ++j) { const u32x4 xw = *(const u32x4*)(ysh + (size_t)row * D + 16 * lane + 8 * j); unpack_bf16x8(xw, v[2 * j], v[2 * j + 1]); }
#pragma unroll
        for (int k = 0; k < TOPK; ++k) { const int r = __builtin_amdgcn_readlane(rk, k); const float g = rdl(gk, k);
            const u32x4 s = *(const u32x4*)(yexp + (size_t)r * D + 16 * lane);
#pragma unroll
            for (int j = 0; j < 4; ++j) { const f32x2 lo = __builtin_amdgcn_cvt_pk_f32_fp8((int)s[j], false), hi = __builtin_amdgcn_cvt_pk_f32_fp8((int)s[j], true);
                v[j][0] += g * lo[0]; v[j][1] += g * lo[1]; v[j][2] += g * hi[0]; v[j][3] += g * hi[1]; } }
        float s = 0.f;
#pragma unroll
        for (int j = 0; j < 4; ++j) s += (v[j][0] + v[j][1]) + (v[j][2] + v[j][3]);
        const float mean = wave_sum(s, lane) * (1.f / D); float s2 = 0.f;
#pragma unroll
        for (int j = 0; j < 4; ++j) { v[j] = v[j] - mean; s2 += (v[j][0] * v[j][0] + v[j][1] * v[j][1]) + (v[j][2] * v[j][2] + v[j][3] * v[j][3]); }
        const float rstd = 1.0f / sqrtf(wave_sum(s2, lane) * (1.f / D) + LN_EPS);
        f32x4 o[4];
#pragma unroll
        for (int j = 0; j < 4; ++j) o[j] = v[j] * rstd * gv[j] + bv[j];
        if (layer == DEPTH - 1 || dry) {
#pragma unroll
            for (int j = 0; j < 4; ++j) *(f32x4*)(outp + (size_t)row * D + 16 * lane + 4 * j) = o[j]; }
        if (layer != DEPTH - 1) { *(u32x4*)(xbo + (size_t)row * D + 16 * lane) = pack_bf16x8(o[0], o[1]); *(u32x4*)(xbo + (size_t)row * D + 16 * lane + 8) = pack_bf16x8(o[2], o[3]);
            if (!dry) { u32x4 q8; q8.x = pk4_fp8(o[0][0], o[0][1], o[0][2], o[0][3]); q8.y = pk4_fp8(o[1][0], o[1][1], o[1][2], o[1][3]); q8.z = pk4_fp8(o[2][0], o[2][1], o[2][2], o[2][3]); q8.w = pk4_fp8(o[3][0], o[3][1], o[3][2], o[3][3]);
                *(u32x4*)((unsigned char*)(F.ws + WS_X) + (size_t)row * D + 16 * lane) = q8; } }
    }
}

constexpr size_t AUX_OB = 96 * MiB, AUX_LSE = 128 * MiB;
__device__ __forceinline__ void phase_attn(const Frame& F, int bx) {
    const bf16* qkv = (const bf16*)(F.ws + WS_BIG); bf16* og = (bf16*)(F.ws + WS_AUX); float* lse = (float*)(F.ws + WS_AUX + AUX_LSE);
    constexpr int KLD = 136;
    LAS bf16* Ks = (LAS bf16*)F.lds; LAS bf16* Vs = Ks + 256 * KLD;
    const int lane = F.lane, w = F.wave, g4 = lane >> 4, l15 = lane & 15, qq = l15 >> 2, pp = lane & 3;
    u32x4 kreg[8], vreg[8];
#define ATT_DECODE(L_) const int h = (L_) & 7, sb = (L_) >> 3, g = sb >> 7, rem = sb & 127, b = rem >> 6, rn = rem & 63; \
        const int dsh = 2 * g, d = 1 << dsh, nbs = 6 - dsh, r = rn >> nbs, n = rn & ((1 << nbs) - 1); const size_t rowbase = (size_t)b * SEQ;
#define ATT_ISSUE(L_) do { ATT_DECODE(L_) _Pragma("unroll") for (int it = 0; it < 8; ++it) { const int idx = F.tid + 512 * it, c = idx >> 4, ch = idx & 15; int pos = 128 * (n - 1) + c; pos = pos < 0 ? 0 : pos; \
            const bf16* src = qkv + (rowbase + (size_t)pos * d + r) * ATT_IN + g * 3072 + 1024 + h * 128 + ch * 8; kreg[it] = *(const u32x4*)src; vreg[it] = *(const u32x4*)(src + 1024); } } while (0)
    if (bx < 3072) ATT_ISSUE(bx);
    for (int L = bx; L < 3072; L += F.G) {
        ATT_DECODE(L)
#pragma unroll
        for (int it = 0; it < 8; ++it) { const int idx = F.tid + 512 * it, c = idx >> 4, ch = idx & 15;
            *(LAS u32x4*)(Ks + c * KLD + ch * 8) = kreg[it]; *(LAS u32x4*)(Vs + c * KLD + ch * 8) = vreg[it]; }
        const int qi = 16 * w + l15; const size_t qrow = rowbase + (size_t)(128 * n + qi) * d + r;
        bf16x8 qf[4];
#pragma unroll
        for (int s = 0; s < 4; ++s) qf[s] = *(const bf16x8*)(qkv + qrow * ATT_IN + g * 3072 + h * 128 + 32 * s + 8 * g4);
        __syncthreads();
        if (L + F.G < 3072) { ATT_ISSUE(L + F.G); }
        __builtin_amdgcn_sched_barrier(0);
        const int ws0 = (16 * w < 96) ? 16 * w : 96;
        f32x4 sacc[10];
        {
            bf16x8 kfa[4], kfb[4];
#pragma unroll
            for (int s = 0; s < 4; ++s) kfa[s] = row_frag(Ks, KLD, ws0, 32 * s, lane);
#pragma unroll
            for (int t = 0; t < 10; t += 2) {
#pragma unroll
                for (int s = 0; s < 4; ++s) kfb[s] = row_frag(Ks, KLD, ws0 + 16 * (t + 1), 32 * s, lane);
                __builtin_amdgcn_sched_barrier(0);
                sacc[t] = (f32x4){0.f, 0.f, 0.f, 0.f};
#pragma unroll
                for (int s = 0; s < 4; ++s) sacc[t] = MFMA16(kfa[s], qf[s], sacc[t]);
                if (t + 2 < 10) {
#pragma unroll
                    for (int s = 0; s < 4; ++s) kfa[s] = row_frag(Ks, KLD, ws0 + 16 * (t + 2), 32 * s, lane); }
                __builtin_amdgcn_sched_barrier(0);
                sacc[t + 1] = (f32x4){0.f, 0.f, 0.f, 0.f};
#pragma unroll
                for (int s = 0; s < 4; ++s) sacc[t + 1] = MFMA16(kfb[s], qf[s], sacc[t + 1]);
            }
        }
        const float slope = exp2f(-(float)(h + 1)) * (float)d;
        float mx = -INFINITY;
#pragma unroll
        for (int t = 0; t < 10; ++t)
#pragma unroll
            for (int i = 0; i < 4; ++i) { const int c = ws0 + 16 * t + 4 * g4 + i, step = 128 + qi - c;
                const bool valid = (step >= 0) && (step <= 128) && (n > 0 || c >= 128);
                const float v = valid ? sacc[t][i] - slope * (float)step : -INFINITY; sacc[t][i] = v; mx = fmaxf(mx, v); }
        mx = fmaxf(mx, shx(mx, 16, lane)); mx = fmaxf(mx, shx(mx, 32, lane));
        float lsum = 0.f;
#pragma unroll
        for (int t = 0; t < 10; ++t)
#pragma unroll
            for (int i = 0; i < 4; ++i) { const float pv = __expf(sacc[t][i] - mx); sacc[t][i] = pv; lsum += pv; }
        lsum += shx(lsum, 16, lane); lsum += shx(lsum, 32, lane);
        bf16x8 pf[5];
#pragma unroll
        for (int kt = 0; kt < 5; ++kt) pf[kt] = pack8(sacc[2 * kt], sacc[2 * kt + 1]);
        f32x4 o[8];
        {
            const LAS bf16* vb = Vs + (ws0 + 4 * g4 + qq) * KLD + 32 * pp;
            bf16x4 va[10], vc[10];
#pragma unroll
            for (int kt = 0; kt < 5; ++kt) { va[2 * kt] = tr4(vb + 32 * kt * KLD); va[2 * kt + 1] = tr4(vb + (32 * kt + 16) * KLD); }
#pragma unroll
            for (int et = 0; et < 8; et += 2) {
#pragma unroll
                for (int kt = 0; kt < 5; ++kt) { vc[2 * kt] = tr4(vb + 32 * kt * KLD + 4 * (et + 1)); vc[2 * kt + 1] = tr4(vb + (32 * kt + 16) * KLD + 4 * (et + 1)); }
                __builtin_amdgcn_sched_barrier(0);
                o[et] = (f32x4){0.f, 0.f, 0.f, 0.f};
#pragma unroll
                for (int kt = 0; kt < 5; ++kt) o[et] = MFMA16(cat8(va[2 * kt], va[2 * kt + 1]), pf[kt], o[et]);
                if (et + 2 < 8) {
#pragma unroll
                    for (int kt = 0; kt < 5; ++kt) { va[2 * kt] = tr4(vb + 32 * kt * KLD + 4 * (et + 2)); va[2 * kt + 1] = tr4(vb + (32 * kt + 16) * KLD + 4 * (et + 2)); } }
                __builtin_amdgcn_sched_barrier(0);
                o[et + 1] = (f32x4){0.f, 0.f, 0.f, 0.f};
#pragma unroll
                for (int kt = 0; kt < 5; ++kt) o[et + 1] = MFMA16(cat8(vc[2 * kt], vc[2 * kt + 1]), pf[kt], o[et + 1]);
            }
        }
        const float inv = 1.0f / lsum;
        bf16* orow = og + ((size_t)g * T + qrow) * D + h * 128 + 32 * g4;
#pragma unroll
        for (int e2 = 0; e2 < 4; ++e2) *(u32x4*)(orow + 8 * e2) = pack_bf16x8(o[2 * e2] * inv, o[2 * e2 + 1] * inv);
        if (g4 == 0) lse[((size_t)g * T + qrow) * AH + h] = mx + __logf(lsum);
        __syncthreads();
    }
#undef ATT_DECODE
#undef ATT_ISSUE
}
__device__ __forceinline__ void phase_attn_combine(const Frame& F) {
    const bf16* og = (const bf16*)(F.ws + WS_AUX); const float* lse = (const float*)(F.ws + WS_AUX + AUX_LSE); bf16* ob = (bf16*)(F.ws + WS_AUX + AUX_OB);
    const int lane = F.lane, gw = F.vcu * NWAVES + F.wave, NGW = F.G * NWAVES, h = lane >> 3;
    for (int row = gw; row < T; row += NGW) {
        const float l0 = lse[((size_t)0 * T + row) * AH + h], l1 = lse[((size_t)1 * T + row) * AH + h], l2 = lse[((size_t)2 * T + row) * AH + h];
        const float m = fmaxf(l0, fmaxf(l1, l2)); float w0 = __expf(l0 - m), w1 = __expf(l1 - m), w2 = __expf(l2 - m); const float inv = 1.0f / (w0 + w1 + w2); w0 *= inv; w1 *= inv; w2 *= inv;
        float a[16];
#pragma unroll
        for (int j = 0; j < 16; ++j) a[j] = 0.f;
#pragma unroll
        for (int g = 0; g < 3; ++g) { const float wg = (g == 0) ? w0 : (g == 1 ? w1 : w2);
#pragma unroll
            for (int q = 0; q < 2; ++q) { const u32x4 s = *(const u32x4*)(og + ((size_t)g * T + row) * D + 16 * lane + 8 * q);
                a[8 * q + 0] += wg * bflo(s.x); a[8 * q + 1] += wg * bfhi(s.x); a[8 * q + 2] += wg * bflo(s.y); a[8 * q + 3] += wg * bfhi(s.y);
                a[8 * q + 4] += wg * bflo(s.z); a[8 * q + 5] += wg * bfhi(s.z); a[8 * q + 6] += wg * bflo(s.w); a[8 * q + 7] += wg * bfhi(s.w); } }
#pragma unroll
        for (int q = 0; q < 2; ++q) { u32x4 o; o.x = pk2(a[8 * q], a[8 * q + 1]); o.y = pk2(a[8 * q + 2], a[8 * q + 3]); o.z = pk2(a[8 * q + 4], a[8 * q + 5]); o.w = pk2(a[8 * q + 6], a[8 * q + 7]);
            *(u32x4*)(ob + (size_t)row * D + 16 * lane + 8 * q) = o; }
    }
}

constexpr size_t BIG_YRET = 192 * MiB;
__device__ __forceinline__ void phase_ret_u(const Frame& F) {
    const bf16* proj = (const bf16*)(F.ws + WS_BIG); bf16* St = (bf16*)(F.ws + WS_AUX);
    constexpr int LD = 264;
    LAS bf16* Kt = (LAS bf16*)F.lds; LAS bf16* Vt = Kt + 128 * LD;
    const int lane = F.lane, w = F.wave, g4 = lane >> 4, l15 = lane & 15, qq = l15 >> 2, pp = lane & 3;
    for (int u = F.vcu; u < 1024; u += F.G) {
        const int eh = u & 1, h = (u >> 1) & 3, n = (u >> 3) & 63, b = u >> 9;
        const size_t row0 = (size_t)b * SEQ + (size_t)n * RC;
#pragma unroll 4
        for (int it = 0; it < 8; ++it) { const int idx = F.tid + 512 * it, j = idx >> 5, ch = idx & 31;
            const bf16* src = proj + (row0 + j) * RET_IN;
            const u32x4 kv = *(const u32x4*)(src + 1024 + h * 256 + ch * 8), vv = *(const u32x4*)(src + 2048 + h * 512 + eh * 256 + ch * 8);
            *(LAS u32x4*)(Kt + j * LD + ch * 8) = kv; *(LAS u32x4*)(Vt + j * LD + ch * 8) = vv; }
        __syncthreads();
        f32x4 acc[16][2];
#pragma unroll
        for (int mt = 0; mt < 16; ++mt) { acc[mt][0] = (f32x4){0.f, 0.f, 0.f, 0.f}; acc[mt][1] = (f32x4){0.f, 0.f, 0.f, 0.f}; }
#pragma unroll
        for (int ks = 0; ks < 4; ++ks) {
            bf16x8 bfr[2];
#pragma unroll
            for (int nt = 0; nt < 2; ++nt) { const LAS bf16* a0 = Vt + (32 * ks + 8 * g4 + qq) * LD + 32 * w + 16 * nt + 4 * pp; bfr[nt] = cat8(tr4(a0), tr4(a0 + 4 * LD)); }
#pragma unroll
            for (int mt = 0; mt < 16; ++mt) { const LAS bf16* a0 = Kt + (32 * ks + 8 * g4 + qq) * LD + 128 * (mt >> 3) + 32 * pp + 4 * (mt & 7);
                const bf16x8 afr = cat8(tr4(a0), tr4(a0 + 4 * LD));
                acc[mt][0] = MFMA16(afr, bfr[0], acc[mt][0]); acc[mt][1] = MFMA16(afr, bfr[1], acc[mt][1]); }
        }
        bf16* outb = St + ((size_t)((b * RH + h) * RNC + n)) * (RDV * RDK);
#pragma unroll
        for (int nt = 0; nt < 2; ++nt) { bf16* orow = outb + (size_t)(eh * 256 + 32 * w + 16 * nt + l15) * RDK + 32 * g4;
#pragma unroll
            for (int mh = 0; mh < 2; ++mh)
#pragma unroll
                for (int q = 0; q < 4; ++q) *(u32x4*)(orow + 128 * mh + 8 * q) = pack_bf16x8(acc[mh * 8 + 2 * q][nt], acc[mh * 8 + 2 * q + 1][nt]); }
        __syncthreads();
    }
}
__device__ __forceinline__ void phase_ret_scan(const Frame& F) {
    bf16* St = (bf16*)(F.ws + WS_AUX);
    for (int gt = F.vcu * NTHREADS + F.tid; gt < 8 * 16384; gt += F.G * NTHREADS) {
        const int bh = gt >> 14, chunk = gt & 16383, h = bh & 3;
        const float g128 = exp2f(128.0f * log2f(1.0f - exp2f(-5.0f - (float)h)));
        bf16* base = St + (size_t)bh * RNC * (RDV * RDK) + (size_t)chunk * 8;
        float c[8];
#pragma unroll
        for (int j = 0; j < 8; ++j) c[j] = 0.f;
#pragma unroll 8
        for (int n = 0; n < RNC; ++n) { bf16* pn = base + (size_t)n * (RDV * RDK); const u32x4 uv = *(const u32x4*)pn;
            u32x4 o; o.x = pk2(c[0], c[1]); o.y = pk2(c[2], c[3]); o.z = pk2(c[4], c[5]); o.w = pk2(c[6], c[7]); *(u32x4*)pn = o;
            c[0] = g128 * (c[0] + bflo(uv.x)); c[1] = g128 * (c[1] + bfhi(uv.x)); c[2] = g128 * (c[2] + bflo(uv.y)); c[3] = g128 * (c[3] + bfhi(uv.y));
            c[4] = g128 * (c[4] + bflo(uv.z)); c[5] = g128 * (c[5] + bfhi(uv.z)); c[6] = g128 * (c[6] + bflo(uv.w)); c[7] = g128 * (c[7] + bfhi(uv.w)); }
    }
}
__device__ __forceinline__ void phase_ret_out(const Frame& F, KP p) {
    const bf16* proj = (const bf16*)(F.ws + WS_BIG); const bf16* St = (const bf16*)(F.ws + WS_AUX); bf16* yret = (bf16*)(F.ws + WS_BIG + BIG_YRET);
    const float* gng = gin(p, 4); const float* gnb = gin(p, 5);
    constexpr int LD = 264, VLD = 136;
    LAS bf16* Rs = (LAS bf16*)F.lds; LAS bf16* Vs = Rs + 128 * LD;
    const int lane = F.lane, w = F.wave, g4 = lane >> 4, l15 = lane & 15, qq = l15 >> 2, pp = lane & 3;
    for (int u = F.vcu; u < 512; u += F.G) {
        const int h = u & 3, n = (u >> 2) & 63, b = u >> 8;
        const size_t row0 = (size_t)b * SEQ + (size_t)n * RC;
#pragma unroll 4
        for (int it = 0; it < 8; ++it) { const int idx = F.tid + 512 * it, j = idx >> 5, ch = idx & 31;
            *(LAS u32x4*)(Rs + j * LD + ch * 8) = *(const u32x4*)(proj + (row0 + j) * RET_IN + 1024 + h * 256 + ch * 8); }
        const int irow = 16 * w + l15; const size_t qrow = row0 + irow;
        bf16x8 qf[8];
#pragma unroll
        for (int s = 0; s < 8; ++s) qf[s] = *(const bf16x8*)(proj + qrow * RET_IN + h * 256 + 32 * s + 8 * g4);
        __syncthreads();
        bf16x8 pf[4];
        { f32x4 sacc[8];
#pragma unroll
            for (int jt = 0; jt < 8; ++jt) { sacc[jt] = (f32x4){0.f, 0.f, 0.f, 0.f};
                if (jt <= w) {
#pragma unroll
                    for (int s = 0; s < 8; ++s) sacc[jt] = MFMA16(row_frag(Rs, LD, 16 * jt, 32 * s, lane), qf[s], sacc[jt]);
#pragma unroll
                    for (int i = 0; i < 4; ++i) if (16 * jt + 4 * g4 + i > irow) sacc[jt][i] = 0.f; } }
#pragma unroll
            for (int kt = 0; kt < 4; ++kt) pf[kt] = pack8(sacc[2 * kt], sacc[2 * kt + 1]); }
        __syncthreads();
        f32x4 acc[4][8];
        const bf16* Sn = St + ((size_t)((b * RH + h) * RNC + n)) * (RDV * RDK);
#pragma unroll
        for (int sl = 0; sl < 4; ++sl) {
#pragma unroll 4
            for (int it = 0; it < 4; ++it) { const int idx = F.tid + 512 * it, j = idx >> 4, ch = idx & 15;
                *(LAS u32x4*)(Vs + j * VLD + ch * 8) = *(const u32x4*)(proj + (row0 + j) * RET_IN + 2048 + h * 512 + sl * 128 + ch * 8); }
#pragma unroll 4
            for (int it = 0; it < 8; ++it) { const int idx = F.tid + 512 * it, e = idx >> 5, ch = idx & 31;
                *(LAS u32x4*)(Rs + e * LD + ch * 8) = *(const u32x4*)(Sn + (size_t)(sl * 128 + e) * RDK + ch * 8); }
            __syncthreads();
#pragma unroll
            for (int et = 0; et < 8; ++et) { f32x4 a = (f32x4){0.f, 0.f, 0.f, 0.f};
#pragma unroll
                for (int kt = 0; kt < 4; ++kt) if (2 * kt <= w) { const LAS bf16* a0 = Vs + (32 * kt + 4 * g4 + qq) * VLD + 32 * pp + 4 * et;
                    a = MFMA16(cat8(tr4(a0), tr4(a0 + 16 * VLD)), pf[kt], a); }
                const LAS bf16* srow = Rs + (32 * qq + 4 * et + pp) * LD + 8 * g4;
#pragma unroll
                for (int s = 0; s < 8; ++s) a = MFMA16(*(const LAS bf16x8*)(srow + 32 * s), qf[s], a);
                acc[sl][et] = a; }
            __syncthreads();
        }
        float s = 0.f;
#pragma unroll
        for (int sl = 0; sl < 4; ++sl)
#pragma unroll
            for (int et = 0; et < 8; ++et) s += (acc[sl][et][0] + acc[sl][et][1]) + (acc[sl][et][2] + acc[sl][et][3]);
        s += shx(s, 16, lane); s += shx(s, 32, lane);
        const float mean = s * (1.0f / RDV); float s2 = 0.f;
#pragma unroll
        for (int sl = 0; sl < 4; ++sl)
#pragma unroll
            for (int et = 0; et < 8; ++et) { acc[sl][et] = acc[sl][et] - mean; s2 += (acc[sl][et][0] * acc[sl][et][0] + acc[sl][et][1] * acc[sl][et][1]) + (acc[sl][et][2] * acc[sl][et][2] + acc[sl][et][3] * acc[sl][et][3]); }
        s2 += shx(s2, 16, lane); s2 += shx(s2, 32, lane);
        const float rstd = 1.0f / sqrtf(s2 * (1.0f / RDV) + LN_EPS);
#pragma unroll
        for (int sl = 0; sl < 4; ++sl) { const int c0 = h * RDV + sl * 128 + 32 * g4;
#pragma unroll
            for (int q = 0; q < 4; ++q) { const u32x4 gw = *(const u32x4*)(proj + qrow * RET_IN + 4096 + c0 + 8 * q);
                const f32x4 gg0 = *(const f32x4*)(gng + c0 + 8 * q), gg1 = *(const f32x4*)(gng + c0 + 8 * q + 4), gb0 = *(const f32x4*)(gnb + c0 + 8 * q), gb1 = *(const f32x4*)(gnb + c0 + 8 * q + 4);
                f32x4 y0 = acc[sl][2 * q] * rstd * gg0 + gb0, y1 = acc[sl][2 * q + 1] * rstd * gg1 + gb1;
                const float gv[8] = {bflo(gw.x), bfhi(gw.x), bflo(gw.y), bfhi(gw.y), bflo(gw.z), bfhi(gw.z), bflo(gw.w), bfhi(gw.w)};
#pragma unroll
                for (int j = 0; j < 4; ++j) { y0[j] *= gv[j] / (1.0f + __expf(-gv[j])); y1[j] *= gv[4 + j] / (1.0f + __expf(-gv[4 + j])); }
                *(u32x4*)(yret + qrow * RET_V + c0 + 8 * q) = pack_bf16x8(y0, y1); } }
    }
}

constexpr size_t AUX_S5E = 64 * MiB;
constexpr int S5L = 256, S5NC = SEQ / S5L;
__device__ __forceinline__ void cmul_add(float& rr, float& ri, float ar, float ai, float xr, float xi, float cr, float ci) { rr = ar * xr - ai * xi + cr; ri = ar * xi + ai * xr + ci; }
template <bool OUT>
__device__ __forceinline__ void phase_s5_scan(const Frame& F, KP p) {
    const bf16* X = (const bf16*)(F.ws + WS_XB); float* E = (float*)(F.ws + WS_AUX + AUX_S5E); bf16* ybuf = (bf16*)(F.ws + WS_AUX);
    const int lane = F.lane, w = F.wave, g4 = lane >> 4, l15 = lane & 15;
    LAS bf16* ut = (LAS bf16*)(F.lds + w * 12288);
    LAS bf16* Hb = (LAS bf16*)(F.lds + w * 12288 + 4096);
    constexpr int HLD = 136;
    const int gw = F.vcu * NWAVES + w, NGW = F.G * NWAVES;
    const int up16 = (lane - 16) << 2, up32 = (lane - 32) << 2, last16 = (48 + l15) << 2;
    for (int unit = gw; unit < BATCH * SG * S5NC; unit += NGW) {
        const int n = unit & (S5NC - 1), g = (unit >> 5) & 63, b = unit >> 11;
        float a1r[4], a1i[4], a4r[4], a4i[4], a8r[4], a8i[4], pwr[4], pwi[4];
        bf16x8 bfrag[8];
        const float dt = expf(gin(p, 14)[g]);
#pragma unroll
        for (int st = 0; st < 4; ++st) { const int ps = 16 * st + l15;
            const float are = gin(p, 7)[g * SP + ps], aim = gin(p, 8)[g * SP + ps];
            const float mag = expf(dt * are); const float abr = mag * cosf(dt * aim), abi = mag * sinf(dt * aim);
            const float den = are * are + aim * aim;
            const float fre = ((abr - 1.0f) * are + abi * aim) / den, fim = (abi * are - (abr - 1.0f) * aim) / den;
            a1r[st] = abr; a1i[st] = abi; { float t2r, t2i; cmul_add(t2r, t2i, abr, abi, abr, abi, 0.f, 0.f); cmul_add(a4r[st], a4i[st], t2r, t2i, t2r, t2i, 0.f, 0.f); }
            cmul_add(a8r[st], a8i[st], a4r[st], a4i[st], a4r[st], a4i[st], 0.f, 0.f);
            float qr = 1.f, qi = 0.f;
            if (g4 & 1) { qr = a4r[st]; qi = a4i[st]; }
            if (g4 & 2) { float tr, ti; cmul_add(tr, ti, qr, qi, a8r[st], a8i[st], 0.f, 0.f); qr = tr; qi = ti; }
            pwr[st] = qr; pwi[st] = qi;
            const float* br = gin(p, 9) + ((size_t)g * SP + ps) * SGC + 8 * (g4 & 1); const float* bi = gin(p, 10) + ((size_t)g * SP + ps) * SGC + 8 * (g4 & 1);
            const f32x4 r0 = *(const f32x4*)br, r1 = *(const f32x4*)(br + 4), i0 = *(const f32x4*)bi, i1 = *(const f32x4*)(bi + 4);
            const float z = (g4 < 2) ? 1.0f : 0.0f; const float fr2 = fre * z, fi2 = fim * z;
            bfrag[st] = pack8(r0 * fr2 - i0 * fi2, r1 * fr2 - i1 * fi2); bfrag[st + 4] = pack8(i0 * fr2 + r0 * fi2, i1 * fr2 + r1 * fi2);
        }
        float sr[4], si[4];
        float* Eu = E + ((size_t)(b * SG + g) * S5NC + n) * 128;
        bf16x8 cf[4]; f32x4 dsk = (f32x4){0.f, 0.f, 0.f, 0.f};
#pragma unroll
        for (int st = 0; st < 4; ++st) { sr[st] = 0.f; si[st] = 0.f; }
        if (OUT) {
#pragma unroll
            for (int st = 0; st < 4; ++st) { sr[st] = Eu[16 * st + l15]; si[st] = Eu[64 + 16 * st + l15]; }
#pragma unroll
            for (int s = 0; s < 4; ++s) { const float* cp = (s < 2 ? gin(p, 11) : gin(p, 12)) + ((size_t)g * SGC + l15) * SP + 32 * (s & 1) + 8 * g4; const float sg = s < 2 ? 1.0f : -1.0f;
                const f32x4 c0 = *(const f32x4*)cp * sg, c1 = *(const f32x4*)(cp + 4) * sg; cf[s] = pack8(c0, c1); }
            dsk = *(const f32x4*)(gin(p, 13) + g * SGC + 4 * g4); }
        const size_t tok0 = (size_t)b * SEQ + (size_t)n * S5L;
        u32x4 pre[2];
        { const bf16* src = X + (tok0 + lane) * D + g * SGC; pre[0] = *(const u32x4*)src; pre[1] = *(const u32x4*)(src + 8); }
        for (int sub = 0; sub < S5L / 64; ++sub) {
            *(LAS u32x4*)(ut + lane * 16) = pre[0]; *(LAS u32x4*)(ut + lane * 16 + 8) = pre[1];
            if (sub + 1 < S5L / 64) { const bf16* src = X + (tok0 + (sub + 1) * 64 + lane) * D + g * SGC; pre[0] = *(const u32x4*)src; pre[1] = *(const u32x4*)(src + 8); }
            LDS_WAIT(); asm volatile("" ::: "memory");
#pragma unroll (OUT ? 1 : 4)
            for (int blk = 0; blk < 4; ++blk) {
                u32x4 uw = *(const LAS u32x4*)(ut + (blk * 16 + l15) * 16 + 8 * (g4 & 1));
                if (g4 >= 2) uw = (u32x4){0u, 0u, 0u, 0u};
                const bf16x8 ufr = __builtin_bit_cast(bf16x8, uw);
                f32x4 dr[4], di[4];
#pragma unroll
                for (int st = 0; st < 4; ++st) { dr[st] = MFMA16(ufr, bfrag[st], ((f32x4){0.f, 0.f, 0.f, 0.f})); di[st] = MFMA16(ufr, bfrag[st + 4], ((f32x4){0.f, 0.f, 0.f, 0.f})); }
                float vr[4], vi[4];
#pragma unroll
                for (int st = 0; st < 4; ++st) {
                    float hr = 0.f, hi = 0.f;
#pragma unroll
                    for (int i = 0; i < 4; ++i) { float nr, ni; cmul_add(nr, ni, a1r[st], a1i[st], hr, hi, dr[st][i], di[st][i]); hr = nr; hi = ni; dr[st][i] = hr; di[st][i] = hi; }
                    vr[st] = hr; vi[st] = hi; }
#define BPF(idx, v) __builtin_bit_cast(float, __builtin_amdgcn_ds_bpermute((idx), __builtin_bit_cast(int, (v))))
                { float xr[4], xi[4];
#pragma unroll
                  for (int st = 0; st < 4; ++st) { xr[st] = BPF(up16, vr[st]); xi[st] = BPF(up16, vi[st]); }
#pragma unroll
                  for (int st = 0; st < 4; ++st) { float tr, ti; cmul_add(tr, ti, a4r[st], a4i[st], xr[st], xi[st], vr[st], vi[st]); if (g4 >= 1) { vr[st] = tr; vi[st] = ti; } }
#pragma unroll
                  for (int st = 0; st < 4; ++st) { xr[st] = BPF(up32, vr[st]); xi[st] = BPF(up32, vi[st]); }
#pragma unroll
                  for (int st = 0; st < 4; ++st) { float tr, ti; cmul_add(tr, ti, a8r[st], a8i[st], xr[st], xi[st], vr[st], vi[st]); if (g4 >= 2) { vr[st] = tr; vi[st] = ti; } } }
                float er[4], ei[4], lr[4], li[4];
#pragma unroll
                for (int st = 0; st < 4; ++st) { if (OUT) { er[st] = BPF(up16, vr[st]); ei[st] = BPF(up16, vi[st]); } else { er[st] = 0.f; ei[st] = 0.f; } lr[st] = BPF(last16, vr[st]); li[st] = BPF(last16, vi[st]); }
#undef BPF
#pragma unroll
                for (int st = 0; st < 4; ++st) {
                    if (g4 == 0) { er[st] = 0.f; ei[st] = 0.f; }
                    if (OUT) { float s0r, s0i; cmul_add(s0r, s0i, pwr[st], pwi[st], sr[st], si[st], er[st], ei[st]);
#pragma unroll
                        for (int i = 0; i < 4; ++i) { float tr, ti; cmul_add(tr, ti, a1r[st], a1i[st], s0r, s0i, 0.f, 0.f); s0r = tr; s0i = ti; dr[st][i] += s0r; di[st][i] += s0i; } }
                    { float a16r, a16i; cmul_add(a16r, a16i, a8r[st], a8i[st], a8r[st], a8i[st], 0.f, 0.f); float tr, ti; cmul_add(tr, ti, a16r, a16i, sr[st], si[st], lr[st], li[st]); sr[st] = tr; si[st] = ti; }
                    if (OUT) {
#pragma unroll
                        for (int i = 0; i < 4; ++i) { const unsigned hw = pk2(dr[st][i], di[st][i]); Hb[(4 * g4 + i) * HLD + 16 * st + l15] = (bf16)hw; Hb[(4 * g4 + i) * HLD + 64 + 16 * st + l15] = (bf16)(hw >> 16); } }
                }
                if (OUT) {
                    LDS_WAIT(); asm volatile("" ::: "memory");
                    f32x4 ya = (f32x4){0.f, 0.f, 0.f, 0.f};
#pragma unroll
                    for (int s = 0; s < 4; ++s) ya = MFMA16(cf[s], row_frag(Hb, HLD, 0, 32 * s, lane), ya);
                    const u32x2 u2 = *(const LAS u32x2*)(ut + (blk * 16 + l15) * 16 + 4 * g4);
                    const f32x4 u4 = (f32x4){bflo(u2.x), bfhi(u2.x), bflo(u2.y), bfhi(u2.y)};
                    f32x4 y = ya + dsk * u4;
#pragma unroll
                    for (int j = 0; j < 4; ++j) { const float v = y[j]; y[j] = v / (1.0f + __expf(-1.5957691216057308f * (v + 0.044715f * v * v * v))); }
                    u32x2 o; o.x = pk2(y[0], y[1]); o.y = pk2(y[2], y[3]);
                    *(u32x2*)(ybuf + (tok0 + sub * 64 + blk * 16 + l15) * D + g * SGC + 4 * g4) = o;
                    asm volatile("" ::: "memory"); }
            }
            LDS_WAIT(); asm volatile("" ::: "memory");
        }
        if (!OUT && g4 == 0) {
#pragma unroll
            for (int st = 0; st < 4; ++st) { Eu[16 * st + l15] = sr[st]; Eu[64 + 16 * st + l15] = si[st]; } }
    }
}
__device__ __forceinline__ void phase_s5_carry(const Frame& F, KP p) {
    float* E = (float*)(F.ws + WS_AUX + AUX_S5E);
    for (int gt = F.vcu * NTHREADS + F.tid; gt < BATCH * SG * SP; gt += F.G * NTHREADS) {
        const int pl = gt & 63, bg = gt >> 6, g = bg & 63;
        const float dt = expf(gin(p, 14)[g]); const float are = gin(p, 7)[g * SP + pl], aim = gin(p, 8)[g * SP + pl];
        const float mag = expf(dt * are); float ar = mag * cosf(dt * aim), ai = mag * sinf(dt * aim);
#pragma unroll
        for (int q = 0; q < 8; ++q) { const float nr = ar * ar - ai * ai, ni = 2.0f * ar * ai; ar = nr; ai = ni; }
        float cr = 0.f, ci = 0.f;
        for (int n = 0; n < S5NC; ++n) { float* Eu = E + ((size_t)bg * S5NC + n) * 128; const float er = Eu[pl], ei = Eu[64 + pl];
            Eu[pl] = cr; Eu[64 + pl] = ci;
            const float nr = ar * cr - ai * ci + er, ni = ar * ci + ai * cr + ei; cr = nr; ci = ni; }
    }
}

constexpr int NPHASES = 34;
#ifndef PROBE_DRY14
#define PROBE_DRY14 0
#endif
#ifndef PROBE_DRY17
#define PROBE_DRY17 0
#endif
#ifndef PH_MASK
#define PH_MASK 0xFFFFFFFFu
#endif
#define PHT(t) ((PH_MASK >> (t)) & 1u)
constexpr int PLAN_OFF = 64;
__device__ __forceinline__ void moe_plan(const Frame& F, int layer) {
    volatile LAS int* tstart = (volatile LAS int*)(F.MISC + PLAN_OFF); volatile LAS int* cnts = tstart + 72;
    __syncthreads();
    if (F.wave == 0) {
        const unsigned* cnt = (const unsigned*)(F.ws + WS_CTL) + CW_CNT + layer * NE * 64;
        const int c = (int)__hip_atomic_load(cnt + F.lane * 64, __ATOMIC_RELAXED, __HIP_MEMORY_SCOPE_AGENT);
        int v = (c + 255) >> 8;
#pragma unroll
        for (int o = 1; o < 64; o <<= 1) { const int nb = __builtin_amdgcn_ds_bpermute((F.lane - o) << 2, v); if (F.lane >= o) v += nb; }
        tstart[F.lane + 1] = v; cnts[F.lane] = c;
        if (F.lane == 0) tstart[0] = 0;
        if (F.lane == 63) { tstart[65] = v + T / 256; cnts[64] = T; }
    }
    __syncthreads();
}
template <bool GATH> struct MoeSched2 {
    static constexpr bool GATHER = GATH, UNIFORMIZE = true, FP8 = GATH;
    static constexpr int ncol = GATH ? 2 : 4, K = GATH ? D / 2 : ED;
    const volatile LAS int* tstart; const volatile LAS int* cnts; int ntiles, G, c, lane;
    const char* Abase; const char* Wbase; const int* lists;
    __device__ __forceinline__ bool next(int i, pg8::UnitG& u) const {
        const int nwg = ntiles * ncol; const long L = (long)i * G + c; if (L >= nwg) return false;
        int wgid = (int)L; { const int q = nwg / 8, r = nwg % 8, xcd = wgid % 8, off = wgid / 8; wgid = (xcd < r ? xcd * (q + 1) : r * (q + 1) + (xcd - r) * q) + off; }
        const int tile = wgid / ncol, pn = wgid % ncol;
        const int ta = tstart[lane], tb = tstart[lane + 1];
        const unsigned long long mm = __ballot(ta <= tile && tile < tb);
        const int e = mm ? (int)__builtin_ctzll(mm) : 64;
        const int ts = __builtin_amdgcn_readfirstlane((int)tstart[e]), ce = __builtin_amdgcn_readfirstlane((int)cnts[e]);
        const int lt = tile - ts; int valid = ce - lt * 256; valid = valid > 256 ? 256 : valid;
        u.gshift = 0; u.aux = e;
        if (GATH) {
            u.B = Wbase + (size_t)e * WMOE_E_BYTES + (size_t)pn * 256 * K * 2;
            if (e < 64) { u.A = Abase; u.gidx = lists + (size_t)e * T + lt * 256; u.gcnt = valid; }
            else { u.A = Abase + (size_t)lt * 256 * K * 2; u.gidx = nullptr; u.gcnt = 0; }
            u.row0 = tile * 256; u.col0 = pn * 128;
        } else {
            u.B = Wbase + (size_t)e * WMOE_E_BYTES + (size_t)512 * 1024 * 2 + (size_t)pn * 256 * K * 2;
            u.A = Abase + (size_t)tile * 256 * K * 2; u.gidx = nullptr; u.gcnt = valid;
            u.row0 = tile * 256; u.col0 = pn * 256;
        }
        return true;
    }
};
__device__ __forceinline__ void phase_load_x(const Frame& F, KP p) {
    const float* xin = gin(p, 0); bf16* XB = (bf16*)(F.ws + WS_XB);
    for (size_t i = (size_t)F.vcu * NTHREADS + F.tid; i < (size_t)T * D / 8; i += (size_t)F.G * NTHREADS) {
        const f32x4 a = *(const f32x4*)(xin + i * 8), b = *(const f32x4*)(xin + i * 8 + 4);
        *(u32x4*)(XB + i * 8) = pack_bf16x8(a, b);
        u32x2 q8; q8.x = pk4_fp8(a[0], a[1], a[2], a[3]); q8.y = pk4_fp8(b[0], b[1], b[2], b[3]); *(u32x2*)((unsigned char*)(F.ws + WS_X) + i * 8) = q8; }
}

__global__ void __launch_bounds__(NTHREADS, 2) fwd_kernel(Params p_unused) {
    KP p0 = (KP)__builtin_amdgcn_kernarg_segment_ptr();
    extern __shared__ __attribute__((aligned(16))) unsigned char lds_raw[];
    Frame F0;
    F0.lds = (LAS unsigned char*)lds_raw; F0.MISC = (volatile LAS unsigned*)(F0.lds + MISC_OFF);
    F0.tid = threadIdx.x; F0.lane = F0.tid & 63; F0.wave = __builtin_amdgcn_readfirstlane(F0.tid >> 6);
    F0.G = gridDim.x; { const int bq = blockIdx.x; F0.vcu = (F0.G % 8 == 0) ? (bq % 8) * (F0.G / 8) + bq / 8 : bq; }
    F0.ws = p0->ws;
    const int bx0 = blockIdx.x;
    for (int u = F0.tid; u < (LDS_BYTES - MISC_OFF) / 4; u += NTHREADS) ((LAS unsigned*)(F0.lds + MISC_OFF))[u] = 0u;
    __syncthreads();
    XcdBarrier bar; bar.bar = (unsigned*)(p0->ws + WS_CTL) + CW_BAR; bar.x = 0; bar.st = nullptr;
    const int use_bar = p0->use_bar;
    if (use_bar) bar = xcd_barrier_post((unsigned*)(p0->ws + WS_CTL) + CW_BAR, F0.MISC + 8);
    const int lo = p0->ph_lo, hi = p0->ph_hi;
#define PHASE_BEGIN Frame F = F0; KP p = p0; { unsigned ones_ = ~0u; asm volatile("" : "+s"(ones_)); F.lane = (int)__builtin_amdgcn_mbcnt_hi(ones_, __builtin_amdgcn_mbcnt_lo(ones_, 0u)); } asm volatile("" : "+v"(F.lane)); F.tid = F.wave * 64 + F.lane; asm volatile("" : "+v"(F.tid));   GAS unsigned char* wsg_ = (GAS unsigned char*)F0.ws; asm volatile("" : "+s"(F.wave), "+s"(F.vcu), "+s"(F.G), "+s"(wsg_), "+s"(p)); \
    F.ws = (unsigned char*)wsg_; int bx = bx0; asm volatile("" : "+s"(bx)); unsigned char* ws = F.ws; (void)ws; (void)bx;
#pragma unroll 1
    for (int ph = lo; ph < hi; ++ph) {
        int layer = 0, type = 0;
        if (ph > 0) { layer = ph >= 26 ? 3 : (ph >= 18 ? 2 : (ph >= 9 ? 1 : 0)); const int q = ph - (layer == 3 ? 26 : (layer == 2 ? 18 : (layer == 1 ? 9 : 1))); const int kind = layer % 3;
            if (kind == 0) type = q < 4 ? 1 + q : 14 + (q - 4); else if (kind == 1) type = q < 5 ? 5 + q : 14 + (q - 5); else type = q < 4 ? 10 + q : 14 + (q - 4); }
        const int j = layer / 3;
#ifdef REPEAT_MASK
        const int nrep = ((REPEAT_MASK >> type) & 1u) ? 2 : 1;
#else
        const int nrep = 1;
#endif
#pragma unroll 1
        for (int rep = 0; rep < nrep; ++rep) {
        if (rep > 0 && use_bar) xcd_barrier(bar);
        if (PHT(0) && type == 0) { PHASE_BEGIN; phase_conv_mixers(F, p); phase_conv_moe(F, p, 0); phase_load_x(F, p); }
        else if (PHT(1) && type == 1) { PHASE_BEGIN; DenseSched8 S; S.init(ws + WS_X, ws + WS_ATT_IN_T + (size_t)j * ATT_IN * D, T, ATT_IN, D / 2, F.G, bx); EpiStoreBf16 E{(bf16*)(ws + WS_BIG), ATT_IN, WUP_INV, 0.08838834764831845f};
            pg8::gemm_phase(F.lds, F.tid, D / 2, S, E); }
        else if (PHT(2) && type == 2) { PHASE_BEGIN; phase_attn(F, bx); }
        else if (PHT(3) && type == 3) { PHASE_BEGIN; phase_attn_combine(F); }
        else if (PHT(4) && type == 4) { PHASE_BEGIN; DenseSched S; S.init(ws + WS_AUX + AUX_OB, ws + WS_ATT_OUT_T + (size_t)j * D * D * 2, T, D, D, F.G, bx); EpiResid E{(const bf16*)(ws + WS_XB), (bf16*)(ws + WS_Y)};
            pg8::gemm_phase(F.lds, F.tid, D, S, E); }
        else if (PHT(5) && type == 5) { PHASE_BEGIN; DenseSched8 S; S.init(ws + WS_X, ws + WS_RET_IN_T, T, RET_IN, D / 2, F.G, bx); EpiRetIn E{(bf16*)(ws + WS_BIG), RET_IN};
            pg8::gemm_phase(F.lds, F.tid, D / 2, S, E); }
        else if (PHT(6) && type == 6) { PHASE_BEGIN; phase_ret_u(F); }
        else if (PHT(7) && type == 7) { PHASE_BEGIN; phase_ret_scan(F); }
        else if (PHT(8) && type == 8) { PHASE_BEGIN; phase_ret_out(F, p); }
        else if (PHT(9) && type == 9) { PHASE_BEGIN; DenseSched S; S.init(ws + WS_BIG + BIG_YRET, ws + WS_RET_OUT_T, T, D, RET_V, F.G, bx); EpiResid E{(const bf16*)(ws + WS_XB), (bf16*)(ws + WS_Y)};
            pg8::gemm_phase(F.lds, F.tid, RET_V, S, E); }
        else if (PHT(10) && type == 10) { PHASE_BEGIN; phase_s5_scan<false>(F, p); }
        else if (PHT(11) && type == 11) { PHASE_BEGIN; phase_s5_carry(F, p); }
        else if (PHT(12) && type == 12) { PHASE_BEGIN; phase_s5_scan<true>(F, p); }
        else if (PHT(13) && type == 13) { PHASE_BEGIN; DenseSched S; S.init(ws + WS_AUX, ws + WS_GLU_T, T, 2 * D, D, F.G, bx); EpiGluResid E{(const bf16*)(ws + WS_XB), (bf16*)(ws + WS_Y)};
            pg8::gemm_phase(F.lds, F.tid, D, S, E); }
        else if (PHT(14) && type == 14) { PHASE_BEGIN; phase_lnr(F, p, layer, PROBE_DRY14 && true); if (PROBE_DRY14) { if (use_bar) xcd_barrier(bar); phase_lnr(F, p, layer, false); } }
        else if (PHT(15) && type == 15) { PHASE_BEGIN; moe_plan(F, layer);
            MoeSched2<true> S; S.tstart = (const volatile LAS int*)(F.MISC + PLAN_OFF); S.cnts = S.tstart + 72; S.ntiles = __builtin_amdgcn_readfirstlane((int)S.tstart[65]); S.G = F.G; S.c = bx; S.lane = F.lane;
            S.Abase = (const char*)(ws + WS_X); S.Wbase = (const char*)(ws + WS_WMOE); S.lists = (const int*)(ws + WS_LIST);
            EpiMoeUp E{(bf16*)(ws + WS_H)};
            pg8::gemm_phase(F.lds, F.tid, D / 2, S, E); }
        else if (PHT(16) && type == 16) { PHASE_BEGIN; moe_plan(F, layer);
            { MoeSched2<false> S; S.tstart = (const volatile LAS int*)(F.MISC + PLAN_OFF); S.cnts = S.tstart + 72; S.ntiles = __builtin_amdgcn_readfirstlane((int)S.tstart[64]); S.G = F.G; S.c = bx; S.lane = F.lane;
              S.Abase = (const char*)(ws + WS_H); S.Wbase = (const char*)(ws + WS_WMOE); S.lists = (const int*)(ws + WS_LIST);
              EpiStoreFp8 E{(unsigned char*)(ws + WS_BIG), D};
              pg8::gemm_phase(F.lds, F.tid, ED, S, E); }
            { const int sh0 = __builtin_amdgcn_readfirstlane((int)((const volatile LAS int*)(F.MISC + PLAN_OFF))[64]);
              DenseSched S; S.init(ws + WS_H + (size_t)sh0 * 256 * ED * 2, ws + WS_WMOE + (size_t)64 * WMOE_E_BYTES + (size_t)512 * 1024 * 2, T, D, ED, F.G, bx); EpiResid E{(const bf16*)(ws + WS_XB), (bf16*)(ws + WS_Y)};
              pg8::gemm_phase(F.lds, F.tid, ED, S, E); } }
        else if (PHT(17) && type == 17) { PHASE_BEGIN; moe_plan(F, layer); if (PROBE_DRY17) { phase_combine(F, p, layer, true); if (use_bar) xcd_barrier(bar); } phase_combine(F, p, layer); if (layer + 1 < DEPTH) phase_conv_moe(F, p, layer + 1); }
        }
        if (use_bar && ph + 1 < hi) xcd_barrier(bar);
    }
}

#ifndef MK_PER_PHASE
#define MK_PER_PHASE 0
#endif
extern "C" void kernel_launch(void* const* d_in, const int* in_sizes, int n_in, void* d_out, int out_size, void* d_ws, size_t ws_size, hipStream_t stream) {
    static int grid = 0;
    if (grid == 0) {
        if (n_in != 26 || in_sizes[0] != T * D || out_size != T * D || ws_size < WS_END) { fprintf(stderr, "kernel_launch: unexpected shapes / workspace (n_in %d, in0 %d, out %d, ws %zu < %zu)\n", n_in, n_in > 0 ? in_sizes[0] : -1, out_size, ws_size, (size_t)WS_END); grid = -1; return; }
        int dev = 0, cus = 0, per_cu = 0;
        if (hipGetDevice(&dev) != hipSuccess || hipDeviceGetAttribute(&cus, hipDeviceAttributeMultiprocessorCount, dev) != hipSuccess) { grid = -1; return; }
        if (hipFuncSetAttribute((const void*)fwd_kernel, hipFuncAttributeMaxDynamicSharedMemorySize, LDS_BYTES) != hipSuccess) { fprintf(stderr, "kernel_launch: hipFuncSetAttribute failed\n"); grid = -1; return; }
        if (hipOccupancyMaxActiveBlocksPerMultiprocessor(&per_cu, (const void*)fwd_kernel, NTHREADS, LDS_BYTES) != hipSuccess || per_cu < 1) { fprintf(stderr, "kernel_launch: occupancy query says %d blocks per CU\n", per_cu); per_cu = 1; }
        (void)hipGetLastError();
        grid = cus;
    }
    if (grid < 0) return;
    (void)hipMemsetAsync((char*)d_ws + WS_CTL, 0, CTL_ZERO_BYTES, stream);
    Params p{};
    for (int i = 0; i < 26; ++i) p.in[i] = (const float*)d_in[i];
    p.out = (float*)d_out; p.ws = (unsigned char*)d_ws;
#if MK_PER_PHASE
    for (int k = 0; k < NPHASES; ++k) { p.ph_lo = k; p.ph_hi = k + 1; p.use_bar = 0; hipLaunchKernelGGL(fwd_kernel, dim3(grid), dim3(NTHREADS), LDS_BYTES, stream, p); }
#else
    p.ph_lo = 0; p.ph_hi = NPHASES; p.use_bar = 1;
    hipLaunchKernelGGL(fwd_kernel, dim3(grid), dim3(NTHREADS), LDS_BYTES, stream, p);
#endif
}
```

```cpp
#include <hip/hip_runtime.h>
#include <cstdio>
#include <cstdint>

#define LAS __attribute__((address_space(3)))
#define GAS __attribute__((address_space(1)))
typedef unsigned short bf16;
typedef short bf16x8 __attribute__((ext_vector_type(8)));
typedef short bf16x4 __attribute__((ext_vector_type(4)));
typedef float f32x4 __attribute__((ext_vector_type(4)));
typedef float f32x2 __attribute__((ext_vector_type(2)));
typedef unsigned u32x4 __attribute__((ext_vector_type(4)));
typedef unsigned u32x2 __attribute__((ext_vector_type(2)));
typedef GAS unsigned gu32;

constexpr int D = 1024, BATCH = 2, SEQ = 8192, T = BATCH * SEQ, DEPTH = 4;
constexpr int AH = 8, AHD = 128, ATT_IN = 9216;
constexpr int RH = 4, RDK = 256, RDV = 512, RET_IN = 6144, RET_V = 2048, RC = 128, RNC = SEQ / RC;
constexpr int SG = 64, SGC = 16, SP = 64;
constexpr int NE = 64, TOPK = 8, NEG = 8, ED = 256, NSLOT = 9;
constexpr float LN_EPS = 1e-5f;
constexpr float ALPHA = 1.6817928305074292f;
constexpr int NWAVES = 8, NTHREADS = 512;

__device__ __forceinline__ unsigned f2bf(float f) { unsigned u = __builtin_bit_cast(unsigned, f); return (u + 0x7fffu + ((u >> 16) & 1u)) >> 16; }
__device__ __forceinline__ unsigned pk2(float lo, float hi) { unsigned r; asm("s_nop 1\n\tv_cvt_pk_bf16_f32 %0, %1, %2" : "=v"(r) : "v"(lo), "v"(hi)); return r; }
__device__ __forceinline__ unsigned pk2sw(float lo, float hi) { return f2bf(lo) | (f2bf(hi) << 16); }
__device__ __forceinline__ unsigned pk2hw(float lo, float hi) { unsigned r; asm volatile("v_cvt_pk_bf16_f32 %0, %1, %2" : "=v"(r) : "v"(lo), "v"(hi)); return r; }
__device__ __forceinline__ float bf2f(unsigned b) { return __builtin_bit_cast(float, b << 16); }
__device__ __forceinline__ float bflo(unsigned w) { return __builtin_bit_cast(float, w << 16); }
__device__ __forceinline__ float bfhi(unsigned w) { return __builtin_bit_cast(float, w & 0xffff0000u); }
__device__ __forceinline__ float shx(float v, int m, int lane) { return __builtin_bit_cast(float, __builtin_amdgcn_ds_bpermute((lane ^ m) << 2, __builtin_bit_cast(int, v))); }
__device__ __forceinline__ int shx_i(int v, int m, int lane) { return __builtin_amdgcn_ds_bpermute((lane ^ m) << 2, v); }
__device__ __forceinline__ float rdl(float v, int src) { return __builtin_bit_cast(float, __builtin_amdgcn_readlane(__builtin_bit_cast(int, v), src)); }
template <int CTRL, int RM = 0xf, int BM = 0xf> __device__ __forceinline__ float dpp0(float v) { return __builtin_bit_cast(float, __builtin_amdgcn_update_dpp(0, __builtin_bit_cast(int, v), CTRL, RM, BM, true)); }
template <int CTRL, int RM = 0xf, int BM = 0xf> __device__ __forceinline__ float dppo(float old, float v) { return __builtin_bit_cast(float, __builtin_amdgcn_update_dpp(__builtin_bit_cast(int, old), __builtin_bit_cast(int, v), CTRL, RM, BM, false)); }
__device__ __forceinline__ float wave_sum(float v, int lane) {
    (void)lane;
    v += dpp0<0x111>(v); v += dpp0<0x112>(v); v += dpp0<0x114>(v); v += dpp0<0x118>(v);
    v += dpp0<0x142, 0xa>(v);
    v += dpp0<0x143, 0xc>(v);
    return rdl(v, 63);
}
__device__ __forceinline__ float max8(float v) {
    v = fmaxf(v, dppo<0xb1>(v, v)); v = fmaxf(v, dppo<0x4e>(v, v)); v = fmaxf(v, dppo<0x141>(v, v)); return v;
}
#define LDS_WAIT() asm volatile("s_waitcnt lgkmcnt(0)" ::: "memory")
#define VM_WAIT() asm volatile("s_waitcnt vmcnt(0)" ::: "memory")
__device__ __forceinline__ const char* rfl_ptr(const char* p) {
    unsigned long long v = (unsigned long long)p; unsigned lo = __builtin_amdgcn_readfirstlane((unsigned)v), hi = __builtin_amdgcn_readfirstlane((unsigned)(v >> 32));
    return (const char*)(((unsigned long long)hi << 32) | lo);
}
__device__ __forceinline__ bf16x8 row_frag(const LAS bf16* base, int ld, int row0, int col0, int lane) {
    return *(const LAS bf16x8*)(base + (row0 + (lane & 15)) * ld + col0 + 8 * (lane >> 4));
}
__device__ __forceinline__ bf16x4 tr4(const LAS bf16* addr) { return __builtin_amdgcn_ds_read_tr16_b64_v4i16((LAS bf16x4*)addr); }
__device__ __forceinline__ bf16x8 cat8(bf16x4 a, bf16x4 b) { bf16x8 r; r[0] = a[0]; r[1] = a[1]; r[2] = a[2]; r[3] = a[3]; r[4] = b[0]; r[5] = b[1]; r[6] = b[2]; r[7] = b[3]; return r; }
#define MFMA16(a, b, c) __builtin_amdgcn_mfma_f32_16x16x32_bf16((a), (b), (c), 0, 0, 0)
__device__ __forceinline__ bf16x8 pack8(f32x4 a, f32x4 b) {
    u32x4 w; w.x = pk2(a[0], a[1]); w.y = pk2(a[2], a[3]); w.z = pk2(b[0], b[1]); w.w = pk2(b[2], b[3]); return __builtin_bit_cast(bf16x8, w);
}

namespace pg8 {
typedef int v4i_t __attribute__((ext_vector_type(4)));
typedef int v8i_t __attribute__((ext_vector_type(8)));
constexpr int BM = 256, BK = 64, HALF = 128, HTB = HALF * BK * 2, STAGE_BYTES = 8 * HTB;
__device__ __forceinline__ int lds_byte(int r, int c) { const int st = (r >> 4) * 2 + (c >> 5), rr = r & 15, cc = c & 31, ob = rr * 64 + cc * 2; return st * 1024 + (ob ^ (((ob >> 9) & 1) << 5)); }
__device__ __forceinline__ void stage_rc(int b, int& R, int& C) { const int st = b / 1024, sb = b % 1024, swz = sb ^ (((sb >> 9) & 1) << 5); R = (st >> 1) * 16 + swz / 64; C = (st & 1) * 32 + (swz % 64) / 2; }
__device__ __forceinline__ int perm32(int rho) { const int n = rho >> 4, i = rho & 15; return 8 * (i >> 2) + 4 * n + (i & 3); }

struct UnitG {
    const char* A;
    const char* B;
    const int* gidx;
    int gcnt, gshift;
    int row0, col0;
    int aux;
};

__device__ __forceinline__ void uniformize(UnitG& u) { u.A = rfl_ptr(u.A); u.B = rfl_ptr(u.B); u.gidx = (const int*)rfl_ptr((const char*)u.gidx); u.gcnt = __builtin_amdgcn_readfirstlane(u.gcnt); u.gshift = __builtin_amdgcn_readfirstlane(u.gshift);
    u.row0 = __builtin_amdgcn_readfirstlane(u.row0); u.col0 = __builtin_amdgcn_readfirstlane(u.col0); u.aux = __builtin_amdgcn_readfirstlane(u.aux); }
template <class Epi, class Sched>
__device__ __forceinline__ void gemm_phase(LAS unsigned char* lds, const int tid, const int K, const Sched& S, const Epi& E) {
    constexpr bool F8 = Sched::FP8;
    constexpr bool GATHER = Sched::GATHER;
    const int wid = __builtin_amdgcn_readfirstlane(tid >> 6), lane = tid & 63, wr = wid >> 2, wc = wid & 3, fr = lane & 15, fq = lane >> 4;
    const int nt = K / BK;
    constexpr bool P16 = Epi::PERM16;
    unsigned voffB[2], voffB1[2], vA[2][2];
#pragma unroll
    for (int i = 0; i < 2; ++i) { int R, C; stage_rc(tid * 16 + i * 8192, R, C); const int Rb = Epi::PERM ? ((R & ~31) + perm32(R & 31)) : R; voffB[i] = (unsigned)(Rb * K + C) * 2u; voffB1[i] = voffB[i]; vA[0][i] = (unsigned)(R * K + C) * 2u; vA[1][i] = vA[0][i];
        if constexpr (P16) { const int x = R & 31, src = 64 * (R >> 5) + 16 * ((x >> 2) & 3) + 4 * (x >> 4) + (x & 3); voffB[i] = (unsigned)(src * K + C) * 2u; voffB1[i] = (unsigned)((src + 8) * K + C) * 2u; } }
    const size_t kstep = (size_t)(BK * 2);
    const size_t hstep = (size_t)HALF * K * 2;
    const size_t hstepB = P16 ? 0 : hstep;
    const size_t hstepA = GATHER ? 0 : hstep;
    const unsigned ldsw = (unsigned)wid * 1024u;
    const int aoff = F8 ? lds_byte(wr * 64 + fr, fq * 16) : lds_byte(wr * 64 + fr, fq * 8), boff = F8 ? lds_byte(wc * 32 + fr, fq * 16) : lds_byte(wc * 32 + fr, fq * 8);
    LAS u32x4* park = (LAS u32x4*)(lds + STAGE_BYTES) + tid;
#define PG8_SA(b, h) (((b) * 2 + (h)) * HTB)
#define PG8_SB(b, h) ((4 + (b) * 2 + (h)) * HTB)
#define PG8_STAGE(bufoff, gbase, voff) do { _Pragma("unroll") for (int _i = 0; _i < 2; ++_i) { asm volatile("" : "+v"((voff)[_i]));   \
        __builtin_amdgcn_global_load_lds((const unsigned*)((const char*)(gbase) + (voff)[_i]), (LAS unsigned*)(lds + (bufoff) + ldsw + _i * 8192), 16, 0, 0); } } while (0)
    constexpr int FKS = F8 ? 16 : 1024;
#define PG8_LD2(p_) __builtin_shufflevector(*(const LAS v4i_t*)(p_), *(const LAS v4i_t*)((p_) + FKS), 0, 1, 2, 3, 4, 5, 6, 7)
#define PG8_LDA(dst, b, h) do { _Pragma("unroll") for (int m = 0; m < 4; ++m) dst[m] = PG8_LD2(lds + PG8_SA(b, h) + aoff + m * 2048); } while (0)
#define PG8_LDB(dst, b, h) do { _Pragma("unroll") for (int n = 0; n < 2; ++n) dst[n] = PG8_LD2(lds + PG8_SB(b, h) + boff + n * 2048); } while (0)
#define PG8_LO(v) __builtin_bit_cast(bf16x8, __builtin_shufflevector((v), (v), 0, 1, 2, 3))
#define PG8_HI(v) __builtin_bit_cast(bf16x8, __builtin_shufflevector((v), (v), 4, 5, 6, 7))
#define PG8_MMA(ai, bj, At, Bt) do { __builtin_amdgcn_s_setprio(1); _Pragma("unroll") for (int m = 0; m < 4; ++m) _Pragma("unroll") for (int n = 0; n < 2; ++n) { \
        if constexpr (F8) { acc[ai][bj][m][n] = __builtin_amdgcn_mfma_scale_f32_16x16x128_f8f6f4(Bt[n], At[m], acc[ai][bj][m][n], 0, 0, 0, 0x7F7F7F7F, 0, 0x7F7F7F7F); } \
        else { acc[ai][bj][m][n] = __builtin_amdgcn_mfma_f32_16x16x32_bf16(PG8_LO(Bt[n]), PG8_LO(At[m]), acc[ai][bj][m][n], 0, 0, 0); \
               acc[ai][bj][m][n] = __builtin_amdgcn_mfma_f32_16x16x32_bf16(PG8_HI(Bt[n]), PG8_HI(At[m]), acc[ai][bj][m][n], 0, 0, 0); } } __builtin_amdgcn_s_setprio(0); } while (0)
#define PG8_WAIT_V(n) asm volatile("s_waitcnt vmcnt(" #n ")" ::: "memory")
#define PG8_WAIT_L(n) asm volatile("s_waitcnt lgkmcnt(" #n ")" ::: "memory")
#define PG8_BAR __builtin_amdgcn_s_barrier()
#define PG8_SCHED __builtin_amdgcn_sched_barrier(0)
#define PG8_VOFF(u, v00, v01, v10, v11) do { int _R0, _C0, _R1, _C1; stage_rc(tid * 16, _R0, _C0); stage_rc(tid * 16 + 8192, _R1, _C1); int _r00 = _R0, _r01 = _R1, _r10 = HALF + _R0, _r11 = HALF + _R1; \
        if ((u).gidx) { const int _a = _r00 < (u).gcnt ? ((const GAS int*)(u).gidx)[_r00] >> (u).gshift : 0, _b = _r01 < (u).gcnt ? ((const GAS int*)(u).gidx)[_r01] >> (u).gshift : 0, _c = _r10 < (u).gcnt ? ((const GAS int*)(u).gidx)[_r10] >> (u).gshift : 0, _d = _r11 < (u).gcnt ? ((const GAS int*)(u).gidx)[_r11] >> (u).gshift : 0; \
            _r00 = _a; _r01 = _b; _r10 = _c; _r11 = _d; } \
        v00 = (unsigned)(_r00 * K + _C0) * 2u; v01 = (unsigned)(_r01 * K + _C1) * 2u; v10 = (unsigned)(_r10 * K + _C0) * 2u; v11 = (unsigned)(_r11 * K + _C1) * 2u; } while (0)
    UnitG cur, nxt; int ui = 0;
    if (!S.next(0, cur)) return;
    if constexpr (Sched::UNIFORMIZE) uniformize(cur);
    f32x4 acc[2][2][4][2];
#pragma unroll
    for (int a = 0; a < 2; ++a)
#pragma unroll
        for (int b = 0; b < 2; ++b)
#pragma unroll
            for (int m = 0; m < 4; ++m)
#pragma unroll
                for (int n = 0; n < 2; ++n) acc[a][b][m][n] = (f32x4){0.f, 0.f, 0.f, 0.f};
    v8i_t At[4], B0[2], B1[2];
    if constexpr (GATHER) PG8_VOFF(cur, vA[0][0], vA[0][1], vA[1][0], vA[1][1]);
    const char* cA = cur.A; const char* cB = cur.B;
    PG8_STAGE(PG8_SB(0, 0), cB, voffB); PG8_STAGE(PG8_SB(0, 1), cB + hstepB, voffB1); PG8_STAGE(PG8_SA(0, 0), cA, vA[0]); PG8_STAGE(PG8_SA(0, 1), cA + hstepA, vA[1]);
    if (wr == 1) PG8_BAR;
    PG8_WAIT_V(2); PG8_BAR;
    PG8_STAGE(PG8_SB(1, 0), cB + kstep, voffB); PG8_STAGE(PG8_SA(1, 0), cA + kstep, vA[0]); PG8_STAGE(PG8_SB(1, 1), cB + hstepB + kstep, voffB1);
    PG8_WAIT_V(6); PG8_BAR;
    for (;;) {
        const bool has_next = S.next(ui + 1, nxt);
        if constexpr (Sched::UNIFORMIZE) { if (has_next) uniformize(nxt); }
        const char* nA = cA; const char* nB = cB;
        if (has_next) { nA = nxt.A; nB = nxt.B; }
        if constexpr (GATHER) { u32x4 pv; pv.x = vA[0][0]; pv.y = vA[0][1]; pv.z = vA[1][0]; pv.w = vA[1][1];
            if (has_next) PG8_VOFF(nxt, pv.x, pv.y, pv.z, pv.w);
            *park = pv; }
#pragma unroll 1
        for (int t = 0; t < nt; t += 2) {
            const bool last = (t == nt - 2);
            const char* a1 = cA + (size_t)(t + 1) * kstep;
            const char* a2 = last ? nA : cA + (size_t)(t + 2) * kstep; const char* b2 = last ? nB : cB + (size_t)(t + 2) * kstep;
            const char* a3 = a2 + kstep; const char* b3 = b2 + kstep;
            PG8_LDB(B0, 0, 0); PG8_LDB(B1, 0, 1); PG8_SCHED; PG8_LDA(At, 0, 0); PG8_STAGE(PG8_SA(1, 1), a1 + hstepA, vA[1]);
            PG8_WAIT_V(8); PG8_WAIT_L(0); PG8_BAR; PG8_MMA(0, 0, At, B0); PG8_MMA(0, 1, At, B1); PG8_BAR; PG8_SCHED;
            if constexpr (GATHER) { if (last) { const u32x4 pv = *park; vA[0][0] = pv.x; vA[0][1] = pv.y; vA[1][0] = pv.z; vA[1][1] = pv.w; } }
            PG8_LDA(At, 0, 1); PG8_STAGE(PG8_SB(0, 0), b2, voffB); PG8_STAGE(PG8_SB(0, 1), b2 + hstepB, voffB1); PG8_STAGE(PG8_SA(0, 0), a2, vA[0]);
            PG8_WAIT_V(8); PG8_WAIT_L(0); PG8_BAR; PG8_MMA(1, 0, At, B0); PG8_MMA(1, 1, At, B1); PG8_BAR; PG8_SCHED;
            PG8_LDB(B0, 1, 0); PG8_LDB(B1, 1, 1); PG8_SCHED; PG8_LDA(At, 1, 0); PG8_STAGE(PG8_SA(0, 1), a2 + hstepA, vA[1]);
            PG8_WAIT_V(8); PG8_WAIT_L(0); PG8_BAR; PG8_MMA(0, 0, At, B0); PG8_MMA(0, 1, At, B1); PG8_BAR; PG8_SCHED;
            PG8_LDA(At, 1, 1); PG8_STAGE(PG8_SB(1, 0), b3, voffB); PG8_STAGE(PG8_SB(1, 1), b3 + hstepB, voffB1); PG8_STAGE(PG8_SA(1, 0), a3, vA[0]);
            PG8_WAIT_V(8); PG8_WAIT_L(0); PG8_BAR; PG8_MMA(1, 0, At, B0); PG8_MMA(1, 1, At, B1); PG8_BAR; PG8_SCHED;
        }
        if (wr == 0) PG8_BAR;
        E(acc, cur, wr, wc, fr, fq);
        if (!has_next) break;
#pragma unroll
        for (int a = 0; a < 2; ++a)
#pragma unroll
            for (int b = 0; b < 2; ++b)
#pragma unroll
                for (int m = 0; m < 4; ++m)
#pragma unroll
                    for (int n = 0; n < 2; ++n) acc[a][b][m][n] = (f32x4){0.f, 0.f, 0.f, 0.f};
        cur = nxt; cA = nA; cB = nB; ++ui;
        if (wr == 1) PG8_BAR;
    }
    PG8_WAIT_V(0);
    PG8_BAR;
#undef PG8_SA
#undef PG8_SB
#undef PG8_STAGE
#undef PG8_LDA
#undef PG8_LDB
#undef PG8_LD2
#undef PG8_LO
#undef PG8_HI
#undef PG8_MMA
#undef PG8_WAIT_V
#undef PG8_WAIT_L
#undef PG8_BAR
#undef PG8_SCHED
#undef PG8_VOFF
}
}

constexpr size_t MiB = 1u << 20;
constexpr size_t WS_CTL = 0, CTL_ZERO_BYTES = 1 * MiB;
constexpr size_t WS_ATT_IN_T = 1 * MiB;
constexpr size_t WS_ATT_OUT_T = WS_ATT_IN_T + 36 * MiB;
constexpr size_t WS_RET_IN_T = WS_ATT_OUT_T + 4 * MiB;
constexpr size_t WS_RET_OUT_T = WS_RET_IN_T + 12 * MiB;
constexpr size_t WS_GLU_T = WS_RET_OUT_T + 4 * MiB;
constexpr size_t WS_RT_HI = WS_GLU_T + 4 * MiB;
constexpr size_t WS_RT_LO = WS_RT_HI + 512 * 1024;
constexpr size_t WS_WMOE = WS_RT_HI + 1 * MiB;
constexpr size_t WMOE_E_BYTES = (size_t)(512 * 1024 + 1024 * 256) * 2;
constexpr size_t WS_X = WS_WMOE + 98 * MiB;
constexpr size_t WS_Y = WS_X + 64 * MiB;
constexpr size_t WS_XB = WS_Y + 64 * MiB;
constexpr size_t WS_BIG = WS_XB + 32 * MiB;
constexpr size_t WS_AUX = WS_BIG + 288 * MiB;
constexpr size_t WS_H = WS_AUX + 160 * MiB;
constexpr size_t WS_LIST = WS_H + 80 * MiB;
constexpr size_t WS_TRASH = WS_LIST + 8 * MiB;
constexpr size_t WS_END = WS_TRASH + 1 * MiB;
static_assert(WS_END <= 1024 * MiB, "workspace map");
constexpr int CW_BAR = 4096;
constexpr int CW_CNT = 16384;
constexpr int CW_CHK = 65536;
constexpr int HROWS = 163840;

#define XB_TMO      128
#define XB_XCNT(j)  (256  + 64 * (j))
#define XB_XSUB(j)  (1280 + 64 * (j))
#define XB_XGEN(j)  (2304 + 64 * (j))
#define XB_TOP      3328
#define XB_TOPGEN   3392
#define XCD_BAR_WORDS 3456
#define XB_SPIN_CAP (1u << 20)
__device__ __forceinline__ unsigned xb_ld(unsigned* p)              { return __hip_atomic_load(p, __ATOMIC_RELAXED, __HIP_MEMORY_SCOPE_AGENT); }
__device__ __forceinline__ unsigned xb_add(unsigned* p, unsigned v) { return __hip_atomic_fetch_add(p, v, __ATOMIC_RELAXED, __HIP_MEMORY_SCOPE_AGENT); }
__device__ __forceinline__ unsigned xb_xcc_id() { return (unsigned)__builtin_amdgcn_s_getreg((3 << 11) | 20) & 0xFu; }
#define XB_SPIN(cond, bar) do { unsigned _sp = 0; while (cond) { __builtin_amdgcn_s_sleep(1); \
    if ((++_sp & 255u) == 0u) { if (xb_ld(&(bar)[XB_TMO])) break; if (_sp > XB_SPIN_CAP) { atomicAdd(&(bar)[XB_TMO], 1u); break; } } } } while (0)
struct XcdBarrier { unsigned* bar; unsigned x; volatile LAS unsigned* st; };
__device__ __forceinline__ XcdBarrier xcd_barrier_post(unsigned* bar, volatile LAS unsigned* st) {
    XcdBarrier b; b.bar = bar; b.x = xb_xcc_id(); b.st = st;
    if (threadIdx.x == 0) (void)xb_add(&bar[XB_XCNT(b.x)], 1u);
    return b;
}
__device__ __forceinline__ void xcd_barrier_complete(unsigned* bar, unsigned x, unsigned& nloc, unsigned& nx) {
    const unsigned G = gridDim.x * gridDim.y * gridDim.z;
    unsigned sum, cnt, mine, sp = 0u;
    for (;;) {
        sum = 0u; cnt = 0u; mine = 0u;
#pragma unroll
        for (unsigned j = 0; j < 16; ++j) { const unsigned c = xb_ld(&bar[XB_XCNT(j)]); sum += c; cnt += (c > 0u) ? 1u : 0u; mine = (j == x) ? c : mine; }
        if (sum == G) break;
        __builtin_amdgcn_s_sleep(1);
        if ((++sp & 255u) == 0u) { if (xb_ld(&bar[XB_TMO])) break; if (sp > XB_SPIN_CAP) { atomicAdd(&bar[XB_TMO], 1u); break; } }
    }
    nloc = mine > 0u ? mine : 1u; nx = cnt > 0u ? cnt : 1u;
}
__device__ __forceinline__ void xcd_barrier(const XcdBarrier& b) {
    asm volatile("s_waitcnt vmcnt(0)" ::: "memory");
    __syncthreads();
    if (threadIdx.x == 0) {
        unsigned* bar = b.bar;
        __builtin_amdgcn_s_waitcnt(0);
        unsigned nloc = b.st[0], nx = b.st[1];
        if (nloc == 0u) { xcd_barrier_complete(bar, b.x, nloc, nx); b.st[0] = nloc; b.st[1] = nx; }
        const unsigned old = xb_add(&bar[XB_XSUB(b.x)], 1u);
        const unsigned gen = old / nloc;
        if (old + 1u == (gen + 1u) * nloc) {
            __builtin_amdgcn_fence(__ATOMIC_RELEASE, "agent");
            asm volatile("s_waitcnt vmcnt(0)" ::: "memory");
            const unsigned og = xb_add(&bar[XB_TOP], 1u);
            const unsigned tg = og / nx;
            if (og + 1u == (tg + 1u) * nx) xb_add(&bar[XB_TOPGEN], 1u);
            else XB_SPIN(xb_ld(&bar[XB_TOPGEN]) == tg, bar);
            __builtin_amdgcn_fence(__ATOMIC_ACQUIRE, "agent");
            xb_add(&bar[XB_XGEN(b.x)], 1u);
            asm volatile("s_waitcnt vmcnt(0)" ::: "memory");
        } else {
            XB_SPIN(xb_ld(&bar[XB_XGEN(b.x)]) == gen, bar);
            __builtin_amdgcn_fence(__ATOMIC_ACQUIRE, "agent");
            asm volatile("s_waitcnt vmcnt(0)" ::: "memory");
        }
    }
    __syncthreads();
}

constexpr int RING_BYTES = 139264;
constexpr int MISC_OFF = RING_BYTES;
constexpr int LDS_BYTES = 147456;
struct Params {
    const float* in[26]; float* out; unsigned char* ws; int ph_lo, ph_hi; int use_bar, pad;
};
typedef const __attribute__((address_space(4))) Params* KP;
__device__ __forceinline__ const float* gin(KP p, int i) { return (const float*)(const GAS float*)p->in[i]; }
__device__ __forceinline__ float* gout(KP p) { return (float*)(GAS float*)p->out; }
struct Frame {
    LAS unsigned char* lds; volatile LAS unsigned* MISC;
    int tid, lane, wave, vcu, G;
    unsigned char* ws;
};

template <bool F8_ = false> struct DenseSchedT {
    static constexpr bool GATHER = false, UNIFORMIZE = false, FP8 = F8_;
    const char* A; const char* Bt; int K, nM, nN, nwg, G, c;
    __device__ __forceinline__ void init(const void* A_, const void* Bt_, int M, int N, int K_, int G_, int c_) { A = (const char*)A_; Bt = (const char*)Bt_; K = K_; nM = M / 256; nN = N / 256; nwg = nM * nN; G = G_; c = c_; }
    __device__ __forceinline__ bool next(int i, pg8::UnitG& u) const {
        const long L = (long)i * G + c; if (L >= nwg) return false;
        int wgid = (int)L; { const int q = nwg / 8, r = nwg % 8, xcd = wgid % 8, off = wgid / 8; wgid = (xcd < r ? xcd * (q + 1) : r * (q + 1) + (xcd - r) * q) + off; }
        const int nig = 8 * nN, gid = wgid / nig, fm = gid * 8, gsz = (nM - fm) < 8 ? (nM - fm) : 8;
        const int pm = fm + ((wgid % nig) % gsz), pn = (wgid % nig) / gsz;
        u.A = A + (size_t)pm * 256 * K * 2; u.B = Bt + (size_t)pn * 256 * K * 2; u.gidx = nullptr; u.gcnt = 0; u.gshift = 0; u.row0 = pm * 256; u.col0 = pn * 256; u.aux = 0; return true;
    }
};
typedef DenseSchedT<false> DenseSched; typedef DenseSchedT<true> DenseSched8;
__device__ __forceinline__ u32x4 pack_bf16x8(const f32x4& v0, const f32x4& v1) { u32x4 w; w.x = pk2hw(v0[0], v0[1]); w.y = pk2hw(v0[2], v0[3]); w.z = pk2hw(v1[0], v1[1]); w.w = pk2hw(v1[2], v1[3]); return w; }

constexpr float WUP_SCALE = 32.0f, WUP_INV = 1.0f / 32.0f;
struct EpiStoreBf16 {
    static constexpr bool PERM = true, PERM16 = false;
    bf16* O; int ldc; float osc, qsc;
    __device__ __forceinline__ void operator()(const f32x4 (&acc)[2][2][4][2], const pg8::UnitG& u, int wr, int wc, int fr, int fq) const {
        const float sc = ((u.col0 % 3072) < 1024) ? osc * qsc : osc;
#pragma unroll
        for (int ai = 0; ai < 2; ++ai)
#pragma unroll
            for (int m = 0; m < 4; ++m) { bf16* rowp = O + (size_t)(u.row0 + ai * 128 + wr * 64 + m * 16 + fr) * ldc + u.col0 + wc * 32 + 8 * fq;
#pragma unroll
                for (int bj = 0; bj < 2; ++bj) *(u32x4*)(rowp + bj * 128) = pack_bf16x8(acc[ai][bj][m][0] * sc, acc[ai][bj][m][1] * sc); }
    }
};
constexpr float YEXP_SCALE = 32.0f, YEXP_INV = 1.0f / 32.0f;
struct EpiStoreFp8 {
    static constexpr bool PERM = false, PERM16 = true;
    unsigned char* O; int ldc;
    __device__ __forceinline__ void operator()(const f32x4 (&acc)[2][2][4][2], const pg8::UnitG& u, int wr, int wc, int fr, int fq) const {
#pragma unroll
        for (int ai = 0; ai < 2; ++ai)
#pragma unroll
            for (int m = 0; m < 4; ++m) { unsigned char* rowp = O + (size_t)(u.row0 + ai * 128 + wr * 64 + m * 16 + fr) * ldc + u.col0 + wc * 64 + 16 * fq;
                u32x4 w;
#pragma unroll
                for (int q = 0; q < 4; ++q) { f32x4 v = acc[ai][q >> 1][m][q & 1] * YEXP_SCALE;
#pragma unroll
                    for (int j = 0; j < 4; ++j) v[j] = fminf(fmaxf(v[j], -448.0f), 448.0f);
                    int d = 0; d = __builtin_amdgcn_cvt_pk_fp8_f32(v[0], v[1], d, false); d = __builtin_amdgcn_cvt_pk_fp8_f32(v[2], v[3], d, true); w[q] = (unsigned)d; }
                *(u32x4*)rowp = w; }
    }
};
struct EpiRetIn {
    static constexpr bool PERM = true, PERM16 = false;
    bf16* O; int ldc;
    __device__ __forceinline__ void operator()(const f32x4 (&acc)[2][2][4][2], const pg8::UnitG& u, int wr, int wc, int fr, int fq) const {
        float l2g = 0.f;
        float cs = WUP_INV;
        if (u.col0 < 2048) { const int h = (u.col0 & 1023) >> 8; const float g = 1.0f - exp2f(-5.0f - (float)h); l2g = log2f(g); if (u.col0 >= 1024) { l2g = -l2g; cs *= 0.0625f; } }
#pragma unroll
        for (int ai = 0; ai < 2; ++ai)
#pragma unroll
            for (int m = 0; m < 4; ++m) { const int row = u.row0 + ai * 128 + wr * 64 + m * 16 + fr; const float sc = exp2f(l2g * (float)(row & 127)) * cs;
                bf16* rowp = O + (size_t)row * ldc + u.col0 + wc * 32 + 8 * fq;
#pragma unroll
                for (int bj = 0; bj < 2; ++bj) *(u32x4*)(rowp + bj * 128) = pack_bf16x8(acc[ai][bj][m][0] * sc, acc[ai][bj][m][1] * sc); }
    }
};
__device__ __forceinline__ void unpack_bf16x8(const u32x4& w, f32x4& a, f32x4& b) { a[0] = bflo(w.x); a[1] = bfhi(w.x); a[2] = bflo(w.y); a[3] = bfhi(w.y); b[0] = bflo(w.z); b[1] = bfhi(w.z); b[2] = bflo(w.w); b[3] = bfhi(w.w); }
struct EpiResid {
    static constexpr bool PERM = true, PERM16 = false;
    const bf16* X; bf16* Y;
    __device__ __forceinline__ void operator()(const f32x4 (&acc)[2][2][4][2], const pg8::UnitG& u, int wr, int wc, int fr, int fq) const {
#pragma unroll
        for (int ai = 0; ai < 2; ++ai)
#pragma unroll
            for (int m = 0; m < 4; ++m) { const size_t off = (size_t)(u.row0 + ai * 128 + wr * 64 + m * 16 + fr) * D + u.col0 + wc * 32 + 8 * fq;
#pragma unroll
                for (int bj = 0; bj < 2; ++bj) { const u32x4 xw = *(const u32x4*)(X + off + bj * 128); f32x4 x0, x1; unpack_bf16x8(xw, x0, x1);
                    *(u32x4*)(Y + off + bj * 128) = pack_bf16x8(x0 * ALPHA + acc[ai][bj][m][0], x1 * ALPHA + acc[ai][bj][m][1]); }
                if (m == 3) asm volatile("" ::: "memory"); }
    }
};
struct EpiGluResid {
    static constexpr bool PERM = true, PERM16 = false;
    const bf16* X; bf16* Y;
    __device__ __forceinline__ void operator()(const f32x4 (&acc)[2][2][4][2], const pg8::UnitG& u, int wr, int wc, int fr, int fq) const {
#pragma unroll
        for (int ai = 0; ai < 2; ++ai)
#pragma unroll
            for (int m = 0; m < 4; ++m) { const size_t off = (size_t)(u.row0 + ai * 128 + wr * 64 + m * 16 + fr) * D + (u.col0 >> 1) + wc * 32 + 8 * fq;
                const u32x4 xw = *(const u32x4*)(X + off); f32x4 x0, x1; unpack_bf16x8(xw, x0, x1); f32x4 o0, o1;
#pragma unroll
                for (int j = 0; j < 4; ++j) { o0[j] = x0[j] * ALPHA + acc[ai][0][m][0][j] / (1.0f + __expf(-acc[ai][1][m][0][j])); o1[j] = x1[j] * ALPHA + acc[ai][0][m][1][j] / (1.0f + __expf(-acc[ai][1][m][1][j])); }
                *(u32x4*)(Y + off) = pack_bf16x8(o0, o1);
                if (m == 3) asm volatile("" ::: "memory"); }
    }
};
struct EpiMoeUp {
    static constexpr bool PERM = true, PERM16 = false;
    bf16* H;
    __device__ __forceinline__ void operator()(const f32x4 (&acc)[2][2][4][2], const pg8::UnitG& u, int wr, int wc, int fr, int fq) const {
#pragma unroll
        for (int ai = 0; ai < 2; ++ai)
#pragma unroll
            for (int m = 0; m < 4; ++m) { bf16* rowp = H + (size_t)(u.row0 + ai * 128 + wr * 64 + m * 16 + fr) * ED + u.col0 + wc * 32 + 8 * fq; f32x4 o[2];
#pragma unroll
                for (int n = 0; n < 2; ++n)
#pragma unroll
                    for (int j = 0; j < 4; ++j) { const float g = acc[ai][0][m][n][j] * WUP_INV, up = acc[ai][1][m][n][j] * WUP_INV; o[n][j] = g / (1.0f + __expf(-g)) * up; }
                *(u32x4*)rowp = pack_bf16x8(o[0], o[1]); }
    }
};

__device__ __forceinline__ unsigned pk4_fp8(float a, float b, float c, float d) {
    a = fminf(fmaxf(a, -448.0f), 448.0f); b = fminf(fmaxf(b, -448.0f), 448.0f); c = fminf(fmaxf(c, -448.0f), 448.0f); d = fminf(fmaxf(d, -448.0f), 448.0f);
    int w = 0; w = __builtin_amdgcn_cvt_pk_fp8_f32(a, b, w, false); w = __builtin_amdgcn_cvt_pk_fp8_f32(c, d, w, true); return (unsigned)w; }
template <bool HILO>
__device__ __forceinline__ void conv_item(const float* W, int ldw, bf16* WT, bf16* WTlo, int ldk, int k0, int n0, int drow0, float scale, LAS float* scr, int lane) {
#pragma unroll 8
    for (int i = 0; i < 32; ++i) { const int kk = 2 * i + (lane >> 5); scr[kk * 33 + (lane & 31)] = W[(size_t)(k0 + kk) * ldw + n0 + (lane & 31)] * scale; }
    LDS_WAIT(); asm volatile("" ::: "memory");
    const int c = lane & 7;
#pragma unroll
    for (int j = 0; j < 4; ++j) { const int n = (lane >> 3) + 8 * j; const LAS float* s = scr + (8 * c) * 33 + n;
        float v[8];
#pragma unroll
        for (int q = 0; q < 8; ++q) v[q] = s[q * 33];
        u32x4 o; o.x = pk2(v[0], v[1]); o.y = pk2(v[2], v[3]); o.z = pk2(v[4], v[5]); o.w = pk2(v[6], v[7]);
        *(u32x4*)(WT + (size_t)(drow0 + n) * ldk + k0 + 8 * c) = o;
        if (HILO) { float r[8];
#pragma unroll
            for (int q = 0; q < 8; ++q) r[q] = v[q] - bf2f(f2bf(v[q]));
            u32x4 o2; o2.x = pk2(r[0], r[1]); o2.y = pk2(r[2], r[3]); o2.z = pk2(r[4], r[5]); o2.w = pk2(r[6], r[7]);
            *(u32x4*)(WTlo + (size_t)(drow0 + n) * ldk + k0 + 8 * c) = o2; } }
    LDS_WAIT(); asm volatile("" ::: "memory");
}
__device__ __forceinline__ void conv_item8(const float* W, int ldw, unsigned char* WT, int ldk, int k0, int n0, int drow0, float scale, LAS float* scr, int lane) {
#pragma unroll 8
    for (int i = 0; i < 32; ++i) { const int kk = 2 * i + (lane >> 5); scr[kk * 33 + (lane & 31)] = W[(size_t)(k0 + kk) * ldw + n0 + (lane & 31)] * scale; }
    LDS_WAIT(); asm volatile("" ::: "memory");
    const int c = lane & 7;
#pragma unroll
    for (int j = 0; j < 4; ++j) { const int n = (lane >> 3) + 8 * j; const LAS float* s = scr + (8 * c) * 33 + n;
        float v[8];
#pragma unroll
        for (int q = 0; q < 8; ++q) v[q] = s[q * 33];
        u32x2 o; o.x = pk4_fp8(v[0], v[1], v[2], v[3]); o.y = pk4_fp8(v[4], v[5], v[6], v[7]);
        *(u32x2*)(WT + (size_t)(drow0 + n) * ldk + k0 + 8 * c) = o; }
    LDS_WAIT(); asm volatile("" ::: "memory");
}
__device__ __forceinline__ void phase_conv_mixers(const Frame& F, KP p) {
    LAS float* scr = (LAS float*)(F.lds + F.wave * 16384);
    const int gw = F.vcu * NWAVES + F.wave, NGW = F.G * NWAVES;
    constexpr int I_AIN = 16 * 288, I_AOUT = 16 * 32, I_RIN = 16 * 192, I_ROUT = 32 * 32, I_GLU = 16 * 64, I_RT = 16 * 2;
    constexpr int NITEMS = 2 * I_AIN + 2 * I_AOUT + I_RIN + I_ROUT + I_GLU + 4 * I_RT;
    unsigned char* ws = F.ws;
    for (int it = gw; it < NITEMS; it += NGW) {
        int r = it;
        if (r < 2 * I_AIN) { const int j = r / I_AIN; r %= I_AIN; const int kb = r / 288, nb = r % 288, n0 = nb * 32;
            conv_item8(gin(p, 1) + (size_t)j * D * ATT_IN, ATT_IN, (unsigned char*)(ws + WS_ATT_IN_T) + (size_t)j * ATT_IN * D, D, kb * 64, n0, n0, WUP_SCALE, scr, F.lane); continue; }
        r -= 2 * I_AIN;
        if (r < 2 * I_AOUT) { const int j = r / I_AOUT; r %= I_AOUT; const int kb = r / 32, nb = r % 32, n0 = nb * 32;
            conv_item<false>(gin(p, 2) + (size_t)j * D * D, D, (bf16*)(ws + WS_ATT_OUT_T) + (size_t)j * D * D, nullptr, D, kb * 64, n0, n0, 1.0f, scr, F.lane); continue; }
        r -= 2 * I_AOUT;
        if (r < I_RIN) { const int kb = r / 192, nb = r % 192, n0 = nb * 32;
            conv_item8(gin(p, 3), RET_IN, (unsigned char*)(ws + WS_RET_IN_T), D, kb * 64, n0, n0, WUP_SCALE, scr, F.lane); continue; }
        r -= I_RIN;
        if (r < I_ROUT) { const int kb = r / 32, nb = r % 32, n0 = nb * 32;
            conv_item<false>(gin(p, 6), D, (bf16*)(ws + WS_RET_OUT_T), nullptr, RET_V, kb * 64, n0, n0, 1.0f, scr, F.lane); continue; }
        r -= I_ROUT;
        if (r < I_GLU) { const int kb = r / 64, nb = r % 64, n0 = nb * 32; const int c = n0 & 1023, drow = (c >> 7) * 256 + (n0 >> 10) * 128 + (c & 127);
            conv_item<false>(gin(p, 15), 2 * D, (bf16*)(ws + WS_GLU_T), nullptr, D, kb * 64, n0, drow, 1.0f, scr, F.lane); continue; }
        r -= I_GLU;
        { const int l = r / I_RT; r %= I_RT; const int kb = r / 2, nb = r % 2, n0 = nb * 32;
            conv_item<true>(gin(p, 16) + (size_t)l * D * NE, NE, (bf16*)(ws + WS_RT_HI) + (size_t)l * NE * D, (bf16*)(ws + WS_RT_LO) + (size_t)l * NE * D, D, kb * 64, n0, n0, 1.0f, scr, F.lane); }
    }
}
__device__ __forceinline__ void phase_conv_moe(const Frame& F, KP p, int l) {
    LAS float* scr = (LAS float*)(F.lds + F.wave * 16384);
    const int gw = F.vcu * NWAVES + F.wave, NGW = F.G * NWAVES;
    for (int it = gw; it < 65 * 384; it += NGW) {
        const int e = it / 384, r = it % 384, which = r >> 7, rr = r & 127;
        bf16* We = (bf16*)(F.ws + WS_WMOE + (size_t)e * WMOE_E_BYTES);
        if (which < 2) { const float* src = (e < 64) ? gin(p, 18 + which) + ((size_t)l * NE + e) * D * ED : gin(p, 21 + which) + (size_t)l * D * ED;
            const int kb = rr >> 3, nb = rr & 7, n0 = nb * 32; const int drow = (n0 >> 7) * 256 + which * 128 + (n0 & 127);
            conv_item8(src, ED, (unsigned char*)We, D, kb * 64, n0, drow, WUP_SCALE, scr, F.lane);
        } else { const float* src = (e < 64) ? gin(p, 20) + ((size_t)l * NE + e) * ED * D : gin(p, 23) + (size_t)l * ED * D;
            const int kb = rr >> 5, nb = rr & 31, n0 = nb * 32;
            conv_item<false>(src, D, We + 512 * 1024, nullptr, ED, kb * 64, n0, n0, 1.0f, scr, F.lane); }
    }
}

__device__ __forceinline__ void phase_lnr(const Frame& F, KP p, int layer, bool dry = false) {
    const bf16* Y = (const bf16*)(F.ws + WS_Y); bf16* XB = (bf16*)(F.ws + WS_XB); unsigned char* XB8 = (unsigned char*)(F.ws + WS_X);
    const float* lng = gin(p, 24) + (size_t)(layer * 2) * D; const float* lnb = gin(p, 25) + (size_t)(layer * 2) * D;
    const bf16* rthi = (const bf16*)(F.ws + WS_RT_HI) + (size_t)layer * NE * D; const bf16* rtlo = (const bf16*)(F.ws + WS_RT_LO) + (size_t)layer * NE * D;
    const float* rbias = gin(p, 17) + layer * NE;
    unsigned* cnt = (unsigned*)(F.ws + WS_CTL) + CW_CNT + layer * NE * 64;
    int* lists = (int*)(F.ws + WS_LIST); int* tokmap = (int*)(F.ws + WS_LIST + 4 * MiB); float* tokgate = (float*)(F.ws + WS_LIST + 5 * MiB);
    constexpr int XLD = 1032, MAXT = 8;
    LAS bf16* Xhi = (LAS bf16*)F.lds; LAS bf16* Xlo = Xhi + 16 * XLD;
    LAS float* part = (LAS float*)(F.lds + 2 * 16 * XLD * 2);
    LAS int* ent = (LAS int*)(part + 2 * 16 * 64);
    LAS int* hist = ent + MAXT * 16 * 8 * 2; LAS int* base = hist + 64;
    const int lane = F.lane, w = F.wave, g4 = lane >> 4, l15 = lane & 15;
    if (F.tid < 64) hist[F.tid] = 0;
    bf16x8 bhi[16], blo[16];
    { const int nt = w & 3, kh = w >> 2; const bf16* bh = rthi + (size_t)(16 * nt + l15) * D + 512 * kh + 8 * g4; const bf16* bl = rtlo + (size_t)(16 * nt + l15) * D + 512 * kh + 8 * g4;
#pragma unroll
        for (int ks = 0; ks < 16; ++ks) { bhi[ks] = *(const bf16x8*)(bh + 32 * ks); blo[ks] = *(const bf16x8*)(bl + 32 * ks); } }
    u32x4 ypre[2][2];
    if (F.vcu < T / 16) {
#pragma unroll
        for (int rr = 0; rr < 2; ++rr)
#pragma unroll
            for (int j = 0; j < 2; ++j) ypre[rr][j] = *(const u32x4*)(Y + (size_t)(F.vcu * 16 + 2 * w + rr) * D + 8 * lane + 512 * j); }
    int ntile = 0;
    for (int tile = F.vcu; tile < T / 16 && ntile < MAXT; tile += F.G, ++ntile) {
        const int t0 = tile * 16;
        u32x4 ycur[2][2];
#pragma unroll
        for (int rr = 0; rr < 2; ++rr)
#pragma unroll
            for (int j = 0; j < 2; ++j) ycur[rr][j] = ypre[rr][j];
        if (tile + F.G < T / 16) {
#pragma unroll
            for (int rr = 0; rr < 2; ++rr)
#pragma unroll
                for (int j = 0; j < 2; ++j) ypre[rr][j] = *(const u32x4*)(Y + (size_t)((tile + F.G) * 16 + 2 * w + rr) * D + 8 * lane + 512 * j); }
#pragma unroll
        for (int rr = 0; rr < 2; ++rr) {
            const int lr = 2 * w + rr; const size_t row = (size_t)(t0 + lr);
            f32x4 v[4]; float s = 0.f;
#pragma unroll
            for (int j = 0; j < 2; ++j) unpack_bf16x8(ycur[rr][j], v[2 * j], v[2 * j + 1]);
#pragma unroll
            for (int j = 0; j < 4; ++j) s += (v[j][0] + v[j][1]) + (v[j][2] + v[j][3]);
            const float mean = wave_sum(s, lane) * (1.f / D); float s2 = 0.f;
#pragma unroll
            for (int j = 0; j < 4; ++j) { v[j] = v[j] - mean; s2 += (v[j][0] * v[j][0] + v[j][1] * v[j][1]) + (v[j][2] * v[j][2] + v[j][3] * v[j][3]); }
            const float rstd = 1.0f / sqrtf(wave_sum(s2, lane) * (1.f / D) + LN_EPS);
#pragma unroll
            for (int j = 0; j < 2; ++j) { const f32x4 g0 = *(const f32x4*)(lng + 8 * lane + 512 * j), g1 = *(const f32x4*)(lng + 8 * lane + 512 * j + 4), b0 = *(const f32x4*)(lnb + 8 * lane + 512 * j), b1 = *(const f32x4*)(lnb + 8 * lane + 512 * j + 4);
                const f32x4 o0 = v[2 * j] * rstd * g0 + b0, o1 = v[2 * j + 1] * rstd * g1 + b1;
                const u32x4 hi = pack_bf16x8(o0, o1);
                *(u32x4*)(XB + row * D + 8 * lane + 512 * j) = hi;
                { u32x2 q8; q8.x = pk4_fp8(o0[0], o0[1], o0[2], o0[3]); q8.y = pk4_fp8(o1[0], o1[1], o1[2], o1[3]); *(u32x2*)(XB8 + row * D + 8 * lane + 512 * j) = q8; }
                f32x4 h0, h1; unpack_bf16x8(hi, h0, h1); const u32x4 lo = pack_bf16x8(o0 - h0, o1 - h1);
                *(LAS u32x4*)(Xhi + lr * XLD + 8 * lane + 512 * j) = hi; *(LAS u32x4*)(Xlo + lr * XLD + 8 * lane + 512 * j) = lo; }
        }
        __syncthreads();
        { const int nt = w & 3, kh = w >> 2; f32x4 a0 = (f32x4){0.f, 0.f, 0.f, 0.f}, a1 = a0, a2 = a0, a3 = a0, a4 = a0, a5 = a0;
#pragma unroll
            for (int ks = 0; ks < 16; ks += 2) { const int k0 = 512 * kh + 32 * ks;
                const bf16x8 ahi = row_frag(Xhi, XLD, 0, k0, lane), alo = row_frag(Xlo, XLD, 0, k0, lane), bhi2 = row_frag(Xhi, XLD, 0, k0 + 32, lane), blo2 = row_frag(Xlo, XLD, 0, k0 + 32, lane);
                a0 = MFMA16(ahi, bhi[ks], a0); a1 = MFMA16(alo, bhi[ks], a1); a2 = MFMA16(ahi, blo[ks], a2);
                a3 = MFMA16(bhi2, bhi[ks + 1], a3); a4 = MFMA16(blo2, bhi[ks + 1], a4); a5 = MFMA16(bhi2, blo[ks + 1], a5); }
            const f32x4 acc = ((a0 + a3) + (a1 + a4)) + (a2 + a5);
#pragma unroll
            for (int i = 0; i < 4; ++i) part[(kh * 16 + 4 * g4 + i) * 64 + 16 * nt + l15] = acc[i];
        }
        __syncthreads();
#pragma unroll
        for (int rr = 0; rr < 2; ++rr) {
            const int lt = ntile * 16 + 2 * w + rr;
            const float lg = part[(2 * w + rr) * 64 + lane] + part[(16 + 2 * w + rr) * 64 + lane];
            float sc = 1.0f / (1.0f + expf(-lg)); sc = (sc == sc) ? sc : 0.5f;
            const float sel = sc + rbias[lane];
            const float m1 = max8(sel);
            const unsigned long long eq = __ballot(sel == m1);
            const unsigned gm = (unsigned)(eq >> (lane & 56)) & 0xffu;
            const int first = (lane & 56) + __builtin_ctz(gm | 0x100u);
            const float m2 = max8((lane == first) ? -INFINITY : sel);
            const float gs = m1 + m2; const int mygrp = lane >> 3; int grank = 0;
#pragma unroll
            for (int gg = 0; gg < 8; ++gg) { const float o = rdl(gs, 8 * gg); grank += (o > gs || (o == gs && gg < mygrp)) ? 1 : 0; }
            const float mv = (grank < 4) ? sel : -INFINITY; int rank = 0;
#pragma unroll
            for (int e2 = 0; e2 < 64; ++e2) { const float o = rdl(mv, e2); rank += (o > mv || (o == mv && e2 < lane)) ? 1 : 0; }
            const bool chosen = rank < TOPK;
            const float wsum = wave_sum(chosen ? sc : 0.f, lane);
            if (chosen) { const int lpos = __hip_atomic_fetch_add(hist + lane, 1, __ATOMIC_RELAXED, __HIP_MEMORY_SCOPE_WORKGROUP);
                ent[(lt * 8 + rank) * 2] = (lane << 16) | lpos; ent[(lt * 8 + rank) * 2 + 1] = __builtin_bit_cast(int, sc / wsum * 2.5f); }
        }
    }
    __syncthreads();
    if (dry) return;
    if (F.tid < 64) { const int hcount = hist[F.tid]; base[F.tid] = hcount ? (int)atomicAdd(cnt + F.tid * 64, (unsigned)hcount) : 0; }
    __syncthreads();
    for (int idx = F.tid; idx < ntile * 16 * 8; idx += NTHREADS) {
        const int ev = ent[idx * 2], gb = ent[idx * 2 + 1]; const int e = ev >> 16, pos = base[e] + (ev & 0xffff);
        const int lt = idx >> 3, rank = idx & 7, tok = (F.vcu + (lt >> 4) * F.G) * 16 + (lt & 15);
        lists[(size_t)e * T + pos] = tok; tokmap[tok * 8 + rank] = (e << 16) | pos; tokgate[tok * 8 + rank] = __builtin_bit_cast(float, gb);
    }
}

__device__ __forceinline__ void phase_combine(const Frame& F, KP p, int layer, bool dry = false) {
    bf16* XB = (bf16*)(F.ws + WS_XB); const unsigned char* yexp = (const unsigned char*)(F.ws + WS_BIG);
    const int* tokmap = (const int*)(F.ws + WS_LIST + 4 * MiB); const float* tokgate = (const float*)(F.ws + WS_LIST + 5 * MiB);
    const volatile LAS int* tstart = (const volatile LAS int*)(F.MISC + 64);
    const float* lng = gin(p, 24) + (size_t)(layer * 2 + 1) * D; const float* lnb = gin(p, 25) + (size_t)(layer * 2 + 1) * D;
    float* outp = gout(p); bf16* xbo = XB; if (dry) { outp = (float*)(F.ws + WS_AUX); xbo = (bf16*)(F.ws + WS_H); }
    const int lane = F.lane, gw = F.vcu * NWAVES + F.wave, NGW = F.G * NWAVES;
    const bf16* ysh = (const bf16*)(F.ws + WS_Y);
    f32x4 gv[4], bv[4];
#pragma unroll
    for (int j = 0; j < 4; ++j) { gv[j] = *(const f32x4*)(lng + 16 * lane + 4 * j); bv[j] = *(const f32x4*)(lnb + 16 * lane + 4 * j); }
    for (int row = gw; row < T; row += NGW) {
        const int mk = tokmap[row * 8 + (lane & 7)]; const float gk = tokgate[row * 8 + (lane & 7)] * YEXP_INV;
        const int rk = (int)tstart[mk >> 16] * 256 + (mk & 0xffff);
        f32x4 v[4];
#pragma unroll
        for (int j = 0; j < 2; ++j) { const u32x4 xw = *(const u32x4*)(ysh + (size_t)row * D + 16 * lane + 8 * j); unpack_bf16x8(xw, v[2 * j], v[2 * j + 1]); }
#pragma unroll
        for (int k = 0; k < TOPK; ++k) { const int r = __builtin_amdgcn_readlane(rk, k); const float g = rdl(gk, k);
            const u32x4 s = *(const u32x4*)(yexp + (size_t)r * D + 16 * lane);
#pragma unroll
            for (int j = 0; j < 4; ++j) { const f32x2 lo = __builtin_amdgcn_cvt_pk_f32_fp8((int)s[j], false), hi = __builtin_amdgcn_cvt_pk_f32_fp8((int)s[j], true);
                v[j][0] += g * lo[0]; v[j][1] += g * lo[1]; v[j][2] += g * hi[0]; v[j][3] += g * hi[1]; } }
        float s = 0.f;
#pragma unroll
        for (int j = 0; j < 4; ++j) s += (v[j][0] + v[j][1]) + (v[j][2] + v[j][3]);
        const float mean = wave_sum(s, lane) * (1.f / D); float s2 = 0.f;
#pragma unroll
        for (int j = 0; j < 4; ++j) { v[j] = v[j] - mean; s2 += (v[j][0] * v[j][0] + v[j][1] * v[j][1]) + (v[j][2] * v[j][2] + v[j][3] * v[j][3]); }
        const float rstd = 1.0f / sqrtf(wave_sum(s2, lane) * (1.f / D) + LN_EPS);
        f32x4 o[4];
#pragma unroll
        for (int j = 0; j < 4; ++j) o[j] = v[j] * rstd * gv[j] + bv[j];
        if (layer == DEPTH - 1 || dry) {
#pragma unroll
            for (int j = 0; j < 4; ++j) *(f32x4*)(outp + (size_t)row * D + 16 * lane + 4 * j) = o[j]; }
        if (layer != DEPTH - 1) { *(u32x4*)(xbo + (size_t)row * D + 16 * lane) = pack_bf16x8(o[0], o[1]); *(u32x4*)(xbo + (size_t)row * D + 16 * lane + 8) = pack_bf16x8(o[2], o[3]);
            if (!dry) { u32x4 q8; q8.x = pk4_fp8(o[0][0], o[0][1], o[0][2], o[0][3]); q8.y = pk4_fp8(o[1][0], o[1][1], o[1][2], o[1][3]); q8.z = pk4_fp8(o[2][0], o[2][1], o[2][2], o[2][3]); q8.w = pk4_fp8(o[3][0], o[3][1], o[3][2], o[3][3]);
                *(u32x4*)((unsigned char*)(F.ws + WS_X) + (size_t)row * D + 16 * lane) = q8; } }
    }
}

constexpr size_t AUX_OB = 96 * MiB, AUX_LSE = 128 * MiB;
__device__ __forceinline__ void phase_attn(const Frame& F, int bx) {
    const bf16* qkv = (const bf16*)(F.ws + WS_BIG); bf16* og = (bf16*)(F.ws + WS_AUX); float* lse = (float*)(F.ws + WS_AUX + AUX_LSE);
    constexpr int KLD = 136;
    LAS bf16* Ks = (LAS bf16*)F.lds; LAS bf16* Vs = Ks + 256 * KLD;
    const int lane = F.lane, w = F.wave, g4 = lane >> 4, l15 = lane & 15, qq = l15 >> 2, pp = lane & 3;
    u32x4 kreg[8], vreg[8];
#define ATT_DECODE(L_) const int h = (L_) & 7, sb = (L_) >> 3, g = sb >> 7, rem = sb & 127, b = rem >> 6, rn = rem & 63; \
        const int dsh = 2 * g, d = 1 << dsh, nbs = 6 - dsh, r = rn >> nbs, n = rn & ((1 << nbs) - 1); const size_t rowbase = (size_t)b * SEQ;
#define ATT_ISSUE(L_) do { ATT_DECODE(L_) _Pragma("unroll") for (int it = 0; it < 8; ++it) { const int idx = F.tid + 512 * it, c = idx >> 4, ch = idx & 15; int pos = 128 * (n - 1) + c; pos = pos < 0 ? 0 : pos; \
            const bf16* src = qkv + (rowbase + (size_t)pos * d + r) * ATT_IN + g * 3072 + 1024 + h * 128 + ch * 8; kreg[it] = *(const u32x4*)src; vreg[it] = *(const u32x4*)(src + 1024); } } while (0)
    if (bx < 3072) ATT_ISSUE(bx);
    for (int L = bx; L < 3072; L += F.G) {
        ATT_DECODE(L)
#pragma unroll
        for (int it = 0; it < 8; ++it) { const int idx = F.tid + 512 * it, c = idx >> 4, ch = idx & 15;
            *(LAS u32x4*)(Ks + c * KLD + ch * 8) = kreg[it]; *(LAS u32x4*)(Vs + c * KLD + ch * 8) = vreg[it]; }
        const int qi = 16 * w + l15; const size_t qrow = rowbase + (size_t)(128 * n + qi) * d + r;
        bf16x8 qf[4];
#pragma unroll
        for (int s = 0; s < 4; ++s) qf[s] = *(const bf16x8*)(qkv + qrow * ATT_IN + g * 3072 + h * 128 + 32 * s + 8 * g4);
        __syncthreads();
        if (L + F.G < 3072) { ATT_ISSUE(L + F.G); }
        __builtin_amdgcn_sched_barrier(0);
        const int ws0 = (16 * w < 96) ? 16 * w : 96;
        f32x4 sacc[10];
        {
            bf16x8 kfa[4], kfb[4];
#pragma unroll
            for (int s = 0; s < 4; ++s) kfa[s] = row_frag(Ks, KLD, ws0, 32 * s, lane);
#pragma unroll
            for (int t = 0; t < 10; t += 2) {
#pragma unroll
                for (int s = 0; s < 4; ++s) kfb[s] = row_frag(Ks, KLD, ws0 + 16 * (t + 1), 32 * s, lane);
                __builtin_amdgcn_sched_barrier(0);
                sacc[t] = (f32x4){0.f, 0.f, 0.f, 0.f};
#pragma unroll
                for (int s = 0; s < 4; ++s) sacc[t] = MFMA16(kfa[s], qf[s], sacc[t]);
                if (t + 2 < 10) {
#pragma unroll
                    for (int s = 0; s < 4; ++s) kfa[s] = row_frag(Ks, KLD, ws0 + 16 * (t + 2), 32 * s, lane); }
                __builtin_amdgcn_sched_barrier(0);
                sacc[t + 1] = (f32x4){0.f, 0.f, 0.f, 0.f};
#pragma unroll
                for (int s = 0; s < 4; ++s) sacc[t + 1] = MFMA16(kfb[s], qf[s], sacc[t + 1]);
            }
        }
        const float slope = exp2f(-(float)(h + 1)) * (float)d;
        float mx = -INFINITY;
#pragma unroll
        for (int t = 0; t < 10; ++t)
#pragma unroll
            for (int i = 0; i < 4; ++i) { const int c = ws0 + 16 * t + 4 * g4 + i, step = 128 + qi - c;
                const bool valid = (step >= 0) && (step <= 128) && (n > 0 || c >= 128);
                const float v = valid ? sacc[t][i] - slope * (float)step : -INFINITY; sacc[t][i] = v; mx = fmaxf(mx, v); }
        mx = fmaxf(mx, shx(mx, 16, lane)); mx = fmaxf(mx, shx(mx, 32, lane));
        float lsum = 0.f;
#pragma unroll
        for (int t = 0; t < 10; ++t)
#pragma unroll
            for (int i = 0; i < 4; ++i) { const float pv = __expf(sacc[t][i] - mx); sacc[t][i] = pv; lsum += pv; }
        lsum += shx(lsum, 16, lane); lsum += shx(lsum, 32, lane);
        bf16x8 pf[5];
#pragma unroll
        for (int kt = 0; kt < 5; ++kt) pf[kt] = pack8(sacc[2 * kt], sacc[2 * kt + 1]);
        f32x4 o[8];
        {
            const LAS bf16* vb = Vs + (ws0 + 4 * g4 + qq) * KLD + 32 * pp;
            bf16x4 va[10], vc[10];
#pragma unroll
            for (int kt = 0; kt < 5; ++kt) { va[2 * kt] = tr4(vb + 32 * kt * KLD); va[2 * kt + 1] = tr4(vb + (32 * kt + 16) * KLD); }
#pragma unroll
            for (int et = 0; et < 8; et += 2) {
#pragma unroll
                for (int kt = 0; kt < 5; ++kt) { vc[2 * kt] = tr4(vb + 32 * kt * KLD + 4 * (et + 1)); vc[2 * kt + 1] = tr4(vb + (32 * kt + 16) * KLD + 4 * (et + 1)); }
                __builtin_amdgcn_sched_barrier(0);
                o[et] = (f32x4){0.f, 0.f, 0.f, 0.f};
#pragma unroll
                for (int kt = 0; kt < 5; ++kt) o[et] = MFMA16(cat8(va[2 * kt], va[2 * kt + 1]), pf[kt], o[et]);
                if (et + 2 < 8) {
#pragma unroll
                    for (int kt = 0; kt < 5; ++kt) { va[2 * kt] = tr4(vb + 32 * kt * KLD + 4 * (et + 2)); va[2 * kt + 1] = tr4(vb + (32 * kt + 16) * KLD + 4 * (et + 2)); } }
                __builtin_amdgcn_sched_barrier(0);
                o[et + 1] = (f32x4){0.f, 0.f, 0.f, 0.f};
#pragma unroll
                for (int kt = 0; kt < 5; ++kt) o[et + 1] = MFMA16(cat8(vc[2 * kt], vc[2 * kt + 1]), pf[kt], o[et + 1]);
            }
        }
        const float inv = 1.0f / lsum;
        bf16* orow = og + ((size_t)g * T + qrow) * D + h * 128 + 32 * g4;
#pragma unroll
        for (int e2 = 0; e2 < 4; ++e2) *(u32x4*)(orow + 8 * e2) = pack_bf16x8(o[2 * e2] * inv, o[2 * e2 + 1] * inv);
        if (g4 == 0) lse[((size_t)g * T + qrow) * AH + h] = mx + __logf(lsum);
        __syncthreads();
    }
#undef ATT_DECODE
#undef ATT_ISSUE
}
__device__ __forceinline__ void phase_attn_combine(const Frame& F) {
    const bf16* og = (const bf16*)(F.ws + WS_AUX); const float* lse = (const float*)(F.ws + WS_AUX + AUX_LSE); bf16* ob = (bf16*)(F.ws + WS_AUX + AUX_OB);
    const int lane = F.lane, gw = F.vcu * NWAVES + F.wave, NGW = F.G * NWAVES, h = lane >> 3;
    for (int row = gw; row < T; row += NGW) {
        const float l0 = lse[((size_t)0 * T + row) * AH + h], l1 = lse[((size_t)1 * T + row) * AH + h], l2 = lse[((size_t)2 * T + row) * AH + h];
        const float m = fmaxf(l0, fmaxf(l1, l2)); float w0 = __expf(l0 - m), w1 = __expf(l1 - m), w2 = __expf(l2 - m); const float inv = 1.0f / (w0 + w1 + w2); w0 *= inv; w1 *= inv; w2 *= inv;
        float a[16];
#pragma unroll
        for (int j = 0; j < 16; ++j) a[j] = 0.f;
#pragma unroll
        for (int g = 0; g < 3; ++g) { const float wg = (g == 0) ? w0 : (g == 1 ? w1 : w2);
#pragma unroll
            for (int q = 0; q < 2; ++q) { const u32x4 s = *(const u32x4*)(og + ((size_t)g * T + row) * D + 16 * lane + 8 * q);
                a[8 * q + 0] += wg * bflo(s.x); a[8 * q + 1] += wg * bfhi(s.x); a[8 * q + 2] += wg * bflo(s.y); a[8 * q + 3] += wg * bfhi(s.y);
                a[8 * q + 4] += wg * bflo(s.z); a[8 * q + 5] += wg * bfhi(s.z); a[8 * q + 6] += wg * bflo(s.w); a[8 * q + 7] += wg * bfhi(s.w); } }
#pragma unroll
        for (int q = 0; q < 2; ++q) { u32x4 o; o.x = pk2(a[8 * q], a[8 * q + 1]); o.y = pk2(a[8 * q + 2], a[8 * q + 3]); o.z = pk2(a[8 * q + 4], a[8 * q + 5]); o.w = pk2(a[8 * q + 6], a[8 * q + 7]);
            *(u32x4*)(ob + (size_t)row * D + 16 * lane + 8 * q) = o; }
    }
}

constexpr size_t BIG_YRET = 192 * MiB;
__device__ __forceinline__ void phase_ret_u(const Frame& F) {
    const bf16* proj = (const bf16*)(F.ws + WS_BIG); bf16* St = (bf16*)(F.ws + WS_AUX);
    constexpr int LD = 264;
    LAS bf16* Kt = (LAS bf16*)F.lds; LAS bf16* Vt = Kt + 128 * LD;
    const int lane = F.lane, w = F.wave, g4 = lane >> 4, l15 = lane & 15, qq = l15 >> 2, pp = lane & 3;
    for (int u = F.vcu; u < 1024; u += F.G) {
        const int eh = u & 1, h = (u >> 1) & 3, n = (u >> 3) & 63, b = u >> 9;
        const size_t row0 = (size_t)b * SEQ + (size_t)n * RC;
#pragma unroll 4
        for (int it = 0; it < 8; ++it) { const int idx = F.tid + 512 * it, j = idx >> 5, ch = idx & 31;
            const bf16* src = proj + (row0 + j) * RET_IN;
            const u32x4 kv = *(const u32x4*)(src + 1024 + h * 256 + ch * 8), vv = *(const u32x4*)(src + 2048 + h * 512 + eh * 256 + ch * 8);
            *(LAS u32x4*)(Kt + j * LD + ch * 8) = kv; *(LAS u32x4*)(Vt + j * LD + ch * 8) = vv; }
        __syncthreads();
        f32x4 acc[16][2];
#pragma unroll
        for (int mt = 0; mt < 16; ++mt) { acc[mt][0] = (f32x4){0.f, 0.f, 0.f, 0.f}; acc[mt][1] = (f32x4){0.f, 0.f, 0.f, 0.f}; }
#pragma unroll
        for (int ks = 0; ks < 4; ++ks) {
            bf16x8 bfr[2];
#pragma unroll
            for (int nt = 0; nt < 2; ++nt) { const LAS bf16* a0 = Vt + (32 * ks + 8 * g4 + qq) * LD + 32 * w + 16 * nt + 4 * pp; bfr[nt] = cat8(tr4(a0), tr4(a0 + 4 * LD)); }
#pragma unroll
            for (int mt = 0; mt < 16; ++mt) { const LAS bf16* a0 = Kt + (32 * ks + 8 * g4 + qq) * LD + 128 * (mt >> 3) + 32 * pp + 4 * (mt & 7);
                const bf16x8 afr = cat8(tr4(a0), tr4(a0 + 4 * LD));
                acc[mt][0] = MFMA16(afr, bfr[0], acc[mt][0]); acc[mt][1] = MFMA16(afr, bfr[1], acc[mt][1]); }
        }
        bf16* outb = St + ((size_t)((b * RH + h) * RNC + n)) * (RDV * RDK);
#pragma unroll
        for (int nt = 0; nt < 2; ++nt) { bf16* orow = outb + (size_t)(eh * 256 + 32 * w + 16 * nt + l15) * RDK + 32 * g4;
#pragma unroll
            for (int mh = 0; mh < 2; ++mh)
#pragma unroll
                for (int q = 0; q < 4; ++q) *(u32x4*)(orow + 128 * mh + 8 * q) = pack_bf16x8(acc[mh * 8 + 2 * q][nt], acc[mh * 8 + 2 * q + 1][nt]); }
        __syncthreads();
    }
}
__device__ __forceinline__ void phase_ret_scan(const Frame& F) {
    bf16* St = (bf16*)(F.ws + WS_AUX);
    for (int gt = F.vcu * NTHREADS + F.tid; gt < 8 * 16384; gt += F.G * NTHREADS) {
        const int bh = gt >> 14, chunk = gt & 16383, h = bh & 3;
        const float g128 = exp2f(128.0f * log2f(1.0f - exp2f(-5.0f - (float)h)));
        bf16* base = St + (size_t)bh * RNC * (RDV * RDK) + (size_t)chunk * 8;
        float c[8];
#pragma unroll
        for (int j = 0; j < 8; ++j) c[j] = 0.f;
#pragma unroll 8
        for (int n = 0; n < RNC; ++n) { bf16* pn = base + (size_t)n * (RDV * RDK); const u32x4 uv = *(const u32x4*)pn;
            u32x4 o; o.x = pk2(c[0], c[1]); o.y = pk2(c[2], c[3]); o.z = pk2(c[4], c[5]); o.w = pk2(c[6], c[7]); *(u32x4*)pn = o;
            c[0] = g128 * (c[0] + bflo(uv.x)); c[1] = g128 * (c[1] + bfhi(uv.x)); c[2] = g128 * (c[2] + bflo(uv.y)); c[3] = g128 * (c[3] + bfhi(uv.y));
            c[4] = g128 * (c[4] + bflo(uv.z)); c[5] = g128 * (c[5] + bfhi(uv.z)); c[6] = g128 * (c[6] + bflo(uv.w)); c[7] = g128 * (c[7] + bfhi(uv.w)); }
    }
}
__device__ __forceinline__ void phase_ret_out(const Frame& F, KP p) {
    const bf16* proj = (const bf16*)(F.ws + WS_BIG); const bf16* St = (const bf16*)(F.ws + WS_AUX); bf16* yret = (bf16*)(F.ws + WS_BIG + BIG_YRET);
    const float* gng = gin(p, 4); const float* gnb = gin(p, 5);
    constexpr int LD = 264, VLD = 136;
    LAS bf16* Rs = (LAS bf16*)F.lds; LAS bf16* Vs = Rs + 128 * LD;
    const int lane = F.lane, w = F.wave, g4 = lane >> 4, l15 = lane & 15, qq = l15 >> 2, pp = lane & 3;
    for (int u = F.vcu; u < 512; u += F.G) {
        const int h = u & 3, n = (u >> 2) & 63, b = u >> 8;
        const size_t row0 = (size_t)b * SEQ + (size_t)n * RC;
#pragma unroll 4
        for (int it = 0; it < 8; ++it) { const int idx = F.tid + 512 * it, j = idx >> 5, ch = idx & 31;
            *(LAS u32x4*)(Rs + j * LD + ch * 8) = *(const u32x4*)(proj + (row0 + j) * RET_IN + 1024 + h * 256 + ch * 8); }
        const int irow = 16 * w + l15; const size_t qrow = row0 + irow;
        bf16x8 qf[8];
#pragma unroll
        for (int s = 0; s < 8; ++s) qf[s] = *(const bf16x8*)(proj + qrow * RET_IN + h * 256 + 32 * s + 8 * g4);
        __syncthreads();
        bf16x8 pf[4];
        { f32x4 sacc[8];
#pragma unroll
            for (int jt = 0; jt < 8; ++jt) { sacc[jt] = (f32x4){0.f, 0.f, 0.f, 0.f};
                if (jt <= w) {
#pragma unroll
                    for (int s = 0; s < 8; ++s) sacc[jt] = MFMA16(row_frag(Rs, LD, 16 * jt, 32 * s, lane), qf[s], sacc[jt]);
#pragma unroll
                    for (int i = 0; i < 4; ++i) if (16 * jt + 4 * g4 + i > irow) sacc[jt][i] = 0.f; } }
#pragma unroll
            for (int kt = 0; kt < 4; ++kt) pf[kt] = pack8(sacc[2 * kt], sacc[2 * kt + 1]); }
        __syncthreads();
        f32x4 acc[4][8];
        const bf16* Sn = St + ((size_t)((b * RH + h) * RNC + n)) * (RDV * RDK);
#pragma unroll
        for (int sl = 0; sl < 4; ++sl) {
#pragma unroll 4
            for (int it = 0; it < 4; ++it) { const int idx = F.tid + 512 * it, j = idx >> 4, ch = idx & 15;
                *(LAS u32x4*)(Vs + j * VLD + ch * 8) = *(const u32x4*)(proj + (row0 + j) * RET_IN + 2048 + h * 512 + sl * 128 + ch * 8); }
#pragma unroll 4
            for (int it = 0; it < 8; ++it) { const int idx = F.tid + 512 * it, e = idx >> 5, ch = idx & 31;
                *(LAS u32x4*)(Rs + e * LD + ch * 8) = *(const u32x4*)(Sn + (size_t)(sl * 128 + e) * RDK + ch * 8); }
            __syncthreads();
#pragma unroll
            for (int et = 0; et < 8; ++et) { f32x4 a = (f32x4){0.f, 0.f, 0.f, 0.f};
#pragma unroll
                for (int kt = 0; kt < 4; ++kt) if (2 * kt <= w) { const LAS bf16* a0 = Vs + (32 * kt + 4 * g4 + qq) * VLD + 32 * pp + 4 * et;
                    a = MFMA16(cat8(tr4(a0), tr4(a0 + 16 * VLD)), pf[kt], a); }
                const LAS bf16* srow = Rs + (32 * qq + 4 * et + pp) * LD + 8 * g4;
#pragma unroll
                for (int s = 0; s < 8; ++s) a = MFMA16(*(const LAS bf16x8*)(srow + 32 * s), qf[s], a);
                acc[sl][et] = a; }
            __syncthreads();
        }
        float s = 0.f;
#pragma unroll
        for (int sl = 0; sl < 4; ++sl)
#pragma unroll
            for (int et = 0; et < 8; ++et) s += (acc[sl][et][0] + acc[sl][et][1]) + (acc[sl][et][2] + acc[sl][et][3]);
        s += shx(s, 16, lane); s += shx(s, 32, lane);
        const float mean = s * (1.0f / RDV); float s2 = 0.f;
#pragma unroll
        for (int sl = 0; sl < 4; ++sl)
#pragma unroll
            for (int et = 0; et < 8; ++et) { acc[sl][et] = acc[sl][et] - mean; s2 += (acc[sl][et][0] * acc[sl][et][0] + acc[sl][et][1] * acc[sl][et][1]) + (acc[sl][et][2] * acc[sl][et][2] + acc[sl][et][3] * acc[sl][et][3]); }
        s2 += shx(s2, 16, lane); s2 += shx(s2, 32, lane);
        const float rstd = 1.0f / sqrtf(s2 * (1.0f / RDV) + LN_EPS);
#pragma unroll
        for (int sl = 0; sl < 4; ++sl) { const int c0 = h * RDV + sl * 128 + 32 * g4;
#pragma unroll
            for (int q = 0; q < 4; ++q) { const u32x4 gw = *(const u32x4*)(proj + qrow * RET_IN + 4096 + c0 + 8 * q);
                const f32x4 gg0 = *(const f32x4*)(gng + c0 + 8 * q), gg1 = *(const f32x4*)(gng + c0 + 8 * q + 4), gb0 = *(const f32x4*)(gnb + c0 + 8 * q), gb1 = *(const f32x4*)(gnb + c0 + 8 * q + 4);
                f32x4 y0 = acc[sl][2 * q] * rstd * gg0 + gb0, y1 = acc[sl][2 * q + 1] * rstd * gg1 + gb1;
                const float gv[8] = {bflo(gw.x), bfhi(gw.x), bflo(gw.y), bfhi(gw.y), bflo(gw.z), bfhi(gw.z), bflo(gw.w), bfhi(gw.w)};
#pragma unroll
                for (int j = 0; j < 4; ++j) { y0[j] *= gv[j] / (1.0f + __expf(-gv[j])); y1[j] *= gv[4 + j] / (1.0f + __expf(-gv[4 + j])); }
                *(u32x4*)(yret + qrow * RET_V + c0 + 8 * q) = pack_bf16x8(y0, y1); } }
    }
}

constexpr size_t AUX_S5E = 64 * MiB;
constexpr int S5L = 256, S5NC = SEQ / S5L;
__device__ __forceinline__ void cmul_add(float& rr, float& ri, float ar, float ai, float xr, float xi, float cr, float ci) { rr = ar * xr - ai * xi + cr; ri = ar * xi + ai * xr + ci; }
template <bool OUT>
__device__ __forceinline__ void phase_s5_scan(const Frame& F, KP p) {
    const bf16* X = (const bf16*)(F.ws + WS_XB); float* E = (float*)(F.ws + WS_AUX + AUX_S5E); bf16* ybuf = (bf16*)(F.ws + WS_AUX);
    const int lane = F.lane, w = F.wave, g4 = lane >> 4, l15 = lane & 15;
    LAS bf16* ut = (LAS bf16*)(F.lds + w * 12288);
    LAS bf16* Hb = (LAS bf16*)(F.lds + w * 12288 + 4096);
    constexpr int HLD = 136;
    const int gw = F.vcu * NWAVES + w, NGW = F.G * NWAVES;
    const int up16 = (lane - 16) << 2, up32 = (lane - 32) << 2, last16 = (48 + l15) << 2;
    for (int unit = gw; unit < BATCH * SG * S5NC; unit += NGW) {
        const int n = unit & (S5NC - 1), g = (unit >> 5) & 63, b = unit >> 11;
        float a1r[4], a1i[4], a4r[4], a4i[4], a8r[4], a8i[4], pwr[4], pwi[4];
        bf16x8 bfrag[8];
        const float dt = expf(gin(p, 14)[g]);
#pragma unroll
        for (int st = 0; st < 4; ++st) { const int ps = 16 * st + l15;
            const float are = gin(p, 7)[g * SP + ps], aim = gin(p, 8)[g * SP + ps];
            const float mag = expf(dt * are); const float abr = mag * cosf(dt * aim), abi = mag * sinf(dt * aim);
            const float den = are * are + aim * aim;
            const float fre = ((abr - 1.0f) * are + abi * aim) / den, fim = (abi * are - (abr - 1.0f) * aim) / den;
            a1r[st] = abr; a1i[st] = abi; { float t2r, t2i; cmul_add(t2r, t2i, abr, abi, abr, abi, 0.f, 0.f); cmul_add(a4r[st], a4i[st], t2r, t2i, t2r, t2i, 0.f, 0.f); }
            cmul_add(a8r[st], a8i[st], a4r[st], a4i[st], a4r[st], a4i[st], 0.f, 0.f);
            float qr = 1.f, qi = 0.f;
            if (g4 & 1) { qr = a4r[st]; qi = a4i[st]; }
            if (g4 & 2) { float tr, ti; cmul_add(tr, ti, qr, qi, a8r[st], a8i[st], 0.f, 0.f); qr = tr; qi = ti; }
            pwr[st] = qr; pwi[st] = qi;
            const float* br = gin(p, 9) + ((size_t)g * SP + ps) * SGC + 8 * (g4 & 1); const float* bi = gin(p, 10) + ((size_t)g * SP + ps) * SGC + 8 * (g4 & 1);
            const f32x4 r0 = *(const f32x4*)br, r1 = *(const f32x4*)(br + 4), i0 = *(const f32x4*)bi, i1 = *(const f32x4*)(bi + 4);
            const float z = (g4 < 2) ? 1.0f : 0.0f; const float fr2 = fre * z, fi2 = fim * z;
            bfrag[st] = pack8(r0 * fr2 - i0 * fi2, r1 * fr2 - i1 * fi2); bfrag[st + 4] = pack8(i0 * fr2 + r0 * fi2, i1 * fr2 + r1 * fi2);
        }
        float sr[4], si[4];
        float* Eu = E + ((size_t)(b * SG + g) * S5NC + n) * 128;
        bf16x8 cf[4]; f32x4 dsk = (f32x4){0.f, 0.f, 0.f, 0.f};
#pragma unroll
        for (int st = 0; st < 4; ++st) { sr[st] = 0.f; si[st] = 0.f; }
        if (OUT) {
#pragma unroll
            for (int st = 0; st < 4; ++st) { sr[st] = Eu[16 * st + l15]; si[st] = Eu[64 + 16 * st + l15]; }
#pragma unroll
            for (int s = 0; s < 4; ++s) { const float* cp = (s < 2 ? gin(p, 11) : gin(p, 12)) + ((size_t)g * SGC + l15) * SP + 32 * (s & 1) + 8 * g4; const float sg = s < 2 ? 1.0f : -1.0f;
                const f32x4 c0 = *(const f32x4*)cp * sg, c1 = *(const f32x4*)(cp + 4) * sg; cf[s] = pack8(c0, c1); }
            dsk = *(const f32x4*)(gin(p, 13) + g * SGC + 4 * g4); }
        const size_t tok0 = (size_t)b * SEQ + (size_t)n * S5L;
        u32x4 pre[2];
        { const bf16* src = X + (tok0 + lane) * D + g * SGC; pre[0] = *(const u32x4*)src; pre[1] = *(const u32x4*)(src + 8); }
        for (int sub = 0; sub < S5L / 64; ++sub) {
            *(LAS u32x4*)(ut + lane * 16) = pre[0]; *(LAS u32x4*)(ut + lane * 16 + 8) = pre[1];
            if (sub + 1 < S5L / 64) { const bf16* src = X + (tok0 + (sub + 1) * 64 + lane) * D + g * SGC; pre[0] = *(const u32x4*)src; pre[1] = *(const u32x4*)(src + 8); }
            LDS_WAIT(); asm volatile("" ::: "memory");
#pragma unroll (OUT ? 1 : 4)
            for (int blk = 0; blk < 4; ++blk) {
                u32x4 uw = *(const LAS u32x4*)(ut + (blk * 16 + l15) * 16 + 8 * (g4 & 1));
                if (g4 >= 2) uw = (u32x4){0u, 0u, 0u, 0u};
                const bf16x8 ufr = __builtin_bit_cast(bf16x8, uw);
                f32x4 dr[4], di[4];
#pragma unroll
                for (int st = 0; st < 4; ++st) { dr[st] = MFMA16(ufr, bfrag[st], ((f32x4){0.f, 0.f, 0.f, 0.f})); di[st] = MFMA16(ufr, bfrag[st + 4], ((f32x4){0.f, 0.f, 0.f, 0.f})); }
                float vr[4], vi[4];
#pragma unroll
                for (int st = 0; st < 4; ++st) {
                    float hr = 0.f, hi = 0.f;
#pragma unroll
                    for (int i = 0; i < 4; ++i) { float nr, ni; cmul_add(nr, ni, a1r[st], a1i[st], hr, hi, dr[st][i], di[st][i]); hr = nr; hi = ni; dr[st][i] = hr; di[st][i] = hi; }
                    vr[st] = hr; vi[st] = hi; }
#define BPF(idx, v) __builtin_bit_cast(float, __builtin_amdgcn_ds_bpermute((idx), __builtin_bit_cast(int, (v))))
                { float xr[4], xi[4];
#pragma unroll
                  for (int st = 0; st < 4; ++st) { xr[st] = BPF(up16, vr[st]); xi[st] = BPF(up16, vi[st]); }
#pragma unroll
                  for (int st = 0; st < 4; ++st) { float tr, ti; cmul_add(tr, ti, a4r[st], a4i[st], xr[st], xi[st], vr[st], vi[st]); if (g4 >= 1) { vr[st] = tr; vi[st] = ti; } }
#pragma unroll
                  for (int st = 0; st < 4; ++st) { xr[st] = BPF(up32, vr[st]); xi[st] = BPF(up32, vi[st]); }
#pragma unroll
                  for (int st = 0; st < 4; ++st) { float tr, ti; cmul_add(tr, ti, a8r[st], a8i[st], xr[st], xi[st], vr[st], vi[st]); if (g4 >= 2) { vr[st] = tr; vi[st] = ti; } } }
                float er[4], ei[4], lr[4], li[4];
#pragma unroll
                for (int st = 0; st < 4; ++st) { if (OUT) { er[st] = BPF(up16, vr[st]); ei[st] = BPF(up16, vi[st]); } else { er[st] = 0.f; ei[st] = 0.f; } lr[st] = BPF(last16, vr[st]); li[st] = BPF(last16, vi[st]); }
#undef BPF
#pragma unroll
                for (int st = 0; st < 4; ++st) {
                    if (g4 == 0) { er[st] = 0.f; ei[st] = 0.f; }
                    if (OUT) { float s0r, s0i; cmul_add(s0r, s0i, pwr[st], pwi[st], sr[st], si[st], er[st], ei[st]);
#pragma unroll
                        for (int i = 0; i < 4; ++i) { float tr, ti; cmul_add(tr, ti, a1r[st], a1i[st], s0r, s0i, 0.f, 0.f); s0r = tr; s0i = ti; dr[st][i] += s0r; di[st][i] += s0i; } }
                    { float a16r, a16i; cmul_add(a16r, a16i, a8r[st], a8i[st], a8r[st], a8i[st], 0.f, 0.f); float tr, ti; cmul_add(tr, ti, a16r, a16i, sr[st], si[st], lr[st], li[st]); sr[st] = tr; si[st] = ti; }
                    if (OUT) {
#pragma unroll
                        for (int i = 0; i < 4; ++i) { const unsigned hw = pk2(dr[st][i], di[st][i]); Hb[(4 * g4 + i) * HLD + 16 * st + l15] = (bf16)hw; Hb[(4 * g4 + i) * HLD + 64 + 16 * st + l15] = (bf16)(hw >> 16); } }
                }
                if (OUT) {
                    LDS_WAIT(); asm volatile("" ::: "memory");
                    f32x4 ya = (f32x4){0.f, 0.f, 0.f, 0.f};
#pragma unroll
                    for (int s = 0; s < 4; ++s) ya = MFMA16(cf[s], row_frag(Hb, HLD, 0, 32 * s, lane), ya);
                    const u32x2 u2 = *(const LAS u32x2*)(ut + (blk * 16 + l15) * 16 + 4 * g4);
                    const f32x4 u4 = (f32x4){bflo(u2.x), bfhi(u2.x), bflo(u2.y), bfhi(u2.y)};
                    f32x4 y = ya + dsk * u4;
#pragma unroll
                    for (int j = 0; j < 4; ++j) { const float v = y[j]; y[j] = v / (1.0f + __expf(-1.5957691216057308f * (v + 0.044715f * v * v * v))); }
                    u32x2 o; o.x = pk2(y[0], y[1]); o.y = pk2(y[2], y[3]);
                    *(u32x2*)(ybuf + (tok0 + sub * 64 + blk * 16 + l15) * D + g * SGC + 4 * g4) = o;
                    asm volatile("" ::: "memory"); }
            }
            LDS_WAIT(); asm volatile("" ::: "memory");
        }
        if (!OUT && g4 == 0) {
#pragma unroll
            for (int st = 0; st < 4; ++st) { Eu[16 * st + l15] = sr[st]; Eu[64 + 16 * st + l15] = si[st]; } }
    }
}
__device__ __forceinline__ void phase_s5_carry(const Frame& F, KP p) {
    float* E = (float*)(F.ws + WS_AUX + AUX_S5E);
    for (int gt = F.vcu * NTHREADS + F.tid; gt < BATCH * SG * SP; gt += F.G * NTHREADS) {
        const int pl = gt & 63, bg = gt >> 6, g = bg & 63;
        const float dt = expf(gin(p, 14)[g]); const float are = gin(p, 7)[g * SP + pl], aim = gin(p, 8)[g * SP + pl];
        const float mag = expf(dt * are); float ar = mag * cosf(dt * aim), ai = mag * sinf(dt * aim);
#pragma unroll
        for (int q = 0; q < 8; ++q) { const float nr = ar * ar - ai * ai, ni = 2.0f * ar * ai; ar = nr; ai = ni; }
        float cr = 0.f, ci = 0.f;
        for (int n = 0; n < S5NC; ++n) { float* Eu = E + ((size_t)bg * S5NC + n) * 128; const float er = Eu[pl], ei = Eu[64 + pl];
            Eu[pl] = cr; Eu[64 + pl] = ci;
            const float nr = ar * cr - ai * ci + er, ni = ar * ci + ai * cr + ei; cr = nr; ci = ni; }
    }
}

constexpr int NPHASES = 34;
#ifndef PROBE_DRY14
#define PROBE_DRY14 0
#endif
#ifndef PROBE_DRY17
#define PROBE_DRY17 0
#endif
#ifndef PH_MASK
#define PH_MASK 0xFFFFFFFFu
#endif
#define PHT(t) ((PH_MASK >> (t)) & 1u)
constexpr int PLAN_OFF = 64;
__device__ __forceinline__ void moe_plan(const Frame& F, int layer) {
    volatile LAS int* tstart = (volatile LAS int*)(F.MISC + PLAN_OFF); volatile LAS int* cnts = tstart + 72;
    __syncthreads();
    if (F.wave == 0) {
        const unsigned* cnt = (const unsigned*)(F.ws + WS_CTL) + CW_CNT + layer * NE * 64;
        const int c = (int)__hip_atomic_load(cnt + F.lane * 64, __ATOMIC_RELAXED, __HIP_MEMORY_SCOPE_AGENT);
        int v = (c + 255) >> 8;
#pragma unroll
        for (int o = 1; o < 64; o <<= 1) { const int nb = __builtin_amdgcn_ds_bpermute((F.lane - o) << 2, v); if (F.lane >= o) v += nb; }
        tstart[F.lane + 1] = v; cnts[F.lane] = c;
        if (F.lane == 0) tstart[0] = 0;
        if (F.lane == 63) { tstart[65] = v + T / 256; cnts[64] = T; }
    }
    __syncthreads();
}
template <bool GATH> struct MoeSched2 {
    static constexpr bool GATHER = GATH, UNIFORMIZE = true, FP8 = GATH;
    static constexpr int ncol = GATH ? 2 : 4, K = GATH ? D / 2 : ED;
    const volatile LAS int* tstart; const volatile LAS int* cnts; int ntiles, G, c, lane;
    const char* Abase; const char* Wbase; const int* lists;
    __device__ __forceinline__ bool next(int i, pg8::UnitG& u) const {
        const int nwg = ntiles * ncol; const long L = (long)i * G + c; if (L >= nwg) return false;
        int wgid = (int)L; { const int q = nwg / 8, r = nwg % 8, xcd = wgid % 8, off = wgid / 8; wgid = (xcd < r ? xcd * (q + 1) : r * (q + 1) + (xcd - r) * q) + off; }
        const int tile = wgid / ncol, pn = wgid % ncol;
        const int ta = tstart[lane], tb = tstart[lane + 1];
        const unsigned long long mm = __ballot(ta <= tile && tile < tb);
        const int e = mm ? (int)__builtin_ctzll(mm) : 64;
        const int ts = __builtin_amdgcn_readfirstlane((int)tstart[e]), ce = __builtin_amdgcn_readfirstlane((int)cnts[e]);
        const int lt = tile - ts; int valid = ce - lt * 256; valid = valid > 256 ? 256 : valid;
        u.gshift = 0; u.aux = e;
        if (GATH) {
            u.B = Wbase + (size_t)e * WMOE_E_BYTES + (size_t)pn * 256 * K * 2;
            if (e < 64) { u.A = Abase; u.gidx = lists + (size_t)e * T + lt * 256; u.gcnt = valid; }
            else { u.A = Abase + (size_t)lt * 256 * K * 2; u.gidx = nullptr; u.gcnt = 0; }
            u.row0 = tile * 256; u.col0 = pn * 128;
        } else {
            u.B = Wbase + (size_t)e * WMOE_E_BYTES + (size_t)512 * 1024 * 2 + (size_t)pn * 256 * K * 2;
            u.A = Abase + (size_t)tile * 256 * K * 2; u.gidx = nullptr; u.gcnt = valid;
            u.row0 = tile * 256; u.col0 = pn * 256;
        }
        return true;
    }
};
__device__ __forceinline__ void phase_load_x(const Frame& F, KP p) {
    const float* xin = gin(p, 0); bf16* XB = (bf16*)(F.ws + WS_XB);
    for (size_t i = (size_t)F.vcu * NTHREADS + F.tid; i < (size_t)T * D / 8; i += (size_t)F.G * NTHREADS) {
        const f32x4 a = *(const f32x4*)(xin + i * 8), b = *(const f32x4*)(xin + i * 8 + 4);
        *(u32x4*)(XB + i * 8) = pack_bf16x8(a, b);
        u32x2 q8; q8.x = pk4_fp8(a[0], a[1], a[2], a[3]); q8.y = pk4_fp8(b[0], b[1], b[2], b[3]); *(u32x2*)((unsigned char*)(F.ws + WS_X) + i * 8) = q8; }
}

__global__ void __launch_bounds__(NTHREADS, 2) fwd_kernel(Params p_unused) {
    KP p0 = (KP)__builtin_amdgcn_kernarg_segment_ptr();
    extern __shared__ __attribute__((aligned(16))) unsigned char lds_raw[];
    Frame F0;
    F0.lds = (LAS unsigned char*)lds_raw; F0.MISC = (volatile LAS unsigned*)(F0.lds + MISC_OFF);
    F0.tid = threadIdx.x; F0.lane = F0.tid & 63; F0.wave = __builtin_amdgcn_readfirstlane(F0.tid >> 6);
    F0.G = gridDim.x; { const int bq = blockIdx.x; F0.vcu = (F0.G % 8 == 0) ? (bq % 8) * (F0.G / 8) + bq / 8 : bq; }
    F0.ws = p0->ws;
    const int bx0 = blockIdx.x;
    for (int u = F0.tid; u < (LDS_BYTES - MISC_OFF) / 4; u += NTHREADS) ((LAS unsigned*)(F0.lds + MISC_OFF))[u] = 0u;
    __syncthreads();
    XcdBarrier bar; bar.bar = (unsigned*)(p0->ws + WS_CTL) + CW_BAR; bar.x = 0; bar.st = nullptr;
    const int use_bar = p0->use_bar;
    if (use_bar) bar = xcd_barrier_post((unsigned*)(p0->ws + WS_CTL) + CW_BAR, F0.MISC + 8);
    const int lo = p0->ph_lo, hi = p0->ph_hi;
#define PHASE_BEGIN Frame F = F0; KP p = p0; { unsigned ones_ = ~0u; asm volatile("" : "+s"(ones_)); F.lane = (int)__builtin_amdgcn_mbcnt_hi(ones_, __builtin_amdgcn_mbcnt_lo(ones_, 0u)); } asm volatile("" : "+v"(F.lane)); F.tid = F.wave * 64 + F.lane; asm volatile("" : "+v"(F.tid));   GAS unsigned char* wsg_ = (GAS unsigned char*)F0.ws; asm volatile("" : "+s"(F.wave), "+s"(F.vcu), "+s"(F.G), "+s"(wsg_), "+s"(p)); \
    F.ws = (unsigned char*)wsg_; int bx = bx0; asm volatile("" : "+s"(bx)); unsigned char* ws = F.ws; (void)ws; (void)bx;
#pragma unroll 1
    for (int ph = lo; ph < hi; ++ph) {
        int layer = 0, type = 0;
        if (ph > 0) { layer = ph >= 26 ? 3 : (ph >= 18 ? 2 : (ph >= 9 ? 1 : 0)); const int q = ph - (layer == 3 ? 26 : (layer == 2 ? 18 : (layer == 1 ? 9 : 1))); const int kind = layer % 3;
            if (kind == 0) type = q < 4 ? 1 + q : 14 + (q - 4); else if (kind == 1) type = q < 5 ? 5 + q : 14 + (q - 5); else type = q < 4 ? 10 + q : 14 + (q - 4); }
        const int j = layer / 3;
#ifdef REPEAT_MASK
        const int nrep = ((REPEAT_MASK >> type) & 1u) ? 2 : 1;
#else
        const int nrep = 1;
#endif
#pragma unroll 1
        for (int rep = 0; rep < nrep; ++rep) {
        if (rep > 0 && use_bar) xcd_barrier(bar);
        if (PHT(0) && type == 0) { PHASE_BEGIN; phase_conv_mixers(F, p); phase_conv_moe(F, p, 0); phase_load_x(F, p); }
        else if (PHT(1) && type == 1) { PHASE_BEGIN; DenseSched8 S; S.init(ws + WS_X, ws + WS_ATT_IN_T + (size_t)j * ATT_IN * D, T, ATT_IN, D / 2, F.G, bx); EpiStoreBf16 E{(bf16*)(ws + WS_BIG), ATT_IN, WUP_INV, 0.08838834764831845f};
            pg8::gemm_phase(F.lds, F.tid, D / 2, S, E); }
        else if (PHT(2) && type == 2) { PHASE_BEGIN; phase_attn(F, bx); }
        else if (PHT(3) && type == 3) { PHASE_BEGIN; phase_attn_combine(F); }
        else if (PHT(4) && type == 4) { PHASE_BEGIN; DenseSched S; S.init(ws + WS_AUX + AUX_OB, ws + WS_ATT_OUT_T + (size_t)j * D * D * 2, T, D, D, F.G, bx); EpiResid E{(const bf16*)(ws + WS_XB), (bf16*)(ws + WS_Y)};
            pg8::gemm_phase(F.lds, F.tid, D, S, E); }
        else if (PHT(5) && type == 5) { PHASE_BEGIN; DenseSched8 S; S.init(ws + WS_X, ws + WS_RET_IN_T, T, RET_IN, D / 2, F.G, bx); EpiRetIn E{(bf16*)(ws + WS_BIG), RET_IN};
            pg8::gemm_phase(F.lds, F.tid, D / 2, S, E); }
        else if (PHT(6) && type == 6) { PHASE_BEGIN; phase_ret_u(F); }
        else if (PHT(7) && type == 7) { PHASE_BEGIN; phase_ret_scan(F); }
        else if (PHT(8) && type == 8) { PHASE_BEGIN; phase_ret_out(F, p); }
        else if (PHT(9) && type == 9) { PHASE_BEGIN; DenseSched S; S.init(ws + WS_BIG + BIG_YRET, ws + WS_RET_OUT_T, T, D, RET_V, F.G, bx); EpiResid E{(const bf16*)(ws + WS_XB), (bf16*)(ws + WS_Y)};
            pg8::gemm_phase(F.lds, F.tid, RET_V, S, E); }
        else if (PHT(10) && type == 10) { PHASE_BEGIN; phase_s5_scan<false>(F, p); }
        else if (PHT(11) && type == 11) { PHASE_BEGIN; phase_s5_carry(F, p); }
        else if (PHT(12) && type == 12) { PHASE_BEGIN; phase_s5_scan<true>(F, p); }
        else if (PHT(13) && type == 13) { PHASE_BEGIN; DenseSched S; S.init(ws + WS_AUX, ws + WS_GLU_T, T, 2 * D, D, F.G, bx); EpiGluResid E{(const bf16*)(ws + WS_XB), (bf16*)(ws + WS_Y)};
            pg8::gemm_phase(F.lds, F.tid, D, S, E); }
        else if (PHT(14) && type == 14) { PHASE_BEGIN; phase_lnr(F, p, layer, PROBE_DRY14 && true); if (PROBE_DRY14) { if (use_bar) xcd_barrier(bar); phase_lnr(F, p, layer, false); } }
        else if (PHT(15) && type == 15) { PHASE_BEGIN; moe_plan(F, layer);
            MoeSched2<true> S; S.tstart = (const volatile LAS int*)(F.MISC + PLAN_OFF); S.cnts = S.tstart + 72; S.ntiles = __builtin_amdgcn_readfirstlane((int)S.tstart[65]); S.G = F.G; S.c = bx; S.lane = F.lane;
            S.Abase = (const char*)(ws + WS_X); S.Wbase = (const char*)(ws + WS_WMOE); S.lists = (const int*)(ws + WS_LIST);
            EpiMoeUp E{(bf16*)(ws + WS_H)};
            pg8::gemm_phase(F.lds, F.tid, D / 2, S, E); }
        else if (PHT(16) && type == 16) { PHASE_BEGIN; moe_plan(F, layer);
            { MoeSched2<false> S; S.tstart = (const volatile LAS int*)(F.MISC + PLAN_OFF); S.cnts = S.tstart + 72; S.ntiles = __builtin_amdgcn_readfirstlane((int)S.tstart[64]); S.G = F.G; S.c = bx; S.lane = F.lane;
              S.Abase = (const char*)(ws + WS_H); S.Wbase = (const char*)(ws + WS_WMOE); S.lists = (const int*)(ws + WS_LIST);
              EpiStoreFp8 E{(unsigned char*)(ws + WS_BIG), D};
              pg8::gemm_phase(F.lds, F.tid, ED, S, E); }
            { const int sh0 = __builtin_amdgcn_readfirstlane((int)((const volatile LAS int*)(F.MISC + PLAN_OFF))[64]);
              DenseSched S; S.init(ws + WS_H + (size_t)sh0 * 256 * ED * 2, ws + WS_WMOE + (size_t)64 * WMOE_E_BYTES + (size_t)512 * 1024 * 2, T, D, ED, F.G, bx); EpiResid E{(const bf16*)(ws + WS_XB), (bf16*)(ws + WS_Y)};
              pg8::gemm_phase(F.lds, F.tid, ED, S, E); } }
        else if (PHT(17) && type == 17) { PHASE_BEGIN; moe_plan(F, layer); if (PROBE_DRY17) { phase_combine(F, p, layer, true); if (use_bar) xcd_barrier(bar); } phase_combine(F, p, layer); if (layer + 1 < DEPTH) phase_conv_moe(F, p, layer + 1); }
        }
        if (use_bar && ph + 1 < hi) xcd_barrier(bar);
    }
}

#ifndef MK_PER_PHASE
#define MK_PER_PHASE 0
#endif
extern "C" void kernel_launch(void* const* d_in, const int* in_sizes, int n_in, void* d_out, int out_size, void* d_ws, size_t ws_size, hipStream_t stream) {
    static int grid = 0;
    if (grid == 0) {
        if (n_in != 26 || in_sizes[0] != T * D || out_size != T * D || ws_size < WS_END) { fprintf(stderr, "kernel_launch: unexpected shapes / workspace (n_in %d, in0 %d, out %d, ws %zu < %zu)\n", n_in, n_in > 0 ? in_sizes[0] : -1, out_size, ws_size, (size_t)WS_END); grid = -1; return; }
        int dev = 0, cus = 0, per_cu = 0;
        if (hipGetDevice(&dev) != hipSuccess || hipDeviceGetAttribute(&cus, hipDeviceAttributeMultiprocessorCount, dev) != hipSuccess) { grid = -1; return; }
        if (hipFuncSetAttribute((const void*)fwd_kernel, hipFuncAttributeMaxDynamicSharedMemorySize, LDS_BYTES) != hipSuccess) { fprintf(stderr, "kernel_launch: hipFuncSetAttribute failed\n"); grid = -1; return; }
        if (hipOccupancyMaxActiveBlocksPerMultiprocessor(&per_cu, (const void*)fwd_kernel, NTHREADS, LDS_BYTES) != hipSuccess || per_cu < 1) { fprintf(stderr, "kernel_launch: occupancy query says %d blocks per CU\n", per_cu); per_cu = 1; }
        (void)hipGetLastError();
        grid = cus;
    }
    if (grid < 0) return;
    (void)hipMemsetAsync((char*)d_ws + WS_CTL, 0, CTL_ZERO_BYTES, stream);
    Params p{};
    for (int i = 0; i < 26; ++i) p.in[i] = (const float*)d_in[i];
    p.out = (float*)d_out; p.ws = (unsigned char*)d_ws;
#if MK_PER_PHASE
    for (int k = 0; k < NPHASES; ++k) { p.ph_lo = k; p.ph_hi = k + 1; p.use_bar = 0; hipLaunchKernelGGL(fwd_kernel, dim3(grid), dim3(NTHREADS), LDS_BYTES, stream, p); }
#else
    p.ph_lo = 0; p.ph_hi = NPHASES; p.use_bar = 1;
    hipLaunchKernelGGL(fwd_kernel, dim3(grid), dim3(NTHREADS), LDS_BYTES, stream, p);
#endif
}
```

```cpp
#include <hip/hip_runtime.h>
#include <cstdio>
#include <cstdint>

#define LAS __attribute__((address_space(3)))
#define GAS __attribute__((address_space(1)))
typedef unsigned short bf16;
typedef short bf16x8 __attribute__((ext_vector_type(8)));
typedef short bf16x4 __attribute__((ext_vector_type(4)));
typedef float f32x4 __attribute__((ext_vector_type(4)));
typedef float f32x2 __attribute__((ext_vector_type(2)));
typedef unsigned u32x4 __attribute__((ext_vector_type(4)));
typedef unsigned u32x2 __attribute__((ext_vector_type(2)));
typedef GAS unsigned gu32;

constexpr int D = 1024, BATCH = 2, SEQ = 8192, T = BATCH * SEQ, DEPTH = 4;
constexpr int AH = 8, AHD = 128, ATT_IN = 9216;
constexpr int RH = 4, RDK = 256, RDV = 512, RET_IN = 6144, RET_V = 2048, RC = 128, RNC = SEQ / RC;
constexpr int SG = 64, SGC = 16, SP = 64;
constexpr int NE = 64, TOPK = 8, NEG = 8, ED = 256, NSLOT = 9;
constexpr float LN_EPS = 1e-5f;
constexpr float ALPHA = 1.6817928305074292f;
constexpr int NWAVES = 8, NTHREADS = 512;

__device__ __forceinline__ unsigned f2bf(float f) { unsigned u = __builtin_bit_cast(unsigned, f); return (u + 0x7fffu + ((u >> 16) & 1u)) >> 16; }
__device__ __forceinline__ unsigned pk2(float lo, float hi) { unsigned r; asm("s_nop 1\n\tv_cvt_pk_bf16_f32 %0, %1, %2" : "=v"(r) : "v"(lo), "v"(hi)); return r; }
__device__ __forceinline__ unsigned pk2sw(float lo, float hi) { return f2bf(lo) | (f2bf(hi) << 16); }
__device__ __forceinline__ unsigned pk2hw(float lo, float hi) { unsigned r; asm volatile("v_cvt_pk_bf16_f32 %0, %1, %2" : "=v"(r) : "v"(lo), "v"(hi)); return r; }
__device__ __forceinline__ float bf2f(unsigned b) { return __builtin_bit_cast(float, b << 16); }
__device__ __forceinline__ float bflo(unsigned w) { return __builtin_bit_cast(float, w << 16); }
__device__ __forceinline__ float bfhi(unsigned w) { return __builtin_bit_cast(float, w & 0xffff0000u); }
__device__ __forceinline__ float shx(float v, int m, int lane) { return __builtin_bit_cast(float, __builtin_amdgcn_ds_bpermute((lane ^ m) << 2, __builtin_bit_cast(int, v))); }
__device__ __forceinline__ int shx_i(int v, int m, int lane) { return __builtin_amdgcn_ds_bpermute((lane ^ m) << 2, v); }
__device__ __forceinline__ float rdl(float v, int src) { return __builtin_bit_cast(float, __builtin_amdgcn_readlane(__builtin_bit_cast(int, v), src)); }
template <int CTRL, int RM = 0xf, int BM = 0xf> __device__ __forceinline__ float dpp0(float v) { return __builtin_bit_cast(float, __builtin_amdgcn_update_dpp(0, __builtin_bit_cast(int, v), CTRL, RM, BM, true)); }
template <int CTRL, int RM = 0xf, int BM = 0xf> __device__ __forceinline__ float dppo(float old, float v) { return __builtin_bit_cast(float, __builtin_amdgcn_update_dpp(__builtin_bit_cast(int, old), __builtin_bit_cast(int, v), CTRL, RM, BM, false)); }
__device__ __forceinline__ float wave_sum(float v, int lane) {
    (void)lane;
    v += dpp0<0x111>(v); v += dpp0<0x112>(v); v += dpp0<0x114>(v); v += dpp0<0x118>(v);
    v += dpp0<0x142, 0xa>(v);
    v += dpp0<0x143, 0xc>(v);
    return rdl(v, 63);
}
__device__ __forceinline__ float max8(float v) {
    v = fmaxf(v, dppo<0xb1>(v, v)); v = fmaxf(v, dppo<0x4e>(v, v)); v = fmaxf(v, dppo<0x141>(v, v)); return v;
}
#define LDS_WAIT() asm volatile("s_waitcnt lgkmcnt(0)" ::: "memory")
#define VM_WAIT() asm volatile("s_waitcnt vmcnt(0)" ::: "memory")
__device__ __forceinline__ const char* rfl_ptr(const char* p) {
    unsigned long long v = (unsigned long long)p; unsigned lo = __builtin_amdgcn_readfirstlane((unsigned)v), hi = __builtin_amdgcn_readfirstlane((unsigned)(v >> 32));
    return (const char*)(((unsigned long long)hi << 32) | lo);
}
__device__ __forceinline__ bf16x8 row_frag(const LAS bf16* base, int ld, int row0, int col0, int lane) {
    return *(const LAS bf16x8*)(base + (row0 + (lane & 15)) * ld + col0 + 8 * (lane >> 4));
}
__device__ __forceinline__ bf16x4 tr4(const LAS bf16* addr) { return __builtin_amdgcn_ds_read_tr16_b64_v4i16((LAS bf16x4*)addr); }
__device__ __forceinline__ bf16x8 cat8(bf16x4 a, bf16x4 b) { bf16x8 r; r[0] = a[0]; r[1] = a[1]; r[2] = a[2]; r[3] = a[3]; r[4] = b[0]; r[5] = b[1]; r[6] = b[2]; r[7] = b[3]; return r; }
#define MFMA16(a, b, c) __builtin_amdgcn_mfma_f32_16x16x32_bf16((a), (b), (c), 0, 0, 0)
__device__ __forceinline__ bf16x8 pack8(f32x4 a, f32x4 b) {
    u32x4 w; w.x = pk2(a[0], a[1]); w.y = pk2(a[2], a[3]); w.z = pk2(b[0], b[1]); w.w = pk2(b[2], b[3]); return __builtin_bit_cast(bf16x8, w);
}

namespace pg8 {
typedef int v4i_t __attribute__((ext_vector_type(4)));
typedef int v8i_t __attribute__((ext_vector_type(8)));
constexpr int BM = 256, BK = 64, HALF = 128, HTB = HALF * BK * 2, STAGE_BYTES = 8 * HTB;
__device__ __forceinline__ int lds_byte(int r, int c) { const int st = (r >> 4) * 2 + (c >> 5), rr = r & 15, cc = c & 31, ob = rr * 64 + cc * 2; return st * 1024 + (ob ^ (((ob >> 9) & 1) << 5)); }
__device__ __forceinline__ void stage_rc(int b, int& R, int& C) { const int st = b / 1024, sb = b % 1024, swz = sb ^ (((sb >> 9) & 1) << 5); R = (st >> 1) * 16 + swz / 64; C = (st & 1) * 32 + (swz % 64) / 2; }
__device__ __forceinline__ int perm32(int rho) { const int n = rho >> 4, i = rho & 15; return 8 * (i >> 2) + 4 * n + (i & 3); }

struct UnitG {
    const char* A;
    const char* B;
    const int* gidx;
    int gcnt, gshift;
    int row0, col0;
    int aux;
};

__device__ __forceinline__ void uniformize(UnitG& u) { u.A = rfl_ptr(u.A); u.B = rfl_ptr(u.B); u.gidx = (const int*)rfl_ptr((const char*)u.gidx); u.gcnt = __builtin_amdgcn_readfirstlane(u.gcnt); u.gshift = __builtin_amdgcn_readfirstlane(u.gshift);
    u.row0 = __builtin_amdgcn_readfirstlane(u.row0); u.col0 = __builtin_amdgcn_readfirstlane(u.col0); u.aux = __builtin_amdgcn_readfirstlane(u.aux); }
template <class Epi, class Sched>
__device__ __forceinline__ void gemm_phase(LAS unsigned char* lds, const int tid, const int K, const Sched& S, const Epi& E) {
    constexpr bool F8 = Sched::FP8;
    constexpr bool GATHER = Sched::GATHER;
    const int wid = __builtin_amdgcn_readfirstlane(tid >> 6), lane = tid & 63, wr = wid >> 2, wc = wid & 3, fr = lane & 15, fq = lane >> 4;
    const int nt = K / BK;
    constexpr bool P16 = Epi::PERM16;
    unsigned voffB[2], voffB1[2], vA[2][2];
#pragma unroll
    for (int i = 0; i < 2; ++i) { int R, C; stage_rc(tid * 16 + i * 8192, R, C); const int Rb = Epi::PERM ? ((R & ~31) + perm32(R & 31)) : R; voffB[i] = (unsigned)(Rb * K + C) * 2u; voffB1[i] = voffB[i]; vA[0][i] = (unsigned)(R * K + C) * 2u; vA[1][i] = vA[0][i];
        if constexpr (P16) { const int x = R & 31, src = 64 * (R >> 5) + 16 * ((x >> 2) & 3) + 4 * (x >> 4) + (x & 3); voffB[i] = (unsigned)(src * K + C) * 2u; voffB1[i] = (unsigned)((src + 8) * K + C) * 2u; } }
    const size_t kstep = (size_t)(BK * 2);
    const size_t hstep = (size_t)HALF * K * 2;
    const size_t hstepB = P16 ? 0 : hstep;
    const size_t hstepA = GATHER ? 0 : hstep;
    const unsigned ldsw = (unsigned)wid * 1024u;
    const int aoff = F8 ? lds_byte(wr * 64 + fr, fq * 16) : lds_byte(wr * 64 + fr, fq * 8), boff = F8 ? lds_byte(wc * 32 + fr, fq * 16) : lds_byte(wc * 32 + fr, fq * 8);
    LAS u32x4* park = (LAS u32x4*)(lds + STAGE_BYTES) + tid;
#define PG8_SA(b, h) (((b) * 2 + (h)) * HTB)
#define PG8_SB(b, h) ((4 + (b) * 2 + (h)) * HTB)
#define PG8_STAGE(bufoff, gbase, voff) do { _Pragma("unroll") for (int _i = 0; _i < 2; ++_i) { asm volatile("" : "+v"((voff)[_i]));   \
        __builtin_amdgcn_global_load_lds((const unsigned*)((const char*)(gbase) + (voff)[_i]), (LAS unsigned*)(lds + (bufoff) + ldsw + _i * 8192), 16, 0, 0); } } while (0)
    constexpr int FKS = F8 ? 16 : 1024;
#define PG8_LD2(p_) __builtin_shufflevector(*(const LAS v4i_t*)(p_), *(const LAS v4i_t*)((p_) + FKS), 0, 1, 2, 3, 4, 5, 6, 7)
#define PG8_LDA(dst, b, h) do { _Pragma("unroll") for (int m = 0; m < 4; ++m) dst[m] = PG8_LD2(lds + PG8_SA(b, h) + aoff + m * 2048); } while (0)
#define PG8_LDB(dst, b, h) do { _Pragma("unroll") for (int n = 0; n < 2; ++n) dst[n] = PG8_LD2(lds + PG8_SB(b, h) + boff + n * 2048); } while (0)
#define PG8_LO(v) __builtin_bit_cast(bf16x8, __builtin_shufflevector((v), (v), 0, 1, 2, 3))
#define PG8_HI(v) __builtin_bit_cast(bf16x8, __builtin_shufflevector((v), (v), 4, 5, 6, 7))
#define PG8_MMA(ai, bj, At, Bt) do { __builtin_amdgcn_s_setprio(1); _Pragma("unroll") for (int m = 0; m < 4; ++m) _Pragma("unroll") for (int n = 0; n < 2; ++n) { \
        if constexpr (F8) { acc[ai][bj][m][n] = __builtin_amdgcn_mfma_scale_f32_16x16x128_f8f6f4(Bt[n], At[m], acc[ai][bj][m][n], 0, 0, 0, 0x7F7F7F7F, 0, 0x7F7F7F7F); } \
        else { acc[ai][bj][m][n] = __builtin_amdgcn_mfma_f32_16x16x32_bf16(PG8_LO(Bt[n]), PG8_LO(At[m]), acc[ai][bj][m][n], 0, 0, 0); \
               acc[ai][bj][m][n] = __builtin_amdgcn_mfma_f32_16x16x32_bf16(PG8_HI(Bt[n]), PG8_HI(At[m]), acc[ai][bj][m][n], 0, 0, 0); } } __builtin_amdgcn_s_setprio(0); } while (0)
#define PG8_WAIT_V(n) asm volatile("s_waitcnt vmcnt(" #n ")" ::: "memory")
#define PG8_WAIT_L(n) asm volatile("s_waitcnt lgkmcnt(" #n ")" ::: "memory")
#define PG8_BAR __builtin_amdgcn_s_barrier()
#define PG8_SCHED __builtin_amdgcn_sched_barrier(0)
#define PG8_VOFF(u, v00, v01, v10, v11) do { int _R0, _C0, _R1, _C1; stage_rc(tid * 16, _R0, _C0); stage_rc(tid * 16 + 8192, _R1, _C1); int _r00 = _R0, _r01 = _R1, _r10 = HALF + _R0, _r11 = HALF + _R1; \
        if ((u).gidx) { const int _a = _r00 < (u).gcnt ? ((const GAS int*)(u).gidx)[_r00] >> (u).gshift : 0, _b = _r01 < (u).gcnt ? ((const GAS int*)(u).gidx)[_r01] >> (u).gshift : 0, _c = _r10 < (u).gcnt ? ((const GAS int*)(u).gidx)[_r10] >> (u).gshift : 0, _d = _r11 < (u).gcnt ? ((const GAS int*)(u).gidx)[_r11] >> (u).gshift : 0; \
            _r00 = _a; _r01 = _b; _r10 = _c; _r11 = _d; } \
        v00 = (unsigned)(_r00 * K + _C0) * 2u; v01 = (unsigned)(_r01 * K + _C1) * 2u; v10 = (unsigned)(_r10 * K + _C0) * 2u; v11 = (unsigned)(_r11 * K + _C1) * 2u; } while (0)
    UnitG cur, nxt; int ui = 0;
    if (!S.next(0, cur)) return;
    if constexpr (Sched::UNIFORMIZE) uniformize(cur);
    f32x4 acc[2][2][4][2];
#pragma unroll
    for (int a = 0; a < 2; ++a)
#pragma unroll
        for (int b = 0; b < 2; ++b)
#pragma unroll
            for (int m = 0; m < 4; ++m)
#pragma unroll
                for (int n = 0; n < 2; ++n) acc[a][b][m][n] = (f32x4){0.f, 0.f, 0.f, 0.f};
    v8i_t At[4], B0[2], B1[2];
    if constexpr (GATHER) PG8_VOFF(cur, vA[0][0], vA[0][1], vA[1][0], vA[1][1]);
    const char* cA = cur.A; const char* cB = cur.B;
    PG8_STAGE(PG8_SB(0, 0), cB, voffB); PG8_STAGE(PG8_SB(0, 1), cB + hstepB, voffB1); PG8_STAGE(PG8_SA(0, 0), cA, vA[0]); PG8_STAGE(PG8_SA(0, 1), cA + hstepA, vA[1]);
    if (wr == 1) PG8_BAR;
    PG8_WAIT_V(2); PG8_BAR;
    PG8_STAGE(PG8_SB(1, 0), cB + kstep, voffB); PG8_STAGE(PG8_SA(1, 0), cA + kstep, vA[0]); PG8_STAGE(PG8_SB(1, 1), cB + hstepB + kstep, voffB1);
    PG8_WAIT_V(6); PG8_BAR;
    for (;;) {
        const bool has_next = S.next(ui + 1, nxt);
        if constexpr (Sched::UNIFORMIZE) { if (has_next) uniformize(nxt); }
        const char* nA = cA; const char* nB = cB;
        if (has_next) { nA = nxt.A; nB = nxt.B; }
        if constexpr (GATHER) { u32x4 pv; pv.x = vA[0][0]; pv.y = vA[0][1]; pv.z = vA[1][0]; pv.w = vA[1][1];
            if (has_next) PG8_VOFF(nxt, pv.x, pv.y, pv.z, pv.w);
            *park = pv; }
#pragma unroll 1
        for (int t = 0; t < nt; t += 2) {
            const bool last = (t == nt - 2);
            const char* a1 = cA + (size_t)(t + 1) * kstep;
            const char* a2 = last ? nA : cA + (size_t)(t + 2) * kstep; const char* b2 = last ? nB : cB + (size_t)(t + 2) * kstep;
            const char* a3 = a2 + kstep; const char* b3 = b2 + kstep;
            PG8_LDB(B0, 0, 0); PG8_LDB(B1, 0, 1); PG8_SCHED; PG8_LDA(At, 0, 0); PG8_STAGE(PG8_SA(1, 1), a1 + hstepA, vA[1]);
            PG8_WAIT_V(8); PG8_WAIT_L(0); PG8_BAR; PG8_MMA(0, 0, At, B0); PG8_MMA(0, 1, At, B1); PG8_BAR; PG8_SCHED;
            if constexpr (GATHER) { if (last) { const u32x4 pv = *park; vA[0][0] = pv.x; vA[0][1] = pv.y; vA[1][0] = pv.z; vA[1][1] = pv.w; } }
            PG8_LDA(At, 0, 1); PG8_STAGE(PG8_SB(0, 0), b2, voffB); PG8_STAGE(PG8_SB(0, 1), b2 + hstepB, voffB1); PG8_STAGE(PG8_SA(0, 0), a2, vA[0]);
            PG8_WAIT_V(8); PG8_WAIT_L(0); PG8_BAR; PG8_MMA(1, 0, At, B0); PG8_MMA(1, 1, At, B1); PG8_BAR; PG8_SCHED;
            PG8_LDB(B0, 1, 0); PG8_LDB(B1, 1, 1); PG8_SCHED; PG8_LDA(At, 1, 0); PG8_STAGE(PG8_SA(0, 1), a2 + hstepA, vA[1]);
            PG8_WAIT_V(8); PG8_WAIT_L(0); PG8_BAR; PG8_MMA(0, 0, At, B0); PG8_MMA(0, 1, At, B1); PG8_BAR; PG8_SCHED;
            PG8_LDA(At, 1, 1); PG8_STAGE(PG8_SB(1, 0), b3, voffB); PG8_STAGE(PG8_SB(1, 1), b3 + hstepB, voffB1); PG8_STAGE(PG8_SA(1, 0), a3, vA[0]);
            PG8_WAIT_V(8); PG8_WAIT_L(0); PG8_BAR; PG8_MMA(1, 0, At, B0); PG8_MMA(1, 1, At, B1); PG8_BAR; PG8_SCHED;
        }
        if (wr == 0) PG8_BAR;
        E(acc, cur, wr, wc, fr, fq);
        if (!has_next) break;
#pragma unroll
        for (int a = 0; a < 2; ++a)
#pragma unroll
            for (int b = 0; b < 2; ++b)
#pragma unroll
                for (int m = 0; m < 4; ++m)
#pragma unroll
                    for (int n = 0; n < 2; ++n) acc[a][b][m][n] = (f32x4){0.f, 0.f, 0.f, 0.f};
        cur = nxt; cA = nA; cB = nB; ++ui;
        if (wr == 1) PG8_BAR;
    }
    PG8_WAIT_V(0);
    PG8_BAR;
#undef PG8_SA
#undef PG8_SB
#undef PG8_STAGE
#undef PG8_LDA
#undef PG8_LDB
#undef PG8_LD2
#undef PG8_LO
#undef PG8_HI
#undef PG8_MMA
#undef PG8_WAIT_V
#undef PG8_WAIT_L
#undef PG8_BAR
#undef PG8_SCHED
#undef PG8_VOFF
}
}

constexpr size_t MiB = 1u << 20;
constexpr size_t WS_CTL = 0, CTL_ZERO_BYTES = 1 * MiB;
constexpr size_t WS_ATT_IN_T = 1 * MiB;
constexpr size_t WS_ATT_OUT_T = WS_ATT_IN_T + 36 * MiB;
constexpr size_t WS_RET_IN_T = WS_ATT_OUT_T + 4 * MiB;
constexpr size_t WS_RET_OUT_T = WS_RET_IN_T + 12 * MiB;
constexpr size_t WS_GLU_T = WS_RET_OUT_T + 4 * MiB;
constexpr size_t WS_RT_HI = WS_GLU_T + 4 * MiB;
constexpr size_t WS_RT_LO = WS_RT_HI + 512 * 1024;
constexpr size_t WS_WMOE = WS_RT_HI + 1 * MiB;
constexpr size_t WMOE_E_BYTES = (size_t)(512 * 1024 + 1024 * 256) * 2;
constexpr size_t WS_X = WS_WMOE + 98 * MiB;
constexpr size_t WS_Y = WS_X + 64 * MiB;
constexpr size_t WS_XB = WS_Y + 64 * MiB;
constexpr size_t WS_BIG = WS_XB + 32 * MiB;
constexpr size_t WS_AUX = WS_BIG + 288 * MiB;
constexpr size_t WS_H = WS_AUX + 160 * MiB;
constexpr size_t WS_LIST = WS_H + 80 * MiB;
constexpr size_t WS_TRASH = WS_LIST + 8 * MiB;
constexpr size_t WS_END = WS_TRASH + 1 * MiB;
static_assert(WS_END <= 1024 * MiB, "workspace map");
constexpr int CW_BAR = 4096;
constexpr int CW_CNT = 16384;
constexpr int CW_CHK = 65536;
constexpr int HROWS = 163840;

#define XB_TMO      128
#define XB_XCNT(j)  (256  + 64 * (j))
#define XB_XSUB(j)  (1280 + 64 * (j))
#define XB_XGEN(j)  (2304 + 64 * (j))
#define XB_TOP      3328
#define XB_TOPGEN   3392
#define XCD_BAR_WORDS 3456
#define XB_SPIN_CAP (1u << 20)
__device__ __forceinline__ unsigned xb_ld(unsigned* p)              { return __hip_atomic_load(p, __ATOMIC_RELAXED, __HIP_MEMORY_SCOPE_AGENT); }
__device__ __forceinline__ unsigned xb_add(unsigned* p, unsigned v) { return __hip_atomic_fetch_add(p, v, __ATOMIC_RELAXED, __HIP_MEMORY_SCOPE_AGENT); }
__device__ __forceinline__ unsigned xb_xcc_id() { return (unsigned)__builtin_amdgcn_s_getreg((3 << 11) | 20) & 0xFu; }
#define XB_SPIN(cond, bar) do { unsigned _sp = 0; while (cond) { __builtin_amdgcn_s_sleep(1); \
    if ((++_sp & 255u) == 0u) { if (xb_ld(&(bar)[XB_TMO])) break; if (_sp > XB_SPIN_CAP) { atomicAdd(&(bar)[XB_TMO], 1u); break; } } } } while (0)
struct XcdBarrier { unsigned* bar; unsigned x; volatile LAS unsigned* st; };
__device__ __forceinline__ XcdBarrier xcd_barrier_post(unsigned* bar, volatile LAS unsigned* st) {
    XcdBarrier b; b.bar = bar; b.x = xb_xcc_id(); b.st = st;
    if (threadIdx.x == 0) (void)xb_add(&bar[XB_XCNT(b.x)], 1u);
    return b;
}
__device__ __forceinline__ void xcd_barrier_complete(unsigned* bar, unsigned x, unsigned& nloc, unsigned& nx) {
    const unsigned G = gridDim.x * gridDim.y * gridDim.z;
    unsigned sum, cnt, mine, sp = 0u;
    for (;;) {
        sum = 0u; cnt = 0u; mine = 0u;
#pragma unroll
        for (unsigned j = 0; j < 16; ++j) { const unsigned c = xb_ld(&bar[XB_XCNT(j)]); sum += c; cnt += (c > 0u) ? 1u : 0u; mine = (j == x) ? c : mine; }
        if (sum == G) break;
        __builtin_amdgcn_s_sleep(1);
        if ((++sp & 255u) == 0u) { if (xb_ld(&bar[XB_TMO])) break; if (sp > XB_SPIN_CAP) { atomicAdd(&bar[XB_TMO], 1u); break; } }
    }
    nloc = mine > 0u ? mine : 1u; nx = cnt > 0u ? cnt : 1u;
}
__device__ __forceinline__ void xcd_barrier(const XcdBarrier& b) {
    asm volatile("s_waitcnt vmcnt(0)" ::: "memory");
    __syncthreads();
    if (threadIdx.x == 0) {
        unsigned* bar = b.bar;
        __builtin_amdgcn_s_waitcnt(0);
        unsigned nloc = b.st[0], nx = b.st[1];
        if (nloc == 0u) { xcd_barrier_complete(bar, b.x, nloc, nx); b.st[0] = nloc; b.st[1] = nx; }
        const unsigned old = xb_add(&bar[XB_XSUB(b.x)], 1u);
        const unsigned gen = old / nloc;
        if (old + 1u == (gen + 1u) * nloc) {
            __builtin_amdgcn_fence(__ATOMIC_RELEASE, "agent");
            asm volatile("s_waitcnt vmcnt(0)" ::: "memory");
            const unsigned og = xb_add(&bar[XB_TOP], 1u);
            const unsigned tg = og / nx;
            if (og + 1u == (tg + 1u) * nx) xb_add(&bar[XB_TOPGEN], 1u);
            else XB_SPIN(xb_ld(&bar[XB_TOPGEN]) == tg, bar);
            __builtin_amdgcn_fence(__ATOMIC_ACQUIRE, "agent");
            xb_add(&bar[XB_XGEN(b.x)], 1u);
            asm volatile("s_waitcnt vmcnt(0)" ::: "memory");
        } else {
            XB_SPIN(xb_ld(&bar[XB_XGEN(b.x)]) == gen, bar);
            __builtin_amdgcn_fence(__ATOMIC_ACQUIRE, "agent");
            asm volatile("s_waitcnt vmcnt(0)" ::: "memory");
        }
    }
    __syncthreads();
}

constexpr int RING_BYTES = 139264;
constexpr int MISC_OFF = RING_BYTES;
constexpr int LDS_BYTES = 147456;
struct Params {
    const float* in[26]; float* out; unsigned char* ws; int ph_lo, ph_hi; int use_bar, pad;
};
typedef const __attribute__((address_space(4))) Params* KP;
__device__ __forceinline__ const float* gin(KP p, int i) { return (const float*)(const GAS float*)p->in[i]; }
__device__ __forceinline__ float* gout(KP p) { return (float*)(GAS float*)p->out; }
struct Frame {
    LAS unsigned char* lds; volatile LAS unsigned* MISC;
    int tid, lane, wave, vcu, G;
    unsigned char* ws;
};

template <bool F8_ = false> struct DenseSchedT {
    static constexpr bool GATHER = false, UNIFORMIZE = false, FP8 = F8_;
    const char* A; const char* Bt; int K, nM, nN, nwg, G, c;
    __device__ __forceinline__ void init(const void* A_, const void* Bt_, int M, int N, int K_, int G_, int c_) { A = (const char*)A_; Bt = (const char*)Bt_; K = K_; nM = M / 256; nN = N / 256; nwg = nM * nN; G = G_; c = c_; }
    __device__ __forceinline__ bool next(int i, pg8::UnitG& u) const {
        const long L = (long)i * G + c; if (L >= nwg) return false;
        int wgid = (int)L; { const int q = nwg / 8, r = nwg % 8, xcd = wgid % 8, off = wgid / 8; wgid = (xcd < r ? xcd * (q + 1) : r * (q + 1) + (xcd - r) * q) + off; }
        const int nig = 8 * nN, gid = wgid / nig, fm = gid * 8, gsz = (nM - fm) < 8 ? (nM - fm) : 8;
        const int pm = fm + ((wgid % nig) % gsz), pn = (wgid % nig) / gsz;
        u.A = A + (size_t)pm * 256 * K * 2; u.B = Bt + (size_t)pn * 256 * K * 2; u.gidx = nullptr; u.gcnt = 0; u.gshift = 0; u.row0 = pm * 256; u.col0 = pn * 256; u.aux = 0; return true;
    }
};
typedef DenseSchedT<false> DenseSched; typedef DenseSchedT<true> DenseSched8;
__device__ __forceinline__ u32x4 pack_bf16x8(const f32x4& v0, const f32x4& v1) { u32x4 w; w.x = pk2hw(v0[0], v0[1]); w.y = pk2hw(v0[2], v0[3]); w.z = pk2hw(v1[0], v1[1]); w.w = pk2hw(v1[2], v1[3]); return w; }

constexpr float WUP_SCALE = 32.0f, WUP_INV = 1.0f / 32.0f;
struct EpiStoreBf16 {
    static constexpr bool PERM = true, PERM16 = false;
    bf16* O; int ldc; float osc, qsc;
    __device__ __forceinline__ void operator()(const f32x4 (&acc)[2][2][4][2], const pg8::UnitG& u, int wr, int wc, int fr, int fq) const {
        const float sc = ((u.col0 % 3072) < 1024) ? osc * qsc : osc;
#pragma unroll
        for (int ai = 0; ai < 2; ++ai)
#pragma unroll
            for (int m = 0; m < 4; ++m) { bf16* rowp = O + (size_t)(u.row0 + ai * 128 + wr * 64 + m * 16 + fr) * ldc + u.col0 + wc * 32 + 8 * fq;
#pragma unroll
                for (int bj = 0; bj < 2; ++bj) *(u32x4*)(rowp + bj * 128) = pack_bf16x8(acc[ai][bj][m][0] * sc, acc[ai][bj][m][1] * sc); }
    }
};
constexpr float YEXP_SCALE = 32.0f, YEXP_INV = 1.0f / 32.0f;
struct EpiStoreFp8 {
    static constexpr bool PERM = false, PERM16 = true;
    unsigned char* O; int ldc;
    __device__ __forceinline__ void operator()(const f32x4 (&acc)[2][2][4][2], const pg8::UnitG& u, int wr, int wc, int fr, int fq) const {
#pragma unroll
        for (int ai = 0; ai < 2; ++ai)
#pragma unroll
            for (int m = 0; m < 4; ++m) { unsigned char* rowp = O + (size_t)(u.row0 + ai * 128 + wr * 64 + m * 16 + fr) * ldc + u.col0 + wc * 64 + 16 * fq;
                u32x4 w;
#pragma unroll
                for (int q = 0; q < 4; ++q) { f32x4 v = acc[ai][q >> 1][m][q & 1] * YEXP_SCALE;
#pragma unroll
                    for (int j = 0; j < 4; ++j) v[j] = fminf(fmaxf(v[j], -448.0f), 448.0f);
                    int d = 0; d = __builtin_amdgcn_cvt_pk_fp8_f32(v[0], v[1], d, false); d = __builtin_amdgcn_cvt_pk_fp8_f32(v[2], v[3], d, true); w[q] = (unsigned)d; }
                *(u32x4*)rowp = w; }
    }
};
struct EpiRetIn {
    static constexpr bool PERM = true, PERM16 = false;
    bf16* O; int ldc;
    __device__ __forceinline__ void operator()(const f32x4 (&acc)[2][2][4][2], const pg8::UnitG& u, int wr, int wc, int fr, int fq) const {
        float l2g = 0.f;
        float cs = WUP_INV;
        if (u.col0 < 2048) { const int h = (u.col0 & 1023) >> 8; const float g = 1.0f - exp2f(-5.0f - (float)h); l2g = log2f(g); if (u.col0 >= 1024) { l2g = -l2g; cs *= 0.0625f; } }
#pragma unroll
        for (int ai = 0; ai < 2; ++ai)
#pragma unroll
            for (int m = 0; m < 4; ++m) { const int row = u.row0 + ai * 128 + wr * 64 + m * 16 + fr; const float sc = exp2f(l2g * (float)(row & 127)) * cs;
                bf16* rowp = O + (size_t)row * ldc + u.col0 + wc * 32 + 8 * fq;
#pragma unroll
                for (int bj = 0; bj < 2; ++bj) *(u32x4*)(rowp + bj * 128) = pack_bf16x8(acc[ai][bj][m][0] * sc, acc[ai][bj][m][1] * sc); }
    }
};
__device__ __forceinline__ void unpack_bf16x8(const u32x4& w, f32x4& a, f32x4& b) { a[0] = bflo(w.x); a[1] = bfhi(w.x); a[2] = bflo(w.y); a[3] = bfhi(w.y); b[0] = bflo(w.z); b[1] = bfhi(w.z); b[2] = bflo(w.w); b[3] = bfhi(w.w); }
struct EpiResid {
    static constexpr bool PERM = true, PERM16 = false;
    const bf16* X; bf16* Y;
    __device__ __forceinline__ void operator()(const f32x4 (&acc)[2][2][4][2], const pg8::UnitG& u, int wr, int wc, int fr, int fq) const {
#pragma unroll
        for (int ai = 0; ai < 2; ++ai)
#pragma unroll
            for (int m = 0; m < 4; ++m) { const size_t off = (size_t)(u.row0 + ai * 128 + wr * 64 + m * 16 + fr) * D + u.col0 + wc * 32 + 8 * fq;
#pragma unroll
                for (int bj = 0; bj < 2; ++bj) { const u32x4 xw = *(const u32x4*)(X + off + bj * 128); f32x4 x0, x1; unpack_bf16x8(xw, x0, x1);
                    *(u32x4*)(Y + off + bj * 128) = pack_bf16x8(x0 * ALPHA + acc[ai][bj][m][0], x1 * ALPHA + acc[ai][bj][m][1]); }
                if (m == 3) asm volatile("" ::: "memory"); }
    }
};
struct EpiGluResid {
    static constexpr bool PERM = true, PERM16 = false;
    const bf16* X; bf16* Y;
    __device__ __forceinline__ void operator()(const f32x4 (&acc)[2][2][4][2], const pg8::UnitG& u, int wr, int wc, int fr, int fq) const {
#pragma unroll
        for (int ai = 0; ai < 2; ++ai)
#pragma unroll
            for (int m = 0; m < 4; ++m) { const size_t off = (size_t)(u.row0 + ai * 128 + wr * 64 + m * 16 + fr) * D + (u.col0 >> 1) + wc * 32 + 8 * fq;
                const u32x4 xw = *(const u32x4*)(X + off); f32x4 x0, x1; unpack_bf16x8(xw, x0, x1); f32x4 o0, o1;
#pragma unroll
                for (int j = 0; j < 4; ++j) { o0[j] = x0[j] * ALPHA + acc[ai][0][m][0][j] / (1.0f + __expf(-acc[ai][1][m][0][j])); o1[j] = x1[j] * ALPHA + acc[ai][0][m][1][j] / (1.0f + __expf(-acc[ai][1][m][1][j])); }
                *(u32x4*)(Y + off) = pack_bf16x8(o0, o1);
                if (m == 3) asm volatile("" ::: "memory"); }
    }
};
struct EpiMoeUp {
    static constexpr bool PERM = true, PERM16 = false;
    bf16* H;
    __device__ __forceinline__ void operator()(const f32x4 (&acc)[2][2][4][2], const pg8::UnitG& u, int wr, int wc, int fr, int fq) const {
#pragma unroll
        for (int ai = 0; ai < 2; ++ai)
#pragma unroll
            for (int m = 0; m < 4; ++m) { bf16* rowp = H + (size_t)(u.row0 + ai * 128 + wr * 64 + m * 16 + fr) * ED + u.col0 + wc * 32 + 8 * fq; f32x4 o[2];
#pragma unroll
                for (int n = 0; n < 2; ++n)
#pragma unroll
                    for (int j = 0; j < 4; ++j) { const float g = acc[ai][0][m][n][j] * WUP_INV, up = acc[ai][1][m][n][j] * WUP_INV; o[n][j] = g / (1.0f + __expf(-g)) * up; }
                *(u32x4*)rowp = pack_bf16x8(o[0], o[1]); }
    }
};

__device__ __forceinline__ unsigned pk4_fp8(float a, float b, float c, float d) {
    a = fminf(fmaxf(a, -448.0f), 448.0f); b = fminf(fmaxf(b, -448.0f), 448.0f); c = fminf(fmaxf(c, -448.0f), 448.0f); d = fminf(fmaxf(d, -448.0f), 448.0f);
    int w = 0; w = __builtin_amdgcn_cvt_pk_fp8_f32(a, b, w, false); w = __builtin_amdgcn_cvt_pk_fp8_f32(c, d, w, true); return (unsigned)w; }
template <bool HILO>
__device__ __forceinline__ void conv_item(const float* W, int ldw, bf16* WT, bf16* WTlo, int ldk, int k0, int n0, int drow0, float scale, LAS float* scr, int lane) {
#pragma unroll 8
    for (int i = 0; i < 32; ++i) { const int kk = 2 * i + (lane >> 5); scr[kk * 33 + (lane & 31)] = W[(size_t)(k0 + kk) * ldw + n0 + (lane & 31)] * scale; }
    LDS_WAIT(); asm volatile("" ::: "memory");
    const int c = lane & 7;
#pragma unroll
    for (int j = 0; j < 4; ++j) { const int n = (lane >> 3) + 8 * j; const LAS float* s = scr + (8 * c) * 33 + n;
        float v[8];
#pragma unroll
        for (int q = 0; q < 8; ++q) v[q] = s[q * 33];
        u32x4 o; o.x = pk2(v[0], v[1]); o.y = pk2(v[2], v[3]); o.z = pk2(v[4], v[5]); o.w = pk2(v[6], v[7]);
        *(u32x4*)(WT + (size_t)(drow0 + n) * ldk + k0 + 8 * c) = o;
        if (HILO) { float r[8];
#pragma unroll
            for (int q = 0; q < 8; ++q) r[q] = v[q] - bf2f(f2bf(v[q]));
            u32x4 o2; o2.x = pk2(r[0], r[1]); o2.y = pk2(r[2], r[3]); o2.z = pk2(r[4], r[5]); o2.w = pk2(r[6], r[7]);
            *(u32x4*)(WTlo + (size_t)(drow0 + n) * ldk + k0 + 8 * c) = o2; } }
    LDS_WAIT(); asm volatile("" ::: "memory");
}
__device__ __forceinline__ void conv_item8(const float* W, int ldw, unsigned char* WT, int ldk, int k0, int n0, int drow0, float scale, LAS float* scr, int lane) {
#pragma unroll 8
    for (int i = 0; i < 32; ++i) { const int kk = 2 * i + (lane >> 5); scr[kk * 33 + (lane & 31)] = W[(size_t)(k0 + kk) * ldw + n0 + (lane & 31)] * scale; }
    LDS_WAIT(); asm volatile("" ::: "memory");
    const int c = lane & 7;
#pragma unroll
    for (int j = 0; j < 4; ++j) { const int n = (lane >> 3) + 8 * j; const LAS float* s = scr + (8 * c) * 33 + n;
        float v[8];
#pragma unroll
        for (int q = 0; q < 8; ++q) v[q] = s[q * 33];
        u32x2 o; o.x = pk4_fp8(v[0], v[1], v[2], v[3]); o.y = pk4_fp8(v[4], v[5], v[6], v[7]);
        *(u32x2*)(WT + (size_t)(drow0 + n) * ldk + k0 + 8 * c) = o; }
    LDS_WAIT(); asm volatile("" ::: "memory");
}
__device__ __forceinline__ void phase_conv_mixers(const Frame& F, KP p) {
    LAS float* scr = (LAS float*)(F.lds + F.wave * 16384);
    const int gw = F.vcu * NWAVES + F.wave, NGW = F.G * NWAVES;
    constexpr int I_AIN = 16 * 288, I_AOUT = 16 * 32, I_RIN = 16 * 192, I_ROUT = 32 * 32, I_GLU = 16 * 64, I_RT = 16 * 2;
    constexpr int NITEMS = 2 * I_AIN + 2 * I_AOUT + I_RIN + I_ROUT + I_GLU + 4 * I_RT;
    unsigned char* ws = F.ws;
    for (int it = gw; it < NITEMS; it += NGW) {
        int r = it;
        if (r < 2 * I_AIN) { const int j = r / I_AIN; r %= I_AIN; const int kb = r / 288, nb = r % 288, n0 = nb * 32;
            conv_item8(gin(p, 1) + (size_t)j * D * ATT_IN, ATT_IN, (unsigned char*)(ws + WS_ATT_IN_T) + (size_t)j * ATT_IN * D, D, kb * 64, n0, n0, WUP_SCALE, scr, F.lane); continue; }
        r -= 2 * I_AIN;
        if (r < 2 * I_AOUT) { const int j = r / I_AOUT; r %= I_AOUT; const int kb = r / 32, nb = r % 32, n0 = nb * 32;
            conv_item<false>(gin(p, 2) + (size_t)j * D * D, D, (bf16*)(ws + WS_ATT_OUT_T) + (size_t)j * D * D, nullptr, D, kb * 64, n0, n0, 1.0f, scr, F.lane); continue; }
        r -= 2 * I_AOUT;
        if (r < I_RIN) { const int kb = r / 192, nb = r % 192, n0 = nb * 32;
            conv_item8(gin(p, 3), RET_IN, (unsigned char*)(ws + WS_RET_IN_T), D, kb * 64, n0, n0, WUP_SCALE, scr, F.lane); continue; }
        r -= I_RIN;
        if (r < I_ROUT) { const int kb = r / 32, nb = r % 32, n0 = nb * 32;
            conv_item<false>(gin(p, 6), D, (bf16*)(ws + WS_RET_OUT_T), nullptr, RET_V, kb * 64, n0, n0, 1.0f, scr, F.lane); continue; }
        r -= I_ROUT;
        if (r < I_GLU) { const int kb = r / 64, nb = r % 64, n0 = nb * 32; const int c = n0 & 1023, drow = (c >> 7) * 256 + (n0 >> 10) * 128 + (c & 127);
            conv_item<false>(gin(p, 15), 2 * D, (bf16*)(ws + WS_GLU_T), nullptr, D, kb * 64, n0, drow, 1.0f, scr, F.lane); continue; }
        r -= I_GLU;
        { const int l = r / I_RT; r %= I_RT; const int kb = r / 2, nb = r % 2, n0 = nb * 32;
            conv_item<true>(gin(p, 16) + (size_t)l * D * NE, NE, (bf16*)(ws + WS_RT_HI) + (size_t)l * NE * D, (bf16*)(ws + WS_RT_LO) + (size_t)l * NE * D, D, kb * 64, n0, n0, 1.0f, scr, F.lane); }
    }
}
__device__ __forceinline__ void phase_conv_moe(const Frame& F, KP p, int l) {
    LAS float* scr = (LAS float*)(F.lds + F.wave * 16384);
    const int gw = F.vcu * NWAVES + F.wave, NGW = F.G * NWAVES;
    for (int it = gw; it < 65 * 384; it += NGW) {
        const int e = it / 384, r = it % 384, which = r >> 7, rr = r & 127;
        bf16* We = (bf16*)(F.ws + WS_WMOE + (size_t)e * WMOE_E_BYTES);
        if (which < 2) { const float* src = (e < 64) ? gin(p, 18 + which) + ((size_t)l * NE + e) * D * ED : gin(p, 21 + which) + (size_t)l * D * ED;
            const int kb = rr >> 3, nb = rr & 7, n0 = nb * 32; const int drow = (n0 >> 7) * 256 + which * 128 + (n0 & 127);
            conv_item8(src, ED, (unsigned char*)We, D, kb * 64, n0, drow, WUP_SCALE, scr, F.lane);
        } else { const float* src = (e < 64) ? gin(p, 20) + ((size_t)l * NE + e) * ED * D : gin(p, 23) + (size_t)l * ED * D;
            const int kb = rr >> 5, nb = rr & 31, n0 = nb * 32;
            conv_item<false>(src, D, We + 512 * 1024, nullptr, ED, kb * 64, n0, n0, 1.0f, scr, F.lane); }
    }
}

__device__ __forceinline__ void phase_lnr(const Frame& F, KP p, int layer, bool dry = false) {
    const bf16* Y = (const bf16*)(F.ws + WS_Y); bf16* XB = (bf16*)(F.ws + WS_XB); unsigned char* XB8 = (unsigned char*)(F.ws + WS_X);
    const float* lng = gin(p, 24) + (size_t)(layer * 2) * D; const float* lnb = gin(p, 25) + (size_t)(layer * 2) * D;
    const bf16* rthi = (const bf16*)(F.ws + WS_RT_HI) + (size_t)layer * NE * D; const bf16* rtlo = (const bf16*)(F.ws + WS_RT_LO) + (size_t)layer * NE * D;
    const float* rbias = gin(p, 17) + layer * NE;
    unsigned* cnt = (unsigned*)(F.ws + WS_CTL) + CW_CNT + layer * NE * 64;
    int* lists = (int*)(F.ws + WS_LIST); int* tokmap = (int*)(F.ws + WS_LIST + 4 * MiB); float* tokgate = (float*)(F.ws + WS_LIST + 5 * MiB);
    constexpr int XLD = 1032, MAXT = 8;
    LAS bf16* Xhi = (LAS bf16*)F.lds; LAS bf16* Xlo = Xhi + 16 * XLD;
    LAS float* part = (LAS float*)(F.lds + 2 * 16 * XLD * 2);
    LAS int* ent = (LAS int*)(part + 2 * 16 * 64);
    LAS int* hist = ent + MAXT * 16 * 8 * 2; LAS int* base = hist + 64;
    const int lane = F.lane, w = F.wave, g4 = lane >> 4, l15 = lane & 15;
    if (F.tid < 64) hist[F.tid] = 0;
    bf16x8 bhi[16], blo[16];
    { const int nt = w & 3, kh = w >> 2; const bf16* bh = rthi + (size_t)(16 * nt + l15) * D + 512 * kh + 8 * g4; const bf16* bl = rtlo + (size_t)(16 * nt + l15) * D + 512 * kh + 8 * g4;
#pragma unroll
        for (int ks = 0; ks < 16; ++ks) { bhi[ks] = *(const bf16x8*)(bh + 32 * ks); blo[ks] = *(const bf16x8*)(bl + 32 * ks); } }
    u32x4 ypre[2][2];
    if (F.vcu < T / 16) {
#pragma unroll
        for (int rr = 0; rr < 2; ++rr)
#pragma unroll
            for (int j = 0; j < 2; ++j) ypre[rr][j] = *(const u32x4*)(Y + (size_t)(F.vcu * 16 + 2 * w + rr) * D + 8 * lane + 512 * j); }
    int ntile = 0;
    for (int tile = F.vcu; tile < T / 16 && ntile < MAXT; tile += F.G, ++ntile) {
        const int t0 = tile * 16;
        u32x4 ycur[2][2];
#pragma unroll
        for (int rr = 0; rr < 2; ++rr)
#pragma unroll
            for (int j = 0; j < 2; ++j) ycur[rr][j] = ypre[rr][j];
        if (tile + F.G < T / 16) {
#pragma unroll
            for (int rr = 0; rr < 2; ++rr)
#pragma unroll
                for (int j = 0; j < 2; ++j) ypre[rr][j] = *(const u32x4*)(Y + (size_t)((tile + F.G) * 16 + 2 * w + rr) * D + 8 * lane + 512 * j); }
#pragma unroll
        for (int rr = 0; rr < 2; ++rr) {
            const int lr = 2 * w + rr; const size_t row = (size_t)(t0 + lr);
            f32x4 v[4]; float s = 0.f;
#pragma unroll
            for (int j = 0; j < 2; ++j) unpack_bf16x8(ycur[rr][j], v[2 * j], v[2 * j + 1]);
#pragma unroll
            for (int j = 0; j < 4; ++j) s += (v[j][0] + v[j][1]) + (v[j][2] + v[j][3]);
            const float mean = wave_sum(s, lane) * (1.f / D); float s2 = 0.f;
#pragma unroll
            for (int j = 0; j < 4; ++j) { v[j] = v[j] - mean; s2 += (v[j][0] * v[j][0] + v[j][1] * v[j][1]) + (v[j][2] * v[j][2] + v[j][3] * v[j][3]); }
            const float rstd = 1.0f / sqrtf(wave_sum(s2, lane) * (1.f / D) + LN_EPS);
#pragma unroll
            for (int j = 0; j < 2; ++j) { const f32x4 g0 = *(const f32x4*)(lng + 8 * lane + 512 * j), g1 = *(const f32x4*)(lng + 8 * lane + 512 * j + 4), b0 = *(const f32x4*)(lnb + 8 * lane + 512 * j), b1 = *(const f32x4*)(lnb + 8 * lane + 512 * j + 4);
                const f32x4 o0 = v[2 * j] * rstd * g0 + b0, o1 = v[2 * j + 1] * rstd * g1 + b1;
                const u32x4 hi = pack_bf16x8(o0, o1);
                *(u32x4*)(XB + row * D + 8 * lane + 512 * j) = hi;
                { u32x2 q8; q8.x = pk4_fp8(o0[0], o0[1], o0[2], o0[3]); q8.y = pk4_fp8(o1[0], o1[1], o1[2], o1[3]); *(u32x2*)(XB8 + row * D + 8 * lane + 512 * j) = q8; }
                f32x4 h0, h1; unpack_bf16x8(hi, h0, h1); const u32x4 lo = pack_bf16x8(o0 - h0, o1 - h1);
                *(LAS u32x4*)(Xhi + lr * XLD + 8 * lane + 512 * j) = hi; *(LAS u32x4*)(Xlo + lr * XLD + 8 * lane + 512 * j) = lo; }
        }
        __syncthreads();
        { const int nt = w & 3, kh = w >> 2; f32x4 a0 = (f32x4){0.f, 0.f, 0.f, 0.f}, a1 = a0, a2 = a0, a3 = a0, a4 = a0, a5 = a0;
#pragma unroll
            for (int ks = 0; ks < 16; ks += 2) { const int k0 = 512 * kh + 32 * ks;
                const bf16x8 ahi = row_frag(Xhi, XLD, 0, k0, lane), alo = row_frag(Xlo, XLD, 0, k0, lane), bhi2 = row_frag(Xhi, XLD, 0, k0 + 32, lane), blo2 = row_frag(Xlo, XLD, 0, k0 + 32, lane);
                a0 = MFMA16(ahi, bhi[ks], a0); a1 = MFMA16(alo, bhi[ks], a1); a2 = MFMA16(ahi, blo[ks], a2);
                a3 = MFMA16(bhi2, bhi[ks + 1], a3); a4 = MFMA16(blo2, bhi[ks + 1], a4); a5 = MFMA16(bhi2, blo[ks + 1], a5); }
            const f32x4 acc = ((a0 + a3) + (a1 + a4)) + (a2 + a5);
#pragma unroll
            for (int i = 0; i < 4; ++i) part[(kh * 16 + 4 * g4 + i) * 64 + 16 * nt + l15] = acc[i];
        }
        __syncthreads();
#pragma unroll
        for (int rr = 0; rr < 2; ++rr) {
            const int lt = ntile * 16 + 2 * w + rr;
            const float lg = part[(2 * w + rr) * 64 + lane] + part[(16 + 2 * w + rr) * 64 + lane];
            float sc = 1.0f / (1.0f + expf(-lg)); sc = (sc == sc) ? sc : 0.5f;
            const float sel = sc + rbias[lane];
            const float m1 = max8(sel);
            const unsigned long long eq = __ballot(sel == m1);
            const unsigned gm = (unsigned)(eq >> (lane & 56)) & 0xffu;
            const int first = (lane & 56) + __builtin_ctz(gm | 0x100u);
            const float m2 = max8((lane == first) ? -INFINITY : sel);
            const float gs = m1 + m2; const int mygrp = lane >> 3; int grank = 0;
#pragma unroll
            for (int gg = 0; gg < 8; ++gg) { const float o = rdl(gs, 8 * gg); grank += (o > gs || (o == gs && gg < mygrp)) ? 1 : 0; }
            const float mv = (grank < 4) ? sel : -INFINITY;
            unsigned key = __builtin_bit_cast(unsigned, mv); key = (key >> 31) ? ~key : (key | 0x80000000u); key = (key & ~63u) | (unsigned)(63 - lane);
            int r0 = 0, r1 = 0, r2 = 0, r3 = 0;
#pragma unroll
            for (int e2 = 0; e2 < 64; e2 += 4) { r0 += ((unsigned)__builtin_amdgcn_readlane((int)key, e2) > key) ? 1 : 0; r1 += ((unsigned)__builtin_amdgcn_readlane((int)key, e2 + 1) > key) ? 1 : 0;
                r2 += ((unsigned)__builtin_amdgcn_readlane((int)key, e2 + 2) > key) ? 1 : 0; r3 += ((unsigned)__builtin_amdgcn_readlane((int)key, e2 + 3) > key) ? 1 : 0; }
            const int rank = (r0 + r1) + (r2 + r3);
            const bool chosen = rank < TOPK;
            const float wsum = wave_sum(chosen ? sc : 0.f, lane);
            if (chosen) { const int lpos = __hip_atomic_fetch_add(hist + lane, 1, __ATOMIC_RELAXED, __HIP_MEMORY_SCOPE_WORKGROUP);
                ent[(lt * 8 + rank) * 2] = (lane << 16) | lpos; ent[(lt * 8 + rank) * 2 + 1] = __builtin_bit_cast(int, sc / wsum * 2.5f); }
        }
    }
    __syncthreads();
    if (dry) return;
    if (F.tid < 64) { const int hcount = hist[F.tid]; base[F.tid] = hcount ? (int)atomicAdd(cnt + F.tid * 64, (unsigned)hcount) : 0; }
    __syncthreads();
    for (int idx = F.tid; idx < ntile * 16 * 8; idx += NTHREADS) {
        const int ev = ent[idx * 2], gb = ent[idx * 2 + 1]; const int e = ev >> 16, pos = base[e] + (ev & 0xffff);
        const int lt = idx >> 3, rank = idx & 7, tok = (F.vcu + (lt >> 4) * F.G) * 16 + (lt & 15);
        lists[(size_t)e * T + pos] = tok; tokmap[tok * 8 + rank] = (e << 16) | pos; tokgate[tok * 8 + rank] = __builtin_bit_cast(float, gb);
    }
}

__device__ __forceinline__ void phase_combine(const Frame& F, KP p, int layer, bool dry = false) {
    bf16* XB = (bf16*)(F.ws + WS_XB); const unsigned char* yexp = (const unsigned char*)(F.ws + WS_BIG);
    const int* tokmap = (const int*)(F.ws + WS_LIST + 4 * MiB); const float* tokgate = (const float*)(F.ws + WS_LIST + 5 * MiB);
    const volatile LAS int* tstart = (const volatile LAS int*)(F.MISC + 64);
    const float* lng = gin(p, 24) + (size_t)(layer * 2 + 1) * D; const float* lnb = gin(p, 25) + (size_t)(layer * 2 + 1) * D;
    float* outp = gout(p); bf16* xbo = XB; if (dry) { outp = (float*)(F.ws + WS_AUX); xbo = (bf16*)(F.ws + WS_H); }
    const int lane = F.lane, gw = F.vcu * NWAVES + F.wave, NGW = F.G * NWAVES;
    const bf16* ysh = (const bf16*)(F.ws + WS_Y);
    f32x4 gv[4], bv[4];
#pragma unroll
    for (int j = 0; j < 4; ++j) { gv[j] = *(const f32x4*)(lng + 16 * lane + 4 * j); bv[j] = *(const f32x4*)(lnb + 16 * lane + 4 * j); }
    for (int row = gw; row < T; row += NGW) {
        const int mk = tokmap[row * 8 + (lane & 7)]; const float gk = tokgate[row * 8 + (lane & 7)] * YEXP_INV;
        const int rk = (int)tstart[mk >> 16] * 256 + (mk & 0xffff);
        f32x4 v[4];
#pragma unroll
        for (int j = 0; j < 2; ++j) { const u32x4 xw = *(const u32x4*)(ysh + (size_t)row * D + 16 * lane + 8 * j); unpack_bf16x8(xw, v[2 * j], v[2 * j + 1]); }
#pragma unroll
        for (int k = 0; k < TOPK; ++k) { const int r = __builtin_amdgcn_readlane(rk, k); const float g = rdl(gk, k);
            const u32x4 s = *(const u32x4*)(yexp + (size_t)r * D + 16 * lane);
#pragma unroll
            for (int j = 0; j < 4; ++j) { const f32x2 lo = __builtin_amdgcn_cvt_pk_f32_fp8((int)s[j], false), hi = __builtin_amdgcn_cvt_pk_f32_fp8((int)s[j], true);
                v[j][0] += g * lo[0]; v[j][1] += g * lo[1]; v[j][2] += g * hi[0]; v[j][3] += g * hi[1]; } }
        float s = 0.f;
#pragma unroll
        for (int j = 0; j < 4; ++j) s += (v[j][0] + v[j][1]) + (v[j][2] + v[j][3]);
        const float mean = wave_sum(s, lane) * (1.f / D); float s2 = 0.f;
#pragma unroll
        for (int j = 0; j < 4; ++j) { v[j] = v[j] - mean; s2 += (v[j][0] * v[j][0] + v[j][1] * v[j][1]) + (v[j][2] * v[j][2] + v[j][3] * v[j][3]); }
        const float rstd = 1.0f / sqrtf(wave_sum(s2, lane) * (1.f / D) + LN_EPS);
        f32x4 o[4];
#pragma unroll
        for (int j = 0; j < 4; ++j) o[j] = v[j] * rstd * gv[j] + bv[j];
        if (layer == DEPTH - 1 || dry) {
#pragma unroll
            for (int j = 0; j < 4; ++j) *(f32x4*)(outp + (size_t)row * D + 16 * lane + 4 * j) = o[j]; }
        if (layer != DEPTH - 1) { *(u32x4*)(xbo + (size_t)row * D + 16 * lane) = pack_bf16x8(o[0], o[1]); *(u32x4*)(xbo + (size_t)row * D + 16 * lane + 8) = pack_bf16x8(o[2], o[3]);
            if (!dry) { u32x4 q8; q8.x = pk4_fp8(o[0][0], o[0][1], o[0][2], o[0][3]); q8.y = pk4_fp8(o[1][0], o[1][1], o[1][2], o[1][3]); q8.z = pk4_fp8(o[2][0], o[2][1], o[2][2], o[2][3]); q8.w = pk4_fp8(o[3][0], o[3][1], o[3][2], o[3][3]);
                *(u32x4*)((unsigned char*)(F.ws + WS_X) + (size_t)row * D + 16 * lane) = q8; } }
    }
}

constexpr size_t AUX_OB = 96 * MiB, AUX_LSE = 128 * MiB;
__device__ __forceinline__ void phase_attn(const Frame& F, int bx) {
    const bf16* qkv = (const bf16*)(F.ws + WS_BIG); bf16* og = (bf16*)(F.ws + WS_AUX); float* lse = (float*)(F.ws + WS_AUX + AUX_LSE);
    constexpr int KLD = 136;
    LAS bf16* Ks = (LAS bf16*)F.lds; LAS bf16* Vs = Ks + 256 * KLD;
    const int lane = F.lane, w = F.wave, g4 = lane >> 4, l15 = lane & 15, qq = l15 >> 2, pp = lane & 3;
    u32x4 kc[4], vc[4];
    constexpr int NRUN = 768;
#define ATT_LOADBLK(KR, VR, nblk) do { _Pragma("unroll") for (int it = 0; it < 4; ++it) { const int idx = F.tid + 512 * it, c = idx >> 4, ch = idx & 15; int pos = 128 * (nblk) + c; pos = pos < 0 ? 0 : pos; \
            const unsigned so = (rowbase + (unsigned)pos * (unsigned)d + (unsigned)r) * (unsigned)ATT_IN + (unsigned)(g * 3072 + 1024 + h * 128 + ch * 8); KR[it] = *(const u32x4*)(qkv + so); VR[it] = *(const u32x4*)(qkv + so + 1024u); } } while (0)
#define ATT_STOREBLK(KR, VR, slot) do { _Pragma("unroll") for (int it = 0; it < 4; ++it) { const int idx = F.tid + 512 * it, c = idx >> 4, ch = idx & 15; \
            *(LAS u32x4*)(Ks + (128 * (slot) + c) * KLD + ch * 8) = KR[it]; *(LAS u32x4*)(Vs + (128 * (slot) + c) * KLD + ch * 8) = VR[it]; } } while (0)
    for (int R = bx; R < NRUN; R += F.G) {
        const int h = R & 7, sbr = R >> 3, g = sbr >> 5, rem = sbr & 31, b = rem >> 4, rr_ = rem & 15;
        const int dsh = 2 * g, d = 1 << dsh, nrs = 4 - dsh, r = rr_ >> nrs, n0 = 4 * (rr_ & ((1 << nrs) - 1)); const unsigned rowbase = (unsigned)b * SEQ;
        ATT_LOADBLK(kc, vc, n0 - 1); ATT_STOREBLK(kc, vc, (n0 - 1) & 1); ATT_LOADBLK(kc, vc, n0);
#pragma unroll 1
        for (int j = 0; j < 4; ++j) {
            const int n = n0 + j, cs = n & 1, ps = cs ^ 1;
            ATT_STOREBLK(kc, vc, cs);
            const int qi = 16 * w + l15; const unsigned qrow = rowbase + (unsigned)(128 * n + qi) * (unsigned)d + (unsigned)r;
            bf16x8 qf[4];
#pragma unroll
            for (int s = 0; s < 4; ++s) qf[s] = *(const bf16x8*)(qkv + (qrow * (unsigned)ATT_IN + (unsigned)(g * 3072 + h * 128 + 32 * s + 8 * g4)));
            __syncthreads();
            if (j < 3) { ATT_LOADBLK(kc, vc, n + 1); }
            __builtin_amdgcn_sched_barrier(0);
            const int ws0 = (16 * w < 96) ? 16 * w : 96;
#define ATT_PROW(c0) (((c0) < 128) ? (128 * ps + (c0)) : (128 * cs + (c0) - 128))
            f32x4 sacc[10];
            {
                bf16x8 kfa[4], kfb[4];
#pragma unroll
                for (int s = 0; s < 4; ++s) kfa[s] = row_frag(Ks, KLD, ATT_PROW(ws0), 32 * s, lane);
#pragma unroll
                for (int t = 0; t < 10; t += 2) {
#pragma unroll
                    for (int s = 0; s < 4; ++s) kfb[s] = row_frag(Ks, KLD, ATT_PROW(ws0 + 16 * (t + 1)), 32 * s, lane);
                    __builtin_amdgcn_sched_barrier(0);
                    sacc[t] = (f32x4){0.f, 0.f, 0.f, 0.f};
#pragma unroll
                    for (int s = 0; s < 4; ++s) sacc[t] = MFMA16(kfa[s], qf[s], sacc[t]);
                    if (t + 2 < 10) {
#pragma unroll
                        for (int s = 0; s < 4; ++s) kfa[s] = row_frag(Ks, KLD, ATT_PROW(ws0 + 16 * (t + 2)), 32 * s, lane); }
                    __builtin_amdgcn_sched_barrier(0);
                    sacc[t + 1] = (f32x4){0.f, 0.f, 0.f, 0.f};
#pragma unroll
                    for (int s = 0; s < 4; ++s) sacc[t + 1] = MFMA16(kfb[s], qf[s], sacc[t + 1]);
                }
            }
            const float slope = exp2f(-(float)(h + 1)) * (float)d;
            float mx = -INFINITY;
#pragma unroll
            for (int t = 0; t < 10; ++t)
#pragma unroll
                for (int i = 0; i < 4; ++i) { const int c = ws0 + 16 * t + 4 * g4 + i, step = 128 + qi - c;
                    const bool valid = (step >= 0) && (step <= 128) && (n > 0 || c >= 128);
                    const float v = valid ? sacc[t][i] - slope * (float)step : -INFINITY; sacc[t][i] = v; mx = fmaxf(mx, v); }
            mx = fmaxf(mx, shx(mx, 16, lane)); mx = fmaxf(mx, shx(mx, 32, lane));
            float lsum = 0.f;
#pragma unroll
            for (int t = 0; t < 10; ++t)
#pragma unroll
                for (int i = 0; i < 4; ++i) { const float pv = __expf(sacc[t][i] - mx); sacc[t][i] = pv; lsum += pv; }
            lsum += shx(lsum, 16, lane); lsum += shx(lsum, 32, lane);
            bf16x8 pf[5];
#pragma unroll
            for (int kt = 0; kt < 5; ++kt) pf[kt] = pack8(sacc[2 * kt], sacc[2 * kt + 1]);
            f32x4 o[8];
            {
                const LAS bf16* vl = Vs + (4 * g4 + qq) * KLD + 32 * pp;
                bf16x4 va[10], vcc[10];
#pragma unroll
                for (int q = 0; q < 10; ++q) va[q] = tr4(vl + ATT_PROW(ws0 + 16 * q) * KLD);
#pragma unroll
                for (int et = 0; et < 8; et += 2) {
#pragma unroll
                    for (int q = 0; q < 10; ++q) vcc[q] = tr4(vl + ATT_PROW(ws0 + 16 * q) * KLD + 4 * (et + 1));
                    __builtin_amdgcn_sched_barrier(0);
                    o[et] = (f32x4){0.f, 0.f, 0.f, 0.f};
#pragma unroll
                    for (int kt = 0; kt < 5; ++kt) o[et] = MFMA16(cat8(va[2 * kt], va[2 * kt + 1]), pf[kt], o[et]);
                    if (et + 2 < 8) {
#pragma unroll
                        for (int q = 0; q < 10; ++q) va[q] = tr4(vl + ATT_PROW(ws0 + 16 * q) * KLD + 4 * (et + 2)); }
                    __builtin_amdgcn_sched_barrier(0);
                    o[et + 1] = (f32x4){0.f, 0.f, 0.f, 0.f};
#pragma unroll
                    for (int kt = 0; kt < 5; ++kt) o[et + 1] = MFMA16(cat8(vcc[2 * kt], vcc[2 * kt + 1]), pf[kt], o[et + 1]);
                }
            }
#undef ATT_PROW
            const float inv = 1.0f / lsum;
            bf16* orow = og + ((size_t)g * T + qrow) * D + h * 128 + 32 * g4;
#pragma unroll
            for (int e2 = 0; e2 < 4; ++e2) *(u32x4*)(orow + 8 * e2) = pack_bf16x8(o[2 * e2] * inv, o[2 * e2 + 1] * inv);
            if (g4 == 0) lse[((size_t)g * T + qrow) * AH + h] = mx + __logf(lsum);
            __syncthreads();
        }
    }
#undef ATT_LOADBLK
#undef ATT_STOREBLK
}
__device__ __forceinline__ void phase_attn_combine(const Frame& F) {
    const bf16* og = (const bf16*)(F.ws + WS_AUX); const float* lse = (const float*)(F.ws + WS_AUX + AUX_LSE); bf16* ob = (bf16*)(F.ws + WS_AUX + AUX_OB);
    const int lane = F.lane, gw = F.vcu * NWAVES + F.wave, NGW = F.G * NWAVES, h = lane >> 3;
    for (int row = gw; row < T; row += NGW) {
        const float l0 = lse[((size_t)0 * T + row) * AH + h], l1 = lse[((size_t)1 * T + row) * AH + h], l2 = lse[((size_t)2 * T + row) * AH + h];
        const float m = fmaxf(l0, fmaxf(l1, l2)); float w0 = __expf(l0 - m), w1 = __expf(l1 - m), w2 = __expf(l2 - m); const float inv = 1.0f / (w0 + w1 + w2); w0 *= inv; w1 *= inv; w2 *= inv;
        float a[16];
#pragma unroll
        for (int j = 0; j < 16; ++j) a[j] = 0.f;
#pragma unroll
        for (int g = 0; g < 3; ++g) { const float wg = (g == 0) ? w0 : (g == 1 ? w1 : w2);
#pragma unroll
            for (int q = 0; q < 2; ++q) { const u32x4 s = *(const u32x4*)(og + ((size_t)g * T + row) * D + 16 * lane + 8 * q);
                a[8 * q + 0] += wg * bflo(s.x); a[8 * q + 1] += wg * bfhi(s.x); a[8 * q + 2] += wg * bflo(s.y); a[8 * q + 3] += wg * bfhi(s.y);
                a[8 * q + 4] += wg * bflo(s.z); a[8 * q + 5] += wg * bfhi(s.z); a[8 * q + 6] += wg * bflo(s.w); a[8 * q + 7] += wg * bfhi(s.w); } }
#pragma unroll
        for (int q = 0; q < 2; ++q) { u32x4 o; o.x = pk2(a[8 * q], a[8 * q + 1]); o.y = pk2(a[8 * q + 2], a[8 * q + 3]); o.z = pk2(a[8 * q + 4], a[8 * q + 5]); o.w = pk2(a[8 * q + 6], a[8 * q + 7]);
            *(u32x4*)(ob + (size_t)row * D + 16 * lane + 8 * q) = o; }
    }
}

constexpr size_t BIG_YRET = 192 * MiB;
__device__ __forceinline__ void phase_ret_u(const Frame& F) {
    const bf16* proj = (const bf16*)(F.ws + WS_BIG); bf16* St = (bf16*)(F.ws + WS_AUX);
    constexpr int LD = 264;
    LAS bf16* Kt = (LAS bf16*)F.lds; LAS bf16* Vt = Kt + 128 * LD;
    const int lane = F.lane, w = F.wave, g4 = lane >> 4, l15 = lane & 15, qq = l15 >> 2, pp = lane & 3;
    for (int u = F.vcu; u < 1024; u += F.G) {
        const int eh = u & 1, h = (u >> 1) & 3, n = (u >> 3) & 63, b = u >> 9;
        const size_t row0 = (size_t)b * SEQ + (size_t)n * RC;
#pragma unroll 4
        for (int it = 0; it < 8; ++it) { const int idx = F.tid + 512 * it, j = idx >> 5, ch = idx & 31;
            const bf16* src = proj + (row0 + j) * RET_IN;
            const u32x4 kv = *(const u32x4*)(src + 1024 + h * 256 + ch * 8), vv = *(const u32x4*)(src + 2048 + h * 512 + eh * 256 + ch * 8);
            *(LAS u32x4*)(Kt + j * LD + ch * 8) = kv; *(LAS u32x4*)(Vt + j * LD + ch * 8) = vv; }
        __syncthreads();
        f32x4 acc[16][2];
#pragma unroll
        for (int mt = 0; mt < 16; ++mt) { acc[mt][0] = (f32x4){0.f, 0.f, 0.f, 0.f}; acc[mt][1] = (f32x4){0.f, 0.f, 0.f, 0.f}; }
#pragma unroll
        for (int ks = 0; ks < 4; ++ks) {
            bf16x8 bfr[2];
#pragma unroll
            for (int nt = 0; nt < 2; ++nt) { const LAS bf16* a0 = Vt + (32 * ks + 8 * g4 + qq) * LD + 32 * w + 16 * nt + 4 * pp; bfr[nt] = cat8(tr4(a0), tr4(a0 + 4 * LD)); }
#pragma unroll
            for (int mt = 0; mt < 16; ++mt) { const LAS bf16* a0 = Kt + (32 * ks + 8 * g4 + qq) * LD + 128 * (mt >> 3) + 32 * pp + 4 * (mt & 7);
                const bf16x8 afr = cat8(tr4(a0), tr4(a0 + 4 * LD));
                acc[mt][0] = MFMA16(afr, bfr[0], acc[mt][0]); acc[mt][1] = MFMA16(afr, bfr[1], acc[mt][1]); }
        }
        bf16* outb = St + ((size_t)((b * RH + h) * RNC + n)) * (RDV * RDK);
#pragma unroll
        for (int nt = 0; nt < 2; ++nt) { bf16* orow = outb + (size_t)(eh * 256 + 32 * w + 16 * nt + l15) * RDK + 32 * g4;
#pragma unroll
            for (int mh = 0; mh < 2; ++mh)
#pragma unroll
                for (int q = 0; q < 4; ++q) *(u32x4*)(orow + 128 * mh + 8 * q) = pack_bf16x8(acc[mh * 8 + 2 * q][nt], acc[mh * 8 + 2 * q + 1][nt]); }
        __syncthreads();
    }
}
__device__ __forceinline__ void phase_ret_scan(const Frame& F) {
    bf16* St = (bf16*)(F.ws + WS_AUX);
    for (int gt = F.vcu * NTHREADS + F.tid; gt < 8 * 16384; gt += F.G * NTHREADS) {
        const int bh = gt >> 14, chunk = gt & 16383, h = bh & 3;
        const float g128 = exp2f(128.0f * log2f(1.0f - exp2f(-5.0f - (float)h)));
        bf16* base = St + (size_t)bh * RNC * (RDV * RDK) + (size_t)chunk * 8;
        float c[8];
#pragma unroll
        for (int j = 0; j < 8; ++j) c[j] = 0.f;
#pragma unroll 8
        for (int n = 0; n < RNC; ++n) { bf16* pn = base + (size_t)n * (RDV * RDK); const u32x4 uv = *(const u32x4*)pn;
            u32x4 o; o.x = pk2(c[0], c[1]); o.y = pk2(c[2], c[3]); o.z = pk2(c[4], c[5]); o.w = pk2(c[6], c[7]); *(u32x4*)pn = o;
            c[0] = g128 * (c[0] + bflo(uv.x)); c[1] = g128 * (c[1] + bfhi(uv.x)); c[2] = g128 * (c[2] + bflo(uv.y)); c[3] = g128 * (c[3] + bfhi(uv.y));
            c[4] = g128 * (c[4] + bflo(uv.z)); c[5] = g128 * (c[5] + bfhi(uv.z)); c[6] = g128 * (c[6] + bflo(uv.w)); c[7] = g128 * (c[7] + bfhi(uv.w)); }
    }
}
__device__ __forceinline__ void phase_ret_out(const Frame& F, KP p) {
    const bf16* proj = (const bf16*)(F.ws + WS_BIG); const bf16* St = (const bf16*)(F.ws + WS_AUX); bf16* yret = (bf16*)(F.ws + WS_BIG + BIG_YRET);
    const float* gng = gin(p, 4); const float* gnb = gin(p, 5);
    constexpr int LD = 264, VLD = 136;
    LAS bf16* Rs = (LAS bf16*)F.lds; LAS bf16* Vs = Rs + 128 * LD;
    const int lane = F.lane, w = F.wave, g4 = lane >> 4, l15 = lane & 15, qq = l15 >> 2, pp = lane & 3;
    for (int u = F.vcu; u < 512; u += F.G) {
        const int h = u & 3, n = (u >> 2) & 63, b = u >> 8;
        const size_t row0 = (size_t)b * SEQ + (size_t)n * RC;
#pragma unroll 4
        for (int it = 0; it < 8; ++it) { const int idx = F.tid + 512 * it, j = idx >> 5, ch = idx & 31;
            *(LAS u32x4*)(Rs + j * LD + ch * 8) = *(const u32x4*)(proj + (row0 + j) * RET_IN + 1024 + h * 256 + ch * 8); }
        const int irow = 16 * w + l15; const size_t qrow = row0 + irow;
        bf16x8 qf[8];
#pragma unroll
        for (int s = 0; s < 8; ++s) qf[s] = *(const bf16x8*)(proj + qrow * RET_IN + h * 256 + 32 * s + 8 * g4);
        __syncthreads();
        bf16x8 pf[4];
        { f32x4 sacc[8];
#pragma unroll
            for (int jt = 0; jt < 8; ++jt) { sacc[jt] = (f32x4){0.f, 0.f, 0.f, 0.f};
                if (jt <= w) {
#pragma unroll
                    for (int s = 0; s < 8; ++s) sacc[jt] = MFMA16(row_frag(Rs, LD, 16 * jt, 32 * s, lane), qf[s], sacc[jt]);
#pragma unroll
                    for (int i = 0; i < 4; ++i) if (16 * jt + 4 * g4 + i > irow) sacc[jt][i] = 0.f; } }
#pragma unroll
            for (int kt = 0; kt < 4; ++kt) pf[kt] = pack8(sacc[2 * kt], sacc[2 * kt + 1]); }
        __syncthreads();
        f32x4 acc[4][8];
        const bf16* Sn = St + ((size_t)((b * RH + h) * RNC + n)) * (RDV * RDK);
#pragma unroll
        for (int sl = 0; sl < 4; ++sl) {
#pragma unroll 4
            for (int it = 0; it < 4; ++it) { const int idx = F.tid + 512 * it, j = idx >> 4, ch = idx & 15;
                *(LAS u32x4*)(Vs + j * VLD + ch * 8) = *(const u32x4*)(proj + (row0 + j) * RET_IN + 2048 + h * 512 + sl * 128 + ch * 8); }
#pragma unroll 4
            for (int it = 0; it < 8; ++it) { const int idx = F.tid + 512 * it, e = idx >> 5, ch = idx & 31;
                *(LAS u32x4*)(Rs + e * LD + ch * 8) = *(const u32x4*)(Sn + (size_t)(sl * 128 + e) * RDK + ch * 8); }
            __syncthreads();
#pragma unroll
            for (int et = 0; et < 8; ++et) { f32x4 a = (f32x4){0.f, 0.f, 0.f, 0.f};
#pragma unroll
                for (int kt = 0; kt < 4; ++kt) if (2 * kt <= w) { const LAS bf16* a0 = Vs + (32 * kt + 4 * g4 + qq) * VLD + 32 * pp + 4 * et;
                    a = MFMA16(cat8(tr4(a0), tr4(a0 + 16 * VLD)), pf[kt], a); }
                const LAS bf16* srow = Rs + (32 * qq + 4 * et + pp) * LD + 8 * g4;
#pragma unroll
                for (int s = 0; s < 8; ++s) a = MFMA16(*(const LAS bf16x8*)(srow + 32 * s), qf[s], a);
                acc[sl][et] = a; }
            __syncthreads();
        }
        float s = 0.f;
#pragma unroll
        for (int sl = 0; sl < 4; ++sl)
#pragma unroll
            for (int et = 0; et < 8; ++et) s += (acc[sl][et][0] + acc[sl][et][1]) + (acc[sl][et][2] + acc[sl][et][3]);
        s += shx(s, 16, lane); s += shx(s, 32, lane);
        const float mean = s * (1.0f / RDV); float s2 = 0.f;
#pragma unroll
        for (int sl = 0; sl < 4; ++sl)
#pragma unroll
            for (int et = 0; et < 8; ++et) { acc[sl][et] = acc[sl][et] - mean; s2 += (acc[sl][et][0] * acc[sl][et][0] + acc[sl][et][1] * acc[sl][et][1]) + (acc[sl][et][2] * acc[sl][et][2] + acc[sl][et][3] * acc[sl][et][3]); }
        s2 += shx(s2, 16, lane); s2 += shx(s2, 32, lane);
        const float rstd = 1.0f / sqrtf(s2 * (1.0f / RDV) + LN_EPS);
#pragma unroll
        for (int sl = 0; sl < 4; ++sl) { const int c0 = h * RDV + sl * 128 + 32 * g4;
#pragma unroll
            for (int q = 0; q < 4; ++q) { const u32x4 gw = *(const u32x4*)(proj + qrow * RET_IN + 4096 + c0 + 8 * q);
                const f32x4 gg0 = *(const f32x4*)(gng + c0 + 8 * q), gg1 = *(const f32x4*)(gng + c0 + 8 * q + 4), gb0 = *(const f32x4*)(gnb + c0 + 8 * q), gb1 = *(const f32x4*)(gnb + c0 + 8 * q + 4);
                f32x4 y0 = acc[sl][2 * q] * rstd * gg0 + gb0, y1 = acc[sl][2 * q + 1] * rstd * gg1 + gb1;
                const float gv[8] = {bflo(gw.x), bfhi(gw.x), bflo(gw.y), bfhi(gw.y), bflo(gw.z), bfhi(gw.z), bflo(gw.w), bfhi(gw.w)};
#pragma unroll
                for (int j = 0; j < 4; ++j) { y0[j] *= gv[j] / (1.0f + __expf(-gv[j])); y1[j] *= gv[4 + j] / (1.0f + __expf(-gv[4 + j])); }
                *(u32x4*)(yret + qrow * RET_V + c0 + 8 * q) = pack_bf16x8(y0, y1); } }
    }
}

constexpr size_t AUX_S5E = 64 * MiB;
constexpr int S5L = 256, S5NC = SEQ / S5L;
__device__ __forceinline__ void cmul_add(float& rr, float& ri, float ar, float ai, float xr, float xi, float cr, float ci) { rr = ar * xr - ai * xi + cr; ri = ar * xi + ai * xr + ci; }
template <bool OUT>
__device__ __forceinline__ void phase_s5_scan(const Frame& F, KP p) {
    const bf16* X = (const bf16*)(F.ws + WS_XB); float* E = (float*)(F.ws + WS_AUX + AUX_S5E); bf16* ybuf = (bf16*)(F.ws + WS_AUX);
    const int lane = F.lane, w = F.wave, g4 = lane >> 4, l15 = lane & 15;
    LAS bf16* ut = (LAS bf16*)(F.lds + w * 12288);
    LAS bf16* Hb = (LAS bf16*)(F.lds + w * 12288 + 4096);
    constexpr int HLD = 136;
    const int gw = F.vcu * NWAVES + w, NGW = F.G * NWAVES;
    const int up16 = (lane - 16) << 2, up32 = (lane - 32) << 2, last16 = (48 + l15) << 2;
    for (int unit = gw; unit < BATCH * SG * S5NC; unit += NGW) {
        const int n = unit & (S5NC - 1), g = (unit >> 5) & 63, b = unit >> 11;
        float a1r[4], a1i[4], a4r[4], a4i[4], a8r[4], a8i[4], pwr[4], pwi[4];
        bf16x8 bfrag[8];
        const float dt = expf(gin(p, 14)[g]);
#pragma unroll
        for (int st = 0; st < 4; ++st) { const int ps = 16 * st + l15;
            const float are = gin(p, 7)[g * SP + ps], aim = gin(p, 8)[g * SP + ps];
            const float mag = expf(dt * are); const float abr = mag * cosf(dt * aim), abi = mag * sinf(dt * aim);
            const float den = are * are + aim * aim;
            const float fre = ((abr - 1.0f) * are + abi * aim) / den, fim = (abi * are - (abr - 1.0f) * aim) / den;
            a1r[st] = abr; a1i[st] = abi; { float t2r, t2i; cmul_add(t2r, t2i, abr, abi, abr, abi, 0.f, 0.f); cmul_add(a4r[st], a4i[st], t2r, t2i, t2r, t2i, 0.f, 0.f); }
            cmul_add(a8r[st], a8i[st], a4r[st], a4i[st], a4r[st], a4i[st], 0.f, 0.f);
            float qr = 1.f, qi = 0.f;
            if (g4 & 1) { qr = a4r[st]; qi = a4i[st]; }
            if (g4 & 2) { float tr, ti; cmul_add(tr, ti, qr, qi, a8r[st], a8i[st], 0.f, 0.f); qr = tr; qi = ti; }
            pwr[st] = qr; pwi[st] = qi;
            const float* br = gin(p, 9) + ((size_t)g * SP + ps) * SGC + 8 * (g4 & 1); const float* bi = gin(p, 10) + ((size_t)g * SP + ps) * SGC + 8 * (g4 & 1);
            const f32x4 r0 = *(const f32x4*)br, r1 = *(const f32x4*)(br + 4), i0 = *(const f32x4*)bi, i1 = *(const f32x4*)(bi + 4);
            const float z = (g4 < 2) ? 1.0f : 0.0f; const float fr2 = fre * z, fi2 = fim * z;
            bfrag[st] = pack8(r0 * fr2 - i0 * fi2, r1 * fr2 - i1 * fi2); bfrag[st + 4] = pack8(i0 * fr2 + r0 * fi2, i1 * fr2 + r1 * fi2);
        }
        float sr[4], si[4];
        float* Eu = E + ((size_t)(b * SG + g) * S5NC + n) * 128;
        bf16x8 cf[4]; f32x4 dsk = (f32x4){0.f, 0.f, 0.f, 0.f};
#pragma unroll
        for (int st = 0; st < 4; ++st) { sr[st] = 0.f; si[st] = 0.f; }
        if (OUT) {
#pragma unroll
            for (int st = 0; st < 4; ++st) { sr[st] = Eu[16 * st + l15]; si[st] = Eu[64 + 16 * st + l15]; }
#pragma unroll
            for (int s = 0; s < 4; ++s) { const float* cp = (s < 2 ? gin(p, 11) : gin(p, 12)) + ((size_t)g * SGC + l15) * SP + 32 * (s & 1) + 8 * g4; const float sg = s < 2 ? 1.0f : -1.0f;
                const f32x4 c0 = *(const f32x4*)cp * sg, c1 = *(const f32x4*)(cp + 4) * sg; cf[s] = pack8(c0, c1); }
            dsk = *(const f32x4*)(gin(p, 13) + g * SGC + 4 * g4); }
        const size_t tok0 = (size_t)b * SEQ + (size_t)n * S5L;
        u32x4 pre[2];
        { const bf16* src = X + (tok0 + lane) * D + g * SGC; pre[0] = *(const u32x4*)src; pre[1] = *(const u32x4*)(src + 8); }
        for (int sub = 0; sub < S5L / 64; ++sub) {
            *(LAS u32x4*)(ut + lane * 16) = pre[0]; *(LAS u32x4*)(ut + lane * 16 + 8) = pre[1];
            if (sub + 1 < S5L / 64) { const bf16* src = X + (tok0 + (sub + 1) * 64 + lane) * D + g * SGC; pre[0] = *(const u32x4*)src; pre[1] = *(const u32x4*)(src + 8); }
            LDS_WAIT(); asm volatile("" ::: "memory");
#pragma unroll (OUT ? 1 : 4)
            for (int blk = 0; blk < 4; ++blk) {
                u32x4 uw = *(const LAS u32x4*)(ut + (blk * 16 + l15) * 16 + 8 * (g4 & 1));
                if (g4 >= 2) uw = (u32x4){0u, 0u, 0u, 0u};
                const bf16x8 ufr = __builtin_bit_cast(bf16x8, uw);
                f32x4 dr[4], di[4];
#pragma unroll
                for (int st = 0; st < 4; ++st) { dr[st] = MFMA16(ufr, bfrag[st], ((f32x4){0.f, 0.f, 0.f, 0.f})); di[st] = MFMA16(ufr, bfrag[st + 4], ((f32x4){0.f, 0.f, 0.f, 0.f})); }
                float vr[4], vi[4];
#pragma unroll
                for (int st = 0; st < 4; ++st) {
                    float hr = 0.f, hi = 0.f;
#pragma unroll
                    for (int i = 0; i < 4; ++i) { float nr, ni; cmul_add(nr, ni, a1r[st], a1i[st], hr, hi, dr[st][i], di[st][i]); hr = nr; hi = ni; dr[st][i] = hr; di[st][i] = hi; }
                    vr[st] = hr; vi[st] = hi; }
#define BPF(idx, v) __builtin_bit_cast(float, __builtin_amdgcn_ds_bpermute((idx), __builtin_bit_cast(int, (v))))
                { float xr[4], xi[4];
#pragma unroll
                  for (int st = 0; st < 4; ++st) { xr[st] = BPF(up16, vr[st]); xi[st] = BPF(up16, vi[st]); }
#pragma unroll
                  for (int st = 0; st < 4; ++st) { float tr, ti; cmul_add(tr, ti, a4r[st], a4i[st], xr[st], xi[st], vr[st], vi[st]); if (g4 >= 1) { vr[st] = tr; vi[st] = ti; } }
#pragma unroll
                  for (int st = 0; st < 4; ++st) { xr[st] = BPF(up32, vr[st]); xi[st] = BPF(up32, vi[st]); }
#pragma unroll
                  for (int st = 0; st < 4; ++st) { float tr, ti; cmul_add(tr, ti, a8r[st], a8i[st], xr[st], xi[st], vr[st], vi[st]); if (g4 >= 2) { vr[st] = tr; vi[st] = ti; } } }
                float er[4], ei[4], lr[4], li[4];
#pragma unroll
                for (int st = 0; st < 4; ++st) { if (OUT) { er[st] = BPF(up16, vr[st]); ei[st] = BPF(up16, vi[st]); } else { er[st] = 0.f; ei[st] = 0.f; } lr[st] = BPF(last16, vr[st]); li[st] = BPF(last16, vi[st]); }
#undef BPF
#pragma unroll
                for (int st = 0; st < 4; ++st) {
                    if (g4 == 0) { er[st] = 0.f; ei[st] = 0.f; }
                    if (OUT) { float s0r, s0i; cmul_add(s0r, s0i, pwr[st], pwi[st], sr[st], si[st], er[st], ei[st]);
#pragma unroll
                        for (int i = 0; i < 4; ++i) { float tr, ti; cmul_add(tr, ti, a1r[st], a1i[st], s0r, s0i, 0.f, 0.f); s0r = tr; s0i = ti; dr[st][i] += s0r; di[st][i] += s0i; } }
                    { float a16r, a16i; cmul_add(a16r, a16i, a8r[st], a8i[st], a8r[st], a8i[st], 0.f, 0.f); float tr, ti; cmul_add(tr, ti, a16r, a16i, sr[st], si[st], lr[st], li[st]); sr[st] = tr; si[st] = ti; }
                    if (OUT) {
#pragma unroll
                        for (int i = 0; i < 4; ++i) { const unsigned hw = pk2(dr[st][i], di[st][i]); Hb[(4 * g4 + i) * HLD + 16 * st + l15] = (bf16)hw; Hb[(4 * g4 + i) * HLD + 64 + 16 * st + l15] = (bf16)(hw >> 16); } }
                }
                if (OUT) {
                    LDS_WAIT(); asm volatile("" ::: "memory");
                    f32x4 ya = (f32x4){0.f, 0.f, 0.f, 0.f};
#pragma unroll
                    for (int s = 0; s < 4; ++s) ya = MFMA16(cf[s], row_frag(Hb, HLD, 0, 32 * s, lane), ya);
                    const u32x2 u2 = *(const LAS u32x2*)(ut + (blk * 16 + l15) * 16 + 4 * g4);
                    const f32x4 u4 = (f32x4){bflo(u2.x), bfhi(u2.x), bflo(u2.y), bfhi(u2.y)};
                    f32x4 y = ya + dsk * u4;
#pragma unroll
                    for (int j = 0; j < 4; ++j) { const float v = y[j]; y[j] = v / (1.0f + __expf(-1.5957691216057308f * (v + 0.044715f * v * v * v))); }
                    u32x2 o; o.x = pk2(y[0], y[1]); o.y = pk2(y[2], y[3]);
                    *(u32x2*)(ybuf + (tok0 + sub * 64 + blk * 16 + l15) * D + g * SGC + 4 * g4) = o;
                    asm volatile("" ::: "memory"); }
            }
            LDS_WAIT(); asm volatile("" ::: "memory");
        }
        if (!OUT && g4 == 0) {
#pragma unroll
            for (int st = 0; st < 4; ++st) { Eu[16 * st + l15] = sr[st]; Eu[64 + 16 * st + l15] = si[st]; } }
    }
}
__device__ __forceinline__ void phase_s5_carry(const Frame& F, KP p) {
    float* E = (float*)(F.ws + WS_AUX + AUX_S5E);
    for (int gt = F.vcu * NTHREADS + F.tid; gt < BATCH * SG * SP; gt += F.G * NTHREADS) {
        const int pl = gt & 63, bg = gt >> 6, g = bg & 63;
        const float dt = expf(gin(p, 14)[g]); const float are = gin(p, 7)[g * SP + pl], aim = gin(p, 8)[g * SP + pl];
        const float mag = expf(dt * are); float ar = mag * cosf(dt * aim), ai = mag * sinf(dt * aim);
#pragma unroll
        for (int q = 0; q < 8; ++q) { const float nr = ar * ar - ai * ai, ni = 2.0f * ar * ai; ar = nr; ai = ni; }
        float cr = 0.f, ci = 0.f;
        for (int n = 0; n < S5NC; ++n) { float* Eu = E + ((size_t)bg * S5NC + n) * 128; const float er = Eu[pl], ei = Eu[64 + pl];
            Eu[pl] = cr; Eu[64 + pl] = ci;
            const float nr = ar * cr - ai * ci + er, ni = ar * ci + ai * cr + ei; cr = nr; ci = ni; }
    }
}

constexpr int NPHASES = 34;
#ifndef PROBE_DRY14
#define PROBE_DRY14 0
#endif
#ifndef PROBE_DRY17
#define PROBE_DRY17 0
#endif
#ifndef PH_MASK
#define PH_MASK 0xFFFFFFFFu
#endif
#define PHT(t) ((PH_MASK >> (t)) & 1u)
constexpr int PLAN_OFF = 64;
__device__ __forceinline__ void moe_plan(const Frame& F, int layer) {
    volatile LAS int* tstart = (volatile LAS int*)(F.MISC + PLAN_OFF); volatile LAS int* cnts = tstart + 72;
    __syncthreads();
    if (F.wave == 0) {
        const unsigned* cnt = (const unsigned*)(F.ws + WS_CTL) + CW_CNT + layer * NE * 64;
        const int c = (int)__hip_atomic_load(cnt + F.lane * 64, __ATOMIC_RELAXED, __HIP_MEMORY_SCOPE_AGENT);
        int v = (c + 255) >> 8;
#pragma unroll
        for (int o = 1; o < 64; o <<= 1) { const int nb = __builtin_amdgcn_ds_bpermute((F.lane - o) << 2, v); if (F.lane >= o) v += nb; }
        tstart[F.lane + 1] = v; cnts[F.lane] = c;
        if (F.lane == 0) tstart[0] = 0;
        if (F.lane == 63) { tstart[65] = v + T / 256; cnts[64] = T; }
    }
    __syncthreads();
}
template <bool GATH> struct MoeSched2 {
    static constexpr bool GATHER = GATH, UNIFORMIZE = true, FP8 = GATH;
    static constexpr int ncol = GATH ? 2 : 4, K = GATH ? D / 2 : ED;
    const volatile LAS int* tstart; const volatile LAS int* cnts; int ntiles, G, c, lane;
    const char* Abase; const char* Wbase; const int* lists;
    __device__ __forceinline__ bool next(int i, pg8::UnitG& u) const {
        const int nwg = ntiles * ncol; const long L = (long)i * G + c; if (L >= nwg) return false;
        int wgid = (int)L; { const int q = nwg / 8, r = nwg % 8, xcd = wgid % 8, off = wgid / 8; wgid = (xcd < r ? xcd * (q + 1) : r * (q + 1) + (xcd - r) * q) + off; }
        const int tile = wgid / ncol, pn = wgid % ncol;
        const int ta = tstart[lane], tb = tstart[lane + 1];
        const unsigned long long mm = __ballot(ta <= tile && tile < tb);
        const int e = mm ? (int)__builtin_ctzll(mm) : 64;
        const int ts = __builtin_amdgcn_readfirstlane((int)tstart[e]), ce = __builtin_amdgcn_readfirstlane((int)cnts[e]);
        const int lt = tile - ts; int valid = ce - lt * 256; valid = valid > 256 ? 256 : valid;
        u.gshift = 0; u.aux = e;
        if (GATH) {
            u.B = Wbase + (size_t)e * WMOE_E_BYTES + (size_t)pn * 256 * K * 2;
            if (e < 64) { u.A = Abase; u.gidx = lists + (size_t)e * T + lt * 256; u.gcnt = valid; }
            else { u.A = Abase + (size_t)lt * 256 * K * 2; u.gidx = nullptr; u.gcnt = 0; }
            u.row0 = tile * 256; u.col0 = pn * 128;
        } else {
            u.B = Wbase + (size_t)e * WMOE_E_BYTES + (size_t)512 * 1024 * 2 + (size_t)pn * 256 * K * 2;
            u.A = Abase + (size_t)tile * 256 * K * 2; u.gidx = nullptr; u.gcnt = valid;
            u.row0 = tile * 256; u.col0 = pn * 256;
        }
        return true;
    }
};
__device__ __forceinline__ void phase_load_x(const Frame& F, KP p) {
    const float* xin = gin(p, 0); bf16* XB = (bf16*)(F.ws + WS_XB);
    for (size_t i = (size_t)F.vcu * NTHREADS + F.tid; i < (size_t)T * D / 8; i += (size_t)F.G * NTHREADS) {
        const f32x4 a = *(const f32x4*)(xin + i * 8), b = *(const f32x4*)(xin + i * 8 + 4);
        *(u32x4*)(XB + i * 8) = pack_bf16x8(a, b);
        u32x2 q8; q8.x = pk4_fp8(a[0], a[1], a[2], a[3]); q8.y = pk4_fp8(b[0], b[1], b[2], b[3]); *(u32x2*)((unsigned char*)(F.ws + WS_X) + i * 8) = q8; }
}

__global__ void __launch_bounds__(NTHREADS, 2) fwd_kernel(Params p_unused) {
    KP p0 = (KP)__builtin_amdgcn_kernarg_segment_ptr();
    extern __shared__ __attribute__((aligned(16))) unsigned char lds_raw[];
    Frame F0;
    F0.lds = (LAS unsigned char*)lds_raw; F0.MISC = (volatile LAS unsigned*)(F0.lds + MISC_OFF);
    F0.tid = threadIdx.x; F0.lane = F0.tid & 63; F0.wave = __builtin_amdgcn_readfirstlane(F0.tid >> 6);
    F0.G = gridDim.x; { const int bq = blockIdx.x; F0.vcu = (F0.G % 8 == 0) ? (bq % 8) * (F0.G / 8) + bq / 8 : bq; }
    F0.ws = p0->ws;
    const int bx0 = blockIdx.x;
    for (int u = F0.tid; u < (LDS_BYTES - MISC_OFF) / 4; u += NTHREADS) ((LAS unsigned*)(F0.lds + MISC_OFF))[u] = 0u;
    __syncthreads();
    XcdBarrier bar; bar.bar = (unsigned*)(p0->ws + WS_CTL) + CW_BAR; bar.x = 0; bar.st = nullptr;
    const int use_bar = p0->use_bar;
    if (use_bar) bar = xcd_barrier_post((unsigned*)(p0->ws + WS_CTL) + CW_BAR, F0.MISC + 8);
    const int lo = p0->ph_lo, hi = p0->ph_hi;
#define PHASE_BEGIN Frame F = F0; KP p = p0; { unsigned ones_ = ~0u; asm volatile("" : "+s"(ones_)); F.lane = (int)__builtin_amdgcn_mbcnt_hi(ones_, __builtin_amdgcn_mbcnt_lo(ones_, 0u)); } asm volatile("" : "+v"(F.lane)); F.tid = F.wave * 64 + F.lane; asm volatile("" : "+v"(F.tid));   GAS unsigned char* wsg_ = (GAS unsigned char*)F0.ws; asm volatile("" : "+s"(F.wave), "+s"(F.vcu), "+s"(F.G), "+s"(wsg_), "+s"(p)); \
    F.ws = (unsigned char*)wsg_; int bx = bx0; asm volatile("" : "+s"(bx)); unsigned char* ws = F.ws; (void)ws; (void)bx;
#pragma unroll 1
    for (int ph = lo; ph < hi; ++ph) {
        int layer = 0, type = 0;
        if (ph > 0) { layer = ph >= 26 ? 3 : (ph >= 18 ? 2 : (ph >= 9 ? 1 : 0)); const int q = ph - (layer == 3 ? 26 : (layer == 2 ? 18 : (layer == 1 ? 9 : 1))); const int kind = layer % 3;
            if (kind == 0) type = q < 4 ? 1 + q : 14 + (q - 4); else if (kind == 1) type = q < 5 ? 5 + q : 14 + (q - 5); else type = q < 4 ? 10 + q : 14 + (q - 4); }
        const int j = layer / 3;
#ifdef REPEAT_MASK
        const int nrep = ((REPEAT_MASK >> type) & 1u) ? 2 : 1;
#else
        const int nrep = 1;
#endif
#pragma unroll 1
        for (int rep = 0; rep < nrep; ++rep) {
        if (rep > 0 && use_bar) xcd_barrier(bar);
        if (PHT(0) && type == 0) { PHASE_BEGIN; phase_conv_mixers(F, p); phase_conv_moe(F, p, 0); phase_load_x(F, p); }
        else if (PHT(1) && type == 1) { PHASE_BEGIN; DenseSched8 S; S.init(ws + WS_X, ws + WS_ATT_IN_T + (size_t)j * ATT_IN * D, T, ATT_IN, D / 2, F.G, bx); EpiStoreBf16 E{(bf16*)(ws + WS_BIG), ATT_IN, WUP_INV, 0.08838834764831845f};
            pg8::gemm_phase(F.lds, F.tid, D / 2, S, E); }
        else if (PHT(2) && type == 2) { PHASE_BEGIN; phase_attn(F, bx); }
        else if (PHT(3) && type == 3) { PHASE_BEGIN; phase_attn_combine(F); }
        else if (PHT(4) && type == 4) { PHASE_BEGIN; DenseSched S; S.init(ws + WS_AUX + AUX_OB, ws + WS_ATT_OUT_T + (size_t)j * D * D * 2, T, D, D, F.G, bx); EpiResid E{(const bf16*)(ws + WS_XB), (bf16*)(ws + WS_Y)};
            pg8::gemm_phase(F.lds, F.tid, D, S, E); }
        else if (PHT(5) && type == 5) { PHASE_BEGIN; DenseSched8 S; S.init(ws + WS_X, ws + WS_RET_IN_T, T, RET_IN, D / 2, F.G, bx); EpiRetIn E{(bf16*)(ws + WS_BIG), RET_IN};
            pg8::gemm_phase(F.lds, F.tid, D / 2, S, E); }
        else if (PHT(6) && type == 6) { PHASE_BEGIN; phase_ret_u(F); }
        else if (PHT(7) && type == 7) { PHASE_BEGIN; phase_ret_scan(F); }
        else if (PHT(8) && type == 8) { PHASE_BEGIN; phase_ret_out(F, p); }
        else if (PHT(9) && type == 9) { PHASE_BEGIN; DenseSched S; S.init(ws + WS_BIG + BIG_YRET, ws + WS_RET_OUT_T, T, D, RET_V, F.G, bx); EpiResid E{(const bf16*)(ws + WS_XB), (bf16*)(ws + WS_Y)};
            pg8::gemm_phase(F.lds, F.tid, RET_V, S, E); }
        else if (PHT(10) && type == 10) { PHASE_BEGIN; phase_s5_scan<false>(F, p); }
        else if (PHT(11) && type == 11) { PHASE_BEGIN; phase_s5_carry(F, p); }
        else if (PHT(12) && type == 12) { PHASE_BEGIN; phase_s5_scan<true>(F, p); }
        else if (PHT(13) && type == 13) { PHASE_BEGIN; DenseSched S; S.init(ws + WS_AUX, ws + WS_GLU_T, T, 2 * D, D, F.G, bx); EpiGluResid E{(const bf16*)(ws + WS_XB), (bf16*)(ws + WS_Y)};
            pg8::gemm_phase(F.lds, F.tid, D, S, E); }
        else if (PHT(14) && type == 14) { PHASE_BEGIN; phase_lnr(F, p, layer, PROBE_DRY14 && true); if (PROBE_DRY14) { if (use_bar) xcd_barrier(bar); phase_lnr(F, p, layer, false); } }
        else if (PHT(15) && type == 15) { PHASE_BEGIN; moe_plan(F, layer);
            MoeSched2<true> S; S.tstart = (const volatile LAS int*)(F.MISC + PLAN_OFF); S.cnts = S.tstart + 72; S.ntiles = __builtin_amdgcn_readfirstlane((int)S.tstart[65]); S.G = F.G; S.c = bx; S.lane = F.lane;
            S.Abase = (const char*)(ws + WS_X); S.Wbase = (const char*)(ws + WS_WMOE); S.lists = (const int*)(ws + WS_LIST);
            EpiMoeUp E{(bf16*)(ws + WS_H)};
            pg8::gemm_phase(F.lds, F.tid, D / 2, S, E); }
        else if (PHT(16) && type == 16) { PHASE_BEGIN; moe_plan(F, layer);
            { MoeSched2<false> S; S.tstart = (const volatile LAS int*)(F.MISC + PLAN_OFF); S.cnts = S.tstart + 72; S.ntiles = __builtin_amdgcn_readfirstlane((int)S.tstart[64]); S.G = F.G; S.c = bx; S.lane = F.lane;
              S.Abase = (const char*)(ws + WS_H); S.Wbase = (const char*)(ws + WS_WMOE); S.lists = (const int*)(ws + WS_LIST);
              EpiStoreFp8 E{(unsigned char*)(ws + WS_BIG), D};
              pg8::gemm_phase(F.lds, F.tid, ED, S, E); }
            { const int sh0 = __builtin_amdgcn_readfirstlane((int)((const volatile LAS int*)(F.MISC + PLAN_OFF))[64]);
              DenseSched S; S.init(ws + WS_H + (size_t)sh0 * 256 * ED * 2, ws + WS_WMOE + (size_t)64 * WMOE_E_BYTES + (size_t)512 * 1024 * 2, T, D, ED, F.G, bx); EpiResid E{(const bf16*)(ws + WS_XB), (bf16*)(ws + WS_Y)};
              pg8::gemm_phase(F.lds, F.tid, ED, S, E); } }
        else if (PHT(17) && type == 17) { PHASE_BEGIN; moe_plan(F, layer); if (PROBE_DRY17) { phase_combine(F, p, layer, true); if (use_bar) xcd_barrier(bar); } phase_combine(F, p, layer); if (layer + 1 < DEPTH) phase_conv_moe(F, p, layer + 1); }
        }
        if (use_bar && ph + 1 < hi) xcd_barrier(bar);
    }
}

#ifndef MK_PER_PHASE
#define MK_PER_PHASE 0
#endif
extern "C" void kernel_launch(void* const* d_in, const int* in_sizes, int n_in, void* d_out, int out_size, void* d_ws, size_t ws_size, hipStream_t stream) {
    static int grid = 0;
    if (grid == 0) {
        if (n_in != 26 || in_sizes[0] != T * D || out_size != T * D || ws_size < WS_END) { fprintf(stderr, "kernel_launch: unexpected shapes / workspace (n_in %d, in0 %d, out %d, ws %zu < %zu)\n", n_in, n_in > 0 ? in_sizes[0] : -1, out_size, ws_size, (size_t)WS_END); grid = -1; return; }
        int dev = 0, cus = 0, per_cu = 0;
        if (hipGetDevice(&dev) != hipSuccess || hipDeviceGetAttribute(&cus, hipDeviceAttributeMultiprocessorCount, dev) != hipSuccess) { grid = -1; return; }
        if (hipFuncSetAttribute((const void*)fwd_kernel, hipFuncAttributeMaxDynamicSharedMemorySize, LDS_BYTES) != hipSuccess) { fprintf(stderr, "kernel_launch: hipFuncSetAttribute failed\n"); grid = -1; return; }
        if (hipOccupancyMaxActiveBlocksPerMultiprocessor(&per_cu, (const void*)fwd_kernel, NTHREADS, LDS_BYTES) != hipSuccess || per_cu < 1) { fprintf(stderr, "kernel_launch: occupancy query says %d blocks per CU\n", per_cu); per_cu = 1; }
        (void)hipGetLastError();
        grid = cus;
    }
    if (grid < 0) return;
    (void)hipMemsetAsync((char*)d_ws + WS_CTL, 0, CTL_ZERO_BYTES, stream);
    Params p{};
    for (int i = 0; i < 26; ++i) p.in[i] = (const float*)d_in[i];
    p.out = (float*)d_out; p.ws = (unsigned char*)d_ws;
#if MK_PER_PHASE
    for (int k = 0; k < NPHASES; ++k) { p.ph_lo = k; p.ph_hi = k + 1; p.use_bar = 0; hipLaunchKernelGGL(fwd_kernel, dim3(grid), dim3(NTHREADS), LDS_BYTES, stream, p); }
#else
    p.ph_lo = 0; p.ph_hi = NPHASES; p.use_bar = 1;
    hipLaunchKernelGGL(fwd_kernel, dim3(grid), dim3(NTHREADS), LDS_BYTES, stream, p);
#endif
}
```

```cpp
#include <hip/hip_runtime.h>
#include <cstdio>
#include <cstdint>

#define LAS __attribute__((address_space(3)))
#define GAS __attribute__((address_space(1)))
typedef unsigned short bf16;
typedef short bf16x8 __attribute__((ext_vector_type(8)));
typedef short bf16x4 __attribute__((ext_vector_type(4)));
typedef float f32x4 __attribute__((ext_vector_type(4)));
typedef float f32x2 __attribute__((ext_vector_type(2)));
typedef unsigned u32x4 __attribute__((ext_vector_type(4)));
typedef unsigned u32x2 __attribute__((ext_vector_type(2)));
typedef GAS unsigned gu32;

constexpr int D = 1024, BATCH = 2, SEQ = 8192, T = BATCH * SEQ, DEPTH = 4;
constexpr int AH = 8, AHD = 128, ATT_IN = 9216;
constexpr int RH = 4, RDK = 256, RDV = 512, RET_IN = 6144, RET_V = 2048, RC = 128, RNC = SEQ / RC;
constexpr int SG = 64, SGC = 16, SP = 64;
constexpr int NE = 64, TOPK = 8, NEG = 8, ED = 256, NSLOT = 9;
constexpr float LN_EPS = 1e-5f;
constexpr float ALPHA = 1.6817928305074292f;
constexpr int NWAVES = 8, NTHREADS = 512;

__device__ __forceinline__ unsigned f2bf(float f) { unsigned u = __builtin_bit_cast(unsigned, f); return (u + 0x7fffu + ((u >> 16) & 1u)) >> 16; }
__device__ __forceinline__ unsigned pk2(float lo, float hi) { unsigned r; asm("s_nop 1\n\tv_cvt_pk_bf16_f32 %0, %1, %2" : "=v"(r) : "v"(lo), "v"(hi)); return r; }
__device__ __forceinline__ unsigned pk2sw(float lo, float hi) { return f2bf(lo) | (f2bf(hi) << 16); }
__device__ __forceinline__ unsigned pk2hw(float lo, float hi) { unsigned r; asm volatile("v_cvt_pk_bf16_f32 %0, %1, %2" : "=v"(r) : "v"(lo), "v"(hi)); return r; }
__device__ __forceinline__ float bf2f(unsigned b) { return __builtin_bit_cast(float, b << 16); }
__device__ __forceinline__ float bflo(unsigned w) { return __builtin_bit_cast(float, w << 16); }
__device__ __forceinline__ float bfhi(unsigned w) { return __builtin_bit_cast(float, w & 0xffff0000u); }
__device__ __forceinline__ float shx(float v, int m, int lane) { return __builtin_bit_cast(float, __builtin_amdgcn_ds_bpermute((lane ^ m) << 2, __builtin_bit_cast(int, v))); }
__device__ __forceinline__ int shx_i(int v, int m, int lane) { return __builtin_amdgcn_ds_bpermute((lane ^ m) << 2, v); }
__device__ __forceinline__ float rdl(float v, int src) { return __builtin_bit_cast(float, __builtin_amdgcn_readlane(__builtin_bit_cast(int, v), src)); }
template <int CTRL, int RM = 0xf, int BM = 0xf> __device__ __forceinline__ float dpp0(float v) { return __builtin_bit_cast(float, __builtin_amdgcn_update_dpp(0, __builtin_bit_cast(int, v), CTRL, RM, BM, true)); }
template <int CTRL, int RM = 0xf, int BM = 0xf> __device__ __forceinline__ float dppo(float old, float v) { return __builtin_bit_cast(float, __builtin_amdgcn_update_dpp(__builtin_bit_cast(int, old), __builtin_bit_cast(int, v), CTRL, RM, BM, false)); }
__device__ __forceinline__ float wave_sum(float v, int lane) {
    (void)lane;
    v += dpp0<0x111>(v); v += dpp0<0x112>(v); v += dpp0<0x114>(v); v += dpp0<0x118>(v);
    v += dpp0<0x142, 0xa>(v);
    v += dpp0<0x143, 0xc>(v);
    return rdl(v, 63);
}
__device__ __forceinline__ float max8(float v) {
    v = fmaxf(v, dppo<0xb1>(v, v)); v = fmaxf(v, dppo<0x4e>(v, v)); v = fmaxf(v, dppo<0x141>(v, v)); return v;
}
#define LDS_WAIT() asm volatile("s_waitcnt lgkmcnt(0)" ::: "memory")
#define VM_WAIT() asm volatile("s_waitcnt vmcnt(0)" ::: "memory")
__device__ __forceinline__ const char* rfl_ptr(const char* p) {
    unsigned long long v = (unsigned long long)p; unsigned lo = __builtin_amdgcn_readfirstlane((unsigned)v), hi = __builtin_amdgcn_readfirstlane((unsigned)(v >> 32));
    return (const char*)(((unsigned long long)hi << 32) | lo);
}
__device__ __forceinline__ bf16x8 row_frag(const LAS bf16* base, int ld, int row0, int col0, int lane) {
    return *(const LAS bf16x8*)(base + (row0 + (lane & 15)) * ld + col0 + 8 * (lane >> 4));
}
__device__ __forceinline__ bf16x4 tr4(const LAS bf16* addr) { return __builtin_amdgcn_ds_read_tr16_b64_v4i16((LAS bf16x4*)addr); }
__device__ __forceinline__ bf16x8 cat8(bf16x4 a, bf16x4 b) { bf16x8 r; r[0] = a[0]; r[1] = a[1]; r[2] = a[2]; r[3] = a[3]; r[4] = b[0]; r[5] = b[1]; r[6] = b[2]; r[7] = b[3]; return r; }
#define MFMA16(a, b, c) __builtin_amdgcn_mfma_f32_16x16x32_bf16((a), (b), (c), 0, 0, 0)
__device__ __forceinline__ bf16x8 pack8(f32x4 a, f32x4 b) {
    u32x4 w; w.x = pk2(a[0], a[1]); w.y = pk2(a[2], a[3]); w.z = pk2(b[0], b[1]); w.w = pk2(b[2], b[3]); return __builtin_bit_cast(bf16x8, w);
}

namespace pg8 {
typedef int v4i_t __attribute__((ext_vector_type(4)));
typedef int v8i_t __attribute__((ext_vector_type(8)));
constexpr int BM = 256, BK = 64, HALF = 128, HTB = HALF * BK * 2, STAGE_BYTES = 8 * HTB;
__device__ __forceinline__ int lds_byte(int r, int c) { const int st = (r >> 4) * 2 + (c >> 5), rr = r & 15, cc = c & 31, ob = rr * 64 + cc * 2; return st * 1024 + (ob ^ (((ob >> 9) & 1) << 5)); }
__device__ __forceinline__ void stage_rc(int b, int& R, int& C) { const int st = b / 1024, sb = b % 1024, swz = sb ^ (((sb >> 9) & 1) << 5); R = (st >> 1) * 16 + swz / 64; C = (st & 1) * 32 + (swz % 64) / 2; }
__device__ __forceinline__ int perm32(int rho) { const int n = rho >> 4, i = rho & 15; return 8 * (i >> 2) + 4 * n + (i & 3); }

struct UnitG {
    const char* A;
    const char* B;
    const int* gidx;
    int gcnt, gshift;
    int row0, col0;
    int aux;
};

__device__ __forceinline__ void uniformize(UnitG& u) { u.A = rfl_ptr(u.A); u.B = rfl_ptr(u.B); u.gidx = (const int*)rfl_ptr((const char*)u.gidx); u.gcnt = __builtin_amdgcn_readfirstlane(u.gcnt); u.gshift = __builtin_amdgcn_readfirstlane(u.gshift);
    u.row0 = __builtin_amdgcn_readfirstlane(u.row0); u.col0 = __builtin_amdgcn_readfirstlane(u.col0); u.aux = __builtin_amdgcn_readfirstlane(u.aux); }
template <class Epi, class Sched>
__device__ __forceinline__ void gemm_phase(LAS unsigned char* lds, const int tid, const int K, const Sched& S, const Epi& E) {
    constexpr bool F8 = Sched::FP8;
    constexpr bool GATHER = Sched::GATHER;
    const int wid = __builtin_amdgcn_readfirstlane(tid >> 6), lane = tid & 63, wr = wid >> 2, wc = wid & 3, fr = lane & 15, fq = lane >> 4;
    const int nt = K / BK;
    constexpr bool P16 = Epi::PERM16;
    unsigned voffB[2], voffB1[2], vA[2][2];
#pragma unroll
    for (int i = 0; i < 2; ++i) { int R, C; stage_rc(tid * 16 + i * 8192, R, C); const int Rb = Epi::PERM ? ((R & ~31) + perm32(R & 31)) : R; voffB[i] = (unsigned)(Rb * K + C) * 2u; voffB1[i] = voffB[i]; vA[0][i] = (unsigned)(R * K + C) * 2u; vA[1][i] = vA[0][i];
        if constexpr (P16) { const int x = R & 31, src = 64 * (R >> 5) + 16 * ((x >> 2) & 3) + 4 * (x >> 4) + (x & 3); voffB[i] = (unsigned)(src * K + C) * 2u; voffB1[i] = (unsigned)((src + 8) * K + C) * 2u; } }
    const size_t kstep = (size_t)(BK * 2);
    const size_t hstep = (size_t)HALF * K * 2;
    const size_t hstepB = P16 ? 0 : hstep;
    const size_t hstepA = GATHER ? 0 : hstep;
    const unsigned ldsw = (unsigned)wid * 1024u;
    const int aoff = F8 ? lds_byte(wr * 64 + fr, fq * 16) : lds_byte(wr * 64 + fr, fq * 8), boff = F8 ? lds_byte(wc * 32 + fr, fq * 16) : lds_byte(wc * 32 + fr, fq * 8);
    LAS u32x4* park = (LAS u32x4*)(lds + STAGE_BYTES) + tid;
#define PG8_SA(b, h) (((b) * 2 + (h)) * HTB)
#define PG8_SB(b, h) ((4 + (b) * 2 + (h)) * HTB)
#define PG8_STAGE(bufoff, gbase, voff) do { _Pragma("unroll") for (int _i = 0; _i < 2; ++_i) { asm volatile("" : "+v"((voff)[_i]));   \
        __builtin_amdgcn_global_load_lds((const unsigned*)((const char*)(gbase) + (voff)[_i]), (LAS unsigned*)(lds + (bufoff) + ldsw + _i * 8192), 16, 0, 0); } } while (0)
    constexpr int FKS = F8 ? 16 : 1024;
#define PG8_LD2(p_) __builtin_shufflevector(*(const LAS v4i_t*)(p_), *(const LAS v4i_t*)((p_) + FKS), 0, 1, 2, 3, 4, 5, 6, 7)
#define PG8_LDA(dst, b, h) do { _Pragma("unroll") for (int m = 0; m < 4; ++m) dst[m] = PG8_LD2(lds + PG8_SA(b, h) + aoff + m * 2048); } while (0)
#define PG8_LDB(dst, b, h) do { _Pragma("unroll") for (int n = 0; n < 2; ++n) dst[n] = PG8_LD2(lds + PG8_SB(b, h) + boff + n * 2048); } while (0)
#define PG8_LO(v) __builtin_bit_cast(bf16x8, __builtin_shufflevector((v), (v), 0, 1, 2, 3))
#define PG8_HI(v) __builtin_bit_cast(bf16x8, __builtin_shufflevector((v), (v), 4, 5, 6, 7))
#define PG8_MMA(ai, bj, At, Bt) do { __builtin_amdgcn_s_setprio(1); _Pragma("unroll") for (int m = 0; m < 4; ++m) _Pragma("unroll") for (int n = 0; n < 2; ++n) { \
        if constexpr (F8) { acc[ai][bj][m][n] = __builtin_amdgcn_mfma_scale_f32_16x16x128_f8f6f4(Bt[n], At[m], acc[ai][bj][m][n], 0, 0, 0, 0x7F7F7F7F, 0, 0x7F7F7F7F); } \
        else { acc[ai][bj][m][n] = __builtin_amdgcn_mfma_f32_16x16x32_bf16(PG8_LO(Bt[n]), PG8_LO(At[m]), acc[ai][bj][m][n], 0, 0, 0); \
               acc[ai][bj][m][n] = __builtin_amdgcn_mfma_f32_16x16x32_bf16(PG8_HI(Bt[n]), PG8_HI(At[m]), acc[ai][bj][m][n], 0, 0, 0); } } __builtin_amdgcn_s_setprio(0); } while (0)
#define PG8_WAIT_V(n) asm volatile("s_waitcnt vmcnt(" #n ")" ::: "memory")
#define PG8_WAIT_L(n) asm volatile("s_waitcnt lgkmcnt(" #n ")" ::: "memory")
#define PG8_BAR __builtin_amdgcn_s_barrier()
#define PG8_SCHED __builtin_amdgcn_sched_barrier(0)
#define PG8_VOFF(u, v00, v01, v10, v11) do { int _R0, _C0, _R1, _C1; stage_rc(tid * 16, _R0, _C0); stage_rc(tid * 16 + 8192, _R1, _C1); int _r00 = _R0, _r01 = _R1, _r10 = HALF + _R0, _r11 = HALF + _R1; \
        if ((u).gidx) { const GAS int* _gp = (const GAS int*)(u).gidx; const int _gc = (u).gcnt;     \
            const int _a = _gp[_r00 < _gc ? _r00 : 0] >> (u).gshift, _b = _gp[_r01 < _gc ? _r01 : 0] >> (u).gshift, _c = _gp[_r10 < _gc ? _r10 : 0] >> (u).gshift, _d = _gp[_r11 < _gc ? _r11 : 0] >> (u).gshift; \
            _r00 = _a; _r01 = _b; _r10 = _c; _r11 = _d; } \
        v00 = (unsigned)(_r00 * K + _C0) * 2u; v01 = (unsigned)(_r01 * K + _C1) * 2u; v10 = (unsigned)(_r10 * K + _C0) * 2u; v11 = (unsigned)(_r11 * K + _C1) * 2u; } while (0)
    UnitG cur, nxt; int ui = 0;
    if (!S.next(0, cur)) return;
    if constexpr (Sched::UNIFORMIZE) uniformize(cur);
    f32x4 acc[2][2][4][2];
#pragma unroll
    for (int a = 0; a < 2; ++a)
#pragma unroll
        for (int b = 0; b < 2; ++b)
#pragma unroll
            for (int m = 0; m < 4; ++m)
#pragma unroll
                for (int n = 0; n < 2; ++n) acc[a][b][m][n] = (f32x4){0.f, 0.f, 0.f, 0.f};
    v8i_t At[4], B0[2], B1[2];
    if constexpr (GATHER) PG8_VOFF(cur, vA[0][0], vA[0][1], vA[1][0], vA[1][1]);
    const char* cA = cur.A; const char* cB = cur.B;
    PG8_STAGE(PG8_SB(0, 0), cB, voffB); PG8_STAGE(PG8_SB(0, 1), cB + hstepB, voffB1); PG8_STAGE(PG8_SA(0, 0), cA, vA[0]); PG8_STAGE(PG8_SA(0, 1), cA + hstepA, vA[1]);
    if (wr == 1) PG8_BAR;
    PG8_WAIT_V(2); PG8_BAR;
    PG8_STAGE(PG8_SB(1, 0), cB + kstep, voffB); PG8_STAGE(PG8_SA(1, 0), cA + kstep, vA[0]); PG8_STAGE(PG8_SB(1, 1), cB + hstepB + kstep, voffB1);
    PG8_WAIT_V(6); PG8_BAR;
    for (;;) {
        const bool has_next = S.next(ui + 1, nxt);
        if constexpr (Sched::UNIFORMIZE) { if (has_next) uniformize(nxt); }
        const char* nA = cA; const char* nB = cB;
        if (has_next) { nA = nxt.A; nB = nxt.B; }
        if constexpr (GATHER) { u32x4 pv; pv.x = vA[0][0]; pv.y = vA[0][1]; pv.z = vA[1][0]; pv.w = vA[1][1];
            if (has_next) PG8_VOFF(nxt, pv.x, pv.y, pv.z, pv.w);
            *park = pv; }
#pragma unroll 1
        for (int t = 0; t < nt; t += 2) {
            const bool last = (t == nt - 2);
            const char* a1 = cA + (size_t)(t + 1) * kstep;
            const char* a2 = last ? nA : cA + (size_t)(t + 2) * kstep; const char* b2 = last ? nB : cB + (size_t)(t + 2) * kstep;
            const char* a3 = a2 + kstep; const char* b3 = b2 + kstep;
            PG8_LDB(B0, 0, 0); PG8_LDB(B1, 0, 1); PG8_SCHED; PG8_LDA(At, 0, 0); PG8_STAGE(PG8_SA(1, 1), a1 + hstepA, vA[1]);
            PG8_WAIT_V(8); PG8_WAIT_L(0); PG8_BAR; PG8_MMA(0, 0, At, B0); PG8_MMA(0, 1, At, B1); PG8_BAR; PG8_SCHED;
            if constexpr (GATHER) { if (last) { const u32x4 pv = *park; vA[0][0] = pv.x; vA[0][1] = pv.y; vA[1][0] = pv.z; vA[1][1] = pv.w; } }
            PG8_LDA(At, 0, 1); PG8_STAGE(PG8_SB(0, 0), b2, voffB); PG8_STAGE(PG8_SB(0, 1), b2 + hstepB, voffB1); PG8_STAGE(PG8_SA(0, 0), a2, vA[0]);
            PG8_WAIT_V(8); PG8_WAIT_L(0); PG8_BAR; PG8_MMA(1, 0, At, B0); PG8_MMA(1, 1, At, B1); PG8_BAR; PG8_SCHED;
            PG8_LDB(B0, 1, 0); PG8_LDB(B1, 1, 1); PG8_SCHED; PG8_LDA(At, 1, 0); PG8_STAGE(PG8_SA(0, 1), a2 + hstepA, vA[1]);
            PG8_WAIT_V(8); PG8_WAIT_L(0); PG8_BAR; PG8_MMA(0, 0, At, B0); PG8_MMA(0, 1, At, B1); PG8_BAR; PG8_SCHED;
            PG8_LDA(At, 1, 1); PG8_STAGE(PG8_SB(1, 0), b3, voffB); PG8_STAGE(PG8_SB(1, 1), b3 + hstepB, voffB1); PG8_STAGE(PG8_SA(1, 0), a3, vA[0]);
            PG8_WAIT_V(8); PG8_WAIT_L(0); PG8_BAR; PG8_MMA(1, 0, At, B0); PG8_MMA(1, 1, At, B1); PG8_BAR; PG8_SCHED;
        }
        if (wr == 0) PG8_BAR;
        E(acc, cur, wr, wc, fr, fq);
        if (!has_next) break;
#pragma unroll
        for (int a = 0; a < 2; ++a)
#pragma unroll
            for (int b = 0; b < 2; ++b)
#pragma unroll
                for (int m = 0; m < 4; ++m)
#pragma unroll
                    for (int n = 0; n < 2; ++n) acc[a][b][m][n] = (f32x4){0.f, 0.f, 0.f, 0.f};
        cur = nxt; cA = nA; cB = nB; ++ui;
        if (wr == 1) PG8_BAR;
    }
    PG8_WAIT_V(0);
    PG8_BAR;
#undef PG8_SA
#undef PG8_SB
#undef PG8_STAGE
#undef PG8_LDA
#undef PG8_LDB
#undef PG8_LD2
#undef PG8_LO
#undef PG8_HI
#undef PG8_MMA
#undef PG8_WAIT_V
#undef PG8_WAIT_L
#undef PG8_BAR
#undef PG8_SCHED
#undef PG8_VOFF
}
}

constexpr size_t MiB = 1u << 20;
constexpr size_t WS_CTL = 0, CTL_ZERO_BYTES = 1 * MiB;
constexpr size_t WS_ATT_IN_T = 1 * MiB;
constexpr size_t WS_ATT_OUT_T = WS_ATT_IN_T + 36 * MiB;
constexpr size_t WS_RET_IN_T = WS_ATT_OUT_T + 4 * MiB;
constexpr size_t WS_RET_OUT_T = WS_RET_IN_T + 12 * MiB;
constexpr size_t WS_GLU_T = WS_RET_OUT_T + 4 * MiB;
constexpr size_t WS_RT_HI = WS_GLU_T + 4 * MiB;
constexpr size_t WS_RT_LO = WS_RT_HI + 512 * 1024;
constexpr size_t WS_WMOE = WS_RT_HI + 1 * MiB;
constexpr size_t WMOE_E_BYTES = (size_t)(512 * 1024 + 1024 * 256) * 2;
constexpr size_t WS_X = WS_WMOE + 98 * MiB;
constexpr size_t WS_Y = WS_X + 64 * MiB;
constexpr size_t WS_XB = WS_Y + 64 * MiB;
constexpr size_t WS_BIG = WS_XB + 32 * MiB;
constexpr size_t WS_AUX = WS_BIG + 288 * MiB;
constexpr size_t WS_H = WS_AUX + 160 * MiB;
constexpr size_t WS_LIST = WS_H + 80 * MiB;
constexpr size_t WS_TRASH = WS_LIST + 8 * MiB;
constexpr size_t WS_END = WS_TRASH + 1 * MiB;
static_assert(WS_END <= 1024 * MiB, "workspace map");
constexpr int CW_BAR = 4096;
constexpr int CW_CNT = 16384;
constexpr int CW_CHK = 65536;
constexpr int HROWS = 163840;

#define XB_TMO      128
#define XB_XCNT(j)  (256  + 64 * (j))
#define XB_XSUB(j)  (1280 + 64 * (j))
#define XB_XGEN(j)  (2304 + 64 * (j))
#define XB_TOP      3328
#define XB_TOPGEN   3392
#define XCD_BAR_WORDS 3456
#define XB_SPIN_CAP (1u << 20)
__device__ __forceinline__ unsigned xb_ld(unsigned* p)              { return __hip_atomic_load(p, __ATOMIC_RELAXED, __HIP_MEMORY_SCOPE_AGENT); }
__device__ __forceinline__ unsigned xb_add(unsigned* p, unsigned v) { return __hip_atomic_fetch_add(p, v, __ATOMIC_RELAXED, __HIP_MEMORY_SCOPE_AGENT); }
__device__ __forceinline__ unsigned xb_xcc_id() { return (unsigned)__builtin_amdgcn_s_getreg((3 << 11) | 20) & 0xFu; }
#define XB_SPIN(cond, bar) do { unsigned _sp = 0; while (cond) { __builtin_amdgcn_s_sleep(1); \
    if ((++_sp & 255u) == 0u) { if (xb_ld(&(bar)[XB_TMO])) break; if (_sp > XB_SPIN_CAP) { atomicAdd(&(bar)[XB_TMO], 1u); break; } } } } while (0)
struct XcdBarrier { unsigned* bar; unsigned x; volatile LAS unsigned* st; };
__device__ __forceinline__ XcdBarrier xcd_barrier_post(unsigned* bar, volatile LAS unsigned* st) {
    XcdBarrier b; b.bar = bar; b.x = xb_xcc_id(); b.st = st;
    if (threadIdx.x == 0) (void)xb_add(&bar[XB_XCNT(b.x)], 1u);
    return b;
}
__device__ __forceinline__ void xcd_barrier_complete(unsigned* bar, unsigned x, unsigned& nloc, unsigned& nx) {
    const unsigned G = gridDim.x * gridDim.y * gridDim.z;
    unsigned sum, cnt, mine, sp = 0u;
    for (;;) {
        sum = 0u; cnt = 0u; mine = 0u;
#pragma unroll
        for (unsigned j = 0; j < 16; ++j) { const unsigned c = xb_ld(&bar[XB_XCNT(j)]); sum += c; cnt += (c > 0u) ? 1u : 0u; mine = (j == x) ? c : mine; }
        if (sum == G) break;
        __builtin_amdgcn_s_sleep(1);
        if ((++sp & 255u) == 0u) { if (xb_ld(&bar[XB_TMO])) break; if (sp > XB_SPIN_CAP) { atomicAdd(&bar[XB_TMO], 1u); break; } }
    }
    nloc = mine > 0u ? mine : 1u; nx = cnt > 0u ? cnt : 1u;
}
__device__ __forceinline__ void xcd_barrier(const XcdBarrier& b) {
    asm volatile("s_waitcnt vmcnt(0)" ::: "memory");
    __syncthreads();
    if (threadIdx.x == 0) {
        unsigned* bar = b.bar;
        __builtin_amdgcn_s_waitcnt(0);
        unsigned nloc = b.st[0], nx = b.st[1];
        if (nloc == 0u) { xcd_barrier_complete(bar, b.x, nloc, nx); b.st[0] = nloc; b.st[1] = nx; }
        const unsigned old = xb_add(&bar[XB_XSUB(b.x)], 1u);
        const unsigned gen = old / nloc;
        if (old + 1u == (gen + 1u) * nloc) {
            __builtin_amdgcn_fence(__ATOMIC_RELEASE, "agent");
            asm volatile("s_waitcnt vmcnt(0)" ::: "memory");
            const unsigned og = xb_add(&bar[XB_TOP], 1u);
            const unsigned tg = og / nx;
            if (og + 1u == (tg + 1u) * nx) xb_add(&bar[XB_TOPGEN], 1u);
            else XB_SPIN(xb_ld(&bar[XB_TOPGEN]) == tg, bar);
            __builtin_amdgcn_fence(__ATOMIC_ACQUIRE, "agent");
            xb_add(&bar[XB_XGEN(b.x)], 1u);
            asm volatile("s_waitcnt vmcnt(0)" ::: "memory");
        } else {
            XB_SPIN(xb_ld(&bar[XB_XGEN(b.x)]) == gen, bar);
            __builtin_amdgcn_fence(__ATOMIC_ACQUIRE, "agent");
            asm volatile("s_waitcnt vmcnt(0)" ::: "memory");
        }
    }
    __syncthreads();
}

constexpr int RING_BYTES = 139264;
constexpr int MISC_OFF = RING_BYTES;
constexpr int LDS_BYTES = 147456;
struct Params {
    const float* in[26]; float* out; unsigned char* ws; int ph_lo, ph_hi; int use_bar, pad;
};
typedef const __attribute__((address_space(4))) Params* KP;
__device__ __forceinline__ const float* gin(KP p, int i) { return (const float*)(const GAS float*)p->in[i]; }
__device__ __forceinline__ float* gout(KP p) { return (float*)(GAS float*)p->out; }
struct Frame {
    LAS unsigned char* lds; volatile LAS unsigned* MISC;
    int tid, lane, wave, vcu, G;
    unsigned char* ws;
};

template <bool F8_ = false> struct DenseSchedT {
    static constexpr bool GATHER = false, UNIFORMIZE = false, FP8 = F8_;
    const char* A; const char* Bt; int K, nM, nN, nwg, G, c;
    __device__ __forceinline__ void init(const void* A_, const void* Bt_, int M, int N, int K_, int G_, int c_) { A = (const char*)A_; Bt = (const char*)Bt_; K = K_; nM = M / 256; nN = N / 256; nwg = nM * nN; G = G_; c = c_; }
    __device__ __forceinline__ bool next(int i, pg8::UnitG& u) const {
        const long L = (long)i * G + c; if (L >= nwg) return false;
        int wgid = (int)L; { const int q = nwg / 8, r = nwg % 8, xcd = wgid % 8, off = wgid / 8; wgid = (xcd < r ? xcd * (q + 1) : r * (q + 1) + (xcd - r) * q) + off; }
        const int nig = 8 * nN, gid = wgid / nig, fm = gid * 8, gsz = (nM - fm) < 8 ? (nM - fm) : 8;
        const int pm = fm + ((wgid % nig) % gsz), pn = (wgid % nig) / gsz;
        u.A = A + (size_t)pm * 256 * K * 2; u.B = Bt + (size_t)pn * 256 * K * 2; u.gidx = nullptr; u.gcnt = 0; u.gshift = 0; u.row0 = pm * 256; u.col0 = pn * 256; u.aux = 0; return true;
    }
};
typedef DenseSchedT<false> DenseSched; typedef DenseSchedT<true> DenseSched8;
__device__ __forceinline__ u32x4 pack_bf16x8(const f32x4& v0, const f32x4& v1) { u32x4 w; w.x = pk2hw(v0[0], v0[1]); w.y = pk2hw(v0[2], v0[3]); w.z = pk2hw(v1[0], v1[1]); w.w = pk2hw(v1[2], v1[3]); return w; }

constexpr float WUP_SCALE = 32.0f, WUP_INV = 1.0f / 32.0f;
struct EpiStoreBf16 {
    static constexpr bool PERM = true, PERM16 = false;
    bf16* O; int ldc; float osc, qsc;
    __device__ __forceinline__ void operator()(const f32x4 (&acc)[2][2][4][2], const pg8::UnitG& u, int wr, int wc, int fr, int fq) const {
        const float sc = ((u.col0 % 3072) < 1024) ? osc * qsc : osc;
#pragma unroll
        for (int ai = 0; ai < 2; ++ai)
#pragma unroll
            for (int m = 0; m < 4; ++m) { bf16* rowp = O + (size_t)(u.row0 + ai * 128 + wr * 64 + m * 16 + fr) * ldc + u.col0 + wc * 32 + 8 * fq;
#pragma unroll
                for (int bj = 0; bj < 2; ++bj) *(u32x4*)(rowp + bj * 128) = pack_bf16x8(acc[ai][bj][m][0] * sc, acc[ai][bj][m][1] * sc); }
    }
};
constexpr float YEXP_SCALE = 32.0f, YEXP_INV = 1.0f / 32.0f;
struct EpiStoreFp8 {
    static constexpr bool PERM = false, PERM16 = true;
    unsigned char* O; int ldc;
    __device__ __forceinline__ void operator()(const f32x4 (&acc)[2][2][4][2], const pg8::UnitG& u, int wr, int wc, int fr, int fq) const {
#pragma unroll
        for (int ai = 0; ai < 2; ++ai)
#pragma unroll
            for (int m = 0; m < 4; ++m) { unsigned char* rowp = O + (size_t)(u.row0 + ai * 128 + wr * 64 + m * 16 + fr) * ldc + u.col0 + wc * 64 + 16 * fq;
                u32x4 w;
#pragma unroll
                for (int q = 0; q < 4; ++q) { f32x4 v = acc[ai][q >> 1][m][q & 1] * YEXP_SCALE;
#pragma unroll
                    for (int j = 0; j < 4; ++j) v[j] = fminf(fmaxf(v[j], -448.0f), 448.0f);
                    int d = 0; d = __builtin_amdgcn_cvt_pk_fp8_f32(v[0], v[1], d, false); d = __builtin_amdgcn_cvt_pk_fp8_f32(v[2], v[3], d, true); w[q] = (unsigned)d; }
                *(u32x4*)rowp = w; }
    }
};
struct EpiRetIn {
    static constexpr bool PERM = true, PERM16 = false;
    bf16* O; int ldc;
    __device__ __forceinline__ void operator()(const f32x4 (&acc)[2][2][4][2], const pg8::UnitG& u, int wr, int wc, int fr, int fq) const {
        float l2g = 0.f;
        float cs = WUP_INV;
        if (u.col0 < 2048) { const int h = (u.col0 & 1023) >> 8; const float g = 1.0f - exp2f(-5.0f - (float)h); l2g = log2f(g); if (u.col0 >= 1024) { l2g = -l2g; cs *= 0.0625f; } }
#pragma unroll
        for (int ai = 0; ai < 2; ++ai)
#pragma unroll
            for (int m = 0; m < 4; ++m) { const int row = u.row0 + ai * 128 + wr * 64 + m * 16 + fr; const float sc = exp2f(l2g * (float)(row & 127)) * cs;
                bf16* rowp = O + (size_t)row * ldc + u.col0 + wc * 32 + 8 * fq;
#pragma unroll
                for (int bj = 0; bj < 2; ++bj) *(u32x4*)(rowp + bj * 128) = pack_bf16x8(acc[ai][bj][m][0] * sc, acc[ai][bj][m][1] * sc); }
    }
};
__device__ __forceinline__ void unpack_bf16x8(const u32x4& w, f32x4& a, f32x4& b) { a[0] = bflo(w.x); a[1] = bfhi(w.x); a[2] = bflo(w.y); a[3] = bfhi(w.y); b[0] = bflo(w.z); b[1] = bfhi(w.z); b[2] = bflo(w.w); b[3] = bfhi(w.w); }
struct EpiResid {
    static constexpr bool PERM = true, PERM16 = false;
    const bf16* X; bf16* Y;
    __device__ __forceinline__ void operator()(const f32x4 (&acc)[2][2][4][2], const pg8::UnitG& u, int wr, int wc, int fr, int fq) const {
#pragma unroll
        for (int ai = 0; ai < 2; ++ai)
#pragma unroll
            for (int m = 0; m < 4; ++m) { const size_t off = (size_t)(u.row0 + ai * 128 + wr * 64 + m * 16 + fr) * D + u.col0 + wc * 32 + 8 * fq;
#pragma unroll
                for (int bj = 0; bj < 2; ++bj) { const u32x4 xw = *(const u32x4*)(X + off + bj * 128); f32x4 x0, x1; unpack_bf16x8(xw, x0, x1);
                    *(u32x4*)(Y + off + bj * 128) = pack_bf16x8(x0 * ALPHA + acc[ai][bj][m][0], x1 * ALPHA + acc[ai][bj][m][1]); }
                if (m == 3) asm volatile("" ::: "memory"); }
    }
};
struct EpiGluResid {
    static constexpr bool PERM = true, PERM16 = false;
    const bf16* X; bf16* Y;
    __device__ __forceinline__ void operator()(const f32x4 (&acc)[2][2][4][2], const pg8::UnitG& u, int wr, int wc, int fr, int fq) const {
#pragma unroll
        for (int ai = 0; ai < 2; ++ai)
#pragma unroll
            for (int m = 0; m < 4; ++m) { const size_t off = (size_t)(u.row0 + ai * 128 + wr * 64 + m * 16 + fr) * D + (u.col0 >> 1) + wc * 32 + 8 * fq;
                const u32x4 xw = *(const u32x4*)(X + off); f32x4 x0, x1; unpack_bf16x8(xw, x0, x1); f32x4 o0, o1;
#pragma unroll
                for (int j = 0; j < 4; ++j) { o0[j] = x0[j] * ALPHA + acc[ai][0][m][0][j] / (1.0f + __expf(-acc[ai][1][m][0][j])); o1[j] = x1[j] * ALPHA + acc[ai][0][m][1][j] / (1.0f + __expf(-acc[ai][1][m][1][j])); }
                *(u32x4*)(Y + off) = pack_bf16x8(o0, o1);
                if (m == 3) asm volatile("" ::: "memory"); }
    }
};
struct EpiMoeUp {
    static constexpr bool PERM = true, PERM16 = false;
    bf16* H;
    __device__ __forceinline__ void operator()(const f32x4 (&acc)[2][2][4][2], const pg8::UnitG& u, int wr, int wc, int fr, int fq) const {
#pragma unroll
        for (int ai = 0; ai < 2; ++ai)
#pragma unroll
            for (int m = 0; m < 4; ++m) { bf16* rowp = H + (size_t)(u.row0 + ai * 128 + wr * 64 + m * 16 + fr) * ED + u.col0 + wc * 32 + 8 * fq; f32x4 o[2];
#pragma unroll
                for (int n = 0; n < 2; ++n)
#pragma unroll
                    for (int j = 0; j < 4; ++j) { const float g = acc[ai][0][m][n][j] * WUP_INV, up = acc[ai][1][m][n][j] * WUP_INV; o[n][j] = g / (1.0f + __expf(-g)) * up; }
                *(u32x4*)rowp = pack_bf16x8(o[0], o[1]); }
    }
};

__device__ __forceinline__ unsigned pk4_fp8(float a, float b, float c, float d) {
    a = fminf(fmaxf(a, -448.0f), 448.0f); b = fminf(fmaxf(b, -448.0f), 448.0f); c = fminf(fmaxf(c, -448.0f), 448.0f); d = fminf(fmaxf(d, -448.0f), 448.0f);
    int w = 0; w = __builtin_amdgcn_cvt_pk_fp8_f32(a, b, w, false); w = __builtin_amdgcn_cvt_pk_fp8_f32(c, d, w, true); return (unsigned)w; }
template <bool HILO>
__device__ __forceinline__ void conv_item(const float* W, int ldw, bf16* WT, bf16* WTlo, int ldk, int k0, int n0, int drow0, float scale, LAS float* scr, int lane) {
#pragma unroll 8
    for (int i = 0; i < 32; ++i) { const int kk = 2 * i + (lane >> 5); scr[kk * 33 + (lane & 31)] = W[(size_t)(k0 + kk) * ldw + n0 + (lane & 31)] * scale; }
    LDS_WAIT(); asm volatile("" ::: "memory");
    const int c = lane & 7;
#pragma unroll
    for (int j = 0; j < 4; ++j) { const int n = (lane >> 3) + 8 * j; const LAS float* s = scr + (8 * c) * 33 + n;
        float v[8];
#pragma unroll
        for (int q = 0; q < 8; ++q) v[q] = s[q * 33];
        u32x4 o; o.x = pk2(v[0], v[1]); o.y = pk2(v[2], v[3]); o.z = pk2(v[4], v[5]); o.w = pk2(v[6], v[7]);
        *(u32x4*)(WT + (size_t)(drow0 + n) * ldk + k0 + 8 * c) = o;
        if (HILO) { float r[8];
#pragma unroll
            for (int q = 0; q < 8; ++q) r[q] = v[q] - bf2f(f2bf(v[q]));
            u32x4 o2; o2.x = pk2(r[0], r[1]); o2.y = pk2(r[2], r[3]); o2.z = pk2(r[4], r[5]); o2.w = pk2(r[6], r[7]);
            *(u32x4*)(WTlo + (size_t)(drow0 + n) * ldk + k0 + 8 * c) = o2; } }
    LDS_WAIT(); asm volatile("" ::: "memory");
}
__device__ __forceinline__ void conv_item8(const float* W, int ldw, unsigned char* WT, int ldk, int k0, int n0, int drow0, float scale, LAS float* scr, int lane) {
#pragma unroll 8
    for (int i = 0; i < 32; ++i) { const int kk = 2 * i + (lane >> 5); scr[kk * 33 + (lane & 31)] = W[(size_t)(k0 + kk) * ldw + n0 + (lane & 31)] * scale; }
    LDS_WAIT(); asm volatile("" ::: "memory");
    const int c = lane & 7;
#pragma unroll
    for (int j = 0; j < 4; ++j) { const int n = (lane >> 3) + 8 * j; const LAS float* s = scr + (8 * c) * 33 + n;
        float v[8];
#pragma unroll
        for (int q = 0; q < 8; ++q) v[q] = s[q * 33];
        u32x2 o; o.x = pk4_fp8(v[0], v[1], v[2], v[3]); o.y = pk4_fp8(v[4], v[5], v[6], v[7]);
        *(u32x2*)(WT + (size_t)(drow0 + n) * ldk + k0 + 8 * c) = o; }
    LDS_WAIT(); asm volatile("" ::: "memory");
}
__device__ __forceinline__ void phase_conv_mixers(const Frame& F, KP p) {
    LAS float* scr = (LAS float*)(F.lds + F.wave * 16384);
    const int gw = F.vcu * NWAVES + F.wave, NGW = F.G * NWAVES;
    constexpr int I_AIN = 16 * 288, I_AOUT = 16 * 32, I_RIN = 16 * 192, I_ROUT = 32 * 32, I_GLU = 16 * 64, I_RT = 16 * 2;
    constexpr int NITEMS = 2 * I_AIN + 2 * I_AOUT + I_RIN + I_ROUT + I_GLU + 4 * I_RT;
    unsigned char* ws = F.ws;
    for (int it = gw; it < NITEMS; it += NGW) {
        int r = it;
        if (r < 2 * I_AIN) { const int j = r / I_AIN; r %= I_AIN; const int kb = r / 288, nb = r % 288, n0 = nb * 32;
            conv_item8(gin(p, 1) + (size_t)j * D * ATT_IN, ATT_IN, (unsigned char*)(ws + WS_ATT_IN_T) + (size_t)j * ATT_IN * D, D, kb * 64, n0, n0, WUP_SCALE, scr, F.lane); continue; }
        r -= 2 * I_AIN;
        if (r < 2 * I_AOUT) { const int j = r / I_AOUT; r %= I_AOUT; const int kb = r / 32, nb = r % 32, n0 = nb * 32;
            conv_item<false>(gin(p, 2) + (size_t)j * D * D, D, (bf16*)(ws + WS_ATT_OUT_T) + (size_t)j * D * D, nullptr, D, kb * 64, n0, n0, 1.0f, scr, F.lane); continue; }
        r -= 2 * I_AOUT;
        if (r < I_RIN) { const int kb = r / 192, nb = r % 192, n0 = nb * 32;
            conv_item8(gin(p, 3), RET_IN, (unsigned char*)(ws + WS_RET_IN_T), D, kb * 64, n0, n0, WUP_SCALE, scr, F.lane); continue; }
        r -= I_RIN;
        if (r < I_ROUT) { const int kb = r / 32, nb = r % 32, n0 = nb * 32;
            conv_item<false>(gin(p, 6), D, (bf16*)(ws + WS_RET_OUT_T), nullptr, RET_V, kb * 64, n0, n0, 1.0f, scr, F.lane); continue; }
        r -= I_ROUT;
        if (r < I_GLU) { const int kb = r / 64, nb = r % 64, n0 = nb * 32; const int c = n0 & 1023, drow = (c >> 7) * 256 + (n0 >> 10) * 128 + (c & 127);
            conv_item<false>(gin(p, 15), 2 * D, (bf16*)(ws + WS_GLU_T), nullptr, D, kb * 64, n0, drow, 1.0f, scr, F.lane); continue; }
        r -= I_GLU;
        { const int l = r / I_RT; r %= I_RT; const int kb = r / 2, nb = r % 2, n0 = nb * 32;
            conv_item<true>(gin(p, 16) + (size_t)l * D * NE, NE, (bf16*)(ws + WS_RT_HI) + (size_t)l * NE * D, (bf16*)(ws + WS_RT_LO) + (size_t)l * NE * D, D, kb * 64, n0, n0, 1.0f, scr, F.lane); }
    }
}
__device__ __forceinline__ void phase_conv_moe(const Frame& F, KP p, int l) {
    LAS float* scr = (LAS float*)(F.lds + F.wave * 16384);
    const int gw = F.vcu * NWAVES + F.wave, NGW = F.G * NWAVES;
    for (int it = gw; it < 65 * 384; it += NGW) {
        const int e = it / 384, r = it % 384, which = r >> 7, rr = r & 127;
        bf16* We = (bf16*)(F.ws + WS_WMOE + (size_t)e * WMOE_E_BYTES);
        if (which < 2) { const float* src = (e < 64) ? gin(p, 18 + which) + ((size_t)l * NE + e) * D * ED : gin(p, 21 + which) + (size_t)l * D * ED;
            const int kb = rr >> 3, nb = rr & 7, n0 = nb * 32; const int drow = (n0 >> 7) * 256 + which * 128 + (n0 & 127);
            conv_item8(src, ED, (unsigned char*)We, D, kb * 64, n0, drow, WUP_SCALE, scr, F.lane);
        } else { const float* src = (e < 64) ? gin(p, 20) + ((size_t)l * NE + e) * ED * D : gin(p, 23) + (size_t)l * ED * D;
            const int kb = rr >> 5, nb = rr & 31, n0 = nb * 32;
            conv_item<false>(src, D, We + 512 * 1024, nullptr, ED, kb * 64, n0, n0, 1.0f, scr, F.lane); }
    }
}

__device__ __forceinline__ void phase_lnr(const Frame& F, KP p, int layer, bool dry = false) {
    const bf16* Y = (const bf16*)(F.ws + WS_Y); bf16* XB = (bf16*)(F.ws + WS_XB); unsigned char* XB8 = (unsigned char*)(F.ws + WS_X);
    const float* lng = gin(p, 24) + (size_t)(layer * 2) * D; const float* lnb = gin(p, 25) + (size_t)(layer * 2) * D;
    const bf16* rthi = (const bf16*)(F.ws + WS_RT_HI) + (size_t)layer * NE * D; const bf16* rtlo = (const bf16*)(F.ws + WS_RT_LO) + (size_t)layer * NE * D;
    const float* rbias = gin(p, 17) + layer * NE;
    unsigned* cnt = (unsigned*)(F.ws + WS_CTL) + CW_CNT + layer * NE * 64;
    int* lists = (int*)(F.ws + WS_LIST); int* tokmap = (int*)(F.ws + WS_LIST + 4 * MiB); float* tokgate = (float*)(F.ws + WS_LIST + 5 * MiB);
    constexpr int XLD = 1032, MAXT = 8;
    LAS bf16* Xhi = (LAS bf16*)F.lds; LAS bf16* Xlo = Xhi + 16 * XLD;
    LAS float* part = (LAS float*)(F.lds + 2 * 16 * XLD * 2);
    LAS int* ent = (LAS int*)(part + 2 * 16 * 64);
    LAS int* hist = ent + MAXT * 16 * 8 * 2; LAS int* base = hist + 64;
    const int lane = F.lane, w = F.wave, g4 = lane >> 4, l15 = lane & 15;
    if (F.tid < 64) hist[F.tid] = 0;
    bf16x8 bhi[16], blo[16];
    { const int nt = w & 3, kh = w >> 2; const bf16* bh = rthi + (size_t)(16 * nt + l15) * D + 512 * kh + 8 * g4; const bf16* bl = rtlo + (size_t)(16 * nt + l15) * D + 512 * kh + 8 * g4;
#pragma unroll
        for (int ks = 0; ks < 16; ++ks) { bhi[ks] = *(const bf16x8*)(bh + 32 * ks); blo[ks] = *(const bf16x8*)(bl + 32 * ks); } }
    u32x4 ypre[2][2];
    if (F.vcu < T / 16) {
#pragma unroll
        for (int rr = 0; rr < 2; ++rr)
#pragma unroll
            for (int j = 0; j < 2; ++j) ypre[rr][j] = *(const u32x4*)(Y + (size_t)(F.vcu * 16 + 2 * w + rr) * D + 8 * lane + 512 * j); }
    int ntile = 0;
    for (int tile = F.vcu; tile < T / 16 && ntile < MAXT; tile += F.G, ++ntile) {
        const int t0 = tile * 16;
        u32x4 ycur[2][2];
#pragma unroll
        for (int rr = 0; rr < 2; ++rr)
#pragma unroll
            for (int j = 0; j < 2; ++j) ycur[rr][j] = ypre[rr][j];
        if (tile + F.G < T / 16) {
#pragma unroll
            for (int rr = 0; rr < 2; ++rr)
#pragma unroll
                for (int j = 0; j < 2; ++j) ypre[rr][j] = *(const u32x4*)(Y + (size_t)((tile + F.G) * 16 + 2 * w + rr) * D + 8 * lane + 512 * j); }
#pragma unroll
        for (int rr = 0; rr < 2; ++rr) {
            const int lr = 2 * w + rr; const size_t row = (size_t)(t0 + lr);
            f32x4 v[4]; float s = 0.f;
#pragma unroll
            for (int j = 0; j < 2; ++j) unpack_bf16x8(ycur[rr][j], v[2 * j], v[2 * j + 1]);
#pragma unroll
            for (int j = 0; j < 4; ++j) s += (v[j][0] + v[j][1]) + (v[j][2] + v[j][3]);
            const float mean = wave_sum(s, lane) * (1.f / D); float s2 = 0.f;
#pragma unroll
            for (int j = 0; j < 4; ++j) { v[j] = v[j] - mean; s2 += (v[j][0] * v[j][0] + v[j][1] * v[j][1]) + (v[j][2] * v[j][2] + v[j][3] * v[j][3]); }
            const float rstd = 1.0f / sqrtf(wave_sum(s2, lane) * (1.f / D) + LN_EPS);
#pragma unroll
            for (int j = 0; j < 2; ++j) { const f32x4 g0 = *(const f32x4*)(lng + 8 * lane + 512 * j), g1 = *(const f32x4*)(lng + 8 * lane + 512 * j + 4), b0 = *(const f32x4*)(lnb + 8 * lane + 512 * j), b1 = *(const f32x4*)(lnb + 8 * lane + 512 * j + 4);
                const f32x4 o0 = v[2 * j] * rstd * g0 + b0, o1 = v[2 * j + 1] * rstd * g1 + b1;
                const u32x4 hi = pack_bf16x8(o0, o1);
                *(u32x4*)(XB + row * D + 8 * lane + 512 * j) = hi;
                { u32x2 q8; q8.x = pk4_fp8(o0[0], o0[1], o0[2], o0[3]); q8.y = pk4_fp8(o1[0], o1[1], o1[2], o1[3]); *(u32x2*)(XB8 + row * D + 8 * lane + 512 * j) = q8; }
                f32x4 h0, h1; unpack_bf16x8(hi, h0, h1); const u32x4 lo = pack_bf16x8(o0 - h0, o1 - h1);
                *(LAS u32x4*)(Xhi + lr * XLD + 8 * lane + 512 * j) = hi; *(LAS u32x4*)(Xlo + lr * XLD + 8 * lane + 512 * j) = lo; }
        }
        __syncthreads();
        { const int nt = w & 3, kh = w >> 2; f32x4 a0 = (f32x4){0.f, 0.f, 0.f, 0.f}, a1 = a0, a2 = a0, a3 = a0, a4 = a0, a5 = a0;
#pragma unroll
            for (int ks = 0; ks < 16; ks += 2) { const int k0 = 512 * kh + 32 * ks;
                const bf16x8 ahi = row_frag(Xhi, XLD, 0, k0, lane), alo = row_frag(Xlo, XLD, 0, k0, lane), bhi2 = row_frag(Xhi, XLD, 0, k0 + 32, lane), blo2 = row_frag(Xlo, XLD, 0, k0 + 32, lane);
                a0 = MFMA16(ahi, bhi[ks], a0); a1 = MFMA16(alo, bhi[ks], a1); a2 = MFMA16(ahi, blo[ks], a2);
                a3 = MFMA16(bhi2, bhi[ks + 1], a3); a4 = MFMA16(blo2, bhi[ks + 1], a4); a5 = MFMA16(bhi2, blo[ks + 1], a5); }
            const f32x4 acc = ((a0 + a3) + (a1 + a4)) + (a2 + a5);
#pragma unroll
            for (int i = 0; i < 4; ++i) part[(kh * 16 + 4 * g4 + i) * 64 + 16 * nt + l15] = acc[i];
        }
        __syncthreads();
#pragma unroll
        for (int rr = 0; rr < 2; ++rr) {
            const int lt = ntile * 16 + 2 * w + rr;
            const float lg = part[(2 * w + rr) * 64 + lane] + part[(16 + 2 * w + rr) * 64 + lane];
            float sc = 1.0f / (1.0f + expf(-lg)); sc = (sc == sc) ? sc : 0.5f;
            const float sel = sc + rbias[lane];
            const float m1 = max8(sel);
            const unsigned long long eq = __ballot(sel == m1);
            const unsigned gm = (unsigned)(eq >> (lane & 56)) & 0xffu;
            const int first = (lane & 56) + __builtin_ctz(gm | 0x100u);
            const float m2 = max8((lane == first) ? -INFINITY : sel);
            const float gs = m1 + m2; const int mygrp = lane >> 3; int grank = 0;
#pragma unroll
            for (int gg = 0; gg < 8; ++gg) { const float o = rdl(gs, 8 * gg); grank += (o > gs || (o == gs && gg < mygrp)) ? 1 : 0; }
            const float mv = (grank < 4) ? sel : -INFINITY;
            unsigned key = __builtin_bit_cast(unsigned, mv); key = (key >> 31) ? ~key : (key | 0x80000000u); key = (key & ~63u) | (unsigned)(63 - lane);
            int r0 = 0, r1 = 0, r2 = 0, r3 = 0;
#pragma unroll
            for (int e2 = 0; e2 < 64; e2 += 4) { r0 += ((unsigned)__builtin_amdgcn_readlane((int)key, e2) > key) ? 1 : 0; r1 += ((unsigned)__builtin_amdgcn_readlane((int)key, e2 + 1) > key) ? 1 : 0;
                r2 += ((unsigned)__builtin_amdgcn_readlane((int)key, e2 + 2) > key) ? 1 : 0; r3 += ((unsigned)__builtin_amdgcn_readlane((int)key, e2 + 3) > key) ? 1 : 0; }
            const int rank = (r0 + r1) + (r2 + r3);
            const bool chosen = rank < TOPK;
            const float wsum = wave_sum(chosen ? sc : 0.f, lane);
            if (chosen) { const int lpos = __hip_atomic_fetch_add(hist + lane, 1, __ATOMIC_RELAXED, __HIP_MEMORY_SCOPE_WORKGROUP);
                ent[(lt * 8 + rank) * 2] = (lane << 16) | lpos; ent[(lt * 8 + rank) * 2 + 1] = __builtin_bit_cast(int, sc / wsum * 2.5f); }
        }
    }
    __syncthreads();
    if (dry) return;
    if (F.tid < 64) { const int hcount = hist[F.tid]; base[F.tid] = hcount ? (int)atomicAdd(cnt + F.tid * 64, (unsigned)hcount) : 0; }
    __syncthreads();
    for (int idx = F.tid; idx < ntile * 16 * 8; idx += NTHREADS) {
        const int ev = ent[idx * 2], gb = ent[idx * 2 + 1]; const int e = ev >> 16, pos = base[e] + (ev & 0xffff);
        const int lt = idx >> 3, rank = idx & 7, tok = (F.vcu + (lt >> 4) * F.G) * 16 + (lt & 15);
        lists[(size_t)e * T + pos] = tok; tokmap[tok * 8 + rank] = (e << 16) | pos; tokgate[tok * 8 + rank] = __builtin_bit_cast(float, gb);
    }
}

__device__ __forceinline__ void phase_combine(const Frame& F, KP p, int layer, bool dry = false) {
    bf16* XB = (bf16*)(F.ws + WS_XB); const unsigned char* yexp = (const unsigned char*)(F.ws + WS_BIG);
    const int* tokmap = (const int*)(F.ws + WS_LIST + 4 * MiB); const float* tokgate = (const float*)(F.ws + WS_LIST + 5 * MiB);
    const volatile LAS int* tstart = (const volatile LAS int*)(F.MISC + 64);
    const float* lng = gin(p, 24) + (size_t)(layer * 2 + 1) * D; const float* lnb = gin(p, 25) + (size_t)(layer * 2 + 1) * D;
    float* outp = gout(p); bf16* xbo = XB; if (dry) { outp = (float*)(F.ws + WS_AUX); xbo = (bf16*)(F.ws + WS_H); }
    const int lane = F.lane, gw = F.vcu * NWAVES + F.wave, NGW = F.G * NWAVES;
    const bf16* ysh = (const bf16*)(F.ws + WS_Y);
    f32x4 gv[4], bv[4];
#pragma unroll
    for (int j = 0; j < 4; ++j) { gv[j] = *(const f32x4*)(lng + 16 * lane + 4 * j); bv[j] = *(const f32x4*)(lnb + 16 * lane + 4 * j); }
    for (int row = gw; row < T; row += NGW) {
        const int mk = tokmap[row * 8 + (lane & 7)]; const float gk = tokgate[row * 8 + (lane & 7)] * YEXP_INV;
        const int rk = (int)tstart[mk >> 16] * 256 + (mk & 0xffff);
        f32x4 v[4];
#pragma unroll
        for (int j = 0; j < 2; ++j) { const u32x4 xw = *(const u32x4*)(ysh + (size_t)row * D + 16 * lane + 8 * j); unpack_bf16x8(xw, v[2 * j], v[2 * j + 1]); }
#pragma unroll
        for (int k = 0; k < TOPK; ++k) { const int r = __builtin_amdgcn_readlane(rk, k); const float g = rdl(gk, k);
            const u32x4 s = *(const u32x4*)(yexp + (size_t)r * D + 16 * lane);
#pragma unroll
            for (int j = 0; j < 4; ++j) { const f32x2 lo = __builtin_amdgcn_cvt_pk_f32_fp8((int)s[j], false), hi = __builtin_amdgcn_cvt_pk_f32_fp8((int)s[j], true);
                v[j][0] += g * lo[0]; v[j][1] += g * lo[1]; v[j][2] += g * hi[0]; v[j][3] += g * hi[1]; } }
        float s = 0.f;
#pragma unroll
        for (int j = 0; j < 4; ++j) s += (v[j][0] + v[j][1]) + (v[j][2] + v[j][3]);
        const float mean = wave_sum(s, lane) * (1.f / D); float s2 = 0.f;
#pragma unroll
        for (int j = 0; j < 4; ++j) { v[j] = v[j] - mean; s2 += (v[j][0] * v[j][0] + v[j][1] * v[j][1]) + (v[j][2] * v[j][2] + v[j][3] * v[j][3]); }
        const float rstd = 1.0f / sqrtf(wave_sum(s2, lane) * (1.f / D) + LN_EPS);
        f32x4 o[4];
#pragma unroll
        for (int j = 0; j < 4; ++j) o[j] = v[j] * rstd * gv[j] + bv[j];
        if (layer == DEPTH - 1 || dry) {
#pragma unroll
            for (int j = 0; j < 4; ++j) *(f32x4*)(outp + (size_t)row * D + 16 * lane + 4 * j) = o[j]; }
        if (layer != DEPTH - 1) { *(u32x4*)(xbo + (size_t)row * D + 16 * lane) = pack_bf16x8(o[0], o[1]); *(u32x4*)(xbo + (size_t)row * D + 16 * lane + 8) = pack_bf16x8(o[2], o[3]);
            if (!dry) { u32x4 q8; q8.x = pk4_fp8(o[0][0], o[0][1], o[0][2], o[0][3]); q8.y = pk4_fp8(o[1][0], o[1][1], o[1][2], o[1][3]); q8.z = pk4_fp8(o[2][0], o[2][1], o[2][2], o[2][3]); q8.w = pk4_fp8(o[3][0], o[3][1], o[3][2], o[3][3]);
                *(u32x4*)((unsigned char*)(F.ws + WS_X) + (size_t)row * D + 16 * lane) = q8; } }
    }
}

constexpr size_t AUX_OB = 96 * MiB, AUX_LSE = 128 * MiB;
__device__ __forceinline__ void phase_attn(const Frame& F, int bx) {
    const bf16* qkv = (const bf16*)(F.ws + WS_BIG); bf16* og = (bf16*)(F.ws + WS_AUX); float* lse = (float*)(F.ws + WS_AUX + AUX_LSE);
    constexpr int KLD = 136;
    LAS bf16* Ks = (LAS bf16*)F.lds; LAS bf16* Vs = Ks + 256 * KLD;
    const int lane = F.lane, w = F.wave, g4 = lane >> 4, l15 = lane & 15, qq = l15 >> 2, pp = lane & 3;
    u32x4 kc[4], vc[4];
    constexpr int NRUN = 768;
#define ATT_LOADBLK(KR, VR, nblk) do { _Pragma("unroll") for (int it = 0; it < 4; ++it) { const int idx = F.tid + 512 * it, c = idx >> 4, ch = idx & 15; int pos = 128 * (nblk) + c; pos = pos < 0 ? 0 : pos; \
            const unsigned so = (rowbase + (unsigned)pos * (unsigned)d + (unsigned)r) * (unsigned)ATT_IN + (unsigned)(g * 3072 + 1024 + h * 128 + ch * 8); KR[it] = *(const u32x4*)(qkv + so); VR[it] = *(const u32x4*)(qkv + so + 1024u); } } while (0)
#define ATT_STOREBLK(KR, VR, slot) do { _Pragma("unroll") for (int it = 0; it < 4; ++it) { const int idx = F.tid + 512 * it, c = idx >> 4, ch = idx & 15; \
            *(LAS u32x4*)(Ks + (128 * (slot) + c) * KLD + ch * 8) = KR[it]; *(LAS u32x4*)(Vs + (128 * (slot) + c) * KLD + ch * 8) = VR[it]; } } while (0)
    for (int R = bx; R < NRUN; R += F.G) {
        const int h = R & 7, sbr = R >> 3, g = sbr >> 5, rem = sbr & 31, b = rem >> 4, rr_ = rem & 15;
        const int dsh = 2 * g, d = 1 << dsh, nrs = 4 - dsh, r = rr_ >> nrs, n0 = 4 * (rr_ & ((1 << nrs) - 1)); const unsigned rowbase = (unsigned)b * SEQ;
        ATT_LOADBLK(kc, vc, n0 - 1); ATT_STOREBLK(kc, vc, (n0 - 1) & 1); ATT_LOADBLK(kc, vc, n0);
#pragma unroll 1
        for (int j = 0; j < 4; ++j) {
            const int n = n0 + j, cs = n & 1, ps = cs ^ 1;
            ATT_STOREBLK(kc, vc, cs);
            const int qi = 16 * w + l15; const unsigned qrow = rowbase + (unsigned)(128 * n + qi) * (unsigned)d + (unsigned)r;
            bf16x8 qf[4];
#pragma unroll
            for (int s = 0; s < 4; ++s) qf[s] = *(const bf16x8*)(qkv + (qrow * (unsigned)ATT_IN + (unsigned)(g * 3072 + h * 128 + 32 * s + 8 * g4)));
            __syncthreads();
            if (j < 3) { ATT_LOADBLK(kc, vc, n + 1); }
            __builtin_amdgcn_sched_barrier(0);
            const int ws0 = (16 * w < 96) ? 16 * w : 96;
#define ATT_PROW(c0) (((c0) < 128) ? (128 * ps + (c0)) : (128 * cs + (c0) - 128))
            f32x4 sacc[10];
            {
                bf16x8 kfa[4], kfb[4];
#pragma unroll
                for (int s = 0; s < 4; ++s) kfa[s] = row_frag(Ks, KLD, ATT_PROW(ws0), 32 * s, lane);
#pragma unroll
                for (int t = 0; t < 10; t += 2) {
#pragma unroll
                    for (int s = 0; s < 4; ++s) kfb[s] = row_frag(Ks, KLD, ATT_PROW(ws0 + 16 * (t + 1)), 32 * s, lane);
                    __builtin_amdgcn_sched_barrier(0);
                    sacc[t] = (f32x4){0.f, 0.f, 0.f, 0.f};
#pragma unroll
                    for (int s = 0; s < 4; ++s) sacc[t] = MFMA16(kfa[s], qf[s], sacc[t]);
                    if (t + 2 < 10) {
#pragma unroll
                        for (int s = 0; s < 4; ++s) kfa[s] = row_frag(Ks, KLD, ATT_PROW(ws0 + 16 * (t + 2)), 32 * s, lane); }
                    __builtin_amdgcn_sched_barrier(0);
                    sacc[t + 1] = (f32x4){0.f, 0.f, 0.f, 0.f};
#pragma unroll
                    for (int s = 0; s < 4; ++s) sacc[t + 1] = MFMA16(kfb[s], qf[s], sacc[t + 1]);
                }
            }
            const float slope = exp2f(-(float)(h + 1)) * (float)d;
            float mx = -INFINITY;
#pragma unroll
            for (int t = 0; t < 10; ++t)
#pragma unroll
                for (int i = 0; i < 4; ++i) { const int c = ws0 + 16 * t + 4 * g4 + i, step = 128 + qi - c;
                    const bool valid = (step >= 0) && (step <= 128) && (n > 0 || c >= 128);
                    const float v = valid ? sacc[t][i] - slope * (float)step : -INFINITY; sacc[t][i] = v; mx = fmaxf(mx, v); }
            mx = fmaxf(mx, shx(mx, 16, lane)); mx = fmaxf(mx, shx(mx, 32, lane));
            float lsum = 0.f;
#pragma unroll
            for (int t = 0; t < 10; ++t)
#pragma unroll
                for (int i = 0; i < 4; ++i) { const float pv = __expf(sacc[t][i] - mx); sacc[t][i] = pv; lsum += pv; }
            lsum += shx(lsum, 16, lane); lsum += shx(lsum, 32, lane);
            bf16x8 pf[5];
#pragma unroll
            for (int kt = 0; kt < 5; ++kt) pf[kt] = pack8(sacc[2 * kt], sacc[2 * kt + 1]);
            f32x4 o[8];
            {
                const LAS bf16* vl = Vs + (4 * g4 + qq) * KLD + 32 * pp;
                bf16x4 va[10], vcc[10];
#pragma unroll
                for (int q = 0; q < 10; ++q) va[q] = tr4(vl + ATT_PROW(ws0 + 16 * q) * KLD);
#pragma unroll
                for (int et = 0; et < 8; et += 2) {
#pragma unroll
                    for (int q = 0; q < 10; ++q) vcc[q] = tr4(vl + ATT_PROW(ws0 + 16 * q) * KLD + 4 * (et + 1));
                    __builtin_amdgcn_sched_barrier(0);
                    o[et] = (f32x4){0.f, 0.f, 0.f, 0.f};
#pragma unroll
                    for (int kt = 0; kt < 5; ++kt) o[et] = MFMA16(cat8(va[2 * kt], va[2 * kt + 1]), pf[kt], o[et]);
                    if (et + 2 < 8) {
#pragma unroll
                        for (int q = 0; q < 10; ++q) va[q] = tr4(vl + ATT_PROW(ws0 + 16 * q) * KLD + 4 * (et + 2)); }
                    __builtin_amdgcn_sched_barrier(0);
                    o[et + 1] = (f32x4){0.f, 0.f, 0.f, 0.f};
#pragma unroll
                    for (int kt = 0; kt < 5; ++kt) o[et + 1] = MFMA16(cat8(vcc[2 * kt], vcc[2 * kt + 1]), pf[kt], o[et + 1]);
                }
            }
#undef ATT_PROW
            const float inv = 1.0f / lsum;
            bf16* orow = og + ((size_t)g * T + qrow) * D + h * 128 + 32 * g4;
#pragma unroll
            for (int e2 = 0; e2 < 4; ++e2) *(u32x4*)(orow + 8 * e2) = pack_bf16x8(o[2 * e2] * inv, o[2 * e2 + 1] * inv);
            if (g4 == 0) lse[((size_t)g * T + qrow) * AH + h] = mx + __logf(lsum);
            __syncthreads();
        }
    }
#undef ATT_LOADBLK
#undef ATT_STOREBLK
}
__device__ __forceinline__ void phase_attn_combine(const Frame& F) {
    const bf16* og = (const bf16*)(F.ws + WS_AUX); const float* lse = (const float*)(F.ws + WS_AUX + AUX_LSE); bf16* ob = (bf16*)(F.ws + WS_AUX + AUX_OB);
    const int lane = F.lane, gw = F.vcu * NWAVES + F.wave, NGW = F.G * NWAVES, h = lane >> 3;
    for (int row = gw; row < T; row += NGW) {
        const float l0 = lse[((size_t)0 * T + row) * AH + h], l1 = lse[((size_t)1 * T + row) * AH + h], l2 = lse[((size_t)2 * T + row) * AH + h];
        const float m = fmaxf(l0, fmaxf(l1, l2)); float w0 = __expf(l0 - m), w1 = __expf(l1 - m), w2 = __expf(l2 - m); const float inv = 1.0f / (w0 + w1 + w2); w0 *= inv; w1 *= inv; w2 *= inv;
        float a[16];
#pragma unroll
        for (int j = 0; j < 16; ++j) a[j] = 0.f;
#pragma unroll
        for (int g = 0; g < 3; ++g) { const float wg = (g == 0) ? w0 : (g == 1 ? w1 : w2);
#pragma unroll
            for (int q = 0; q < 2; ++q) { const u32x4 s = *(const u32x4*)(og + ((size_t)g * T + row) * D + 16 * lane + 8 * q);
                a[8 * q + 0] += wg * bflo(s.x); a[8 * q + 1] += wg * bfhi(s.x); a[8 * q + 2] += wg * bflo(s.y); a[8 * q + 3] += wg * bfhi(s.y);
                a[8 * q + 4] += wg * bflo(s.z); a[8 * q + 5] += wg * bfhi(s.z); a[8 * q + 6] += wg * bflo(s.w); a[8 * q + 7] += wg * bfhi(s.w); } }
#pragma unroll
        for (int q = 0; q < 2; ++q) { u32x4 o; o.x = pk2(a[8 * q], a[8 * q + 1]); o.y = pk2(a[8 * q + 2], a[8 * q + 3]); o.z = pk2(a[8 * q + 4], a[8 * q + 5]); o.w = pk2(a[8 * q + 6], a[8 * q + 7]);
            *(u32x4*)(ob + (size_t)row * D + 16 * lane + 8 * q) = o; }
    }
}

constexpr size_t BIG_YRET = 192 * MiB;
__device__ __forceinline__ void phase_ret_u(const Frame& F) {
    const bf16* proj = (const bf16*)(F.ws + WS_BIG); bf16* St = (bf16*)(F.ws + WS_AUX);
    constexpr int LD = 264;
    LAS bf16* Kt = (LAS bf16*)F.lds; LAS bf16* Vt = Kt + 128 * LD;
    const int lane = F.lane, w = F.wave, g4 = lane >> 4, l15 = lane & 15, qq = l15 >> 2, pp = lane & 3;
    for (int u = F.vcu; u < 1024; u += F.G) {
        const int eh = u & 1, h = (u >> 1) & 3, n = (u >> 3) & 63, b = u >> 9;
        const size_t row0 = (size_t)b * SEQ + (size_t)n * RC;
#pragma unroll 4
        for (int it = 0; it < 8; ++it) { const int idx = F.tid + 512 * it, j = idx >> 5, ch = idx & 31;
            const bf16* src = proj + (row0 + j) * RET_IN;
            const u32x4 kv = *(const u32x4*)(src + 1024 + h * 256 + ch * 8), vv = *(const u32x4*)(src + 2048 + h * 512 + eh * 256 + ch * 8);
            *(LAS u32x4*)(Kt + j * LD + ch * 8) = kv; *(LAS u32x4*)(Vt + j * LD + ch * 8) = vv; }
        __syncthreads();
        f32x4 acc[16][2];
#pragma unroll
        for (int mt = 0; mt < 16; ++mt) { acc[mt][0] = (f32x4){0.f, 0.f, 0.f, 0.f}; acc[mt][1] = (f32x4){0.f, 0.f, 0.f, 0.f}; }
#pragma unroll
        for (int ks = 0; ks < 4; ++ks) {
            bf16x8 bfr[2];
#pragma unroll
            for (int nt = 0; nt < 2; ++nt) { const LAS bf16* a0 = Vt + (32 * ks + 8 * g4 + qq) * LD + 32 * w + 16 * nt + 4 * pp; bfr[nt] = cat8(tr4(a0), tr4(a0 + 4 * LD)); }
#pragma unroll
            for (int mt = 0; mt < 16; ++mt) { const LAS bf16* a0 = Kt + (32 * ks + 8 * g4 + qq) * LD + 128 * (mt >> 3) + 32 * pp + 4 * (mt & 7);
                const bf16x8 afr = cat8(tr4(a0), tr4(a0 + 4 * LD));
                acc[mt][0] = MFMA16(afr, bfr[0], acc[mt][0]); acc[mt][1] = MFMA16(afr, bfr[1], acc[mt][1]); }
        }
        bf16* outb = St + ((size_t)((b * RH + h) * RNC + n)) * (RDV * RDK);
#pragma unroll
        for (int nt = 0; nt < 2; ++nt) { bf16* orow = outb + (size_t)(eh * 256 + 32 * w + 16 * nt + l15) * RDK + 32 * g4;
#pragma unroll
            for (int mh = 0; mh < 2; ++mh)
#pragma unroll
                for (int q = 0; q < 4; ++q) *(u32x4*)(orow + 128 * mh + 8 * q) = pack_bf16x8(acc[mh * 8 + 2 * q][nt], acc[mh * 8 + 2 * q + 1][nt]); }
        __syncthreads();
    }
}
__device__ __forceinline__ void phase_ret_scan(const Frame& F) {
    bf16* St = (bf16*)(F.ws + WS_AUX);
    for (int gt = F.vcu * NTHREADS + F.tid; gt < 8 * 16384; gt += F.G * NTHREADS) {
        const int bh = gt >> 14, chunk = gt & 16383, h = bh & 3;
        const float g128 = exp2f(128.0f * log2f(1.0f - exp2f(-5.0f - (float)h)));
        bf16* base = St + (size_t)bh * RNC * (RDV * RDK) + (size_t)chunk * 8;
        float c[8];
#pragma unroll
        for (int j = 0; j < 8; ++j) c[j] = 0.f;
#pragma unroll 8
        for (int n = 0; n < RNC; ++n) { bf16* pn = base + (size_t)n * (RDV * RDK); const u32x4 uv = *(const u32x4*)pn;
            u32x4 o; o.x = pk2(c[0], c[1]); o.y = pk2(c[2], c[3]); o.z = pk2(c[4], c[5]); o.w = pk2(c[6], c[7]); *(u32x4*)pn = o;
            c[0] = g128 * (c[0] + bflo(uv.x)); c[1] = g128 * (c[1] + bfhi(uv.x)); c[2] = g128 * (c[2] + bflo(uv.y)); c[3] = g128 * (c[3] + bfhi(uv.y));
            c[4] = g128 * (c[4] + bflo(uv.z)); c[5] = g128 * (c[5] + bfhi(uv.z)); c[6] = g128 * (c[6] + bflo(uv.w)); c[7] = g128 * (c[7] + bfhi(uv.w)); }
    }
}
__device__ __forceinline__ void phase_ret_out(const Frame& F, KP p) {
    const bf16* proj = (const bf16*)(F.ws + WS_BIG); const bf16* St = (const bf16*)(F.ws + WS_AUX); bf16* yret = (bf16*)(F.ws + WS_BIG + BIG_YRET);
    const float* gng = gin(p, 4); const float* gnb = gin(p, 5);
    constexpr int LD = 264, VLD = 136;
    LAS bf16* Rs = (LAS bf16*)F.lds; LAS bf16* Vs = Rs + 128 * LD;
    const int lane = F.lane, w = F.wave, g4 = lane >> 4, l15 = lane & 15, qq = l15 >> 2, pp = lane & 3;
    for (int u = F.vcu; u < 512; u += F.G) {
        const int h = u & 3, n = (u >> 2) & 63, b = u >> 8;
        const size_t row0 = (size_t)b * SEQ + (size_t)n * RC;
#pragma unroll 4
        for (int it = 0; it < 8; ++it) { const int idx = F.tid + 512 * it, j = idx >> 5, ch = idx & 31;
            *(LAS u32x4*)(Rs + j * LD + ch * 8) = *(const u32x4*)(proj + (row0 + j) * RET_IN + 1024 + h * 256 + ch * 8); }
        const int irow = 16 * w + l15; const size_t qrow = row0 + irow;
        bf16x8 qf[8];
#pragma unroll
        for (int s = 0; s < 8; ++s) qf[s] = *(const bf16x8*)(proj + qrow * RET_IN + h * 256 + 32 * s + 8 * g4);
        __syncthreads();
        bf16x8 pf[4];
        { f32x4 sacc[8];
#pragma unroll
            for (int jt = 0; jt < 8; ++jt) { sacc[jt] = (f32x4){0.f, 0.f, 0.f, 0.f};
                if (jt <= w) {
#pragma unroll
                    for (int s = 0; s < 8; ++s) sacc[jt] = MFMA16(row_frag(Rs, LD, 16 * jt, 32 * s, lane), qf[s], sacc[jt]);
#pragma unroll
                    for (int i = 0; i < 4; ++i) if (16 * jt + 4 * g4 + i > irow) sacc[jt][i] = 0.f; } }
#pragma unroll
            for (int kt = 0; kt < 4; ++kt) pf[kt] = pack8(sacc[2 * kt], sacc[2 * kt + 1]); }
        __syncthreads();
        f32x4 acc[4][8];
        const bf16* Sn = St + ((size_t)((b * RH + h) * RNC + n)) * (RDV * RDK);
#pragma unroll
        for (int sl = 0; sl < 4; ++sl) {
#pragma unroll 4
            for (int it = 0; it < 4; ++it) { const int idx = F.tid + 512 * it, j = idx >> 4, ch = idx & 15;
                *(LAS u32x4*)(Vs + j * VLD + ch * 8) = *(const u32x4*)(proj + (row0 + j) * RET_IN + 2048 + h * 512 + sl * 128 + ch * 8); }
#pragma unroll 4
            for (int it = 0; it < 8; ++it) { const int idx = F.tid + 512 * it, e = idx >> 5, ch = idx & 31;
                *(LAS u32x4*)(Rs + e * LD + ch * 8) = *(const u32x4*)(Sn + (size_t)(sl * 128 + e) * RDK + ch * 8); }
            __syncthreads();
#pragma unroll
            for (int et = 0; et < 8; ++et) { f32x4 a = (f32x4){0.f, 0.f, 0.f, 0.f};
#pragma unroll
                for (int kt = 0; kt < 4; ++kt) if (2 * kt <= w) { const LAS bf16* a0 = Vs + (32 * kt + 4 * g4 + qq) * VLD + 32 * pp + 4 * et;
                    a = MFMA16(cat8(tr4(a0), tr4(a0 + 16 * VLD)), pf[kt], a); }
                const LAS bf16* srow = Rs + (32 * qq + 4 * et + pp) * LD + 8 * g4;
#pragma unroll
                for (int s = 0; s < 8; ++s) a = MFMA16(*(const LAS bf16x8*)(srow + 32 * s), qf[s], a);
                acc[sl][et] = a; }
            __syncthreads();
        }
        float s = 0.f;
#pragma unroll
        for (int sl = 0; sl < 4; ++sl)
#pragma unroll
            for (int et = 0; et < 8; ++et) s += (acc[sl][et][0] + acc[sl][et][1]) + (acc[sl][et][2] + acc[sl][et][3]);
        s += shx(s, 16, lane); s += shx(s, 32, lane);
        const float mean = s * (1.0f / RDV); float s2 = 0.f;
#pragma unroll
        for (int sl = 0; sl < 4; ++sl)
#pragma unroll
            for (int et = 0; et < 8; ++et) { acc[sl][et] = acc[sl][et] - mean; s2 += (acc[sl][et][0] * acc[sl][et][0] + acc[sl][et][1] * acc[sl][et][1]) + (acc[sl][et][2] * acc[sl][et][2] + acc[sl][et][3] * acc[sl][et][3]); }
        s2 += shx(s2, 16, lane); s2 += shx(s2, 32, lane);
        const float rstd = 1.0f / sqrtf(s2 * (1.0f / RDV) + LN_EPS);
#pragma unroll
        for (int sl = 0; sl < 4; ++sl) { const int c0 = h * RDV + sl * 128 + 32 * g4;
#pragma unroll
            for (int q = 0; q < 4; ++q) { const u32x4 gw = *(const u32x4*)(proj + qrow * RET_IN + 4096 + c0 + 8 * q);
                const f32x4 gg0 = *(const f32x4*)(gng + c0 + 8 * q), gg1 = *(const f32x4*)(gng + c0 + 8 * q + 4), gb0 = *(const f32x4*)(gnb + c0 + 8 * q), gb1 = *(const f32x4*)(gnb + c0 + 8 * q + 4);
                f32x4 y0 = acc[sl][2 * q] * rstd * gg0 + gb0, y1 = acc[sl][2 * q + 1] * rstd * gg1 + gb1;
                const float gv[8] = {bflo(gw.x), bfhi(gw.x), bflo(gw.y), bfhi(gw.y), bflo(gw.z), bfhi(gw.z), bflo(gw.w), bfhi(gw.w)};
#pragma unroll
                for (int j = 0; j < 4; ++j) { y0[j] *= gv[j] / (1.0f + __expf(-gv[j])); y1[j] *= gv[4 + j] / (1.0f + __expf(-gv[4 + j])); }
                *(u32x4*)(yret + qrow * RET_V + c0 + 8 * q) = pack_bf16x8(y0, y1); } }
    }
}

constexpr size_t AUX_S5E = 64 * MiB;
constexpr int S5L = 256, S5NC = SEQ / S5L;
__device__ __forceinline__ void cmul_add(float& rr, float& ri, float ar, float ai, float xr, float xi, float cr, float ci) { rr = ar * xr - ai * xi + cr; ri = ar * xi + ai * xr + ci; }
template <bool OUT>
__device__ __forceinline__ void phase_s5_scan(const Frame& F, KP p) {
    const bf16* X = (const bf16*)(F.ws + WS_XB); float* E = (float*)(F.ws + WS_AUX + AUX_S5E); bf16* ybuf = (bf16*)(F.ws + WS_AUX);
    const int lane = F.lane, w = F.wave, g4 = lane >> 4, l15 = lane & 15;
    LAS bf16* ut = (LAS bf16*)(F.lds + w * 12288);
    LAS bf16* Hb = (LAS bf16*)(F.lds + w * 12288 + 4096);
    constexpr int HLD = 136;
    const int gw = F.vcu * NWAVES + w, NGW = F.G * NWAVES;
    const int up16 = (lane - 16) << 2, up32 = (lane - 32) << 2, last16 = (48 + l15) << 2;
    for (int unit = gw; unit < BATCH * SG * S5NC; unit += NGW) {
        const int n = unit & (S5NC - 1), g = (unit >> 5) & 63, b = unit >> 11;
        float a1r[4], a1i[4], a4r[4], a4i[4], a8r[4], a8i[4], pwr[4], pwi[4];
        bf16x8 bfrag[8];
        const float dt = expf(gin(p, 14)[g]);
#pragma unroll
        for (int st = 0; st < 4; ++st) { const int ps = 16 * st + l15;
            const float are = gin(p, 7)[g * SP + ps], aim = gin(p, 8)[g * SP + ps];
            const float mag = expf(dt * are); const float abr = mag * cosf(dt * aim), abi = mag * sinf(dt * aim);
            const float den = are * are + aim * aim;
            const float fre = ((abr - 1.0f) * are + abi * aim) / den, fim = (abi * are - (abr - 1.0f) * aim) / den;
            a1r[st] = abr; a1i[st] = abi; { float t2r, t2i; cmul_add(t2r, t2i, abr, abi, abr, abi, 0.f, 0.f); cmul_add(a4r[st], a4i[st], t2r, t2i, t2r, t2i, 0.f, 0.f); }
            cmul_add(a8r[st], a8i[st], a4r[st], a4i[st], a4r[st], a4i[st], 0.f, 0.f);
            float qr = 1.f, qi = 0.f;
            if (g4 & 1) { qr = a4r[st]; qi = a4i[st]; }
            if (g4 & 2) { float tr, ti; cmul_add(tr, ti, qr, qi, a8r[st], a8i[st], 0.f, 0.f); qr = tr; qi = ti; }
            pwr[st] = qr; pwi[st] = qi;
            const float* br = gin(p, 9) + ((size_t)g * SP + ps) * SGC + 8 * (g4 & 1); const float* bi = gin(p, 10) + ((size_t)g * SP + ps) * SGC + 8 * (g4 & 1);
            const f32x4 r0 = *(const f32x4*)br, r1 = *(const f32x4*)(br + 4), i0 = *(const f32x4*)bi, i1 = *(const f32x4*)(bi + 4);
            const float z = (g4 < 2) ? 1.0f : 0.0f; const float fr2 = fre * z, fi2 = fim * z;
            bfrag[st] = pack8(r0 * fr2 - i0 * fi2, r1 * fr2 - i1 * fi2); bfrag[st + 4] = pack8(i0 * fr2 + r0 * fi2, i1 * fr2 + r1 * fi2);
        }
        float sr[4], si[4];
        float* Eu = E + ((size_t)(b * SG + g) * S5NC + n) * 128;
        bf16x8 cf[4]; f32x4 dsk = (f32x4){0.f, 0.f, 0.f, 0.f};
#pragma unroll
        for (int st = 0; st < 4; ++st) { sr[st] = 0.f; si[st] = 0.f; }
        if (OUT) {
#pragma unroll
            for (int st = 0; st < 4; ++st) { sr[st] = Eu[16 * st + l15]; si[st] = Eu[64 + 16 * st + l15]; }
#pragma unroll
            for (int s = 0; s < 4; ++s) { const float* cp = (s < 2 ? gin(p, 11) : gin(p, 12)) + ((size_t)g * SGC + l15) * SP + 32 * (s & 1) + 8 * g4; const float sg = s < 2 ? 1.0f : -1.0f;
                const f32x4 c0 = *(const f32x4*)cp * sg, c1 = *(const f32x4*)(cp + 4) * sg; cf[s] = pack8(c0, c1); }
            dsk = *(const f32x4*)(gin(p, 13) + g * SGC + 4 * g4); }
        const size_t tok0 = (size_t)b * SEQ + (size_t)n * S5L;
        u32x4 pre[2];
        { const bf16* src = X + (tok0 + lane) * D + g * SGC; pre[0] = *(const u32x4*)src; pre[1] = *(const u32x4*)(src + 8); }
        for (int sub = 0; sub < S5L / 64; ++sub) {
            *(LAS u32x4*)(ut + lane * 16) = pre[0]; *(LAS u32x4*)(ut + lane * 16 + 8) = pre[1];
            if (sub + 1 < S5L / 64) { const bf16* src = X + (tok0 + (sub + 1) * 64 + lane) * D + g * SGC; pre[0] = *(const u32x4*)src; pre[1] = *(const u32x4*)(src + 8); }
            LDS_WAIT(); asm volatile("" ::: "memory");
#pragma unroll (OUT ? 1 : 4)
            for (int blk = 0; blk < 4; ++blk) {
                u32x4 uw = *(const LAS u32x4*)(ut + (blk * 16 + l15) * 16 + 8 * (g4 & 1));
                if (g4 >= 2) uw = (u32x4){0u, 0u, 0u, 0u};
                const bf16x8 ufr = __builtin_bit_cast(bf16x8, uw);
                f32x4 dr[4], di[4];
#pragma unroll
                for (int st = 0; st < 4; ++st) { dr[st] = MFMA16(ufr, bfrag[st], ((f32x4){0.f, 0.f, 0.f, 0.f})); di[st] = MFMA16(ufr, bfrag[st + 4], ((f32x4){0.f, 0.f, 0.f, 0.f})); }
                float vr[4], vi[4];
#pragma unroll
                for (int st = 0; st < 4; ++st) {
                    float hr = 0.f, hi = 0.f;
#pragma unroll
                    for (int i = 0; i < 4; ++i) { float nr, ni; cmul_add(nr, ni, a1r[st], a1i[st], hr, hi, dr[st][i], di[st][i]); hr = nr; hi = ni; dr[st][i] = hr; di[st][i] = hi; }
                    vr[st] = hr; vi[st] = hi; }
#define BPF(idx, v) __builtin_bit_cast(float, __builtin_amdgcn_ds_bpermute((idx), __builtin_bit_cast(int, (v))))
                { float xr[4], xi[4];
#pragma unroll
                  for (int st = 0; st < 4; ++st) { xr[st] = BPF(up16, vr[st]); xi[st] = BPF(up16, vi[st]); }
#pragma unroll
                  for (int st = 0; st < 4; ++st) { float tr, ti; cmul_add(tr, ti, a4r[st], a4i[st], xr[st], xi[st], vr[st], vi[st]); if (g4 >= 1) { vr[st] = tr; vi[st] = ti; } }
#pragma unroll
                  for (int st = 0; st < 4; ++st) { xr[st] = BPF(up32, vr[st]); xi[st] = BPF(up32, vi[st]); }
#pragma unroll
                  for (int st = 0; st < 4; ++st) { float tr, ti; cmul_add(tr, ti, a8r[st], a8i[st], xr[st], xi[st], vr[st], vi[st]); if (g4 >= 2) { vr[st] = tr; vi[st] = ti; } } }
                float er[4], ei[4], lr[4], li[4];
#pragma unroll
                for (int st = 0; st < 4; ++st) { if (OUT) { er[st] = BPF(up16, vr[st]); ei[st] = BPF(up16, vi[st]); } else { er[st] = 0.f; ei[st] = 0.f; } lr[st] = BPF(last16, vr[st]); li[st] = BPF(last16, vi[st]); }
#undef BPF
#pragma unroll
                for (int st = 0; st < 4; ++st) {
                    if (g4 == 0) { er[st] = 0.f; ei[st] = 0.f; }
                    if (OUT) { float s0r, s0i; cmul_add(s0r, s0i, pwr[st], pwi[st], sr[st], si[st], er[st], ei[st]);
#pragma unroll
                        for (int i = 0; i < 4; ++i) { float tr, ti; cmul_add(tr, ti, a1r[st], a1i[st], s0r, s0i, 0.f, 0.f); s0r = tr; s0i = ti; dr[st][i] += s0r; di[st][i] += s0i; } }
                    { float a16r, a16i; cmul_add(a16r, a16i, a8r[st], a8i[st], a8r[st], a8i[st], 0.f, 0.f); float tr, ti; cmul_add(tr, ti, a16r, a16i, sr[st], si[st], lr[st], li[st]); sr[st] = tr; si[st] = ti; }
                    if (OUT) {
#pragma unroll
                        for (int i = 0; i < 4; ++i) { const unsigned hw = pk2(dr[st][i], di[st][i]); Hb[(4 * g4 + i) * HLD + 16 * st + l15] = (bf16)hw; Hb[(4 * g4 + i) * HLD + 64 + 16 * st + l15] = (bf16)(hw >> 16); } }
                }
                if (OUT) {
                    LDS_WAIT(); asm volatile("" ::: "memory");
                    f32x4 ya = (f32x4){0.f, 0.f, 0.f, 0.f};
#pragma unroll
                    for (int s = 0; s < 4; ++s) ya = MFMA16(cf[s], row_frag(Hb, HLD, 0, 32 * s, lane), ya);
                    const u32x2 u2 = *(const LAS u32x2*)(ut + (blk * 16 + l15) * 16 + 4 * g4);
                    const f32x4 u4 = (f32x4){bflo(u2.x), bfhi(u2.x), bflo(u2.y), bfhi(u2.y)};
                    f32x4 y = ya + dsk * u4;
#pragma unroll
                    for (int j = 0; j < 4; ++j) { const float v = y[j]; y[j] = v / (1.0f + __expf(-1.5957691216057308f * (v + 0.044715f * v * v * v))); }
                    u32x2 o; o.x = pk2(y[0], y[1]); o.y = pk2(y[2], y[3]);
                    *(u32x2*)(ybuf + (tok0 + sub * 64 + blk * 16 + l15) * D + g * SGC + 4 * g4) = o;
                    asm volatile("" ::: "memory"); }
            }
            LDS_WAIT(); asm volatile("" ::: "memory");
        }
        if (!OUT && g4 == 0) {
#pragma unroll
            for (int st = 0; st < 4; ++st) { Eu[16 * st + l15] = sr[st]; Eu[64 + 16 * st + l15] = si[st]; } }
    }
}
__device__ __forceinline__ void phase_s5_carry(const Frame& F, KP p) {
    float* E = (float*)(F.ws + WS_AUX + AUX_S5E);
    for (int gt = F.vcu * NTHREADS + F.tid; gt < BATCH * SG * SP; gt += F.G * NTHREADS) {
        const int pl = gt & 63, bg = gt >> 6, g = bg & 63;
        const float dt = expf(gin(p, 14)[g]); const float are = gin(p, 7)[g * SP + pl], aim = gin(p, 8)[g * SP + pl];
        const float mag = expf(dt * are); float ar = mag * cosf(dt * aim), ai = mag * sinf(dt * aim);
#pragma unroll
        for (int q = 0; q < 8; ++q) { const float nr = ar * ar - ai * ai, ni = 2.0f * ar * ai; ar = nr; ai = ni; }
        float cr = 0.f, ci = 0.f;
        for (int n = 0; n < S5NC; ++n) { float* Eu = E + ((size_t)bg * S5NC + n) * 128; const float er = Eu[pl], ei = Eu[64 + pl];
            Eu[pl] = cr; Eu[64 + pl] = ci;
            const float nr = ar * cr - ai * ci + er, ni = ar * ci + ai * cr + ei; cr = nr; ci = ni; }
    }
}

constexpr int NPHASES = 34;
#ifndef PROBE_DRY14
#define PROBE_DRY14 0
#endif
#ifndef PROBE_DRY17
#define PROBE_DRY17 0
#endif
#ifndef PH_MASK
#define PH_MASK 0xFFFFFFFFu
#endif
#define PHT(t) ((PH_MASK >> (t)) & 1u)
constexpr int PLAN_OFF = 64;
__device__ __forceinline__ void moe_plan(const Frame& F, int layer) {
    volatile LAS int* tstart = (volatile LAS int*)(F.MISC + PLAN_OFF); volatile LAS int* cnts = tstart + 72;
    __syncthreads();
    if (F.wave == 0) {
        const unsigned* cnt = (const unsigned*)(F.ws + WS_CTL) + CW_CNT + layer * NE * 64;
        const int c = (int)__hip_atomic_load(cnt + F.lane * 64, __ATOMIC_RELAXED, __HIP_MEMORY_SCOPE_AGENT);
        int v = (c + 255) >> 8;
#pragma unroll
        for (int o = 1; o < 64; o <<= 1) { const int nb = __builtin_amdgcn_ds_bpermute((F.lane - o) << 2, v); if (F.lane >= o) v += nb; }
        tstart[F.lane + 1] = v; cnts[F.lane] = c;
        if (F.lane == 0) tstart[0] = 0;
        if (F.lane == 63) { tstart[65] = v + T / 256; cnts[64] = T; }
    }
    __syncthreads();
}
template <bool GATH> struct MoeSched2 {
    static constexpr bool GATHER = GATH, UNIFORMIZE = true, FP8 = GATH;
    static constexpr int ncol = GATH ? 2 : 4, K = GATH ? D / 2 : ED;
    const volatile LAS int* tstart; const volatile LAS int* cnts; int ntiles, G, c, lane;
    const char* Abase; const char* Wbase; const int* lists;
    __device__ __forceinline__ bool next(int i, pg8::UnitG& u) const {
        const int nwg = ntiles * ncol; const long L = (long)i * G + c; if (L >= nwg) return false;
        int wgid = (int)L; { const int q = nwg / 8, r = nwg % 8, xcd = wgid % 8, off = wgid / 8; wgid = (xcd < r ? xcd * (q + 1) : r * (q + 1) + (xcd - r) * q) + off; }
        const int tile = wgid / ncol, pn = wgid % ncol;
        const int ta = tstart[lane], tb = tstart[lane + 1];
        const unsigned long long mm = __ballot(ta <= tile && tile < tb);
        const int e = mm ? (int)__builtin_ctzll(mm) : 64;
        const int ts = __builtin_amdgcn_readfirstlane((int)tstart[e]), ce = __builtin_amdgcn_readfirstlane((int)cnts[e]);
        const int lt = tile - ts; int valid = ce - lt * 256; valid = valid > 256 ? 256 : valid;
        u.gshift = 0; u.aux = e;
        if (GATH) {
            u.B = Wbase + (size_t)e * WMOE_E_BYTES + (size_t)pn * 256 * K * 2;
            if (e < 64) { u.A = Abase; u.gidx = lists + (size_t)e * T + lt * 256; u.gcnt = valid; }
            else { u.A = Abase + (size_t)lt * 256 * K * 2; u.gidx = nullptr; u.gcnt = 0; }
            u.row0 = tile * 256; u.col0 = pn * 128;
        } else {
            u.B = Wbase + (size_t)e * WMOE_E_BYTES + (size_t)512 * 1024 * 2 + (size_t)pn * 256 * K * 2;
            u.A = Abase + (size_t)tile * 256 * K * 2; u.gidx = nullptr; u.gcnt = valid;
            u.row0 = tile * 256; u.col0 = pn * 256;
        }
        return true;
    }
};
__device__ __forceinline__ void phase_load_x(const Frame& F, KP p) {
    const float* xin = gin(p, 0); bf16* XB = (bf16*)(F.ws + WS_XB);
    for (size_t i = (size_t)F.vcu * NTHREADS + F.tid; i < (size_t)T * D / 8; i += (size_t)F.G * NTHREADS) {
        const f32x4 a = *(const f32x4*)(xin + i * 8), b = *(const f32x4*)(xin + i * 8 + 4);
        *(u32x4*)(XB + i * 8) = pack_bf16x8(a, b);
        u32x2 q8; q8.x = pk4_fp8(a[0], a[1], a[2], a[3]); q8.y = pk4_fp8(b[0], b[1], b[2], b[3]); *(u32x2*)((unsigned char*)(F.ws + WS_X) + i * 8) = q8; }
}

__global__ void __launch_bounds__(NTHREADS, 2) fwd_kernel(Params p_unused) {
    KP p0 = (KP)__builtin_amdgcn_kernarg_segment_ptr();
    extern __shared__ __attribute__((aligned(16))) unsigned char lds_raw[];
    Frame F0;
    F0.lds = (LAS unsigned char*)lds_raw; F0.MISC = (volatile LAS unsigned*)(F0.lds + MISC_OFF);
    F0.tid = threadIdx.x; F0.lane = F0.tid & 63; F0.wave = __builtin_amdgcn_readfirstlane(F0.tid >> 6);
    F0.G = gridDim.x; { const int bq = blockIdx.x; F0.vcu = (F0.G % 8 == 0) ? (bq % 8) * (F0.G / 8) + bq / 8 : bq; }
    F0.ws = p0->ws;
    const int bx0 = blockIdx.x;
    for (int u = F0.tid; u < (LDS_BYTES - MISC_OFF) / 4; u += NTHREADS) ((LAS unsigned*)(F0.lds + MISC_OFF))[u] = 0u;
    __syncthreads();
    XcdBarrier bar; bar.bar = (unsigned*)(p0->ws + WS_CTL) + CW_BAR; bar.x = 0; bar.st = nullptr;
    const int use_bar = p0->use_bar;
    if (use_bar) bar = xcd_barrier_post((unsigned*)(p0->ws + WS_CTL) + CW_BAR, F0.MISC + 8);
    const int lo = p0->ph_lo, hi = p0->ph_hi;
#define PHASE_BEGIN Frame F = F0; KP p = p0; { unsigned ones_ = ~0u; asm volatile("" : "+s"(ones_)); F.lane = (int)__builtin_amdgcn_mbcnt_hi(ones_, __builtin_amdgcn_mbcnt_lo(ones_, 0u)); } asm volatile("" : "+v"(F.lane)); F.tid = F.wave * 64 + F.lane; asm volatile("" : "+v"(F.tid));   GAS unsigned char* wsg_ = (GAS unsigned char*)F0.ws; asm volatile("" : "+s"(F.wave), "+s"(F.vcu), "+s"(F.G), "+s"(wsg_), "+s"(p)); \
    F.ws = (unsigned char*)wsg_; int bx = bx0; asm volatile("" : "+s"(bx)); unsigned char* ws = F.ws; (void)ws; (void)bx;
#pragma unroll 1
    for (int ph = lo; ph < hi; ++ph) {
        int layer = 0, type = 0;
        if (ph > 0) { layer = ph >= 26 ? 3 : (ph >= 18 ? 2 : (ph >= 9 ? 1 : 0)); const int q = ph - (layer == 3 ? 26 : (layer == 2 ? 18 : (layer == 1 ? 9 : 1))); const int kind = layer % 3;
            if (kind == 0) type = q < 4 ? 1 + q : 14 + (q - 4); else if (kind == 1) type = q < 5 ? 5 + q : 14 + (q - 5); else type = q < 4 ? 10 + q : 14 + (q - 4); }
        const int j = layer / 3;
#ifdef REPEAT_MASK
        const int nrep = ((REPEAT_MASK >> type) & 1u) ? 2 : 1;
#else
        const int nrep = 1;
#endif
#pragma unroll 1
        for (int rep = 0; rep < nrep; ++rep) {
        if (rep > 0 && use_bar) xcd_barrier(bar);
        if (PHT(0) && type == 0) { PHASE_BEGIN; phase_conv_mixers(F, p); phase_conv_moe(F, p, 0); phase_load_x(F, p); }
        else if (PHT(1) && type == 1) { PHASE_BEGIN; DenseSched8 S; S.init(ws + WS_X, ws + WS_ATT_IN_T + (size_t)j * ATT_IN * D, T, ATT_IN, D / 2, F.G, bx); EpiStoreBf16 E{(bf16*)(ws + WS_BIG), ATT_IN, WUP_INV, 0.08838834764831845f};
            pg8::gemm_phase(F.lds, F.tid, D / 2, S, E); }
        else if (PHT(2) && type == 2) { PHASE_BEGIN; phase_attn(F, bx); }
        else if (PHT(3) && type == 3) { PHASE_BEGIN; phase_attn_combine(F); }
        else if (PHT(4) && type == 4) { PHASE_BEGIN; DenseSched S; S.init(ws + WS_AUX + AUX_OB, ws + WS_ATT_OUT_T + (size_t)j * D * D * 2, T, D, D, F.G, bx); EpiResid E{(const bf16*)(ws + WS_XB), (bf16*)(ws + WS_Y)};
            pg8::gemm_phase(F.lds, F.tid, D, S, E); }
        else if (PHT(5) && type == 5) { PHASE_BEGIN; DenseSched8 S; S.init(ws + WS_X, ws + WS_RET_IN_T, T, RET_IN, D / 2, F.G, bx); EpiRetIn E{(bf16*)(ws + WS_BIG), RET_IN};
            pg8::gemm_phase(F.lds, F.tid, D / 2, S, E); }
        else if (PHT(6) && type == 6) { PHASE_BEGIN; phase_ret_u(F); }
        else if (PHT(7) && type == 7) { PHASE_BEGIN; phase_ret_scan(F); }
        else if (PHT(8) && type == 8) { PHASE_BEGIN; phase_ret_out(F, p); }
        else if (PHT(9) && type == 9) { PHASE_BEGIN; DenseSched S; S.init(ws + WS_BIG + BIG_YRET, ws + WS_RET_OUT_T, T, D, RET_V, F.G, bx); EpiResid E{(const bf16*)(ws + WS_XB), (bf16*)(ws + WS_Y)};
            pg8::gemm_phase(F.lds, F.tid, RET_V, S, E); }
        else if (PHT(10) && type == 10) { PHASE_BEGIN; phase_s5_scan<false>(F, p); }
        else if (PHT(11) && type == 11) { PHASE_BEGIN; phase_s5_carry(F, p); }
        else if (PHT(12) && type == 12) { PHASE_BEGIN; phase_s5_scan<true>(F, p); }
        else if (PHT(13) && type == 13) { PHASE_BEGIN; DenseSched S; S.init(ws + WS_AUX, ws + WS_GLU_T, T, 2 * D, D, F.G, bx); EpiGluResid E{(const bf16*)(ws + WS_XB), (bf16*)(ws + WS_Y)};
            pg8::gemm_phase(F.lds, F.tid, D, S, E); }
        else if (PHT(14) && type == 14) { PHASE_BEGIN; phase_lnr(F, p, layer, PROBE_DRY14 && true); if (PROBE_DRY14) { if (use_bar) xcd_barrier(bar); phase_lnr(F, p, layer, false); } }
        else if (PHT(15) && type == 15) { PHASE_BEGIN; moe_plan(F, layer);
            MoeSched2<true> S; S.tstart = (const volatile LAS int*)(F.MISC + PLAN_OFF); S.cnts = S.tstart + 72; S.ntiles = __builtin_amdgcn_readfirstlane((int)S.tstart[65]); S.G = F.G; S.c = bx; S.lane = F.lane;
            S.Abase = (const char*)(ws + WS_X); S.Wbase = (const char*)(ws + WS_WMOE); S.lists = (const int*)(ws + WS_LIST);
            EpiMoeUp E{(bf16*)(ws + WS_H)};
            pg8::gemm_phase(F.lds, F.tid, D / 2, S, E); }
        else if (PHT(16) && type == 16) { PHASE_BEGIN; moe_plan(F, layer);
            { MoeSched2<false> S; S.tstart = (const volatile LAS int*)(F.MISC + PLAN_OFF); S.cnts = S.tstart + 72; S.ntiles = __builtin_amdgcn_readfirstlane((int)S.tstart[64]); S.G = F.G; S.c = bx; S.lane = F.lane;
              S.Abase = (const char*)(ws + WS_H); S.Wbase = (const char*)(ws + WS_WMOE); S.lists = (const int*)(ws + WS_LIST);
              EpiStoreFp8 E{(unsigned char*)(ws + WS_BIG), D};
              pg8::gemm_phase(F.lds, F.tid, ED, S, E); }
            { const int sh0 = __builtin_amdgcn_readfirstlane((int)((const volatile LAS int*)(F.MISC + PLAN_OFF))[64]);
              DenseSched S; S.init(ws + WS_H + (size_t)sh0 * 256 * ED * 2, ws + WS_WMOE + (size_t)64 * WMOE_E_BYTES + (size_t)512 * 1024 * 2, T, D, ED, F.G, bx); EpiResid E{(const bf16*)(ws + WS_XB), (bf16*)(ws + WS_Y)};
              pg8::gemm_phase(F.lds, F.tid, ED, S, E); } }
        else if (PHT(17) && type == 17) { PHASE_BEGIN; moe_plan(F, layer); if (PROBE_DRY17) { phase_combine(F, p, layer, true); if (use_bar) xcd_barrier(bar); } phase_combine(F, p, layer); if (layer + 1 < DEPTH) phase_conv_moe(F, p, layer + 1); }
        }
        if (use_bar && ph + 1 < hi) xcd_barrier(bar);
    }
}

#ifndef MK_PER_PHASE
#define MK_PER_PHASE 0
#endif
extern "C" void kernel_launch(void* const* d_in, const int* in_sizes, int n_in, void* d_out, int out_size, void* d_ws, size_t ws_size, hipStream_t stream) {
    static int grid = 0;
    if (grid == 0) {
        if (n_in != 26 || in_sizes[0] != T * D || out_size != T * D || ws_size < WS_END) { fprintf(stderr, "kernel_launch: unexpected shapes / workspace (n_in %d, in0 %d, out %d, ws %zu < %zu)\n", n_in, n_in > 0 ? in_sizes[0] : -1, out_size, ws_size, (size_t)WS_END); grid = -1; return; }
        int dev = 0, cus = 0, per_cu = 0;
        if (hipGetDevice(&dev) != hipSuccess || hipDeviceGetAttribute(&cus, hipDeviceAttributeMultiprocessorCount, dev) != hipSuccess) { grid = -1; return; }
        if (hipFuncSetAttribute((const void*)fwd_kernel, hipFuncAttributeMaxDynamicSharedMemorySize, LDS_BYTES) != hipSuccess) { fprintf(stderr, "kernel_launch: hipFuncSetAttribute failed\n"); grid = -1; return; }
        if (hipOccupancyMaxActiveBlocksPerMultiprocessor(&per_cu, (const void*)fwd_kernel, NTHREADS, LDS_BYTES) != hipSuccess || per_cu < 1) { fprintf(stderr, "kernel_launch: occupancy query says %d blocks per CU\n", per_cu); per_cu = 1; }
        (void)hipGetLastError();
        grid = cus;
    }
    if (grid < 0) return;
    (void)hipMemsetAsync((char*)d_ws + WS_CTL, 0, CTL_ZERO_BYTES, stream);
    Params p{};
    for (int i = 0; i < 26; ++i) p.in[i] = (const float*)d_in[i];
    p.out = (float*)d_out; p.ws = (unsigned char*)d_ws;
#if MK_PER_PHASE
    for (int k = 0; k < NPHASES; ++k) { p.ph_lo = k; p.ph_hi = k + 1; p.use_bar = 0; hipLaunchKernelGGL(fwd_kernel, dim3(grid), dim3(NTHREADS), LDS_BYTES, stream, p); }
#else
    p.ph_lo = 0; p.ph_hi = NPHASES; p.use_bar = 1;
    hipLaunchKernelGGL(fwd_kernel, dim3(grid), dim3(NTHREADS), LDS_BYTES, stream, p);
#endif
}
```

```cpp
#include <hip/hip_runtime.h>
#include <cstdio>
#include <cstdint>

#define LAS __attribute__((address_space(3)))
#define GAS __attribute__((address_space(1)))
typedef unsigned short bf16;
typedef short bf16x8 __attribute__((ext_vector_type(8)));
typedef short bf16x4 __attribute__((ext_vector_type(4)));
typedef float f32x4 __attribute__((ext_vector_type(4)));
typedef float f32x2 __attribute__((ext_vector_type(2)));
typedef unsigned u32x4 __attribute__((ext_vector_type(4)));
typedef unsigned u32x2 __attribute__((ext_vector_type(2)));
typedef GAS unsigned gu32;

constexpr int D = 1024, BATCH = 2, SEQ = 8192, T = BATCH * SEQ, DEPTH = 4;
constexpr int AH = 8, AHD = 128, ATT_IN = 9216;
constexpr int RH = 4, RDK = 256, RDV = 512, RET_IN = 6144, RET_V = 2048, RC = 128, RNC = SEQ / RC;
constexpr int SG = 64, SGC = 16, SP = 64;
constexpr int NE = 64, TOPK = 8, NEG = 8, ED = 256, NSLOT = 9;
constexpr float LN_EPS = 1e-5f;
constexpr float ALPHA = 1.6817928305074292f;
constexpr int NWAVES = 8, NTHREADS = 512;

__device__ __forceinline__ unsigned f2bf(float f) { unsigned u = __builtin_bit_cast(unsigned, f); return (u + 0x7fffu + ((u >> 16) & 1u)) >> 16; }
__device__ __forceinline__ unsigned pk2(float lo, float hi) { unsigned r; asm("s_nop 1\n\tv_cvt_pk_bf16_f32 %0, %1, %2" : "=v"(r) : "v"(lo), "v"(hi)); return r; }
__device__ __forceinline__ unsigned pk2sw(float lo, float hi) { return f2bf(lo) | (f2bf(hi) << 16); }
__device__ __forceinline__ unsigned pk2hw(float lo, float hi) { unsigned r; asm volatile("v_cvt_pk_bf16_f32 %0, %1, %2" : "=v"(r) : "v"(lo), "v"(hi)); return r; }
__device__ __forceinline__ float bf2f(unsigned b) { return __builtin_bit_cast(float, b << 16); }
__device__ __forceinline__ float bflo(unsigned w) { return __builtin_bit_cast(float, w << 16); }
__device__ __forceinline__ float bfhi(unsigned w) { return __builtin_bit_cast(float, w & 0xffff0000u); }
__device__ __forceinline__ float shx(float v, int m, int lane) { return __builtin_bit_cast(float, __builtin_amdgcn_ds_bpermute((lane ^ m) << 2, __builtin_bit_cast(int, v))); }
__device__ __forceinline__ int shx_i(int v, int m, int lane) { return __builtin_amdgcn_ds_bpermute((lane ^ m) << 2, v); }
__device__ __forceinline__ float rdl(float v, int src) { return __builtin_bit_cast(float, __builtin_amdgcn_readlane(__builtin_bit_cast(int, v), src)); }
template <int CTRL, int RM = 0xf, int BM = 0xf> __device__ __forceinline__ float dpp0(float v) { return __builtin_bit_cast(float, __builtin_amdgcn_update_dpp(0, __builtin_bit_cast(int, v), CTRL, RM, BM, true)); }
template <int CTRL, int RM = 0xf, int BM = 0xf> __device__ __forceinline__ float dppo(float old, float v) { return __builtin_bit_cast(float, __builtin_amdgcn_update_dpp(__builtin_bit_cast(int, old), __builtin_bit_cast(int, v), CTRL, RM, BM, false)); }
__device__ __forceinline__ float wave_sum(float v, int lane) {
    (void)lane;
    v += dpp0<0x111>(v); v += dpp0<0x112>(v); v += dpp0<0x114>(v); v += dpp0<0x118>(v);
    v += dpp0<0x142, 0xa>(v);
    v += dpp0<0x143, 0xc>(v);
    return rdl(v, 63);
}
__device__ __forceinline__ float max8(float v) {
    v = fmaxf(v, dppo<0xb1>(v, v)); v = fmaxf(v, dppo<0x4e>(v, v)); v = fmaxf(v, dppo<0x141>(v, v)); return v;
}
__device__ __forceinline__ float fsig(float x) { return __builtin_amdgcn_rcpf(1.0f + __expf(-x)); }
#define LDS_WAIT() asm volatile("s_waitcnt lgkmcnt(0)" ::: "memory")
#define VM_WAIT() asm volatile("s_waitcnt vmcnt(0)" ::: "memory")
__device__ __forceinline__ const char* rfl_ptr(const char* p) {
    unsigned long long v = (unsigned long long)p; unsigned lo = __builtin_amdgcn_readfirstlane((unsigned)v), hi = __builtin_amdgcn_readfirstlane((unsigned)(v >> 32));
    return (const char*)(((unsigned long long)hi << 32) | lo);
}
__device__ __forceinline__ bf16x8 row_frag(const LAS bf16* base, int ld, int row0, int col0, int lane) {
    return *(const LAS bf16x8*)(base + (row0 + (lane & 15)) * ld + col0 + 8 * (lane >> 4));
}
__device__ __forceinline__ bf16x4 tr4(const LAS bf16* addr) { return __builtin_amdgcn_ds_read_tr16_b64_v4i16((LAS bf16x4*)addr); }
__device__ __forceinline__ bf16x8 cat8(bf16x4 a, bf16x4 b) { bf16x8 r; r[0] = a[0]; r[1] = a[1]; r[2] = a[2]; r[3] = a[3]; r[4] = b[0]; r[5] = b[1]; r[6] = b[2]; r[7] = b[3]; return r; }
#define MFMA16(a, b, c) __builtin_amdgcn_mfma_f32_16x16x32_bf16((a), (b), (c), 0, 0, 0)
__device__ __forceinline__ bf16x8 pack8(f32x4 a, f32x4 b) {
    u32x4 w; w.x = pk2(a[0], a[1]); w.y = pk2(a[2], a[3]); w.z = pk2(b[0], b[1]); w.w = pk2(b[2], b[3]); return __builtin_bit_cast(bf16x8, w);
}

namespace pg8 {
typedef int v4i_t __attribute__((ext_vector_type(4)));
typedef int v8i_t __attribute__((ext_vector_type(8)));
constexpr int BM = 256, BK = 64, HALF = 128, HTB = HALF * BK * 2, STAGE_BYTES = 8 * HTB;
__device__ __forceinline__ int lds_byte(int r, int c) { const int st = (r >> 4) * 2 + (c >> 5), rr = r & 15, cc = c & 31, ob = rr * 64 + cc * 2; return st * 1024 + (ob ^ (((ob >> 9) & 1) << 5)); }
__device__ __forceinline__ void stage_rc(int b, int& R, int& C) { const int st = b / 1024, sb = b % 1024, swz = sb ^ (((sb >> 9) & 1) << 5); R = (st >> 1) * 16 + swz / 64; C = (st & 1) * 32 + (swz % 64) / 2; }
__device__ __forceinline__ int perm32(int rho) { const int n = rho >> 4, i = rho & 15; return 8 * (i >> 2) + 4 * n + (i & 3); }

struct UnitG {
    const char* A;
    const char* B;
    const int* gidx;
    int gcnt, gshift;
    int row0, col0;
    int aux;
};

__device__ __forceinline__ void uniformize(UnitG& u) { u.A = rfl_ptr(u.A); u.B = rfl_ptr(u.B); u.gidx = (const int*)rfl_ptr((const char*)u.gidx); u.gcnt = __builtin_amdgcn_readfirstlane(u.gcnt); u.gshift = __builtin_amdgcn_readfirstlane(u.gshift);
    u.row0 = __builtin_amdgcn_readfirstlane(u.row0); u.col0 = __builtin_amdgcn_readfirstlane(u.col0); u.aux = __builtin_amdgcn_readfirstlane(u.aux); }
template <class Epi, class Sched>
__device__ __forceinline__ void gemm_phase(LAS unsigned char* lds, const int tid, const int K, const Sched& S, const Epi& E) {
    constexpr bool F8 = Sched::FP8;
    constexpr bool GATHER = Sched::GATHER;
    const int wid = __builtin_amdgcn_readfirstlane(tid >> 6), lane = tid & 63, wr = wid >> 2, wc = wid & 3, fr = lane & 15, fq = lane >> 4;
    const int nt = K / BK;
    constexpr bool P16 = Epi::PERM16;
    unsigned voffB[2], voffB1[2], vA[2][2];
#pragma unroll
    for (int i = 0; i < 2; ++i) { int R, C; stage_rc(tid * 16 + i * 8192, R, C); const int Rb = Epi::PERM ? ((R & ~31) + perm32(R & 31)) : R; voffB[i] = (unsigned)(Rb * K + C) * 2u; voffB1[i] = voffB[i]; vA[0][i] = (unsigned)(R * K + C) * 2u; vA[1][i] = vA[0][i];
        if constexpr (P16) { const int x = R & 31, src = 64 * (R >> 5) + 16 * ((x >> 2) & 3) + 4 * (x >> 4) + (x & 3); voffB[i] = (unsigned)(src * K + C) * 2u; voffB1[i] = (unsigned)((src + 8) * K + C) * 2u; } }
    const size_t kstep = (size_t)(BK * 2);
    const size_t hstep = (size_t)HALF * K * 2;
    const size_t hstepB = P16 ? 0 : hstep;
    const size_t hstepA = GATHER ? 0 : hstep;
    const unsigned ldsw = (unsigned)wid * 1024u;
    const int aoff = F8 ? lds_byte(wr * 64 + fr, fq * 16) : lds_byte(wr * 64 + fr, fq * 8), boff = F8 ? lds_byte(wc * 32 + fr, fq * 16) : lds_byte(wc * 32 + fr, fq * 8);
    LAS u32x4* park = (LAS u32x4*)(lds + STAGE_BYTES) + tid;
#define PG8_SA(b, h) (((b) * 2 + (h)) * HTB)
#define PG8_SB(b, h) ((4 + (b) * 2 + (h)) * HTB)
#define PG8_STAGE(bufoff, gbase, voff) do { _Pragma("unroll") for (int _i = 0; _i < 2; ++_i) { asm volatile("" : "+v"((voff)[_i]));   \
        __builtin_amdgcn_global_load_lds((const unsigned*)((const char*)(gbase) + (voff)[_i]), (LAS unsigned*)(lds + (bufoff) + ldsw + _i * 8192), 16, 0, 0); } } while (0)
    constexpr int FKS = F8 ? 16 : 1024;
#define PG8_LD2(p_) __builtin_shufflevector(*(const LAS v4i_t*)(p_), *(const LAS v4i_t*)((p_) + FKS), 0, 1, 2, 3, 4, 5, 6, 7)
#define PG8_LDA(dst, b, h) do { _Pragma("unroll") for (int m = 0; m < 4; ++m) dst[m] = PG8_LD2(lds + PG8_SA(b, h) + aoff + m * 2048); } while (0)
#define PG8_LDB(dst, b, h) do { _Pragma("unroll") for (int n = 0; n < 2; ++n) dst[n] = PG8_LD2(lds + PG8_SB(b, h) + boff + n * 2048); } while (0)
#define PG8_LO(v) __builtin_bit_cast(bf16x8, __builtin_shufflevector((v), (v), 0, 1, 2, 3))
#define PG8_HI(v) __builtin_bit_cast(bf16x8, __builtin_shufflevector((v), (v), 4, 5, 6, 7))
#define PG8_MMA(ai, bj, At, Bt) do { __builtin_amdgcn_s_setprio(1); _Pragma("unroll") for (int m = 0; m < 4; ++m) _Pragma("unroll") for (int n = 0; n < 2; ++n) { \
        if constexpr (F8) { acc[ai][bj][m][n] = __builtin_amdgcn_mfma_scale_f32_16x16x128_f8f6f4(Bt[n], At[m], acc[ai][bj][m][n], 0, 0, 0, 0x7F7F7F7F, 0, 0x7F7F7F7F); } \
        else { acc[ai][bj][m][n] = __builtin_amdgcn_mfma_f32_16x16x32_bf16(PG8_LO(Bt[n]), PG8_LO(At[m]), acc[ai][bj][m][n], 0, 0, 0); \
               acc[ai][bj][m][n] = __builtin_amdgcn_mfma_f32_16x16x32_bf16(PG8_HI(Bt[n]), PG8_HI(At[m]), acc[ai][bj][m][n], 0, 0, 0); } } __builtin_amdgcn_s_setprio(0); } while (0)
#define PG8_WAIT_V(n) asm volatile("s_waitcnt vmcnt(" #n ")" ::: "memory")
#define PG8_WAIT_L(n) asm volatile("s_waitcnt lgkmcnt(" #n ")" ::: "memory")
#define PG8_BAR __builtin_amdgcn_s_barrier()
#define PG8_SCHED __builtin_amdgcn_sched_barrier(0)
#define PG8_VOFF(u, v00, v01, v10, v11) do { int _R0, _C0, _R1, _C1; stage_rc(tid * 16, _R0, _C0); stage_rc(tid * 16 + 8192, _R1, _C1); int _r00 = _R0, _r01 = _R1, _r10 = HALF + _R0, _r11 = HALF + _R1; \
        if ((u).gidx) { const GAS int* _gp = (const GAS int*)(u).gidx; const int _gc = (u).gcnt;     \
            const int _a = _gp[_r00 < _gc ? _r00 : 0] >> (u).gshift, _b = _gp[_r01 < _gc ? _r01 : 0] >> (u).gshift, _c = _gp[_r10 < _gc ? _r10 : 0] >> (u).gshift, _d = _gp[_r11 < _gc ? _r11 : 0] >> (u).gshift; \
            _r00 = _a; _r01 = _b; _r10 = _c; _r11 = _d; } \
        v00 = (unsigned)(_r00 * K + _C0) * 2u; v01 = (unsigned)(_r01 * K + _C1) * 2u; v10 = (unsigned)(_r10 * K + _C0) * 2u; v11 = (unsigned)(_r11 * K + _C1) * 2u; } while (0)
    UnitG cur, nxt; int ui = 0;
    if (!S.next(0, cur)) return;
    if constexpr (Sched::UNIFORMIZE) uniformize(cur);
    f32x4 acc[2][2][4][2];
#pragma unroll
    for (int a = 0; a < 2; ++a)
#pragma unroll
        for (int b = 0; b < 2; ++b)
#pragma unroll
            for (int m = 0; m < 4; ++m)
#pragma unroll
                for (int n = 0; n < 2; ++n) acc[a][b][m][n] = (f32x4){0.f, 0.f, 0.f, 0.f};
    v8i_t At[4], B0[2], B1[2];
    if constexpr (GATHER) PG8_VOFF(cur, vA[0][0], vA[0][1], vA[1][0], vA[1][1]);
    const char* cA = cur.A; const char* cB = cur.B;
    PG8_STAGE(PG8_SB(0, 0), cB, voffB); PG8_STAGE(PG8_SB(0, 1), cB + hstepB, voffB1); PG8_STAGE(PG8_SA(0, 0), cA, vA[0]); PG8_STAGE(PG8_SA(0, 1), cA + hstepA, vA[1]);
    if (wr == 1) PG8_BAR;
    PG8_WAIT_V(2); PG8_BAR;
    PG8_STAGE(PG8_SB(1, 0), cB + kstep, voffB); PG8_STAGE(PG8_SA(1, 0), cA + kstep, vA[0]); PG8_STAGE(PG8_SB(1, 1), cB + hstepB + kstep, voffB1);
    PG8_WAIT_V(6); PG8_BAR;
    for (;;) {
        const bool has_next = S.next(ui + 1, nxt);
        if constexpr (Sched::UNIFORMIZE) { if (has_next) uniformize(nxt); }
        const char* nA = cA; const char* nB = cB;
        if (has_next) { nA = nxt.A; nB = nxt.B; }
        if constexpr (GATHER) { u32x4 pv; pv.x = vA[0][0]; pv.y = vA[0][1]; pv.z = vA[1][0]; pv.w = vA[1][1];
            if (has_next) PG8_VOFF(nxt, pv.x, pv.y, pv.z, pv.w);
            *park = pv; }
#pragma unroll 1
        for (int t = 0; t < nt; t += 2) {
            const bool last = (t == nt - 2);
            const char* a1 = cA + (size_t)(t + 1) * kstep;
            const char* a2 = last ? nA : cA + (size_t)(t + 2) * kstep; const char* b2 = last ? nB : cB + (size_t)(t + 2) * kstep;
            const char* a3 = a2 + kstep; const char* b3 = b2 + kstep;
            PG8_LDB(B0, 0, 0); PG8_LDB(B1, 0, 1); PG8_SCHED; PG8_LDA(At, 0, 0); PG8_STAGE(PG8_SA(1, 1), a1 + hstepA, vA[1]);
            PG8_WAIT_V(8); PG8_WAIT_L(0); PG8_BAR; PG8_MMA(0, 0, At, B0); PG8_MMA(0, 1, At, B1); PG8_BAR; PG8_SCHED;
            if constexpr (GATHER) { if (last) { const u32x4 pv = *park; vA[0][0] = pv.x; vA[0][1] = pv.y; vA[1][0] = pv.z; vA[1][1] = pv.w; } }
            PG8_LDA(At, 0, 1); PG8_STAGE(PG8_SB(0, 0), b2, voffB); PG8_STAGE(PG8_SB(0, 1), b2 + hstepB, voffB1); PG8_STAGE(PG8_SA(0, 0), a2, vA[0]);
            PG8_WAIT_V(8); PG8_WAIT_L(0); PG8_BAR; PG8_MMA(1, 0, At, B0); PG8_MMA(1, 1, At, B1); PG8_BAR; PG8_SCHED;
            PG8_LDB(B0, 1, 0); PG8_LDB(B1, 1, 1); PG8_SCHED; PG8_LDA(At, 1, 0); PG8_STAGE(PG8_SA(0, 1), a2 + hstepA, vA[1]);
            PG8_WAIT_V(8); PG8_WAIT_L(0); PG8_BAR; PG8_MMA(0, 0, At, B0); PG8_MMA(0, 1, At, B1); PG8_BAR; PG8_SCHED;
            PG8_LDA(At, 1, 1); PG8_STAGE(PG8_SB(1, 0), b3, voffB); PG8_STAGE(PG8_SB(1, 1), b3 + hstepB, voffB1); PG8_STAGE(PG8_SA(1, 0), a3, vA[0]);
            PG8_WAIT_V(8); PG8_WAIT_L(0); PG8_BAR; PG8_MMA(1, 0, At, B0); PG8_MMA(1, 1, At, B1); PG8_BAR; PG8_SCHED;
        }
        if (wr == 0) PG8_BAR;
        E(acc, cur, wr, wc, fr, fq);
        if (!has_next) break;
#pragma unroll
        for (int a = 0; a < 2; ++a)
#pragma unroll
            for (int b = 0; b < 2; ++b)
#pragma unroll
                for (int m = 0; m < 4; ++m)
#pragma unroll
                    for (int n = 0; n < 2; ++n) acc[a][b][m][n] = (f32x4){0.f, 0.f, 0.f, 0.f};
        cur = nxt; cA = nA; cB = nB; ++ui;
        if (wr == 1) PG8_BAR;
    }
    PG8_WAIT_V(0);
    PG8_BAR;
#undef PG8_SA
#undef PG8_SB
#undef PG8_STAGE
#undef PG8_LDA
#undef PG8_LDB
#undef PG8_LD2
#undef PG8_LO
#undef PG8_HI
#undef PG8_MMA
#undef PG8_WAIT_V
#undef PG8_WAIT_L
#undef PG8_BAR
#undef PG8_SCHED
#undef PG8_VOFF
}
}

constexpr size_t MiB = 1u << 20;
constexpr size_t WS_CTL = 0, CTL_ZERO_BYTES = 1 * MiB;
constexpr size_t WS_ATT_IN_T = 1 * MiB;
constexpr size_t WS_ATT_OUT_T = WS_ATT_IN_T + 36 * MiB;
constexpr size_t WS_RET_IN_T = WS_ATT_OUT_T + 4 * MiB;
constexpr size_t WS_RET_OUT_T = WS_RET_IN_T + 12 * MiB;
constexpr size_t WS_GLU_T = WS_RET_OUT_T + 4 * MiB;
constexpr size_t WS_RT_HI = WS_GLU_T + 4 * MiB;
constexpr size_t WS_RT_LO = WS_RT_HI + 512 * 1024;
constexpr size_t WS_WMOE = WS_RT_HI + 1 * MiB;
constexpr size_t WMOE_E_BYTES = (size_t)(512 * 1024 + 1024 * 256) * 2;
constexpr size_t WS_X = WS_WMOE + 98 * MiB;
constexpr size_t WS_Y = WS_X + 64 * MiB;
constexpr size_t WS_XB = WS_Y + 64 * MiB;
constexpr size_t WS_BIG = WS_XB + 32 * MiB;
constexpr size_t WS_AUX = WS_BIG + 288 * MiB;
constexpr size_t WS_H = WS_AUX + 160 * MiB;
constexpr size_t WS_LIST = WS_H + 80 * MiB;
constexpr size_t WS_TRASH = WS_LIST + 8 * MiB;
constexpr size_t WS_END = WS_TRASH + 1 * MiB;
static_assert(WS_END <= 1024 * MiB, "workspace map");
constexpr int CW_BAR = 4096;
constexpr int CW_CNT = 16384;
constexpr int CW_CHK = 65536;
constexpr int HROWS = 163840;

#define XB_TMO      128
#define XB_XCNT(j)  (256  + 64 * (j))
#define XB_XSUB(j)  (1280 + 64 * (j))
#define XB_XGEN(j)  (2304 + 64 * (j))
#define XB_TOP      3328
#define XB_TOPGEN   3392
#define XCD_BAR_WORDS 3456
#define XB_SPIN_CAP (1u << 20)
__device__ __forceinline__ unsigned xb_ld(unsigned* p)              { return __hip_atomic_load(p, __ATOMIC_RELAXED, __HIP_MEMORY_SCOPE_AGENT); }
__device__ __forceinline__ unsigned xb_add(unsigned* p, unsigned v) { return __hip_atomic_fetch_add(p, v, __ATOMIC_RELAXED, __HIP_MEMORY_SCOPE_AGENT); }
__device__ __forceinline__ unsigned xb_xcc_id() { return (unsigned)__builtin_amdgcn_s_getreg((3 << 11) | 20) & 0xFu; }
#define XB_SPIN(cond, bar) do { unsigned _sp = 0; while (cond) { __builtin_amdgcn_s_sleep(1); \
    if ((++_sp & 255u) == 0u) { if (xb_ld(&(bar)[XB_TMO])) break; if (_sp > XB_SPIN_CAP) { atomicAdd(&(bar)[XB_TMO], 1u); break; } } } } while (0)
struct XcdBarrier { unsigned* bar; unsigned x; volatile LAS unsigned* st; };
__device__ __forceinline__ XcdBarrier xcd_barrier_post(unsigned* bar, volatile LAS unsigned* st) {
    XcdBarrier b; b.bar = bar; b.x = xb_xcc_id(); b.st = st;
    if (threadIdx.x == 0) (void)xb_add(&bar[XB_XCNT(b.x)], 1u);
    return b;
}
__device__ __forceinline__ void xcd_barrier_complete(unsigned* bar, unsigned x, unsigned& nloc, unsigned& nx) {
    const unsigned G = gridDim.x * gridDim.y * gridDim.z;
    unsigned sum, cnt, mine, sp = 0u;
    for (;;) {
        sum = 0u; cnt = 0u; mine = 0u;
#pragma unroll
        for (unsigned j = 0; j < 16; ++j) { const unsigned c = xb_ld(&bar[XB_XCNT(j)]); sum += c; cnt += (c > 0u) ? 1u : 0u; mine = (j == x) ? c : mine; }
        if (sum == G) break;
        __builtin_amdgcn_s_sleep(1);
        if ((++sp & 255u) == 0u) { if (xb_ld(&bar[XB_TMO])) break; if (sp > XB_SPIN_CAP) { atomicAdd(&bar[XB_TMO], 1u); break; } }
    }
    nloc = mine > 0u ? mine : 1u; nx = cnt > 0u ? cnt : 1u;
}
__device__ __forceinline__ void xcd_barrier(const XcdBarrier& b) {
    asm volatile("s_waitcnt vmcnt(0)" ::: "memory");
    __syncthreads();
    if (threadIdx.x == 0) {
        unsigned* bar = b.bar;
        __builtin_amdgcn_s_waitcnt(0);
        unsigned nloc = b.st[0], nx = b.st[1];
        if (nloc == 0u) { xcd_barrier_complete(bar, b.x, nloc, nx); b.st[0] = nloc; b.st[1] = nx; }
        const unsigned old = xb_add(&bar[XB_XSUB(b.x)], 1u);
        const unsigned gen = old / nloc;
        if (old + 1u == (gen + 1u) * nloc) {
            __builtin_amdgcn_fence(__ATOMIC_RELEASE, "agent");
            asm volatile("s_waitcnt vmcnt(0)" ::: "memory");
            const unsigned og = xb_add(&bar[XB_TOP], 1u);
            const unsigned tg = og / nx;
            if (og + 1u == (tg + 1u) * nx) xb_add(&bar[XB_TOPGEN], 1u);
            else XB_SPIN(xb_ld(&bar[XB_TOPGEN]) == tg, bar);
            __builtin_amdgcn_fence(__ATOMIC_ACQUIRE, "agent");
            xb_add(&bar[XB_XGEN(b.x)], 1u);
            asm volatile("s_waitcnt vmcnt(0)" ::: "memory");
        } else {
            XB_SPIN(xb_ld(&bar[XB_XGEN(b.x)]) == gen, bar);
            __builtin_amdgcn_fence(__ATOMIC_ACQUIRE, "agent");
            asm volatile("s_waitcnt vmcnt(0)" ::: "memory");
        }
    }
    __syncthreads();
}

constexpr int RING_BYTES = 139264;
constexpr int MISC_OFF = RING_BYTES;
constexpr int LDS_BYTES = 147456;
struct Params {
    const float* in[26]; float* out; unsigned char* ws; int ph_lo, ph_hi; int use_bar, pad;
};
typedef const __attribute__((address_space(4))) Params* KP;
__device__ __forceinline__ const float* gin(KP p, int i) { return (const float*)(const GAS float*)p->in[i]; }
__device__ __forceinline__ float* gout(KP p) { return (float*)(GAS float*)p->out; }
struct Frame {
    LAS unsigned char* lds; volatile LAS unsigned* MISC;
    int tid, lane, wave, vcu, G;
    unsigned char* ws;
};

template <bool F8_ = false> struct DenseSchedT {
    static constexpr bool GATHER = false, UNIFORMIZE = false, FP8 = F8_;
    const char* A; const char* Bt; int K, nM, nN, nwg, G, c;
    __device__ __forceinline__ void init(const void* A_, const void* Bt_, int M, int N, int K_, int G_, int c_) { A = (const char*)A_; Bt = (const char*)Bt_; K = K_; nM = M / 256; nN = N / 256; nwg = nM * nN; G = G_; c = c_; }
    __device__ __forceinline__ bool next(int i, pg8::UnitG& u) const {
        const long L = (long)i * G + c; if (L >= nwg) return false;
        int wgid = (int)L; { const int q = nwg / 8, r = nwg % 8, xcd = wgid % 8, off = wgid / 8; wgid = (xcd < r ? xcd * (q + 1) : r * (q + 1) + (xcd - r) * q) + off; }
        const int nig = 8 * nN, gid = wgid / nig, fm = gid * 8, gsz = (nM - fm) < 8 ? (nM - fm) : 8;
        const int pm = fm + ((wgid % nig) % gsz), pn = (wgid % nig) / gsz;
        u.A = A + (size_t)pm * 256 * K * 2; u.B = Bt + (size_t)pn * 256 * K * 2; u.gidx = nullptr; u.gcnt = 0; u.gshift = 0; u.row0 = pm * 256; u.col0 = pn * 256; u.aux = 0; return true;
    }
};
typedef DenseSchedT<false> DenseSched; typedef DenseSchedT<true> DenseSched8;
__device__ __forceinline__ u32x4 pack_bf16x8(const f32x4& v0, const f32x4& v1) { u32x4 w; w.x = pk2hw(v0[0], v0[1]); w.y = pk2hw(v0[2], v0[3]); w.z = pk2hw(v1[0], v1[1]); w.w = pk2hw(v1[2], v1[3]); return w; }

constexpr float WUP_SCALE = 32.0f, WUP_INV = 1.0f / 32.0f;
struct EpiStoreBf16 {
    static constexpr bool PERM = true, PERM16 = false;
    bf16* O; int ldc; float osc, qsc;
    __device__ __forceinline__ void operator()(const f32x4 (&acc)[2][2][4][2], const pg8::UnitG& u, int wr, int wc, int fr, int fq) const {
        const float sc = ((u.col0 % 3072) < 1024) ? osc * qsc : osc;
#pragma unroll
        for (int ai = 0; ai < 2; ++ai)
#pragma unroll
            for (int m = 0; m < 4; ++m) { bf16* rowp = O + (size_t)(u.row0 + ai * 128 + wr * 64 + m * 16 + fr) * ldc + u.col0 + wc * 32 + 8 * fq;
#pragma unroll
                for (int bj = 0; bj < 2; ++bj) *(u32x4*)(rowp + bj * 128) = pack_bf16x8(acc[ai][bj][m][0] * sc, acc[ai][bj][m][1] * sc); }
    }
};
constexpr float YEXP_SCALE = 32.0f, YEXP_INV = 1.0f / 32.0f;
struct EpiStoreFp8 {
    static constexpr bool PERM = false, PERM16 = true;
    unsigned char* O; int ldc;
    __device__ __forceinline__ void operator()(const f32x4 (&acc)[2][2][4][2], const pg8::UnitG& u, int wr, int wc, int fr, int fq) const {
#pragma unroll
        for (int ai = 0; ai < 2; ++ai)
#pragma unroll
            for (int m = 0; m < 4; ++m) { unsigned char* rowp = O + (size_t)(u.row0 + ai * 128 + wr * 64 + m * 16 + fr) * ldc + u.col0 + wc * 64 + 16 * fq;
                u32x4 w;
#pragma unroll
                for (int q = 0; q < 4; ++q) { f32x4 v = acc[ai][q >> 1][m][q & 1] * YEXP_SCALE;
#pragma unroll
                    for (int j = 0; j < 4; ++j) v[j] = fminf(fmaxf(v[j], -448.0f), 448.0f);
                    int d = 0; d = __builtin_amdgcn_cvt_pk_fp8_f32(v[0], v[1], d, false); d = __builtin_amdgcn_cvt_pk_fp8_f32(v[2], v[3], d, true); w[q] = (unsigned)d; }
                *(u32x4*)rowp = w; }
    }
};
struct EpiRetIn {
    static constexpr bool PERM = true, PERM16 = false;
    bf16* O; int ldc;
    __device__ __forceinline__ void operator()(const f32x4 (&acc)[2][2][4][2], const pg8::UnitG& u, int wr, int wc, int fr, int fq) const {
        float l2g = 0.f;
        float cs = WUP_INV;
        if (u.col0 < 2048) { const int h = (u.col0 & 1023) >> 8; const float g = 1.0f - exp2f(-5.0f - (float)h); l2g = log2f(g); if (u.col0 >= 1024) { l2g = -l2g; cs *= 0.0625f; } }
#pragma unroll
        for (int ai = 0; ai < 2; ++ai)
#pragma unroll
            for (int m = 0; m < 4; ++m) { const int row = u.row0 + ai * 128 + wr * 64 + m * 16 + fr; const float sc = exp2f(l2g * (float)(row & 127)) * cs;
                bf16* rowp = O + (size_t)row * ldc + u.col0 + wc * 32 + 8 * fq;
#pragma unroll
                for (int bj = 0; bj < 2; ++bj) *(u32x4*)(rowp + bj * 128) = pack_bf16x8(acc[ai][bj][m][0] * sc, acc[ai][bj][m][1] * sc); }
    }
};
__device__ __forceinline__ void unpack_bf16x8(const u32x4& w, f32x4& a, f32x4& b) { a[0] = bflo(w.x); a[1] = bfhi(w.x); a[2] = bflo(w.y); a[3] = bfhi(w.y); b[0] = bflo(w.z); b[1] = bfhi(w.z); b[2] = bflo(w.w); b[3] = bfhi(w.w); }
struct EpiResid {
    static constexpr bool PERM = true, PERM16 = false;
    const bf16* X; bf16* Y;
    __device__ __forceinline__ void operator()(const f32x4 (&acc)[2][2][4][2], const pg8::UnitG& u, int wr, int wc, int fr, int fq) const {
#pragma unroll
        for (int ai = 0; ai < 2; ++ai)
#pragma unroll
            for (int m = 0; m < 4; ++m) { const size_t off = (size_t)(u.row0 + ai * 128 + wr * 64 + m * 16 + fr) * D + u.col0 + wc * 32 + 8 * fq;
#pragma unroll
                for (int bj = 0; bj < 2; ++bj) { const u32x4 xw = *(const u32x4*)(X + off + bj * 128); f32x4 x0, x1; unpack_bf16x8(xw, x0, x1);
                    *(u32x4*)(Y + off + bj * 128) = pack_bf16x8(x0 * ALPHA + acc[ai][bj][m][0], x1 * ALPHA + acc[ai][bj][m][1]); }
                if (m == 3) asm volatile("" ::: "memory"); }
    }
};
struct EpiGluResid {
    static constexpr bool PERM = true, PERM16 = false;
    const bf16* X; bf16* Y;
    __device__ __forceinline__ void operator()(const f32x4 (&acc)[2][2][4][2], const pg8::UnitG& u, int wr, int wc, int fr, int fq) const {
#pragma unroll
        for (int ai = 0; ai < 2; ++ai)
#pragma unroll
            for (int m = 0; m < 4; ++m) { const size_t off = (size_t)(u.row0 + ai * 128 + wr * 64 + m * 16 + fr) * D + (u.col0 >> 1) + wc * 32 + 8 * fq;
                const u32x4 xw = *(const u32x4*)(X + off); f32x4 x0, x1; unpack_bf16x8(xw, x0, x1); f32x4 o0, o1;
#pragma unroll
                for (int j = 0; j < 4; ++j) { o0[j] = x0[j] * ALPHA + acc[ai][0][m][0][j] * fsig(acc[ai][1][m][0][j]); o1[j] = x1[j] * ALPHA + acc[ai][0][m][1][j] * fsig(acc[ai][1][m][1][j]); }
                *(u32x4*)(Y + off) = pack_bf16x8(o0, o1);
                if (m == 3) asm volatile("" ::: "memory"); }
    }
};
struct EpiMoeUp {
    static constexpr bool PERM = true, PERM16 = false;
    bf16* H;
    __device__ __forceinline__ void operator()(const f32x4 (&acc)[2][2][4][2], const pg8::UnitG& u, int wr, int wc, int fr, int fq) const {
#pragma unroll
        for (int ai = 0; ai < 2; ++ai)
#pragma unroll
            for (int m = 0; m < 4; ++m) { bf16* rowp = H + (size_t)(u.row0 + ai * 128 + wr * 64 + m * 16 + fr) * ED + u.col0 + wc * 32 + 8 * fq; f32x4 o[2];
#pragma unroll
                for (int n = 0; n < 2; ++n)
#pragma unroll
                    for (int j = 0; j < 4; ++j) { const float g = acc[ai][0][m][n][j] * WUP_INV, up = acc[ai][1][m][n][j] * WUP_INV; o[n][j] = g * fsig(g) * up; }
                *(u32x4*)rowp = pack_bf16x8(o[0], o[1]); }
    }
};

__device__ __forceinline__ unsigned pk4_fp8(float a, float b, float c, float d) {
    a = fminf(fmaxf(a, -448.0f), 448.0f); b = fminf(fmaxf(b, -448.0f), 448.0f); c = fminf(fmaxf(c, -448.0f), 448.0f); d = fminf(fmaxf(d, -448.0f), 448.0f);
    int w = 0; w = __builtin_amdgcn_cvt_pk_fp8_f32(a, b, w, false); w = __builtin_amdgcn_cvt_pk_fp8_f32(c, d, w, true); return (unsigned)w; }
template <bool HILO>
__device__ __forceinline__ void conv_item(const float* W, int ldw, bf16* WT, bf16* WTlo, int ldk, int k0, int n0, int drow0, float scale, LAS float* scr, int lane) {
#pragma unroll 8
    for (int i = 0; i < 32; ++i) { const int kk = 2 * i + (lane >> 5); scr[kk * 33 + (lane & 31)] = W[(size_t)(k0 + kk) * ldw + n0 + (lane & 31)] * scale; }
    LDS_WAIT(); asm volatile("" ::: "memory");
    const int c = lane & 7;
#pragma unroll
    for (int j = 0; j < 4; ++j) { const int n = (lane >> 3) + 8 * j; const LAS float* s = scr + (8 * c) * 33 + n;
        float v[8];
#pragma unroll
        for (int q = 0; q < 8; ++q) v[q] = s[q * 33];
        u32x4 o; o.x = pk2(v[0], v[1]); o.y = pk2(v[2], v[3]); o.z = pk2(v[4], v[5]); o.w = pk2(v[6], v[7]);
        *(u32x4*)(WT + (size_t)(drow0 + n) * ldk + k0 + 8 * c) = o;
        if (HILO) { float r[8];
#pragma unroll
            for (int q = 0; q < 8; ++q) r[q] = v[q] - bf2f(f2bf(v[q]));
            u32x4 o2; o2.x = pk2(r[0], r[1]); o2.y = pk2(r[2], r[3]); o2.z = pk2(r[4], r[5]); o2.w = pk2(r[6], r[7]);
            *(u32x4*)(WTlo + (size_t)(drow0 + n) * ldk + k0 + 8 * c) = o2; } }
    LDS_WAIT(); asm volatile("" ::: "memory");
}
__device__ __forceinline__ void conv_item8(const float* W, int ldw, unsigned char* WT, int ldk, int k0, int n0, int drow0, float scale, LAS float* scr, int lane) {
#pragma unroll 8
    for (int i = 0; i < 32; ++i) { const int kk = 2 * i + (lane >> 5); scr[kk * 33 + (lane & 31)] = W[(size_t)(k0 + kk) * ldw + n0 + (lane & 31)] * scale; }
    LDS_WAIT(); asm volatile("" ::: "memory");
    const int c = lane & 7;
#pragma unroll
    for (int j = 0; j < 4; ++j) { const int n = (lane >> 3) + 8 * j; const LAS float* s = scr + (8 * c) * 33 + n;
        float v[8];
#pragma unroll
        for (int q = 0; q < 8; ++q) v[q] = s[q * 33];
        u32x2 o; o.x = pk4_fp8(v[0], v[1], v[2], v[3]); o.y = pk4_fp8(v[4], v[5], v[6], v[7]);
        *(u32x2*)(WT + (size_t)(drow0 + n) * ldk + k0 + 8 * c) = o; }
    LDS_WAIT(); asm volatile("" ::: "memory");
}
__device__ __forceinline__ void phase_conv_mixers(const Frame& F, KP p) {
    LAS float* scr = (LAS float*)(F.lds + F.wave * 16384);
    const int gw = F.vcu * NWAVES + F.wave, NGW = F.G * NWAVES;
    constexpr int I_AIN = 16 * 288, I_AOUT = 16 * 32, I_RIN = 16 * 192, I_ROUT = 32 * 32, I_GLU = 16 * 64, I_RT = 16 * 2;
    constexpr int NITEMS = 2 * I_AIN + 2 * I_AOUT + I_RIN + I_ROUT + I_GLU + 4 * I_RT;
    unsigned char* ws = F.ws;
    for (int it = gw; it < NITEMS; it += NGW) {
        int r = it;
        if (r < 2 * I_AIN) { const int j = r / I_AIN; r %= I_AIN; const int kb = r / 288, nb = r % 288, n0 = nb * 32;
            conv_item8(gin(p, 1) + (size_t)j * D * ATT_IN, ATT_IN, (unsigned char*)(ws + WS_ATT_IN_T) + (size_t)j * ATT_IN * D, D, kb * 64, n0, n0, WUP_SCALE, scr, F.lane); continue; }
        r -= 2 * I_AIN;
        if (r < 2 * I_AOUT) { const int j = r / I_AOUT; r %= I_AOUT; const int kb = r / 32, nb = r % 32, n0 = nb * 32;
            conv_item<false>(gin(p, 2) + (size_t)j * D * D, D, (bf16*)(ws + WS_ATT_OUT_T) + (size_t)j * D * D, nullptr, D, kb * 64, n0, n0, 1.0f, scr, F.lane); continue; }
        r -= 2 * I_AOUT;
        if (r < I_RIN) { const int kb = r / 192, nb = r % 192, n0 = nb * 32;
            conv_item8(gin(p, 3), RET_IN, (unsigned char*)(ws + WS_RET_IN_T), D, kb * 64, n0, n0, WUP_SCALE, scr, F.lane); continue; }
        r -= I_RIN;
        if (r < I_ROUT) { const int kb = r / 32, nb = r % 32, n0 = nb * 32;
            conv_item<false>(gin(p, 6), D, (bf16*)(ws + WS_RET_OUT_T), nullptr, RET_V, kb * 64, n0, n0, 1.0f, scr, F.lane); continue; }
        r -= I_ROUT;
        if (r < I_GLU) { const int kb = r / 64, nb = r % 64, n0 = nb * 32; const int c = n0 & 1023, drow = (c >> 7) * 256 + (n0 >> 10) * 128 + (c & 127);
            conv_item<false>(gin(p, 15), 2 * D, (bf16*)(ws + WS_GLU_T), nullptr, D, kb * 64, n0, drow, 1.0f, scr, F.lane); continue; }
        r -= I_GLU;
        { const int l = r / I_RT; r %= I_RT; const int kb = r / 2, nb = r % 2, n0 = nb * 32;
            conv_item<true>(gin(p, 16) + (size_t)l * D * NE, NE, (bf16*)(ws + WS_RT_HI) + (size_t)l * NE * D, (bf16*)(ws + WS_RT_LO) + (size_t)l * NE * D, D, kb * 64, n0, n0, 1.0f, scr, F.lane); }
    }
}
__device__ __forceinline__ void phase_conv_moe(const Frame& F, KP p, int l) {
    LAS float* scr = (LAS float*)(F.lds + F.wave * 16384);
    const int gw = F.vcu * NWAVES + F.wave, NGW = F.G * NWAVES;
    for (int it = gw; it < 65 * 384; it += NGW) {
        const int e = it / 384, r = it % 384, which = r >> 7, rr = r & 127;
        bf16* We = (bf16*)(F.ws + WS_WMOE + (size_t)e * WMOE_E_BYTES);
        if (which < 2) { const float* src = (e < 64) ? gin(p, 18 + which) + ((size_t)l * NE + e) * D * ED : gin(p, 21 + which) + (size_t)l * D * ED;
            const int kb = rr >> 3, nb = rr & 7, n0 = nb * 32; const int drow = (n0 >> 7) * 256 + which * 128 + (n0 & 127);
            conv_item8(src, ED, (unsigned char*)We, D, kb * 64, n0, drow, WUP_SCALE, scr, F.lane);
        } else { const float* src = (e < 64) ? gin(p, 20) + ((size_t)l * NE + e) * ED * D : gin(p, 23) + (size_t)l * ED * D;
            const int kb = rr >> 5, nb = rr & 31, n0 = nb * 32;
            conv_item<false>(src, D, We + 512 * 1024, nullptr, ED, kb * 64, n0, n0, 1.0f, scr, F.lane); }
    }
}

__device__ __forceinline__ void phase_lnr(const Frame& F, KP p, int layer, bool dry = false) {
    const bf16* Y = (const bf16*)(F.ws + WS_Y); bf16* XB = (bf16*)(F.ws + WS_XB); unsigned char* XB8 = (unsigned char*)(F.ws + WS_X);
    const float* lng = gin(p, 24) + (size_t)(layer * 2) * D; const float* lnb = gin(p, 25) + (size_t)(layer * 2) * D;
    const bf16* rthi = (const bf16*)(F.ws + WS_RT_HI) + (size_t)layer * NE * D; const bf16* rtlo = (const bf16*)(F.ws + WS_RT_LO) + (size_t)layer * NE * D;
    const float* rbias = gin(p, 17) + layer * NE;
    unsigned* cnt = (unsigned*)(F.ws + WS_CTL) + CW_CNT + layer * NE * 64;
    int* lists = (int*)(F.ws + WS_LIST); int* tokmap = (int*)(F.ws + WS_LIST + 4 * MiB); float* tokgate = (float*)(F.ws + WS_LIST + 5 * MiB);
    constexpr int XLD = 1032, MAXT = 8;
    LAS bf16* Xhi = (LAS bf16*)F.lds; LAS bf16* Xlo = Xhi + 16 * XLD;
    LAS float* part = (LAS float*)(F.lds + 2 * 16 * XLD * 2);
    LAS int* ent = (LAS int*)(part + 2 * 16 * 64);
    LAS int* hist = ent + MAXT * 16 * 8 * 2; LAS int* base = hist + 64;
    const int lane = F.lane, w = F.wave, g4 = lane >> 4, l15 = lane & 15;
    if (F.tid < 64) hist[F.tid] = 0;
    bf16x8 bhi[16], blo[16];
    { const int nt = w & 3, kh = w >> 2; const bf16* bh = rthi + (size_t)(16 * nt + l15) * D + 512 * kh + 8 * g4; const bf16* bl = rtlo + (size_t)(16 * nt + l15) * D + 512 * kh + 8 * g4;
#pragma unroll
        for (int ks = 0; ks < 16; ++ks) { bhi[ks] = *(const bf16x8*)(bh + 32 * ks); blo[ks] = *(const bf16x8*)(bl + 32 * ks); } }
    u32x4 ypre[2][2];
    if (F.vcu < T / 16) {
#pragma unroll
        for (int rr = 0; rr < 2; ++rr)
#pragma unroll
            for (int j = 0; j < 2; ++j) ypre[rr][j] = *(const u32x4*)(Y + (size_t)(F.vcu * 16 + 2 * w + rr) * D + 8 * lane + 512 * j); }
    int ntile = 0;
    for (int tile = F.vcu; tile < T / 16 && ntile < MAXT; tile += F.G, ++ntile) {
        const int t0 = tile * 16;
        u32x4 ycur[2][2];
#pragma unroll
        for (int rr = 0; rr < 2; ++rr)
#pragma unroll
            for (int j = 0; j < 2; ++j) ycur[rr][j] = ypre[rr][j];
        if (tile + F.G < T / 16) {
#pragma unroll
            for (int rr = 0; rr < 2; ++rr)
#pragma unroll
                for (int j = 0; j < 2; ++j) ypre[rr][j] = *(const u32x4*)(Y + (size_t)((tile + F.G) * 16 + 2 * w + rr) * D + 8 * lane + 512 * j); }
#pragma unroll
        for (int rr = 0; rr < 2; ++rr) {
            const int lr = 2 * w + rr; const size_t row = (size_t)(t0 + lr);
            f32x4 v[4]; float s = 0.f;
#pragma unroll
            for (int j = 0; j < 2; ++j) unpack_bf16x8(ycur[rr][j], v[2 * j], v[2 * j + 1]);
#pragma unroll
            for (int j = 0; j < 4; ++j) s += (v[j][0] + v[j][1]) + (v[j][2] + v[j][3]);
            const float mean = wave_sum(s, lane) * (1.f / D); float s2 = 0.f;
#pragma unroll
            for (int j = 0; j < 4; ++j) { v[j] = v[j] - mean; s2 += (v[j][0] * v[j][0] + v[j][1] * v[j][1]) + (v[j][2] * v[j][2] + v[j][3] * v[j][3]); }
            const float rstd = 1.0f / sqrtf(wave_sum(s2, lane) * (1.f / D) + LN_EPS);
#pragma unroll
            for (int j = 0; j < 2; ++j) { const f32x4 g0 = *(const f32x4*)(lng + 8 * lane + 512 * j), g1 = *(const f32x4*)(lng + 8 * lane + 512 * j + 4), b0 = *(const f32x4*)(lnb + 8 * lane + 512 * j), b1 = *(const f32x4*)(lnb + 8 * lane + 512 * j + 4);
                const f32x4 o0 = v[2 * j] * rstd * g0 + b0, o1 = v[2 * j + 1] * rstd * g1 + b1;
                const u32x4 hi = pack_bf16x8(o0, o1);
                *(u32x4*)(XB + row * D + 8 * lane + 512 * j) = hi;
                { u32x2 q8; q8.x = pk4_fp8(o0[0], o0[1], o0[2], o0[3]); q8.y = pk4_fp8(o1[0], o1[1], o1[2], o1[3]); *(u32x2*)(XB8 + row * D + 8 * lane + 512 * j) = q8; }
                f32x4 h0, h1; unpack_bf16x8(hi, h0, h1); const u32x4 lo = pack_bf16x8(o0 - h0, o1 - h1);
                *(LAS u32x4*)(Xhi + lr * XLD + 8 * lane + 512 * j) = hi; *(LAS u32x4*)(Xlo + lr * XLD + 8 * lane + 512 * j) = lo; }
        }
        __syncthreads();
        { const int nt = w & 3, kh = w >> 2; f32x4 a0 = (f32x4){0.f, 0.f, 0.f, 0.f}, a1 = a0, a2 = a0, a3 = a0, a4 = a0, a5 = a0;
#pragma unroll
            for (int ks = 0; ks < 16; ks += 2) { const int k0 = 512 * kh + 32 * ks;
                const bf16x8 ahi = row_frag(Xhi, XLD, 0, k0, lane), alo = row_frag(Xlo, XLD, 0, k0, lane), bhi2 = row_frag(Xhi, XLD, 0, k0 + 32, lane), blo2 = row_frag(Xlo, XLD, 0, k0 + 32, lane);
                a0 = MFMA16(ahi, bhi[ks], a0); a1 = MFMA16(alo, bhi[ks], a1); a2 = MFMA16(ahi, blo[ks], a2);
                a3 = MFMA16(bhi2, bhi[ks + 1], a3); a4 = MFMA16(blo2, bhi[ks + 1], a4); a5 = MFMA16(bhi2, blo[ks + 1], a5); }
            const f32x4 acc = ((a0 + a3) + (a1 + a4)) + (a2 + a5);
#pragma unroll
            for (int i = 0; i < 4; ++i) part[(kh * 16 + 4 * g4 + i) * 64 + 16 * nt + l15] = acc[i];
        }
        __syncthreads();
#pragma unroll
        for (int rr = 0; rr < 2; ++rr) {
            const int lt = ntile * 16 + 2 * w + rr;
            const float lg = part[(2 * w + rr) * 64 + lane] + part[(16 + 2 * w + rr) * 64 + lane];
            float sc = 1.0f / (1.0f + expf(-lg)); sc = (sc == sc) ? sc : 0.5f;
            const float sel = sc + rbias[lane];
            const float m1 = max8(sel);
            const unsigned long long eq = __ballot(sel == m1);
            const unsigned gm = (unsigned)(eq >> (lane & 56)) & 0xffu;
            const int first = (lane & 56) + __builtin_ctz(gm | 0x100u);
            const float m2 = max8((lane == first) ? -INFINITY : sel);
            const float gs = m1 + m2; const int mygrp = lane >> 3; int grank = 0;
#pragma unroll
            for (int gg = 0; gg < 8; ++gg) { const float o = rdl(gs, 8 * gg); grank += (o > gs || (o == gs && gg < mygrp)) ? 1 : 0; }
            const float mv = (grank < 4) ? sel : -INFINITY;
            unsigned key = __builtin_bit_cast(unsigned, mv); key = (key >> 31) ? ~key : (key | 0x80000000u); key = (key & ~63u) | (unsigned)(63 - lane);
            int r0 = 0, r1 = 0, r2 = 0, r3 = 0;
#pragma unroll
            for (int e2 = 0; e2 < 64; e2 += 4) { r0 += ((unsigned)__builtin_amdgcn_readlane((int)key, e2) > key) ? 1 : 0; r1 += ((unsigned)__builtin_amdgcn_readlane((int)key, e2 + 1) > key) ? 1 : 0;
                r2 += ((unsigned)__builtin_amdgcn_readlane((int)key, e2 + 2) > key) ? 1 : 0; r3 += ((unsigned)__builtin_amdgcn_readlane((int)key, e2 + 3) > key) ? 1 : 0; }
            const int rank = (r0 + r1) + (r2 + r3);
            const bool chosen = rank < TOPK;
            const float wsum = wave_sum(chosen ? sc : 0.f, lane);
            if (chosen) { const int lpos = __hip_atomic_fetch_add(hist + lane, 1, __ATOMIC_RELAXED, __HIP_MEMORY_SCOPE_WORKGROUP);
                ent[(lt * 8 + rank) * 2] = (lane << 16) | lpos; ent[(lt * 8 + rank) * 2 + 1] = __builtin_bit_cast(int, sc / wsum * 2.5f); }
        }
    }
    __syncthreads();
    if (dry) return;
    if (F.tid < 64) { const int hcount = hist[F.tid]; base[F.tid] = hcount ? (int)atomicAdd(cnt + F.tid * 64, (unsigned)hcount) : 0; }
    __syncthreads();
    for (int idx = F.tid; idx < ntile * 16 * 8; idx += NTHREADS) {
        const int ev = ent[idx * 2], gb = ent[idx * 2 + 1]; const int e = ev >> 16, pos = base[e] + (ev & 0xffff);
        const int lt = idx >> 3, rank = idx & 7, tok = (F.vcu + (lt >> 4) * F.G) * 16 + (lt & 15);
        lists[(size_t)e * T + pos] = tok; tokmap[tok * 8 + rank] = (e << 16) | pos; tokgate[tok * 8 + rank] = __builtin_bit_cast(float, gb);
    }
}

__device__ __forceinline__ void phase_combine(const Frame& F, KP p, int layer, bool dry = false) {
    bf16* XB = (bf16*)(F.ws + WS_XB); const unsigned char* yexp = (const unsigned char*)(F.ws + WS_BIG);
    const int* tokmap = (const int*)(F.ws + WS_LIST + 4 * MiB); const float* tokgate = (const float*)(F.ws + WS_LIST + 5 * MiB);
    const volatile LAS int* tstart = (const volatile LAS int*)(F.MISC + 64);
    const float* lng = gin(p, 24) + (size_t)(layer * 2 + 1) * D; const float* lnb = gin(p, 25) + (size_t)(layer * 2 + 1) * D;
    float* outp = gout(p); bf16* xbo = XB; if (dry) { outp = (float*)(F.ws + WS_AUX); xbo = (bf16*)(F.ws + WS_H); }
    const int lane = F.lane, gw = F.vcu * NWAVES + F.wave, NGW = F.G * NWAVES;
    const bf16* ysh = (const bf16*)(F.ws + WS_Y);
    f32x4 gv[4], bv[4];
#pragma unroll
    for (int j = 0; j < 4; ++j) { gv[j] = *(const f32x4*)(lng + 16 * lane + 4 * j); bv[j] = *(const f32x4*)(lnb + 16 * lane + 4 * j); }
    for (int row = gw; row < T; row += NGW) {
        const int mk = tokmap[row * 8 + (lane & 7)]; const float gk = tokgate[row * 8 + (lane & 7)] * YEXP_INV;
        const int rk = (int)tstart[mk >> 16] * 256 + (mk & 0xffff);
        f32x4 v[4];
#pragma unroll
        for (int j = 0; j < 2; ++j) { const u32x4 xw = *(const u32x4*)(ysh + (size_t)row * D + 16 * lane + 8 * j); unpack_bf16x8(xw, v[2 * j], v[2 * j + 1]); }
#pragma unroll
        for (int k = 0; k < TOPK; ++k) { const int r = __builtin_amdgcn_readlane(rk, k); const float g = rdl(gk, k);
            const u32x4 s = *(const u32x4*)(yexp + (size_t)r * D + 16 * lane);
#pragma unroll
            for (int j = 0; j < 4; ++j) { const f32x2 lo = __builtin_amdgcn_cvt_pk_f32_fp8((int)s[j], false), hi = __builtin_amdgcn_cvt_pk_f32_fp8((int)s[j], true);
                v[j][0] += g * lo[0]; v[j][1] += g * lo[1]; v[j][2] += g * hi[0]; v[j][3] += g * hi[1]; } }
        float s = 0.f;
#pragma unroll
        for (int j = 0; j < 4; ++j) s += (v[j][0] + v[j][1]) + (v[j][2] + v[j][3]);
        const float mean = wave_sum(s, lane) * (1.f / D); float s2 = 0.f;
#pragma unroll
        for (int j = 0; j < 4; ++j) { v[j] = v[j] - mean; s2 += (v[j][0] * v[j][0] + v[j][1] * v[j][1]) + (v[j][2] * v[j][2] + v[j][3] * v[j][3]); }
        const float rstd = 1.0f / sqrtf(wave_sum(s2, lane) * (1.f / D) + LN_EPS);
        f32x4 o[4];
#pragma unroll
        for (int j = 0; j < 4; ++j) o[j] = v[j] * rstd * gv[j] + bv[j];
        if (layer == DEPTH - 1 || dry) {
#pragma unroll
            for (int j = 0; j < 4; ++j) *(f32x4*)(outp + (size_t)row * D + 16 * lane + 4 * j) = o[j]; }
        if (layer != DEPTH - 1) { *(u32x4*)(xbo + (size_t)row * D + 16 * lane) = pack_bf16x8(o[0], o[1]); *(u32x4*)(xbo + (size_t)row * D + 16 * lane + 8) = pack_bf16x8(o[2], o[3]);
            if (!dry) { u32x4 q8; q8.x = pk4_fp8(o[0][0], o[0][1], o[0][2], o[0][3]); q8.y = pk4_fp8(o[1][0], o[1][1], o[1][2], o[1][3]); q8.z = pk4_fp8(o[2][0], o[2][1], o[2][2], o[2][3]); q8.w = pk4_fp8(o[3][0], o[3][1], o[3][2], o[3][3]);
                *(u32x4*)((unsigned char*)(F.ws + WS_X) + (size_t)row * D + 16 * lane) = q8; } }
    }
}

constexpr size_t AUX_OB = 96 * MiB, AUX_LSE = 128 * MiB;
__device__ __forceinline__ void phase_attn(const Frame& F, int bx) {
    const bf16* qkv = (const bf16*)(F.ws + WS_BIG); bf16* og = (bf16*)(F.ws + WS_AUX); float* lse = (float*)(F.ws + WS_AUX + AUX_LSE);
    constexpr int KLD = 136;
    LAS bf16* Ks = (LAS bf16*)F.lds; LAS bf16* Vs = Ks + 256 * KLD;
    const int lane = F.lane, w = F.wave, g4 = lane >> 4, l15 = lane & 15, qq = l15 >> 2, pp = lane & 3;
    u32x4 kc[4], vc[4];
    constexpr int NRUN = 768;
#define ATT_LOADBLK(KR, VR, nblk) do { _Pragma("unroll") for (int it = 0; it < 4; ++it) { const int idx = F.tid + 512 * it, c = idx >> 4, ch = idx & 15; int pos = 128 * (nblk) + c; pos = pos < 0 ? 0 : pos; \
            const unsigned so = (rowbase + (unsigned)pos * (unsigned)d + (unsigned)r) * (unsigned)ATT_IN + (unsigned)(g * 3072 + 1024 + h * 128 + ch * 8); KR[it] = *(const u32x4*)(qkv + so); VR[it] = *(const u32x4*)(qkv + so + 1024u); } } while (0)
#define ATT_STOREBLK(KR, VR, slot) do { _Pragma("unroll") for (int it = 0; it < 4; ++it) { const int idx = F.tid + 512 * it, c = idx >> 4, ch = idx & 15; \
            *(LAS u32x4*)(Ks + (128 * (slot) + c) * KLD + ch * 8) = KR[it]; *(LAS u32x4*)(Vs + (128 * (slot) + c) * KLD + ch * 8) = VR[it]; } } while (0)
    for (int R = bx; R < NRUN; R += F.G) {
        const int h = R & 7, sbr = R >> 3, g = sbr >> 5, rem = sbr & 31, b = rem >> 4, rr_ = rem & 15;
        const int dsh = 2 * g, d = 1 << dsh, nrs = 4 - dsh, r = rr_ >> nrs, n0 = 4 * (rr_ & ((1 << nrs) - 1)); const unsigned rowbase = (unsigned)b * SEQ;
        ATT_LOADBLK(kc, vc, n0 - 1); ATT_STOREBLK(kc, vc, (n0 - 1) & 1); ATT_LOADBLK(kc, vc, n0);
#pragma unroll 1
        for (int j = 0; j < 4; ++j) {
            const int n = n0 + j, cs = n & 1, ps = cs ^ 1;
            ATT_STOREBLK(kc, vc, cs);
            const int qi = 16 * w + l15; const unsigned qrow = rowbase + (unsigned)(128 * n + qi) * (unsigned)d + (unsigned)r;
            bf16x8 qf[4];
#pragma unroll
            for (int s = 0; s < 4; ++s) qf[s] = *(const bf16x8*)(qkv + (qrow * (unsigned)ATT_IN + (unsigned)(g * 3072 + h * 128 + 32 * s + 8 * g4)));
            __syncthreads();
            if (j < 3) { ATT_LOADBLK(kc, vc, n + 1); }
            __builtin_amdgcn_sched_barrier(0);
            const int ws0 = (16 * w < 96) ? 16 * w : 96;
#define ATT_PROW(c0) (((c0) < 128) ? (128 * ps + (c0)) : (128 * cs + (c0) - 128))
            f32x4 sacc[10];
            {
                bf16x8 kfa[4], kfb[4];
#pragma unroll
                for (int s = 0; s < 4; ++s) kfa[s] = row_frag(Ks, KLD, ATT_PROW(ws0), 32 * s, lane);
#pragma unroll
                for (int t = 0; t < 10; t += 2) {
#pragma unroll
                    for (int s = 0; s < 4; ++s) kfb[s] = row_frag(Ks, KLD, ATT_PROW(ws0 + 16 * (t + 1)), 32 * s, lane);
                    __builtin_amdgcn_sched_barrier(0);
                    sacc[t] = (f32x4){0.f, 0.f, 0.f, 0.f};
#pragma unroll
                    for (int s = 0; s < 4; ++s) sacc[t] = MFMA16(kfa[s], qf[s], sacc[t]);
                    if (t + 2 < 10) {
#pragma unroll
                        for (int s = 0; s < 4; ++s) kfa[s] = row_frag(Ks, KLD, ATT_PROW(ws0 + 16 * (t + 2)), 32 * s, lane); }
                    __builtin_amdgcn_sched_barrier(0);
                    sacc[t + 1] = (f32x4){0.f, 0.f, 0.f, 0.f};
#pragma unroll
                    for (int s = 0; s < 4; ++s) sacc[t + 1] = MFMA16(kfb[s], qf[s], sacc[t + 1]);
                }
            }
            const float slope = exp2f(-(float)(h + 1)) * (float)d;
            float mx = -INFINITY;
#pragma unroll
            for (int t = 0; t < 10; ++t)
#pragma unroll
                for (int i = 0; i < 4; ++i) { const int c = ws0 + 16 * t + 4 * g4 + i, step = 128 + qi - c;
                    const bool valid = (step >= 0) && (step <= 128) && (n > 0 || c >= 128);
                    const float v = valid ? sacc[t][i] - slope * (float)step : -INFINITY; sacc[t][i] = v; mx = fmaxf(mx, v); }
            mx = fmaxf(mx, shx(mx, 16, lane)); mx = fmaxf(mx, shx(mx, 32, lane));
            float lsum = 0.f;
#pragma unroll
            for (int t = 0; t < 10; ++t)
#pragma unroll
                for (int i = 0; i < 4; ++i) { const float pv = __expf(sacc[t][i] - mx); sacc[t][i] = pv; lsum += pv; }
            lsum += shx(lsum, 16, lane); lsum += shx(lsum, 32, lane);
            bf16x8 pf[5];
#pragma unroll
            for (int kt = 0; kt < 5; ++kt) pf[kt] = pack8(sacc[2 * kt], sacc[2 * kt + 1]);
            f32x4 o[8];
            {
                const LAS bf16* vl = Vs + (4 * g4 + qq) * KLD + 32 * pp;
                bf16x4 va[10], vcc[10];
#pragma unroll
                for (int q = 0; q < 10; ++q) va[q] = tr4(vl + ATT_PROW(ws0 + 16 * q) * KLD);
#pragma unroll
                for (int et = 0; et < 8; et += 2) {
#pragma unroll
                    for (int q = 0; q < 10; ++q) vcc[q] = tr4(vl + ATT_PROW(ws0 + 16 * q) * KLD + 4 * (et + 1));
                    __builtin_amdgcn_sched_barrier(0);
                    o[et] = (f32x4){0.f, 0.f, 0.f, 0.f};
#pragma unroll
                    for (int kt = 0; kt < 5; ++kt) o[et] = MFMA16(cat8(va[2 * kt], va[2 * kt + 1]), pf[kt], o[et]);
                    if (et + 2 < 8) {
#pragma unroll
                        for (int q = 0; q < 10; ++q) va[q] = tr4(vl + ATT_PROW(ws0 + 16 * q) * KLD + 4 * (et + 2)); }
                    __builtin_amdgcn_sched_barrier(0);
                    o[et + 1] = (f32x4){0.f, 0.f, 0.f, 0.f};
#pragma unroll
                    for (int kt = 0; kt < 5; ++kt) o[et + 1] = MFMA16(cat8(vcc[2 * kt], vcc[2 * kt + 1]), pf[kt], o[et + 1]);
                }
            }
#undef ATT_PROW
            const float inv = 1.0f / lsum;
            bf16* orow = og + ((size_t)g * T + qrow) * D + h * 128 + 32 * g4;
#pragma unroll
            for (int e2 = 0; e2 < 4; ++e2) *(u32x4*)(orow + 8 * e2) = pack_bf16x8(o[2 * e2] * inv, o[2 * e2 + 1] * inv);
            if (g4 == 0) lse[((size_t)g * T + qrow) * AH + h] = mx + __logf(lsum);
            __syncthreads();
        }
    }
#undef ATT_LOADBLK
#undef ATT_STOREBLK
}
__device__ __forceinline__ void phase_attn_combine(const Frame& F) {
    const bf16* og = (const bf16*)(F.ws + WS_AUX); const float* lse = (const float*)(F.ws + WS_AUX + AUX_LSE); bf16* ob = (bf16*)(F.ws + WS_AUX + AUX_OB);
    const int lane = F.lane, gw = F.vcu * NWAVES + F.wave, NGW = F.G * NWAVES, h = lane >> 3;
    for (int row = gw; row < T; row += NGW) {
        const float l0 = lse[((size_t)0 * T + row) * AH + h], l1 = lse[((size_t)1 * T + row) * AH + h], l2 = lse[((size_t)2 * T + row) * AH + h];
        const float m = fmaxf(l0, fmaxf(l1, l2)); float w0 = __expf(l0 - m), w1 = __expf(l1 - m), w2 = __expf(l2 - m); const float inv = 1.0f / (w0 + w1 + w2); w0 *= inv; w1 *= inv; w2 *= inv;
        float a[16];
#pragma unroll
        for (int j = 0; j < 16; ++j) a[j] = 0.f;
#pragma unroll
        for (int g = 0; g < 3; ++g) { const float wg = (g == 0) ? w0 : (g == 1 ? w1 : w2);
#pragma unroll
            for (int q = 0; q < 2; ++q) { const u32x4 s = *(const u32x4*)(og + ((size_t)g * T + row) * D + 16 * lane + 8 * q);
                a[8 * q + 0] += wg * bflo(s.x); a[8 * q + 1] += wg * bfhi(s.x); a[8 * q + 2] += wg * bflo(s.y); a[8 * q + 3] += wg * bfhi(s.y);
                a[8 * q + 4] += wg * bflo(s.z); a[8 * q + 5] += wg * bfhi(s.z); a[8 * q + 6] += wg * bflo(s.w); a[8 * q + 7] += wg * bfhi(s.w); } }
#pragma unroll
        for (int q = 0; q < 2; ++q) { u32x4 o; o.x = pk2(a[8 * q], a[8 * q + 1]); o.y = pk2(a[8 * q + 2], a[8 * q + 3]); o.z = pk2(a[8 * q + 4], a[8 * q + 5]); o.w = pk2(a[8 * q + 6], a[8 * q + 7]);
            *(u32x4*)(ob + (size_t)row * D + 16 * lane + 8 * q) = o; }
    }
}

constexpr size_t BIG_YRET = 192 * MiB;
__device__ __forceinline__ void phase_ret_u(const Frame& F) {
    const bf16* proj = (const bf16*)(F.ws + WS_BIG); bf16* St = (bf16*)(F.ws + WS_AUX);
    constexpr int LD = 264;
    LAS bf16* Kt = (LAS bf16*)F.lds; LAS bf16* Vt = Kt + 128 * LD;
    const int lane = F.lane, w = F.wave, g4 = lane >> 4, l15 = lane & 15, qq = l15 >> 2, pp = lane & 3;
    for (int u = F.vcu; u < 1024; u += F.G) {
        const int eh = u & 1, h = (u >> 1) & 3, n = (u >> 3) & 63, b = u >> 9;
        const size_t row0 = (size_t)b * SEQ + (size_t)n * RC;
#pragma unroll 4
        for (int it = 0; it < 8; ++it) { const int idx = F.tid + 512 * it, j = idx >> 5, ch = idx & 31;
            const bf16* src = proj + (row0 + j) * RET_IN;
            const u32x4 kv = *(const u32x4*)(src + 1024 + h * 256 + ch * 8), vv = *(const u32x4*)(src + 2048 + h * 512 + eh * 256 + ch * 8);
            *(LAS u32x4*)(Kt + j * LD + ch * 8) = kv; *(LAS u32x4*)(Vt + j * LD + ch * 8) = vv; }
        __syncthreads();
        f32x4 acc[16][2];
#pragma unroll
        for (int mt = 0; mt < 16; ++mt) { acc[mt][0] = (f32x4){0.f, 0.f, 0.f, 0.f}; acc[mt][1] = (f32x4){0.f, 0.f, 0.f, 0.f}; }
#pragma unroll
        for (int ks = 0; ks < 4; ++ks) {
            bf16x8 bfr[2];
#pragma unroll
            for (int nt = 0; nt < 2; ++nt) { const LAS bf16* a0 = Vt + (32 * ks + 8 * g4 + qq) * LD + 32 * w + 16 * nt + 4 * pp; bfr[nt] = cat8(tr4(a0), tr4(a0 + 4 * LD)); }
#pragma unroll
            for (int mt = 0; mt < 16; ++mt) { const LAS bf16* a0 = Kt + (32 * ks + 8 * g4 + qq) * LD + 128 * (mt >> 3) + 32 * pp + 4 * (mt & 7);
                const bf16x8 afr = cat8(tr4(a0), tr4(a0 + 4 * LD));
                acc[mt][0] = MFMA16(afr, bfr[0], acc[mt][0]); acc[mt][1] = MFMA16(afr, bfr[1], acc[mt][1]); }
        }
        bf16* outb = St + ((size_t)((b * RH + h) * RNC + n)) * (RDV * RDK);
#pragma unroll
        for (int nt = 0; nt < 2; ++nt) { bf16* orow = outb + (size_t)(eh * 256 + 32 * w + 16 * nt + l15) * RDK + 32 * g4;
#pragma unroll
            for (int mh = 0; mh < 2; ++mh)
#pragma unroll
                for (int q = 0; q < 4; ++q) *(u32x4*)(orow + 128 * mh + 8 * q) = pack_bf16x8(acc[mh * 8 + 2 * q][nt], acc[mh * 8 + 2 * q + 1][nt]); }
        __syncthreads();
    }
}
__device__ __forceinline__ void phase_ret_scan(const Frame& F) {
    bf16* St = (bf16*)(F.ws + WS_AUX);
    for (int gt = F.vcu * NTHREADS + F.tid; gt < 8 * 16384; gt += F.G * NTHREADS) {
        const int bh = gt >> 14, chunk = gt & 16383, h = bh & 3;
        const float g128 = exp2f(128.0f * log2f(1.0f - exp2f(-5.0f - (float)h)));
        bf16* base = St + (size_t)bh * RNC * (RDV * RDK) + (size_t)chunk * 8;
        float c[8];
#pragma unroll
        for (int j = 0; j < 8; ++j) c[j] = 0.f;
#pragma unroll 8
        for (int n = 0; n < RNC; ++n) { bf16* pn = base + (size_t)n * (RDV * RDK); const u32x4 uv = *(const u32x4*)pn;
            u32x4 o; o.x = pk2(c[0], c[1]); o.y = pk2(c[2], c[3]); o.z = pk2(c[4], c[5]); o.w = pk2(c[6], c[7]); *(u32x4*)pn = o;
            c[0] = g128 * (c[0] + bflo(uv.x)); c[1] = g128 * (c[1] + bfhi(uv.x)); c[2] = g128 * (c[2] + bflo(uv.y)); c[3] = g128 * (c[3] + bfhi(uv.y));
            c[4] = g128 * (c[4] + bflo(uv.z)); c[5] = g128 * (c[5] + bfhi(uv.z)); c[6] = g128 * (c[6] + bflo(uv.w)); c[7] = g128 * (c[7] + bfhi(uv.w)); }
    }
}
__device__ __forceinline__ void phase_ret_out(const Frame& F, KP p) {
    const bf16* proj = (const bf16*)(F.ws + WS_BIG); const bf16* St = (const bf16*)(F.ws + WS_AUX); bf16* yret = (bf16*)(F.ws + WS_BIG + BIG_YRET);
    const float* gng = gin(p, 4); const float* gnb = gin(p, 5);
    constexpr int LD = 264, VLD = 136;
    LAS bf16* Rs = (LAS bf16*)F.lds; LAS bf16* Vs = Rs + 128 * LD;
    const int lane = F.lane, w = F.wave, g4 = lane >> 4, l15 = lane & 15, qq = l15 >> 2, pp = lane & 3;
    for (int u = F.vcu; u < 512; u += F.G) {
        const int h = u & 3, n = (u >> 2) & 63, b = u >> 8;
        const size_t row0 = (size_t)b * SEQ + (size_t)n * RC;
#pragma unroll 4
        for (int it = 0; it < 8; ++it) { const int idx = F.tid + 512 * it, j = idx >> 5, ch = idx & 31;
            *(LAS u32x4*)(Rs + j * LD + ch * 8) = *(const u32x4*)(proj + (row0 + j) * RET_IN + 1024 + h * 256 + ch * 8); }
        const int irow = 16 * w + l15; const size_t qrow = row0 + irow;
        bf16x8 qf[8];
#pragma unroll
        for (int s = 0; s < 8; ++s) qf[s] = *(const bf16x8*)(proj + qrow * RET_IN + h * 256 + 32 * s + 8 * g4);
        __syncthreads();
        bf16x8 pf[4];
        { f32x4 sacc[8];
#pragma unroll
            for (int jt = 0; jt < 8; ++jt) { sacc[jt] = (f32x4){0.f, 0.f, 0.f, 0.f};
                if (jt <= w) {
#pragma unroll
                    for (int s = 0; s < 8; ++s) sacc[jt] = MFMA16(row_frag(Rs, LD, 16 * jt, 32 * s, lane), qf[s], sacc[jt]);
#pragma unroll
                    for (int i = 0; i < 4; ++i) if (16 * jt + 4 * g4 + i > irow) sacc[jt][i] = 0.f; } }
#pragma unroll
            for (int kt = 0; kt < 4; ++kt) pf[kt] = pack8(sacc[2 * kt], sacc[2 * kt + 1]); }
        __syncthreads();
        f32x4 acc[4][8];
        const bf16* Sn = St + ((size_t)((b * RH + h) * RNC + n)) * (RDV * RDK);
#pragma unroll
        for (int sl = 0; sl < 4; ++sl) {
#pragma unroll 4
            for (int it = 0; it < 4; ++it) { const int idx = F.tid + 512 * it, j = idx >> 4, ch = idx & 15;
                *(LAS u32x4*)(Vs + j * VLD + ch * 8) = *(const u32x4*)(proj + (row0 + j) * RET_IN + 2048 + h * 512 + sl * 128 + ch * 8); }
#pragma unroll 4
            for (int it = 0; it < 8; ++it) { const int idx = F.tid + 512 * it, e = idx >> 5, ch = idx & 31;
                *(LAS u32x4*)(Rs + e * LD + ch * 8) = *(const u32x4*)(Sn + (size_t)(sl * 128 + e) * RDK + ch * 8); }
            __syncthreads();
#pragma unroll
            for (int et = 0; et < 8; ++et) { f32x4 a = (f32x4){0.f, 0.f, 0.f, 0.f};
#pragma unroll
                for (int kt = 0; kt < 4; ++kt) if (2 * kt <= w) { const LAS bf16* a0 = Vs + (32 * kt + 4 * g4 + qq) * VLD + 32 * pp + 4 * et;
                    a = MFMA16(cat8(tr4(a0), tr4(a0 + 16 * VLD)), pf[kt], a); }
                const LAS bf16* srow = Rs + (32 * qq + 4 * et + pp) * LD + 8 * g4;
#pragma unroll
                for (int s = 0; s < 8; ++s) a = MFMA16(*(const LAS bf16x8*)(srow + 32 * s), qf[s], a);
                acc[sl][et] = a; }
            __syncthreads();
        }
        float s = 0.f;
#pragma unroll
        for (int sl = 0; sl < 4; ++sl)
#pragma unroll
            for (int et = 0; et < 8; ++et) s += (acc[sl][et][0] + acc[sl][et][1]) + (acc[sl][et][2] + acc[sl][et][3]);
        s += shx(s, 16, lane); s += shx(s, 32, lane);
        const float mean = s * (1.0f / RDV); float s2 = 0.f;
#pragma unroll
        for (int sl = 0; sl < 4; ++sl)
#pragma unroll
            for (int et = 0; et < 8; ++et) { acc[sl][et] = acc[sl][et] - mean; s2 += (acc[sl][et][0] * acc[sl][et][0] + acc[sl][et][1] * acc[sl][et][1]) + (acc[sl][et][2] * acc[sl][et][2] + acc[sl][et][3] * acc[sl][et][3]); }
        s2 += shx(s2, 16, lane); s2 += shx(s2, 32, lane);
        const float rstd = 1.0f / sqrtf(s2 * (1.0f / RDV) + LN_EPS);
#pragma unroll
        for (int sl = 0; sl < 4; ++sl) { const int c0 = h * RDV + sl * 128 + 32 * g4;
#pragma unroll
            for (int q = 0; q < 4; ++q) { const u32x4 gw = *(const u32x4*)(proj + qrow * RET_IN + 4096 + c0 + 8 * q);
                const f32x4 gg0 = *(const f32x4*)(gng + c0 + 8 * q), gg1 = *(const f32x4*)(gng + c0 + 8 * q + 4), gb0 = *(const f32x4*)(gnb + c0 + 8 * q), gb1 = *(const f32x4*)(gnb + c0 + 8 * q + 4);
                f32x4 y0 = acc[sl][2 * q] * rstd * gg0 + gb0, y1 = acc[sl][2 * q + 1] * rstd * gg1 + gb1;
                const float gv[8] = {bflo(gw.x), bfhi(gw.x), bflo(gw.y), bfhi(gw.y), bflo(gw.z), bfhi(gw.z), bflo(gw.w), bfhi(gw.w)};
#pragma unroll
                for (int j = 0; j < 4; ++j) { y0[j] *= gv[j] * fsig(gv[j]); y1[j] *= gv[4 + j] * fsig(gv[4 + j]); }
                *(u32x4*)(yret + qrow * RET_V + c0 + 8 * q) = pack_bf16x8(y0, y1); } }
    }
}

constexpr size_t AUX_S5E = 64 * MiB;
constexpr int S5L = 256, S5NC = SEQ / S5L;
__device__ __forceinline__ void cmul_add(float& rr, float& ri, float ar, float ai, float xr, float xi, float cr, float ci) { rr = ar * xr - ai * xi + cr; ri = ar * xi + ai * xr + ci; }
template <bool OUT>
__device__ __forceinline__ void phase_s5_scan(const Frame& F, KP p) {
    const bf16* X = (const bf16*)(F.ws + WS_XB); float* E = (float*)(F.ws + WS_AUX + AUX_S5E); bf16* ybuf = (bf16*)(F.ws + WS_AUX);
    const int lane = F.lane, w = F.wave, g4 = lane >> 4, l15 = lane & 15;
    LAS bf16* ut = (LAS bf16*)(F.lds + w * 12288);
    LAS bf16* Hb = (LAS bf16*)(F.lds + w * 12288 + 4096);
    constexpr int HLD = 136;
    const int gw = F.vcu * NWAVES + w, NGW = F.G * NWAVES;
    const int up16 = (lane - 16) << 2, up32 = (lane - 32) << 2, last16 = (48 + l15) << 2;
    for (int unit = gw; unit < BATCH * SG * S5NC; unit += NGW) {
        const int n = unit & (S5NC - 1), g = (unit >> 5) & 63, b = unit >> 11;
        float a1r[4], a1i[4], a4r[4], a4i[4], a8r[4], a8i[4], pwr[4], pwi[4];
        bf16x8 bfrag[8];
        const float dt = expf(gin(p, 14)[g]);
#pragma unroll
        for (int st = 0; st < 4; ++st) { const int ps = 16 * st + l15;
            const float are = gin(p, 7)[g * SP + ps], aim = gin(p, 8)[g * SP + ps];
            const float mag = expf(dt * are); const float abr = mag * cosf(dt * aim), abi = mag * sinf(dt * aim);
            const float den = are * are + aim * aim;
            const float fre = ((abr - 1.0f) * are + abi * aim) / den, fim = (abi * are - (abr - 1.0f) * aim) / den;
            a1r[st] = abr; a1i[st] = abi; { float t2r, t2i; cmul_add(t2r, t2i, abr, abi, abr, abi, 0.f, 0.f); cmul_add(a4r[st], a4i[st], t2r, t2i, t2r, t2i, 0.f, 0.f); }
            cmul_add(a8r[st], a8i[st], a4r[st], a4i[st], a4r[st], a4i[st], 0.f, 0.f);
            float qr = 1.f, qi = 0.f;
            if (g4 & 1) { qr = a4r[st]; qi = a4i[st]; }
            if (g4 & 2) { float tr, ti; cmul_add(tr, ti, qr, qi, a8r[st], a8i[st], 0.f, 0.f); qr = tr; qi = ti; }
            pwr[st] = qr; pwi[st] = qi;
            const float* br = gin(p, 9) + ((size_t)g * SP + ps) * SGC + 8 * (g4 & 1); const float* bi = gin(p, 10) + ((size_t)g * SP + ps) * SGC + 8 * (g4 & 1);
            const f32x4 r0 = *(const f32x4*)br, r1 = *(const f32x4*)(br + 4), i0 = *(const f32x4*)bi, i1 = *(const f32x4*)(bi + 4);
            const float z = (g4 < 2) ? 1.0f : 0.0f; const float fr2 = fre * z, fi2 = fim * z;
            bfrag[st] = pack8(r0 * fr2 - i0 * fi2, r1 * fr2 - i1 * fi2); bfrag[st + 4] = pack8(i0 * fr2 + r0 * fi2, i1 * fr2 + r1 * fi2);
        }
        float sr[4], si[4];
        float* Eu = E + ((size_t)(b * SG + g) * S5NC + n) * 128;
        bf16x8 cf[4]; f32x4 dsk = (f32x4){0.f, 0.f, 0.f, 0.f};
#pragma unroll
        for (int st = 0; st < 4; ++st) { sr[st] = 0.f; si[st] = 0.f; }
        if (OUT) {
#pragma unroll
            for (int st = 0; st < 4; ++st) { sr[st] = Eu[16 * st + l15]; si[st] = Eu[64 + 16 * st + l15]; }
#pragma unroll
            for (int s = 0; s < 4; ++s) { const float* cp = (s < 2 ? gin(p, 11) : gin(p, 12)) + ((size_t)g * SGC + l15) * SP + 32 * (s & 1) + 8 * g4; const float sg = s < 2 ? 1.0f : -1.0f;
                const f32x4 c0 = *(const f32x4*)cp * sg, c1 = *(const f32x4*)(cp + 4) * sg; cf[s] = pack8(c0, c1); }
            dsk = *(const f32x4*)(gin(p, 13) + g * SGC + 4 * g4); }
        const size_t tok0 = (size_t)b * SEQ + (size_t)n * S5L;
        u32x4 pre[2];
        { const bf16* src = X + (tok0 + lane) * D + g * SGC; pre[0] = *(const u32x4*)src; pre[1] = *(const u32x4*)(src + 8); }
        for (int sub = 0; sub < S5L / 64; ++sub) {
            *(LAS u32x4*)(ut + lane * 16) = pre[0]; *(LAS u32x4*)(ut + lane * 16 + 8) = pre[1];
            if (sub + 1 < S5L / 64) { const bf16* src = X + (tok0 + (sub + 1) * 64 + lane) * D + g * SGC; pre[0] = *(const u32x4*)src; pre[1] = *(const u32x4*)(src + 8); }
            LDS_WAIT(); asm volatile("" ::: "memory");
#pragma unroll (OUT ? 1 : 4)
            for (int blk = 0; blk < 4; ++blk) {
                u32x4 uw = *(const LAS u32x4*)(ut + (blk * 16 + l15) * 16 + 8 * (g4 & 1));
                if (g4 >= 2) uw = (u32x4){0u, 0u, 0u, 0u};
                const bf16x8 ufr = __builtin_bit_cast(bf16x8, uw);
                f32x4 dr[4], di[4];
#pragma unroll
                for (int st = 0; st < 4; ++st) { dr[st] = MFMA16(ufr, bfrag[st], ((f32x4){0.f, 0.f, 0.f, 0.f})); di[st] = MFMA16(ufr, bfrag[st + 4], ((f32x4){0.f, 0.f, 0.f, 0.f})); }
                float vr[4], vi[4];
#pragma unroll
                for (int st = 0; st < 4; ++st) {
                    float hr = 0.f, hi = 0.f;
#pragma unroll
                    for (int i = 0; i < 4; ++i) { float nr, ni; cmul_add(nr, ni, a1r[st], a1i[st], hr, hi, dr[st][i], di[st][i]); hr = nr; hi = ni; dr[st][i] = hr; di[st][i] = hi; }
                    vr[st] = hr; vi[st] = hi; }
#define BPF(idx, v) __builtin_bit_cast(float, __builtin_amdgcn_ds_bpermute((idx), __builtin_bit_cast(int, (v))))
                { float xr[4], xi[4];
#pragma unroll
                  for (int st = 0; st < 4; ++st) { xr[st] = BPF(up16, vr[st]); xi[st] = BPF(up16, vi[st]); }
#pragma unroll
                  for (int st = 0; st < 4; ++st) { float tr, ti; cmul_add(tr, ti, a4r[st], a4i[st], xr[st], xi[st], vr[st], vi[st]); if (g4 >= 1) { vr[st] = tr; vi[st] = ti; } }
#pragma unroll
                  for (int st = 0; st < 4; ++st) { xr[st] = BPF(up32, vr[st]); xi[st] = BPF(up32, vi[st]); }
#pragma unroll
                  for (int st = 0; st < 4; ++st) { float tr, ti; cmul_add(tr, ti, a8r[st], a8i[st], xr[st], xi[st], vr[st], vi[st]); if (g4 >= 2) { vr[st] = tr; vi[st] = ti; } } }
                float er[4], ei[4], lr[4], li[4];
#pragma unroll
                for (int st = 0; st < 4; ++st) { if (OUT) { er[st] = BPF(up16, vr[st]); ei[st] = BPF(up16, vi[st]); } else { er[st] = 0.f; ei[st] = 0.f; } lr[st] = BPF(last16, vr[st]); li[st] = BPF(last16, vi[st]); }
#undef BPF
#pragma unroll
                for (int st = 0; st < 4; ++st) {
                    if (g4 == 0) { er[st] = 0.f; ei[st] = 0.f; }
                    if (OUT) { float s0r, s0i; cmul_add(s0r, s0i, pwr[st], pwi[st], sr[st], si[st], er[st], ei[st]);
#pragma unroll
                        for (int i = 0; i < 4; ++i) { float tr, ti; cmul_add(tr, ti, a1r[st], a1i[st], s0r, s0i, 0.f, 0.f); s0r = tr; s0i = ti; dr[st][i] += s0r; di[st][i] += s0i; } }
                    { float a16r, a16i; cmul_add(a16r, a16i, a8r[st], a8i[st], a8r[st], a8i[st], 0.f, 0.f); float tr, ti; cmul_add(tr, ti, a16r, a16i, sr[st], si[st], lr[st], li[st]); sr[st] = tr; si[st] = ti; }
                    if (OUT) {
#pragma unroll
                        for (int i = 0; i < 4; ++i) { const unsigned hw = pk2(dr[st][i], di[st][i]); Hb[(4 * g4 + i) * HLD + 16 * st + l15] = (bf16)hw; Hb[(4 * g4 + i) * HLD + 64 + 16 * st + l15] = (bf16)(hw >> 16); } }
                }
                if (OUT) {
                    LDS_WAIT(); asm volatile("" ::: "memory");
                    f32x4 ya = (f32x4){0.f, 0.f, 0.f, 0.f};
#pragma unroll
                    for (int s = 0; s < 4; ++s) ya = MFMA16(cf[s], row_frag(Hb, HLD, 0, 32 * s, lane), ya);
                    const u32x2 u2 = *(const LAS u32x2*)(ut + (blk * 16 + l15) * 16 + 4 * g4);
                    const f32x4 u4 = (f32x4){bflo(u2.x), bfhi(u2.x), bflo(u2.y), bfhi(u2.y)};
                    f32x4 y = ya + dsk * u4;
#pragma unroll
                    for (int j = 0; j < 4; ++j) { const float v = y[j]; y[j] = v * fsig(1.5957691216057308f * (v + 0.044715f * v * v * v)); }
                    u32x2 o; o.x = pk2(y[0], y[1]); o.y = pk2(y[2], y[3]);
                    *(u32x2*)(ybuf + (tok0 + sub * 64 + blk * 16 + l15) * D + g * SGC + 4 * g4) = o;
                    asm volatile("" ::: "memory"); }
            }
            LDS_WAIT(); asm volatile("" ::: "memory");
        }
        if (!OUT && g4 == 0) {
#pragma unroll
            for (int st = 0; st < 4; ++st) { Eu[16 * st + l15] = sr[st]; Eu[64 + 16 * st + l15] = si[st]; } }
    }
}
__device__ __forceinline__ void phase_s5_carry(const Frame& F, KP p) {
    float* E = (float*)(F.ws + WS_AUX + AUX_S5E);
    for (int gt = F.vcu * NTHREADS + F.tid; gt < BATCH * SG * SP; gt += F.G * NTHREADS) {
        const int pl = gt & 63, bg = gt >> 6, g = bg & 63;
        const float dt = expf(gin(p, 14)[g]); const float are = gin(p, 7)[g * SP + pl], aim = gin(p, 8)[g * SP + pl];
        const float mag = expf(dt * are); float ar = mag * cosf(dt * aim), ai = mag * sinf(dt * aim);
#pragma unroll
        for (int q = 0; q < 8; ++q) { const float nr = ar * ar - ai * ai, ni = 2.0f * ar * ai; ar = nr; ai = ni; }
        float cr = 0.f, ci = 0.f;
        for (int n = 0; n < S5NC; ++n) { float* Eu = E + ((size_t)bg * S5NC + n) * 128; const float er = Eu[pl], ei = Eu[64 + pl];
            Eu[pl] = cr; Eu[64 + pl] = ci;
            const float nr = ar * cr - ai * ci + er, ni = ar * ci + ai * cr + ei; cr = nr; ci = ni; }
    }
}

constexpr int NPHASES = 34;
#ifndef PROBE_DRY14
#define PROBE_DRY14 0
#endif
#ifndef PROBE_DRY17
#define PROBE_DRY17 0
#endif
#ifndef PH_MASK
#define PH_MASK 0xFFFFFFFFu
#endif
#define PHT(t) ((PH_MASK >> (t)) & 1u)
constexpr int PLAN_OFF = 64;
__device__ __forceinline__ void moe_plan(const Frame& F, int layer) {
    volatile LAS int* tstart = (volatile LAS int*)(F.MISC + PLAN_OFF); volatile LAS int* cnts = tstart + 72;
    __syncthreads();
    if (F.wave == 0) {
        const unsigned* cnt = (const unsigned*)(F.ws + WS_CTL) + CW_CNT + layer * NE * 64;
        const int c = (int)__hip_atomic_load(cnt + F.lane * 64, __ATOMIC_RELAXED, __HIP_MEMORY_SCOPE_AGENT);
        int v = (c + 255) >> 8;
#pragma unroll
        for (int o = 1; o < 64; o <<= 1) { const int nb = __builtin_amdgcn_ds_bpermute((F.lane - o) << 2, v); if (F.lane >= o) v += nb; }
        tstart[F.lane + 1] = v; cnts[F.lane] = c;
        if (F.lane == 0) tstart[0] = 0;
        if (F.lane == 63) { tstart[65] = v + T / 256; cnts[64] = T; }
    }
    __syncthreads();
}
template <bool GATH> struct MoeSched2 {
    static constexpr bool GATHER = GATH, UNIFORMIZE = true, FP8 = GATH;
    static constexpr int ncol = GATH ? 2 : 4, K = GATH ? D / 2 : ED;
    const volatile LAS int* tstart; const volatile LAS int* cnts; int ntiles, G, c, lane;
    const char* Abase; const char* Wbase; const int* lists;
    __device__ __forceinline__ bool next(int i, pg8::UnitG& u) const {
        const int nwg = ntiles * ncol; const long L = (long)i * G + c; if (L >= nwg) return false;
        int wgid = (int)L; { const int q = nwg / 8, r = nwg % 8, xcd = wgid % 8, off = wgid / 8; wgid = (xcd < r ? xcd * (q + 1) : r * (q + 1) + (xcd - r) * q) + off; }
        const int tile = wgid / ncol, pn = wgid % ncol;
        const int ta = tstart[lane], tb = tstart[lane + 1];
        const unsigned long long mm = __ballot(ta <= tile && tile < tb);
        const int e = mm ? (int)__builtin_ctzll(mm) : 64;
        const int ts = __builtin_amdgcn_readfirstlane((int)tstart[e]), ce = __builtin_amdgcn_readfirstlane((int)cnts[e]);
        const int lt = tile - ts; int valid = ce - lt * 256; valid = valid > 256 ? 256 : valid;
        u.gshift = 0; u.aux = e;
        if (GATH) {
            u.B = Wbase + (size_t)e * WMOE_E_BYTES + (size_t)pn * 256 * K * 2;
            if (e < 64) { u.A = Abase; u.gidx = lists + (size_t)e * T + lt * 256; u.gcnt = valid; }
            else { u.A = Abase + (size_t)lt * 256 * K * 2; u.gidx = nullptr; u.gcnt = 0; }
            u.row0 = tile * 256; u.col0 = pn * 128;
        } else {
            u.B = Wbase + (size_t)e * WMOE_E_BYTES + (size_t)512 * 1024 * 2 + (size_t)pn * 256 * K * 2;
            u.A = Abase + (size_t)tile * 256 * K * 2; u.gidx = nullptr; u.gcnt = valid;
            u.row0 = tile * 256; u.col0 = pn * 256;
        }
        return true;
    }
};
__device__ __forceinline__ void phase_load_x(const Frame& F, KP p) {
    const float* xin = gin(p, 0); bf16* XB = (bf16*)(F.ws + WS_XB);
    for (size_t i = (size_t)F.vcu * NTHREADS + F.tid; i < (size_t)T * D / 8; i += (size_t)F.G * NTHREADS) {
        const f32x4 a = *(const f32x4*)(xin + i * 8), b = *(const f32x4*)(xin + i * 8 + 4);
        *(u32x4*)(XB + i * 8) = pack_bf16x8(a, b);
        u32x2 q8; q8.x = pk4_fp8(a[0], a[1], a[2], a[3]); q8.y = pk4_fp8(b[0], b[1], b[2], b[3]); *(u32x2*)((unsigned char*)(F.ws + WS_X) + i * 8) = q8; }
}

__global__ void __launch_bounds__(NTHREADS, 2) fwd_kernel(Params p_unused) {
    KP p0 = (KP)__builtin_amdgcn_kernarg_segment_ptr();
    extern __shared__ __attribute__((aligned(16))) unsigned char lds_raw[];
    Frame F0;
    F0.lds = (LAS unsigned char*)lds_raw; F0.MISC = (volatile LAS unsigned*)(F0.lds + MISC_OFF);
    F0.tid = threadIdx.x; F0.lane = F0.tid & 63; F0.wave = __builtin_amdgcn_readfirstlane(F0.tid >> 6);
    F0.G = gridDim.x; { const int bq = blockIdx.x; F0.vcu = (F0.G % 8 == 0) ? (bq % 8) * (F0.G / 8) + bq / 8 : bq; }
    F0.ws = p0->ws;
    const int bx0 = blockIdx.x;
    for (int u = F0.tid; u < (LDS_BYTES - MISC_OFF) / 4; u += NTHREADS) ((LAS unsigned*)(F0.lds + MISC_OFF))[u] = 0u;
    __syncthreads();
    XcdBarrier bar; bar.bar = (unsigned*)(p0->ws + WS_CTL) + CW_BAR; bar.x = 0; bar.st = nullptr;
    const int use_bar = p0->use_bar;
    if (use_bar) bar = xcd_barrier_post((unsigned*)(p0->ws + WS_CTL) + CW_BAR, F0.MISC + 8);
    const int lo = p0->ph_lo, hi = p0->ph_hi;
#define PHASE_BEGIN Frame F = F0; KP p = p0; { unsigned ones_ = ~0u; asm volatile("" : "+s"(ones_)); F.lane = (int)__builtin_amdgcn_mbcnt_hi(ones_, __builtin_amdgcn_mbcnt_lo(ones_, 0u)); } asm volatile("" : "+v"(F.lane)); F.tid = F.wave * 64 + F.lane; asm volatile("" : "+v"(F.tid));   GAS unsigned char* wsg_ = (GAS unsigned char*)F0.ws; asm volatile("" : "+s"(F.wave), "+s"(F.vcu), "+s"(F.G), "+s"(wsg_), "+s"(p)); \
    F.ws = (unsigned char*)wsg_; int bx = bx0; asm volatile("" : "+s"(bx)); unsigned char* ws = F.ws; (void)ws; (void)bx;
#pragma unroll 1
    for (int ph = lo; ph < hi; ++ph) {
        int layer = 0, type = 0;
        if (ph > 0) { layer = ph >= 26 ? 3 : (ph >= 18 ? 2 : (ph >= 9 ? 1 : 0)); const int q = ph - (layer == 3 ? 26 : (layer == 2 ? 18 : (layer == 1 ? 9 : 1))); const int kind = layer % 3;
            if (kind == 0) type = q < 4 ? 1 + q : 14 + (q - 4); else if (kind == 1) type = q < 5 ? 5 + q : 14 + (q - 5); else type = q < 4 ? 10 + q : 14 + (q - 4); }
        const int j = layer / 3;
#ifdef REPEAT_MASK
        const int nrep = ((REPEAT_MASK >> type) & 1u) ? 2 : 1;
#else
        const int nrep = 1;
#endif
#pragma unroll 1
        for (int rep = 0; rep < nrep; ++rep) {
        if (rep > 0 && use_bar) xcd_barrier(bar);
        if (PHT(0) && type == 0) { PHASE_BEGIN; phase_conv_mixers(F, p); phase_conv_moe(F, p, 0); phase_load_x(F, p); }
        else if (PHT(1) && type == 1) { PHASE_BEGIN; DenseSched8 S; S.init(ws + WS_X, ws + WS_ATT_IN_T + (size_t)j * ATT_IN * D, T, ATT_IN, D / 2, F.G, bx); EpiStoreBf16 E{(bf16*)(ws + WS_BIG), ATT_IN, WUP_INV, 0.08838834764831845f};
            pg8::gemm_phase(F.lds, F.tid, D / 2, S, E); }
        else if (PHT(2) && type == 2) { PHASE_BEGIN; phase_attn(F, bx); }
        else if (PHT(3) && type == 3) { PHASE_BEGIN; phase_attn_combine(F); }
        else if (PHT(4) && type == 4) { PHASE_BEGIN; DenseSched S; S.init(ws + WS_AUX + AUX_OB, ws + WS_ATT_OUT_T + (size_t)j * D * D * 2, T, D, D, F.G, bx); EpiResid E{(const bf16*)(ws + WS_XB), (bf16*)(ws + WS_Y)};
            pg8::gemm_phase(F.lds, F.tid, D, S, E); }
        else if (PHT(5) && type == 5) { PHASE_BEGIN; DenseSched8 S; S.init(ws + WS_X, ws + WS_RET_IN_T, T, RET_IN, D / 2, F.G, bx); EpiRetIn E{(bf16*)(ws + WS_BIG), RET_IN};
            pg8::gemm_phase(F.lds, F.tid, D / 2, S, E); }
        else if (PHT(6) && type == 6) { PHASE_BEGIN; phase_ret_u(F); }
        else if (PHT(7) && type == 7) { PHASE_BEGIN; phase_ret_scan(F); }
        else if (PHT(8) && type == 8) { PHASE_BEGIN; phase_ret_out(F, p); }
        else if (PHT(9) && type == 9) { PHASE_BEGIN; DenseSched S; S.init(ws + WS_BIG + BIG_YRET, ws + WS_RET_OUT_T, T, D, RET_V, F.G, bx); EpiResid E{(const bf16*)(ws + WS_XB), (bf16*)(ws + WS_Y)};
            pg8::gemm_phase(F.lds, F.tid, RET_V, S, E); }
        else if (PHT(10) && type == 10) { PHASE_BEGIN; phase_s5_scan<false>(F, p); }
        else if (PHT(11) && type == 11) { PHASE_BEGIN; phase_s5_carry(F, p); }
        else if (PHT(12) && type == 12) { PHASE_BEGIN; phase_s5_scan<true>(F, p); }
        else if (PHT(13) && type == 13) { PHASE_BEGIN; DenseSched S; S.init(ws + WS_AUX, ws + WS_GLU_T, T, 2 * D, D, F.G, bx); EpiGluResid E{(const bf16*)(ws + WS_XB), (bf16*)(ws + WS_Y)};
            pg8::gemm_phase(F.lds, F.tid, D, S, E); }
        else if (PHT(14) && type == 14) { PHASE_BEGIN; phase_lnr(F, p, layer, PROBE_DRY14 && true); if (PROBE_DRY14) { if (use_bar) xcd_barrier(bar); phase_lnr(F, p, layer, false); } }
        else if (PHT(15) && type == 15) { PHASE_BEGIN; moe_plan(F, layer);
            MoeSched2<true> S; S.tstart = (const volatile LAS int*)(F.MISC + PLAN_OFF); S.cnts = S.tstart + 72; S.ntiles = __builtin_amdgcn_readfirstlane((int)S.tstart[65]); S.G = F.G; S.c = bx; S.lane = F.lane;
            S.Abase = (const char*)(ws + WS_X); S.Wbase = (const char*)(ws + WS_WMOE); S.lists = (const int*)(ws + WS_LIST);
            EpiMoeUp E{(bf16*)(ws + WS_H)};
            pg8::gemm_phase(F.lds, F.tid, D / 2, S, E); }
        else if (PHT(16) && type == 16) { PHASE_BEGIN; moe_plan(F, layer);
            { MoeSched2<false> S; S.tstart = (const volatile LAS int*)(F.MISC + PLAN_OFF); S.cnts = S.tstart + 72; S.ntiles = __builtin_amdgcn_readfirstlane((int)S.tstart[64]); S.G = F.G; S.c = bx; S.lane = F.lane;
              S.Abase = (const char*)(ws + WS_H); S.Wbase = (const char*)(ws + WS_WMOE); S.lists = (const int*)(ws + WS_LIST);
              EpiStoreFp8 E{(unsigned char*)(ws + WS_BIG), D};
              pg8::gemm_phase(F.lds, F.tid, ED, S, E); }
            { const int sh0 = __builtin_amdgcn_readfirstlane((int)((const volatile LAS int*)(F.MISC + PLAN_OFF))[64]);
              DenseSched S; S.init(ws + WS_H + (size_t)sh0 * 256 * ED * 2, ws + WS_WMOE + (size_t)64 * WMOE_E_BYTES + (size_t)512 * 1024 * 2, T, D, ED, F.G, bx); EpiResid E{(const bf16*)(ws + WS_XB), (bf16*)(ws + WS_Y)};
              pg8::gemm_phase(F.lds, F.tid, ED, S, E); } }
        else if (PHT(17) && type == 17) { PHASE_BEGIN; moe_plan(F, layer); if (PROBE_DRY17) { phase_combine(F, p, layer, true); if (use_bar) xcd_barrier(bar); } phase_combine(F, p, layer); if (layer + 1 < DEPTH) phase_conv_moe(F, p, layer + 1); }
        }
        if (use_bar && ph + 1 < hi) xcd_barrier(bar);
    }
}

#ifndef MK_PER_PHASE
#define MK_PER_PHASE 0
#endif
extern "C" void kernel_launch(void* const* d_in, const int* in_sizes, int n_in, void* d_out, int out_size, void* d_ws, size_t ws_size, hipStream_t stream) {
    static int grid = 0;
    if (grid == 0) {
        if (n_in != 26 || in_sizes[0] != T * D || out_size != T * D || ws_size < WS_END) { fprintf(stderr, "kernel_launch: unexpected shapes / workspace (n_in %d, in0 %d, out %d, ws %zu < %zu)\n", n_in, n_in > 0 ? in_sizes[0] : -1, out_size, ws_size, (size_t)WS_END); grid = -1; return; }
        int dev = 0, cus = 0, per_cu = 0;
        if (hipGetDevice(&dev) != hipSuccess || hipDeviceGetAttribute(&cus, hipDeviceAttributeMultiprocessorCount, dev) != hipSuccess) { grid = -1; return; }
        if (hipFuncSetAttribute((const void*)fwd_kernel, hipFuncAttributeMaxDynamicSharedMemorySize, LDS_BYTES) != hipSuccess) { fprintf(stderr, "kernel_launch: hipFuncSetAttribute failed\n"); grid = -1; return; }
        if (hipOccupancyMaxActiveBlocksPerMultiprocessor(&per_cu, (const void*)fwd_kernel, NTHREADS, LDS_BYTES) != hipSuccess || per_cu < 1) { fprintf(stderr, "kernel_launch: occupancy query says %d blocks per CU\n", per_cu); per_cu = 1; }
        (void)hipGetLastError();
        grid = cus;
    }
    if (grid < 0) return;
    (void)hipMemsetAsync((char*)d_ws + WS_CTL, 0, CTL_ZERO_BYTES, stream);
    Params p{};
    for (int i = 0; i < 26; ++i) p.in[i] = (const float*)d_in[i];
    p.out = (float*)d_out; p.ws = (unsigned char*)d_ws;
#if MK_PER_PHASE
    for (int k = 0; k < NPHASES; ++k) { p.ph_lo = k; p.ph_hi = k + 1; p.use_bar = 0; hipLaunchKernelGGL(fwd_kernel, dim3(grid), dim3(NTHREADS), LDS_BYTES, stream, p); }
#else
    p.ph_lo = 0; p.ph_hi = NPHASES; p.use_bar = 1;
    hipLaunchKernelGGL(fwd_kernel, dim3(grid), dim3(NTHREADS), LDS_BYTES, stream, p);
#endif
}
```

```cpp
#include <hip/hip_runtime.h>
#include <cstdio>
#include <cstdint>

#define LAS __attribute__((address_space(3)))
#define GAS __attribute__((address_space(1)))
typedef unsigned short bf16;
typedef short bf16x8 __attribute__((ext_vector_type(8)));
typedef short bf16x4 __attribute__((ext_vector_type(4)));
typedef float f32x4 __attribute__((ext_vector_type(4)));
typedef float f32x2 __attribute__((ext_vector_type(2)));
typedef unsigned u32x4 __attribute__((ext_vector_type(4)));
typedef unsigned u32x2 __attribute__((ext_vector_type(2)));
typedef GAS unsigned gu32;

constexpr int D = 1024, BATCH = 2, SEQ = 8192, T = BATCH * SEQ, DEPTH = 4;
constexpr int AH = 8, AHD = 128, ATT_IN = 9216;
constexpr int RH = 4, RDK = 256, RDV = 512, RET_IN = 6144, RET_V = 2048, RC = 128, RNC = SEQ / RC;
constexpr int SG = 64, SGC = 16, SP = 64;
constexpr int NE = 64, TOPK = 8, NEG = 8, ED = 256, NSLOT = 9;
constexpr float LN_EPS = 1e-5f;
constexpr float ALPHA = 1.6817928305074292f;
constexpr int NWAVES = 8, NTHREADS = 512;

__device__ __forceinline__ unsigned f2bf(float f) { unsigned u = __builtin_bit_cast(unsigned, f); return (u + 0x7fffu + ((u >> 16) & 1u)) >> 16; }
__device__ __forceinline__ unsigned pk2(float lo, float hi) { unsigned r; asm("s_nop 1\n\tv_cvt_pk_bf16_f32 %0, %1, %2" : "=v"(r) : "v"(lo), "v"(hi)); return r; }
__device__ __forceinline__ unsigned pk2sw(float lo, float hi) { return f2bf(lo) | (f2bf(hi) << 16); }
__device__ __forceinline__ unsigned pk2hw(float lo, float hi) { unsigned r; asm volatile("v_cvt_pk_bf16_f32 %0, %1, %2" : "=v"(r) : "v"(lo), "v"(hi)); return r; }
__device__ __forceinline__ float bf2f(unsigned b) { return __builtin_bit_cast(float, b << 16); }
__device__ __forceinline__ float bflo(unsigned w) { return __builtin_bit_cast(float, w << 16); }
__device__ __forceinline__ float bfhi(unsigned w) { return __builtin_bit_cast(float, w & 0xffff0000u); }
__device__ __forceinline__ float shx(float v, int m, int lane) { return __builtin_bit_cast(float, __builtin_amdgcn_ds_bpermute((lane ^ m) << 2, __builtin_bit_cast(int, v))); }
__device__ __forceinline__ int shx_i(int v, int m, int lane) { return __builtin_amdgcn_ds_bpermute((lane ^ m) << 2, v); }
__device__ __forceinline__ float rdl(float v, int src) { return __builtin_bit_cast(float, __builtin_amdgcn_readlane(__builtin_bit_cast(int, v), src)); }
template <int CTRL, int RM = 0xf, int BM = 0xf> __device__ __forceinline__ float dpp0(float v) { return __builtin_bit_cast(float, __builtin_amdgcn_update_dpp(0, __builtin_bit_cast(int, v), CTRL, RM, BM, true)); }
template <int CTRL, int RM = 0xf, int BM = 0xf> __device__ __forceinline__ float dppo(float old, float v) { return __builtin_bit_cast(float, __builtin_amdgcn_update_dpp(__builtin_bit_cast(int, old), __builtin_bit_cast(int, v), CTRL, RM, BM, false)); }
__device__ __forceinline__ float wave_sum(float v, int lane) {
    (void)lane;
    v += dpp0<0x111>(v); v += dpp0<0x112>(v); v += dpp0<0x114>(v); v += dpp0<0x118>(v);
    v += dpp0<0x142, 0xa>(v);
    v += dpp0<0x143, 0xc>(v);
    return rdl(v, 63);
}
__device__ __forceinline__ float max8(float v) {
    v = fmaxf(v, dppo<0xb1>(v, v)); v = fmaxf(v, dppo<0x4e>(v, v)); v = fmaxf(v, dppo<0x141>(v, v)); return v;
}
__device__ __forceinline__ float fsig(float x) { return __builtin_amdgcn_rcpf(1.0f + __expf(-x)); }
#define LDS_WAIT() asm volatile("s_waitcnt lgkmcnt(0)" ::: "memory")
#define VM_WAIT() asm volatile("s_waitcnt vmcnt(0)" ::: "memory")
__device__ __forceinline__ const char* rfl_ptr(const char* p) {
    unsigned long long v = (unsigned long long)p; unsigned lo = __builtin_amdgcn_readfirstlane((unsigned)v), hi = __builtin_amdgcn_readfirstlane((unsigned)(v >> 32));
    return (const char*)(((unsigned long long)hi << 32) | lo);
}
__device__ __forceinline__ bf16x8 row_frag(const LAS bf16* base, int ld, int row0, int col0, int lane) {
    return *(const LAS bf16x8*)(base + (row0 + (lane & 15)) * ld + col0 + 8 * (lane >> 4));
}
__device__ __forceinline__ bf16x4 tr4(const LAS bf16* addr) { return __builtin_amdgcn_ds_read_tr16_b64_v4i16((LAS bf16x4*)addr); }
__device__ __forceinline__ bf16x8 cat8(bf16x4 a, bf16x4 b) { bf16x8 r; r[0] = a[0]; r[1] = a[1]; r[2] = a[2]; r[3] = a[3]; r[4] = b[0]; r[5] = b[1]; r[6] = b[2]; r[7] = b[3]; return r; }
#define MFMA16(a, b, c) __builtin_amdgcn_mfma_f32_16x16x32_bf16((a), (b), (c), 0, 0, 0)
__device__ __forceinline__ bf16x8 pack8(f32x4 a, f32x4 b) {
    u32x4 w; w.x = pk2(a[0], a[1]); w.y = pk2(a[2], a[3]); w.z = pk2(b[0], b[1]); w.w = pk2(b[2], b[3]); return __builtin_bit_cast(bf16x8, w);
}

namespace pg8 {
typedef int v4i_t __attribute__((ext_vector_type(4)));
typedef int v8i_t __attribute__((ext_vector_type(8)));
constexpr int BM = 256, BK = 64, HALF = 128, HTB = HALF * BK * 2, STAGE_BYTES = 8 * HTB;
__device__ __forceinline__ int lds_byte(int r, int c) { const int st = (r >> 4) * 2 + (c >> 5), rr = r & 15, cc = c & 31, ob = rr * 64 + cc * 2; return st * 1024 + (ob ^ (((ob >> 9) & 1) << 5)); }
__device__ __forceinline__ void stage_rc(int b, int& R, int& C) { const int st = b / 1024, sb = b % 1024, swz = sb ^ (((sb >> 9) & 1) << 5); R = (st >> 1) * 16 + swz / 64; C = (st & 1) * 32 + (swz % 64) / 2; }
__device__ __forceinline__ int perm32(int rho) { const int n = rho >> 4, i = rho & 15; return 8 * (i >> 2) + 4 * n + (i & 3); }

struct UnitG {
    const char* A;
    const char* B;
    const int* gidx;
    int gcnt, gshift;
    int row0, col0;
    int aux;
};

__device__ __forceinline__ void uniformize(UnitG& u) { u.A = rfl_ptr(u.A); u.B = rfl_ptr(u.B); u.gidx = (const int*)rfl_ptr((const char*)u.gidx); u.gcnt = __builtin_amdgcn_readfirstlane(u.gcnt); u.gshift = __builtin_amdgcn_readfirstlane(u.gshift);
    u.row0 = __builtin_amdgcn_readfirstlane(u.row0); u.col0 = __builtin_amdgcn_readfirstlane(u.col0); u.aux = __builtin_amdgcn_readfirstlane(u.aux); }
template <class Epi, class Sched>
__device__ __forceinline__ void gemm_phase(LAS unsigned char* lds, const int tid, const int K, const Sched& S, const Epi& E) {
    constexpr bool F8 = Sched::FP8;
    constexpr bool GATHER = Sched::GATHER;
    const int wid = __builtin_amdgcn_readfirstlane(tid >> 6), lane = tid & 63, wr = wid >> 2, wc = wid & 3, fr = lane & 15, fq = lane >> 4;
    const int nt = K / BK;
    constexpr bool P16 = Epi::PERM16;
    unsigned voffB[2], voffB1[2], vA[2][2];
#pragma unroll
    for (int i = 0; i < 2; ++i) { int R, C; stage_rc(tid * 16 + i * 8192, R, C); const int Rb = Epi::PERM ? ((R & ~31) + perm32(R & 31)) : R; voffB[i] = (unsigned)(Rb * K + C) * 2u; voffB1[i] = voffB[i]; vA[0][i] = (unsigned)(R * K + C) * 2u; vA[1][i] = vA[0][i];
        if constexpr (P16) { const int x = R & 31, src = 64 * (R >> 5) + 16 * ((x >> 2) & 3) + 4 * (x >> 4) + (x & 3); voffB[i] = (unsigned)(src * K + C) * 2u; voffB1[i] = (unsigned)((src + 8) * K + C) * 2u; } }
    const size_t kstep = (size_t)(BK * 2);
    const size_t hstep = (size_t)HALF * K * 2;
    const size_t hstepB = P16 ? 0 : hstep;
    const size_t hstepA = GATHER ? 0 : hstep;
    const unsigned ldsw = (unsigned)wid * 1024u;
    const int aoff = F8 ? lds_byte(wr * 64 + fr, fq * 16) : lds_byte(wr * 64 + fr, fq * 8), boff = F8 ? lds_byte(wc * 32 + fr, fq * 16) : lds_byte(wc * 32 + fr, fq * 8);
    LAS u32x4* park = (LAS u32x4*)(lds + STAGE_BYTES) + tid;
#define PG8_SA(b, h) (((b) * 2 + (h)) * HTB)
#define PG8_SB(b, h) ((4 + (b) * 2 + (h)) * HTB)
#define PG8_STAGE(bufoff, gbase, voff) do { _Pragma("unroll") for (int _i = 0; _i < 2; ++_i) { asm volatile("" : "+v"((voff)[_i]));   \
        __builtin_amdgcn_global_load_lds((const unsigned*)((const char*)(gbase) + (voff)[_i]), (LAS unsigned*)(lds + (bufoff) + ldsw + _i * 8192), 16, 0, 0); } } while (0)
    constexpr int FKS = F8 ? 16 : 1024;
#define PG8_LD2(p_) __builtin_shufflevector(*(const LAS v4i_t*)(p_), *(const LAS v4i_t*)((p_) + FKS), 0, 1, 2, 3, 4, 5, 6, 7)
#define PG8_LDA(dst, b, h) do { _Pragma("unroll") for (int m = 0; m < 4; ++m) dst[m] = PG8_LD2(lds + PG8_SA(b, h) + aoff + m * 2048); } while (0)
#define PG8_LDB(dst, b, h) do { _Pragma("unroll") for (int n = 0; n < 2; ++n) dst[n] = PG8_LD2(lds + PG8_SB(b, h) + boff + n * 2048); } while (0)
#define PG8_LO(v) __builtin_bit_cast(bf16x8, __builtin_shufflevector((v), (v), 0, 1, 2, 3))
#define PG8_HI(v) __builtin_bit_cast(bf16x8, __builtin_shufflevector((v), (v), 4, 5, 6, 7))
#define PG8_MMA(ai, bj, At, Bt) do { __builtin_amdgcn_s_setprio(1); _Pragma("unroll") for (int m = 0; m < 4; ++m) _Pragma("unroll") for (int n = 0; n < 2; ++n) { \
        if constexpr (F8) { acc[ai][bj][m][n] = __builtin_amdgcn_mfma_scale_f32_16x16x128_f8f6f4(Bt[n], At[m], acc[ai][bj][m][n], 0, 0, 0, 0x7F7F7F7F, 0, 0x7F7F7F7F); } \
        else { acc[ai][bj][m][n] = __builtin_amdgcn_mfma_f32_16x16x32_bf16(PG8_LO(Bt[n]), PG8_LO(At[m]), acc[ai][bj][m][n], 0, 0, 0); \
               acc[ai][bj][m][n] = __builtin_amdgcn_mfma_f32_16x16x32_bf16(PG8_HI(Bt[n]), PG8_HI(At[m]), acc[ai][bj][m][n], 0, 0, 0); } } __builtin_amdgcn_s_setprio(0); } while (0)
#define PG8_WAIT_V(n) asm volatile("s_waitcnt vmcnt(" #n ")" ::: "memory")
#define PG8_WAIT_L(n) asm volatile("s_waitcnt lgkmcnt(" #n ")" ::: "memory")
#define PG8_BAR __builtin_amdgcn_s_barrier()
#define PG8_SCHED __builtin_amdgcn_sched_barrier(0)
#define PG8_VOFF(u, v00, v01, v10, v11) do { int _R0, _C0, _R1, _C1; stage_rc(tid * 16, _R0, _C0); stage_rc(tid * 16 + 8192, _R1, _C1); int _r00 = _R0, _r01 = _R1, _r10 = HALF + _R0, _r11 = HALF + _R1; \
        if ((u).gidx) { const GAS int* _gp = (const GAS int*)(u).gidx; const int _gc = (u).gcnt;     \
            const int _a = _gp[_r00 < _gc ? _r00 : 0] >> (u).gshift, _b = _gp[_r01 < _gc ? _r01 : 0] >> (u).gshift, _c = _gp[_r10 < _gc ? _r10 : 0] >> (u).gshift, _d = _gp[_r11 < _gc ? _r11 : 0] >> (u).gshift; \
            _r00 = _a; _r01 = _b; _r10 = _c; _r11 = _d; } \
        v00 = (unsigned)(_r00 * K + _C0) * 2u; v01 = (unsigned)(_r01 * K + _C1) * 2u; v10 = (unsigned)(_r10 * K + _C0) * 2u; v11 = (unsigned)(_r11 * K + _C1) * 2u; } while (0)
    UnitG cur, nxt; int ui = 0;
    if (!S.next(0, cur)) return;
    if constexpr (Sched::UNIFORMIZE) uniformize(cur);
    f32x4 acc[2][2][4][2];
#pragma unroll
    for (int a = 0; a < 2; ++a)
#pragma unroll
        for (int b = 0; b < 2; ++b)
#pragma unroll
            for (int m = 0; m < 4; ++m)
#pragma unroll
                for (int n = 0; n < 2; ++n) acc[a][b][m][n] = (f32x4){0.f, 0.f, 0.f, 0.f};
    v8i_t At[4], B0[2], B1[2];
    if constexpr (GATHER) PG8_VOFF(cur, vA[0][0], vA[0][1], vA[1][0], vA[1][1]);
    const char* cA = cur.A; const char* cB = cur.B;
    PG8_STAGE(PG8_SB(0, 0), cB, voffB); PG8_STAGE(PG8_SB(0, 1), cB + hstepB, voffB1); PG8_STAGE(PG8_SA(0, 0), cA, vA[0]); PG8_STAGE(PG8_SA(0, 1), cA + hstepA, vA[1]);
    if (wr == 1) PG8_BAR;
    PG8_WAIT_V(2); PG8_BAR;
    PG8_STAGE(PG8_SB(1, 0), cB + kstep, voffB); PG8_STAGE(PG8_SA(1, 0), cA + kstep, vA[0]); PG8_STAGE(PG8_SB(1, 1), cB + hstepB + kstep, voffB1);
    PG8_WAIT_V(6); PG8_BAR;
    for (;;) {
        const bool has_next = S.next(ui + 1, nxt);
        if constexpr (Sched::UNIFORMIZE) { if (has_next) uniformize(nxt); }
        const char* nA = cA; const char* nB = cB;
        if (has_next) { nA = nxt.A; nB = nxt.B; }
        if constexpr (GATHER) { u32x4 pv; pv.x = vA[0][0]; pv.y = vA[0][1]; pv.z = vA[1][0]; pv.w = vA[1][1];
            if (has_next) PG8_VOFF(nxt, pv.x, pv.y, pv.z, pv.w);
            *park = pv; }
#pragma unroll 1
        for (int t = 0; t < nt; t += 2) {
            const bool last = (t == nt - 2);
            const char* a1 = cA + (size_t)(t + 1) * kstep;
            const char* a2 = last ? nA : cA + (size_t)(t + 2) * kstep; const char* b2 = last ? nB : cB + (size_t)(t + 2) * kstep;
            const char* a3 = a2 + kstep; const char* b3 = b2 + kstep;
            PG8_LDB(B0, 0, 0); PG8_LDB(B1, 0, 1); PG8_SCHED; PG8_LDA(At, 0, 0); PG8_STAGE(PG8_SA(1, 1), a1 + hstepA, vA[1]);
            PG8_WAIT_V(8); PG8_WAIT_L(0); PG8_BAR; PG8_MMA(0, 0, At, B0); PG8_MMA(0, 1, At, B1); PG8_BAR; PG8_SCHED;
            if constexpr (GATHER) { if (last) { const u32x4 pv = *park; vA[0][0] = pv.x; vA[0][1] = pv.y; vA[1][0] = pv.z; vA[1][1] = pv.w; } }
            PG8_LDA(At, 0, 1); PG8_STAGE(PG8_SB(0, 0), b2, voffB); PG8_STAGE(PG8_SB(0, 1), b2 + hstepB, voffB1); PG8_STAGE(PG8_SA(0, 0), a2, vA[0]);
            PG8_WAIT_V(8); PG8_WAIT_L(0); PG8_BAR; PG8_MMA(1, 0, At, B0); PG8_MMA(1, 1, At, B1); PG8_BAR; PG8_SCHED;
            PG8_LDB(B0, 1, 0); PG8_LDB(B1, 1, 1); PG8_SCHED; PG8_LDA(At, 1, 0); PG8_STAGE(PG8_SA(0, 1), a2 + hstepA, vA[1]);
            PG8_WAIT_V(8); PG8_WAIT_L(0); PG8_BAR; PG8_MMA(0, 0, At, B0); PG8_MMA(0, 1, At, B1); PG8_BAR; PG8_SCHED;
            PG8_LDA(At, 1, 1); PG8_STAGE(PG8_SB(1, 0), b3, voffB); PG8_STAGE(PG8_SB(1, 1), b3 + hstepB, voffB1); PG8_STAGE(PG8_SA(1, 0), a3, vA[0]);
            PG8_WAIT_V(8); PG8_WAIT_L(0); PG8_BAR; PG8_MMA(1, 0, At, B0); PG8_MMA(1, 1, At, B1); PG8_BAR; PG8_SCHED;
        }
        if (wr == 0) PG8_BAR;
        E(acc, cur, wr, wc, fr, fq);
        if (!has_next) break;
#pragma unroll
        for (int a = 0; a < 2; ++a)
#pragma unroll
            for (int b = 0; b < 2; ++b)
#pragma unroll
                for (int m = 0; m < 4; ++m)
#pragma unroll
                    for (int n = 0; n < 2; ++n) acc[a][b][m][n] = (f32x4){0.f, 0.f, 0.f, 0.f};
        cur = nxt; cA = nA; cB = nB; ++ui;
        if (wr == 1) PG8_BAR;
    }
    PG8_WAIT_V(0);
    PG8_BAR;
#undef PG8_SA
#undef PG8_SB
#undef PG8_STAGE
#undef PG8_LDA
#undef PG8_LDB
#undef PG8_LD2
#undef PG8_LO
#undef PG8_HI
#undef PG8_MMA
#undef PG8_WAIT_V
#undef PG8_WAIT_L
#undef PG8_BAR
#undef PG8_SCHED
#undef PG8_VOFF
}
}

constexpr size_t MiB = 1u << 20;
constexpr size_t WS_CTL = 0, CTL_ZERO_BYTES = 1 * MiB;
constexpr size_t WS_ATT_IN_T = 1 * MiB;
constexpr size_t WS_ATT_OUT_T = WS_ATT_IN_T + 36 * MiB;
constexpr size_t WS_RET_IN_T = WS_ATT_OUT_T + 4 * MiB;
constexpr size_t WS_RET_OUT_T = WS_RET_IN_T + 12 * MiB;
constexpr size_t WS_GLU_T = WS_RET_OUT_T + 4 * MiB;
constexpr size_t WS_RT_HI = WS_GLU_T + 4 * MiB;
constexpr size_t WS_RT_LO = WS_RT_HI + 512 * 1024;
constexpr size_t WS_WMOE = WS_RT_HI + 1 * MiB;
constexpr size_t WMOE_E_BYTES = (size_t)(512 * 1024 + 1024 * 256) * 2;
constexpr size_t WS_X = WS_WMOE + 98 * MiB;
constexpr size_t WS_Y = WS_X + 64 * MiB;
constexpr size_t WS_XB = WS_Y + 64 * MiB;
constexpr size_t WS_BIG = WS_XB + 32 * MiB;
constexpr size_t WS_AUX = WS_BIG + 288 * MiB;
constexpr size_t WS_H = WS_AUX + 160 * MiB;
constexpr size_t WS_LIST = WS_H + 80 * MiB;
constexpr size_t WS_TRASH = WS_LIST + 8 * MiB;
constexpr size_t WS_END = WS_TRASH + 1 * MiB;
static_assert(WS_END <= 1024 * MiB, "workspace map");
constexpr int CW_BAR = 4096;
constexpr int CW_CNT = 16384;
constexpr int CW_CHK = 65536;
constexpr int HROWS = 163840;

#define XB_TMO      128
#define XB_XCNT(j)  (256  + 64 * (j))
#define XB_XSUB(j)  (1280 + 64 * (j))
#define XB_XGEN(j)  (2304 + 64 * (j))
#define XB_TOP      3328
#define XB_TOPGEN   3392
#define XCD_BAR_WORDS 3456
#define XB_SPIN_CAP (1u << 20)
__device__ __forceinline__ unsigned xb_ld(unsigned* p)              { return __hip_atomic_load(p, __ATOMIC_RELAXED, __HIP_MEMORY_SCOPE_AGENT); }
__device__ __forceinline__ unsigned xb_add(unsigned* p, unsigned v) { return __hip_atomic_fetch_add(p, v, __ATOMIC_RELAXED, __HIP_MEMORY_SCOPE_AGENT); }
__device__ __forceinline__ unsigned xb_xcc_id() { return (unsigned)__builtin_amdgcn_s_getreg((3 << 11) | 20) & 0xFu; }
#define XB_SPIN(cond, bar) do { unsigned _sp = 0; while (cond) { __builtin_amdgcn_s_sleep(1); \
    if ((++_sp & 255u) == 0u) { if (xb_ld(&(bar)[XB_TMO])) break; if (_sp > XB_SPIN_CAP) { atomicAdd(&(bar)[XB_TMO], 1u); break; } } } } while (0)
struct XcdBarrier { unsigned* bar; unsigned x; volatile LAS unsigned* st; };
__device__ __forceinline__ XcdBarrier xcd_barrier_post(unsigned* bar, volatile LAS unsigned* st) {
    XcdBarrier b; b.bar = bar; b.x = xb_xcc_id(); b.st = st;
    if (threadIdx.x == 0) (void)xb_add(&bar[XB_XCNT(b.x)], 1u);
    return b;
}
__device__ __forceinline__ void xcd_barrier_complete(unsigned* bar, unsigned x, unsigned& nloc, unsigned& nx) {
    const unsigned G = gridDim.x * gridDim.y * gridDim.z;
    unsigned sum, cnt, mine, sp = 0u;
    for (;;) {
        sum = 0u; cnt = 0u; mine = 0u;
#pragma unroll
        for (unsigned j = 0; j < 16; ++j) { const unsigned c = xb_ld(&bar[XB_XCNT(j)]); sum += c; cnt += (c > 0u) ? 1u : 0u; mine = (j == x) ? c : mine; }
        if (sum == G) break;
        __builtin_amdgcn_s_sleep(1);
        if ((++sp & 255u) == 0u) { if (xb_ld(&bar[XB_TMO])) break; if (sp > XB_SPIN_CAP) { atomicAdd(&bar[XB_TMO], 1u); break; } }
    }
    nloc = mine > 0u ? mine : 1u; nx = cnt > 0u ? cnt : 1u;
}
__device__ __forceinline__ void xcd_barrier(const XcdBarrier& b) {
    asm volatile("s_waitcnt vmcnt(0)" ::: "memory");
    __syncthreads();
    if (threadIdx.x == 0) {
        unsigned* bar = b.bar;
        __builtin_amdgcn_s_waitcnt(0);
        unsigned nloc = b.st[0], nx = b.st[1];
        if (nloc == 0u) { xcd_barrier_complete(bar, b.x, nloc, nx); b.st[0] = nloc; b.st[1] = nx; }
        const unsigned old = xb_add(&bar[XB_XSUB(b.x)], 1u);
        const unsigned gen = old / nloc;
        if (old + 1u == (gen + 1u) * nloc) {
            __builtin_amdgcn_fence(__ATOMIC_RELEASE, "agent");
            asm volatile("s_waitcnt vmcnt(0)" ::: "memory");
            const unsigned og = xb_add(&bar[XB_TOP], 1u);
            const unsigned tg = og / nx;
            if (og + 1u == (tg + 1u) * nx) xb_add(&bar[XB_TOPGEN], 1u);
            else XB_SPIN(xb_ld(&bar[XB_TOPGEN]) == tg, bar);
            __builtin_amdgcn_fence(__ATOMIC_ACQUIRE, "agent");
            xb_add(&bar[XB_XGEN(b.x)], 1u);
            asm volatile("s_waitcnt vmcnt(0)" ::: "memory");
        } else {
            XB_SPIN(xb_ld(&bar[XB_XGEN(b.x)]) == gen, bar);
            __builtin_amdgcn_fence(__ATOMIC_ACQUIRE, "agent");
            asm volatile("s_waitcnt vmcnt(0)" ::: "memory");
        }
    }
    __syncthreads();
}

constexpr int RING_BYTES = 139264;
constexpr int MISC_OFF = RING_BYTES;
constexpr int LDS_BYTES = 147456;
struct Params {
    const float* in[26]; float* out; unsigned char* ws; int ph_lo, ph_hi; int use_bar, pad;
};
typedef const __attribute__((address_space(4))) Params* KP;
__device__ __forceinline__ const float* gin(KP p, int i) { return (const float*)(const GAS float*)p->in[i]; }
__device__ __forceinline__ float* gout(KP p) { return (float*)(GAS float*)p->out; }
struct Frame {
    LAS unsigned char* lds; volatile LAS unsigned* MISC;
    int tid, lane, wave, vcu, G;
    unsigned char* ws;
};

template <bool F8_ = false> struct DenseSchedT {
    static constexpr bool GATHER = false, UNIFORMIZE = false, FP8 = F8_;
    const char* A; const char* Bt; int K, nM, nN, nwg, G, c;
    __device__ __forceinline__ void init(const void* A_, const void* Bt_, int M, int N, int K_, int G_, int c_) { A = (const char*)A_; Bt = (const char*)Bt_; K = K_; nM = M / 256; nN = N / 256; nwg = nM * nN; G = G_; c = c_; }
    __device__ __forceinline__ bool next(int i, pg8::UnitG& u) const {
        const long L = (long)i * G + c; if (L >= nwg) return false;
        int wgid = (int)L; { const int q = nwg / 8, r = nwg % 8, xcd = wgid % 8, off = wgid / 8; wgid = (xcd < r ? xcd * (q + 1) : r * (q + 1) + (xcd - r) * q) + off; }
        const int nig = 8 * nN, gid = wgid / nig, fm = gid * 8, gsz = (nM - fm) < 8 ? (nM - fm) : 8;
        const int pm = fm + ((wgid % nig) % gsz), pn = (wgid % nig) / gsz;
        u.A = A + (size_t)pm * 256 * K * 2; u.B = Bt + (size_t)pn * 256 * K * 2; u.gidx = nullptr; u.gcnt = 0; u.gshift = 0; u.row0 = pm * 256; u.col0 = pn * 256; u.aux = 0; return true;
    }
};
typedef DenseSchedT<false> DenseSched; typedef DenseSchedT<true> DenseSched8;
__device__ __forceinline__ u32x4 pack_bf16x8(const f32x4& v0, const f32x4& v1) { u32x4 w; w.x = pk2hw(v0[0], v0[1]); w.y = pk2hw(v0[2], v0[3]); w.z = pk2hw(v1[0], v1[1]); w.w = pk2hw(v1[2], v1[3]); return w; }

constexpr float WUP_SCALE = 32.0f, WUP_INV = 1.0f / 32.0f;
struct EpiStoreBf16 {
    static constexpr bool PERM = true, PERM16 = false;
    bf16* O; int ldc; float osc, qsc;
    __device__ __forceinline__ void operator()(const f32x4 (&acc)[2][2][4][2], const pg8::UnitG& u, int wr, int wc, int fr, int fq) const {
        const float sc = ((u.col0 % 3072) < 1024) ? osc * qsc : osc;
#pragma unroll
        for (int ai = 0; ai < 2; ++ai)
#pragma unroll
            for (int m = 0; m < 4; ++m) { bf16* rowp = O + (size_t)(u.row0 + ai * 128 + wr * 64 + m * 16 + fr) * ldc + u.col0 + wc * 32 + 8 * fq;
#pragma unroll
                for (int bj = 0; bj < 2; ++bj) *(u32x4*)(rowp + bj * 128) = pack_bf16x8(acc[ai][bj][m][0] * sc, acc[ai][bj][m][1] * sc); }
    }
};
constexpr float YEXP_SCALE = 32.0f, YEXP_INV = 1.0f / 32.0f;
struct EpiStoreFp8 {
    static constexpr bool PERM = false, PERM16 = true;
    unsigned char* O; int ldc;
    __device__ __forceinline__ void operator()(const f32x4 (&acc)[2][2][4][2], const pg8::UnitG& u, int wr, int wc, int fr, int fq) const {
#pragma unroll
        for (int ai = 0; ai < 2; ++ai)
#pragma unroll
            for (int m = 0; m < 4; ++m) { unsigned char* rowp = O + (size_t)(u.row0 + ai * 128 + wr * 64 + m * 16 + fr) * ldc + u.col0 + wc * 64 + 16 * fq;
                u32x4 w;
#pragma unroll
                for (int q = 0; q < 4; ++q) { f32x4 v = acc[ai][q >> 1][m][q & 1] * YEXP_SCALE;
#pragma unroll
                    for (int j = 0; j < 4; ++j) v[j] = fminf(fmaxf(v[j], -448.0f), 448.0f);
                    int d = 0; d = __builtin_amdgcn_cvt_pk_fp8_f32(v[0], v[1], d, false); d = __builtin_amdgcn_cvt_pk_fp8_f32(v[2], v[3], d, true); w[q] = (unsigned)d; }
                *(u32x4*)rowp = w; }
    }
};
struct EpiRetIn {
    static constexpr bool PERM = true, PERM16 = false;
    bf16* O; int ldc;
    __device__ __forceinline__ void operator()(const f32x4 (&acc)[2][2][4][2], const pg8::UnitG& u, int wr, int wc, int fr, int fq) const {
        float l2g = 0.f;
        float cs = WUP_INV;
        if (u.col0 < 2048) { const int h = (u.col0 & 1023) >> 8; const float g = 1.0f - exp2f(-5.0f - (float)h); l2g = log2f(g); if (u.col0 >= 1024) { l2g = -l2g; cs *= 0.0625f; } }
#pragma unroll
        for (int ai = 0; ai < 2; ++ai)
#pragma unroll
            for (int m = 0; m < 4; ++m) { const int row = u.row0 + ai * 128 + wr * 64 + m * 16 + fr; const float sc = exp2f(l2g * (float)(row & 127)) * cs;
                bf16* rowp = O + (size_t)row * ldc + u.col0 + wc * 32 + 8 * fq;
#pragma unroll
                for (int bj = 0; bj < 2; ++bj) *(u32x4*)(rowp + bj * 128) = pack_bf16x8(acc[ai][bj][m][0] * sc, acc[ai][bj][m][1] * sc); }
    }
};
__device__ __forceinline__ void unpack_bf16x8(const u32x4& w, f32x4& a, f32x4& b) { a[0] = bflo(w.x); a[1] = bfhi(w.x); a[2] = bflo(w.y); a[3] = bfhi(w.y); b[0] = bflo(w.z); b[1] = bfhi(w.z); b[2] = bflo(w.w); b[3] = bfhi(w.w); }
struct EpiResid {
    static constexpr bool PERM = true, PERM16 = false;
    const bf16* X; bf16* Y;
    __device__ __forceinline__ void operator()(const f32x4 (&acc)[2][2][4][2], const pg8::UnitG& u, int wr, int wc, int fr, int fq) const {
#pragma unroll
        for (int ai = 0; ai < 2; ++ai)
#pragma unroll
            for (int m = 0; m < 4; ++m) { const size_t off = (size_t)(u.row0 + ai * 128 + wr * 64 + m * 16 + fr) * D + u.col0 + wc * 32 + 8 * fq;
#pragma unroll
                for (int bj = 0; bj < 2; ++bj) { const u32x4 xw = *(const u32x4*)(X + off + bj * 128); f32x4 x0, x1; unpack_bf16x8(xw, x0, x1);
                    *(u32x4*)(Y + off + bj * 128) = pack_bf16x8(x0 * ALPHA + acc[ai][bj][m][0], x1 * ALPHA + acc[ai][bj][m][1]); }
                if (m == 3) asm volatile("" ::: "memory"); }
    }
};
struct EpiGluResid {
    static constexpr bool PERM = true, PERM16 = false;
    const bf16* X; bf16* Y;
    __device__ __forceinline__ void operator()(const f32x4 (&acc)[2][2][4][2], const pg8::UnitG& u, int wr, int wc, int fr, int fq) const {
#pragma unroll
        for (int ai = 0; ai < 2; ++ai)
#pragma unroll
            for (int m = 0; m < 4; ++m) { const size_t off = (size_t)(u.row0 + ai * 128 + wr * 64 + m * 16 + fr) * D + (u.col0 >> 1) + wc * 32 + 8 * fq;
                const u32x4 xw = *(const u32x4*)(X + off); f32x4 x0, x1; unpack_bf16x8(xw, x0, x1); f32x4 o0, o1;
#pragma unroll
                for (int j = 0; j < 4; ++j) { o0[j] = x0[j] * ALPHA + acc[ai][0][m][0][j] * fsig(acc[ai][1][m][0][j]); o1[j] = x1[j] * ALPHA + acc[ai][0][m][1][j] * fsig(acc[ai][1][m][1][j]); }
                *(u32x4*)(Y + off) = pack_bf16x8(o0, o1);
                if (m == 3) asm volatile("" ::: "memory"); }
    }
};
struct EpiMoeUp {
    static constexpr bool PERM = true, PERM16 = false;
    bf16* H;
    __device__ __forceinline__ void operator()(const f32x4 (&acc)[2][2][4][2], const pg8::UnitG& u, int wr, int wc, int fr, int fq) const {
#pragma unroll
        for (int ai = 0; ai < 2; ++ai)
#pragma unroll
            for (int m = 0; m < 4; ++m) { bf16* rowp = H + (size_t)(u.row0 + ai * 128 + wr * 64 + m * 16 + fr) * ED + u.col0 + wc * 32 + 8 * fq; f32x4 o[2];
#pragma unroll
                for (int n = 0; n < 2; ++n)
#pragma unroll
                    for (int j = 0; j < 4; ++j) { const float ga = acc[ai][0][m][n][j], ua = acc[ai][1][m][n][j];
                        o[n][j] = (ga * ua) * (WUP_INV * WUP_INV) * __builtin_amdgcn_rcpf(1.0f + __builtin_amdgcn_exp2f(ga * (-WUP_INV * 1.4426950408889634f))); }
                *(u32x4*)rowp = pack_bf16x8(o[0], o[1]); }
    }
};

__device__ __forceinline__ unsigned pk4_fp8(float a, float b, float c, float d) {
    a = fminf(fmaxf(a, -448.0f), 448.0f); b = fminf(fmaxf(b, -448.0f), 448.0f); c = fminf(fmaxf(c, -448.0f), 448.0f); d = fminf(fmaxf(d, -448.0f), 448.0f);
    int w = 0; w = __builtin_amdgcn_cvt_pk_fp8_f32(a, b, w, false); w = __builtin_amdgcn_cvt_pk_fp8_f32(c, d, w, true); return (unsigned)w; }
template <bool HILO>
__device__ __forceinline__ void conv_item(const float* W, int ldw, bf16* WT, bf16* WTlo, int ldk, int k0, int n0, int drow0, float scale, LAS float* scr, int lane) {
#pragma unroll 8
    for (int i = 0; i < 32; ++i) { const int kk = 2 * i + (lane >> 5); scr[kk * 33 + (lane & 31)] = W[(size_t)(k0 + kk) * ldw + n0 + (lane & 31)] * scale; }
    LDS_WAIT(); asm volatile("" ::: "memory");
    const int c = lane & 7;
#pragma unroll
    for (int j = 0; j < 4; ++j) { const int n = (lane >> 3) + 8 * j; const LAS float* s = scr + (8 * c) * 33 + n;
        float v[8];
#pragma unroll
        for (int q = 0; q < 8; ++q) v[q] = s[q * 33];
        u32x4 o; o.x = pk2(v[0], v[1]); o.y = pk2(v[2], v[3]); o.z = pk2(v[4], v[5]); o.w = pk2(v[6], v[7]);
        *(u32x4*)(WT + (size_t)(drow0 + n) * ldk + k0 + 8 * c) = o;
        if (HILO) { float r[8];
#pragma unroll
            for (int q = 0; q < 8; ++q) r[q] = v[q] - bf2f(f2bf(v[q]));
            u32x4 o2; o2.x = pk2(r[0], r[1]); o2.y = pk2(r[2], r[3]); o2.z = pk2(r[4], r[5]); o2.w = pk2(r[6], r[7]);
            *(u32x4*)(WTlo + (size_t)(drow0 + n) * ldk + k0 + 8 * c) = o2; } }
    LDS_WAIT(); asm volatile("" ::: "memory");
}
__device__ __forceinline__ void conv_item8(const float* W, int ldw, unsigned char* WT, int ldk, int k0, int n0, int drow0, float scale, LAS float* scr, int lane) {
#pragma unroll 8
    for (int i = 0; i < 32; ++i) { const int kk = 2 * i + (lane >> 5); scr[kk * 33 + (lane & 31)] = W[(size_t)(k0 + kk) * ldw + n0 + (lane & 31)] * scale; }
    LDS_WAIT(); asm volatile("" ::: "memory");
    const int c = lane & 7;
#pragma unroll
    for (int j = 0; j < 4; ++j) { const int n = (lane >> 3) + 8 * j; const LAS float* s = scr + (8 * c) * 33 + n;
        float v[8];
#pragma unroll
        for (int q = 0; q < 8; ++q) v[q] = s[q * 33];
        u32x2 o; o.x = pk4_fp8(v[0], v[1], v[2], v[3]); o.y = pk4_fp8(v[4], v[5], v[6], v[7]);
        *(u32x2*)(WT + (size_t)(drow0 + n) * ldk + k0 + 8 * c) = o; }
    LDS_WAIT(); asm volatile("" ::: "memory");
}
__device__ __forceinline__ void phase_conv_mixers(const Frame& F, KP p) {
    LAS float* scr = (LAS float*)(F.lds + F.wave * 16384);
    const int gw = F.vcu * NWAVES + F.wave, NGW = F.G * NWAVES;
    constexpr int I_AIN = 16 * 288, I_AOUT = 16 * 32, I_RIN = 16 * 192, I_ROUT = 32 * 32, I_GLU = 16 * 64, I_RT = 16 * 2;
    constexpr int NITEMS = 2 * I_AIN + 2 * I_AOUT + I_RIN + I_ROUT + I_GLU + 4 * I_RT;
    unsigned char* ws = F.ws;
    for (int it = gw; it < NITEMS; it += NGW) {
        int r = it;
        if (r < 2 * I_AIN) { const int j = r / I_AIN; r %= I_AIN; const int kb = r / 288, nb = r % 288, n0 = nb * 32;
            conv_item8(gin(p, 1) + (size_t)j * D * ATT_IN, ATT_IN, (unsigned char*)(ws + WS_ATT_IN_T) + (size_t)j * ATT_IN * D, D, kb * 64, n0, n0, WUP_SCALE, scr, F.lane); continue; }
        r -= 2 * I_AIN;
        if (r < 2 * I_AOUT) { const int j = r / I_AOUT; r %= I_AOUT; const int kb = r / 32, nb = r % 32, n0 = nb * 32;
            conv_item<false>(gin(p, 2) + (size_t)j * D * D, D, (bf16*)(ws + WS_ATT_OUT_T) + (size_t)j * D * D, nullptr, D, kb * 64, n0, n0, 1.0f, scr, F.lane); continue; }
        r -= 2 * I_AOUT;
        if (r < I_RIN) { const int kb = r / 192, nb = r % 192, n0 = nb * 32;
            conv_item8(gin(p, 3), RET_IN, (unsigned char*)(ws + WS_RET_IN_T), D, kb * 64, n0, n0, WUP_SCALE, scr, F.lane); continue; }
        r -= I_RIN;
        if (r < I_ROUT) { const int kb = r / 32, nb = r % 32, n0 = nb * 32;
            conv_item<false>(gin(p, 6), D, (bf16*)(ws + WS_RET_OUT_T), nullptr, RET_V, kb * 64, n0, n0, 1.0f, scr, F.lane); continue; }
        r -= I_ROUT;
        if (r < I_GLU) { const int kb = r / 64, nb = r % 64, n0 = nb * 32; const int c = n0 & 1023, drow = (c >> 7) * 256 + (n0 >> 10) * 128 + (c & 127);
            conv_item<false>(gin(p, 15), 2 * D, (bf16*)(ws + WS_GLU_T), nullptr, D, kb * 64, n0, drow, 1.0f, scr, F.lane); continue; }
        r -= I_GLU;
        { const int l = r / I_RT; r %= I_RT; const int kb = r / 2, nb = r % 2, n0 = nb * 32;
            conv_item<true>(gin(p, 16) + (size_t)l * D * NE, NE, (bf16*)(ws + WS_RT_HI) + (size_t)l * NE * D, (bf16*)(ws + WS_RT_LO) + (size_t)l * NE * D, D, kb * 64, n0, n0, 1.0f, scr, F.lane); }
    }
}
__device__ __forceinline__ void phase_conv_moe(const Frame& F, KP p, int l) {
    LAS float* scr = (LAS float*)(F.lds + F.wave * 16384);
    const int gw = F.vcu * NWAVES + F.wave, NGW = F.G * NWAVES;
    for (int it = gw; it < 65 * 384; it += NGW) {
        const int e = it / 384, r = it % 384, which = r >> 7, rr = r & 127;
        bf16* We = (bf16*)(F.ws + WS_WMOE + (size_t)e * WMOE_E_BYTES);
        if (which < 2) { const float* src = (e < 64) ? gin(p, 18 + which) + ((size_t)l * NE + e) * D * ED : gin(p, 21 + which) + (size_t)l * D * ED;
            const int kb = rr >> 3, nb = rr & 7, n0 = nb * 32; const int drow = (n0 >> 7) * 256 + which * 128 + (n0 & 127);
            conv_item8(src, ED, (unsigned char*)We, D, kb * 64, n0, drow, WUP_SCALE, scr, F.lane);
        } else { const float* src = (e < 64) ? gin(p, 20) + ((size_t)l * NE + e) * ED * D : gin(p, 23) + (size_t)l * ED * D;
            const int kb = rr >> 5, nb = rr & 31, n0 = nb * 32;
            conv_item<false>(src, D, We + 512 * 1024, nullptr, ED, kb * 64, n0, n0, 1.0f, scr, F.lane); }
    }
}

__device__ __forceinline__ void phase_lnr(const Frame& F, KP p, int layer, bool dry = false) {
    const bf16* Y = (const bf16*)(F.ws + WS_Y); bf16* XB = (bf16*)(F.ws + WS_XB); unsigned char* XB8 = (unsigned char*)(F.ws + WS_X);
    const float* lng = gin(p, 24) + (size_t)(layer * 2) * D; const float* lnb = gin(p, 25) + (size_t)(layer * 2) * D;
    const bf16* rthi = (const bf16*)(F.ws + WS_RT_HI) + (size_t)layer * NE * D; const bf16* rtlo = (const bf16*)(F.ws + WS_RT_LO) + (size_t)layer * NE * D;
    const float* rbias = gin(p, 17) + layer * NE;
    unsigned* cnt = (unsigned*)(F.ws + WS_CTL) + CW_CNT + layer * NE * 64;
    int* lists = (int*)(F.ws + WS_LIST); int* tokmap = (int*)(F.ws + WS_LIST + 4 * MiB); float* tokgate = (float*)(F.ws + WS_LIST + 5 * MiB);
    constexpr int XLD = 1032, MAXT = 8;
    LAS bf16* Xhi = (LAS bf16*)F.lds; LAS bf16* Xlo = Xhi + 16 * XLD;
    LAS float* part = (LAS float*)(F.lds + 2 * 16 * XLD * 2);
    LAS int* ent = (LAS int*)(part + 2 * 16 * 64);
    LAS int* hist = ent + MAXT * 16 * 8 * 2; LAS int* base = hist + 64;
    const int lane = F.lane, w = F.wave, g4 = lane >> 4, l15 = lane & 15;
    if (F.tid < 64) hist[F.tid] = 0;
    bf16x8 bhi[16], blo[16];
    { const int nt = w & 3, kh = w >> 2; const bf16* bh = rthi + (size_t)(16 * nt + l15) * D + 512 * kh + 8 * g4; const bf16* bl = rtlo + (size_t)(16 * nt + l15) * D + 512 * kh + 8 * g4;
#pragma unroll
        for (int ks = 0; ks < 16; ++ks) { bhi[ks] = *(const bf16x8*)(bh + 32 * ks); blo[ks] = *(const bf16x8*)(bl + 32 * ks); } }
    u32x4 ypre[2][2];
    if (F.vcu < T / 16) {
#pragma unroll
        for (int rr = 0; rr < 2; ++rr)
#pragma unroll
            for (int j = 0; j < 2; ++j) ypre[rr][j] = *(const u32x4*)(Y + (size_t)(F.vcu * 16 + 2 * w + rr) * D + 8 * lane + 512 * j); }
    int ntile = 0;
    for (int tile = F.vcu; tile < T / 16 && ntile < MAXT; tile += F.G, ++ntile) {
        const int t0 = tile * 16;
        u32x4 ycur[2][2];
#pragma unroll
        for (int rr = 0; rr < 2; ++rr)
#pragma unroll
            for (int j = 0; j < 2; ++j) ycur[rr][j] = ypre[rr][j];
        if (tile + F.G < T / 16) {
#pragma unroll
            for (int rr = 0; rr < 2; ++rr)
#pragma unroll
                for (int j = 0; j < 2; ++j) ypre[rr][j] = *(const u32x4*)(Y + (size_t)((tile + F.G) * 16 + 2 * w + rr) * D + 8 * lane + 512 * j); }
#pragma unroll
        for (int rr = 0; rr < 2; ++rr) {
            const int lr = 2 * w + rr; const size_t row = (size_t)(t0 + lr);
            f32x4 v[4]; float s = 0.f;
#pragma unroll
            for (int j = 0; j < 2; ++j) unpack_bf16x8(ycur[rr][j], v[2 * j], v[2 * j + 1]);
#pragma unroll
            for (int j = 0; j < 4; ++j) s += (v[j][0] + v[j][1]) + (v[j][2] + v[j][3]);
            const float mean = wave_sum(s, lane) * (1.f / D); float s2 = 0.f;
#pragma unroll
            for (int j = 0; j < 4; ++j) { v[j] = v[j] - mean; s2 += (v[j][0] * v[j][0] + v[j][1] * v[j][1]) + (v[j][2] * v[j][2] + v[j][3] * v[j][3]); }
            const float rstd = 1.0f / sqrtf(wave_sum(s2, lane) * (1.f / D) + LN_EPS);
#pragma unroll
            for (int j = 0; j < 2; ++j) { const f32x4 g0 = *(const f32x4*)(lng + 8 * lane + 512 * j), g1 = *(const f32x4*)(lng + 8 * lane + 512 * j + 4), b0 = *(const f32x4*)(lnb + 8 * lane + 512 * j), b1 = *(const f32x4*)(lnb + 8 * lane + 512 * j + 4);
                const f32x4 o0 = v[2 * j] * rstd * g0 + b0, o1 = v[2 * j + 1] * rstd * g1 + b1;
                const u32x4 hi = pack_bf16x8(o0, o1);
                *(u32x4*)(XB + row * D + 8 * lane + 512 * j) = hi;
                { u32x2 q8; q8.x = pk4_fp8(o0[0], o0[1], o0[2], o0[3]); q8.y = pk4_fp8(o1[0], o1[1], o1[2], o1[3]); *(u32x2*)(XB8 + row * D + 8 * lane + 512 * j) = q8; }
                f32x4 h0, h1; unpack_bf16x8(hi, h0, h1); const u32x4 lo = pack_bf16x8(o0 - h0, o1 - h1);
                *(LAS u32x4*)(Xhi + lr * XLD + 8 * lane + 512 * j) = hi; *(LAS u32x4*)(Xlo + lr * XLD + 8 * lane + 512 * j) = lo; }
        }
        __syncthreads();
        { const int nt = w & 3, kh = w >> 2; f32x4 a0 = (f32x4){0.f, 0.f, 0.f, 0.f}, a1 = a0, a2 = a0, a3 = a0, a4 = a0, a5 = a0;
#pragma unroll
            for (int ks = 0; ks < 16; ks += 2) { const int k0 = 512 * kh + 32 * ks;
                const bf16x8 ahi = row_frag(Xhi, XLD, 0, k0, lane), alo = row_frag(Xlo, XLD, 0, k0, lane), bhi2 = row_frag(Xhi, XLD, 0, k0 + 32, lane), blo2 = row_frag(Xlo, XLD, 0, k0 + 32, lane);
                a0 = MFMA16(ahi, bhi[ks], a0); a1 = MFMA16(alo, bhi[ks], a1); a2 = MFMA16(ahi, blo[ks], a2);
                a3 = MFMA16(bhi2, bhi[ks + 1], a3); a4 = MFMA16(blo2, bhi[ks + 1], a4); a5 = MFMA16(bhi2, blo[ks + 1], a5); }
            const f32x4 acc = ((a0 + a3) + (a1 + a4)) + (a2 + a5);
#pragma unroll
            for (int i = 0; i < 4; ++i) part[(kh * 16 + 4 * g4 + i) * 64 + 16 * nt + l15] = acc[i];
        }
        __syncthreads();
#pragma unroll
        for (int rr = 0; rr < 2; ++rr) {
            const int lt = ntile * 16 + 2 * w + rr;
            const float lg = part[(2 * w + rr) * 64 + lane] + part[(16 + 2 * w + rr) * 64 + lane];
            float sc = 1.0f / (1.0f + expf(-lg)); sc = (sc == sc) ? sc : 0.5f;
            const float sel = sc + rbias[lane];
            const float m1 = max8(sel);
            const unsigned long long eq = __ballot(sel == m1);
            const unsigned gm = (unsigned)(eq >> (lane & 56)) & 0xffu;
            const int first = (lane & 56) + __builtin_ctz(gm | 0x100u);
            const float m2 = max8((lane == first) ? -INFINITY : sel);
            const float gs = m1 + m2; const int mygrp = lane >> 3; int grank = 0;
#pragma unroll
            for (int gg = 0; gg < 8; ++gg) { const float o = rdl(gs, 8 * gg); grank += (o > gs || (o == gs && gg < mygrp)) ? 1 : 0; }
            const float mv = (grank < 4) ? sel : -INFINITY;
            unsigned key = __builtin_bit_cast(unsigned, mv); key = (key >> 31) ? ~key : (key | 0x80000000u); key = (key & ~63u) | (unsigned)(63 - lane);
            int r0 = 0, r1 = 0, r2 = 0, r3 = 0;
#pragma unroll
            for (int e2 = 0; e2 < 64; e2 += 4) { r0 += ((unsigned)__builtin_amdgcn_readlane((int)key, e2) > key) ? 1 : 0; r1 += ((unsigned)__builtin_amdgcn_readlane((int)key, e2 + 1) > key) ? 1 : 0;
                r2 += ((unsigned)__builtin_amdgcn_readlane((int)key, e2 + 2) > key) ? 1 : 0; r3 += ((unsigned)__builtin_amdgcn_readlane((int)key, e2 + 3) > key) ? 1 : 0; }
            const int rank = (r0 + r1) + (r2 + r3);
            const bool chosen = rank < TOPK;
            const float wsum = wave_sum(chosen ? sc : 0.f, lane);
            if (chosen) { const int lpos = __hip_atomic_fetch_add(hist + lane, 1, __ATOMIC_RELAXED, __HIP_MEMORY_SCOPE_WORKGROUP);
                ent[(lt * 8 + rank) * 2] = (lane << 16) | lpos; ent[(lt * 8 + rank) * 2 + 1] = __builtin_bit_cast(int, sc / wsum * 2.5f); }
        }
    }
    __syncthreads();
    if (dry) return;
    if (F.tid < 64) { const int hcount = hist[F.tid]; base[F.tid] = hcount ? (int)atomicAdd(cnt + F.tid * 64, (unsigned)hcount) : 0; }
    __syncthreads();
    for (int idx = F.tid; idx < ntile * 16 * 8; idx += NTHREADS) {
        const int ev = ent[idx * 2], gb = ent[idx * 2 + 1]; const int e = ev >> 16, pos = base[e] + (ev & 0xffff);
        const int lt = idx >> 3, rank = idx & 7, tok = (F.vcu + (lt >> 4) * F.G) * 16 + (lt & 15);
        lists[(size_t)e * T + pos] = tok; tokmap[tok * 8 + rank] = (e << 16) | pos; tokgate[tok * 8 + rank] = __builtin_bit_cast(float, gb);
    }
}

__device__ __forceinline__ void phase_combine(const Frame& F, KP p, int layer, bool dry = false) {
    bf16* XB = (bf16*)(F.ws + WS_XB); const unsigned char* yexp = (const unsigned char*)(F.ws + WS_BIG);
    const int* tokmap = (const int*)(F.ws + WS_LIST + 4 * MiB); const float* tokgate = (const float*)(F.ws + WS_LIST + 5 * MiB);
    const volatile LAS int* tstart = (const volatile LAS int*)(F.MISC + 64);
    const float* lng = gin(p, 24) + (size_t)(layer * 2 + 1) * D; const float* lnb = gin(p, 25) + (size_t)(layer * 2 + 1) * D;
    float* outp = gout(p); bf16* xbo = XB; if (dry) { outp = (float*)(F.ws + WS_AUX); xbo = (bf16*)(F.ws + WS_H); }
    const int lane = F.lane, gw = F.vcu * NWAVES + F.wave, NGW = F.G * NWAVES;
    const bf16* ysh = (const bf16*)(F.ws + WS_Y);
    f32x4 gv[4], bv[4];
#pragma unroll
    for (int j = 0; j < 4; ++j) { gv[j] = *(const f32x4*)(lng + 16 * lane + 4 * j); bv[j] = *(const f32x4*)(lnb + 16 * lane + 4 * j); }
    for (int row = gw; row < T; row += NGW) {
        const int mk = tokmap[row * 8 + (lane & 7)]; const float gk = tokgate[row * 8 + (lane & 7)] * YEXP_INV;
        const int rk = (int)tstart[mk >> 16] * 256 + (mk & 0xffff);
        f32x4 v[4];
#pragma unroll
        for (int j = 0; j < 2; ++j) { const u32x4 xw = *(const u32x4*)(ysh + (size_t)row * D + 16 * lane + 8 * j); unpack_bf16x8(xw, v[2 * j], v[2 * j + 1]); }
#pragma unroll
        for (int k = 0; k < TOPK; ++k) { const int r = __builtin_amdgcn_readlane(rk, k); const float g = rdl(gk, k);
            const u32x4 s = *(const u32x4*)(yexp + (size_t)r * D + 16 * lane);
#pragma unroll
            for (int j = 0; j < 4; ++j) { const f32x2 lo = __builtin_amdgcn_cvt_pk_f32_fp8((int)s[j], false), hi = __builtin_amdgcn_cvt_pk_f32_fp8((int)s[j], true);
                v[j][0] += g * lo[0]; v[j][1] += g * lo[1]; v[j][2] += g * hi[0]; v[j][3] += g * hi[1]; } }
        float s = 0.f;
#pragma unroll
        for (int j = 0; j < 4; ++j) s += (v[j][0] + v[j][1]) + (v[j][2] + v[j][3]);
        const float mean = wave_sum(s, lane) * (1.f / D); float s2 = 0.f;
#pragma unroll
        for (int j = 0; j < 4; ++j) { v[j] = v[j] - mean; s2 += (v[j][0] * v[j][0] + v[j][1] * v[j][1]) + (v[j][2] * v[j][2] + v[j][3] * v[j][3]); }
        const float rstd = 1.0f / sqrtf(wave_sum(s2, lane) * (1.f / D) + LN_EPS);
        f32x4 o[4];
#pragma unroll
        for (int j = 0; j < 4; ++j) o[j] = v[j] * rstd * gv[j] + bv[j];
        if (layer == DEPTH - 1 || dry) {
#pragma unroll
            for (int j = 0; j < 4; ++j) *(f32x4*)(outp + (size_t)row * D + 16 * lane + 4 * j) = o[j]; }
        if (layer != DEPTH - 1) { *(u32x4*)(xbo + (size_t)row * D + 16 * lane) = pack_bf16x8(o[0], o[1]); *(u32x4*)(xbo + (size_t)row * D + 16 * lane + 8) = pack_bf16x8(o[2], o[3]);
            if (!dry) { u32x4 q8; q8.x = pk4_fp8(o[0][0], o[0][1], o[0][2], o[0][3]); q8.y = pk4_fp8(o[1][0], o[1][1], o[1][2], o[1][3]); q8.z = pk4_fp8(o[2][0], o[2][1], o[2][2], o[2][3]); q8.w = pk4_fp8(o[3][0], o[3][1], o[3][2], o[3][3]);
                *(u32x4*)((unsigned char*)(F.ws + WS_X) + (size_t)row * D + 16 * lane) = q8; } }
    }
}

constexpr size_t AUX_OB = 96 * MiB, AUX_LSE = 128 * MiB;
__device__ __forceinline__ void phase_attn(const Frame& F, int bx) {
    const bf16* qkv = (const bf16*)(F.ws + WS_BIG); bf16* og = (bf16*)(F.ws + WS_AUX); float* lse = (float*)(F.ws + WS_AUX + AUX_LSE);
    constexpr int KLD = 136;
    LAS bf16* Ks = (LAS bf16*)F.lds; LAS bf16* Vs = Ks + 256 * KLD;
    const int lane = F.lane, w = F.wave, g4 = lane >> 4, l15 = lane & 15, qq = l15 >> 2, pp = lane & 3;
    u32x4 kc[4], vc[4];
    constexpr int NRUN = 768;
#define ATT_LOADBLK(KR, VR, nblk) do { _Pragma("unroll") for (int it = 0; it < 4; ++it) { const int idx = F.tid + 512 * it, c = idx >> 4, ch = idx & 15; int pos = 128 * (nblk) + c; pos = pos < 0 ? 0 : pos; \
            const unsigned so = (rowbase + (unsigned)pos * (unsigned)d + (unsigned)r) * (unsigned)ATT_IN + (unsigned)(g * 3072 + 1024 + h * 128 + ch * 8); KR[it] = *(const u32x4*)(qkv + so); VR[it] = *(const u32x4*)(qkv + so + 1024u); } } while (0)
#define ATT_STOREBLK(KR, VR, slot) do { _Pragma("unroll") for (int it = 0; it < 4; ++it) { const int idx = F.tid + 512 * it, c = idx >> 4, ch = idx & 15; \
            *(LAS u32x4*)(Ks + (128 * (slot) + c) * KLD + ch * 8) = KR[it]; *(LAS u32x4*)(Vs + (128 * (slot) + c) * KLD + ch * 8) = VR[it]; } } while (0)
    for (int R = bx; R < NRUN; R += F.G) {
        const int h = R & 7, sbr = R >> 3, g = sbr >> 5, rem = sbr & 31, b = rem >> 4, rr_ = rem & 15;
        const int dsh = 2 * g, d = 1 << dsh, nrs = 4 - dsh, r = rr_ >> nrs, n0 = 4 * (rr_ & ((1 << nrs) - 1)); const unsigned rowbase = (unsigned)b * SEQ;
        ATT_LOADBLK(kc, vc, n0 - 1); ATT_STOREBLK(kc, vc, (n0 - 1) & 1); ATT_LOADBLK(kc, vc, n0);
#pragma unroll 1
        for (int j = 0; j < 4; ++j) {
            const int n = n0 + j, cs = n & 1, ps = cs ^ 1;
            ATT_STOREBLK(kc, vc, cs);
            const int qi = 16 * w + l15; const unsigned qrow = rowbase + (unsigned)(128 * n + qi) * (unsigned)d + (unsigned)r;
            bf16x8 qf[4];
#pragma unroll
            for (int s = 0; s < 4; ++s) qf[s] = *(const bf16x8*)(qkv + (qrow * (unsigned)ATT_IN + (unsigned)(g * 3072 + h * 128 + 32 * s + 8 * g4)));
            __syncthreads();
            if (j < 3) { ATT_LOADBLK(kc, vc, n + 1); }
            __builtin_amdgcn_sched_barrier(0);
            const int ws0 = (16 * w < 96) ? 16 * w : 96;
#define ATT_PROW(c0) (((c0) < 128) ? (128 * ps + (c0)) : (128 * cs + (c0) - 128))
            f32x4 sacc[10];
            {
                bf16x8 kfa[4], kfb[4];
#pragma unroll
                for (int s = 0; s < 4; ++s) kfa[s] = row_frag(Ks, KLD, ATT_PROW(ws0), 32 * s, lane);
#pragma unroll
                for (int t = 0; t < 10; t += 2) {
#pragma unroll
                    for (int s = 0; s < 4; ++s) kfb[s] = row_frag(Ks, KLD, ATT_PROW(ws0 + 16 * (t + 1)), 32 * s, lane);
                    __builtin_amdgcn_sched_barrier(0);
                    sacc[t] = (f32x4){0.f, 0.f, 0.f, 0.f};
#pragma unroll
                    for (int s = 0; s < 4; ++s) sacc[t] = MFMA16(kfa[s], qf[s], sacc[t]);
                    if (t + 2 < 10) {
#pragma unroll
                        for (int s = 0; s < 4; ++s) kfa[s] = row_frag(Ks, KLD, ATT_PROW(ws0 + 16 * (t + 2)), 32 * s, lane); }
                    __builtin_amdgcn_sched_barrier(0);
                    sacc[t + 1] = (f32x4){0.f, 0.f, 0.f, 0.f};
#pragma unroll
                    for (int s = 0; s < 4; ++s) sacc[t + 1] = MFMA16(kfb[s], qf[s], sacc[t + 1]);
                }
            }
            const float slope = exp2f(-(float)(h + 1)) * (float)d;
            float mx = -INFINITY;
#pragma unroll
            for (int t = 0; t < 10; ++t)
#pragma unroll
                for (int i = 0; i < 4; ++i) { const int c = ws0 + 16 * t + 4 * g4 + i, step = 128 + qi - c;
                    const bool valid = (step >= 0) && (step <= 128) && (n > 0 || c >= 128);
                    const float v = valid ? sacc[t][i] - slope * (float)step : -INFINITY; sacc[t][i] = v; mx = fmaxf(mx, v); }
            mx = fmaxf(mx, shx(mx, 16, lane)); mx = fmaxf(mx, shx(mx, 32, lane));
            float lsum = 0.f;
#pragma unroll
            for (int t = 0; t < 10; ++t)
#pragma unroll
                for (int i = 0; i < 4; ++i) { const float pv = __expf(sacc[t][i] - mx); sacc[t][i] = pv; lsum += pv; }
            lsum += shx(lsum, 16, lane); lsum += shx(lsum, 32, lane);
            bf16x8 pf[5];
#pragma unroll
            for (int kt = 0; kt < 5; ++kt) pf[kt] = pack8(sacc[2 * kt], sacc[2 * kt + 1]);
            f32x4 o[8];
            {
                const LAS bf16* vl = Vs + (4 * g4 + qq) * KLD + 32 * pp;
                bf16x4 va[10], vcc[10];
#pragma unroll
                for (int q = 0; q < 10; ++q) va[q] = tr4(vl + ATT_PROW(ws0 + 16 * q) * KLD);
#pragma unroll
                for (int et = 0; et < 8; et += 2) {
#pragma unroll
                    for (int q = 0; q < 10; ++q) vcc[q] = tr4(vl + ATT_PROW(ws0 + 16 * q) * KLD + 4 * (et + 1));
                    __builtin_amdgcn_sched_barrier(0);
                    o[et] = (f32x4){0.f, 0.f, 0.f, 0.f};
#pragma unroll
                    for (int kt = 0; kt < 5; ++kt) o[et] = MFMA16(cat8(va[2 * kt], va[2 * kt + 1]), pf[kt], o[et]);
                    if (et + 2 < 8) {
#pragma unroll
                        for (int q = 0; q < 10; ++q) va[q] = tr4(vl + ATT_PROW(ws0 + 16 * q) * KLD + 4 * (et + 2)); }
                    __builtin_amdgcn_sched_barrier(0);
                    o[et + 1] = (f32x4){0.f, 0.f, 0.f, 0.f};
#pragma unroll
                    for (int kt = 0; kt < 5; ++kt) o[et + 1] = MFMA16(cat8(vcc[2 * kt], vcc[2 * kt + 1]), pf[kt], o[et + 1]);
                }
            }
#undef ATT_PROW
            const float inv = 1.0f / lsum;
            bf16* orow = og + ((size_t)g * T + qrow) * D + h * 128 + 32 * g4;
#pragma unroll
            for (int e2 = 0; e2 < 4; ++e2) *(u32x4*)(orow + 8 * e2) = pack_bf16x8(o[2 * e2] * inv, o[2 * e2 + 1] * inv);
            if (g4 == 0) lse[((size_t)g * T + qrow) * AH + h] = mx + __logf(lsum);
            __syncthreads();
        }
    }
#undef ATT_LOADBLK
#undef ATT_STOREBLK
}
__device__ __forceinline__ void phase_attn_combine(const Frame& F) {
    const bf16* og = (const bf16*)(F.ws + WS_AUX); const float* lse = (const float*)(F.ws + WS_AUX + AUX_LSE); bf16* ob = (bf16*)(F.ws + WS_AUX + AUX_OB);
    const int lane = F.lane, gw = F.vcu * NWAVES + F.wave, NGW = F.G * NWAVES, h = lane >> 3;
    for (int row = gw; row < T; row += NGW) {
        const float l0 = lse[((size_t)0 * T + row) * AH + h], l1 = lse[((size_t)1 * T + row) * AH + h], l2 = lse[((size_t)2 * T + row) * AH + h];
        const float m = fmaxf(l0, fmaxf(l1, l2)); float w0 = __expf(l0 - m), w1 = __expf(l1 - m), w2 = __expf(l2 - m); const float inv = 1.0f / (w0 + w1 + w2); w0 *= inv; w1 *= inv; w2 *= inv;
        float a[16];
#pragma unroll
        for (int j = 0; j < 16; ++j) a[j] = 0.f;
#pragma unroll
        for (int g = 0; g < 3; ++g) { const float wg = (g == 0) ? w0 : (g == 1 ? w1 : w2);
#pragma unroll
            for (int q = 0; q < 2; ++q) { const u32x4 s = *(const u32x4*)(og + ((size_t)g * T + row) * D + 16 * lane + 8 * q);
                a[8 * q + 0] += wg * bflo(s.x); a[8 * q + 1] += wg * bfhi(s.x); a[8 * q + 2] += wg * bflo(s.y); a[8 * q + 3] += wg * bfhi(s.y);
                a[8 * q + 4] += wg * bflo(s.z); a[8 * q + 5] += wg * bfhi(s.z); a[8 * q + 6] += wg * bflo(s.w); a[8 * q + 7] += wg * bfhi(s.w); } }
#pragma unroll
        for (int q = 0; q < 2; ++q) { u32x4 o; o.x = pk2(a[8 * q], a[8 * q + 1]); o.y = pk2(a[8 * q + 2], a[8 * q + 3]); o.z = pk2(a[8 * q + 4], a[8 * q + 5]); o.w = pk2(a[8 * q + 6], a[8 * q + 7]);
            *(u32x4*)(ob + (size_t)row * D + 16 * lane + 8 * q) = o; }
    }
}

constexpr size_t BIG_YRET = 192 * MiB;
__device__ __forceinline__ void phase_ret_u(const Frame& F) {
    const bf16* proj = (const bf16*)(F.ws + WS_BIG); bf16* St = (bf16*)(F.ws + WS_AUX);
    constexpr int LD = 264;
    LAS bf16* Kt = (LAS bf16*)F.lds; LAS bf16* Vt = Kt + 128 * LD;
    const int lane = F.lane, w = F.wave, g4 = lane >> 4, l15 = lane & 15, qq = l15 >> 2, pp = lane & 3;
    for (int u = F.vcu; u < 1024; u += F.G) {
        const int eh = u & 1, h = (u >> 1) & 3, n = (u >> 3) & 63, b = u >> 9;
        const size_t row0 = (size_t)b * SEQ + (size_t)n * RC;
#pragma unroll 4
        for (int it = 0; it < 8; ++it) { const int idx = F.tid + 512 * it, j = idx >> 5, ch = idx & 31;
            const bf16* src = proj + (row0 + j) * RET_IN;
            const u32x4 kv = *(const u32x4*)(src + 1024 + h * 256 + ch * 8), vv = *(const u32x4*)(src + 2048 + h * 512 + eh * 256 + ch * 8);
            *(LAS u32x4*)(Kt + j * LD + ch * 8) = kv; *(LAS u32x4*)(Vt + j * LD + ch * 8) = vv; }
        __syncthreads();
        f32x4 acc[16][2];
#pragma unroll
        for (int mt = 0; mt < 16; ++mt) { acc[mt][0] = (f32x4){0.f, 0.f, 0.f, 0.f}; acc[mt][1] = (f32x4){0.f, 0.f, 0.f, 0.f}; }
#pragma unroll
        for (int ks = 0; ks < 4; ++ks) {
            bf16x8 bfr[2];
#pragma unroll
            for (int nt = 0; nt < 2; ++nt) { const LAS bf16* a0 = Vt + (32 * ks + 8 * g4 + qq) * LD + 32 * w + 16 * nt + 4 * pp; bfr[nt] = cat8(tr4(a0), tr4(a0 + 4 * LD)); }
#pragma unroll
            for (int mt = 0; mt < 16; ++mt) { const LAS bf16* a0 = Kt + (32 * ks + 8 * g4 + qq) * LD + 128 * (mt >> 3) + 32 * pp + 4 * (mt & 7);
                const bf16x8 afr = cat8(tr4(a0), tr4(a0 + 4 * LD));
                acc[mt][0] = MFMA16(afr, bfr[0], acc[mt][0]); acc[mt][1] = MFMA16(afr, bfr[1], acc[mt][1]); }
        }
        bf16* outb = St + ((size_t)((b * RH + h) * RNC + n)) * (RDV * RDK);
#pragma unroll
        for (int nt = 0; nt < 2; ++nt) { bf16* orow = outb + (size_t)(eh * 256 + 32 * w + 16 * nt + l15) * RDK + 32 * g4;
#pragma unroll
            for (int mh = 0; mh < 2; ++mh)
#pragma unroll
                for (int q = 0; q < 4; ++q) *(u32x4*)(orow + 128 * mh + 8 * q) = pack_bf16x8(acc[mh * 8 + 2 * q][nt], acc[mh * 8 + 2 * q + 1][nt]); }
        __syncthreads();
    }
}
__device__ __forceinline__ void phase_ret_scan(const Frame& F) {
    bf16* St = (bf16*)(F.ws + WS_AUX);
    for (int gt = F.vcu * NTHREADS + F.tid; gt < 8 * 16384; gt += F.G * NTHREADS) {
        const int bh = gt >> 14, chunk = gt & 16383, h = bh & 3;
        const float g128 = exp2f(128.0f * log2f(1.0f - exp2f(-5.0f - (float)h)));
        bf16* base = St + (size_t)bh * RNC * (RDV * RDK) + (size_t)chunk * 8;
        float c[8];
#pragma unroll
        for (int j = 0; j < 8; ++j) c[j] = 0.f;
#pragma unroll 8
        for (int n = 0; n < RNC; ++n) { bf16* pn = base + (size_t)n * (RDV * RDK); const u32x4 uv = *(const u32x4*)pn;
            u32x4 o; o.x = pk2(c[0], c[1]); o.y = pk2(c[2], c[3]); o.z = pk2(c[4], c[5]); o.w = pk2(c[6], c[7]); *(u32x4*)pn = o;
            c[0] = g128 * (c[0] + bflo(uv.x)); c[1] = g128 * (c[1] + bfhi(uv.x)); c[2] = g128 * (c[2] + bflo(uv.y)); c[3] = g128 * (c[3] + bfhi(uv.y));
            c[4] = g128 * (c[4] + bflo(uv.z)); c[5] = g128 * (c[5] + bfhi(uv.z)); c[6] = g128 * (c[6] + bflo(uv.w)); c[7] = g128 * (c[7] + bfhi(uv.w)); }
    }
}
__device__ __forceinline__ void phase_ret_out(const Frame& F, KP p) {
    const bf16* proj = (const bf16*)(F.ws + WS_BIG); const bf16* St = (const bf16*)(F.ws + WS_AUX); bf16* yret = (bf16*)(F.ws + WS_BIG + BIG_YRET);
    const float* gng = gin(p, 4); const float* gnb = gin(p, 5);
    constexpr int LD = 264, VLD = 136;
    LAS bf16* Rs = (LAS bf16*)F.lds; LAS bf16* Vs = Rs + 128 * LD;
    const int lane = F.lane, w = F.wave, g4 = lane >> 4, l15 = lane & 15, qq = l15 >> 2, pp = lane & 3;
    for (int u = F.vcu; u < 512; u += F.G) {
        const int h = u & 3, n = (u >> 2) & 63, b = u >> 8;
        const size_t row0 = (size_t)b * SEQ + (size_t)n * RC;
#pragma unroll 4
        for (int it = 0; it < 8; ++it) { const int idx = F.tid + 512 * it, j = idx >> 5, ch = idx & 31;
            *(LAS u32x4*)(Rs + j * LD + ch * 8) = *(const u32x4*)(proj + (row0 + j) * RET_IN + 1024 + h * 256 + ch * 8); }
        const int irow = 16 * w + l15; const size_t qrow = row0 + irow;
        bf16x8 qf[8];
#pragma unroll
        for (int s = 0; s < 8; ++s) qf[s] = *(const bf16x8*)(proj + qrow * RET_IN + h * 256 + 32 * s + 8 * g4);
        __syncthreads();
        bf16x8 pf[4];
        { f32x4 sacc[8];
#pragma unroll
            for (int jt = 0; jt < 8; ++jt) { sacc[jt] = (f32x4){0.f, 0.f, 0.f, 0.f};
                if (jt <= w) {
#pragma unroll
                    for (int s = 0; s < 8; ++s) sacc[jt] = MFMA16(row_frag(Rs, LD, 16 * jt, 32 * s, lane), qf[s], sacc[jt]);
#pragma unroll
                    for (int i = 0; i < 4; ++i) if (16 * jt + 4 * g4 + i > irow) sacc[jt][i] = 0.f; } }
#pragma unroll
            for (int kt = 0; kt < 4; ++kt) pf[kt] = pack8(sacc[2 * kt], sacc[2 * kt + 1]); }
        __syncthreads();
        f32x4 acc[4][8];
        const bf16* Sn = St + ((size_t)((b * RH + h) * RNC + n)) * (RDV * RDK);
#pragma unroll
        for (int sl = 0; sl < 4; ++sl) {
#pragma unroll 4
            for (int it = 0; it < 4; ++it) { const int idx = F.tid + 512 * it, j = idx >> 4, ch = idx & 15;
                *(LAS u32x4*)(Vs + j * VLD + ch * 8) = *(const u32x4*)(proj + (row0 + j) * RET_IN + 2048 + h * 512 + sl * 128 + ch * 8); }
#pragma unroll 4
            for (int it = 0; it < 8; ++it) { const int idx = F.tid + 512 * it, e = idx >> 5, ch = idx & 31;
                *(LAS u32x4*)(Rs + e * LD + ch * 8) = *(const u32x4*)(Sn + (size_t)(sl * 128 + e) * RDK + ch * 8); }
            __syncthreads();
#pragma unroll
            for (int et = 0; et < 8; ++et) { f32x4 a = (f32x4){0.f, 0.f, 0.f, 0.f};
#pragma unroll
                for (int kt = 0; kt < 4; ++kt) if (2 * kt <= w) { const LAS bf16* a0 = Vs + (32 * kt + 4 * g4 + qq) * VLD + 32 * pp + 4 * et;
                    a = MFMA16(cat8(tr4(a0), tr4(a0 + 16 * VLD)), pf[kt], a); }
                const LAS bf16* srow = Rs + (32 * qq + 4 * et + pp) * LD + 8 * g4;
#pragma unroll
                for (int s = 0; s < 8; ++s) a = MFMA16(*(const LAS bf16x8*)(srow + 32 * s), qf[s], a);
                acc[sl][et] = a; }
            __syncthreads();
        }
        float s = 0.f;
#pragma unroll
        for (int sl = 0; sl < 4; ++sl)
#pragma unroll
            for (int et = 0; et < 8; ++et) s += (acc[sl][et][0] + acc[sl][et][1]) + (acc[sl][et][2] + acc[sl][et][3]);
        s += shx(s, 16, lane); s += shx(s, 32, lane);
        const float mean = s * (1.0f / RDV); float s2 = 0.f;
#pragma unroll
        for (int sl = 0; sl < 4; ++sl)
#pragma unroll
            for (int et = 0; et < 8; ++et) { acc[sl][et] = acc[sl][et] - mean; s2 += (acc[sl][et][0] * acc[sl][et][0] + acc[sl][et][1] * acc[sl][et][1]) + (acc[sl][et][2] * acc[sl][et][2] + acc[sl][et][3] * acc[sl][et][3]); }
        s2 += shx(s2, 16, lane); s2 += shx(s2, 32, lane);
        const float rstd = 1.0f / sqrtf(s2 * (1.0f / RDV) + LN_EPS);
#pragma unroll
        for (int sl = 0; sl < 4; ++sl) { const int c0 = h * RDV + sl * 128 + 32 * g4;
#pragma unroll
            for (int q = 0; q < 4; ++q) { const u32x4 gw = *(const u32x4*)(proj + qrow * RET_IN + 4096 + c0 + 8 * q);
                const f32x4 gg0 = *(const f32x4*)(gng + c0 + 8 * q), gg1 = *(const f32x4*)(gng + c0 + 8 * q + 4), gb0 = *(const f32x4*)(gnb + c0 + 8 * q), gb1 = *(const f32x4*)(gnb + c0 + 8 * q + 4);
                f32x4 y0 = acc[sl][2 * q] * rstd * gg0 + gb0, y1 = acc[sl][2 * q + 1] * rstd * gg1 + gb1;
                const float gv[8] = {bflo(gw.x), bfhi(gw.x), bflo(gw.y), bfhi(gw.y), bflo(gw.z), bfhi(gw.z), bflo(gw.w), bfhi(gw.w)};
#pragma unroll
                for (int j = 0; j < 4; ++j) { y0[j] *= gv[j] * fsig(gv[j]); y1[j] *= gv[4 + j] * fsig(gv[4 + j]); }
                *(u32x4*)(yret + qrow * RET_V + c0 + 8 * q) = pack_bf16x8(y0, y1); } }
    }
}

constexpr size_t AUX_S5E = 64 * MiB;
constexpr int S5L = 256, S5NC = SEQ / S5L;
__device__ __forceinline__ void cmul_add(float& rr, float& ri, float ar, float ai, float xr, float xi, float cr, float ci) { rr = ar * xr - ai * xi + cr; ri = ar * xi + ai * xr + ci; }
template <bool OUT>
__device__ __forceinline__ void phase_s5_scan(const Frame& F, KP p) {
    const bf16* X = (const bf16*)(F.ws + WS_XB); float* E = (float*)(F.ws + WS_AUX + AUX_S5E); bf16* ybuf = (bf16*)(F.ws + WS_AUX);
    const int lane = F.lane, w = F.wave, g4 = lane >> 4, l15 = lane & 15;
    LAS bf16* ut = (LAS bf16*)(F.lds + w * 12288);
    LAS bf16* Hb = (LAS bf16*)(F.lds + w * 12288 + 4096);
    constexpr int HLD = 136;
    const int gw = F.vcu * NWAVES + w, NGW = F.G * NWAVES;
    const int up16 = (lane - 16) << 2, up32 = (lane - 32) << 2, last16 = (48 + l15) << 2;
    for (int unit = gw; unit < BATCH * SG * S5NC; unit += NGW) {
        const int n = unit & (S5NC - 1), g = (unit >> 5) & 63, b = unit >> 11;
        float a1r[4], a1i[4], a4r[4], a4i[4], a8r[4], a8i[4], pwr[4], pwi[4];
        bf16x8 bfrag[8];
        const float dt = expf(gin(p, 14)[g]);
#pragma unroll
        for (int st = 0; st < 4; ++st) { const int ps = 16 * st + l15;
            const float are = gin(p, 7)[g * SP + ps], aim = gin(p, 8)[g * SP + ps];
            const float mag = expf(dt * are); const float abr = mag * cosf(dt * aim), abi = mag * sinf(dt * aim);
            const float den = are * are + aim * aim;
            const float fre = ((abr - 1.0f) * are + abi * aim) / den, fim = (abi * are - (abr - 1.0f) * aim) / den;
            a1r[st] = abr; a1i[st] = abi; { float t2r, t2i; cmul_add(t2r, t2i, abr, abi, abr, abi, 0.f, 0.f); cmul_add(a4r[st], a4i[st], t2r, t2i, t2r, t2i, 0.f, 0.f); }
            cmul_add(a8r[st], a8i[st], a4r[st], a4i[st], a4r[st], a4i[st], 0.f, 0.f);
            float qr = 1.f, qi = 0.f;
            if (g4 & 1) { qr = a4r[st]; qi = a4i[st]; }
            if (g4 & 2) { float tr, ti; cmul_add(tr, ti, qr, qi, a8r[st], a8i[st], 0.f, 0.f); qr = tr; qi = ti; }
            pwr[st] = qr; pwi[st] = qi;
            const float* br = gin(p, 9) + ((size_t)g * SP + ps) * SGC + 8 * (g4 & 1); const float* bi = gin(p, 10) + ((size_t)g * SP + ps) * SGC + 8 * (g4 & 1);
            const f32x4 r0 = *(const f32x4*)br, r1 = *(const f32x4*)(br + 4), i0 = *(const f32x4*)bi, i1 = *(const f32x4*)(bi + 4);
            const float z = (g4 < 2) ? 1.0f : 0.0f; const float fr2 = fre * z, fi2 = fim * z;
            bfrag[st] = pack8(r0 * fr2 - i0 * fi2, r1 * fr2 - i1 * fi2); bfrag[st + 4] = pack8(i0 * fr2 + r0 * fi2, i1 * fr2 + r1 * fi2);
        }
        float sr[4], si[4];
        float* Eu = E + ((size_t)(b * SG + g) * S5NC + n) * 128;
        bf16x8 cf[4]; f32x4 dsk = (f32x4){0.f, 0.f, 0.f, 0.f};
#pragma unroll
        for (int st = 0; st < 4; ++st) { sr[st] = 0.f; si[st] = 0.f; }
        if (OUT) {
#pragma unroll
            for (int st = 0; st < 4; ++st) { sr[st] = Eu[16 * st + l15]; si[st] = Eu[64 + 16 * st + l15]; }
#pragma unroll
            for (int s = 0; s < 4; ++s) { const float* cp = (s < 2 ? gin(p, 11) : gin(p, 12)) + ((size_t)g * SGC + l15) * SP + 32 * (s & 1) + 8 * g4; const float sg = s < 2 ? 1.0f : -1.0f;
                const f32x4 c0 = *(const f32x4*)cp * sg, c1 = *(const f32x4*)(cp + 4) * sg; cf[s] = pack8(c0, c1); }
            dsk = *(const f32x4*)(gin(p, 13) + g * SGC + 4 * g4); }
        const size_t tok0 = (size_t)b * SEQ + (size_t)n * S5L;
        u32x4 pre[2];
        { const bf16* src = X + (tok0 + lane) * D + g * SGC; pre[0] = *(const u32x4*)src; pre[1] = *(const u32x4*)(src + 8); }
        for (int sub = 0; sub < S5L / 64; ++sub) {
            *(LAS u32x4*)(ut + lane * 16) = pre[0]; *(LAS u32x4*)(ut + lane * 16 + 8) = pre[1];
            if (sub + 1 < S5L / 64) { const bf16* src = X + (tok0 + (sub + 1) * 64 + lane) * D + g * SGC; pre[0] = *(const u32x4*)src; pre[1] = *(const u32x4*)(src + 8); }
            LDS_WAIT(); asm volatile("" ::: "memory");
#pragma unroll (OUT ? 1 : 4)
            for (int blk = 0; blk < 4; ++blk) {
                u32x4 uw = *(const LAS u32x4*)(ut + (blk * 16 + l15) * 16 + 8 * (g4 & 1));
                if (g4 >= 2) uw = (u32x4){0u, 0u, 0u, 0u};
                const bf16x8 ufr = __builtin_bit_cast(bf16x8, uw);
                f32x4 dr[4], di[4];
#pragma unroll
                for (int st = 0; st < 4; ++st) { dr[st] = MFMA16(ufr, bfrag[st], ((f32x4){0.f, 0.f, 0.f, 0.f})); di[st] = MFMA16(ufr, bfrag[st + 4], ((f32x4){0.f, 0.f, 0.f, 0.f})); }
                float vr[4], vi[4];
#pragma unroll
                for (int st = 0; st < 4; ++st) {
                    float hr = 0.f, hi = 0.f;
#pragma unroll
                    for (int i = 0; i < 4; ++i) { float nr, ni; cmul_add(nr, ni, a1r[st], a1i[st], hr, hi, dr[st][i], di[st][i]); hr = nr; hi = ni; dr[st][i] = hr; di[st][i] = hi; }
                    vr[st] = hr; vi[st] = hi; }
#define BPF(idx, v) __builtin_bit_cast(float, __builtin_amdgcn_ds_bpermute((idx), __builtin_bit_cast(int, (v))))
                { float xr[4], xi[4];
#pragma unroll
                  for (int st = 0; st < 4; ++st) { xr[st] = BPF(up16, vr[st]); xi[st] = BPF(up16, vi[st]); }
#pragma unroll
                  for (int st = 0; st < 4; ++st) { float tr, ti; cmul_add(tr, ti, a4r[st], a4i[st], xr[st], xi[st], vr[st], vi[st]); if (g4 >= 1) { vr[st] = tr; vi[st] = ti; } }
#pragma unroll
                  for (int st = 0; st < 4; ++st) { xr[st] = BPF(up32, vr[st]); xi[st] = BPF(up32, vi[st]); }
#pragma unroll
                  for (int st = 0; st < 4; ++st) { float tr, ti; cmul_add(tr, ti, a8r[st], a8i[st], xr[st], xi[st], vr[st], vi[st]); if (g4 >= 2) { vr[st] = tr; vi[st] = ti; } } }
                float er[4], ei[4], lr[4], li[4];
#pragma unroll
                for (int st = 0; st < 4; ++st) { if (OUT) { er[st] = BPF(up16, vr[st]); ei[st] = BPF(up16, vi[st]); } else { er[st] = 0.f; ei[st] = 0.f; } lr[st] = BPF(last16, vr[st]); li[st] = BPF(last16, vi[st]); }
#undef BPF
#pragma unroll
                for (int st = 0; st < 4; ++st) {
                    if (g4 == 0) { er[st] = 0.f; ei[st] = 0.f; }
                    if (OUT) { float s0r, s0i; cmul_add(s0r, s0i, pwr[st], pwi[st], sr[st], si[st], er[st], ei[st]);
#pragma unroll
                        for (int i = 0; i < 4; ++i) { float tr, ti; cmul_add(tr, ti, a1r[st], a1i[st], s0r, s0i, 0.f, 0.f); s0r = tr; s0i = ti; dr[st][i] += s0r; di[st][i] += s0i; } }
                    { float a16r, a16i; cmul_add(a16r, a16i, a8r[st], a8i[st], a8r[st], a8i[st], 0.f, 0.f); float tr, ti; cmul_add(tr, ti, a16r, a16i, sr[st], si[st], lr[st], li[st]); sr[st] = tr; si[st] = ti; }
                    if (OUT) {
#pragma unroll
                        for (int i = 0; i < 4; ++i) { const unsigned hw = pk2(dr[st][i], di[st][i]); Hb[(4 * g4 + i) * HLD + 16 * st + l15] = (bf16)hw; Hb[(4 * g4 + i) * HLD + 64 + 16 * st + l15] = (bf16)(hw >> 16); } }
                }
                if (OUT) {
                    LDS_WAIT(); asm volatile("" ::: "memory");
                    f32x4 ya = (f32x4){0.f, 0.f, 0.f, 0.f};
#pragma unroll
                    for (int s = 0; s < 4; ++s) ya = MFMA16(cf[s], row_frag(Hb, HLD, 0, 32 * s, lane), ya);
                    const u32x2 u2 = *(const LAS u32x2*)(ut + (blk * 16 + l15) * 16 + 4 * g4);
                    const f32x4 u4 = (f32x4){bflo(u2.x), bfhi(u2.x), bflo(u2.y), bfhi(u2.y)};
                    f32x4 y = ya + dsk * u4;
#pragma unroll
                    for (int j = 0; j < 4; ++j) { const float v = y[j]; y[j] = v * fsig(1.5957691216057308f * (v + 0.044715f * v * v * v)); }
                    u32x2 o; o.x = pk2(y[0], y[1]); o.y = pk2(y[2], y[3]);
                    *(u32x2*)(ybuf + (tok0 + sub * 64 + blk * 16 + l15) * D + g * SGC + 4 * g4) = o;
                    asm volatile("" ::: "memory"); }
            }
            LDS_WAIT(); asm volatile("" ::: "memory");
        }
        if (!OUT && g4 == 0) {
#pragma unroll
            for (int st = 0; st < 4; ++st) { Eu[16 * st + l15] = sr[st]; Eu[64 + 16 * st + l15] = si[st]; } }
    }
}
__device__ __forceinline__ void phase_s5_carry(const Frame& F, KP p) {
    float* E = (float*)(F.ws + WS_AUX + AUX_S5E);
    for (int gt = F.vcu * NTHREADS + F.tid; gt < BATCH * SG * SP; gt += F.G * NTHREADS) {
        const int pl = gt & 63, bg = gt >> 6, g = bg & 63;
        const float dt = expf(gin(p, 14)[g]); const float are = gin(p, 7)[g * SP + pl], aim = gin(p, 8)[g * SP + pl];
        const float mag = expf(dt * are); float ar = mag * cosf(dt * aim), ai = mag * sinf(dt * aim);
#pragma unroll
        for (int q = 0; q < 8; ++q) { const float nr = ar * ar - ai * ai, ni = 2.0f * ar * ai; ar = nr; ai = ni; }
        float cr = 0.f, ci = 0.f;
        for (int n = 0; n < S5NC; ++n) { float* Eu = E + ((size_t)bg * S5NC + n) * 128; const float er = Eu[pl], ei = Eu[64 + pl];
            Eu[pl] = cr; Eu[64 + pl] = ci;
            const float nr = ar * cr - ai * ci + er, ni = ar * ci + ai * cr + ei; cr = nr; ci = ni; }
    }
}

constexpr int NPHASES = 34;
#ifndef PROBE_DRY14
#define PROBE_DRY14 0
#endif
#ifndef PROBE_DRY17
#define PROBE_DRY17 0
#endif
#ifndef PH_MASK
#define PH_MASK 0xFFFFFFFFu
#endif
#define PHT(t) ((PH_MASK >> (t)) & 1u)
constexpr int PLAN_OFF = 64;
__device__ __forceinline__ void moe_plan(const Frame& F, int layer) {
    volatile LAS int* tstart = (volatile LAS int*)(F.MISC + PLAN_OFF); volatile LAS int* cnts = tstart + 72;
    __syncthreads();
    if (F.wave == 0) {
        const unsigned* cnt = (const unsigned*)(F.ws + WS_CTL) + CW_CNT + layer * NE * 64;
        const int c = (int)__hip_atomic_load(cnt + F.lane * 64, __ATOMIC_RELAXED, __HIP_MEMORY_SCOPE_AGENT);
        int v = (c + 255) >> 8;
#pragma unroll
        for (int o = 1; o < 64; o <<= 1) { const int nb = __builtin_amdgcn_ds_bpermute((F.lane - o) << 2, v); if (F.lane >= o) v += nb; }
        tstart[F.lane + 1] = v; cnts[F.lane] = c;
        if (F.lane == 0) tstart[0] = 0;
        if (F.lane == 63) { tstart[65] = v + T / 256; cnts[64] = T; }
    }
    __syncthreads();
}
template <bool GATH> struct MoeSched2 {
    static constexpr bool GATHER = GATH, UNIFORMIZE = true, FP8 = GATH;
    static constexpr int ncol = GATH ? 2 : 4, K = GATH ? D / 2 : ED;
    const volatile LAS int* tstart; const volatile LAS int* cnts; int ntiles, G, c, lane;
    const char* Abase; const char* Wbase; const int* lists;
    __device__ __forceinline__ bool next(int i, pg8::UnitG& u) const {
        const int nwg = ntiles * ncol; const long L = (long)i * G + c; if (L >= nwg) return false;
        int wgid = (int)L; { const int q = nwg / 8, r = nwg % 8, xcd = wgid % 8, off = wgid / 8; wgid = (xcd < r ? xcd * (q + 1) : r * (q + 1) + (xcd - r) * q) + off; }
        const int tile = wgid / ncol, pn = wgid % ncol;
        const int ta = tstart[lane], tb = tstart[lane + 1];
        const unsigned long long mm = __ballot(ta <= tile && tile < tb);
        const int e = mm ? (int)__builtin_ctzll(mm) : 64;
        const int ts = __builtin_amdgcn_readfirstlane((int)tstart[e]), ce = __builtin_amdgcn_readfirstlane((int)cnts[e]);
        const int lt = tile - ts; int valid = ce - lt * 256; valid = valid > 256 ? 256 : valid;
        u.gshift = 0; u.aux = e;
        if (GATH) {
            u.B = Wbase + (size_t)e * WMOE_E_BYTES + (size_t)pn * 256 * K * 2;
            if (e < 64) { u.A = Abase; u.gidx = lists + (size_t)e * T + lt * 256; u.gcnt = valid; }
            else { u.A = Abase + (size_t)lt * 256 * K * 2; u.gidx = nullptr; u.gcnt = 0; }
            u.row0 = tile * 256; u.col0 = pn * 128;
        } else {
            u.B = Wbase + (size_t)e * WMOE_E_BYTES + (size_t)512 * 1024 * 2 + (size_t)pn * 256 * K * 2;
            u.A = Abase + (size_t)tile * 256 * K * 2; u.gidx = nullptr; u.gcnt = valid;
            u.row0 = tile * 256; u.col0 = pn * 256;
        }
        return true;
    }
};
__device__ __forceinline__ void phase_load_x(const Frame& F, KP p) {
    const float* xin = gin(p, 0); bf16* XB = (bf16*)(F.ws + WS_XB);
    for (size_t i = (size_t)F.vcu * NTHREADS + F.tid; i < (size_t)T * D / 8; i += (size_t)F.G * NTHREADS) {
        const f32x4 a = *(const f32x4*)(xin + i * 8), b = *(const f32x4*)(xin + i * 8 + 4);
        *(u32x4*)(XB + i * 8) = pack_bf16x8(a, b);
        u32x2 q8; q8.x = pk4_fp8(a[0], a[1], a[2], a[3]); q8.y = pk4_fp8(b[0], b[1], b[2], b[3]); *(u32x2*)((unsigned char*)(F.ws + WS_X) + i * 8) = q8; }
}

__global__ void __launch_bounds__(NTHREADS, 2) fwd_kernel(Params p_unused) {
    KP p0 = (KP)__builtin_amdgcn_kernarg_segment_ptr();
    extern __shared__ __attribute__((aligned(16))) unsigned char lds_raw[];
    Frame F0;
    F0.lds = (LAS unsigned char*)lds_raw; F0.MISC = (volatile LAS unsigned*)(F0.lds + MISC_OFF);
    F0.tid = threadIdx.x; F0.lane = F0.tid & 63; F0.wave = __builtin_amdgcn_readfirstlane(F0.tid >> 6);
    F0.G = gridDim.x; { const int bq = blockIdx.x; F0.vcu = (F0.G % 8 == 0) ? (bq % 8) * (F0.G / 8) + bq / 8 : bq; }
    F0.ws = p0->ws;
    const int bx0 = blockIdx.x;
    for (int u = F0.tid; u < (LDS_BYTES - MISC_OFF) / 4; u += NTHREADS) ((LAS unsigned*)(F0.lds + MISC_OFF))[u] = 0u;
    __syncthreads();
    XcdBarrier bar; bar.bar = (unsigned*)(p0->ws + WS_CTL) + CW_BAR; bar.x = 0; bar.st = nullptr;
    const int use_bar = p0->use_bar;
    if (use_bar) bar = xcd_barrier_post((unsigned*)(p0->ws + WS_CTL) + CW_BAR, F0.MISC + 8);
    const int lo = p0->ph_lo, hi = p0->ph_hi;
#define PHASE_BEGIN Frame F = F0; KP p = p0; { unsigned ones_ = ~0u; asm volatile("" : "+s"(ones_)); F.lane = (int)__builtin_amdgcn_mbcnt_hi(ones_, __builtin_amdgcn_mbcnt_lo(ones_, 0u)); } asm volatile("" : "+v"(F.lane)); F.tid = F.wave * 64 + F.lane; asm volatile("" : "+v"(F.tid));   GAS unsigned char* wsg_ = (GAS unsigned char*)F0.ws; asm volatile("" : "+s"(F.wave), "+s"(F.vcu), "+s"(F.G), "+s"(wsg_), "+s"(p)); \
    F.ws = (unsigned char*)wsg_; int bx = bx0; asm volatile("" : "+s"(bx)); unsigned char* ws = F.ws; (void)ws; (void)bx;
#pragma unroll 1
    for (int ph = lo; ph < hi; ++ph) {
        int layer = 0, type = 0;
        if (ph > 0) { layer = ph >= 26 ? 3 : (ph >= 18 ? 2 : (ph >= 9 ? 1 : 0)); const int q = ph - (layer == 3 ? 26 : (layer == 2 ? 18 : (layer == 1 ? 9 : 1))); const int kind = layer % 3;
            if (kind == 0) type = q < 4 ? 1 + q : 14 + (q - 4); else if (kind == 1) type = q < 5 ? 5 + q : 14 + (q - 5); else type = q < 4 ? 10 + q : 14 + (q - 4); }
        const int j = layer / 3;
#ifdef REPEAT_MASK
        const int nrep = ((REPEAT_MASK >> type) & 1u) ? 2 : 1;
#else
        const int nrep = 1;
#endif
#pragma unroll 1
        for (int rep = 0; rep < nrep; ++rep) {
        if (rep > 0 && use_bar) xcd_barrier(bar);
        if (PHT(0) && type == 0) { PHASE_BEGIN; phase_conv_mixers(F, p); phase_conv_moe(F, p, 0); phase_load_x(F, p); }
        else if (PHT(1) && type == 1) { PHASE_BEGIN; DenseSched8 S; S.init(ws + WS_X, ws + WS_ATT_IN_T + (size_t)j * ATT_IN * D, T, ATT_IN, D / 2, F.G, bx); EpiStoreBf16 E{(bf16*)(ws + WS_BIG), ATT_IN, WUP_INV, 0.08838834764831845f};
            pg8::gemm_phase(F.lds, F.tid, D / 2, S, E); }
        else if (PHT(2) && type == 2) { PHASE_BEGIN; phase_attn(F, bx); }
        else if (PHT(3) && type == 3) { PHASE_BEGIN; phase_attn_combine(F); }
        else if (PHT(4) && type == 4) { PHASE_BEGIN; DenseSched S; S.init(ws + WS_AUX + AUX_OB, ws + WS_ATT_OUT_T + (size_t)j * D * D * 2, T, D, D, F.G, bx); EpiResid E{(const bf16*)(ws + WS_XB), (bf16*)(ws + WS_Y)};
            pg8::gemm_phase(F.lds, F.tid, D, S, E); }
        else if (PHT(5) && type == 5) { PHASE_BEGIN; DenseSched8 S; S.init(ws + WS_X, ws + WS_RET_IN_T, T, RET_IN, D / 2, F.G, bx); EpiRetIn E{(bf16*)(ws + WS_BIG), RET_IN};
            pg8::gemm_phase(F.lds, F.tid, D / 2, S, E); }
        else if (PHT(6) && type == 6) { PHASE_BEGIN; phase_ret_u(F); }
        else if (PHT(7) && type == 7) { PHASE_BEGIN; phase_ret_scan(F); }
        else if (PHT(8) && type == 8) { PHASE_BEGIN; phase_ret_out(F, p); }
        else if (PHT(9) && type == 9) { PHASE_BEGIN; DenseSched S; S.init(ws + WS_BIG + BIG_YRET, ws + WS_RET_OUT_T, T, D, RET_V, F.G, bx); EpiResid E{(const bf16*)(ws + WS_XB), (bf16*)(ws + WS_Y)};
            pg8::gemm_phase(F.lds, F.tid, RET_V, S, E); }
        else if (PHT(10) && type == 10) { PHASE_BEGIN; phase_s5_scan<false>(F, p); }
        else if (PHT(11) && type == 11) { PHASE_BEGIN; phase_s5_carry(F, p); }
        else if (PHT(12) && type == 12) { PHASE_BEGIN; phase_s5_scan<true>(F, p); }
        else if (PHT(13) && type == 13) { PHASE_BEGIN; DenseSched S; S.init(ws + WS_AUX, ws + WS_GLU_T, T, 2 * D, D, F.G, bx); EpiGluResid E{(const bf16*)(ws + WS_XB), (bf16*)(ws + WS_Y)};
            pg8::gemm_phase(F.lds, F.tid, D, S, E); }
        else if (PHT(14) && type == 14) { PHASE_BEGIN; phase_lnr(F, p, layer, PROBE_DRY14 && true); if (PROBE_DRY14) { if (use_bar) xcd_barrier(bar); phase_lnr(F, p, layer, false); } }
        else if (PHT(15) && type == 15) { PHASE_BEGIN; moe_plan(F, layer);
            MoeSched2<true> S; S.tstart = (const volatile LAS int*)(F.MISC + PLAN_OFF); S.cnts = S.tstart + 72; S.ntiles = __builtin_amdgcn_readfirstlane((int)S.tstart[65]); S.G = F.G; S.c = bx; S.lane = F.lane;
            S.Abase = (const char*)(ws + WS_X); S.Wbase = (const char*)(ws + WS_WMOE); S.lists = (const int*)(ws + WS_LIST);
            EpiMoeUp E{(bf16*)(ws + WS_H)};
            pg8::gemm_phase(F.lds, F.tid, D / 2, S, E); }
        else if (PHT(16) && type == 16) { PHASE_BEGIN; moe_plan(F, layer);
            { MoeSched2<false> S; S.tstart = (const volatile LAS int*)(F.MISC + PLAN_OFF); S.cnts = S.tstart + 72; S.ntiles = __builtin_amdgcn_readfirstlane((int)S.tstart[64]); S.G = F.G; S.c = bx; S.lane = F.lane;
              S.Abase = (const char*)(ws + WS_H); S.Wbase = (const char*)(ws + WS_WMOE); S.lists = (const int*)(ws + WS_LIST);
              EpiStoreFp8 E{(unsigned char*)(ws + WS_BIG), D};
              pg8::gemm_phase(F.lds, F.tid, ED, S, E); }
            { const int sh0 = __builtin_amdgcn_readfirstlane((int)((const volatile LAS int*)(F.MISC + PLAN_OFF))[64]);
              DenseSched S; S.init(ws + WS_H + (size_t)sh0 * 256 * ED * 2, ws + WS_WMOE + (size_t)64 * WMOE_E_BYTES + (size_t)512 * 1024 * 2, T, D, ED, F.G, bx); EpiResid E{(const bf16*)(ws + WS_XB), (bf16*)(ws + WS_Y)};
              pg8::gemm_phase(F.lds, F.tid, ED, S, E); } }
        else if (PHT(17) && type == 17) { PHASE_BEGIN; moe_plan(F, layer); if (PROBE_DRY17) { phase_combine(F, p, layer, true); if (use_bar) xcd_barrier(bar); } phase_combine(F, p, layer); if (layer + 1 < DEPTH) phase_conv_moe(F, p, layer + 1); }
        }
        if (use_bar && ph + 1 < hi) xcd_barrier(bar);
    }
}

#ifndef MK_PER_PHASE
#define MK_PER_PHASE 0
#endif
extern "C" void kernel_launch(void* const* d_in, const int* in_sizes, int n_in, void* d_out, int out_size, void* d_ws, size_t ws_size, hipStream_t stream) {
    static int grid = 0;
    if (grid == 0) {
        if (n_in != 26 || in_sizes[0] != T * D || out_size != T * D || ws_size < WS_END) { fprintf(stderr, "kernel_launch: unexpected shapes / workspace (n_in %d, in0 %d, out %d, ws %zu < %zu)\n", n_in, n_in > 0 ? in_sizes[0] : -1, out_size, ws_size, (size_t)WS_END); grid = -1; return; }
        int dev = 0, cus = 0, per_cu = 0;
        if (hipGetDevice(&dev) != hipSuccess || hipDeviceGetAttribute(&cus, hipDeviceAttributeMultiprocessorCount, dev) != hipSuccess) { grid = -1; return; }
        if (hipFuncSetAttribute((const void*)fwd_kernel, hipFuncAttributeMaxDynamicSharedMemorySize, LDS_BYTES) != hipSuccess) { fprintf(stderr, "kernel_launch: hipFuncSetAttribute failed\n"); grid = -1; return; }
        if (hipOccupancyMaxActiveBlocksPerMultiprocessor(&per_cu, (const void*)fwd_kernel, NTHREADS, LDS_BYTES) != hipSuccess || per_cu < 1) { fprintf(stderr, "kernel_launch: occupancy query says %d blocks per CU\n", per_cu); per_cu = 1; }
        (void)hipGetLastError();
        grid = cus;
    }
    if (grid < 0) return;
    (void)hipMemsetAsync((char*)d_ws + WS_CTL, 0, CTL_ZERO_BYTES, stream);
    Params p{};
    for (int i = 0; i < 26; ++i) p.in[i] = (const float*)d_in[i];
    p.out = (float*)d_out; p.ws = (unsigned char*)d_ws;
#if MK_PER_PHASE
    for (int k = 0; k < NPHASES; ++k) { p.ph_lo = k; p.ph_hi = k + 1; p.use_bar = 0; hipLaunchKernelGGL(fwd_kernel, dim3(grid), dim3(NTHREADS), LDS_BYTES, stream, p); }
#else
    p.ph_lo = 0; p.ph_hi = NPHASES; p.use_bar = 1;
    hipLaunchKernelGGL(fwd_kernel, dim3(grid), dim3(NTHREADS), LDS_BYTES, stream, p);
#endif
}
```

```cpp
#include <hip/hip_runtime.h>
#include <cstdio>
#include <cstdint>

#define LAS __attribute__((address_space(3)))
#define GAS __attribute__((address_space(1)))
typedef unsigned short bf16;
typedef short bf16x8 __attribute__((ext_vector_type(8)));
typedef short bf16x4 __attribute__((ext_vector_type(4)));
typedef float f32x4 __attribute__((ext_vector_type(4)));
typedef float f32x2 __attribute__((ext_vector_type(2)));
typedef unsigned u32x4 __attribute__((ext_vector_type(4)));
typedef unsigned u32x2 __attribute__((ext_vector_type(2)));
typedef GAS unsigned gu32;

constexpr int D = 1024, BATCH = 2, SEQ = 8192, T = BATCH * SEQ, DEPTH = 4;
constexpr int AH = 8, AHD = 128, ATT_IN = 9216;
constexpr int RH = 4, RDK = 256, RDV = 512, RET_IN = 6144, RET_V = 2048, RC = 128, RNC = SEQ / RC;
constexpr int SG = 64, SGC = 16, SP = 64;
constexpr int NE = 64, TOPK = 8, NEG = 8, ED = 256, NSLOT = 9;
constexpr float LN_EPS = 1e-5f;
constexpr float ALPHA = 1.6817928305074292f;
constexpr int NWAVES = 8, NTHREADS = 512;

__device__ __forceinline__ unsigned f2bf(float f) { unsigned u = __builtin_bit_cast(unsigned, f); return (u + 0x7fffu + ((u >> 16) & 1u)) >> 16; }
__device__ __forceinline__ unsigned pk2(float lo, float hi) { unsigned r; asm("s_nop 1\n\tv_cvt_pk_bf16_f32 %0, %1, %2" : "=v"(r) : "v"(lo), "v"(hi)); return r; }
__device__ __forceinline__ unsigned pk2sw(float lo, float hi) { return f2bf(lo) | (f2bf(hi) << 16); }
__device__ __forceinline__ unsigned pk2hw(float lo, float hi) { unsigned r; asm volatile("v_cvt_pk_bf16_f32 %0, %1, %2" : "=v"(r) : "v"(lo), "v"(hi)); return r; }
__device__ __forceinline__ float bf2f(unsigned b) { return __builtin_bit_cast(float, b << 16); }
__device__ __forceinline__ float bflo(unsigned w) { return __builtin_bit_cast(float, w << 16); }
__device__ __forceinline__ float bfhi(unsigned w) { return __builtin_bit_cast(float, w & 0xffff0000u); }
__device__ __forceinline__ float shx(float v, int m, int lane) { return __builtin_bit_cast(float, __builtin_amdgcn_ds_bpermute((lane ^ m) << 2, __builtin_bit_cast(int, v))); }
__device__ __forceinline__ int shx_i(int v, int m, int lane) { return __builtin_amdgcn_ds_bpermute((lane ^ m) << 2, v); }
__device__ __forceinline__ float rdl(float v, int src) { return __builtin_bit_cast(float, __builtin_amdgcn_readlane(__builtin_bit_cast(int, v), src)); }
template <int CTRL, int RM = 0xf, int BM = 0xf> __device__ __forceinline__ float dpp0(float v) { return __builtin_bit_cast(float, __builtin_amdgcn_update_dpp(0, __builtin_bit_cast(int, v), CTRL, RM, BM, true)); }
template <int CTRL, int RM = 0xf, int BM = 0xf> __device__ __forceinline__ float dppo(float old, float v) { return __builtin_bit_cast(float, __builtin_amdgcn_update_dpp(__builtin_bit_cast(int, old), __builtin_bit_cast(int, v), CTRL, RM, BM, false)); }
__device__ __forceinline__ float wave_sum(float v, int lane) {
    (void)lane;
    v += dpp0<0x111>(v); v += dpp0<0x112>(v); v += dpp0<0x114>(v); v += dpp0<0x118>(v);
    v += dpp0<0x142, 0xa>(v);
    v += dpp0<0x143, 0xc>(v);
    return rdl(v, 63);
}
__device__ __forceinline__ float max8(float v) {
    v = fmaxf(v, dppo<0xb1>(v, v)); v = fmaxf(v, dppo<0x4e>(v, v)); v = fmaxf(v, dppo<0x141>(v, v)); return v;
}
__device__ __forceinline__ float fsig(float x) { return __builtin_amdgcn_rcpf(1.0f + __expf(-x)); }
#define LDS_WAIT() asm volatile("s_waitcnt lgkmcnt(0)" ::: "memory")
#define VM_WAIT() asm volatile("s_waitcnt vmcnt(0)" ::: "memory")
__device__ __forceinline__ const char* rfl_ptr(const char* p) {
    unsigned long long v = (unsigned long long)p; unsigned lo = __builtin_amdgcn_readfirstlane((unsigned)v), hi = __builtin_amdgcn_readfirstlane((unsigned)(v >> 32));
    return (const char*)(((unsigned long long)hi << 32) | lo);
}
__device__ __forceinline__ bf16x8 row_frag(const LAS bf16* base, int ld, int row0, int col0, int lane) {
    return *(const LAS bf16x8*)(base + (row0 + (lane & 15)) * ld + col0 + 8 * (lane >> 4));
}
__device__ __forceinline__ bf16x4 tr4(const LAS bf16* addr) { return __builtin_amdgcn_ds_read_tr16_b64_v4i16((LAS bf16x4*)addr); }
__device__ __forceinline__ bf16x8 cat8(bf16x4 a, bf16x4 b) { bf16x8 r; r[0] = a[0]; r[1] = a[1]; r[2] = a[2]; r[3] = a[3]; r[4] = b[0]; r[5] = b[1]; r[6] = b[2]; r[7] = b[3]; return r; }
#define MFMA16(a, b, c) __builtin_amdgcn_mfma_f32_16x16x32_bf16((a), (b), (c), 0, 0, 0)
__device__ __forceinline__ bf16x8 pack8(f32x4 a, f32x4 b) {
    u32x4 w; w.x = pk2(a[0], a[1]); w.y = pk2(a[2], a[3]); w.z = pk2(b[0], b[1]); w.w = pk2(b[2], b[3]); return __builtin_bit_cast(bf16x8, w);
}

namespace pg8 {
typedef int v4i_t __attribute__((ext_vector_type(4)));
typedef int v8i_t __attribute__((ext_vector_type(8)));
constexpr int BM = 256, BK = 64, HALF = 128, HTB = HALF * BK * 2, STAGE_BYTES = 8 * HTB;
__device__ __forceinline__ int lds_byte(int r, int c) { const int st = (r >> 4) * 2 + (c >> 5), rr = r & 15, cc = c & 31, ob = rr * 64 + cc * 2; return st * 1024 + (ob ^ (((ob >> 9) & 1) << 5)); }
__device__ __forceinline__ void stage_rc(int b, int& R, int& C) { const int st = b / 1024, sb = b % 1024, swz = sb ^ (((sb >> 9) & 1) << 5); R = (st >> 1) * 16 + swz / 64; C = (st & 1) * 32 + (swz % 64) / 2; }
__device__ __forceinline__ int perm32(int rho) { const int n = rho >> 4, i = rho & 15; return 8 * (i >> 2) + 4 * n + (i & 3); }

struct UnitG {
    const char* A;
    const char* B;
    const int* gidx;
    int gcnt, gshift;
    int row0, col0;
    int aux;
};

__device__ __forceinline__ void uniformize(UnitG& u) { u.A = rfl_ptr(u.A); u.B = rfl_ptr(u.B); u.gidx = (const int*)rfl_ptr((const char*)u.gidx); u.gcnt = __builtin_amdgcn_readfirstlane(u.gcnt); u.gshift = __builtin_amdgcn_readfirstlane(u.gshift);
    u.row0 = __builtin_amdgcn_readfirstlane(u.row0); u.col0 = __builtin_amdgcn_readfirstlane(u.col0); u.aux = __builtin_amdgcn_readfirstlane(u.aux); }
template <class Epi, class Sched>
__device__ __forceinline__ void gemm_phase(LAS unsigned char* lds, const int tid, const int K, const Sched& S, const Epi& E) {
    constexpr bool F8 = Sched::FP8;
    constexpr bool GATHER = Sched::GATHER;
    const int wid = __builtin_amdgcn_readfirstlane(tid >> 6), lane = tid & 63, wr = wid >> 2, wc = wid & 3, fr = lane & 15, fq = lane >> 4;
    const int nt = K / BK;
    constexpr bool P16 = Epi::PERM16;
    unsigned voffB[2], voffB1[2], vA[2][2];
#pragma unroll
    for (int i = 0; i < 2; ++i) { int R, C; stage_rc(tid * 16 + i * 8192, R, C); const int Rb = Epi::PERM ? ((R & ~31) + perm32(R & 31)) : R; voffB[i] = (unsigned)(Rb * K + C) * 2u; voffB1[i] = voffB[i]; vA[0][i] = (unsigned)(R * K + C) * 2u; vA[1][i] = vA[0][i];
        if constexpr (P16) { const int x = R & 31, src = 64 * (R >> 5) + 16 * ((x >> 2) & 3) + 4 * (x >> 4) + (x & 3); voffB[i] = (unsigned)(src * K + C) * 2u; voffB1[i] = (unsigned)((src + 8) * K + C) * 2u; } }
    const size_t kstep = (size_t)(BK * 2);
    const size_t hstep = (size_t)HALF * K * 2;
    const size_t hstepB = P16 ? 0 : hstep;
    const size_t hstepA = GATHER ? 0 : hstep;
    const unsigned ldsw = (unsigned)wid * 1024u;
    const int aoff = F8 ? lds_byte(wr * 64 + fr, fq * 16) : lds_byte(wr * 64 + fr, fq * 8), boff = F8 ? lds_byte(wc * 32 + fr, fq * 16) : lds_byte(wc * 32 + fr, fq * 8);
    LAS u32x4* park = (LAS u32x4*)(lds + STAGE_BYTES) + tid;
#define PG8_SA(b, h) (((b) * 2 + (h)) * HTB)
#define PG8_SB(b, h) ((4 + (b) * 2 + (h)) * HTB)
#define PG8_STAGE(bufoff, gbase, voff) do { _Pragma("unroll") for (int _i = 0; _i < 2; ++_i) { asm volatile("" : "+v"((voff)[_i]));   \
        __builtin_amdgcn_global_load_lds((const unsigned*)((const char*)(gbase) + (voff)[_i]), (LAS unsigned*)(lds + (bufoff) + ldsw + _i * 8192), 16, 0, 0); } } while (0)
    constexpr int FKS = F8 ? 16 : 1024;
#define PG8_LD2(p_) __builtin_shufflevector(*(const LAS v4i_t*)(p_), *(const LAS v4i_t*)((p_) + FKS), 0, 1, 2, 3, 4, 5, 6, 7)
#define PG8_LDA(dst, b, h) do { _Pragma("unroll") for (int m = 0; m < 4; ++m) dst[m] = PG8_LD2(lds + PG8_SA(b, h) + aoff + m * 2048); } while (0)
#define PG8_LDB(dst, b, h) do { _Pragma("unroll") for (int n = 0; n < 2; ++n) dst[n] = PG8_LD2(lds + PG8_SB(b, h) + boff + n * 2048); } while (0)
#define PG8_LO(v) __builtin_bit_cast(bf16x8, __builtin_shufflevector((v), (v), 0, 1, 2, 3))
#define PG8_HI(v) __builtin_bit_cast(bf16x8, __builtin_shufflevector((v), (v), 4, 5, 6, 7))
#define PG8_MMA(ai, bj, At, Bt) do { __builtin_amdgcn_s_setprio(1); _Pragma("unroll") for (int m = 0; m < 4; ++m) _Pragma("unroll") for (int n = 0; n < 2; ++n) { \
        if constexpr (F8) { acc[ai][bj][m][n] = __builtin_amdgcn_mfma_scale_f32_16x16x128_f8f6f4(Bt[n], At[m], acc[ai][bj][m][n], 0, 0, 0, 0x7F7F7F7F, 0, 0x7F7F7F7F); } \
        else { acc[ai][bj][m][n] = __builtin_amdgcn_mfma_f32_16x16x32_bf16(PG8_LO(Bt[n]), PG8_LO(At[m]), acc[ai][bj][m][n], 0, 0, 0); \
               acc[ai][bj][m][n] = __builtin_amdgcn_mfma_f32_16x16x32_bf16(PG8_HI(Bt[n]), PG8_HI(At[m]), acc[ai][bj][m][n], 0, 0, 0); } } __builtin_amdgcn_s_setprio(0); } while (0)
#define PG8_WAIT_V(n) asm volatile("s_waitcnt vmcnt(" #n ")" ::: "memory")
#define PG8_WAIT_L(n) asm volatile("s_waitcnt lgkmcnt(" #n ")" ::: "memory")
#define PG8_BAR __builtin_amdgcn_s_barrier()
#define PG8_SCHED __builtin_amdgcn_sched_barrier(0)
#define PG8_VOFF(u, v00, v01, v10, v11) do { int _R0, _C0, _R1, _C1; stage_rc(tid * 16, _R0, _C0); stage_rc(tid * 16 + 8192, _R1, _C1); int _r00 = _R0, _r01 = _R1, _r10 = HALF + _R0, _r11 = HALF + _R1; \
        if ((u).gidx) { const GAS int* _gp = (const GAS int*)(u).gidx; const int _gc = (u).gcnt;     \
            const int _a = _gp[_r00 < _gc ? _r00 : 0] >> (u).gshift, _b = _gp[_r01 < _gc ? _r01 : 0] >> (u).gshift, _c = _gp[_r10 < _gc ? _r10 : 0] >> (u).gshift, _d = _gp[_r11 < _gc ? _r11 : 0] >> (u).gshift; \
            _r00 = _a; _r01 = _b; _r10 = _c; _r11 = _d; } \
        v00 = (unsigned)(_r00 * K + _C0) * 2u; v01 = (unsigned)(_r01 * K + _C1) * 2u; v10 = (unsigned)(_r10 * K + _C0) * 2u; v11 = (unsigned)(_r11 * K + _C1) * 2u; } while (0)
    UnitG cur, nxt; int ui = 0;
    if (!S.next(0, cur)) return;
    if constexpr (Sched::UNIFORMIZE) uniformize(cur);
    f32x4 acc[2][2][4][2];
#pragma unroll
    for (int a = 0; a < 2; ++a)
#pragma unroll
        for (int b = 0; b < 2; ++b)
#pragma unroll
            for (int m = 0; m < 4; ++m)
#pragma unroll
                for (int n = 0; n < 2; ++n) acc[a][b][m][n] = (f32x4){0.f, 0.f, 0.f, 0.f};
    v8i_t At[4], B0[2], B1[2];
    if constexpr (GATHER) PG8_VOFF(cur, vA[0][0], vA[0][1], vA[1][0], vA[1][1]);
    const char* cA = cur.A; const char* cB = cur.B;
    PG8_STAGE(PG8_SB(0, 0), cB, voffB); PG8_STAGE(PG8_SB(0, 1), cB + hstepB, voffB1); PG8_STAGE(PG8_SA(0, 0), cA, vA[0]); PG8_STAGE(PG8_SA(0, 1), cA + hstepA, vA[1]);
    if (wr == 1) PG8_BAR;
    PG8_WAIT_V(2); PG8_BAR;
    PG8_STAGE(PG8_SB(1, 0), cB + kstep, voffB); PG8_STAGE(PG8_SA(1, 0), cA + kstep, vA[0]); PG8_STAGE(PG8_SB(1, 1), cB + hstepB + kstep, voffB1);
    PG8_WAIT_V(6); PG8_BAR;
    for (;;) {
        const bool has_next = S.next(ui + 1, nxt);
        if constexpr (Sched::UNIFORMIZE) { if (has_next) uniformize(nxt); }
        const char* nA = cA; const char* nB = cB;
        if (has_next) { nA = nxt.A; nB = nxt.B; }
        if constexpr (GATHER) { u32x4 pv; pv.x = vA[0][0]; pv.y = vA[0][1]; pv.z = vA[1][0]; pv.w = vA[1][1];
            if (has_next) PG8_VOFF(nxt, pv.x, pv.y, pv.z, pv.w);
            *park = pv; }
#pragma unroll 1
        for (int t = 0; t < nt; t += 2) {
            const bool last = (t == nt - 2);
            const char* a1 = cA + (size_t)(t + 1) * kstep;
            const char* a2 = last ? nA : cA + (size_t)(t + 2) * kstep; const char* b2 = last ? nB : cB + (size_t)(t + 2) * kstep;
            const char* a3 = a2 + kstep; const char* b3 = b2 + kstep;
            PG8_LDB(B0, 0, 0); PG8_LDB(B1, 0, 1); PG8_SCHED; PG8_LDA(At, 0, 0); PG8_STAGE(PG8_SA(1, 1), a1 + hstepA, vA[1]);
            PG8_WAIT_V(8); PG8_WAIT_L(0); PG8_BAR; PG8_MMA(0, 0, At, B0); PG8_MMA(0, 1, At, B1); PG8_BAR; PG8_SCHED;
            if constexpr (GATHER) { if (last) { const u32x4 pv = *park; vA[0][0] = pv.x; vA[0][1] = pv.y; vA[1][0] = pv.z; vA[1][1] = pv.w; } }
            PG8_LDA(At, 0, 1); PG8_STAGE(PG8_SB(0, 0), b2, voffB); PG8_STAGE(PG8_SB(0, 1), b2 + hstepB, voffB1); PG8_STAGE(PG8_SA(0, 0), a2, vA[0]);
            PG8_WAIT_V(8); PG8_WAIT_L(0); PG8_BAR; PG8_MMA(1, 0, At, B0); PG8_MMA(1, 1, At, B1); PG8_BAR; PG8_SCHED;
            PG8_LDB(B0, 1, 0); PG8_LDB(B1, 1, 1); PG8_SCHED; PG8_LDA(At, 1, 0); PG8_STAGE(PG8_SA(0, 1), a2 + hstepA, vA[1]);
            PG8_WAIT_V(8); PG8_WAIT_L(0); PG8_BAR; PG8_MMA(0, 0, At, B0); PG8_MMA(0, 1, At, B1); PG8_BAR; PG8_SCHED;
            PG8_LDA(At, 1, 1); PG8_STAGE(PG8_SB(1, 0), b3, voffB); PG8_STAGE(PG8_SB(1, 1), b3 + hstepB, voffB1); PG8_STAGE(PG8_SA(1, 0), a3, vA[0]);
            PG8_WAIT_V(8); PG8_WAIT_L(0); PG8_BAR; PG8_MMA(1, 0, At, B0); PG8_MMA(1, 1, At, B1); PG8_BAR; PG8_SCHED;
        }
        if (wr == 0) PG8_BAR;
        E(acc, cur, wr, wc, fr, fq);
        if (!has_next) break;
#pragma unroll
        for (int a = 0; a < 2; ++a)
#pragma unroll
            for (int b = 0; b < 2; ++b)
#pragma unroll
                for (int m = 0; m < 4; ++m)
#pragma unroll
                    for (int n = 0; n < 2; ++n) acc[a][b][m][n] = (f32x4){0.f, 0.f, 0.f, 0.f};
        cur = nxt; cA = nA; cB = nB; ++ui;
        if (wr == 1) PG8_BAR;
    }
    PG8_WAIT_V(0);
    PG8_BAR;
#undef PG8_SA
#undef PG8_SB
#undef PG8_STAGE
#undef PG8_LDA
#undef PG8_LDB
#undef PG8_LD2
#undef PG8_LO
#undef PG8_HI
#undef PG8_MMA
#undef PG8_WAIT_V
#undef PG8_WAIT_L
#undef PG8_BAR
#undef PG8_SCHED
#undef PG8_VOFF
}
}

constexpr size_t MiB = 1u << 20;
constexpr size_t WS_CTL = 0, CTL_ZERO_BYTES = 1 * MiB;
constexpr size_t WS_ATT_IN_T = 1 * MiB;
constexpr size_t WS_ATT_OUT_T = WS_ATT_IN_T + 36 * MiB;
constexpr size_t WS_RET_IN_T = WS_ATT_OUT_T + 4 * MiB;
constexpr size_t WS_RET_OUT_T = WS_RET_IN_T + 12 * MiB;
constexpr size_t WS_GLU_T = WS_RET_OUT_T + 4 * MiB;
constexpr size_t WS_RT_HI = WS_GLU_T + 4 * MiB;
constexpr size_t WS_RT_LO = WS_RT_HI + 512 * 1024;
constexpr size_t WS_WMOE = WS_RT_HI + 1 * MiB;
constexpr size_t WMOE_E_BYTES = (size_t)(512 * 1024 + 1024 * 256) * 2;
constexpr size_t WS_X = WS_WMOE + 98 * MiB;
constexpr size_t WS_Y = WS_X + 64 * MiB;
constexpr size_t WS_XB = WS_Y + 64 * MiB;
constexpr size_t WS_BIG = WS_XB + 32 * MiB;
constexpr size_t WS_AUX = WS_BIG + 288 * MiB;
constexpr size_t WS_H = WS_AUX + 160 * MiB;
constexpr size_t WS_LIST = WS_H + 80 * MiB;
constexpr size_t WS_TRASH = WS_LIST + 8 * MiB;
constexpr size_t WS_END = WS_TRASH + 1 * MiB;
static_assert(WS_END <= 1024 * MiB, "workspace map");
constexpr int CW_BAR = 4096;
constexpr int CW_CNT = 16384;
constexpr int CW_CHK = 65536;
constexpr int HROWS = 163840;

#define XB_TMO      128
#define XB_XCNT(j)  (256  + 64 * (j))
#define XB_XSUB(j)  (1280 + 64 * (j))
#define XB_XGEN(j)  (2304 + 64 * (j))
#define XB_TOP      3328
#define XB_TOPGEN   3392
#define XCD_BAR_WORDS 3456
#define XB_SPIN_CAP (1u << 20)
__device__ __forceinline__ unsigned xb_ld(unsigned* p)              { return __hip_atomic_load(p, __ATOMIC_RELAXED, __HIP_MEMORY_SCOPE_AGENT); }
__device__ __forceinline__ unsigned xb_add(unsigned* p, unsigned v) { return __hip_atomic_fetch_add(p, v, __ATOMIC_RELAXED, __HIP_MEMORY_SCOPE_AGENT); }
__device__ __forceinline__ unsigned xb_xcc_id() { return (unsigned)__builtin_amdgcn_s_getreg((3 << 11) | 20) & 0xFu; }
#define XB_SPIN(cond, bar) do { unsigned _sp = 0; while (cond) { __builtin_amdgcn_s_sleep(1); \
    if ((++_sp & 255u) == 0u) { if (xb_ld(&(bar)[XB_TMO])) break; if (_sp > XB_SPIN_CAP) { atomicAdd(&(bar)[XB_TMO], 1u); break; } } } } while (0)
struct XcdBarrier { unsigned* bar; unsigned x; volatile LAS unsigned* st; };
__device__ __forceinline__ XcdBarrier xcd_barrier_post(unsigned* bar, volatile LAS unsigned* st) {
    XcdBarrier b; b.bar = bar; b.x = xb_xcc_id(); b.st = st;
    if (threadIdx.x == 0) (void)xb_add(&bar[XB_XCNT(b.x)], 1u);
    return b;
}
__device__ __forceinline__ void xcd_barrier_complete(unsigned* bar, unsigned x, unsigned& nloc, unsigned& nx) {
    const unsigned G = gridDim.x * gridDim.y * gridDim.z;
    unsigned sum, cnt, mine, sp = 0u;
    for (;;) {
        sum = 0u; cnt = 0u; mine = 0u;
#pragma unroll
        for (unsigned j = 0; j < 16; ++j) { const unsigned c = xb_ld(&bar[XB_XCNT(j)]); sum += c; cnt += (c > 0u) ? 1u : 0u; mine = (j == x) ? c : mine; }
        if (sum == G) break;
        __builtin_amdgcn_s_sleep(1);
        if ((++sp & 255u) == 0u) { if (xb_ld(&bar[XB_TMO])) break; if (sp > XB_SPIN_CAP) { atomicAdd(&bar[XB_TMO], 1u); break; } }
    }
    nloc = mine > 0u ? mine : 1u; nx = cnt > 0u ? cnt : 1u;
}
__device__ __forceinline__ void xcd_barrier(const XcdBarrier& b) {
    asm volatile("s_waitcnt vmcnt(0)" ::: "memory");
    __syncthreads();
    if (threadIdx.x == 0) {
        unsigned* bar = b.bar;
        __builtin_amdgcn_s_waitcnt(0);
        unsigned nloc = b.st[0], nx = b.st[1];
        if (nloc == 0u) { xcd_barrier_complete(bar, b.x, nloc, nx); b.st[0] = nloc; b.st[1] = nx; }
        const unsigned old = xb_add(&bar[XB_XSUB(b.x)], 1u);
        const unsigned gen = old / nloc;
        if (old + 1u == (gen + 1u) * nloc) {
            __builtin_amdgcn_fence(__ATOMIC_RELEASE, "agent");
            asm volatile("s_waitcnt vmcnt(0)" ::: "memory");
            const unsigned og = xb_add(&bar[XB_TOP], 1u);
            const unsigned tg = og / nx;
            if (og + 1u == (tg + 1u) * nx) xb_add(&bar[XB_TOPGEN], 1u);
            else XB_SPIN(xb_ld(&bar[XB_TOPGEN]) == tg, bar);
            __builtin_amdgcn_fence(__ATOMIC_ACQUIRE, "agent");
            xb_add(&bar[XB_XGEN(b.x)], 1u);
            asm volatile("s_waitcnt vmcnt(0)" ::: "memory");
        } else {
            XB_SPIN(xb_ld(&bar[XB_XGEN(b.x)]) == gen, bar);
            __builtin_amdgcn_fence(__ATOMIC_ACQUIRE, "agent");
            asm volatile("s_waitcnt vmcnt(0)" ::: "memory");
        }
    }
    __syncthreads();
}

constexpr int RING_BYTES = 139264;
constexpr int MISC_OFF = RING_BYTES;
constexpr int LDS_BYTES = 147456;
struct Params {
    const float* in[26]; float* out; unsigned char* ws; int ph_lo, ph_hi; int use_bar, pad;
};
typedef const __attribute__((address_space(4))) Params* KP;
__device__ __forceinline__ const float* gin(KP p, int i) { return (const float*)(const GAS float*)p->in[i]; }
__device__ __forceinline__ float* gout(KP p) { return (float*)(GAS float*)p->out; }
struct Frame {
    LAS unsigned char* lds; volatile LAS unsigned* MISC;
    int tid, lane, wave, vcu, G;
    unsigned char* ws;
};

template <bool F8_ = false> struct DenseSchedT {
    static constexpr bool GATHER = false, UNIFORMIZE = false, FP8 = F8_;
    const char* A; const char* Bt; int K, nM, nN, nwg, G, c;
    __device__ __forceinline__ void init(const void* A_, const void* Bt_, int M, int N, int K_, int G_, int c_) { A = (const char*)A_; Bt = (const char*)Bt_; K = K_; nM = M / 256; nN = N / 256; nwg = nM * nN; G = G_; c = c_; }
    __device__ __forceinline__ bool next(int i, pg8::UnitG& u) const {
        const long L = (long)i * G + c; if (L >= nwg) return false;
        int wgid = (int)L; { const int q = nwg / 8, r = nwg % 8, xcd = wgid % 8, off = wgid / 8; wgid = (xcd < r ? xcd * (q + 1) : r * (q + 1) + (xcd - r) * q) + off; }
        const int nig = 8 * nN, gid = wgid / nig, fm = gid * 8, gsz = (nM - fm) < 8 ? (nM - fm) : 8;
        const int pm = fm + ((wgid % nig) % gsz), pn = (wgid % nig) / gsz;
        u.A = A + (size_t)pm * 256 * K * 2; u.B = Bt + (size_t)pn * 256 * K * 2; u.gidx = nullptr; u.gcnt = 0; u.gshift = 0; u.row0 = pm * 256; u.col0 = pn * 256; u.aux = 0; return true;
    }
};
typedef DenseSchedT<false> DenseSched; typedef DenseSchedT<true> DenseSched8;
__device__ __forceinline__ u32x4 pack_bf16x8(const f32x4& v0, const f32x4& v1) { u32x4 w; w.x = pk2hw(v0[0], v0[1]); w.y = pk2hw(v0[2], v0[3]); w.z = pk2hw(v1[0], v1[1]); w.w = pk2hw(v1[2], v1[3]); return w; }

constexpr float WUP_SCALE = 32.0f, WUP_INV = 1.0f / 32.0f;
struct EpiStoreBf16 {
    static constexpr bool PERM = true, PERM16 = false;
    bf16* O; int ldc; float osc, qsc;
    __device__ __forceinline__ void operator()(const f32x4 (&acc)[2][2][4][2], const pg8::UnitG& u, int wr, int wc, int fr, int fq) const {
        const float sc = ((u.col0 % 3072) < 1024) ? osc * qsc : osc;
#pragma unroll
        for (int ai = 0; ai < 2; ++ai)
#pragma unroll
            for (int m = 0; m < 4; ++m) { bf16* rowp = O + (size_t)(u.row0 + ai * 128 + wr * 64 + m * 16 + fr) * ldc + u.col0 + wc * 32 + 8 * fq;
#pragma unroll
                for (int bj = 0; bj < 2; ++bj) *(u32x4*)(rowp + bj * 128) = pack_bf16x8(acc[ai][bj][m][0] * sc, acc[ai][bj][m][1] * sc); }
    }
};
constexpr float YEXP_SCALE = 32.0f, YEXP_INV = 1.0f / 32.0f;
struct EpiStoreFp8 {
    static constexpr bool PERM = false, PERM16 = true;
    unsigned char* O; int ldc;
    __device__ __forceinline__ void operator()(const f32x4 (&acc)[2][2][4][2], const pg8::UnitG& u, int wr, int wc, int fr, int fq) const {
#pragma unroll
        for (int ai = 0; ai < 2; ++ai)
#pragma unroll
            for (int m = 0; m < 4; ++m) { unsigned char* rowp = O + (size_t)(u.row0 + ai * 128 + wr * 64 + m * 16 + fr) * ldc + u.col0 + wc * 64 + 16 * fq;
                u32x4 w;
#pragma unroll
                for (int q = 0; q < 4; ++q) { f32x4 v = acc[ai][q >> 1][m][q & 1] * YEXP_SCALE;
#pragma unroll
                    for (int j = 0; j < 4; ++j) v[j] = fminf(fmaxf(v[j], -448.0f), 448.0f);
                    int d = 0; d = __builtin_amdgcn_cvt_pk_fp8_f32(v[0], v[1], d, false); d = __builtin_amdgcn_cvt_pk_fp8_f32(v[2], v[3], d, true); w[q] = (unsigned)d; }
                *(u32x4*)rowp = w; }
    }
};
struct EpiRetIn {
    static constexpr bool PERM = true, PERM16 = false;
    bf16* O; int ldc;
    __device__ __forceinline__ void operator()(const f32x4 (&acc)[2][2][4][2], const pg8::UnitG& u, int wr, int wc, int fr, int fq) const {
        float l2g = 0.f;
        float cs = WUP_INV;
        if (u.col0 < 2048) { const int h = (u.col0 & 1023) >> 8; const float g = 1.0f - exp2f(-5.0f - (float)h); l2g = log2f(g); if (u.col0 >= 1024) { l2g = -l2g; cs *= 0.0625f; } }
#pragma unroll
        for (int ai = 0; ai < 2; ++ai)
#pragma unroll
            for (int m = 0; m < 4; ++m) { const int row = u.row0 + ai * 128 + wr * 64 + m * 16 + fr; const float sc = exp2f(l2g * (float)(row & 127)) * cs;
                bf16* rowp = O + (size_t)row * ldc + u.col0 + wc * 32 + 8 * fq;
#pragma unroll
                for (int bj = 0; bj < 2; ++bj) *(u32x4*)(rowp + bj * 128) = pack_bf16x8(acc[ai][bj][m][0] * sc, acc[ai][bj][m][1] * sc); }
    }
};
__device__ __forceinline__ void unpack_bf16x8(const u32x4& w, f32x4& a, f32x4& b) { a[0] = bflo(w.x); a[1] = bfhi(w.x); a[2] = bflo(w.y); a[3] = bfhi(w.y); b[0] = bflo(w.z); b[1] = bfhi(w.z); b[2] = bflo(w.w); b[3] = bfhi(w.w); }
struct EpiResid {
    static constexpr bool PERM = true, PERM16 = false;
    const bf16* X; bf16* Y;
    __device__ __forceinline__ void operator()(const f32x4 (&acc)[2][2][4][2], const pg8::UnitG& u, int wr, int wc, int fr, int fq) const {
#pragma unroll
        for (int ai = 0; ai < 2; ++ai)
#pragma unroll
            for (int m = 0; m < 4; ++m) { const size_t off = (size_t)(u.row0 + ai * 128 + wr * 64 + m * 16 + fr) * D + u.col0 + wc * 32 + 8 * fq;
#pragma unroll
                for (int bj = 0; bj < 2; ++bj) { const u32x4 xw = *(const u32x4*)(X + off + bj * 128); f32x4 x0, x1; unpack_bf16x8(xw, x0, x1);
                    *(u32x4*)(Y + off + bj * 128) = pack_bf16x8(x0 * ALPHA + acc[ai][bj][m][0], x1 * ALPHA + acc[ai][bj][m][1]); }
                if (m == 3) asm volatile("" ::: "memory"); }
    }
};
struct EpiGluResid {
    static constexpr bool PERM = true, PERM16 = false;
    const bf16* X; bf16* Y;
    __device__ __forceinline__ void operator()(const f32x4 (&acc)[2][2][4][2], const pg8::UnitG& u, int wr, int wc, int fr, int fq) const {
#pragma unroll
        for (int ai = 0; ai < 2; ++ai)
#pragma unroll
            for (int m = 0; m < 4; ++m) { const size_t off = (size_t)(u.row0 + ai * 128 + wr * 64 + m * 16 + fr) * D + (u.col0 >> 1) + wc * 32 + 8 * fq;
                const u32x4 xw = *(const u32x4*)(X + off); f32x4 x0, x1; unpack_bf16x8(xw, x0, x1); f32x4 o0, o1;
#pragma unroll
                for (int j = 0; j < 4; ++j) { o0[j] = x0[j] * ALPHA + acc[ai][0][m][0][j] * fsig(acc[ai][1][m][0][j]); o1[j] = x1[j] * ALPHA + acc[ai][0][m][1][j] * fsig(acc[ai][1][m][1][j]); }
                *(u32x4*)(Y + off) = pack_bf16x8(o0, o1);
                if (m == 3) asm volatile("" ::: "memory"); }
    }
};
struct EpiMoeUp {
    static constexpr bool PERM = true, PERM16 = false;
    bf16* H;
    __device__ __forceinline__ void operator()(const f32x4 (&acc)[2][2][4][2], const pg8::UnitG& u, int wr, int wc, int fr, int fq) const {
#pragma unroll
        for (int ai = 0; ai < 2; ++ai)
#pragma unroll
            for (int m = 0; m < 4; ++m) { bf16* rowp = H + (size_t)(u.row0 + ai * 128 + wr * 64 + m * 16 + fr) * ED + u.col0 + wc * 32 + 8 * fq; f32x4 o[2];
#pragma unroll
                for (int n = 0; n < 2; ++n)
#pragma unroll
                    for (int j = 0; j < 4; ++j) { const float ga = acc[ai][0][m][n][j], ua = acc[ai][1][m][n][j];
                        o[n][j] = (ga * ua) * (WUP_INV * WUP_INV) * __builtin_amdgcn_rcpf(1.0f + __builtin_amdgcn_exp2f(ga * (-WUP_INV * 1.4426950408889634f))); }
                *(u32x4*)rowp = pack_bf16x8(o[0], o[1]); }
    }
};

__device__ __forceinline__ unsigned pk4_fp8(float a, float b, float c, float d) {
    a = fminf(fmaxf(a, -448.0f), 448.0f); b = fminf(fmaxf(b, -448.0f), 448.0f); c = fminf(fmaxf(c, -448.0f), 448.0f); d = fminf(fmaxf(d, -448.0f), 448.0f);
    int w = 0; w = __builtin_amdgcn_cvt_pk_fp8_f32(a, b, w, false); w = __builtin_amdgcn_cvt_pk_fp8_f32(c, d, w, true); return (unsigned)w; }
template <bool HILO>
__device__ __forceinline__ void conv_item(const float* W, int ldw, bf16* WT, bf16* WTlo, int ldk, int k0, int n0, int drow0, float scale, LAS float* scr, int lane) {
#pragma unroll
    for (int i = 0; i < 8; ++i) { const int kk = 8 * i + (lane >> 3), c4 = 4 * (lane & 7); const f32x4 wv = *(const f32x4*)(W + (size_t)(k0 + kk) * ldw + n0 + c4);
        scr[kk * 33 + c4] = wv[0] * scale; scr[kk * 33 + c4 + 1] = wv[1] * scale; scr[kk * 33 + c4 + 2] = wv[2] * scale; scr[kk * 33 + c4 + 3] = wv[3] * scale; }
    LDS_WAIT(); asm volatile("" ::: "memory");
    const int c = lane & 7;
#pragma unroll
    for (int j = 0; j < 4; ++j) { const int n = (lane >> 3) + 8 * j; const LAS float* s = scr + (8 * c) * 33 + n;
        float v[8];
#pragma unroll
        for (int q = 0; q < 8; ++q) v[q] = s[q * 33];
        u32x4 o; o.x = pk2(v[0], v[1]); o.y = pk2(v[2], v[3]); o.z = pk2(v[4], v[5]); o.w = pk2(v[6], v[7]);
        *(u32x4*)(WT + (size_t)(drow0 + n) * ldk + k0 + 8 * c) = o;
        if (HILO) { float r[8];
#pragma unroll
            for (int q = 0; q < 8; ++q) r[q] = v[q] - bf2f(f2bf(v[q]));
            u32x4 o2; o2.x = pk2(r[0], r[1]); o2.y = pk2(r[2], r[3]); o2.z = pk2(r[4], r[5]); o2.w = pk2(r[6], r[7]);
            *(u32x4*)(WTlo + (size_t)(drow0 + n) * ldk + k0 + 8 * c) = o2; } }
    LDS_WAIT(); asm volatile("" ::: "memory");
}
__device__ __forceinline__ void conv_item8(const float* W, int ldw, unsigned char* WT, int ldk, int k0, int n0, int drow0, float scale, LAS float* scr, int lane) {
#pragma unroll
    for (int i = 0; i < 8; ++i) { const int kk = 8 * i + (lane >> 3), c4 = 4 * (lane & 7); const f32x4 wv = *(const f32x4*)(W + (size_t)(k0 + kk) * ldw + n0 + c4);
        scr[kk * 33 + c4] = wv[0] * scale; scr[kk * 33 + c4 + 1] = wv[1] * scale; scr[kk * 33 + c4 + 2] = wv[2] * scale; scr[kk * 33 + c4 + 3] = wv[3] * scale; }
    LDS_WAIT(); asm volatile("" ::: "memory");
    const int c = lane & 7;
#pragma unroll
    for (int j = 0; j < 4; ++j) { const int n = (lane >> 3) + 8 * j; const LAS float* s = scr + (8 * c) * 33 + n;
        float v[8];
#pragma unroll
        for (int q = 0; q < 8; ++q) v[q] = s[q * 33];
        u32x2 o; o.x = pk4_fp8(v[0], v[1], v[2], v[3]); o.y = pk4_fp8(v[4], v[5], v[6], v[7]);
        *(u32x2*)(WT + (size_t)(drow0 + n) * ldk + k0 + 8 * c) = o; }
    LDS_WAIT(); asm volatile("" ::: "memory");
}
__device__ __forceinline__ void phase_conv_mixers(const Frame& F, KP p) {
    LAS float* scr = (LAS float*)(F.lds + F.wave * 16384);
    const int gw = F.vcu * NWAVES + F.wave, NGW = F.G * NWAVES;
    constexpr int I_AIN = 16 * 288, I_AOUT = 16 * 32, I_RIN = 16 * 192, I_ROUT = 32 * 32, I_GLU = 16 * 64, I_RT = 16 * 2;
    constexpr int NITEMS = 2 * I_AIN + 2 * I_AOUT + I_RIN + I_ROUT + I_GLU + 4 * I_RT;
    unsigned char* ws = F.ws;
    for (int it = gw; it < NITEMS; it += NGW) {
        int r = it;
        if (r < 2 * I_AIN) { const int j = r / I_AIN; r %= I_AIN; const int kb = r / 288, nb = r % 288, n0 = nb * 32;
            conv_item8(gin(p, 1) + (size_t)j * D * ATT_IN, ATT_IN, (unsigned char*)(ws + WS_ATT_IN_T) + (size_t)j * ATT_IN * D, D, kb * 64, n0, n0, WUP_SCALE, scr, F.lane); continue; }
        r -= 2 * I_AIN;
        if (r < 2 * I_AOUT) { const int j = r / I_AOUT; r %= I_AOUT; const int kb = r / 32, nb = r % 32, n0 = nb * 32;
            conv_item<false>(gin(p, 2) + (size_t)j * D * D, D, (bf16*)(ws + WS_ATT_OUT_T) + (size_t)j * D * D, nullptr, D, kb * 64, n0, n0, 1.0f, scr, F.lane); continue; }
        r -= 2 * I_AOUT;
        if (r < I_RIN) { const int kb = r / 192, nb = r % 192, n0 = nb * 32;
            conv_item8(gin(p, 3), RET_IN, (unsigned char*)(ws + WS_RET_IN_T), D, kb * 64, n0, n0, WUP_SCALE, scr, F.lane); continue; }
        r -= I_RIN;
        if (r < I_ROUT) { const int kb = r / 32, nb = r % 32, n0 = nb * 32;
            conv_item<false>(gin(p, 6), D, (bf16*)(ws + WS_RET_OUT_T), nullptr, RET_V, kb * 64, n0, n0, 1.0f, scr, F.lane); continue; }
        r -= I_ROUT;
        if (r < I_GLU) { const int kb = r / 64, nb = r % 64, n0 = nb * 32; const int c = n0 & 1023, drow = (c >> 7) * 256 + (n0 >> 10) * 128 + (c & 127);
            conv_item<false>(gin(p, 15), 2 * D, (bf16*)(ws + WS_GLU_T), nullptr, D, kb * 64, n0, drow, 1.0f, scr, F.lane); continue; }
        r -= I_GLU;
        { const int l = r / I_RT; r %= I_RT; const int kb = r / 2, nb = r % 2, n0 = nb * 32;
            conv_item<true>(gin(p, 16) + (size_t)l * D * NE, NE, (bf16*)(ws + WS_RT_HI) + (size_t)l * NE * D, (bf16*)(ws + WS_RT_LO) + (size_t)l * NE * D, D, kb * 64, n0, n0, 1.0f, scr, F.lane); }
    }
}
__device__ __forceinline__ void phase_conv_moe(const Frame& F, KP p, int l) {
    LAS float* scr = (LAS float*)(F.lds + F.wave * 16384);
    const int gw = F.vcu * NWAVES + F.wave, NGW = F.G * NWAVES;
    for (int it = gw; it < 65 * 384; it += NGW) {
        const int e = it / 384, r = it % 384, which = r >> 7, rr = r & 127;
        bf16* We = (bf16*)(F.ws + WS_WMOE + (size_t)e * WMOE_E_BYTES);
        if (which < 2) { const float* src = (e < 64) ? gin(p, 18 + which) + ((size_t)l * NE + e) * D * ED : gin(p, 21 + which) + (size_t)l * D * ED;
            const int kb = rr >> 3, nb = rr & 7, n0 = nb * 32; const int drow = (n0 >> 7) * 256 + which * 128 + (n0 & 127);
            conv_item8(src, ED, (unsigned char*)We, D, kb * 64, n0, drow, WUP_SCALE, scr, F.lane);
        } else { const float* src = (e < 64) ? gin(p, 20) + ((size_t)l * NE + e) * ED * D : gin(p, 23) + (size_t)l * ED * D;
            const int kb = rr >> 5, nb = rr & 31, n0 = nb * 32;
            conv_item<false>(src, D, We + 512 * 1024, nullptr, ED, kb * 64, n0, n0, 1.0f, scr, F.lane); }
    }
}

__device__ __forceinline__ void phase_lnr(const Frame& F, KP p, int layer, bool dry = false) {
    const bf16* Y = (const bf16*)(F.ws + WS_Y); bf16* XB = (bf16*)(F.ws + WS_XB); unsigned char* XB8 = (unsigned char*)(F.ws + WS_X);
    const float* lng = gin(p, 24) + (size_t)(layer * 2) * D; const float* lnb = gin(p, 25) + (size_t)(layer * 2) * D;
    const bf16* rthi = (const bf16*)(F.ws + WS_RT_HI) + (size_t)layer * NE * D; const bf16* rtlo = (const bf16*)(F.ws + WS_RT_LO) + (size_t)layer * NE * D;
    const float* rbias = gin(p, 17) + layer * NE;
    unsigned* cnt = (unsigned*)(F.ws + WS_CTL) + CW_CNT + layer * NE * 64;
    int* lists = (int*)(F.ws + WS_LIST); int* tokmap = (int*)(F.ws + WS_LIST + 4 * MiB); float* tokgate = (float*)(F.ws + WS_LIST + 5 * MiB);
    constexpr int XLD = 1032, MAXT = 8;
    LAS bf16* Xhi = (LAS bf16*)F.lds; LAS bf16* Xlo = Xhi + 16 * XLD;
    LAS float* part = (LAS float*)(F.lds + 2 * 16 * XLD * 2);
    LAS int* ent = (LAS int*)(part + 2 * 16 * 64);
    LAS int* hist = ent + MAXT * 16 * 8 * 2; LAS int* base = hist + 64;
    const int lane = F.lane, w = F.wave, g4 = lane >> 4, l15 = lane & 15;
    if (F.tid < 64) hist[F.tid] = 0;
    bf16x8 bhi[16], blo[16];
    { const int nt = w & 3, kh = w >> 2; const bf16* bh = rthi + (size_t)(16 * nt + l15) * D + 512 * kh + 8 * g4; const bf16* bl = rtlo + (size_t)(16 * nt + l15) * D + 512 * kh + 8 * g4;
#pragma unroll
        for (int ks = 0; ks < 16; ++ks) { bhi[ks] = *(const bf16x8*)(bh + 32 * ks); blo[ks] = *(const bf16x8*)(bl + 32 * ks); } }
    u32x4 ypre[2][2];
    if (F.vcu < T / 16) {
#pragma unroll
        for (int rr = 0; rr < 2; ++rr)
#pragma unroll
            for (int j = 0; j < 2; ++j) ypre[rr][j] = *(const u32x4*)(Y + (size_t)(F.vcu * 16 + 2 * w + rr) * D + 8 * lane + 512 * j); }
    int ntile = 0;
    for (int tile = F.vcu; tile < T / 16 && ntile < MAXT; tile += F.G, ++ntile) {
        const int t0 = tile * 16;
        u32x4 ycur[2][2];
#pragma unroll
        for (int rr = 0; rr < 2; ++rr)
#pragma unroll
            for (int j = 0; j < 2; ++j) ycur[rr][j] = ypre[rr][j];
        if (tile + F.G < T / 16) {
#pragma unroll
            for (int rr = 0; rr < 2; ++rr)
#pragma unroll
                for (int j = 0; j < 2; ++j) ypre[rr][j] = *(const u32x4*)(Y + (size_t)((tile + F.G) * 16 + 2 * w + rr) * D + 8 * lane + 512 * j); }
#pragma unroll
        for (int rr = 0; rr < 2; ++rr) {
            const int lr = 2 * w + rr; const size_t row = (size_t)(t0 + lr);
            f32x4 v[4]; float s = 0.f;
#pragma unroll
            for (int j = 0; j < 2; ++j) unpack_bf16x8(ycur[rr][j], v[2 * j], v[2 * j + 1]);
#pragma unroll
            for (int j = 0; j < 4; ++j) s += (v[j][0] + v[j][1]) + (v[j][2] + v[j][3]);
            const float mean = wave_sum(s, lane) * (1.f / D); float s2 = 0.f;
#pragma unroll
            for (int j = 0; j < 4; ++j) { v[j] = v[j] - mean; s2 += (v[j][0] * v[j][0] + v[j][1] * v[j][1]) + (v[j][2] * v[j][2] + v[j][3] * v[j][3]); }
            const float rstd = 1.0f / sqrtf(wave_sum(s2, lane) * (1.f / D) + LN_EPS);
#pragma unroll
            for (int j = 0; j < 2; ++j) { const f32x4 g0 = *(const f32x4*)(lng + 8 * lane + 512 * j), g1 = *(const f32x4*)(lng + 8 * lane + 512 * j + 4), b0 = *(const f32x4*)(lnb + 8 * lane + 512 * j), b1 = *(const f32x4*)(lnb + 8 * lane + 512 * j + 4);
                const f32x4 o0 = v[2 * j] * rstd * g0 + b0, o1 = v[2 * j + 1] * rstd * g1 + b1;
                const u32x4 hi = pack_bf16x8(o0, o1);
                *(u32x4*)(XB + row * D + 8 * lane + 512 * j) = hi;
                { u32x2 q8; q8.x = pk4_fp8(o0[0], o0[1], o0[2], o0[3]); q8.y = pk4_fp8(o1[0], o1[1], o1[2], o1[3]); *(u32x2*)(XB8 + row * D + 8 * lane + 512 * j) = q8; }
                f32x4 h0, h1; unpack_bf16x8(hi, h0, h1); const u32x4 lo = pack_bf16x8(o0 - h0, o1 - h1);
                *(LAS u32x4*)(Xhi + lr * XLD + 8 * lane + 512 * j) = hi; *(LAS u32x4*)(Xlo + lr * XLD + 8 * lane + 512 * j) = lo; }
        }
        __syncthreads();
        { const int nt = w & 3, kh = w >> 2; f32x4 a0 = (f32x4){0.f, 0.f, 0.f, 0.f}, a1 = a0, a2 = a0, a3 = a0, a4 = a0, a5 = a0;
#pragma unroll
            for (int ks = 0; ks < 16; ks += 2) { const int k0 = 512 * kh + 32 * ks;
                const bf16x8 ahi = row_frag(Xhi, XLD, 0, k0, lane), alo = row_frag(Xlo, XLD, 0, k0, lane), bhi2 = row_frag(Xhi, XLD, 0, k0 + 32, lane), blo2 = row_frag(Xlo, XLD, 0, k0 + 32, lane);
                a0 = MFMA16(ahi, bhi[ks], a0); a1 = MFMA16(alo, bhi[ks], a1); a2 = MFMA16(ahi, blo[ks], a2);
                a3 = MFMA16(bhi2, bhi[ks + 1], a3); a4 = MFMA16(blo2, bhi[ks + 1], a4); a5 = MFMA16(bhi2, blo[ks + 1], a5); }
            const f32x4 acc = ((a0 + a3) + (a1 + a4)) + (a2 + a5);
#pragma unroll
            for (int i = 0; i < 4; ++i) part[(kh * 16 + 4 * g4 + i) * 64 + 16 * nt + l15] = acc[i];
        }
        __syncthreads();
#pragma unroll
        for (int rr = 0; rr < 2; ++rr) {
            const int lt = ntile * 16 + 2 * w + rr;
            const float lg = part[(2 * w + rr) * 64 + lane] + part[(16 + 2 * w + rr) * 64 + lane];
            float sc = 1.0f / (1.0f + expf(-lg)); sc = (sc == sc) ? sc : 0.5f;
            const float sel = sc + rbias[lane];
            const float m1 = max8(sel);
            const unsigned long long eq = __ballot(sel == m1);
            const unsigned gm = (unsigned)(eq >> (lane & 56)) & 0xffu;
            const int first = (lane & 56) + __builtin_ctz(gm | 0x100u);
            const float m2 = max8((lane == first) ? -INFINITY : sel);
            const float gs = m1 + m2; const int mygrp = lane >> 3; int grank = 0;
#pragma unroll
            for (int gg = 0; gg < 8; ++gg) { const float o = rdl(gs, 8 * gg); grank += (o > gs || (o == gs && gg < mygrp)) ? 1 : 0; }
            const float mv = (grank < 4) ? sel : -INFINITY;
            unsigned key = __builtin_bit_cast(unsigned, mv); key = (key >> 31) ? ~key : (key | 0x80000000u); key = (key & ~63u) | (unsigned)(63 - lane);
            int r0 = 0, r1 = 0, r2 = 0, r3 = 0;
#pragma unroll
            for (int e2 = 0; e2 < 64; e2 += 4) { r0 += ((unsigned)__builtin_amdgcn_readlane((int)key, e2) > key) ? 1 : 0; r1 += ((unsigned)__builtin_amdgcn_readlane((int)key, e2 + 1) > key) ? 1 : 0;
                r2 += ((unsigned)__builtin_amdgcn_readlane((int)key, e2 + 2) > key) ? 1 : 0; r3 += ((unsigned)__builtin_amdgcn_readlane((int)key, e2 + 3) > key) ? 1 : 0; }
            const int rank = (r0 + r1) + (r2 + r3);
            const bool chosen = rank < TOPK;
            const float wsum = wave_sum(chosen ? sc : 0.f, lane);
            if (chosen) { const int lpos = __hip_atomic_fetch_add(hist + lane, 1, __ATOMIC_RELAXED, __HIP_MEMORY_SCOPE_WORKGROUP);
                ent[(lt * 8 + rank) * 2] = (lane << 16) | lpos; ent[(lt * 8 + rank) * 2 + 1] = __builtin_bit_cast(int, sc / wsum * 2.5f); }
        }
    }
    __syncthreads();
    if (dry) return;
    if (F.tid < 64) { const int hcount = hist[F.tid]; base[F.tid] = hcount ? (int)atomicAdd(cnt + F.tid * 64, (unsigned)hcount) : 0; }
    __syncthreads();
    for (int idx = F.tid; idx < ntile * 16 * 8; idx += NTHREADS) {
        const int ev = ent[idx * 2], gb = ent[idx * 2 + 1]; const int e = ev >> 16, pos = base[e] + (ev & 0xffff);
        const int lt = idx >> 3, rank = idx & 7, tok = (F.vcu + (lt >> 4) * F.G) * 16 + (lt & 15);
        lists[(size_t)e * T + pos] = tok; tokmap[tok * 8 + rank] = (e << 16) | pos; tokgate[tok * 8 + rank] = __builtin_bit_cast(float, gb);
    }
}

__device__ __forceinline__ void phase_combine(const Frame& F, KP p, int layer, bool dry = false) {
    bf16* XB = (bf16*)(F.ws + WS_XB); const unsigned char* yexp = (const unsigned char*)(F.ws + WS_BIG);
    const int* tokmap = (const int*)(F.ws + WS_LIST + 4 * MiB); const float* tokgate = (const float*)(F.ws + WS_LIST + 5 * MiB);
    const volatile LAS int* tstart = (const volatile LAS int*)(F.MISC + 64);
    const float* lng = gin(p, 24) + (size_t)(layer * 2 + 1) * D; const float* lnb = gin(p, 25) + (size_t)(layer * 2 + 1) * D;
    float* outp = gout(p); bf16* xbo = XB; if (dry) { outp = (float*)(F.ws + WS_AUX); xbo = (bf16*)(F.ws + WS_H); }
    const int lane = F.lane, gw = F.vcu * NWAVES + F.wave, NGW = F.G * NWAVES;
    const bf16* ysh = (const bf16*)(F.ws + WS_Y);
    f32x4 gv[4], bv[4];
#pragma unroll
    for (int j = 0; j < 4; ++j) { gv[j] = *(const f32x4*)(lng + 16 * lane + 4 * j); bv[j] = *(const f32x4*)(lnb + 16 * lane + 4 * j); }
    for (int row = gw; row < T; row += NGW) {
        const int mk = tokmap[row * 8 + (lane & 7)]; const float gk = tokgate[row * 8 + (lane & 7)] * YEXP_INV;
        const int rk = (int)tstart[mk >> 16] * 256 + (mk & 0xffff);
        f32x4 v[4];
#pragma unroll
        for (int j = 0; j < 2; ++j) { const u32x4 xw = *(const u32x4*)(ysh + (size_t)row * D + 16 * lane + 8 * j); unpack_bf16x8(xw, v[2 * j], v[2 * j + 1]); }
#pragma unroll
        for (int k = 0; k < TOPK; ++k) { const int r = __builtin_amdgcn_readlane(rk, k); const float g = rdl(gk, k);
            const u32x4 s = *(const u32x4*)(yexp + (size_t)r * D + 16 * lane);
#pragma unroll
            for (int j = 0; j < 4; ++j) { const f32x2 lo = __builtin_amdgcn_cvt_pk_f32_fp8((int)s[j], false), hi = __builtin_amdgcn_cvt_pk_f32_fp8((int)s[j], true);
                v[j][0] += g * lo[0]; v[j][1] += g * lo[1]; v[j][2] += g * hi[0]; v[j][3] += g * hi[1]; } }
        float s = 0.f;
#pragma unroll
        for (int j = 0; j < 4; ++j) s += (v[j][0] + v[j][1]) + (v[j][2] + v[j][3]);
        const float mean = wave_sum(s, lane) * (1.f / D); float s2 = 0.f;
#pragma unroll
        for (int j = 0; j < 4; ++j) { v[j] = v[j] - mean; s2 += (v[j][0] * v[j][0] + v[j][1] * v[j][1]) + (v[j][2] * v[j][2] + v[j][3] * v[j][3]); }
        const float rstd = 1.0f / sqrtf(wave_sum(s2, lane) * (1.f / D) + LN_EPS);
        f32x4 o[4];
#pragma unroll
        for (int j = 0; j < 4; ++j) o[j] = v[j] * rstd * gv[j] + bv[j];
        if (layer == DEPTH - 1 || dry) {
#pragma unroll
            for (int j = 0; j < 4; ++j) *(f32x4*)(outp + (size_t)row * D + 16 * lane + 4 * j) = o[j]; }
        if (layer != DEPTH - 1) { *(u32x4*)(xbo + (size_t)row * D + 16 * lane) = pack_bf16x8(o[0], o[1]); *(u32x4*)(xbo + (size_t)row * D + 16 * lane + 8) = pack_bf16x8(o[2], o[3]);
            if (!dry) { u32x4 q8; q8.x = pk4_fp8(o[0][0], o[0][1], o[0][2], o[0][3]); q8.y = pk4_fp8(o[1][0], o[1][1], o[1][2], o[1][3]); q8.z = pk4_fp8(o[2][0], o[2][1], o[2][2], o[2][3]); q8.w = pk4_fp8(o[3][0], o[3][1], o[3][2], o[3][3]);
                *(u32x4*)((unsigned char*)(F.ws + WS_X) + (size_t)row * D + 16 * lane) = q8; } }
    }
}

constexpr size_t AUX_OB = 96 * MiB, AUX_LSE = 128 * MiB;
__device__ __forceinline__ void phase_attn(const Frame& F, int bx) {
    const bf16* qkv = (const bf16*)(F.ws + WS_BIG); bf16* og = (bf16*)(F.ws + WS_AUX); float* lse = (float*)(F.ws + WS_AUX + AUX_LSE);
    constexpr int KLD = 136;
    LAS bf16* Ks = (LAS bf16*)F.lds; LAS bf16* Vs = Ks + 256 * KLD;
    const int lane = F.lane, w = F.wave, g4 = lane >> 4, l15 = lane & 15, qq = l15 >> 2, pp = lane & 3;
    u32x4 kc[4], vc[4];
    constexpr int NRUN = 768;
#define ATT_LOADBLK(KR, VR, nblk) do { _Pragma("unroll") for (int it = 0; it < 4; ++it) { const int idx = F.tid + 512 * it, c = idx >> 4, ch = idx & 15; int pos = 128 * (nblk) + c; pos = pos < 0 ? 0 : pos; \
            const unsigned so = (rowbase + (unsigned)pos * (unsigned)d + (unsigned)r) * (unsigned)ATT_IN + (unsigned)(g * 3072 + 1024 + h * 128 + ch * 8); KR[it] = *(const u32x4*)(qkv + so); VR[it] = *(const u32x4*)(qkv + so + 1024u); } } while (0)
#define ATT_STOREBLK(KR, VR, slot) do { _Pragma("unroll") for (int it = 0; it < 4; ++it) { const int idx = F.tid + 512 * it, c = idx >> 4, ch = idx & 15; \
            *(LAS u32x4*)(Ks + (128 * (slot) + c) * KLD + ch * 8) = KR[it]; *(LAS u32x4*)(Vs + (128 * (slot) + c) * KLD + ch * 8) = VR[it]; } } while (0)
    for (int R = bx; R < NRUN; R += F.G) {
        const int h = R & 7, sbr = R >> 3, g = sbr >> 5, rem = sbr & 31, b = rem >> 4, rr_ = rem & 15;
        const int dsh = 2 * g, d = 1 << dsh, nrs = 4 - dsh, r = rr_ >> nrs, n0 = 4 * (rr_ & ((1 << nrs) - 1)); const unsigned rowbase = (unsigned)b * SEQ;
        ATT_LOADBLK(kc, vc, n0 - 1); ATT_STOREBLK(kc, vc, (n0 - 1) & 1); ATT_LOADBLK(kc, vc, n0);
#pragma unroll 1
        for (int j = 0; j < 4; ++j) {
            const int n = n0 + j, cs = n & 1, ps = cs ^ 1;
            ATT_STOREBLK(kc, vc, cs);
            const int qi = 16 * w + l15; const unsigned qrow = rowbase + (unsigned)(128 * n + qi) * (unsigned)d + (unsigned)r;
            bf16x8 qf[4];
#pragma unroll
            for (int s = 0; s < 4; ++s) qf[s] = *(const bf16x8*)(qkv + (qrow * (unsigned)ATT_IN + (unsigned)(g * 3072 + h * 128 + 32 * s + 8 * g4)));
            __syncthreads();
            if (j < 3) { ATT_LOADBLK(kc, vc, n + 1); }
            __builtin_amdgcn_sched_barrier(0);
            const int ws0 = (16 * w < 96) ? 16 * w : 96;
#define ATT_PROW(c0) (((c0) < 128) ? (128 * ps + (c0)) : (128 * cs + (c0) - 128))
            f32x4 sacc[10];
            {
                bf16x8 kfa[4], kfb[4];
#pragma unroll
                for (int s = 0; s < 4; ++s) kfa[s] = row_frag(Ks, KLD, ATT_PROW(ws0), 32 * s, lane);
#pragma unroll
                for (int t = 0; t < 10; t += 2) {
#pragma unroll
                    for (int s = 0; s < 4; ++s) kfb[s] = row_frag(Ks, KLD, ATT_PROW(ws0 + 16 * (t + 1)), 32 * s, lane);
                    __builtin_amdgcn_sched_barrier(0);
                    sacc[t] = (f32x4){0.f, 0.f, 0.f, 0.f};
#pragma unroll
                    for (int s = 0; s < 4; ++s) sacc[t] = MFMA16(kfa[s], qf[s], sacc[t]);
                    if (t + 2 < 10) {
#pragma unroll
                        for (int s = 0; s < 4; ++s) kfa[s] = row_frag(Ks, KLD, ATT_PROW(ws0 + 16 * (t + 2)), 32 * s, lane); }
                    __builtin_amdgcn_sched_barrier(0);
                    sacc[t + 1] = (f32x4){0.f, 0.f, 0.f, 0.f};
#pragma unroll
                    for (int s = 0; s < 4; ++s) sacc[t + 1] = MFMA16(kfb[s], qf[s], sacc[t + 1]);
                }
            }
            const float slope = exp2f(-(float)(h + 1)) * (float)d;
            float mx = -INFINITY;
#pragma unroll
            for (int t = 0; t < 10; ++t)
#pragma unroll
                for (int i = 0; i < 4; ++i) { const int c = ws0 + 16 * t + 4 * g4 + i, step = 128 + qi - c;
                    const bool valid = (step >= 0) && (step <= 128) && (n > 0 || c >= 128);
                    const float v = valid ? sacc[t][i] - slope * (float)step : -INFINITY; sacc[t][i] = v; mx = fmaxf(mx, v); }
            mx = fmaxf(mx, shx(mx, 16, lane)); mx = fmaxf(mx, shx(mx, 32, lane));
            float lsum = 0.f;
#pragma unroll
            for (int t = 0; t < 10; ++t)
#pragma unroll
                for (int i = 0; i < 4; ++i) { const float pv = __expf(sacc[t][i] - mx); sacc[t][i] = pv; lsum += pv; }
            lsum += shx(lsum, 16, lane); lsum += shx(lsum, 32, lane);
            bf16x8 pf[5];
#pragma unroll
            for (int kt = 0; kt < 5; ++kt) pf[kt] = pack8(sacc[2 * kt], sacc[2 * kt + 1]);
            f32x4 o[8];
            {
                const LAS bf16* vl = Vs + (4 * g4 + qq) * KLD + 32 * pp;
                bf16x4 va[10], vcc[10];
#pragma unroll
                for (int q = 0; q < 10; ++q) va[q] = tr4(vl + ATT_PROW(ws0 + 16 * q) * KLD);
#pragma unroll
                for (int et = 0; et < 8; et += 2) {
#pragma unroll
                    for (int q = 0; q < 10; ++q) vcc[q] = tr4(vl + ATT_PROW(ws0 + 16 * q) * KLD + 4 * (et + 1));
                    __builtin_amdgcn_sched_barrier(0);
                    o[et] = (f32x4){0.f, 0.f, 0.f, 0.f};
#pragma unroll
                    for (int kt = 0; kt < 5; ++kt) o[et] = MFMA16(cat8(va[2 * kt], va[2 * kt + 1]), pf[kt], o[et]);
                    if (et + 2 < 8) {
#pragma unroll
                        for (int q = 0; q < 10; ++q) va[q] = tr4(vl + ATT_PROW(ws0 + 16 * q) * KLD + 4 * (et + 2)); }
                    __builtin_amdgcn_sched_barrier(0);
                    o[et + 1] = (f32x4){0.f, 0.f, 0.f, 0.f};
#pragma unroll
                    for (int kt = 0; kt < 5; ++kt) o[et + 1] = MFMA16(cat8(vcc[2 * kt], vcc[2 * kt + 1]), pf[kt], o[et + 1]);
                }
            }
#undef ATT_PROW
            const float inv = 1.0f / lsum;
            bf16* orow = og + ((size_t)g * T + qrow) * D + h * 128 + 32 * g4;
#pragma unroll
            for (int e2 = 0; e2 < 4; ++e2) *(u32x4*)(orow + 8 * e2) = pack_bf16x8(o[2 * e2] * inv, o[2 * e2 + 1] * inv);
            if (g4 == 0) lse[((size_t)g * T + qrow) * AH + h] = mx + __logf(lsum);
            __syncthreads();
        }
    }
#undef ATT_LOADBLK
#undef ATT_STOREBLK
}
__device__ __forceinline__ void phase_attn_combine(const Frame& F) {
    const bf16* og = (const bf16*)(F.ws + WS_AUX); const float* lse = (const float*)(F.ws + WS_AUX + AUX_LSE); bf16* ob = (bf16*)(F.ws + WS_AUX + AUX_OB);
    const int lane = F.lane, gw = F.vcu * NWAVES + F.wave, NGW = F.G * NWAVES, h = lane >> 3;
    for (int row = gw; row < T; row += NGW) {
        const float l0 = lse[((size_t)0 * T + row) * AH + h], l1 = lse[((size_t)1 * T + row) * AH + h], l2 = lse[((size_t)2 * T + row) * AH + h];
        const float m = fmaxf(l0, fmaxf(l1, l2)); float w0 = __expf(l0 - m), w1 = __expf(l1 - m), w2 = __expf(l2 - m); const float inv = 1.0f / (w0 + w1 + w2); w0 *= inv; w1 *= inv; w2 *= inv;
        float a[16];
#pragma unroll
        for (int j = 0; j < 16; ++j) a[j] = 0.f;
#pragma unroll
        for (int g = 0; g < 3; ++g) { const float wg = (g == 0) ? w0 : (g == 1 ? w1 : w2);
#pragma unroll
            for (int q = 0; q < 2; ++q) { const u32x4 s = *(const u32x4*)(og + ((size_t)g * T + row) * D + 16 * lane + 8 * q);
                a[8 * q + 0] += wg * bflo(s.x); a[8 * q + 1] += wg * bfhi(s.x); a[8 * q + 2] += wg * bflo(s.y); a[8 * q + 3] += wg * bfhi(s.y);
                a[8 * q + 4] += wg * bflo(s.z); a[8 * q + 5] += wg * bfhi(s.z); a[8 * q + 6] += wg * bflo(s.w); a[8 * q + 7] += wg * bfhi(s.w); } }
#pragma unroll
        for (int q = 0; q < 2; ++q) { u32x4 o; o.x = pk2(a[8 * q], a[8 * q + 1]); o.y = pk2(a[8 * q + 2], a[8 * q + 3]); o.z = pk2(a[8 * q + 4], a[8 * q + 5]); o.w = pk2(a[8 * q + 6], a[8 * q + 7]);
            *(u32x4*)(ob + (size_t)row * D + 16 * lane + 8 * q) = o; }
    }
}

constexpr size_t BIG_YRET = 192 * MiB;
__device__ __forceinline__ void phase_ret_u(const Frame& F) {
    const bf16* proj = (const bf16*)(F.ws + WS_BIG); bf16* St = (bf16*)(F.ws + WS_AUX);
    constexpr int LD = 264;
    LAS bf16* Kt = (LAS bf16*)F.lds; LAS bf16* Vt = Kt + 128 * LD;
    const int lane = F.lane, w = F.wave, g4 = lane >> 4, l15 = lane & 15, qq = l15 >> 2, pp = lane & 3;
    for (int u = F.vcu; u < 1024; u += F.G) {
        const int eh = u & 1, h = (u >> 1) & 3, n = (u >> 3) & 63, b = u >> 9;
        const size_t row0 = (size_t)b * SEQ + (size_t)n * RC;
#pragma unroll 4
        for (int it = 0; it < 8; ++it) { const int idx = F.tid + 512 * it, j = idx >> 5, ch = idx & 31;
            const bf16* src = proj + (row0 + j) * RET_IN;
            const u32x4 kv = *(const u32x4*)(src + 1024 + h * 256 + ch * 8), vv = *(const u32x4*)(src + 2048 + h * 512 + eh * 256 + ch * 8);
            *(LAS u32x4*)(Kt + j * LD + ch * 8) = kv; *(LAS u32x4*)(Vt + j * LD + ch * 8) = vv; }
        __syncthreads();
        f32x4 acc[16][2];
#pragma unroll
        for (int mt = 0; mt < 16; ++mt) { acc[mt][0] = (f32x4){0.f, 0.f, 0.f, 0.f}; acc[mt][1] = (f32x4){0.f, 0.f, 0.f, 0.f}; }
#pragma unroll
        for (int ks = 0; ks < 4; ++ks) {
            bf16x8 bfr[2];
#pragma unroll
            for (int nt = 0; nt < 2; ++nt) { const LAS bf16* a0 = Vt + (32 * ks + 8 * g4 + qq) * LD + 32 * w + 16 * nt + 4 * pp; bfr[nt] = cat8(tr4(a0), tr4(a0 + 4 * LD)); }
#pragma unroll
            for (int mt = 0; mt < 16; ++mt) { const LAS bf16* a0 = Kt + (32 * ks + 8 * g4 + qq) * LD + 128 * (mt >> 3) + 32 * pp + 4 * (mt & 7);
                const bf16x8 afr = cat8(tr4(a0), tr4(a0 + 4 * LD));
                acc[mt][0] = MFMA16(afr, bfr[0], acc[mt][0]); acc[mt][1] = MFMA16(afr, bfr[1], acc[mt][1]); }
        }
        bf16* outb = St + ((size_t)((b * RH + h) * RNC + n)) * (RDV * RDK);
#pragma unroll
        for (int nt = 0; nt < 2; ++nt) { bf16* orow = outb + (size_t)(eh * 256 + 32 * w + 16 * nt + l15) * RDK + 32 * g4;
#pragma unroll
            for (int mh = 0; mh < 2; ++mh)
#pragma unroll
                for (int q = 0; q < 4; ++q) *(u32x4*)(orow + 128 * mh + 8 * q) = pack_bf16x8(acc[mh * 8 + 2 * q][nt], acc[mh * 8 + 2 * q + 1][nt]); }
        __syncthreads();
    }
}
__device__ __forceinline__ void phase_ret_scan(const Frame& F) {
    bf16* St = (bf16*)(F.ws + WS_AUX);
    for (int gt = F.vcu * NTHREADS + F.tid; gt < 8 * 16384; gt += F.G * NTHREADS) {
        const int bh = gt >> 14, chunk = gt & 16383, h = bh & 3;
        const float g128 = exp2f(128.0f * log2f(1.0f - exp2f(-5.0f - (float)h)));
        bf16* base = St + (size_t)bh * RNC * (RDV * RDK) + (size_t)chunk * 8;
        float c[8];
#pragma unroll
        for (int j = 0; j < 8; ++j) c[j] = 0.f;
#pragma unroll 8
        for (int n = 0; n < RNC; ++n) { bf16* pn = base + (size_t)n * (RDV * RDK); const u32x4 uv = *(const u32x4*)pn;
            u32x4 o; o.x = pk2(c[0], c[1]); o.y = pk2(c[2], c[3]); o.z = pk2(c[4], c[5]); o.w = pk2(c[6], c[7]); *(u32x4*)pn = o;
            c[0] = g128 * (c[0] + bflo(uv.x)); c[1] = g128 * (c[1] + bfhi(uv.x)); c[2] = g128 * (c[2] + bflo(uv.y)); c[3] = g128 * (c[3] + bfhi(uv.y));
            c[4] = g128 * (c[4] + bflo(uv.z)); c[5] = g128 * (c[5] + bfhi(uv.z)); c[6] = g128 * (c[6] + bflo(uv.w)); c[7] = g128 * (c[7] + bfhi(uv.w)); }
    }
}
__device__ __forceinline__ void phase_ret_out(const Frame& F, KP p) {
    const bf16* proj = (const bf16*)(F.ws + WS_BIG); const bf16* St = (const bf16*)(F.ws + WS_AUX); bf16* yret = (bf16*)(F.ws + WS_BIG + BIG_YRET);
    const float* gng = gin(p, 4); const float* gnb = gin(p, 5);
    constexpr int LD = 264, VLD = 136;
    LAS bf16* Rs = (LAS bf16*)F.lds; LAS bf16* Vs = Rs + 128 * LD;
    const int lane = F.lane, w = F.wave, g4 = lane >> 4, l15 = lane & 15, qq = l15 >> 2, pp = lane & 3;
    for (int u = F.vcu; u < 512; u += F.G) {
        const int h = u & 3, n = (u >> 2) & 63, b = u >> 8;
        const size_t row0 = (size_t)b * SEQ + (size_t)n * RC;
#pragma unroll 4
        for (int it = 0; it < 8; ++it) { const int idx = F.tid + 512 * it, j = idx >> 5, ch = idx & 31;
            *(LAS u32x4*)(Rs + j * LD + ch * 8) = *(const u32x4*)(proj + (row0 + j) * RET_IN + 1024 + h * 256 + ch * 8); }
        const int irow = 16 * w + l15; const size_t qrow = row0 + irow;
        bf16x8 qf[8];
#pragma unroll
        for (int s = 0; s < 8; ++s) qf[s] = *(const bf16x8*)(proj + qrow * RET_IN + h * 256 + 32 * s + 8 * g4);
        __syncthreads();
        bf16x8 pf[4];
        { f32x4 sacc[8];
#pragma unroll
            for (int jt = 0; jt < 8; ++jt) { sacc[jt] = (f32x4){0.f, 0.f, 0.f, 0.f};
                if (jt <= w) {
#pragma unroll
                    for (int s = 0; s < 8; ++s) sacc[jt] = MFMA16(row_frag(Rs, LD, 16 * jt, 32 * s, lane), qf[s], sacc[jt]);
#pragma unroll
                    for (int i = 0; i < 4; ++i) if (16 * jt + 4 * g4 + i > irow) sacc[jt][i] = 0.f; } }
#pragma unroll
            for (int kt = 0; kt < 4; ++kt) pf[kt] = pack8(sacc[2 * kt], sacc[2 * kt + 1]); }
        __syncthreads();
        f32x4 acc[4][8];
        const bf16* Sn = St + ((size_t)((b * RH + h) * RNC + n)) * (RDV * RDK);
#pragma unroll
        for (int sl = 0; sl < 4; ++sl) {
#pragma unroll 4
            for (int it = 0; it < 4; ++it) { const int idx = F.tid + 512 * it, j = idx >> 4, ch = idx & 15;
                *(LAS u32x4*)(Vs + j * VLD + ch * 8) = *(const u32x4*)(proj + (row0 + j) * RET_IN + 2048 + h * 512 + sl * 128 + ch * 8); }
#pragma unroll 4
            for (int it = 0; it < 8; ++it) { const int idx = F.tid + 512 * it, e = idx >> 5, ch = idx & 31;
                *(LAS u32x4*)(Rs + e * LD + ch * 8) = *(const u32x4*)(Sn + (size_t)(sl * 128 + e) * RDK + ch * 8); }
            __syncthreads();
#pragma unroll
            for (int et = 0; et < 8; ++et) { f32x4 a = (f32x4){0.f, 0.f, 0.f, 0.f};
#pragma unroll
                for (int kt = 0; kt < 4; ++kt) if (2 * kt <= w) { const LAS bf16* a0 = Vs + (32 * kt + 4 * g4 + qq) * VLD + 32 * pp + 4 * et;
                    a = MFMA16(cat8(tr4(a0), tr4(a0 + 16 * VLD)), pf[kt], a); }
                const LAS bf16* srow = Rs + (32 * qq + 4 * et + pp) * LD + 8 * g4;
#pragma unroll
                for (int s = 0; s < 8; ++s) a = MFMA16(*(const LAS bf16x8*)(srow + 32 * s), qf[s], a);
                acc[sl][et] = a; }
            __syncthreads();
        }
        float s = 0.f;
#pragma unroll
        for (int sl = 0; sl < 4; ++sl)
#pragma unroll
            for (int et = 0; et < 8; ++et) s += (acc[sl][et][0] + acc[sl][et][1]) + (acc[sl][et][2] + acc[sl][et][3]);
        s += shx(s, 16, lane); s += shx(s, 32, lane);
        const float mean = s * (1.0f / RDV); float s2 = 0.f;
#pragma unroll
        for (int sl = 0; sl < 4; ++sl)
#pragma unroll
            for (int et = 0; et < 8; ++et) { acc[sl][et] = acc[sl][et] - mean; s2 += (acc[sl][et][0] * acc[sl][et][0] + acc[sl][et][1] * acc[sl][et][1]) + (acc[sl][et][2] * acc[sl][et][2] + acc[sl][et][3] * acc[sl][et][3]); }
        s2 += shx(s2, 16, lane); s2 += shx(s2, 32, lane);
        const float rstd = 1.0f / sqrtf(s2 * (1.0f / RDV) + LN_EPS);
#pragma unroll
        for (int sl = 0; sl < 4; ++sl) { const int c0 = h * RDV + sl * 128 + 32 * g4;
#pragma unroll
            for (int q = 0; q < 4; ++q) { const u32x4 gw = *(const u32x4*)(proj + qrow * RET_IN + 4096 + c0 + 8 * q);
                const f32x4 gg0 = *(const f32x4*)(gng + c0 + 8 * q), gg1 = *(const f32x4*)(gng + c0 + 8 * q + 4), gb0 = *(const f32x4*)(gnb + c0 + 8 * q), gb1 = *(const f32x4*)(gnb + c0 + 8 * q + 4);
                f32x4 y0 = acc[sl][2 * q] * rstd * gg0 + gb0, y1 = acc[sl][2 * q + 1] * rstd * gg1 + gb1;
                const float gv[8] = {bflo(gw.x), bfhi(gw.x), bflo(gw.y), bfhi(gw.y), bflo(gw.z), bfhi(gw.z), bflo(gw.w), bfhi(gw.w)};
#pragma unroll
                for (int j = 0; j < 4; ++j) { y0[j] *= gv[j] * fsig(gv[j]); y1[j] *= gv[4 + j] * fsig(gv[4 + j]); }
                *(u32x4*)(yret + qrow * RET_V + c0 + 8 * q) = pack_bf16x8(y0, y1); } }
    }
}

constexpr size_t AUX_S5E = 64 * MiB;
constexpr int S5L = 256, S5NC = SEQ / S5L;
__device__ __forceinline__ void cmul_add(float& rr, float& ri, float ar, float ai, float xr, float xi, float cr, float ci) { rr = ar * xr - ai * xi + cr; ri = ar * xi + ai * xr + ci; }
template <bool OUT>
__device__ __forceinline__ void phase_s5_scan(const Frame& F, KP p) {
    const bf16* X = (const bf16*)(F.ws + WS_XB); float* E = (float*)(F.ws + WS_AUX + AUX_S5E); bf16* ybuf = (bf16*)(F.ws + WS_AUX);
    const int lane = F.lane, w = F.wave, g4 = lane >> 4, l15 = lane & 15;
    LAS bf16* ut = (LAS bf16*)(F.lds + w * 12288);
    LAS bf16* Hb = (LAS bf16*)(F.lds + w * 12288 + 4096);
    constexpr int HLD = 136;
    const int gw = F.vcu * NWAVES + w, NGW = F.G * NWAVES;
    const int up16 = (lane - 16) << 2, up32 = (lane - 32) << 2, last16 = (48 + l15) << 2;
    for (int unit = gw; unit < BATCH * SG * S5NC; unit += NGW) {
        const int n = unit & (S5NC - 1), g = (unit >> 5) & 63, b = unit >> 11;
        float a1r[4], a1i[4], a4r[4], a4i[4], a8r[4], a8i[4], pwr[4], pwi[4];
        bf16x8 bfrag[8];
        const float dt = expf(gin(p, 14)[g]);
#pragma unroll
        for (int st = 0; st < 4; ++st) { const int ps = 16 * st + l15;
            const float are = gin(p, 7)[g * SP + ps], aim = gin(p, 8)[g * SP + ps];
            const float mag = expf(dt * are); const float abr = mag * cosf(dt * aim), abi = mag * sinf(dt * aim);
            const float den = are * are + aim * aim;
            const float fre = ((abr - 1.0f) * are + abi * aim) / den, fim = (abi * are - (abr - 1.0f) * aim) / den;
            a1r[st] = abr; a1i[st] = abi; { float t2r, t2i; cmul_add(t2r, t2i, abr, abi, abr, abi, 0.f, 0.f); cmul_add(a4r[st], a4i[st], t2r, t2i, t2r, t2i, 0.f, 0.f); }
            cmul_add(a8r[st], a8i[st], a4r[st], a4i[st], a4r[st], a4i[st], 0.f, 0.f);
            float qr = 1.f, qi = 0.f;
            if (g4 & 1) { qr = a4r[st]; qi = a4i[st]; }
            if (g4 & 2) { float tr, ti; cmul_add(tr, ti, qr, qi, a8r[st], a8i[st], 0.f, 0.f); qr = tr; qi = ti; }
            pwr[st] = qr; pwi[st] = qi;
            const float* br = gin(p, 9) + ((size_t)g * SP + ps) * SGC + 8 * (g4 & 1); const float* bi = gin(p, 10) + ((size_t)g * SP + ps) * SGC + 8 * (g4 & 1);
            const f32x4 r0 = *(const f32x4*)br, r1 = *(const f32x4*)(br + 4), i0 = *(const f32x4*)bi, i1 = *(const f32x4*)(bi + 4);
            const float z = (g4 < 2) ? 1.0f : 0.0f; const float fr2 = fre * z, fi2 = fim * z;
            bfrag[st] = pack8(r0 * fr2 - i0 * fi2, r1 * fr2 - i1 * fi2); bfrag[st + 4] = pack8(i0 * fr2 + r0 * fi2, i1 * fr2 + r1 * fi2);
        }
        float sr[4], si[4];
        float* Eu = E + ((size_t)(b * SG + g) * S5NC + n) * 128;
        bf16x8 cf[4]; f32x4 dsk = (f32x4){0.f, 0.f, 0.f, 0.f};
#pragma unroll
        for (int st = 0; st < 4; ++st) { sr[st] = 0.f; si[st] = 0.f; }
        if (OUT) {
#pragma unroll
            for (int st = 0; st < 4; ++st) { sr[st] = Eu[16 * st + l15]; si[st] = Eu[64 + 16 * st + l15]; }
#pragma unroll
            for (int s = 0; s < 4; ++s) { const float* cp = (s < 2 ? gin(p, 11) : gin(p, 12)) + ((size_t)g * SGC + l15) * SP + 32 * (s & 1) + 8 * g4; const float sg = s < 2 ? 1.0f : -1.0f;
                const f32x4 c0 = *(const f32x4*)cp * sg, c1 = *(const f32x4*)(cp + 4) * sg; cf[s] = pack8(c0, c1); }
            dsk = *(const f32x4*)(gin(p, 13) + g * SGC + 4 * g4); }
        const size_t tok0 = (size_t)b * SEQ + (size_t)n * S5L;
        u32x4 pre[2];
        { const bf16* src = X + (tok0 + lane) * D + g * SGC; pre[0] = *(const u32x4*)src; pre[1] = *(const u32x4*)(src + 8); }
        for (int sub = 0; sub < S5L / 64; ++sub) {
            *(LAS u32x4*)(ut + lane * 16) = pre[0]; *(LAS u32x4*)(ut + lane * 16 + 8) = pre[1];
            if (sub + 1 < S5L / 64) { const bf16* src = X + (tok0 + (sub + 1) * 64 + lane) * D + g * SGC; pre[0] = *(const u32x4*)src; pre[1] = *(const u32x4*)(src + 8); }
            LDS_WAIT(); asm volatile("" ::: "memory");
#pragma unroll (OUT ? 1 : 4)
            for (int blk = 0; blk < 4; ++blk) {
                u32x4 uw = *(const LAS u32x4*)(ut + (blk * 16 + l15) * 16 + 8 * (g4 & 1));
                if (g4 >= 2) uw = (u32x4){0u, 0u, 0u, 0u};
                const bf16x8 ufr = __builtin_bit_cast(bf16x8, uw);
                f32x4 dr[4], di[4];
#pragma unroll
                for (int st = 0; st < 4; ++st) { dr[st] = MFMA16(ufr, bfrag[st], ((f32x4){0.f, 0.f, 0.f, 0.f})); di[st] = MFMA16(ufr, bfrag[st + 4], ((f32x4){0.f, 0.f, 0.f, 0.f})); }
                float vr[4], vi[4];
#pragma unroll
                for (int st = 0; st < 4; ++st) {
                    float hr = 0.f, hi = 0.f;
#pragma unroll
                    for (int i = 0; i < 4; ++i) { float nr, ni; cmul_add(nr, ni, a1r[st], a1i[st], hr, hi, dr[st][i], di[st][i]); hr = nr; hi = ni; dr[st][i] = hr; di[st][i] = hi; }
                    vr[st] = hr; vi[st] = hi; }
#define BPF(idx, v) __builtin_bit_cast(float, __builtin_amdgcn_ds_bpermute((idx), __builtin_bit_cast(int, (v))))
                { float xr[4], xi[4];
#pragma unroll
                  for (int st = 0; st < 4; ++st) { xr[st] = BPF(up16, vr[st]); xi[st] = BPF(up16, vi[st]); }
#pragma unroll
                  for (int st = 0; st < 4; ++st) { float tr, ti; cmul_add(tr, ti, a4r[st], a4i[st], xr[st], xi[st], vr[st], vi[st]); if (g4 >= 1) { vr[st] = tr; vi[st] = ti; } }
#pragma unroll
                  for (int st = 0; st < 4; ++st) { xr[st] = BPF(up32, vr[st]); xi[st] = BPF(up32, vi[st]); }
#pragma unroll
                  for (int st = 0; st < 4; ++st) { float tr, ti; cmul_add(tr, ti, a8r[st], a8i[st], xr[st], xi[st], vr[st], vi[st]); if (g4 >= 2) { vr[st] = tr; vi[st] = ti; } } }
                float er[4], ei[4], lr[4], li[4];
#pragma unroll
                for (int st = 0; st < 4; ++st) { if (OUT) { er[st] = BPF(up16, vr[st]); ei[st] = BPF(up16, vi[st]); } else { er[st] = 0.f; ei[st] = 0.f; } lr[st] = BPF(last16, vr[st]); li[st] = BPF(last16, vi[st]); }
#undef BPF
#pragma unroll
                for (int st = 0; st < 4; ++st) {
                    if (g4 == 0) { er[st] = 0.f; ei[st] = 0.f; }
                    if (OUT) { float s0r, s0i; cmul_add(s0r, s0i, pwr[st], pwi[st], sr[st], si[st], er[st], ei[st]);
#pragma unroll
                        for (int i = 0; i < 4; ++i) { float tr, ti; cmul_add(tr, ti, a1r[st], a1i[st], s0r, s0i, 0.f, 0.f); s0r = tr; s0i = ti; dr[st][i] += s0r; di[st][i] += s0i; } }
                    { float a16r, a16i; cmul_add(a16r, a16i, a8r[st], a8i[st], a8r[st], a8i[st], 0.f, 0.f); float tr, ti; cmul_add(tr, ti, a16r, a16i, sr[st], si[st], lr[st], li[st]); sr[st] = tr; si[st] = ti; }
                    if (OUT) {
#pragma unroll
                        for (int i = 0; i < 4; ++i) { const unsigned hw = pk2(dr[st][i], di[st][i]); Hb[(4 * g4 + i) * HLD + 16 * st + l15] = (bf16)hw; Hb[(4 * g4 + i) * HLD + 64 + 16 * st + l15] = (bf16)(hw >> 16); } }
                }
                if (OUT) {
                    LDS_WAIT(); asm volatile("" ::: "memory");
                    f32x4 ya = (f32x4){0.f, 0.f, 0.f, 0.f};
#pragma unroll
                    for (int s = 0; s < 4; ++s) ya = MFMA16(cf[s], row_frag(Hb, HLD, 0, 32 * s, lane), ya);
                    const u32x2 u2 = *(const LAS u32x2*)(ut + (blk * 16 + l15) * 16 + 4 * g4);
                    const f32x4 u4 = (f32x4){bflo(u2.x), bfhi(u2.x), bflo(u2.y), bfhi(u2.y)};
                    f32x4 y = ya + dsk * u4;
#pragma unroll
                    for (int j = 0; j < 4; ++j) { const float v = y[j]; y[j] = v * fsig(1.5957691216057308f * (v + 0.044715f * v * v * v)); }
                    u32x2 o; o.x = pk2(y[0], y[1]); o.y = pk2(y[2], y[3]);
                    *(u32x2*)(ybuf + (tok0 + sub * 64 + blk * 16 + l15) * D + g * SGC + 4 * g4) = o;
                    asm volatile("" ::: "memory"); }
            }
            LDS_WAIT(); asm volatile("" ::: "memory");
        }
        if (!OUT && g4 == 0) {
#pragma unroll
            for (int st = 0; st < 4; ++st) { Eu[16 * st + l15] = sr[st]; Eu[64 + 16 * st + l15] = si[st]; } }
    }
}
__device__ __forceinline__ void phase_s5_carry(const Frame& F, KP p) {
    float* E = (float*)(F.ws + WS_AUX + AUX_S5E);
    for (int gt = F.vcu * NTHREADS + F.tid; gt < BATCH * SG * SP; gt += F.G * NTHREADS) {
        const int pl = gt & 63, bg = gt >> 6, g = bg & 63;
        const float dt = expf(gin(p, 14)[g]); const float are = gin(p, 7)[g * SP + pl], aim = gin(p, 8)[g * SP + pl];
        const float mag = expf(dt * are); float ar = mag * cosf(dt * aim), ai = mag * sinf(dt * aim);
#pragma unroll
        for (int q = 0; q < 8; ++q) { const float nr = ar * ar - ai * ai, ni = 2.0f * ar * ai; ar = nr; ai = ni; }
        float cr = 0.f, ci = 0.f;
        for (int n = 0; n < S5NC; ++n) { float* Eu = E + ((size_t)bg * S5NC + n) * 128; const float er = Eu[pl], ei = Eu[64 + pl];
            Eu[pl] = cr; Eu[64 + pl] = ci;
            const float nr = ar * cr - ai * ci + er, ni = ar * ci + ai * cr + ei; cr = nr; ci = ni; }
    }
}

constexpr int NPHASES = 34;
#ifndef PROBE_DRY14
#define PROBE_DRY14 0
#endif
#ifndef PROBE_DRY17
#define PROBE_DRY17 0
#endif
#ifndef PH_MASK
#define PH_MASK 0xFFFFFFFFu
#endif
#define PHT(t) ((PH_MASK >> (t)) & 1u)
constexpr int PLAN_OFF = 64;
__device__ __forceinline__ void moe_plan(const Frame& F, int layer) {
    volatile LAS int* tstart = (volatile LAS int*)(F.MISC + PLAN_OFF); volatile LAS int* cnts = tstart + 72;
    __syncthreads();
    if (F.wave == 0) {
        const unsigned* cnt = (const unsigned*)(F.ws + WS_CTL) + CW_CNT + layer * NE * 64;
        const int c = (int)__hip_atomic_load(cnt + F.lane * 64, __ATOMIC_RELAXED, __HIP_MEMORY_SCOPE_AGENT);
        int v = (c + 255) >> 8;
#pragma unroll
        for (int o = 1; o < 64; o <<= 1) { const int nb = __builtin_amdgcn_ds_bpermute((F.lane - o) << 2, v); if (F.lane >= o) v += nb; }
        tstart[F.lane + 1] = v; cnts[F.lane] = c;
        if (F.lane == 0) tstart[0] = 0;
        if (F.lane == 63) { tstart[65] = v + T / 256; cnts[64] = T; }
    }
    __syncthreads();
}
template <bool GATH> struct MoeSched2 {
    static constexpr bool GATHER = GATH, UNIFORMIZE = true, FP8 = GATH;
    static constexpr int ncol = GATH ? 2 : 4, K = GATH ? D / 2 : ED;
    const volatile LAS int* tstart; const volatile LAS int* cnts; int ntiles, G, c, lane;
    const char* Abase; const char* Wbase; const int* lists;
    __device__ __forceinline__ bool next(int i, pg8::UnitG& u) const {
        const int nwg = ntiles * ncol; const long L = (long)i * G + c; if (L >= nwg) return false;
        int wgid = (int)L; { const int q = nwg / 8, r = nwg % 8, xcd = wgid % 8, off = wgid / 8; wgid = (xcd < r ? xcd * (q + 1) : r * (q + 1) + (xcd - r) * q) + off; }
        const int tile = wgid / ncol, pn = wgid % ncol;
        const int ta = tstart[lane], tb = tstart[lane + 1];
        const unsigned long long mm = __ballot(ta <= tile && tile < tb);
        const int e = mm ? (int)__builtin_ctzll(mm) : 64;
        const int ts = __builtin_amdgcn_readfirstlane((int)tstart[e]), ce = __builtin_amdgcn_readfirstlane((int)cnts[e]);
        const int lt = tile - ts; int valid = ce - lt * 256; valid = valid > 256 ? 256 : valid;
        u.gshift = 0; u.aux = e;
        if (GATH) {
            u.B = Wbase + (size_t)e * WMOE_E_BYTES + (size_t)pn * 256 * K * 2;
            if (e < 64) { u.A = Abase; u.gidx = lists + (size_t)e * T + lt * 256; u.gcnt = valid; }
            else { u.A = Abase + (size_t)lt * 256 * K * 2; u.gidx = nullptr; u.gcnt = 0; }
            u.row0 = tile * 256; u.col0 = pn * 128;
        } else {
            u.B = Wbase + (size_t)e * WMOE_E_BYTES + (size_t)512 * 1024 * 2 + (size_t)pn * 256 * K * 2;
            u.A = Abase + (size_t)tile * 256 * K * 2; u.gidx = nullptr; u.gcnt = valid;
            u.row0 = tile * 256; u.col0 = pn * 256;
        }
        return true;
    }
};
__device__ __forceinline__ void phase_load_x(const Frame& F, KP p) {
    const float* xin = gin(p, 0); bf16* XB = (bf16*)(F.ws + WS_XB);
    for (size_t i = (size_t)F.vcu * NTHREADS + F.tid; i < (size_t)T * D / 8; i += (size_t)F.G * NTHREADS) {
        const f32x4 a = *(const f32x4*)(xin + i * 8), b = *(const f32x4*)(xin + i * 8 + 4);
        *(u32x4*)(XB + i * 8) = pack_bf16x8(a, b);
        u32x2 q8; q8.x = pk4_fp8(a[0], a[1], a[2], a[3]); q8.y = pk4_fp8(b[0], b[1], b[2], b[3]); *(u32x2*)((unsigned char*)(F.ws + WS_X) + i * 8) = q8; }
}

__global__ void __launch_bounds__(NTHREADS, 2) fwd_kernel(Params p_unused) {
    KP p0 = (KP)__builtin_amdgcn_kernarg_segment_ptr();
    extern __shared__ __attribute__((aligned(16))) unsigned char lds_raw[];
    Frame F0;
    F0.lds = (LAS unsigned char*)lds_raw; F0.MISC = (volatile LAS unsigned*)(F0.lds + MISC_OFF);
    F0.tid = threadIdx.x; F0.lane = F0.tid & 63; F0.wave = __builtin_amdgcn_readfirstlane(F0.tid >> 6);
    F0.G = gridDim.x; { const int bq = blockIdx.x; F0.vcu = (F0.G % 8 == 0) ? (bq % 8) * (F0.G / 8) + bq / 8 : bq; }
    F0.ws = p0->ws;
    const int bx0 = blockIdx.x;
    for (int u = F0.tid; u < (LDS_BYTES - MISC_OFF) / 4; u += NTHREADS) ((LAS unsigned*)(F0.lds + MISC_OFF))[u] = 0u;
    __syncthreads();
    XcdBarrier bar; bar.bar = (unsigned*)(p0->ws + WS_CTL) + CW_BAR; bar.x = 0; bar.st = nullptr;
    const int use_bar = p0->use_bar;
    if (use_bar) bar = xcd_barrier_post((unsigned*)(p0->ws + WS_CTL) + CW_BAR, F0.MISC + 8);
    const int lo = p0->ph_lo, hi = p0->ph_hi;
#define PHASE_BEGIN Frame F = F0; KP p = p0; { unsigned ones_ = ~0u; asm volatile("" : "+s"(ones_)); F.lane = (int)__builtin_amdgcn_mbcnt_hi(ones_, __builtin_amdgcn_mbcnt_lo(ones_, 0u)); } asm volatile("" : "+v"(F.lane)); F.tid = F.wave * 64 + F.lane; asm volatile("" : "+v"(F.tid));   GAS unsigned char* wsg_ = (GAS unsigned char*)F0.ws; asm volatile("" : "+s"(F.wave), "+s"(F.vcu), "+s"(F.G), "+s"(wsg_), "+s"(p)); \
    F.ws = (unsigned char*)wsg_; int bx = bx0; asm volatile("" : "+s"(bx)); unsigned char* ws = F.ws; (void)ws; (void)bx;
#pragma unroll 1
    for (int ph = lo; ph < hi; ++ph) {
        int layer = 0, type = 0;
        if (ph > 0) { layer = ph >= 26 ? 3 : (ph >= 18 ? 2 : (ph >= 9 ? 1 : 0)); const int q = ph - (layer == 3 ? 26 : (layer == 2 ? 18 : (layer == 1 ? 9 : 1))); const int kind = layer % 3;
            if (kind == 0) type = q < 4 ? 1 + q : 14 + (q - 4); else if (kind == 1) type = q < 5 ? 5 + q : 14 + (q - 5); else type = q < 4 ? 10 + q : 14 + (q - 4); }
        const int j = layer / 3;
#ifdef REPEAT_MASK
        const int nrep = ((REPEAT_MASK >> type) & 1u) ? 2 : 1;
#else
        const int nrep = 1;
#endif
#pragma unroll 1
        for (int rep = 0; rep < nrep; ++rep) {
        if (rep > 0 && use_bar) xcd_barrier(bar);
        if (PHT(0) && type == 0) { PHASE_BEGIN; phase_conv_mixers(F, p); phase_conv_moe(F, p, 0); phase_load_x(F, p); }
        else if (PHT(1) && type == 1) { PHASE_BEGIN; DenseSched8 S; S.init(ws + WS_X, ws + WS_ATT_IN_T + (size_t)j * ATT_IN * D, T, ATT_IN, D / 2, F.G, bx); EpiStoreBf16 E{(bf16*)(ws + WS_BIG), ATT_IN, WUP_INV, 0.08838834764831845f};
            pg8::gemm_phase(F.lds, F.tid, D / 2, S, E); }
        else if (PHT(2) && type == 2) { PHASE_BEGIN; phase_attn(F, bx); }
        else if (PHT(3) && type == 3) { PHASE_BEGIN; phase_attn_combine(F); }
        else if (PHT(4) && type == 4) { PHASE_BEGIN; DenseSched S; S.init(ws + WS_AUX + AUX_OB, ws + WS_ATT_OUT_T + (size_t)j * D * D * 2, T, D, D, F.G, bx); EpiResid E{(const bf16*)(ws + WS_XB), (bf16*)(ws + WS_Y)};
            pg8::gemm_phase(F.lds, F.tid, D, S, E); }
        else if (PHT(5) && type == 5) { PHASE_BEGIN; DenseSched8 S; S.init(ws + WS_X, ws + WS_RET_IN_T, T, RET_IN, D / 2, F.G, bx); EpiRetIn E{(bf16*)(ws + WS_BIG), RET_IN};
            pg8::gemm_phase(F.lds, F.tid, D / 2, S, E); }
        else if (PHT(6) && type == 6) { PHASE_BEGIN; phase_ret_u(F); }
        else if (PHT(7) && type == 7) { PHASE_BEGIN; phase_ret_scan(F); }
        else if (PHT(8) && type == 8) { PHASE_BEGIN; phase_ret_out(F, p); }
        else if (PHT(9) && type == 9) { PHASE_BEGIN; DenseSched S; S.init(ws + WS_BIG + BIG_YRET, ws + WS_RET_OUT_T, T, D, RET_V, F.G, bx); EpiResid E{(const bf16*)(ws + WS_XB), (bf16*)(ws + WS_Y)};
            pg8::gemm_phase(F.lds, F.tid, RET_V, S, E); }
        else if (PHT(10) && type == 10) { PHASE_BEGIN; phase_s5_scan<false>(F, p); }
        else if (PHT(11) && type == 11) { PHASE_BEGIN; phase_s5_carry(F, p); }
        else if (PHT(12) && type == 12) { PHASE_BEGIN; phase_s5_scan<true>(F, p); }
        else if (PHT(13) && type == 13) { PHASE_BEGIN; DenseSched S; S.init(ws + WS_AUX, ws + WS_GLU_T, T, 2 * D, D, F.G, bx); EpiGluResid E{(const bf16*)(ws + WS_XB), (bf16*)(ws + WS_Y)};
            pg8::gemm_phase(F.lds, F.tid, D, S, E); }
        else if (PHT(14) && type == 14) { PHASE_BEGIN; phase_lnr(F, p, layer, PROBE_DRY14 && true); if (PROBE_DRY14) { if (use_bar) xcd_barrier(bar); phase_lnr(F, p, layer, false); } }
        else if (PHT(15) && type == 15) { PHASE_BEGIN; moe_plan(F, layer);
            MoeSched2<true> S; S.tstart = (const volatile LAS int*)(F.MISC + PLAN_OFF); S.cnts = S.tstart + 72; S.ntiles = __builtin_amdgcn_readfirstlane((int)S.tstart[65]); S.G = F.G; S.c = bx; S.lane = F.lane;
            S.Abase = (const char*)(ws + WS_X); S.Wbase = (const char*)(ws + WS_WMOE); S.lists = (const int*)(ws + WS_LIST);
            EpiMoeUp E{(bf16*)(ws + WS_H)};
            pg8::gemm_phase(F.lds, F.tid, D / 2, S, E); }
        else if (PHT(16) && type == 16) { PHASE_BEGIN; moe_plan(F, layer);
            { MoeSched2<false> S; S.tstart = (const volatile LAS int*)(F.MISC + PLAN_OFF); S.cnts = S.tstart + 72; S.ntiles = __builtin_amdgcn_readfirstlane((int)S.tstart[64]); S.G = F.G; S.c = bx; S.lane = F.lane;
              S.Abase = (const char*)(ws + WS_H); S.Wbase = (const char*)(ws + WS_WMOE); S.lists = (const int*)(ws + WS_LIST);
              EpiStoreFp8 E{(unsigned char*)(ws + WS_BIG), D};
              pg8::gemm_phase(F.lds, F.tid, ED, S, E); }
            { const int sh0 = __builtin_amdgcn_readfirstlane((int)((const volatile LAS int*)(F.MISC + PLAN_OFF))[64]);
              DenseSched S; S.init(ws + WS_H + (size_t)sh0 * 256 * ED * 2, ws + WS_WMOE + (size_t)64 * WMOE_E_BYTES + (size_t)512 * 1024 * 2, T, D, ED, F.G, bx); EpiResid E{(const bf16*)(ws + WS_XB), (bf16*)(ws + WS_Y)};
              pg8::gemm_phase(F.lds, F.tid, ED, S, E); } }
        else if (PHT(17) && type == 17) { PHASE_BEGIN; moe_plan(F, layer); if (PROBE_DRY17) { phase_combine(F, p, layer, true); if (use_bar) xcd_barrier(bar); } phase_combine(F, p, layer); if (layer + 1 < DEPTH) phase_conv_moe(F, p, layer + 1); }
        }
        if (use_bar && ph + 1 < hi) xcd_barrier(bar);
    }
}

#ifndef MK_PER_PHASE
#define MK_PER_PHASE 0
#endif
extern "C" void kernel_launch(void* const* d_in, const int* in_sizes, int n_in, void* d_out, int out_size, void* d_ws, size_t ws_size, hipStream_t stream) {
    static int grid = 0;
    if (grid == 0) {
        if (n_in != 26 || in_sizes[0] != T * D || out_size != T * D || ws_size < WS_END) { fprintf(stderr, "kernel_launch: unexpected shapes / workspace (n_in %d, in0 %d, out %d, ws %zu < %zu)\n", n_in, n_in > 0 ? in_sizes[0] : -1, out_size, ws_size, (size_t)WS_END); grid = -1; return; }
        int dev = 0, cus = 0, per_cu = 0;
        if (hipGetDevice(&dev) != hipSuccess || hipDeviceGetAttribute(&cus, hipDeviceAttributeMultiprocessorCount, dev) != hipSuccess) { grid = -1; return; }
        if (hipFuncSetAttribute((const void*)fwd_kernel, hipFuncAttributeMaxDynamicSharedMemorySize, LDS_BYTES) != hipSuccess) { fprintf(stderr, "kernel_launch: hipFuncSetAttribute failed\n"); grid = -1; return; }
        if (hipOccupancyMaxActiveBlocksPerMultiprocessor(&per_cu, (const void*)fwd_kernel, NTHREADS, LDS_BYTES) != hipSuccess || per_cu < 1) { fprintf(stderr, "kernel_launch: occupancy query says %d blocks per CU\n", per_cu); per_cu = 1; }
        (void)hipGetLastError();
        grid = cus;
    }
    if (grid < 0) return;
    (void)hipMemsetAsync((char*)d_ws + WS_CTL, 0, CTL_ZERO_BYTES, stream);
    Params p{};
    for (int i = 0; i < 26; ++i) p.in[i] = (const float*)d_in[i];
    p.out = (float*)d_out; p.ws = (unsigned char*)d_ws;
#if MK_PER_PHASE
    for (int k = 0; k < NPHASES; ++k) { p.ph_lo = k; p.ph_hi = k + 1; p.use_bar = 0; hipLaunchKernelGGL(fwd_kernel, dim3(grid), dim3(NTHREADS), LDS_BYTES, stream, p); }
#else
    p.ph_lo = 0; p.ph_hi = NPHASES; p.use_bar = 1;
    hipLaunchKernelGGL(fwd_kernel, dim3(grid), dim3(NTHREADS), LDS_BYTES, stream, p);
#endif
}
```

```cpp
#include <hip/hip_runtime.h>
#include <cstdio>
#include <cstdint>

#define LAS __attribute__((address_space(3)))
#define GAS __attribute__((address_space(1)))
typedef unsigned short bf16;
typedef short bf16x8 __attribute__((ext_vector_type(8)));
typedef short bf16x4 __attribute__((ext_vector_type(4)));
typedef float f32x4 __attribute__((ext_vector_type(4)));
typedef float f32x2 __attribute__((ext_vector_type(2)));
typedef unsigned u32x4 __attribute__((ext_vector_type(4)));
typedef unsigned u32x2 __attribute__((ext_vector_type(2)));
typedef GAS unsigned gu32;

constexpr int D = 1024, BATCH = 2, SEQ = 8192, T = BATCH * SEQ, DEPTH = 4;
constexpr int AH = 8, AHD = 128, ATT_IN = 9216;
constexpr int RH = 4, RDK = 256, RDV = 512, RET_IN = 6144, RET_V = 2048, RC = 128, RNC = SEQ / RC;
constexpr int SG = 64, SGC = 16, SP = 64;
constexpr int NE = 64, TOPK = 8, NEG = 8, ED = 256, NSLOT = 9;
constexpr float LN_EPS = 1e-5f;
constexpr float ALPHA = 1.6817928305074292f;
constexpr int NWAVES = 8, NTHREADS = 512;

__device__ __forceinline__ unsigned f2bf(float f) { unsigned u = __builtin_bit_cast(unsigned, f); return (u + 0x7fffu + ((u >> 16) & 1u)) >> 16; }
__device__ __forceinline__ unsigned pk2(float lo, float hi) { unsigned r; asm("s_nop 1\n\tv_cvt_pk_bf16_f32 %0, %1, %2" : "=v"(r) : "v"(lo), "v"(hi)); return r; }
__device__ __forceinline__ unsigned pk2sw(float lo, float hi) { return f2bf(lo) | (f2bf(hi) << 16); }
__device__ __forceinline__ unsigned pk2hw(float lo, float hi) { unsigned r; asm volatile("v_cvt_pk_bf16_f32 %0, %1, %2" : "=v"(r) : "v"(lo), "v"(hi)); return r; }
__device__ __forceinline__ float bf2f(unsigned b) { return __builtin_bit_cast(float, b << 16); }
__device__ __forceinline__ float bflo(unsigned w) { return __builtin_bit_cast(float, w << 16); }
__device__ __forceinline__ float bfhi(unsigned w) { return __builtin_bit_cast(float, w & 0xffff0000u); }
__device__ __forceinline__ float shx(float v, int m, int lane) { return __builtin_bit_cast(float, __builtin_amdgcn_ds_bpermute((lane ^ m) << 2, __builtin_bit_cast(int, v))); }
__device__ __forceinline__ int shx_i(int v, int m, int lane) { return __builtin_amdgcn_ds_bpermute((lane ^ m) << 2, v); }
__device__ __forceinline__ float rdl(float v, int src) { return __builtin_bit_cast(float, __builtin_amdgcn_readlane(__builtin_bit_cast(int, v), src)); }
template <int CTRL, int RM = 0xf, int BM = 0xf> __device__ __forceinline__ float dpp0(float v) { return __builtin_bit_cast(float, __builtin_amdgcn_update_dpp(0, __builtin_bit_cast(int, v), CTRL, RM, BM, true)); }
template <int CTRL, int RM = 0xf, int BM = 0xf> __device__ __forceinline__ float dppo(float old, float v) { return __builtin_bit_cast(float, __builtin_amdgcn_update_dpp(__builtin_bit_cast(int, old), __builtin_bit_cast(int, v), CTRL, RM, BM, false)); }
__device__ __forceinline__ float wave_sum(float v, int lane) {
    (void)lane;
    v += dpp0<0x111>(v); v += dpp0<0x112>(v); v += dpp0<0x114>(v); v += dpp0<0x118>(v);
    v += dpp0<0x142, 0xa>(v);
    v += dpp0<0x143, 0xc>(v);
    return rdl(v, 63);
}
__device__ __forceinline__ float max8(float v) {
    v = fmaxf(v, dppo<0xb1>(v, v)); v = fmaxf(v, dppo<0x4e>(v, v)); v = fmaxf(v, dppo<0x141>(v, v)); return v;
}
__device__ __forceinline__ float fsig(float x) { return __builtin_amdgcn_rcpf(1.0f + __expf(-x)); }
#define LDS_WAIT() asm volatile("s_waitcnt lgkmcnt(0)" ::: "memory")
#define VM_WAIT() asm volatile("s_waitcnt vmcnt(0)" ::: "memory")
__device__ __forceinline__ const char* rfl_ptr(const char* p) {
    unsigned long long v = (unsigned long long)p; unsigned lo = __builtin_amdgcn_readfirstlane((unsigned)v), hi = __builtin_amdgcn_readfirstlane((unsigned)(v >> 32));
    return (const char*)(((unsigned long long)hi << 32) | lo);
}
__device__ __forceinline__ bf16x8 row_frag(const LAS bf16* base, int ld, int row0, int col0, int lane) {
    return *(const LAS bf16x8*)(base + (row0 + (lane & 15)) * ld + col0 + 8 * (lane >> 4));
}
__device__ __forceinline__ bf16x4 tr4(const LAS bf16* addr) { return __builtin_amdgcn_ds_read_tr16_b64_v4i16((LAS bf16x4*)addr); }
__device__ __forceinline__ bf16x8 cat8(bf16x4 a, bf16x4 b) { bf16x8 r; r[0] = a[0]; r[1] = a[1]; r[2] = a[2]; r[3] = a[3]; r[4] = b[0]; r[5] = b[1]; r[6] = b[2]; r[7] = b[3]; return r; }
#define MFMA16(a, b, c) __builtin_amdgcn_mfma_f32_16x16x32_bf16((a), (b), (c), 0, 0, 0)
__device__ __forceinline__ bf16x8 pack8(f32x4 a, f32x4 b) {
    u32x4 w; w.x = pk2(a[0], a[1]); w.y = pk2(a[2], a[3]); w.z = pk2(b[0], b[1]); w.w = pk2(b[2], b[3]); return __builtin_bit_cast(bf16x8, w);
}

namespace pg8 {
typedef int v4i_t __attribute__((ext_vector_type(4)));
typedef int v8i_t __attribute__((ext_vector_type(8)));
constexpr int BM = 256, BK = 64, HALF = 128, HTB = HALF * BK * 2, STAGE_BYTES = 8 * HTB;
__device__ __forceinline__ int lds_byte(int r, int c) { const int st = (r >> 4) * 2 + (c >> 5), rr = r & 15, cc = c & 31, ob = rr * 64 + cc * 2; return st * 1024 + (ob ^ (((ob >> 9) & 1) << 5)); }
__device__ __forceinline__ void stage_rc(int b, int& R, int& C) { const int st = b / 1024, sb = b % 1024, swz = sb ^ (((sb >> 9) & 1) << 5); R = (st >> 1) * 16 + swz / 64; C = (st & 1) * 32 + (swz % 64) / 2; }
__device__ __forceinline__ int perm32(int rho) { const int n = rho >> 4, i = rho & 15; return 8 * (i >> 2) + 4 * n + (i & 3); }

struct UnitG {
    const char* A;
    const char* B;
    const int* gidx;
    int gcnt, gshift;
    int row0, col0;
    int aux;
};

__device__ __forceinline__ void uniformize(UnitG& u) { u.A = rfl_ptr(u.A); u.B = rfl_ptr(u.B); u.gidx = (const int*)rfl_ptr((const char*)u.gidx); u.gcnt = __builtin_amdgcn_readfirstlane(u.gcnt); u.gshift = __builtin_amdgcn_readfirstlane(u.gshift);
    u.row0 = __builtin_amdgcn_readfirstlane(u.row0); u.col0 = __builtin_amdgcn_readfirstlane(u.col0); u.aux = __builtin_amdgcn_readfirstlane(u.aux); }
template <class Epi, class Sched>
__device__ __forceinline__ void gemm_phase(LAS unsigned char* lds, const int tid, const int K, const Sched& S, const Epi& E) {
    constexpr bool F8 = Sched::FP8;
    constexpr bool GATHER = Sched::GATHER;
    const int wid = __builtin_amdgcn_readfirstlane(tid >> 6), lane = tid & 63, wr = wid >> 2, wc = wid & 3, fr = lane & 15, fq = lane >> 4;
    const int nt = K / BK;
    constexpr bool P16 = Epi::PERM16;
    unsigned voffB[2], voffB1[2], vA[2][2];
#pragma unroll
    for (int i = 0; i < 2; ++i) { int R, C; stage_rc(tid * 16 + i * 8192, R, C); const int Rb = Epi::PERM ? ((R & ~31) + perm32(R & 31)) : R; voffB[i] = (unsigned)(Rb * K + C) * 2u; voffB1[i] = voffB[i]; vA[0][i] = (unsigned)(R * K + C) * 2u; vA[1][i] = vA[0][i];
        if constexpr (P16) { const int x = R & 31, src = 64 * (R >> 5) + 16 * ((x >> 2) & 3) + 4 * (x >> 4) + (x & 3); voffB[i] = (unsigned)(src * K + C) * 2u; voffB1[i] = (unsigned)((src + 8) * K + C) * 2u; } }
    const size_t kstep = (size_t)(BK * 2);
    const size_t hstep = (size_t)HALF * K * 2;
    const size_t hstepB = P16 ? 0 : hstep;
    const size_t hstepA = GATHER ? 0 : hstep;
    const unsigned ldsw = (unsigned)wid * 1024u;
    const int aoff = F8 ? lds_byte(wr * 64 + fr, fq * 16) : lds_byte(wr * 64 + fr, fq * 8), boff = F8 ? lds_byte(wc * 32 + fr, fq * 16) : lds_byte(wc * 32 + fr, fq * 8);
    LAS u32x4* park = (LAS u32x4*)(lds + STAGE_BYTES) + tid;
#define PG8_SA(b, h) (((b) * 2 + (h)) * HTB)
#define PG8_SB(b, h) ((4 + (b) * 2 + (h)) * HTB)
#define PG8_STAGE(bufoff, gbase, voff) do { _Pragma("unroll") for (int _i = 0; _i < 2; ++_i) { asm volatile("" : "+v"((voff)[_i]));   \
        __builtin_amdgcn_global_load_lds((const unsigned*)((const char*)(gbase) + (voff)[_i]), (LAS unsigned*)(lds + (bufoff) + ldsw + _i * 8192), 16, 0, 0); } } while (0)
    constexpr int FKS = F8 ? 16 : 1024;
#define PG8_LD2(p_) __builtin_shufflevector(*(const LAS v4i_t*)(p_), *(const LAS v4i_t*)((p_) + FKS), 0, 1, 2, 3, 4, 5, 6, 7)
#define PG8_LDA(dst, b, h) do { _Pragma("unroll") for (int m = 0; m < 4; ++m) dst[m] = PG8_LD2(lds + PG8_SA(b, h) + aoff + m * 2048); } while (0)
#define PG8_LDB(dst, b, h) do { _Pragma("unroll") for (int n = 0; n < 2; ++n) dst[n] = PG8_LD2(lds + PG8_SB(b, h) + boff + n * 2048); } while (0)
#define PG8_LO(v) __builtin_bit_cast(bf16x8, __builtin_shufflevector((v), (v), 0, 1, 2, 3))
#define PG8_HI(v) __builtin_bit_cast(bf16x8, __builtin_shufflevector((v), (v), 4, 5, 6, 7))
#define PG8_MMA(ai, bj, At, Bt) do { __builtin_amdgcn_s_setprio(1); _Pragma("unroll") for (int m = 0; m < 4; ++m) _Pragma("unroll") for (int n = 0; n < 2; ++n) { \
        if constexpr (F8) { acc[ai][bj][m][n] = __builtin_amdgcn_mfma_scale_f32_16x16x128_f8f6f4(Bt[n], At[m], acc[ai][bj][m][n], 0, 0, 0, 0x7F7F7F7F, 0, 0x7F7F7F7F); } \
        else { acc[ai][bj][m][n] = __builtin_amdgcn_mfma_f32_16x16x32_bf16(PG8_LO(Bt[n]), PG8_LO(At[m]), acc[ai][bj][m][n], 0, 0, 0); \
               acc[ai][bj][m][n] = __builtin_amdgcn_mfma_f32_16x16x32_bf16(PG8_HI(Bt[n]), PG8_HI(At[m]), acc[ai][bj][m][n], 0, 0, 0); } } __builtin_amdgcn_s_setprio(0); } while (0)
#define PG8_WAIT_V(n) asm volatile("s_waitcnt vmcnt(" #n ")" ::: "memory")
#define PG8_WAIT_L(n) asm volatile("s_waitcnt lgkmcnt(" #n ")" ::: "memory")
#define PG8_BAR __builtin_amdgcn_s_barrier()
#define PG8_SCHED __builtin_amdgcn_sched_barrier(0)
#define PG8_VOFF(u, v00, v01, v10, v11) do { int _R0, _C0, _R1, _C1; stage_rc(tid * 16, _R0, _C0); stage_rc(tid * 16 + 8192, _R1, _C1); int _r00 = _R0, _r01 = _R1, _r10 = HALF + _R0, _r11 = HALF + _R1; \
        if ((u).gidx) { const GAS int* _gp = (const GAS int*)(u).gidx; const int _gc = (u).gcnt;     \
            const int _a = _gp[_r00 < _gc ? _r00 : 0] >> (u).gshift, _b = _gp[_r01 < _gc ? _r01 : 0] >> (u).gshift, _c = _gp[_r10 < _gc ? _r10 : 0] >> (u).gshift, _d = _gp[_r11 < _gc ? _r11 : 0] >> (u).gshift; \
            _r00 = _a; _r01 = _b; _r10 = _c; _r11 = _d; } \
        v00 = (unsigned)(_r00 * K + _C0) * 2u; v01 = (unsigned)(_r01 * K + _C1) * 2u; v10 = (unsigned)(_r10 * K + _C0) * 2u; v11 = (unsigned)(_r11 * K + _C1) * 2u; } while (0)
    UnitG cur, nxt; int ui = 0;
    if (!S.next(0, cur)) return;
    if constexpr (Sched::UNIFORMIZE) uniformize(cur);
    f32x4 acc[2][2][4][2];
#pragma unroll
    for (int a = 0; a < 2; ++a)
#pragma unroll
        for (int b = 0; b < 2; ++b)
#pragma unroll
            for (int m = 0; m < 4; ++m)
#pragma unroll
                for (int n = 0; n < 2; ++n) acc[a][b][m][n] = (f32x4){0.f, 0.f, 0.f, 0.f};
    v8i_t At[4], B0[2], B1[2];
    if constexpr (GATHER) PG8_VOFF(cur, vA[0][0], vA[0][1], vA[1][0], vA[1][1]);
    const char* cA = cur.A; const char* cB = cur.B;
    PG8_STAGE(PG8_SB(0, 0), cB, voffB); PG8_STAGE(PG8_SB(0, 1), cB + hstepB, voffB1); PG8_STAGE(PG8_SA(0, 0), cA, vA[0]); PG8_STAGE(PG8_SA(0, 1), cA + hstepA, vA[1]);
    if (wr == 1) PG8_BAR;
    PG8_WAIT_V(2); PG8_BAR;
    PG8_STAGE(PG8_SB(1, 0), cB + kstep, voffB); PG8_STAGE(PG8_SA(1, 0), cA + kstep, vA[0]); PG8_STAGE(PG8_SB(1, 1), cB + hstepB + kstep, voffB1);
    PG8_WAIT_V(6); PG8_BAR;
    for (;;) {
        const bool has_next = S.next(ui + 1, nxt);
        if constexpr (Sched::UNIFORMIZE) { if (has_next) uniformize(nxt); }
        const char* nA = cA; const char* nB = cB;
        if (has_next) { nA = nxt.A; nB = nxt.B; }
        if constexpr (GATHER) { u32x4 pv; pv.x = vA[0][0]; pv.y = vA[0][1]; pv.z = vA[1][0]; pv.w = vA[1][1];
            if (has_next) PG8_VOFF(nxt, pv.x, pv.y, pv.z, pv.w);
            *park = pv; }
#pragma unroll 1
        for (int t = 0; t < nt; t += 2) {
            const bool last = (t == nt - 2);
            const char* a1 = cA + (size_t)(t + 1) * kstep;
            const char* a2 = last ? nA : cA + (size_t)(t + 2) * kstep; const char* b2 = last ? nB : cB + (size_t)(t + 2) * kstep;
            const char* a3 = a2 + kstep; const char* b3 = b2 + kstep;
            PG8_LDB(B0, 0, 0); PG8_LDB(B1, 0, 1); PG8_SCHED; PG8_LDA(At, 0, 0); PG8_STAGE(PG8_SA(1, 1), a1 + hstepA, vA[1]);
            PG8_WAIT_V(8); PG8_WAIT_L(0); PG8_BAR; PG8_MMA(0, 0, At, B0); PG8_MMA(0, 1, At, B1); PG8_BAR; PG8_SCHED;
            if constexpr (GATHER) { if (last) { const u32x4 pv = *park; vA[0][0] = pv.x; vA[0][1] = pv.y; vA[1][0] = pv.z; vA[1][1] = pv.w; } }
            PG8_LDA(At, 0, 1); PG8_STAGE(PG8_SB(0, 0), b2, voffB); PG8_STAGE(PG8_SB(0, 1), b2 + hstepB, voffB1); PG8_STAGE(PG8_SA(0, 0), a2, vA[0]);
            PG8_WAIT_V(8); PG8_WAIT_L(0); PG8_BAR; PG8_MMA(1, 0, At, B0); PG8_MMA(1, 1, At, B1); PG8_BAR; PG8_SCHED;
            PG8_LDB(B0, 1, 0); PG8_LDB(B1, 1, 1); PG8_SCHED; PG8_LDA(At, 1, 0); PG8_STAGE(PG8_SA(0, 1), a2 + hstepA, vA[1]);
            PG8_WAIT_V(8); PG8_WAIT_L(0); PG8_BAR; PG8_MMA(0, 0, At, B0); PG8_MMA(0, 1, At, B1); PG8_BAR; PG8_SCHED;
            PG8_LDA(At, 1, 1); PG8_STAGE(PG8_SB(1, 0), b3, voffB); PG8_STAGE(PG8_SB(1, 1), b3 + hstepB, voffB1); PG8_STAGE(PG8_SA(1, 0), a3, vA[0]);
            PG8_WAIT_V(8); PG8_WAIT_L(0); PG8_BAR; PG8_MMA(1, 0, At, B0); PG8_MMA(1, 1, At, B1); PG8_BAR; PG8_SCHED;
        }
        if (wr == 0) PG8_BAR;
        E(acc, cur, wr, wc, fr, fq);
        if (!has_next) break;
#pragma unroll
        for (int a = 0; a < 2; ++a)
#pragma unroll
            for (int b = 0; b < 2; ++b)
#pragma unroll
                for (int m = 0; m < 4; ++m)
#pragma unroll
                    for (int n = 0; n < 2; ++n) acc[a][b][m][n] = (f32x4){0.f, 0.f, 0.f, 0.f};
        cur = nxt; cA = nA; cB = nB; ++ui;
        if (wr == 1) PG8_BAR;
    }
    PG8_WAIT_V(0);
    PG8_BAR;
#undef PG8_SA
#undef PG8_SB
#undef PG8_STAGE
#undef PG8_LDA
#undef PG8_LDB
#undef PG8_LD2
#undef PG8_LO
#undef PG8_HI
#undef PG8_MMA
#undef PG8_WAIT_V
#undef PG8_WAIT_L
#undef PG8_BAR
#undef PG8_SCHED
#undef PG8_VOFF
}
}

constexpr size_t MiB = 1u << 20;
constexpr size_t WS_CTL = 0, CTL_ZERO_BYTES = 1 * MiB;
constexpr size_t WS_ATT_IN_T = 1 * MiB;
constexpr size_t WS_ATT_OUT_T = WS_ATT_IN_T + 36 * MiB;
constexpr size_t WS_RET_IN_T = WS_ATT_OUT_T + 4 * MiB;
constexpr size_t WS_RET_OUT_T = WS_RET_IN_T + 12 * MiB;
constexpr size_t WS_GLU_T = WS_RET_OUT_T + 4 * MiB;
constexpr size_t WS_RT_HI = WS_GLU_T + 4 * MiB;
constexpr size_t WS_RT_LO = WS_RT_HI + 512 * 1024;
constexpr size_t WS_WMOE = WS_RT_HI + 1 * MiB;
constexpr size_t WMOE_E_BYTES = (size_t)(512 * 1024 + 1024 * 256) * 2;
constexpr size_t WS_X = WS_WMOE + 98 * MiB;
constexpr size_t WS_Y = WS_X + 64 * MiB;
constexpr size_t WS_XB = WS_Y + 64 * MiB;
constexpr size_t WS_BIG = WS_XB + 32 * MiB;
constexpr size_t WS_AUX = WS_BIG + 288 * MiB;
constexpr size_t WS_H = WS_AUX + 160 * MiB;
constexpr size_t WS_LIST = WS_H + 80 * MiB;
constexpr size_t WS_TRASH = WS_LIST + 8 * MiB;
constexpr size_t WS_END = WS_TRASH + 1 * MiB;
static_assert(WS_END <= 1024 * MiB, "workspace map");
constexpr int CW_BAR = 4096;
constexpr int CW_CNT = 16384;
constexpr int CW_CHK = 65536;
constexpr int HROWS = 163840;

#define XB_TMO      128
#define XB_XCNT(j)  (256  + 64 * (j))
#define XB_XSUB(j)  (1280 + 64 * (j))
#define XB_XGEN(j)  (2304 + 64 * (j))
#define XB_TOP      3328
#define XB_TOPGEN   3392
#define XCD_BAR_WORDS 3456
#define XB_SPIN_CAP (1u << 20)
__device__ __forceinline__ unsigned xb_ld(unsigned* p)              { return __hip_atomic_load(p, __ATOMIC_RELAXED, __HIP_MEMORY_SCOPE_AGENT); }
__device__ __forceinline__ unsigned xb_add(unsigned* p, unsigned v) { return __hip_atomic_fetch_add(p, v, __ATOMIC_RELAXED, __HIP_MEMORY_SCOPE_AGENT); }
__device__ __forceinline__ unsigned xb_xcc_id() { return (unsigned)__builtin_amdgcn_s_getreg((3 << 11) | 20) & 0xFu; }
#define XB_SPIN(cond, bar) do { unsigned _sp = 0; while (cond) { __builtin_amdgcn_s_sleep(1); \
    if ((++_sp & 255u) == 0u) { if (xb_ld(&(bar)[XB_TMO])) break; if (_sp > XB_SPIN_CAP) { atomicAdd(&(bar)[XB_TMO], 1u); break; } } } } while (0)
struct XcdBarrier { unsigned* bar; unsigned x; volatile LAS unsigned* st; };
__device__ __forceinline__ XcdBarrier xcd_barrier_post(unsigned* bar, volatile LAS unsigned* st) {
    XcdBarrier b; b.bar = bar; b.x = xb_xcc_id(); b.st = st;
    if (threadIdx.x == 0) (void)xb_add(&bar[XB_XCNT(b.x)], 1u);
    return b;
}
__device__ __forceinline__ void xcd_barrier_complete(unsigned* bar, unsigned x, unsigned& nloc, unsigned& nx) {
    const unsigned G = gridDim.x * gridDim.y * gridDim.z;
    unsigned sum, cnt, mine, sp = 0u;
    for (;;) {
        sum = 0u; cnt = 0u; mine = 0u;
#pragma unroll
        for (unsigned j = 0; j < 16; ++j) { const unsigned c = xb_ld(&bar[XB_XCNT(j)]); sum += c; cnt += (c > 0u) ? 1u : 0u; mine = (j == x) ? c : mine; }
        if (sum == G) break;
        __builtin_amdgcn_s_sleep(1);
        if ((++sp & 255u) == 0u) { if (xb_ld(&bar[XB_TMO])) break; if (sp > XB_SPIN_CAP) { atomicAdd(&bar[XB_TMO], 1u); break; } }
    }
    nloc = mine > 0u ? mine : 1u; nx = cnt > 0u ? cnt : 1u;
}
__device__ __forceinline__ void xcd_barrier(const XcdBarrier& b) {
    asm volatile("s_waitcnt vmcnt(0)" ::: "memory");
    __syncthreads();
    if (threadIdx.x == 0) {
        unsigned* bar = b.bar;
        __builtin_amdgcn_s_waitcnt(0);
        unsigned nloc = b.st[0], nx = b.st[1];
        if (nloc == 0u) { xcd_barrier_complete(bar, b.x, nloc, nx); b.st[0] = nloc; b.st[1] = nx; }
        const unsigned old = xb_add(&bar[XB_XSUB(b.x)], 1u);
        const unsigned gen = old / nloc;
        if (old + 1u == (gen + 1u) * nloc) {
            __builtin_amdgcn_fence(__ATOMIC_RELEASE, "agent");
            asm volatile("s_waitcnt vmcnt(0)" ::: "memory");
            const unsigned og = xb_add(&bar[XB_TOP], 1u);
            const unsigned tg = og / nx;
            if (og + 1u == (tg + 1u) * nx) xb_add(&bar[XB_TOPGEN], 1u);
            else XB_SPIN(xb_ld(&bar[XB_TOPGEN]) == tg, bar);
            __builtin_amdgcn_fence(__ATOMIC_ACQUIRE, "agent");
            xb_add(&bar[XB_XGEN(b.x)], 1u);
            asm volatile("s_waitcnt vmcnt(0)" ::: "memory");
        } else {
            XB_SPIN(xb_ld(&bar[XB_XGEN(b.x)]) == gen, bar);
            __builtin_amdgcn_fence(__ATOMIC_ACQUIRE, "agent");
            asm volatile("s_waitcnt vmcnt(0)" ::: "memory");
        }
    }
    __syncthreads();
}

constexpr int RING_BYTES = 139264;
constexpr int MISC_OFF = RING_BYTES;
constexpr int LDS_BYTES = 147456;
struct Params {
    const float* in[26]; float* out; unsigned char* ws; int ph_lo, ph_hi; int use_bar, pad;
};
typedef const __attribute__((address_space(4))) Params* KP;
__device__ __forceinline__ const float* gin(KP p, int i) { return (const float*)(const GAS float*)p->in[i]; }
__device__ __forceinline__ float* gout(KP p) { return (float*)(GAS float*)p->out; }
struct Frame {
    LAS unsigned char* lds; volatile LAS unsigned* MISC;
    int tid, lane, wave, vcu, G;
    unsigned char* ws;
};

template <bool F8_ = false> struct DenseSchedT {
    static constexpr bool GATHER = false, UNIFORMIZE = false, FP8 = F8_;
    const char* A; const char* Bt; int K, nM, nN, nwg, G, c;
    __device__ __forceinline__ void init(const void* A_, const void* Bt_, int M, int N, int K_, int G_, int c_) { A = (const char*)A_; Bt = (const char*)Bt_; K = K_; nM = M / 256; nN = N / 256; nwg = nM * nN; G = G_; c = c_; }
    __device__ __forceinline__ bool next(int i, pg8::UnitG& u) const {
        const long L = (long)i * G + c; if (L >= nwg) return false;
        int wgid = (int)L; { const int q = nwg / 8, r = nwg % 8, xcd = wgid % 8, off = wgid / 8; wgid = (xcd < r ? xcd * (q + 1) : r * (q + 1) + (xcd - r) * q) + off; }
        const int nig = 8 * nN, gid = wgid / nig, fm = gid * 8, gsz = (nM - fm) < 8 ? (nM - fm) : 8;
        const int pm = fm + ((wgid % nig) % gsz), pn = (wgid % nig) / gsz;
        u.A = A + (size_t)pm * 256 * K * 2; u.B = Bt + (size_t)pn * 256 * K * 2; u.gidx = nullptr; u.gcnt = 0; u.gshift = 0; u.row0 = pm * 256; u.col0 = pn * 256; u.aux = 0; return true;
    }
};
typedef DenseSchedT<false> DenseSched; typedef DenseSchedT<true> DenseSched8;
__device__ __forceinline__ u32x4 pack_bf16x8(const f32x4& v0, const f32x4& v1) { u32x4 w; w.x = pk2hw(v0[0], v0[1]); w.y = pk2hw(v0[2], v0[3]); w.z = pk2hw(v1[0], v1[1]); w.w = pk2hw(v1[2], v1[3]); return w; }

constexpr float WUP_SCALE = 32.0f, WUP_INV = 1.0f / 32.0f;
struct EpiStoreBf16 {
    static constexpr bool PERM = true, PERM16 = false;
    bf16* O; int ldc; float osc, qsc;
    __device__ __forceinline__ void operator()(const f32x4 (&acc)[2][2][4][2], const pg8::UnitG& u, int wr, int wc, int fr, int fq) const {
        const float sc = ((u.col0 % 3072) < 1024) ? osc * qsc : osc;
#pragma unroll
        for (int ai = 0; ai < 2; ++ai)
#pragma unroll
            for (int m = 0; m < 4; ++m) { bf16* rowp = O + (size_t)(u.row0 + ai * 128 + wr * 64 + m * 16 + fr) * ldc + u.col0 + wc * 32 + 8 * fq;
#pragma unroll
                for (int bj = 0; bj < 2; ++bj) *(u32x4*)(rowp + bj * 128) = pack_bf16x8(acc[ai][bj][m][0] * sc, acc[ai][bj][m][1] * sc); }
    }
};
constexpr float YEXP_SCALE = 32.0f, YEXP_INV = 1.0f / 32.0f;
struct EpiStoreFp8 {
    static constexpr bool PERM = false, PERM16 = true;
    unsigned char* O; int ldc;
    __device__ __forceinline__ void operator()(const f32x4 (&acc)[2][2][4][2], const pg8::UnitG& u, int wr, int wc, int fr, int fq) const {
#pragma unroll
        for (int ai = 0; ai < 2; ++ai)
#pragma unroll
            for (int m = 0; m < 4; ++m) { unsigned char* rowp = O + (size_t)(u.row0 + ai * 128 + wr * 64 + m * 16 + fr) * ldc + u.col0 + wc * 64 + 16 * fq;
                u32x4 w;
#pragma unroll
                for (int q = 0; q < 4; ++q) { f32x4 v = acc[ai][q >> 1][m][q & 1] * YEXP_SCALE;
#pragma unroll
                    for (int j = 0; j < 4; ++j) v[j] = fminf(fmaxf(v[j], -448.0f), 448.0f);
                    int d = 0; d = __builtin_amdgcn_cvt_pk_fp8_f32(v[0], v[1], d, false); d = __builtin_amdgcn_cvt_pk_fp8_f32(v[2], v[3], d, true); w[q] = (unsigned)d; }
                *(u32x4*)rowp = w; }
    }
};
struct EpiRetIn {
    static constexpr bool PERM = true, PERM16 = false;
    bf16* O; int ldc;
    __device__ __forceinline__ void operator()(const f32x4 (&acc)[2][2][4][2], const pg8::UnitG& u, int wr, int wc, int fr, int fq) const {
        float l2g = 0.f;
        float cs = WUP_INV;
        if (u.col0 < 2048) { const int h = (u.col0 & 1023) >> 8; const float g = 1.0f - exp2f(-5.0f - (float)h); l2g = log2f(g); if (u.col0 >= 1024) { l2g = -l2g; cs *= 0.0625f; } }
#pragma unroll
        for (int ai = 0; ai < 2; ++ai)
#pragma unroll
            for (int m = 0; m < 4; ++m) { const int row = u.row0 + ai * 128 + wr * 64 + m * 16 + fr; const float sc = exp2f(l2g * (float)(row & 127)) * cs;
                bf16* rowp = O + (size_t)row * ldc + u.col0 + wc * 32 + 8 * fq;
#pragma unroll
                for (int bj = 0; bj < 2; ++bj) *(u32x4*)(rowp + bj * 128) = pack_bf16x8(acc[ai][bj][m][0] * sc, acc[ai][bj][m][1] * sc); }
    }
};
__device__ __forceinline__ void unpack_bf16x8(const u32x4& w, f32x4& a, f32x4& b) { a[0] = bflo(w.x); a[1] = bfhi(w.x); a[2] = bflo(w.y); a[3] = bfhi(w.y); b[0] = bflo(w.z); b[1] = bfhi(w.z); b[2] = bflo(w.w); b[3] = bfhi(w.w); }
struct EpiResid {
    static constexpr bool PERM = true, PERM16 = false;
    const bf16* X; bf16* Y;
    __device__ __forceinline__ void operator()(const f32x4 (&acc)[2][2][4][2], const pg8::UnitG& u, int wr, int wc, int fr, int fq) const {
        u32x4 xw[2][4][2];
#pragma unroll
        for (int ai = 0; ai < 2; ++ai)
#pragma unroll
            for (int m = 0; m < 4; ++m) { const size_t off = (size_t)(u.row0 + ai * 128 + wr * 64 + m * 16 + fr) * D + u.col0 + wc * 32 + 8 * fq;
#pragma unroll
                for (int bj = 0; bj < 2; ++bj) xw[ai][m][bj] = *(const u32x4*)(X + off + bj * 128); }
        asm volatile("" ::: "memory");
#pragma unroll
        for (int ai = 0; ai < 2; ++ai)
#pragma unroll
            for (int m = 0; m < 4; ++m) { const size_t off = (size_t)(u.row0 + ai * 128 + wr * 64 + m * 16 + fr) * D + u.col0 + wc * 32 + 8 * fq;
#pragma unroll
                for (int bj = 0; bj < 2; ++bj) { f32x4 x0, x1; unpack_bf16x8(xw[ai][m][bj], x0, x1);
                    *(u32x4*)(Y + off + bj * 128) = pack_bf16x8(x0 * ALPHA + acc[ai][bj][m][0], x1 * ALPHA + acc[ai][bj][m][1]); } }
    }
};
struct EpiGluResid {
    static constexpr bool PERM = true, PERM16 = false;
    const bf16* X; bf16* Y;
    __device__ __forceinline__ void operator()(const f32x4 (&acc)[2][2][4][2], const pg8::UnitG& u, int wr, int wc, int fr, int fq) const {
        u32x4 xw[2][4];
#pragma unroll
        for (int ai = 0; ai < 2; ++ai)
#pragma unroll
            for (int m = 0; m < 4; ++m) { const size_t off = (size_t)(u.row0 + ai * 128 + wr * 64 + m * 16 + fr) * D + (u.col0 >> 1) + wc * 32 + 8 * fq; xw[ai][m] = *(const u32x4*)(X + off); }
        asm volatile("" ::: "memory");
#pragma unroll
        for (int ai = 0; ai < 2; ++ai)
#pragma unroll
            for (int m = 0; m < 4; ++m) { const size_t off = (size_t)(u.row0 + ai * 128 + wr * 64 + m * 16 + fr) * D + (u.col0 >> 1) + wc * 32 + 8 * fq;
                f32x4 x0, x1; unpack_bf16x8(xw[ai][m], x0, x1); f32x4 o0, o1;
#pragma unroll
                for (int j = 0; j < 4; ++j) { o0[j] = x0[j] * ALPHA + acc[ai][0][m][0][j] * fsig(acc[ai][1][m][0][j]); o1[j] = x1[j] * ALPHA + acc[ai][0][m][1][j] * fsig(acc[ai][1][m][1][j]); }
                *(u32x4*)(Y + off) = pack_bf16x8(o0, o1); }
    }
};
struct EpiMoeUp {
    static constexpr bool PERM = true, PERM16 = false;
    bf16* H;
    __device__ __forceinline__ void operator()(const f32x4 (&acc)[2][2][4][2], const pg8::UnitG& u, int wr, int wc, int fr, int fq) const {
#pragma unroll
        for (int ai = 0; ai < 2; ++ai)
#pragma unroll
            for (int m = 0; m < 4; ++m) { bf16* rowp = H + (size_t)(u.row0 + ai * 128 + wr * 64 + m * 16 + fr) * ED + u.col0 + wc * 32 + 8 * fq; f32x4 o[2];
#pragma unroll
                for (int n = 0; n < 2; ++n)
#pragma unroll
                    for (int j = 0; j < 4; ++j) { const float ga = acc[ai][0][m][n][j], ua = acc[ai][1][m][n][j];
                        o[n][j] = (ga * ua) * (WUP_INV * WUP_INV) * __builtin_amdgcn_rcpf(1.0f + __builtin_amdgcn_exp2f(ga * (-WUP_INV * 1.4426950408889634f))); }
                *(u32x4*)rowp = pack_bf16x8(o[0], o[1]); }
    }
};

__device__ __forceinline__ unsigned pk4_fp8(float a, float b, float c, float d) {
    a = fminf(fmaxf(a, -448.0f), 448.0f); b = fminf(fmaxf(b, -448.0f), 448.0f); c = fminf(fmaxf(c, -448.0f), 448.0f); d = fminf(fmaxf(d, -448.0f), 448.0f);
    int w = 0; w = __builtin_amdgcn_cvt_pk_fp8_f32(a, b, w, false); w = __builtin_amdgcn_cvt_pk_fp8_f32(c, d, w, true); return (unsigned)w; }
template <bool HILO>
__device__ __forceinline__ void conv_item(const float* W, int ldw, bf16* WT, bf16* WTlo, int ldk, int k0, int n0, int drow0, float scale, LAS float* scr, int lane) {
#pragma unroll
    for (int i = 0; i < 8; ++i) { const int kk = 8 * i + (lane >> 3), c4 = 4 * (lane & 7); const f32x4 wv = *(const f32x4*)(W + (size_t)(k0 + kk) * ldw + n0 + c4);
        scr[kk * 33 + c4] = wv[0] * scale; scr[kk * 33 + c4 + 1] = wv[1] * scale; scr[kk * 33 + c4 + 2] = wv[2] * scale; scr[kk * 33 + c4 + 3] = wv[3] * scale; }
    LDS_WAIT(); asm volatile("" ::: "memory");
    const int c = lane & 7;
#pragma unroll
    for (int j = 0; j < 4; ++j) { const int n = (lane >> 3) + 8 * j; const LAS float* s = scr + (8 * c) * 33 + n;
        float v[8];
#pragma unroll
        for (int q = 0; q < 8; ++q) v[q] = s[q * 33];
        u32x4 o; o.x = pk2(v[0], v[1]); o.y = pk2(v[2], v[3]); o.z = pk2(v[4], v[5]); o.w = pk2(v[6], v[7]);
        *(u32x4*)(WT + (size_t)(drow0 + n) * ldk + k0 + 8 * c) = o;
        if (HILO) { float r[8];
#pragma unroll
            for (int q = 0; q < 8; ++q) r[q] = v[q] - bf2f(f2bf(v[q]));
            u32x4 o2; o2.x = pk2(r[0], r[1]); o2.y = pk2(r[2], r[3]); o2.z = pk2(r[4], r[5]); o2.w = pk2(r[6], r[7]);
            *(u32x4*)(WTlo + (size_t)(drow0 + n) * ldk + k0 + 8 * c) = o2; } }
    LDS_WAIT(); asm volatile("" ::: "memory");
}
__device__ __forceinline__ void conv_item8(const float* W, int ldw, unsigned char* WT, int ldk, int k0, int n0, int drow0, float scale, LAS float* scr, int lane) {
#pragma unroll
    for (int i = 0; i < 8; ++i) { const int kk = 8 * i + (lane >> 3), c4 = 4 * (lane & 7); const f32x4 wv = *(const f32x4*)(W + (size_t)(k0 + kk) * ldw + n0 + c4);
        scr[kk * 33 + c4] = wv[0] * scale; scr[kk * 33 + c4 + 1] = wv[1] * scale; scr[kk * 33 + c4 + 2] = wv[2] * scale; scr[kk * 33 + c4 + 3] = wv[3] * scale; }
    LDS_WAIT(); asm volatile("" ::: "memory");
    const int c = lane & 7;
#pragma unroll
    for (int j = 0; j < 4; ++j) { const int n = (lane >> 3) + 8 * j; const LAS float* s = scr + (8 * c) * 33 + n;
        float v[8];
#pragma unroll
        for (int q = 0; q < 8; ++q) v[q] = s[q * 33];
        u32x2 o; o.x = pk4_fp8(v[0], v[1], v[2], v[3]); o.y = pk4_fp8(v[4], v[5], v[6], v[7]);
        *(u32x2*)(WT + (size_t)(drow0 + n) * ldk + k0 + 8 * c) = o; }
    LDS_WAIT(); asm volatile("" ::: "memory");
}
__device__ __forceinline__ void phase_conv_mixers(const Frame& F, KP p) {
    LAS float* scr = (LAS float*)(F.lds + F.wave * 16384);
    const int gw = F.vcu * NWAVES + F.wave, NGW = F.G * NWAVES;
    constexpr int I_AIN = 16 * 288, I_AOUT = 16 * 32, I_RIN = 16 * 192, I_ROUT = 32 * 32, I_GLU = 16 * 64, I_RT = 16 * 2;
    constexpr int NITEMS = 2 * I_AIN + 2 * I_AOUT + I_RIN + I_ROUT + I_GLU + 4 * I_RT;
    unsigned char* ws = F.ws;
    for (int it = gw; it < NITEMS; it += NGW) {
        int r = it;
        if (r < 2 * I_AIN) { const int j = r / I_AIN; r %= I_AIN; const int kb = r / 288, nb = r % 288, n0 = nb * 32;
            conv_item8(gin(p, 1) + (size_t)j * D * ATT_IN, ATT_IN, (unsigned char*)(ws + WS_ATT_IN_T) + (size_t)j * ATT_IN * D, D, kb * 64, n0, n0, WUP_SCALE, scr, F.lane); continue; }
        r -= 2 * I_AIN;
        if (r < 2 * I_AOUT) { const int j = r / I_AOUT; r %= I_AOUT; const int kb = r / 32, nb = r % 32, n0 = nb * 32;
            conv_item<false>(gin(p, 2) + (size_t)j * D * D, D, (bf16*)(ws + WS_ATT_OUT_T) + (size_t)j * D * D, nullptr, D, kb * 64, n0, n0, 1.0f, scr, F.lane); continue; }
        r -= 2 * I_AOUT;
        if (r < I_RIN) { const int kb = r / 192, nb = r % 192, n0 = nb * 32;
            conv_item8(gin(p, 3), RET_IN, (unsigned char*)(ws + WS_RET_IN_T), D, kb * 64, n0, n0, WUP_SCALE, scr, F.lane); continue; }
        r -= I_RIN;
        if (r < I_ROUT) { const int kb = r / 32, nb = r % 32, n0 = nb * 32;
            conv_item<false>(gin(p, 6), D, (bf16*)(ws + WS_RET_OUT_T), nullptr, RET_V, kb * 64, n0, n0, 1.0f, scr, F.lane); continue; }
        r -= I_ROUT;
        if (r < I_GLU) { const int kb = r / 64, nb = r % 64, n0 = nb * 32; const int c = n0 & 1023, drow = (c >> 7) * 256 + (n0 >> 10) * 128 + (c & 127);
            conv_item<false>(gin(p, 15), 2 * D, (bf16*)(ws + WS_GLU_T), nullptr, D, kb * 64, n0, drow, 1.0f, scr, F.lane); continue; }
        r -= I_GLU;
        { const int l = r / I_RT; r %= I_RT; const int kb = r / 2, nb = r % 2, n0 = nb * 32;
            conv_item<true>(gin(p, 16) + (size_t)l * D * NE, NE, (bf16*)(ws + WS_RT_HI) + (size_t)l * NE * D, (bf16*)(ws + WS_RT_LO) + (size_t)l * NE * D, D, kb * 64, n0, n0, 1.0f, scr, F.lane); }
    }
}
__device__ __forceinline__ void phase_conv_moe(const Frame& F, KP p, int l) {
    LAS float* scr = (LAS float*)(F.lds + F.wave * 16384);
    const int gw = F.vcu * NWAVES + F.wave, NGW = F.G * NWAVES;
    for (int it = gw; it < 65 * 384; it += NGW) {
        const int e = it / 384, r = it % 384, which = r >> 7, rr = r & 127;
        bf16* We = (bf16*)(F.ws + WS_WMOE + (size_t)e * WMOE_E_BYTES);
        if (which < 2) { const float* src = (e < 64) ? gin(p, 18 + which) + ((size_t)l * NE + e) * D * ED : gin(p, 21 + which) + (size_t)l * D * ED;
            const int kb = rr >> 3, nb = rr & 7, n0 = nb * 32; const int drow = (n0 >> 7) * 256 + which * 128 + (n0 & 127);
            conv_item8(src, ED, (unsigned char*)We, D, kb * 64, n0, drow, WUP_SCALE, scr, F.lane);
        } else { const float* src = (e < 64) ? gin(p, 20) + ((size_t)l * NE + e) * ED * D : gin(p, 23) + (size_t)l * ED * D;
            const int kb = rr >> 5, nb = rr & 31, n0 = nb * 32;
            conv_item<false>(src, D, We + 512 * 1024, nullptr, ED, kb * 64, n0, n0, 1.0f, scr, F.lane); }
    }
}

__device__ __forceinline__ void phase_lnr(const Frame& F, KP p, int layer, bool dry = false) {
    const bf16* Y = (const bf16*)(F.ws + WS_Y); bf16* XB = (bf16*)(F.ws + WS_XB); unsigned char* XB8 = (unsigned char*)(F.ws + WS_X);
    const float* lng = gin(p, 24) + (size_t)(layer * 2) * D; const float* lnb = gin(p, 25) + (size_t)(layer * 2) * D;
    const bf16* rthi = (const bf16*)(F.ws + WS_RT_HI) + (size_t)layer * NE * D; const bf16* rtlo = (const bf16*)(F.ws + WS_RT_LO) + (size_t)layer * NE * D;
    const float* rbias = gin(p, 17) + layer * NE;
    unsigned* cnt = (unsigned*)(F.ws + WS_CTL) + CW_CNT + layer * NE * 64;
    int* lists = (int*)(F.ws + WS_LIST); int* tokmap = (int*)(F.ws + WS_LIST + 4 * MiB); float* tokgate = (float*)(F.ws + WS_LIST + 5 * MiB);
    constexpr int XLD = 1032, MAXT = 8;
    LAS bf16* Xhi = (LAS bf16*)F.lds; LAS bf16* Xlo = Xhi + 16 * XLD;
    LAS float* part = (LAS float*)(F.lds + 2 * 16 * XLD * 2);
    LAS int* ent = (LAS int*)(part + 2 * 16 * 64);
    LAS int* hist = ent + MAXT * 16 * 8 * 2; LAS int* base = hist + 64;
    const int lane = F.lane, w = F.wave, g4 = lane >> 4, l15 = lane & 15;
    if (F.tid < 64) hist[F.tid] = 0;
    bf16x8 bhi[16], blo[16];
    { const int nt = w & 3, kh = w >> 2; const bf16* bh = rthi + (size_t)(16 * nt + l15) * D + 512 * kh + 8 * g4; const bf16* bl = rtlo + (size_t)(16 * nt + l15) * D + 512 * kh + 8 * g4;
#pragma unroll
        for (int ks = 0; ks < 16; ++ks) { bhi[ks] = *(const bf16x8*)(bh + 32 * ks); blo[ks] = *(const bf16x8*)(bl + 32 * ks); } }
    u32x4 ypre[2][2];
    if (F.vcu < T / 16) {
#pragma unroll
        for (int rr = 0; rr < 2; ++rr)
#pragma unroll
            for (int j = 0; j < 2; ++j) ypre[rr][j] = *(const u32x4*)(Y + (size_t)(F.vcu * 16 + 2 * w + rr) * D + 8 * lane + 512 * j); }
    int ntile = 0;
    for (int tile = F.vcu; tile < T / 16 && ntile < MAXT; tile += F.G, ++ntile) {
        const int t0 = tile * 16;
        u32x4 ycur[2][2];
#pragma unroll
        for (int rr = 0; rr < 2; ++rr)
#pragma unroll
            for (int j = 0; j < 2; ++j) ycur[rr][j] = ypre[rr][j];
        if (tile + F.G < T / 16) {
#pragma unroll
            for (int rr = 0; rr < 2; ++rr)
#pragma unroll
                for (int j = 0; j < 2; ++j) ypre[rr][j] = *(const u32x4*)(Y + (size_t)((tile + F.G) * 16 + 2 * w + rr) * D + 8 * lane + 512 * j); }
#pragma unroll
        for (int rr = 0; rr < 2; ++rr) {
            const int lr = 2 * w + rr; const size_t row = (size_t)(t0 + lr);
            f32x4 v[4]; float s = 0.f;
#pragma unroll
            for (int j = 0; j < 2; ++j) unpack_bf16x8(ycur[rr][j], v[2 * j], v[2 * j + 1]);
#pragma unroll
            for (int j = 0; j < 4; ++j) s += (v[j][0] + v[j][1]) + (v[j][2] + v[j][3]);
            const float mean = wave_sum(s, lane) * (1.f / D); float s2 = 0.f;
#pragma unroll
            for (int j = 0; j < 4; ++j) { v[j] = v[j] - mean; s2 += (v[j][0] * v[j][0] + v[j][1] * v[j][1]) + (v[j][2] * v[j][2] + v[j][3] * v[j][3]); }
            const float rstd = 1.0f / sqrtf(wave_sum(s2, lane) * (1.f / D) + LN_EPS);
#pragma unroll
            for (int j = 0; j < 2; ++j) { const f32x4 g0 = *(const f32x4*)(lng + 8 * lane + 512 * j), g1 = *(const f32x4*)(lng + 8 * lane + 512 * j + 4), b0 = *(const f32x4*)(lnb + 8 * lane + 512 * j), b1 = *(const f32x4*)(lnb + 8 * lane + 512 * j + 4);
                const f32x4 o0 = v[2 * j] * rstd * g0 + b0, o1 = v[2 * j + 1] * rstd * g1 + b1;
                const u32x4 hi = pack_bf16x8(o0, o1);
                *(u32x4*)(XB + row * D + 8 * lane + 512 * j) = hi;
                { u32x2 q8; q8.x = pk4_fp8(o0[0], o0[1], o0[2], o0[3]); q8.y = pk4_fp8(o1[0], o1[1], o1[2], o1[3]); *(u32x2*)(XB8 + row * D + 8 * lane + 512 * j) = q8; }
                f32x4 h0, h1; unpack_bf16x8(hi, h0, h1); const u32x4 lo = pack_bf16x8(o0 - h0, o1 - h1);
                *(LAS u32x4*)(Xhi + lr * XLD + 8 * lane + 512 * j) = hi; *(LAS u32x4*)(Xlo + lr * XLD + 8 * lane + 512 * j) = lo; }
        }
        __syncthreads();
        { const int nt = w & 3, kh = w >> 2; f32x4 a0 = (f32x4){0.f, 0.f, 0.f, 0.f}, a1 = a0, a2 = a0, a3 = a0, a4 = a0, a5 = a0;
#pragma unroll
            for (int ks = 0; ks < 16; ks += 2) { const int k0 = 512 * kh + 32 * ks;
                const bf16x8 ahi = row_frag(Xhi, XLD, 0, k0, lane), alo = row_frag(Xlo, XLD, 0, k0, lane), bhi2 = row_frag(Xhi, XLD, 0, k0 + 32, lane), blo2 = row_frag(Xlo, XLD, 0, k0 + 32, lane);
                a0 = MFMA16(ahi, bhi[ks], a0); a1 = MFMA16(alo, bhi[ks], a1); a2 = MFMA16(ahi, blo[ks], a2);
                a3 = MFMA16(bhi2, bhi[ks + 1], a3); a4 = MFMA16(blo2, bhi[ks + 1], a4); a5 = MFMA16(bhi2, blo[ks + 1], a5); }
            const f32x4 acc = ((a0 + a3) + (a1 + a4)) + (a2 + a5);
#pragma unroll
            for (int i = 0; i < 4; ++i) part[(kh * 16 + 4 * g4 + i) * 64 + 16 * nt + l15] = acc[i];
        }
        __syncthreads();
#pragma unroll
        for (int rr = 0; rr < 2; ++rr) {
            const int lt = ntile * 16 + 2 * w + rr;
            const float lg = part[(2 * w + rr) * 64 + lane] + part[(16 + 2 * w + rr) * 64 + lane];
            float sc = 1.0f / (1.0f + expf(-lg)); sc = (sc == sc) ? sc : 0.5f;
            const float sel = sc + rbias[lane];
            const float m1 = max8(sel);
            const unsigned long long eq = __ballot(sel == m1);
            const unsigned gm = (unsigned)(eq >> (lane & 56)) & 0xffu;
            const int first = (lane & 56) + __builtin_ctz(gm | 0x100u);
            const float m2 = max8((lane == first) ? -INFINITY : sel);
            const float gs = m1 + m2; const int mygrp = lane >> 3; int grank = 0;
#pragma unroll
            for (int gg = 0; gg < 8; ++gg) { const float o = rdl(gs, 8 * gg); grank += (o > gs || (o == gs && gg < mygrp)) ? 1 : 0; }
            const float mv = (grank < 4) ? sel : -INFINITY;
            unsigned key = __builtin_bit_cast(unsigned, mv); key = (key >> 31) ? ~key : (key | 0x80000000u); key = (key & ~63u) | (unsigned)(63 - lane);
            int r0 = 0, r1 = 0, r2 = 0, r3 = 0;
#pragma unroll
            for (int e2 = 0; e2 < 64; e2 += 4) { r0 += ((unsigned)__builtin_amdgcn_readlane((int)key, e2) > key) ? 1 : 0; r1 += ((unsigned)__builtin_amdgcn_readlane((int)key, e2 + 1) > key) ? 1 : 0;
                r2 += ((unsigned)__builtin_amdgcn_readlane((int)key, e2 + 2) > key) ? 1 : 0; r3 += ((unsigned)__builtin_amdgcn_readlane((int)key, e2 + 3) > key) ? 1 : 0; }
            const int rank = (r0 + r1) + (r2 + r3);
            const bool chosen = rank < TOPK;
            const float wsum = wave_sum(chosen ? sc : 0.f, lane);
            if (chosen) { const int lpos = __hip_atomic_fetch_add(hist + lane, 1, __ATOMIC_RELAXED, __HIP_MEMORY_SCOPE_WORKGROUP);
                ent[(lt * 8 + rank) * 2] = (lane << 16) | lpos; ent[(lt * 8 + rank) * 2 + 1] = __builtin_bit_cast(int, sc / wsum * 2.5f); }
        }
    }
    __syncthreads();
    if (dry) return;
    if (F.tid < 64) { const int hcount = hist[F.tid]; base[F.tid] = hcount ? (int)atomicAdd(cnt + F.tid * 64, (unsigned)hcount) : 0; }
    __syncthreads();
    for (int idx = F.tid; idx < ntile * 16 * 8; idx += NTHREADS) {
        const int ev = ent[idx * 2], gb = ent[idx * 2 + 1]; const int e = ev >> 16, pos = base[e] + (ev & 0xffff);
        const int lt = idx >> 3, rank = idx & 7, tok = (F.vcu + (lt >> 4) * F.G) * 16 + (lt & 15);
        lists[(size_t)e * T + pos] = tok; tokmap[tok * 8 + rank] = (e << 16) | pos; tokgate[tok * 8 + rank] = __builtin_bit_cast(float, gb);
    }
}

__device__ __forceinline__ void phase_combine(const Frame& F, KP p, int layer, bool dry = false) {
    bf16* XB = (bf16*)(F.ws + WS_XB); const unsigned char* yexp = (const unsigned char*)(F.ws + WS_BIG);
    const int* tokmap = (const int*)(F.ws + WS_LIST + 4 * MiB); const float* tokgate = (const float*)(F.ws + WS_LIST + 5 * MiB);
    const volatile LAS int* tstart = (const volatile LAS int*)(F.MISC + 64);
    const float* lng = gin(p, 24) + (size_t)(layer * 2 + 1) * D; const float* lnb = gin(p, 25) + (size_t)(layer * 2 + 1) * D;
    float* outp = gout(p); bf16* xbo = XB; if (dry) { outp = (float*)(F.ws + WS_AUX); xbo = (bf16*)(F.ws + WS_H); }
    const int lane = F.lane, gw = F.vcu * NWAVES + F.wave, NGW = F.G * NWAVES;
    const bf16* ysh = (const bf16*)(F.ws + WS_Y);
    f32x4 gv[4], bv[4];
#pragma unroll
    for (int j = 0; j < 4; ++j) { gv[j] = *(const f32x4*)(lng + 16 * lane + 4 * j); bv[j] = *(const f32x4*)(lnb + 16 * lane + 4 * j); }
    for (int row = gw; row < T; row += NGW) {
        const int mk = tokmap[row * 8 + (lane & 7)]; const float gk = tokgate[row * 8 + (lane & 7)] * YEXP_INV;
        const int rk = (int)tstart[mk >> 16] * 256 + (mk & 0xffff);
        f32x4 v[4];
#pragma unroll
        for (int j = 0; j < 2; ++j) { const u32x4 xw = *(const u32x4*)(ysh + (size_t)row * D + 16 * lane + 8 * j); unpack_bf16x8(xw, v[2 * j], v[2 * j + 1]); }
#pragma unroll
        for (int k = 0; k < TOPK; ++k) { const int r = __builtin_amdgcn_readlane(rk, k); const float g = rdl(gk, k);
            const u32x4 s = *(const u32x4*)(yexp + (size_t)r * D + 16 * lane);
#pragma unroll
            for (int j = 0; j < 4; ++j) { const f32x2 lo = __builtin_amdgcn_cvt_pk_f32_fp8((int)s[j], false), hi = __builtin_amdgcn_cvt_pk_f32_fp8((int)s[j], true);
                v[j][0] += g * lo[0]; v[j][1] += g * lo[1]; v[j][2] += g * hi[0]; v[j][3] += g * hi[1]; } }
        float s = 0.f;
#pragma unroll
        for (int j = 0; j < 4; ++j) s += (v[j][0] + v[j][1]) + (v[j][2] + v[j][3]);
        const float mean = wave_sum(s, lane) * (1.f / D); float s2 = 0.f;
#pragma unroll
        for (int j = 0; j < 4; ++j) { v[j] = v[j] - mean; s2 += (v[j][0] * v[j][0] + v[j][1] * v[j][1]) + (v[j][2] * v[j][2] + v[j][3] * v[j][3]); }
        const float rstd = 1.0f / sqrtf(wave_sum(s2, lane) * (1.f / D) + LN_EPS);
        f32x4 o[4];
#pragma unroll
        for (int j = 0; j < 4; ++j) o[j] = v[j] * rstd * gv[j] + bv[j];
        if (layer == DEPTH - 1 || dry) {
#pragma unroll
            for (int j = 0; j < 4; ++j) *(f32x4*)(outp + (size_t)row * D + 16 * lane + 4 * j) = o[j]; }
        if (layer != DEPTH - 1) { *(u32x4*)(xbo + (size_t)row * D + 16 * lane) = pack_bf16x8(o[0], o[1]); *(u32x4*)(xbo + (size_t)row * D + 16 * lane + 8) = pack_bf16x8(o[2], o[3]);
            if (!dry) { u32x4 q8; q8.x = pk4_fp8(o[0][0], o[0][1], o[0][2], o[0][3]); q8.y = pk4_fp8(o[1][0], o[1][1], o[1][2], o[1][3]); q8.z = pk4_fp8(o[2][0], o[2][1], o[2][2], o[2][3]); q8.w = pk4_fp8(o[3][0], o[3][1], o[3][2], o[3][3]);
                *(u32x4*)((unsigned char*)(F.ws + WS_X) + (size_t)row * D + 16 * lane) = q8; } }
    }
}

constexpr size_t AUX_OB = 96 * MiB, AUX_LSE = 128 * MiB;
__device__ __forceinline__ void phase_attn(const Frame& F, int bx) {
    const bf16* qkv = (const bf16*)(F.ws + WS_BIG); bf16* og = (bf16*)(F.ws + WS_AUX); float* lse = (float*)(F.ws + WS_AUX + AUX_LSE);
    constexpr int KLD = 136;
    LAS bf16* Ks = (LAS bf16*)F.lds; LAS bf16* Vs = Ks + 256 * KLD;
    const int lane = F.lane, w = F.wave, g4 = lane >> 4, l15 = lane & 15, qq = l15 >> 2, pp = lane & 3;
    u32x4 kc[4], vc[4];
    constexpr int NRUN = 768;
#define ATT_LOADBLK(KR, VR, nblk) do { _Pragma("unroll") for (int it = 0; it < 4; ++it) { const int idx = F.tid + 512 * it, c = idx >> 4, ch = idx & 15; int pos = 128 * (nblk) + c; pos = pos < 0 ? 0 : pos; \
            const unsigned so = (rowbase + (unsigned)pos * (unsigned)d + (unsigned)r) * (unsigned)ATT_IN + (unsigned)(g * 3072 + 1024 + h * 128 + ch * 8); KR[it] = *(const u32x4*)(qkv + so); VR[it] = *(const u32x4*)(qkv + so + 1024u); } } while (0)
#define ATT_STOREBLK(KR, VR, slot) do { _Pragma("unroll") for (int it = 0; it < 4; ++it) { const int idx = F.tid + 512 * it, c = idx >> 4, ch = idx & 15; \
            *(LAS u32x4*)(Ks + (128 * (slot) + c) * KLD + ch * 8) = KR[it]; *(LAS u32x4*)(Vs + (128 * (slot) + c) * KLD + ch * 8) = VR[it]; } } while (0)
    for (int R = bx; R < NRUN; R += F.G) {
        const int h = R & 7, sbr = R >> 3, g = sbr >> 5, rem = sbr & 31, b = rem >> 4, rr_ = rem & 15;
        const int dsh = 2 * g, d = 1 << dsh, nrs = 4 - dsh, r = rr_ >> nrs, n0 = 4 * (rr_ & ((1 << nrs) - 1)); const unsigned rowbase = (unsigned)b * SEQ;
        ATT_LOADBLK(kc, vc, n0 - 1); ATT_STOREBLK(kc, vc, (n0 - 1) & 1); ATT_LOADBLK(kc, vc, n0);
#pragma unroll 1
        for (int j = 0; j < 4; ++j) {
            const int n = n0 + j, cs = n & 1, ps = cs ^ 1;
            ATT_STOREBLK(kc, vc, cs);
            const int qi = 16 * w + l15; const unsigned qrow = rowbase + (unsigned)(128 * n + qi) * (unsigned)d + (unsigned)r;
            bf16x8 qf[4];
#pragma unroll
            for (int s = 0; s < 4; ++s) qf[s] = *(const bf16x8*)(qkv + (qrow * (unsigned)ATT_IN + (unsigned)(g * 3072 + h * 128 + 32 * s + 8 * g4)));
            __syncthreads();
            if (j < 3) { ATT_LOADBLK(kc, vc, n + 1); }
            __builtin_amdgcn_sched_barrier(0);
            const int ws0 = (16 * w < 96) ? 16 * w : 96;
#define ATT_PROW(c0) (((c0) < 128) ? (128 * ps + (c0)) : (128 * cs + (c0) - 128))
            f32x4 sacc[10];
            {
                bf16x8 kfa[4], kfb[4];
#pragma unroll
                for (int s = 0; s < 4; ++s) kfa[s] = row_frag(Ks, KLD, ATT_PROW(ws0), 32 * s, lane);
#pragma unroll
                for (int t = 0; t < 10; t += 2) {
#pragma unroll
                    for (int s = 0; s < 4; ++s) kfb[s] = row_frag(Ks, KLD, ATT_PROW(ws0 + 16 * (t + 1)), 32 * s, lane);
                    __builtin_amdgcn_sched_barrier(0);
                    sacc[t] = (f32x4){0.f, 0.f, 0.f, 0.f};
#pragma unroll
                    for (int s = 0; s < 4; ++s) sacc[t] = MFMA16(kfa[s], qf[s], sacc[t]);
                    if (t + 2 < 10) {
#pragma unroll
                        for (int s = 0; s < 4; ++s) kfa[s] = row_frag(Ks, KLD, ATT_PROW(ws0 + 16 * (t + 2)), 32 * s, lane); }
                    __builtin_amdgcn_sched_barrier(0);
                    sacc[t + 1] = (f32x4){0.f, 0.f, 0.f, 0.f};
#pragma unroll
                    for (int s = 0; s < 4; ++s) sacc[t + 1] = MFMA16(kfb[s], qf[s], sacc[t + 1]);
                }
            }
            const float slope = exp2f(-(float)(h + 1)) * (float)d;
            float mx = -INFINITY;
#pragma unroll
            for (int t = 0; t < 10; ++t)
#pragma unroll
                for (int i = 0; i < 4; ++i) { const int c = ws0 + 16 * t + 4 * g4 + i, step = 128 + qi - c;
                    const bool valid = (step >= 0) && (step <= 128) && (n > 0 || c >= 128);
                    const float v = valid ? sacc[t][i] - slope * (float)step : -INFINITY; sacc[t][i] = v; mx = fmaxf(mx, v); }
            mx = fmaxf(mx, shx(mx, 16, lane)); mx = fmaxf(mx, shx(mx, 32, lane));
            float lsum = 0.f;
#pragma unroll
            for (int t = 0; t < 10; ++t)
#pragma unroll
                for (int i = 0; i < 4; ++i) { const float pv = __expf(sacc[t][i] - mx); sacc[t][i] = pv; lsum += pv; }
            lsum += shx(lsum, 16, lane); lsum += shx(lsum, 32, lane);
            bf16x8 pf[5];
#pragma unroll
            for (int kt = 0; kt < 5; ++kt) pf[kt] = pack8(sacc[2 * kt], sacc[2 * kt + 1]);
            f32x4 o[8];
            {
                const LAS bf16* vl = Vs + (4 * g4 + qq) * KLD + 32 * pp;
                bf16x4 va[10], vcc[10];
#pragma unroll
                for (int q = 0; q < 10; ++q) va[q] = tr4(vl + ATT_PROW(ws0 + 16 * q) * KLD);
#pragma unroll
                for (int et = 0; et < 8; et += 2) {
#pragma unroll
                    for (int q = 0; q < 10; ++q) vcc[q] = tr4(vl + ATT_PROW(ws0 + 16 * q) * KLD + 4 * (et + 1));
                    __builtin_amdgcn_sched_barrier(0);
                    o[et] = (f32x4){0.f, 0.f, 0.f, 0.f};
#pragma unroll
                    for (int kt = 0; kt < 5; ++kt) o[et] = MFMA16(cat8(va[2 * kt], va[2 * kt + 1]), pf[kt], o[et]);
                    if (et + 2 < 8) {
#pragma unroll
                        for (int q = 0; q < 10; ++q) va[q] = tr4(vl + ATT_PROW(ws0 + 16 * q) * KLD + 4 * (et + 2)); }
                    __builtin_amdgcn_sched_barrier(0);
                    o[et + 1] = (f32x4){0.f, 0.f, 0.f, 0.f};
#pragma unroll
                    for (int kt = 0; kt < 5; ++kt) o[et + 1] = MFMA16(cat8(vcc[2 * kt], vcc[2 * kt + 1]), pf[kt], o[et + 1]);
                }
            }
#undef ATT_PROW
            const float inv = 1.0f / lsum;
            bf16* orow = og + ((size_t)g * T + qrow) * D + h * 128 + 32 * g4;
#pragma unroll
            for (int e2 = 0; e2 < 4; ++e2) *(u32x4*)(orow + 8 * e2) = pack_bf16x8(o[2 * e2] * inv, o[2 * e2 + 1] * inv);
            if (g4 == 0) lse[((size_t)g * T + qrow) * AH + h] = mx + __logf(lsum);
            __syncthreads();
        }
    }
#undef ATT_LOADBLK
#undef ATT_STOREBLK
}
__device__ __forceinline__ void phase_attn_combine(const Frame& F) {
    const bf16* og = (const bf16*)(F.ws + WS_AUX); const float* lse = (const float*)(F.ws + WS_AUX + AUX_LSE); bf16* ob = (bf16*)(F.ws + WS_AUX + AUX_OB);
    const int lane = F.lane, gw = F.vcu * NWAVES + F.wave, NGW = F.G * NWAVES, h = lane >> 3;
    for (int row = gw; row < T; row += NGW) {
        const float l0 = lse[((size_t)0 * T + row) * AH + h], l1 = lse[((size_t)1 * T + row) * AH + h], l2 = lse[((size_t)2 * T + row) * AH + h];
        const float m = fmaxf(l0, fmaxf(l1, l2)); float w0 = __expf(l0 - m), w1 = __expf(l1 - m), w2 = __expf(l2 - m); const float inv = 1.0f / (w0 + w1 + w2); w0 *= inv; w1 *= inv; w2 *= inv;
        float a[16];
#pragma unroll
        for (int j = 0; j < 16; ++j) a[j] = 0.f;
#pragma unroll
        for (int g = 0; g < 3; ++g) { const float wg = (g == 0) ? w0 : (g == 1 ? w1 : w2);
#pragma unroll
            for (int q = 0; q < 2; ++q) { const u32x4 s = *(const u32x4*)(og + ((size_t)g * T + row) * D + 16 * lane + 8 * q);
                a[8 * q + 0] += wg * bflo(s.x); a[8 * q + 1] += wg * bfhi(s.x); a[8 * q + 2] += wg * bflo(s.y); a[8 * q + 3] += wg * bfhi(s.y);
                a[8 * q + 4] += wg * bflo(s.z); a[8 * q + 5] += wg * bfhi(s.z); a[8 * q + 6] += wg * bflo(s.w); a[8 * q + 7] += wg * bfhi(s.w); } }
#pragma unroll
        for (int q = 0; q < 2; ++q) { u32x4 o; o.x = pk2(a[8 * q], a[8 * q + 1]); o.y = pk2(a[8 * q + 2], a[8 * q + 3]); o.z = pk2(a[8 * q + 4], a[8 * q + 5]); o.w = pk2(a[8 * q + 6], a[8 * q + 7]);
            *(u32x4*)(ob + (size_t)row * D + 16 * lane + 8 * q) = o; }
    }
}

constexpr size_t BIG_YRET = 192 * MiB;
__device__ __forceinline__ void phase_ret_u(const Frame& F) {
    const bf16* proj = (const bf16*)(F.ws + WS_BIG); bf16* St = (bf16*)(F.ws + WS_AUX);
    constexpr int LD = 264;
    LAS bf16* Kt = (LAS bf16*)F.lds; LAS bf16* Vt = Kt + 128 * LD;
    const int lane = F.lane, w = F.wave, g4 = lane >> 4, l15 = lane & 15, qq = l15 >> 2, pp = lane & 3;
    for (int u = F.vcu; u < 1024; u += F.G) {
        const int eh = u & 1, h = (u >> 1) & 3, n = (u >> 3) & 63, b = u >> 9;
        const size_t row0 = (size_t)b * SEQ + (size_t)n * RC;
#pragma unroll 4
        for (int it = 0; it < 8; ++it) { const int idx = F.tid + 512 * it, j = idx >> 5, ch = idx & 31;
            const bf16* src = proj + (row0 + j) * RET_IN;
            const u32x4 kv = *(const u32x4*)(src + 1024 + h * 256 + ch * 8), vv = *(const u32x4*)(src + 2048 + h * 512 + eh * 256 + ch * 8);
            *(LAS u32x4*)(Kt + j * LD + ch * 8) = kv; *(LAS u32x4*)(Vt + j * LD + ch * 8) = vv; }
        __syncthreads();
        f32x4 acc[16][2];
#pragma unroll
        for (int mt = 0; mt < 16; ++mt) { acc[mt][0] = (f32x4){0.f, 0.f, 0.f, 0.f}; acc[mt][1] = (f32x4){0.f, 0.f, 0.f, 0.f}; }
#pragma unroll
        for (int ks = 0; ks < 4; ++ks) {
            bf16x8 bfr[2];
#pragma unroll
            for (int nt = 0; nt < 2; ++nt) { const LAS bf16* a0 = Vt + (32 * ks + 8 * g4 + qq) * LD + 32 * w + 16 * nt + 4 * pp; bfr[nt] = cat8(tr4(a0), tr4(a0 + 4 * LD)); }
#pragma unroll
            for (int mt = 0; mt < 16; ++mt) { const LAS bf16* a0 = Kt + (32 * ks + 8 * g4 + qq) * LD + 128 * (mt >> 3) + 32 * pp + 4 * (mt & 7);
                const bf16x8 afr = cat8(tr4(a0), tr4(a0 + 4 * LD));
                acc[mt][0] = MFMA16(afr, bfr[0], acc[mt][0]); acc[mt][1] = MFMA16(afr, bfr[1], acc[mt][1]); }
        }
        bf16* outb = St + ((size_t)((b * RH + h) * RNC + n)) * (RDV * RDK);
#pragma unroll
        for (int nt = 0; nt < 2; ++nt) { bf16* orow = outb + (size_t)(eh * 256 + 32 * w + 16 * nt + l15) * RDK + 32 * g4;
#pragma unroll
            for (int mh = 0; mh < 2; ++mh)
#pragma unroll
                for (int q = 0; q < 4; ++q) *(u32x4*)(orow + 128 * mh + 8 * q) = pack_bf16x8(acc[mh * 8 + 2 * q][nt], acc[mh * 8 + 2 * q + 1][nt]); }
        __syncthreads();
    }
}
__device__ __forceinline__ void phase_ret_scan(const Frame& F) {
    bf16* St = (bf16*)(F.ws + WS_AUX);
    for (int gt = F.vcu * NTHREADS + F.tid; gt < 8 * 16384; gt += F.G * NTHREADS) {
        const int bh = gt >> 14, chunk = gt & 16383, h = bh & 3;
        const float g128 = exp2f(128.0f * log2f(1.0f - exp2f(-5.0f - (float)h)));
        bf16* base = St + (size_t)bh * RNC * (RDV * RDK) + (size_t)chunk * 8;
        float c[8];
#pragma unroll
        for (int j = 0; j < 8; ++j) c[j] = 0.f;
#pragma unroll 8
        for (int n = 0; n < RNC; ++n) { bf16* pn = base + (size_t)n * (RDV * RDK); const u32x4 uv = *(const u32x4*)pn;
            u32x4 o; o.x = pk2(c[0], c[1]); o.y = pk2(c[2], c[3]); o.z = pk2(c[4], c[5]); o.w = pk2(c[6], c[7]); *(u32x4*)pn = o;
            c[0] = g128 * (c[0] + bflo(uv.x)); c[1] = g128 * (c[1] + bfhi(uv.x)); c[2] = g128 * (c[2] + bflo(uv.y)); c[3] = g128 * (c[3] + bfhi(uv.y));
            c[4] = g128 * (c[4] + bflo(uv.z)); c[5] = g128 * (c[5] + bfhi(uv.z)); c[6] = g128 * (c[6] + bflo(uv.w)); c[7] = g128 * (c[7] + bfhi(uv.w)); }
    }
}
__device__ __forceinline__ void phase_ret_out(const Frame& F, KP p) {
    const bf16* proj = (const bf16*)(F.ws + WS_BIG); const bf16* St = (const bf16*)(F.ws + WS_AUX); bf16* yret = (bf16*)(F.ws + WS_BIG + BIG_YRET);
    const float* gng = gin(p, 4); const float* gnb = gin(p, 5);
    constexpr int LD = 264, VLD = 136;
    LAS bf16* Rs = (LAS bf16*)F.lds; LAS bf16* Vs = Rs + 128 * LD;
    const int lane = F.lane, w = F.wave, g4 = lane >> 4, l15 = lane & 15, qq = l15 >> 2, pp = lane & 3;
    for (int u = F.vcu; u < 512; u += F.G) {
        const int h = u & 3, n = (u >> 2) & 63, b = u >> 8;
        const size_t row0 = (size_t)b * SEQ + (size_t)n * RC;
#pragma unroll 4
        for (int it = 0; it < 8; ++it) { const int idx = F.tid + 512 * it, j = idx >> 5, ch = idx & 31;
            *(LAS u32x4*)(Rs + j * LD + ch * 8) = *(const u32x4*)(proj + (row0 + j) * RET_IN + 1024 + h * 256 + ch * 8); }
        const int irow = 16 * w + l15; const size_t qrow = row0 + irow;
        bf16x8 qf[8];
#pragma unroll
        for (int s = 0; s < 8; ++s) qf[s] = *(const bf16x8*)(proj + qrow * RET_IN + h * 256 + 32 * s + 8 * g4);
        __syncthreads();
        bf16x8 pf[4];
        { f32x4 sacc[8];
#pragma unroll
            for (int jt = 0; jt < 8; ++jt) { sacc[jt] = (f32x4){0.f, 0.f, 0.f, 0.f};
                if (jt <= w) {
#pragma unroll
                    for (int s = 0; s < 8; ++s) sacc[jt] = MFMA16(row_frag(Rs, LD, 16 * jt, 32 * s, lane), qf[s], sacc[jt]);
#pragma unroll
                    for (int i = 0; i < 4; ++i) if (16 * jt + 4 * g4 + i > irow) sacc[jt][i] = 0.f; } }
#pragma unroll
            for (int kt = 0; kt < 4; ++kt) pf[kt] = pack8(sacc[2 * kt], sacc[2 * kt + 1]); }
        __syncthreads();
        f32x4 acc[4][8];
        const bf16* Sn = St + ((size_t)((b * RH + h) * RNC + n)) * (RDV * RDK);
#pragma unroll
        for (int sl = 0; sl < 4; ++sl) {
#pragma unroll 4
            for (int it = 0; it < 4; ++it) { const int idx = F.tid + 512 * it, j = idx >> 4, ch = idx & 15;
                *(LAS u32x4*)(Vs + j * VLD + ch * 8) = *(const u32x4*)(proj + (row0 + j) * RET_IN + 2048 + h * 512 + sl * 128 + ch * 8); }
#pragma unroll 4
            for (int it = 0; it < 8; ++it) { const int idx = F.tid + 512 * it, e = idx >> 5, ch = idx & 31;
                *(LAS u32x4*)(Rs + e * LD + ch * 8) = *(const u32x4*)(Sn + (size_t)(sl * 128 + e) * RDK + ch * 8); }
            __syncthreads();
#pragma unroll
            for (int et = 0; et < 8; ++et) { f32x4 a = (f32x4){0.f, 0.f, 0.f, 0.f};
#pragma unroll
                for (int kt = 0; kt < 4; ++kt) if (2 * kt <= w) { const LAS bf16* a0 = Vs + (32 * kt + 4 * g4 + qq) * VLD + 32 * pp + 4 * et;
                    a = MFMA16(cat8(tr4(a0), tr4(a0 + 16 * VLD)), pf[kt], a); }
                const LAS bf16* srow = Rs + (32 * qq + 4 * et + pp) * LD + 8 * g4;
#pragma unroll
                for (int s = 0; s < 8; ++s) a = MFMA16(*(const LAS bf16x8*)(srow + 32 * s), qf[s], a);
                acc[sl][et] = a; }
            __syncthreads();
        }
        float s = 0.f;
#pragma unroll
        for (int sl = 0; sl < 4; ++sl)
#pragma unroll
            for (int et = 0; et < 8; ++et) s += (acc[sl][et][0] + acc[sl][et][1]) + (acc[sl][et][2] + acc[sl][et][3]);
        s += shx(s, 16, lane); s += shx(s, 32, lane);
        const float mean = s * (1.0f / RDV); float s2 = 0.f;
#pragma unroll
        for (int sl = 0; sl < 4; ++sl)
#pragma unroll
            for (int et = 0; et < 8; ++et) { acc[sl][et] = acc[sl][et] - mean; s2 += (acc[sl][et][0] * acc[sl][et][0] + acc[sl][et][1] * acc[sl][et][1]) + (acc[sl][et][2] * acc[sl][et][2] + acc[sl][et][3] * acc[sl][et][3]); }
        s2 += shx(s2, 16, lane); s2 += shx(s2, 32, lane);
        const float rstd = 1.0f / sqrtf(s2 * (1.0f / RDV) + LN_EPS);
#pragma unroll
        for (int sl = 0; sl < 4; ++sl) { const int c0 = h * RDV + sl * 128 + 32 * g4;
#pragma unroll
            for (int q = 0; q < 4; ++q) { const u32x4 gw = *(const u32x4*)(proj + qrow * RET_IN + 4096 + c0 + 8 * q);
                const f32x4 gg0 = *(const f32x4*)(gng + c0 + 8 * q), gg1 = *(const f32x4*)(gng + c0 + 8 * q + 4), gb0 = *(const f32x4*)(gnb + c0 + 8 * q), gb1 = *(const f32x4*)(gnb + c0 + 8 * q + 4);
                f32x4 y0 = acc[sl][2 * q] * rstd * gg0 + gb0, y1 = acc[sl][2 * q + 1] * rstd * gg1 + gb1;
                const float gv[8] = {bflo(gw.x), bfhi(gw.x), bflo(gw.y), bfhi(gw.y), bflo(gw.z), bfhi(gw.z), bflo(gw.w), bfhi(gw.w)};
#pragma unroll
                for (int j = 0; j < 4; ++j) { y0[j] *= gv[j] * fsig(gv[j]); y1[j] *= gv[4 + j] * fsig(gv[4 + j]); }
                *(u32x4*)(yret + qrow * RET_V + c0 + 8 * q) = pack_bf16x8(y0, y1); } }
    }
}

constexpr size_t AUX_S5E = 64 * MiB;
constexpr int S5L = 256, S5NC = SEQ / S5L;
__device__ __forceinline__ void cmul_add(float& rr, float& ri, float ar, float ai, float xr, float xi, float cr, float ci) { rr = ar * xr - ai * xi + cr; ri = ar * xi + ai * xr + ci; }
template <bool OUT>
__device__ __forceinline__ void phase_s5_scan(const Frame& F, KP p) {
    const bf16* X = (const bf16*)(F.ws + WS_XB); float* E = (float*)(F.ws + WS_AUX + AUX_S5E); bf16* ybuf = (bf16*)(F.ws + WS_AUX);
    const int lane = F.lane, w = F.wave, g4 = lane >> 4, l15 = lane & 15;
    LAS bf16* ut = (LAS bf16*)(F.lds + w * 12288);
    LAS bf16* Hb = (LAS bf16*)(F.lds + w * 12288 + 4096);
    constexpr int HLD = 136;
    const int gw = F.vcu * NWAVES + w, NGW = F.G * NWAVES;
    const int up16 = (lane - 16) << 2, up32 = (lane - 32) << 2, last16 = (48 + l15) << 2;
    for (int unit = gw; unit < BATCH * SG * S5NC; unit += NGW) {
        const int n = unit & (S5NC - 1), g = (unit >> 5) & 63, b = unit >> 11;
        float a1r[4], a1i[4], a4r[4], a4i[4], a8r[4], a8i[4], pwr[4], pwi[4];
        bf16x8 bfrag[8];
        const float dt = expf(gin(p, 14)[g]);
#pragma unroll
        for (int st = 0; st < 4; ++st) { const int ps = 16 * st + l15;
            const float are = gin(p, 7)[g * SP + ps], aim = gin(p, 8)[g * SP + ps];
            const float mag = expf(dt * are); const float abr = mag * cosf(dt * aim), abi = mag * sinf(dt * aim);
            const float den = are * are + aim * aim;
            const float fre = ((abr - 1.0f) * are + abi * aim) / den, fim = (abi * are - (abr - 1.0f) * aim) / den;
            a1r[st] = abr; a1i[st] = abi; { float t2r, t2i; cmul_add(t2r, t2i, abr, abi, abr, abi, 0.f, 0.f); cmul_add(a4r[st], a4i[st], t2r, t2i, t2r, t2i, 0.f, 0.f); }
            cmul_add(a8r[st], a8i[st], a4r[st], a4i[st], a4r[st], a4i[st], 0.f, 0.f);
            float qr = 1.f, qi = 0.f;
            if (g4 & 1) { qr = a4r[st]; qi = a4i[st]; }
            if (g4 & 2) { float tr, ti; cmul_add(tr, ti, qr, qi, a8r[st], a8i[st], 0.f, 0.f); qr = tr; qi = ti; }
            pwr[st] = qr; pwi[st] = qi;
            const float* br = gin(p, 9) + ((size_t)g * SP + ps) * SGC + 8 * (g4 & 1); const float* bi = gin(p, 10) + ((size_t)g * SP + ps) * SGC + 8 * (g4 & 1);
            const f32x4 r0 = *(const f32x4*)br, r1 = *(const f32x4*)(br + 4), i0 = *(const f32x4*)bi, i1 = *(const f32x4*)(bi + 4);
            const float z = (g4 < 2) ? 1.0f : 0.0f; const float fr2 = fre * z, fi2 = fim * z;
            bfrag[st] = pack8(r0 * fr2 - i0 * fi2, r1 * fr2 - i1 * fi2); bfrag[st + 4] = pack8(i0 * fr2 + r0 * fi2, i1 * fr2 + r1 * fi2);
        }
        float sr[4], si[4];
        float* Eu = E + ((size_t)(b * SG + g) * S5NC + n) * 128;
        bf16x8 cf[4]; f32x4 dsk = (f32x4){0.f, 0.f, 0.f, 0.f};
#pragma unroll
        for (int st = 0; st < 4; ++st) { sr[st] = 0.f; si[st] = 0.f; }
        if (OUT) {
#pragma unroll
            for (int st = 0; st < 4; ++st) { sr[st] = Eu[16 * st + l15]; si[st] = Eu[64 + 16 * st + l15]; }
#pragma unroll
            for (int s = 0; s < 4; ++s) { const float* cp = (s < 2 ? gin(p, 11) : gin(p, 12)) + ((size_t)g * SGC + l15) * SP + 32 * (s & 1) + 8 * g4; const float sg = s < 2 ? 1.0f : -1.0f;
                const f32x4 c0 = *(const f32x4*)cp * sg, c1 = *(const f32x4*)(cp + 4) * sg; cf[s] = pack8(c0, c1); }
            dsk = *(const f32x4*)(gin(p, 13) + g * SGC + 4 * g4); }
        const size_t tok0 = (size_t)b * SEQ + (size_t)n * S5L;
        u32x4 pre[2];
        { const bf16* src = X + (tok0 + lane) * D + g * SGC; pre[0] = *(const u32x4*)src; pre[1] = *(const u32x4*)(src + 8); }
        for (int sub = 0; sub < S5L / 64; ++sub) {
            *(LAS u32x4*)(ut + lane * 16) = pre[0]; *(LAS u32x4*)(ut + lane * 16 + 8) = pre[1];
            if (sub + 1 < S5L / 64) { const bf16* src = X + (tok0 + (sub + 1) * 64 + lane) * D + g * SGC; pre[0] = *(const u32x4*)src; pre[1] = *(const u32x4*)(src + 8); }
            LDS_WAIT(); asm volatile("" ::: "memory");
#pragma unroll (OUT ? 1 : 4)
            for (int blk = 0; blk < 4; ++blk) {
                u32x4 uw = *(const LAS u32x4*)(ut + (blk * 16 + l15) * 16 + 8 * (g4 & 1));
                if (g4 >= 2) uw = (u32x4){0u, 0u, 0u, 0u};
                const bf16x8 ufr = __builtin_bit_cast(bf16x8, uw);
                f32x4 dr[4], di[4];
#pragma unroll
                for (int st = 0; st < 4; ++st) { dr[st] = MFMA16(ufr, bfrag[st], ((f32x4){0.f, 0.f, 0.f, 0.f})); di[st] = MFMA16(ufr, bfrag[st + 4], ((f32x4){0.f, 0.f, 0.f, 0.f})); }
                float vr[4], vi[4];
#pragma unroll
                for (int st = 0; st < 4; ++st) {
                    float hr = 0.f, hi = 0.f;
#pragma unroll
                    for (int i = 0; i < 4; ++i) { float nr, ni; cmul_add(nr, ni, a1r[st], a1i[st], hr, hi, dr[st][i], di[st][i]); hr = nr; hi = ni; dr[st][i] = hr; di[st][i] = hi; }
                    vr[st] = hr; vi[st] = hi; }
#define BPF(idx, v) __builtin_bit_cast(float, __builtin_amdgcn_ds_bpermute((idx), __builtin_bit_cast(int, (v))))
                { float xr[4], xi[4];
#pragma unroll
                  for (int st = 0; st < 4; ++st) { xr[st] = BPF(up16, vr[st]); xi[st] = BPF(up16, vi[st]); }
#pragma unroll
                  for (int st = 0; st < 4; ++st) { float tr, ti; cmul_add(tr, ti, a4r[st], a4i[st], xr[st], xi[st], vr[st], vi[st]); if (g4 >= 1) { vr[st] = tr; vi[st] = ti; } }
#pragma unroll
                  for (int st = 0; st < 4; ++st) { xr[st] = BPF(up32, vr[st]); xi[st] = BPF(up32, vi[st]); }
#pragma unroll
                  for (int st = 0; st < 4; ++st) { float tr, ti; cmul_add(tr, ti, a8r[st], a8i[st], xr[st], xi[st], vr[st], vi[st]); if (g4 >= 2) { vr[st] = tr; vi[st] = ti; } } }
                float er[4], ei[4], lr[4], li[4];
#pragma unroll
                for (int st = 0; st < 4; ++st) { if (OUT) { er[st] = BPF(up16, vr[st]); ei[st] = BPF(up16, vi[st]); } else { er[st] = 0.f; ei[st] = 0.f; } lr[st] = BPF(last16, vr[st]); li[st] = BPF(last16, vi[st]); }
#undef BPF
#pragma unroll
                for (int st = 0; st < 4; ++st) {
                    if (g4 == 0) { er[st] = 0.f; ei[st] = 0.f; }
                    if (OUT) { float s0r, s0i; cmul_add(s0r, s0i, pwr[st], pwi[st], sr[st], si[st], er[st], ei[st]);
#pragma unroll
                        for (int i = 0; i < 4; ++i) { float tr, ti; cmul_add(tr, ti, a1r[st], a1i[st], s0r, s0i, 0.f, 0.f); s0r = tr; s0i = ti; dr[st][i] += s0r; di[st][i] += s0i; } }
                    { float a16r, a16i; cmul_add(a16r, a16i, a8r[st], a8i[st], a8r[st], a8i[st], 0.f, 0.f); float tr, ti; cmul_add(tr, ti, a16r, a16i, sr[st], si[st], lr[st], li[st]); sr[st] = tr; si[st] = ti; }
                    if (OUT) {
#pragma unroll
                        for (int i = 0; i < 4; ++i) { const unsigned hw = pk2(dr[st][i], di[st][i]); Hb[(4 * g4 + i) * HLD + 16 * st + l15] = (bf16)hw; Hb[(4 * g4 + i) * HLD + 64 + 16 * st + l15] = (bf16)(hw >> 16); } }
                }
                if (OUT) {
                    LDS_WAIT(); asm volatile("" ::: "memory");
                    f32x4 ya = (f32x4){0.f, 0.f, 0.f, 0.f};
#pragma unroll
                    for (int s = 0; s < 4; ++s) ya = MFMA16(cf[s], row_frag(Hb, HLD, 0, 32 * s, lane), ya);
                    const u32x2 u2 = *(const LAS u32x2*)(ut + (blk * 16 + l15) * 16 + 4 * g4);
                    const f32x4 u4 = (f32x4){bflo(u2.x), bfhi(u2.x), bflo(u2.y), bfhi(u2.y)};
                    f32x4 y = ya + dsk * u4;
#pragma unroll
                    for (int j = 0; j < 4; ++j) { const float v = y[j]; y[j] = v * fsig(1.5957691216057308f * (v + 0.044715f * v * v * v)); }
                    u32x2 o; o.x = pk2(y[0], y[1]); o.y = pk2(y[2], y[3]);
                    *(u32x2*)(ybuf + (tok0 + sub * 64 + blk * 16 + l15) * D + g * SGC + 4 * g4) = o;
                    asm volatile("" ::: "memory"); }
            }
            LDS_WAIT(); asm volatile("" ::: "memory");
        }
        if (!OUT && g4 == 0) {
#pragma unroll
            for (int st = 0; st < 4; ++st) { Eu[16 * st + l15] = sr[st]; Eu[64 + 16 * st + l15] = si[st]; } }
    }
}
__device__ __forceinline__ void phase_s5_carry(const Frame& F, KP p) {
    float* E = (float*)(F.ws + WS_AUX + AUX_S5E);
    for (int gt = F.vcu * NTHREADS + F.tid; gt < BATCH * SG * SP; gt += F.G * NTHREADS) {
        const int pl = gt & 63, bg = gt >> 6, g = bg & 63;
        const float dt = expf(gin(p, 14)[g]); const float are = gin(p, 7)[g * SP + pl], aim = gin(p, 8)[g * SP + pl];
        const float mag = expf(dt * are); float ar = mag * cosf(dt * aim), ai = mag * sinf(dt * aim);
#pragma unroll
        for (int q = 0; q < 8; ++q) { const float nr = ar * ar - ai * ai, ni = 2.0f * ar * ai; ar = nr; ai = ni; }
        float cr = 0.f, ci = 0.f;
        for (int n = 0; n < S5NC; ++n) { float* Eu = E + ((size_t)bg * S5NC + n) * 128; const float er = Eu[pl], ei = Eu[64 + pl];
            Eu[pl] = cr; Eu[64 + pl] = ci;
            const float nr = ar * cr - ai * ci + er, ni = ar * ci + ai * cr + ei; cr = nr; ci = ni; }
    }
}

constexpr int NPHASES = 34;
#ifndef PROBE_DRY14
#define PROBE_DRY14 0
#endif
#ifndef PROBE_DRY17
#define PROBE_DRY17 0
#endif
#ifndef PH_MASK
#define PH_MASK 0xFFFFFFFFu
#endif
#define PHT(t) ((PH_MASK >> (t)) & 1u)
constexpr int PLAN_OFF = 64;
__device__ __forceinline__ void moe_plan(const Frame& F, int layer) {
    volatile LAS int* tstart = (volatile LAS int*)(F.MISC + PLAN_OFF); volatile LAS int* cnts = tstart + 72;
    __syncthreads();
    if (F.wave == 0) {
        const unsigned* cnt = (const unsigned*)(F.ws + WS_CTL) + CW_CNT + layer * NE * 64;
        const int c = (int)__hip_atomic_load(cnt + F.lane * 64, __ATOMIC_RELAXED, __HIP_MEMORY_SCOPE_AGENT);
        int v = (c + 255) >> 8;
#pragma unroll
        for (int o = 1; o < 64; o <<= 1) { const int nb = __builtin_amdgcn_ds_bpermute((F.lane - o) << 2, v); if (F.lane >= o) v += nb; }
        tstart[F.lane + 1] = v; cnts[F.lane] = c;
        if (F.lane == 0) tstart[0] = 0;
        if (F.lane == 63) { tstart[65] = v + T / 256; cnts[64] = T; }
    }
    __syncthreads();
}
template <bool GATH> struct MoeSched2 {
    static constexpr bool GATHER = GATH, UNIFORMIZE = true, FP8 = GATH;
    static constexpr int ncol = GATH ? 2 : 4, K = GATH ? D / 2 : ED;
    const volatile LAS int* tstart; const volatile LAS int* cnts; int ntiles, G, c, lane;
    const char* Abase; const char* Wbase; const int* lists;
    __device__ __forceinline__ bool next(int i, pg8::UnitG& u) const {
        const int nwg = ntiles * ncol; const long L = (long)i * G + c; if (L >= nwg) return false;
        int wgid = (int)L; { const int q = nwg / 8, r = nwg % 8, xcd = wgid % 8, off = wgid / 8; wgid = (xcd < r ? xcd * (q + 1) : r * (q + 1) + (xcd - r) * q) + off; }
        const int tile = wgid / ncol, pn = wgid % ncol;
        const int ta = tstart[lane], tb = tstart[lane + 1];
        const unsigned long long mm = __ballot(ta <= tile && tile < tb);
        const int e = mm ? (int)__builtin_ctzll(mm) : 64;
        const int ts = __builtin_amdgcn_readfirstlane((int)tstart[e]), ce = __builtin_amdgcn_readfirstlane((int)cnts[e]);
        const int lt = tile - ts; int valid = ce - lt * 256; valid = valid > 256 ? 256 : valid;
        u.gshift = 0; u.aux = e;
        if (GATH) {
            u.B = Wbase + (size_t)e * WMOE_E_BYTES + (size_t)pn * 256 * K * 2;
            if (e < 64) { u.A = Abase; u.gidx = lists + (size_t)e * T + lt * 256; u.gcnt = valid; }
            else { u.A = Abase + (size_t)lt * 256 * K * 2; u.gidx = nullptr; u.gcnt = 0; }
            u.row0 = tile * 256; u.col0 = pn * 128;
        } else {
            u.B = Wbase + (size_t)e * WMOE_E_BYTES + (size_t)512 * 1024 * 2 + (size_t)pn * 256 * K * 2;
            u.A = Abase + (size_t)tile * 256 * K * 2; u.gidx = nullptr; u.gcnt = valid;
            u.row0 = tile * 256; u.col0 = pn * 256;
        }
        return true;
    }
};
__device__ __forceinline__ void phase_load_x(const Frame& F, KP p) {
    const float* xin = gin(p, 0); bf16* XB = (bf16*)(F.ws + WS_XB);
    for (size_t i = (size_t)F.vcu * NTHREADS + F.tid; i < (size_t)T * D / 8; i += (size_t)F.G * NTHREADS) {
        const f32x4 a = *(const f32x4*)(xin + i * 8), b = *(const f32x4*)(xin + i * 8 + 4);
        *(u32x4*)(XB + i * 8) = pack_bf16x8(a, b);
        u32x2 q8; q8.x = pk4_fp8(a[0], a[1], a[2], a[3]); q8.y = pk4_fp8(b[0], b[1], b[2], b[3]); *(u32x2*)((unsigned char*)(F.ws + WS_X) + i * 8) = q8; }
}

__global__ void __launch_bounds__(NTHREADS, 2) fwd_kernel(Params p_unused) {
    KP p0 = (KP)__builtin_amdgcn_kernarg_segment_ptr();
    extern __shared__ __attribute__((aligned(16))) unsigned char lds_raw[];
    Frame F0;
    F0.lds = (LAS unsigned char*)lds_raw; F0.MISC = (volatile LAS unsigned*)(F0.lds + MISC_OFF);
    F0.tid = threadIdx.x; F0.lane = F0.tid & 63; F0.wave = __builtin_amdgcn_readfirstlane(F0.tid >> 6);
    F0.G = gridDim.x; { const int bq = blockIdx.x; F0.vcu = (F0.G % 8 == 0) ? (bq % 8) * (F0.G / 8) + bq / 8 : bq; }
    F0.ws = p0->ws;
    const int bx0 = blockIdx.x;
    for (int u = F0.tid; u < (LDS_BYTES - MISC_OFF) / 4; u += NTHREADS) ((LAS unsigned*)(F0.lds + MISC_OFF))[u] = 0u;
    __syncthreads();
    XcdBarrier bar; bar.bar = (unsigned*)(p0->ws + WS_CTL) + CW_BAR; bar.x = 0; bar.st = nullptr;
    const int use_bar = p0->use_bar;
    if (use_bar) bar = xcd_barrier_post((unsigned*)(p0->ws + WS_CTL) + CW_BAR, F0.MISC + 8);
    const int lo = p0->ph_lo, hi = p0->ph_hi;
#define PHASE_BEGIN Frame F = F0; KP p = p0; { unsigned ones_ = ~0u; asm volatile("" : "+s"(ones_)); F.lane = (int)__builtin_amdgcn_mbcnt_hi(ones_, __builtin_amdgcn_mbcnt_lo(ones_, 0u)); } asm volatile("" : "+v"(F.lane)); F.tid = F.wave * 64 + F.lane; asm volatile("" : "+v"(F.tid));   GAS unsigned char* wsg_ = (GAS unsigned char*)F0.ws; asm volatile("" : "+s"(F.wave), "+s"(F.vcu), "+s"(F.G), "+s"(wsg_), "+s"(p)); \
    F.ws = (unsigned char*)wsg_; int bx = bx0; asm volatile("" : "+s"(bx)); unsigned char* ws = F.ws; (void)ws; (void)bx;
#pragma unroll 1
    for (int ph = lo; ph < hi; ++ph) {
        int layer = 0, type = 0;
        if (ph > 0) { layer = ph >= 26 ? 3 : (ph >= 18 ? 2 : (ph >= 9 ? 1 : 0)); const int q = ph - (layer == 3 ? 26 : (layer == 2 ? 18 : (layer == 1 ? 9 : 1))); const int kind = layer % 3;
            if (kind == 0) type = q < 4 ? 1 + q : 14 + (q - 4); else if (kind == 1) type = q < 5 ? 5 + q : 14 + (q - 5); else type = q < 4 ? 10 + q : 14 + (q - 4); }
        const int j = layer / 3;
#ifdef REPEAT_MASK
        const int nrep = ((REPEAT_MASK >> type) & 1u) ? 2 : 1;
#else
        const int nrep = 1;
#endif
#pragma unroll 1
        for (int rep = 0; rep < nrep; ++rep) {
        if (rep > 0 && use_bar) xcd_barrier(bar);
        if (PHT(0) && type == 0) { PHASE_BEGIN; phase_conv_mixers(F, p); phase_conv_moe(F, p, 0); phase_load_x(F, p); }
        else if (PHT(1) && type == 1) { PHASE_BEGIN; DenseSched8 S; S.init(ws + WS_X, ws + WS_ATT_IN_T + (size_t)j * ATT_IN * D, T, ATT_IN, D / 2, F.G, bx); EpiStoreBf16 E{(bf16*)(ws + WS_BIG), ATT_IN, WUP_INV, 0.08838834764831845f};
            pg8::gemm_phase(F.lds, F.tid, D / 2, S, E); }
        else if (PHT(2) && type == 2) { PHASE_BEGIN; phase_attn(F, bx); }
        else if (PHT(3) && type == 3) { PHASE_BEGIN; phase_attn_combine(F); }
        else if (PHT(4) && type == 4) { PHASE_BEGIN; DenseSched S; S.init(ws + WS_AUX + AUX_OB, ws + WS_ATT_OUT_T + (size_t)j * D * D * 2, T, D, D, F.G, bx); EpiResid E{(const bf16*)(ws + WS_XB), (bf16*)(ws + WS_Y)};
            pg8::gemm_phase(F.lds, F.tid, D, S, E); }
        else if (PHT(5) && type == 5) { PHASE_BEGIN; DenseSched8 S; S.init(ws + WS_X, ws + WS_RET_IN_T, T, RET_IN, D / 2, F.G, bx); EpiRetIn E{(bf16*)(ws + WS_BIG), RET_IN};
            pg8::gemm_phase(F.lds, F.tid, D / 2, S, E); }
        else if (PHT(6) && type == 6) { PHASE_BEGIN; phase_ret_u(F); }
        else if (PHT(7) && type == 7) { PHASE_BEGIN; phase_ret_scan(F); }
        else if (PHT(8) && type == 8) { PHASE_BEGIN; phase_ret_out(F, p); }
        else if (PHT(9) && type == 9) { PHASE_BEGIN; DenseSched S; S.init(ws + WS_BIG + BIG_YRET, ws + WS_RET_OUT_T, T, D, RET_V, F.G, bx); EpiResid E{(const bf16*)(ws + WS_XB), (bf16*)(ws + WS_Y)};
            pg8::gemm_phase(F.lds, F.tid, RET_V, S, E); }
        else if (PHT(10) && type == 10) { PHASE_BEGIN; phase_s5_scan<false>(F, p); }
        else if (PHT(11) && type == 11) { PHASE_BEGIN; phase_s5_carry(F, p); }
        else if (PHT(12) && type == 12) { PHASE_BEGIN; phase_s5_scan<true>(F, p); }
        else if (PHT(13) && type == 13) { PHASE_BEGIN; DenseSched S; S.init(ws + WS_AUX, ws + WS_GLU_T, T, 2 * D, D, F.G, bx); EpiGluResid E{(const bf16*)(ws + WS_XB), (bf16*)(ws + WS_Y)};
            pg8::gemm_phase(F.lds, F.tid, D, S, E); }
        else if (PHT(14) && type == 14) { PHASE_BEGIN; phase_lnr(F, p, layer, PROBE_DRY14 && true); if (PROBE_DRY14) { if (use_bar) xcd_barrier(bar); phase_lnr(F, p, layer, false); } }
        else if (PHT(15) && type == 15) { PHASE_BEGIN; moe_plan(F, layer);
            MoeSched2<true> S; S.tstart = (const volatile LAS int*)(F.MISC + PLAN_OFF); S.cnts = S.tstart + 72; S.ntiles = __builtin_amdgcn_readfirstlane((int)S.tstart[65]); S.G = F.G; S.c = bx; S.lane = F.lane;
            S.Abase = (const char*)(ws + WS_X); S.Wbase = (const char*)(ws + WS_WMOE); S.lists = (const int*)(ws + WS_LIST);
            EpiMoeUp E{(bf16*)(ws + WS_H)};
            pg8::gemm_phase(F.lds, F.tid, D / 2, S, E); }
        else if (PHT(16) && type == 16) { PHASE_BEGIN; moe_plan(F, layer);
            { MoeSched2<false> S; S.tstart = (const volatile LAS int*)(F.MISC + PLAN_OFF); S.cnts = S.tstart + 72; S.ntiles = __builtin_amdgcn_readfirstlane((int)S.tstart[64]); S.G = F.G; S.c = bx; S.lane = F.lane;
              S.Abase = (const char*)(ws + WS_H); S.Wbase = (const char*)(ws + WS_WMOE); S.lists = (const int*)(ws + WS_LIST);
              EpiStoreFp8 E{(unsigned char*)(ws + WS_BIG), D};
              pg8::gemm_phase(F.lds, F.tid, ED, S, E); }
            { const int sh0 = __builtin_amdgcn_readfirstlane((int)((const volatile LAS int*)(F.MISC + PLAN_OFF))[64]);
              DenseSched S; S.init(ws + WS_H + (size_t)sh0 * 256 * ED * 2, ws + WS_WMOE + (size_t)64 * WMOE_E_BYTES + (size_t)512 * 1024 * 2, T, D, ED, F.G, bx); EpiResid E{(const bf16*)(ws + WS_XB), (bf16*)(ws + WS_Y)};
              pg8::gemm_phase(F.lds, F.tid, ED, S, E); } }
        else if (PHT(17) && type == 17) { PHASE_BEGIN; moe_plan(F, layer); if (PROBE_DRY17) { phase_combine(F, p, layer, true); if (use_bar) xcd_barrier(bar); } phase_combine(F, p, layer); if (layer + 1 < DEPTH) phase_conv_moe(F, p, layer + 1); }
        }
        if (use_bar && ph + 1 < hi) xcd_barrier(bar);
    }
}

#ifndef MK_PER_PHASE
#define MK_PER_PHASE 0
#endif
extern "C" void kernel_launch(void* const* d_in, const int* in_sizes, int n_in, void* d_out, int out_size, void* d_ws, size_t ws_size, hipStream_t stream) {
    static int grid = 0;
    if (grid == 0) {
        if (n_in != 26 || in_sizes[0] != T * D || out_size != T * D || ws_size < WS_END) { fprintf(stderr, "kernel_launch: unexpected shapes / workspace (n_in %d, in0 %d, out %d, ws %zu < %zu)\n", n_in, n_in > 0 ? in_sizes[0] : -1, out_size, ws_size, (size_t)WS_END); grid = -1; return; }
        int dev = 0, cus = 0, per_cu = 0;
        if (hipGetDevice(&dev) != hipSuccess || hipDeviceGetAttribute(&cus, hipDeviceAttributeMultiprocessorCount, dev) != hipSuccess) { grid = -1; return; }
        if (hipFuncSetAttribute((const void*)fwd_kernel, hipFuncAttributeMaxDynamicSharedMemorySize, LDS_BYTES) != hipSuccess) { fprintf(stderr, "kernel_launch: hipFuncSetAttribute failed\n"); grid = -1; return; }
        if (hipOccupancyMaxActiveBlocksPerMultiprocessor(&per_cu, (const void*)fwd_kernel, NTHREADS, LDS_BYTES) != hipSuccess || per_cu < 1) { fprintf(stderr, "kernel_launch: occupancy query says %d blocks per CU\n", per_cu); per_cu = 1; }
        (void)hipGetLastError();
        grid = cus;
    }
    if (grid < 0) return;
    (void)hipMemsetAsync((char*)d_ws + WS_CTL, 0, CTL_ZERO_BYTES, stream);
    Params p{};
    for (int i = 0; i < 26; ++i) p.in[i] = (const float*)d_in[i];
    p.out = (float*)d_out; p.ws = (unsigned char*)d_ws;
#if MK_PER_PHASE
    for (int k = 0; k < NPHASES; ++k) { p.ph_lo = k; p.ph_hi = k + 1; p.use_bar = 0; hipLaunchKernelGGL(fwd_kernel, dim3(grid), dim3(NTHREADS), LDS_BYTES, stream, p); }
#else
    p.ph_lo = 0; p.ph_hi = NPHASES; p.use_bar = 1;
    hipLaunchKernelGGL(fwd_kernel, dim3(grid), dim3(NTHREADS), LDS_BYTES, stream, p);
#endif
}
```

```cpp
#include <hip/hip_runtime.h>
#include <cstdio>
#include <cstdint>

#define LAS __attribute__((address_space(3)))
#define GAS __attribute__((address_space(1)))
typedef unsigned short bf16;
typedef short bf16x8 __attribute__((ext_vector_type(8)));
typedef short bf16x4 __attribute__((ext_vector_type(4)));
typedef float f32x4 __attribute__((ext_vector_type(4)));
typedef float f32x2 __attribute__((ext_vector_type(2)));
typedef unsigned u32x4 __attribute__((ext_vector_type(4)));
typedef unsigned u32x2 __attribute__((ext_vector_type(2)));
typedef GAS unsigned gu32;

constexpr int D = 1024, BATCH = 2, SEQ = 8192, T = BATCH * SEQ, DEPTH = 4;
constexpr int AH = 8, AHD = 128, ATT_IN = 9216;
constexpr int RH = 4, RDK = 256, RDV = 512, RET_IN = 6144, RET_V = 2048, RC = 128, RNC = SEQ / RC;
constexpr int SG = 64, SGC = 16, SP = 64;
constexpr int NE = 64, TOPK = 8, NEG = 8, ED = 256, NSLOT = 9;
constexpr float LN_EPS = 1e-5f;
constexpr float ALPHA = 1.6817928305074292f;
constexpr int NWAVES = 8, NTHREADS = 512;

__device__ __forceinline__ unsigned f2bf(float f) { unsigned u = __builtin_bit_cast(unsigned, f); return (u + 0x7fffu + ((u >> 16) & 1u)) >> 16; }
__device__ __forceinline__ unsigned pk2(float lo, float hi) { unsigned r; asm("s_nop 1\n\tv_cvt_pk_bf16_f32 %0, %1, %2" : "=v"(r) : "v"(lo), "v"(hi)); return r; }
__device__ __forceinline__ unsigned pk2sw(float lo, float hi) { return f2bf(lo) | (f2bf(hi) << 16); }
__device__ __forceinline__ unsigned pk2hw(float lo, float hi) { unsigned r; asm volatile("v_cvt_pk_bf16_f32 %0, %1, %2" : "=v"(r) : "v"(lo), "v"(hi)); return r; }
__device__ __forceinline__ float bf2f(unsigned b) { return __builtin_bit_cast(float, b << 16); }
__device__ __forceinline__ float bflo(unsigned w) { return __builtin_bit_cast(float, w << 16); }
__device__ __forceinline__ float bfhi(unsigned w) { return __builtin_bit_cast(float, w & 0xffff0000u); }
__device__ __forceinline__ float shx(float v, int m, int lane) { return __builtin_bit_cast(float, __builtin_amdgcn_ds_bpermute((lane ^ m) << 2, __builtin_bit_cast(int, v))); }
__device__ __forceinline__ int shx_i(int v, int m, int lane) { return __builtin_amdgcn_ds_bpermute((lane ^ m) << 2, v); }
__device__ __forceinline__ float rdl(float v, int src) { return __builtin_bit_cast(float, __builtin_amdgcn_readlane(__builtin_bit_cast(int, v), src)); }
template <int CTRL, int RM = 0xf, int BM = 0xf> __device__ __forceinline__ float dpp0(float v) { return __builtin_bit_cast(float, __builtin_amdgcn_update_dpp(0, __builtin_bit_cast(int, v), CTRL, RM, BM, true)); }
template <int CTRL, int RM = 0xf, int BM = 0xf> __device__ __forceinline__ float dppo(float old, float v) { return __builtin_bit_cast(float, __builtin_amdgcn_update_dpp(__builtin_bit_cast(int, old), __builtin_bit_cast(int, v), CTRL, RM, BM, false)); }
__device__ __forceinline__ float wave_sum(float v, int lane) {
    (void)lane;
    v += dpp0<0x111>(v); v += dpp0<0x112>(v); v += dpp0<0x114>(v); v += dpp0<0x118>(v);
    v += dpp0<0x142, 0xa>(v);
    v += dpp0<0x143, 0xc>(v);
    return rdl(v, 63);
}
__device__ __forceinline__ float max8(float v) {
    v = fmaxf(v, dppo<0xb1>(v, v)); v = fmaxf(v, dppo<0x4e>(v, v)); v = fmaxf(v, dppo<0x141>(v, v)); return v;
}
__device__ __forceinline__ float fsig(float x) { return __builtin_amdgcn_rcpf(1.0f + __expf(-x)); }
#define LDS_WAIT() asm volatile("s_waitcnt lgkmcnt(0)" ::: "memory")
#define VM_WAIT() asm volatile("s_waitcnt vmcnt(0)" ::: "memory")
__device__ __forceinline__ const char* rfl_ptr(const char* p) {
    unsigned long long v = (unsigned long long)p; unsigned lo = __builtin_amdgcn_readfirstlane((unsigned)v), hi = __builtin_amdgcn_readfirstlane((unsigned)(v >> 32));
    return (const char*)(((unsigned long long)hi << 32) | lo);
}
__device__ __forceinline__ bf16x8 row_frag(const LAS bf16* base, int ld, int row0, int col0, int lane) {
    return *(const LAS bf16x8*)(base + (row0 + (lane & 15)) * ld + col0 + 8 * (lane >> 4));
}
__device__ __forceinline__ bf16x4 tr4(const LAS bf16* addr) { return __builtin_amdgcn_ds_read_tr16_b64_v4i16((LAS bf16x4*)addr); }
__device__ __forceinline__ bf16x8 cat8(bf16x4 a, bf16x4 b) { bf16x8 r; r[0] = a[0]; r[1] = a[1]; r[2] = a[2]; r[3] = a[3]; r[4] = b[0]; r[5] = b[1]; r[6] = b[2]; r[7] = b[3]; return r; }
#define MFMA16(a, b, c) __builtin_amdgcn_mfma_f32_16x16x32_bf16((a), (b), (c), 0, 0, 0)
__device__ __forceinline__ bf16x8 pack8(f32x4 a, f32x4 b) {
    u32x4 w; w.x = pk2(a[0], a[1]); w.y = pk2(a[2], a[3]); w.z = pk2(b[0], b[1]); w.w = pk2(b[2], b[3]); return __builtin_bit_cast(bf16x8, w);
}

namespace pg8 {
typedef int v4i_t __attribute__((ext_vector_type(4)));
typedef int v8i_t __attribute__((ext_vector_type(8)));
constexpr int BM = 256, BK = 64, HALF = 128, HTB = HALF * BK * 2, STAGE_BYTES = 8 * HTB;
__device__ __forceinline__ int lds_byte(int r, int c) { const int st = (r >> 4) * 2 + (c >> 5), rr = r & 15, cc = c & 31, ob = rr * 64 + cc * 2; return st * 1024 + (ob ^ (((ob >> 9) & 1) << 5)); }
__device__ __forceinline__ void stage_rc(int b, int& R, int& C) { const int st = b / 1024, sb = b % 1024, swz = sb ^ (((sb >> 9) & 1) << 5); R = (st >> 1) * 16 + swz / 64; C = (st & 1) * 32 + (swz % 64) / 2; }
__device__ __forceinline__ int perm32(int rho) { const int n = rho >> 4, i = rho & 15; return 8 * (i >> 2) + 4 * n + (i & 3); }

struct UnitG {
    const char* A;
    const char* B;
    const int* gidx;
    int gcnt, gshift;
    int row0, col0;
    int aux;
};

__device__ __forceinline__ void uniformize(UnitG& u) { u.A = rfl_ptr(u.A); u.B = rfl_ptr(u.B); u.gidx = (const int*)rfl_ptr((const char*)u.gidx); u.gcnt = __builtin_amdgcn_readfirstlane(u.gcnt); u.gshift = __builtin_amdgcn_readfirstlane(u.gshift);
    u.row0 = __builtin_amdgcn_readfirstlane(u.row0); u.col0 = __builtin_amdgcn_readfirstlane(u.col0); u.aux = __builtin_amdgcn_readfirstlane(u.aux); }
template <class Epi, class Sched>
__device__ __forceinline__ void gemm_phase(LAS unsigned char* lds, const int tid, const int K, const Sched& S, const Epi& E) {
    constexpr bool F8 = Sched::FP8;
    constexpr bool GATHER = Sched::GATHER;
    const int wid = __builtin_amdgcn_readfirstlane(tid >> 6), lane = tid & 63, wr = wid >> 2, wc = wid & 3, fr = lane & 15, fq = lane >> 4;
    const int nt = K / BK;
    constexpr bool P16 = Epi::PERM16;
    unsigned voffB[2], voffB1[2], vA[2][2];
#pragma unroll
    for (int i = 0; i < 2; ++i) { int R, C; stage_rc(tid * 16 + i * 8192, R, C); const int Rb = Epi::PERM ? ((R & ~31) + perm32(R & 31)) : R; voffB[i] = (unsigned)(Rb * K + C) * 2u; voffB1[i] = voffB[i]; vA[0][i] = (unsigned)(R * K + C) * 2u; vA[1][i] = vA[0][i];
        if constexpr (P16) { const int x = R & 31, src = 64 * (R >> 5) + 16 * ((x >> 2) & 3) + 4 * (x >> 4) + (x & 3); voffB[i] = (unsigned)(src * K + C) * 2u; voffB1[i] = (unsigned)((src + 8) * K + C) * 2u; } }
    const size_t kstep = (size_t)(BK * 2);
    const size_t hstep = (size_t)HALF * K * 2;
    const size_t hstepB = P16 ? 0 : hstep;
    const size_t hstepA = GATHER ? 0 : hstep;
    const unsigned ldsw = (unsigned)wid * 1024u;
    const int aoff = F8 ? lds_byte(wr * 64 + fr, fq * 16) : lds_byte(wr * 64 + fr, fq * 8), boff = F8 ? lds_byte(wc * 32 + fr, fq * 16) : lds_byte(wc * 32 + fr, fq * 8);
    LAS u32x4* park = (LAS u32x4*)(lds + STAGE_BYTES) + tid;
#define PG8_SA(b, h) (((b) * 2 + (h)) * HTB)
#define PG8_SB(b, h) ((4 + (b) * 2 + (h)) * HTB)
#define PG8_STAGE(bufoff, gbase, voff) do { _Pragma("unroll") for (int _i = 0; _i < 2; ++_i) { asm volatile("" : "+v"((voff)[_i]));   \
        __builtin_amdgcn_global_load_lds((const unsigned*)((const char*)(gbase) + (voff)[_i]), (LAS unsigned*)(lds + (bufoff) + ldsw + _i * 8192), 16, 0, 0); } } while (0)
    constexpr int FKS = F8 ? 16 : 1024;
#define PG8_LD2(p_) __builtin_shufflevector(*(const LAS v4i_t*)(p_), *(const LAS v4i_t*)((p_) + FKS), 0, 1, 2, 3, 4, 5, 6, 7)
#define PG8_LDA(dst, b, h) do { _Pragma("unroll") for (int m = 0; m < 4; ++m) dst[m] = PG8_LD2(lds + PG8_SA(b, h) + aoff + m * 2048); } while (0)
#define PG8_LDB(dst, b, h) do { _Pragma("unroll") for (int n = 0; n < 2; ++n) dst[n] = PG8_LD2(lds + PG8_SB(b, h) + boff + n * 2048); } while (0)
#define PG8_LO(v) __builtin_bit_cast(bf16x8, __builtin_shufflevector((v), (v), 0, 1, 2, 3))
#define PG8_HI(v) __builtin_bit_cast(bf16x8, __builtin_shufflevector((v), (v), 4, 5, 6, 7))
#define PG8_MMA(ai, bj, At, Bt) do { __builtin_amdgcn_s_setprio(1); _Pragma("unroll") for (int m = 0; m < 4; ++m) _Pragma("unroll") for (int n = 0; n < 2; ++n) { \
        if constexpr (F8) { acc[ai][bj][m][n] = __builtin_amdgcn_mfma_scale_f32_16x16x128_f8f6f4(Bt[n], At[m], acc[ai][bj][m][n], 0, 0, 0, 0x7F7F7F7F, 0, 0x7F7F7F7F); } \
        else { acc[ai][bj][m][n] = __builtin_amdgcn_mfma_f32_16x16x32_bf16(PG8_LO(Bt[n]), PG8_LO(At[m]), acc[ai][bj][m][n], 0, 0, 0); \
               acc[ai][bj][m][n] = __builtin_amdgcn_mfma_f32_16x16x32_bf16(PG8_HI(Bt[n]), PG8_HI(At[m]), acc[ai][bj][m][n], 0, 0, 0); } } __builtin_amdgcn_s_setprio(0); } while (0)
#define PG8_WAIT_V(n) asm volatile("s_waitcnt vmcnt(" #n ")" ::: "memory")
#define PG8_WAIT_L(n) asm volatile("s_waitcnt lgkmcnt(" #n ")" ::: "memory")
#define PG8_BAR __builtin_amdgcn_s_barrier()
#define PG8_SCHED __builtin_amdgcn_sched_barrier(0)
#define PG8_VOFF(u, v00, v01, v10, v11) do { int _R0, _C0, _R1, _C1; stage_rc(tid * 16, _R0, _C0); stage_rc(tid * 16 + 8192, _R1, _C1); int _r00 = _R0, _r01 = _R1, _r10 = HALF + _R0, _r11 = HALF + _R1; \
        if ((u).gidx) { const GAS int* _gp = (const GAS int*)(u).gidx; const int _gc = (u).gcnt;     \
            const int _a = _gp[_r00 < _gc ? _r00 : 0] >> (u).gshift, _b = _gp[_r01 < _gc ? _r01 : 0] >> (u).gshift, _c = _gp[_r10 < _gc ? _r10 : 0] >> (u).gshift, _d = _gp[_r11 < _gc ? _r11 : 0] >> (u).gshift; \
            _r00 = _a; _r01 = _b; _r10 = _c; _r11 = _d; } \
        v00 = (unsigned)(_r00 * K + _C0) * 2u; v01 = (unsigned)(_r01 * K + _C1) * 2u; v10 = (unsigned)(_r10 * K + _C0) * 2u; v11 = (unsigned)(_r11 * K + _C1) * 2u; } while (0)
    UnitG cur, nxt; int ui = 0;
    if (!S.next(0, cur)) return;
    if constexpr (Sched::UNIFORMIZE) uniformize(cur);
    f32x4 acc[2][2][4][2];
#pragma unroll
    for (int a = 0; a < 2; ++a)
#pragma unroll
        for (int b = 0; b < 2; ++b)
#pragma unroll
            for (int m = 0; m < 4; ++m)
#pragma unroll
                for (int n = 0; n < 2; ++n) acc[a][b][m][n] = (f32x4){0.f, 0.f, 0.f, 0.f};
    v8i_t At[4], B0[2], B1[2];
    if constexpr (GATHER) PG8_VOFF(cur, vA[0][0], vA[0][1], vA[1][0], vA[1][1]);
    const char* cA = cur.A; const char* cB = cur.B;
    PG8_STAGE(PG8_SB(0, 0), cB, voffB); PG8_STAGE(PG8_SB(0, 1), cB + hstepB, voffB1); PG8_STAGE(PG8_SA(0, 0), cA, vA[0]); PG8_STAGE(PG8_SA(0, 1), cA + hstepA, vA[1]);
    if (wr == 1) PG8_BAR;
    PG8_WAIT_V(2); PG8_BAR;
    PG8_STAGE(PG8_SB(1, 0), cB + kstep, voffB); PG8_STAGE(PG8_SA(1, 0), cA + kstep, vA[0]); PG8_STAGE(PG8_SB(1, 1), cB + hstepB + kstep, voffB1);
    PG8_WAIT_V(6); PG8_BAR;
    for (;;) {
        const bool has_next = S.next(ui + 1, nxt);
        if constexpr (Sched::UNIFORMIZE) { if (has_next) uniformize(nxt); }
        const char* nA = cA; const char* nB = cB;
        if (has_next) { nA = nxt.A; nB = nxt.B; }
        if constexpr (GATHER) { u32x4 pv; pv.x = vA[0][0]; pv.y = vA[0][1]; pv.z = vA[1][0]; pv.w = vA[1][1];
            if (has_next) PG8_VOFF(nxt, pv.x, pv.y, pv.z, pv.w);
            *park = pv; }
#pragma unroll 1
        for (int t = 0; t < nt; t += 2) {
            const bool last = (t == nt - 2);
            const char* a1 = cA + (size_t)(t + 1) * kstep;
            const char* a2 = last ? nA : cA + (size_t)(t + 2) * kstep; const char* b2 = last ? nB : cB + (size_t)(t + 2) * kstep;
            const char* a3 = a2 + kstep; const char* b3 = b2 + kstep;
            PG8_LDB(B0, 0, 0); PG8_LDB(B1, 0, 1); PG8_SCHED; PG8_LDA(At, 0, 0); PG8_STAGE(PG8_SA(1, 1), a1 + hstepA, vA[1]);
            PG8_WAIT_V(8); PG8_WAIT_L(0); PG8_BAR; PG8_MMA(0, 0, At, B0); PG8_MMA(0, 1, At, B1); PG8_BAR; PG8_SCHED;
            if constexpr (GATHER) { if (last) { const u32x4 pv = *park; vA[0][0] = pv.x; vA[0][1] = pv.y; vA[1][0] = pv.z; vA[1][1] = pv.w; } }
            PG8_LDA(At, 0, 1); PG8_STAGE(PG8_SB(0, 0), b2, voffB); PG8_STAGE(PG8_SB(0, 1), b2 + hstepB, voffB1); PG8_STAGE(PG8_SA(0, 0), a2, vA[0]);
            PG8_WAIT_V(8); PG8_WAIT_L(0); PG8_BAR; PG8_MMA(1, 0, At, B0); PG8_MMA(1, 1, At, B1); PG8_BAR; PG8_SCHED;
            PG8_LDB(B0, 1, 0); PG8_LDB(B1, 1, 1); PG8_SCHED; PG8_LDA(At, 1, 0); PG8_STAGE(PG8_SA(0, 1), a2 + hstepA, vA[1]);
            PG8_WAIT_V(8); PG8_WAIT_L(0); PG8_BAR; PG8_MMA(0, 0, At, B0); PG8_MMA(0, 1, At, B1); PG8_BAR; PG8_SCHED;
            PG8_LDA(At, 1, 1); PG8_STAGE(PG8_SB(1, 0), b3, voffB); PG8_STAGE(PG8_SB(1, 1), b3 + hstepB, voffB1); PG8_STAGE(PG8_SA(1, 0), a3, vA[0]);
            PG8_WAIT_V(8); PG8_WAIT_L(0); PG8_BAR; PG8_MMA(1, 0, At, B0); PG8_MMA(1, 1, At, B1); PG8_BAR; PG8_SCHED;
        }
        if (wr == 0) PG8_BAR;
        E(acc, cur, wr, wc, fr, fq);
        if (!has_next) break;
#pragma unroll
        for (int a = 0; a < 2; ++a)
#pragma unroll
            for (int b = 0; b < 2; ++b)
#pragma unroll
                for (int m = 0; m < 4; ++m)
#pragma unroll
                    for (int n = 0; n < 2; ++n) acc[a][b][m][n] = (f32x4){0.f, 0.f, 0.f, 0.f};
        cur = nxt; cA = nA; cB = nB; ++ui;
        if (wr == 1) PG8_BAR;
    }
    PG8_WAIT_V(0);
    PG8_BAR;
#undef PG8_SA
#undef PG8_SB
#undef PG8_STAGE
#undef PG8_LDA
#undef PG8_LDB
#undef PG8_LD2
#undef PG8_LO
#undef PG8_HI
#undef PG8_MMA
#undef PG8_WAIT_V
#undef PG8_WAIT_L
#undef PG8_BAR
#undef PG8_SCHED
#undef PG8_VOFF
}
}

constexpr size_t MiB = 1u << 20;
constexpr size_t WS_CTL = 0, CTL_ZERO_BYTES = 1 * MiB;
constexpr size_t WS_ATT_IN_T = 1 * MiB;
constexpr size_t WS_ATT_OUT_T = WS_ATT_IN_T + 36 * MiB;
constexpr size_t WS_RET_IN_T = WS_ATT_OUT_T + 4 * MiB;
constexpr size_t WS_RET_OUT_T = WS_RET_IN_T + 12 * MiB;
constexpr size_t WS_GLU_T = WS_RET_OUT_T + 4 * MiB;
constexpr size_t WS_RT_HI = WS_GLU_T + 4 * MiB;
constexpr size_t WS_RT_LO = WS_RT_HI + 512 * 1024;
constexpr size_t WS_WMOE = WS_RT_HI + 1 * MiB;
constexpr size_t WMOE_E_BYTES = (size_t)(512 * 1024 + 1024 * 256) * 2;
constexpr size_t WS_X = WS_WMOE + 98 * MiB;
constexpr size_t WS_Y = WS_X + 64 * MiB;
constexpr size_t WS_XB = WS_Y + 64 * MiB;
constexpr size_t WS_BIG = WS_XB + 32 * MiB;
constexpr size_t WS_AUX = WS_BIG + 288 * MiB;
constexpr size_t WS_H = WS_AUX + 160 * MiB;
constexpr size_t WS_LIST = WS_H + 80 * MiB;
constexpr size_t WS_TRASH = WS_LIST + 8 * MiB;
constexpr size_t WS_END = WS_TRASH + 1 * MiB;
static_assert(WS_END <= 1024 * MiB, "workspace map");
constexpr int CW_BAR = 4096;
constexpr int CW_CNT = 16384;
constexpr int CW_CHK = 65536;
constexpr int HROWS = 163840;

#define XB_TMO      128
#define XB_XCNT(j)  (256  + 64 * (j))
#define XB_XSUB(j)  (1280 + 64 * (j))
#define XB_XGEN(j)  (2304 + 64 * (j))
#define XB_TOP      3328
#define XB_TOPGEN   3392
#define XCD_BAR_WORDS 3456
#define XB_SPIN_CAP (1u << 20)
__device__ __forceinline__ unsigned xb_ld(unsigned* p)              { return __hip_atomic_load(p, __ATOMIC_RELAXED, __HIP_MEMORY_SCOPE_AGENT); }
__device__ __forceinline__ unsigned xb_add(unsigned* p, unsigned v) { return __hip_atomic_fetch_add(p, v, __ATOMIC_RELAXED, __HIP_MEMORY_SCOPE_AGENT); }
__device__ __forceinline__ unsigned xb_xcc_id() { return (unsigned)__builtin_amdgcn_s_getreg((3 << 11) | 20) & 0xFu; }
#define XB_SPIN(cond, bar) do { unsigned _sp = 0; while (cond) { __builtin_amdgcn_s_sleep(1); \
    if ((++_sp & 255u) == 0u) { if (xb_ld(&(bar)[XB_TMO])) break; if (_sp > XB_SPIN_CAP) { atomicAdd(&(bar)[XB_TMO], 1u); break; } } } } while (0)
struct XcdBarrier { unsigned* bar; unsigned x; volatile LAS unsigned* st; };
__device__ __forceinline__ XcdBarrier xcd_barrier_post(unsigned* bar, volatile LAS unsigned* st) {
    XcdBarrier b; b.bar = bar; b.x = xb_xcc_id(); b.st = st;
    if (threadIdx.x == 0) (void)xb_add(&bar[XB_XCNT(b.x)], 1u);
    return b;
}
__device__ __forceinline__ void xcd_barrier_complete(unsigned* bar, unsigned x, unsigned& nloc, unsigned& nx) {
    const unsigned G = gridDim.x * gridDim.y * gridDim.z;
    unsigned sum, cnt, mine, sp = 0u;
    for (;;) {
        sum = 0u; cnt = 0u; mine = 0u;
#pragma unroll
        for (unsigned j = 0; j < 16; ++j) { const unsigned c = xb_ld(&bar[XB_XCNT(j)]); sum += c; cnt += (c > 0u) ? 1u : 0u; mine = (j == x) ? c : mine; }
        if (sum == G) break;
        __builtin_amdgcn_s_sleep(1);
        if ((++sp & 255u) == 0u) { if (xb_ld(&bar[XB_TMO])) break; if (sp > XB_SPIN_CAP) { atomicAdd(&bar[XB_TMO], 1u); break; } }
    }
    nloc = mine > 0u ? mine : 1u; nx = cnt > 0u ? cnt : 1u;
}
__device__ __forceinline__ void xcd_barrier(const XcdBarrier& b) {
    asm volatile("s_waitcnt vmcnt(0)" ::: "memory");
    __syncthreads();
    if (threadIdx.x == 0) {
        unsigned* bar = b.bar;
        __builtin_amdgcn_s_waitcnt(0);
        unsigned nloc = b.st[0], nx = b.st[1];
        if (nloc == 0u) { xcd_barrier_complete(bar, b.x, nloc, nx); b.st[0] = nloc; b.st[1] = nx; }
        const unsigned old = xb_add(&bar[XB_XSUB(b.x)], 1u);
        const unsigned gen = old / nloc;
        if (old + 1u == (gen + 1u) * nloc) {
            __builtin_amdgcn_fence(__ATOMIC_RELEASE, "agent");
            asm volatile("s_waitcnt vmcnt(0)" ::: "memory");
            const unsigned og = xb_add(&bar[XB_TOP], 1u);
            const unsigned tg = og / nx;
            if (og + 1u == (tg + 1u) * nx) xb_add(&bar[XB_TOPGEN], 1u);
            else XB_SPIN(xb_ld(&bar[XB_TOPGEN]) == tg, bar);
            __builtin_amdgcn_fence(__ATOMIC_ACQUIRE, "agent");
            xb_add(&bar[XB_XGEN(b.x)], 1u);
            asm volatile("s_waitcnt vmcnt(0)" ::: "memory");
        } else {
            XB_SPIN(xb_ld(&bar[XB_XGEN(b.x)]) == gen, bar);
            __builtin_amdgcn_fence(__ATOMIC_ACQUIRE, "agent");
            asm volatile("s_waitcnt vmcnt(0)" ::: "memory");
        }
    }
    __syncthreads();
}

constexpr int RING_BYTES = 139264;
constexpr int MISC_OFF = RING_BYTES;
constexpr int LDS_BYTES = 147456;
struct Params {
    const float* in[26]; float* out; unsigned char* ws; int ph_lo, ph_hi; int use_bar, pad;
};
typedef const __attribute__((address_space(4))) Params* KP;
__device__ __forceinline__ const float* gin(KP p, int i) { return (const float*)(const GAS float*)p->in[i]; }
__device__ __forceinline__ float* gout(KP p) { return (float*)(GAS float*)p->out; }
struct Frame {
    LAS unsigned char* lds; volatile LAS unsigned* MISC;
    int tid, lane, wave, vcu, G;
    unsigned char* ws;
};

template <bool F8_ = false> struct DenseSchedT {
    static constexpr bool GATHER = false, UNIFORMIZE = false, FP8 = F8_;
    const char* A; const char* Bt; int K, nM, nN, nwg, G, c;
    __device__ __forceinline__ void init(const void* A_, const void* Bt_, int M, int N, int K_, int G_, int c_) { A = (const char*)A_; Bt = (const char*)Bt_; K = K_; nM = M / 256; nN = N / 256; nwg = nM * nN; G = G_; c = c_; }
    __device__ __forceinline__ bool next(int i, pg8::UnitG& u) const {
        const long L = (long)i * G + c; if (L >= nwg) return false;
        int wgid = (int)L; { const int q = nwg / 8, r = nwg % 8, xcd = wgid % 8, off = wgid / 8; wgid = (xcd < r ? xcd * (q + 1) : r * (q + 1) + (xcd - r) * q) + off; }
        const int nig = 8 * nN, gid = wgid / nig, fm = gid * 8, gsz = (nM - fm) < 8 ? (nM - fm) : 8;
        const int pm = fm + ((wgid % nig) % gsz), pn = (wgid % nig) / gsz;
        u.A = A + (size_t)pm * 256 * K * 2; u.B = Bt + (size_t)pn * 256 * K * 2; u.gidx = nullptr; u.gcnt = 0; u.gshift = 0; u.row0 = pm * 256; u.col0 = pn * 256; u.aux = 0; return true;
    }
};
typedef DenseSchedT<false> DenseSched; typedef DenseSchedT<true> DenseSched8;
__device__ __forceinline__ u32x4 pack_bf16x8(const f32x4& v0, const f32x4& v1) { u32x4 w; w.x = pk2hw(v0[0], v0[1]); w.y = pk2hw(v0[2], v0[3]); w.z = pk2hw(v1[0], v1[1]); w.w = pk2hw(v1[2], v1[3]); return w; }

constexpr float WUP_SCALE = 32.0f, WUP_INV = 1.0f / 32.0f;
struct EpiStoreBf16 {
    static constexpr bool PERM = true, PERM16 = false;
    bf16* O; int ldc; float osc, qsc;
    __device__ __forceinline__ void operator()(const f32x4 (&acc)[2][2][4][2], const pg8::UnitG& u, int wr, int wc, int fr, int fq) const {
        const float sc = ((u.col0 % 3072) < 1024) ? osc * qsc : osc;
#pragma unroll
        for (int ai = 0; ai < 2; ++ai)
#pragma unroll
            for (int m = 0; m < 4; ++m) { bf16* rowp = O + (size_t)(u.row0 + ai * 128 + wr * 64 + m * 16 + fr) * ldc + u.col0 + wc * 32 + 8 * fq;
#pragma unroll
                for (int bj = 0; bj < 2; ++bj) *(u32x4*)(rowp + bj * 128) = pack_bf16x8(acc[ai][bj][m][0] * sc, acc[ai][bj][m][1] * sc); }
    }
};
constexpr float YEXP_SCALE = 32.0f, YEXP_INV = 1.0f / 32.0f;
struct EpiStoreFp8 {
    static constexpr bool PERM = false, PERM16 = true;
    unsigned char* O; int ldc;
    __device__ __forceinline__ void operator()(const f32x4 (&acc)[2][2][4][2], const pg8::UnitG& u, int wr, int wc, int fr, int fq) const {
#pragma unroll
        for (int ai = 0; ai < 2; ++ai)
#pragma unroll
            for (int m = 0; m < 4; ++m) { unsigned char* rowp = O + (size_t)(u.row0 + ai * 128 + wr * 64 + m * 16 + fr) * ldc + u.col0 + wc * 64 + 16 * fq;
                u32x4 w;
#pragma unroll
                for (int q = 0; q < 4; ++q) { f32x4 v = acc[ai][q >> 1][m][q & 1] * YEXP_SCALE;
#pragma unroll
                    for (int j = 0; j < 4; ++j) v[j] = fminf(fmaxf(v[j], -448.0f), 448.0f);
                    int d = 0; d = __builtin_amdgcn_cvt_pk_fp8_f32(v[0], v[1], d, false); d = __builtin_amdgcn_cvt_pk_fp8_f32(v[2], v[3], d, true); w[q] = (unsigned)d; }
                *(u32x4*)rowp = w; }
    }
};
struct EpiRetIn {
    static constexpr bool PERM = true, PERM16 = false;
    bf16* O; int ldc;
    __device__ __forceinline__ void operator()(const f32x4 (&acc)[2][2][4][2], const pg8::UnitG& u, int wr, int wc, int fr, int fq) const {
        float l2g = 0.f;
        float cs = WUP_INV;
        if (u.col0 < 2048) { const int h = (u.col0 & 1023) >> 8; const float g = 1.0f - exp2f(-5.0f - (float)h); l2g = log2f(g); if (u.col0 >= 1024) { l2g = -l2g; cs *= 0.0625f; } }
#pragma unroll
        for (int ai = 0; ai < 2; ++ai)
#pragma unroll
            for (int m = 0; m < 4; ++m) { const int row = u.row0 + ai * 128 + wr * 64 + m * 16 + fr; const float sc = exp2f(l2g * (float)(row & 127)) * cs;
                bf16* rowp = O + (size_t)row * ldc + u.col0 + wc * 32 + 8 * fq;
#pragma unroll
                for (int bj = 0; bj < 2; ++bj) *(u32x4*)(rowp + bj * 128) = pack_bf16x8(acc[ai][bj][m][0] * sc, acc[ai][bj][m][1] * sc); }
    }
};
__device__ __forceinline__ void unpack_bf16x8(const u32x4& w, f32x4& a, f32x4& b) { a[0] = bflo(w.x); a[1] = bfhi(w.x); a[2] = bflo(w.y); a[3] = bfhi(w.y); b[0] = bflo(w.z); b[1] = bfhi(w.z); b[2] = bflo(w.w); b[3] = bfhi(w.w); }
struct EpiResid {
    static constexpr bool PERM = true, PERM16 = false;
    const bf16* X; bf16* Y;
    __device__ __forceinline__ void operator()(const f32x4 (&acc)[2][2][4][2], const pg8::UnitG& u, int wr, int wc, int fr, int fq) const {
        u32x4 xw[2][4][2];
#pragma unroll
        for (int ai = 0; ai < 2; ++ai)
#pragma unroll
            for (int m = 0; m < 4; ++m) { const size_t off = (size_t)(u.row0 + ai * 128 + wr * 64 + m * 16 + fr) * D + u.col0 + wc * 32 + 8 * fq;
#pragma unroll
                for (int bj = 0; bj < 2; ++bj) xw[ai][m][bj] = *(const u32x4*)(X + off + bj * 128); }
        asm volatile("" ::: "memory");
#pragma unroll
        for (int ai = 0; ai < 2; ++ai)
#pragma unroll
            for (int m = 0; m < 4; ++m) { const size_t off = (size_t)(u.row0 + ai * 128 + wr * 64 + m * 16 + fr) * D + u.col0 + wc * 32 + 8 * fq;
#pragma unroll
                for (int bj = 0; bj < 2; ++bj) { f32x4 x0, x1; unpack_bf16x8(xw[ai][m][bj], x0, x1);
                    *(u32x4*)(Y + off + bj * 128) = pack_bf16x8(x0 * ALPHA + acc[ai][bj][m][0], x1 * ALPHA + acc[ai][bj][m][1]); } }
    }
};
struct EpiGluResid {
    static constexpr bool PERM = true, PERM16 = false;
    const bf16* X; bf16* Y;
    __device__ __forceinline__ void operator()(const f32x4 (&acc)[2][2][4][2], const pg8::UnitG& u, int wr, int wc, int fr, int fq) const {
        u32x4 xw[2][4];
#pragma unroll
        for (int ai = 0; ai < 2; ++ai)
#pragma unroll
            for (int m = 0; m < 4; ++m) { const size_t off = (size_t)(u.row0 + ai * 128 + wr * 64 + m * 16 + fr) * D + (u.col0 >> 1) + wc * 32 + 8 * fq; xw[ai][m] = *(const u32x4*)(X + off); }
        asm volatile("" ::: "memory");
#pragma unroll
        for (int ai = 0; ai < 2; ++ai)
#pragma unroll
            for (int m = 0; m < 4; ++m) { const size_t off = (size_t)(u.row0 + ai * 128 + wr * 64 + m * 16 + fr) * D + (u.col0 >> 1) + wc * 32 + 8 * fq;
                f32x4 x0, x1; unpack_bf16x8(xw[ai][m], x0, x1); f32x4 o0, o1;
#pragma unroll
                for (int j = 0; j < 4; ++j) { o0[j] = x0[j] * ALPHA + acc[ai][0][m][0][j] * fsig(acc[ai][1][m][0][j]); o1[j] = x1[j] * ALPHA + acc[ai][0][m][1][j] * fsig(acc[ai][1][m][1][j]); }
                *(u32x4*)(Y + off) = pack_bf16x8(o0, o1); }
    }
};
struct EpiMoeUp {
    static constexpr bool PERM = true, PERM16 = false;
    bf16* H;
    __device__ __forceinline__ void operator()(const f32x4 (&acc)[2][2][4][2], const pg8::UnitG& u, int wr, int wc, int fr, int fq) const {
#pragma unroll
        for (int ai = 0; ai < 2; ++ai)
#pragma unroll
            for (int m = 0; m < 4; ++m) { bf16* rowp = H + (size_t)(u.row0 + ai * 128 + wr * 64 + m * 16 + fr) * ED + u.col0 + wc * 32 + 8 * fq; f32x4 o[2];
#pragma unroll
                for (int n = 0; n < 2; ++n)
#pragma unroll
                    for (int j = 0; j < 4; ++j) { const float ga = acc[ai][0][m][n][j], ua = acc[ai][1][m][n][j];
                        o[n][j] = (ga * ua) * (WUP_INV * WUP_INV) * __builtin_amdgcn_rcpf(1.0f + __builtin_amdgcn_exp2f(ga * (-WUP_INV * 1.4426950408889634f))); }
                *(u32x4*)rowp = pack_bf16x8(o[0], o[1]); }
    }
};

__device__ __forceinline__ unsigned pk4_fp8(float a, float b, float c, float d) {
    a = fminf(fmaxf(a, -448.0f), 448.0f); b = fminf(fmaxf(b, -448.0f), 448.0f); c = fminf(fmaxf(c, -448.0f), 448.0f); d = fminf(fmaxf(d, -448.0f), 448.0f);
    int w = 0; w = __builtin_amdgcn_cvt_pk_fp8_f32(a, b, w, false); w = __builtin_amdgcn_cvt_pk_fp8_f32(c, d, w, true); return (unsigned)w; }
struct ConvD { const float* src; unsigned char* dst; unsigned char* dst2; int ldw, ldk, kind; };
__device__ __forceinline__ ConvD conv_mk8(const float* W, int ldw, unsigned char* WT, int ldk, int k0, int n0, int drow0) {
    ConvD d; d.src = W + (size_t)k0 * ldw + n0; d.dst = WT + (size_t)drow0 * ldk + k0; d.dst2 = nullptr; d.ldw = ldw; d.ldk = ldk; d.kind = 1; return d; }
__device__ __forceinline__ ConvD conv_mk16(const float* W, int ldw, bf16* WT, bf16* WTlo, int ldk, int k0, int n0, int drow0) {
    ConvD d; d.src = W + (size_t)k0 * ldw + n0; d.dst = (unsigned char*)(WT + (size_t)drow0 * ldk + k0); d.dst2 = WTlo ? (unsigned char*)(WTlo + (size_t)drow0 * ldk + k0) : nullptr; d.ldw = ldw; d.ldk = ldk * 2; d.kind = WTlo ? 2 : 0; return d; }
__device__ __forceinline__ void conv_load(const ConvD& d, int lane, f32x4 (&r)[8]) {
#pragma unroll
    for (int i = 0; i < 8; ++i) { const int kk = 8 * i + (lane >> 3), c4 = 4 * (lane & 7); r[i] = *(const f32x4*)(d.src + (size_t)kk * d.ldw + c4); }
}
template <bool HILO>
__device__ __forceinline__ void conv_finish(const ConvD& d, int lane, const f32x4 (&r)[8], LAS float* scr) {
    const float scale = (d.kind == 1) ? WUP_SCALE : 1.0f;
#pragma unroll
    for (int i = 0; i < 8; ++i) { const int kk = 8 * i + (lane >> 3), c4 = 4 * (lane & 7);
        scr[kk * 33 + c4] = r[i][0] * scale; scr[kk * 33 + c4 + 1] = r[i][1] * scale; scr[kk * 33 + c4 + 2] = r[i][2] * scale; scr[kk * 33 + c4 + 3] = r[i][3] * scale; }
    LDS_WAIT(); asm volatile("" ::: "memory");
    const int c = lane & 7;
#pragma unroll
    for (int j = 0; j < 4; ++j) { const int n = (lane >> 3) + 8 * j; const LAS float* s = scr + (8 * c) * 33 + n;
        float v[8];
#pragma unroll
        for (int q = 0; q < 8; ++q) v[q] = s[q * 33];
        if (d.kind == 1) { u32x2 o; o.x = pk4_fp8(v[0], v[1], v[2], v[3]); o.y = pk4_fp8(v[4], v[5], v[6], v[7]); *(u32x2*)(d.dst + (size_t)n * d.ldk + 8 * c) = o; }
        else { u32x4 o; o.x = pk2(v[0], v[1]); o.y = pk2(v[2], v[3]); o.z = pk2(v[4], v[5]); o.w = pk2(v[6], v[7]);
            *(u32x4*)(d.dst + (size_t)n * d.ldk + 16 * c) = o;
            if (HILO) { float rr[8];
#pragma unroll
                for (int q = 0; q < 8; ++q) rr[q] = v[q] - bf2f(f2bf(v[q]));
                u32x4 o2; o2.x = pk2(rr[0], rr[1]); o2.y = pk2(rr[2], rr[3]); o2.z = pk2(rr[4], rr[5]); o2.w = pk2(rr[6], rr[7]);
                *(u32x4*)(d.dst2 + (size_t)n * d.ldk + 16 * c) = o2; } } }
    LDS_WAIT(); asm volatile("" ::: "memory");
}
__device__ __forceinline__ void conv_dma(const ConvD& d, int lane, LAS float* buf) {
#pragma unroll
    for (int i = 0; i < 8; ++i) { const float* g = d.src + (size_t)(8 * i + (lane >> 3)) * d.ldw + 4 * ((lane & 7) ^ i);
        __builtin_amdgcn_global_load_lds((const unsigned*)g, (LAS unsigned*)(buf + i * 256), 16, 0, 0); }
}
__device__ __forceinline__ void conv_finish_lds(const ConvD& d, int lane, const LAS float* buf) {
    const float scale = (d.kind == 1) ? WUP_SCALE : 1.0f;
    const int c = lane & 7;
#pragma unroll
    for (int j = 0; j < 4; ++j) { const int n = (lane >> 3) + 8 * j; const LAS float* s = buf + (8 * c) * 32 + (((n >> 2) ^ c) & 7) * 4 + (n & 3);
        float v[8];
#pragma unroll
        for (int q = 0; q < 8; ++q) v[q] = s[q * 32] * scale;
        if (d.kind == 1) { u32x2 o; o.x = pk4_fp8(v[0], v[1], v[2], v[3]); o.y = pk4_fp8(v[4], v[5], v[6], v[7]); *(u32x2*)(d.dst + (size_t)n * d.ldk + 8 * c) = o; }
        else { u32x4 o; o.x = pk2(v[0], v[1]); o.y = pk2(v[2], v[3]); o.z = pk2(v[4], v[5]); o.w = pk2(v[6], v[7]); *(u32x4*)(d.dst + (size_t)n * d.ldk + 16 * c) = o; } }
    LDS_WAIT(); asm volatile("" ::: "memory");
}
#define CONV_RUN(NIT, DEC) do { int it_ = gw; if (it_ < (NIT)) { ConvD dc_ = DEC(it_); int par_ = 0; conv_dma(dc_, F.lane, scr); asm volatile("s_waitcnt vmcnt(0)" ::: "memory"); \
        for (; it_ < (NIT); it_ += NGW) { const int itn_ = (it_ + NGW < (NIT)) ? it_ + NGW : it_; const ConvD dn_ = DEC(itn_); conv_dma(dn_, F.lane, scr + (par_ ^ 1) * 2048);     \
            asm volatile("s_waitcnt vmcnt(12)" ::: "memory"); conv_finish_lds(dc_, F.lane, scr + par_ * 2048); dc_ = dn_; par_ ^= 1; } \
        asm volatile("s_waitcnt vmcnt(0)" ::: "memory"); } } while (0)
__device__ __forceinline__ ConvD conv_dec_mixers(KP p, unsigned char* ws, int it) {
    constexpr int I_AIN = 16 * 288, I_AOUT = 16 * 32, I_RIN = 16 * 192, I_ROUT = 32 * 32, I_GLU = 16 * 64, I_RT = 16 * 2;
    int r = it;
    if (r < 2 * I_AIN) { const int j = r / I_AIN; r %= I_AIN; const int kb = r / 288, nb = r % 288, n0 = nb * 32;
        return conv_mk8(gin(p, 1) + (size_t)j * D * ATT_IN, ATT_IN, (unsigned char*)(ws + WS_ATT_IN_T) + (size_t)j * ATT_IN * D, D, kb * 64, n0, n0); }
    r -= 2 * I_AIN;
    if (r < 2 * I_AOUT) { const int j = r / I_AOUT; r %= I_AOUT; const int kb = r / 32, nb = r % 32, n0 = nb * 32;
        return conv_mk16(gin(p, 2) + (size_t)j * D * D, D, (bf16*)(ws + WS_ATT_OUT_T) + (size_t)j * D * D, nullptr, D, kb * 64, n0, n0); }
    r -= 2 * I_AOUT;
    if (r < I_RIN) { const int kb = r / 192, nb = r % 192, n0 = nb * 32;
        return conv_mk8(gin(p, 3), RET_IN, (unsigned char*)(ws + WS_RET_IN_T), D, kb * 64, n0, n0); }
    r -= I_RIN;
    if (r < I_ROUT) { const int kb = r / 32, nb = r % 32, n0 = nb * 32;
        return conv_mk16(gin(p, 6), D, (bf16*)(ws + WS_RET_OUT_T), nullptr, RET_V, kb * 64, n0, n0); }
    r -= I_ROUT;
    if (r < I_GLU) { const int kb = r / 64, nb = r % 64, n0 = nb * 32; const int c = n0 & 1023, drow = (c >> 7) * 256 + (n0 >> 10) * 128 + (c & 127);
        return conv_mk16(gin(p, 15), 2 * D, (bf16*)(ws + WS_GLU_T), nullptr, D, kb * 64, n0, drow); }
    r -= I_GLU;
    { const int l = r / I_RT; r %= I_RT; const int kb = r / 2, nb = r % 2, n0 = nb * 32;
        return conv_mk16(gin(p, 16) + (size_t)l * D * NE, NE, (bf16*)(ws + WS_RT_HI) + (size_t)l * NE * D, (bf16*)(ws + WS_RT_LO) + (size_t)l * NE * D, D, kb * 64, n0, n0); }
}
__device__ __forceinline__ ConvD conv_dec_moe(KP p, unsigned char* ws, int l, int it) {
    const int e = it / 384, r = it % 384, which = r >> 7, rr = r & 127;
    bf16* We = (bf16*)(ws + WS_WMOE + (size_t)e * WMOE_E_BYTES);
    if (which < 2) { const float* src = (e < 64) ? gin(p, 18 + which) + ((size_t)l * NE + e) * D * ED : gin(p, 21 + which) + (size_t)l * D * ED;
        const int kb = rr >> 3, nb = rr & 7, n0 = nb * 32; const int drow = (n0 >> 7) * 256 + which * 128 + (n0 & 127);
        return conv_mk8(src, ED, (unsigned char*)We, D, kb * 64, n0, drow); }
    const float* src = (e < 64) ? gin(p, 20) + ((size_t)l * NE + e) * ED * D : gin(p, 23) + (size_t)l * ED * D;
    const int kb = rr >> 5, nb = rr & 31, n0 = nb * 32;
    return conv_mk16(src, D, We + 512 * 1024, nullptr, ED, kb * 64, n0, n0);
}
__device__ __forceinline__ void phase_conv_mixers(const Frame& F, KP p) {
    LAS float* scr = (LAS float*)(F.lds + F.wave * 16384);
    const int gw = F.vcu * NWAVES + F.wave, NGW = F.G * NWAVES;
    constexpr int NMAIN = 2 * (16 * 288) + 2 * (16 * 32) + 16 * 192 + 32 * 32 + 16 * 64, NRT = 4 * (16 * 2);
    unsigned char* ws = F.ws;
#define CONV_DEC_MIX(i_) conv_dec_mixers(p, ws, (i_))
    CONV_RUN(NMAIN, CONV_DEC_MIX);
    for (int it = NMAIN + gw; it < NMAIN + NRT; it += NGW) { const ConvD d = conv_dec_mixers(p, ws, it); f32x4 r[8]; conv_load(d, F.lane, r); conv_finish<true>(d, F.lane, r, scr); }
#undef CONV_DEC_MIX
}
__device__ __forceinline__ void phase_conv_moe(const Frame& F, KP p, int l) {
    LAS float* scr = (LAS float*)(F.lds + F.wave * 16384);
    const int gw = F.vcu * NWAVES + F.wave, NGW = F.G * NWAVES;
    unsigned char* ws = F.ws;
#define CONV_DEC_MOE(i_) conv_dec_moe(p, ws, l, (i_))
    CONV_RUN(65 * 384, CONV_DEC_MOE);
#undef CONV_DEC_MOE
}

__device__ __forceinline__ void phase_lnr(const Frame& F, KP p, int layer, bool dry = false) {
    const bf16* Y = (const bf16*)(F.ws + WS_Y); bf16* XB = (bf16*)(F.ws + WS_XB); unsigned char* XB8 = (unsigned char*)(F.ws + WS_X);
    const float* lng = gin(p, 24) + (size_t)(layer * 2) * D; const float* lnb = gin(p, 25) + (size_t)(layer * 2) * D;
    const bf16* rthi = (const bf16*)(F.ws + WS_RT_HI) + (size_t)layer * NE * D; const bf16* rtlo = (const bf16*)(F.ws + WS_RT_LO) + (size_t)layer * NE * D;
    const float* rbias = gin(p, 17) + layer * NE;
    unsigned* cnt = (unsigned*)(F.ws + WS_CTL) + CW_CNT + layer * NE * 64;
    int* lists = (int*)(F.ws + WS_LIST); int* tokmap = (int*)(F.ws + WS_LIST + 4 * MiB); float* tokgate = (float*)(F.ws + WS_LIST + 5 * MiB);
    constexpr int XLD = 1032, MAXT = 8;
    LAS bf16* Xhi = (LAS bf16*)F.lds; LAS bf16* Xlo = Xhi + 16 * XLD;
    LAS float* part = (LAS float*)(F.lds + 2 * 16 * XLD * 2);
    LAS int* ent = (LAS int*)(part + 2 * 16 * 64);
    LAS int* hist = ent + MAXT * 16 * 8 * 2; LAS int* base = hist + 64;
    const int lane = F.lane, w = F.wave, g4 = lane >> 4, l15 = lane & 15;
    if (F.tid < 64) hist[F.tid] = 0;
    bf16x8 bhi[16], blo[16];
    { const int nt = w & 3, kh = w >> 2; const bf16* bh = rthi + (size_t)(16 * nt + l15) * D + 512 * kh + 8 * g4; const bf16* bl = rtlo + (size_t)(16 * nt + l15) * D + 512 * kh + 8 * g4;
#pragma unroll
        for (int ks = 0; ks < 16; ++ks) { bhi[ks] = *(const bf16x8*)(bh + 32 * ks); blo[ks] = *(const bf16x8*)(bl + 32 * ks); } }
    u32x4 ypre[2][2];
    if (F.vcu < T / 16) {
#pragma unroll
        for (int rr = 0; rr < 2; ++rr)
#pragma unroll
            for (int j = 0; j < 2; ++j) ypre[rr][j] = *(const u32x4*)(Y + (size_t)(F.vcu * 16 + 2 * w + rr) * D + 8 * lane + 512 * j); }
    int ntile = 0;
    for (int tile = F.vcu; tile < T / 16 && ntile < MAXT; tile += F.G, ++ntile) {
        const int t0 = tile * 16;
        u32x4 ycur[2][2];
#pragma unroll
        for (int rr = 0; rr < 2; ++rr)
#pragma unroll
            for (int j = 0; j < 2; ++j) ycur[rr][j] = ypre[rr][j];
        if (tile + F.G < T / 16) {
#pragma unroll
            for (int rr = 0; rr < 2; ++rr)
#pragma unroll
                for (int j = 0; j < 2; ++j) ypre[rr][j] = *(const u32x4*)(Y + (size_t)((tile + F.G) * 16 + 2 * w + rr) * D + 8 * lane + 512 * j); }
#pragma unroll
        for (int rr = 0; rr < 2; ++rr) {
            const int lr = 2 * w + rr; const size_t row = (size_t)(t0 + lr);
            f32x4 v[4]; float s = 0.f;
#pragma unroll
            for (int j = 0; j < 2; ++j) unpack_bf16x8(ycur[rr][j], v[2 * j], v[2 * j + 1]);
#pragma unroll
            for (int j = 0; j < 4; ++j) s += (v[j][0] + v[j][1]) + (v[j][2] + v[j][3]);
            const float mean = wave_sum(s, lane) * (1.f / D); float s2 = 0.f;
#pragma unroll
            for (int j = 0; j < 4; ++j) { v[j] = v[j] - mean; s2 += (v[j][0] * v[j][0] + v[j][1] * v[j][1]) + (v[j][2] * v[j][2] + v[j][3] * v[j][3]); }
            const float rstd = 1.0f / sqrtf(wave_sum(s2, lane) * (1.f / D) + LN_EPS);
#pragma unroll
            for (int j = 0; j < 2; ++j) { const f32x4 g0 = *(const f32x4*)(lng + 8 * lane + 512 * j), g1 = *(const f32x4*)(lng + 8 * lane + 512 * j + 4), b0 = *(const f32x4*)(lnb + 8 * lane + 512 * j), b1 = *(const f32x4*)(lnb + 8 * lane + 512 * j + 4);
                const f32x4 o0 = v[2 * j] * rstd * g0 + b0, o1 = v[2 * j + 1] * rstd * g1 + b1;
                const u32x4 hi = pack_bf16x8(o0, o1);
                *(u32x4*)(XB + row * D + 8 * lane + 512 * j) = hi;
                { u32x2 q8; q8.x = pk4_fp8(o0[0], o0[1], o0[2], o0[3]); q8.y = pk4_fp8(o1[0], o1[1], o1[2], o1[3]); *(u32x2*)(XB8 + row * D + 8 * lane + 512 * j) = q8; }
                f32x4 h0, h1; unpack_bf16x8(hi, h0, h1); const u32x4 lo = pack_bf16x8(o0 - h0, o1 - h1);
                *(LAS u32x4*)(Xhi + lr * XLD + 8 * lane + 512 * j) = hi; *(LAS u32x4*)(Xlo + lr * XLD + 8 * lane + 512 * j) = lo; }
        }
        __syncthreads();
        { const int nt = w & 3, kh = w >> 2; f32x4 a0 = (f32x4){0.f, 0.f, 0.f, 0.f}, a1 = a0, a2 = a0, a3 = a0, a4 = a0, a5 = a0;
#pragma unroll
            for (int ks = 0; ks < 16; ks += 2) { const int k0 = 512 * kh + 32 * ks;
                const bf16x8 ahi = row_frag(Xhi, XLD, 0, k0, lane), alo = row_frag(Xlo, XLD, 0, k0, lane), bhi2 = row_frag(Xhi, XLD, 0, k0 + 32, lane), blo2 = row_frag(Xlo, XLD, 0, k0 + 32, lane);
                a0 = MFMA16(ahi, bhi[ks], a0); a1 = MFMA16(alo, bhi[ks], a1); a2 = MFMA16(ahi, blo[ks], a2);
                a3 = MFMA16(bhi2, bhi[ks + 1], a3); a4 = MFMA16(blo2, bhi[ks + 1], a4); a5 = MFMA16(bhi2, blo[ks + 1], a5); }
            const f32x4 acc = ((a0 + a3) + (a1 + a4)) + (a2 + a5);
#pragma unroll
            for (int i = 0; i < 4; ++i) part[(kh * 16 + 4 * g4 + i) * 64 + 16 * nt + l15] = acc[i];
        }
        __syncthreads();
#pragma unroll
        for (int rr = 0; rr < 2; ++rr) {
            const int lt = ntile * 16 + 2 * w + rr;
            const float lg = part[(2 * w + rr) * 64 + lane] + part[(16 + 2 * w + rr) * 64 + lane];
            float sc = 1.0f / (1.0f + expf(-lg)); sc = (sc == sc) ? sc : 0.5f;
            const float sel = sc + rbias[lane];
            const float m1 = max8(sel);
            const unsigned long long eq = __ballot(sel == m1);
            const unsigned gm = (unsigned)(eq >> (lane & 56)) & 0xffu;
            const int first = (lane & 56) + __builtin_ctz(gm | 0x100u);
            const float m2 = max8((lane == first) ? -INFINITY : sel);
            const float gs = m1 + m2; const int mygrp = lane >> 3; int grank = 0;
#pragma unroll
            for (int gg = 0; gg < 8; ++gg) { const float o = rdl(gs, 8 * gg); grank += (o > gs || (o == gs && gg < mygrp)) ? 1 : 0; }
            const float mv = (grank < 4) ? sel : -INFINITY;
            unsigned key = __builtin_bit_cast(unsigned, mv); key = (key >> 31) ? ~key : (key | 0x80000000u); key = (key & ~63u) | (unsigned)(63 - lane);
            int r0 = 0, r1 = 0, r2 = 0, r3 = 0;
#pragma unroll
            for (int e2 = 0; e2 < 64; e2 += 4) { r0 += ((unsigned)__builtin_amdgcn_readlane((int)key, e2) > key) ? 1 : 0; r1 += ((unsigned)__builtin_amdgcn_readlane((int)key, e2 + 1) > key) ? 1 : 0;
                r2 += ((unsigned)__builtin_amdgcn_readlane((int)key, e2 + 2) > key) ? 1 : 0; r3 += ((unsigned)__builtin_amdgcn_readlane((int)key, e2 + 3) > key) ? 1 : 0; }
            const int rank = (r0 + r1) + (r2 + r3);
            const bool chosen = rank < TOPK;
            const float wsum = wave_sum(chosen ? sc : 0.f, lane);
            if (chosen) { const int lpos = __hip_atomic_fetch_add(hist + lane, 1, __ATOMIC_RELAXED, __HIP_MEMORY_SCOPE_WORKGROUP);
                ent[(lt * 8 + rank) * 2] = (lane << 16) | lpos; ent[(lt * 8 + rank) * 2 + 1] = __builtin_bit_cast(int, sc / wsum * 2.5f); }
        }
    }
    __syncthreads();
    if (dry) return;
    if (F.tid < 64) { const int hcount = hist[F.tid]; base[F.tid] = hcount ? (int)atomicAdd(cnt + F.tid * 64, (unsigned)hcount) : 0; }
    __syncthreads();
    for (int idx = F.tid; idx < ntile * 16 * 8; idx += NTHREADS) {
        const int ev = ent[idx * 2], gb = ent[idx * 2 + 1]; const int e = ev >> 16, pos = base[e] + (ev & 0xffff);
        const int lt = idx >> 3, rank = idx & 7, tok = (F.vcu + (lt >> 4) * F.G) * 16 + (lt & 15);
        lists[(size_t)e * T + pos] = tok; tokmap[tok * 8 + rank] = (e << 16) | pos; tokgate[tok * 8 + rank] = __builtin_bit_cast(float, gb);
    }
}

__device__ __forceinline__ void phase_combine(const Frame& F, KP p, int layer, bool dry = false) {
    bf16* XB = (bf16*)(F.ws + WS_XB); const unsigned char* yexp = (const unsigned char*)(F.ws + WS_BIG);
    const int* tokmap = (const int*)(F.ws + WS_LIST + 4 * MiB); const float* tokgate = (const float*)(F.ws + WS_LIST + 5 * MiB);
    const volatile LAS int* tstart = (const volatile LAS int*)(F.MISC + 64);
    const float* lng = gin(p, 24) + (size_t)(layer * 2 + 1) * D; const float* lnb = gin(p, 25) + (size_t)(layer * 2 + 1) * D;
    float* outp = gout(p); bf16* xbo = XB; if (dry) { outp = (float*)(F.ws + WS_AUX); xbo = (bf16*)(F.ws + WS_H); }
    const int lane = F.lane, gw = F.vcu * NWAVES + F.wave, NGW = F.G * NWAVES;
    const bf16* ysh = (const bf16*)(F.ws + WS_Y);
    f32x4 gv[4], bv[4];
#pragma unroll
    for (int j = 0; j < 4; ++j) { gv[j] = *(const f32x4*)(lng + 16 * lane + 4 * j); bv[j] = *(const f32x4*)(lnb + 16 * lane + 4 * j); }
    for (int row = gw; row < T; row += NGW) {
        const int mk = tokmap[row * 8 + (lane & 7)]; const float gk = tokgate[row * 8 + (lane & 7)] * YEXP_INV;
        const int rk = (int)tstart[mk >> 16] * 256 + (mk & 0xffff);
        f32x4 v[4];
#pragma unroll
        for (int j = 0; j < 2; ++j) { const u32x4 xw = *(const u32x4*)(ysh + (size_t)row * D + 16 * lane + 8 * j); unpack_bf16x8(xw, v[2 * j], v[2 * j + 1]); }
#pragma unroll
        for (int k = 0; k < TOPK; ++k) { const int r = __builtin_amdgcn_readlane(rk, k); const float g = rdl(gk, k);
            const u32x4 s = *(const u32x4*)(yexp + (size_t)r * D + 16 * lane);
#pragma unroll
            for (int j = 0; j < 4; ++j) { const f32x2 lo = __builtin_amdgcn_cvt_pk_f32_fp8((int)s[j], false), hi = __builtin_amdgcn_cvt_pk_f32_fp8((int)s[j], true);
                v[j][0] += g * lo[0]; v[j][1] += g * lo[1]; v[j][2] += g * hi[0]; v[j][3] += g * hi[1]; } }
        float s = 0.f;
#pragma unroll
        for (int j = 0; j < 4; ++j) s += (v[j][0] + v[j][1]) + (v[j][2] + v[j][3]);
        const float mean = wave_sum(s, lane) * (1.f / D); float s2 = 0.f;
#pragma unroll
        for (int j = 0; j < 4; ++j) { v[j] = v[j] - mean; s2 += (v[j][0] * v[j][0] + v[j][1] * v[j][1]) + (v[j][2] * v[j][2] + v[j][3] * v[j][3]); }
        const float rstd = 1.0f / sqrtf(wave_sum(s2, lane) * (1.f / D) + LN_EPS);
        f32x4 o[4];
#pragma unroll
        for (int j = 0; j < 4; ++j) o[j] = v[j] * rstd * gv[j] + bv[j];
        if (layer == DEPTH - 1 || dry) {
#pragma unroll
            for (int j = 0; j < 4; ++j) *(f32x4*)(outp + (size_t)row * D + 16 * lane + 4 * j) = o[j]; }
        if (layer != DEPTH - 1) { *(u32x4*)(xbo + (size_t)row * D + 16 * lane) = pack_bf16x8(o[0], o[1]); *(u32x4*)(xbo + (size_t)row * D + 16 * lane + 8) = pack_bf16x8(o[2], o[3]);
            if (!dry) { u32x4 q8; q8.x = pk4_fp8(o[0][0], o[0][1], o[0][2], o[0][3]); q8.y = pk4_fp8(o[1][0], o[1][1], o[1][2], o[1][3]); q8.z = pk4_fp8(o[2][0], o[2][1], o[2][2], o[2][3]); q8.w = pk4_fp8(o[3][0], o[3][1], o[3][2], o[3][3]);
                *(u32x4*)((unsigned char*)(F.ws + WS_X) + (size_t)row * D + 16 * lane) = q8; } }
    }
}

constexpr size_t AUX_OB = 96 * MiB, AUX_LSE = 128 * MiB;
__device__ __forceinline__ void phase_attn(const Frame& F, int bx) {
    const bf16* qkv = (const bf16*)(F.ws + WS_BIG); bf16* og = (bf16*)(F.ws + WS_AUX); float* lse = (float*)(F.ws + WS_AUX + AUX_LSE);
    constexpr int KLD = 136;
    LAS bf16* Ks = (LAS bf16*)F.lds; LAS bf16* Vs = Ks + 256 * KLD;
    const int lane = F.lane, w = F.wave, g4 = lane >> 4, l15 = lane & 15, qq = l15 >> 2, pp = lane & 3;
    u32x4 kc[4], vc[4];
    constexpr int NRUN = 768;
#define ATT_LOADBLK(KR, VR, nblk) do { _Pragma("unroll") for (int it = 0; it < 4; ++it) { const int idx = F.tid + 512 * it, c = idx >> 4, ch = idx & 15; int pos = 128 * (nblk) + c; pos = pos < 0 ? 0 : pos; \
            const unsigned so = (rowbase + (unsigned)pos * (unsigned)d + (unsigned)r) * (unsigned)ATT_IN + (unsigned)(g * 3072 + 1024 + h * 128 + ch * 8); KR[it] = *(const u32x4*)(qkv + so); VR[it] = *(const u32x4*)(qkv + so + 1024u); } } while (0)
#define ATT_STOREBLK(KR, VR, slot) do { _Pragma("unroll") for (int it = 0; it < 4; ++it) { const int idx = F.tid + 512 * it, c = idx >> 4, ch = idx & 15; \
            *(LAS u32x4*)(Ks + (128 * (slot) + c) * KLD + ch * 8) = KR[it]; *(LAS u32x4*)(Vs + (128 * (slot) + c) * KLD + ch * 8) = VR[it]; } } while (0)
    for (int R = bx; R < NRUN; R += F.G) {
        const int h = R & 7, sbr = R >> 3, g = sbr >> 5, rem = sbr & 31, b = rem >> 4, rr_ = rem & 15;
        const int dsh = 2 * g, d = 1 << dsh, nrs = 4 - dsh, r = rr_ >> nrs, n0 = 4 * (rr_ & ((1 << nrs) - 1)); const unsigned rowbase = (unsigned)b * SEQ;
        ATT_LOADBLK(kc, vc, n0 - 1); ATT_STOREBLK(kc, vc, (n0 - 1) & 1); ATT_LOADBLK(kc, vc, n0);
#pragma unroll 1
        for (int j = 0; j < 4; ++j) {
            const int n = n0 + j, cs = n & 1, ps = cs ^ 1;
            ATT_STOREBLK(kc, vc, cs);
            const int qi = 16 * w + l15; const unsigned qrow = rowbase + (unsigned)(128 * n + qi) * (unsigned)d + (unsigned)r;
            bf16x8 qf[4];
#pragma unroll
            for (int s = 0; s < 4; ++s) qf[s] = *(const bf16x8*)(qkv + (qrow * (unsigned)ATT_IN + (unsigned)(g * 3072 + h * 128 + 32 * s + 8 * g4)));
            __syncthreads();
            if (j < 3) { ATT_LOADBLK(kc, vc, n + 1); }
            __builtin_amdgcn_sched_barrier(0);
            const int ws0 = (16 * w < 96) ? 16 * w : 96;
#define ATT_PROW(c0) (((c0) < 128) ? (128 * ps + (c0)) : (128 * cs + (c0) - 128))
            f32x4 sacc[10];
            {
                bf16x8 kfa[4], kfb[4];
#pragma unroll
                for (int s = 0; s < 4; ++s) kfa[s] = row_frag(Ks, KLD, ATT_PROW(ws0), 32 * s, lane);
#pragma unroll
                for (int t = 0; t < 10; t += 2) {
#pragma unroll
                    for (int s = 0; s < 4; ++s) kfb[s] = row_frag(Ks, KLD, ATT_PROW(ws0 + 16 * (t + 1)), 32 * s, lane);
                    __builtin_amdgcn_sched_barrier(0);
                    sacc[t] = (f32x4){0.f, 0.f, 0.f, 0.f};
#pragma unroll
                    for (int s = 0; s < 4; ++s) sacc[t] = MFMA16(kfa[s], qf[s], sacc[t]);
                    if (t + 2 < 10) {
#pragma unroll
                        for (int s = 0; s < 4; ++s) kfa[s] = row_frag(Ks, KLD, ATT_PROW(ws0 + 16 * (t + 2)), 32 * s, lane); }
                    __builtin_amdgcn_sched_barrier(0);
                    sacc[t + 1] = (f32x4){0.f, 0.f, 0.f, 0.f};
#pragma unroll
                    for (int s = 0; s < 4; ++s) sacc[t + 1] = MFMA16(kfb[s], qf[s], sacc[t + 1]);
                }
            }
            const float slope = exp2f(-(float)(h + 1)) * (float)d;
            float mx = -INFINITY;
#pragma unroll
            for (int t = 0; t < 10; ++t)
#pragma unroll
                for (int i = 0; i < 4; ++i) { const int c = ws0 + 16 * t + 4 * g4 + i, step = 128 + qi - c;
                    const bool valid = (step >= 0) && (step <= 128) && (n > 0 || c >= 128);
                    const float v = valid ? sacc[t][i] - slope * (float)step : -INFINITY; sacc[t][i] = v; mx = fmaxf(mx, v); }
            mx = fmaxf(mx, shx(mx, 16, lane)); mx = fmaxf(mx, shx(mx, 32, lane));
            float lsum = 0.f;
#pragma unroll
            for (int t = 0; t < 10; ++t)
#pragma unroll
                for (int i = 0; i < 4; ++i) { const float pv = __expf(sacc[t][i] - mx); sacc[t][i] = pv; lsum += pv; }
            lsum += shx(lsum, 16, lane); lsum += shx(lsum, 32, lane);
            bf16x8 pf[5];
#pragma unroll
            for (int kt = 0; kt < 5; ++kt) pf[kt] = pack8(sacc[2 * kt], sacc[2 * kt + 1]);
            f32x4 o[8];
            {
                const LAS bf16* vl = Vs + (4 * g4 + qq) * KLD + 32 * pp;
                bf16x4 va[10], vcc[10];
#pragma unroll
                for (int q = 0; q < 10; ++q) va[q] = tr4(vl + ATT_PROW(ws0 + 16 * q) * KLD);
#pragma unroll
                for (int et = 0; et < 8; et += 2) {
#pragma unroll
                    for (int q = 0; q < 10; ++q) vcc[q] = tr4(vl + ATT_PROW(ws0 + 16 * q) * KLD + 4 * (et + 1));
                    __builtin_amdgcn_sched_barrier(0);
                    o[et] = (f32x4){0.f, 0.f, 0.f, 0.f};
#pragma unroll
                    for (int kt = 0; kt < 5; ++kt) o[et] = MFMA16(cat8(va[2 * kt], va[2 * kt + 1]), pf[kt], o[et]);
                    if (et + 2 < 8) {
#pragma unroll
                        for (int q = 0; q < 10; ++q) va[q] = tr4(vl + ATT_PROW(ws0 + 16 * q) * KLD + 4 * (et + 2)); }
                    __builtin_amdgcn_sched_barrier(0);
                    o[et + 1] = (f32x4){0.f, 0.f, 0.f, 0.f};
#pragma unroll
                    for (int kt = 0; kt < 5; ++kt) o[et + 1] = MFMA16(cat8(vcc[2 * kt], vcc[2 * kt + 1]), pf[kt], o[et + 1]);
                }
            }
#undef ATT_PROW
            const float inv = 1.0f / lsum;
            bf16* orow = og + ((size_t)g * T + qrow) * D + h * 128 + 32 * g4;
#pragma unroll
            for (int e2 = 0; e2 < 4; ++e2) *(u32x4*)(orow + 8 * e2) = pack_bf16x8(o[2 * e2] * inv, o[2 * e2 + 1] * inv);
            if (g4 == 0) lse[((size_t)g * T + qrow) * AH + h] = mx + __logf(lsum);
            __syncthreads();
        }
    }
#undef ATT_LOADBLK
#undef ATT_STOREBLK
}
__device__ __forceinline__ void phase_attn_combine(const Frame& F) {
    const bf16* og = (const bf16*)(F.ws + WS_AUX); const float* lse = (const float*)(F.ws + WS_AUX + AUX_LSE); bf16* ob = (bf16*)(F.ws + WS_AUX + AUX_OB);
    const int lane = F.lane, gw = F.vcu * NWAVES + F.wave, NGW = F.G * NWAVES, h = lane >> 3;
    for (int row = gw; row < T; row += NGW) {
        const float l0 = lse[((size_t)0 * T + row) * AH + h], l1 = lse[((size_t)1 * T + row) * AH + h], l2 = lse[((size_t)2 * T + row) * AH + h];
        const float m = fmaxf(l0, fmaxf(l1, l2)); float w0 = __expf(l0 - m), w1 = __expf(l1 - m), w2 = __expf(l2 - m); const float inv = 1.0f / (w0 + w1 + w2); w0 *= inv; w1 *= inv; w2 *= inv;
        float a[16];
#pragma unroll
        for (int j = 0; j < 16; ++j) a[j] = 0.f;
#pragma unroll
        for (int g = 0; g < 3; ++g) { const float wg = (g == 0) ? w0 : (g == 1 ? w1 : w2);
#pragma unroll
            for (int q = 0; q < 2; ++q) { const u32x4 s = *(const u32x4*)(og + ((size_t)g * T + row) * D + 16 * lane + 8 * q);
                a[8 * q + 0] += wg * bflo(s.x); a[8 * q + 1] += wg * bfhi(s.x); a[8 * q + 2] += wg * bflo(s.y); a[8 * q + 3] += wg * bfhi(s.y);
                a[8 * q + 4] += wg * bflo(s.z); a[8 * q + 5] += wg * bfhi(s.z); a[8 * q + 6] += wg * bflo(s.w); a[8 * q + 7] += wg * bfhi(s.w); } }
#pragma unroll
        for (int q = 0; q < 2; ++q) { u32x4 o; o.x = pk2(a[8 * q], a[8 * q + 1]); o.y = pk2(a[8 * q + 2], a[8 * q + 3]); o.z = pk2(a[8 * q + 4], a[8 * q + 5]); o.w = pk2(a[8 * q + 6], a[8 * q + 7]);
            *(u32x4*)(ob + (size_t)row * D + 16 * lane + 8 * q) = o; }
    }
}

constexpr size_t BIG_YRET = 192 * MiB;
__device__ __forceinline__ void phase_ret_u(const Frame& F) {
    const bf16* proj = (const bf16*)(F.ws + WS_BIG); bf16* St = (bf16*)(F.ws + WS_AUX);
    constexpr int LD = 264;
    LAS bf16* Kt = (LAS bf16*)F.lds; LAS bf16* Vt = Kt + 128 * LD;
    const int lane = F.lane, w = F.wave, g4 = lane >> 4, l15 = lane & 15, qq = l15 >> 2, pp = lane & 3;
    for (int u = F.vcu; u < 1024; u += F.G) {
        const int eh = u & 1, h = (u >> 1) & 3, n = (u >> 3) & 63, b = u >> 9;
        const size_t row0 = (size_t)b * SEQ + (size_t)n * RC;
#pragma unroll 4
        for (int it = 0; it < 8; ++it) { const int idx = F.tid + 512 * it, j = idx >> 5, ch = idx & 31;
            const bf16* src = proj + (row0 + j) * RET_IN;
            const u32x4 kv = *(const u32x4*)(src + 1024 + h * 256 + ch * 8), vv = *(const u32x4*)(src + 2048 + h * 512 + eh * 256 + ch * 8);
            *(LAS u32x4*)(Kt + j * LD + ch * 8) = kv; *(LAS u32x4*)(Vt + j * LD + ch * 8) = vv; }
        __syncthreads();
        f32x4 acc[16][2];
#pragma unroll
        for (int mt = 0; mt < 16; ++mt) { acc[mt][0] = (f32x4){0.f, 0.f, 0.f, 0.f}; acc[mt][1] = (f32x4){0.f, 0.f, 0.f, 0.f}; }
#pragma unroll
        for (int ks = 0; ks < 4; ++ks) {
            bf16x8 bfr[2];
#pragma unroll
            for (int nt = 0; nt < 2; ++nt) { const LAS bf16* a0 = Vt + (32 * ks + 8 * g4 + qq) * LD + 32 * w + 16 * nt + 4 * pp; bfr[nt] = cat8(tr4(a0), tr4(a0 + 4 * LD)); }
#pragma unroll
            for (int mt = 0; mt < 16; ++mt) { const LAS bf16* a0 = Kt + (32 * ks + 8 * g4 + qq) * LD + 128 * (mt >> 3) + 32 * pp + 4 * (mt & 7);
                const bf16x8 afr = cat8(tr4(a0), tr4(a0 + 4 * LD));
                acc[mt][0] = MFMA16(afr, bfr[0], acc[mt][0]); acc[mt][1] = MFMA16(afr, bfr[1], acc[mt][1]); }
        }
        bf16* outb = St + ((size_t)((b * RH + h) * RNC + n)) * (RDV * RDK);
#pragma unroll
        for (int nt = 0; nt < 2; ++nt) { bf16* orow = outb + (size_t)(eh * 256 + 32 * w + 16 * nt + l15) * RDK + 32 * g4;
#pragma unroll
            for (int mh = 0; mh < 2; ++mh)
#pragma unroll
                for (int q = 0; q < 4; ++q) *(u32x4*)(orow + 128 * mh + 8 * q) = pack_bf16x8(acc[mh * 8 + 2 * q][nt], acc[mh * 8 + 2 * q + 1][nt]); }
        __syncthreads();
    }
}
__device__ __forceinline__ void phase_ret_scan(const Frame& F) {
    bf16* St = (bf16*)(F.ws + WS_AUX);
    for (int gt = F.vcu * NTHREADS + F.tid; gt < 8 * 16384; gt += F.G * NTHREADS) {
        const int bh = gt >> 14, chunk = gt & 16383, h = bh & 3;
        const float g128 = exp2f(128.0f * log2f(1.0f - exp2f(-5.0f - (float)h)));
        bf16* base = St + (size_t)bh * RNC * (RDV * RDK) + (size_t)chunk * 8;
        float c[8];
#pragma unroll
        for (int j = 0; j < 8; ++j) c[j] = 0.f;
#pragma unroll 8
        for (int n = 0; n < RNC; ++n) { bf16* pn = base + (size_t)n * (RDV * RDK); const u32x4 uv = *(const u32x4*)pn;
            u32x4 o; o.x = pk2(c[0], c[1]); o.y = pk2(c[2], c[3]); o.z = pk2(c[4], c[5]); o.w = pk2(c[6], c[7]); *(u32x4*)pn = o;
            c[0] = g128 * (c[0] + bflo(uv.x)); c[1] = g128 * (c[1] + bfhi(uv.x)); c[2] = g128 * (c[2] + bflo(uv.y)); c[3] = g128 * (c[3] + bfhi(uv.y));
            c[4] = g128 * (c[4] + bflo(uv.z)); c[5] = g128 * (c[5] + bfhi(uv.z)); c[6] = g128 * (c[6] + bflo(uv.w)); c[7] = g128 * (c[7] + bfhi(uv.w)); }
    }
}
__device__ __forceinline__ void phase_ret_out(const Frame& F, KP p) {
    const bf16* proj = (const bf16*)(F.ws + WS_BIG); const bf16* St = (const bf16*)(F.ws + WS_AUX); bf16* yret = (bf16*)(F.ws + WS_BIG + BIG_YRET);
    const float* gng = gin(p, 4); const float* gnb = gin(p, 5);
    constexpr int LD = 264, VLD = 136;
    LAS bf16* Rs = (LAS bf16*)F.lds; LAS bf16* Vs = Rs + 128 * LD;
    const int lane = F.lane, w = F.wave, g4 = lane >> 4, l15 = lane & 15, qq = l15 >> 2, pp = lane & 3;
    for (int u = F.vcu; u < 512; u += F.G) {
        const int h = u & 3, n = (u >> 2) & 63, b = u >> 8;
        const size_t row0 = (size_t)b * SEQ + (size_t)n * RC;
#pragma unroll 4
        for (int it = 0; it < 8; ++it) { const int idx = F.tid + 512 * it, j = idx >> 5, ch = idx & 31;
            *(LAS u32x4*)(Rs + j * LD + ch * 8) = *(const u32x4*)(proj + (row0 + j) * RET_IN + 1024 + h * 256 + ch * 8); }
        const int irow = 16 * w + l15; const size_t qrow = row0 + irow;
        bf16x8 qf[8];
#pragma unroll
        for (int s = 0; s < 8; ++s) qf[s] = *(const bf16x8*)(proj + qrow * RET_IN + h * 256 + 32 * s + 8 * g4);
        __syncthreads();
        bf16x8 pf[4];
        { f32x4 sacc[8];
#pragma unroll
            for (int jt = 0; jt < 8; ++jt) { sacc[jt] = (f32x4){0.f, 0.f, 0.f, 0.f};
                if (jt <= w) {
#pragma unroll
                    for (int s = 0; s < 8; ++s) sacc[jt] = MFMA16(row_frag(Rs, LD, 16 * jt, 32 * s, lane), qf[s], sacc[jt]);
#pragma unroll
                    for (int i = 0; i < 4; ++i) if (16 * jt + 4 * g4 + i > irow) sacc[jt][i] = 0.f; } }
#pragma unroll
            for (int kt = 0; kt < 4; ++kt) pf[kt] = pack8(sacc[2 * kt], sacc[2 * kt + 1]); }
        __syncthreads();
        f32x4 acc[4][8];
        const bf16* Sn = St + ((size_t)((b * RH + h) * RNC + n)) * (RDV * RDK);
#pragma unroll
        for (int sl = 0; sl < 4; ++sl) {
#pragma unroll 4
            for (int it = 0; it < 4; ++it) { const int idx = F.tid + 512 * it, j = idx >> 4, ch = idx & 15;
                *(LAS u32x4*)(Vs + j * VLD + ch * 8) = *(const u32x4*)(proj + (row0 + j) * RET_IN + 2048 + h * 512 + sl * 128 + ch * 8); }
#pragma unroll 4
            for (int it = 0; it < 8; ++it) { const int idx = F.tid + 512 * it, e = idx >> 5, ch = idx & 31;
                *(LAS u32x4*)(Rs + e * LD + ch * 8) = *(const u32x4*)(Sn + (size_t)(sl * 128 + e) * RDK + ch * 8); }
            __syncthreads();
#pragma unroll
            for (int et = 0; et < 8; ++et) { f32x4 a = (f32x4){0.f, 0.f, 0.f, 0.f};
#pragma unroll
                for (int kt = 0; kt < 4; ++kt) if (2 * kt <= w) { const LAS bf16* a0 = Vs + (32 * kt + 4 * g4 + qq) * VLD + 32 * pp + 4 * et;
                    a = MFMA16(cat8(tr4(a0), tr4(a0 + 16 * VLD)), pf[kt], a); }
                const LAS bf16* srow = Rs + (32 * qq + 4 * et + pp) * LD + 8 * g4;
#pragma unroll
                for (int s = 0; s < 8; ++s) a = MFMA16(*(const LAS bf16x8*)(srow + 32 * s), qf[s], a);
                acc[sl][et] = a; }
            __syncthreads();
        }
        float s = 0.f;
#pragma unroll
        for (int sl = 0; sl < 4; ++sl)
#pragma unroll
            for (int et = 0; et < 8; ++et) s += (acc[sl][et][0] + acc[sl][et][1]) + (acc[sl][et][2] + acc[sl][et][3]);
        s += shx(s, 16, lane); s += shx(s, 32, lane);
        const float mean = s * (1.0f / RDV); float s2 = 0.f;
#pragma unroll
        for (int sl = 0; sl < 4; ++sl)
#pragma unroll
            for (int et = 0; et < 8; ++et) { acc[sl][et] = acc[sl][et] - mean; s2 += (acc[sl][et][0] * acc[sl][et][0] + acc[sl][et][1] * acc[sl][et][1]) + (acc[sl][et][2] * acc[sl][et][2] + acc[sl][et][3] * acc[sl][et][3]); }
        s2 += shx(s2, 16, lane); s2 += shx(s2, 32, lane);
        const float rstd = 1.0f / sqrtf(s2 * (1.0f / RDV) + LN_EPS);
#pragma unroll
        for (int sl = 0; sl < 4; ++sl) { const int c0 = h * RDV + sl * 128 + 32 * g4;
#pragma unroll
            for (int q = 0; q < 4; ++q) { const u32x4 gw = *(const u32x4*)(proj + qrow * RET_IN + 4096 + c0 + 8 * q);
                const f32x4 gg0 = *(const f32x4*)(gng + c0 + 8 * q), gg1 = *(const f32x4*)(gng + c0 + 8 * q + 4), gb0 = *(const f32x4*)(gnb + c0 + 8 * q), gb1 = *(const f32x4*)(gnb + c0 + 8 * q + 4);
                f32x4 y0 = acc[sl][2 * q] * rstd * gg0 + gb0, y1 = acc[sl][2 * q + 1] * rstd * gg1 + gb1;
                const float gv[8] = {bflo(gw.x), bfhi(gw.x), bflo(gw.y), bfhi(gw.y), bflo(gw.z), bfhi(gw.z), bflo(gw.w), bfhi(gw.w)};
#pragma unroll
                for (int j = 0; j < 4; ++j) { y0[j] *= gv[j] * fsig(gv[j]); y1[j] *= gv[4 + j] * fsig(gv[4 + j]); }
                *(u32x4*)(yret + qrow * RET_V + c0 + 8 * q) = pack_bf16x8(y0, y1); } }
    }
}

constexpr size_t AUX_S5E = 64 * MiB;
constexpr int S5L = 256, S5NC = SEQ / S5L;
__device__ __forceinline__ void cmul_add(float& rr, float& ri, float ar, float ai, float xr, float xi, float cr, float ci) { rr = ar * xr - ai * xi + cr; ri = ar * xi + ai * xr + ci; }
template <bool OUT>
__device__ __forceinline__ void phase_s5_scan(const Frame& F, KP p) {
    const bf16* X = (const bf16*)(F.ws + WS_XB); float* E = (float*)(F.ws + WS_AUX + AUX_S5E); bf16* ybuf = (bf16*)(F.ws + WS_AUX);
    const int lane = F.lane, w = F.wave, g4 = lane >> 4, l15 = lane & 15;
    LAS bf16* ut = (LAS bf16*)(F.lds + w * 12288);
    LAS bf16* Hb = (LAS bf16*)(F.lds + w * 12288 + 4096);
    constexpr int HLD = 136;
    const int gw = F.vcu * NWAVES + w, NGW = F.G * NWAVES;
    const int up16 = (lane - 16) << 2, up32 = (lane - 32) << 2, last16 = (48 + l15) << 2;
    for (int unit = gw; unit < BATCH * SG * S5NC; unit += NGW) {
        const int n = unit & (S5NC - 1), g = (unit >> 5) & 63, b = unit >> 11;
        float a1r[4], a1i[4], a4r[4], a4i[4], a8r[4], a8i[4], pwr[4], pwi[4];
        bf16x8 bfrag[8];
        const float dt = expf(gin(p, 14)[g]);
#pragma unroll
        for (int st = 0; st < 4; ++st) { const int ps = 16 * st + l15;
            const float are = gin(p, 7)[g * SP + ps], aim = gin(p, 8)[g * SP + ps];
            const float mag = expf(dt * are); const float abr = mag * cosf(dt * aim), abi = mag * sinf(dt * aim);
            const float den = are * are + aim * aim;
            const float fre = ((abr - 1.0f) * are + abi * aim) / den, fim = (abi * are - (abr - 1.0f) * aim) / den;
            a1r[st] = abr; a1i[st] = abi; { float t2r, t2i; cmul_add(t2r, t2i, abr, abi, abr, abi, 0.f, 0.f); cmul_add(a4r[st], a4i[st], t2r, t2i, t2r, t2i, 0.f, 0.f); }
            cmul_add(a8r[st], a8i[st], a4r[st], a4i[st], a4r[st], a4i[st], 0.f, 0.f);
            float qr = 1.f, qi = 0.f;
            if (g4 & 1) { qr = a4r[st]; qi = a4i[st]; }
            if (g4 & 2) { float tr, ti; cmul_add(tr, ti, qr, qi, a8r[st], a8i[st], 0.f, 0.f); qr = tr; qi = ti; }
            pwr[st] = qr; pwi[st] = qi;
            const float* br = gin(p, 9) + ((size_t)g * SP + ps) * SGC + 8 * (g4 & 1); const float* bi = gin(p, 10) + ((size_t)g * SP + ps) * SGC + 8 * (g4 & 1);
            const f32x4 r0 = *(const f32x4*)br, r1 = *(const f32x4*)(br + 4), i0 = *(const f32x4*)bi, i1 = *(const f32x4*)(bi + 4);
            const float z = (g4 < 2) ? 1.0f : 0.0f; const float fr2 = fre * z, fi2 = fim * z;
            bfrag[st] = pack8(r0 * fr2 - i0 * fi2, r1 * fr2 - i1 * fi2); bfrag[st + 4] = pack8(i0 * fr2 + r0 * fi2, i1 * fr2 + r1 * fi2);
        }
        float sr[4], si[4];
        float* Eu = E + ((size_t)(b * SG + g) * S5NC + n) * 128;
        bf16x8 cf[4]; f32x4 dsk = (f32x4){0.f, 0.f, 0.f, 0.f};
#pragma unroll
        for (int st = 0; st < 4; ++st) { sr[st] = 0.f; si[st] = 0.f; }
        if (OUT) {
#pragma unroll
            for (int st = 0; st < 4; ++st) { sr[st] = Eu[16 * st + l15]; si[st] = Eu[64 + 16 * st + l15]; }
#pragma unroll
            for (int s = 0; s < 4; ++s) { const float* cp = (s < 2 ? gin(p, 11) : gin(p, 12)) + ((size_t)g * SGC + l15) * SP + 32 * (s & 1) + 8 * g4; const float sg = s < 2 ? 1.0f : -1.0f;
                const f32x4 c0 = *(const f32x4*)cp * sg, c1 = *(const f32x4*)(cp + 4) * sg; cf[s] = pack8(c0, c1); }
            dsk = *(const f32x4*)(gin(p, 13) + g * SGC + 4 * g4); }
        const size_t tok0 = (size_t)b * SEQ + (size_t)n * S5L;
        u32x4 pre[2];
        { const bf16* src = X + (tok0 + lane) * D + g * SGC; pre[0] = *(const u32x4*)src; pre[1] = *(const u32x4*)(src + 8); }
        for (int sub = 0; sub < S5L / 64; ++sub) {
            *(LAS u32x4*)(ut + lane * 16) = pre[0]; *(LAS u32x4*)(ut + lane * 16 + 8) = pre[1];
            if (sub + 1 < S5L / 64) { const bf16* src = X + (tok0 + (sub + 1) * 64 + lane) * D + g * SGC; pre[0] = *(const u32x4*)src; pre[1] = *(const u32x4*)(src + 8); }
            LDS_WAIT(); asm volatile("" ::: "memory");
#pragma unroll (OUT ? 1 : 4)
            for (int blk = 0; blk < 4; ++blk) {
                u32x4 uw = *(const LAS u32x4*)(ut + (blk * 16 + l15) * 16 + 8 * (g4 & 1));
                if (g4 >= 2) uw = (u32x4){0u, 0u, 0u, 0u};
                const bf16x8 ufr = __builtin_bit_cast(bf16x8, uw);
                f32x4 dr[4], di[4];
#pragma unroll
                for (int st = 0; st < 4; ++st) { dr[st] = MFMA16(ufr, bfrag[st], ((f32x4){0.f, 0.f, 0.f, 0.f})); di[st] = MFMA16(ufr, bfrag[st + 4], ((f32x4){0.f, 0.f, 0.f, 0.f})); }
                float vr[4], vi[4];
#pragma unroll
                for (int st = 0; st < 4; ++st) {
                    float hr = 0.f, hi = 0.f;
#pragma unroll
                    for (int i = 0; i < 4; ++i) { float nr, ni; cmul_add(nr, ni, a1r[st], a1i[st], hr, hi, dr[st][i], di[st][i]); hr = nr; hi = ni; dr[st][i] = hr; di[st][i] = hi; }
                    vr[st] = hr; vi[st] = hi; }
#define BPF(idx, v) __builtin_bit_cast(float, __builtin_amdgcn_ds_bpermute((idx), __builtin_bit_cast(int, (v))))
                { float xr[4], xi[4];
#pragma unroll
                  for (int st = 0; st < 4; ++st) { xr[st] = BPF(up16, vr[st]); xi[st] = BPF(up16, vi[st]); }
#pragma unroll
                  for (int st = 0; st < 4; ++st) { float tr, ti; cmul_add(tr, ti, a4r[st], a4i[st], xr[st], xi[st], vr[st], vi[st]); if (g4 >= 1) { vr[st] = tr; vi[st] = ti; } }
#pragma unroll
                  for (int st = 0; st < 4; ++st) { xr[st] = BPF(up32, vr[st]); xi[st] = BPF(up32, vi[st]); }
#pragma unroll
                  for (int st = 0; st < 4; ++st) { float tr, ti; cmul_add(tr, ti, a8r[st], a8i[st], xr[st], xi[st], vr[st], vi[st]); if (g4 >= 2) { vr[st] = tr; vi[st] = ti; } } }
                float er[4], ei[4], lr[4], li[4];
#pragma unroll
                for (int st = 0; st < 4; ++st) { if (OUT) { er[st] = BPF(up16, vr[st]); ei[st] = BPF(up16, vi[st]); } else { er[st] = 0.f; ei[st] = 0.f; } lr[st] = BPF(last16, vr[st]); li[st] = BPF(last16, vi[st]); }
#undef BPF
#pragma unroll
                for (int st = 0; st < 4; ++st) {
                    if (g4 == 0) { er[st] = 0.f; ei[st] = 0.f; }
                    if (OUT) { float s0r, s0i; cmul_add(s0r, s0i, pwr[st], pwi[st], sr[st], si[st], er[st], ei[st]);
#pragma unroll
                        for (int i = 0; i < 4; ++i) { float tr, ti; cmul_add(tr, ti, a1r[st], a1i[st], s0r, s0i, 0.f, 0.f); s0r = tr; s0i = ti; dr[st][i] += s0r; di[st][i] += s0i; } }
                    { float a16r, a16i; cmul_add(a16r, a16i, a8r[st], a8i[st], a8r[st], a8i[st], 0.f, 0.f); float tr, ti; cmul_add(tr, ti, a16r, a16i, sr[st], si[st], lr[st], li[st]); sr[st] = tr; si[st] = ti; }
                    if (OUT) {
#pragma unroll
                        for (int i = 0; i < 4; ++i) { const unsigned hw = pk2(dr[st][i], di[st][i]); Hb[(4 * g4 + i) * HLD + 16 * st + l15] = (bf16)hw; Hb[(4 * g4 + i) * HLD + 64 + 16 * st + l15] = (bf16)(hw >> 16); } }
                }
                if (OUT) {
                    LDS_WAIT(); asm volatile("" ::: "memory");
                    f32x4 ya = (f32x4){0.f, 0.f, 0.f, 0.f};
#pragma unroll
                    for (int s = 0; s < 4; ++s) ya = MFMA16(cf[s], row_frag(Hb, HLD, 0, 32 * s, lane), ya);
                    const u32x2 u2 = *(const LAS u32x2*)(ut + (blk * 16 + l15) * 16 + 4 * g4);
                    const f32x4 u4 = (f32x4){bflo(u2.x), bfhi(u2.x), bflo(u2.y), bfhi(u2.y)};
                    f32x4 y = ya + dsk * u4;
#pragma unroll
                    for (int j = 0; j < 4; ++j) { const float v = y[j]; y[j] = v * fsig(1.5957691216057308f * (v + 0.044715f * v * v * v)); }
                    u32x2 o; o.x = pk2(y[0], y[1]); o.y = pk2(y[2], y[3]);
                    *(u32x2*)(ybuf + (tok0 + sub * 64 + blk * 16 + l15) * D + g * SGC + 4 * g4) = o;
                    asm volatile("" ::: "memory"); }
            }
            LDS_WAIT(); asm volatile("" ::: "memory");
        }
        if (!OUT && g4 == 0) {
#pragma unroll
            for (int st = 0; st < 4; ++st) { Eu[16 * st + l15] = sr[st]; Eu[64 + 16 * st + l15] = si[st]; } }
    }
}
__device__ __forceinline__ void phase_s5_carry(const Frame& F, KP p) {
    float* E = (float*)(F.ws + WS_AUX + AUX_S5E);
    for (int gt = F.vcu * NTHREADS + F.tid; gt < BATCH * SG * SP; gt += F.G * NTHREADS) {
        const int pl = gt & 63, bg = gt >> 6, g = bg & 63;
        const float dt = expf(gin(p, 14)[g]); const float are = gin(p, 7)[g * SP + pl], aim = gin(p, 8)[g * SP + pl];
        const float mag = expf(dt * are); float ar = mag * cosf(dt * aim), ai = mag * sinf(dt * aim);
#pragma unroll
        for (int q = 0; q < 8; ++q) { const float nr = ar * ar - ai * ai, ni = 2.0f * ar * ai; ar = nr; ai = ni; }
        float cr = 0.f, ci = 0.f;
        for (int n = 0; n < S5NC; ++n) { float* Eu = E + ((size_t)bg * S5NC + n) * 128; const float er = Eu[pl], ei = Eu[64 + pl];
            Eu[pl] = cr; Eu[64 + pl] = ci;
            const float nr = ar * cr - ai * ci + er, ni = ar * ci + ai * cr + ei; cr = nr; ci = ni; }
    }
}

constexpr int NPHASES = 34;
#ifndef PROBE_DRY14
#define PROBE_DRY14 0
#endif
#ifndef PROBE_DRY17
#define PROBE_DRY17 0
#endif
#ifndef PH_MASK
#define PH_MASK 0xFFFFFFFFu
#endif
#define PHT(t) ((PH_MASK >> (t)) & 1u)
constexpr int PLAN_OFF = 64;
__device__ __forceinline__ void moe_plan(const Frame& F, int layer) {
    volatile LAS int* tstart = (volatile LAS int*)(F.MISC + PLAN_OFF); volatile LAS int* cnts = tstart + 72;
    __syncthreads();
    if (F.wave == 0) {
        const unsigned* cnt = (const unsigned*)(F.ws + WS_CTL) + CW_CNT + layer * NE * 64;
        const int c = (int)__hip_atomic_load(cnt + F.lane * 64, __ATOMIC_RELAXED, __HIP_MEMORY_SCOPE_AGENT);
        int v = (c + 255) >> 8;
#pragma unroll
        for (int o = 1; o < 64; o <<= 1) { const int nb = __builtin_amdgcn_ds_bpermute((F.lane - o) << 2, v); if (F.lane >= o) v += nb; }
        tstart[F.lane + 1] = v; cnts[F.lane] = c;
        if (F.lane == 0) tstart[0] = 0;
        if (F.lane == 63) { tstart[65] = v + T / 256; cnts[64] = T; }
    }
    __syncthreads();
}
template <bool GATH> struct MoeSched2 {
    static constexpr bool GATHER = GATH, UNIFORMIZE = true, FP8 = GATH;
    static constexpr int ncol = GATH ? 2 : 4, K = GATH ? D / 2 : ED;
    const volatile LAS int* tstart; const volatile LAS int* cnts; int ntiles, G, c, lane;
    const char* Abase; const char* Wbase; const int* lists;
    __device__ __forceinline__ bool next(int i, pg8::UnitG& u) const {
        const int nwg = ntiles * ncol; const long L = (long)i * G + c; if (L >= nwg) return false;
        int wgid = (int)L; { const int q = nwg / 8, r = nwg % 8, xcd = wgid % 8, off = wgid / 8; wgid = (xcd < r ? xcd * (q + 1) : r * (q + 1) + (xcd - r) * q) + off; }
        const int tile = wgid / ncol, pn = wgid % ncol;
        const int ta = tstart[lane], tb = tstart[lane + 1];
        const unsigned long long mm = __ballot(ta <= tile && tile < tb);
        const int e = mm ? (int)__builtin_ctzll(mm) : 64;
        const int ts = __builtin_amdgcn_readfirstlane((int)tstart[e]), ce = __builtin_amdgcn_readfirstlane((int)cnts[e]);
        const int lt = tile - ts; int valid = ce - lt * 256; valid = valid > 256 ? 256 : valid;
        u.gshift = 0; u.aux = e;
        if (GATH) {
            u.B = Wbase + (size_t)e * WMOE_E_BYTES + (size_t)pn * 256 * K * 2;
            if (e < 64) { u.A = Abase; u.gidx = lists + (size_t)e * T + lt * 256; u.gcnt = valid; }
            else { u.A = Abase + (size_t)lt * 256 * K * 2; u.gidx = nullptr; u.gcnt = 0; }
            u.row0 = tile * 256; u.col0 = pn * 128;
        } else {
            u.B = Wbase + (size_t)e * WMOE_E_BYTES + (size_t)512 * 1024 * 2 + (size_t)pn * 256 * K * 2;
            u.A = Abase + (size_t)tile * 256 * K * 2; u.gidx = nullptr; u.gcnt = valid;
            u.row0 = tile * 256; u.col0 = pn * 256;
        }
        return true;
    }
};
__device__ __forceinline__ void phase_load_x(const Frame& F, KP p) {
    const float* xin = gin(p, 0); bf16* XB = (bf16*)(F.ws + WS_XB);
    for (size_t i = (size_t)F.vcu * NTHREADS + F.tid; i < (size_t)T * D / 8; i += (size_t)F.G * NTHREADS) {
        const f32x4 a = *(const f32x4*)(xin + i * 8), b = *(const f32x4*)(xin + i * 8 + 4);
        *(u32x4*)(XB + i * 8) = pack_bf16x8(a, b);
        u32x2 q8; q8.x = pk4_fp8(a[0], a[1], a[2], a[3]); q8.y = pk4_fp8(b[0], b[1], b[2], b[3]); *(u32x2*)((unsigned char*)(F.ws + WS_X) + i * 8) = q8; }
}

__global__ void __launch_bounds__(NTHREADS, 2) fwd_kernel(Params p_unused) {
    KP p0 = (KP)__builtin_amdgcn_kernarg_segment_ptr();
    extern __shared__ __attribute__((aligned(16))) unsigned char lds_raw[];
    Frame F0;
    F0.lds = (LAS unsigned char*)lds_raw; F0.MISC = (volatile LAS unsigned*)(F0.lds + MISC_OFF);
    F0.tid = threadIdx.x; F0.lane = F0.tid & 63; F0.wave = __builtin_amdgcn_readfirstlane(F0.tid >> 6);
    F0.G = gridDim.x; { const int bq = blockIdx.x; F0.vcu = (F0.G % 8 == 0) ? (bq % 8) * (F0.G / 8) + bq / 8 : bq; }
    F0.ws = p0->ws;
    const int bx0 = blockIdx.x;
    for (int u = F0.tid; u < (LDS_BYTES - MISC_OFF) / 4; u += NTHREADS) ((LAS unsigned*)(F0.lds + MISC_OFF))[u] = 0u;
    __syncthreads();
    XcdBarrier bar; bar.bar = (unsigned*)(p0->ws + WS_CTL) + CW_BAR; bar.x = 0; bar.st = nullptr;
    const int use_bar = p0->use_bar;
    if (use_bar) bar = xcd_barrier_post((unsigned*)(p0->ws + WS_CTL) + CW_BAR, F0.MISC + 8);
    const int lo = p0->ph_lo, hi = p0->ph_hi;
#define PHASE_BEGIN Frame F = F0; KP p = p0; { unsigned ones_ = ~0u; asm volatile("" : "+s"(ones_)); F.lane = (int)__builtin_amdgcn_mbcnt_hi(ones_, __builtin_amdgcn_mbcnt_lo(ones_, 0u)); } asm volatile("" : "+v"(F.lane)); F.tid = F.wave * 64 + F.lane; asm volatile("" : "+v"(F.tid));   GAS unsigned char* wsg_ = (GAS unsigned char*)F0.ws; asm volatile("" : "+s"(F.wave), "+s"(F.vcu), "+s"(F.G), "+s"(wsg_), "+s"(p)); \
    F.ws = (unsigned char*)wsg_; int bx = bx0; asm volatile("" : "+s"(bx)); unsigned char* ws = F.ws; (void)ws; (void)bx;
#pragma unroll 1
    for (int ph = lo; ph < hi; ++ph) {
        int layer = 0, type = 0;
        if (ph > 0) { layer = ph >= 26 ? 3 : (ph >= 18 ? 2 : (ph >= 9 ? 1 : 0)); const int q = ph - (layer == 3 ? 26 : (layer == 2 ? 18 : (layer == 1 ? 9 : 1))); const int kind = layer % 3;
            if (kind == 0) type = q < 4 ? 1 + q : 14 + (q - 4); else if (kind == 1) type = q < 5 ? 5 + q : 14 + (q - 5); else type = q < 4 ? 10 + q : 14 + (q - 4); }
        const int j = layer / 3;
#ifdef REPEAT_MASK
        const int nrep = ((REPEAT_MASK >> type) & 1u) ? 2 : 1;
#else
        const int nrep = 1;
#endif
#pragma unroll 1
        for (int rep = 0; rep < nrep; ++rep) {
        if (rep > 0 && use_bar) xcd_barrier(bar);
        if (PHT(0) && type == 0) { PHASE_BEGIN; phase_conv_mixers(F, p); phase_conv_moe(F, p, 0); phase_load_x(F, p); }
        else if (PHT(1) && type == 1) { PHASE_BEGIN; DenseSched8 S; S.init(ws + WS_X, ws + WS_ATT_IN_T + (size_t)j * ATT_IN * D, T, ATT_IN, D / 2, F.G, bx); EpiStoreBf16 E{(bf16*)(ws + WS_BIG), ATT_IN, WUP_INV, 0.08838834764831845f};
            pg8::gemm_phase(F.lds, F.tid, D / 2, S, E); }
        else if (PHT(2) && type == 2) { PHASE_BEGIN; phase_attn(F, bx); }
        else if (PHT(3) && type == 3) { PHASE_BEGIN; phase_attn_combine(F); }
        else if (PHT(4) && type == 4) { PHASE_BEGIN; DenseSched S; S.init(ws + WS_AUX + AUX_OB, ws + WS_ATT_OUT_T + (size_t)j * D * D * 2, T, D, D, F.G, bx); EpiResid E{(const bf16*)(ws + WS_XB), (bf16*)(ws + WS_Y)};
            pg8::gemm_phase(F.lds, F.tid, D, S, E); }
        else if (PHT(5) && type == 5) { PHASE_BEGIN; DenseSched8 S; S.init(ws + WS_X, ws + WS_RET_IN_T, T, RET_IN, D / 2, F.G, bx); EpiRetIn E{(bf16*)(ws + WS_BIG), RET_IN};
            pg8::gemm_phase(F.lds, F.tid, D / 2, S, E); }
        else if (PHT(6) && type == 6) { PHASE_BEGIN; phase_ret_u(F); }
        else if (PHT(7) && type == 7) { PHASE_BEGIN; phase_ret_scan(F); }
        else if (PHT(8) && type == 8) { PHASE_BEGIN; phase_ret_out(F, p); }
        else if (PHT(9) && type == 9) { PHASE_BEGIN; DenseSched S; S.init(ws + WS_BIG + BIG_YRET, ws + WS_RET_OUT_T, T, D, RET_V, F.G, bx); EpiResid E{(const bf16*)(ws + WS_XB), (bf16*)(ws + WS_Y)};
            pg8::gemm_phase(F.lds, F.tid, RET_V, S, E); }
        else if (PHT(10) && type == 10) { PHASE_BEGIN; phase_s5_scan<false>(F, p); }
        else if (PHT(11) && type == 11) { PHASE_BEGIN; phase_s5_carry(F, p); }
        else if (PHT(12) && type == 12) { PHASE_BEGIN; phase_s5_scan<true>(F, p); }
        else if (PHT(13) && type == 13) { PHASE_BEGIN; DenseSched S; S.init(ws + WS_AUX, ws + WS_GLU_T, T, 2 * D, D, F.G, bx); EpiGluResid E{(const bf16*)(ws + WS_XB), (bf16*)(ws + WS_Y)};
            pg8::gemm_phase(F.lds, F.tid, D, S, E); }
        else if (PHT(14) && type == 14) { PHASE_BEGIN; phase_lnr(F, p, layer, PROBE_DRY14 && true); if (PROBE_DRY14) { if (use_bar) xcd_barrier(bar); phase_lnr(F, p, layer, false); } }
        else if (PHT(15) && type == 15) { PHASE_BEGIN; moe_plan(F, layer);
            MoeSched2<true> S; S.tstart = (const volatile LAS int*)(F.MISC + PLAN_OFF); S.cnts = S.tstart + 72; S.ntiles = __builtin_amdgcn_readfirstlane((int)S.tstart[65]); S.G = F.G; S.c = bx; S.lane = F.lane;
            S.Abase = (const char*)(ws + WS_X); S.Wbase = (const char*)(ws + WS_WMOE); S.lists = (const int*)(ws + WS_LIST);
            EpiMoeUp E{(bf16*)(ws + WS_H)};
            pg8::gemm_phase(F.lds, F.tid, D / 2, S, E); }
        else if (PHT(16) && type == 16) { PHASE_BEGIN; moe_plan(F, layer);
            { MoeSched2<false> S; S.tstart = (const volatile LAS int*)(F.MISC + PLAN_OFF); S.cnts = S.tstart + 72; S.ntiles = __builtin_amdgcn_readfirstlane((int)S.tstart[64]); S.G = F.G; S.c = bx; S.lane = F.lane;
              S.Abase = (const char*)(ws + WS_H); S.Wbase = (const char*)(ws + WS_WMOE); S.lists = (const int*)(ws + WS_LIST);
              EpiStoreFp8 E{(unsigned char*)(ws + WS_BIG), D};
              pg8::gemm_phase(F.lds, F.tid, ED, S, E); }
            { const int sh0 = __builtin_amdgcn_readfirstlane((int)((const volatile LAS int*)(F.MISC + PLAN_OFF))[64]);
              DenseSched S; S.init(ws + WS_H + (size_t)sh0 * 256 * ED * 2, ws + WS_WMOE + (size_t)64 * WMOE_E_BYTES + (size_t)512 * 1024 * 2, T, D, ED, F.G, bx); EpiResid E{(const bf16*)(ws + WS_XB), (bf16*)(ws + WS_Y)};
              pg8::gemm_phase(F.lds, F.tid, ED, S, E); } }
        else if (PHT(17) && type == 17) { PHASE_BEGIN; moe_plan(F, layer); if (PROBE_DRY17) { phase_combine(F, p, layer, true); if (use_bar) xcd_barrier(bar); } phase_combine(F, p, layer); if (layer + 1 < DEPTH) phase_conv_moe(F, p, layer + 1); }
        }
        if (use_bar && ph + 1 < hi) xcd_barrier(bar);
    }
}

#ifndef MK_PER_PHASE
#define MK_PER_PHASE 0
#endif
extern "C" void kernel_launch(void* const* d_in, const int* in_sizes, int n_in, void* d_out, int out_size, void* d_ws, size_t ws_size, hipStream_t stream) {
    static int grid = 0;
    if (grid == 0) {
        if (n_in != 26 || in_sizes[0] != T * D || out_size != T * D || ws_size < WS_END) { fprintf(stderr, "kernel_launch: unexpected shapes / workspace (n_in %d, in0 %d, out %d, ws %zu < %zu)\n", n_in, n_in > 0 ? in_sizes[0] : -1, out_size, ws_size, (size_t)WS_END); grid = -1; return; }
        int dev = 0, cus = 0, per_cu = 0;
        if (hipGetDevice(&dev) != hipSuccess || hipDeviceGetAttribute(&cus, hipDeviceAttributeMultiprocessorCount, dev) != hipSuccess) { grid = -1; return; }
        if (hipFuncSetAttribute((const void*)fwd_kernel, hipFuncAttributeMaxDynamicSharedMemorySize, LDS_BYTES) != hipSuccess) { fprintf(stderr, "kernel_launch: hipFuncSetAttribute failed\n"); grid = -1; return; }
        if (hipOccupancyMaxActiveBlocksPerMultiprocessor(&per_cu, (const void*)fwd_kernel, NTHREADS, LDS_BYTES) != hipSuccess || per_cu < 1) { fprintf(stderr, "kernel_launch: occupancy query says %d blocks per CU\n", per_cu); per_cu = 1; }
        (void)hipGetLastError();
        grid = cus;
    }
    if (grid < 0) return;
    (void)hipMemsetAsync((char*)d_ws + WS_CTL, 0, CTL_ZERO_BYTES, stream);
    Params p{};
    for (int i = 0; i < 26; ++i) p.in[i] = (const float*)d_in[i];
    p.out = (float*)d_out; p.ws = (unsigned char*)d_ws;
#if MK_PER_PHASE
    for (int k = 0; k < NPHASES; ++k) { p.ph_lo = k; p.ph_hi = k + 1; p.use_bar = 0; hipLaunchKernelGGL(fwd_kernel, dim3(grid), dim3(NTHREADS), LDS_BYTES, stream, p); }
#else
    p.ph_lo = 0; p.ph_hi = NPHASES; p.use_bar = 1;
    hipLaunchKernelGGL(fwd_kernel, dim3(grid), dim3(NTHREADS), LDS_BYTES, stream, p);
#endif
}
```

```cpp
#include <hip/hip_runtime.h>
#include <cstdio>
#include <cstdint>

#define LAS __attribute__((address_space(3)))
#define GAS __attribute__((address_space(1)))
typedef unsigned short bf16;
typedef short bf16x8 __attribute__((ext_vector_type(8)));
typedef short bf16x4 __attribute__((ext_vector_type(4)));
typedef float f32x4 __attribute__((ext_vector_type(4)));
typedef float f32x2 __attribute__((ext_vector_type(2)));
typedef unsigned u32x4 __attribute__((ext_vector_type(4)));
typedef unsigned u32x2 __attribute__((ext_vector_type(2)));
typedef GAS unsigned gu32;

constexpr int D = 1024, BATCH = 2, SEQ = 8192, T = BATCH * SEQ, DEPTH = 4;
constexpr int AH = 8, AHD = 128, ATT_IN = 9216;
constexpr int RH = 4, RDK = 256, RDV = 512, RET_IN = 6144, RET_V = 2048, RC = 128, RNC = SEQ / RC;
constexpr int SG = 64, SGC = 16, SP = 64;
constexpr int NE = 64, TOPK = 8, NEG = 8, ED = 256, NSLOT = 9;
constexpr float LN_EPS = 1e-5f;
constexpr float ALPHA = 1.6817928305074292f;
constexpr int NWAVES = 8, NTHREADS = 512;

__device__ __forceinline__ unsigned f2bf(float f) { unsigned u = __builtin_bit_cast(unsigned, f); return (u + 0x7fffu + ((u >> 16) & 1u)) >> 16; }
__device__ __forceinline__ unsigned pk2(float lo, float hi) { unsigned r; asm("s_nop 1\n\tv_cvt_pk_bf16_f32 %0, %1, %2" : "=v"(r) : "v"(lo), "v"(hi)); return r; }
__device__ __forceinline__ unsigned pk2sw(float lo, float hi) { return f2bf(lo) | (f2bf(hi) << 16); }
__device__ __forceinline__ unsigned pk2hw(float lo, float hi) { unsigned r; asm volatile("v_cvt_pk_bf16_f32 %0, %1, %2" : "=v"(r) : "v"(lo), "v"(hi)); return r; }
__device__ __forceinline__ float bf2f(unsigned b) { return __builtin_bit_cast(float, b << 16); }
__device__ __forceinline__ float bflo(unsigned w) { return __builtin_bit_cast(float, w << 16); }
__device__ __forceinline__ float bfhi(unsigned w) { return __builtin_bit_cast(float, w & 0xffff0000u); }
__device__ __forceinline__ float shx(float v, int m, int lane) { return __builtin_bit_cast(float, __builtin_amdgcn_ds_bpermute((lane ^ m) << 2, __builtin_bit_cast(int, v))); }
__device__ __forceinline__ int shx_i(int v, int m, int lane) { return __builtin_amdgcn_ds_bpermute((lane ^ m) << 2, v); }
__device__ __forceinline__ float rdl(float v, int src) { return __builtin_bit_cast(float, __builtin_amdgcn_readlane(__builtin_bit_cast(int, v), src)); }
template <int CTRL, int RM = 0xf, int BM = 0xf> __device__ __forceinline__ float dpp0(float v) { return __builtin_bit_cast(float, __builtin_amdgcn_update_dpp(0, __builtin_bit_cast(int, v), CTRL, RM, BM, true)); }
template <int CTRL, int RM = 0xf, int BM = 0xf> __device__ __forceinline__ float dppo(float old, float v) { return __builtin_bit_cast(float, __builtin_amdgcn_update_dpp(__builtin_bit_cast(int, old), __builtin_bit_cast(int, v), CTRL, RM, BM, false)); }
__device__ __forceinline__ float wave_sum(float v, int lane) {
    (void)lane;
    v += dpp0<0x111>(v); v += dpp0<0x112>(v); v += dpp0<0x114>(v); v += dpp0<0x118>(v);
    v += dpp0<0x142, 0xa>(v);
    v += dpp0<0x143, 0xc>(v);
    return rdl(v, 63);
}
__device__ __forceinline__ float max8(float v) {
    v = fmaxf(v, dppo<0xb1>(v, v)); v = fmaxf(v, dppo<0x4e>(v, v)); v = fmaxf(v, dppo<0x141>(v, v)); return v;
}
__device__ __forceinline__ float fsig(float x) { return __builtin_amdgcn_rcpf(1.0f + __expf(-x)); }
#define LDS_WAIT() asm volatile("s_waitcnt lgkmcnt(0)" ::: "memory")
#define VM_WAIT() asm volatile("s_waitcnt vmcnt(0)" ::: "memory")
__device__ __forceinline__ const char* rfl_ptr(const char* p) {
    unsigned long long v = (unsigned long long)p; unsigned lo = __builtin_amdgcn_readfirstlane((unsigned)v), hi = __builtin_amdgcn_readfirstlane((unsigned)(v >> 32));
    return (const char*)(((unsigned long long)hi << 32) | lo);
}
__device__ __forceinline__ bf16x8 row_frag(const LAS bf16* base, int ld, int row0, int col0, int lane) {
    return *(const LAS bf16x8*)(base + (row0 + (lane & 15)) * ld + col0 + 8 * (lane >> 4));
}
__device__ __forceinline__ bf16x4 tr4(const LAS bf16* addr) { return __builtin_amdgcn_ds_read_tr16_b64_v4i16((LAS bf16x4*)addr); }
__device__ __forceinline__ bf16x8 cat8(bf16x4 a, bf16x4 b) { bf16x8 r; r[0] = a[0]; r[1] = a[1]; r[2] = a[2]; r[3] = a[3]; r[4] = b[0]; r[5] = b[1]; r[6] = b[2]; r[7] = b[3]; return r; }
#define MFMA16(a, b, c) __builtin_amdgcn_mfma_f32_16x16x32_bf16((a), (b), (c), 0, 0, 0)
__device__ __forceinline__ bf16x8 pack8(f32x4 a, f32x4 b) {
    u32x4 w; w.x = pk2(a[0], a[1]); w.y = pk2(a[2], a[3]); w.z = pk2(b[0], b[1]); w.w = pk2(b[2], b[3]); return __builtin_bit_cast(bf16x8, w);
}

namespace pg8 {
typedef int v4i_t __attribute__((ext_vector_type(4)));
typedef int v8i_t __attribute__((ext_vector_type(8)));
constexpr int BM = 256, BK = 64, HALF = 128, HTB = HALF * BK * 2, STAGE_BYTES = 8 * HTB;
__device__ __forceinline__ int lds_byte(int r, int c) { const int st = (r >> 4) * 2 + (c >> 5), rr = r & 15, cc = c & 31, ob = rr * 64 + cc * 2; return st * 1024 + (ob ^ (((ob >> 9) & 1) << 5)); }
__device__ __forceinline__ void stage_rc(int b, int& R, int& C) { const int st = b / 1024, sb = b % 1024, swz = sb ^ (((sb >> 9) & 1) << 5); R = (st >> 1) * 16 + swz / 64; C = (st & 1) * 32 + (swz % 64) / 2; }
__device__ __forceinline__ int perm32(int rho) { const int n = rho >> 4, i = rho & 15; return 8 * (i >> 2) + 4 * n + (i & 3); }

struct UnitG {
    const char* A;
    const char* B;
    const int* gidx;
    int gcnt, gshift;
    int row0, col0;
    int aux;
};

__device__ __forceinline__ void uniformize(UnitG& u) { u.A = rfl_ptr(u.A); u.B = rfl_ptr(u.B); u.gidx = (const int*)rfl_ptr((const char*)u.gidx); u.gcnt = __builtin_amdgcn_readfirstlane(u.gcnt); u.gshift = __builtin_amdgcn_readfirstlane(u.gshift);
    u.row0 = __builtin_amdgcn_readfirstlane(u.row0); u.col0 = __builtin_amdgcn_readfirstlane(u.col0); u.aux = __builtin_amdgcn_readfirstlane(u.aux); }
template <class Epi, class Sched>
__device__ __forceinline__ void gemm_phase(LAS unsigned char* lds, const int tid, const int K, const Sched& S, const Epi& E) {
    constexpr bool F8 = Sched::FP8;
    constexpr bool GATHER = Sched::GATHER;
    const int wid = __builtin_amdgcn_readfirstlane(tid >> 6), lane = tid & 63, wr = wid >> 2, wc = wid & 3, fr = lane & 15, fq = lane >> 4;
    int nt = K / BK; asm volatile("" : "+s"(nt));
    constexpr bool P16 = Epi::PERM16;
    unsigned voffB[2], voffB1[2], vA[2][2];
#pragma unroll
    for (int i = 0; i < 2; ++i) { int R, C; stage_rc(tid * 16 + i * 8192, R, C); const int Rb = Epi::PERM ? ((R & ~31) + perm32(R & 31)) : R; voffB[i] = (unsigned)(Rb * K + C) * 2u; voffB1[i] = voffB[i]; vA[0][i] = (unsigned)(R * K + C) * 2u; vA[1][i] = vA[0][i];
        if constexpr (P16) { const int x = R & 31, src = 64 * (R >> 5) + 16 * ((x >> 2) & 3) + 4 * (x >> 4) + (x & 3); voffB[i] = (unsigned)(src * K + C) * 2u; voffB1[i] = (unsigned)((src + 8) * K + C) * 2u; } }
    const size_t kstep = (size_t)(BK * 2);
    const size_t hstep = (size_t)HALF * K * 2;
    const size_t hstepB = P16 ? 0 : hstep;
    const size_t hstepA = GATHER ? 0 : hstep;
    const unsigned ldsw = (unsigned)wid * 1024u;
    const int aoff = F8 ? lds_byte(wr * 64 + fr, fq * 16) : lds_byte(wr * 64 + fr, fq * 8), boff = F8 ? lds_byte(wc * 32 + fr, fq * 16) : lds_byte(wc * 32 + fr, fq * 8);
    LAS u32x4* park = (LAS u32x4*)(lds + STAGE_BYTES) + tid;
#define PG8_SA(b, h) (((b) * 2 + (h)) * HTB)
#define PG8_SB(b, h) ((4 + (b) * 2 + (h)) * HTB)
#define PG8_STAGE(bufoff, gbase, voff) do { _Pragma("unroll") for (int _i = 0; _i < 2; ++_i) { asm volatile("" : "+v"((voff)[_i]));   \
        __builtin_amdgcn_global_load_lds((const unsigned*)((const char*)(gbase) + (voff)[_i]), (LAS unsigned*)(lds + (bufoff) + ldsw + _i * 8192), 16, 0, 0); } } while (0)
    constexpr int FKS = F8 ? 16 : 1024;
#define PG8_LD2(p_) __builtin_shufflevector(*(const LAS v4i_t*)(p_), *(const LAS v4i_t*)((p_) + FKS), 0, 1, 2, 3, 4, 5, 6, 7)
#define PG8_LDA(dst, b, h) do { _Pragma("unroll") for (int m = 0; m < 4; ++m) dst[m] = PG8_LD2(lds + PG8_SA(b, h) + aoff + m * 2048); } while (0)
#define PG8_LDB(dst, b, h) do { _Pragma("unroll") for (int n = 0; n < 2; ++n) dst[n] = PG8_LD2(lds + PG8_SB(b, h) + boff + n * 2048); } while (0)
#define PG8_LO(v) __builtin_bit_cast(bf16x8, __builtin_shufflevector((v), (v), 0, 1, 2, 3))
#define PG8_HI(v) __builtin_bit_cast(bf16x8, __builtin_shufflevector((v), (v), 4, 5, 6, 7))
#define PG8_MMA(ai, bj, At, Bt) do { __builtin_amdgcn_s_setprio(1); _Pragma("unroll") for (int m = 0; m < 4; ++m) _Pragma("unroll") for (int n = 0; n < 2; ++n) { \
        if constexpr (F8) { acc[ai][bj][m][n] = __builtin_amdgcn_mfma_scale_f32_16x16x128_f8f6f4(Bt[n], At[m], acc[ai][bj][m][n], 0, 0, 0, 0x7F7F7F7F, 0, 0x7F7F7F7F); } \
        else { acc[ai][bj][m][n] = __builtin_amdgcn_mfma_f32_16x16x32_bf16(PG8_LO(Bt[n]), PG8_LO(At[m]), acc[ai][bj][m][n], 0, 0, 0); \
               acc[ai][bj][m][n] = __builtin_amdgcn_mfma_f32_16x16x32_bf16(PG8_HI(Bt[n]), PG8_HI(At[m]), acc[ai][bj][m][n], 0, 0, 0); } } __builtin_amdgcn_s_setprio(0); } while (0)
#define PG8_WAIT_V(n) asm volatile("s_waitcnt vmcnt(" #n ")" ::: "memory")
#define PG8_WAIT_L(n) asm volatile("s_waitcnt lgkmcnt(" #n ")" ::: "memory")
#define PG8_BAR __builtin_amdgcn_s_barrier()
#define PG8_SCHED __builtin_amdgcn_sched_barrier(0)
#define PG8_VOFF(u, v00, v01, v10, v11) do { int _R0, _C0, _R1, _C1; stage_rc(tid * 16, _R0, _C0); stage_rc(tid * 16 + 8192, _R1, _C1); int _r00 = _R0, _r01 = _R1, _r10 = HALF + _R0, _r11 = HALF + _R1; \
        if ((u).gidx) { const GAS int* _gp = (const GAS int*)(u).gidx; const int _gc = (u).gcnt;     \
            const int _a = _gp[_r00 < _gc ? _r00 : 0] >> (u).gshift, _b = _gp[_r01 < _gc ? _r01 : 0] >> (u).gshift, _c = _gp[_r10 < _gc ? _r10 : 0] >> (u).gshift, _d = _gp[_r11 < _gc ? _r11 : 0] >> (u).gshift; \
            _r00 = _a; _r01 = _b; _r10 = _c; _r11 = _d; } \
        v00 = (unsigned)(_r00 * K + _C0) * 2u; v01 = (unsigned)(_r01 * K + _C1) * 2u; v10 = (unsigned)(_r10 * K + _C0) * 2u; v11 = (unsigned)(_r11 * K + _C1) * 2u; } while (0)
    UnitG cur, nxt; int ui = 0;
    if (!S.next(0, cur)) return;
    if constexpr (Sched::UNIFORMIZE) uniformize(cur);
    f32x4 acc[2][2][4][2];
#pragma unroll
    for (int a = 0; a < 2; ++a)
#pragma unroll
        for (int b = 0; b < 2; ++b)
#pragma unroll
            for (int m = 0; m < 4; ++m)
#pragma unroll
                for (int n = 0; n < 2; ++n) acc[a][b][m][n] = (f32x4){0.f, 0.f, 0.f, 0.f};
    v8i_t At[4], B0[2], B1[2];
    if constexpr (GATHER) PG8_VOFF(cur, vA[0][0], vA[0][1], vA[1][0], vA[1][1]);
    const char* cA = cur.A; const char* cB = cur.B;
    PG8_STAGE(PG8_SB(0, 0), cB, voffB); PG8_STAGE(PG8_SB(0, 1), cB + hstepB, voffB1); PG8_STAGE(PG8_SA(0, 0), cA, vA[0]); PG8_STAGE(PG8_SA(0, 1), cA + hstepA, vA[1]);
    if (wr == 1) PG8_BAR;
    PG8_WAIT_V(2); PG8_BAR;
    PG8_STAGE(PG8_SB(1, 0), cB + kstep, voffB); PG8_STAGE(PG8_SA(1, 0), cA + kstep, vA[0]); PG8_STAGE(PG8_SB(1, 1), cB + hstepB + kstep, voffB1);
    PG8_WAIT_V(6); PG8_BAR;
    for (;;) {
        const bool has_next = S.next(ui + 1, nxt);
        if constexpr (Sched::UNIFORMIZE) { if (has_next) uniformize(nxt); }
        const char* nA = cA; const char* nB = cB;
        if (has_next) { nA = nxt.A; nB = nxt.B; }
        if constexpr (GATHER) { u32x4 pv; pv.x = vA[0][0]; pv.y = vA[0][1]; pv.z = vA[1][0]; pv.w = vA[1][1];
            if (has_next) PG8_VOFF(nxt, pv.x, pv.y, pv.z, pv.w);
            *park = pv; }
#pragma unroll 1
        for (int t = 0; t < nt; t += 2) {
            const bool last = (t == nt - 2);
            const char* a1 = cA + (size_t)(t + 1) * kstep;
            const char* a2 = last ? nA : cA + (size_t)(t + 2) * kstep; const char* b2 = last ? nB : cB + (size_t)(t + 2) * kstep;
            const char* a3 = a2 + kstep; const char* b3 = b2 + kstep;
            PG8_LDB(B0, 0, 0); PG8_LDB(B1, 0, 1); PG8_SCHED; PG8_LDA(At, 0, 0); PG8_STAGE(PG8_SA(1, 1), a1 + hstepA, vA[1]);
            PG8_WAIT_V(8); PG8_WAIT_L(0); PG8_BAR; PG8_MMA(0, 0, At, B0); PG8_MMA(0, 1, At, B1); PG8_BAR; PG8_SCHED;
            if constexpr (GATHER) { if (last) { const u32x4 pv = *park; vA[0][0] = pv.x; vA[0][1] = pv.y; vA[1][0] = pv.z; vA[1][1] = pv.w; } }
            PG8_LDA(At, 0, 1); PG8_STAGE(PG8_SB(0, 0), b2, voffB); PG8_STAGE(PG8_SB(0, 1), b2 + hstepB, voffB1); PG8_STAGE(PG8_SA(0, 0), a2, vA[0]);
            PG8_WAIT_V(8); PG8_WAIT_L(0); PG8_BAR; PG8_MMA(1, 0, At, B0); PG8_MMA(1, 1, At, B1); PG8_BAR; PG8_SCHED;
            PG8_LDB(B0, 1, 0); PG8_LDB(B1, 1, 1); PG8_SCHED; PG8_LDA(At, 1, 0); PG8_STAGE(PG8_SA(0, 1), a2 + hstepA, vA[1]);
            PG8_WAIT_V(8); PG8_WAIT_L(0); PG8_BAR; PG8_MMA(0, 0, At, B0); PG8_MMA(0, 1, At, B1); PG8_BAR; PG8_SCHED;
            PG8_LDA(At, 1, 1); PG8_STAGE(PG8_SB(1, 0), b3, voffB); PG8_STAGE(PG8_SB(1, 1), b3 + hstepB, voffB1); PG8_STAGE(PG8_SA(1, 0), a3, vA[0]);
            PG8_WAIT_V(8); PG8_WAIT_L(0); PG8_BAR; PG8_MMA(1, 0, At, B0); PG8_MMA(1, 1, At, B1); PG8_BAR; PG8_SCHED;
        }
        if (wr == 0) PG8_BAR;
        { int l2; { unsigned o2 = ~0u; asm volatile("" : "+s"(o2)); l2 = (int)__builtin_amdgcn_mbcnt_hi(o2, __builtin_amdgcn_mbcnt_lo(o2, 0u)); }
          E(acc, cur, wr, wc, l2 & 15, l2 >> 4); }
        if (!has_next) break;
#pragma unroll
        for (int a = 0; a < 2; ++a)
#pragma unroll
            for (int b = 0; b < 2; ++b)
#pragma unroll
                for (int m = 0; m < 4; ++m)
#pragma unroll
                    for (int n = 0; n < 2; ++n) acc[a][b][m][n] = (f32x4){0.f, 0.f, 0.f, 0.f};
        cur = nxt; cA = nA; cB = nB; ++ui;
        if (wr == 1) PG8_BAR;
    }
    PG8_WAIT_V(0);
    PG8_BAR;
#undef PG8_SA
#undef PG8_SB
#undef PG8_STAGE
#undef PG8_LDA
#undef PG8_LDB
#undef PG8_LD2
#undef PG8_LO
#undef PG8_HI
#undef PG8_MMA
#undef PG8_WAIT_V
#undef PG8_WAIT_L
#undef PG8_BAR
#undef PG8_SCHED
#undef PG8_VOFF
}
}

constexpr size_t MiB = 1u << 20;
constexpr size_t WS_CTL = 0, CTL_ZERO_BYTES = 1 * MiB;
constexpr size_t WS_ATT_IN_T = 1 * MiB;
constexpr size_t WS_ATT_OUT_T = WS_ATT_IN_T + 36 * MiB;
constexpr size_t WS_RET_IN_T = WS_ATT_OUT_T + 4 * MiB;
constexpr size_t WS_RET_OUT_T = WS_RET_IN_T + 12 * MiB;
constexpr size_t WS_GLU_T = WS_RET_OUT_T + 4 * MiB;
constexpr size_t WS_RT_HI = WS_GLU_T + 4 * MiB;
constexpr size_t WS_RT_LO = WS_RT_HI + 512 * 1024;
constexpr size_t WS_WMOE = WS_RT_HI + 1 * MiB;
constexpr size_t WMOE_E_BYTES = (size_t)(512 * 1024 + 1024 * 256) * 2;
constexpr size_t WS_X = WS_WMOE + 98 * MiB;
constexpr size_t WS_Y = WS_X + 64 * MiB;
constexpr size_t WS_XB = WS_Y + 64 * MiB;
constexpr size_t WS_BIG = WS_XB + 32 * MiB;
constexpr size_t WS_AUX = WS_BIG + 288 * MiB;
constexpr size_t WS_H = WS_AUX + 160 * MiB;
constexpr size_t WS_LIST = WS_H + 80 * MiB;
constexpr size_t WS_TRASH = WS_LIST + 8 * MiB;
constexpr size_t WS_END = WS_TRASH + 1 * MiB;
static_assert(WS_END <= 1024 * MiB, "workspace map");
constexpr int CW_BAR = 4096;
constexpr int CW_CNT = 16384;
constexpr int CW_CHK = 65536;
constexpr int HROWS = 163840;

#define XB_TMO      128
#define XB_XCNT(j)  (256  + 64 * (j))
#define XB_XSUB(j)  (1280 + 64 * (j))
#define XB_XGEN(j)  (2304 + 64 * (j))
#define XB_TOP      3328
#define XB_TOPGEN   3392
#define XCD_BAR_WORDS 3456
#define XB_SPIN_CAP (1u << 20)
__device__ __forceinline__ unsigned xb_ld(unsigned* p)              { return __hip_atomic_load(p, __ATOMIC_RELAXED, __HIP_MEMORY_SCOPE_AGENT); }
__device__ __forceinline__ unsigned xb_add(unsigned* p, unsigned v) { return __hip_atomic_fetch_add(p, v, __ATOMIC_RELAXED, __HIP_MEMORY_SCOPE_AGENT); }
__device__ __forceinline__ unsigned xb_xcc_id() { return (unsigned)__builtin_amdgcn_s_getreg((3 << 11) | 20) & 0xFu; }
#define XB_SPIN(cond, bar) do { unsigned _sp = 0; while (cond) { __builtin_amdgcn_s_sleep(1); \
    if ((++_sp & 255u) == 0u) { if (xb_ld(&(bar)[XB_TMO])) break; if (_sp > XB_SPIN_CAP) { atomicAdd(&(bar)[XB_TMO], 1u); break; } } } } while (0)
struct XcdBarrier { unsigned* bar; unsigned x; volatile LAS unsigned* st; };
__device__ __forceinline__ XcdBarrier xcd_barrier_post(unsigned* bar, volatile LAS unsigned* st) {
    XcdBarrier b; b.bar = bar; b.x = xb_xcc_id(); b.st = st;
    if (threadIdx.x == 0) (void)xb_add(&bar[XB_XCNT(b.x)], 1u);
    return b;
}
__device__ __forceinline__ void xcd_barrier_complete(unsigned* bar, unsigned x, unsigned& nloc, unsigned& nx) {
    const unsigned G = gridDim.x * gridDim.y * gridDim.z;
    unsigned sum, cnt, mine, sp = 0u;
    for (;;) {
        sum = 0u; cnt = 0u; mine = 0u;
#pragma unroll
        for (unsigned j = 0; j < 16; ++j) { const unsigned c = xb_ld(&bar[XB_XCNT(j)]); sum += c; cnt += (c > 0u) ? 1u : 0u; mine = (j == x) ? c : mine; }
        if (sum == G) break;
        __builtin_amdgcn_s_sleep(1);
        if ((++sp & 255u) == 0u) { if (xb_ld(&bar[XB_TMO])) break; if (sp > XB_SPIN_CAP) { atomicAdd(&bar[XB_TMO], 1u); break; } }
    }
    nloc = mine > 0u ? mine : 1u; nx = cnt > 0u ? cnt : 1u;
}
__device__ __forceinline__ void xcd_barrier(const XcdBarrier& b) {
    asm volatile("s_waitcnt vmcnt(0)" ::: "memory");
    __syncthreads();
    if (threadIdx.x == 0) {
        unsigned* bar = b.bar;
        __builtin_amdgcn_s_waitcnt(0);
        unsigned nloc = b.st[0], nx = b.st[1];
        if (nloc == 0u) { xcd_barrier_complete(bar, b.x, nloc, nx); b.st[0] = nloc; b.st[1] = nx; }
        const unsigned old = xb_add(&bar[XB_XSUB(b.x)], 1u);
        const unsigned gen = old / nloc;
        if (old + 1u == (gen + 1u) * nloc) {
            __builtin_amdgcn_fence(__ATOMIC_RELEASE, "agent");
            asm volatile("s_waitcnt vmcnt(0)" ::: "memory");
            const unsigned og = xb_add(&bar[XB_TOP], 1u);
            const unsigned tg = og / nx;
            if (og + 1u == (tg + 1u) * nx) xb_add(&bar[XB_TOPGEN], 1u);
            else XB_SPIN(xb_ld(&bar[XB_TOPGEN]) == tg, bar);
            __builtin_amdgcn_fence(__ATOMIC_ACQUIRE, "agent");
            xb_add(&bar[XB_XGEN(b.x)], 1u);
            asm volatile("s_waitcnt vmcnt(0)" ::: "memory");
        } else {
            XB_SPIN(xb_ld(&bar[XB_XGEN(b.x)]) == gen, bar);
            __builtin_amdgcn_fence(__ATOMIC_ACQUIRE, "agent");
            asm volatile("s_waitcnt vmcnt(0)" ::: "memory");
        }
    }
    __syncthreads();
}

constexpr int RING_BYTES = 139264;
constexpr int MISC_OFF = RING_BYTES;
constexpr int LDS_BYTES = 147456;
struct Params {
    const float* in[26]; float* out; unsigned char* ws; int ph_lo, ph_hi; int use_bar, pad;
};
typedef const __attribute__((address_space(4))) Params* KP;
__device__ __forceinline__ const float* gin(KP p, int i) { return (const float*)(const GAS float*)p->in[i]; }
__device__ __forceinline__ float* gout(KP p) { return (float*)(GAS float*)p->out; }
struct Frame {
    LAS unsigned char* lds; volatile LAS unsigned* MISC;
    int tid, lane, wave, vcu, G;
    unsigned char* ws;
};

template <bool F8_ = false> struct DenseSchedT {
    static constexpr bool GATHER = false, UNIFORMIZE = false, FP8 = F8_;
    const char* A; const char* Bt; int K, nM, nN, nwg, G, c;
    __device__ __forceinline__ void init(const void* A_, const void* Bt_, int M, int N, int K_, int G_, int c_) { A = (const char*)A_; Bt = (const char*)Bt_; K = K_; nM = M / 256; nN = N / 256; nwg = nM * nN; G = G_; c = c_; }
    __device__ __forceinline__ bool next(int i, pg8::UnitG& u) const {
        const long L = (long)i * G + c; if (L >= nwg) return false;
        int wgid = (int)L; { const int q = nwg / 8, r = nwg % 8, xcd = wgid % 8, off = wgid / 8; wgid = (xcd < r ? xcd * (q + 1) : r * (q + 1) + (xcd - r) * q) + off; }
        const int nig = 8 * nN, gid = wgid / nig, fm = gid * 8, gsz = (nM - fm) < 8 ? (nM - fm) : 8;
        const int pm = fm + ((wgid % nig) % gsz), pn = (wgid % nig) / gsz;
        u.A = A + (size_t)pm * 256 * K * 2; u.B = Bt + (size_t)pn * 256 * K * 2; u.gidx = nullptr; u.gcnt = 0; u.gshift = 0; u.row0 = pm * 256; u.col0 = pn * 256; u.aux = 0; return true;
    }
};
typedef DenseSchedT<false> DenseSched; typedef DenseSchedT<true> DenseSched8;
__device__ __forceinline__ u32x4 pack_bf16x8(const f32x4& v0, const f32x4& v1) { u32x4 w; w.x = pk2hw(v0[0], v0[1]); w.y = pk2hw(v0[2], v0[3]); w.z = pk2hw(v1[0], v1[1]); w.w = pk2hw(v1[2], v1[3]); return w; }

__device__ __forceinline__ unsigned pk4_fp8(float a, float b, float c, float d) {
    a = fminf(fmaxf(a, -448.0f), 448.0f); b = fminf(fmaxf(b, -448.0f), 448.0f); c = fminf(fmaxf(c, -448.0f), 448.0f); d = fminf(fmaxf(d, -448.0f), 448.0f);
    int w = 0; w = __builtin_amdgcn_cvt_pk_fp8_f32(a, b, w, false); w = __builtin_amdgcn_cvt_pk_fp8_f32(c, d, w, true); return (unsigned)w; }
constexpr float WUP_SCALE = 32.0f, WUP_INV = 1.0f / 32.0f;
struct EpiStoreBf16 {
    static constexpr bool PERM = true, PERM16 = false;
    bf16* O; int ldc; float osc, qsc;
    __device__ __forceinline__ void operator()(const f32x4 (&acc)[2][2][4][2], const pg8::UnitG& u, int wr, int wc, int fr, int fq) const {
        const float sc = ((u.col0 % 3072) < 1024) ? osc * qsc : osc;
#pragma unroll
        for (int ai = 0; ai < 2; ++ai)
#pragma unroll
            for (int m = 0; m < 4; ++m) { bf16* rowp = O + (size_t)(u.row0 + ai * 128 + wr * 64 + m * 16 + fr) * ldc + u.col0 + wc * 32 + 8 * fq;
#pragma unroll
                for (int bj = 0; bj < 2; ++bj) *(u32x4*)(rowp + bj * 128) = pack_bf16x8(acc[ai][bj][m][0] * sc, acc[ai][bj][m][1] * sc); }
    }
};
constexpr float YEXP_SCALE = 32.0f, YEXP_INV = 1.0f / 32.0f;
constexpr float H_SCALE = 16.0f;
struct EpiStoreFp8 {
    static constexpr bool PERM = false, PERM16 = true;
    unsigned char* O; int ldc;
    __device__ __forceinline__ void operator()(const f32x4 (&acc)[2][2][4][2], const pg8::UnitG& u, int wr, int wc, int fr, int fq) const {
#pragma unroll
        for (int ai = 0; ai < 2; ++ai)
#pragma unroll
            for (int m = 0; m < 4; ++m) { unsigned char* rowp = O + (size_t)(u.row0 + ai * 128 + wr * 64 + m * 16 + fr) * ldc + u.col0 + wc * 64 + 16 * fq;
                u32x4 w;
#pragma unroll
                for (int q = 0; q < 4; ++q) { f32x4 v = acc[ai][q >> 1][m][q & 1] * (YEXP_SCALE / (H_SCALE * WUP_SCALE));
#pragma unroll
                    for (int j = 0; j < 4; ++j) v[j] = fminf(fmaxf(v[j], -448.0f), 448.0f);
                    int d = 0; d = __builtin_amdgcn_cvt_pk_fp8_f32(v[0], v[1], d, false); d = __builtin_amdgcn_cvt_pk_fp8_f32(v[2], v[3], d, true); w[q] = (unsigned)d; }
                *(u32x4*)rowp = w; }
    }
};
struct EpiRetIn {
    static constexpr bool PERM = true, PERM16 = false;
    bf16* O; int ldc;
    __device__ __forceinline__ void operator()(const f32x4 (&acc)[2][2][4][2], const pg8::UnitG& u, int wr, int wc, int fr, int fq) const {
        float l2g = 0.f;
        float cs = WUP_INV;
        if (u.col0 < 2048) { const int h = (u.col0 & 1023) >> 8; const float g = 1.0f - exp2f(-5.0f - (float)h); l2g = log2f(g); if (u.col0 >= 1024) { l2g = -l2g; cs *= 0.0625f; } }
#pragma unroll
        for (int ai = 0; ai < 2; ++ai)
#pragma unroll
            for (int m = 0; m < 4; ++m) { const int row = u.row0 + ai * 128 + wr * 64 + m * 16 + fr; const float sc = exp2f(l2g * (float)(row & 127)) * cs;
                bf16* rowp = O + (size_t)row * ldc + u.col0 + wc * 32 + 8 * fq;
#pragma unroll
                for (int bj = 0; bj < 2; ++bj) *(u32x4*)(rowp + bj * 128) = pack_bf16x8(acc[ai][bj][m][0] * sc, acc[ai][bj][m][1] * sc); }
    }
};
__device__ __forceinline__ void unpack_bf16x8(const u32x4& w, f32x4& a, f32x4& b) { a[0] = bflo(w.x); a[1] = bfhi(w.x); a[2] = bflo(w.y); a[3] = bfhi(w.y); b[0] = bflo(w.z); b[1] = bfhi(w.z); b[2] = bflo(w.w); b[3] = bfhi(w.w); }
template <bool ALL16> struct EpiResidT {
    static constexpr bool PERM = true, PERM16 = false;
    const bf16* X; bf16* Y; float asc;
    __device__ __forceinline__ void operator()(const f32x4 (&acc)[2][2][4][2], const pg8::UnitG& u, int wr, int wc, int fr, int fq) const {
        constexpr int NB = ALL16 ? 1 : 2, PER = 2 / NB;
#pragma unroll
        for (int bt = 0; bt < NB; ++bt) {
            u32x4 xw[PER][4][2];
#pragma unroll
            for (int a2 = 0; a2 < PER; ++a2)
#pragma unroll
                for (int m = 0; m < 4; ++m) { const int ai = bt * PER + a2; const size_t off = (size_t)(u.row0 + ai * 128 + wr * 64 + m * 16 + fr) * D + u.col0 + wc * 32 + 8 * fq;
#pragma unroll
                    for (int bj = 0; bj < 2; ++bj) xw[a2][m][bj] = *(const u32x4*)(X + off + bj * 128); }
            asm volatile("" ::: "memory");
#pragma unroll
            for (int a2 = 0; a2 < PER; ++a2)
#pragma unroll
                for (int m = 0; m < 4; ++m) { const int ai = bt * PER + a2; const size_t off = (size_t)(u.row0 + ai * 128 + wr * 64 + m * 16 + fr) * D + u.col0 + wc * 32 + 8 * fq;
#pragma unroll
                    for (int bj = 0; bj < 2; ++bj) { f32x4 x0, x1; unpack_bf16x8(xw[a2][m][bj], x0, x1);
                        *(u32x4*)(Y + off + bj * 128) = pack_bf16x8(x0 * ALPHA + acc[ai][bj][m][0] * asc, x1 * ALPHA + acc[ai][bj][m][1] * asc); } }
            asm volatile("" ::: "memory");
        }
    }
};
typedef EpiResidT<true> EpiResid; typedef EpiResidT<false> EpiResid8;
struct EpiGluResid {
    static constexpr bool PERM = true, PERM16 = false;
    const bf16* X; bf16* Y;
    __device__ __forceinline__ void operator()(const f32x4 (&acc)[2][2][4][2], const pg8::UnitG& u, int wr, int wc, int fr, int fq) const {
        u32x4 xw[2][4];
#pragma unroll
        for (int ai = 0; ai < 2; ++ai)
#pragma unroll
            for (int m = 0; m < 4; ++m) { const size_t off = (size_t)(u.row0 + ai * 128 + wr * 64 + m * 16 + fr) * D + (u.col0 >> 1) + wc * 32 + 8 * fq; xw[ai][m] = *(const u32x4*)(X + off); }
        asm volatile("" ::: "memory");
#pragma unroll
        for (int ai = 0; ai < 2; ++ai)
#pragma unroll
            for (int m = 0; m < 4; ++m) { const size_t off = (size_t)(u.row0 + ai * 128 + wr * 64 + m * 16 + fr) * D + (u.col0 >> 1) + wc * 32 + 8 * fq;
                f32x4 x0, x1; unpack_bf16x8(xw[ai][m], x0, x1); f32x4 o0, o1;
#pragma unroll
                for (int j = 0; j < 4; ++j) { o0[j] = x0[j] * ALPHA + acc[ai][0][m][0][j] * fsig(acc[ai][1][m][0][j]); o1[j] = x1[j] * ALPHA + acc[ai][0][m][1][j] * fsig(acc[ai][1][m][1][j]); }
                *(u32x4*)(Y + off) = pack_bf16x8(o0, o1); }
    }
};
struct EpiMoeUp {
    static constexpr bool PERM = true, PERM16 = false;
    unsigned char* H;
    __device__ __forceinline__ void operator()(const f32x4 (&acc)[2][2][4][2], const pg8::UnitG& u, int wr, int wc, int fr, int fq) const {
#pragma unroll
        for (int ai = 0; ai < 2; ++ai)
#pragma unroll
            for (int m = 0; m < 4; ++m) { unsigned char* rowp = H + (size_t)(u.row0 + ai * 128 + wr * 64 + m * 16 + fr) * ED + u.col0 + wc * 32 + 8 * fq; f32x4 o[2];
#pragma unroll
                for (int n = 0; n < 2; ++n)
#pragma unroll
                    for (int j = 0; j < 4; ++j) { const float ga = acc[ai][0][m][n][j], ua = acc[ai][1][m][n][j];
                        o[n][j] = (ga * ua) * (WUP_INV * WUP_INV * H_SCALE) * __builtin_amdgcn_rcpf(1.0f + __builtin_amdgcn_exp2f(ga * (-WUP_INV * 1.4426950408889634f))); }
                u32x2 w8; w8.x = pk4_fp8(o[0][0], o[0][1], o[0][2], o[0][3]); w8.y = pk4_fp8(o[1][0], o[1][1], o[1][2], o[1][3]); *(u32x2*)rowp = w8; }
    }
};

struct ConvD { const float* src; unsigned char* dst; unsigned char* dst2; int ldw, ldk, kind; };
__device__ __forceinline__ ConvD conv_mk8(const float* W, int ldw, unsigned char* WT, int ldk, int k0, int n0, int drow0) {
    ConvD d; d.src = W + (size_t)k0 * ldw + n0; d.dst = WT + (size_t)drow0 * ldk + k0; d.dst2 = nullptr; d.ldw = ldw; d.ldk = ldk; d.kind = 1; return d; }
__device__ __forceinline__ ConvD conv_mk16(const float* W, int ldw, bf16* WT, bf16* WTlo, int ldk, int k0, int n0, int drow0) {
    ConvD d; d.src = W + (size_t)k0 * ldw + n0; d.dst = (unsigned char*)(WT + (size_t)drow0 * ldk + k0); d.dst2 = WTlo ? (unsigned char*)(WTlo + (size_t)drow0 * ldk + k0) : nullptr; d.ldw = ldw; d.ldk = ldk * 2; d.kind = WTlo ? 2 : 0; return d; }
__device__ __forceinline__ void conv_load(const ConvD& d, int lane, f32x4 (&r)[8]) {
#pragma unroll
    for (int i = 0; i < 8; ++i) { const int kk = 8 * i + (lane >> 3), c4 = 4 * (lane & 7); r[i] = *(const f32x4*)(d.src + (size_t)kk * d.ldw + c4); }
}
template <bool HILO>
__device__ __forceinline__ void conv_finish(const ConvD& d, int lane, const f32x4 (&r)[8], LAS float* scr) {
    const float scale = (d.kind == 1) ? WUP_SCALE : 1.0f;
#pragma unroll
    for (int i = 0; i < 8; ++i) { const int kk = 8 * i + (lane >> 3), c4 = 4 * (lane & 7);
        scr[kk * 33 + c4] = r[i][0] * scale; scr[kk * 33 + c4 + 1] = r[i][1] * scale; scr[kk * 33 + c4 + 2] = r[i][2] * scale; scr[kk * 33 + c4 + 3] = r[i][3] * scale; }
    LDS_WAIT(); asm volatile("" ::: "memory");
    const int c = lane & 7;
#pragma unroll
    for (int j = 0; j < 4; ++j) { const int n = (lane >> 3) + 8 * j; const LAS float* s = scr + (8 * c) * 33 + n;
        float v[8];
#pragma unroll
        for (int q = 0; q < 8; ++q) v[q] = s[q * 33];
        if (d.kind == 1) { u32x2 o; o.x = pk4_fp8(v[0], v[1], v[2], v[3]); o.y = pk4_fp8(v[4], v[5], v[6], v[7]); *(u32x2*)(d.dst + (size_t)n * d.ldk + 8 * c) = o; }
        else { u32x4 o; o.x = pk2(v[0], v[1]); o.y = pk2(v[2], v[3]); o.z = pk2(v[4], v[5]); o.w = pk2(v[6], v[7]);
            *(u32x4*)(d.dst + (size_t)n * d.ldk + 16 * c) = o;
            if (HILO) { float rr[8];
#pragma unroll
                for (int q = 0; q < 8; ++q) rr[q] = v[q] - bf2f(f2bf(v[q]));
                u32x4 o2; o2.x = pk2(rr[0], rr[1]); o2.y = pk2(rr[2], rr[3]); o2.z = pk2(rr[4], rr[5]); o2.w = pk2(rr[6], rr[7]);
                *(u32x4*)(d.dst2 + (size_t)n * d.ldk + 16 * c) = o2; } } }
    LDS_WAIT(); asm volatile("" ::: "memory");
}
__device__ __forceinline__ void conv_dma(const ConvD& d, int lane, LAS float* buf) {
#pragma unroll
    for (int i = 0; i < 8; ++i) { const float* g = d.src + (size_t)(8 * i + (lane >> 3)) * d.ldw + 4 * ((lane & 7) ^ i);
        __builtin_amdgcn_global_load_lds((const unsigned*)g, (LAS unsigned*)(buf + i * 256), 16, 0, 0); }
}
__device__ __forceinline__ void conv_finish_lds(const ConvD& d, int lane, const LAS float* buf) {
    const float scale = (d.kind == 1) ? WUP_SCALE : 1.0f;
    const int c = lane & 7;
#pragma unroll
    for (int j = 0; j < 4; ++j) { const int n = (lane >> 3) + 8 * j; const LAS float* s = buf + (8 * c) * 32 + (((n >> 2) ^ c) & 7) * 4 + (n & 3);
        float v[8];
#pragma unroll
        for (int q = 0; q < 8; ++q) v[q] = s[q * 32] * scale;
        if (d.kind == 1) { u32x2 o; o.x = pk4_fp8(v[0], v[1], v[2], v[3]); o.y = pk4_fp8(v[4], v[5], v[6], v[7]); *(u32x2*)(d.dst + (size_t)n * d.ldk + 8 * c) = o; }
        else { u32x4 o; o.x = pk2(v[0], v[1]); o.y = pk2(v[2], v[3]); o.z = pk2(v[4], v[5]); o.w = pk2(v[6], v[7]); *(u32x4*)(d.dst + (size_t)n * d.ldk + 16 * c) = o; } }
    LDS_WAIT(); asm volatile("" ::: "memory");
}
#define CONV_RUN(NIT, DEC) do { int it_ = gw; if (it_ < (NIT)) { ConvD dc_ = DEC(it_); int par_ = 0; conv_dma(dc_, F.lane, scr); asm volatile("s_waitcnt vmcnt(0)" ::: "memory"); \
        for (; it_ < (NIT); it_ += NGW) { const int itn_ = (it_ + NGW < (NIT)) ? it_ + NGW : it_; const ConvD dn_ = DEC(itn_); conv_dma(dn_, F.lane, scr + (par_ ^ 1) * 2048);     \
            asm volatile("s_waitcnt vmcnt(12)" ::: "memory"); conv_finish_lds(dc_, F.lane, scr + par_ * 2048); dc_ = dn_; par_ ^= 1; } \
        asm volatile("s_waitcnt vmcnt(0)" ::: "memory"); } } while (0)
__device__ __forceinline__ ConvD conv_dec_mixers(KP p, unsigned char* ws, int it) {
    constexpr int I_AIN = 16 * 288, I_AOUT = 16 * 32, I_RIN = 16 * 192, I_ROUT = 32 * 32, I_GLU = 16 * 64, I_RT = 16 * 2;
    int r = it;
    if (r < 2 * I_AIN) { const int j = r / I_AIN; r %= I_AIN; const int kb = r / 288, nb = r % 288, n0 = nb * 32;
        return conv_mk8(gin(p, 1) + (size_t)j * D * ATT_IN, ATT_IN, (unsigned char*)(ws + WS_ATT_IN_T) + (size_t)j * ATT_IN * D, D, kb * 64, n0, n0); }
    r -= 2 * I_AIN;
    if (r < 2 * I_AOUT) { const int j = r / I_AOUT; r %= I_AOUT; const int kb = r / 32, nb = r % 32, n0 = nb * 32;
        return conv_mk16(gin(p, 2) + (size_t)j * D * D, D, (bf16*)(ws + WS_ATT_OUT_T) + (size_t)j * D * D, nullptr, D, kb * 64, n0, n0); }
    r -= 2 * I_AOUT;
    if (r < I_RIN) { const int kb = r / 192, nb = r % 192, n0 = nb * 32;
        return conv_mk8(gin(p, 3), RET_IN, (unsigned char*)(ws + WS_RET_IN_T), D, kb * 64, n0, n0); }
    r -= I_RIN;
    if (r < I_ROUT) { const int kb = r / 32, nb = r % 32, n0 = nb * 32;
        return conv_mk16(gin(p, 6), D, (bf16*)(ws + WS_RET_OUT_T), nullptr, RET_V, kb * 64, n0, n0); }
    r -= I_ROUT;
    if (r < I_GLU) { const int kb = r / 64, nb = r % 64, n0 = nb * 32; const int c = n0 & 1023, drow = (c >> 7) * 256 + (n0 >> 10) * 128 + (c & 127);
        return conv_mk16(gin(p, 15), 2 * D, (bf16*)(ws + WS_GLU_T), nullptr, D, kb * 64, n0, drow); }
    r -= I_GLU;
    { const int l = r / I_RT; r %= I_RT; const int kb = r / 2, nb = r % 2, n0 = nb * 32;
        return conv_mk16(gin(p, 16) + (size_t)l * D * NE, NE, (bf16*)(ws + WS_RT_HI) + (size_t)l * NE * D, (bf16*)(ws + WS_RT_LO) + (size_t)l * NE * D, D, kb * 64, n0, n0); }
}
__device__ __forceinline__ ConvD conv_dec_moe(KP p, unsigned char* ws, int l, int it) {
    const int e = it / 384, r = it % 384, which = r >> 7, rr = r & 127;
    bf16* We = (bf16*)(ws + WS_WMOE + (size_t)e * WMOE_E_BYTES);
    if (which < 2) { const float* src = (e < 64) ? gin(p, 18 + which) + ((size_t)l * NE + e) * D * ED : gin(p, 21 + which) + (size_t)l * D * ED;
        const int kb = rr >> 3, nb = rr & 7, n0 = nb * 32; const int drow = (n0 >> 7) * 256 + which * 128 + (n0 & 127);
        return conv_mk8(src, ED, (unsigned char*)We, D, kb * 64, n0, drow); }
    const float* src = (e < 64) ? gin(p, 20) + ((size_t)l * NE + e) * ED * D : gin(p, 23) + (size_t)l * ED * D;
    const int kb = rr >> 5, nb = rr & 31, n0 = nb * 32;
    return conv_mk8(src, D, (unsigned char*)(We + 512 * 1024), ED, kb * 64, n0, n0);
}
__device__ __forceinline__ void phase_conv_mixers(const Frame& F, KP p) {
    LAS float* scr = (LAS float*)(F.lds + F.wave * 16384);
    const int gw = F.vcu * NWAVES + F.wave, NGW = F.G * NWAVES;
    constexpr int NMAIN = 2 * (16 * 288) + 2 * (16 * 32) + 16 * 192 + 32 * 32 + 16 * 64, NRT = 4 * (16 * 2);
    unsigned char* ws = F.ws;
#define CONV_DEC_MIX(i_) conv_dec_mixers(p, ws, (i_))
    CONV_RUN(NMAIN, CONV_DEC_MIX);
    for (int it = NMAIN + gw; it < NMAIN + NRT; it += NGW) { const ConvD d = conv_dec_mixers(p, ws, it); f32x4 r[8]; conv_load(d, F.lane, r); conv_finish<true>(d, F.lane, r, scr); }
#undef CONV_DEC_MIX
}
__device__ __forceinline__ void phase_conv_moe(const Frame& F, KP p, int l) {
    LAS float* scr = (LAS float*)(F.lds + F.wave * 16384);
    const int gw = F.vcu * NWAVES + F.wave, NGW = F.G * NWAVES;
    unsigned char* ws = F.ws;
#define CONV_DEC_MOE(i_) conv_dec_moe(p, ws, l, (i_))
    CONV_RUN(65 * 384, CONV_DEC_MOE);
#undef CONV_DEC_MOE
}

__device__ __forceinline__ void phase_lnr(const Frame& F, KP p, int layer, bool dry = false) {
    const bf16* Y = (const bf16*)(F.ws + WS_Y); bf16* XB = (bf16*)(F.ws + WS_XB); unsigned char* XB8 = (unsigned char*)(F.ws + WS_X);
    const float* lng = gin(p, 24) + (size_t)(layer * 2) * D; const float* lnb = gin(p, 25) + (size_t)(layer * 2) * D;
    const bf16* rthi = (const bf16*)(F.ws + WS_RT_HI) + (size_t)layer * NE * D; const bf16* rtlo = (const bf16*)(F.ws + WS_RT_LO) + (size_t)layer * NE * D;
    const float* rbias = gin(p, 17) + layer * NE;
    unsigned* cnt = (unsigned*)(F.ws + WS_CTL) + CW_CNT + layer * NE * 64;
    int* lists = (int*)(F.ws + WS_LIST); int* tokmap = (int*)(F.ws + WS_LIST + 4 * MiB); float* tokgate = (float*)(F.ws + WS_LIST + 5 * MiB);
    constexpr int XLD = 1032, MAXT = 8;
    LAS bf16* Xhi = (LAS bf16*)F.lds; LAS bf16* Xlo = Xhi + 16 * XLD;
    LAS float* part = (LAS float*)(F.lds + 2 * 16 * XLD * 2);
    LAS int* ent = (LAS int*)(part + 2 * 16 * 64);
    LAS int* hist = ent + MAXT * 16 * 8 * 2; LAS int* base = hist + 64;
    const int lane = F.lane, w = F.wave, g4 = lane >> 4, l15 = lane & 15;
    if (F.tid < 64) hist[F.tid] = 0;
    bf16x8 bhi[16], blo[16];
    { const int nt = w & 3, kh = w >> 2; const bf16* bh = rthi + (size_t)(16 * nt + l15) * D + 512 * kh + 8 * g4; const bf16* bl = rtlo + (size_t)(16 * nt + l15) * D + 512 * kh + 8 * g4;
#pragma unroll
        for (int ks = 0; ks < 16; ++ks) { bhi[ks] = *(const bf16x8*)(bh + 32 * ks); blo[ks] = *(const bf16x8*)(bl + 32 * ks); } }
    u32x4 ypre[2][2];
    if (F.vcu < T / 16) {
#pragma unroll
        for (int rr = 0; rr < 2; ++rr)
#pragma unroll
            for (int j = 0; j < 2; ++j) ypre[rr][j] = *(const u32x4*)(Y + (size_t)(F.vcu * 16 + 2 * w + rr) * D + 8 * lane + 512 * j); }
    int ntile = 0;
    for (int tile = F.vcu; tile < T / 16 && ntile < MAXT; tile += F.G, ++ntile) {
        const int t0 = tile * 16;
        u32x4 ycur[2][2];
#pragma unroll
        for (int rr = 0; rr < 2; ++rr)
#pragma unroll
            for (int j = 0; j < 2; ++j) ycur[rr][j] = ypre[rr][j];
        if (tile + F.G < T / 16) {
#pragma unroll
            for (int rr = 0; rr < 2; ++rr)
#pragma unroll
                for (int j = 0; j < 2; ++j) ypre[rr][j] = *(const u32x4*)(Y + (size_t)((tile + F.G) * 16 + 2 * w + rr) * D + 8 * lane + 512 * j); }
#pragma unroll
        for (int rr = 0; rr < 2; ++rr) {
            const int lr = 2 * w + rr; const size_t row = (size_t)(t0 + lr);
            f32x4 v[4]; float s = 0.f;
#pragma unroll
            for (int j = 0; j < 2; ++j) unpack_bf16x8(ycur[rr][j], v[2 * j], v[2 * j + 1]);
#pragma unroll
            for (int j = 0; j < 4; ++j) s += (v[j][0] + v[j][1]) + (v[j][2] + v[j][3]);
            const float mean = wave_sum(s, lane) * (1.f / D); float s2 = 0.f;
#pragma unroll
            for (int j = 0; j < 4; ++j) { v[j] = v[j] - mean; s2 += (v[j][0] * v[j][0] + v[j][1] * v[j][1]) + (v[j][2] * v[j][2] + v[j][3] * v[j][3]); }
            const float rstd = 1.0f / sqrtf(wave_sum(s2, lane) * (1.f / D) + LN_EPS);
#pragma unroll
            for (int j = 0; j < 2; ++j) { const f32x4 g0 = *(const f32x4*)(lng + 8 * lane + 512 * j), g1 = *(const f32x4*)(lng + 8 * lane + 512 * j + 4), b0 = *(const f32x4*)(lnb + 8 * lane + 512 * j), b1 = *(const f32x4*)(lnb + 8 * lane + 512 * j + 4);
                const f32x4 o0 = v[2 * j] * rstd * g0 + b0, o1 = v[2 * j + 1] * rstd * g1 + b1;
                const u32x4 hi = pack_bf16x8(o0, o1);
                *(u32x4*)(XB + row * D + 8 * lane + 512 * j) = hi;
                { u32x2 q8; q8.x = pk4_fp8(o0[0], o0[1], o0[2], o0[3]); q8.y = pk4_fp8(o1[0], o1[1], o1[2], o1[3]); *(u32x2*)(XB8 + row * D + 8 * lane + 512 * j) = q8; }
                f32x4 h0, h1; unpack_bf16x8(hi, h0, h1); const u32x4 lo = pack_bf16x8(o0 - h0, o1 - h1);
                *(LAS u32x4*)(Xhi + lr * XLD + 8 * lane + 512 * j) = hi; *(LAS u32x4*)(Xlo + lr * XLD + 8 * lane + 512 * j) = lo; }
        }
        __syncthreads();
        { const int nt = w & 3, kh = w >> 2; f32x4 a0 = (f32x4){0.f, 0.f, 0.f, 0.f}, a1 = a0, a2 = a0, a3 = a0, a4 = a0, a5 = a0;
#pragma unroll
            for (int ks = 0; ks < 16; ks += 2) { const int k0 = 512 * kh + 32 * ks;
                const bf16x8 ahi = row_frag(Xhi, XLD, 0, k0, lane), alo = row_frag(Xlo, XLD, 0, k0, lane), bhi2 = row_frag(Xhi, XLD, 0, k0 + 32, lane), blo2 = row_frag(Xlo, XLD, 0, k0 + 32, lane);
                a0 = MFMA16(ahi, bhi[ks], a0); a1 = MFMA16(alo, bhi[ks], a1); a2 = MFMA16(ahi, blo[ks], a2);
                a3 = MFMA16(bhi2, bhi[ks + 1], a3); a4 = MFMA16(blo2, bhi[ks + 1], a4); a5 = MFMA16(bhi2, blo[ks + 1], a5); }
            const f32x4 acc = ((a0 + a3) + (a1 + a4)) + (a2 + a5);
#pragma unroll
            for (int i = 0; i < 4; ++i) part[(kh * 16 + 4 * g4 + i) * 64 + 16 * nt + l15] = acc[i];
        }
        __syncthreads();
#pragma unroll
        for (int rr = 0; rr < 2; ++rr) {
            const int lt = ntile * 16 + 2 * w + rr;
            const float lg = part[(2 * w + rr) * 64 + lane] + part[(16 + 2 * w + rr) * 64 + lane];
            float sc = 1.0f / (1.0f + expf(-lg)); sc = (sc == sc) ? sc : 0.5f;
            const float sel = sc + rbias[lane];
            const float m1 = max8(sel);
            const unsigned long long eq = __ballot(sel == m1);
            const unsigned gm = (unsigned)(eq >> (lane & 56)) & 0xffu;
            const int first = (lane & 56) + __builtin_ctz(gm | 0x100u);
            const float m2 = max8((lane == first) ? -INFINITY : sel);
            const float gs = m1 + m2; const int mygrp = lane >> 3; int grank = 0;
#pragma unroll
            for (int gg = 0; gg < 8; ++gg) { const float o = rdl(gs, 8 * gg); grank += (o > gs || (o == gs && gg < mygrp)) ? 1 : 0; }
            const float mv = (grank < 4) ? sel : -INFINITY;
            unsigned key = __builtin_bit_cast(unsigned, mv); key = (key >> 31) ? ~key : (key | 0x80000000u); key = (key & ~63u) | (unsigned)(63 - lane);
            int r0 = 0, r1 = 0, r2 = 0, r3 = 0;
#pragma unroll
            for (int e2 = 0; e2 < 64; e2 += 4) { r0 += ((unsigned)__builtin_amdgcn_readlane((int)key, e2) > key) ? 1 : 0; r1 += ((unsigned)__builtin_amdgcn_readlane((int)key, e2 + 1) > key) ? 1 : 0;
                r2 += ((unsigned)__builtin_amdgcn_readlane((int)key, e2 + 2) > key) ? 1 : 0; r3 += ((unsigned)__builtin_amdgcn_readlane((int)key, e2 + 3) > key) ? 1 : 0; }
            const int rank = (r0 + r1) + (r2 + r3);
            const bool chosen = rank < TOPK;
            const float wsum = wave_sum(chosen ? sc : 0.f, lane);
            if (chosen) { const int lpos = __hip_atomic_fetch_add(hist + lane, 1, __ATOMIC_RELAXED, __HIP_MEMORY_SCOPE_WORKGROUP);
                ent[(lt * 8 + rank) * 2] = (lane << 16) | lpos; ent[(lt * 8 + rank) * 2 + 1] = __builtin_bit_cast(int, sc / wsum * 2.5f); }
        }
    }
    __syncthreads();
    if (dry) return;
    if (F.tid < 64) { const int hcount = hist[F.tid]; base[F.tid] = hcount ? (int)atomicAdd(cnt + F.tid * 64, (unsigned)hcount) : 0; }
    __syncthreads();
    for (int idx = F.tid; idx < ntile * 16 * 8; idx += NTHREADS) {
        const int ev = ent[idx * 2], gb = ent[idx * 2 + 1]; const int e = ev >> 16, pos = base[e] + (ev & 0xffff);
        const int lt = idx >> 3, rank = idx & 7, tok = (F.vcu + (lt >> 4) * F.G) * 16 + (lt & 15);
        lists[(size_t)e * T + pos] = tok; tokmap[tok * 8 + rank] = (e << 16) | pos; tokgate[tok * 8 + rank] = __builtin_bit_cast(float, gb);
    }
}

__device__ __forceinline__ void phase_combine(const Frame& F, KP p, int layer, bool dry = false) {
    bf16* XB = (bf16*)(F.ws + WS_XB); const unsigned char* yexp = (const unsigned char*)(F.ws + WS_BIG);
    const int* tokmap = (const int*)(F.ws + WS_LIST + 4 * MiB); const float* tokgate = (const float*)(F.ws + WS_LIST + 5 * MiB);
    const volatile LAS int* tstart = (const volatile LAS int*)(F.MISC + 64);
    const float* lng = gin(p, 24) + (size_t)(layer * 2 + 1) * D; const float* lnb = gin(p, 25) + (size_t)(layer * 2 + 1) * D;
    float* outp = gout(p); bf16* xbo = XB; if (dry) { outp = (float*)(F.ws + WS_AUX); xbo = (bf16*)(F.ws + WS_H); }
    const int lane = F.lane, gw = F.vcu * NWAVES + F.wave, NGW = F.G * NWAVES;
    const bf16* ysh = (const bf16*)(F.ws + WS_Y);
    f32x4 gv[4], bv[4];
#pragma unroll
    for (int j = 0; j < 4; ++j) { gv[j] = *(const f32x4*)(lng + 16 * lane + 4 * j); bv[j] = *(const f32x4*)(lnb + 16 * lane + 4 * j); }
    for (int row = gw; row < T; row += NGW) {
        const int mk = tokmap[row * 8 + (lane & 7)]; const float gk = tokgate[row * 8 + (lane & 7)] * YEXP_INV;
        const int rk = (int)tstart[mk >> 16] * 256 + (mk & 0xffff);
        f32x4 v[4];
#pragma unroll
        for (int j = 0; j < 2; ++j) { const u32x4 xw = *(const u32x4*)(ysh + (size_t)row * D + 16 * lane + 8 * j); unpack_bf16x8(xw, v[2 * j], v[2 * j + 1]); }
#pragma unroll
        for (int k = 0; k < TOPK; ++k) { const int r = __builtin_amdgcn_readlane(rk, k); const float g = rdl(gk, k);
            const u32x4 s = *(const u32x4*)(yexp + (size_t)r * D + 16 * lane);
#pragma unroll
            for (int j = 0; j < 4; ++j) { const f32x2 lo = __builtin_amdgcn_cvt_pk_f32_fp8((int)s[j], false), hi = __builtin_amdgcn_cvt_pk_f32_fp8((int)s[j], true);
                v[j][0] += g * lo[0]; v[j][1] += g * lo[1]; v[j][2] += g * hi[0]; v[j][3] += g * hi[1]; } }
        float s = 0.f;
#pragma unroll
        for (int j = 0; j < 4; ++j) s += (v[j][0] + v[j][1]) + (v[j][2] + v[j][3]);
        const float mean = wave_sum(s, lane) * (1.f / D); float s2 = 0.f;
#pragma unroll
        for (int j = 0; j < 4; ++j) { v[j] = v[j] - mean; s2 += (v[j][0] * v[j][0] + v[j][1] * v[j][1]) + (v[j][2] * v[j][2] + v[j][3] * v[j][3]); }
        const float rstd = 1.0f / sqrtf(wave_sum(s2, lane) * (1.f / D) + LN_EPS);
        f32x4 o[4];
#pragma unroll
        for (int j = 0; j < 4; ++j) o[j] = v[j] * rstd * gv[j] + bv[j];
        if (layer == DEPTH - 1 || dry) {
#pragma unroll
            for (int j = 0; j < 4; ++j) *(f32x4*)(outp + (size_t)row * D + 16 * lane + 4 * j) = o[j]; }
        if (layer != DEPTH - 1) { *(u32x4*)(xbo + (size_t)row * D + 16 * lane) = pack_bf16x8(o[0], o[1]); *(u32x4*)(xbo + (size_t)row * D + 16 * lane + 8) = pack_bf16x8(o[2], o[3]);
            if (!dry) { u32x4 q8; q8.x = pk4_fp8(o[0][0], o[0][1], o[0][2], o[0][3]); q8.y = pk4_fp8(o[1][0], o[1][1], o[1][2], o[1][3]); q8.z = pk4_fp8(o[2][0], o[2][1], o[2][2], o[2][3]); q8.w = pk4_fp8(o[3][0], o[3][1], o[3][2], o[3][3]);
                *(u32x4*)((unsigned char*)(F.ws + WS_X) + (size_t)row * D + 16 * lane) = q8; } }
    }
}

constexpr size_t AUX_OB = 96 * MiB, AUX_LSE = 128 * MiB;
__device__ __forceinline__ void phase_attn(const Frame& F, int bx) {
    const bf16* qkv = (const bf16*)(F.ws + WS_BIG); bf16* og = (bf16*)(F.ws + WS_AUX); float* lse = (float*)(F.ws + WS_AUX + AUX_LSE);
    constexpr int KLD = 136;
    LAS bf16* Ks = (LAS bf16*)F.lds; LAS bf16* Vs = Ks + 256 * KLD;
    const int lane = F.lane, w = F.wave, g4 = lane >> 4, l15 = lane & 15, qq = l15 >> 2, pp = lane & 3;
    u32x4 kc[4], vc[4];
    constexpr int NRUN = 768;
#define ATT_LOADBLK(KR, VR, nblk) do { _Pragma("unroll") for (int it = 0; it < 4; ++it) { const int idx = F.tid + 512 * it, c = idx >> 4, ch = idx & 15; int pos = 128 * (nblk) + c; pos = pos < 0 ? 0 : pos; \
            const unsigned so = (rowbase + (unsigned)pos * (unsigned)d + (unsigned)r) * (unsigned)ATT_IN + (unsigned)(g * 3072 + 1024 + h * 128 + ch * 8); KR[it] = *(const u32x4*)(qkv + so); VR[it] = *(const u32x4*)(qkv + so + 1024u); } } while (0)
#define ATT_STOREBLK(KR, VR, slot) do { _Pragma("unroll") for (int it = 0; it < 4; ++it) { const int idx = F.tid + 512 * it, c = idx >> 4, ch = idx & 15; \
            *(LAS u32x4*)(Ks + (128 * (slot) + c) * KLD + ch * 8) = KR[it]; *(LAS u32x4*)(Vs + (128 * (slot) + c) * KLD + ch * 8) = VR[it]; } } while (0)
    for (int R = bx; R < NRUN; R += F.G) {
        const int h = R & 7, sbr = R >> 3, g = sbr >> 5, rem = sbr & 31, b = rem >> 4, rr_ = rem & 15;
        const int dsh = 2 * g, d = 1 << dsh, nrs = 4 - dsh, r = rr_ >> nrs, n0 = 4 * (rr_ & ((1 << nrs) - 1)); const unsigned rowbase = (unsigned)b * SEQ;
        ATT_LOADBLK(kc, vc, n0 - 1); ATT_STOREBLK(kc, vc, (n0 - 1) & 1); ATT_LOADBLK(kc, vc, n0);
#pragma unroll 1
        for (int j = 0; j < 4; ++j) {
            const int n = n0 + j, cs = n & 1, ps = cs ^ 1;
            ATT_STOREBLK(kc, vc, cs);
            const int qi = 16 * w + l15; const unsigned qrow = rowbase + (unsigned)(128 * n + qi) * (unsigned)d + (unsigned)r;
            bf16x8 qf[4];
#pragma unroll
            for (int s = 0; s < 4; ++s) qf[s] = *(const bf16x8*)(qkv + (qrow * (unsigned)ATT_IN + (unsigned)(g * 3072 + h * 128 + 32 * s + 8 * g4)));
            __syncthreads();
            if (j < 3) { ATT_LOADBLK(kc, vc, n + 1); }
            __builtin_amdgcn_sched_barrier(0);
            const int ws0 = (16 * w < 96) ? 16 * w : 96;
#define ATT_PROW(c0) (((c0) < 128) ? (128 * ps + (c0)) : (128 * cs + (c0) - 128))
            f32x4 sacc[10];
            {
                bf16x8 kfa[4], kfb[4];
#pragma unroll
                for (int s = 0; s < 4; ++s) kfa[s] = row_frag(Ks, KLD, ATT_PROW(ws0), 32 * s, lane);
#pragma unroll
                for (int t = 0; t < 10; t += 2) {
#pragma unroll
                    for (int s = 0; s < 4; ++s) kfb[s] = row_frag(Ks, KLD, ATT_PROW(ws0 + 16 * (t + 1)), 32 * s, lane);
                    __builtin_amdgcn_sched_barrier(0);
                    sacc[t] = (f32x4){0.f, 0.f, 0.f, 0.f};
#pragma unroll
                    for (int s = 0; s < 4; ++s) sacc[t] = MFMA16(kfa[s], qf[s], sacc[t]);
                    if (t + 2 < 10) {
#pragma unroll
                        for (int s = 0; s < 4; ++s) kfa[s] = row_frag(Ks, KLD, ATT_PROW(ws0 + 16 * (t + 2)), 32 * s, lane); }
                    __builtin_amdgcn_sched_barrier(0);
                    sacc[t + 1] = (f32x4){0.f, 0.f, 0.f, 0.f};
#pragma unroll
                    for (int s = 0; s < 4; ++s) sacc[t + 1] = MFMA16(kfb[s], qf[s], sacc[t + 1]);
                }
            }
            const float slope = exp2f(-(float)(h + 1)) * (float)d;
            float mx = -INFINITY;
#pragma unroll
            for (int t = 0; t < 10; ++t)
#pragma unroll
                for (int i = 0; i < 4; ++i) { const int c = ws0 + 16 * t + 4 * g4 + i, step = 128 + qi - c;
                    const bool valid = (step >= 0) && (step <= 128) && (n > 0 || c >= 128);
                    const float v = valid ? sacc[t][i] - slope * (float)step : -INFINITY; sacc[t][i] = v; mx = fmaxf(mx, v); }
            mx = fmaxf(mx, shx(mx, 16, lane)); mx = fmaxf(mx, shx(mx, 32, lane));
            float lsum = 0.f;
#pragma unroll
            for (int t = 0; t < 10; ++t)
#pragma unroll
                for (int i = 0; i < 4; ++i) { const float pv = __expf(sacc[t][i] - mx); sacc[t][i] = pv; lsum += pv; }
            lsum += shx(lsum, 16, lane); lsum += shx(lsum, 32, lane);
            bf16x8 pf[5];
#pragma unroll
            for (int kt = 0; kt < 5; ++kt) pf[kt] = pack8(sacc[2 * kt], sacc[2 * kt + 1]);
            f32x4 o[8];
            {
                const LAS bf16* vl = Vs + (4 * g4 + qq) * KLD + 32 * pp;
                bf16x4 va[10], vcc[10];
#pragma unroll
                for (int q = 0; q < 10; ++q) va[q] = tr4(vl + ATT_PROW(ws0 + 16 * q) * KLD);
#pragma unroll
                for (int et = 0; et < 8; et += 2) {
#pragma unroll
                    for (int q = 0; q < 10; ++q) vcc[q] = tr4(vl + ATT_PROW(ws0 + 16 * q) * KLD + 4 * (et + 1));
                    __builtin_amdgcn_sched_barrier(0);
                    o[et] = (f32x4){0.f, 0.f, 0.f, 0.f};
#pragma unroll
                    for (int kt = 0; kt < 5; ++kt) o[et] = MFMA16(cat8(va[2 * kt], va[2 * kt + 1]), pf[kt], o[et]);
                    if (et + 2 < 8) {
#pragma unroll
                        for (int q = 0; q < 10; ++q) va[q] = tr4(vl + ATT_PROW(ws0 + 16 * q) * KLD + 4 * (et + 2)); }
                    __builtin_amdgcn_sched_barrier(0);
                    o[et + 1] = (f32x4){0.f, 0.f, 0.f, 0.f};
#pragma unroll
                    for (int kt = 0; kt < 5; ++kt) o[et + 1] = MFMA16(cat8(vcc[2 * kt], vcc[2 * kt + 1]), pf[kt], o[et + 1]);
                }
            }
#undef ATT_PROW
            const float inv = 1.0f / lsum;
            bf16* orow = og + ((size_t)g * T + qrow) * D + h * 128 + 32 * g4;
#pragma unroll
            for (int e2 = 0; e2 < 4; ++e2) *(u32x4*)(orow + 8 * e2) = pack_bf16x8(o[2 * e2] * inv, o[2 * e2 + 1] * inv);
            if (g4 == 0) lse[((size_t)g * T + qrow) * AH + h] = mx + __logf(lsum);
            __syncthreads();
        }
    }
#undef ATT_LOADBLK
#undef ATT_STOREBLK
}
__device__ __forceinline__ void phase_attn_combine(const Frame& F) {
    const bf16* og = (const bf16*)(F.ws + WS_AUX); const float* lse = (const float*)(F.ws + WS_AUX + AUX_LSE); bf16* ob = (bf16*)(F.ws + WS_AUX + AUX_OB);
    const int lane = F.lane, gw = F.vcu * NWAVES + F.wave, NGW = F.G * NWAVES, h = lane >> 3;
    for (int row = gw; row < T; row += NGW) {
        const float l0 = lse[((size_t)0 * T + row) * AH + h], l1 = lse[((size_t)1 * T + row) * AH + h], l2 = lse[((size_t)2 * T + row) * AH + h];
        const float m = fmaxf(l0, fmaxf(l1, l2)); float w0 = __expf(l0 - m), w1 = __expf(l1 - m), w2 = __expf(l2 - m); const float inv = 1.0f / (w0 + w1 + w2); w0 *= inv; w1 *= inv; w2 *= inv;
        float a[16];
#pragma unroll
        for (int j = 0; j < 16; ++j) a[j] = 0.f;
#pragma unroll
        for (int g = 0; g < 3; ++g) { const float wg = (g == 0) ? w0 : (g == 1 ? w1 : w2);
#pragma unroll
            for (int q = 0; q < 2; ++q) { const u32x4 s = *(const u32x4*)(og + ((size_t)g * T + row) * D + 16 * lane + 8 * q);
                a[8 * q + 0] += wg * bflo(s.x); a[8 * q + 1] += wg * bfhi(s.x); a[8 * q + 2] += wg * bflo(s.y); a[8 * q + 3] += wg * bfhi(s.y);
                a[8 * q + 4] += wg * bflo(s.z); a[8 * q + 5] += wg * bfhi(s.z); a[8 * q + 6] += wg * bflo(s.w); a[8 * q + 7] += wg * bfhi(s.w); } }
#pragma unroll
        for (int q = 0; q < 2; ++q) { u32x4 o; o.x = pk2(a[8 * q], a[8 * q + 1]); o.y = pk2(a[8 * q + 2], a[8 * q + 3]); o.z = pk2(a[8 * q + 4], a[8 * q + 5]); o.w = pk2(a[8 * q + 6], a[8 * q + 7]);
            *(u32x4*)(ob + (size_t)row * D + 16 * lane + 8 * q) = o; }
    }
}

constexpr size_t BIG_YRET = 192 * MiB;
__device__ __forceinline__ void phase_ret_u(const Frame& F) {
    const bf16* proj = (const bf16*)(F.ws + WS_BIG); bf16* St = (bf16*)(F.ws + WS_AUX);
    constexpr int LD = 264;
    LAS bf16* Kt = (LAS bf16*)F.lds; LAS bf16* Vt = Kt + 128 * LD;
    const int lane = F.lane, w = F.wave, g4 = lane >> 4, l15 = lane & 15, qq = l15 >> 2, pp = lane & 3;
    for (int u = F.vcu; u < 1024; u += F.G) {
        const int eh = u & 1, h = (u >> 1) & 3, n = (u >> 3) & 63, b = u >> 9;
        const size_t row0 = (size_t)b * SEQ + (size_t)n * RC;
#pragma unroll 4
        for (int it = 0; it < 8; ++it) { const int idx = F.tid + 512 * it, j = idx >> 5, ch = idx & 31;
            const bf16* src = proj + (row0 + j) * RET_IN;
            const u32x4 kv = *(const u32x4*)(src + 1024 + h * 256 + ch * 8), vv = *(const u32x4*)(src + 2048 + h * 512 + eh * 256 + ch * 8);
            *(LAS u32x4*)(Kt + j * LD + ch * 8) = kv; *(LAS u32x4*)(Vt + j * LD + ch * 8) = vv; }
        __syncthreads();
        f32x4 acc[16][2];
#pragma unroll
        for (int mt = 0; mt < 16; ++mt) { acc[mt][0] = (f32x4){0.f, 0.f, 0.f, 0.f}; acc[mt][1] = (f32x4){0.f, 0.f, 0.f, 0.f}; }
#pragma unroll
        for (int ks = 0; ks < 4; ++ks) {
            bf16x8 bfr[2];
#pragma unroll
            for (int nt = 0; nt < 2; ++nt) { const LAS bf16* a0 = Vt + (32 * ks + 8 * g4 + qq) * LD + 32 * w + 16 * nt + 4 * pp; bfr[nt] = cat8(tr4(a0), tr4(a0 + 4 * LD)); }
#pragma unroll
            for (int mt = 0; mt < 16; ++mt) { const LAS bf16* a0 = Kt + (32 * ks + 8 * g4 + qq) * LD + 128 * (mt >> 3) + 32 * pp + 4 * (mt & 7);
                const bf16x8 afr = cat8(tr4(a0), tr4(a0 + 4 * LD));
                acc[mt][0] = MFMA16(afr, bfr[0], acc[mt][0]); acc[mt][1] = MFMA16(afr, bfr[1], acc[mt][1]); }
        }
        bf16* outb = St + ((size_t)((b * RH + h) * RNC + n)) * (RDV * RDK);
#pragma unroll
        for (int nt = 0; nt < 2; ++nt) { bf16* orow = outb + (size_t)(eh * 256 + 32 * w + 16 * nt + l15) * RDK + 32 * g4;
#pragma unroll
            for (int mh = 0; mh < 2; ++mh)
#pragma unroll
                for (int q = 0; q < 4; ++q) *(u32x4*)(orow + 128 * mh + 8 * q) = pack_bf16x8(acc[mh * 8 + 2 * q][nt], acc[mh * 8 + 2 * q + 1][nt]); }
        __syncthreads();
    }
}
__device__ __forceinline__ void phase_ret_scan(const Frame& F) {
    bf16* St = (bf16*)(F.ws + WS_AUX);
    for (int gt = F.vcu * NTHREADS + F.tid; gt < 8 * 16384; gt += F.G * NTHREADS) {
        const int bh = gt >> 14, chunk = gt & 16383, h = bh & 3;
        const float g128 = exp2f(128.0f * log2f(1.0f - exp2f(-5.0f - (float)h)));
        bf16* base = St + (size_t)bh * RNC * (RDV * RDK) + (size_t)chunk * 8;
        float c[8];
#pragma unroll
        for (int j = 0; j < 8; ++j) c[j] = 0.f;
#pragma unroll 8
        for (int n = 0; n < RNC; ++n) { bf16* pn = base + (size_t)n * (RDV * RDK); const u32x4 uv = *(const u32x4*)pn;
            u32x4 o; o.x = pk2(c[0], c[1]); o.y = pk2(c[2], c[3]); o.z = pk2(c[4], c[5]); o.w = pk2(c[6], c[7]); *(u32x4*)pn = o;
            c[0] = g128 * (c[0] + bflo(uv.x)); c[1] = g128 * (c[1] + bfhi(uv.x)); c[2] = g128 * (c[2] + bflo(uv.y)); c[3] = g128 * (c[3] + bfhi(uv.y));
            c[4] = g128 * (c[4] + bflo(uv.z)); c[5] = g128 * (c[5] + bfhi(uv.z)); c[6] = g128 * (c[6] + bflo(uv.w)); c[7] = g128 * (c[7] + bfhi(uv.w)); }
    }
}
__device__ __forceinline__ void phase_ret_out(const Frame& F, KP p) {
    const bf16* proj = (const bf16*)(F.ws + WS_BIG); const bf16* St = (const bf16*)(F.ws + WS_AUX); bf16* yret = (bf16*)(F.ws + WS_BIG + BIG_YRET);
    const float* gng = gin(p, 4); const float* gnb = gin(p, 5);
    constexpr int LD = 264, VLD = 136;
    LAS bf16* Rs = (LAS bf16*)F.lds; LAS bf16* Vs = Rs + 128 * LD;
    const int lane = F.lane, w = F.wave, g4 = lane >> 4, l15 = lane & 15, qq = l15 >> 2, pp = lane & 3;
    for (int u = F.vcu; u < 512; u += F.G) {
        const int h = u & 3, n = (u >> 2) & 63, b = u >> 8;
        const size_t row0 = (size_t)b * SEQ + (size_t)n * RC;
#pragma unroll 4
        for (int it = 0; it < 8; ++it) { const int idx = F.tid + 512 * it, j = idx >> 5, ch = idx & 31;
            *(LAS u32x4*)(Rs + j * LD + ch * 8) = *(const u32x4*)(proj + (row0 + j) * RET_IN + 1024 + h * 256 + ch * 8); }
        const int irow = 16 * w + l15; const size_t qrow = row0 + irow;
        bf16x8 qf[8];
#pragma unroll
        for (int s = 0; s < 8; ++s) qf[s] = *(const bf16x8*)(proj + qrow * RET_IN + h * 256 + 32 * s + 8 * g4);
        __syncthreads();
        bf16x8 pf[4];
        { f32x4 sacc[8];
#pragma unroll
            for (int jt = 0; jt < 8; ++jt) { sacc[jt] = (f32x4){0.f, 0.f, 0.f, 0.f};
                if (jt <= w) {
#pragma unroll
                    for (int s = 0; s < 8; ++s) sacc[jt] = MFMA16(row_frag(Rs, LD, 16 * jt, 32 * s, lane), qf[s], sacc[jt]);
#pragma unroll
                    for (int i = 0; i < 4; ++i) if (16 * jt + 4 * g4 + i > irow) sacc[jt][i] = 0.f; } }
#pragma unroll
            for (int kt = 0; kt < 4; ++kt) pf[kt] = pack8(sacc[2 * kt], sacc[2 * kt + 1]); }
        __syncthreads();
        f32x4 acc[4][8];
        const bf16* Sn = St + ((size_t)((b * RH + h) * RNC + n)) * (RDV * RDK);
#pragma unroll
        for (int sl = 0; sl < 4; ++sl) {
#pragma unroll 4
            for (int it = 0; it < 4; ++it) { const int idx = F.tid + 512 * it, j = idx >> 4, ch = idx & 15;
                *(LAS u32x4*)(Vs + j * VLD + ch * 8) = *(const u32x4*)(proj + (row0 + j) * RET_IN + 2048 + h * 512 + sl * 128 + ch * 8); }
#pragma unroll 4
            for (int it = 0; it < 8; ++it) { const int idx = F.tid + 512 * it, e = idx >> 5, ch = idx & 31;
                *(LAS u32x4*)(Rs + e * LD + ch * 8) = *(const u32x4*)(Sn + (size_t)(sl * 128 + e) * RDK + ch * 8); }
            __syncthreads();
#pragma unroll
            for (int et = 0; et < 8; ++et) { f32x4 a = (f32x4){0.f, 0.f, 0.f, 0.f};
#pragma unroll
                for (int kt = 0; kt < 4; ++kt) if (2 * kt <= w) { const LAS bf16* a0 = Vs + (32 * kt + 4 * g4 + qq) * VLD + 32 * pp + 4 * et;
                    a = MFMA16(cat8(tr4(a0), tr4(a0 + 16 * VLD)), pf[kt], a); }
                const LAS bf16* srow = Rs + (32 * qq + 4 * et + pp) * LD + 8 * g4;
#pragma unroll
                for (int s = 0; s < 8; ++s) a = MFMA16(*(const LAS bf16x8*)(srow + 32 * s), qf[s], a);
                acc[sl][et] = a; }
            __syncthreads();
        }
        float s = 0.f;
#pragma unroll
        for (int sl = 0; sl < 4; ++sl)
#pragma unroll
            for (int et = 0; et < 8; ++et) s += (acc[sl][et][0] + acc[sl][et][1]) + (acc[sl][et][2] + acc[sl][et][3]);
        s += shx(s, 16, lane); s += shx(s, 32, lane);
        const float mean = s * (1.0f / RDV); float s2 = 0.f;
#pragma unroll
        for (int sl = 0; sl < 4; ++sl)
#pragma unroll
            for (int et = 0; et < 8; ++et) { acc[sl][et] = acc[sl][et] - mean; s2 += (acc[sl][et][0] * acc[sl][et][0] + acc[sl][et][1] * acc[sl][et][1]) + (acc[sl][et][2] * acc[sl][et][2] + acc[sl][et][3] * acc[sl][et][3]); }
        s2 += shx(s2, 16, lane); s2 += shx(s2, 32, lane);
        const float rstd = 1.0f / sqrtf(s2 * (1.0f / RDV) + LN_EPS);
#pragma unroll
        for (int sl = 0; sl < 4; ++sl) { const int c0 = h * RDV + sl * 128 + 32 * g4;
#pragma unroll
            for (int q = 0; q < 4; ++q) { const u32x4 gw = *(const u32x4*)(proj + qrow * RET_IN + 4096 + c0 + 8 * q);
                const f32x4 gg0 = *(const f32x4*)(gng + c0 + 8 * q), gg1 = *(const f32x4*)(gng + c0 + 8 * q + 4), gb0 = *(const f32x4*)(gnb + c0 + 8 * q), gb1 = *(const f32x4*)(gnb + c0 + 8 * q + 4);
                f32x4 y0 = acc[sl][2 * q] * rstd * gg0 + gb0, y1 = acc[sl][2 * q + 1] * rstd * gg1 + gb1;
                const float gv[8] = {bflo(gw.x), bfhi(gw.x), bflo(gw.y), bfhi(gw.y), bflo(gw.z), bfhi(gw.z), bflo(gw.w), bfhi(gw.w)};
#pragma unroll
                for (int j = 0; j < 4; ++j) { y0[j] *= gv[j] * fsig(gv[j]); y1[j] *= gv[4 + j] * fsig(gv[4 + j]); }
                *(u32x4*)(yret + qrow * RET_V + c0 + 8 * q) = pack_bf16x8(y0, y1); } }
    }
}

constexpr size_t AUX_S5E = 64 * MiB;
constexpr int S5L = 256, S5NC = SEQ / S5L;
__device__ __forceinline__ void cmul_add(float& rr, float& ri, float ar, float ai, float xr, float xi, float cr, float ci) { rr = ar * xr - ai * xi + cr; ri = ar * xi + ai * xr + ci; }
template <bool OUT>
__device__ __forceinline__ void phase_s5_scan(const Frame& F, KP p) {
    const bf16* X = (const bf16*)(F.ws + WS_XB); float* E = (float*)(F.ws + WS_AUX + AUX_S5E); bf16* ybuf = (bf16*)(F.ws + WS_AUX);
    const int lane = F.lane, w = F.wave, g4 = lane >> 4, l15 = lane & 15;
    LAS bf16* ut = (LAS bf16*)(F.lds + w * 12288);
    LAS bf16* Hb = (LAS bf16*)(F.lds + w * 12288 + 4096);
    constexpr int HLD = 136;
    const int gw = F.vcu * NWAVES + w, NGW = F.G * NWAVES;
    const int up16 = (lane - 16) << 2, up32 = (lane - 32) << 2, last16 = (48 + l15) << 2;
    for (int unit = gw; unit < BATCH * SG * S5NC; unit += NGW) {
        const int n = unit & (S5NC - 1), g = (unit >> 5) & 63, b = unit >> 11;
        float a1r[4], a1i[4], a4r[4], a4i[4], a8r[4], a8i[4], pwr[4], pwi[4];
        bf16x8 bfrag[8];
        const float dt = expf(gin(p, 14)[g]);
#pragma unroll
        for (int st = 0; st < 4; ++st) { const int ps = 16 * st + l15;
            const float are = gin(p, 7)[g * SP + ps], aim = gin(p, 8)[g * SP + ps];
            const float mag = expf(dt * are); const float abr = mag * cosf(dt * aim), abi = mag * sinf(dt * aim);
            const float den = are * are + aim * aim;
            const float fre = ((abr - 1.0f) * are + abi * aim) / den, fim = (abi * are - (abr - 1.0f) * aim) / den;
            a1r[st] = abr; a1i[st] = abi; { float t2r, t2i; cmul_add(t2r, t2i, abr, abi, abr, abi, 0.f, 0.f); cmul_add(a4r[st], a4i[st], t2r, t2i, t2r, t2i, 0.f, 0.f); }
            cmul_add(a8r[st], a8i[st], a4r[st], a4i[st], a4r[st], a4i[st], 0.f, 0.f);
            float qr = 1.f, qi = 0.f;
            if (g4 & 1) { qr = a4r[st]; qi = a4i[st]; }
            if (g4 & 2) { float tr, ti; cmul_add(tr, ti, qr, qi, a8r[st], a8i[st], 0.f, 0.f); qr = tr; qi = ti; }
            pwr[st] = qr; pwi[st] = qi;
            const float* br = gin(p, 9) + ((size_t)g * SP + ps) * SGC + 8 * (g4 & 1); const float* bi = gin(p, 10) + ((size_t)g * SP + ps) * SGC + 8 * (g4 & 1);
            const f32x4 r0 = *(const f32x4*)br, r1 = *(const f32x4*)(br + 4), i0 = *(const f32x4*)bi, i1 = *(const f32x4*)(bi + 4);
            const float z = (g4 < 2) ? 1.0f : 0.0f; const float fr2 = fre * z, fi2 = fim * z;
            bfrag[st] = pack8(r0 * fr2 - i0 * fi2, r1 * fr2 - i1 * fi2); bfrag[st + 4] = pack8(i0 * fr2 + r0 * fi2, i1 * fr2 + r1 * fi2);
        }
        float sr[4], si[4];
        float* Eu = E + ((size_t)(b * SG + g) * S5NC + n) * 128;
        bf16x8 cf[4]; f32x4 dsk = (f32x4){0.f, 0.f, 0.f, 0.f};
#pragma unroll
        for (int st = 0; st < 4; ++st) { sr[st] = 0.f; si[st] = 0.f; }
        if (OUT) {
#pragma unroll
            for (int st = 0; st < 4; ++st) { sr[st] = Eu[16 * st + l15]; si[st] = Eu[64 + 16 * st + l15]; }
#pragma unroll
            for (int s = 0; s < 4; ++s) { const float* cp = (s < 2 ? gin(p, 11) : gin(p, 12)) + ((size_t)g * SGC + l15) * SP + 32 * (s & 1) + 8 * g4; const float sg = s < 2 ? 1.0f : -1.0f;
                const f32x4 c0 = *(const f32x4*)cp * sg, c1 = *(const f32x4*)(cp + 4) * sg; cf[s] = pack8(c0, c1); }
            dsk = *(const f32x4*)(gin(p, 13) + g * SGC + 4 * g4); }
        const size_t tok0 = (size_t)b * SEQ + (size_t)n * S5L;
        u32x4 pre[2];
        { const bf16* src = X + (tok0 + lane) * D + g * SGC; pre[0] = *(const u32x4*)src; pre[1] = *(const u32x4*)(src + 8); }
        for (int sub = 0; sub < S5L / 64; ++sub) {
            *(LAS u32x4*)(ut + lane * 16) = pre[0]; *(LAS u32x4*)(ut + lane * 16 + 8) = pre[1];
            if (sub + 1 < S5L / 64) { const bf16* src = X + (tok0 + (sub + 1) * 64 + lane) * D + g * SGC; pre[0] = *(const u32x4*)src; pre[1] = *(const u32x4*)(src + 8); }
            LDS_WAIT(); asm volatile("" ::: "memory");
#pragma unroll (OUT ? 1 : 4)
            for (int blk = 0; blk < 4; ++blk) {
                u32x4 uw = *(const LAS u32x4*)(ut + (blk * 16 + l15) * 16 + 8 * (g4 & 1));
                if (g4 >= 2) uw = (u32x4){0u, 0u, 0u, 0u};
                const bf16x8 ufr = __builtin_bit_cast(bf16x8, uw);
                f32x4 dr[4], di[4];
#pragma unroll
                for (int st = 0; st < 4; ++st) { dr[st] = MFMA16(ufr, bfrag[st], ((f32x4){0.f, 0.f, 0.f, 0.f})); di[st] = MFMA16(ufr, bfrag[st + 4], ((f32x4){0.f, 0.f, 0.f, 0.f})); }
                float vr[4], vi[4];
#pragma unroll
                for (int st = 0; st < 4; ++st) {
                    float hr = 0.f, hi = 0.f;
#pragma unroll
                    for (int i = 0; i < 4; ++i) { float nr, ni; cmul_add(nr, ni, a1r[st], a1i[st], hr, hi, dr[st][i], di[st][i]); hr = nr; hi = ni; dr[st][i] = hr; di[st][i] = hi; }
                    vr[st] = hr; vi[st] = hi; }
#define BPF(idx, v) __builtin_bit_cast(float, __builtin_amdgcn_ds_bpermute((idx), __builtin_bit_cast(int, (v))))
                { float xr[4], xi[4];
#pragma unroll
                  for (int st = 0; st < 4; ++st) { xr[st] = BPF(up16, vr[st]); xi[st] = BPF(up16, vi[st]); }
#pragma unroll
                  for (int st = 0; st < 4; ++st) { float tr, ti; cmul_add(tr, ti, a4r[st], a4i[st], xr[st], xi[st], vr[st], vi[st]); if (g4 >= 1) { vr[st] = tr; vi[st] = ti; } }
#pragma unroll
                  for (int st = 0; st < 4; ++st) { xr[st] = BPF(up32, vr[st]); xi[st] = BPF(up32, vi[st]); }
#pragma unroll
                  for (int st = 0; st < 4; ++st) { float tr, ti; cmul_add(tr, ti, a8r[st], a8i[st], xr[st], xi[st], vr[st], vi[st]); if (g4 >= 2) { vr[st] = tr; vi[st] = ti; } } }
                float er[4], ei[4], lr[4], li[4];
#pragma unroll
                for (int st = 0; st < 4; ++st) { if (OUT) { er[st] = BPF(up16, vr[st]); ei[st] = BPF(up16, vi[st]); } else { er[st] = 0.f; ei[st] = 0.f; } lr[st] = BPF(last16, vr[st]); li[st] = BPF(last16, vi[st]); }
#undef BPF
#pragma unroll
                for (int st = 0; st < 4; ++st) {
                    if (g4 == 0) { er[st] = 0.f; ei[st] = 0.f; }
                    if (OUT) { float s0r, s0i; cmul_add(s0r, s0i, pwr[st], pwi[st], sr[st], si[st], er[st], ei[st]);
#pragma unroll
                        for (int i = 0; i < 4; ++i) { float tr, ti; cmul_add(tr, ti, a1r[st], a1i[st], s0r, s0i, 0.f, 0.f); s0r = tr; s0i = ti; dr[st][i] += s0r; di[st][i] += s0i; } }
                    { float a16r, a16i; cmul_add(a16r, a16i, a8r[st], a8i[st], a8r[st], a8i[st], 0.f, 0.f); float tr, ti; cmul_add(tr, ti, a16r, a16i, sr[st], si[st], lr[st], li[st]); sr[st] = tr; si[st] = ti; }
                    if (OUT) {
#pragma unroll
                        for (int i = 0; i < 4; ++i) { const unsigned hw = pk2(dr[st][i], di[st][i]); Hb[(4 * g4 + i) * HLD + 16 * st + l15] = (bf16)hw; Hb[(4 * g4 + i) * HLD + 64 + 16 * st + l15] = (bf16)(hw >> 16); } }
                }
                if (OUT) {
                    LDS_WAIT(); asm volatile("" ::: "memory");
                    f32x4 ya = (f32x4){0.f, 0.f, 0.f, 0.f};
#pragma unroll
                    for (int s = 0; s < 4; ++s) ya = MFMA16(cf[s], row_frag(Hb, HLD, 0, 32 * s, lane), ya);
                    const u32x2 u2 = *(const LAS u32x2*)(ut + (blk * 16 + l15) * 16 + 4 * g4);
                    const f32x4 u4 = (f32x4){bflo(u2.x), bfhi(u2.x), bflo(u2.y), bfhi(u2.y)};
                    f32x4 y = ya + dsk * u4;
#pragma unroll
                    for (int j = 0; j < 4; ++j) { const float v = y[j]; y[j] = v * fsig(1.5957691216057308f * (v + 0.044715f * v * v * v)); }
                    u32x2 o; o.x = pk2(y[0], y[1]); o.y = pk2(y[2], y[3]);
                    *(u32x2*)(ybuf + (tok0 + sub * 64 + blk * 16 + l15) * D + g * SGC + 4 * g4) = o;
                    asm volatile("" ::: "memory"); }
            }
            LDS_WAIT(); asm volatile("" ::: "memory");
        }
        if (!OUT && g4 == 0) {
#pragma unroll
            for (int st = 0; st < 4; ++st) { Eu[16 * st + l15] = sr[st]; Eu[64 + 16 * st + l15] = si[st]; } }
    }
}
__device__ __forceinline__ void phase_s5_carry(const Frame& F, KP p) {
    float* E = (float*)(F.ws + WS_AUX + AUX_S5E);
    for (int gt = F.vcu * NTHREADS + F.tid; gt < BATCH * SG * SP; gt += F.G * NTHREADS) {
        const int pl = gt & 63, bg = gt >> 6, g = bg & 63;
        const float dt = expf(gin(p, 14)[g]); const float are = gin(p, 7)[g * SP + pl], aim = gin(p, 8)[g * SP + pl];
        const float mag = expf(dt * are); float ar = mag * cosf(dt * aim), ai = mag * sinf(dt * aim);
#pragma unroll
        for (int q = 0; q < 8; ++q) { const float nr = ar * ar - ai * ai, ni = 2.0f * ar * ai; ar = nr; ai = ni; }
        float cr = 0.f, ci = 0.f;
        for (int n = 0; n < S5NC; ++n) { float* Eu = E + ((size_t)bg * S5NC + n) * 128; const float er = Eu[pl], ei = Eu[64 + pl];
            Eu[pl] = cr; Eu[64 + pl] = ci;
            const float nr = ar * cr - ai * ci + er, ni = ar * ci + ai * cr + ei; cr = nr; ci = ni; }
    }
}

constexpr int NPHASES = 34;
#ifndef PROBE_DRY14
#define PROBE_DRY14 0
#endif
#ifndef PROBE_DRY17
#define PROBE_DRY17 0
#endif
#ifndef PH_MASK
#define PH_MASK 0xFFFFFFFFu
#endif
#define PHT(t) ((PH_MASK >> (t)) & 1u)
constexpr int PLAN_OFF = 64;
__device__ __forceinline__ void moe_plan(const Frame& F, int layer) {
    volatile LAS int* tstart = (volatile LAS int*)(F.MISC + PLAN_OFF); volatile LAS int* cnts = tstart + 72;
    __syncthreads();
    if (F.wave == 0) {
        const unsigned* cnt = (const unsigned*)(F.ws + WS_CTL) + CW_CNT + layer * NE * 64;
        const int c = (int)__hip_atomic_load(cnt + F.lane * 64, __ATOMIC_RELAXED, __HIP_MEMORY_SCOPE_AGENT);
        int v = (c + 255) >> 8;
#pragma unroll
        for (int o = 1; o < 64; o <<= 1) { const int nb = __builtin_amdgcn_ds_bpermute((F.lane - o) << 2, v); if (F.lane >= o) v += nb; }
        tstart[F.lane + 1] = v; cnts[F.lane] = c;
        if (F.lane == 0) tstart[0] = 0;
        if (F.lane == 63) { tstart[65] = v + T / 256; cnts[64] = T; }
    }
    __syncthreads();
}
template <bool GATH> struct MoeSched2 {
    static constexpr bool GATHER = GATH, UNIFORMIZE = true, FP8 = true;
    static constexpr int ncol = GATH ? 2 : 4, K = GATH ? D / 2 : ED / 2;
    const volatile LAS int* tstart; const volatile LAS int* cnts; int ntiles, G, c, lane;
    const char* Abase; const char* Wbase; const int* lists;
    __device__ __forceinline__ bool next(int i, pg8::UnitG& u) const {
        const int nwg = ntiles * ncol; const long L = (long)i * G + c; if (L >= nwg) return false;
        int wgid = (int)L; { const int q = nwg / 8, r = nwg % 8, xcd = wgid % 8, off = wgid / 8; wgid = (xcd < r ? xcd * (q + 1) : r * (q + 1) + (xcd - r) * q) + off; }
        const int tile = wgid / ncol, pn = wgid % ncol;
        int ln; { unsigned o2 = ~0u; asm volatile("" : "+s"(o2)); ln = (int)__builtin_amdgcn_mbcnt_hi(o2, __builtin_amdgcn_mbcnt_lo(o2, 0u)); }
        const int ta = tstart[ln], tb = tstart[ln + 1];
        const unsigned long long mm = __ballot(ta <= tile && tile < tb);
        const int e = mm ? (int)__builtin_ctzll(mm) : 64;
        const int ts = __builtin_amdgcn_readfirstlane((int)tstart[e]), ce = __builtin_amdgcn_readfirstlane((int)cnts[e]);
        const int lt = tile - ts; int valid = ce - lt * 256; valid = valid > 256 ? 256 : valid;
        u.gshift = 0; u.aux = e;
        if (GATH) {
            u.B = Wbase + (size_t)e * WMOE_E_BYTES + (size_t)pn * 256 * K * 2;
            if (e < 64) { u.A = Abase; u.gidx = lists + (size_t)e * T + lt * 256; u.gcnt = valid; }
            else { u.A = Abase + (size_t)lt * 256 * K * 2; u.gidx = nullptr; u.gcnt = 0; }
            u.row0 = tile * 256; u.col0 = pn * 128;
        } else {
            u.B = Wbase + (size_t)e * WMOE_E_BYTES + (size_t)512 * 1024 * 2 + (size_t)pn * 256 * K * 2;
            u.A = Abase + (size_t)tile * 256 * K * 2; u.gidx = nullptr; u.gcnt = valid;
            u.row0 = tile * 256; u.col0 = pn * 256;
        }
        return true;
    }
};
__device__ __forceinline__ void phase_load_x(const Frame& F, KP p) {
    const float* xin = gin(p, 0); bf16* XB = (bf16*)(F.ws + WS_XB);
    for (size_t i = (size_t)F.vcu * NTHREADS + F.tid; i < (size_t)T * D / 8; i += (size_t)F.G * NTHREADS) {
        const f32x4 a = *(const f32x4*)(xin + i * 8), b = *(const f32x4*)(xin + i * 8 + 4);
        *(u32x4*)(XB + i * 8) = pack_bf16x8(a, b);
        u32x2 q8; q8.x = pk4_fp8(a[0], a[1], a[2], a[3]); q8.y = pk4_fp8(b[0], b[1], b[2], b[3]); *(u32x2*)((unsigned char*)(F.ws + WS_X) + i * 8) = q8; }
}

__global__ void __launch_bounds__(NTHREADS, 2) fwd_kernel(Params p_unused) {
    KP p0 = (KP)__builtin_amdgcn_kernarg_segment_ptr();
    extern __shared__ __attribute__((aligned(16))) unsigned char lds_raw[];
    Frame F0;
    F0.lds = (LAS unsigned char*)lds_raw; F0.MISC = (volatile LAS unsigned*)(F0.lds + MISC_OFF);
    F0.tid = threadIdx.x; F0.lane = F0.tid & 63; F0.wave = __builtin_amdgcn_readfirstlane(F0.tid >> 6);
    F0.G = gridDim.x; { const int bq = blockIdx.x; F0.vcu = (F0.G % 8 == 0) ? (bq % 8) * (F0.G / 8) + bq / 8 : bq; }
    F0.ws = p0->ws;
    const int bx0 = blockIdx.x;
    for (int u = F0.tid; u < (LDS_BYTES - MISC_OFF) / 4; u += NTHREADS) ((LAS unsigned*)(F0.lds + MISC_OFF))[u] = 0u;
    __syncthreads();
    XcdBarrier bar; bar.bar = (unsigned*)(p0->ws + WS_CTL) + CW_BAR; bar.x = 0; bar.st = nullptr;
    const int use_bar = p0->use_bar;
    if (use_bar) bar = xcd_barrier_post((unsigned*)(p0->ws + WS_CTL) + CW_BAR, F0.MISC + 8);
    const int lo = p0->ph_lo, hi = p0->ph_hi;
#define PHASE_BEGIN Frame F = F0; KP p = p0; { unsigned ones_ = ~0u; asm volatile("" : "+s"(ones_)); F.lane = (int)__builtin_amdgcn_mbcnt_hi(ones_, __builtin_amdgcn_mbcnt_lo(ones_, 0u)); } asm volatile("" : "+v"(F.lane)); F.tid = F.wave * 64 + F.lane; asm volatile("" : "+v"(F.tid));   GAS unsigned char* wsg_ = (GAS unsigned char*)F0.ws; asm volatile("" : "+s"(F.wave), "+s"(F.vcu), "+s"(F.G), "+s"(wsg_), "+s"(p)); \
    F.ws = (unsigned char*)wsg_; int bx = bx0; asm volatile("" : "+s"(bx)); unsigned char* ws = F.ws; (void)ws; (void)bx;
#pragma unroll 1
    for (int ph = lo; ph < hi; ++ph) {
        int layer = 0, type = 0;
        if (ph > 0) { layer = ph >= 26 ? 3 : (ph >= 18 ? 2 : (ph >= 9 ? 1 : 0)); const int q = ph - (layer == 3 ? 26 : (layer == 2 ? 18 : (layer == 1 ? 9 : 1))); const int kind = layer % 3;
            if (kind == 0) type = q < 4 ? 1 + q : 14 + (q - 4); else if (kind == 1) type = q < 5 ? 5 + q : 14 + (q - 5); else type = q < 4 ? 10 + q : 14 + (q - 4); }
        const int j = layer / 3;
#ifdef REPEAT_MASK
        const int nrep = ((REPEAT_MASK >> type) & 1u) ? 2 : 1;
#else
        const int nrep = 1;
#endif
#pragma unroll 1
        for (int rep = 0; rep < nrep; ++rep) {
        if (rep > 0 && use_bar) xcd_barrier(bar);
        if (PHT(0) && type == 0) { PHASE_BEGIN; phase_conv_mixers(F, p); phase_conv_moe(F, p, 0); phase_load_x(F, p); }
        else if (PHT(1) && type == 1) { PHASE_BEGIN; DenseSched8 S; S.init(ws + WS_X, ws + WS_ATT_IN_T + (size_t)j * ATT_IN * D, T, ATT_IN, D / 2, F.G, bx); EpiStoreBf16 E{(bf16*)(ws + WS_BIG), ATT_IN, WUP_INV, 0.08838834764831845f};
            pg8::gemm_phase(F.lds, F.tid, D / 2, S, E); }
        else if (PHT(2) && type == 2) { PHASE_BEGIN; phase_attn(F, bx); }
        else if (PHT(3) && type == 3) { PHASE_BEGIN; phase_attn_combine(F); }
        else if (PHT(4) && type == 4) { PHASE_BEGIN; DenseSched S; S.init(ws + WS_AUX + AUX_OB, ws + WS_ATT_OUT_T + (size_t)j * D * D * 2, T, D, D, F.G, bx); EpiResid E{(const bf16*)(ws + WS_XB), (bf16*)(ws + WS_Y), 1.0f};
            pg8::gemm_phase(F.lds, F.tid, D, S, E); }
        else if (PHT(5) && type == 5) { PHASE_BEGIN; DenseSched8 S; S.init(ws + WS_X, ws + WS_RET_IN_T, T, RET_IN, D / 2, F.G, bx); EpiRetIn E{(bf16*)(ws + WS_BIG), RET_IN};
            pg8::gemm_phase(F.lds, F.tid, D / 2, S, E); }
        else if (PHT(6) && type == 6) { PHASE_BEGIN; phase_ret_u(F); }
        else if (PHT(7) && type == 7) { PHASE_BEGIN; phase_ret_scan(F); }
        else if (PHT(8) && type == 8) { PHASE_BEGIN; phase_ret_out(F, p); }
        else if (PHT(9) && type == 9) { PHASE_BEGIN; DenseSched S; S.init(ws + WS_BIG + BIG_YRET, ws + WS_RET_OUT_T, T, D, RET_V, F.G, bx); EpiResid E{(const bf16*)(ws + WS_XB), (bf16*)(ws + WS_Y), 1.0f};
            pg8::gemm_phase(F.lds, F.tid, RET_V, S, E); }
        else if (PHT(10) && type == 10) { PHASE_BEGIN; phase_s5_scan<false>(F, p); }
        else if (PHT(11) && type == 11) { PHASE_BEGIN; phase_s5_carry(F, p); }
        else if (PHT(12) && type == 12) { PHASE_BEGIN; phase_s5_scan<true>(F, p); }
        else if (PHT(13) && type == 13) { PHASE_BEGIN; DenseSched S; S.init(ws + WS_AUX, ws + WS_GLU_T, T, 2 * D, D, F.G, bx); EpiGluResid E{(const bf16*)(ws + WS_XB), (bf16*)(ws + WS_Y)};
            pg8::gemm_phase(F.lds, F.tid, D, S, E); }
        else if (PHT(14) && type == 14) { PHASE_BEGIN; phase_lnr(F, p, layer, PROBE_DRY14 && true); if (PROBE_DRY14) { if (use_bar) xcd_barrier(bar); phase_lnr(F, p, layer, false); } }
        else if (PHT(15) && type == 15) { PHASE_BEGIN; moe_plan(F, layer);
            MoeSched2<true> S; S.tstart = (const volatile LAS int*)(F.MISC + PLAN_OFF); S.cnts = S.tstart + 72; S.ntiles = __builtin_amdgcn_readfirstlane((int)S.tstart[65]); S.G = F.G; S.c = bx; S.lane = F.lane;
            S.Abase = (const char*)(ws + WS_X); S.Wbase = (const char*)(ws + WS_WMOE); S.lists = (const int*)(ws + WS_LIST);
            EpiMoeUp E{(unsigned char*)(ws + WS_H)};
            pg8::gemm_phase(F.lds, F.tid, D / 2, S, E); }
        else if (PHT(16) && type == 16) { PHASE_BEGIN; moe_plan(F, layer);
            { MoeSched2<false> S; S.tstart = (const volatile LAS int*)(F.MISC + PLAN_OFF); S.cnts = S.tstart + 72; S.ntiles = __builtin_amdgcn_readfirstlane((int)S.tstart[64]); S.G = F.G; S.c = bx; S.lane = F.lane;
              S.Abase = (const char*)(ws + WS_H); S.Wbase = (const char*)(ws + WS_WMOE); S.lists = (const int*)(ws + WS_LIST);
              EpiStoreFp8 E{(unsigned char*)(ws + WS_BIG), D};
              pg8::gemm_phase(F.lds, F.tid, ED / 2, S, E); }
            { const int sh0 = __builtin_amdgcn_readfirstlane((int)((const volatile LAS int*)(F.MISC + PLAN_OFF))[64]);
              DenseSched8 S; S.init(ws + WS_H + (size_t)sh0 * 256 * ED, ws + WS_WMOE + (size_t)64 * WMOE_E_BYTES + (size_t)512 * 1024 * 2, T, D, ED / 2, F.G, bx); EpiResid8 E{(const bf16*)(ws + WS_XB), (bf16*)(ws + WS_Y), 1.0f / (H_SCALE * WUP_SCALE)};
              int tid2; { unsigned o2 = ~0u; asm volatile("" : "+s"(o2)); tid2 = F.wave * 64 + (int)__builtin_amdgcn_mbcnt_hi(o2, __builtin_amdgcn_mbcnt_lo(o2, 0u)); }
              pg8::gemm_phase(F.lds, tid2, ED / 2, S, E); } }
        else if (PHT(17) && type == 17) { PHASE_BEGIN; moe_plan(F, layer); if (PROBE_DRY17) { phase_combine(F, p, layer, true); if (use_bar) xcd_barrier(bar); } phase_combine(F, p, layer); if (layer + 1 < DEPTH) phase_conv_moe(F, p, layer + 1); }
        }
        if (use_bar && ph + 1 < hi) xcd_barrier(bar);
    }
}

#ifndef MK_PER_PHASE
#define MK_PER_PHASE 0
#endif
extern "C" void kernel_launch(void* const* d_in, const int* in_sizes, int n_in, void* d_out, int out_size, void* d_ws, size_t ws_size, hipStream_t stream) {
    static int grid = 0;
    if (grid == 0) {
        if (n_in != 26 || in_sizes[0] != T * D || out_size != T * D || ws_size < WS_END) { fprintf(stderr, "kernel_launch: unexpected shapes / workspace (n_in %d, in0 %d, out %d, ws %zu < %zu)\n", n_in, n_in > 0 ? in_sizes[0] : -1, out_size, ws_size, (size_t)WS_END); grid = -1; return; }
        int dev = 0, cus = 0, per_cu = 0;
        if (hipGetDevice(&dev) != hipSuccess || hipDeviceGetAttribute(&cus, hipDeviceAttributeMultiprocessorCount, dev) != hipSuccess) { grid = -1; return; }
        if (hipFuncSetAttribute((const void*)fwd_kernel, hipFuncAttributeMaxDynamicSharedMemorySize, LDS_BYTES) != hipSuccess) { fprintf(stderr, "kernel_launch: hipFuncSetAttribute failed\n"); grid = -1; return; }
        if (hipOccupancyMaxActiveBlocksPerMultiprocessor(&per_cu, (const void*)fwd_kernel, NTHREADS, LDS_BYTES) != hipSuccess || per_cu < 1) { fprintf(stderr, "kernel_launch: occupancy query says %d blocks per CU\n", per_cu); per_cu = 1; }
        (void)hipGetLastError();
        grid = cus;
    }
    if (grid < 0) return;
    (void)hipMemsetAsync((char*)d_ws + WS_CTL, 0, CTL_ZERO_BYTES, stream);
    Params p{};
    for (int i = 0; i < 26; ++i) p.in[i] = (const float*)d_in[i];
    p.out = (float*)d_out; p.ws = (unsigned char*)d_ws;
#if MK_PER_PHASE
    for (int k = 0; k < NPHASES; ++k) { p.ph_lo = k; p.ph_hi = k + 1; p.use_bar = 0; hipLaunchKernelGGL(fwd_kernel, dim3(grid), dim3(NTHREADS), LDS_BYTES, stream, p); }
#else
    p.ph_lo = 0; p.ph_hi = NPHASES; p.use_bar = 1;
    hipLaunchKernelGGL(fwd_kernel, dim3(grid), dim3(NTHREADS), LDS_BYTES, stream, p);
#endif
}
```

```cpp
#include <hip/hip_runtime.h>
#include <cstdio>
#include <cstdint>

#define LAS __attribute__((address_space(3)))
#define GAS __attribute__((address_space(1)))
typedef unsigned short bf16;
typedef short bf16x8 __attribute__((ext_vector_type(8)));
typedef short bf16x4 __attribute__((ext_vector_type(4)));
typedef float f32x4 __attribute__((ext_vector_type(4)));
typedef float f32x2 __attribute__((ext_vector_type(2)));
typedef unsigned u32x4 __attribute__((ext_vector_type(4)));
typedef unsigned u32x2 __attribute__((ext_vector_type(2)));
typedef GAS unsigned gu32;

constexpr int D = 1024, BATCH = 2, SEQ = 8192, T = BATCH * SEQ, DEPTH = 4;
constexpr int AH = 8, AHD = 128, ATT_IN = 9216;
constexpr int RH = 4, RDK = 256, RDV = 512, RET_IN = 6144, RET_V = 2048, RC = 128, RNC = SEQ / RC;
constexpr int SG = 64, SGC = 16, SP = 64;
constexpr int NE = 64, TOPK = 8, NEG = 8, ED = 256, NSLOT = 9;
constexpr float LN_EPS = 1e-5f;
constexpr float ALPHA = 1.6817928305074292f;
constexpr int NWAVES = 8, NTHREADS = 512;

__device__ __forceinline__ unsigned f2bf(float f) { unsigned u = __builtin_bit_cast(unsigned, f); return (u + 0x7fffu + ((u >> 16) & 1u)) >> 16; }
__device__ __forceinline__ unsigned pk2(float lo, float hi) { unsigned r; asm("s_nop 1\n\tv_cvt_pk_bf16_f32 %0, %1, %2" : "=v"(r) : "v"(lo), "v"(hi)); return r; }
__device__ __forceinline__ unsigned pk2sw(float lo, float hi) { return f2bf(lo) | (f2bf(hi) << 16); }
__device__ __forceinline__ unsigned pk2hw(float lo, float hi) { unsigned r; asm volatile("v_cvt_pk_bf16_f32 %0, %1, %2" : "=v"(r) : "v"(lo), "v"(hi)); return r; }
__device__ __forceinline__ float bf2f(unsigned b) { return __builtin_bit_cast(float, b << 16); }
__device__ __forceinline__ float bflo(unsigned w) { return __builtin_bit_cast(float, w << 16); }
__device__ __forceinline__ float bfhi(unsigned w) { return __builtin_bit_cast(float, w & 0xffff0000u); }
__device__ __forceinline__ float shx(float v, int m, int lane) { return __builtin_bit_cast(float, __builtin_amdgcn_ds_bpermute((lane ^ m) << 2, __builtin_bit_cast(int, v))); }
__device__ __forceinline__ int shx_i(int v, int m, int lane) { return __builtin_amdgcn_ds_bpermute((lane ^ m) << 2, v); }
__device__ __forceinline__ float rdl(float v, int src) { return __builtin_bit_cast(float, __builtin_amdgcn_readlane(__builtin_bit_cast(int, v), src)); }
template <int CTRL, int RM = 0xf, int BM = 0xf> __device__ __forceinline__ float dpp0(float v) { return __builtin_bit_cast(float, __builtin_amdgcn_update_dpp(0, __builtin_bit_cast(int, v), CTRL, RM, BM, true)); }
template <int CTRL, int RM = 0xf, int BM = 0xf> __device__ __forceinline__ float dppo(float old, float v) { return __builtin_bit_cast(float, __builtin_amdgcn_update_dpp(__builtin_bit_cast(int, old), __builtin_bit_cast(int, v), CTRL, RM, BM, false)); }
__device__ __forceinline__ float wave_sum(float v, int lane) {
    (void)lane;
    v += dpp0<0x111>(v); v += dpp0<0x112>(v); v += dpp0<0x114>(v); v += dpp0<0x118>(v);
    v += dpp0<0x142, 0xa>(v);
    v += dpp0<0x143, 0xc>(v);
    return rdl(v, 63);
}
__device__ __forceinline__ float max8(float v) {
    v = fmaxf(v, dppo<0xb1>(v, v)); v = fmaxf(v, dppo<0x4e>(v, v)); v = fmaxf(v, dppo<0x141>(v, v)); return v;
}
__device__ __forceinline__ float fsig(float x) { return __builtin_amdgcn_rcpf(1.0f + __expf(-x)); }
#define LDS_WAIT() asm volatile("s_waitcnt lgkmcnt(0)" ::: "memory")
#define VM_WAIT() asm volatile("s_waitcnt vmcnt(0)" ::: "memory")
__device__ __forceinline__ const char* rfl_ptr(const char* p) {
    unsigned long long v = (unsigned long long)p; unsigned lo = __builtin_amdgcn_readfirstlane((unsigned)v), hi = __builtin_amdgcn_readfirstlane((unsigned)(v >> 32));
    return (const char*)(((unsigned long long)hi << 32) | lo);
}
__device__ __forceinline__ bf16x8 row_frag(const LAS bf16* base, int ld, int row0, int col0, int lane) {
    return *(const LAS bf16x8*)(base + (row0 + (lane & 15)) * ld + col0 + 8 * (lane >> 4));
}
__device__ __forceinline__ bf16x4 tr4(const LAS bf16* addr) { return __builtin_amdgcn_ds_read_tr16_b64_v4i16((LAS bf16x4*)addr); }
__device__ __forceinline__ bf16x8 cat8(bf16x4 a, bf16x4 b) { bf16x8 r; r[0] = a[0]; r[1] = a[1]; r[2] = a[2]; r[3] = a[3]; r[4] = b[0]; r[5] = b[1]; r[6] = b[2]; r[7] = b[3]; return r; }
#define MFMA16(a, b, c) __builtin_amdgcn_mfma_f32_16x16x32_bf16((a), (b), (c), 0, 0, 0)
__device__ __forceinline__ bf16x8 pack8(f32x4 a, f32x4 b) {
    u32x4 w; w.x = pk2(a[0], a[1]); w.y = pk2(a[2], a[3]); w.z = pk2(b[0], b[1]); w.w = pk2(b[2], b[3]); return __builtin_bit_cast(bf16x8, w);
}

namespace pg8 {
typedef int v4i_t __attribute__((ext_vector_type(4)));
typedef int v8i_t __attribute__((ext_vector_type(8)));
constexpr int BM = 256, BK = 64, HALF = 128, HTB = HALF * BK * 2, STAGE_BYTES = 8 * HTB;
__device__ __forceinline__ int lds_byte(int r, int c) { const int st = (r >> 4) * 2 + (c >> 5), rr = r & 15, cc = c & 31, ob = rr * 64 + cc * 2; return st * 1024 + (ob ^ (((ob >> 9) & 1) << 5)); }
__device__ __forceinline__ void stage_rc(int b, int& R, int& C) { const int st = b / 1024, sb = b % 1024, swz = sb ^ (((sb >> 9) & 1) << 5); R = (st >> 1) * 16 + swz / 64; C = (st & 1) * 32 + (swz % 64) / 2; }
__device__ __forceinline__ int perm32(int rho) { const int n = rho >> 4, i = rho & 15; return 8 * (i >> 2) + 4 * n + (i & 3); }

struct UnitG {
    const char* A;
    const char* B;
    const int* gidx;
    int gcnt, gshift;
    int row0, col0;
    int aux;
};

__device__ __forceinline__ void uniformize(UnitG& u) { u.A = rfl_ptr(u.A); u.B = rfl_ptr(u.B); u.gidx = (const int*)rfl_ptr((const char*)u.gidx); u.gcnt = __builtin_amdgcn_readfirstlane(u.gcnt); u.gshift = __builtin_amdgcn_readfirstlane(u.gshift);
    u.row0 = __builtin_amdgcn_readfirstlane(u.row0); u.col0 = __builtin_amdgcn_readfirstlane(u.col0); u.aux = __builtin_amdgcn_readfirstlane(u.aux); }
template <class Epi, class Sched>
__device__ __forceinline__ void gemm_phase(LAS unsigned char* lds, const int tid, const int K, const Sched& S, const Epi& E) {
    constexpr bool F8 = Sched::FP8;
    constexpr bool GATHER = Sched::GATHER;
    const int wid = __builtin_amdgcn_readfirstlane(tid >> 6), lane = tid & 63, wr = wid >> 2, wc = wid & 3, fr = lane & 15, fq = lane >> 4;
    int nt = K / BK; asm volatile("" : "+s"(nt));
    constexpr bool P16 = Epi::PERM16;
    unsigned voffB[2], voffB1[2], vA[2][2];
#pragma unroll
    for (int i = 0; i < 2; ++i) { int R, C; stage_rc(tid * 16 + i * 8192, R, C); const int Rb = Epi::PERM ? ((R & ~31) + perm32(R & 31)) : R; voffB[i] = (unsigned)(Rb * K + C) * 2u; voffB1[i] = voffB[i]; vA[0][i] = (unsigned)(R * K + C) * 2u; vA[1][i] = vA[0][i];
        if constexpr (P16) { const int x = R & 31, src = 64 * (R >> 5) + 16 * ((x >> 2) & 3) + 4 * (x >> 4) + (x & 3); voffB[i] = (unsigned)(src * K + C) * 2u; voffB1[i] = (unsigned)((src + 8) * K + C) * 2u; } }
    const size_t kstep = (size_t)(BK * 2);
    const size_t hstep = (size_t)HALF * K * 2;
    const size_t hstepB = P16 ? 0 : hstep;
    const size_t hstepA = GATHER ? 0 : hstep;
    const unsigned ldsw = (unsigned)wid * 1024u;
    const int aoff = F8 ? lds_byte(wr * 64 + fr, fq * 16) : lds_byte(wr * 64 + fr, fq * 8), boff = F8 ? lds_byte(wc * 32 + fr, fq * 16) : lds_byte(wc * 32 + fr, fq * 8);
    LAS u32x4* park = (LAS u32x4*)(lds + STAGE_BYTES) + tid;
#define PG8_SA(b, h) (((b) * 2 + (h)) * HTB)
#define PG8_SB(b, h) ((4 + (b) * 2 + (h)) * HTB)
#define PG8_STAGE(bufoff, gbase, voff) do { _Pragma("unroll") for (int _i = 0; _i < 2; ++_i) { asm volatile("" : "+v"((voff)[_i]));   \
        __builtin_amdgcn_global_load_lds((const unsigned*)((const char*)(gbase) + (voff)[_i]), (LAS unsigned*)(lds + (bufoff) + ldsw + _i * 8192), 16, 0, 0); } } while (0)
    constexpr int FKS = F8 ? 16 : 1024;
#define PG8_LD2(p_) __builtin_shufflevector(*(const LAS v4i_t*)(p_), *(const LAS v4i_t*)((p_) + FKS), 0, 1, 2, 3, 4, 5, 6, 7)
#define PG8_LDA(dst, b, h) do { _Pragma("unroll") for (int m = 0; m < 4; ++m) dst[m] = PG8_LD2(lds + PG8_SA(b, h) + aoff + m * 2048); } while (0)
#define PG8_LDB(dst, b, h) do { _Pragma("unroll") for (int n = 0; n < 2; ++n) dst[n] = PG8_LD2(lds + PG8_SB(b, h) + boff + n * 2048); } while (0)
#define PG8_LO(v) __builtin_bit_cast(bf16x8, __builtin_shufflevector((v), (v), 0, 1, 2, 3))
#define PG8_HI(v) __builtin_bit_cast(bf16x8, __builtin_shufflevector((v), (v), 4, 5, 6, 7))
#define PG8_MMA(ai, bj, At, Bt) do { __builtin_amdgcn_s_setprio(1); _Pragma("unroll") for (int m = 0; m < 4; ++m) _Pragma("unroll") for (int n = 0; n < 2; ++n) { \
        if constexpr (F8) { acc[ai][bj][m][n] = __builtin_amdgcn_mfma_scale_f32_16x16x128_f8f6f4(Bt[n], At[m], acc[ai][bj][m][n], 0, 0, 0, 0x7F7F7F7F, 0, 0x7F7F7F7F); } \
        else { acc[ai][bj][m][n] = __builtin_amdgcn_mfma_f32_16x16x32_bf16(PG8_LO(Bt[n]), PG8_LO(At[m]), acc[ai][bj][m][n], 0, 0, 0); \
               acc[ai][bj][m][n] = __builtin_amdgcn_mfma_f32_16x16x32_bf16(PG8_HI(Bt[n]), PG8_HI(At[m]), acc[ai][bj][m][n], 0, 0, 0); } } __builtin_amdgcn_s_setprio(0); } while (0)
#define PG8_WAIT_V(n) asm volatile("s_waitcnt vmcnt(" #n ")" ::: "memory")
#define PG8_WAIT_L(n) asm volatile("s_waitcnt lgkmcnt(" #n ")" ::: "memory")
#define PG8_BAR __builtin_amdgcn_s_barrier()
#define PG8_SCHED __builtin_amdgcn_sched_barrier(0)
#define PG8_VOFF(u, v00, v01, v10, v11) do { int _R0, _C0, _R1, _C1; stage_rc(tid * 16, _R0, _C0); stage_rc(tid * 16 + 8192, _R1, _C1); int _r00 = _R0, _r01 = _R1, _r10 = HALF + _R0, _r11 = HALF + _R1; \
        if ((u).gidx) { const GAS int* _gp = (const GAS int*)(u).gidx; const int _gc = (u).gcnt;     \
            const int _a = _gp[_r00 < _gc ? _r00 : 0] >> (u).gshift, _b = _gp[_r01 < _gc ? _r01 : 0] >> (u).gshift, _c = _gp[_r10 < _gc ? _r10 : 0] >> (u).gshift, _d = _gp[_r11 < _gc ? _r11 : 0] >> (u).gshift; \
            _r00 = _a; _r01 = _b; _r10 = _c; _r11 = _d; } \
        v00 = (unsigned)(_r00 * K + _C0) * 2u; v01 = (unsigned)(_r01 * K + _C1) * 2u; v10 = (unsigned)(_r10 * K + _C0) * 2u; v11 = (unsigned)(_r11 * K + _C1) * 2u; } while (0)
    UnitG cur, nxt; int ui = 0;
    if (!S.next(0, cur)) return;
    if constexpr (Sched::UNIFORMIZE) uniformize(cur);
    f32x4 acc[2][2][4][2];
#pragma unroll
    for (int a = 0; a < 2; ++a)
#pragma unroll
        for (int b = 0; b < 2; ++b)
#pragma unroll
            for (int m = 0; m < 4; ++m)
#pragma unroll
                for (int n = 0; n < 2; ++n) acc[a][b][m][n] = (f32x4){0.f, 0.f, 0.f, 0.f};
    v8i_t At[4], B0[2], B1[2];
    if constexpr (GATHER) PG8_VOFF(cur, vA[0][0], vA[0][1], vA[1][0], vA[1][1]);
    const char* cA = cur.A; const char* cB = cur.B;
    PG8_STAGE(PG8_SB(0, 0), cB, voffB); PG8_STAGE(PG8_SB(0, 1), cB + hstepB, voffB1); PG8_STAGE(PG8_SA(0, 0), cA, vA[0]); PG8_STAGE(PG8_SA(0, 1), cA + hstepA, vA[1]);
    if (wr == 1) PG8_BAR;
    PG8_WAIT_V(2); PG8_BAR;
    PG8_STAGE(PG8_SB(1, 0), cB + kstep, voffB); PG8_STAGE(PG8_SA(1, 0), cA + kstep, vA[0]); PG8_STAGE(PG8_SB(1, 1), cB + hstepB + kstep, voffB1);
    PG8_WAIT_V(6); PG8_BAR;
    for (;;) {
        const bool has_next = S.next(ui + 1, nxt);
        if constexpr (Sched::UNIFORMIZE) { if (has_next) uniformize(nxt); }
        const char* nA = cA; const char* nB = cB;
        if (has_next) { nA = nxt.A; nB = nxt.B; }
        if constexpr (GATHER) { u32x4 pv; pv.x = vA[0][0]; pv.y = vA[0][1]; pv.z = vA[1][0]; pv.w = vA[1][1];
            if (has_next) PG8_VOFF(nxt, pv.x, pv.y, pv.z, pv.w);
            *park = pv; }
#pragma unroll 1
        for (int t = 0; t < nt; t += 2) {
            const bool last = (t == nt - 2);
            const char* a1 = cA + (size_t)(t + 1) * kstep;
            const char* a2 = last ? nA : cA + (size_t)(t + 2) * kstep; const char* b2 = last ? nB : cB + (size_t)(t + 2) * kstep;
            const char* a3 = a2 + kstep; const char* b3 = b2 + kstep;
            PG8_LDB(B0, 0, 0); PG8_LDB(B1, 0, 1); PG8_SCHED; PG8_LDA(At, 0, 0); PG8_STAGE(PG8_SA(1, 1), a1 + hstepA, vA[1]);
            PG8_WAIT_V(8); PG8_WAIT_L(0); PG8_BAR; PG8_MMA(0, 0, At, B0); PG8_MMA(0, 1, At, B1); PG8_BAR; PG8_SCHED;
            if constexpr (GATHER) { if (last) { const u32x4 pv = *park; vA[0][0] = pv.x; vA[0][1] = pv.y; vA[1][0] = pv.z; vA[1][1] = pv.w; } }
            PG8_LDA(At, 0, 1); PG8_STAGE(PG8_SB(0, 0), b2, voffB); PG8_STAGE(PG8_SB(0, 1), b2 + hstepB, voffB1); PG8_STAGE(PG8_SA(0, 0), a2, vA[0]);
            PG8_WAIT_V(8); PG8_WAIT_L(0); PG8_BAR; PG8_MMA(1, 0, At, B0); PG8_MMA(1, 1, At, B1); PG8_BAR; PG8_SCHED;
            PG8_LDB(B0, 1, 0); PG8_LDB(B1, 1, 1); PG8_SCHED; PG8_LDA(At, 1, 0); PG8_STAGE(PG8_SA(0, 1), a2 + hstepA, vA[1]);
            PG8_WAIT_V(8); PG8_WAIT_L(0); PG8_BAR; PG8_MMA(0, 0, At, B0); PG8_MMA(0, 1, At, B1); PG8_BAR; PG8_SCHED;
            PG8_LDA(At, 1, 1); PG8_STAGE(PG8_SB(1, 0), b3, voffB); PG8_STAGE(PG8_SB(1, 1), b3 + hstepB, voffB1); PG8_STAGE(PG8_SA(1, 0), a3, vA[0]);
            PG8_WAIT_V(8); PG8_WAIT_L(0); PG8_BAR; PG8_MMA(1, 0, At, B0); PG8_MMA(1, 1, At, B1); PG8_BAR; PG8_SCHED;
        }
        if (wr == 0) PG8_BAR;
        { int l2; { unsigned o2 = ~0u; asm volatile("" : "+s"(o2)); l2 = (int)__builtin_amdgcn_mbcnt_hi(o2, __builtin_amdgcn_mbcnt_lo(o2, 0u)); }
          E(acc, cur, wr, wc, l2 & 15, l2 >> 4); }
        if (!has_next) break;
#pragma unroll
        for (int a = 0; a < 2; ++a)
#pragma unroll
            for (int b = 0; b < 2; ++b)
#pragma unroll
                for (int m = 0; m < 4; ++m)
#pragma unroll
                    for (int n = 0; n < 2; ++n) acc[a][b][m][n] = (f32x4){0.f, 0.f, 0.f, 0.f};
        cur = nxt; cA = nA; cB = nB; ++ui;
        if (wr == 1) PG8_BAR;
    }
    PG8_WAIT_V(0);
    PG8_BAR;
#undef PG8_SA
#undef PG8_SB
#undef PG8_STAGE
#undef PG8_LDA
#undef PG8_LDB
#undef PG8_LD2
#undef PG8_LO
#undef PG8_HI
#undef PG8_MMA
#undef PG8_WAIT_V
#undef PG8_WAIT_L
#undef PG8_BAR
#undef PG8_SCHED
#undef PG8_VOFF
}
}

constexpr size_t MiB = 1u << 20;
constexpr size_t WS_CTL = 0, CTL_ZERO_BYTES = 1 * MiB;
constexpr size_t WS_ATT_IN_T = 1 * MiB;
constexpr size_t WS_ATT_OUT_T = WS_ATT_IN_T + 36 * MiB;
constexpr size_t WS_RET_IN_T = WS_ATT_OUT_T + 4 * MiB;
constexpr size_t WS_RET_OUT_T = WS_RET_IN_T + 12 * MiB;
constexpr size_t WS_GLU_T = WS_RET_OUT_T + 4 * MiB;
constexpr size_t WS_RT_HI = WS_GLU_T + 4 * MiB;
constexpr size_t WS_RT_LO = WS_RT_HI + 512 * 1024;
constexpr size_t WS_WMOE = WS_RT_HI + 1 * MiB;
constexpr size_t WMOE_E_BYTES = (size_t)(512 * 1024 + 1024 * 256) * 2;
constexpr size_t WS_X = WS_WMOE + 98 * MiB;
constexpr size_t WS_Y = WS_X + 64 * MiB;
constexpr size_t WS_XB = WS_Y + 64 * MiB;
constexpr size_t WS_BIG = WS_XB + 32 * MiB;
constexpr size_t WS_AUX = WS_BIG + 288 * MiB;
constexpr size_t WS_H = WS_AUX + 160 * MiB;
constexpr size_t WS_LIST = WS_H + 80 * MiB;
constexpr size_t WS_TRASH = WS_LIST + 8 * MiB;
constexpr size_t WS_END = WS_TRASH + 1 * MiB;
static_assert(WS_END <= 1024 * MiB, "workspace map");
constexpr int CW_BAR = 4096;
constexpr int CW_CNT = 16384;
constexpr int CW_CHK = 65536;
constexpr int HROWS = 163840;

#define XB_TMO      128
#define XB_XCNT(j)  (256  + 64 * (j))
#define XB_XSUB(j)  (1280 + 64 * (j))
#define XB_XGEN(j)  (2304 + 64 * (j))
#define XB_TOP      3328
#define XB_TOPGEN   3392
#define XCD_BAR_WORDS 3456
#define XB_SPIN_CAP (1u << 20)
__device__ __forceinline__ unsigned xb_ld(unsigned* p)              { return __hip_atomic_load(p, __ATOMIC_RELAXED, __HIP_MEMORY_SCOPE_AGENT); }
__device__ __forceinline__ unsigned xb_add(unsigned* p, unsigned v) { return __hip_atomic_fetch_add(p, v, __ATOMIC_RELAXED, __HIP_MEMORY_SCOPE_AGENT); }
__device__ __forceinline__ unsigned xb_xcc_id() { return (unsigned)__builtin_amdgcn_s_getreg((3 << 11) | 20) & 0xFu; }
#define XB_SPIN(cond, bar) do { unsigned _sp = 0; while (cond) { __builtin_amdgcn_s_sleep(1); \
    if ((++_sp & 255u) == 0u) { if (xb_ld(&(bar)[XB_TMO])) break; if (_sp > XB_SPIN_CAP) { atomicAdd(&(bar)[XB_TMO], 1u); break; } } } } while (0)
struct XcdBarrier { unsigned* bar; unsigned x; volatile LAS unsigned* st; };
__device__ __forceinline__ XcdBarrier xcd_barrier_post(unsigned* bar, volatile LAS unsigned* st) {
    XcdBarrier b; b.bar = bar; b.x = xb_xcc_id(); b.st = st;
    if (threadIdx.x == 0) (void)xb_add(&bar[XB_XCNT(b.x)], 1u);
    return b;
}
__device__ __forceinline__ void xcd_barrier_complete(unsigned* bar, unsigned x, unsigned& nloc, unsigned& nx) {
    const unsigned G = gridDim.x * gridDim.y * gridDim.z;
    unsigned sum, cnt, mine, sp = 0u;
    for (;;) {
        sum = 0u; cnt = 0u; mine = 0u;
#pragma unroll
        for (unsigned j = 0; j < 16; ++j) { const unsigned c = xb_ld(&bar[XB_XCNT(j)]); sum += c; cnt += (c > 0u) ? 1u : 0u; mine = (j == x) ? c : mine; }
        if (sum == G) break;
        __builtin_amdgcn_s_sleep(1);
        if ((++sp & 255u) == 0u) { if (xb_ld(&bar[XB_TMO])) break; if (sp > XB_SPIN_CAP) { atomicAdd(&bar[XB_TMO], 1u); break; } }
    }
    nloc = mine > 0u ? mine : 1u; nx = cnt > 0u ? cnt : 1u;
}
__device__ __forceinline__ void xcd_barrier(const XcdBarrier& b) {
    asm volatile("s_waitcnt vmcnt(0)" ::: "memory");
    __syncthreads();
    if (threadIdx.x == 0) {
        unsigned* bar = b.bar;
        __builtin_amdgcn_s_waitcnt(0);
        unsigned nloc = b.st[0], nx = b.st[1];
        if (nloc == 0u) { xcd_barrier_complete(bar, b.x, nloc, nx); b.st[0] = nloc; b.st[1] = nx; }
        const unsigned old = xb_add(&bar[XB_XSUB(b.x)], 1u);
        const unsigned gen = old / nloc;
        if (old + 1u == (gen + 1u) * nloc) {
            __builtin_amdgcn_fence(__ATOMIC_RELEASE, "agent");
            asm volatile("s_waitcnt vmcnt(0)" ::: "memory");
            const unsigned og = xb_add(&bar[XB_TOP], 1u);
            const unsigned tg = og / nx;
            if (og + 1u == (tg + 1u) * nx) xb_add(&bar[XB_TOPGEN], 1u);
            else XB_SPIN(xb_ld(&bar[XB_TOPGEN]) == tg, bar);
            __builtin_amdgcn_fence(__ATOMIC_ACQUIRE, "agent");
            xb_add(&bar[XB_XGEN(b.x)], 1u);
            asm volatile("s_waitcnt vmcnt(0)" ::: "memory");
        } else {
            XB_SPIN(xb_ld(&bar[XB_XGEN(b.x)]) == gen, bar);
            __builtin_amdgcn_fence(__ATOMIC_ACQUIRE, "agent");
            asm volatile("s_waitcnt vmcnt(0)" ::: "memory");
        }
    }
    __syncthreads();
}

constexpr int RING_BYTES = 139264;
constexpr int MISC_OFF = RING_BYTES;
constexpr int LDS_BYTES = 147456;
struct Params {
    const float* in[26]; float* out; unsigned char* ws; int ph_lo, ph_hi; int use_bar, pad;
};
typedef const __attribute__((address_space(4))) Params* KP;
__device__ __forceinline__ const float* gin(KP p, int i) { return (const float*)(const GAS float*)p->in[i]; }
__device__ __forceinline__ float* gout(KP p) { return (float*)(GAS float*)p->out; }
struct Frame {
    LAS unsigned char* lds; volatile LAS unsigned* MISC;
    int tid, lane, wave, vcu, G;
    unsigned char* ws;
};

template <bool F8_ = false> struct DenseSchedT {
    static constexpr bool GATHER = false, UNIFORMIZE = false, FP8 = F8_;
    const char* A; const char* Bt; int K, nM, nN, nwg, G, c;
    __device__ __forceinline__ void init(const void* A_, const void* Bt_, int M, int N, int K_, int G_, int c_) { A = (const char*)A_; Bt = (const char*)Bt_; K = K_; nM = M / 256; nN = N / 256; nwg = nM * nN; G = G_; c = c_; }
    __device__ __forceinline__ bool next(int i, pg8::UnitG& u) const {
        const long L = (long)i * G + c; if (L >= nwg) return false;
        int wgid = (int)L; { const int q = nwg / 8, r = nwg % 8, xcd = wgid % 8, off = wgid / 8; wgid = (xcd < r ? xcd * (q + 1) : r * (q + 1) + (xcd - r) * q) + off; }
        const int nig = 8 * nN, gid = wgid / nig, fm = gid * 8, gsz = (nM - fm) < 8 ? (nM - fm) : 8;
        const int pm = fm + ((wgid % nig) % gsz), pn = (wgid % nig) / gsz;
        u.A = A + (size_t)pm * 256 * K * 2; u.B = Bt + (size_t)pn * 256 * K * 2; u.gidx = nullptr; u.gcnt = 0; u.gshift = 0; u.row0 = pm * 256; u.col0 = pn * 256; u.aux = 0; return true;
    }
};
typedef DenseSchedT<false> DenseSched; typedef DenseSchedT<true> DenseSched8;
__device__ __forceinline__ u32x4 pack_bf16x8(const f32x4& v0, const f32x4& v1) { u32x4 w; w.x = pk2hw(v0[0], v0[1]); w.y = pk2hw(v0[2], v0[3]); w.z = pk2hw(v1[0], v1[1]); w.w = pk2hw(v1[2], v1[3]); return w; }

__device__ __forceinline__ unsigned pk4_fp8(float a, float b, float c, float d) {
    a = fminf(fmaxf(a, -448.0f), 448.0f); b = fminf(fmaxf(b, -448.0f), 448.0f); c = fminf(fmaxf(c, -448.0f), 448.0f); d = fminf(fmaxf(d, -448.0f), 448.0f);
    int w = 0; w = __builtin_amdgcn_cvt_pk_fp8_f32(a, b, w, false); w = __builtin_amdgcn_cvt_pk_fp8_f32(c, d, w, true); return (unsigned)w; }
constexpr float WUP_SCALE = 32.0f, WUP_INV = 1.0f / 32.0f;
struct EpiStoreBf16 {
    static constexpr bool PERM = true, PERM16 = false;
    bf16* O; int ldc; float osc, qsc;
    __device__ __forceinline__ void operator()(const f32x4 (&acc)[2][2][4][2], const pg8::UnitG& u, int wr, int wc, int fr, int fq) const {
        const float sc = ((u.col0 % 3072) < 1024) ? osc * qsc : osc;
#pragma unroll
        for (int ai = 0; ai < 2; ++ai)
#pragma unroll
            for (int m = 0; m < 4; ++m) { bf16* rowp = O + (size_t)(u.row0 + ai * 128 + wr * 64 + m * 16 + fr) * ldc + u.col0 + wc * 32 + 8 * fq;
#pragma unroll
                for (int bj = 0; bj < 2; ++bj) *(u32x4*)(rowp + bj * 128) = pack_bf16x8(acc[ai][bj][m][0] * sc, acc[ai][bj][m][1] * sc); }
    }
};
constexpr float YEXP_SCALE = 32.0f, YEXP_INV = 1.0f / 32.0f;
constexpr float H_SCALE = 16.0f;
struct EpiStoreFp8 {
    static constexpr bool PERM = false, PERM16 = true;
    unsigned char* O; int ldc;
    __device__ __forceinline__ void operator()(const f32x4 (&acc)[2][2][4][2], const pg8::UnitG& u, int wr, int wc, int fr, int fq) const {
#pragma unroll
        for (int ai = 0; ai < 2; ++ai)
#pragma unroll
            for (int m = 0; m < 4; ++m) { unsigned char* rowp = O + (size_t)(u.row0 + ai * 128 + wr * 64 + m * 16 + fr) * ldc + u.col0 + wc * 64 + 16 * fq;
                u32x4 w;
#pragma unroll
                for (int q = 0; q < 4; ++q) { f32x4 v = acc[ai][q >> 1][m][q & 1] * (YEXP_SCALE / (H_SCALE * WUP_SCALE));
#pragma unroll
                    for (int j = 0; j < 4; ++j) v[j] = fminf(fmaxf(v[j], -448.0f), 448.0f);
                    int d = 0; d = __builtin_amdgcn_cvt_pk_fp8_f32(v[0], v[1], d, false); d = __builtin_amdgcn_cvt_pk_fp8_f32(v[2], v[3], d, true); w[q] = (unsigned)d; }
                *(u32x4*)rowp = w; }
    }
};
struct EpiRetIn {
    static constexpr bool PERM = true, PERM16 = false;
    bf16* O; int ldc;
    __device__ __forceinline__ void operator()(const f32x4 (&acc)[2][2][4][2], const pg8::UnitG& u, int wr, int wc, int fr, int fq) const {
        float l2g = 0.f;
        float cs = WUP_INV;
        if (u.col0 < 2048) { const int h = (u.col0 & 1023) >> 8; const float g = 1.0f - exp2f(-5.0f - (float)h); l2g = log2f(g); if (u.col0 >= 1024) { l2g = -l2g; cs *= 0.0625f; } }
#pragma unroll
        for (int ai = 0; ai < 2; ++ai)
#pragma unroll
            for (int m = 0; m < 4; ++m) { const int row = u.row0 + ai * 128 + wr * 64 + m * 16 + fr; const float sc = exp2f(l2g * (float)(row & 127)) * cs;
                bf16* rowp = O + (size_t)row * ldc + u.col0 + wc * 32 + 8 * fq;
#pragma unroll
                for (int bj = 0; bj < 2; ++bj) *(u32x4*)(rowp + bj * 128) = pack_bf16x8(acc[ai][bj][m][0] * sc, acc[ai][bj][m][1] * sc); }
    }
};
__device__ __forceinline__ void unpack_bf16x8(const u32x4& w, f32x4& a, f32x4& b) { a[0] = bflo(w.x); a[1] = bfhi(w.x); a[2] = bflo(w.y); a[3] = bfhi(w.y); b[0] = bflo(w.z); b[1] = bfhi(w.z); b[2] = bflo(w.w); b[3] = bfhi(w.w); }
template <bool ALL16> struct EpiResidT {
    static constexpr bool PERM = true, PERM16 = false;
    const bf16* X; bf16* Y; float asc;
    __device__ __forceinline__ void operator()(const f32x4 (&acc)[2][2][4][2], const pg8::UnitG& u, int wr, int wc, int fr, int fq) const {
        constexpr int NB = ALL16 ? 1 : 2, PER = 2 / NB;
#pragma unroll
        for (int bt = 0; bt < NB; ++bt) {
            u32x4 xw[PER][4][2];
#pragma unroll
            for (int a2 = 0; a2 < PER; ++a2)
#pragma unroll
                for (int m = 0; m < 4; ++m) { const int ai = bt * PER + a2; const size_t off = (size_t)(u.row0 + ai * 128 + wr * 64 + m * 16 + fr) * D + u.col0 + wc * 32 + 8 * fq;
#pragma unroll
                    for (int bj = 0; bj < 2; ++bj) xw[a2][m][bj] = *(const u32x4*)(X + off + bj * 128); }
            asm volatile("" ::: "memory");
#pragma unroll
            for (int a2 = 0; a2 < PER; ++a2)
#pragma unroll
                for (int m = 0; m < 4; ++m) { const int ai = bt * PER + a2; const size_t off = (size_t)(u.row0 + ai * 128 + wr * 64 + m * 16 + fr) * D + u.col0 + wc * 32 + 8 * fq;
#pragma unroll
                    for (int bj = 0; bj < 2; ++bj) { f32x4 x0, x1; unpack_bf16x8(xw[a2][m][bj], x0, x1);
                        *(u32x4*)(Y + off + bj * 128) = pack_bf16x8(x0 * ALPHA + acc[ai][bj][m][0] * asc, x1 * ALPHA + acc[ai][bj][m][1] * asc); } }
            asm volatile("" ::: "memory");
        }
    }
};
typedef EpiResidT<true> EpiResid; typedef EpiResidT<false> EpiResid8;
struct EpiGluResid {
    static constexpr bool PERM = true, PERM16 = false;
    const bf16* X; bf16* Y;
    __device__ __forceinline__ void operator()(const f32x4 (&acc)[2][2][4][2], const pg8::UnitG& u, int wr, int wc, int fr, int fq) const {
        u32x4 xw[2][4];
#pragma unroll
        for (int ai = 0; ai < 2; ++ai)
#pragma unroll
            for (int m = 0; m < 4; ++m) { const size_t off = (size_t)(u.row0 + ai * 128 + wr * 64 + m * 16 + fr) * D + (u.col0 >> 1) + wc * 32 + 8 * fq; xw[ai][m] = *(const u32x4*)(X + off); }
        asm volatile("" ::: "memory");
#pragma unroll
        for (int ai = 0; ai < 2; ++ai)
#pragma unroll
            for (int m = 0; m < 4; ++m) { const size_t off = (size_t)(u.row0 + ai * 128 + wr * 64 + m * 16 + fr) * D + (u.col0 >> 1) + wc * 32 + 8 * fq;
                f32x4 x0, x1; unpack_bf16x8(xw[ai][m], x0, x1); f32x4 o0, o1;
#pragma unroll
                for (int j = 0; j < 4; ++j) { o0[j] = x0[j] * ALPHA + acc[ai][0][m][0][j] * fsig(acc[ai][1][m][0][j]); o1[j] = x1[j] * ALPHA + acc[ai][0][m][1][j] * fsig(acc[ai][1][m][1][j]); }
                *(u32x4*)(Y + off) = pack_bf16x8(o0, o1); }
    }
};
struct EpiMoeUp {
    static constexpr bool PERM = true, PERM16 = false;
    unsigned char* H;
    __device__ __forceinline__ void operator()(const f32x4 (&acc)[2][2][4][2], const pg8::UnitG& u, int wr, int wc, int fr, int fq) const {
#pragma unroll
        for (int ai = 0; ai < 2; ++ai)
#pragma unroll
            for (int m = 0; m < 4; ++m) { unsigned char* rowp = H + (size_t)(u.row0 + ai * 128 + wr * 64 + m * 16 + fr) * ED + u.col0 + wc * 32 + 8 * fq; f32x4 o[2];
#pragma unroll
                for (int n = 0; n < 2; ++n)
#pragma unroll
                    for (int j = 0; j < 4; ++j) { const float ga = acc[ai][0][m][n][j], ua = acc[ai][1][m][n][j];
                        o[n][j] = (ga * ua) * (WUP_INV * WUP_INV * H_SCALE) * __builtin_amdgcn_rcpf(1.0f + __builtin_amdgcn_exp2f(ga * (-WUP_INV * 1.4426950408889634f))); }
                u32x2 w8; w8.x = pk4_fp8(o[0][0], o[0][1], o[0][2], o[0][3]); w8.y = pk4_fp8(o[1][0], o[1][1], o[1][2], o[1][3]); *(u32x2*)rowp = w8; }
    }
};

struct ConvD { const float* src; unsigned char* dst; unsigned char* dst2; int ldw, ldk, kind; };
__device__ __forceinline__ ConvD conv_mk8(const float* W, int ldw, unsigned char* WT, int ldk, int k0, int n0, int drow0) {
    ConvD d; d.src = W + (size_t)k0 * ldw + n0; d.dst = WT + (size_t)drow0 * ldk + k0; d.dst2 = nullptr; d.ldw = ldw; d.ldk = ldk; d.kind = 1; return d; }
__device__ __forceinline__ ConvD conv_mk16(const float* W, int ldw, bf16* WT, bf16* WTlo, int ldk, int k0, int n0, int drow0) {
    ConvD d; d.src = W + (size_t)k0 * ldw + n0; d.dst = (unsigned char*)(WT + (size_t)drow0 * ldk + k0); d.dst2 = WTlo ? (unsigned char*)(WTlo + (size_t)drow0 * ldk + k0) : nullptr; d.ldw = ldw; d.ldk = ldk * 2; d.kind = WTlo ? 2 : 0; return d; }
__device__ __forceinline__ void conv_load(const ConvD& d, int lane, f32x4 (&r)[8]) {
#pragma unroll
    for (int i = 0; i < 8; ++i) { const int kk = 8 * i + (lane >> 3), c4 = 4 * (lane & 7); r[i] = *(const f32x4*)(d.src + (size_t)kk * d.ldw + c4); }
}
template <bool HILO>
__device__ __forceinline__ void conv_finish(const ConvD& d, int lane, const f32x4 (&r)[8], LAS float* scr) {
    const float scale = (d.kind == 1) ? WUP_SCALE : 1.0f;
#pragma unroll
    for (int i = 0; i < 8; ++i) { const int kk = 8 * i + (lane >> 3), c4 = 4 * (lane & 7);
        scr[kk * 33 + c4] = r[i][0] * scale; scr[kk * 33 + c4 + 1] = r[i][1] * scale; scr[kk * 33 + c4 + 2] = r[i][2] * scale; scr[kk * 33 + c4 + 3] = r[i][3] * scale; }
    LDS_WAIT(); asm volatile("" ::: "memory");
    const int c = lane & 7;
#pragma unroll
    for (int j = 0; j < 4; ++j) { const int n = (lane >> 3) + 8 * j; const LAS float* s = scr + (8 * c) * 33 + n;
        float v[8];
#pragma unroll
        for (int q = 0; q < 8; ++q) v[q] = s[q * 33];
        if (d.kind == 1) { u32x2 o; o.x = pk4_fp8(v[0], v[1], v[2], v[3]); o.y = pk4_fp8(v[4], v[5], v[6], v[7]); *(u32x2*)(d.dst + (size_t)n * d.ldk + 8 * c) = o; }
        else { u32x4 o; o.x = pk2(v[0], v[1]); o.y = pk2(v[2], v[3]); o.z = pk2(v[4], v[5]); o.w = pk2(v[6], v[7]);
            *(u32x4*)(d.dst + (size_t)n * d.ldk + 16 * c) = o;
            if (HILO) { float rr[8];
#pragma unroll
                for (int q = 0; q < 8; ++q) rr[q] = v[q] - bf2f(f2bf(v[q]));
                u32x4 o2; o2.x = pk2(rr[0], rr[1]); o2.y = pk2(rr[2], rr[3]); o2.z = pk2(rr[4], rr[5]); o2.w = pk2(rr[6], rr[7]);
                *(u32x4*)(d.dst2 + (size_t)n * d.ldk + 16 * c) = o2; } } }
    LDS_WAIT(); asm volatile("" ::: "memory");
}
__device__ __forceinline__ void conv_dma(const ConvD& d, int lane, LAS float* buf) {
#pragma unroll
    for (int i = 0; i < 8; ++i) { const float* g = d.src + (size_t)(8 * i + (lane >> 3)) * d.ldw + 4 * ((lane & 7) ^ i);
        __builtin_amdgcn_global_load_lds((const unsigned*)g, (LAS unsigned*)(buf + i * 256), 16, 0, 0); }
}
__device__ __forceinline__ void conv_finish_lds(const ConvD& d, int lane, const LAS float* buf) {
    const float scale = (d.kind == 1) ? WUP_SCALE : 1.0f;
    const int c = lane & 7;
#pragma unroll
    for (int j = 0; j < 4; ++j) { const int n = (lane >> 3) + 8 * j; const LAS float* s = buf + (8 * c) * 32 + (((n >> 2) ^ c) & 7) * 4 + (n & 3);
        float v[8];
#pragma unroll
        for (int q = 0; q < 8; ++q) v[q] = s[q * 32] * scale;
        if (d.kind == 1) { u32x2 o; o.x = pk4_fp8(v[0], v[1], v[2], v[3]); o.y = pk4_fp8(v[4], v[5], v[6], v[7]); *(u32x2*)(d.dst + (size_t)n * d.ldk + 8 * c) = o; }
        else { u32x4 o; o.x = pk2(v[0], v[1]); o.y = pk2(v[2], v[3]); o.z = pk2(v[4], v[5]); o.w = pk2(v[6], v[7]); *(u32x4*)(d.dst + (size_t)n * d.ldk + 16 * c) = o; } }
    LDS_WAIT(); asm volatile("" ::: "memory");
}
#define CONV_RUN(NIT, DEC) do { int it_ = gw; if (it_ < (NIT)) { ConvD dc_ = DEC(it_); int par_ = 0; conv_dma(dc_, F.lane, scr); asm volatile("s_waitcnt vmcnt(0)" ::: "memory"); \
        for (; it_ < (NIT); it_ += NGW) { const int itn_ = (it_ + NGW < (NIT)) ? it_ + NGW : it_; const ConvD dn_ = DEC(itn_); conv_dma(dn_, F.lane, scr + (par_ ^ 1) * 2048);     \
            asm volatile("s_waitcnt vmcnt(12)" ::: "memory"); conv_finish_lds(dc_, F.lane, scr + par_ * 2048); dc_ = dn_; par_ ^= 1; } \
        asm volatile("s_waitcnt vmcnt(0)" ::: "memory"); } } while (0)
__device__ __forceinline__ ConvD conv_dec_mixers(KP p, unsigned char* ws, int it) {
    constexpr int I_AIN = 16 * 288, I_AOUT = 16 * 32, I_RIN = 16 * 192, I_ROUT = 32 * 32, I_GLU = 16 * 64, I_RT = 16 * 2;
    int r = it;
    if (r < 2 * I_AIN) { const int j = r / I_AIN; r %= I_AIN; const int kb = r / 288, nb = r % 288, n0 = nb * 32;
        return conv_mk8(gin(p, 1) + (size_t)j * D * ATT_IN, ATT_IN, (unsigned char*)(ws + WS_ATT_IN_T) + (size_t)j * ATT_IN * D, D, kb * 64, n0, n0); }
    r -= 2 * I_AIN;
    if (r < 2 * I_AOUT) { const int j = r / I_AOUT; r %= I_AOUT; const int kb = r / 32, nb = r % 32, n0 = nb * 32;
        return conv_mk16(gin(p, 2) + (size_t)j * D * D, D, (bf16*)(ws + WS_ATT_OUT_T) + (size_t)j * D * D, nullptr, D, kb * 64, n0, n0); }
    r -= 2 * I_AOUT;
    if (r < I_RIN) { const int kb = r / 192, nb = r % 192, n0 = nb * 32;
        return conv_mk8(gin(p, 3), RET_IN, (unsigned char*)(ws + WS_RET_IN_T), D, kb * 64, n0, n0); }
    r -= I_RIN;
    if (r < I_ROUT) { const int kb = r / 32, nb = r % 32, n0 = nb * 32;
        return conv_mk16(gin(p, 6), D, (bf16*)(ws + WS_RET_OUT_T), nullptr, RET_V, kb * 64, n0, n0); }
    r -= I_ROUT;
    if (r < I_GLU) { const int kb = r / 64, nb = r % 64, n0 = nb * 32; const int c = n0 & 1023, drow = (c >> 7) * 256 + (n0 >> 10) * 128 + (c & 127);
        return conv_mk16(gin(p, 15), 2 * D, (bf16*)(ws + WS_GLU_T), nullptr, D, kb * 64, n0, drow); }
    r -= I_GLU;
    { const int l = r / I_RT; r %= I_RT; const int kb = r / 2, nb = r % 2, n0 = nb * 32;
        return conv_mk16(gin(p, 16) + (size_t)l * D * NE, NE, (bf16*)(ws + WS_RT_HI) + (size_t)l * NE * D, (bf16*)(ws + WS_RT_LO) + (size_t)l * NE * D, D, kb * 64, n0, n0); }
}
__device__ __forceinline__ ConvD conv_dec_moe(KP p, unsigned char* ws, int l, int it) {
    const int e = it / 384, r = it % 384, which = r >> 7, rr = r & 127;
    bf16* We = (bf16*)(ws + WS_WMOE + (size_t)e * WMOE_E_BYTES);
    if (which < 2) { const float* src = (e < 64) ? gin(p, 18 + which) + ((size_t)l * NE + e) * D * ED : gin(p, 21 + which) + (size_t)l * D * ED;
        const int kb = rr >> 3, nb = rr & 7, n0 = nb * 32; const int drow = (n0 >> 7) * 256 + which * 128 + (n0 & 127);
        return conv_mk8(src, ED, (unsigned char*)We, D, kb * 64, n0, drow); }
    const float* src = (e < 64) ? gin(p, 20) + ((size_t)l * NE + e) * ED * D : gin(p, 23) + (size_t)l * ED * D;
    const int kb = rr >> 5, nb = rr & 31, n0 = nb * 32;
    return conv_mk8(src, D, (unsigned char*)(We + 512 * 1024), ED, kb * 64, n0, n0);
}
__device__ __forceinline__ void phase_conv_mixers(const Frame& F, KP p) {
    LAS float* scr = (LAS float*)(F.lds + F.wave * 16384);
    const int gw = F.vcu * NWAVES + F.wave, NGW = F.G * NWAVES;
    constexpr int NMAIN = 2 * (16 * 288) + 2 * (16 * 32) + 16 * 192 + 32 * 32 + 16 * 64, NRT = 4 * (16 * 2);
    unsigned char* ws = F.ws;
#define CONV_DEC_MIX(i_) conv_dec_mixers(p, ws, (i_))
    CONV_RUN(NMAIN, CONV_DEC_MIX);
    for (int it = NMAIN + gw; it < NMAIN + NRT; it += NGW) { const ConvD d = conv_dec_mixers(p, ws, it); f32x4 r[8]; conv_load(d, F.lane, r); conv_finish<true>(d, F.lane, r, scr); }
#undef CONV_DEC_MIX
}
__device__ __forceinline__ void phase_conv_moe(const Frame& F, KP p, int l) {
    LAS float* scr = (LAS float*)(F.lds + F.wave * 16384);
    const int gw = F.vcu * NWAVES + F.wave, NGW = F.G * NWAVES;
    unsigned char* ws = F.ws;
#define CONV_DEC_MOE(i_) conv_dec_moe(p, ws, l, (i_))
    CONV_RUN(65 * 384, CONV_DEC_MOE);
#undef CONV_DEC_MOE
}

__device__ __forceinline__ void phase_lnr(const Frame& F, KP p, int layer, bool dry = false) {
    const bf16* Y = (const bf16*)(F.ws + WS_Y); bf16* XB = (bf16*)(F.ws + WS_XB); unsigned char* XB8 = (unsigned char*)(F.ws + WS_X);
    const float* lng = gin(p, 24) + (size_t)(layer * 2) * D; const float* lnb = gin(p, 25) + (size_t)(layer * 2) * D;
    const bf16* rthi = (const bf16*)(F.ws + WS_RT_HI) + (size_t)layer * NE * D; const bf16* rtlo = (const bf16*)(F.ws + WS_RT_LO) + (size_t)layer * NE * D;
    const float* rbias = gin(p, 17) + layer * NE;
    unsigned* cnt = (unsigned*)(F.ws + WS_CTL) + CW_CNT + layer * NE * 64;
    int* lists = (int*)(F.ws + WS_LIST); int* tokmap = (int*)(F.ws + WS_LIST + 4 * MiB); float* tokgate = (float*)(F.ws + WS_LIST + 5 * MiB);
    constexpr int XLD = 1032, MAXT = 8;
    LAS bf16* Xhi = (LAS bf16*)F.lds; LAS bf16* Xlo = Xhi + 16 * XLD;
    LAS float* part = (LAS float*)(F.lds + 2 * 16 * XLD * 2);
    LAS int* ent = (LAS int*)(part + 2 * 16 * 64);
    LAS int* hist = ent + MAXT * 16 * 8 * 2; LAS int* base = hist + 64;
    const int lane = F.lane, w = F.wave, g4 = lane >> 4, l15 = lane & 15;
    if (F.tid < 64) hist[F.tid] = 0;
    bf16x8 bhi[16], blo[16];
    { const int nt = w & 3, kh = w >> 2; const bf16* bh = rthi + (size_t)(16 * nt + l15) * D + 512 * kh + 8 * g4; const bf16* bl = rtlo + (size_t)(16 * nt + l15) * D + 512 * kh + 8 * g4;
#pragma unroll
        for (int ks = 0; ks < 16; ++ks) { bhi[ks] = *(const bf16x8*)(bh + 32 * ks); blo[ks] = *(const bf16x8*)(bl + 32 * ks); } }
    u32x4 ypre[2][2];
    if (F.vcu < T / 16) {
#pragma unroll
        for (int rr = 0; rr < 2; ++rr)
#pragma unroll
            for (int j = 0; j < 2; ++j) ypre[rr][j] = *(const u32x4*)(Y + (size_t)(F.vcu * 16 + 2 * w + rr) * D + 8 * lane + 512 * j); }
    int ntile = 0;
    for (int tile = F.vcu; tile < T / 16 && ntile < MAXT; tile += F.G, ++ntile) {
        const int t0 = tile * 16;
        u32x4 ycur[2][2];
#pragma unroll
        for (int rr = 0; rr < 2; ++rr)
#pragma unroll
            for (int j = 0; j < 2; ++j) ycur[rr][j] = ypre[rr][j];
        if (tile + F.G < T / 16) {
#pragma unroll
            for (int rr = 0; rr < 2; ++rr)
#pragma unroll
                for (int j = 0; j < 2; ++j) ypre[rr][j] = *(const u32x4*)(Y + (size_t)((tile + F.G) * 16 + 2 * w + rr) * D + 8 * lane + 512 * j); }
#pragma unroll
        for (int rr = 0; rr < 2; ++rr) {
            const int lr = 2 * w + rr; const size_t row = (size_t)(t0 + lr);
            f32x4 v[4]; float s = 0.f;
#pragma unroll
            for (int j = 0; j < 2; ++j) unpack_bf16x8(ycur[rr][j], v[2 * j], v[2 * j + 1]);
#pragma unroll
            for (int j = 0; j < 4; ++j) s += (v[j][0] + v[j][1]) + (v[j][2] + v[j][3]);
            const float mean = wave_sum(s, lane) * (1.f / D); float s2 = 0.f;
#pragma unroll
            for (int j = 0; j < 4; ++j) { v[j] = v[j] - mean; s2 += (v[j][0] * v[j][0] + v[j][1] * v[j][1]) + (v[j][2] * v[j][2] + v[j][3] * v[j][3]); }
            const float rstd = 1.0f / sqrtf(wave_sum(s2, lane) * (1.f / D) + LN_EPS);
#pragma unroll
            for (int j = 0; j < 2; ++j) { const f32x4 g0 = *(const f32x4*)(lng + 8 * lane + 512 * j), g1 = *(const f32x4*)(lng + 8 * lane + 512 * j + 4), b0 = *(const f32x4*)(lnb + 8 * lane + 512 * j), b1 = *(const f32x4*)(lnb + 8 * lane + 512 * j + 4);
                const f32x4 o0 = v[2 * j] * rstd * g0 + b0, o1 = v[2 * j + 1] * rstd * g1 + b1;
                const u32x4 hi = pack_bf16x8(o0, o1);
                *(u32x4*)(XB + row * D + 8 * lane + 512 * j) = hi;
                { u32x2 q8; q8.x = pk4_fp8(o0[0], o0[1], o0[2], o0[3]); q8.y = pk4_fp8(o1[0], o1[1], o1[2], o1[3]); *(u32x2*)(XB8 + row * D + 8 * lane + 512 * j) = q8; }
                f32x4 h0, h1; unpack_bf16x8(hi, h0, h1); const u32x4 lo = pack_bf16x8(o0 - h0, o1 - h1);
                *(LAS u32x4*)(Xhi + lr * XLD + 8 * lane + 512 * j) = hi; *(LAS u32x4*)(Xlo + lr * XLD + 8 * lane + 512 * j) = lo; }
        }
        __syncthreads();
        { const int nt = w & 3, kh = w >> 2; f32x4 a0 = (f32x4){0.f, 0.f, 0.f, 0.f}, a1 = a0, a2 = a0, a3 = a0, a4 = a0, a5 = a0;
#pragma unroll
            for (int ks = 0; ks < 16; ks += 2) { const int k0 = 512 * kh + 32 * ks;
                const bf16x8 ahi = row_frag(Xhi, XLD, 0, k0, lane), alo = row_frag(Xlo, XLD, 0, k0, lane), bhi2 = row_frag(Xhi, XLD, 0, k0 + 32, lane), blo2 = row_frag(Xlo, XLD, 0, k0 + 32, lane);
                a0 = MFMA16(ahi, bhi[ks], a0); a1 = MFMA16(alo, bhi[ks], a1); a2 = MFMA16(ahi, blo[ks], a2);
                a3 = MFMA16(bhi2, bhi[ks + 1], a3); a4 = MFMA16(blo2, bhi[ks + 1], a4); a5 = MFMA16(bhi2, blo[ks + 1], a5); }
            const f32x4 acc = ((a0 + a3) + (a1 + a4)) + (a2 + a5);
#pragma unroll
            for (int i = 0; i < 4; ++i) part[(kh * 16 + 4 * g4 + i) * 64 + 16 * nt + l15] = acc[i];
        }
        __syncthreads();
#pragma unroll
        for (int rr = 0; rr < 2; ++rr) {
            const int lt = ntile * 16 + 2 * w + rr;
            const float lg = part[(2 * w + rr) * 64 + lane] + part[(16 + 2 * w + rr) * 64 + lane];
            float sc = 1.0f / (1.0f + expf(-lg)); sc = (sc == sc) ? sc : 0.5f;
            const float sel = sc + rbias[lane];
            const float m1 = max8(sel);
            const unsigned long long eq = __ballot(sel == m1);
            const unsigned gm = (unsigned)(eq >> (lane & 56)) & 0xffu;
            const int first = (lane & 56) + __builtin_ctz(gm | 0x100u);
            const float m2 = max8((lane == first) ? -INFINITY : sel);
            const float gs = m1 + m2; const int mygrp = lane >> 3; int grank = 0;
#pragma unroll
            for (int gg = 0; gg < 8; ++gg) { const float o = rdl(gs, 8 * gg); grank += (o > gs || (o == gs && gg < mygrp)) ? 1 : 0; }
            const float mv = (grank < 4) ? sel : -INFINITY;
            unsigned key = __builtin_bit_cast(unsigned, mv); key = (key >> 31) ? ~key : (key | 0x80000000u); key = (key & ~63u) | (unsigned)(63 - lane);
            int r0 = 0, r1 = 0, r2 = 0, r3 = 0;
#pragma unroll
            for (int e2 = 0; e2 < 64; e2 += 4) { r0 += ((unsigned)__builtin_amdgcn_readlane((int)key, e2) > key) ? 1 : 0; r1 += ((unsigned)__builtin_amdgcn_readlane((int)key, e2 + 1) > key) ? 1 : 0;
                r2 += ((unsigned)__builtin_amdgcn_readlane((int)key, e2 + 2) > key) ? 1 : 0; r3 += ((unsigned)__builtin_amdgcn_readlane((int)key, e2 + 3) > key) ? 1 : 0; }
            const int rank = (r0 + r1) + (r2 + r3);
            const bool chosen = rank < TOPK;
            const float wsum = wave_sum(chosen ? sc : 0.f, lane);
            if (chosen) { const int lpos = __hip_atomic_fetch_add(hist + lane, 1, __ATOMIC_RELAXED, __HIP_MEMORY_SCOPE_WORKGROUP);
                ent[(lt * 8 + rank) * 2] = (lane << 16) | lpos; ent[(lt * 8 + rank) * 2 + 1] = __builtin_bit_cast(int, sc / wsum * 2.5f); }
        }
    }
    __syncthreads();
    if (dry) return;
    if (F.tid < 64) { const int hcount = hist[F.tid]; base[F.tid] = hcount ? (int)atomicAdd(cnt + F.tid * 64, (unsigned)hcount) : 0; }
    __syncthreads();
    for (int idx = F.tid; idx < ntile * 16 * 8; idx += NTHREADS) {
        const int ev = ent[idx * 2], gb = ent[idx * 2 + 1]; const int e = ev >> 16, pos = base[e] + (ev & 0xffff);
        const int lt = idx >> 3, rank = idx & 7, tok = (F.vcu + (lt >> 4) * F.G) * 16 + (lt & 15);
        lists[(size_t)e * T + pos] = tok; tokmap[tok * 8 + rank] = (e << 16) | pos; tokgate[tok * 8 + rank] = __builtin_bit_cast(float, gb);
    }
}

__device__ __forceinline__ void phase_combine(const Frame& F, KP p, int layer, bool dry = false) {
    bf16* XB = (bf16*)(F.ws + WS_XB); const unsigned char* yexp = (const unsigned char*)(F.ws + WS_BIG);
    const int* tokmap = (const int*)(F.ws + WS_LIST + 4 * MiB); const float* tokgate = (const float*)(F.ws + WS_LIST + 5 * MiB);
    const volatile LAS int* tstart = (const volatile LAS int*)(F.MISC + 64);
    const float* lng = gin(p, 24) + (size_t)(layer * 2 + 1) * D; const float* lnb = gin(p, 25) + (size_t)(layer * 2 + 1) * D;
    float* outp = gout(p); bf16* xbo = XB; if (dry) { outp = (float*)(F.ws + WS_AUX); xbo = (bf16*)(F.ws + WS_H); }
    const int lane = F.lane, gw = F.vcu * NWAVES + F.wave, NGW = F.G * NWAVES;
    const bf16* ysh = (const bf16*)(F.ws + WS_Y);
    f32x4 gv[4], bv[4];
#pragma unroll
    for (int j = 0; j < 4; ++j) { gv[j] = *(const f32x4*)(lng + 16 * lane + 4 * j); bv[j] = *(const f32x4*)(lnb + 16 * lane + 4 * j); }
    for (int row = gw; row < T; row += NGW) {
        const int mk = tokmap[row * 8 + (lane & 7)]; const float gk = tokgate[row * 8 + (lane & 7)] * YEXP_INV;
        const int rk = (int)tstart[mk >> 16] * 256 + (mk & 0xffff);
        f32x4 v[4];
#pragma unroll
        for (int j = 0; j < 2; ++j) { const u32x4 xw = *(const u32x4*)(ysh + (size_t)row * D + 16 * lane + 8 * j); unpack_bf16x8(xw, v[2 * j], v[2 * j + 1]); }
#pragma unroll
        for (int k = 0; k < TOPK; ++k) { const int r = __builtin_amdgcn_readlane(rk, k); const float g = rdl(gk, k);
            const u32x4 s = *(const u32x4*)(yexp + (size_t)r * D + 16 * lane);
#pragma unroll
            for (int j = 0; j < 4; ++j) { const f32x2 lo = __builtin_amdgcn_cvt_pk_f32_fp8((int)s[j], false), hi = __builtin_amdgcn_cvt_pk_f32_fp8((int)s[j], true);
                v[j][0] += g * lo[0]; v[j][1] += g * lo[1]; v[j][2] += g * hi[0]; v[j][3] += g * hi[1]; } }
        float s = 0.f;
#pragma unroll
        for (int j = 0; j < 4; ++j) s += (v[j][0] + v[j][1]) + (v[j][2] + v[j][3]);
        const float mean = wave_sum(s, lane) * (1.f / D); float s2 = 0.f;
#pragma unroll
        for (int j = 0; j < 4; ++j) { v[j] = v[j] - mean; s2 += (v[j][0] * v[j][0] + v[j][1] * v[j][1]) + (v[j][2] * v[j][2] + v[j][3] * v[j][3]); }
        const float rstd = 1.0f / sqrtf(wave_sum(s2, lane) * (1.f / D) + LN_EPS);
        f32x4 o[4];
#pragma unroll
        for (int j = 0; j < 4; ++j) o[j] = v[j] * rstd * gv[j] + bv[j];
        if (layer == DEPTH - 1 || dry) {
#pragma unroll
            for (int j = 0; j < 4; ++j) *(f32x4*)(outp + (size_t)row * D + 16 * lane + 4 * j) = o[j]; }
        if (layer != DEPTH - 1) { *(u32x4*)(xbo + (size_t)row * D + 16 * lane) = pack_bf16x8(o[0], o[1]); *(u32x4*)(xbo + (size_t)row * D + 16 * lane + 8) = pack_bf16x8(o[2], o[3]);
            if (!dry) { u32x4 q8; q8.x = pk4_fp8(o[0][0], o[0][1], o[0][2], o[0][3]); q8.y = pk4_fp8(o[1][0], o[1][1], o[1][2], o[1][3]); q8.z = pk4_fp8(o[2][0], o[2][1], o[2][2], o[2][3]); q8.w = pk4_fp8(o[3][0], o[3][1], o[3][2], o[3][3]);
                *(u32x4*)((unsigned char*)(F.ws + WS_X) + (size_t)row * D + 16 * lane) = q8; } }
    }
}

constexpr size_t AUX_OB = 96 * MiB, AUX_LSE = 128 * MiB;
__device__ __forceinline__ void phase_attn(const Frame& F, int bx) {
    const bf16* qkv = (const bf16*)(F.ws + WS_BIG); bf16* og = (bf16*)(F.ws + WS_AUX); float* lse = (float*)(F.ws + WS_AUX + AUX_LSE);
    constexpr int KLD = 136;
    LAS bf16* Ks = (LAS bf16*)F.lds; LAS bf16* Vs = Ks + 256 * KLD;
    const int lane = F.lane, w = F.wave, g4 = lane >> 4, l15 = lane & 15, qq = l15 >> 2, pp = lane & 3;
    u32x4 kc[4], vc[4];
    constexpr int NRUN = 768;
#define ATT_LOADBLK(KR, VR, nblk) do { _Pragma("unroll") for (int it = 0; it < 4; ++it) { const int idx = F.tid + 512 * it, c = idx >> 4, ch = idx & 15; int pos = 128 * (nblk) + c; pos = pos < 0 ? 0 : pos; \
            const unsigned so = (rowbase + (unsigned)pos * (unsigned)d + (unsigned)r) * (unsigned)ATT_IN + (unsigned)(g * 3072 + 1024 + h * 128 + ch * 8); KR[it] = *(const u32x4*)(qkv + so); VR[it] = *(const u32x4*)(qkv + so + 1024u); } } while (0)
#define ATT_STOREBLK(KR, VR, slot) do { _Pragma("unroll") for (int it = 0; it < 4; ++it) { const int idx = F.tid + 512 * it, c = idx >> 4, ch = idx & 15; \
            *(LAS u32x4*)(Ks + (128 * (slot) + c) * KLD + ch * 8) = KR[it]; *(LAS u32x4*)(Vs + (128 * (slot) + c) * KLD + ch * 8) = VR[it]; } } while (0)
    for (int R = bx; R < NRUN; R += F.G) {
        const int h = R & 7, sbr = R >> 3, g = sbr >> 5, rem = sbr & 31, b = rem >> 4, rr_ = rem & 15;
        const int dsh = 2 * g, d = 1 << dsh, nrs = 4 - dsh, r = rr_ >> nrs, n0 = 4 * (rr_ & ((1 << nrs) - 1)); const unsigned rowbase = (unsigned)b * SEQ;
        ATT_LOADBLK(kc, vc, n0 - 1); ATT_STOREBLK(kc, vc, (n0 - 1) & 1); ATT_LOADBLK(kc, vc, n0);
#pragma unroll 1
        for (int j = 0; j < 4; ++j) {
            const int n = n0 + j, cs = n & 1, ps = cs ^ 1;
            ATT_STOREBLK(kc, vc, cs);
            const int qi = 16 * w + l15; const unsigned qrow = rowbase + (unsigned)(128 * n + qi) * (unsigned)d + (unsigned)r;
            bf16x8 qf[4];
#pragma unroll
            for (int s = 0; s < 4; ++s) qf[s] = *(const bf16x8*)(qkv + (qrow * (unsigned)ATT_IN + (unsigned)(g * 3072 + h * 128 + 32 * s + 8 * g4)));
            __syncthreads();
            if (j < 3) { ATT_LOADBLK(kc, vc, n + 1); }
            __builtin_amdgcn_sched_barrier(0);
            const int ws0 = (16 * w < 96) ? 16 * w : 96;
#define ATT_PROW(c0) (((c0) < 128) ? (128 * ps + (c0)) : (128 * cs + (c0) - 128))
            f32x4 sacc[10];
            {
                bf16x8 kfa[4], kfb[4];
#pragma unroll
                for (int s = 0; s < 4; ++s) kfa[s] = row_frag(Ks, KLD, ATT_PROW(ws0), 32 * s, lane);
#pragma unroll
                for (int t = 0; t < 10; t += 2) {
#pragma unroll
                    for (int s = 0; s < 4; ++s) kfb[s] = row_frag(Ks, KLD, ATT_PROW(ws0 + 16 * (t + 1)), 32 * s, lane);
                    __builtin_amdgcn_sched_barrier(0);
                    sacc[t] = (f32x4){0.f, 0.f, 0.f, 0.f};
#pragma unroll
                    for (int s = 0; s < 4; ++s) sacc[t] = MFMA16(kfa[s], qf[s], sacc[t]);
                    if (t + 2 < 10) {
#pragma unroll
                        for (int s = 0; s < 4; ++s) kfa[s] = row_frag(Ks, KLD, ATT_PROW(ws0 + 16 * (t + 2)), 32 * s, lane); }
                    __builtin_amdgcn_sched_barrier(0);
                    sacc[t + 1] = (f32x4){0.f, 0.f, 0.f, 0.f};
#pragma unroll
                    for (int s = 0; s < 4; ++s) sacc[t + 1] = MFMA16(kfb[s], qf[s], sacc[t + 1]);
                }
            }
            const float slope = exp2f(-(float)(h + 1)) * (float)d;
            float mx = -INFINITY;
#pragma unroll
            for (int t = 0; t < 10; ++t)
#pragma unroll
                for (int i = 0; i < 4; ++i) { const int c = ws0 + 16 * t + 4 * g4 + i, step = 128 + qi - c;
                    const bool valid = (step >= 0) && (step <= 128) && (n > 0 || c >= 128);
                    const float v = valid ? sacc[t][i] - slope * (float)step : -INFINITY; sacc[t][i] = v; mx = fmaxf(mx, v); }
            mx = fmaxf(mx, shx(mx, 16, lane)); mx = fmaxf(mx, shx(mx, 32, lane));
            float lsum = 0.f;
#pragma unroll
            for (int t = 0; t < 10; ++t)
#pragma unroll
                for (int i = 0; i < 4; ++i) { const float pv = __expf(sacc[t][i] - mx); sacc[t][i] = pv; lsum += pv; }
            lsum += shx(lsum, 16, lane); lsum += shx(lsum, 32, lane);
            bf16x8 pf[5];
#pragma unroll
            for (int kt = 0; kt < 5; ++kt) pf[kt] = pack8(sacc[2 * kt], sacc[2 * kt + 1]);
            f32x4 o[8];
            {
                const LAS bf16* vl = Vs + (4 * g4 + qq) * KLD + 32 * pp;
                bf16x4 va[10], vcc[10];
#pragma unroll
                for (int q = 0; q < 10; ++q) va[q] = tr4(vl + ATT_PROW(ws0 + 16 * q) * KLD);
#pragma unroll
                for (int et = 0; et < 8; et += 2) {
#pragma unroll
                    for (int q = 0; q < 10; ++q) vcc[q] = tr4(vl + ATT_PROW(ws0 + 16 * q) * KLD + 4 * (et + 1));
                    __builtin_amdgcn_sched_barrier(0);
                    o[et] = (f32x4){0.f, 0.f, 0.f, 0.f};
#pragma unroll
                    for (int kt = 0; kt < 5; ++kt) o[et] = MFMA16(cat8(va[2 * kt], va[2 * kt + 1]), pf[kt], o[et]);
                    if (et + 2 < 8) {
#pragma unroll
                        for (int q = 0; q < 10; ++q) va[q] = tr4(vl + ATT_PROW(ws0 + 16 * q) * KLD + 4 * (et + 2)); }
                    __builtin_amdgcn_sched_barrier(0);
                    o[et + 1] = (f32x4){0.f, 0.f, 0.f, 0.f};
#pragma unroll
                    for (int kt = 0; kt < 5; ++kt) o[et + 1] = MFMA16(cat8(vcc[2 * kt], vcc[2 * kt + 1]), pf[kt], o[et + 1]);
                }
            }
#undef ATT_PROW
            const float inv = 1.0f / lsum;
            bf16* orow = og + ((size_t)g * T + qrow) * D + h * 128 + 32 * g4;
#pragma unroll
            for (int e2 = 0; e2 < 4; ++e2) *(u32x4*)(orow + 8 * e2) = pack_bf16x8(o[2 * e2] * inv, o[2 * e2 + 1] * inv);
            if (g4 == 0) lse[((size_t)g * T + qrow) * AH + h] = mx + __logf(lsum);
            __syncthreads();
        }
    }
#undef ATT_LOADBLK
#undef ATT_STOREBLK
}
__device__ __forceinline__ void phase_attn_combine(const Frame& F) {
    const bf16* og = (const bf16*)(F.ws + WS_AUX); const float* lse = (const float*)(F.ws + WS_AUX + AUX_LSE); bf16* ob = (bf16*)(F.ws + WS_AUX + AUX_OB);
    const int lane = F.lane, gw = F.vcu * NWAVES + F.wave, NGW = F.G * NWAVES, h = lane >> 3;
    for (int row = gw; row < T; row += NGW) {
        const float l0 = lse[((size_t)0 * T + row) * AH + h], l1 = lse[((size_t)1 * T + row) * AH + h], l2 = lse[((size_t)2 * T + row) * AH + h];
        const float m = fmaxf(l0, fmaxf(l1, l2)); float w0 = __expf(l0 - m), w1 = __expf(l1 - m), w2 = __expf(l2 - m); const float inv = 1.0f / (w0 + w1 + w2); w0 *= inv; w1 *= inv; w2 *= inv;
        float a[16];
#pragma unroll
        for (int j = 0; j < 16; ++j) a[j] = 0.f;
#pragma unroll
        for (int g = 0; g < 3; ++g) { const float wg = (g == 0) ? w0 : (g == 1 ? w1 : w2);
#pragma unroll
            for (int q = 0; q < 2; ++q) { const u32x4 s = *(const u32x4*)(og + ((size_t)g * T + row) * D + 16 * lane + 8 * q);
                a[8 * q + 0] += wg * bflo(s.x); a[8 * q + 1] += wg * bfhi(s.x); a[8 * q + 2] += wg * bflo(s.y); a[8 * q + 3] += wg * bfhi(s.y);
                a[8 * q + 4] += wg * bflo(s.z); a[8 * q + 5] += wg * bfhi(s.z); a[8 * q + 6] += wg * bflo(s.w); a[8 * q + 7] += wg * bfhi(s.w); } }
#pragma unroll
        for (int q = 0; q < 2; ++q) { u32x4 o; o.x = pk2(a[8 * q], a[8 * q + 1]); o.y = pk2(a[8 * q + 2], a[8 * q + 3]); o.z = pk2(a[8 * q + 4], a[8 * q + 5]); o.w = pk2(a[8 * q + 6], a[8 * q + 7]);
            *(u32x4*)(ob + (size_t)row * D + 16 * lane + 8 * q) = o; }
    }
}

constexpr size_t BIG_YRET = 192 * MiB;
__device__ __forceinline__ void phase_ret_u(const Frame& F) {
    const bf16* proj = (const bf16*)(F.ws + WS_BIG); bf16* St = (bf16*)(F.ws + WS_AUX);
    constexpr int LD = 264;
    LAS bf16* Kt = (LAS bf16*)F.lds; LAS bf16* Vt = Kt + 128 * LD;
    const int lane = F.lane, w = F.wave, g4 = lane >> 4, l15 = lane & 15, qq = l15 >> 2, pp = lane & 3;
    for (int u = F.vcu; u < 1024; u += F.G) {
        const int eh = u & 1, h = (u >> 1) & 3, n = (u >> 3) & 63, b = u >> 9;
        const size_t row0 = (size_t)b * SEQ + (size_t)n * RC;
#pragma unroll 4
        for (int it = 0; it < 8; ++it) { const int idx = F.tid + 512 * it, j = idx >> 5, ch = idx & 31;
            const bf16* src = proj + (row0 + j) * RET_IN;
            const u32x4 kv = *(const u32x4*)(src + 1024 + h * 256 + ch * 8), vv = *(const u32x4*)(src + 2048 + h * 512 + eh * 256 + ch * 8);
            *(LAS u32x4*)(Kt + j * LD + ch * 8) = kv; *(LAS u32x4*)(Vt + j * LD + ch * 8) = vv; }
        __syncthreads();
        f32x4 acc[16][2];
#pragma unroll
        for (int mt = 0; mt < 16; ++mt) { acc[mt][0] = (f32x4){0.f, 0.f, 0.f, 0.f}; acc[mt][1] = (f32x4){0.f, 0.f, 0.f, 0.f}; }
#pragma unroll
        for (int ks = 0; ks < 4; ++ks) {
            bf16x8 bfr[2];
#pragma unroll
            for (int nt = 0; nt < 2; ++nt) { const LAS bf16* a0 = Vt + (32 * ks + 8 * g4 + qq) * LD + 32 * w + 16 * nt + 4 * pp; bfr[nt] = cat8(tr4(a0), tr4(a0 + 4 * LD)); }
#pragma unroll
            for (int mt = 0; mt < 16; ++mt) { const LAS bf16* a0 = Kt + (32 * ks + 8 * g4 + qq) * LD + 128 * (mt >> 3) + 32 * pp + 4 * (mt & 7);
                const bf16x8 afr = cat8(tr4(a0), tr4(a0 + 4 * LD));
                acc[mt][0] = MFMA16(afr, bfr[0], acc[mt][0]); acc[mt][1] = MFMA16(afr, bfr[1], acc[mt][1]); }
        }
        bf16* outb = St + ((size_t)((b * RH + h) * RNC + n)) * (RDV * RDK);
#pragma unroll
        for (int nt = 0; nt < 2; ++nt) { bf16* orow = outb + (size_t)(eh * 256 + 32 * w + 16 * nt + l15) * RDK + 32 * g4;
#pragma unroll
            for (int mh = 0; mh < 2; ++mh)
#pragma unroll
                for (int q = 0; q < 4; ++q) *(u32x4*)(orow + 128 * mh + 8 * q) = pack_bf16x8(acc[mh * 8 + 2 * q][nt], acc[mh * 8 + 2 * q + 1][nt]); }
        __syncthreads();
    }
}
__device__ __forceinline__ void phase_ret_scan(const Frame& F) {
    bf16* St = (bf16*)(F.ws + WS_AUX);
    for (int gt = F.vcu * NTHREADS + F.tid; gt < 8 * 16384; gt += F.G * NTHREADS) {
        const int bh = gt >> 14, chunk = gt & 16383, h = bh & 3;
        const float g128 = exp2f(128.0f * log2f(1.0f - exp2f(-5.0f - (float)h)));
        bf16* base = St + (size_t)bh * RNC * (RDV * RDK) + (size_t)chunk * 8;
        float c[8];
#pragma unroll
        for (int j = 0; j < 8; ++j) c[j] = 0.f;
#pragma unroll 8
        for (int n = 0; n < RNC; ++n) { bf16* pn = base + (size_t)n * (RDV * RDK); const u32x4 uv = *(const u32x4*)pn;
            u32x4 o; o.x = pk2(c[0], c[1]); o.y = pk2(c[2], c[3]); o.z = pk2(c[4], c[5]); o.w = pk2(c[6], c[7]); *(u32x4*)pn = o;
            c[0] = g128 * (c[0] + bflo(uv.x)); c[1] = g128 * (c[1] + bfhi(uv.x)); c[2] = g128 * (c[2] + bflo(uv.y)); c[3] = g128 * (c[3] + bfhi(uv.y));
            c[4] = g128 * (c[4] + bflo(uv.z)); c[5] = g128 * (c[5] + bfhi(uv.z)); c[6] = g128 * (c[6] + bflo(uv.w)); c[7] = g128 * (c[7] + bfhi(uv.w)); }
    }
}
__device__ __forceinline__ void phase_ret_out(const Frame& F, KP p) {
    const bf16* proj = (const bf16*)(F.ws + WS_BIG); const bf16* St = (const bf16*)(F.ws + WS_AUX); bf16* yret = (bf16*)(F.ws + WS_BIG + BIG_YRET);
    const float* gng = gin(p, 4); const float* gnb = gin(p, 5);
    constexpr int LD = 264, VLD = 72, NSL = 8, ESL = 64;
    LAS bf16* Rs = (LAS bf16*)F.lds; LAS bf16* Vs = Rs + 128 * LD;
    const int w = F.wave;
#define RO_TID(t_) int t_ = F.tid; asm volatile("" : "+v"(t_))
#define RO_LD(base_, off_) (*(const u32x4*)((const char*)(base_) + (off_)))
    for (int u = F.vcu; u < 512; u += F.G) {
        const int h = u & 3, n = (u >> 2) & 63, b = u >> 8;
        const size_t row0 = (size_t)b * SEQ + (size_t)n * RC;
        const bf16* Sn = St + ((size_t)((b * RH + h) * RNC + n)) * (RDV * RDK);
        const char* pbase = (const char*)(proj + row0 * RET_IN);
        u32x4 pv[2], ps[4];
        bf16x8 qf[8];
        { RO_TID(t0); u32x4 kreg[8];
          unsigned koff = (unsigned)(((t0 >> 5) * RET_IN + (t0 & 31) * 8) * 2), qoff = (unsigned)(((16 * w + (t0 & 15)) * RET_IN + 8 * ((t0 & 63) >> 4)) * 2);
#pragma unroll
          for (int it = 0; it < 8; ++it) { asm volatile("" : "+v"(koff)); kreg[it] = RO_LD(pbase + (size_t)(1024 + h * 256 + it * 16 * RET_IN) * 2, koff); }
#pragma unroll
          for (int s = 0; s < 8; ++s) { asm volatile("" : "+v"(qoff)); qf[s] = __builtin_bit_cast(bf16x8, RO_LD(pbase + (size_t)(h * 256 + 32 * s) * 2, qoff)); }
#define RO_LOAD_SLICE(sl_) do { RO_TID(tl_); unsigned voff = (unsigned)(((tl_ >> 3) * RET_IN + (tl_ & 7) * 8) * 2), soff = (unsigned)(((tl_ >> 5) * RDK + (tl_ & 31) * 8) * 2); \
            _Pragma("unroll") for (int it = 0; it < 2; ++it) { asm volatile("" : "+v"(voff)); pv[it] = RO_LD(pbase + (size_t)(2048 + h * 512 + (sl_) * ESL + it * 64 * RET_IN) * 2, voff); } \
            _Pragma("unroll") for (int it = 0; it < 4; ++it) { asm volatile("" : "+v"(soff)); ps[it] = RO_LD((const char*)Sn + (size_t)(((sl_) * ESL + it * 16) * RDK) * 2, soff); } } while (0)
          RO_LOAD_SLICE(0);
#pragma unroll
          for (int it = 0; it < 8; ++it) { const int idx = t0 + 512 * it, j = idx >> 5, ch = idx & 31; *(LAS u32x4*)(Rs + j * LD + ch * 8) = kreg[it]; } }
        __syncthreads();
        bf16x8 pf[4];
        { RO_TID(t1); const int lane = t1 & 63, g4 = lane >> 4, irow = 16 * w + (lane & 15);
          f32x4 sacc[8];
#pragma unroll
            for (int jt = 0; jt < 8; ++jt) { sacc[jt] = (f32x4){0.f, 0.f, 0.f, 0.f};
                if (jt <= w) {
#pragma unroll
                    for (int s = 0; s < 8; ++s) sacc[jt] = MFMA16(row_frag(Rs, LD, 16 * jt, 32 * s, lane), qf[s], sacc[jt]);
#pragma unroll
                    for (int i = 0; i < 4; ++i) if (16 * jt + 4 * g4 + i > irow) sacc[jt][i] = 0.f; } }
#pragma unroll
            for (int kt = 0; kt < 4; ++kt) pf[kt] = pack8(sacc[2 * kt], sacc[2 * kt + 1]); }
        __syncthreads();
        u32x4 accp[NSL][2];
        float s1 = 0.f, s2 = 0.f;
#pragma unroll
        for (int sl = 0; sl < NSL; ++sl) {
            { RO_TID(t2);
#pragma unroll
              for (int it = 0; it < 2; ++it) { const int idx = t2 + 512 * it, j = idx >> 3, ch = idx & 7; *(LAS u32x4*)(Vs + j * VLD + ch * 8) = pv[it]; }
#pragma unroll
              for (int it = 0; it < 4; ++it) { const int idx = t2 + 512 * it, e = idx >> 5, ch = idx & 31; *(LAS u32x4*)(Rs + e * LD + ch * 8) = ps[it]; } }
            __syncthreads();
            if (sl + 1 < NSL) RO_LOAD_SLICE(sl + 1);
            RO_TID(t3); const int lane = t3 & 63, g4 = lane >> 4, qq = (lane & 15) >> 2, pp = lane & 3;
            f32x4 acc[4];
#pragma unroll
            for (int et = 0; et < 4; ++et) { f32x4 a = (f32x4){0.f, 0.f, 0.f, 0.f};
#pragma unroll
                for (int kt = 0; kt < 4; ++kt) if (2 * kt <= w) { const LAS bf16* a0 = Vs + (32 * kt + 4 * g4 + qq) * VLD + 16 * pp + 4 * et;
                    a = MFMA16(cat8(tr4(a0), tr4(a0 + 16 * VLD)), pf[kt], a); }
                const LAS bf16* srow = Rs + (16 * qq + 4 * et + pp) * LD + 8 * g4;
#pragma unroll
                for (int s = 0; s < 8; ++s) a = MFMA16(*(const LAS bf16x8*)(srow + 32 * s), qf[s], a);
                acc[et] = a; s1 += (a[0] + a[1]) + (a[2] + a[3]); s2 += (a[0] * a[0] + a[1] * a[1]) + (a[2] * a[2] + a[3] * a[3]);
                __builtin_amdgcn_sched_barrier(0); }
            accp[sl][0] = pack_bf16x8(acc[0], acc[1]); accp[sl][1] = pack_bf16x8(acc[2], acc[3]);
            __syncthreads();
        }
#undef RO_LOAD_SLICE
        RO_TID(t4); const int lane = t4 & 63, g4 = lane >> 4, irow = 16 * w + (lane & 15); const size_t qrow = row0 + irow;
        s1 += shx(s1, 16, lane); s1 += shx(s1, 32, lane); s2 += shx(s2, 16, lane); s2 += shx(s2, 32, lane);
        const float mean = s1 * (1.0f / RDV); const float var = fmaxf(s2 * (1.0f / RDV) - mean * mean, 0.f);
        const float rstd = 1.0f / sqrtf(var + LN_EPS);
        unsigned goff = (unsigned)((irow * RET_IN + 16 * g4) * 2);
#pragma unroll
        for (int sp = 0; sp < NSL; sp += 2) {
            u32x4 gq[2][2]; f32x4 gg[2][4], gb[2][4];
#pragma unroll
            for (int d2 = 0; d2 < 2; ++d2) { const int c0 = h * RDV + (sp + d2) * ESL + 16 * g4;
#pragma unroll
                for (int q = 0; q < 2; ++q) { asm volatile("" : "+v"(goff)); gq[d2][q] = RO_LD(pbase + (size_t)(4096 + h * RDV + (sp + d2) * ESL + 8 * q) * 2, goff); }
#pragma unroll
                for (int q = 0; q < 4; ++q) { gg[d2][q] = *(const f32x4*)(gng + c0 + 4 * q); gb[d2][q] = *(const f32x4*)(gnb + c0 + 4 * q); } }
#pragma unroll
            for (int d2 = 0; d2 < 2; ++d2) { const int c0 = h * RDV + (sp + d2) * ESL + 16 * g4;
#pragma unroll
                for (int q = 0; q < 2; ++q) { const u32x4 gw = gq[d2][q]; f32x4 a0, a1; unpack_bf16x8(accp[sp + d2][q], a0, a1);
                    f32x4 y0 = (a0 - mean) * rstd * gg[d2][2 * q] + gb[d2][2 * q], y1 = (a1 - mean) * rstd * gg[d2][2 * q + 1] + gb[d2][2 * q + 1];
                    const float gv[8] = {bflo(gw.x), bfhi(gw.x), bflo(gw.y), bfhi(gw.y), bflo(gw.z), bfhi(gw.z), bflo(gw.w), bfhi(gw.w)};
#pragma unroll
                    for (int j = 0; j < 4; ++j) { y0[j] *= gv[j] * fsig(gv[j]); y1[j] *= gv[4 + j] * fsig(gv[4 + j]); }
                    *(u32x4*)(yret + qrow * RET_V + c0 + 8 * q) = pack_bf16x8(y0, y1); } }
        }
    }
#undef RO_LD
#undef RO_TID
}

constexpr size_t AUX_S5E = 64 * MiB;
constexpr int S5L = 256, S5NC = SEQ / S5L;
__device__ __forceinline__ void cmul_add(float& rr, float& ri, float ar, float ai, float xr, float xi, float cr, float ci) { rr = ar * xr - ai * xi + cr; ri = ar * xi + ai * xr + ci; }
template <bool OUT>
__device__ __forceinline__ void phase_s5_scan(const Frame& F, KP p) {
    const bf16* X = (const bf16*)(F.ws + WS_XB); float* E = (float*)(F.ws + WS_AUX + AUX_S5E); bf16* ybuf = (bf16*)(F.ws + WS_AUX);
    const int lane = F.lane, w = F.wave, g4 = lane >> 4, l15 = lane & 15;
    LAS bf16* ut = (LAS bf16*)(F.lds + w * 12288);
    LAS bf16* Hb = (LAS bf16*)(F.lds + w * 12288 + 4096);
    constexpr int HLD = 136;
    const int gw = F.vcu * NWAVES + w, NGW = F.G * NWAVES;
    const int up16 = (lane - 16) << 2, up32 = (lane - 32) << 2, last16 = (48 + l15) << 2;
    for (int unit = gw; unit < BATCH * SG * S5NC; unit += NGW) {
        const int n = unit & (S5NC - 1), g = (unit >> 5) & 63, b = unit >> 11;
        float a1r[4], a1i[4], a4r[4], a4i[4], a8r[4], a8i[4], pwr[4], pwi[4];
        bf16x8 bfrag[8];
        const float dt = expf(gin(p, 14)[g]);
#pragma unroll
        for (int st = 0; st < 4; ++st) { const int ps = 16 * st + l15;
            const float are = gin(p, 7)[g * SP + ps], aim = gin(p, 8)[g * SP + ps];
            const float mag = expf(dt * are); const float abr = mag * cosf(dt * aim), abi = mag * sinf(dt * aim);
            const float den = are * are + aim * aim;
            const float fre = ((abr - 1.0f) * are + abi * aim) / den, fim = (abi * are - (abr - 1.0f) * aim) / den;
            a1r[st] = abr; a1i[st] = abi; { float t2r, t2i; cmul_add(t2r, t2i, abr, abi, abr, abi, 0.f, 0.f); cmul_add(a4r[st], a4i[st], t2r, t2i, t2r, t2i, 0.f, 0.f); }
            cmul_add(a8r[st], a8i[st], a4r[st], a4i[st], a4r[st], a4i[st], 0.f, 0.f);
            float qr = 1.f, qi = 0.f;
            if (g4 & 1) { qr = a4r[st]; qi = a4i[st]; }
            if (g4 & 2) { float tr, ti; cmul_add(tr, ti, qr, qi, a8r[st], a8i[st], 0.f, 0.f); qr = tr; qi = ti; }
            pwr[st] = qr; pwi[st] = qi;
            const float* br = gin(p, 9) + ((size_t)g * SP + ps) * SGC + 8 * (g4 & 1); const float* bi = gin(p, 10) + ((size_t)g * SP + ps) * SGC + 8 * (g4 & 1);
            const f32x4 r0 = *(const f32x4*)br, r1 = *(const f32x4*)(br + 4), i0 = *(const f32x4*)bi, i1 = *(const f32x4*)(bi + 4);
            const float z = (g4 < 2) ? 1.0f : 0.0f; const float fr2 = fre * z, fi2 = fim * z;
            bfrag[st] = pack8(r0 * fr2 - i0 * fi2, r1 * fr2 - i1 * fi2); bfrag[st + 4] = pack8(i0 * fr2 + r0 * fi2, i1 * fr2 + r1 * fi2);
        }
        float sr[4], si[4];
        float* Eu = E + ((size_t)(b * SG + g) * S5NC + n) * 128;
        bf16x8 cf[4]; f32x4 dsk = (f32x4){0.f, 0.f, 0.f, 0.f};
#pragma unroll
        for (int st = 0; st < 4; ++st) { sr[st] = 0.f; si[st] = 0.f; }
        if (OUT) {
#pragma unroll
            for (int st = 0; st < 4; ++st) { sr[st] = Eu[16 * st + l15]; si[st] = Eu[64 + 16 * st + l15]; }
#pragma unroll
            for (int s = 0; s < 4; ++s) { const float* cp = (s < 2 ? gin(p, 11) : gin(p, 12)) + ((size_t)g * SGC + l15) * SP + 32 * (s & 1) + 8 * g4; const float sg = s < 2 ? 1.0f : -1.0f;
                const f32x4 c0 = *(const f32x4*)cp * sg, c1 = *(const f32x4*)(cp + 4) * sg; cf[s] = pack8(c0, c1); }
            dsk = *(const f32x4*)(gin(p, 13) + g * SGC + 4 * g4); }
        const size_t tok0 = (size_t)b * SEQ + (size_t)n * S5L;
        u32x4 pre[2];
        { const bf16* src = X + (tok0 + lane) * D + g * SGC; pre[0] = *(const u32x4*)src; pre[1] = *(const u32x4*)(src + 8); }
        for (int sub = 0; sub < S5L / 64; ++sub) {
            *(LAS u32x4*)(ut + lane * 16) = pre[0]; *(LAS u32x4*)(ut + lane * 16 + 8) = pre[1];
            if (sub + 1 < S5L / 64) { const bf16* src = X + (tok0 + (sub + 1) * 64 + lane) * D + g * SGC; pre[0] = *(const u32x4*)src; pre[1] = *(const u32x4*)(src + 8); }
            LDS_WAIT(); asm volatile("" ::: "memory");
#pragma unroll (OUT ? 1 : 4)
            for (int blk = 0; blk < 4; ++blk) {
                u32x4 uw = *(const LAS u32x4*)(ut + (blk * 16 + l15) * 16 + 8 * (g4 & 1));
                if (g4 >= 2) uw = (u32x4){0u, 0u, 0u, 0u};
                const bf16x8 ufr = __builtin_bit_cast(bf16x8, uw);
                f32x4 dr[4], di[4];
#pragma unroll
                for (int st = 0; st < 4; ++st) { dr[st] = MFMA16(ufr, bfrag[st], ((f32x4){0.f, 0.f, 0.f, 0.f})); di[st] = MFMA16(ufr, bfrag[st + 4], ((f32x4){0.f, 0.f, 0.f, 0.f})); }
                float vr[4], vi[4];
#pragma unroll
                for (int st = 0; st < 4; ++st) {
                    float hr = 0.f, hi = 0.f;
#pragma unroll
                    for (int i = 0; i < 4; ++i) { float nr, ni; cmul_add(nr, ni, a1r[st], a1i[st], hr, hi, dr[st][i], di[st][i]); hr = nr; hi = ni; dr[st][i] = hr; di[st][i] = hi; }
                    vr[st] = hr; vi[st] = hi; }
#define BPF(idx, v) __builtin_bit_cast(float, __builtin_amdgcn_ds_bpermute((idx), __builtin_bit_cast(int, (v))))
                { float xr[4], xi[4];
#pragma unroll
                  for (int st = 0; st < 4; ++st) { xr[st] = BPF(up16, vr[st]); xi[st] = BPF(up16, vi[st]); }
#pragma unroll
                  for (int st = 0; st < 4; ++st) { float tr, ti; cmul_add(tr, ti, a4r[st], a4i[st], xr[st], xi[st], vr[st], vi[st]); if (g4 >= 1) { vr[st] = tr; vi[st] = ti; } }
#pragma unroll
                  for (int st = 0; st < 4; ++st) { xr[st] = BPF(up32, vr[st]); xi[st] = BPF(up32, vi[st]); }
#pragma unroll
                  for (int st = 0; st < 4; ++st) { float tr, ti; cmul_add(tr, ti, a8r[st], a8i[st], xr[st], xi[st], vr[st], vi[st]); if (g4 >= 2) { vr[st] = tr; vi[st] = ti; } } }
                float er[4], ei[4], lr[4], li[4];
#pragma unroll
                for (int st = 0; st < 4; ++st) { if (OUT) { er[st] = BPF(up16, vr[st]); ei[st] = BPF(up16, vi[st]); } else { er[st] = 0.f; ei[st] = 0.f; } lr[st] = BPF(last16, vr[st]); li[st] = BPF(last16, vi[st]); }
#undef BPF
#pragma unroll
                for (int st = 0; st < 4; ++st) {
                    if (g4 == 0) { er[st] = 0.f; ei[st] = 0.f; }
                    if (OUT) { float s0r, s0i; cmul_add(s0r, s0i, pwr[st], pwi[st], sr[st], si[st], er[st], ei[st]);
#pragma unroll
                        for (int i = 0; i < 4; ++i) { float tr, ti; cmul_add(tr, ti, a1r[st], a1i[st], s0r, s0i, 0.f, 0.f); s0r = tr; s0i = ti; dr[st][i] += s0r; di[st][i] += s0i; } }
                    { float a16r, a16i; cmul_add(a16r, a16i, a8r[st], a8i[st], a8r[st], a8i[st], 0.f, 0.f); float tr, ti; cmul_add(tr, ti, a16r, a16i, sr[st], si[st], lr[st], li[st]); sr[st] = tr; si[st] = ti; }
                    if (OUT) {
#pragma unroll
                        for (int i = 0; i < 4; ++i) { const unsigned hw = pk2(dr[st][i], di[st][i]); Hb[(4 * g4 + i) * HLD + 16 * st + l15] = (bf16)hw; Hb[(4 * g4 + i) * HLD + 64 + 16 * st + l15] = (bf16)(hw >> 16); } }
                }
                if (OUT) {
                    LDS_WAIT(); asm volatile("" ::: "memory");
                    f32x4 ya = (f32x4){0.f, 0.f, 0.f, 0.f};
#pragma unroll
                    for (int s = 0; s < 4; ++s) ya = MFMA16(cf[s], row_frag(Hb, HLD, 0, 32 * s, lane), ya);
                    const u32x2 u2 = *(const LAS u32x2*)(ut + (blk * 16 + l15) * 16 + 4 * g4);
                    const f32x4 u4 = (f32x4){bflo(u2.x), bfhi(u2.x), bflo(u2.y), bfhi(u2.y)};
                    f32x4 y = ya + dsk * u4;
#pragma unroll
                    for (int j = 0; j < 4; ++j) { const float v = y[j]; y[j] = v * fsig(1.5957691216057308f * (v + 0.044715f * v * v * v)); }
                    u32x2 o; o.x = pk2(y[0], y[1]); o.y = pk2(y[2], y[3]);
                    *(u32x2*)(ybuf + (tok0 + sub * 64 + blk * 16 + l15) * D + g * SGC + 4 * g4) = o;
                    asm volatile("" ::: "memory"); }
            }
            LDS_WAIT(); asm volatile("" ::: "memory");
        }
        if (!OUT && g4 == 0) {
#pragma unroll
            for (int st = 0; st < 4; ++st) { Eu[16 * st + l15] = sr[st]; Eu[64 + 16 * st + l15] = si[st]; } }
    }
}
__device__ __forceinline__ void phase_s5_carry(const Frame& F, KP p) {
    float* E = (float*)(F.ws + WS_AUX + AUX_S5E);
    for (int gt = F.vcu * NTHREADS + F.tid; gt < BATCH * SG * SP; gt += F.G * NTHREADS) {
        const int pl = gt & 63, bg = gt >> 6, g = bg & 63;
        const float dt = expf(gin(p, 14)[g]); const float are = gin(p, 7)[g * SP + pl], aim = gin(p, 8)[g * SP + pl];
        const float mag = expf(dt * are); float ar = mag * cosf(dt * aim), ai = mag * sinf(dt * aim);
#pragma unroll
        for (int q = 0; q < 8; ++q) { const float nr = ar * ar - ai * ai, ni = 2.0f * ar * ai; ar = nr; ai = ni; }
        float cr = 0.f, ci = 0.f;
        for (int n = 0; n < S5NC; ++n) { float* Eu = E + ((size_t)bg * S5NC + n) * 128; const float er = Eu[pl], ei = Eu[64 + pl];
            Eu[pl] = cr; Eu[64 + pl] = ci;
            const float nr = ar * cr - ai * ci + er, ni = ar * ci + ai * cr + ei; cr = nr; ci = ni; }
    }
}

constexpr int NPHASES = 34;
#ifndef PROBE_DRY14
#define PROBE_DRY14 0
#endif
#ifndef PROBE_DRY17
#define PROBE_DRY17 0
#endif
#ifndef PH_MASK
#define PH_MASK 0xFFFFFFFFu
#endif
#define PHT(t) ((PH_MASK >> (t)) & 1u)
constexpr int PLAN_OFF = 64;
__device__ __forceinline__ void moe_plan(const Frame& F, int layer) {
    volatile LAS int* tstart = (volatile LAS int*)(F.MISC + PLAN_OFF); volatile LAS int* cnts = tstart + 72;
    __syncthreads();
    if (F.wave == 0) {
        const unsigned* cnt = (const unsigned*)(F.ws + WS_CTL) + CW_CNT + layer * NE * 64;
        const int c = (int)__hip_atomic_load(cnt + F.lane * 64, __ATOMIC_RELAXED, __HIP_MEMORY_SCOPE_AGENT);
        int v = (c + 255) >> 8;
#pragma unroll
        for (int o = 1; o < 64; o <<= 1) { const int nb = __builtin_amdgcn_ds_bpermute((F.lane - o) << 2, v); if (F.lane >= o) v += nb; }
        tstart[F.lane + 1] = v; cnts[F.lane] = c;
        if (F.lane == 0) tstart[0] = 0;
        if (F.lane == 63) { tstart[65] = v + T / 256; cnts[64] = T; }
    }
    __syncthreads();
}
template <bool GATH> struct MoeSched2 {
    static constexpr bool GATHER = GATH, UNIFORMIZE = true, FP8 = true;
    static constexpr int ncol = GATH ? 2 : 4, K = GATH ? D / 2 : ED / 2;
    const volatile LAS int* tstart; const volatile LAS int* cnts; int ntiles, G, c, lane;
    const char* Abase; const char* Wbase; const int* lists;
    __device__ __forceinline__ bool next(int i, pg8::UnitG& u) const {
        const int nwg = ntiles * ncol; const long L = (long)i * G + c; if (L >= nwg) return false;
        int wgid = (int)L; { const int q = nwg / 8, r = nwg % 8, xcd = wgid % 8, off = wgid / 8; wgid = (xcd < r ? xcd * (q + 1) : r * (q + 1) + (xcd - r) * q) + off; }
        const int tile = wgid / ncol, pn = wgid % ncol;
        int ln; { unsigned o2 = ~0u; asm volatile("" : "+s"(o2)); ln = (int)__builtin_amdgcn_mbcnt_hi(o2, __builtin_amdgcn_mbcnt_lo(o2, 0u)); }
        const int ta = tstart[ln], tb = tstart[ln + 1];
        const unsigned long long mm = __ballot(ta <= tile && tile < tb);
        const int e = mm ? (int)__builtin_ctzll(mm) : 64;
        const int ts = __builtin_amdgcn_readfirstlane((int)tstart[e]), ce = __builtin_amdgcn_readfirstlane((int)cnts[e]);
        const int lt = tile - ts; int valid = ce - lt * 256; valid = valid > 256 ? 256 : valid;
        u.gshift = 0; u.aux = e;
        if (GATH) {
            u.B = Wbase + (size_t)e * WMOE_E_BYTES + (size_t)pn * 256 * K * 2;
            if (e < 64) { u.A = Abase; u.gidx = lists + (size_t)e * T + lt * 256; u.gcnt = valid; }
            else { u.A = Abase + (size_t)lt * 256 * K * 2; u.gidx = nullptr; u.gcnt = 0; }
            u.row0 = tile * 256; u.col0 = pn * 128;
        } else {
            u.B = Wbase + (size_t)e * WMOE_E_BYTES + (size_t)512 * 1024 * 2 + (size_t)pn * 256 * K * 2;
            u.A = Abase + (size_t)tile * 256 * K * 2; u.gidx = nullptr; u.gcnt = valid;
            u.row0 = tile * 256; u.col0 = pn * 256;
        }
        return true;
    }
};
__device__ __forceinline__ void phase_load_x(const Frame& F, KP p) {
    const float* xin = gin(p, 0); bf16* XB = (bf16*)(F.ws + WS_XB);
    for (size_t i = (size_t)F.vcu * NTHREADS + F.tid; i < (size_t)T * D / 8; i += (size_t)F.G * NTHREADS) {
        const f32x4 a = *(const f32x4*)(xin + i * 8), b = *(const f32x4*)(xin + i * 8 + 4);
        *(u32x4*)(XB + i * 8) = pack_bf16x8(a, b);
        u32x2 q8; q8.x = pk4_fp8(a[0], a[1], a[2], a[3]); q8.y = pk4_fp8(b[0], b[1], b[2], b[3]); *(u32x2*)((unsigned char*)(F.ws + WS_X) + i * 8) = q8; }
}

__global__ void __launch_bounds__(NTHREADS, 2) fwd_kernel(Params p_unused) {
    KP p0 = (KP)__builtin_amdgcn_kernarg_segment_ptr();
    extern __shared__ __attribute__((aligned(16))) unsigned char lds_raw[];
    Frame F0;
    F0.lds = (LAS unsigned char*)lds_raw; F0.MISC = (volatile LAS unsigned*)(F0.lds + MISC_OFF);
    F0.tid = threadIdx.x; F0.lane = F0.tid & 63; F0.wave = __builtin_amdgcn_readfirstlane(F0.tid >> 6);
    F0.G = gridDim.x; { const int bq = blockIdx.x; F0.vcu = (F0.G % 8 == 0) ? (bq % 8) * (F0.G / 8) + bq / 8 : bq; }
    F0.ws = p0->ws;
    const int bx0 = blockIdx.x;
    for (int u = F0.tid; u < (LDS_BYTES - MISC_OFF) / 4; u += NTHREADS) ((LAS unsigned*)(F0.lds + MISC_OFF))[u] = 0u;
    __syncthreads();
    XcdBarrier bar; bar.bar = (unsigned*)(p0->ws + WS_CTL) + CW_BAR; bar.x = 0; bar.st = nullptr;
    const int use_bar = p0->use_bar;
    if (use_bar) bar = xcd_barrier_post((unsigned*)(p0->ws + WS_CTL) + CW_BAR, F0.MISC + 8);
    const int lo = p0->ph_lo, hi = p0->ph_hi;
#define PHASE_BEGIN Frame F = F0; KP p = p0; { unsigned ones_ = ~0u; asm volatile("" : "+s"(ones_)); F.lane = (int)__builtin_amdgcn_mbcnt_hi(ones_, __builtin_amdgcn_mbcnt_lo(ones_, 0u)); } asm volatile("" : "+v"(F.lane)); F.tid = F.wave * 64 + F.lane; asm volatile("" : "+v"(F.tid));   GAS unsigned char* wsg_ = (GAS unsigned char*)F0.ws; asm volatile("" : "+s"(F.wave), "+s"(F.vcu), "+s"(F.G), "+s"(wsg_), "+s"(p)); \
    F.ws = (unsigned char*)wsg_; int bx = bx0; asm volatile("" : "+s"(bx)); unsigned char* ws = F.ws; (void)ws; (void)bx;
#pragma unroll 1
    for (int ph = lo; ph < hi; ++ph) {
        int layer = 0, type = 0;
        if (ph > 0) { layer = ph >= 26 ? 3 : (ph >= 18 ? 2 : (ph >= 9 ? 1 : 0)); const int q = ph - (layer == 3 ? 26 : (layer == 2 ? 18 : (layer == 1 ? 9 : 1))); const int kind = layer % 3;
            if (kind == 0) type = q < 4 ? 1 + q : 14 + (q - 4); else if (kind == 1) type = q < 5 ? 5 + q : 14 + (q - 5); else type = q < 4 ? 10 + q : 14 + (q - 4); }
        const int j = layer / 3;
#ifdef REPEAT_MASK
        const int nrep = ((REPEAT_MASK >> type) & 1u) ? 2 : 1;
#else
        const int nrep = 1;
#endif
#pragma unroll 1
        for (int rep = 0; rep < nrep; ++rep) {
        if (rep > 0 && use_bar) xcd_barrier(bar);
        if (PHT(0) && type == 0) { PHASE_BEGIN; phase_conv_mixers(F, p); phase_conv_moe(F, p, 0); phase_load_x(F, p); }
        else if (PHT(1) && type == 1) { PHASE_BEGIN; DenseSched8 S; S.init(ws + WS_X, ws + WS_ATT_IN_T + (size_t)j * ATT_IN * D, T, ATT_IN, D / 2, F.G, bx); EpiStoreBf16 E{(bf16*)(ws + WS_BIG), ATT_IN, WUP_INV, 0.08838834764831845f};
            pg8::gemm_phase(F.lds, F.tid, D / 2, S, E); }
        else if (PHT(2) && type == 2) { PHASE_BEGIN; phase_attn(F, bx); }
        else if (PHT(3) && type == 3) { PHASE_BEGIN; phase_attn_combine(F); }
        else if (PHT(4) && type == 4) { PHASE_BEGIN; DenseSched S; S.init(ws + WS_AUX + AUX_OB, ws + WS_ATT_OUT_T + (size_t)j * D * D * 2, T, D, D, F.G, bx); EpiResid E{(const bf16*)(ws + WS_XB), (bf16*)(ws + WS_Y), 1.0f};
            pg8::gemm_phase(F.lds, F.tid, D, S, E); }
        else if (PHT(5) && type == 5) { PHASE_BEGIN; DenseSched8 S; S.init(ws + WS_X, ws + WS_RET_IN_T, T, RET_IN, D / 2, F.G, bx); EpiRetIn E{(bf16*)(ws + WS_BIG), RET_IN};
            pg8::gemm_phase(F.lds, F.tid, D / 2, S, E); }
        else if (PHT(6) && type == 6) { PHASE_BEGIN; phase_ret_u(F); }
        else if (PHT(7) && type == 7) { PHASE_BEGIN; phase_ret_scan(F); }
        else if (PHT(8) && type == 8) { PHASE_BEGIN; phase_ret_out(F, p); }
        else if (PHT(9) && type == 9) { PHASE_BEGIN; DenseSched S; S.init(ws + WS_BIG + BIG_YRET, ws + WS_RET_OUT_T, T, D, RET_V, F.G, bx); EpiResid E{(const bf16*)(ws + WS_XB), (bf16*)(ws + WS_Y), 1.0f};
            pg8::gemm_phase(F.lds, F.tid, RET_V, S, E); }
        else if (PHT(10) && type == 10) { PHASE_BEGIN; phase_s5_scan<false>(F, p); }
        else if (PHT(11) && type == 11) { PHASE_BEGIN; phase_s5_carry(F, p); }
        else if (PHT(12) && type == 12) { PHASE_BEGIN; phase_s5_scan<true>(F, p); }
        else if (PHT(13) && type == 13) { PHASE_BEGIN; DenseSched S; S.init(ws + WS_AUX, ws + WS_GLU_T, T, 2 * D, D, F.G, bx); EpiGluResid E{(const bf16*)(ws + WS_XB), (bf16*)(ws + WS_Y)};
            pg8::gemm_phase(F.lds, F.tid, D, S, E); }
        else if (PHT(14) && type == 14) { PHASE_BEGIN; phase_lnr(F, p, layer, PROBE_DRY14 && true); if (PROBE_DRY14) { if (use_bar) xcd_barrier(bar); phase_lnr(F, p, layer, false); } }
        else if (PHT(15) && type == 15) { PHASE_BEGIN; moe_plan(F, layer);
            MoeSched2<true> S; S.tstart = (const volatile LAS int*)(F.MISC + PLAN_OFF); S.cnts = S.tstart + 72; S.ntiles = __builtin_amdgcn_readfirstlane((int)S.tstart[65]); S.G = F.G; S.c = bx; S.lane = F.lane;
            S.Abase = (const char*)(ws + WS_X); S.Wbase = (const char*)(ws + WS_WMOE); S.lists = (const int*)(ws + WS_LIST);
            EpiMoeUp E{(unsigned char*)(ws + WS_H)};
            pg8::gemm_phase(F.lds, F.tid, D / 2, S, E); }
        else if (PHT(16) && type == 16) { PHASE_BEGIN; moe_plan(F, layer);
            { MoeSched2<false> S; S.tstart = (const volatile LAS int*)(F.MISC + PLAN_OFF); S.cnts = S.tstart + 72; S.ntiles = __builtin_amdgcn_readfirstlane((int)S.tstart[64]); S.G = F.G; S.c = bx; S.lane = F.lane;
              S.Abase = (const char*)(ws + WS_H); S.Wbase = (const char*)(ws + WS_WMOE); S.lists = (const int*)(ws + WS_LIST);
              EpiStoreFp8 E{(unsigned char*)(ws + WS_BIG), D};
              pg8::gemm_phase(F.lds, F.tid, ED / 2, S, E); }
            { const int sh0 = __builtin_amdgcn_readfirstlane((int)((const volatile LAS int*)(F.MISC + PLAN_OFF))[64]);
              DenseSched8 S; S.init(ws + WS_H + (size_t)sh0 * 256 * ED, ws + WS_WMOE + (size_t)64 * WMOE_E_BYTES + (size_t)512 * 1024 * 2, T, D, ED / 2, F.G, bx); EpiResid8 E{(const bf16*)(ws + WS_XB), (bf16*)(ws + WS_Y), 1.0f / (H_SCALE * WUP_SCALE)};
              int tid2; { unsigned o2 = ~0u; asm volatile("" : "+s"(o2)); tid2 = F.wave * 64 + (int)__builtin_amdgcn_mbcnt_hi(o2, __builtin_amdgcn_mbcnt_lo(o2, 0u)); }
              pg8::gemm_phase(F.lds, tid2, ED / 2, S, E); } }
        else if (PHT(17) && type == 17) { PHASE_BEGIN; moe_plan(F, layer); if (PROBE_DRY17) { phase_combine(F, p, layer, true); if (use_bar) xcd_barrier(bar); } phase_combine(F, p, layer); if (layer + 1 < DEPTH) phase_conv_moe(F, p, layer + 1); }
        }
        if (use_bar && ph + 1 < hi) xcd_barrier(bar);
    }
}

#ifndef MK_PER_PHASE
#define MK_PER_PHASE 0
#endif
extern "C" void kernel_launch(void* const* d_in, const int* in_sizes, int n_in, void* d_out, int out_size, void* d_ws, size_t ws_size, hipStream_t stream) {
    static int grid = 0;
    if (grid == 0) {
        if (n_in != 26 || in_sizes[0] != T * D || out_size != T * D || ws_size < WS_END) { fprintf(stderr, "kernel_launch: unexpected shapes / workspace (n_in %d, in0 %d, out %d, ws %zu < %zu)\n", n_in, n_in > 0 ? in_sizes[0] : -1, out_size, ws_size, (size_t)WS_END); grid = -1; return; }
        int dev = 0, cus = 0, per_cu = 0;
        if (hipGetDevice(&dev) != hipSuccess || hipDeviceGetAttribute(&cus, hipDeviceAttributeMultiprocessorCount, dev) != hipSuccess) { grid = -1; return; }
        if (hipFuncSetAttribute((const void*)fwd_kernel, hipFuncAttributeMaxDynamicSharedMemorySize, LDS_BYTES) != hipSuccess) { fprintf(stderr, "kernel_launch: hipFuncSetAttribute failed\n"); grid = -1; return; }
        if (hipOccupancyMaxActiveBlocksPerMultiprocessor(&per_cu, (const void*)fwd_kernel, NTHREADS, LDS_BYTES) != hipSuccess || per_cu < 1) { fprintf(stderr, "kernel_launch: occupancy query says %d blocks per CU\n", per_cu); per_cu = 1; }
        (void)hipGetLastError();
        grid = cus;
    }
    if (grid < 0) return;
    (void)hipMemsetAsync((char*)d_ws + WS_CTL, 0, CTL_ZERO_BYTES, stream);
    Params p{};
    for (int i = 0; i < 26; ++i) p.in[i] = (const float*)d_in[i];
    p.out = (float*)d_out; p.ws = (unsigned char*)d_ws;
#if MK_PER_PHASE
    for (int k = 0; k < NPHASES; ++k) { p.ph_lo = k; p.ph_hi = k + 1; p.use_bar = 0; hipLaunchKernelGGL(fwd_kernel, dim3(grid), dim3(NTHREADS), LDS_BYTES, stream, p); }
#else
    p.ph_lo = 0; p.ph_hi = NPHASES; p.use_bar = 1;
    hipLaunchKernelGGL(fwd_kernel, dim3(grid), dim3(NTHREADS), LDS_BYTES, stream, p);
#endif
}
```

```cpp
#include <hip/hip_runtime.h>
#include <cstdio>
#include <cstdint>

#define LAS __attribute__((address_space(3)))
#define GAS __attribute__((address_space(1)))
typedef unsigned short bf16;
typedef short bf16x8 __attribute__((ext_vector_type(8)));
typedef short bf16x4 __attribute__((ext_vector_type(4)));
typedef float f32x4 __attribute__((ext_vector_type(4)));
typedef float f32x2 __attribute__((ext_vector_type(2)));
typedef unsigned u32x4 __attribute__((ext_vector_type(4)));
typedef unsigned u32x2 __attribute__((ext_vector_type(2)));
typedef GAS unsigned gu32;

constexpr int D = 1024, BATCH = 2, SEQ = 8192, T = BATCH * SEQ, DEPTH = 4;
constexpr int AH = 8, AHD = 128, ATT_IN = 9216;
constexpr int RH = 4, RDK = 256, RDV = 512, RET_IN = 6144, RET_V = 2048, RC = 128, RNC = SEQ / RC;
constexpr int SG = 64, SGC = 16, SP = 64;
constexpr int NE = 64, TOPK = 8, NEG = 8, ED = 256, NSLOT = 9;
constexpr float LN_EPS = 1e-5f;
constexpr float ALPHA = 1.6817928305074292f;
constexpr int NWAVES = 8, NTHREADS = 512;

__device__ __forceinline__ unsigned f2bf(float f) { unsigned u = __builtin_bit_cast(unsigned, f); return (u + 0x7fffu + ((u >> 16) & 1u)) >> 16; }
__device__ __forceinline__ unsigned pk2(float lo, float hi) { unsigned r; asm("s_nop 1\n\tv_cvt_pk_bf16_f32 %0, %1, %2" : "=v"(r) : "v"(lo), "v"(hi)); return r; }
__device__ __forceinline__ unsigned pk2sw(float lo, float hi) { return f2bf(lo) | (f2bf(hi) << 16); }
__device__ __forceinline__ unsigned pk2hw(float lo, float hi) { unsigned r; asm volatile("v_cvt_pk_bf16_f32 %0, %1, %2" : "=v"(r) : "v"(lo), "v"(hi)); return r; }
__device__ __forceinline__ float bf2f(unsigned b) { return __builtin_bit_cast(float, b << 16); }
__device__ __forceinline__ float bflo(unsigned w) { return __builtin_bit_cast(float, w << 16); }
__device__ __forceinline__ float bfhi(unsigned w) { return __builtin_bit_cast(float, w & 0xffff0000u); }
__device__ __forceinline__ float shx(float v, int m, int lane) { return __builtin_bit_cast(float, __builtin_amdgcn_ds_bpermute((lane ^ m) << 2, __builtin_bit_cast(int, v))); }
__device__ __forceinline__ int shx_i(int v, int m, int lane) { return __builtin_amdgcn_ds_bpermute((lane ^ m) << 2, v); }
__device__ __forceinline__ float rdl(float v, int src) { return __builtin_bit_cast(float, __builtin_amdgcn_readlane(__builtin_bit_cast(int, v), src)); }
template <int CTRL, int RM = 0xf, int BM = 0xf> __device__ __forceinline__ float dpp0(float v) { return __builtin_bit_cast(float, __builtin_amdgcn_update_dpp(0, __builtin_bit_cast(int, v), CTRL, RM, BM, true)); }
template <int CTRL, int RM = 0xf, int BM = 0xf> __device__ __forceinline__ float dppo(float old, float v) { return __builtin_bit_cast(float, __builtin_amdgcn_update_dpp(__builtin_bit_cast(int, old), __builtin_bit_cast(int, v), CTRL, RM, BM, false)); }
__device__ __forceinline__ float wave_sum(float v, int lane) {
    (void)lane;
    v += dpp0<0x111>(v); v += dpp0<0x112>(v); v += dpp0<0x114>(v); v += dpp0<0x118>(v);
    v += dpp0<0x142, 0xa>(v);
    v += dpp0<0x143, 0xc>(v);
    return rdl(v, 63);
}
__device__ __forceinline__ float max8(float v) {
    v = fmaxf(v, dppo<0xb1>(v, v)); v = fmaxf(v, dppo<0x4e>(v, v)); v = fmaxf(v, dppo<0x141>(v, v)); return v;
}
__device__ __forceinline__ float fsig(float x) { return __builtin_amdgcn_rcpf(1.0f + __expf(-x)); }
#define LDS_WAIT() asm volatile("s_waitcnt lgkmcnt(0)" ::: "memory")
#define VM_WAIT() asm volatile("s_waitcnt vmcnt(0)" ::: "memory")
__device__ __forceinline__ const char* rfl_ptr(const char* p) {
    unsigned long long v = (unsigned long long)p; unsigned lo = __builtin_amdgcn_readfirstlane((unsigned)v), hi = __builtin_amdgcn_readfirstlane((unsigned)(v >> 32));
    return (const char*)(((unsigned long long)hi << 32) | lo);
}
__device__ __forceinline__ bf16x8 row_frag(const LAS bf16* base, int ld, int row0, int col0, int lane) {
    return *(const LAS bf16x8*)(base + (row0 + (lane & 15)) * ld + col0 + 8 * (lane >> 4));
}
__device__ __forceinline__ bf16x4 tr4(const LAS bf16* addr) { return __builtin_amdgcn_ds_read_tr16_b64_v4i16((LAS bf16x4*)addr); }
__device__ __forceinline__ bf16x8 cat8(bf16x4 a, bf16x4 b) { bf16x8 r; r[0] = a[0]; r[1] = a[1]; r[2] = a[2]; r[3] = a[3]; r[4] = b[0]; r[5] = b[1]; r[6] = b[2]; r[7] = b[3]; return r; }
#define MFMA16(a, b, c) __builtin_amdgcn_mfma_f32_16x16x32_bf16((a), (b), (c), 0, 0, 0)
__device__ __forceinline__ bf16x8 pack8(f32x4 a, f32x4 b) {
    u32x4 w; w.x = pk2(a[0], a[1]); w.y = pk2(a[2], a[3]); w.z = pk2(b[0], b[1]); w.w = pk2(b[2], b[3]); return __builtin_bit_cast(bf16x8, w);
}

namespace pg8 {
typedef int v4i_t __attribute__((ext_vector_type(4)));
typedef int v8i_t __attribute__((ext_vector_type(8)));
constexpr int BM = 256, BK = 64, HALF = 128, HTB = HALF * BK * 2, STAGE_BYTES = 8 * HTB;
__device__ __forceinline__ int lds_byte(int r, int c) { const int st = (r >> 4) * 2 + (c >> 5), rr = r & 15, cc = c & 31, ob = rr * 64 + cc * 2; return st * 1024 + (ob ^ (((ob >> 9) & 1) << 5)); }
__device__ __forceinline__ void stage_rc(int b, int& R, int& C) { const int st = b / 1024, sb = b % 1024, swz = sb ^ (((sb >> 9) & 1) << 5); R = (st >> 1) * 16 + swz / 64; C = (st & 1) * 32 + (swz % 64) / 2; }
__device__ __forceinline__ int perm32(int rho) { const int n = rho >> 4, i = rho & 15; return 8 * (i >> 2) + 4 * n + (i & 3); }

struct UnitG {
    const char* A;
    const char* B;
    const int* gidx;
    int gcnt, gshift;
    int row0, col0;
    int aux;
};

__device__ __forceinline__ void uniformize(UnitG& u) { u.A = rfl_ptr(u.A); u.B = rfl_ptr(u.B); u.gidx = (const int*)rfl_ptr((const char*)u.gidx); u.gcnt = __builtin_amdgcn_readfirstlane(u.gcnt); u.gshift = __builtin_amdgcn_readfirstlane(u.gshift);
    u.row0 = __builtin_amdgcn_readfirstlane(u.row0); u.col0 = __builtin_amdgcn_readfirstlane(u.col0); u.aux = __builtin_amdgcn_readfirstlane(u.aux); }
template <class Epi, class Sched>
__device__ __forceinline__ void gemm_phase(LAS unsigned char* lds, const int tid, const int K, const Sched& S, const Epi& E) {
    constexpr bool F8 = Sched::FP8;
    constexpr bool GATHER = Sched::GATHER;
    const int wid = __builtin_amdgcn_readfirstlane(tid >> 6), lane = tid & 63, wr = wid >> 2, wc = wid & 3, fr = lane & 15, fq = lane >> 4;
    int nt = K / BK; asm volatile("" : "+s"(nt));
    constexpr bool P16 = Epi::PERM16;
    unsigned voffB[2], voffB1[2], vA[2][2];
#pragma unroll
    for (int i = 0; i < 2; ++i) { int R, C; stage_rc(tid * 16 + i * 8192, R, C); const int Rb = Epi::PERM ? ((R & ~31) + perm32(R & 31)) : R; voffB[i] = (unsigned)(Rb * K + C) * 2u; voffB1[i] = voffB[i]; vA[0][i] = (unsigned)(R * K + C) * 2u; vA[1][i] = vA[0][i];
        if constexpr (P16) { const int x = R & 31, src = 64 * (R >> 5) + 16 * ((x >> 2) & 3) + 4 * (x >> 4) + (x & 3); voffB[i] = (unsigned)(src * K + C) * 2u; voffB1[i] = (unsigned)((src + 8) * K + C) * 2u; } }
    const size_t kstep = (size_t)(BK * 2);
    const size_t hstep = (size_t)HALF * K * 2;
    const size_t hstepB = P16 ? 0 : hstep;
    const size_t hstepA = GATHER ? 0 : hstep;
    const unsigned ldsw = (unsigned)wid * 1024u;
    const int aoff = F8 ? lds_byte(wr * 64 + fr, fq * 16) : lds_byte(wr * 64 + fr, fq * 8), boff = F8 ? lds_byte(wc * 32 + fr, fq * 16) : lds_byte(wc * 32 + fr, fq * 8);
    LAS u32x4* park = (LAS u32x4*)(lds + STAGE_BYTES) + tid;
#define PG8_SA(b, h) (((b) * 2 + (h)) * HTB)
#define PG8_SB(b, h) ((4 + (b) * 2 + (h)) * HTB)
#define PG8_STAGE(bufoff, gbase, voff) do { _Pragma("unroll") for (int _i = 0; _i < 2; ++_i) { asm volatile("" : "+v"((voff)[_i]));   \
        __builtin_amdgcn_global_load_lds((const unsigned*)((const char*)(gbase) + (voff)[_i]), (LAS unsigned*)(lds + (bufoff) + ldsw + _i * 8192), 16, 0, 0); } } while (0)
    constexpr int FKS = F8 ? 16 : 1024;
#define PG8_LD2(p_) __builtin_shufflevector(*(const LAS v4i_t*)(p_), *(const LAS v4i_t*)((p_) + FKS), 0, 1, 2, 3, 4, 5, 6, 7)
#define PG8_LDA(dst, b, h) do { _Pragma("unroll") for (int m = 0; m < 4; ++m) dst[m] = PG8_LD2(lds + PG8_SA(b, h) + aoff + m * 2048); } while (0)
#define PG8_LDB(dst, b, h) do { _Pragma("unroll") for (int n = 0; n < 2; ++n) dst[n] = PG8_LD2(lds + PG8_SB(b, h) + boff + n * 2048); } while (0)
#define PG8_LO(v) __builtin_bit_cast(bf16x8, __builtin_shufflevector((v), (v), 0, 1, 2, 3))
#define PG8_HI(v) __builtin_bit_cast(bf16x8, __builtin_shufflevector((v), (v), 4, 5, 6, 7))
#define PG8_MMA(ai, bj, At, Bt) do { __builtin_amdgcn_s_setprio(1); _Pragma("unroll") for (int m = 0; m < 4; ++m) _Pragma("unroll") for (int n = 0; n < 2; ++n) { \
        if constexpr (F8) { acc[ai][bj][m][n] = __builtin_amdgcn_mfma_scale_f32_16x16x128_f8f6f4(Bt[n], At[m], acc[ai][bj][m][n], 0, 0, 0, 0x7F7F7F7F, 0, 0x7F7F7F7F); } \
        else { acc[ai][bj][m][n] = __builtin_amdgcn_mfma_f32_16x16x32_bf16(PG8_LO(Bt[n]), PG8_LO(At[m]), acc[ai][bj][m][n], 0, 0, 0); \
               acc[ai][bj][m][n] = __builtin_amdgcn_mfma_f32_16x16x32_bf16(PG8_HI(Bt[n]), PG8_HI(At[m]), acc[ai][bj][m][n], 0, 0, 0); } } __builtin_amdgcn_s_setprio(0); } while (0)
#define PG8_WAIT_V(n) asm volatile("s_waitcnt vmcnt(" #n ")" ::: "memory")
#define PG8_WAIT_L(n) asm volatile("s_waitcnt lgkmcnt(" #n ")" ::: "memory")
#define PG8_BAR __builtin_amdgcn_s_barrier()
#define PG8_SCHED __builtin_amdgcn_sched_barrier(0)
#define PG8_VOFF(u, v00, v01, v10, v11) do { int _R0, _C0, _R1, _C1; stage_rc(tid * 16, _R0, _C0); stage_rc(tid * 16 + 8192, _R1, _C1); int _r00 = _R0, _r01 = _R1, _r10 = HALF + _R0, _r11 = HALF + _R1; \
        if ((u).gidx) { const GAS int* _gp = (const GAS int*)(u).gidx; const int _gc = (u).gcnt;     \
            const int _a = _gp[_r00 < _gc ? _r00 : 0] >> (u).gshift, _b = _gp[_r01 < _gc ? _r01 : 0] >> (u).gshift, _c = _gp[_r10 < _gc ? _r10 : 0] >> (u).gshift, _d = _gp[_r11 < _gc ? _r11 : 0] >> (u).gshift; \
            _r00 = _a; _r01 = _b; _r10 = _c; _r11 = _d; } \
        v00 = (unsigned)(_r00 * K + _C0) * 2u; v01 = (unsigned)(_r01 * K + _C1) * 2u; v10 = (unsigned)(_r10 * K + _C0) * 2u; v11 = (unsigned)(_r11 * K + _C1) * 2u; } while (0)
    UnitG cur, nxt; int ui = 0;
    if (!S.next(0, cur)) return;
    if constexpr (Sched::UNIFORMIZE) uniformize(cur);
    f32x4 acc[2][2][4][2];
#pragma unroll
    for (int a = 0; a < 2; ++a)
#pragma unroll
        for (int b = 0; b < 2; ++b)
#pragma unroll
            for (int m = 0; m < 4; ++m)
#pragma unroll
                for (int n = 0; n < 2; ++n) acc[a][b][m][n] = (f32x4){0.f, 0.f, 0.f, 0.f};
    v8i_t At[4], B0[2], B1[2];
    if constexpr (GATHER) PG8_VOFF(cur, vA[0][0], vA[0][1], vA[1][0], vA[1][1]);
    const char* cA = cur.A; const char* cB = cur.B;
    PG8_STAGE(PG8_SB(0, 0), cB, voffB); PG8_STAGE(PG8_SB(0, 1), cB + hstepB, voffB1); PG8_STAGE(PG8_SA(0, 0), cA, vA[0]); PG8_STAGE(PG8_SA(0, 1), cA + hstepA, vA[1]);
    if (wr == 1) PG8_BAR;
    PG8_WAIT_V(2); PG8_BAR;
    PG8_STAGE(PG8_SB(1, 0), cB + kstep, voffB); PG8_STAGE(PG8_SA(1, 0), cA + kstep, vA[0]); PG8_STAGE(PG8_SB(1, 1), cB + hstepB + kstep, voffB1);
    PG8_WAIT_V(6); PG8_BAR;
    for (;;) {
        const bool has_next = S.next(ui + 1, nxt);
        if constexpr (Sched::UNIFORMIZE) { if (has_next) uniformize(nxt); }
        const char* nA = cA; const char* nB = cB;
        if (has_next) { nA = nxt.A; nB = nxt.B; }
        if constexpr (GATHER) { u32x4 pv; pv.x = vA[0][0]; pv.y = vA[0][1]; pv.z = vA[1][0]; pv.w = vA[1][1];
            if (has_next) PG8_VOFF(nxt, pv.x, pv.y, pv.z, pv.w);
            *park = pv; }
#pragma unroll 1
        for (int t = 0; t < nt; t += 2) {
            const bool last = (t == nt - 2);
            const char* a1 = cA + (size_t)(t + 1) * kstep;
            const char* a2 = last ? nA : cA + (size_t)(t + 2) * kstep; const char* b2 = last ? nB : cB + (size_t)(t + 2) * kstep;
            const char* a3 = a2 + kstep; const char* b3 = b2 + kstep;
            PG8_LDB(B0, 0, 0); PG8_LDB(B1, 0, 1); PG8_SCHED; PG8_LDA(At, 0, 0); PG8_STAGE(PG8_SA(1, 1), a1 + hstepA, vA[1]);
            PG8_WAIT_V(8); PG8_WAIT_L(0); PG8_BAR; PG8_MMA(0, 0, At, B0); PG8_MMA(0, 1, At, B1); PG8_BAR; PG8_SCHED;
            if constexpr (GATHER) { if (last) { const u32x4 pv = *park; vA[0][0] = pv.x; vA[0][1] = pv.y; vA[1][0] = pv.z; vA[1][1] = pv.w; } }
            PG8_LDA(At, 0, 1); PG8_STAGE(PG8_SB(0, 0), b2, voffB); PG8_STAGE(PG8_SB(0, 1), b2 + hstepB, voffB1); PG8_STAGE(PG8_SA(0, 0), a2, vA[0]);
            PG8_WAIT_V(8); PG8_WAIT_L(0); PG8_BAR; PG8_MMA(1, 0, At, B0); PG8_MMA(1, 1, At, B1); PG8_BAR; PG8_SCHED;
            PG8_LDB(B0, 1, 0); PG8_LDB(B1, 1, 1); PG8_SCHED; PG8_LDA(At, 1, 0); PG8_STAGE(PG8_SA(0, 1), a2 + hstepA, vA[1]);
            PG8_WAIT_V(8); PG8_WAIT_L(0); PG8_BAR; PG8_MMA(0, 0, At, B0); PG8_MMA(0, 1, At, B1); PG8_BAR; PG8_SCHED;
            PG8_LDA(At, 1, 1); PG8_STAGE(PG8_SB(1, 0), b3, voffB); PG8_STAGE(PG8_SB(1, 1), b3 + hstepB, voffB1); PG8_STAGE(PG8_SA(1, 0), a3, vA[0]);
            PG8_WAIT_V(8); PG8_WAIT_L(0); PG8_BAR; PG8_MMA(1, 0, At, B0); PG8_MMA(1, 1, At, B1); PG8_BAR; PG8_SCHED;
        }
        if (wr == 0) PG8_BAR;
        { int l2; { unsigned o2 = ~0u; asm volatile("" : "+s"(o2)); l2 = (int)__builtin_amdgcn_mbcnt_hi(o2, __builtin_amdgcn_mbcnt_lo(o2, 0u)); }
          E(acc, cur, wr, wc, l2 & 15, l2 >> 4); }
        if (!has_next) break;
#pragma unroll
        for (int a = 0; a < 2; ++a)
#pragma unroll
            for (int b = 0; b < 2; ++b)
#pragma unroll
                for (int m = 0; m < 4; ++m)
#pragma unroll
                    for (int n = 0; n < 2; ++n) acc[a][b][m][n] = (f32x4){0.f, 0.f, 0.f, 0.f};
        cur = nxt; cA = nA; cB = nB; ++ui;
        if (wr == 1) PG8_BAR;
    }
    PG8_WAIT_V(0);
    PG8_BAR;
#undef PG8_SA
#undef PG8_SB
#undef PG8_STAGE
#undef PG8_LDA
#undef PG8_LDB
#undef PG8_LD2
#undef PG8_LO
#undef PG8_HI
#undef PG8_MMA
#undef PG8_WAIT_V
#undef PG8_WAIT_L
#undef PG8_BAR
#undef PG8_SCHED
#undef PG8_VOFF
}
}

constexpr size_t MiB = 1u << 20;
constexpr size_t WS_CTL = 0, CTL_ZERO_BYTES = 1 * MiB;
constexpr size_t WS_ATT_IN_T = 1 * MiB;
constexpr size_t WS_ATT_OUT_T = WS_ATT_IN_T + 36 * MiB;
constexpr size_t WS_RET_IN_T = WS_ATT_OUT_T + 4 * MiB;
constexpr size_t WS_RET_OUT_T = WS_RET_IN_T + 12 * MiB;
constexpr size_t WS_GLU_T = WS_RET_OUT_T + 4 * MiB;
constexpr size_t WS_RT_HI = WS_GLU_T + 4 * MiB;
constexpr size_t WS_RT_LO = WS_RT_HI + 512 * 1024;
constexpr size_t WS_WMOE = WS_RT_HI + 1 * MiB;
constexpr size_t WMOE_E_BYTES = (size_t)(512 * 1024 + 1024 * 256) * 2;
constexpr size_t WS_X = WS_WMOE + 98 * MiB;
constexpr size_t WS_Y = WS_X + 64 * MiB;
constexpr size_t WS_XB = WS_Y + 64 * MiB;
constexpr size_t WS_BIG = WS_XB + 32 * MiB;
constexpr size_t WS_AUX = WS_BIG + 288 * MiB;
constexpr size_t WS_H = WS_AUX + 160 * MiB;
constexpr size_t WS_LIST = WS_H + 80 * MiB;
constexpr size_t WS_TRASH = WS_LIST + 8 * MiB;
constexpr size_t WS_END = WS_TRASH + 1 * MiB;
static_assert(WS_END <= 1024 * MiB, "workspace map");
constexpr int CW_BAR = 4096;
constexpr int CW_CNT = 16384;
constexpr int CW_CHK = 65536;
constexpr int HROWS = 163840;

#define XB_TMO      128
#define XB_XCNT(j)  (256  + 64 * (j))
#define XB_XSUB(j)  (1280 + 64 * (j))
#define XB_XGEN(j)  (2304 + 64 * (j))
#define XB_TOP      3328
#define XB_TOPGEN   3392
#define XCD_BAR_WORDS 3456
#define XB_SPIN_CAP (1u << 20)
__device__ __forceinline__ unsigned xb_ld(unsigned* p)              { return __hip_atomic_load(p, __ATOMIC_RELAXED, __HIP_MEMORY_SCOPE_AGENT); }
__device__ __forceinline__ unsigned xb_add(unsigned* p, unsigned v) { return __hip_atomic_fetch_add(p, v, __ATOMIC_RELAXED, __HIP_MEMORY_SCOPE_AGENT); }
__device__ __forceinline__ unsigned xb_xcc_id() { return (unsigned)__builtin_amdgcn_s_getreg((3 << 11) | 20) & 0xFu; }
#define XB_SPIN(cond, bar) do { unsigned _sp = 0; while (cond) { __builtin_amdgcn_s_sleep(1); \
    if ((++_sp & 255u) == 0u) { if (xb_ld(&(bar)[XB_TMO])) break; if (_sp > XB_SPIN_CAP) { atomicAdd(&(bar)[XB_TMO], 1u); break; } } } } while (0)
struct XcdBarrier { unsigned* bar; unsigned x; volatile LAS unsigned* st; };
__device__ __forceinline__ XcdBarrier xcd_barrier_post(unsigned* bar, volatile LAS unsigned* st) {
    XcdBarrier b; b.bar = bar; b.x = xb_xcc_id(); b.st = st;
    if (threadIdx.x == 0) (void)xb_add(&bar[XB_XCNT(b.x)], 1u);
    return b;
}
__device__ __forceinline__ void xcd_barrier_complete(unsigned* bar, unsigned x, unsigned& nloc, unsigned& nx) {
    const unsigned G = gridDim.x * gridDim.y * gridDim.z;
    unsigned sum, cnt, mine, sp = 0u;
    for (;;) {
        sum = 0u; cnt = 0u; mine = 0u;
#pragma unroll
        for (unsigned j = 0; j < 16; ++j) { const unsigned c = xb_ld(&bar[XB_XCNT(j)]); sum += c; cnt += (c > 0u) ? 1u : 0u; mine = (j == x) ? c : mine; }
        if (sum == G) break;
        __builtin_amdgcn_s_sleep(1);
        if ((++sp & 255u) == 0u) { if (xb_ld(&bar[XB_TMO])) break; if (sp > XB_SPIN_CAP) { atomicAdd(&bar[XB_TMO], 1u); break; } }
    }
    nloc = mine > 0u ? mine : 1u; nx = cnt > 0u ? cnt : 1u;
}
__device__ __forceinline__ void xcd_barrier(const XcdBarrier& b) {
    asm volatile("s_waitcnt vmcnt(0)" ::: "memory");
    __syncthreads();
    if (threadIdx.x == 0) {
        unsigned* bar = b.bar;
        __builtin_amdgcn_s_waitcnt(0);
        unsigned nloc = b.st[0], nx = b.st[1];
        if (nloc == 0u) { xcd_barrier_complete(bar, b.x, nloc, nx); b.st[0] = nloc; b.st[1] = nx; }
        const unsigned old = xb_add(&bar[XB_XSUB(b.x)], 1u);
        const unsigned gen = old / nloc;
        if (old + 1u == (gen + 1u) * nloc) {
            __builtin_amdgcn_fence(__ATOMIC_RELEASE, "agent");
            asm volatile("s_waitcnt vmcnt(0)" ::: "memory");
            const unsigned og = xb_add(&bar[XB_TOP], 1u);
            const unsigned tg = og / nx;
            if (og + 1u == (tg + 1u) * nx) xb_add(&bar[XB_TOPGEN], 1u);
            else XB_SPIN(xb_ld(&bar[XB_TOPGEN]) == tg, bar);
            __builtin_amdgcn_fence(__ATOMIC_ACQUIRE, "agent");
            xb_add(&bar[XB_XGEN(b.x)], 1u);
            asm volatile("s_waitcnt vmcnt(0)" ::: "memory");
        } else {
            XB_SPIN(xb_ld(&bar[XB_XGEN(b.x)]) == gen, bar);
            __builtin_amdgcn_fence(__ATOMIC_ACQUIRE, "agent");
            asm volatile("s_waitcnt vmcnt(0)" ::: "memory");
        }
    }
    __syncthreads();
}

constexpr int RING_BYTES = 139264;
constexpr int MISC_OFF = RING_BYTES;
constexpr int LDS_BYTES = 147456;
struct Params {
    const float* in[26]; float* out; unsigned char* ws; int ph_lo, ph_hi; int use_bar, pad;
};
typedef const __attribute__((address_space(4))) Params* KP;
__device__ __forceinline__ const float* gin(KP p, int i) { return (const float*)(const GAS float*)p->in[i]; }
__device__ __forceinline__ float* gout(KP p) { return (float*)(GAS float*)p->out; }
struct Frame {
    LAS unsigned char* lds; volatile LAS unsigned* MISC;
    int tid, lane, wave, vcu, G;
    unsigned char* ws;
};

template <bool F8_ = false> struct DenseSchedT {
    static constexpr bool GATHER = false, UNIFORMIZE = false, FP8 = F8_;
    const char* A; const char* Bt; int K, nM, nN, nwg, G, c;
    __device__ __forceinline__ void init(const void* A_, const void* Bt_, int M, int N, int K_, int G_, int c_) { A = (const char*)A_; Bt = (const char*)Bt_; K = K_; nM = M / 256; nN = N / 256; nwg = nM * nN; G = G_; c = c_; }
    __device__ __forceinline__ bool next(int i, pg8::UnitG& u) const {
        const long L = (long)i * G + c; if (L >= nwg) return false;
        int wgid = (int)L; { const int q = nwg / 8, r = nwg % 8, xcd = wgid % 8, off = wgid / 8; wgid = (xcd < r ? xcd * (q + 1) : r * (q + 1) + (xcd - r) * q) + off; }
        const int nig = 8 * nN, gid = wgid / nig, fm = gid * 8, gsz = (nM - fm) < 8 ? (nM - fm) : 8;
        const int pm = fm + ((wgid % nig) % gsz), pn = (wgid % nig) / gsz;
        u.A = A + (size_t)pm * 256 * K * 2; u.B = Bt + (size_t)pn * 256 * K * 2; u.gidx = nullptr; u.gcnt = 0; u.gshift = 0; u.row0 = pm * 256; u.col0 = pn * 256; u.aux = 0; return true;
    }
};
typedef DenseSchedT<false> DenseSched; typedef DenseSchedT<true> DenseSched8;
__device__ __forceinline__ u32x4 pack_bf16x8(const f32x4& v0, const f32x4& v1) { u32x4 w; w.x = pk2hw(v0[0], v0[1]); w.y = pk2hw(v0[2], v0[3]); w.z = pk2hw(v1[0], v1[1]); w.w = pk2hw(v1[2], v1[3]); return w; }

__device__ __forceinline__ unsigned pk4_fp8(float a, float b, float c, float d) {
    a = fminf(fmaxf(a, -448.0f), 448.0f); b = fminf(fmaxf(b, -448.0f), 448.0f); c = fminf(fmaxf(c, -448.0f), 448.0f); d = fminf(fmaxf(d, -448.0f), 448.0f);
    int w = 0; w = __builtin_amdgcn_cvt_pk_fp8_f32(a, b, w, false); w = __builtin_amdgcn_cvt_pk_fp8_f32(c, d, w, true); return (unsigned)w; }
constexpr float WUP_SCALE = 32.0f, WUP_INV = 1.0f / 32.0f;
struct EpiStoreBf16 {
    static constexpr bool PERM = true, PERM16 = false;
    bf16* O; int ldc; float osc, qsc;
    __device__ __forceinline__ void operator()(const f32x4 (&acc)[2][2][4][2], const pg8::UnitG& u, int wr, int wc, int fr, int fq) const {
        const float sc = ((u.col0 % 3072) < 1024) ? osc * qsc : osc;
#pragma unroll
        for (int ai = 0; ai < 2; ++ai)
#pragma unroll
            for (int m = 0; m < 4; ++m) { bf16* rowp = O + (size_t)(u.row0 + ai * 128 + wr * 64 + m * 16 + fr) * ldc + u.col0 + wc * 32 + 8 * fq;
#pragma unroll
                for (int bj = 0; bj < 2; ++bj) *(u32x4*)(rowp + bj * 128) = pack_bf16x8(acc[ai][bj][m][0] * sc, acc[ai][bj][m][1] * sc); }
    }
};
constexpr float YEXP_SCALE = 32.0f, YEXP_INV = 1.0f / 32.0f;
constexpr float A_SCALE = 16.0f;
constexpr float H_SCALE = 16.0f;
struct EpiStoreFp8 {
    static constexpr bool PERM = false, PERM16 = true;
    unsigned char* O; int ldc;
    __device__ __forceinline__ void operator()(const f32x4 (&acc)[2][2][4][2], const pg8::UnitG& u, int wr, int wc, int fr, int fq) const {
#pragma unroll
        for (int ai = 0; ai < 2; ++ai)
#pragma unroll
            for (int m = 0; m < 4; ++m) { unsigned char* rowp = O + (size_t)(u.row0 + ai * 128 + wr * 64 + m * 16 + fr) * ldc + u.col0 + wc * 64 + 16 * fq;
                u32x4 w;
#pragma unroll
                for (int q = 0; q < 4; ++q) { f32x4 v = acc[ai][q >> 1][m][q & 1] * (YEXP_SCALE / (H_SCALE * WUP_SCALE));
#pragma unroll
                    for (int j = 0; j < 4; ++j) v[j] = fminf(fmaxf(v[j], -448.0f), 448.0f);
                    int d = 0; d = __builtin_amdgcn_cvt_pk_fp8_f32(v[0], v[1], d, false); d = __builtin_amdgcn_cvt_pk_fp8_f32(v[2], v[3], d, true); w[q] = (unsigned)d; }
                *(u32x4*)rowp = w; }
    }
};
struct EpiRetIn {
    static constexpr bool PERM = true, PERM16 = false;
    bf16* O; int ldc;
    __device__ __forceinline__ void operator()(const f32x4 (&acc)[2][2][4][2], const pg8::UnitG& u, int wr, int wc, int fr, int fq) const {
        float l2g = 0.f;
        float cs = WUP_INV;
        if (u.col0 < 2048) { const int h = (u.col0 & 1023) >> 8; const float g = 1.0f - exp2f(-5.0f - (float)h); l2g = log2f(g); if (u.col0 >= 1024) { l2g = -l2g; cs *= 0.0625f; } }
#pragma unroll
        for (int ai = 0; ai < 2; ++ai)
#pragma unroll
            for (int m = 0; m < 4; ++m) { const int row = u.row0 + ai * 128 + wr * 64 + m * 16 + fr; const float sc = exp2f(l2g * (float)(row & 127)) * cs;
                bf16* rowp = O + (size_t)row * ldc + u.col0 + wc * 32 + 8 * fq;
#pragma unroll
                for (int bj = 0; bj < 2; ++bj) *(u32x4*)(rowp + bj * 128) = pack_bf16x8(acc[ai][bj][m][0] * sc, acc[ai][bj][m][1] * sc); }
    }
};
__device__ __forceinline__ void unpack_bf16x8(const u32x4& w, f32x4& a, f32x4& b) { a[0] = bflo(w.x); a[1] = bfhi(w.x); a[2] = bflo(w.y); a[3] = bfhi(w.y); b[0] = bflo(w.z); b[1] = bfhi(w.z); b[2] = bflo(w.w); b[3] = bfhi(w.w); }
template <bool ALL16> struct EpiResidT {
    static constexpr bool PERM = true, PERM16 = false;
    const bf16* X; bf16* Y; float asc;
    __device__ __forceinline__ void operator()(const f32x4 (&acc)[2][2][4][2], const pg8::UnitG& u, int wr, int wc, int fr, int fq) const {
        constexpr int NB = ALL16 ? 1 : 2, PER = 2 / NB;
#pragma unroll
        for (int bt = 0; bt < NB; ++bt) {
            u32x4 xw[PER][4][2];
#pragma unroll
            for (int a2 = 0; a2 < PER; ++a2)
#pragma unroll
                for (int m = 0; m < 4; ++m) { const int ai = bt * PER + a2; const size_t off = (size_t)(u.row0 + ai * 128 + wr * 64 + m * 16 + fr) * D + u.col0 + wc * 32 + 8 * fq;
#pragma unroll
                    for (int bj = 0; bj < 2; ++bj) xw[a2][m][bj] = *(const u32x4*)(X + off + bj * 128); }
            asm volatile("" ::: "memory");
#pragma unroll
            for (int a2 = 0; a2 < PER; ++a2)
#pragma unroll
                for (int m = 0; m < 4; ++m) { const int ai = bt * PER + a2; const size_t off = (size_t)(u.row0 + ai * 128 + wr * 64 + m * 16 + fr) * D + u.col0 + wc * 32 + 8 * fq;
#pragma unroll
                    for (int bj = 0; bj < 2; ++bj) { f32x4 x0, x1; unpack_bf16x8(xw[a2][m][bj], x0, x1);
                        *(u32x4*)(Y + off + bj * 128) = pack_bf16x8(x0 * ALPHA + acc[ai][bj][m][0] * asc, x1 * ALPHA + acc[ai][bj][m][1] * asc); } }
            asm volatile("" ::: "memory");
        }
    }
};
typedef EpiResidT<true> EpiResid; typedef EpiResidT<false> EpiResid8;
struct EpiGluResid {
    static constexpr bool PERM = true, PERM16 = false;
    const bf16* X; bf16* Y; float asc;
    __device__ __forceinline__ void operator()(const f32x4 (&acc)[2][2][4][2], const pg8::UnitG& u, int wr, int wc, int fr, int fq) const {
        u32x4 xw[2][4];
#pragma unroll
        for (int ai = 0; ai < 2; ++ai)
#pragma unroll
            for (int m = 0; m < 4; ++m) { const size_t off = (size_t)(u.row0 + ai * 128 + wr * 64 + m * 16 + fr) * D + (u.col0 >> 1) + wc * 32 + 8 * fq; xw[ai][m] = *(const u32x4*)(X + off); }
        asm volatile("" ::: "memory");
#pragma unroll
        for (int ai = 0; ai < 2; ++ai)
#pragma unroll
            for (int m = 0; m < 4; ++m) { const size_t off = (size_t)(u.row0 + ai * 128 + wr * 64 + m * 16 + fr) * D + (u.col0 >> 1) + wc * 32 + 8 * fq;
                f32x4 x0, x1; unpack_bf16x8(xw[ai][m], x0, x1); f32x4 o0, o1;
#pragma unroll
                for (int j = 0; j < 4; ++j) { o0[j] = x0[j] * ALPHA + acc[ai][0][m][0][j] * asc * fsig(acc[ai][1][m][0][j] * asc); o1[j] = x1[j] * ALPHA + acc[ai][0][m][1][j] * asc * fsig(acc[ai][1][m][1][j] * asc); }
                *(u32x4*)(Y + off) = pack_bf16x8(o0, o1); }
    }
};
struct EpiMoeUp {
    static constexpr bool PERM = true, PERM16 = false;
    unsigned char* H;
    __device__ __forceinline__ void operator()(const f32x4 (&acc)[2][2][4][2], const pg8::UnitG& u, int wr, int wc, int fr, int fq) const {
#pragma unroll
        for (int ai = 0; ai < 2; ++ai)
#pragma unroll
            for (int m = 0; m < 4; ++m) { unsigned char* rowp = H + (size_t)(u.row0 + ai * 128 + wr * 64 + m * 16 + fr) * ED + u.col0 + wc * 32 + 8 * fq; f32x4 o[2];
#pragma unroll
                for (int n = 0; n < 2; ++n)
#pragma unroll
                    for (int j = 0; j < 4; ++j) { const float ga = acc[ai][0][m][n][j], ua = acc[ai][1][m][n][j];
                        o[n][j] = (ga * ua) * (WUP_INV * WUP_INV * H_SCALE) * __builtin_amdgcn_rcpf(1.0f + __builtin_amdgcn_exp2f(ga * (-WUP_INV * 1.4426950408889634f))); }
                u32x2 w8; w8.x = pk4_fp8(o[0][0], o[0][1], o[0][2], o[0][3]); w8.y = pk4_fp8(o[1][0], o[1][1], o[1][2], o[1][3]); *(u32x2*)rowp = w8; }
    }
};

struct ConvD { const float* src; unsigned char* dst; unsigned char* dst2; int ldw, ldk, kind; };
__device__ __forceinline__ ConvD conv_mk8(const float* W, int ldw, unsigned char* WT, int ldk, int k0, int n0, int drow0) {
    ConvD d; d.src = W + (size_t)k0 * ldw + n0; d.dst = WT + (size_t)drow0 * ldk + k0; d.dst2 = nullptr; d.ldw = ldw; d.ldk = ldk; d.kind = 1; return d; }
__device__ __forceinline__ ConvD conv_mk16(const float* W, int ldw, bf16* WT, bf16* WTlo, int ldk, int k0, int n0, int drow0) {
    ConvD d; d.src = W + (size_t)k0 * ldw + n0; d.dst = (unsigned char*)(WT + (size_t)drow0 * ldk + k0); d.dst2 = WTlo ? (unsigned char*)(WTlo + (size_t)drow0 * ldk + k0) : nullptr; d.ldw = ldw; d.ldk = ldk * 2; d.kind = WTlo ? 2 : 0; return d; }
__device__ __forceinline__ void conv_load(const ConvD& d, int lane, f32x4 (&r)[8]) {
#pragma unroll
    for (int i = 0; i < 8; ++i) { const int kk = 8 * i + (lane >> 3), c4 = 4 * (lane & 7); r[i] = *(const f32x4*)(d.src + (size_t)kk * d.ldw + c4); }
}
template <bool HILO>
__device__ __forceinline__ void conv_finish(const ConvD& d, int lane, const f32x4 (&r)[8], LAS float* scr) {
    const float scale = (d.kind == 1) ? WUP_SCALE : 1.0f;
#pragma unroll
    for (int i = 0; i < 8; ++i) { const int kk = 8 * i + (lane >> 3), c4 = 4 * (lane & 7);
        scr[kk * 33 + c4] = r[i][0] * scale; scr[kk * 33 + c4 + 1] = r[i][1] * scale; scr[kk * 33 + c4 + 2] = r[i][2] * scale; scr[kk * 33 + c4 + 3] = r[i][3] * scale; }
    LDS_WAIT(); asm volatile("" ::: "memory");
    const int c = lane & 7;
#pragma unroll
    for (int j = 0; j < 4; ++j) { const int n = (lane >> 3) + 8 * j; const LAS float* s = scr + (8 * c) * 33 + n;
        float v[8];
#pragma unroll
        for (int q = 0; q < 8; ++q) v[q] = s[q * 33];
        if (d.kind == 1) { u32x2 o; o.x = pk4_fp8(v[0], v[1], v[2], v[3]); o.y = pk4_fp8(v[4], v[5], v[6], v[7]); *(u32x2*)(d.dst + (size_t)n * d.ldk + 8 * c) = o; }
        else { u32x4 o; o.x = pk2(v[0], v[1]); o.y = pk2(v[2], v[3]); o.z = pk2(v[4], v[5]); o.w = pk2(v[6], v[7]);
            *(u32x4*)(d.dst + (size_t)n * d.ldk + 16 * c) = o;
            if (HILO) { float rr[8];
#pragma unroll
                for (int q = 0; q < 8; ++q) rr[q] = v[q] - bf2f(f2bf(v[q]));
                u32x4 o2; o2.x = pk2(rr[0], rr[1]); o2.y = pk2(rr[2], rr[3]); o2.z = pk2(rr[4], rr[5]); o2.w = pk2(rr[6], rr[7]);
                *(u32x4*)(d.dst2 + (size_t)n * d.ldk + 16 * c) = o2; } } }
    LDS_WAIT(); asm volatile("" ::: "memory");
}
__device__ __forceinline__ void conv_dma(const ConvD& d, int lane, LAS float* buf) {
#pragma unroll
    for (int i = 0; i < 8; ++i) { const float* g = d.src + (size_t)(8 * i + (lane >> 3)) * d.ldw + 4 * ((lane & 7) ^ i);
        __builtin_amdgcn_global_load_lds((const unsigned*)g, (LAS unsigned*)(buf + i * 256), 16, 0, 0); }
}
__device__ __forceinline__ void conv_finish_lds(const ConvD& d, int lane, const LAS float* buf) {
    const float scale = (d.kind == 1) ? WUP_SCALE : 1.0f;
    const int c = lane & 7;
#pragma unroll
    for (int j = 0; j < 4; ++j) { const int n = (lane >> 3) + 8 * j; const LAS float* s = buf + (8 * c) * 32 + (((n >> 2) ^ c) & 7) * 4 + (n & 3);
        float v[8];
#pragma unroll
        for (int q = 0; q < 8; ++q) v[q] = s[q * 32] * scale;
        if (d.kind == 1) { u32x2 o; o.x = pk4_fp8(v[0], v[1], v[2], v[3]); o.y = pk4_fp8(v[4], v[5], v[6], v[7]); *(u32x2*)(d.dst + (size_t)n * d.ldk + 8 * c) = o; }
        else { u32x4 o; o.x = pk2(v[0], v[1]); o.y = pk2(v[2], v[3]); o.z = pk2(v[4], v[5]); o.w = pk2(v[6], v[7]); *(u32x4*)(d.dst + (size_t)n * d.ldk + 16 * c) = o; } }
    LDS_WAIT(); asm volatile("" ::: "memory");
}
#define CONV_RUN(NIT, DEC) do { int it_ = gw; if (it_ < (NIT)) { ConvD dc_ = DEC(it_); int par_ = 0; conv_dma(dc_, F.lane, scr); asm volatile("s_waitcnt vmcnt(0)" ::: "memory"); \
        for (; it_ < (NIT); it_ += NGW) { const int itn_ = (it_ + NGW < (NIT)) ? it_ + NGW : it_; const ConvD dn_ = DEC(itn_); conv_dma(dn_, F.lane, scr + (par_ ^ 1) * 2048);     \
            asm volatile("s_waitcnt vmcnt(12)" ::: "memory"); conv_finish_lds(dc_, F.lane, scr + par_ * 2048); dc_ = dn_; par_ ^= 1; } \
        asm volatile("s_waitcnt vmcnt(0)" ::: "memory"); } } while (0)
__device__ __forceinline__ ConvD conv_dec_mixers(KP p, unsigned char* ws, int it) {
    constexpr int I_AIN = 16 * 288, I_AOUT = 16 * 32, I_RIN = 16 * 192, I_ROUT = 32 * 32, I_GLU = 16 * 64, I_RT = 16 * 2;
    int r = it;
    if (r < 2 * I_AIN) { const int j = r / I_AIN; r %= I_AIN; const int kb = r / 288, nb = r % 288, n0 = nb * 32;
        return conv_mk8(gin(p, 1) + (size_t)j * D * ATT_IN, ATT_IN, (unsigned char*)(ws + WS_ATT_IN_T) + (size_t)j * ATT_IN * D, D, kb * 64, n0, n0); }
    r -= 2 * I_AIN;
    if (r < 2 * I_AOUT) { const int j = r / I_AOUT; r %= I_AOUT; const int kb = r / 32, nb = r % 32, n0 = nb * 32;
        return conv_mk8(gin(p, 2) + (size_t)j * D * D, D, (unsigned char*)(ws + WS_ATT_OUT_T) + (size_t)j * D * D, D, kb * 64, n0, n0); }
    r -= 2 * I_AOUT;
    if (r < I_RIN) { const int kb = r / 192, nb = r % 192, n0 = nb * 32;
        return conv_mk8(gin(p, 3), RET_IN, (unsigned char*)(ws + WS_RET_IN_T), D, kb * 64, n0, n0); }
    r -= I_RIN;
    if (r < I_ROUT) { const int kb = r / 32, nb = r % 32, n0 = nb * 32;
        return conv_mk8(gin(p, 6), D, (unsigned char*)(ws + WS_RET_OUT_T), RET_V, kb * 64, n0, n0); }
    r -= I_ROUT;
    if (r < I_GLU) { const int kb = r / 64, nb = r % 64, n0 = nb * 32; const int c = n0 & 1023, drow = (c >> 7) * 256 + (n0 >> 10) * 128 + (c & 127);
        return conv_mk8(gin(p, 15), 2 * D, (unsigned char*)(ws + WS_GLU_T), D, kb * 64, n0, drow); }
    r -= I_GLU;
    { const int l = r / I_RT; r %= I_RT; const int kb = r / 2, nb = r % 2, n0 = nb * 32;
        return conv_mk16(gin(p, 16) + (size_t)l * D * NE, NE, (bf16*)(ws + WS_RT_HI) + (size_t)l * NE * D, (bf16*)(ws + WS_RT_LO) + (size_t)l * NE * D, D, kb * 64, n0, n0); }
}
__device__ __forceinline__ ConvD conv_dec_moe(KP p, unsigned char* ws, int l, int it) {
    const int e = it / 384, r = it % 384, which = r >> 7, rr = r & 127;
    bf16* We = (bf16*)(ws + WS_WMOE + (size_t)e * WMOE_E_BYTES);
    if (which < 2) { const float* src = (e < 64) ? gin(p, 18 + which) + ((size_t)l * NE + e) * D * ED : gin(p, 21 + which) + (size_t)l * D * ED;
        const int kb = rr >> 3, nb = rr & 7, n0 = nb * 32; const int drow = (n0 >> 7) * 256 + which * 128 + (n0 & 127);
        return conv_mk8(src, ED, (unsigned char*)We, D, kb * 64, n0, drow); }
    const float* src = (e < 64) ? gin(p, 20) + ((size_t)l * NE + e) * ED * D : gin(p, 23) + (size_t)l * ED * D;
    const int kb = rr >> 5, nb = rr & 31, n0 = nb * 32;
    return conv_mk8(src, D, (unsigned char*)(We + 512 * 1024), ED, kb * 64, n0, n0);
}
__device__ __forceinline__ void phase_conv_mixers(const Frame& F, KP p) {
    LAS float* scr = (LAS float*)(F.lds + F.wave * 16384);
    const int gw = F.vcu * NWAVES + F.wave, NGW = F.G * NWAVES;
    constexpr int NMAIN = 2 * (16 * 288) + 2 * (16 * 32) + 16 * 192 + 32 * 32 + 16 * 64, NRT = 4 * (16 * 2);
    unsigned char* ws = F.ws;
#define CONV_DEC_MIX(i_) conv_dec_mixers(p, ws, (i_))
    CONV_RUN(NMAIN, CONV_DEC_MIX);
    for (int it = NMAIN + gw; it < NMAIN + NRT; it += NGW) { const ConvD d = conv_dec_mixers(p, ws, it); f32x4 r[8]; conv_load(d, F.lane, r); conv_finish<true>(d, F.lane, r, scr); }
#undef CONV_DEC_MIX
}
__device__ __forceinline__ void phase_conv_moe(const Frame& F, KP p, int l) {
    LAS float* scr = (LAS float*)(F.lds + F.wave * 16384);
    const int gw = F.vcu * NWAVES + F.wave, NGW = F.G * NWAVES;
    unsigned char* ws = F.ws;
#define CONV_DEC_MOE(i_) conv_dec_moe(p, ws, l, (i_))
    CONV_RUN(65 * 384, CONV_DEC_MOE);
#undef CONV_DEC_MOE
}

__device__ __forceinline__ void phase_lnr(const Frame& F, KP p, int layer, bool dry = false) {
    const bf16* Y = (const bf16*)(F.ws + WS_Y); bf16* XB = (bf16*)(F.ws + WS_XB); unsigned char* XB8 = (unsigned char*)(F.ws + WS_X);
    const float* lng = gin(p, 24) + (size_t)(layer * 2) * D; const float* lnb = gin(p, 25) + (size_t)(layer * 2) * D;
    const bf16* rthi = (const bf16*)(F.ws + WS_RT_HI) + (size_t)layer * NE * D; const bf16* rtlo = (const bf16*)(F.ws + WS_RT_LO) + (size_t)layer * NE * D;
    const float* rbias = gin(p, 17) + layer * NE;
    unsigned* cnt = (unsigned*)(F.ws + WS_CTL) + CW_CNT + layer * NE * 64;
    int* lists = (int*)(F.ws + WS_LIST); int* tokmap = (int*)(F.ws + WS_LIST + 4 * MiB); float* tokgate = (float*)(F.ws + WS_LIST + 5 * MiB);
    constexpr int XLD = 1032, MAXT = 8;
    LAS bf16* Xhi = (LAS bf16*)F.lds; LAS bf16* Xlo = Xhi + 16 * XLD;
    LAS float* part = (LAS float*)(F.lds + 2 * 16 * XLD * 2);
    LAS int* ent = (LAS int*)(part + 2 * 16 * 64);
    LAS int* hist = ent + MAXT * 16 * 8 * 2; LAS int* base = hist + 64;
    const int lane = F.lane, w = F.wave, g4 = lane >> 4, l15 = lane & 15;
    if (F.tid < 64) hist[F.tid] = 0;
    bf16x8 bhi[16], blo[16];
    { const int nt = w & 3, kh = w >> 2; const bf16* bh = rthi + (size_t)(16 * nt + l15) * D + 512 * kh + 8 * g4; const bf16* bl = rtlo + (size_t)(16 * nt + l15) * D + 512 * kh + 8 * g4;
#pragma unroll
        for (int ks = 0; ks < 16; ++ks) { bhi[ks] = *(const bf16x8*)(bh + 32 * ks); blo[ks] = *(const bf16x8*)(bl + 32 * ks); } }
    u32x4 ypre[2][2];
    if (F.vcu < T / 16) {
#pragma unroll
        for (int rr = 0; rr < 2; ++rr)
#pragma unroll
            for (int j = 0; j < 2; ++j) ypre[rr][j] = *(const u32x4*)(Y + (size_t)(F.vcu * 16 + 2 * w + rr) * D + 8 * lane + 512 * j); }
    int ntile = 0;
    for (int tile = F.vcu; tile < T / 16 && ntile < MAXT; tile += F.G, ++ntile) {
        const int t0 = tile * 16;
        u32x4 ycur[2][2];
#pragma unroll
        for (int rr = 0; rr < 2; ++rr)
#pragma unroll
            for (int j = 0; j < 2; ++j) ycur[rr][j] = ypre[rr][j];
        if (tile + F.G < T / 16) {
#pragma unroll
            for (int rr = 0; rr < 2; ++rr)
#pragma unroll
                for (int j = 0; j < 2; ++j) ypre[rr][j] = *(const u32x4*)(Y + (size_t)((tile + F.G) * 16 + 2 * w + rr) * D + 8 * lane + 512 * j); }
#pragma unroll
        for (int rr = 0; rr < 2; ++rr) {
            const int lr = 2 * w + rr; const size_t row = (size_t)(t0 + lr);
            f32x4 v[4]; float s = 0.f;
#pragma unroll
            for (int j = 0; j < 2; ++j) unpack_bf16x8(ycur[rr][j], v[2 * j], v[2 * j + 1]);
#pragma unroll
            for (int j = 0; j < 4; ++j) s += (v[j][0] + v[j][1]) + (v[j][2] + v[j][3]);
            const float mean = wave_sum(s, lane) * (1.f / D); float s2 = 0.f;
#pragma unroll
            for (int j = 0; j < 4; ++j) { v[j] = v[j] - mean; s2 += (v[j][0] * v[j][0] + v[j][1] * v[j][1]) + (v[j][2] * v[j][2] + v[j][3] * v[j][3]); }
            const float rstd = 1.0f / sqrtf(wave_sum(s2, lane) * (1.f / D) + LN_EPS);
#pragma unroll
            for (int j = 0; j < 2; ++j) { const f32x4 g0 = *(const f32x4*)(lng + 8 * lane + 512 * j), g1 = *(const f32x4*)(lng + 8 * lane + 512 * j + 4), b0 = *(const f32x4*)(lnb + 8 * lane + 512 * j), b1 = *(const f32x4*)(lnb + 8 * lane + 512 * j + 4);
                const f32x4 o0 = v[2 * j] * rstd * g0 + b0, o1 = v[2 * j + 1] * rstd * g1 + b1;
                const u32x4 hi = pack_bf16x8(o0, o1);
                *(u32x4*)(XB + row * D + 8 * lane + 512 * j) = hi;
                { u32x2 q8; q8.x = pk4_fp8(o0[0], o0[1], o0[2], o0[3]); q8.y = pk4_fp8(o1[0], o1[1], o1[2], o1[3]); *(u32x2*)(XB8 + row * D + 8 * lane + 512 * j) = q8; }
                f32x4 h0, h1; unpack_bf16x8(hi, h0, h1); const u32x4 lo = pack_bf16x8(o0 - h0, o1 - h1);
                *(LAS u32x4*)(Xhi + lr * XLD + 8 * lane + 512 * j) = hi; *(LAS u32x4*)(Xlo + lr * XLD + 8 * lane + 512 * j) = lo; }
        }
        __syncthreads();
        { const int nt = w & 3, kh = w >> 2; f32x4 a0 = (f32x4){0.f, 0.f, 0.f, 0.f}, a1 = a0, a2 = a0, a3 = a0, a4 = a0, a5 = a0;
#pragma unroll
            for (int ks = 0; ks < 16; ks += 2) { const int k0 = 512 * kh + 32 * ks;
                const bf16x8 ahi = row_frag(Xhi, XLD, 0, k0, lane), alo = row_frag(Xlo, XLD, 0, k0, lane), bhi2 = row_frag(Xhi, XLD, 0, k0 + 32, lane), blo2 = row_frag(Xlo, XLD, 0, k0 + 32, lane);
                a0 = MFMA16(ahi, bhi[ks], a0); a1 = MFMA16(alo, bhi[ks], a1); a2 = MFMA16(ahi, blo[ks], a2);
                a3 = MFMA16(bhi2, bhi[ks + 1], a3); a4 = MFMA16(blo2, bhi[ks + 1], a4); a5 = MFMA16(bhi2, blo[ks + 1], a5); }
            const f32x4 acc = ((a0 + a3) + (a1 + a4)) + (a2 + a5);
#pragma unroll
            for (int i = 0; i < 4; ++i) part[(kh * 16 + 4 * g4 + i) * 64 + 16 * nt + l15] = acc[i];
        }
        __syncthreads();
#pragma unroll
        for (int rr = 0; rr < 2; ++rr) {
            const int lt = ntile * 16 + 2 * w + rr;
            const float lg = part[(2 * w + rr) * 64 + lane] + part[(16 + 2 * w + rr) * 64 + lane];
            float sc = 1.0f / (1.0f + expf(-lg)); sc = (sc == sc) ? sc : 0.5f;
            const float sel = sc + rbias[lane];
            const float m1 = max8(sel);
            const unsigned long long eq = __ballot(sel == m1);
            const unsigned gm = (unsigned)(eq >> (lane & 56)) & 0xffu;
            const int first = (lane & 56) + __builtin_ctz(gm | 0x100u);
            const float m2 = max8((lane == first) ? -INFINITY : sel);
            const float gs = m1 + m2; const int mygrp = lane >> 3; int grank = 0;
#pragma unroll
            for (int gg = 0; gg < 8; ++gg) { const float o = rdl(gs, 8 * gg); grank += (o > gs || (o == gs && gg < mygrp)) ? 1 : 0; }
            const float mv = (grank < 4) ? sel : -INFINITY;
            unsigned key = __builtin_bit_cast(unsigned, mv); key = (key >> 31) ? ~key : (key | 0x80000000u); key = (key & ~63u) | (unsigned)(63 - lane);
            int r0 = 0, r1 = 0, r2 = 0, r3 = 0;
#pragma unroll
            for (int e2 = 0; e2 < 64; e2 += 4) { r0 += ((unsigned)__builtin_amdgcn_readlane((int)key, e2) > key) ? 1 : 0; r1 += ((unsigned)__builtin_amdgcn_readlane((int)key, e2 + 1) > key) ? 1 : 0;
                r2 += ((unsigned)__builtin_amdgcn_readlane((int)key, e2 + 2) > key) ? 1 : 0; r3 += ((unsigned)__builtin_amdgcn_readlane((int)key, e2 + 3) > key) ? 1 : 0; }
            const int rank = (r0 + r1) + (r2 + r3);
            const bool chosen = rank < TOPK;
            const float wsum = wave_sum(chosen ? sc : 0.f, lane);
            if (chosen) { const int lpos = __hip_atomic_fetch_add(hist + lane, 1, __ATOMIC_RELAXED, __HIP_MEMORY_SCOPE_WORKGROUP);
                ent[(lt * 8 + rank) * 2] = (lane << 16) | lpos; ent[(lt * 8 + rank) * 2 + 1] = __builtin_bit_cast(int, sc / wsum * 2.5f); }
        }
    }
    __syncthreads();
    if (dry) return;
    if (F.tid < 64) { const int hcount = hist[F.tid]; base[F.tid] = hcount ? (int)atomicAdd(cnt + F.tid * 64, (unsigned)hcount) : 0; }
    __syncthreads();
    for (int idx = F.tid; idx < ntile * 16 * 8; idx += NTHREADS) {
        const int ev = ent[idx * 2], gb = ent[idx * 2 + 1]; const int e = ev >> 16, pos = base[e] + (ev & 0xffff);
        const int lt = idx >> 3, rank = idx & 7, tok = (F.vcu + (lt >> 4) * F.G) * 16 + (lt & 15);
        lists[(size_t)e * T + pos] = tok; tokmap[tok * 8 + rank] = (e << 16) | pos; tokgate[tok * 8 + rank] = __builtin_bit_cast(float, gb);
    }
}

__device__ __forceinline__ void phase_combine(const Frame& F, KP p, int layer, bool dry = false) {
    bf16* XB = (bf16*)(F.ws + WS_XB); const unsigned char* yexp = (const unsigned char*)(F.ws + WS_BIG);
    const int* tokmap = (const int*)(F.ws + WS_LIST + 4 * MiB); const float* tokgate = (const float*)(F.ws + WS_LIST + 5 * MiB);
    const volatile LAS int* tstart = (const volatile LAS int*)(F.MISC + 64);
    const float* lng = gin(p, 24) + (size_t)(layer * 2 + 1) * D; const float* lnb = gin(p, 25) + (size_t)(layer * 2 + 1) * D;
    float* outp = gout(p); bf16* xbo = XB; if (dry) { outp = (float*)(F.ws + WS_AUX); xbo = (bf16*)(F.ws + WS_H); }
    const int lane = F.lane, gw = F.vcu * NWAVES + F.wave, NGW = F.G * NWAVES;
    const bf16* ysh = (const bf16*)(F.ws + WS_Y);
    f32x4 gv[4], bv[4];
#pragma unroll
    for (int j = 0; j < 4; ++j) { gv[j] = *(const f32x4*)(lng + 16 * lane + 4 * j); bv[j] = *(const f32x4*)(lnb + 16 * lane + 4 * j); }
    for (int row = gw; row < T; row += NGW) {
        const int mk = tokmap[row * 8 + (lane & 7)]; const float gk = tokgate[row * 8 + (lane & 7)] * YEXP_INV;
        const int rk = (int)tstart[mk >> 16] * 256 + (mk & 0xffff);
        f32x4 v[4];
#pragma unroll
        for (int j = 0; j < 2; ++j) { const u32x4 xw = *(const u32x4*)(ysh + (size_t)row * D + 16 * lane + 8 * j); unpack_bf16x8(xw, v[2 * j], v[2 * j + 1]); }
#pragma unroll
        for (int k = 0; k < TOPK; ++k) { const int r = __builtin_amdgcn_readlane(rk, k); const float g = rdl(gk, k);
            const u32x4 s = *(const u32x4*)(yexp + (size_t)r * D + 16 * lane);
#pragma unroll
            for (int j = 0; j < 4; ++j) { const f32x2 lo = __builtin_amdgcn_cvt_pk_f32_fp8((int)s[j], false), hi = __builtin_amdgcn_cvt_pk_f32_fp8((int)s[j], true);
                v[j][0] += g * lo[0]; v[j][1] += g * lo[1]; v[j][2] += g * hi[0]; v[j][3] += g * hi[1]; } }
        float s = 0.f;
#pragma unroll
        for (int j = 0; j < 4; ++j) s += (v[j][0] + v[j][1]) + (v[j][2] + v[j][3]);
        const float mean = wave_sum(s, lane) * (1.f / D); float s2 = 0.f;
#pragma unroll
        for (int j = 0; j < 4; ++j) { v[j] = v[j] - mean; s2 += (v[j][0] * v[j][0] + v[j][1] * v[j][1]) + (v[j][2] * v[j][2] + v[j][3] * v[j][3]); }
        const float rstd = 1.0f / sqrtf(wave_sum(s2, lane) * (1.f / D) + LN_EPS);
        f32x4 o[4];
#pragma unroll
        for (int j = 0; j < 4; ++j) o[j] = v[j] * rstd * gv[j] + bv[j];
        if (layer == DEPTH - 1 || dry) {
#pragma unroll
            for (int j = 0; j < 4; ++j) *(f32x4*)(outp + (size_t)row * D + 16 * lane + 4 * j) = o[j]; }
        if (layer != DEPTH - 1) { *(u32x4*)(xbo + (size_t)row * D + 16 * lane) = pack_bf16x8(o[0], o[1]); *(u32x4*)(xbo + (size_t)row * D + 16 * lane + 8) = pack_bf16x8(o[2], o[3]);
            if (!dry) { u32x4 q8; q8.x = pk4_fp8(o[0][0], o[0][1], o[0][2], o[0][3]); q8.y = pk4_fp8(o[1][0], o[1][1], o[1][2], o[1][3]); q8.z = pk4_fp8(o[2][0], o[2][1], o[2][2], o[2][3]); q8.w = pk4_fp8(o[3][0], o[3][1], o[3][2], o[3][3]);
                *(u32x4*)((unsigned char*)(F.ws + WS_X) + (size_t)row * D + 16 * lane) = q8; } }
    }
}

constexpr size_t AUX_OB = 96 * MiB, AUX_LSE = 128 * MiB;
__device__ __forceinline__ void phase_attn(const Frame& F, int bx) {
    const bf16* qkv = (const bf16*)(F.ws + WS_BIG); bf16* og = (bf16*)(F.ws + WS_AUX); float* lse = (float*)(F.ws + WS_AUX + AUX_LSE);
    constexpr int KLD = 136;
    LAS bf16* Ks = (LAS bf16*)F.lds; LAS bf16* Vs = Ks + 256 * KLD;
    const int lane = F.lane, w = F.wave, g4 = lane >> 4, l15 = lane & 15, qq = l15 >> 2, pp = lane & 3;
    u32x4 kc[4], vc[4];
    constexpr int NRUN = 768;
#define ATT_LOADBLK(KR, VR, nblk) do { _Pragma("unroll") for (int it = 0; it < 4; ++it) { const int idx = F.tid + 512 * it, c = idx >> 4, ch = idx & 15; int pos = 128 * (nblk) + c; pos = pos < 0 ? 0 : pos; \
            const unsigned so = (rowbase + (unsigned)pos * (unsigned)d + (unsigned)r) * (unsigned)ATT_IN + (unsigned)(g * 3072 + 1024 + h * 128 + ch * 8); KR[it] = *(const u32x4*)(qkv + so); VR[it] = *(const u32x4*)(qkv + so + 1024u); } } while (0)
#define ATT_STOREBLK(KR, VR, slot) do { _Pragma("unroll") for (int it = 0; it < 4; ++it) { const int idx = F.tid + 512 * it, c = idx >> 4, ch = idx & 15; \
            *(LAS u32x4*)(Ks + (128 * (slot) + c) * KLD + ch * 8) = KR[it]; *(LAS u32x4*)(Vs + (128 * (slot) + c) * KLD + ch * 8) = VR[it]; } } while (0)
    for (int R = bx; R < NRUN; R += F.G) {
        const int h = R & 7, sbr = R >> 3, g = sbr >> 5, rem = sbr & 31, b = rem >> 4, rr_ = rem & 15;
        const int dsh = 2 * g, d = 1 << dsh, nrs = 4 - dsh, r = rr_ >> nrs, n0 = 4 * (rr_ & ((1 << nrs) - 1)); const unsigned rowbase = (unsigned)b * SEQ;
        ATT_LOADBLK(kc, vc, n0 - 1); ATT_STOREBLK(kc, vc, (n0 - 1) & 1); ATT_LOADBLK(kc, vc, n0);
#pragma unroll 1
        for (int j = 0; j < 4; ++j) {
            const int n = n0 + j, cs = n & 1, ps = cs ^ 1;
            ATT_STOREBLK(kc, vc, cs);
            const int qi = 16 * w + l15; const unsigned qrow = rowbase + (unsigned)(128 * n + qi) * (unsigned)d + (unsigned)r;
            bf16x8 qf[4];
#pragma unroll
            for (int s = 0; s < 4; ++s) qf[s] = *(const bf16x8*)(qkv + (qrow * (unsigned)ATT_IN + (unsigned)(g * 3072 + h * 128 + 32 * s + 8 * g4)));
            __syncthreads();
            if (j < 3) { ATT_LOADBLK(kc, vc, n + 1); }
            __builtin_amdgcn_sched_barrier(0);
            const int ws0 = (16 * w < 96) ? 16 * w : 96;
#define ATT_PROW(c0) (((c0) < 128) ? (128 * ps + (c0)) : (128 * cs + (c0) - 128))
            f32x4 sacc[10];
            {
                bf16x8 kfa[4], kfb[4];
#pragma unroll
                for (int s = 0; s < 4; ++s) kfa[s] = row_frag(Ks, KLD, ATT_PROW(ws0), 32 * s, lane);
#pragma unroll
                for (int t = 0; t < 10; t += 2) {
#pragma unroll
                    for (int s = 0; s < 4; ++s) kfb[s] = row_frag(Ks, KLD, ATT_PROW(ws0 + 16 * (t + 1)), 32 * s, lane);
                    __builtin_amdgcn_sched_barrier(0);
                    sacc[t] = (f32x4){0.f, 0.f, 0.f, 0.f};
#pragma unroll
                    for (int s = 0; s < 4; ++s) sacc[t] = MFMA16(kfa[s], qf[s], sacc[t]);
                    if (t + 2 < 10) {
#pragma unroll
                        for (int s = 0; s < 4; ++s) kfa[s] = row_frag(Ks, KLD, ATT_PROW(ws0 + 16 * (t + 2)), 32 * s, lane); }
                    __builtin_amdgcn_sched_barrier(0);
                    sacc[t + 1] = (f32x4){0.f, 0.f, 0.f, 0.f};
#pragma unroll
                    for (int s = 0; s < 4; ++s) sacc[t + 1] = MFMA16(kfb[s], qf[s], sacc[t + 1]);
                }
            }
            const float slope = exp2f(-(float)(h + 1)) * (float)d;
            float mx = -INFINITY;
#pragma unroll
            for (int t = 0; t < 10; ++t)
#pragma unroll
                for (int i = 0; i < 4; ++i) { const int c = ws0 + 16 * t + 4 * g4 + i, step = 128 + qi - c;
                    const bool valid = (step >= 0) && (step <= 128) && (n > 0 || c >= 128);
                    const float v = valid ? sacc[t][i] - slope * (float)step : -INFINITY; sacc[t][i] = v; mx = fmaxf(mx, v); }
            mx = fmaxf(mx, shx(mx, 16, lane)); mx = fmaxf(mx, shx(mx, 32, lane));
            float lsum = 0.f;
#pragma unroll
            for (int t = 0; t < 10; ++t)
#pragma unroll
                for (int i = 0; i < 4; ++i) { const float pv = __expf(sacc[t][i] - mx); sacc[t][i] = pv; lsum += pv; }
            lsum += shx(lsum, 16, lane); lsum += shx(lsum, 32, lane);
            bf16x8 pf[5];
#pragma unroll
            for (int kt = 0; kt < 5; ++kt) pf[kt] = pack8(sacc[2 * kt], sacc[2 * kt + 1]);
            f32x4 o[8];
            {
                const LAS bf16* vl = Vs + (4 * g4 + qq) * KLD + 32 * pp;
                bf16x4 va[10], vcc[10];
#pragma unroll
                for (int q = 0; q < 10; ++q) va[q] = tr4(vl + ATT_PROW(ws0 + 16 * q) * KLD);
#pragma unroll
                for (int et = 0; et < 8; et += 2) {
#pragma unroll
                    for (int q = 0; q < 10; ++q) vcc[q] = tr4(vl + ATT_PROW(ws0 + 16 * q) * KLD + 4 * (et + 1));
                    __builtin_amdgcn_sched_barrier(0);
                    o[et] = (f32x4){0.f, 0.f, 0.f, 0.f};
#pragma unroll
                    for (int kt = 0; kt < 5; ++kt) o[et] = MFMA16(cat8(va[2 * kt], va[2 * kt + 1]), pf[kt], o[et]);
                    if (et + 2 < 8) {
#pragma unroll
                        for (int q = 0; q < 10; ++q) va[q] = tr4(vl + ATT_PROW(ws0 + 16 * q) * KLD + 4 * (et + 2)); }
                    __builtin_amdgcn_sched_barrier(0);
                    o[et + 1] = (f32x4){0.f, 0.f, 0.f, 0.f};
#pragma unroll
                    for (int kt = 0; kt < 5; ++kt) o[et + 1] = MFMA16(cat8(vcc[2 * kt], vcc[2 * kt + 1]), pf[kt], o[et + 1]);
                }
            }
#undef ATT_PROW
            const float inv = 1.0f / lsum;
            bf16* orow = og + ((size_t)g * T + qrow) * D + h * 128 + 32 * g4;
#pragma unroll
            for (int e2 = 0; e2 < 4; ++e2) *(u32x4*)(orow + 8 * e2) = pack_bf16x8(o[2 * e2] * inv, o[2 * e2 + 1] * inv);
            if (g4 == 0) lse[((size_t)g * T + qrow) * AH + h] = mx + __logf(lsum);
            __syncthreads();
        }
    }
#undef ATT_LOADBLK
#undef ATT_STOREBLK
}
__device__ __forceinline__ void phase_attn_combine(const Frame& F) {
    const bf16* og = (const bf16*)(F.ws + WS_AUX); const float* lse = (const float*)(F.ws + WS_AUX + AUX_LSE); bf16* ob = (bf16*)(F.ws + WS_AUX + AUX_OB);
    const int lane = F.lane, gw = F.vcu * NWAVES + F.wave, NGW = F.G * NWAVES, h = lane >> 3;
    for (int row = gw; row < T; row += NGW) {
        const float l0 = lse[((size_t)0 * T + row) * AH + h], l1 = lse[((size_t)1 * T + row) * AH + h], l2 = lse[((size_t)2 * T + row) * AH + h];
        const float m = fmaxf(l0, fmaxf(l1, l2)); float w0 = __expf(l0 - m), w1 = __expf(l1 - m), w2 = __expf(l2 - m); const float inv = 1.0f / (w0 + w1 + w2); w0 *= inv; w1 *= inv; w2 *= inv;
        float a[16];
#pragma unroll
        for (int j = 0; j < 16; ++j) a[j] = 0.f;
#pragma unroll
        for (int g = 0; g < 3; ++g) { const float wg = (g == 0) ? w0 : (g == 1 ? w1 : w2);
#pragma unroll
            for (int q = 0; q < 2; ++q) { const u32x4 s = *(const u32x4*)(og + ((size_t)g * T + row) * D + 16 * lane + 8 * q);
                a[8 * q + 0] += wg * bflo(s.x); a[8 * q + 1] += wg * bfhi(s.x); a[8 * q + 2] += wg * bflo(s.y); a[8 * q + 3] += wg * bfhi(s.y);
                a[8 * q + 4] += wg * bflo(s.z); a[8 * q + 5] += wg * bfhi(s.z); a[8 * q + 6] += wg * bflo(s.w); a[8 * q + 7] += wg * bfhi(s.w); } }
        { u32x4 o;
#pragma unroll
          for (int q = 0; q < 4; ++q) o[q] = pk4_fp8(a[4 * q] * A_SCALE, a[4 * q + 1] * A_SCALE, a[4 * q + 2] * A_SCALE, a[4 * q + 3] * A_SCALE);
          *(u32x4*)((unsigned char*)ob + (size_t)row * D + 16 * lane) = o; }
    }
}

constexpr size_t BIG_YRET = 192 * MiB;
__device__ __forceinline__ void phase_ret_u(const Frame& F) {
    const bf16* proj = (const bf16*)(F.ws + WS_BIG); bf16* St = (bf16*)(F.ws + WS_AUX);
    constexpr int LD = 264;
    LAS bf16* Kt = (LAS bf16*)F.lds; LAS bf16* Vt = Kt + 128 * LD;
    const int lane = F.lane, w = F.wave, g4 = lane >> 4, l15 = lane & 15, qq = l15 >> 2, pp = lane & 3;
    u32x4 kr[8], vr[8];
#define RU_LOAD(u_) do { const int eh_ = (u_) & 1, h_ = ((u_) >> 1) & 3, n_ = ((u_) >> 3) & 63, b_ = (u_) >> 9; const char* pb_ = (const char*)(proj + ((size_t)b_ * SEQ + (size_t)n_ * RC) * RET_IN); \
        int t_ = F.tid; asm volatile("" : "+v"(t_)); unsigned off_ = (unsigned)(((t_ >> 5) * RET_IN + (t_ & 31) * 8) * 2); \
        _Pragma("unroll") for (int it = 0; it < 8; ++it) { asm volatile("" : "+v"(off_)); kr[it] = *(const u32x4*)(pb_ + (size_t)(1024 + h_ * 256 + it * 16 * RET_IN) * 2 + off_); \
            vr[it] = *(const u32x4*)(pb_ + (size_t)(2048 + h_ * 512 + eh_ * 256 + it * 16 * RET_IN) * 2 + off_); } } while (0)
    if (F.vcu < 1024) RU_LOAD(F.vcu);
    for (int u = F.vcu; u < 1024; u += F.G) {
        const int eh = u & 1, h = (u >> 1) & 3, n = (u >> 3) & 63, b = u >> 9;
        { int t_ = F.tid; asm volatile("" : "+v"(t_));
#pragma unroll
          for (int it = 0; it < 8; ++it) { const int idx = t_ + 512 * it, j = idx >> 5, ch = idx & 31; *(LAS u32x4*)(Kt + j * LD + ch * 8) = kr[it]; *(LAS u32x4*)(Vt + j * LD + ch * 8) = vr[it]; } }
        __syncthreads();
        f32x4 acc[16][2];
#pragma unroll
        for (int mt = 0; mt < 16; ++mt) { acc[mt][0] = (f32x4){0.f, 0.f, 0.f, 0.f}; acc[mt][1] = (f32x4){0.f, 0.f, 0.f, 0.f}; }
#pragma unroll
        for (int ks = 0; ks < 4; ++ks) {
            bf16x8 bfr[2];
#pragma unroll
            for (int nt = 0; nt < 2; ++nt) { const LAS bf16* a0 = Vt + (32 * ks + 8 * g4 + qq) * LD + 32 * w + 16 * nt + 4 * pp; bfr[nt] = cat8(tr4(a0), tr4(a0 + 4 * LD)); }
#pragma unroll
            for (int mt = 0; mt < 16; ++mt) { const LAS bf16* a0 = Kt + (32 * ks + 8 * g4 + qq) * LD + 128 * (mt >> 3) + 32 * pp + 4 * (mt & 7);
                const bf16x8 afr = cat8(tr4(a0), tr4(a0 + 4 * LD));
                acc[mt][0] = MFMA16(afr, bfr[0], acc[mt][0]); acc[mt][1] = MFMA16(afr, bfr[1], acc[mt][1]); }
        }
        { const int un = (u + F.G < 1024) ? u + F.G : u; RU_LOAD(un); }
        bf16* outb = St + ((size_t)((b * RH + h) * RNC + n)) * (RDV * RDK);
#pragma unroll
        for (int nt = 0; nt < 2; ++nt) { bf16* orow = outb + (size_t)(eh * 256 + 32 * w + 16 * nt + l15) * RDK + 32 * g4;
#pragma unroll
            for (int mh = 0; mh < 2; ++mh)
#pragma unroll
                for (int q = 0; q < 4; ++q) *(u32x4*)(orow + 128 * mh + 8 * q) = pack_bf16x8(acc[mh * 8 + 2 * q][nt], acc[mh * 8 + 2 * q + 1][nt]); }
        __syncthreads();
    }
#undef RU_LOAD
}
__device__ __forceinline__ void phase_ret_scan(const Frame& F) {
    bf16* St = (bf16*)(F.ws + WS_AUX);
    for (int gt = F.vcu * NTHREADS + F.tid; gt < 8 * 16384; gt += F.G * NTHREADS) {
        const int bh = gt >> 14, chunk = gt & 16383, h = bh & 3;
        const float g128 = exp2f(128.0f * log2f(1.0f - exp2f(-5.0f - (float)h)));
        bf16* base = St + (size_t)bh * RNC * (RDV * RDK) + (size_t)chunk * 8;
        float c[8];
#pragma unroll
        for (int j = 0; j < 8; ++j) c[j] = 0.f;
#pragma unroll 8
        for (int n = 0; n < RNC; ++n) { bf16* pn = base + (size_t)n * (RDV * RDK); const u32x4 uv = *(const u32x4*)pn;
            u32x4 o; o.x = pk2(c[0], c[1]); o.y = pk2(c[2], c[3]); o.z = pk2(c[4], c[5]); o.w = pk2(c[6], c[7]); *(u32x4*)pn = o;
            c[0] = g128 * (c[0] + bflo(uv.x)); c[1] = g128 * (c[1] + bfhi(uv.x)); c[2] = g128 * (c[2] + bflo(uv.y)); c[3] = g128 * (c[3] + bfhi(uv.y));
            c[4] = g128 * (c[4] + bflo(uv.z)); c[5] = g128 * (c[5] + bfhi(uv.z)); c[6] = g128 * (c[6] + bflo(uv.w)); c[7] = g128 * (c[7] + bfhi(uv.w)); }
    }
}
__device__ __forceinline__ void phase_ret_out(const Frame& F, KP p) {
    const bf16* proj = (const bf16*)(F.ws + WS_BIG); const bf16* St = (const bf16*)(F.ws + WS_AUX); bf16* yret = (bf16*)(F.ws + WS_BIG + BIG_YRET);
    const float* gng = gin(p, 4); const float* gnb = gin(p, 5);
    constexpr int LD = 264, VLD = 72, NSL = 8, ESL = 64;
    LAS bf16* Rs = (LAS bf16*)F.lds; LAS bf16* Vs = Rs + 128 * LD;
    const int w = F.wave;
#define RO_TID(t_) int t_ = F.tid; asm volatile("" : "+v"(t_))
#define RO_LD(base_, off_) (*(const u32x4*)((const char*)(base_) + (off_)))
    for (int u = F.vcu; u < 512; u += F.G) {
        const int h = u & 3, n = (u >> 2) & 63, b = u >> 8;
        const size_t row0 = (size_t)b * SEQ + (size_t)n * RC;
        const bf16* Sn = St + ((size_t)((b * RH + h) * RNC + n)) * (RDV * RDK);
        const char* pbase = (const char*)(proj + row0 * RET_IN);
        u32x4 pv[2], ps[4];
        bf16x8 qf[8];
        { RO_TID(t0); u32x4 kreg[8];
          unsigned koff = (unsigned)(((t0 >> 5) * RET_IN + (t0 & 31) * 8) * 2), qoff = (unsigned)(((16 * w + (t0 & 15)) * RET_IN + 8 * ((t0 & 63) >> 4)) * 2);
#pragma unroll
          for (int it = 0; it < 8; ++it) { asm volatile("" : "+v"(koff)); kreg[it] = RO_LD(pbase + (size_t)(1024 + h * 256 + it * 16 * RET_IN) * 2, koff); }
#pragma unroll
          for (int s = 0; s < 8; ++s) { asm volatile("" : "+v"(qoff)); qf[s] = __builtin_bit_cast(bf16x8, RO_LD(pbase + (size_t)(h * 256 + 32 * s) * 2, qoff)); }
#define RO_LOAD_SLICE(sl_) do { RO_TID(tl_); unsigned voff = (unsigned)(((tl_ >> 3) * RET_IN + (tl_ & 7) * 8) * 2), soff = (unsigned)(((tl_ >> 5) * RDK + (tl_ & 31) * 8) * 2); \
            _Pragma("unroll") for (int it = 0; it < 2; ++it) { asm volatile("" : "+v"(voff)); pv[it] = RO_LD(pbase + (size_t)(2048 + h * 512 + (sl_) * ESL + it * 64 * RET_IN) * 2, voff); } \
            _Pragma("unroll") for (int it = 0; it < 4; ++it) { asm volatile("" : "+v"(soff)); ps[it] = RO_LD((const char*)Sn + (size_t)(((sl_) * ESL + it * 16) * RDK) * 2, soff); } } while (0)
          RO_LOAD_SLICE(0);
#pragma unroll
          for (int it = 0; it < 8; ++it) { const int idx = t0 + 512 * it, j = idx >> 5, ch = idx & 31; *(LAS u32x4*)(Rs + j * LD + ch * 8) = kreg[it]; } }
        __syncthreads();
        bf16x8 pf[4];
        { RO_TID(t1); const int lane = t1 & 63, g4 = lane >> 4, irow = 16 * w + (lane & 15);
          f32x4 sacc[8];
#pragma unroll
            for (int jt = 0; jt < 8; ++jt) { sacc[jt] = (f32x4){0.f, 0.f, 0.f, 0.f};
                if (jt <= w) {
#pragma unroll
                    for (int s = 0; s < 8; ++s) sacc[jt] = MFMA16(row_frag(Rs, LD, 16 * jt, 32 * s, lane), qf[s], sacc[jt]);
#pragma unroll
                    for (int i = 0; i < 4; ++i) if (16 * jt + 4 * g4 + i > irow) sacc[jt][i] = 0.f; } }
#pragma unroll
            for (int kt = 0; kt < 4; ++kt) pf[kt] = pack8(sacc[2 * kt], sacc[2 * kt + 1]); }
        __syncthreads();
        u32x4 accp[NSL][2];
        float s1 = 0.f, s2 = 0.f;
#pragma unroll
        for (int sl = 0; sl < NSL; ++sl) {
            { RO_TID(t2);
#pragma unroll
              for (int it = 0; it < 2; ++it) { const int idx = t2 + 512 * it, j = idx >> 3, ch = idx & 7; *(LAS u32x4*)(Vs + j * VLD + ch * 8) = pv[it]; }
#pragma unroll
              for (int it = 0; it < 4; ++it) { const int idx = t2 + 512 * it, e = idx >> 5, ch = idx & 31; *(LAS u32x4*)(Rs + e * LD + ch * 8) = ps[it]; } }
            __syncthreads();
            if (sl + 1 < NSL) RO_LOAD_SLICE(sl + 1);
            RO_TID(t3); const int lane = t3 & 63, g4 = lane >> 4, qq = (lane & 15) >> 2, pp = lane & 3;
            f32x4 acc[4];
#pragma unroll
            for (int et = 0; et < 4; ++et) { f32x4 a = (f32x4){0.f, 0.f, 0.f, 0.f};
#pragma unroll
                for (int kt = 0; kt < 4; ++kt) if (2 * kt <= w) { const LAS bf16* a0 = Vs + (32 * kt + 4 * g4 + qq) * VLD + 16 * pp + 4 * et;
                    a = MFMA16(cat8(tr4(a0), tr4(a0 + 16 * VLD)), pf[kt], a); }
                const LAS bf16* srow = Rs + (16 * qq + 4 * et + pp) * LD + 8 * g4;
#pragma unroll
                for (int s = 0; s < 8; ++s) a = MFMA16(*(const LAS bf16x8*)(srow + 32 * s), qf[s], a);
                acc[et] = a; s1 += (a[0] + a[1]) + (a[2] + a[3]); s2 += (a[0] * a[0] + a[1] * a[1]) + (a[2] * a[2] + a[3] * a[3]);
                __builtin_amdgcn_sched_barrier(0); }
            accp[sl][0] = pack_bf16x8(acc[0], acc[1]); accp[sl][1] = pack_bf16x8(acc[2], acc[3]);
            __syncthreads();
        }
#undef RO_LOAD_SLICE
        RO_TID(t4); const int lane = t4 & 63, g4 = lane >> 4, irow = 16 * w + (lane & 15); const size_t qrow = row0 + irow;
        s1 += shx(s1, 16, lane); s1 += shx(s1, 32, lane); s2 += shx(s2, 16, lane); s2 += shx(s2, 32, lane);
        const float mean = s1 * (1.0f / RDV); const float var = fmaxf(s2 * (1.0f / RDV) - mean * mean, 0.f);
        const float rstd = 1.0f / sqrtf(var + LN_EPS);
        unsigned goff = (unsigned)((irow * RET_IN + 16 * g4) * 2);
#pragma unroll
        for (int sp = 0; sp < NSL; sp += 2) {
            u32x4 gq[2][2]; f32x4 gg[2][4], gb[2][4];
#pragma unroll
            for (int d2 = 0; d2 < 2; ++d2) { const int c0 = h * RDV + (sp + d2) * ESL + 16 * g4;
#pragma unroll
                for (int q = 0; q < 2; ++q) { asm volatile("" : "+v"(goff)); gq[d2][q] = RO_LD(pbase + (size_t)(4096 + h * RDV + (sp + d2) * ESL + 8 * q) * 2, goff); }
#pragma unroll
                for (int q = 0; q < 4; ++q) { gg[d2][q] = *(const f32x4*)(gng + c0 + 4 * q); gb[d2][q] = *(const f32x4*)(gnb + c0 + 4 * q); } }
#pragma unroll
            for (int d2 = 0; d2 < 2; ++d2) { const int c0 = h * RDV + (sp + d2) * ESL + 16 * g4; u32x4 o8;
#pragma unroll
                for (int q = 0; q < 2; ++q) { const u32x4 gw = gq[d2][q]; f32x4 a0, a1; unpack_bf16x8(accp[sp + d2][q], a0, a1);
                    f32x4 y0 = (a0 - mean) * rstd * gg[d2][2 * q] + gb[d2][2 * q], y1 = (a1 - mean) * rstd * gg[d2][2 * q + 1] + gb[d2][2 * q + 1];
                    const float gv[8] = {bflo(gw.x), bfhi(gw.x), bflo(gw.y), bfhi(gw.y), bflo(gw.z), bfhi(gw.z), bflo(gw.w), bfhi(gw.w)};
#pragma unroll
                    for (int j = 0; j < 4; ++j) { y0[j] *= gv[j] * fsig(gv[j]) * A_SCALE; y1[j] *= gv[4 + j] * fsig(gv[4 + j]) * A_SCALE; }
                    o8[2 * q] = pk4_fp8(y0[0], y0[1], y0[2], y0[3]); o8[2 * q + 1] = pk4_fp8(y1[0], y1[1], y1[2], y1[3]); }
                *(u32x4*)((unsigned char*)yret + qrow * RET_V + c0) = o8; }
        }
    }
#undef RO_LD
#undef RO_TID
}

constexpr size_t AUX_S5E = 64 * MiB;
constexpr int S5L = 256, S5NC = SEQ / S5L;
__device__ __forceinline__ void cmul_add(float& rr, float& ri, float ar, float ai, float xr, float xi, float cr, float ci) { rr = ar * xr - ai * xi + cr; ri = ar * xi + ai * xr + ci; }
template <bool OUT>
__device__ __forceinline__ void phase_s5_scan(const Frame& F, KP p) {
    const bf16* X = (const bf16*)(F.ws + WS_XB); float* E = (float*)(F.ws + WS_AUX + AUX_S5E); bf16* ybuf = (bf16*)(F.ws + WS_AUX);
    const int lane = F.lane, w = F.wave, g4 = lane >> 4, l15 = lane & 15;
    LAS bf16* ut = (LAS bf16*)(F.lds + w * 12288);
    LAS bf16* Hb = (LAS bf16*)(F.lds + w * 12288 + 4096);
    constexpr int HLD = 136;
    const int gw = F.vcu * NWAVES + w, NGW = F.G * NWAVES;
    const int up16 = (lane - 16) << 2, up32 = (lane - 32) << 2, last16 = (48 + l15) << 2;
    for (int unit = gw; unit < BATCH * SG * S5NC; unit += NGW) {
        const int n = unit & (S5NC - 1), g = (unit >> 5) & 63, b = unit >> 11;
        float a1r[4], a1i[4], a4r[4], a4i[4], a8r[4], a8i[4], pwr[4], pwi[4];
        bf16x8 bfrag[8];
        const float dt = expf(gin(p, 14)[g]);
#pragma unroll
        for (int st = 0; st < 4; ++st) { const int ps = 16 * st + l15;
            const float are = gin(p, 7)[g * SP + ps], aim = gin(p, 8)[g * SP + ps];
            const float mag = expf(dt * are); const float abr = mag * cosf(dt * aim), abi = mag * sinf(dt * aim);
            const float den = are * are + aim * aim;
            const float fre = ((abr - 1.0f) * are + abi * aim) / den, fim = (abi * are - (abr - 1.0f) * aim) / den;
            a1r[st] = abr; a1i[st] = abi; { float t2r, t2i; cmul_add(t2r, t2i, abr, abi, abr, abi, 0.f, 0.f); cmul_add(a4r[st], a4i[st], t2r, t2i, t2r, t2i, 0.f, 0.f); }
            cmul_add(a8r[st], a8i[st], a4r[st], a4i[st], a4r[st], a4i[st], 0.f, 0.f);
            float qr = 1.f, qi = 0.f;
            if (g4 & 1) { qr = a4r[st]; qi = a4i[st]; }
            if (g4 & 2) { float tr, ti; cmul_add(tr, ti, qr, qi, a8r[st], a8i[st], 0.f, 0.f); qr = tr; qi = ti; }
            pwr[st] = qr; pwi[st] = qi;
            const float* br = gin(p, 9) + ((size_t)g * SP + ps) * SGC + 8 * (g4 & 1); const float* bi = gin(p, 10) + ((size_t)g * SP + ps) * SGC + 8 * (g4 & 1);
            const f32x4 r0 = *(const f32x4*)br, r1 = *(const f32x4*)(br + 4), i0 = *(const f32x4*)bi, i1 = *(const f32x4*)(bi + 4);
            const float z = (g4 < 2) ? 1.0f : 0.0f; const float fr2 = fre * z, fi2 = fim * z;
            bfrag[st] = pack8(r0 * fr2 - i0 * fi2, r1 * fr2 - i1 * fi2); bfrag[st + 4] = pack8(i0 * fr2 + r0 * fi2, i1 * fr2 + r1 * fi2);
        }
        float sr[4], si[4];
        float* Eu = E + ((size_t)(b * SG + g) * S5NC + n) * 128;
        bf16x8 cf[4]; f32x4 dsk = (f32x4){0.f, 0.f, 0.f, 0.f};
#pragma unroll
        for (int st = 0; st < 4; ++st) { sr[st] = 0.f; si[st] = 0.f; }
        if (OUT) {
#pragma unroll
            for (int st = 0; st < 4; ++st) { sr[st] = Eu[16 * st + l15]; si[st] = Eu[64 + 16 * st + l15]; }
#pragma unroll
            for (int s = 0; s < 4; ++s) { const float* cp = (s < 2 ? gin(p, 11) : gin(p, 12)) + ((size_t)g * SGC + l15) * SP + 32 * (s & 1) + 8 * g4; const float sg = s < 2 ? 1.0f : -1.0f;
                const f32x4 c0 = *(const f32x4*)cp * sg, c1 = *(const f32x4*)(cp + 4) * sg; cf[s] = pack8(c0, c1); }
            dsk = *(const f32x4*)(gin(p, 13) + g * SGC + 4 * g4); }
        const size_t tok0 = (size_t)b * SEQ + (size_t)n * S5L;
        u32x4 pre[2];
        { const bf16* src = X + (tok0 + lane) * D + g * SGC; pre[0] = *(const u32x4*)src; pre[1] = *(const u32x4*)(src + 8); }
        for (int sub = 0; sub < S5L / 64; ++sub) {
            *(LAS u32x4*)(ut + lane * 16) = pre[0]; *(LAS u32x4*)(ut + lane * 16 + 8) = pre[1];
            if (sub + 1 < S5L / 64) { const bf16* src = X + (tok0 + (sub + 1) * 64 + lane) * D + g * SGC; pre[0] = *(const u32x4*)src; pre[1] = *(const u32x4*)(src + 8); }
            LDS_WAIT(); asm volatile("" ::: "memory");
#pragma unroll (OUT ? 1 : 4)
            for (int blk = 0; blk < 4; ++blk) {
                u32x4 uw = *(const LAS u32x4*)(ut + (blk * 16 + l15) * 16 + 8 * (g4 & 1));
                if (g4 >= 2) uw = (u32x4){0u, 0u, 0u, 0u};
                const bf16x8 ufr = __builtin_bit_cast(bf16x8, uw);
                f32x4 dr[4], di[4];
#pragma unroll
                for (int st = 0; st < 4; ++st) { dr[st] = MFMA16(ufr, bfrag[st], ((f32x4){0.f, 0.f, 0.f, 0.f})); di[st] = MFMA16(ufr, bfrag[st + 4], ((f32x4){0.f, 0.f, 0.f, 0.f})); }
                float vr[4], vi[4];
#pragma unroll
                for (int st = 0; st < 4; ++st) {
                    float hr = 0.f, hi = 0.f;
#pragma unroll
                    for (int i = 0; i < 4; ++i) { float nr, ni; cmul_add(nr, ni, a1r[st], a1i[st], hr, hi, dr[st][i], di[st][i]); hr = nr; hi = ni; dr[st][i] = hr; di[st][i] = hi; }
                    vr[st] = hr; vi[st] = hi; }
#define BPF(idx, v) __builtin_bit_cast(float, __builtin_amdgcn_ds_bpermute((idx), __builtin_bit_cast(int, (v))))
                { float xr[4], xi[4];
#pragma unroll
                  for (int st = 0; st < 4; ++st) { xr[st] = BPF(up16, vr[st]); xi[st] = BPF(up16, vi[st]); }
#pragma unroll
                  for (int st = 0; st < 4; ++st) { float tr, ti; cmul_add(tr, ti, a4r[st], a4i[st], xr[st], xi[st], vr[st], vi[st]); if (g4 >= 1) { vr[st] = tr; vi[st] = ti; } }
#pragma unroll
                  for (int st = 0; st < 4; ++st) { xr[st] = BPF(up32, vr[st]); xi[st] = BPF(up32, vi[st]); }
#pragma unroll
                  for (int st = 0; st < 4; ++st) { float tr, ti; cmul_add(tr, ti, a8r[st], a8i[st], xr[st], xi[st], vr[st], vi[st]); if (g4 >= 2) { vr[st] = tr; vi[st] = ti; } } }
                float er[4], ei[4], lr[4], li[4];
#pragma unroll
                for (int st = 0; st < 4; ++st) { if (OUT) { er[st] = BPF(up16, vr[st]); ei[st] = BPF(up16, vi[st]); } else { er[st] = 0.f; ei[st] = 0.f; } lr[st] = BPF(last16, vr[st]); li[st] = BPF(last16, vi[st]); }
#undef BPF
#pragma unroll
                for (int st = 0; st < 4; ++st) {
                    if (g4 == 0) { er[st] = 0.f; ei[st] = 0.f; }
                    if (OUT) { float s0r, s0i; cmul_add(s0r, s0i, pwr[st], pwi[st], sr[st], si[st], er[st], ei[st]);
#pragma unroll
                        for (int i = 0; i < 4; ++i) { float tr, ti; cmul_add(tr, ti, a1r[st], a1i[st], s0r, s0i, 0.f, 0.f); s0r = tr; s0i = ti; dr[st][i] += s0r; di[st][i] += s0i; } }
                    { float a16r, a16i; cmul_add(a16r, a16i, a8r[st], a8i[st], a8r[st], a8i[st], 0.f, 0.f); float tr, ti; cmul_add(tr, ti, a16r, a16i, sr[st], si[st], lr[st], li[st]); sr[st] = tr; si[st] = ti; }
                    if (OUT) {
#pragma unroll
                        for (int i = 0; i < 4; ++i) { const unsigned hw = pk2(dr[st][i], di[st][i]); Hb[(4 * g4 + i) * HLD + 16 * st + l15] = (bf16)hw; Hb[(4 * g4 + i) * HLD + 64 + 16 * st + l15] = (bf16)(hw >> 16); } }
                }
                if (OUT) {
                    LDS_WAIT(); asm volatile("" ::: "memory");
                    f32x4 ya = (f32x4){0.f, 0.f, 0.f, 0.f};
#pragma unroll
                    for (int s = 0; s < 4; ++s) ya = MFMA16(cf[s], row_frag(Hb, HLD, 0, 32 * s, lane), ya);
                    const u32x2 u2 = *(const LAS u32x2*)(ut + (blk * 16 + l15) * 16 + 4 * g4);
                    const f32x4 u4 = (f32x4){bflo(u2.x), bfhi(u2.x), bflo(u2.y), bfhi(u2.y)};
                    f32x4 y = ya + dsk * u4;
#pragma unroll
                    for (int j = 0; j < 4; ++j) { const float v = y[j]; y[j] = v * fsig(1.5957691216057308f * (v + 0.044715f * v * v * v)); }
                    *(unsigned*)((unsigned char*)ybuf + (size_t)(tok0 + sub * 64 + blk * 16 + l15) * D + g * SGC + 4 * g4) = pk4_fp8(y[0] * A_SCALE, y[1] * A_SCALE, y[2] * A_SCALE, y[3] * A_SCALE);
                    asm volatile("" ::: "memory"); }
            }
            LDS_WAIT(); asm volatile("" ::: "memory");
        }
        if (!OUT && g4 == 0) {
#pragma unroll
            for (int st = 0; st < 4; ++st) { Eu[16 * st + l15] = sr[st]; Eu[64 + 16 * st + l15] = si[st]; } }
    }
}
__device__ __forceinline__ void phase_s5_carry(const Frame& F, KP p) {
    float* E = (float*)(F.ws + WS_AUX + AUX_S5E);
    for (int gt = F.vcu * NTHREADS + F.tid; gt < BATCH * SG * SP; gt += F.G * NTHREADS) {
        const int pl = gt & 63, bg = gt >> 6, g = bg & 63;
        const float dt = expf(gin(p, 14)[g]); const float are = gin(p, 7)[g * SP + pl], aim = gin(p, 8)[g * SP + pl];
        const float mag = expf(dt * are); float ar = mag * cosf(dt * aim), ai = mag * sinf(dt * aim);
#pragma unroll
        for (int q = 0; q < 8; ++q) { const float nr = ar * ar - ai * ai, ni = 2.0f * ar * ai; ar = nr; ai = ni; }
        float cr = 0.f, ci = 0.f;
        for (int n = 0; n < S5NC; ++n) { float* Eu = E + ((size_t)bg * S5NC + n) * 128; const float er = Eu[pl], ei = Eu[64 + pl];
            Eu[pl] = cr; Eu[64 + pl] = ci;
            const float nr = ar * cr - ai * ci + er, ni = ar * ci + ai * cr + ei; cr = nr; ci = ni; }
    }
}

constexpr int NPHASES = 34;
#ifndef PROBE_DRY14
#define PROBE_DRY14 0
#endif
#ifndef PROBE_DRY17
#define PROBE_DRY17 0
#endif
#ifndef PH_MASK
#define PH_MASK 0xFFFFFFFFu
#endif
#define PHT(t) ((PH_MASK >> (t)) & 1u)
constexpr int PLAN_OFF = 64;
__device__ __forceinline__ void moe_plan(const Frame& F, int layer) {
    volatile LAS int* tstart = (volatile LAS int*)(F.MISC + PLAN_OFF); volatile LAS int* cnts = tstart + 72;
    __syncthreads();
    if (F.wave == 0) {
        const unsigned* cnt = (const unsigned*)(F.ws + WS_CTL) + CW_CNT + layer * NE * 64;
        const int c = (int)__hip_atomic_load(cnt + F.lane * 64, __ATOMIC_RELAXED, __HIP_MEMORY_SCOPE_AGENT);
        int v = (c + 255) >> 8;
#pragma unroll
        for (int o = 1; o < 64; o <<= 1) { const int nb = __builtin_amdgcn_ds_bpermute((F.lane - o) << 2, v); if (F.lane >= o) v += nb; }
        tstart[F.lane + 1] = v; cnts[F.lane] = c;
        if (F.lane == 0) tstart[0] = 0;
        if (F.lane == 63) { tstart[65] = v + T / 256; cnts[64] = T; }
    }
    __syncthreads();
}
template <bool GATH> struct MoeSched2 {
    static constexpr bool GATHER = GATH, UNIFORMIZE = true, FP8 = true;
    static constexpr int ncol = GATH ? 2 : 4, K = GATH ? D / 2 : ED / 2;
    const volatile LAS int* tstart; const volatile LAS int* cnts; int ntiles, G, c, lane;
    const char* Abase; const char* Wbase; const int* lists;
    __device__ __forceinline__ bool next(int i, pg8::UnitG& u) const {
        const int nwg = ntiles * ncol; const long L = (long)i * G + c; if (L >= nwg) return false;
        int wgid = (int)L; { const int q = nwg / 8, r = nwg % 8, xcd = wgid % 8, off = wgid / 8; wgid = (xcd < r ? xcd * (q + 1) : r * (q + 1) + (xcd - r) * q) + off; }
        const int tile = wgid / ncol, pn = wgid % ncol;
        int ln; { unsigned o2 = ~0u; asm volatile("" : "+s"(o2)); ln = (int)__builtin_amdgcn_mbcnt_hi(o2, __builtin_amdgcn_mbcnt_lo(o2, 0u)); }
        const int ta = tstart[ln], tb = tstart[ln + 1];
        const unsigned long long mm = __ballot(ta <= tile && tile < tb);
        const int e = mm ? (int)__builtin_ctzll(mm) : 64;
        const int ts = __builtin_amdgcn_readfirstlane((int)tstart[e]), ce = __builtin_amdgcn_readfirstlane((int)cnts[e]);
        const int lt = tile - ts; int valid = ce - lt * 256; valid = valid > 256 ? 256 : valid;
        u.gshift = 0; u.aux = e;
        if (GATH) {
            u.B = Wbase + (size_t)e * WMOE_E_BYTES + (size_t)pn * 256 * K * 2;
            if (e < 64) { u.A = Abase; u.gidx = lists + (size_t)e * T + lt * 256; u.gcnt = valid; }
            else { u.A = Abase + (size_t)lt * 256 * K * 2; u.gidx = nullptr; u.gcnt = 0; }
            u.row0 = tile * 256; u.col0 = pn * 128;
        } else {
            u.B = Wbase + (size_t)e * WMOE_E_BYTES + (size_t)512 * 1024 * 2 + (size_t)pn * 256 * K * 2;
            u.A = Abase + (size_t)tile * 256 * K * 2; u.gidx = nullptr; u.gcnt = valid;
            u.row0 = tile * 256; u.col0 = pn * 256;
        }
        return true;
    }
};
__device__ __forceinline__ void phase_load_x(const Frame& F, KP p) {
    const float* xin = gin(p, 0); bf16* XB = (bf16*)(F.ws + WS_XB);
    for (size_t i = (size_t)F.vcu * NTHREADS + F.tid; i < (size_t)T * D / 8; i += (size_t)F.G * NTHREADS) {
        const f32x4 a = *(const f32x4*)(xin + i * 8), b = *(const f32x4*)(xin + i * 8 + 4);
        *(u32x4*)(XB + i * 8) = pack_bf16x8(a, b);
        u32x2 q8; q8.x = pk4_fp8(a[0], a[1], a[2], a[3]); q8.y = pk4_fp8(b[0], b[1], b[2], b[3]); *(u32x2*)((unsigned char*)(F.ws + WS_X) + i * 8) = q8; }
}

__global__ void __launch_bounds__(NTHREADS, 2) fwd_kernel(Params p_unused) {
    KP p0 = (KP)__builtin_amdgcn_kernarg_segment_ptr();
    extern __shared__ __attribute__((aligned(16))) unsigned char lds_raw[];
    Frame F0;
    F0.lds = (LAS unsigned char*)lds_raw; F0.MISC = (volatile LAS unsigned*)(F0.lds + MISC_OFF);
    F0.tid = threadIdx.x; F0.lane = F0.tid & 63; F0.wave = __builtin_amdgcn_readfirstlane(F0.tid >> 6);
    F0.G = gridDim.x; { const int bq = blockIdx.x; F0.vcu = (F0.G % 8 == 0) ? (bq % 8) * (F0.G / 8) + bq / 8 : bq; }
    F0.ws = p0->ws;
    const int bx0 = blockIdx.x;
    for (int u = F0.tid; u < (LDS_BYTES - MISC_OFF) / 4; u += NTHREADS) ((LAS unsigned*)(F0.lds + MISC_OFF))[u] = 0u;
    __syncthreads();
    XcdBarrier bar; bar.bar = (unsigned*)(p0->ws + WS_CTL) + CW_BAR; bar.x = 0; bar.st = nullptr;
    const int use_bar = p0->use_bar;
    if (use_bar) bar = xcd_barrier_post((unsigned*)(p0->ws + WS_CTL) + CW_BAR, F0.MISC + 8);
    const int lo = p0->ph_lo, hi = p0->ph_hi;
#define PHASE_BEGIN Frame F = F0; KP p = p0; { unsigned ones_ = ~0u; asm volatile("" : "+s"(ones_)); F.lane = (int)__builtin_amdgcn_mbcnt_hi(ones_, __builtin_amdgcn_mbcnt_lo(ones_, 0u)); } asm volatile("" : "+v"(F.lane)); F.tid = F.wave * 64 + F.lane; asm volatile("" : "+v"(F.tid));   GAS unsigned char* wsg_ = (GAS unsigned char*)F0.ws; asm volatile("" : "+s"(F.wave), "+s"(F.vcu), "+s"(F.G), "+s"(wsg_), "+s"(p)); \
    F.ws = (unsigned char*)wsg_; int bx = bx0; asm volatile("" : "+s"(bx)); unsigned char* ws = F.ws; (void)ws; (void)bx;
#pragma unroll 1
    for (int ph = lo; ph < hi; ++ph) {
        int layer = 0, type = 0;
        if (ph > 0) { layer = ph >= 26 ? 3 : (ph >= 18 ? 2 : (ph >= 9 ? 1 : 0)); const int q = ph - (layer == 3 ? 26 : (layer == 2 ? 18 : (layer == 1 ? 9 : 1))); const int kind = layer % 3;
            if (kind == 0) type = q < 4 ? 1 + q : 14 + (q - 4); else if (kind == 1) type = q < 5 ? 5 + q : 14 + (q - 5); else type = q < 4 ? 10 + q : 14 + (q - 4); }
        const int j = layer / 3;
#ifdef REPEAT_MASK
        const int nrep = ((REPEAT_MASK >> type) & 1u) ? 2 : 1;
#else
        const int nrep = 1;
#endif
#pragma unroll 1
        for (int rep = 0; rep < nrep; ++rep) {
        if (rep > 0 && use_bar) xcd_barrier(bar);
        if (PHT(0) && type == 0) { PHASE_BEGIN; phase_conv_mixers(F, p); phase_conv_moe(F, p, 0); phase_load_x(F, p); }
        else if (PHT(1) && type == 1) { PHASE_BEGIN; DenseSched8 S; S.init(ws + WS_X, ws + WS_ATT_IN_T + (size_t)j * ATT_IN * D, T, ATT_IN, D / 2, F.G, bx); EpiStoreBf16 E{(bf16*)(ws + WS_BIG), ATT_IN, WUP_INV, 0.08838834764831845f};
            pg8::gemm_phase(F.lds, F.tid, D / 2, S, E); }
        else if (PHT(2) && type == 2) { PHASE_BEGIN; phase_attn(F, bx); }
        else if (PHT(3) && type == 3) { PHASE_BEGIN; phase_attn_combine(F); }
        else if (PHT(4) && type == 4) { PHASE_BEGIN; DenseSched8 S; S.init(ws + WS_AUX + AUX_OB, ws + WS_ATT_OUT_T + (size_t)j * D * D, T, D, D / 2, F.G, bx); EpiResid E{(const bf16*)(ws + WS_XB), (bf16*)(ws + WS_Y), 1.0f / (A_SCALE * WUP_SCALE)};
            pg8::gemm_phase(F.lds, F.tid, D / 2, S, E); }
        else if (PHT(5) && type == 5) { PHASE_BEGIN; DenseSched8 S; S.init(ws + WS_X, ws + WS_RET_IN_T, T, RET_IN, D / 2, F.G, bx); EpiRetIn E{(bf16*)(ws + WS_BIG), RET_IN};
            pg8::gemm_phase(F.lds, F.tid, D / 2, S, E); }
        else if (PHT(6) && type == 6) { PHASE_BEGIN; phase_ret_u(F); }
        else if (PHT(7) && type == 7) { PHASE_BEGIN; phase_ret_scan(F); }
        else if (PHT(8) && type == 8) { PHASE_BEGIN; phase_ret_out(F, p); }
        else if (PHT(9) && type == 9) { PHASE_BEGIN; DenseSched8 S; S.init(ws + WS_BIG + BIG_YRET, ws + WS_RET_OUT_T, T, D, RET_V / 2, F.G, bx); EpiResid E{(const bf16*)(ws + WS_XB), (bf16*)(ws + WS_Y), 1.0f / (A_SCALE * WUP_SCALE)};
            pg8::gemm_phase(F.lds, F.tid, RET_V / 2, S, E); }
        else if (PHT(10) && type == 10) { PHASE_BEGIN; phase_s5_scan<false>(F, p); }
        else if (PHT(11) && type == 11) { PHASE_BEGIN; phase_s5_carry(F, p); }
        else if (PHT(12) && type == 12) { PHASE_BEGIN; phase_s5_scan<true>(F, p); }
        else if (PHT(13) && type == 13) { PHASE_BEGIN; DenseSched8 S; S.init(ws + WS_AUX, ws + WS_GLU_T, T, 2 * D, D / 2, F.G, bx); EpiGluResid E{(const bf16*)(ws + WS_XB), (bf16*)(ws + WS_Y), 1.0f / (A_SCALE * WUP_SCALE)};
            pg8::gemm_phase(F.lds, F.tid, D / 2, S, E); }
        else if (PHT(14) && type == 14) { PHASE_BEGIN; phase_lnr(F, p, layer, PROBE_DRY14 && true); if (PROBE_DRY14) { if (use_bar) xcd_barrier(bar); phase_lnr(F, p, layer, false); } }
        else if (PHT(15) && type == 15) { PHASE_BEGIN; moe_plan(F, layer);
            MoeSched2<true> S; S.tstart = (const volatile LAS int*)(F.MISC + PLAN_OFF); S.cnts = S.tstart + 72; S.ntiles = __builtin_amdgcn_readfirstlane((int)S.tstart[65]); S.G = F.G; S.c = bx; S.lane = F.lane;
            S.Abase = (const char*)(ws + WS_X); S.Wbase = (const char*)(ws + WS_WMOE); S.lists = (const int*)(ws + WS_LIST);
            EpiMoeUp E{(unsigned char*)(ws + WS_H)};
            pg8::gemm_phase(F.lds, F.tid, D / 2, S, E); }
        else if (PHT(16) && type == 16) { PHASE_BEGIN; moe_plan(F, layer);
            { MoeSched2<false> S; S.tstart = (const volatile LAS int*)(F.MISC + PLAN_OFF); S.cnts = S.tstart + 72; S.ntiles = __builtin_amdgcn_readfirstlane((int)S.tstart[64]); S.G = F.G; S.c = bx; S.lane = F.lane;
              S.Abase = (const char*)(ws + WS_H); S.Wbase = (const char*)(ws + WS_WMOE); S.lists = (const int*)(ws + WS_LIST);
              EpiStoreFp8 E{(unsigned char*)(ws + WS_BIG), D};
              pg8::gemm_phase(F.lds, F.tid, ED / 2, S, E); }
            { const int sh0 = __builtin_amdgcn_readfirstlane((int)((const volatile LAS int*)(F.MISC + PLAN_OFF))[64]);
              DenseSched8 S; S.init(ws + WS_H + (size_t)sh0 * 256 * ED, ws + WS_WMOE + (size_t)64 * WMOE_E_BYTES + (size_t)512 * 1024 * 2, T, D, ED / 2, F.G, bx); EpiResid8 E{(const bf16*)(ws + WS_XB), (bf16*)(ws + WS_Y), 1.0f / (H_SCALE * WUP_SCALE)};
              int tid2; { unsigned o2 = ~0u; asm volatile("" : "+s"(o2)); tid2 = F.wave * 64 + (int)__builtin_amdgcn_mbcnt_hi(o2, __builtin_amdgcn_mbcnt_lo(o2, 0u)); }
              pg8::gemm_phase(F.lds, tid2, ED / 2, S, E); } }
        else if (PHT(17) && type == 17) { PHASE_BEGIN; moe_plan(F, layer); if (PROBE_DRY17) { phase_combine(F, p, layer, true); if (use_bar) xcd_barrier(bar); } phase_combine(F, p, layer); if (layer + 1 < DEPTH) phase_conv_moe(F, p, layer + 1); }
        }
        if (use_bar && ph + 1 < hi) xcd_barrier(bar);
    }
}

#ifndef MK_PER_PHASE
#define MK_PER_PHASE 0
#endif
extern "C" void kernel_launch(void* const* d_in, const int* in_sizes, int n_in, void* d_out, int out_size, void* d_ws, size_t ws_size, hipStream_t stream) {
    static int grid = 0;
    if (grid == 0) {
        if (n_in != 26 || in_sizes[0] != T * D || out_size != T * D || ws_size < WS_END) { fprintf(stderr, "kernel_launch: unexpected shapes / workspace (n_in %d, in0 %d, out %d, ws %zu < %zu)\n", n_in, n_in > 0 ? in_sizes[0] : -1, out_size, ws_size, (size_t)WS_END); grid = -1; return; }
        int dev = 0, cus = 0, per_cu = 0;
        if (hipGetDevice(&dev) != hipSuccess || hipDeviceGetAttribute(&cus, hipDeviceAttributeMultiprocessorCount, dev) != hipSuccess) { grid = -1; return; }
        if (hipFuncSetAttribute((const void*)fwd_kernel, hipFuncAttributeMaxDynamicSharedMemorySize, LDS_BYTES) != hipSuccess) { fprintf(stderr, "kernel_launch: hipFuncSetAttribute failed\n"); grid = -1; return; }
        if (hipOccupancyMaxActiveBlocksPerMultiprocessor(&per_cu, (const void*)fwd_kernel, NTHREADS, LDS_BYTES) != hipSuccess || per_cu < 1) { fprintf(stderr, "kernel_launch: occupancy query says %d blocks per CU\n", per_cu); per_cu = 1; }
        (void)hipGetLastError();
        grid = cus;
    }
    if (grid < 0) return;
    (void)hipMemsetAsync((char*)d_ws + WS_CTL, 0, CTL_ZERO_BYTES, stream);
    Params p{};
    for (int i = 0; i < 26; ++i) p.in[i] = (const float*)d_in[i];
    p.out = (float*)d_out; p.ws = (unsigned char*)d_ws;
#if MK_PER_PHASE
    for (int k = 0; k < NPHASES; ++k) { p.ph_lo = k; p.ph_hi = k + 1; p.use_bar = 0; hipLaunchKernelGGL(fwd_kernel, dim3(grid), dim3(NTHREADS), LDS_BYTES, stream, p); }
#else
    p.ph_lo = 0; p.ph_hi = NPHASES; p.use_bar = 1;
    hipLaunchKernelGGL(fwd_kernel, dim3(grid), dim3(NTHREADS), LDS_BYTES, stream, p);
#endif
}
```

```cpp
#include <hip/hip_runtime.h>
#include <cstdio>
#include <cstdint>

#define LAS __attribute__((address_space(3)))
#define GAS __attribute__((address_space(1)))
typedef unsigned short bf16;
typedef short bf16x8 __attribute__((ext_vector_type(8)));
typedef short bf16x4 __attribute__((ext_vector_type(4)));
typedef float f32x4 __attribute__((ext_vector_type(4)));
typedef float f32x2 __attribute__((ext_vector_type(2)));
typedef unsigned u32x4 __attribute__((ext_vector_type(4)));
typedef unsigned u32x2 __attribute__((ext_vector_type(2)));
typedef GAS unsigned gu32;

constexpr int D = 1024, BATCH = 2, SEQ = 8192, T = BATCH * SEQ, DEPTH = 4;
constexpr int AH = 8, AHD = 128, ATT_IN = 9216;
constexpr int RH = 4, RDK = 256, RDV = 512, RET_IN = 6144, RET_V = 2048, RC = 128, RNC = SEQ / RC;
constexpr int SG = 64, SGC = 16, SP = 64;
constexpr int NE = 64, TOPK = 8, NEG = 8, ED = 256, NSLOT = 9;
constexpr float LN_EPS = 1e-5f;
constexpr float ALPHA = 1.6817928305074292f;
constexpr int NWAVES = 8, NTHREADS = 512;

__device__ __forceinline__ unsigned f2bf(float f) { unsigned u = __builtin_bit_cast(unsigned, f); return (u + 0x7fffu + ((u >> 16) & 1u)) >> 16; }
__device__ __forceinline__ unsigned pk2(float lo, float hi) { unsigned r; asm("s_nop 1\n\tv_cvt_pk_bf16_f32 %0, %1, %2" : "=v"(r) : "v"(lo), "v"(hi)); return r; }
__device__ __forceinline__ unsigned pk2sw(float lo, float hi) { return f2bf(lo) | (f2bf(hi) << 16); }
__device__ __forceinline__ unsigned pk2hw(float lo, float hi) { unsigned r; asm volatile("v_cvt_pk_bf16_f32 %0, %1, %2" : "=v"(r) : "v"(lo), "v"(hi)); return r; }
__device__ __forceinline__ float bf2f(unsigned b) { return __builtin_bit_cast(float, b << 16); }
__device__ __forceinline__ float bflo(unsigned w) { return __builtin_bit_cast(float, w << 16); }
__device__ __forceinline__ float bfhi(unsigned w) { return __builtin_bit_cast(float, w & 0xffff0000u); }
__device__ __forceinline__ float shx(float v, int m, int lane) { return __builtin_bit_cast(float, __builtin_amdgcn_ds_bpermute((lane ^ m) << 2, __builtin_bit_cast(int, v))); }
__device__ __forceinline__ int shx_i(int v, int m, int lane) { return __builtin_amdgcn_ds_bpermute((lane ^ m) << 2, v); }
__device__ __forceinline__ float rdl(float v, int src) { return __builtin_bit_cast(float, __builtin_amdgcn_readlane(__builtin_bit_cast(int, v), src)); }
template <int CTRL, int RM = 0xf, int BM = 0xf> __device__ __forceinline__ float dpp0(float v) { return __builtin_bit_cast(float, __builtin_amdgcn_update_dpp(0, __builtin_bit_cast(int, v), CTRL, RM, BM, true)); }
template <int CTRL, int RM = 0xf, int BM = 0xf> __device__ __forceinline__ float dppo(float old, float v) { return __builtin_bit_cast(float, __builtin_amdgcn_update_dpp(__builtin_bit_cast(int, old), __builtin_bit_cast(int, v), CTRL, RM, BM, false)); }
__device__ __forceinline__ float wave_sum(float v, int lane) {
    (void)lane;
    v += dpp0<0x111>(v); v += dpp0<0x112>(v); v += dpp0<0x114>(v); v += dpp0<0x118>(v);
    v += dpp0<0x142, 0xa>(v);
    v += dpp0<0x143, 0xc>(v);
    return rdl(v, 63);
}
__device__ __forceinline__ float max8(float v) {
    v = fmaxf(v, dppo<0xb1>(v, v)); v = fmaxf(v, dppo<0x4e>(v, v)); v = fmaxf(v, dppo<0x141>(v, v)); return v;
}
__device__ __forceinline__ float fsig(float x) { return __builtin_amdgcn_rcpf(1.0f + __expf(-x)); }
#define LDS_WAIT() asm volatile("s_waitcnt lgkmcnt(0)" ::: "memory")
#define VM_WAIT() asm volatile("s_waitcnt vmcnt(0)" ::: "memory")
__device__ __forceinline__ const char* rfl_ptr(const char* p) {
    unsigned long long v = (unsigned long long)p; unsigned lo = __builtin_amdgcn_readfirstlane((unsigned)v), hi = __builtin_amdgcn_readfirstlane((unsigned)(v >> 32));
    return (const char*)(((unsigned long long)hi << 32) | lo);
}
__device__ __forceinline__ bf16x8 row_frag(const LAS bf16* base, int ld, int row0, int col0, int lane) {
    return *(const LAS bf16x8*)(base + (row0 + (lane & 15)) * ld + col0 + 8 * (lane >> 4));
}
__device__ __forceinline__ bf16x4 tr4(const LAS bf16* addr) { return __builtin_amdgcn_ds_read_tr16_b64_v4i16((LAS bf16x4*)addr); }
__device__ __forceinline__ bf16x8 cat8(bf16x4 a, bf16x4 b) { bf16x8 r; r[0] = a[0]; r[1] = a[1]; r[2] = a[2]; r[3] = a[3]; r[4] = b[0]; r[5] = b[1]; r[6] = b[2]; r[7] = b[3]; return r; }
#define MFMA16(a, b, c) __builtin_amdgcn_mfma_f32_16x16x32_bf16((a), (b), (c), 0, 0, 0)
__device__ __forceinline__ bf16x8 pack8(f32x4 a, f32x4 b) {
    u32x4 w; w.x = pk2(a[0], a[1]); w.y = pk2(a[2], a[3]); w.z = pk2(b[0], b[1]); w.w = pk2(b[2], b[3]); return __builtin_bit_cast(bf16x8, w);
}

namespace pg8 {
typedef int v4i_t __attribute__((ext_vector_type(4)));
typedef int v8i_t __attribute__((ext_vector_type(8)));
constexpr int BM = 256, BK = 64, HALF = 128, HTB = HALF * BK * 2, STAGE_BYTES = 8 * HTB;
__device__ __forceinline__ int lds_byte(int r, int c) { const int st = (r >> 4) * 2 + (c >> 5), rr = r & 15, cc = c & 31, ob = rr * 64 + cc * 2; return st * 1024 + (ob ^ (((ob >> 9) & 1) << 5)); }
__device__ __forceinline__ void stage_rc(int b, int& R, int& C) { const int st = b / 1024, sb = b % 1024, swz = sb ^ (((sb >> 9) & 1) << 5); R = (st >> 1) * 16 + swz / 64; C = (st & 1) * 32 + (swz % 64) / 2; }
__device__ __forceinline__ int perm32(int rho) { const int n = rho >> 4, i = rho & 15; return 8 * (i >> 2) + 4 * n + (i & 3); }

struct UnitG {
    const char* A;
    const char* B;
    const int* gidx;
    int gcnt, gshift;
    int row0, col0;
    int aux;
};

__device__ __forceinline__ void uniformize(UnitG& u) { u.A = rfl_ptr(u.A); u.B = rfl_ptr(u.B); u.gidx = (const int*)rfl_ptr((const char*)u.gidx); u.gcnt = __builtin_amdgcn_readfirstlane(u.gcnt); u.gshift = __builtin_amdgcn_readfirstlane(u.gshift);
    u.row0 = __builtin_amdgcn_readfirstlane(u.row0); u.col0 = __builtin_amdgcn_readfirstlane(u.col0); u.aux = __builtin_amdgcn_readfirstlane(u.aux); }
template <class Epi, class Sched>
__device__ __forceinline__ void gemm_phase(LAS unsigned char* lds, const int tid, const int K, const Sched& S, const Epi& E) {
    constexpr bool F8 = Sched::FP8;
    constexpr bool GATHER = Sched::GATHER;
    const int wid = __builtin_amdgcn_readfirstlane(tid >> 6), lane = tid & 63, wr = wid >> 2, wc = wid & 3, fr = lane & 15, fq = lane >> 4;
    int nt = K / BK; asm volatile("" : "+s"(nt));
    constexpr bool P16 = Epi::PERM16;
    unsigned voffB[2], voffB1[2], vA[2][2];
#pragma unroll
    for (int i = 0; i < 2; ++i) { int R, C; stage_rc(tid * 16 + i * 8192, R, C); const int Rb = Epi::PERM ? ((R & ~31) + perm32(R & 31)) : R; voffB[i] = (unsigned)(Rb * K + C) * 2u; voffB1[i] = voffB[i]; vA[0][i] = (unsigned)(R * K + C) * 2u; vA[1][i] = vA[0][i];
        if constexpr (P16) { const int x = R & 31, src = 64 * (R >> 5) + 16 * ((x >> 2) & 3) + 4 * (x >> 4) + (x & 3); voffB[i] = (unsigned)(src * K + C) * 2u; voffB1[i] = (unsigned)((src + 8) * K + C) * 2u; } }
    const size_t kstep = (size_t)(BK * 2);
    const size_t hstep = (size_t)HALF * K * 2;
    const size_t hstepB = P16 ? 0 : hstep;
    const size_t hstepA = GATHER ? 0 : hstep;
    const unsigned ldsw = (unsigned)wid * 1024u;
    const int aoff = F8 ? lds_byte(wr * 64 + fr, fq * 16) : lds_byte(wr * 64 + fr, fq * 8), boff = F8 ? lds_byte(wc * 32 + fr, fq * 16) : lds_byte(wc * 32 + fr, fq * 8);
    LAS u32x4* park = (LAS u32x4*)(lds + STAGE_BYTES) + tid;
#define PG8_SA(b, h) (((b) * 2 + (h)) * HTB)
#define PG8_SB(b, h) ((4 + (b) * 2 + (h)) * HTB)
#define PG8_STAGE(bufoff, gbase, voff) do { _Pragma("unroll") for (int _i = 0; _i < 2; ++_i) { asm volatile("" : "+v"((voff)[_i]));   \
        __builtin_amdgcn_global_load_lds((const unsigned*)((const char*)(gbase) + (voff)[_i]), (LAS unsigned*)(lds + (bufoff) + ldsw + _i * 8192), 16, 0, 0); } } while (0)
    constexpr int FKS = F8 ? 16 : 1024;
#define PG8_LD2(p_) __builtin_shufflevector(*(const LAS v4i_t*)(p_), *(const LAS v4i_t*)((p_) + FKS), 0, 1, 2, 3, 4, 5, 6, 7)
#define PG8_LDA(dst, b, h) do { _Pragma("unroll") for (int m = 0; m < 4; ++m) dst[m] = PG8_LD2(lds + PG8_SA(b, h) + aoff + m * 2048); } while (0)
#define PG8_LDB(dst, b, h) do { _Pragma("unroll") for (int n = 0; n < 2; ++n) dst[n] = PG8_LD2(lds + PG8_SB(b, h) + boff + n * 2048); } while (0)
#define PG8_LO(v) __builtin_bit_cast(bf16x8, __builtin_shufflevector((v), (v), 0, 1, 2, 3))
#define PG8_HI(v) __builtin_bit_cast(bf16x8, __builtin_shufflevector((v), (v), 4, 5, 6, 7))
#define PG8_MMA(ai, bj, At, Bt) do { __builtin_amdgcn_s_setprio(1); _Pragma("unroll") for (int m = 0; m < 4; ++m) _Pragma("unroll") for (int n = 0; n < 2; ++n) { \
        if constexpr (F8) { acc[ai][bj][m][n] = __builtin_amdgcn_mfma_scale_f32_16x16x128_f8f6f4(Bt[n], At[m], acc[ai][bj][m][n], 0, 0, 0, 0x7F7F7F7F, 0, 0x7F7F7F7F); } \
        else { acc[ai][bj][m][n] = __builtin_amdgcn_mfma_f32_16x16x32_bf16(PG8_LO(Bt[n]), PG8_LO(At[m]), acc[ai][bj][m][n], 0, 0, 0); \
               acc[ai][bj][m][n] = __builtin_amdgcn_mfma_f32_16x16x32_bf16(PG8_HI(Bt[n]), PG8_HI(At[m]), acc[ai][bj][m][n], 0, 0, 0); } } __builtin_amdgcn_s_setprio(0); } while (0)
#define PG8_WAIT_V(n) asm volatile("s_waitcnt vmcnt(" #n ")" ::: "memory")
#define PG8_WAIT_L(n) asm volatile("s_waitcnt lgkmcnt(" #n ")" ::: "memory")
#define PG8_BAR __builtin_amdgcn_s_barrier()
#define PG8_SCHED __builtin_amdgcn_sched_barrier(0)
#define PG8_VOFF(u, v00, v01, v10, v11) do { int _R0, _C0, _R1, _C1; stage_rc(tid * 16, _R0, _C0); stage_rc(tid * 16 + 8192, _R1, _C1); int _r00 = _R0, _r01 = _R1, _r10 = HALF + _R0, _r11 = HALF + _R1; \
        if ((u).gidx) { const GAS int* _gp = (const GAS int*)(u).gidx; const int _gc = (u).gcnt;     \
            const int _a = _gp[_r00 < _gc ? _r00 : 0] >> (u).gshift, _b = _gp[_r01 < _gc ? _r01 : 0] >> (u).gshift, _c = _gp[_r10 < _gc ? _r10 : 0] >> (u).gshift, _d = _gp[_r11 < _gc ? _r11 : 0] >> (u).gshift; \
            _r00 = _a; _r01 = _b; _r10 = _c; _r11 = _d; } \
        v00 = (unsigned)(_r00 * K + _C0) * 2u; v01 = (unsigned)(_r01 * K + _C1) * 2u; v10 = (unsigned)(_r10 * K + _C0) * 2u; v11 = (unsigned)(_r11 * K + _C1) * 2u; } while (0)
    UnitG cur, nxt; int ui = 0;
    if (!S.next(0, cur)) return;
    if constexpr (Sched::UNIFORMIZE) uniformize(cur);
    f32x4 acc[2][2][4][2];
#pragma unroll
    for (int a = 0; a < 2; ++a)
#pragma unroll
        for (int b = 0; b < 2; ++b)
#pragma unroll
            for (int m = 0; m < 4; ++m)
#pragma unroll
                for (int n = 0; n < 2; ++n) acc[a][b][m][n] = (f32x4){0.f, 0.f, 0.f, 0.f};
    v8i_t At[4], B0[2], B1[2];
    if constexpr (GATHER) PG8_VOFF(cur, vA[0][0], vA[0][1], vA[1][0], vA[1][1]);
    const char* cA = cur.A; const char* cB = cur.B;
    PG8_STAGE(PG8_SB(0, 0), cB, voffB); PG8_STAGE(PG8_SB(0, 1), cB + hstepB, voffB1); PG8_STAGE(PG8_SA(0, 0), cA, vA[0]); PG8_STAGE(PG8_SA(0, 1), cA + hstepA, vA[1]);
    if (wr == 1) PG8_BAR;
    PG8_WAIT_V(2); PG8_BAR;
    PG8_STAGE(PG8_SB(1, 0), cB + kstep, voffB); PG8_STAGE(PG8_SA(1, 0), cA + kstep, vA[0]); PG8_STAGE(PG8_SB(1, 1), cB + hstepB + kstep, voffB1);
    PG8_WAIT_V(6); PG8_BAR;
    for (;;) {
        const bool has_next = S.next(ui + 1, nxt);
        if constexpr (Sched::UNIFORMIZE) { if (has_next) uniformize(nxt); }
        const char* nA = cA; const char* nB = cB;
        if (has_next) { nA = nxt.A; nB = nxt.B; }
        if constexpr (GATHER) { u32x4 pv; pv.x = vA[0][0]; pv.y = vA[0][1]; pv.z = vA[1][0]; pv.w = vA[1][1];
            if (has_next) PG8_VOFF(nxt, pv.x, pv.y, pv.z, pv.w);
            *park = pv; }
#pragma unroll 1
        for (int t = 0; t < nt; t += 2) {
            const bool last = (t == nt - 2);
            const char* a1 = cA + (size_t)(t + 1) * kstep;
            const char* a2 = last ? nA : cA + (size_t)(t + 2) * kstep; const char* b2 = last ? nB : cB + (size_t)(t + 2) * kstep;
            const char* a3 = a2 + kstep; const char* b3 = b2 + kstep;
            PG8_LDB(B0, 0, 0); PG8_LDB(B1, 0, 1); PG8_SCHED; PG8_LDA(At, 0, 0); PG8_STAGE(PG8_SA(1, 1), a1 + hstepA, vA[1]);
            PG8_WAIT_V(8); PG8_WAIT_L(0); PG8_BAR; PG8_MMA(0, 0, At, B0); PG8_MMA(0, 1, At, B1); PG8_BAR; PG8_SCHED;
            if constexpr (GATHER) { if (last) { const u32x4 pv = *park; vA[0][0] = pv.x; vA[0][1] = pv.y; vA[1][0] = pv.z; vA[1][1] = pv.w; } }
            PG8_LDA(At, 0, 1); PG8_STAGE(PG8_SB(0, 0), b2, voffB); PG8_STAGE(PG8_SB(0, 1), b2 + hstepB, voffB1); PG8_STAGE(PG8_SA(0, 0), a2, vA[0]);
            PG8_WAIT_V(8); PG8_WAIT_L(0); PG8_BAR; PG8_MMA(1, 0, At, B0); PG8_MMA(1, 1, At, B1); PG8_BAR; PG8_SCHED;
            PG8_LDB(B0, 1, 0); PG8_LDB(B1, 1, 1); PG8_SCHED; PG8_LDA(At, 1, 0); PG8_STAGE(PG8_SA(0, 1), a2 + hstepA, vA[1]);
            PG8_WAIT_V(8); PG8_WAIT_L(0); PG8_BAR; PG8_MMA(0, 0, At, B0); PG8_MMA(0, 1, At, B1); PG8_BAR; PG8_SCHED;
            PG8_LDA(At, 1, 1); PG8_STAGE(PG8_SB(1, 0), b3, voffB); PG8_STAGE(PG8_SB(1, 1), b3 + hstepB, voffB1); PG8_STAGE(PG8_SA(1, 0), a3, vA[0]);
            PG8_WAIT_V(8); PG8_WAIT_L(0); PG8_BAR; PG8_MMA(1, 0, At, B0); PG8_MMA(1, 1, At, B1); PG8_BAR; PG8_SCHED;
        }
        if (wr == 0) PG8_BAR;
        { int l2; { unsigned o2 = ~0u; asm volatile("" : "+s"(o2)); l2 = (int)__builtin_amdgcn_mbcnt_hi(o2, __builtin_amdgcn_mbcnt_lo(o2, 0u)); }
          E(acc, cur, wr, wc, l2 & 15, l2 >> 4); }
        if (!has_next) break;
#pragma unroll
        for (int a = 0; a < 2; ++a)
#pragma unroll
            for (int b = 0; b < 2; ++b)
#pragma unroll
                for (int m = 0; m < 4; ++m)
#pragma unroll
                    for (int n = 0; n < 2; ++n) acc[a][b][m][n] = (f32x4){0.f, 0.f, 0.f, 0.f};
        cur = nxt; cA = nA; cB = nB; ++ui;
        if (wr == 1) PG8_BAR;
    }
    PG8_WAIT_V(0);
    PG8_BAR;
#undef PG8_SA
#undef PG8_SB
#undef PG8_STAGE
#undef PG8_LDA
#undef PG8_LDB
#undef PG8_LD2
#undef PG8_LO
#undef PG8_HI
#undef PG8_MMA
#undef PG8_WAIT_V
#undef PG8_WAIT_L
#undef PG8_BAR
#undef PG8_SCHED
#undef PG8_VOFF
}
}

constexpr size_t MiB = 1u << 20;
constexpr size_t WS_CTL = 0, CTL_ZERO_BYTES = 1 * MiB;
constexpr size_t WS_ATT_IN_T = 1 * MiB;
constexpr size_t WS_ATT_OUT_T = WS_ATT_IN_T + 36 * MiB;
constexpr size_t WS_RET_IN_T = WS_ATT_OUT_T + 4 * MiB;
constexpr size_t WS_RET_OUT_T = WS_RET_IN_T + 12 * MiB;
constexpr size_t WS_GLU_T = WS_RET_OUT_T + 4 * MiB;
constexpr size_t WS_RT_HI = WS_GLU_T + 4 * MiB;
constexpr size_t WS_RT_LO = WS_RT_HI + 512 * 1024;
constexpr size_t WS_WMOE = WS_RT_HI + 1 * MiB;
constexpr size_t WMOE_E_BYTES = (size_t)(512 * 1024 + 1024 * 256) * 2;
constexpr size_t WS_X = WS_WMOE + 98 * MiB;
constexpr size_t WS_Y = WS_X + 64 * MiB;
constexpr size_t WS_XB = WS_Y + 64 * MiB;
constexpr size_t WS_BIG = WS_XB + 32 * MiB;
constexpr size_t WS_AUX = WS_BIG + 288 * MiB;
constexpr size_t WS_H = WS_AUX + 160 * MiB;
constexpr size_t WS_LIST = WS_H + 80 * MiB;
constexpr size_t WS_TRASH = WS_LIST + 8 * MiB;
constexpr size_t WS_END = WS_TRASH + 1 * MiB;
static_assert(WS_END <= 1024 * MiB, "workspace map");
constexpr int CW_BAR = 4096;
constexpr int CW_CNT = 16384;
constexpr int CW_CHK = 65536;
constexpr int HROWS = 163840;

#define XB_TMO      128
#define XB_XCNT(j)  (256  + 64 * (j))
#define XB_XSUB(j)  (1280 + 64 * (j))
#define XB_XGEN(j)  (2304 + 64 * (j))
#define XB_TOP      3328
#define XB_TOPGEN   3392
#define XCD_BAR_WORDS 3456
#define XB_SPIN_CAP (1u << 20)
__device__ __forceinline__ unsigned xb_ld(unsigned* p)              { return __hip_atomic_load(p, __ATOMIC_RELAXED, __HIP_MEMORY_SCOPE_AGENT); }
__device__ __forceinline__ unsigned xb_add(unsigned* p, unsigned v) { return __hip_atomic_fetch_add(p, v, __ATOMIC_RELAXED, __HIP_MEMORY_SCOPE_AGENT); }
__device__ __forceinline__ unsigned xb_xcc_id() { return (unsigned)__builtin_amdgcn_s_getreg((3 << 11) | 20) & 0xFu; }
#define XB_SPIN(cond, bar) do { unsigned _sp = 0; while (cond) { __builtin_amdgcn_s_sleep(1); \
    if ((++_sp & 255u) == 0u) { if (xb_ld(&(bar)[XB_TMO])) break; if (_sp > XB_SPIN_CAP) { atomicAdd(&(bar)[XB_TMO], 1u); break; } } } } while (0)
struct XcdBarrier { unsigned* bar; unsigned x; volatile LAS unsigned* st; };
__device__ __forceinline__ XcdBarrier xcd_barrier_post(unsigned* bar, volatile LAS unsigned* st) {
    XcdBarrier b; b.bar = bar; b.x = xb_xcc_id(); b.st = st;
    if (threadIdx.x == 0) (void)xb_add(&bar[XB_XCNT(b.x)], 1u);
    return b;
}
__device__ __forceinline__ void xcd_barrier_complete(unsigned* bar, unsigned x, unsigned& nloc, unsigned& nx) {
    const unsigned G = gridDim.x * gridDim.y * gridDim.z;
    unsigned sum, cnt, mine, sp = 0u;
    for (;;) {
        sum = 0u; cnt = 0u; mine = 0u;
#pragma unroll
        for (unsigned j = 0; j < 16; ++j) { const unsigned c = xb_ld(&bar[XB_XCNT(j)]); sum += c; cnt += (c > 0u) ? 1u : 0u; mine = (j == x) ? c : mine; }
        if (sum == G) break;
        __builtin_amdgcn_s_sleep(1);
        if ((++sp & 255u) == 0u) { if (xb_ld(&bar[XB_TMO])) break; if (sp > XB_SPIN_CAP) { atomicAdd(&bar[XB_TMO], 1u); break; } }
    }
    nloc = mine > 0u ? mine : 1u; nx = cnt > 0u ? cnt : 1u;
}
__device__ __forceinline__ void xcd_barrier(const XcdBarrier& b) {
    asm volatile("s_waitcnt vmcnt(0)" ::: "memory");
    __syncthreads();
    if (threadIdx.x == 0) {
        unsigned* bar = b.bar;
        __builtin_amdgcn_s_waitcnt(0);
        unsigned nloc = b.st[0], nx = b.st[1];
        if (nloc == 0u) { xcd_barrier_complete(bar, b.x, nloc, nx); b.st[0] = nloc; b.st[1] = nx; }
        const unsigned old = xb_add(&bar[XB_XSUB(b.x)], 1u);
        const unsigned gen = old / nloc;
        if (old + 1u == (gen + 1u) * nloc) {
            __builtin_amdgcn_fence(__ATOMIC_RELEASE, "agent");
            asm volatile("s_waitcnt vmcnt(0)" ::: "memory");
            const unsigned og = xb_add(&bar[XB_TOP], 1u);
            const unsigned tg = og / nx;
            if (og + 1u == (tg + 1u) * nx) xb_add(&bar[XB_TOPGEN], 1u);
            else XB_SPIN(xb_ld(&bar[XB_TOPGEN]) == tg, bar);
            __builtin_amdgcn_fence(__ATOMIC_ACQUIRE, "agent");
            xb_add(&bar[XB_XGEN(b.x)], 1u);
            asm volatile("s_waitcnt vmcnt(0)" ::: "memory");
        } else {
            XB_SPIN(xb_ld(&bar[XB_XGEN(b.x)]) == gen, bar);
            __builtin_amdgcn_fence(__ATOMIC_ACQUIRE, "agent");
            asm volatile("s_waitcnt vmcnt(0)" ::: "memory");
        }
    }
    __syncthreads();
}

constexpr int RING_BYTES = 139264;
constexpr int MISC_OFF = RING_BYTES;
constexpr int LDS_BYTES = 147456;
struct Params {
    const float* in[26]; float* out; unsigned char* ws; int ph_lo, ph_hi; int use_bar, pad;
};
typedef const __attribute__((address_space(4))) Params* KP;
__device__ __forceinline__ const float* gin(KP p, int i) { return (const float*)(const GAS float*)p->in[i]; }
__device__ __forceinline__ float* gout(KP p) { return (float*)(GAS float*)p->out; }
struct Frame {
    LAS unsigned char* lds; volatile LAS unsigned* MISC;
    int tid, lane, wave, vcu, G;
    unsigned char* ws;
};

template <bool F8_ = false> struct DenseSchedT {
    static constexpr bool GATHER = false, UNIFORMIZE = false, FP8 = F8_;
    const char* A; const char* Bt; int K, nM, nN, nwg, G, c;
    __device__ __forceinline__ void init(const void* A_, const void* Bt_, int M, int N, int K_, int G_, int c_) { A = (const char*)A_; Bt = (const char*)Bt_; K = K_; nM = M / 256; nN = N / 256; nwg = nM * nN; G = G_; c = c_; }
    __device__ __forceinline__ bool next(int i, pg8::UnitG& u) const {
        const long L = (long)i * G + c; if (L >= nwg) return false;
        int wgid = (int)L; { const int q = nwg / 8, r = nwg % 8, xcd = wgid % 8, off = wgid / 8; wgid = (xcd < r ? xcd * (q + 1) : r * (q + 1) + (xcd - r) * q) + off; }
        const int nig = 8 * nN, gid = wgid / nig, fm = gid * 8, gsz = (nM - fm) < 8 ? (nM - fm) : 8;
        const int pm = fm + ((wgid % nig) % gsz), pn = (wgid % nig) / gsz;
        u.A = A + (size_t)pm * 256 * K * 2; u.B = Bt + (size_t)pn * 256 * K * 2; u.gidx = nullptr; u.gcnt = 0; u.gshift = 0; u.row0 = pm * 256; u.col0 = pn * 256; u.aux = 0; return true;
    }
};
typedef DenseSchedT<false> DenseSched; typedef DenseSchedT<true> DenseSched8;
__device__ __forceinline__ u32x4 pack_bf16x8(const f32x4& v0, const f32x4& v1) { u32x4 w; w.x = pk2hw(v0[0], v0[1]); w.y = pk2hw(v0[2], v0[3]); w.z = pk2hw(v1[0], v1[1]); w.w = pk2hw(v1[2], v1[3]); return w; }

__device__ __forceinline__ unsigned pk4_fp8(float a, float b, float c, float d) {
    a = fminf(fmaxf(a, -448.0f), 448.0f); b = fminf(fmaxf(b, -448.0f), 448.0f); c = fminf(fmaxf(c, -448.0f), 448.0f); d = fminf(fmaxf(d, -448.0f), 448.0f);
    int w = 0; w = __builtin_amdgcn_cvt_pk_fp8_f32(a, b, w, false); w = __builtin_amdgcn_cvt_pk_fp8_f32(c, d, w, true); return (unsigned)w; }
constexpr float WUP_SCALE = 32.0f, WUP_INV = 1.0f / 32.0f;
struct EpiStoreBf16 {
    static constexpr bool PERM = true, PERM16 = false;
    bf16* O; int ldc; float osc, qsc;
    __device__ __forceinline__ void operator()(const f32x4 (&acc)[2][2][4][2], const pg8::UnitG& u, int wr, int wc, int fr, int fq) const {
        const float sc = ((u.col0 % 3072) < 1024) ? osc * qsc : osc;
#pragma unroll
        for (int ai = 0; ai < 2; ++ai)
#pragma unroll
            for (int m = 0; m < 4; ++m) { bf16* rowp = O + (size_t)(u.row0 + ai * 128 + wr * 64 + m * 16 + fr) * ldc + u.col0 + wc * 32 + 8 * fq;
#pragma unroll
                for (int bj = 0; bj < 2; ++bj) *(u32x4*)(rowp + bj * 128) = pack_bf16x8(acc[ai][bj][m][0] * sc, acc[ai][bj][m][1] * sc); }
    }
};
constexpr float YEXP_SCALE = 32.0f, YEXP_INV = 1.0f / 32.0f;
constexpr float A_SCALE = 16.0f;
constexpr float H_SCALE = 16.0f;
struct EpiStoreFp8 {
    static constexpr bool PERM = false, PERM16 = true;
    unsigned char* O; int ldc;
    __device__ __forceinline__ void operator()(const f32x4 (&acc)[2][2][4][2], const pg8::UnitG& u, int wr, int wc, int fr, int fq) const {
#pragma unroll
        for (int ai = 0; ai < 2; ++ai)
#pragma unroll
            for (int m = 0; m < 4; ++m) { unsigned char* rowp = O + (size_t)(u.row0 + ai * 128 + wr * 64 + m * 16 + fr) * ldc + u.col0 + wc * 64 + 16 * fq;
                u32x4 w;
#pragma unroll
                for (int q = 0; q < 4; ++q) { f32x4 v = acc[ai][q >> 1][m][q & 1] * (YEXP_SCALE / (H_SCALE * WUP_SCALE));
#pragma unroll
                    for (int j = 0; j < 4; ++j) v[j] = fminf(fmaxf(v[j], -448.0f), 448.0f);
                    int d = 0; d = __builtin_amdgcn_cvt_pk_fp8_f32(v[0], v[1], d, false); d = __builtin_amdgcn_cvt_pk_fp8_f32(v[2], v[3], d, true); w[q] = (unsigned)d; }
                *(u32x4*)rowp = w; }
    }
};
struct EpiRetIn {
    static constexpr bool PERM = true, PERM16 = false;
    bf16* O; int ldc;
    __device__ __forceinline__ void operator()(const f32x4 (&acc)[2][2][4][2], const pg8::UnitG& u, int wr, int wc, int fr, int fq) const {
        float l2g = 0.f;
        float cs = WUP_INV;
        if (u.col0 < 2048) { const int h = (u.col0 & 1023) >> 8; const float g = 1.0f - exp2f(-5.0f - (float)h); l2g = log2f(g); if (u.col0 >= 1024) { l2g = -l2g; cs *= 0.0625f; } }
#pragma unroll
        for (int ai = 0; ai < 2; ++ai)
#pragma unroll
            for (int m = 0; m < 4; ++m) { const int row = u.row0 + ai * 128 + wr * 64 + m * 16 + fr; const float sc = exp2f(l2g * (float)(row & 127)) * cs;
                bf16* rowp = O + (size_t)row * ldc + u.col0 + wc * 32 + 8 * fq;
#pragma unroll
                for (int bj = 0; bj < 2; ++bj) *(u32x4*)(rowp + bj * 128) = pack_bf16x8(acc[ai][bj][m][0] * sc, acc[ai][bj][m][1] * sc); }
    }
};
__device__ __forceinline__ void unpack_bf16x8(const u32x4& w, f32x4& a, f32x4& b) { a[0] = bflo(w.x); a[1] = bfhi(w.x); a[2] = bflo(w.y); a[3] = bfhi(w.y); b[0] = bflo(w.z); b[1] = bfhi(w.z); b[2] = bflo(w.w); b[3] = bfhi(w.w); }
template <bool ALL16> struct EpiResidT {
    static constexpr bool PERM = true, PERM16 = false;
    const bf16* X; bf16* Y; float asc;
    __device__ __forceinline__ void operator()(const f32x4 (&acc)[2][2][4][2], const pg8::UnitG& u, int wr, int wc, int fr, int fq) const {
        constexpr int NB = ALL16 ? 1 : 2, PER = 2 / NB;
#pragma unroll
        for (int bt = 0; bt < NB; ++bt) {
            u32x4 xw[PER][4][2];
#pragma unroll
            for (int a2 = 0; a2 < PER; ++a2)
#pragma unroll
                for (int m = 0; m < 4; ++m) { const int ai = bt * PER + a2; const size_t off = (size_t)(u.row0 + ai * 128 + wr * 64 + m * 16 + fr) * D + u.col0 + wc * 32 + 8 * fq;
#pragma unroll
                    for (int bj = 0; bj < 2; ++bj) xw[a2][m][bj] = *(const u32x4*)(X + off + bj * 128); }
            asm volatile("" ::: "memory");
#pragma unroll
            for (int a2 = 0; a2 < PER; ++a2)
#pragma unroll
                for (int m = 0; m < 4; ++m) { const int ai = bt * PER + a2; const size_t off = (size_t)(u.row0 + ai * 128 + wr * 64 + m * 16 + fr) * D + u.col0 + wc * 32 + 8 * fq;
#pragma unroll
                    for (int bj = 0; bj < 2; ++bj) { f32x4 x0, x1; unpack_bf16x8(xw[a2][m][bj], x0, x1);
                        *(u32x4*)(Y + off + bj * 128) = pack_bf16x8(x0 * ALPHA + acc[ai][bj][m][0] * asc, x1 * ALPHA + acc[ai][bj][m][1] * asc); } }
            asm volatile("" ::: "memory");
        }
    }
};
typedef EpiResidT<true> EpiResid; typedef EpiResidT<false> EpiResid8;
struct EpiGluResid {
    static constexpr bool PERM = true, PERM16 = false;
    const bf16* X; bf16* Y; float asc;
    __device__ __forceinline__ void operator()(const f32x4 (&acc)[2][2][4][2], const pg8::UnitG& u, int wr, int wc, int fr, int fq) const {
        u32x4 xw[2][4];
#pragma unroll
        for (int ai = 0; ai < 2; ++ai)
#pragma unroll
            for (int m = 0; m < 4; ++m) { const size_t off = (size_t)(u.row0 + ai * 128 + wr * 64 + m * 16 + fr) * D + (u.col0 >> 1) + wc * 32 + 8 * fq; xw[ai][m] = *(const u32x4*)(X + off); }
        asm volatile("" ::: "memory");
#pragma unroll
        for (int ai = 0; ai < 2; ++ai)
#pragma unroll
            for (int m = 0; m < 4; ++m) { const size_t off = (size_t)(u.row0 + ai * 128 + wr * 64 + m * 16 + fr) * D + (u.col0 >> 1) + wc * 32 + 8 * fq;
                f32x4 x0, x1; unpack_bf16x8(xw[ai][m], x0, x1); f32x4 o0, o1;
#pragma unroll
                for (int j = 0; j < 4; ++j) { o0[j] = x0[j] * ALPHA + acc[ai][0][m][0][j] * asc * fsig(acc[ai][1][m][0][j] * asc); o1[j] = x1[j] * ALPHA + acc[ai][0][m][1][j] * asc * fsig(acc[ai][1][m][1][j] * asc); }
                *(u32x4*)(Y + off) = pack_bf16x8(o0, o1); }
    }
};
struct EpiMoeUp {
    static constexpr bool PERM = true, PERM16 = false;
    unsigned char* H;
    __device__ __forceinline__ void operator()(const f32x4 (&acc)[2][2][4][2], const pg8::UnitG& u, int wr, int wc, int fr, int fq) const {
#pragma unroll
        for (int ai = 0; ai < 2; ++ai)
#pragma unroll
            for (int m = 0; m < 4; ++m) { unsigned char* rowp = H + (size_t)(u.row0 + ai * 128 + wr * 64 + m * 16 + fr) * ED + u.col0 + wc * 32 + 8 * fq; f32x4 o[2];
#pragma unroll
                for (int n = 0; n < 2; ++n)
#pragma unroll
                    for (int j = 0; j < 4; ++j) { const float ga = acc[ai][0][m][n][j], ua = acc[ai][1][m][n][j];
                        o[n][j] = (ga * ua) * (WUP_INV * WUP_INV * H_SCALE) * __builtin_amdgcn_rcpf(1.0f + __builtin_amdgcn_exp2f(ga * (-WUP_INV * 1.4426950408889634f))); }
                u32x2 w8; w8.x = pk4_fp8(o[0][0], o[0][1], o[0][2], o[0][3]); w8.y = pk4_fp8(o[1][0], o[1][1], o[1][2], o[1][3]); *(u32x2*)rowp = w8; }
    }
};

struct ConvD { const float* src; unsigned char* dst; unsigned char* dst2; int ldw, ldk, kind; };
__device__ __forceinline__ ConvD conv_mk8(const float* W, int ldw, unsigned char* WT, int ldk, int k0, int n0, int drow0) {
    ConvD d; d.src = W + (size_t)k0 * ldw + n0; d.dst = WT + (size_t)drow0 * ldk + k0; d.dst2 = nullptr; d.ldw = ldw; d.ldk = ldk; d.kind = 1; return d; }
__device__ __forceinline__ ConvD conv_mk16(const float* W, int ldw, bf16* WT, bf16* WTlo, int ldk, int k0, int n0, int drow0) {
    ConvD d; d.src = W + (size_t)k0 * ldw + n0; d.dst = (unsigned char*)(WT + (size_t)drow0 * ldk + k0); d.dst2 = WTlo ? (unsigned char*)(WTlo + (size_t)drow0 * ldk + k0) : nullptr; d.ldw = ldw; d.ldk = ldk * 2; d.kind = WTlo ? 2 : 0; return d; }
__device__ __forceinline__ void conv_load(const ConvD& d, int lane, f32x4 (&r)[8]) {
#pragma unroll
    for (int i = 0; i < 8; ++i) { const int kk = 8 * i + (lane >> 3), c4 = 4 * (lane & 7); r[i] = *(const f32x4*)(d.src + (size_t)kk * d.ldw + c4); }
}
template <bool HILO>
__device__ __forceinline__ void conv_finish(const ConvD& d, int lane, const f32x4 (&r)[8], LAS float* scr) {
    const float scale = (d.kind == 1) ? WUP_SCALE : 1.0f;
#pragma unroll
    for (int i = 0; i < 8; ++i) { const int kk = 8 * i + (lane >> 3), c4 = 4 * (lane & 7);
        scr[kk * 33 + c4] = r[i][0] * scale; scr[kk * 33 + c4 + 1] = r[i][1] * scale; scr[kk * 33 + c4 + 2] = r[i][2] * scale; scr[kk * 33 + c4 + 3] = r[i][3] * scale; }
    LDS_WAIT(); asm volatile("" ::: "memory");
    const int c = lane & 7;
#pragma unroll
    for (int j = 0; j < 4; ++j) { const int n = (lane >> 3) + 8 * j; const LAS float* s = scr + (8 * c) * 33 + n;
        float v[8];
#pragma unroll
        for (int q = 0; q < 8; ++q) v[q] = s[q * 33];
        if (d.kind == 1) { u32x2 o; o.x = pk4_fp8(v[0], v[1], v[2], v[3]); o.y = pk4_fp8(v[4], v[5], v[6], v[7]); *(u32x2*)(d.dst + (size_t)n * d.ldk + 8 * c) = o; }
        else { u32x4 o; o.x = pk2(v[0], v[1]); o.y = pk2(v[2], v[3]); o.z = pk2(v[4], v[5]); o.w = pk2(v[6], v[7]);
            *(u32x4*)(d.dst + (size_t)n * d.ldk + 16 * c) = o;
            if (HILO) { float rr[8];
#pragma unroll
                for (int q = 0; q < 8; ++q) rr[q] = v[q] - bf2f(f2bf(v[q]));
                u32x4 o2; o2.x = pk2(rr[0], rr[1]); o2.y = pk2(rr[2], rr[3]); o2.z = pk2(rr[4], rr[5]); o2.w = pk2(rr[6], rr[7]);
                *(u32x4*)(d.dst2 + (size_t)n * d.ldk + 16 * c) = o2; } } }
    LDS_WAIT(); asm volatile("" ::: "memory");
}
__device__ __forceinline__ void conv_dma(const ConvD& d, int lane, LAS float* buf) {
#pragma unroll
    for (int i = 0; i < 8; ++i) { const float* g = d.src + (size_t)(8 * i + (lane >> 3)) * d.ldw + 4 * ((lane & 7) ^ i);
        __builtin_amdgcn_global_load_lds((const unsigned*)g, (LAS unsigned*)(buf + i * 256), 16, 0, 0); }
}
__device__ __forceinline__ void conv_finish_lds(const ConvD& d, int lane, const LAS float* buf) {
    const float scale = (d.kind == 1) ? WUP_SCALE : 1.0f;
    const int c = lane & 7;
#pragma unroll
    for (int j = 0; j < 4; ++j) { const int n = (lane >> 3) + 8 * j; const LAS float* s = buf + (8 * c) * 32 + (((n >> 2) ^ c) & 7) * 4 + (n & 3);
        float v[8];
#pragma unroll
        for (int q = 0; q < 8; ++q) v[q] = s[q * 32] * scale;
        if (d.kind == 1) { u32x2 o; o.x = pk4_fp8(v[0], v[1], v[2], v[3]); o.y = pk4_fp8(v[4], v[5], v[6], v[7]); *(u32x2*)(d.dst + (size_t)n * d.ldk + 8 * c) = o; }
        else { u32x4 o; o.x = pk2(v[0], v[1]); o.y = pk2(v[2], v[3]); o.z = pk2(v[4], v[5]); o.w = pk2(v[6], v[7]); *(u32x4*)(d.dst + (size_t)n * d.ldk + 16 * c) = o; } }
    LDS_WAIT(); asm volatile("" ::: "memory");
}
#define CONV_RUN(NIT, DEC) do { int it_ = gw; if (it_ < (NIT)) { ConvD dc_ = DEC(it_); int par_ = 0; conv_dma(dc_, F.lane, scr); asm volatile("s_waitcnt vmcnt(0)" ::: "memory"); \
        for (; it_ < (NIT); it_ += NGW) { const int itn_ = (it_ + NGW < (NIT)) ? it_ + NGW : it_; const ConvD dn_ = DEC(itn_); conv_dma(dn_, F.lane, scr + (par_ ^ 1) * 2048);     \
            asm volatile("s_waitcnt vmcnt(12)" ::: "memory"); conv_finish_lds(dc_, F.lane, scr + par_ * 2048); dc_ = dn_; par_ ^= 1; } \
        asm volatile("s_waitcnt vmcnt(0)" ::: "memory"); } } while (0)
__device__ __forceinline__ ConvD conv_dec_mixers(KP p, unsigned char* ws, int it) {
    constexpr int I_AIN = 16 * 288, I_AOUT = 16 * 32, I_RIN = 16 * 192, I_ROUT = 32 * 32, I_GLU = 16 * 64, I_RT = 16 * 2;
    int r = it;
    if (r < 2 * I_AIN) { const int j = r / I_AIN; r %= I_AIN; const int kb = r / 288, nb = r % 288, n0 = nb * 32;
        return conv_mk8(gin(p, 1) + (size_t)j * D * ATT_IN, ATT_IN, (unsigned char*)(ws + WS_ATT_IN_T) + (size_t)j * ATT_IN * D, D, kb * 64, n0, n0); }
    r -= 2 * I_AIN;
    if (r < 2 * I_AOUT) { const int j = r / I_AOUT; r %= I_AOUT; const int kb = r / 32, nb = r % 32, n0 = nb * 32;
        return conv_mk8(gin(p, 2) + (size_t)j * D * D, D, (unsigned char*)(ws + WS_ATT_OUT_T) + (size_t)j * D * D, D, kb * 64, n0, n0); }
    r -= 2 * I_AOUT;
    if (r < I_RIN) { const int kb = r / 192, nb = r % 192, n0 = nb * 32;
        return conv_mk8(gin(p, 3), RET_IN, (unsigned char*)(ws + WS_RET_IN_T), D, kb * 64, n0, n0); }
    r -= I_RIN;
    if (r < I_ROUT) { const int kb = r / 32, nb = r % 32, n0 = nb * 32;
        return conv_mk8(gin(p, 6), D, (unsigned char*)(ws + WS_RET_OUT_T), RET_V, kb * 64, n0, n0); }
    r -= I_ROUT;
    if (r < I_GLU) { const int kb = r / 64, nb = r % 64, n0 = nb * 32; const int c = n0 & 1023, drow = (c >> 7) * 256 + (n0 >> 10) * 128 + (c & 127);
        return conv_mk8(gin(p, 15), 2 * D, (unsigned char*)(ws + WS_GLU_T), D, kb * 64, n0, drow); }
    r -= I_GLU;
    { const int l = r / I_RT; r %= I_RT; const int kb = r / 2, nb = r % 2, n0 = nb * 32;
        return conv_mk16(gin(p, 16) + (size_t)l * D * NE, NE, (bf16*)(ws + WS_RT_HI) + (size_t)l * NE * D, (bf16*)(ws + WS_RT_LO) + (size_t)l * NE * D, D, kb * 64, n0, n0); }
}
__device__ __forceinline__ ConvD conv_dec_moe(KP p, unsigned char* ws, int l, int it) {
    const int e = it / 384, r = it % 384, which = r >> 7, rr = r & 127;
    bf16* We = (bf16*)(ws + WS_WMOE + (size_t)e * WMOE_E_BYTES);
    if (which < 2) { const float* src = (e < 64) ? gin(p, 18 + which) + ((size_t)l * NE + e) * D * ED : gin(p, 21 + which) + (size_t)l * D * ED;
        const int kb = rr >> 3, nb = rr & 7, n0 = nb * 32; const int drow = (n0 >> 7) * 256 + which * 128 + (n0 & 127);
        return conv_mk8(src, ED, (unsigned char*)We, D, kb * 64, n0, drow); }
    const float* src = (e < 64) ? gin(p, 20) + ((size_t)l * NE + e) * ED * D : gin(p, 23) + (size_t)l * ED * D;
    const int kb = rr >> 5, nb = rr & 31, n0 = nb * 32;
    return conv_mk8(src, D, (unsigned char*)(We + 512 * 1024), ED, kb * 64, n0, n0);
}
__device__ __forceinline__ void phase_conv_mixers(const Frame& F, KP p) {
    LAS float* scr = (LAS float*)(F.lds + F.wave * 16384);
    const int gw = F.vcu * NWAVES + F.wave, NGW = F.G * NWAVES;
    constexpr int NMAIN = 2 * (16 * 288) + 2 * (16 * 32) + 16 * 192 + 32 * 32 + 16 * 64, NRT = 4 * (16 * 2);
    unsigned char* ws = F.ws;
#define CONV_DEC_MIX(i_) conv_dec_mixers(p, ws, (i_))
    CONV_RUN(NMAIN, CONV_DEC_MIX);
    for (int it = NMAIN + gw; it < NMAIN + NRT; it += NGW) { const ConvD d = conv_dec_mixers(p, ws, it); f32x4 r[8]; conv_load(d, F.lane, r); conv_finish<true>(d, F.lane, r, scr); }
#undef CONV_DEC_MIX
}
__device__ __forceinline__ void phase_conv_moe(const Frame& F, KP p, int l) {
    LAS float* scr = (LAS float*)(F.lds + F.wave * 16384);
    const int gw = F.vcu * NWAVES + F.wave, NGW = F.G * NWAVES;
    unsigned char* ws = F.ws;
#define CONV_DEC_MOE(i_) conv_dec_moe(p, ws, l, (i_))
    CONV_RUN(65 * 384, CONV_DEC_MOE);
#undef CONV_DEC_MOE
}

__device__ __forceinline__ void phase_lnr(const Frame& F, KP p, int layer, bool dry = false) {
    const bf16* Y = (const bf16*)(F.ws + WS_Y); bf16* XB = (bf16*)(F.ws + WS_XB); unsigned char* XB8 = (unsigned char*)(F.ws + WS_X);
    const float* lng = gin(p, 24) + (size_t)(layer * 2) * D; const float* lnb = gin(p, 25) + (size_t)(layer * 2) * D;
    const bf16* rthi = (const bf16*)(F.ws + WS_RT_HI) + (size_t)layer * NE * D; const bf16* rtlo = (const bf16*)(F.ws + WS_RT_LO) + (size_t)layer * NE * D;
    const float* rbias = gin(p, 17) + layer * NE;
    unsigned* cnt = (unsigned*)(F.ws + WS_CTL) + CW_CNT + layer * NE * 64;
    int* lists = (int*)(F.ws + WS_LIST); int* tokmap = (int*)(F.ws + WS_LIST + 4 * MiB); float* tokgate = (float*)(F.ws + WS_LIST + 5 * MiB);
    constexpr int XLD = 1032, MAXT = 8;
    LAS bf16* Xhi = (LAS bf16*)F.lds; LAS bf16* Xlo = Xhi + 16 * XLD;
    LAS float* part = (LAS float*)(F.lds + 2 * 16 * XLD * 2);
    LAS int* ent = (LAS int*)(part + 2 * 16 * 64);
    LAS int* hist = ent + MAXT * 16 * 8 * 2; LAS int* base = hist + 64;
    const int lane = F.lane, w = F.wave, g4 = lane >> 4, l15 = lane & 15;
    if (F.tid < 64) hist[F.tid] = 0;
    bf16x8 bhi[16], blo[16];
    { const int nt = w & 3, kh = w >> 2; const bf16* bh = rthi + (size_t)(16 * nt + l15) * D + 512 * kh + 8 * g4; const bf16* bl = rtlo + (size_t)(16 * nt + l15) * D + 512 * kh + 8 * g4;
#pragma unroll
        for (int ks = 0; ks < 16; ++ks) { bhi[ks] = *(const bf16x8*)(bh + 32 * ks); blo[ks] = *(const bf16x8*)(bl + 32 * ks); } }
    u32x4 ypre[2][2];
    if (F.vcu < T / 16) {
#pragma unroll
        for (int rr = 0; rr < 2; ++rr)
#pragma unroll
            for (int j = 0; j < 2; ++j) ypre[rr][j] = *(const u32x4*)(Y + (size_t)(F.vcu * 16 + 2 * w + rr) * D + 8 * lane + 512 * j); }
    int ntile = 0;
    for (int tile = F.vcu; tile < T / 16 && ntile < MAXT; tile += F.G, ++ntile) {
        const int t0 = tile * 16;
        u32x4 ycur[2][2];
#pragma unroll
        for (int rr = 0; rr < 2; ++rr)
#pragma unroll
            for (int j = 0; j < 2; ++j) ycur[rr][j] = ypre[rr][j];
        if (tile + F.G < T / 16) {
#pragma unroll
            for (int rr = 0; rr < 2; ++rr)
#pragma unroll
                for (int j = 0; j < 2; ++j) ypre[rr][j] = *(const u32x4*)(Y + (size_t)((tile + F.G) * 16 + 2 * w + rr) * D + 8 * lane + 512 * j); }
#pragma unroll
        for (int rr = 0; rr < 2; ++rr) {
            const int lr = 2 * w + rr; const size_t row = (size_t)(t0 + lr);
            f32x4 v[4]; float s = 0.f;
#pragma unroll
            for (int j = 0; j < 2; ++j) unpack_bf16x8(ycur[rr][j], v[2 * j], v[2 * j + 1]);
#pragma unroll
            for (int j = 0; j < 4; ++j) s += (v[j][0] + v[j][1]) + (v[j][2] + v[j][3]);
            const float mean = wave_sum(s, lane) * (1.f / D); float s2 = 0.f;
#pragma unroll
            for (int j = 0; j < 4; ++j) { v[j] = v[j] - mean; s2 += (v[j][0] * v[j][0] + v[j][1] * v[j][1]) + (v[j][2] * v[j][2] + v[j][3] * v[j][3]); }
            const float rstd = 1.0f / sqrtf(wave_sum(s2, lane) * (1.f / D) + LN_EPS);
#pragma unroll
            for (int j = 0; j < 2; ++j) { const f32x4 g0 = *(const f32x4*)(lng + 8 * lane + 512 * j), g1 = *(const f32x4*)(lng + 8 * lane + 512 * j + 4), b0 = *(const f32x4*)(lnb + 8 * lane + 512 * j), b1 = *(const f32x4*)(lnb + 8 * lane + 512 * j + 4);
                const f32x4 o0 = v[2 * j] * rstd * g0 + b0, o1 = v[2 * j + 1] * rstd * g1 + b1;
                const u32x4 hi = pack_bf16x8(o0, o1);
                *(u32x4*)(XB + row * D + 8 * lane + 512 * j) = hi;
                { u32x2 q8; q8.x = pk4_fp8(o0[0], o0[1], o0[2], o0[3]); q8.y = pk4_fp8(o1[0], o1[1], o1[2], o1[3]); *(u32x2*)(XB8 + row * D + 8 * lane + 512 * j) = q8; }
                f32x4 h0, h1; unpack_bf16x8(hi, h0, h1); const u32x4 lo = pack_bf16x8(o0 - h0, o1 - h1);
                *(LAS u32x4*)(Xhi + lr * XLD + 8 * lane + 512 * j) = hi; *(LAS u32x4*)(Xlo + lr * XLD + 8 * lane + 512 * j) = lo; }
        }
        __syncthreads();
        { const int nt = w & 3, kh = w >> 2; f32x4 a0 = (f32x4){0.f, 0.f, 0.f, 0.f}, a1 = a0, a2 = a0, a3 = a0, a4 = a0, a5 = a0;
#pragma unroll
            for (int ks = 0; ks < 16; ks += 2) { const int k0 = 512 * kh + 32 * ks;
                const bf16x8 ahi = row_frag(Xhi, XLD, 0, k0, lane), alo = row_frag(Xlo, XLD, 0, k0, lane), bhi2 = row_frag(Xhi, XLD, 0, k0 + 32, lane), blo2 = row_frag(Xlo, XLD, 0, k0 + 32, lane);
                a0 = MFMA16(ahi, bhi[ks], a0); a1 = MFMA16(alo, bhi[ks], a1); a2 = MFMA16(ahi, blo[ks], a2);
                a3 = MFMA16(bhi2, bhi[ks + 1], a3); a4 = MFMA16(blo2, bhi[ks + 1], a4); a5 = MFMA16(bhi2, blo[ks + 1], a5); }
            const f32x4 acc = ((a0 + a3) + (a1 + a4)) + (a2 + a5);
#pragma unroll
            for (int i = 0; i < 4; ++i) part[(kh * 16 + 4 * g4 + i) * 64 + 16 * nt + l15] = acc[i];
        }
        __syncthreads();
#pragma unroll
        for (int rr = 0; rr < 2; ++rr) {
            const int lt = ntile * 16 + 2 * w + rr;
            const float lg = part[(2 * w + rr) * 64 + lane] + part[(16 + 2 * w + rr) * 64 + lane];
            float sc = 1.0f / (1.0f + expf(-lg)); sc = (sc == sc) ? sc : 0.5f;
            const float sel = sc + rbias[lane];
            const float m1 = max8(sel);
            const unsigned long long eq = __ballot(sel == m1);
            const unsigned gm = (unsigned)(eq >> (lane & 56)) & 0xffu;
            const int first = (lane & 56) + __builtin_ctz(gm | 0x100u);
            const float m2 = max8((lane == first) ? -INFINITY : sel);
            const float gs = m1 + m2; const int mygrp = lane >> 3; int grank = 0;
#pragma unroll
            for (int gg = 0; gg < 8; ++gg) { const float o = rdl(gs, 8 * gg); grank += (o > gs || (o == gs && gg < mygrp)) ? 1 : 0; }
            const float mv = (grank < 4) ? sel : -INFINITY;
            unsigned key = __builtin_bit_cast(unsigned, mv); key = (key >> 31) ? ~key : (key | 0x80000000u); key = (key & ~63u) | (unsigned)(63 - lane);
            int r0 = 0, r1 = 0, r2 = 0, r3 = 0;
#pragma unroll
            for (int e2 = 0; e2 < 64; e2 += 4) { r0 += ((unsigned)__builtin_amdgcn_readlane((int)key, e2) > key) ? 1 : 0; r1 += ((unsigned)__builtin_amdgcn_readlane((int)key, e2 + 1) > key) ? 1 : 0;
                r2 += ((unsigned)__builtin_amdgcn_readlane((int)key, e2 + 2) > key) ? 1 : 0; r3 += ((unsigned)__builtin_amdgcn_readlane((int)key, e2 + 3) > key) ? 1 : 0; }
            const int rank = (r0 + r1) + (r2 + r3);
            const bool chosen = rank < TOPK;
            const float wsum = wave_sum(chosen ? sc : 0.f, lane);
            if (chosen) { const int lpos = __hip_atomic_fetch_add(hist + lane, 1, __ATOMIC_RELAXED, __HIP_MEMORY_SCOPE_WORKGROUP);
                ent[(lt * 8 + rank) * 2] = (lane << 16) | lpos; ent[(lt * 8 + rank) * 2 + 1] = __builtin_bit_cast(int, sc / wsum * 2.5f); }
        }
    }
    __syncthreads();
    if (dry) return;
    if (F.tid < 64) { const int hcount = hist[F.tid]; base[F.tid] = hcount ? (int)atomicAdd(cnt + F.tid * 64, (unsigned)hcount) : 0; }
    __syncthreads();
    for (int idx = F.tid; idx < ntile * 16 * 8; idx += NTHREADS) {
        const int ev = ent[idx * 2], gb = ent[idx * 2 + 1]; const int e = ev >> 16, pos = base[e] + (ev & 0xffff);
        const int lt = idx >> 3, rank = idx & 7, tok = (F.vcu + (lt >> 4) * F.G) * 16 + (lt & 15);
        lists[(size_t)e * T + pos] = tok; tokmap[tok * 8 + rank] = (e << 16) | pos; tokgate[tok * 8 + rank] = __builtin_bit_cast(float, gb);
    }
}

__device__ __forceinline__ void phase_combine(const Frame& F, KP p, int layer, bool dry = false) {
    bf16* XB = (bf16*)(F.ws + WS_XB); const unsigned char* yexp = (const unsigned char*)(F.ws + WS_BIG);
    const int* tokmap = (const int*)(F.ws + WS_LIST + 4 * MiB); const float* tokgate = (const float*)(F.ws + WS_LIST + 5 * MiB);
    const volatile LAS int* tstart = (const volatile LAS int*)(F.MISC + 64);
    const float* lng = gin(p, 24) + (size_t)(layer * 2 + 1) * D; const float* lnb = gin(p, 25) + (size_t)(layer * 2 + 1) * D;
    float* outp = gout(p); bf16* xbo = XB; if (dry) { outp = (float*)(F.ws + WS_AUX); xbo = (bf16*)(F.ws + WS_H); }
    const int lane = F.lane, gw = F.vcu * NWAVES + F.wave, NGW = F.G * NWAVES;
    const bf16* ysh = (const bf16*)(F.ws + WS_Y);
    f32x4 gv[4], bv[4];
#pragma unroll
    for (int j = 0; j < 4; ++j) { gv[j] = *(const f32x4*)(lng + 16 * lane + 4 * j); bv[j] = *(const f32x4*)(lnb + 16 * lane + 4 * j); }
    for (int row = gw; row < T; row += NGW) {
        const int mk = tokmap[row * 8 + (lane & 7)]; const float gk = tokgate[row * 8 + (lane & 7)] * YEXP_INV;
        const int rk = (int)tstart[mk >> 16] * 256 + (mk & 0xffff);
        f32x4 v[4];
#pragma unroll
        for (int j = 0; j < 2; ++j) { const u32x4 xw = *(const u32x4*)(ysh + (size_t)row * D + 16 * lane + 8 * j); unpack_bf16x8(xw, v[2 * j], v[2 * j + 1]); }
#pragma unroll
        for (int k = 0; k < TOPK; ++k) { const int r = __builtin_amdgcn_readlane(rk, k); const float g = rdl(gk, k);
            const u32x4 s = *(const u32x4*)(yexp + (size_t)r * D + 16 * lane);
#pragma unroll
            for (int j = 0; j < 4; ++j) { const f32x2 lo = __builtin_amdgcn_cvt_pk_f32_fp8((int)s[j], false), hi = __builtin_amdgcn_cvt_pk_f32_fp8((int)s[j], true);
                v[j][0] += g * lo[0]; v[j][1] += g * lo[1]; v[j][2] += g * hi[0]; v[j][3] += g * hi[1]; } }
        float s = 0.f;
#pragma unroll
        for (int j = 0; j < 4; ++j) s += (v[j][0] + v[j][1]) + (v[j][2] + v[j][3]);
        const float mean = wave_sum(s, lane) * (1.f / D); float s2 = 0.f;
#pragma unroll
        for (int j = 0; j < 4; ++j) { v[j] = v[j] - mean; s2 += (v[j][0] * v[j][0] + v[j][1] * v[j][1]) + (v[j][2] * v[j][2] + v[j][3] * v[j][3]); }
        const float rstd = 1.0f / sqrtf(wave_sum(s2, lane) * (1.f / D) + LN_EPS);
        f32x4 o[4];
#pragma unroll
        for (int j = 0; j < 4; ++j) o[j] = v[j] * rstd * gv[j] + bv[j];
        if (layer == DEPTH - 1 || dry) {
#pragma unroll
            for (int j = 0; j < 4; ++j) *(f32x4*)(outp + (size_t)row * D + 16 * lane + 4 * j) = o[j]; }
        if (layer != DEPTH - 1) { *(u32x4*)(xbo + (size_t)row * D + 16 * lane) = pack_bf16x8(o[0], o[1]); *(u32x4*)(xbo + (size_t)row * D + 16 * lane + 8) = pack_bf16x8(o[2], o[3]);
            if (!dry) { u32x4 q8; q8.x = pk4_fp8(o[0][0], o[0][1], o[0][2], o[0][3]); q8.y = pk4_fp8(o[1][0], o[1][1], o[1][2], o[1][3]); q8.z = pk4_fp8(o[2][0], o[2][1], o[2][2], o[2][3]); q8.w = pk4_fp8(o[3][0], o[3][1], o[3][2], o[3][3]);
                *(u32x4*)((unsigned char*)(F.ws + WS_X) + (size_t)row * D + 16 * lane) = q8; } }
    }
}

constexpr size_t AUX_OB = 96 * MiB, AUX_LSE = 128 * MiB;
__device__ __forceinline__ unsigned att_qoff(int R, int j, int qi, int g4) {
    const int h = R & 7, sbr = R >> 3, g = sbr >> 5, rem = sbr & 31, b = rem >> 4, rr_ = rem & 15;
    const int dsh = 2 * g, d = 1 << dsh, nrs = 4 - dsh, r = rr_ >> nrs, n = 4 * (rr_ & ((1 << nrs) - 1)) + j;
    const unsigned qrow = (unsigned)b * SEQ + (unsigned)(128 * n + qi) * (unsigned)d + (unsigned)r;
    return qrow * (unsigned)ATT_IN + (unsigned)(g * 3072 + h * 128 + 8 * g4);
}
__device__ __forceinline__ void phase_attn(const Frame& F, int bx) {
    const bf16* qkv = (const bf16*)(F.ws + WS_BIG); bf16* og = (bf16*)(F.ws + WS_AUX); float* lse = (float*)(F.ws + WS_AUX + AUX_LSE);
    constexpr int KLD = 136;
    LAS bf16* Ks = (LAS bf16*)F.lds; LAS bf16* Vs = Ks + 256 * KLD;
    const int lane = F.lane, w = F.wave, g4 = lane >> 4, l15 = lane & 15, qq = l15 >> 2, pp = lane & 3;
    u32x4 kc[4], vc[4];
    constexpr int NRUN = 768;
#define ATT_LOADBLK(KR, VR, nblk) do { _Pragma("unroll") for (int it = 0; it < 4; ++it) { const int idx = F.tid + 512 * it, c = idx >> 4, ch = idx & 15; int pos = 128 * (nblk) + c; pos = pos < 0 ? 0 : pos; \
            const unsigned so = (rowbase + (unsigned)pos * (unsigned)d + (unsigned)r) * (unsigned)ATT_IN + (unsigned)(g * 3072 + 1024 + h * 128 + ch * 8); KR[it] = *(const u32x4*)(qkv + so); VR[it] = *(const u32x4*)(qkv + so + 1024u); } } while (0)
#define ATT_STOREBLK(KR, VR, slot) do { _Pragma("unroll") for (int it = 0; it < 4; ++it) { const int idx = F.tid + 512 * it, c = idx >> 4, ch = idx & 15; \
            *(LAS u32x4*)(Ks + (128 * (slot) + c) * KLD + ch * 8) = KR[it]; *(LAS u32x4*)(Vs + (128 * (slot) + c) * KLD + ch * 8) = VR[it]; } } while (0)
    const int qi = 16 * w + l15;
    bf16x8 qf[4];
    if (bx < NRUN) { const unsigned qo = att_qoff(bx, 0, qi, g4);
#pragma unroll
        for (int s = 0; s < 4; ++s) qf[s] = *(const bf16x8*)(qkv + qo + 32 * s); }
    for (int R = bx; R < NRUN; R += F.G) {
        const int h = R & 7, sbr = R >> 3, g = sbr >> 5, rem = sbr & 31, b = rem >> 4, rr_ = rem & 15;
        const int dsh = 2 * g, d = 1 << dsh, nrs = 4 - dsh, r = rr_ >> nrs, n0 = 4 * (rr_ & ((1 << nrs) - 1)); const unsigned rowbase = (unsigned)b * SEQ;
        { u32x4 k0[4], v0[4]; ATT_LOADBLK(k0, v0, n0 - 1); ATT_LOADBLK(kc, vc, n0); ATT_STOREBLK(k0, v0, (n0 - 1) & 1); }
#pragma unroll 1
        for (int j = 0; j < 4; ++j) {
            const int n = n0 + j, cs = n & 1, ps = cs ^ 1;
            ATT_STOREBLK(kc, vc, cs);
            const unsigned qrow = rowbase + (unsigned)(128 * n + qi) * (unsigned)d + (unsigned)r;
            __syncthreads();
            if (j < 3) { ATT_LOADBLK(kc, vc, n + 1); }
            __builtin_amdgcn_sched_barrier(0);
            const int ws0 = (16 * w < 96) ? 16 * w : 96;
#define ATT_PROW(c0) (((c0) < 128) ? (128 * ps + (c0)) : (128 * cs + (c0) - 128))
            f32x4 sacc[10];
            {
                bf16x8 kfa[4], kfb[4];
#pragma unroll
                for (int s = 0; s < 4; ++s) kfa[s] = row_frag(Ks, KLD, ATT_PROW(ws0), 32 * s, lane);
#pragma unroll
                for (int t = 0; t < 10; t += 2) {
#pragma unroll
                    for (int s = 0; s < 4; ++s) kfb[s] = row_frag(Ks, KLD, ATT_PROW(ws0 + 16 * (t + 1)), 32 * s, lane);
                    __builtin_amdgcn_sched_barrier(0);
                    sacc[t] = (f32x4){0.f, 0.f, 0.f, 0.f};
#pragma unroll
                    for (int s = 0; s < 4; ++s) sacc[t] = MFMA16(kfa[s], qf[s], sacc[t]);
                    if (t + 2 < 10) {
#pragma unroll
                        for (int s = 0; s < 4; ++s) kfa[s] = row_frag(Ks, KLD, ATT_PROW(ws0 + 16 * (t + 2)), 32 * s, lane); }
                    __builtin_amdgcn_sched_barrier(0);
                    sacc[t + 1] = (f32x4){0.f, 0.f, 0.f, 0.f};
#pragma unroll
                    for (int s = 0; s < 4; ++s) sacc[t + 1] = MFMA16(kfb[s], qf[s], sacc[t + 1]);
                }
            }
            { const int Rn = (j < 3) ? R : ((R + F.G < NRUN) ? R + F.G : R), jn = (j < 3) ? j + 1 : 0; const unsigned qo = att_qoff(Rn, jn, qi, g4);
#pragma unroll
              for (int s = 0; s < 4; ++s) qf[s] = *(const bf16x8*)(qkv + qo + 32 * s); }
            const float slope = exp2f(-(float)(h + 1)) * (float)d;
            float mx = -INFINITY;
            int sbase = 128 + qi - ws0 - 4 * g4; asm volatile("" : "+v"(sbase));
            const float nsb = -slope * (float)sbase; const int kmin = (n > 0) ? sbase - 128 : ((sbase - 128 > 128 - ws0 - 4 * g4) ? sbase - 128 : 128 - ws0 - 4 * g4);
#pragma unroll
            for (int t = 0; t < 10; ++t)
#pragma unroll
                for (int i = 0; i < 4; ++i) { const int k = 16 * t + i;
                    const bool valid = (k <= sbase) && (k >= kmin);
                    const float v = valid ? __builtin_fmaf(slope, (float)k, sacc[t][i] + nsb) : -INFINITY; sacc[t][i] = v; mx = fmaxf(mx, v); }
            mx = fmaxf(mx, shx(mx, 16, lane)); mx = fmaxf(mx, shx(mx, 32, lane));
            float lsum = 0.f;
#pragma unroll
            for (int t = 0; t < 10; ++t)
#pragma unroll
                for (int i = 0; i < 4; ++i) { const float pv = __expf(sacc[t][i] - mx); sacc[t][i] = pv; lsum += pv; }
            lsum += shx(lsum, 16, lane); lsum += shx(lsum, 32, lane);
            bf16x8 pf[5];
#pragma unroll
            for (int kt = 0; kt < 5; ++kt) pf[kt] = pack8(sacc[2 * kt], sacc[2 * kt + 1]);
            f32x4 o[8];
            {
                const LAS bf16* vl = Vs + (4 * g4 + qq) * KLD + 32 * pp;
                bf16x4 va[10], vcc[10];
#pragma unroll
                for (int q = 0; q < 10; ++q) va[q] = tr4(vl + ATT_PROW(ws0 + 16 * q) * KLD);
#pragma unroll
                for (int et = 0; et < 8; et += 2) {
#pragma unroll
                    for (int q = 0; q < 10; ++q) vcc[q] = tr4(vl + ATT_PROW(ws0 + 16 * q) * KLD + 4 * (et + 1));
                    __builtin_amdgcn_sched_barrier(0);
                    o[et] = (f32x4){0.f, 0.f, 0.f, 0.f};
#pragma unroll
                    for (int kt = 0; kt < 5; ++kt) o[et] = MFMA16(cat8(va[2 * kt], va[2 * kt + 1]), pf[kt], o[et]);
                    if (et + 2 < 8) {
#pragma unroll
                        for (int q = 0; q < 10; ++q) va[q] = tr4(vl + ATT_PROW(ws0 + 16 * q) * KLD + 4 * (et + 2)); }
                    __builtin_amdgcn_sched_barrier(0);
                    o[et + 1] = (f32x4){0.f, 0.f, 0.f, 0.f};
#pragma unroll
                    for (int kt = 0; kt < 5; ++kt) o[et + 1] = MFMA16(cat8(vcc[2 * kt], vcc[2 * kt + 1]), pf[kt], o[et + 1]);
                }
            }
#undef ATT_PROW
            const float inv = 1.0f / lsum;
            bf16* orow = og + ((size_t)g * T + qrow) * D + h * 128 + 32 * g4;
#pragma unroll
            for (int e2 = 0; e2 < 4; ++e2) *(u32x4*)(orow + 8 * e2) = pack_bf16x8(o[2 * e2] * inv, o[2 * e2 + 1] * inv);
            if (g4 == 0) lse[((size_t)g * T + qrow) * AH + h] = mx + __logf(lsum);
            __syncthreads();
        }
    }
#undef ATT_LOADBLK
#undef ATT_STOREBLK
}
__device__ __forceinline__ void phase_attn_combine(const Frame& F) {
    const bf16* og = (const bf16*)(F.ws + WS_AUX); const float* lse = (const float*)(F.ws + WS_AUX + AUX_LSE); bf16* ob = (bf16*)(F.ws + WS_AUX + AUX_OB);
    const int lane = F.lane, gw = F.vcu * NWAVES + F.wave, NGW = F.G * NWAVES, h = lane >> 3;
    for (int row = gw; row < T; row += NGW) {
        const float l0 = lse[((size_t)0 * T + row) * AH + h], l1 = lse[((size_t)1 * T + row) * AH + h], l2 = lse[((size_t)2 * T + row) * AH + h];
        const float m = fmaxf(l0, fmaxf(l1, l2)); float w0 = __expf(l0 - m), w1 = __expf(l1 - m), w2 = __expf(l2 - m); const float inv = 1.0f / (w0 + w1 + w2); w0 *= inv; w1 *= inv; w2 *= inv;
        float a[16];
#pragma unroll
        for (int j = 0; j < 16; ++j) a[j] = 0.f;
#pragma unroll
        for (int g = 0; g < 3; ++g) { const float wg = (g == 0) ? w0 : (g == 1 ? w1 : w2);
#pragma unroll
            for (int q = 0; q < 2; ++q) { const u32x4 s = *(const u32x4*)(og + ((size_t)g * T + row) * D + 16 * lane + 8 * q);
                a[8 * q + 0] += wg * bflo(s.x); a[8 * q + 1] += wg * bfhi(s.x); a[8 * q + 2] += wg * bflo(s.y); a[8 * q + 3] += wg * bfhi(s.y);
                a[8 * q + 4] += wg * bflo(s.z); a[8 * q + 5] += wg * bfhi(s.z); a[8 * q + 6] += wg * bflo(s.w); a[8 * q + 7] += wg * bfhi(s.w); } }
        { u32x4 o;
#pragma unroll
          for (int q = 0; q < 4; ++q) o[q] = pk4_fp8(a[4 * q] * A_SCALE, a[4 * q + 1] * A_SCALE, a[4 * q + 2] * A_SCALE, a[4 * q + 3] * A_SCALE);
          *(u32x4*)((unsigned char*)ob + (size_t)row * D + 16 * lane) = o; }
    }
}

constexpr size_t BIG_YRET = 192 * MiB;
__device__ __forceinline__ void phase_ret_u(const Frame& F) {
    const bf16* proj = (const bf16*)(F.ws + WS_BIG); bf16* St = (bf16*)(F.ws + WS_AUX);
    constexpr int LD = 264;
    LAS bf16* Kt = (LAS bf16*)F.lds; LAS bf16* Vt = Kt + 128 * LD;
    const int lane = F.lane, w = F.wave, g4 = lane >> 4, l15 = lane & 15, qq = l15 >> 2, pp = lane & 3;
    u32x4 kr[8], vr[8];
#define RU_LOAD(u_) do { const int eh_ = (u_) & 1, h_ = ((u_) >> 1) & 3, n_ = ((u_) >> 3) & 63, b_ = (u_) >> 9; const char* pb_ = (const char*)(proj + ((size_t)b_ * SEQ + (size_t)n_ * RC) * RET_IN); \
        int t_ = F.tid; asm volatile("" : "+v"(t_)); unsigned off_ = (unsigned)(((t_ >> 5) * RET_IN + (t_ & 31) * 8) * 2); \
        _Pragma("unroll") for (int it = 0; it < 8; ++it) { asm volatile("" : "+v"(off_)); kr[it] = *(const u32x4*)(pb_ + (size_t)(1024 + h_ * 256 + it * 16 * RET_IN) * 2 + off_); \
            vr[it] = *(const u32x4*)(pb_ + (size_t)(2048 + h_ * 512 + eh_ * 256 + it * 16 * RET_IN) * 2 + off_); } } while (0)
    if (F.vcu < 1024) RU_LOAD(F.vcu);
    for (int u = F.vcu; u < 1024; u += F.G) {
        const int eh = u & 1, h = (u >> 1) & 3, n = (u >> 3) & 63, b = u >> 9;
        { int t_ = F.tid; asm volatile("" : "+v"(t_));
#pragma unroll
          for (int it = 0; it < 8; ++it) { const int idx = t_ + 512 * it, j = idx >> 5, ch = idx & 31; *(LAS u32x4*)(Kt + j * LD + ch * 8) = kr[it]; *(LAS u32x4*)(Vt + j * LD + ch * 8) = vr[it]; } }
        __syncthreads();
        f32x4 acc[16][2];
#pragma unroll
        for (int mt = 0; mt < 16; ++mt) { acc[mt][0] = (f32x4){0.f, 0.f, 0.f, 0.f}; acc[mt][1] = (f32x4){0.f, 0.f, 0.f, 0.f}; }
#pragma unroll
        for (int ks = 0; ks < 4; ++ks) {
            bf16x8 bfr[2];
#pragma unroll
            for (int nt = 0; nt < 2; ++nt) { const LAS bf16* a0 = Vt + (32 * ks + 8 * g4 + qq) * LD + 32 * w + 16 * nt + 4 * pp; bfr[nt] = cat8(tr4(a0), tr4(a0 + 4 * LD)); }
#pragma unroll
            for (int mt = 0; mt < 16; ++mt) { const LAS bf16* a0 = Kt + (32 * ks + 8 * g4 + qq) * LD + 128 * (mt >> 3) + 32 * pp + 4 * (mt & 7);
                const bf16x8 afr = cat8(tr4(a0), tr4(a0 + 4 * LD));
                acc[mt][0] = MFMA16(afr, bfr[0], acc[mt][0]); acc[mt][1] = MFMA16(afr, bfr[1], acc[mt][1]); }
        }
        { const int un = (u + F.G < 1024) ? u + F.G : u; RU_LOAD(un); }
        bf16* outb = St + ((size_t)((b * RH + h) * RNC + n)) * (RDV * RDK);
#pragma unroll
        for (int nt = 0; nt < 2; ++nt) { bf16* orow = outb + (size_t)(eh * 256 + 32 * w + 16 * nt + l15) * RDK + 32 * g4;
#pragma unroll
            for (int mh = 0; mh < 2; ++mh)
#pragma unroll
                for (int q = 0; q < 4; ++q) *(u32x4*)(orow + 128 * mh + 8 * q) = pack_bf16x8(acc[mh * 8 + 2 * q][nt], acc[mh * 8 + 2 * q + 1][nt]); }
        __syncthreads();
    }
#undef RU_LOAD
}
__device__ __forceinline__ void phase_ret_scan(const Frame& F) {
    bf16* St = (bf16*)(F.ws + WS_AUX);
    for (int gt = F.vcu * NTHREADS + F.tid; gt < 8 * 16384; gt += F.G * NTHREADS) {
        const int bh = gt >> 14, chunk = gt & 16383, h = bh & 3;
        const float g128 = exp2f(128.0f * log2f(1.0f - exp2f(-5.0f - (float)h)));
        bf16* base = St + (size_t)bh * RNC * (RDV * RDK) + (size_t)chunk * 8;
        float c[8];
#pragma unroll
        for (int j = 0; j < 8; ++j) c[j] = 0.f;
#pragma unroll 8
        for (int n = 0; n < RNC; ++n) { bf16* pn = base + (size_t)n * (RDV * RDK); const u32x4 uv = *(const u32x4*)pn;
            u32x4 o; o.x = pk2(c[0], c[1]); o.y = pk2(c[2], c[3]); o.z = pk2(c[4], c[5]); o.w = pk2(c[6], c[7]); *(u32x4*)pn = o;
            c[0] = g128 * (c[0] + bflo(uv.x)); c[1] = g128 * (c[1] + bfhi(uv.x)); c[2] = g128 * (c[2] + bflo(uv.y)); c[3] = g128 * (c[3] + bfhi(uv.y));
            c[4] = g128 * (c[4] + bflo(uv.z)); c[5] = g128 * (c[5] + bfhi(uv.z)); c[6] = g128 * (c[6] + bflo(uv.w)); c[7] = g128 * (c[7] + bfhi(uv.w)); }
    }
}
__device__ __forceinline__ void phase_ret_out(const Frame& F, KP p) {
    const bf16* proj = (const bf16*)(F.ws + WS_BIG); const bf16* St = (const bf16*)(F.ws + WS_AUX); bf16* yret = (bf16*)(F.ws + WS_BIG + BIG_YRET);
    const float* gng = gin(p, 4); const float* gnb = gin(p, 5);
    constexpr int LD = 264, VLD = 72, NSL = 8, ESL = 64;
    LAS bf16* Rs = (LAS bf16*)F.lds; LAS bf16* Vs = Rs + 128 * LD;
    const int w = F.wave;
#define RO_TID(t_) int t_ = F.tid; asm volatile("" : "+v"(t_))
#define RO_LD(base_, off_) (*(const u32x4*)((const char*)(base_) + (off_)))
    for (int u = F.vcu; u < 512; u += F.G) {
        const int h = u & 3, n = (u >> 2) & 63, b = u >> 8;
        const size_t row0 = (size_t)b * SEQ + (size_t)n * RC;
        const bf16* Sn = St + ((size_t)((b * RH + h) * RNC + n)) * (RDV * RDK);
        const char* pbase = (const char*)(proj + row0 * RET_IN);
        u32x4 pv[2], ps[4];
        bf16x8 qf[8];
        { RO_TID(t0); u32x4 kreg[8];
          unsigned koff = (unsigned)(((t0 >> 5) * RET_IN + (t0 & 31) * 8) * 2), qoff = (unsigned)(((16 * w + (t0 & 15)) * RET_IN + 8 * ((t0 & 63) >> 4)) * 2);
#pragma unroll
          for (int it = 0; it < 8; ++it) { asm volatile("" : "+v"(koff)); kreg[it] = RO_LD(pbase + (size_t)(1024 + h * 256 + it * 16 * RET_IN) * 2, koff); }
#pragma unroll
          for (int s = 0; s < 8; ++s) { asm volatile("" : "+v"(qoff)); qf[s] = __builtin_bit_cast(bf16x8, RO_LD(pbase + (size_t)(h * 256 + 32 * s) * 2, qoff)); }
#define RO_LOAD_SLICE(sl_) do { RO_TID(tl_); unsigned voff = (unsigned)(((tl_ >> 3) * RET_IN + (tl_ & 7) * 8) * 2), soff = (unsigned)(((tl_ >> 5) * RDK + (tl_ & 31) * 8) * 2); \
            _Pragma("unroll") for (int it = 0; it < 2; ++it) { asm volatile("" : "+v"(voff)); pv[it] = RO_LD(pbase + (size_t)(2048 + h * 512 + (sl_) * ESL + it * 64 * RET_IN) * 2, voff); } \
            _Pragma("unroll") for (int it = 0; it < 4; ++it) { asm volatile("" : "+v"(soff)); ps[it] = RO_LD((const char*)Sn + (size_t)(((sl_) * ESL + it * 16) * RDK) * 2, soff); } } while (0)
          RO_LOAD_SLICE(0);
#pragma unroll
          for (int it = 0; it < 8; ++it) { const int idx = t0 + 512 * it, j = idx >> 5, ch = idx & 31; *(LAS u32x4*)(Rs + j * LD + ch * 8) = kreg[it]; } }
        __syncthreads();
        bf16x8 pf[4];
        { RO_TID(t1); const int lane = t1 & 63, g4 = lane >> 4, irow = 16 * w + (lane & 15);
          f32x4 sacc[8];
#pragma unroll
            for (int jt = 0; jt < 8; ++jt) { sacc[jt] = (f32x4){0.f, 0.f, 0.f, 0.f};
                if (jt <= w) {
#pragma unroll
                    for (int s = 0; s < 8; ++s) sacc[jt] = MFMA16(row_frag(Rs, LD, 16 * jt, 32 * s, lane), qf[s], sacc[jt]);
#pragma unroll
                    for (int i = 0; i < 4; ++i) if (16 * jt + 4 * g4 + i > irow) sacc[jt][i] = 0.f; } }
#pragma unroll
            for (int kt = 0; kt < 4; ++kt) pf[kt] = pack8(sacc[2 * kt], sacc[2 * kt + 1]); }
        __syncthreads();
        u32x4 accp[NSL][2];
        float s1 = 0.f, s2 = 0.f;
#pragma unroll
        for (int sl = 0; sl < NSL; ++sl) {
            { RO_TID(t2);
#pragma unroll
              for (int it = 0; it < 2; ++it) { const int idx = t2 + 512 * it, j = idx >> 3, ch = idx & 7; *(LAS u32x4*)(Vs + j * VLD + ch * 8) = pv[it]; }
#pragma unroll
              for (int it = 0; it < 4; ++it) { const int idx = t2 + 512 * it, e = idx >> 5, ch = idx & 31; *(LAS u32x4*)(Rs + e * LD + ch * 8) = ps[it]; } }
            __syncthreads();
            if (sl + 1 < NSL) RO_LOAD_SLICE(sl + 1);
            RO_TID(t3); const int lane = t3 & 63, g4 = lane >> 4, qq = (lane & 15) >> 2, pp = lane & 3;
            f32x4 acc[4];
#pragma unroll
            for (int et = 0; et < 4; ++et) { f32x4 a = (f32x4){0.f, 0.f, 0.f, 0.f};
#pragma unroll
                for (int kt = 0; kt < 4; ++kt) if (2 * kt <= w) { const LAS bf16* a0 = Vs + (32 * kt + 4 * g4 + qq) * VLD + 16 * pp + 4 * et;
                    a = MFMA16(cat8(tr4(a0), tr4(a0 + 16 * VLD)), pf[kt], a); }
                const LAS bf16* srow = Rs + (16 * qq + 4 * et + pp) * LD + 8 * g4;
#pragma unroll
                for (int s = 0; s < 8; ++s) a = MFMA16(*(const LAS bf16x8*)(srow + 32 * s), qf[s], a);
                acc[et] = a; s1 += (a[0] + a[1]) + (a[2] + a[3]); s2 += (a[0] * a[0] + a[1] * a[1]) + (a[2] * a[2] + a[3] * a[3]);
                __builtin_amdgcn_sched_barrier(0); }
            accp[sl][0] = pack_bf16x8(acc[0], acc[1]); accp[sl][1] = pack_bf16x8(acc[2], acc[3]);
            __syncthreads();
        }
#undef RO_LOAD_SLICE
        RO_TID(t4); const int lane = t4 & 63, g4 = lane >> 4, irow = 16 * w + (lane & 15); const size_t qrow = row0 + irow;
        s1 += shx(s1, 16, lane); s1 += shx(s1, 32, lane); s2 += shx(s2, 16, lane); s2 += shx(s2, 32, lane);
        const float mean = s1 * (1.0f / RDV); const float var = fmaxf(s2 * (1.0f / RDV) - mean * mean, 0.f);
        const float rstd = 1.0f / sqrtf(var + LN_EPS);
        unsigned goff = (unsigned)((irow * RET_IN + 16 * g4) * 2);
#pragma unroll
        for (int sp = 0; sp < NSL; sp += 2) {
            u32x4 gq[2][2]; f32x4 gg[2][4], gb[2][4];
#pragma unroll
            for (int d2 = 0; d2 < 2; ++d2) { const int c0 = h * RDV + (sp + d2) * ESL + 16 * g4;
#pragma unroll
                for (int q = 0; q < 2; ++q) { asm volatile("" : "+v"(goff)); gq[d2][q] = RO_LD(pbase + (size_t)(4096 + h * RDV + (sp + d2) * ESL + 8 * q) * 2, goff); }
#pragma unroll
                for (int q = 0; q < 4; ++q) { gg[d2][q] = *(const f32x4*)(gng + c0 + 4 * q); gb[d2][q] = *(const f32x4*)(gnb + c0 + 4 * q); } }
#pragma unroll
            for (int d2 = 0; d2 < 2; ++d2) { const int c0 = h * RDV + (sp + d2) * ESL + 16 * g4; u32x4 o8;
#pragma unroll
                for (int q = 0; q < 2; ++q) { const u32x4 gw = gq[d2][q]; f32x4 a0, a1; unpack_bf16x8(accp[sp + d2][q], a0, a1);
                    f32x4 y0 = (a0 - mean) * rstd * gg[d2][2 * q] + gb[d2][2 * q], y1 = (a1 - mean) * rstd * gg[d2][2 * q + 1] + gb[d2][2 * q + 1];
                    const float gv[8] = {bflo(gw.x), bfhi(gw.x), bflo(gw.y), bfhi(gw.y), bflo(gw.z), bfhi(gw.z), bflo(gw.w), bfhi(gw.w)};
#pragma unroll
                    for (int j = 0; j < 4; ++j) { y0[j] *= gv[j] * fsig(gv[j]) * A_SCALE; y1[j] *= gv[4 + j] * fsig(gv[4 + j]) * A_SCALE; }
                    o8[2 * q] = pk4_fp8(y0[0], y0[1], y0[2], y0[3]); o8[2 * q + 1] = pk4_fp8(y1[0], y1[1], y1[2], y1[3]); }
                *(u32x4*)((unsigned char*)yret + qrow * RET_V + c0) = o8; }
        }
    }
#undef RO_LD
#undef RO_TID
}

constexpr size_t AUX_S5E = 64 * MiB;
constexpr int S5L = 256, S5NC = SEQ / S5L;
__device__ __forceinline__ void cmul_add(float& rr, float& ri, float ar, float ai, float xr, float xi, float cr, float ci) { rr = ar * xr - ai * xi + cr; ri = ar * xi + ai * xr + ci; }
template <bool OUT>
__device__ __forceinline__ void phase_s5_scan(const Frame& F, KP p) {
    const bf16* X = (const bf16*)(F.ws + WS_XB); float* E = (float*)(F.ws + WS_AUX + AUX_S5E); bf16* ybuf = (bf16*)(F.ws + WS_AUX);
    const int lane = F.lane, w = F.wave, g4 = lane >> 4, l15 = lane & 15;
    LAS bf16* ut = (LAS bf16*)(F.lds + w * 12288);
    LAS bf16* Hb = (LAS bf16*)(F.lds + w * 12288 + 4096);
    constexpr int HLD = 136;
    const int gw = F.vcu * NWAVES + w, NGW = F.G * NWAVES;
    const int up16 = (lane - 16) << 2, up32 = (lane - 32) << 2, last16 = (48 + l15) << 2;
    for (int unit = gw; unit < BATCH * SG * S5NC; unit += NGW) {
        const int n = unit & (S5NC - 1), g = (unit >> 5) & 63, b = unit >> 11;
        float a1r[4], a1i[4], a4r[4], a4i[4], a8r[4], a8i[4], pwr[4], pwi[4];
        bf16x8 bfrag[8];
        const float dt = expf(gin(p, 14)[g]);
#pragma unroll
        for (int st = 0; st < 4; ++st) { const int ps = 16 * st + l15;
            const float are = gin(p, 7)[g * SP + ps], aim = gin(p, 8)[g * SP + ps];
            const float mag = expf(dt * are); const float abr = mag * cosf(dt * aim), abi = mag * sinf(dt * aim);
            const float den = are * are + aim * aim;
            const float fre = ((abr - 1.0f) * are + abi * aim) / den, fim = (abi * are - (abr - 1.0f) * aim) / den;
            a1r[st] = abr; a1i[st] = abi; { float t2r, t2i; cmul_add(t2r, t2i, abr, abi, abr, abi, 0.f, 0.f); cmul_add(a4r[st], a4i[st], t2r, t2i, t2r, t2i, 0.f, 0.f); }
            cmul_add(a8r[st], a8i[st], a4r[st], a4i[st], a4r[st], a4i[st], 0.f, 0.f);
            float qr = 1.f, qi = 0.f;
            if (g4 & 1) { qr = a4r[st]; qi = a4i[st]; }
            if (g4 & 2) { float tr, ti; cmul_add(tr, ti, qr, qi, a8r[st], a8i[st], 0.f, 0.f); qr = tr; qi = ti; }
            pwr[st] = qr; pwi[st] = qi;
            const float* br = gin(p, 9) + ((size_t)g * SP + ps) * SGC + 8 * (g4 & 1); const float* bi = gin(p, 10) + ((size_t)g * SP + ps) * SGC + 8 * (g4 & 1);
            const f32x4 r0 = *(const f32x4*)br, r1 = *(const f32x4*)(br + 4), i0 = *(const f32x4*)bi, i1 = *(const f32x4*)(bi + 4);
            const float z = (g4 < 2) ? 1.0f : 0.0f; const float fr2 = fre * z, fi2 = fim * z;
            bfrag[st] = pack8(r0 * fr2 - i0 * fi2, r1 * fr2 - i1 * fi2); bfrag[st + 4] = pack8(i0 * fr2 + r0 * fi2, i1 * fr2 + r1 * fi2);
        }
        float sr[4], si[4];
        float* Eu = E + ((size_t)(b * SG + g) * S5NC + n) * 128;
        bf16x8 cf[4]; f32x4 dsk = (f32x4){0.f, 0.f, 0.f, 0.f};
#pragma unroll
        for (int st = 0; st < 4; ++st) { sr[st] = 0.f; si[st] = 0.f; }
        if (OUT) {
#pragma unroll
            for (int st = 0; st < 4; ++st) { sr[st] = Eu[16 * st + l15]; si[st] = Eu[64 + 16 * st + l15]; }
#pragma unroll
            for (int s = 0; s < 4; ++s) { const float* cp = (s < 2 ? gin(p, 11) : gin(p, 12)) + ((size_t)g * SGC + l15) * SP + 32 * (s & 1) + 8 * g4; const float sg = s < 2 ? 1.0f : -1.0f;
                const f32x4 c0 = *(const f32x4*)cp * sg, c1 = *(const f32x4*)(cp + 4) * sg; cf[s] = pack8(c0, c1); }
            dsk = *(const f32x4*)(gin(p, 13) + g * SGC + 4 * g4); }
        const size_t tok0 = (size_t)b * SEQ + (size_t)n * S5L;
        u32x4 pre[2];
        { const bf16* src = X + (tok0 + lane) * D + g * SGC; pre[0] = *(const u32x4*)src; pre[1] = *(const u32x4*)(src + 8); }
        for (int sub = 0; sub < S5L / 64; ++sub) {
            *(LAS u32x4*)(ut + lane * 16) = pre[0]; *(LAS u32x4*)(ut + lane * 16 + 8) = pre[1];
            if (sub + 1 < S5L / 64) { const bf16* src = X + (tok0 + (sub + 1) * 64 + lane) * D + g * SGC; pre[0] = *(const u32x4*)src; pre[1] = *(const u32x4*)(src + 8); }
            LDS_WAIT(); asm volatile("" ::: "memory");
#pragma unroll (OUT ? 1 : 4)
            for (int blk = 0; blk < 4; ++blk) {
                u32x4 uw = *(const LAS u32x4*)(ut + (blk * 16 + l15) * 16 + 8 * (g4 & 1));
                if (g4 >= 2) uw = (u32x4){0u, 0u, 0u, 0u};
                const bf16x8 ufr = __builtin_bit_cast(bf16x8, uw);
                f32x4 dr[4], di[4];
#pragma unroll
                for (int st = 0; st < 4; ++st) { dr[st] = MFMA16(ufr, bfrag[st], ((f32x4){0.f, 0.f, 0.f, 0.f})); di[st] = MFMA16(ufr, bfrag[st + 4], ((f32x4){0.f, 0.f, 0.f, 0.f})); }
                float vr[4], vi[4];
#pragma unroll
                for (int st = 0; st < 4; ++st) {
                    float hr = 0.f, hi = 0.f;
#pragma unroll
                    for (int i = 0; i < 4; ++i) { float nr, ni; cmul_add(nr, ni, a1r[st], a1i[st], hr, hi, dr[st][i], di[st][i]); hr = nr; hi = ni; dr[st][i] = hr; di[st][i] = hi; }
                    vr[st] = hr; vi[st] = hi; }
#define BPF(idx, v) __builtin_bit_cast(float, __builtin_amdgcn_ds_bpermute((idx), __builtin_bit_cast(int, (v))))
                { float xr[4], xi[4];
#pragma unroll
                  for (int st = 0; st < 4; ++st) { xr[st] = BPF(up16, vr[st]); xi[st] = BPF(up16, vi[st]); }
#pragma unroll
                  for (int st = 0; st < 4; ++st) { float tr, ti; cmul_add(tr, ti, a4r[st], a4i[st], xr[st], xi[st], vr[st], vi[st]); if (g4 >= 1) { vr[st] = tr; vi[st] = ti; } }
#pragma unroll
                  for (int st = 0; st < 4; ++st) { xr[st] = BPF(up32, vr[st]); xi[st] = BPF(up32, vi[st]); }
#pragma unroll
                  for (int st = 0; st < 4; ++st) { float tr, ti; cmul_add(tr, ti, a8r[st], a8i[st], xr[st], xi[st], vr[st], vi[st]); if (g4 >= 2) { vr[st] = tr; vi[st] = ti; } } }
                float er[4], ei[4], lr[4], li[4];
#pragma unroll
                for (int st = 0; st < 4; ++st) { if (OUT) { er[st] = BPF(up16, vr[st]); ei[st] = BPF(up16, vi[st]); } else { er[st] = 0.f; ei[st] = 0.f; } lr[st] = BPF(last16, vr[st]); li[st] = BPF(last16, vi[st]); }
#undef BPF
#pragma unroll
                for (int st = 0; st < 4; ++st) {
                    if (g4 == 0) { er[st] = 0.f; ei[st] = 0.f; }
                    if (OUT) { float s0r, s0i; cmul_add(s0r, s0i, pwr[st], pwi[st], sr[st], si[st], er[st], ei[st]);
#pragma unroll
                        for (int i = 0; i < 4; ++i) { float tr, ti; cmul_add(tr, ti, a1r[st], a1i[st], s0r, s0i, 0.f, 0.f); s0r = tr; s0i = ti; dr[st][i] += s0r; di[st][i] += s0i; } }
                    { float a16r, a16i; cmul_add(a16r, a16i, a8r[st], a8i[st], a8r[st], a8i[st], 0.f, 0.f); float tr, ti; cmul_add(tr, ti, a16r, a16i, sr[st], si[st], lr[st], li[st]); sr[st] = tr; si[st] = ti; }
                    if (OUT) {
#pragma unroll
                        for (int i = 0; i < 4; ++i) { const unsigned hw = pk2(dr[st][i], di[st][i]); Hb[(4 * g4 + i) * HLD + 16 * st + l15] = (bf16)hw; Hb[(4 * g4 + i) * HLD + 64 + 16 * st + l15] = (bf16)(hw >> 16); } }
                }
                if (OUT) {
                    LDS_WAIT(); asm volatile("" ::: "memory");
                    f32x4 ya = (f32x4){0.f, 0.f, 0.f, 0.f};
#pragma unroll
                    for (int s = 0; s < 4; ++s) ya = MFMA16(cf[s], row_frag(Hb, HLD, 0, 32 * s, lane), ya);
                    const u32x2 u2 = *(const LAS u32x2*)(ut + (blk * 16 + l15) * 16 + 4 * g4);
                    const f32x4 u4 = (f32x4){bflo(u2.x), bfhi(u2.x), bflo(u2.y), bfhi(u2.y)};
                    f32x4 y = ya + dsk * u4;
#pragma unroll
                    for (int j = 0; j < 4; ++j) { const float v = y[j]; y[j] = v * fsig(1.5957691216057308f * (v + 0.044715f * v * v * v)); }
                    *(unsigned*)((unsigned char*)ybuf + (size_t)(tok0 + sub * 64 + blk * 16 + l15) * D + g * SGC + 4 * g4) = pk4_fp8(y[0] * A_SCALE, y[1] * A_SCALE, y[2] * A_SCALE, y[3] * A_SCALE);
                    asm volatile("" ::: "memory"); }
            }
            LDS_WAIT(); asm volatile("" ::: "memory");
        }
        if (!OUT && g4 == 0) {
#pragma unroll
            for (int st = 0; st < 4; ++st) { Eu[16 * st + l15] = sr[st]; Eu[64 + 16 * st + l15] = si[st]; } }
    }
}
__device__ __forceinline__ void phase_s5_carry(const Frame& F, KP p) {
    float* E = (float*)(F.ws + WS_AUX + AUX_S5E);
    for (int gt = F.vcu * NTHREADS + F.tid; gt < BATCH * SG * SP; gt += F.G * NTHREADS) {
        const int pl = gt & 63, bg = gt >> 6, g = bg & 63;
        const float dt = expf(gin(p, 14)[g]); const float are = gin(p, 7)[g * SP + pl], aim = gin(p, 8)[g * SP + pl];
        const float mag = expf(dt * are); float ar = mag * cosf(dt * aim), ai = mag * sinf(dt * aim);
#pragma unroll
        for (int q = 0; q < 8; ++q) { const float nr = ar * ar - ai * ai, ni = 2.0f * ar * ai; ar = nr; ai = ni; }
        float cr = 0.f, ci = 0.f;
        for (int n = 0; n < S5NC; ++n) { float* Eu = E + ((size_t)bg * S5NC + n) * 128; const float er = Eu[pl], ei = Eu[64 + pl];
            Eu[pl] = cr; Eu[64 + pl] = ci;
            const float nr = ar * cr - ai * ci + er, ni = ar * ci + ai * cr + ei; cr = nr; ci = ni; }
    }
}

constexpr int NPHASES = 34;
#ifndef PROBE_DRY14
#define PROBE_DRY14 0
#endif
#ifndef PROBE_DRY17
#define PROBE_DRY17 0
#endif
#ifndef PH_MASK
#define PH_MASK 0xFFFFFFFFu
#endif
#define PHT(t) ((PH_MASK >> (t)) & 1u)
constexpr int PLAN_OFF = 64;
__device__ __forceinline__ void moe_plan(const Frame& F, int layer) {
    volatile LAS int* tstart = (volatile LAS int*)(F.MISC + PLAN_OFF); volatile LAS int* cnts = tstart + 72;
    __syncthreads();
    if (F.wave == 0) {
        const unsigned* cnt = (const unsigned*)(F.ws + WS_CTL) + CW_CNT + layer * NE * 64;
        const int c = (int)__hip_atomic_load(cnt + F.lane * 64, __ATOMIC_RELAXED, __HIP_MEMORY_SCOPE_AGENT);
        int v = (c + 255) >> 8;
#pragma unroll
        for (int o = 1; o < 64; o <<= 1) { const int nb = __builtin_amdgcn_ds_bpermute((F.lane - o) << 2, v); if (F.lane >= o) v += nb; }
        tstart[F.lane + 1] = v; cnts[F.lane] = c;
        if (F.lane == 0) tstart[0] = 0;
        if (F.lane == 63) { tstart[65] = v + T / 256; cnts[64] = T; }
    }
    __syncthreads();
}
template <bool GATH> struct MoeSched2 {
    static constexpr bool GATHER = GATH, UNIFORMIZE = true, FP8 = true;
    static constexpr int ncol = GATH ? 2 : 4, K = GATH ? D / 2 : ED / 2;
    const volatile LAS int* tstart; const volatile LAS int* cnts; int ntiles, G, c, lane;
    const char* Abase; const char* Wbase; const int* lists;
    __device__ __forceinline__ bool next(int i, pg8::UnitG& u) const {
        const int nwg = ntiles * ncol; const long L = (long)i * G + c; if (L >= nwg) return false;
        int wgid = (int)L; { const int q = nwg / 8, r = nwg % 8, xcd = wgid % 8, off = wgid / 8; wgid = (xcd < r ? xcd * (q + 1) : r * (q + 1) + (xcd - r) * q) + off; }
        const int tile = wgid / ncol, pn = wgid % ncol;
        int ln; { unsigned o2 = ~0u; asm volatile("" : "+s"(o2)); ln = (int)__builtin_amdgcn_mbcnt_hi(o2, __builtin_amdgcn_mbcnt_lo(o2, 0u)); }
        const int ta = tstart[ln], tb = tstart[ln + 1];
        const unsigned long long mm = __ballot(ta <= tile && tile < tb);
        const int e = mm ? (int)__builtin_ctzll(mm) : 64;
        const int ts = __builtin_amdgcn_readfirstlane((int)tstart[e]), ce = __builtin_amdgcn_readfirstlane((int)cnts[e]);
        const int lt = tile - ts; int valid = ce - lt * 256; valid = valid > 256 ? 256 : valid;
        u.gshift = 0; u.aux = e;
        if (GATH) {
            u.B = Wbase + (size_t)e * WMOE_E_BYTES + (size_t)pn * 256 * K * 2;
            if (e < 64) { u.A = Abase; u.gidx = lists + (size_t)e * T + lt * 256; u.gcnt = valid; }
            else { u.A = Abase + (size_t)lt * 256 * K * 2; u.gidx = nullptr; u.gcnt = 0; }
            u.row0 = tile * 256; u.col0 = pn * 128;
        } else {
            u.B = Wbase + (size_t)e * WMOE_E_BYTES + (size_t)512 * 1024 * 2 + (size_t)pn * 256 * K * 2;
            u.A = Abase + (size_t)tile * 256 * K * 2; u.gidx = nullptr; u.gcnt = valid;
            u.row0 = tile * 256; u.col0 = pn * 256;
        }
        return true;
    }
};
__device__ __forceinline__ void phase_load_x(const Frame& F, KP p) {
    const float* xin = gin(p, 0); bf16* XB = (bf16*)(F.ws + WS_XB);
    for (size_t i = (size_t)F.vcu * NTHREADS + F.tid; i < (size_t)T * D / 8; i += (size_t)F.G * NTHREADS) {
        const f32x4 a = *(const f32x4*)(xin + i * 8), b = *(const f32x4*)(xin + i * 8 + 4);
        *(u32x4*)(XB + i * 8) = pack_bf16x8(a, b);
        u32x2 q8; q8.x = pk4_fp8(a[0], a[1], a[2], a[3]); q8.y = pk4_fp8(b[0], b[1], b[2], b[3]); *(u32x2*)((unsigned char*)(F.ws + WS_X) + i * 8) = q8; }
}

__global__ void __launch_bounds__(NTHREADS, 2) fwd_kernel(Params p_unused) {
    KP p0 = (KP)__builtin_amdgcn_kernarg_segment_ptr();
    extern __shared__ __attribute__((aligned(16))) unsigned char lds_raw[];
    Frame F0;
    F0.lds = (LAS unsigned char*)lds_raw; F0.MISC = (volatile LAS unsigned*)(F0.lds + MISC_OFF);
    F0.tid = threadIdx.x; F0.lane = F0.tid & 63; F0.wave = __builtin_amdgcn_readfirstlane(F0.tid >> 6);
    F0.G = gridDim.x; { const int bq = blockIdx.x; F0.vcu = (F0.G % 8 == 0) ? (bq % 8) * (F0.G / 8) + bq / 8 : bq; }
    F0.ws = p0->ws;
    const int bx0 = blockIdx.x;
    for (int u = F0.tid; u < (LDS_BYTES - MISC_OFF) / 4; u += NTHREADS) ((LAS unsigned*)(F0.lds + MISC_OFF))[u] = 0u;
    __syncthreads();
    XcdBarrier bar; bar.bar = (unsigned*)(p0->ws + WS_CTL) + CW_BAR; bar.x = 0; bar.st = nullptr;
    const int use_bar = p0->use_bar;
    if (use_bar) bar = xcd_barrier_post((unsigned*)(p0->ws + WS_CTL) + CW_BAR, F0.MISC + 8);
    const int lo = p0->ph_lo, hi = p0->ph_hi;
#define PHASE_BEGIN Frame F = F0; KP p = p0; { unsigned ones_ = ~0u; asm volatile("" : "+s"(ones_)); F.lane = (int)__builtin_amdgcn_mbcnt_hi(ones_, __builtin_amdgcn_mbcnt_lo(ones_, 0u)); } asm volatile("" : "+v"(F.lane)); F.tid = F.wave * 64 + F.lane; asm volatile("" : "+v"(F.tid));   GAS unsigned char* wsg_ = (GAS unsigned char*)F0.ws; asm volatile("" : "+s"(F.wave), "+s"(F.vcu), "+s"(F.G), "+s"(wsg_), "+s"(p)); \
    F.ws = (unsigned char*)wsg_; int bx = bx0; asm volatile("" : "+s"(bx)); unsigned char* ws = F.ws; (void)ws; (void)bx;
#pragma unroll 1
    for (int ph = lo; ph < hi; ++ph) {
        int layer = 0, type = 0;
        if (ph > 0) { layer = ph >= 26 ? 3 : (ph >= 18 ? 2 : (ph >= 9 ? 1 : 0)); const int q = ph - (layer == 3 ? 26 : (layer == 2 ? 18 : (layer == 1 ? 9 : 1))); const int kind = layer % 3;
            if (kind == 0) type = q < 4 ? 1 + q : 14 + (q - 4); else if (kind == 1) type = q < 5 ? 5 + q : 14 + (q - 5); else type = q < 4 ? 10 + q : 14 + (q - 4); }
        const int j = layer / 3;
#ifdef REPEAT_MASK
        const int nrep = ((REPEAT_MASK >> type) & 1u) ? 2 : 1;
#else
        const int nrep = 1;
#endif
#pragma unroll 1
        for (int rep = 0; rep < nrep; ++rep) {
        if (rep > 0 && use_bar) xcd_barrier(bar);
        if (PHT(0) && type == 0) { PHASE_BEGIN; phase_conv_mixers(F, p); phase_conv_moe(F, p, 0); phase_load_x(F, p); }
        else if (PHT(1) && type == 1) { PHASE_BEGIN; DenseSched8 S; S.init(ws + WS_X, ws + WS_ATT_IN_T + (size_t)j * ATT_IN * D, T, ATT_IN, D / 2, F.G, bx); EpiStoreBf16 E{(bf16*)(ws + WS_BIG), ATT_IN, WUP_INV, 0.08838834764831845f};
            pg8::gemm_phase(F.lds, F.tid, D / 2, S, E); }
        else if (PHT(2) && type == 2) { PHASE_BEGIN; phase_attn(F, bx); }
        else if (PHT(3) && type == 3) { PHASE_BEGIN; phase_attn_combine(F); }
        else if (PHT(4) && type == 4) { PHASE_BEGIN; DenseSched8 S; S.init(ws + WS_AUX + AUX_OB, ws + WS_ATT_OUT_T + (size_t)j * D * D, T, D, D / 2, F.G, bx); EpiResid E{(const bf16*)(ws + WS_XB), (bf16*)(ws + WS_Y), 1.0f / (A_SCALE * WUP_SCALE)};
            pg8::gemm_phase(F.lds, F.tid, D / 2, S, E); }
        else if (PHT(5) && type == 5) { PHASE_BEGIN; DenseSched8 S; S.init(ws + WS_X, ws + WS_RET_IN_T, T, RET_IN, D / 2, F.G, bx); EpiRetIn E{(bf16*)(ws + WS_BIG), RET_IN};
            pg8::gemm_phase(F.lds, F.tid, D / 2, S, E); }
        else if (PHT(6) && type == 6) { PHASE_BEGIN; phase_ret_u(F); }
        else if (PHT(7) && type == 7) { PHASE_BEGIN; phase_ret_scan(F); }
        else if (PHT(8) && type == 8) { PHASE_BEGIN; phase_ret_out(F, p); }
        else if (PHT(9) && type == 9) { PHASE_BEGIN; DenseSched8 S; S.init(ws + WS_BIG + BIG_YRET, ws + WS_RET_OUT_T, T, D, RET_V / 2, F.G, bx); EpiResid E{(const bf16*)(ws + WS_XB), (bf16*)(ws + WS_Y), 1.0f / (A_SCALE * WUP_SCALE)};
            pg8::gemm_phase(F.lds, F.tid, RET_V / 2, S, E); }
        else if (PHT(10) && type == 10) { PHASE_BEGIN; phase_s5_scan<false>(F, p); }
        else if (PHT(11) && type == 11) { PHASE_BEGIN; phase_s5_carry(F, p); }
        else if (PHT(12) && type == 12) { PHASE_BEGIN; phase_s5_scan<true>(F, p); }
        else if (PHT(13) && type == 13) { PHASE_BEGIN; DenseSched8 S; S.init(ws + WS_AUX, ws + WS_GLU_T, T, 2 * D, D / 2, F.G, bx); EpiGluResid E{(const bf16*)(ws + WS_XB), (bf16*)(ws + WS_Y), 1.0f / (A_SCALE * WUP_SCALE)};
            pg8::gemm_phase(F.lds, F.tid, D / 2, S, E); }
        else if (PHT(14) && type == 14) { PHASE_BEGIN; phase_lnr(F, p, layer, PROBE_DRY14 && true); if (PROBE_DRY14) { if (use_bar) xcd_barrier(bar); phase_lnr(F, p, layer, false); } }
        else if (PHT(15) && type == 15) { PHASE_BEGIN; moe_plan(F, layer);
            MoeSched2<true> S; S.tstart = (const volatile LAS int*)(F.MISC + PLAN_OFF); S.cnts = S.tstart + 72; S.ntiles = __builtin_amdgcn_readfirstlane((int)S.tstart[65]); S.G = F.G; S.c = bx; S.lane = F.lane;
            S.Abase = (const char*)(ws + WS_X); S.Wbase = (const char*)(ws + WS_WMOE); S.lists = (const int*)(ws + WS_LIST);
            EpiMoeUp E{(unsigned char*)(ws + WS_H)};
            pg8::gemm_phase(F.lds, F.tid, D / 2, S, E); }
        else if (PHT(16) && type == 16) { PHASE_BEGIN; moe_plan(F, layer);
            { MoeSched2<false> S; S.tstart = (const volatile LAS int*)(F.MISC + PLAN_OFF); S.cnts = S.tstart + 72; S.ntiles = __builtin_amdgcn_readfirstlane((int)S.tstart[64]); S.G = F.G; S.c = bx; S.lane = F.lane;
              S.Abase = (const char*)(ws + WS_H); S.Wbase = (const char*)(ws + WS_WMOE); S.lists = (const int*)(ws + WS_LIST);
              EpiStoreFp8 E{(unsigned char*)(ws + WS_BIG), D};
              pg8::gemm_phase(F.lds, F.tid, ED / 2, S, E); }
            { const int sh0 = __builtin_amdgcn_readfirstlane((int)((const volatile LAS int*)(F.MISC + PLAN_OFF))[64]);
              DenseSched8 S; S.init(ws + WS_H + (size_t)sh0 * 256 * ED, ws + WS_WMOE + (size_t)64 * WMOE_E_BYTES + (size_t)512 * 1024 * 2, T, D, ED / 2, F.G, bx); EpiResid8 E{(const bf16*)(ws + WS_XB), (bf16*)(ws + WS_Y), 1.0f / (H_SCALE * WUP_SCALE)};
              int tid2; { unsigned o2 = ~0u; asm volatile("" : "+s"(o2)); tid2 = F.wave * 64 + (int)__builtin_amdgcn_mbcnt_hi(o2, __builtin_amdgcn_mbcnt_lo(o2, 0u)); }
              pg8::gemm_phase(F.lds, tid2, ED / 2, S, E); } }
        else if (PHT(17) && type == 17) { PHASE_BEGIN; moe_plan(F, layer); if (PROBE_DRY17) { phase_combine(F, p, layer, true); if (use_bar) xcd_barrier(bar); } phase_combine(F, p, layer); if (layer + 1 < DEPTH) phase_conv_moe(F, p, layer + 1); }
        }
        if (use_bar && ph + 1 < hi) xcd_barrier(bar);
    }
}

#ifndef MK_PER_PHASE
#define MK_PER_PHASE 0
#endif
extern "C" void kernel_launch(void* const* d_in, const int* in_sizes, int n_in, void* d_out, int out_size, void* d_ws, size_t ws_size, hipStream_t stream) {
    static int grid = 0;
    if (grid == 0) {
        if (n_in != 26 || in_sizes[0] != T * D || out_size != T * D || ws_size < WS_END) { fprintf(stderr, "kernel_launch: unexpected shapes / workspace (n_in %d, in0 %d, out %d, ws %zu < %zu)\n", n_in, n_in > 0 ? in_sizes[0] : -1, out_size, ws_size, (size_t)WS_END); grid = -1; return; }
        int dev = 0, cus = 0, per_cu = 0;
        if (hipGetDevice(&dev) != hipSuccess || hipDeviceGetAttribute(&cus, hipDeviceAttributeMultiprocessorCount, dev) != hipSuccess) { grid = -1; return; }
        if (hipFuncSetAttribute((const void*)fwd_kernel, hipFuncAttributeMaxDynamicSharedMemorySize, LDS_BYTES) != hipSuccess) { fprintf(stderr, "kernel_launch: hipFuncSetAttribute failed\n"); grid = -1; return; }
        if (hipOccupancyMaxActiveBlocksPerMultiprocessor(&per_cu, (const void*)fwd_kernel, NTHREADS, LDS_BYTES) != hipSuccess || per_cu < 1) { fprintf(stderr, "kernel_launch: occupancy query says %d blocks per CU\n", per_cu); per_cu = 1; }
        (void)hipGetLastError();
        grid = cus;
    }
    if (grid < 0) return;
    (void)hipMemsetAsync((char*)d_ws + WS_CTL, 0, CTL_ZERO_BYTES, stream);
    Params p{};
    for (int i = 0; i < 26; ++i) p.in[i] = (const float*)d_in[i];
    p.out = (float*)d_out; p.ws = (unsigned char*)d_ws;
#if MK_PER_PHASE
    for (int k = 0; k < NPHASES; ++k) { p.ph_lo = k; p.ph_hi = k + 1; p.use_bar = 0; hipLaunchKernelGGL(fwd_kernel, dim3(grid), dim3(NTHREADS), LDS_BYTES, stream, p); }
#else
    p.ph_lo = 0; p.ph_hi = NPHASES; p.use_bar = 1;
    hipLaunchKernelGGL(fwd_kernel, dim3(grid), dim3(NTHREADS), LDS_BYTES, stream, p);
#endif
}
```

```cpp
#include <hip/hip_runtime.h>
#include <cstdio>
#include <cstdint>

#define LAS __attribute__((address_space(3)))
#define GAS __attribute__((address_space(1)))
typedef unsigned short bf16;
typedef short bf16x8 __attribute__((ext_vector_type(8)));
typedef short bf16x4 __attribute__((ext_vector_type(4)));
typedef float f32x4 __attribute__((ext_vector_type(4)));
typedef float f32x2 __attribute__((ext_vector_type(2)));
typedef unsigned u32x4 __attribute__((ext_vector_type(4)));
typedef unsigned u32x2 __attribute__((ext_vector_type(2)));
typedef GAS unsigned gu32;

constexpr int D = 1024, BATCH = 2, SEQ = 8192, T = BATCH * SEQ, DEPTH = 4;
constexpr int AH = 8, AHD = 128, ATT_IN = 9216;
constexpr int RH = 4, RDK = 256, RDV = 512, RET_IN = 6144, RET_V = 2048, RC = 128, RNC = SEQ / RC;
constexpr int SG = 64, SGC = 16, SP = 64;
constexpr int NE = 64, TOPK = 8, NEG = 8, ED = 256, NSLOT = 9;
constexpr float LN_EPS = 1e-5f;
constexpr float ALPHA = 1.6817928305074292f;
constexpr int NWAVES = 8, NTHREADS = 512;

__device__ __forceinline__ unsigned f2bf(float f) { unsigned u = __builtin_bit_cast(unsigned, f); return (u + 0x7fffu + ((u >> 16) & 1u)) >> 16; }
__device__ __forceinline__ unsigned pk2(float lo, float hi) { unsigned r; asm("s_nop 1\n\tv_cvt_pk_bf16_f32 %0, %1, %2" : "=v"(r) : "v"(lo), "v"(hi)); return r; }
__device__ __forceinline__ unsigned pk2sw(float lo, float hi) { return f2bf(lo) | (f2bf(hi) << 16); }
__device__ __forceinline__ unsigned pk2hw(float lo, float hi) { unsigned r; asm volatile("v_cvt_pk_bf16_f32 %0, %1, %2" : "=v"(r) : "v"(lo), "v"(hi)); return r; }
__device__ __forceinline__ float bf2f(unsigned b) { return __builtin_bit_cast(float, b << 16); }
__device__ __forceinline__ float bflo(unsigned w) { return __builtin_bit_cast(float, w << 16); }
__device__ __forceinline__ float bfhi(unsigned w) { return __builtin_bit_cast(float, w & 0xffff0000u); }
__device__ __forceinline__ float shx(float v, int m, int lane) { return __builtin_bit_cast(float, __builtin_amdgcn_ds_bpermute((lane ^ m) << 2, __builtin_bit_cast(int, v))); }
__device__ __forceinline__ int shx_i(int v, int m, int lane) { return __builtin_amdgcn_ds_bpermute((lane ^ m) << 2, v); }
__device__ __forceinline__ float rdl(float v, int src) { return __builtin_bit_cast(float, __builtin_amdgcn_readlane(__builtin_bit_cast(int, v), src)); }
template <int CTRL, int RM = 0xf, int BM = 0xf> __device__ __forceinline__ float dpp0(float v) { return __builtin_bit_cast(float, __builtin_amdgcn_update_dpp(0, __builtin_bit_cast(int, v), CTRL, RM, BM, true)); }
template <int CTRL, int RM = 0xf, int BM = 0xf> __device__ __forceinline__ float dppo(float old, float v) { return __builtin_bit_cast(float, __builtin_amdgcn_update_dpp(__builtin_bit_cast(int, old), __builtin_bit_cast(int, v), CTRL, RM, BM, false)); }
__device__ __forceinline__ float wave_sum(float v, int lane) {
    (void)lane;
    v += dpp0<0x111>(v); v += dpp0<0x112>(v); v += dpp0<0x114>(v); v += dpp0<0x118>(v);
    v += dpp0<0x142, 0xa>(v);
    v += dpp0<0x143, 0xc>(v);
    return rdl(v, 63);
}
__device__ __forceinline__ float max8(float v) {
    v = fmaxf(v, dppo<0xb1>(v, v)); v = fmaxf(v, dppo<0x4e>(v, v)); v = fmaxf(v, dppo<0x141>(v, v)); return v;
}
__device__ __forceinline__ float fsig(float x) { return __builtin_amdgcn_rcpf(1.0f + __expf(-x)); }
#define LDS_WAIT() asm volatile("s_waitcnt lgkmcnt(0)" ::: "memory")
#define VM_WAIT() asm volatile("s_waitcnt vmcnt(0)" ::: "memory")
__device__ __forceinline__ const char* rfl_ptr(const char* p) {
    unsigned long long v = (unsigned long long)p; unsigned lo = __builtin_amdgcn_readfirstlane((unsigned)v), hi = __builtin_amdgcn_readfirstlane((unsigned)(v >> 32));
    return (const char*)(((unsigned long long)hi << 32) | lo);
}
__device__ __forceinline__ bf16x8 row_frag(const LAS bf16* base, int ld, int row0, int col0, int lane) {
    return *(const LAS bf16x8*)(base + (row0 + (lane & 15)) * ld + col0 + 8 * (lane >> 4));
}
__device__ __forceinline__ bf16x4 tr4(const LAS bf16* addr) { return __builtin_amdgcn_ds_read_tr16_b64_v4i16((LAS bf16x4*)addr); }
__device__ __forceinline__ bf16x8 cat8(bf16x4 a, bf16x4 b) { bf16x8 r; r[0] = a[0]; r[1] = a[1]; r[2] = a[2]; r[3] = a[3]; r[4] = b[0]; r[5] = b[1]; r[6] = b[2]; r[7] = b[3]; return r; }
#define MFMA16(a, b, c) __builtin_amdgcn_mfma_f32_16x16x32_bf16((a), (b), (c), 0, 0, 0)
__device__ __forceinline__ bf16x8 pack8(f32x4 a, f32x4 b) {
    u32x4 w; w.x = pk2(a[0], a[1]); w.y = pk2(a[2], a[3]); w.z = pk2(b[0], b[1]); w.w = pk2(b[2], b[3]); return __builtin_bit_cast(bf16x8, w);
}

namespace pg8 {
typedef int v4i_t __attribute__((ext_vector_type(4)));
typedef int v8i_t __attribute__((ext_vector_type(8)));
constexpr int BM = 256, BK = 64, HALF = 128, HTB = HALF * BK * 2, STAGE_BYTES = 8 * HTB;
__device__ __forceinline__ int lds_byte(int r, int c) { const int st = (r >> 4) * 2 + (c >> 5), rr = r & 15, cc = c & 31, ob = rr * 64 + cc * 2; return st * 1024 + (ob ^ (((ob >> 9) & 1) << 5)); }
__device__ __forceinline__ void stage_rc(int b, int& R, int& C) { const int st = b / 1024, sb = b % 1024, swz = sb ^ (((sb >> 9) & 1) << 5); R = (st >> 1) * 16 + swz / 64; C = (st & 1) * 32 + (swz % 64) / 2; }
__device__ __forceinline__ int perm32(int rho) { const int n = rho >> 4, i = rho & 15; return 8 * (i >> 2) + 4 * n + (i & 3); }

struct UnitG {
    const char* A;
    const char* B;
    const int* gidx;
    int gcnt, gshift;
    int row0, col0;
    int aux;
};

__device__ __forceinline__ void uniformize(UnitG& u) { u.A = rfl_ptr(u.A); u.B = rfl_ptr(u.B); u.gidx = (const int*)rfl_ptr((const char*)u.gidx); u.gcnt = __builtin_amdgcn_readfirstlane(u.gcnt); u.gshift = __builtin_amdgcn_readfirstlane(u.gshift);
    u.row0 = __builtin_amdgcn_readfirstlane(u.row0); u.col0 = __builtin_amdgcn_readfirstlane(u.col0); u.aux = __builtin_amdgcn_readfirstlane(u.aux); }
template <class Epi, class Sched>
__device__ __forceinline__ void gemm_phase(LAS unsigned char* lds, const int tid, const int K, const Sched& S, const Epi& E) {
    constexpr bool F8 = Sched::FP8;
    constexpr bool GATHER = Sched::GATHER;
    const int wid = __builtin_amdgcn_readfirstlane(tid >> 6), lane = tid & 63, wr = wid >> 2, wc = wid & 3, fr = lane & 15, fq = lane >> 4;
    int nt = K / BK; asm volatile("" : "+s"(nt));
    constexpr bool P16 = Epi::PERM16;
    unsigned voffB[2], voffB1[2], vA[2][2];
#pragma unroll
    for (int i = 0; i < 2; ++i) { int R, C; stage_rc(tid * 16 + i * 8192, R, C); const int Rb = Epi::PERM ? ((R & ~31) + perm32(R & 31)) : R; voffB[i] = (unsigned)(Rb * K + C) * 2u; voffB1[i] = voffB[i]; vA[0][i] = (unsigned)(R * K + C) * 2u; vA[1][i] = vA[0][i];
        if constexpr (P16) { const int x = R & 31, src = 64 * (R >> 5) + 16 * ((x >> 2) & 3) + 4 * (x >> 4) + (x & 3); voffB[i] = (unsigned)(src * K + C) * 2u; voffB1[i] = (unsigned)((src + 8) * K + C) * 2u; } }
    const size_t kstep = (size_t)(BK * 2);
    const size_t hstep = (size_t)HALF * K * 2;
    const size_t hstepB = P16 ? 0 : hstep;
    const size_t hstepA = GATHER ? 0 : hstep;
    const unsigned ldsw = (unsigned)wid * 1024u;
    const int aoff = F8 ? lds_byte(wr * 64 + fr, fq * 16) : lds_byte(wr * 64 + fr, fq * 8), boff = F8 ? lds_byte(wc * 32 + fr, fq * 16) : lds_byte(wc * 32 + fr, fq * 8);
    LAS u32x4* park = (LAS u32x4*)(lds + STAGE_BYTES) + tid;
#define PG8_SA(b, h) (((b) * 2 + (h)) * HTB)
#define PG8_SB(b, h) ((4 + (b) * 2 + (h)) * HTB)
#define PG8_STAGE(bufoff, gbase, voff) do { _Pragma("unroll") for (int _i = 0; _i < 2; ++_i) { asm volatile("" : "+v"((voff)[_i]));   \
        __builtin_amdgcn_global_load_lds((const unsigned*)((const char*)(gbase) + (voff)[_i]), (LAS unsigned*)(lds + (bufoff) + ldsw + _i * 8192), 16, 0, 0); } } while (0)
    constexpr int FKS = F8 ? 16 : 1024;
#define PG8_LD2(p_) __builtin_shufflevector(*(const LAS v4i_t*)(p_), *(const LAS v4i_t*)((p_) + FKS), 0, 1, 2, 3, 4, 5, 6, 7)
#define PG8_LDA(dst, b, h) do { _Pragma("unroll") for (int m = 0; m < 4; ++m) dst[m] = PG8_LD2(lds + PG8_SA(b, h) + aoff + m * 2048); } while (0)
#define PG8_LDB(dst, b, h) do { _Pragma("unroll") for (int n = 0; n < 2; ++n) dst[n] = PG8_LD2(lds + PG8_SB(b, h) + boff + n * 2048); } while (0)
#define PG8_LO(v) __builtin_bit_cast(bf16x8, __builtin_shufflevector((v), (v), 0, 1, 2, 3))
#define PG8_HI(v) __builtin_bit_cast(bf16x8, __builtin_shufflevector((v), (v), 4, 5, 6, 7))
#define PG8_MMA(ai, bj, At, Bt) do { __builtin_amdgcn_s_setprio(1); _Pragma("unroll") for (int m = 0; m < 4; ++m) _Pragma("unroll") for (int n = 0; n < 2; ++n) { \
        if constexpr (F8) { acc[ai][bj][m][n] = __builtin_amdgcn_mfma_scale_f32_16x16x128_f8f6f4(Bt[n], At[m], acc[ai][bj][m][n], 0, 0, 0, 0x7F7F7F7F, 0, 0x7F7F7F7F); } \
        else { acc[ai][bj][m][n] = __builtin_amdgcn_mfma_f32_16x16x32_bf16(PG8_LO(Bt[n]), PG8_LO(At[m]), acc[ai][bj][m][n], 0, 0, 0); \
               acc[ai][bj][m][n] = __builtin_amdgcn_mfma_f32_16x16x32_bf16(PG8_HI(Bt[n]), PG8_HI(At[m]), acc[ai][bj][m][n], 0, 0, 0); } } __builtin_amdgcn_s_setprio(0); } while (0)
#define PG8_WAIT_V(n) asm volatile("s_waitcnt vmcnt(" #n ")" ::: "memory")
#define PG8_WAIT_L(n) asm volatile("s_waitcnt lgkmcnt(" #n ")" ::: "memory")
#define PG8_BAR __builtin_amdgcn_s_barrier()
#define PG8_SCHED __builtin_amdgcn_sched_barrier(0)
#define PG8_VOFF(u, v00, v01, v10, v11) do { int _R0, _C0, _R1, _C1; stage_rc(tid * 16, _R0, _C0); stage_rc(tid * 16 + 8192, _R1, _C1); int _r00 = _R0, _r01 = _R1, _r10 = HALF + _R0, _r11 = HALF + _R1; \
        if ((u).gidx) { const GAS int* _gp = (const GAS int*)(u).gidx; const int _gc = (u).gcnt;     \
            const int _a = _gp[_r00 < _gc ? _r00 : 0] >> (u).gshift, _b = _gp[_r01 < _gc ? _r01 : 0] >> (u).gshift, _c = _gp[_r10 < _gc ? _r10 : 0] >> (u).gshift, _d = _gp[_r11 < _gc ? _r11 : 0] >> (u).gshift; \
            _r00 = _a; _r01 = _b; _r10 = _c; _r11 = _d; } \
        v00 = (unsigned)(_r00 * K + _C0) * 2u; v01 = (unsigned)(_r01 * K + _C1) * 2u; v10 = (unsigned)(_r10 * K + _C0) * 2u; v11 = (unsigned)(_r11 * K + _C1) * 2u; } while (0)
    UnitG cur, nxt; int ui = 0;
    if (!S.next(0, cur)) return;
    if constexpr (Sched::UNIFORMIZE) uniformize(cur);
    f32x4 acc[2][2][4][2];
#pragma unroll
    for (int a = 0; a < 2; ++a)
#pragma unroll
        for (int b = 0; b < 2; ++b)
#pragma unroll
            for (int m = 0; m < 4; ++m)
#pragma unroll
                for (int n = 0; n < 2; ++n) acc[a][b][m][n] = (f32x4){0.f, 0.f, 0.f, 0.f};
    v8i_t At[4], B0[2], B1[2];
    if constexpr (GATHER) PG8_VOFF(cur, vA[0][0], vA[0][1], vA[1][0], vA[1][1]);
    const char* cA = cur.A; const char* cB = cur.B;
    PG8_STAGE(PG8_SB(0, 0), cB, voffB); PG8_STAGE(PG8_SB(0, 1), cB + hstepB, voffB1); PG8_STAGE(PG8_SA(0, 0), cA, vA[0]); PG8_STAGE(PG8_SA(0, 1), cA + hstepA, vA[1]);
    if (wr == 1) PG8_BAR;
    PG8_WAIT_V(2); PG8_BAR;
    PG8_STAGE(PG8_SB(1, 0), cB + kstep, voffB); PG8_STAGE(PG8_SA(1, 0), cA + kstep, vA[0]); PG8_STAGE(PG8_SB(1, 1), cB + hstepB + kstep, voffB1);
    PG8_WAIT_V(6); PG8_BAR;
    for (;;) {
        const bool has_next = S.next(ui + 1, nxt);
        if constexpr (Sched::UNIFORMIZE) { if (has_next) uniformize(nxt); }
        const char* nA = cA; const char* nB = cB;
        if (has_next) { nA = nxt.A; nB = nxt.B; }
        if constexpr (GATHER) { u32x4 pv; pv.x = vA[0][0]; pv.y = vA[0][1]; pv.z = vA[1][0]; pv.w = vA[1][1];
            if (has_next) PG8_VOFF(nxt, pv.x, pv.y, pv.z, pv.w);
            *park = pv; }
#pragma unroll 1
        for (int t = 0; t < nt; t += 2) {
            const bool last = (t == nt - 2);
            const char* a1 = cA + (size_t)(t + 1) * kstep;
            const char* a2 = last ? nA : cA + (size_t)(t + 2) * kstep; const char* b2 = last ? nB : cB + (size_t)(t + 2) * kstep;
            const char* a3 = a2 + kstep; const char* b3 = b2 + kstep;
            PG8_LDB(B0, 0, 0); PG8_LDB(B1, 0, 1); PG8_SCHED; PG8_LDA(At, 0, 0); PG8_STAGE(PG8_SA(1, 1), a1 + hstepA, vA[1]);
            PG8_WAIT_V(8); PG8_WAIT_L(0); PG8_BAR; PG8_MMA(0, 0, At, B0); PG8_MMA(0, 1, At, B1); PG8_BAR; PG8_SCHED;
            if constexpr (GATHER) { if (last) { const u32x4 pv = *park; vA[0][0] = pv.x; vA[0][1] = pv.y; vA[1][0] = pv.z; vA[1][1] = pv.w; } }
            PG8_LDA(At, 0, 1); PG8_STAGE(PG8_SB(0, 0), b2, voffB); PG8_STAGE(PG8_SB(0, 1), b2 + hstepB, voffB1); PG8_STAGE(PG8_SA(0, 0), a2, vA[0]);
            PG8_WAIT_V(8); PG8_WAIT_L(0); PG8_BAR; PG8_MMA(1, 0, At, B0); PG8_MMA(1, 1, At, B1); PG8_BAR; PG8_SCHED;
            PG8_LDB(B0, 1, 0); PG8_LDB(B1, 1, 1); PG8_SCHED; PG8_LDA(At, 1, 0); PG8_STAGE(PG8_SA(0, 1), a2 + hstepA, vA[1]);
            PG8_WAIT_V(8); PG8_WAIT_L(0); PG8_BAR; PG8_MMA(0, 0, At, B0); PG8_MMA(0, 1, At, B1); PG8_BAR; PG8_SCHED;
            PG8_LDA(At, 1, 1); PG8_STAGE(PG8_SB(1, 0), b3, voffB); PG8_STAGE(PG8_SB(1, 1), b3 + hstepB, voffB1); PG8_STAGE(PG8_SA(1, 0), a3, vA[0]);
            PG8_WAIT_V(8); PG8_WAIT_L(0); PG8_BAR; PG8_MMA(1, 0, At, B0); PG8_MMA(1, 1, At, B1); PG8_BAR; PG8_SCHED;
        }
        if (wr == 0) PG8_BAR;
        { int l2; { unsigned o2 = ~0u; asm volatile("" : "+s"(o2)); l2 = (int)__builtin_amdgcn_mbcnt_hi(o2, __builtin_amdgcn_mbcnt_lo(o2, 0u)); }
          E(acc, cur, wr, wc, l2 & 15, l2 >> 4); }
        if (!has_next) break;
#pragma unroll
        for (int a = 0; a < 2; ++a)
#pragma unroll
            for (int b = 0; b < 2; ++b)
#pragma unroll
                for (int m = 0; m < 4; ++m)
#pragma unroll
                    for (int n = 0; n < 2; ++n) acc[a][b][m][n] = (f32x4){0.f, 0.f, 0.f, 0.f};
        cur = nxt; cA = nA; cB = nB; ++ui;
        if (wr == 1) PG8_BAR;
    }
    PG8_WAIT_V(0);
    PG8_BAR;
#undef PG8_SA
#undef PG8_SB
#undef PG8_STAGE
#undef PG8_LDA
#undef PG8_LDB
#undef PG8_LD2
#undef PG8_LO
#undef PG8_HI
#undef PG8_MMA
#undef PG8_WAIT_V
#undef PG8_WAIT_L
#undef PG8_BAR
#undef PG8_SCHED
#undef PG8_VOFF
}
}

constexpr size_t MiB = 1u << 20;
constexpr size_t WS_CTL = 0, CTL_ZERO_BYTES = 1 * MiB;
constexpr size_t WS_ATT_IN_T = 1 * MiB;
constexpr size_t WS_ATT_OUT_T = WS_ATT_IN_T + 36 * MiB;
constexpr size_t WS_RET_IN_T = WS_ATT_OUT_T + 4 * MiB;
constexpr size_t WS_RET_OUT_T = WS_RET_IN_T + 12 * MiB;
constexpr size_t WS_GLU_T = WS_RET_OUT_T + 4 * MiB;
constexpr size_t WS_RT_HI = WS_GLU_T + 4 * MiB;
constexpr size_t WS_RT_LO = WS_RT_HI + 512 * 1024;
constexpr size_t WS_WMOE = WS_RT_HI + 1 * MiB;
constexpr size_t WMOE_E_BYTES = (size_t)(512 * 1024 + 1024 * 256) * 2;
constexpr size_t WS_X = WS_WMOE + 98 * MiB;
constexpr size_t WS_Y = WS_X + 64 * MiB;
constexpr size_t WS_XB = WS_Y + 64 * MiB;
constexpr size_t WS_BIG = WS_XB + 32 * MiB;
constexpr size_t WS_AUX = WS_BIG + 288 * MiB;
constexpr size_t WS_H = WS_AUX + 160 * MiB;
constexpr size_t WS_LIST = WS_H + 80 * MiB;
constexpr size_t WS_TRASH = WS_LIST + 8 * MiB;
constexpr size_t WS_END = WS_TRASH + 1 * MiB;
static_assert(WS_END <= 1024 * MiB, "workspace map");
constexpr int CW_BAR = 4096;
constexpr int CW_CNT = 16384;
constexpr int CW_CHK = 65536;
constexpr int HROWS = 163840;

#define XB_TMO      128
#define XB_XCNT(j)  (256  + 64 * (j))
#define XB_XSUB(j)  (1280 + 64 * (j))
#define XB_XGEN(j)  (2304 + 64 * (j))
#define XB_TOP      3328
#define XB_TOPGEN   3392
#define XCD_BAR_WORDS 3456
#define XB_SPIN_CAP (1u << 20)
__device__ __forceinline__ unsigned xb_ld(unsigned* p)              { return __hip_atomic_load(p, __ATOMIC_RELAXED, __HIP_MEMORY_SCOPE_AGENT); }
__device__ __forceinline__ unsigned xb_add(unsigned* p, unsigned v) { return __hip_atomic_fetch_add(p, v, __ATOMIC_RELAXED, __HIP_MEMORY_SCOPE_AGENT); }
__device__ __forceinline__ unsigned xb_xcc_id() { return (unsigned)__builtin_amdgcn_s_getreg((3 << 11) | 20) & 0xFu; }
#define XB_SPIN(cond, bar) do { unsigned _sp = 0; while (cond) { __builtin_amdgcn_s_sleep(1); \
    if ((++_sp & 255u) == 0u) { if (xb_ld(&(bar)[XB_TMO])) break; if (_sp > XB_SPIN_CAP) { atomicAdd(&(bar)[XB_TMO], 1u); break; } } } } while (0)
struct XcdBarrier { unsigned* bar; unsigned x; volatile LAS unsigned* st; };
__device__ __forceinline__ XcdBarrier xcd_barrier_post(unsigned* bar, volatile LAS unsigned* st) {
    XcdBarrier b; b.bar = bar; b.x = xb_xcc_id(); b.st = st;
    if (threadIdx.x == 0) (void)xb_add(&bar[XB_XCNT(b.x)], 1u);
    return b;
}
__device__ __forceinline__ void xcd_barrier_complete(unsigned* bar, unsigned x, unsigned& nloc, unsigned& nx) {
    const unsigned G = gridDim.x * gridDim.y * gridDim.z;
    unsigned sum, cnt, mine, sp = 0u;
    for (;;) {
        sum = 0u; cnt = 0u; mine = 0u;
#pragma unroll
        for (unsigned j = 0; j < 16; ++j) { const unsigned c = xb_ld(&bar[XB_XCNT(j)]); sum += c; cnt += (c > 0u) ? 1u : 0u; mine = (j == x) ? c : mine; }
        if (sum == G) break;
        __builtin_amdgcn_s_sleep(1);
        if ((++sp & 255u) == 0u) { if (xb_ld(&bar[XB_TMO])) break; if (sp > XB_SPIN_CAP) { atomicAdd(&bar[XB_TMO], 1u); break; } }
    }
    nloc = mine > 0u ? mine : 1u; nx = cnt > 0u ? cnt : 1u;
}
__device__ __forceinline__ void xcd_barrier(const XcdBarrier& b) {
    asm volatile("s_waitcnt vmcnt(0)" ::: "memory");
    __syncthreads();
    if (threadIdx.x == 0) {
        unsigned* bar = b.bar;
        __builtin_amdgcn_s_waitcnt(0);
        unsigned nloc = b.st[0], nx = b.st[1];
        if (nloc == 0u) { xcd_barrier_complete(bar, b.x, nloc, nx); b.st[0] = nloc; b.st[1] = nx; }
        const unsigned old = xb_add(&bar[XB_XSUB(b.x)], 1u);
        const unsigned gen = old / nloc;
        if (old + 1u == (gen + 1u) * nloc) {
            __builtin_amdgcn_fence(__ATOMIC_RELEASE, "agent");
            asm volatile("s_waitcnt vmcnt(0)" ::: "memory");
            const unsigned og = xb_add(&bar[XB_TOP], 1u);
            const unsigned tg = og / nx;
            if (og + 1u == (tg + 1u) * nx) xb_add(&bar[XB_TOPGEN], 1u);
            else XB_SPIN(xb_ld(&bar[XB_TOPGEN]) == tg, bar);
            __builtin_amdgcn_fence(__ATOMIC_ACQUIRE, "agent");
            xb_add(&bar[XB_XGEN(b.x)], 1u);
            asm volatile("s_waitcnt vmcnt(0)" ::: "memory");
        } else {
            XB_SPIN(xb_ld(&bar[XB_XGEN(b.x)]) == gen, bar);
            __builtin_amdgcn_fence(__ATOMIC_ACQUIRE, "agent");
            asm volatile("s_waitcnt vmcnt(0)" ::: "memory");
        }
    }
    __syncthreads();
}

constexpr int RING_BYTES = 139264;
constexpr int MISC_OFF = RING_BYTES;
constexpr int LDS_BYTES = 147456;
struct Params {
    const float* in[26]; float* out; unsigned char* ws; int ph_lo, ph_hi; int use_bar, pad;
};
typedef const __attribute__((address_space(4))) Params* KP;
__device__ __forceinline__ const float* gin(KP p, int i) { return (const float*)(const GAS float*)p->in[i]; }
__device__ __forceinline__ float* gout(KP p) { return (float*)(GAS float*)p->out; }
struct Frame {
    LAS unsigned char* lds; volatile LAS unsigned* MISC;
    int tid, lane, wave, vcu, G;
    unsigned char* ws;
};

template <bool F8_ = false> struct DenseSchedT {
    static constexpr bool GATHER = false, UNIFORMIZE = false, FP8 = F8_;
    const char* A; const char* Bt; int K, nM, nN, nwg, G, c;
    __device__ __forceinline__ void init(const void* A_, const void* Bt_, int M, int N, int K_, int G_, int c_) { A = (const char*)A_; Bt = (const char*)Bt_; K = K_; nM = M / 256; nN = N / 256; nwg = nM * nN; G = G_; c = c_; }
    __device__ __forceinline__ bool next(int i, pg8::UnitG& u) const {
        const long L = (long)i * G + c; if (L >= nwg) return false;
        int wgid = (int)L; { const int q = nwg / 8, r = nwg % 8, xcd = wgid % 8, off = wgid / 8; wgid = (xcd < r ? xcd * (q + 1) : r * (q + 1) + (xcd - r) * q) + off; }
        const int nig = 8 * nN, gid = wgid / nig, fm = gid * 8, gsz = (nM - fm) < 8 ? (nM - fm) : 8;
        const int pm = fm + ((wgid % nig) % gsz), pn = (wgid % nig) / gsz;
        u.A = A + (size_t)pm * 256 * K * 2; u.B = Bt + (size_t)pn * 256 * K * 2; u.gidx = nullptr; u.gcnt = 0; u.gshift = 0; u.row0 = pm * 256; u.col0 = pn * 256; u.aux = 0; return true;
    }
};
typedef DenseSchedT<false> DenseSched; typedef DenseSchedT<true> DenseSched8;
__device__ __forceinline__ u32x4 pack_bf16x8(const f32x4& v0, const f32x4& v1) { u32x4 w; w.x = pk2hw(v0[0], v0[1]); w.y = pk2hw(v0[2], v0[3]); w.z = pk2hw(v1[0], v1[1]); w.w = pk2hw(v1[2], v1[3]); return w; }

__device__ __forceinline__ unsigned pk4_fp8(float a, float b, float c, float d) {
    a = fminf(fmaxf(a, -448.0f), 448.0f); b = fminf(fmaxf(b, -448.0f), 448.0f); c = fminf(fmaxf(c, -448.0f), 448.0f); d = fminf(fmaxf(d, -448.0f), 448.0f);
    int w = 0; w = __builtin_amdgcn_cvt_pk_fp8_f32(a, b, w, false); w = __builtin_amdgcn_cvt_pk_fp8_f32(c, d, w, true); return (unsigned)w; }
constexpr float WUP_SCALE = 32.0f, WUP_INV = 1.0f / 32.0f;
struct EpiStoreBf16 {
    static constexpr bool PERM = true, PERM16 = false;
    bf16* O; int ldc; float osc, qsc;
    __device__ __forceinline__ void operator()(const f32x4 (&acc)[2][2][4][2], const pg8::UnitG& u, int wr, int wc, int fr, int fq) const {
        const float sc = ((u.col0 % 3072) < 1024) ? osc * qsc : osc;
#pragma unroll
        for (int ai = 0; ai < 2; ++ai)
#pragma unroll
            for (int m = 0; m < 4; ++m) { bf16* rowp = O + (size_t)(u.row0 + ai * 128 + wr * 64 + m * 16 + fr) * ldc + u.col0 + wc * 32 + 8 * fq;
#pragma unroll
                for (int bj = 0; bj < 2; ++bj) *(u32x4*)(rowp + bj * 128) = pack_bf16x8(acc[ai][bj][m][0] * sc, acc[ai][bj][m][1] * sc); }
    }
};
constexpr float YEXP_SCALE = 32.0f, YEXP_INV = 1.0f / 32.0f;
constexpr float A_SCALE = 16.0f;
constexpr float H_SCALE = 16.0f;
struct EpiStoreFp8 {
    static constexpr bool PERM = false, PERM16 = true;
    unsigned char* O; int ldc;
    __device__ __forceinline__ void operator()(const f32x4 (&acc)[2][2][4][2], const pg8::UnitG& u, int wr, int wc, int fr, int fq) const {
#pragma unroll
        for (int ai = 0; ai < 2; ++ai)
#pragma unroll
            for (int m = 0; m < 4; ++m) { unsigned char* rowp = O + (size_t)(u.row0 + ai * 128 + wr * 64 + m * 16 + fr) * ldc + u.col0 + wc * 64 + 16 * fq;
                u32x4 w;
#pragma unroll
                for (int q = 0; q < 4; ++q) { f32x4 v = acc[ai][q >> 1][m][q & 1] * (YEXP_SCALE / (H_SCALE * WUP_SCALE));
#pragma unroll
                    for (int j = 0; j < 4; ++j) v[j] = fminf(fmaxf(v[j], -448.0f), 448.0f);
                    int d = 0; d = __builtin_amdgcn_cvt_pk_fp8_f32(v[0], v[1], d, false); d = __builtin_amdgcn_cvt_pk_fp8_f32(v[2], v[3], d, true); w[q] = (unsigned)d; }
                *(u32x4*)rowp = w; }
    }
};
struct EpiRetIn {
    static constexpr bool PERM = true, PERM16 = false;
    bf16* O; int ldc;
    __device__ __forceinline__ void operator()(const f32x4 (&acc)[2][2][4][2], const pg8::UnitG& u, int wr, int wc, int fr, int fq) const {
        float l2g = 0.f;
        float cs = WUP_INV;
        if (u.col0 < 2048) { const int h = (u.col0 & 1023) >> 8; const float g = 1.0f - exp2f(-5.0f - (float)h); l2g = log2f(g); if (u.col0 >= 1024) { l2g = -l2g; cs *= 0.0625f; } }
#pragma unroll
        for (int ai = 0; ai < 2; ++ai)
#pragma unroll
            for (int m = 0; m < 4; ++m) { const int row = u.row0 + ai * 128 + wr * 64 + m * 16 + fr; const float sc = exp2f(l2g * (float)(row & 127)) * cs;
                bf16* rowp = O + (size_t)row * ldc + u.col0 + wc * 32 + 8 * fq;
#pragma unroll
                for (int bj = 0; bj < 2; ++bj) *(u32x4*)(rowp + bj * 128) = pack_bf16x8(acc[ai][bj][m][0] * sc, acc[ai][bj][m][1] * sc); }
    }
};
__device__ __forceinline__ void unpack_bf16x8(const u32x4& w, f32x4& a, f32x4& b) { a[0] = bflo(w.x); a[1] = bfhi(w.x); a[2] = bflo(w.y); a[3] = bfhi(w.y); b[0] = bflo(w.z); b[1] = bfhi(w.z); b[2] = bflo(w.w); b[3] = bfhi(w.w); }
template <bool ALL16> struct EpiResidT {
    static constexpr bool PERM = true, PERM16 = false;
    const bf16* X; bf16* Y; float asc;
    __device__ __forceinline__ void operator()(const f32x4 (&acc)[2][2][4][2], const pg8::UnitG& u, int wr, int wc, int fr, int fq) const {
        constexpr int NB = ALL16 ? 1 : 2, PER = 2 / NB;
#pragma unroll
        for (int bt = 0; bt < NB; ++bt) {
            u32x4 xw[PER][4][2];
#pragma unroll
            for (int a2 = 0; a2 < PER; ++a2)
#pragma unroll
                for (int m = 0; m < 4; ++m) { const int ai = bt * PER + a2; const size_t off = (size_t)(u.row0 + ai * 128 + wr * 64 + m * 16 + fr) * D + u.col0 + wc * 32 + 8 * fq;
#pragma unroll
                    for (int bj = 0; bj < 2; ++bj) xw[a2][m][bj] = *(const u32x4*)(X + off + bj * 128); }
            asm volatile("" ::: "memory");
#pragma unroll
            for (int a2 = 0; a2 < PER; ++a2)
#pragma unroll
                for (int m = 0; m < 4; ++m) { const int ai = bt * PER + a2; const size_t off = (size_t)(u.row0 + ai * 128 + wr * 64 + m * 16 + fr) * D + u.col0 + wc * 32 + 8 * fq;
#pragma unroll
                    for (int bj = 0; bj < 2; ++bj) { f32x4 x0, x1; unpack_bf16x8(xw[a2][m][bj], x0, x1);
                        *(u32x4*)(Y + off + bj * 128) = pack_bf16x8(x0 * ALPHA + acc[ai][bj][m][0] * asc, x1 * ALPHA + acc[ai][bj][m][1] * asc); } }
            asm volatile("" ::: "memory");
        }
    }
};
typedef EpiResidT<true> EpiResid; typedef EpiResidT<false> EpiResid8;
struct EpiGluResid {
    static constexpr bool PERM = true, PERM16 = false;
    const bf16* X; bf16* Y; float asc;
    __device__ __forceinline__ void operator()(const f32x4 (&acc)[2][2][4][2], const pg8::UnitG& u, int wr, int wc, int fr, int fq) const {
        u32x4 xw[2][4];
#pragma unroll
        for (int ai = 0; ai < 2; ++ai)
#pragma unroll
            for (int m = 0; m < 4; ++m) { const size_t off = (size_t)(u.row0 + ai * 128 + wr * 64 + m * 16 + fr) * D + (u.col0 >> 1) + wc * 32 + 8 * fq; xw[ai][m] = *(const u32x4*)(X + off); }
        asm volatile("" ::: "memory");
#pragma unroll
        for (int ai = 0; ai < 2; ++ai)
#pragma unroll
            for (int m = 0; m < 4; ++m) { const size_t off = (size_t)(u.row0 + ai * 128 + wr * 64 + m * 16 + fr) * D + (u.col0 >> 1) + wc * 32 + 8 * fq;
                f32x4 x0, x1; unpack_bf16x8(xw[ai][m], x0, x1); f32x4 o0, o1;
#pragma unroll
                for (int j = 0; j < 4; ++j) { o0[j] = x0[j] * ALPHA + acc[ai][0][m][0][j] * asc * fsig(acc[ai][1][m][0][j] * asc); o1[j] = x1[j] * ALPHA + acc[ai][0][m][1][j] * asc * fsig(acc[ai][1][m][1][j] * asc); }
                *(u32x4*)(Y + off) = pack_bf16x8(o0, o1); }
    }
};
struct EpiMoeUp {
    static constexpr bool PERM = true, PERM16 = false;
    unsigned char* H;
    __device__ __forceinline__ void operator()(const f32x4 (&acc)[2][2][4][2], const pg8::UnitG& u, int wr, int wc, int fr, int fq) const {
        typedef unsigned u2_t __attribute__((ext_vector_type(2)));
#pragma unroll
        for (int ai = 0; ai < 2; ++ai) {
            u32x2 w8[4];
#pragma unroll
            for (int m = 0; m < 4; ++m) { f32x4 o[2];
#pragma unroll
                for (int n = 0; n < 2; ++n)
#pragma unroll
                    for (int j = 0; j < 4; ++j) { const float ga = acc[ai][0][m][n][j], ua = acc[ai][1][m][n][j];
                        o[n][j] = (ga * ua) * (WUP_INV * WUP_INV * H_SCALE) * __builtin_amdgcn_rcpf(1.0f + __builtin_amdgcn_exp2f(ga * (-WUP_INV * 1.4426950408889634f))); }
                w8[m].x = pk4_fp8(o[0][0], o[0][1], o[0][2], o[0][3]); w8[m].y = pk4_fp8(o[1][0], o[1][1], o[1][2], o[1][3]); }
            u32x4 s0, s1;
            { const u2_t a = __builtin_amdgcn_permlane16_swap(w8[0].x, w8[2].x, false, false), b = __builtin_amdgcn_permlane16_swap(w8[0].y, w8[2].y, false, false);
              s0.x = a.x; s0.y = b.x; s0.z = a.y; s0.w = b.y; }
            { const u2_t a = __builtin_amdgcn_permlane16_swap(w8[1].x, w8[3].x, false, false), b = __builtin_amdgcn_permlane16_swap(w8[1].y, w8[3].y, false, false);
              s1.x = a.x; s1.y = b.x; s1.z = a.y; s1.w = b.y; }
            const int mb = (fq & 1) ? 2 : 0;
            unsigned char* rowp = H + (size_t)(u.row0 + ai * 128 + wr * 64 + mb * 16 + fr) * ED + u.col0 + wc * 32 + 8 * (fq & 2);
            *(u32x4*)rowp = s0; *(u32x4*)(rowp + (size_t)16 * ED) = s1; }
    }
};

struct ConvD { const float* src; unsigned char* dst; unsigned char* dst2; int ldw, ldk, kind; };
__device__ __forceinline__ ConvD conv_mk8(const float* W, int ldw, unsigned char* WT, int ldk, int k0, int n0, int drow0) {
    ConvD d; d.src = W + (size_t)k0 * ldw + n0; d.dst = WT + (size_t)drow0 * ldk + k0; d.dst2 = nullptr; d.ldw = ldw; d.ldk = ldk; d.kind = 1; return d; }
__device__ __forceinline__ ConvD conv_mk16(const float* W, int ldw, bf16* WT, bf16* WTlo, int ldk, int k0, int n0, int drow0) {
    ConvD d; d.src = W + (size_t)k0 * ldw + n0; d.dst = (unsigned char*)(WT + (size_t)drow0 * ldk + k0); d.dst2 = WTlo ? (unsigned char*)(WTlo + (size_t)drow0 * ldk + k0) : nullptr; d.ldw = ldw; d.ldk = ldk * 2; d.kind = WTlo ? 2 : 0; return d; }
__device__ __forceinline__ void conv_load(const ConvD& d, int lane, f32x4 (&r)[8]) {
#pragma unroll
    for (int i = 0; i < 8; ++i) { const int kk = 8 * i + (lane >> 3), c4 = 4 * (lane & 7); r[i] = *(const f32x4*)(d.src + (size_t)kk * d.ldw + c4); }
}
template <bool HILO>
__device__ __forceinline__ void conv_finish(const ConvD& d, int lane, const f32x4 (&r)[8], LAS float* scr) {
    const float scale = (d.kind == 1) ? WUP_SCALE : 1.0f;
#pragma unroll
    for (int i = 0; i < 8; ++i) { const int kk = 8 * i + (lane >> 3), c4 = 4 * (lane & 7);
        scr[kk * 33 + c4] = r[i][0] * scale; scr[kk * 33 + c4 + 1] = r[i][1] * scale; scr[kk * 33 + c4 + 2] = r[i][2] * scale; scr[kk * 33 + c4 + 3] = r[i][3] * scale; }
    LDS_WAIT(); asm volatile("" ::: "memory");
    const int c = lane & 7;
#pragma unroll
    for (int j = 0; j < 4; ++j) { const int n = (lane >> 3) + 8 * j; const LAS float* s = scr + (8 * c) * 33 + n;
        float v[8];
#pragma unroll
        for (int q = 0; q < 8; ++q) v[q] = s[q * 33];
        if (d.kind == 1) { u32x2 o; o.x = pk4_fp8(v[0], v[1], v[2], v[3]); o.y = pk4_fp8(v[4], v[5], v[6], v[7]); *(u32x2*)(d.dst + (size_t)n * d.ldk + 8 * c) = o; }
        else { u32x4 o; o.x = pk2(v[0], v[1]); o.y = pk2(v[2], v[3]); o.z = pk2(v[4], v[5]); o.w = pk2(v[6], v[7]);
            *(u32x4*)(d.dst + (size_t)n * d.ldk + 16 * c) = o;
            if (HILO) { float rr[8];
#pragma unroll
                for (int q = 0; q < 8; ++q) rr[q] = v[q] - bf2f(f2bf(v[q]));
                u32x4 o2; o2.x = pk2(rr[0], rr[1]); o2.y = pk2(rr[2], rr[3]); o2.z = pk2(rr[4], rr[5]); o2.w = pk2(rr[6], rr[7]);
                *(u32x4*)(d.dst2 + (size_t)n * d.ldk + 16 * c) = o2; } } }
    LDS_WAIT(); asm volatile("" ::: "memory");
}
__device__ __forceinline__ void conv_dma(const ConvD& d, int lane, LAS float* buf) {
#pragma unroll
    for (int i = 0; i < 8; ++i) { const float* g = d.src + (size_t)(8 * i + (lane >> 3)) * d.ldw + 4 * ((lane & 7) ^ i);
        __builtin_amdgcn_global_load_lds((const unsigned*)g, (LAS unsigned*)(buf + i * 256), 16, 0, 0); }
}
__device__ __forceinline__ void conv_finish_lds(const ConvD& d, int lane, const LAS float* buf) {
    const float scale = (d.kind == 1) ? WUP_SCALE : 1.0f;
    const int c = lane & 7;
#pragma unroll
    for (int j = 0; j < 4; ++j) { const int n = (lane >> 3) + 8 * j; const LAS float* s = buf + (8 * c) * 32 + (((n >> 2) ^ c) & 7) * 4 + (n & 3);
        float v[8];
#pragma unroll
        for (int q = 0; q < 8; ++q) v[q] = s[q * 32] * scale;
        if (d.kind == 1) { u32x2 o; o.x = pk4_fp8(v[0], v[1], v[2], v[3]); o.y = pk4_fp8(v[4], v[5], v[6], v[7]); *(u32x2*)(d.dst + (size_t)n * d.ldk + 8 * c) = o; }
        else { u32x4 o; o.x = pk2(v[0], v[1]); o.y = pk2(v[2], v[3]); o.z = pk2(v[4], v[5]); o.w = pk2(v[6], v[7]); *(u32x4*)(d.dst + (size_t)n * d.ldk + 16 * c) = o; } }
    LDS_WAIT(); asm volatile("" ::: "memory");
}
#define CONV_RUN(NIT, DEC) do { int it_ = gw; if (it_ < (NIT)) { ConvD dc_ = DEC(it_); int par_ = 0; conv_dma(dc_, F.lane, scr); asm volatile("s_waitcnt vmcnt(0)" ::: "memory"); \
        for (; it_ < (NIT); it_ += NGW) { const int itn_ = (it_ + NGW < (NIT)) ? it_ + NGW : it_; const ConvD dn_ = DEC(itn_); conv_dma(dn_, F.lane, scr + (par_ ^ 1) * 2048);     \
            asm volatile("s_waitcnt vmcnt(12)" ::: "memory"); conv_finish_lds(dc_, F.lane, scr + par_ * 2048); dc_ = dn_; par_ ^= 1; } \
        asm volatile("s_waitcnt vmcnt(0)" ::: "memory"); } } while (0)
__device__ __forceinline__ ConvD conv_dec_mixers(KP p, unsigned char* ws, int it) {
    constexpr int I_AIN = 16 * 288, I_AOUT = 16 * 32, I_RIN = 16 * 192, I_ROUT = 32 * 32, I_GLU = 16 * 64, I_RT = 16 * 2;
    int r = it;
    if (r < 2 * I_AIN) { const int j = r / I_AIN; r %= I_AIN; const int kb = r / 288, nb = r % 288, n0 = nb * 32;
        return conv_mk8(gin(p, 1) + (size_t)j * D * ATT_IN, ATT_IN, (unsigned char*)(ws + WS_ATT_IN_T) + (size_t)j * ATT_IN * D, D, kb * 64, n0, n0); }
    r -= 2 * I_AIN;
    if (r < 2 * I_AOUT) { const int j = r / I_AOUT; r %= I_AOUT; const int kb = r / 32, nb = r % 32, n0 = nb * 32;
        return conv_mk8(gin(p, 2) + (size_t)j * D * D, D, (unsigned char*)(ws + WS_ATT_OUT_T) + (size_t)j * D * D, D, kb * 64, n0, n0); }
    r -= 2 * I_AOUT;
    if (r < I_RIN) { const int kb = r / 192, nb = r % 192, n0 = nb * 32;
        return conv_mk8(gin(p, 3), RET_IN, (unsigned char*)(ws + WS_RET_IN_T), D, kb * 64, n0, n0); }
    r -= I_RIN;
    if (r < I_ROUT) { const int kb = r / 32, nb = r % 32, n0 = nb * 32;
        return conv_mk8(gin(p, 6), D, (unsigned char*)(ws + WS_RET_OUT_T), RET_V, kb * 64, n0, n0); }
    r -= I_ROUT;
    if (r < I_GLU) { const int kb = r / 64, nb = r % 64, n0 = nb * 32; const int c = n0 & 1023, drow = (c >> 7) * 256 + (n0 >> 10) * 128 + (c & 127);
        return conv_mk8(gin(p, 15), 2 * D, (unsigned char*)(ws + WS_GLU_T), D, kb * 64, n0, drow); }
    r -= I_GLU;
    { const int l = r / I_RT; r %= I_RT; const int kb = r / 2, nb = r % 2, n0 = nb * 32;
        return conv_mk16(gin(p, 16) + (size_t)l * D * NE, NE, (bf16*)(ws + WS_RT_HI) + (size_t)l * NE * D, (bf16*)(ws + WS_RT_LO) + (size_t)l * NE * D, D, kb * 64, n0, n0); }
}
__device__ __forceinline__ ConvD conv_dec_moe(KP p, unsigned char* ws, int l, int it) {
    const int e = it / 384, r = it % 384, which = r >> 7, rr = r & 127;
    bf16* We = (bf16*)(ws + WS_WMOE + (size_t)e * WMOE_E_BYTES);
    if (which < 2) { const float* src = (e < 64) ? gin(p, 18 + which) + ((size_t)l * NE + e) * D * ED : gin(p, 21 + which) + (size_t)l * D * ED;
        const int kb = rr >> 3, nb = rr & 7, n0 = nb * 32; const int drow = (n0 >> 7) * 256 + which * 128 + (n0 & 127);
        return conv_mk8(src, ED, (unsigned char*)We, D, kb * 64, n0, drow); }
    const float* src = (e < 64) ? gin(p, 20) + ((size_t)l * NE + e) * ED * D : gin(p, 23) + (size_t)l * ED * D;
    const int kb = rr >> 5, nb = rr & 31, n0 = nb * 32;
    return conv_mk8(src, D, (unsigned char*)(We + 512 * 1024), ED, kb * 64, n0, n0);
}
__device__ __forceinline__ void phase_conv_mixers(const Frame& F, KP p) {
    LAS float* scr = (LAS float*)(F.lds + F.wave * 16384);
    const int gw = F.vcu * NWAVES + F.wave, NGW = F.G * NWAVES;
    constexpr int NMAIN = 2 * (16 * 288) + 2 * (16 * 32) + 16 * 192 + 32 * 32 + 16 * 64, NRT = 4 * (16 * 2);
    unsigned char* ws = F.ws;
#define CONV_DEC_MIX(i_) conv_dec_mixers(p, ws, (i_))
    CONV_RUN(NMAIN, CONV_DEC_MIX);
    for (int it = NMAIN + gw; it < NMAIN + NRT; it += NGW) { const ConvD d = conv_dec_mixers(p, ws, it); f32x4 r[8]; conv_load(d, F.lane, r); conv_finish<true>(d, F.lane, r, scr); }
#undef CONV_DEC_MIX
}
__device__ __forceinline__ void phase_conv_moe(const Frame& F, KP p, int l) {
    LAS float* scr = (LAS float*)(F.lds + F.wave * 16384);
    const int gw = F.vcu * NWAVES + F.wave, NGW = F.G * NWAVES;
    unsigned char* ws = F.ws;
#define CONV_DEC_MOE(i_) conv_dec_moe(p, ws, l, (i_))
    CONV_RUN(65 * 384, CONV_DEC_MOE);
#undef CONV_DEC_MOE
}

__device__ __forceinline__ void phase_lnr(const Frame& F, KP p, int layer, bool dry = false) {
    const bf16* Y = (const bf16*)(F.ws + WS_Y); bf16* XB = (bf16*)(F.ws + WS_XB); unsigned char* XB8 = (unsigned char*)(F.ws + WS_X);
    const float* lng = gin(p, 24) + (size_t)(layer * 2) * D; const float* lnb = gin(p, 25) + (size_t)(layer * 2) * D;
    const bf16* rthi = (const bf16*)(F.ws + WS_RT_HI) + (size_t)layer * NE * D; const bf16* rtlo = (const bf16*)(F.ws + WS_RT_LO) + (size_t)layer * NE * D;
    const float* rbias = gin(p, 17) + layer * NE;
    unsigned* cnt = (unsigned*)(F.ws + WS_CTL) + CW_CNT + layer * NE * 64;
    int* lists = (int*)(F.ws + WS_LIST); int* tokmap = (int*)(F.ws + WS_LIST + 4 * MiB); float* tokgate = (float*)(F.ws + WS_LIST + 5 * MiB);
    constexpr int XLD = 1032, MAXT = 8;
    LAS bf16* Xhi = (LAS bf16*)F.lds; LAS bf16* Xlo = Xhi + 16 * XLD;
    LAS float* part = (LAS float*)(F.lds + 2 * 16 * XLD * 2);
    LAS int* ent = (LAS int*)(part + 2 * 16 * 64);
    LAS int* hist = ent + MAXT * 16 * 8 * 2; LAS int* base = hist + 64;
    const int lane = F.lane, w = F.wave, g4 = lane >> 4, l15 = lane & 15;
    if (F.tid < 64) hist[F.tid] = 0;
    bf16x8 bhi[16], blo[16];
    { const int nt = w & 3, kh = w >> 2; const bf16* bh = rthi + (size_t)(16 * nt + l15) * D + 512 * kh + 8 * g4; const bf16* bl = rtlo + (size_t)(16 * nt + l15) * D + 512 * kh + 8 * g4;
#pragma unroll
        for (int ks = 0; ks < 16; ++ks) { bhi[ks] = *(const bf16x8*)(bh + 32 * ks); blo[ks] = *(const bf16x8*)(bl + 32 * ks); } }
    u32x4 ypre[2][2];
    if (F.vcu < T / 16) {
#pragma unroll
        for (int rr = 0; rr < 2; ++rr)
#pragma unroll
            for (int j = 0; j < 2; ++j) ypre[rr][j] = *(const u32x4*)(Y + (size_t)(F.vcu * 16 + 2 * w + rr) * D + 8 * lane + 512 * j); }
    int ntile = 0;
    for (int tile = F.vcu; tile < T / 16 && ntile < MAXT; tile += F.G, ++ntile) {
        const int t0 = tile * 16;
        u32x4 ycur[2][2];
#pragma unroll
        for (int rr = 0; rr < 2; ++rr)
#pragma unroll
            for (int j = 0; j < 2; ++j) ycur[rr][j] = ypre[rr][j];
        if (tile + F.G < T / 16) {
#pragma unroll
            for (int rr = 0; rr < 2; ++rr)
#pragma unroll
                for (int j = 0; j < 2; ++j) ypre[rr][j] = *(const u32x4*)(Y + (size_t)((tile + F.G) * 16 + 2 * w + rr) * D + 8 * lane + 512 * j); }
#pragma unroll
        for (int rr = 0; rr < 2; ++rr) {
            const int lr = 2 * w + rr; const size_t row = (size_t)(t0 + lr);
            f32x4 v[4]; float s = 0.f;
#pragma unroll
            for (int j = 0; j < 2; ++j) unpack_bf16x8(ycur[rr][j], v[2 * j], v[2 * j + 1]);
#pragma unroll
            for (int j = 0; j < 4; ++j) s += (v[j][0] + v[j][1]) + (v[j][2] + v[j][3]);
            const float mean = wave_sum(s, lane) * (1.f / D); float s2 = 0.f;
#pragma unroll
            for (int j = 0; j < 4; ++j) { v[j] = v[j] - mean; s2 += (v[j][0] * v[j][0] + v[j][1] * v[j][1]) + (v[j][2] * v[j][2] + v[j][3] * v[j][3]); }
            const float rstd = 1.0f / sqrtf(wave_sum(s2, lane) * (1.f / D) + LN_EPS);
#pragma unroll
            for (int j = 0; j < 2; ++j) { const f32x4 g0 = *(const f32x4*)(lng + 8 * lane + 512 * j), g1 = *(const f32x4*)(lng + 8 * lane + 512 * j + 4), b0 = *(const f32x4*)(lnb + 8 * lane + 512 * j), b1 = *(const f32x4*)(lnb + 8 * lane + 512 * j + 4);
                const f32x4 o0 = v[2 * j] * rstd * g0 + b0, o1 = v[2 * j + 1] * rstd * g1 + b1;
                const u32x4 hi = pack_bf16x8(o0, o1);
                *(u32x4*)(XB + row * D + 8 * lane + 512 * j) = hi;
                { u32x2 q8; q8.x = pk4_fp8(o0[0], o0[1], o0[2], o0[3]); q8.y = pk4_fp8(o1[0], o1[1], o1[2], o1[3]); *(u32x2*)(XB8 + row * D + 8 * lane + 512 * j) = q8; }
                f32x4 h0, h1; unpack_bf16x8(hi, h0, h1); const u32x4 lo = pack_bf16x8(o0 - h0, o1 - h1);
                *(LAS u32x4*)(Xhi + lr * XLD + 8 * lane + 512 * j) = hi; *(LAS u32x4*)(Xlo + lr * XLD + 8 * lane + 512 * j) = lo; }
        }
        __syncthreads();
        { const int nt = w & 3, kh = w >> 2; f32x4 a0 = (f32x4){0.f, 0.f, 0.f, 0.f}, a1 = a0, a2 = a0, a3 = a0, a4 = a0, a5 = a0;
#pragma unroll
            for (int ks = 0; ks < 16; ks += 2) { const int k0 = 512 * kh + 32 * ks;
                const bf16x8 ahi = row_frag(Xhi, XLD, 0, k0, lane), alo = row_frag(Xlo, XLD, 0, k0, lane), bhi2 = row_frag(Xhi, XLD, 0, k0 + 32, lane), blo2 = row_frag(Xlo, XLD, 0, k0 + 32, lane);
                a0 = MFMA16(ahi, bhi[ks], a0); a1 = MFMA16(alo, bhi[ks], a1); a2 = MFMA16(ahi, blo[ks], a2);
                a3 = MFMA16(bhi2, bhi[ks + 1], a3); a4 = MFMA16(blo2, bhi[ks + 1], a4); a5 = MFMA16(bhi2, blo[ks + 1], a5); }
            const f32x4 acc = ((a0 + a3) + (a1 + a4)) + (a2 + a5);
#pragma unroll
            for (int i = 0; i < 4; ++i) part[(kh * 16 + 4 * g4 + i) * 64 + 16 * nt + l15] = acc[i];
        }
        __syncthreads();
#pragma unroll
        for (int rr = 0; rr < 2; ++rr) {
            const int lt = ntile * 16 + 2 * w + rr;
            const float lg = part[(2 * w + rr) * 64 + lane] + part[(16 + 2 * w + rr) * 64 + lane];
            float sc = 1.0f / (1.0f + expf(-lg)); sc = (sc == sc) ? sc : 0.5f;
            const float sel = sc + rbias[lane];
            const float m1 = max8(sel);
            const unsigned long long eq = __ballot(sel == m1);
            const unsigned gm = (unsigned)(eq >> (lane & 56)) & 0xffu;
            const int first = (lane & 56) + __builtin_ctz(gm | 0x100u);
            const float m2 = max8((lane == first) ? -INFINITY : sel);
            const float gs = m1 + m2; const int mygrp = lane >> 3; int grank = 0;
#pragma unroll
            for (int gg = 0; gg < 8; ++gg) { const float o = rdl(gs, 8 * gg); grank += (o > gs || (o == gs && gg < mygrp)) ? 1 : 0; }
            const float mv = (grank < 4) ? sel : -INFINITY;
            unsigned key = __builtin_bit_cast(unsigned, mv); key = (key >> 31) ? ~key : (key | 0x80000000u); key = (key & ~63u) | (unsigned)(63 - lane);
            int r0 = 0, r1 = 0, r2 = 0, r3 = 0;
#pragma unroll
            for (int e2 = 0; e2 < 64; e2 += 4) { r0 += ((unsigned)__builtin_amdgcn_readlane((int)key, e2) > key) ? 1 : 0; r1 += ((unsigned)__builtin_amdgcn_readlane((int)key, e2 + 1) > key) ? 1 : 0;
                r2 += ((unsigned)__builtin_amdgcn_readlane((int)key, e2 + 2) > key) ? 1 : 0; r3 += ((unsigned)__builtin_amdgcn_readlane((int)key, e2 + 3) > key) ? 1 : 0; }
            const int rank = (r0 + r1) + (r2 + r3);
            const bool chosen = rank < TOPK;
            const float wsum = wave_sum(chosen ? sc : 0.f, lane);
            if (chosen) { const int lpos = __hip_atomic_fetch_add(hist + lane, 1, __ATOMIC_RELAXED, __HIP_MEMORY_SCOPE_WORKGROUP);
                ent[(lt * 8 + rank) * 2] = (lane << 16) | lpos; ent[(lt * 8 + rank) * 2 + 1] = __builtin_bit_cast(int, sc / wsum * 2.5f); }
        }
    }
    __syncthreads();
    if (dry) return;
    if (F.tid < 64) { const int hcount = hist[F.tid]; base[F.tid] = hcount ? (int)atomicAdd(cnt + F.tid * 64, (unsigned)hcount) : 0; }
    __syncthreads();
    for (int idx = F.tid; idx < ntile * 16 * 8; idx += NTHREADS) {
        const int ev = ent[idx * 2], gb = ent[idx * 2 + 1]; const int e = ev >> 16, pos = base[e] + (ev & 0xffff);
        const int lt = idx >> 3, rank = idx & 7, tok = (F.vcu + (lt >> 4) * F.G) * 16 + (lt & 15);
        lists[(size_t)e * T + pos] = tok; tokmap[tok * 8 + rank] = (e << 16) | pos; tokgate[tok * 8 + rank] = __builtin_bit_cast(float, gb);
    }
}

__device__ __forceinline__ void phase_combine(const Frame& F, KP p, int layer, bool dry = false) {
    bf16* XB = (bf16*)(F.ws + WS_XB); const unsigned char* yexp = (const unsigned char*)(F.ws + WS_BIG);
    const int* tokmap = (const int*)(F.ws + WS_LIST + 4 * MiB); const float* tokgate = (const float*)(F.ws + WS_LIST + 5 * MiB);
    const volatile LAS int* tstart = (const volatile LAS int*)(F.MISC + 64);
    const float* lng = gin(p, 24) + (size_t)(layer * 2 + 1) * D; const float* lnb = gin(p, 25) + (size_t)(layer * 2 + 1) * D;
    float* outp = gout(p); bf16* xbo = XB; if (dry) { outp = (float*)(F.ws + WS_AUX); xbo = (bf16*)(F.ws + WS_H); }
    const int lane = F.lane, gw = F.vcu * NWAVES + F.wave, NGW = F.G * NWAVES;
    const bf16* ysh = (const bf16*)(F.ws + WS_Y);
    f32x4 gv[4], bv[4];
#pragma unroll
    for (int j = 0; j < 4; ++j) { gv[j] = *(const f32x4*)(lng + 16 * lane + 4 * j); bv[j] = *(const f32x4*)(lnb + 16 * lane + 4 * j); }
    for (int row = gw; row < T; row += NGW) {
        const int mk = tokmap[row * 8 + (lane & 7)]; const float gk = tokgate[row * 8 + (lane & 7)] * YEXP_INV;
        const int rk = (int)tstart[mk >> 16] * 256 + (mk & 0xffff);
        f32x4 v[4];
#pragma unroll
        for (int j = 0; j < 2; ++j) { const u32x4 xw = *(const u32x4*)(ysh + (size_t)row * D + 16 * lane + 8 * j); unpack_bf16x8(xw, v[2 * j], v[2 * j + 1]); }
#pragma unroll
        for (int k = 0; k < TOPK; ++k) { const int r = __builtin_amdgcn_readlane(rk, k); const float g = rdl(gk, k);
            const u32x4 s = *(const u32x4*)(yexp + (size_t)r * D + 16 * lane);
#pragma unroll
            for (int j = 0; j < 4; ++j) { const f32x2 lo = __builtin_amdgcn_cvt_pk_f32_fp8((int)s[j], false), hi = __builtin_amdgcn_cvt_pk_f32_fp8((int)s[j], true);
                v[j][0] += g * lo[0]; v[j][1] += g * lo[1]; v[j][2] += g * hi[0]; v[j][3] += g * hi[1]; } }
        float s = 0.f;
#pragma unroll
        for (int j = 0; j < 4; ++j) s += (v[j][0] + v[j][1]) + (v[j][2] + v[j][3]);
        const float mean = wave_sum(s, lane) * (1.f / D); float s2 = 0.f;
#pragma unroll
        for (int j = 0; j < 4; ++j) { v[j] = v[j] - mean; s2 += (v[j][0] * v[j][0] + v[j][1] * v[j][1]) + (v[j][2] * v[j][2] + v[j][3] * v[j][3]); }
        const float rstd = 1.0f / sqrtf(wave_sum(s2, lane) * (1.f / D) + LN_EPS);
        f32x4 o[4];
#pragma unroll
        for (int j = 0; j < 4; ++j) o[j] = v[j] * rstd * gv[j] + bv[j];
        if (layer == DEPTH - 1 || dry) {
#pragma unroll
            for (int j = 0; j < 4; ++j) *(f32x4*)(outp + (size_t)row * D + 16 * lane + 4 * j) = o[j]; }
        if (layer != DEPTH - 1) { *(u32x4*)(xbo + (size_t)row * D + 16 * lane) = pack_bf16x8(o[0], o[1]); *(u32x4*)(xbo + (size_t)row * D + 16 * lane + 8) = pack_bf16x8(o[2], o[3]);
            if (!dry) { u32x4 q8; q8.x = pk4_fp8(o[0][0], o[0][1], o[0][2], o[0][3]); q8.y = pk4_fp8(o[1][0], o[1][1], o[1][2], o[1][3]); q8.z = pk4_fp8(o[2][0], o[2][1], o[2][2], o[2][3]); q8.w = pk4_fp8(o[3][0], o[3][1], o[3][2], o[3][3]);
                *(u32x4*)((unsigned char*)(F.ws + WS_X) + (size_t)row * D + 16 * lane) = q8; } }
    }
}

constexpr size_t AUX_OB = 96 * MiB, AUX_LSE = 128 * MiB;
__device__ __forceinline__ unsigned att_qoff(int R, int j, int qi, int g4) {
    const int h = R & 7, sbr = R >> 3, g = sbr >> 5, rem = sbr & 31, b = rem >> 4, rr_ = rem & 15;
    const int dsh = 2 * g, d = 1 << dsh, nrs = 4 - dsh, r = rr_ >> nrs, n = 4 * (rr_ & ((1 << nrs) - 1)) + j;
    const unsigned qrow = (unsigned)b * SEQ + (unsigned)(128 * n + qi) * (unsigned)d + (unsigned)r;
    return qrow * (unsigned)ATT_IN + (unsigned)(g * 3072 + h * 128 + 8 * g4);
}
__device__ __forceinline__ void phase_attn(const Frame& F, int bx) {
    const bf16* qkv = (const bf16*)(F.ws + WS_BIG); bf16* og = (bf16*)(F.ws + WS_AUX); float* lse = (float*)(F.ws + WS_AUX + AUX_LSE);
    constexpr int KLD = 136;
    LAS bf16* Ks = (LAS bf16*)F.lds; LAS bf16* Vs = Ks + 256 * KLD;
    const int lane = F.lane, w = F.wave, g4 = lane >> 4, l15 = lane & 15, qq = l15 >> 2, pp = lane & 3;
    u32x4 kc[4], vc[4];
    constexpr int NRUN = 768;
#define ATT_LOADBLK(KR, VR, nblk) do { _Pragma("unroll") for (int it = 0; it < 4; ++it) { const int idx = F.tid + 512 * it, c = idx >> 4, ch = idx & 15; int pos = 128 * (nblk) + c; pos = pos < 0 ? 0 : pos; \
            const unsigned so = (rowbase + (unsigned)pos * (unsigned)d + (unsigned)r) * (unsigned)ATT_IN + (unsigned)(g * 3072 + 1024 + h * 128 + ch * 8); KR[it] = *(const u32x4*)(qkv + so); VR[it] = *(const u32x4*)(qkv + so + 1024u); } } while (0)
#define ATT_STOREBLK(KR, VR, slot) do { _Pragma("unroll") for (int it = 0; it < 4; ++it) { const int idx = F.tid + 512 * it, c = idx >> 4, ch = idx & 15; \
            *(LAS u32x4*)(Ks + (128 * (slot) + c) * KLD + ch * 8) = KR[it]; *(LAS u32x4*)(Vs + (128 * (slot) + c) * KLD + ch * 8) = VR[it]; } } while (0)
    const int qi = 16 * w + l15;
    bf16x8 qf[4];
    if (bx < NRUN) { const unsigned qo = att_qoff(bx, 0, qi, g4);
#pragma unroll
        for (int s = 0; s < 4; ++s) qf[s] = *(const bf16x8*)(qkv + qo + 32 * s); }
    for (int R = bx; R < NRUN; R += F.G) {
        const int h = R & 7, sbr = R >> 3, g = sbr >> 5, rem = sbr & 31, b = rem >> 4, rr_ = rem & 15;
        const int dsh = 2 * g, d = 1 << dsh, nrs = 4 - dsh, r = rr_ >> nrs, n0 = 4 * (rr_ & ((1 << nrs) - 1)); const unsigned rowbase = (unsigned)b * SEQ;
        { u32x4 k0[4], v0[4]; ATT_LOADBLK(k0, v0, n0 - 1); ATT_LOADBLK(kc, vc, n0); ATT_STOREBLK(k0, v0, (n0 - 1) & 1); }
#pragma unroll 1
        for (int j = 0; j < 4; ++j) {
            const int n = n0 + j, cs = n & 1, ps = cs ^ 1;
            ATT_STOREBLK(kc, vc, cs);
            const unsigned qrow = rowbase + (unsigned)(128 * n + qi) * (unsigned)d + (unsigned)r;
            __syncthreads();
            if (j < 3) { ATT_LOADBLK(kc, vc, n + 1); }
            __builtin_amdgcn_sched_barrier(0);
            const int ws0 = (16 * w < 96) ? 16 * w : 96;
#define ATT_PROW(c0) (((c0) < 128) ? (128 * ps + (c0)) : (128 * cs + (c0) - 128))
            f32x4 sacc[10];
            {
                bf16x8 kfa[4], kfb[4];
#pragma unroll
                for (int s = 0; s < 4; ++s) kfa[s] = row_frag(Ks, KLD, ATT_PROW(ws0), 32 * s, lane);
#pragma unroll
                for (int t = 0; t < 10; t += 2) {
#pragma unroll
                    for (int s = 0; s < 4; ++s) kfb[s] = row_frag(Ks, KLD, ATT_PROW(ws0 + 16 * (t + 1)), 32 * s, lane);
                    __builtin_amdgcn_sched_barrier(0);
                    sacc[t] = (f32x4){0.f, 0.f, 0.f, 0.f};
#pragma unroll
                    for (int s = 0; s < 4; ++s) sacc[t] = MFMA16(kfa[s], qf[s], sacc[t]);
                    if (t + 2 < 10) {
#pragma unroll
                        for (int s = 0; s < 4; ++s) kfa[s] = row_frag(Ks, KLD, ATT_PROW(ws0 + 16 * (t + 2)), 32 * s, lane); }
                    __builtin_amdgcn_sched_barrier(0);
                    sacc[t + 1] = (f32x4){0.f, 0.f, 0.f, 0.f};
#pragma unroll
                    for (int s = 0; s < 4; ++s) sacc[t + 1] = MFMA16(kfb[s], qf[s], sacc[t + 1]);
                }
            }
            { const int Rn = (j < 3) ? R : ((R + F.G < NRUN) ? R + F.G : R), jn = (j < 3) ? j + 1 : 0; const unsigned qo = att_qoff(Rn, jn, qi, g4);
#pragma unroll
              for (int s = 0; s < 4; ++s) qf[s] = *(const bf16x8*)(qkv + qo + 32 * s); }
            const float slope = exp2f(-(float)(h + 1)) * (float)d;
            float mx = -INFINITY;
            int sbase = 128 + qi - ws0 - 4 * g4; asm volatile("" : "+v"(sbase));
            const float nsb = -slope * (float)sbase; const int kmin = (n > 0) ? sbase - 128 : ((sbase - 128 > 128 - ws0 - 4 * g4) ? sbase - 128 : 128 - ws0 - 4 * g4);
#pragma unroll
            for (int t = 0; t < 10; ++t)
#pragma unroll
                for (int i = 0; i < 4; ++i) { const int k = 16 * t + i;
                    const bool valid = (k <= sbase) && (k >= kmin);
                    const float v = valid ? __builtin_fmaf(slope, (float)k, sacc[t][i] + nsb) : -INFINITY; sacc[t][i] = v; mx = fmaxf(mx, v); }
            mx = fmaxf(mx, shx(mx, 16, lane)); mx = fmaxf(mx, shx(mx, 32, lane));
            float lsum = 0.f;
#pragma unroll
            for (int t = 0; t < 10; ++t)
#pragma unroll
                for (int i = 0; i < 4; ++i) { const float pv = __expf(sacc[t][i] - mx); sacc[t][i] = pv; lsum += pv; }
            lsum += shx(lsum, 16, lane); lsum += shx(lsum, 32, lane);
            bf16x8 pf[5];
#pragma unroll
            for (int kt = 0; kt < 5; ++kt) pf[kt] = pack8(sacc[2 * kt], sacc[2 * kt + 1]);
            f32x4 o[8];
            {
                const LAS bf16* vl = Vs + (4 * g4 + qq) * KLD + 32 * pp;
                bf16x4 va[10], vcc[10];
#pragma unroll
                for (int q = 0; q < 10; ++q) va[q] = tr4(vl + ATT_PROW(ws0 + 16 * q) * KLD);
#pragma unroll
                for (int et = 0; et < 8; et += 2) {
#pragma unroll
                    for (int q = 0; q < 10; ++q) vcc[q] = tr4(vl + ATT_PROW(ws0 + 16 * q) * KLD + 4 * (et + 1));
                    __builtin_amdgcn_sched_barrier(0);
                    o[et] = (f32x4){0.f, 0.f, 0.f, 0.f};
#pragma unroll
                    for (int kt = 0; kt < 5; ++kt) o[et] = MFMA16(cat8(va[2 * kt], va[2 * kt + 1]), pf[kt], o[et]);
                    if (et + 2 < 8) {
#pragma unroll
                        for (int q = 0; q < 10; ++q) va[q] = tr4(vl + ATT_PROW(ws0 + 16 * q) * KLD + 4 * (et + 2)); }
                    __builtin_amdgcn_sched_barrier(0);
                    o[et + 1] = (f32x4){0.f, 0.f, 0.f, 0.f};
#pragma unroll
                    for (int kt = 0; kt < 5; ++kt) o[et + 1] = MFMA16(cat8(vcc[2 * kt], vcc[2 * kt + 1]), pf[kt], o[et + 1]);
                }
            }
#undef ATT_PROW
            const float inv = 1.0f / lsum;
            bf16* orow = og + ((size_t)g * T + qrow) * D + h * 128 + 32 * g4;
#pragma unroll
            for (int e2 = 0; e2 < 4; ++e2) *(u32x4*)(orow + 8 * e2) = pack_bf16x8(o[2 * e2] * inv, o[2 * e2 + 1] * inv);
            if (g4 == 0) lse[((size_t)g * T + qrow) * AH + h] = mx + __logf(lsum);
            __syncthreads();
        }
    }
#undef ATT_LOADBLK
#undef ATT_STOREBLK
}
__device__ __forceinline__ void phase_attn_combine(const Frame& F) {
    const bf16* og = (const bf16*)(F.ws + WS_AUX); const float* lse = (const float*)(F.ws + WS_AUX + AUX_LSE); bf16* ob = (bf16*)(F.ws + WS_AUX + AUX_OB);
    const int lane = F.lane, gw = F.vcu * NWAVES + F.wave, NGW = F.G * NWAVES, h = lane >> 3;
    for (int row = gw; row < T; row += NGW) {
        const float l0 = lse[((size_t)0 * T + row) * AH + h], l1 = lse[((size_t)1 * T + row) * AH + h], l2 = lse[((size_t)2 * T + row) * AH + h];
        const float m = fmaxf(l0, fmaxf(l1, l2)); float w0 = __expf(l0 - m), w1 = __expf(l1 - m), w2 = __expf(l2 - m); const float inv = 1.0f / (w0 + w1 + w2); w0 *= inv; w1 *= inv; w2 *= inv;
        float a[16];
#pragma unroll
        for (int j = 0; j < 16; ++j) a[j] = 0.f;
#pragma unroll
        for (int g = 0; g < 3; ++g) { const float wg = (g == 0) ? w0 : (g == 1 ? w1 : w2);
#pragma unroll
            for (int q = 0; q < 2; ++q) { const u32x4 s = *(const u32x4*)(og + ((size_t)g * T + row) * D + 16 * lane + 8 * q);
                a[8 * q + 0] += wg * bflo(s.x); a[8 * q + 1] += wg * bfhi(s.x); a[8 * q + 2] += wg * bflo(s.y); a[8 * q + 3] += wg * bfhi(s.y);
                a[8 * q + 4] += wg * bflo(s.z); a[8 * q + 5] += wg * bfhi(s.z); a[8 * q + 6] += wg * bflo(s.w); a[8 * q + 7] += wg * bfhi(s.w); } }
        { u32x4 o;
#pragma unroll
          for (int q = 0; q < 4; ++q) o[q] = pk4_fp8(a[4 * q] * A_SCALE, a[4 * q + 1] * A_SCALE, a[4 * q + 2] * A_SCALE, a[4 * q + 3] * A_SCALE);
          *(u32x4*)((unsigned char*)ob + (size_t)row * D + 16 * lane) = o; }
    }
}

constexpr size_t BIG_YRET = 192 * MiB;
__device__ __forceinline__ void phase_ret_u(const Frame& F) {
    const bf16* proj = (const bf16*)(F.ws + WS_BIG); bf16* St = (bf16*)(F.ws + WS_AUX);
    constexpr int LD = 264;
    LAS bf16* Kt = (LAS bf16*)F.lds; LAS bf16* Vt = Kt + 128 * LD;
    const int lane = F.lane, w = F.wave, g4 = lane >> 4, l15 = lane & 15, qq = l15 >> 2, pp = lane & 3;
    u32x4 kr[8], vr[8];
#define RU_LOAD(u_) do { const int eh_ = (u_) & 1, h_ = ((u_) >> 1) & 3, n_ = ((u_) >> 3) & 63, b_ = (u_) >> 9; const char* pb_ = (const char*)(proj + ((size_t)b_ * SEQ + (size_t)n_ * RC) * RET_IN); \
        int t_ = F.tid; asm volatile("" : "+v"(t_)); unsigned off_ = (unsigned)(((t_ >> 5) * RET_IN + (t_ & 31) * 8) * 2); \
        _Pragma("unroll") for (int it = 0; it < 8; ++it) { asm volatile("" : "+v"(off_)); kr[it] = *(const u32x4*)(pb_ + (size_t)(1024 + h_ * 256 + it * 16 * RET_IN) * 2 + off_); \
            vr[it] = *(const u32x4*)(pb_ + (size_t)(2048 + h_ * 512 + eh_ * 256 + it * 16 * RET_IN) * 2 + off_); } } while (0)
    if (F.vcu < 1024) RU_LOAD(F.vcu);
    for (int u = F.vcu; u < 1024; u += F.G) {
        const int eh = u & 1, h = (u >> 1) & 3, n = (u >> 3) & 63, b = u >> 9;
        { int t_ = F.tid; asm volatile("" : "+v"(t_));
#pragma unroll
          for (int it = 0; it < 8; ++it) { const int idx = t_ + 512 * it, j = idx >> 5, ch = idx & 31; *(LAS u32x4*)(Kt + j * LD + ch * 8) = kr[it]; *(LAS u32x4*)(Vt + j * LD + ch * 8) = vr[it]; } }
        __syncthreads();
        f32x4 acc[16][2];
#pragma unroll
        for (int mt = 0; mt < 16; ++mt) { acc[mt][0] = (f32x4){0.f, 0.f, 0.f, 0.f}; acc[mt][1] = (f32x4){0.f, 0.f, 0.f, 0.f}; }
#pragma unroll
        for (int ks = 0; ks < 4; ++ks) {
            bf16x8 bfr[2];
#pragma unroll
            for (int nt = 0; nt < 2; ++nt) { const LAS bf16* a0 = Vt + (32 * ks + 8 * g4 + qq) * LD + 32 * w + 16 * nt + 4 * pp; bfr[nt] = cat8(tr4(a0), tr4(a0 + 4 * LD)); }
#pragma unroll
            for (int mt = 0; mt < 16; ++mt) { const LAS bf16* a0 = Kt + (32 * ks + 8 * g4 + qq) * LD + 128 * (mt >> 3) + 32 * pp + 4 * (mt & 7);
                const bf16x8 afr = cat8(tr4(a0), tr4(a0 + 4 * LD));
                acc[mt][0] = MFMA16(afr, bfr[0], acc[mt][0]); acc[mt][1] = MFMA16(afr, bfr[1], acc[mt][1]); }
        }
        { const int un = (u + F.G < 1024) ? u + F.G : u; RU_LOAD(un); }
        bf16* outb = St + ((size_t)((b * RH + h) * RNC + n)) * (RDV * RDK);
#pragma unroll
        for (int nt = 0; nt < 2; ++nt) { bf16* orow = outb + (size_t)(eh * 256 + 32 * w + 16 * nt + l15) * RDK + 32 * g4;
#pragma unroll
            for (int mh = 0; mh < 2; ++mh)
#pragma unroll
                for (int q = 0; q < 4; ++q) *(u32x4*)(orow + 128 * mh + 8 * q) = pack_bf16x8(acc[mh * 8 + 2 * q][nt], acc[mh * 8 + 2 * q + 1][nt]); }
        __syncthreads();
    }
#undef RU_LOAD
}
__device__ __forceinline__ void phase_ret_scan(const Frame& F) {
    bf16* St = (bf16*)(F.ws + WS_AUX);
    for (int gt = F.vcu * NTHREADS + F.tid; gt < 8 * 16384; gt += F.G * NTHREADS) {
        const int bh = gt >> 14, chunk = gt & 16383, h = bh & 3;
        const float g128 = exp2f(128.0f * log2f(1.0f - exp2f(-5.0f - (float)h)));
        bf16* base = St + (size_t)bh * RNC * (RDV * RDK) + (size_t)chunk * 8;
        float c[8];
#pragma unroll
        for (int j = 0; j < 8; ++j) c[j] = 0.f;
#pragma unroll 8
        for (int n = 0; n < RNC; ++n) { bf16* pn = base + (size_t)n * (RDV * RDK); const u32x4 uv = *(const u32x4*)pn;
            u32x4 o; o.x = pk2(c[0], c[1]); o.y = pk2(c[2], c[3]); o.z = pk2(c[4], c[5]); o.w = pk2(c[6], c[7]); *(u32x4*)pn = o;
            c[0] = g128 * (c[0] + bflo(uv.x)); c[1] = g128 * (c[1] + bfhi(uv.x)); c[2] = g128 * (c[2] + bflo(uv.y)); c[3] = g128 * (c[3] + bfhi(uv.y));
            c[4] = g128 * (c[4] + bflo(uv.z)); c[5] = g128 * (c[5] + bfhi(uv.z)); c[6] = g128 * (c[6] + bflo(uv.w)); c[7] = g128 * (c[7] + bfhi(uv.w)); }
    }
}
__device__ __forceinline__ void phase_ret_out(const Frame& F, KP p) {
    const bf16* proj = (const bf16*)(F.ws + WS_BIG); const bf16* St = (const bf16*)(F.ws + WS_AUX); bf16* yret = (bf16*)(F.ws + WS_BIG + BIG_YRET);
    const float* gng = gin(p, 4); const float* gnb = gin(p, 5);
    constexpr int LD = 264, VLD = 72, NSL = 8, ESL = 64;
    LAS bf16* Rs = (LAS bf16*)F.lds; LAS bf16* Vs = Rs + 128 * LD;
    const int w = F.wave;
#define RO_TID(t_) int t_ = F.tid; asm volatile("" : "+v"(t_))
#define RO_LD(base_, off_) (*(const u32x4*)((const char*)(base_) + (off_)))
    for (int u = F.vcu; u < 512; u += F.G) {
        const int h = u & 3, n = (u >> 2) & 63, b = u >> 8;
        const size_t row0 = (size_t)b * SEQ + (size_t)n * RC;
        const bf16* Sn = St + ((size_t)((b * RH + h) * RNC + n)) * (RDV * RDK);
        const char* pbase = (const char*)(proj + row0 * RET_IN);
        u32x4 pv[2], ps[4];
        bf16x8 qf[8];
        { RO_TID(t0); u32x4 kreg[8];
          unsigned koff = (unsigned)(((t0 >> 5) * RET_IN + (t0 & 31) * 8) * 2), qoff = (unsigned)(((16 * w + (t0 & 15)) * RET_IN + 8 * ((t0 & 63) >> 4)) * 2);
#pragma unroll
          for (int it = 0; it < 8; ++it) { asm volatile("" : "+v"(koff)); kreg[it] = RO_LD(pbase + (size_t)(1024 + h * 256 + it * 16 * RET_IN) * 2, koff); }
#pragma unroll
          for (int s = 0; s < 8; ++s) { asm volatile("" : "+v"(qoff)); qf[s] = __builtin_bit_cast(bf16x8, RO_LD(pbase + (size_t)(h * 256 + 32 * s) * 2, qoff)); }
#define RO_LOAD_SLICE(sl_) do { RO_TID(tl_); unsigned voff = (unsigned)(((tl_ >> 3) * RET_IN + (tl_ & 7) * 8) * 2), soff = (unsigned)(((tl_ >> 5) * RDK + (tl_ & 31) * 8) * 2); \
            _Pragma("unroll") for (int it = 0; it < 2; ++it) { asm volatile("" : "+v"(voff)); pv[it] = RO_LD(pbase + (size_t)(2048 + h * 512 + (sl_) * ESL + it * 64 * RET_IN) * 2, voff); } \
            _Pragma("unroll") for (int it = 0; it < 4; ++it) { asm volatile("" : "+v"(soff)); ps[it] = RO_LD((const char*)Sn + (size_t)(((sl_) * ESL + it * 16) * RDK) * 2, soff); } } while (0)
          RO_LOAD_SLICE(0);
#pragma unroll
          for (int it = 0; it < 8; ++it) { const int idx = t0 + 512 * it, j = idx >> 5, ch = idx & 31; *(LAS u32x4*)(Rs + j * LD + ch * 8) = kreg[it]; } }
        __syncthreads();
        bf16x8 pf[4];
        { RO_TID(t1); const int lane = t1 & 63, g4 = lane >> 4, irow = 16 * w + (lane & 15);
          f32x4 sacc[8];
#pragma unroll
            for (int jt = 0; jt < 8; ++jt) { sacc[jt] = (f32x4){0.f, 0.f, 0.f, 0.f};
                if (jt <= w) {
#pragma unroll
                    for (int s = 0; s < 8; ++s) sacc[jt] = MFMA16(row_frag(Rs, LD, 16 * jt, 32 * s, lane), qf[s], sacc[jt]);
#pragma unroll
                    for (int i = 0; i < 4; ++i) if (16 * jt + 4 * g4 + i > irow) sacc[jt][i] = 0.f; } }
#pragma unroll
            for (int kt = 0; kt < 4; ++kt) pf[kt] = pack8(sacc[2 * kt], sacc[2 * kt + 1]); }
        __syncthreads();
        u32x4 accp[NSL][2];
        float s1 = 0.f, s2 = 0.f;
#pragma unroll
        for (int sl = 0; sl < NSL; ++sl) {
            { RO_TID(t2);
#pragma unroll
              for (int it = 0; it < 2; ++it) { const int idx = t2 + 512 * it, j = idx >> 3, ch = idx & 7; *(LAS u32x4*)(Vs + j * VLD + ch * 8) = pv[it]; }
#pragma unroll
              for (int it = 0; it < 4; ++it) { const int idx = t2 + 512 * it, e = idx >> 5, ch = idx & 31; *(LAS u32x4*)(Rs + e * LD + ch * 8) = ps[it]; } }
            __syncthreads();
            if (sl + 1 < NSL) RO_LOAD_SLICE(sl + 1);
            RO_TID(t3); const int lane = t3 & 63, g4 = lane >> 4, qq = (lane & 15) >> 2, pp = lane & 3;
            f32x4 acc[4];
#pragma unroll
            for (int et = 0; et < 4; ++et) { f32x4 a = (f32x4){0.f, 0.f, 0.f, 0.f};
#pragma unroll
                for (int kt = 0; kt < 4; ++kt) if (2 * kt <= w) { const LAS bf16* a0 = Vs + (32 * kt + 4 * g4 + qq) * VLD + 16 * pp + 4 * et;
                    a = MFMA16(cat8(tr4(a0), tr4(a0 + 16 * VLD)), pf[kt], a); }
                const LAS bf16* srow = Rs + (16 * qq + 4 * et + pp) * LD + 8 * g4;
#pragma unroll
                for (int s = 0; s < 8; ++s) a = MFMA16(*(const LAS bf16x8*)(srow + 32 * s), qf[s], a);
                acc[et] = a; s1 += (a[0] + a[1]) + (a[2] + a[3]); s2 += (a[0] * a[0] + a[1] * a[1]) + (a[2] * a[2] + a[3] * a[3]);
                __builtin_amdgcn_sched_barrier(0); }
            accp[sl][0] = pack_bf16x8(acc[0], acc[1]); accp[sl][1] = pack_bf16x8(acc[2], acc[3]);
            __syncthreads();
        }
#undef RO_LOAD_SLICE
        RO_TID(t4); const int lane = t4 & 63, g4 = lane >> 4, irow = 16 * w + (lane & 15); const size_t qrow = row0 + irow;
        s1 += shx(s1, 16, lane); s1 += shx(s1, 32, lane); s2 += shx(s2, 16, lane); s2 += shx(s2, 32, lane);
        const float mean = s1 * (1.0f / RDV); const float var = fmaxf(s2 * (1.0f / RDV) - mean * mean, 0.f);
        const float rstd = 1.0f / sqrtf(var + LN_EPS);
        unsigned goff = (unsigned)((irow * RET_IN + 16 * g4) * 2);
#pragma unroll
        for (int sp = 0; sp < NSL; sp += 2) {
            u32x4 gq[2][2]; f32x4 gg[2][4], gb[2][4];
#pragma unroll
            for (int d2 = 0; d2 < 2; ++d2) { const int c0 = h * RDV + (sp + d2) * ESL + 16 * g4;
#pragma unroll
                for (int q = 0; q < 2; ++q) { asm volatile("" : "+v"(goff)); gq[d2][q] = RO_LD(pbase + (size_t)(4096 + h * RDV + (sp + d2) * ESL + 8 * q) * 2, goff); }
#pragma unroll
                for (int q = 0; q < 4; ++q) { gg[d2][q] = *(const f32x4*)(gng + c0 + 4 * q); gb[d2][q] = *(const f32x4*)(gnb + c0 + 4 * q); } }
#pragma unroll
            for (int d2 = 0; d2 < 2; ++d2) { const int c0 = h * RDV + (sp + d2) * ESL + 16 * g4; u32x4 o8;
#pragma unroll
                for (int q = 0; q < 2; ++q) { const u32x4 gw = gq[d2][q]; f32x4 a0, a1; unpack_bf16x8(accp[sp + d2][q], a0, a1);
                    f32x4 y0 = (a0 - mean) * rstd * gg[d2][2 * q] + gb[d2][2 * q], y1 = (a1 - mean) * rstd * gg[d2][2 * q + 1] + gb[d2][2 * q + 1];
                    const float gv[8] = {bflo(gw.x), bfhi(gw.x), bflo(gw.y), bfhi(gw.y), bflo(gw.z), bfhi(gw.z), bflo(gw.w), bfhi(gw.w)};
#pragma unroll
                    for (int j = 0; j < 4; ++j) { y0[j] *= gv[j] * fsig(gv[j]) * A_SCALE; y1[j] *= gv[4 + j] * fsig(gv[4 + j]) * A_SCALE; }
                    o8[2 * q] = pk4_fp8(y0[0], y0[1], y0[2], y0[3]); o8[2 * q + 1] = pk4_fp8(y1[0], y1[1], y1[2], y1[3]); }
                *(u32x4*)((unsigned char*)yret + qrow * RET_V + c0) = o8; }
        }
    }
#undef RO_LD
#undef RO_TID
}

constexpr size_t AUX_S5E = 64 * MiB;
constexpr int S5L = 256, S5NC = SEQ / S5L;
__device__ __forceinline__ void cmul_add(float& rr, float& ri, float ar, float ai, float xr, float xi, float cr, float ci) { rr = ar * xr - ai * xi + cr; ri = ar * xi + ai * xr + ci; }
template <bool OUT>
__device__ __forceinline__ void phase_s5_scan(const Frame& F, KP p) {
    const bf16* X = (const bf16*)(F.ws + WS_XB); float* E = (float*)(F.ws + WS_AUX + AUX_S5E); bf16* ybuf = (bf16*)(F.ws + WS_AUX);
    const int lane = F.lane, w = F.wave, g4 = lane >> 4, l15 = lane & 15;
    LAS bf16* ut = (LAS bf16*)(F.lds + w * 12288);
    LAS bf16* Hb = (LAS bf16*)(F.lds + w * 12288 + 4096);
    constexpr int HLD = 136;
    const int gw = F.vcu * NWAVES + w, NGW = F.G * NWAVES;
    const int up16 = (lane - 16) << 2, up32 = (lane - 32) << 2, last16 = (48 + l15) << 2;
    for (int unit = gw; unit < BATCH * SG * S5NC; unit += NGW) {
        const int n = unit & (S5NC - 1), g = (unit >> 5) & 63, b = unit >> 11;
        float a1r[4], a1i[4], a4r[4], a4i[4], a8r[4], a8i[4], pwr[4], pwi[4];
        bf16x8 bfrag[8];
        const float dt = expf(gin(p, 14)[g]);
#pragma unroll
        for (int st = 0; st < 4; ++st) { const int ps = 16 * st + l15;
            const float are = gin(p, 7)[g * SP + ps], aim = gin(p, 8)[g * SP + ps];
            const float mag = expf(dt * are); const float abr = mag * cosf(dt * aim), abi = mag * sinf(dt * aim);
            const float den = are * are + aim * aim;
            const float fre = ((abr - 1.0f) * are + abi * aim) / den, fim = (abi * are - (abr - 1.0f) * aim) / den;
            a1r[st] = abr; a1i[st] = abi; { float t2r, t2i; cmul_add(t2r, t2i, abr, abi, abr, abi, 0.f, 0.f); cmul_add(a4r[st], a4i[st], t2r, t2i, t2r, t2i, 0.f, 0.f); }
            cmul_add(a8r[st], a8i[st], a4r[st], a4i[st], a4r[st], a4i[st], 0.f, 0.f);
            float qr = 1.f, qi = 0.f;
            if (g4 & 1) { qr = a4r[st]; qi = a4i[st]; }
            if (g4 & 2) { float tr, ti; cmul_add(tr, ti, qr, qi, a8r[st], a8i[st], 0.f, 0.f); qr = tr; qi = ti; }
            pwr[st] = qr; pwi[st] = qi;
            const float* br = gin(p, 9) + ((size_t)g * SP + ps) * SGC + 8 * (g4 & 1); const float* bi = gin(p, 10) + ((size_t)g * SP + ps) * SGC + 8 * (g4 & 1);
            const f32x4 r0 = *(const f32x4*)br, r1 = *(const f32x4*)(br + 4), i0 = *(const f32x4*)bi, i1 = *(const f32x4*)(bi + 4);
            const float z = (g4 < 2) ? 1.0f : 0.0f; const float fr2 = fre * z, fi2 = fim * z;
            bfrag[st] = pack8(r0 * fr2 - i0 * fi2, r1 * fr2 - i1 * fi2); bfrag[st + 4] = pack8(i0 * fr2 + r0 * fi2, i1 * fr2 + r1 * fi2);
        }
        float sr[4], si[4];
        float* Eu = E + ((size_t)(b * SG + g) * S5NC + n) * 128;
        bf16x8 cf[4]; f32x4 dsk = (f32x4){0.f, 0.f, 0.f, 0.f};
#pragma unroll
        for (int st = 0; st < 4; ++st) { sr[st] = 0.f; si[st] = 0.f; }
        if (OUT) {
#pragma unroll
            for (int st = 0; st < 4; ++st) { sr[st] = Eu[16 * st + l15]; si[st] = Eu[64 + 16 * st + l15]; }
#pragma unroll
            for (int s = 0; s < 4; ++s) { const float* cp = (s < 2 ? gin(p, 11) : gin(p, 12)) + ((size_t)g * SGC + l15) * SP + 32 * (s & 1) + 8 * g4; const float sg = s < 2 ? 1.0f : -1.0f;
                const f32x4 c0 = *(const f32x4*)cp * sg, c1 = *(const f32x4*)(cp + 4) * sg; cf[s] = pack8(c0, c1); }
            dsk = *(const f32x4*)(gin(p, 13) + g * SGC + 4 * g4); }
        const size_t tok0 = (size_t)b * SEQ + (size_t)n * S5L;
        u32x4 pre[2];
        { const bf16* src = X + (tok0 + lane) * D + g * SGC; pre[0] = *(const u32x4*)src; pre[1] = *(const u32x4*)(src + 8); }
        for (int sub = 0; sub < S5L / 64; ++sub) {
            *(LAS u32x4*)(ut + lane * 16) = pre[0]; *(LAS u32x4*)(ut + lane * 16 + 8) = pre[1];
            if (sub + 1 < S5L / 64) { const bf16* src = X + (tok0 + (sub + 1) * 64 + lane) * D + g * SGC; pre[0] = *(const u32x4*)src; pre[1] = *(const u32x4*)(src + 8); }
            LDS_WAIT(); asm volatile("" ::: "memory");
#pragma unroll (OUT ? 1 : 4)
            for (int blk = 0; blk < 4; ++blk) {
                u32x4 uw = *(const LAS u32x4*)(ut + (blk * 16 + l15) * 16 + 8 * (g4 & 1));
                if (g4 >= 2) uw = (u32x4){0u, 0u, 0u, 0u};
                const bf16x8 ufr = __builtin_bit_cast(bf16x8, uw);
                f32x4 dr[4], di[4];
#pragma unroll
                for (int st = 0; st < 4; ++st) { dr[st] = MFMA16(ufr, bfrag[st], ((f32x4){0.f, 0.f, 0.f, 0.f})); di[st] = MFMA16(ufr, bfrag[st + 4], ((f32x4){0.f, 0.f, 0.f, 0.f})); }
                float vr[4], vi[4];
#pragma unroll
                for (int st = 0; st < 4; ++st) {
                    float hr = 0.f, hi = 0.f;
#pragma unroll
                    for (int i = 0; i < 4; ++i) { float nr, ni; cmul_add(nr, ni, a1r[st], a1i[st], hr, hi, dr[st][i], di[st][i]); hr = nr; hi = ni; dr[st][i] = hr; di[st][i] = hi; }
                    vr[st] = hr; vi[st] = hi; }
#define BPF(idx, v) __builtin_bit_cast(float, __builtin_amdgcn_ds_bpermute((idx), __builtin_bit_cast(int, (v))))
                { float xr[4], xi[4];
#pragma unroll
                  for (int st = 0; st < 4; ++st) { xr[st] = BPF(up16, vr[st]); xi[st] = BPF(up16, vi[st]); }
#pragma unroll
                  for (int st = 0; st < 4; ++st) { float tr, ti; cmul_add(tr, ti, a4r[st], a4i[st], xr[st], xi[st], vr[st], vi[st]); if (g4 >= 1) { vr[st] = tr; vi[st] = ti; } }
#pragma unroll
                  for (int st = 0; st < 4; ++st) { xr[st] = BPF(up32, vr[st]); xi[st] = BPF(up32, vi[st]); }
#pragma unroll
                  for (int st = 0; st < 4; ++st) { float tr, ti; cmul_add(tr, ti, a8r[st], a8i[st], xr[st], xi[st], vr[st], vi[st]); if (g4 >= 2) { vr[st] = tr; vi[st] = ti; } } }
                float er[4], ei[4], lr[4], li[4];
#pragma unroll
                for (int st = 0; st < 4; ++st) { if (OUT) { er[st] = BPF(up16, vr[st]); ei[st] = BPF(up16, vi[st]); } else { er[st] = 0.f; ei[st] = 0.f; } lr[st] = BPF(last16, vr[st]); li[st] = BPF(last16, vi[st]); }
#undef BPF
#pragma unroll
                for (int st = 0; st < 4; ++st) {
                    if (g4 == 0) { er[st] = 0.f; ei[st] = 0.f; }
                    if (OUT) { float s0r, s0i; cmul_add(s0r, s0i, pwr[st], pwi[st], sr[st], si[st], er[st], ei[st]);
#pragma unroll
                        for (int i = 0; i < 4; ++i) { float tr, ti; cmul_add(tr, ti, a1r[st], a1i[st], s0r, s0i, 0.f, 0.f); s0r = tr; s0i = ti; dr[st][i] += s0r; di[st][i] += s0i; } }
                    { float a16r, a16i; cmul_add(a16r, a16i, a8r[st], a8i[st], a8r[st], a8i[st], 0.f, 0.f); float tr, ti; cmul_add(tr, ti, a16r, a16i, sr[st], si[st], lr[st], li[st]); sr[st] = tr; si[st] = ti; }
                    if (OUT) {
#pragma unroll
                        for (int i = 0; i < 4; ++i) { const unsigned hw = pk2(dr[st][i], di[st][i]); Hb[(4 * g4 + i) * HLD + 16 * st + l15] = (bf16)hw; Hb[(4 * g4 + i) * HLD + 64 + 16 * st + l15] = (bf16)(hw >> 16); } }
                }
                if (OUT) {
                    LDS_WAIT(); asm volatile("" ::: "memory");
                    f32x4 ya = (f32x4){0.f, 0.f, 0.f, 0.f};
#pragma unroll
                    for (int s = 0; s < 4; ++s) ya = MFMA16(cf[s], row_frag(Hb, HLD, 0, 32 * s, lane), ya);
                    const u32x2 u2 = *(const LAS u32x2*)(ut + (blk * 16 + l15) * 16 + 4 * g4);
                    const f32x4 u4 = (f32x4){bflo(u2.x), bfhi(u2.x), bflo(u2.y), bfhi(u2.y)};
                    f32x4 y = ya + dsk * u4;
#pragma unroll
                    for (int j = 0; j < 4; ++j) { const float v = y[j]; y[j] = v * fsig(1.5957691216057308f * (v + 0.044715f * v * v * v)); }
                    *(unsigned*)((unsigned char*)ybuf + (size_t)(tok0 + sub * 64 + blk * 16 + l15) * D + g * SGC + 4 * g4) = pk4_fp8(y[0] * A_SCALE, y[1] * A_SCALE, y[2] * A_SCALE, y[3] * A_SCALE);
                    asm volatile("" ::: "memory"); }
            }
            LDS_WAIT(); asm volatile("" ::: "memory");
        }
        if (!OUT && g4 == 0) {
#pragma unroll
            for (int st = 0; st < 4; ++st) { Eu[16 * st + l15] = sr[st]; Eu[64 + 16 * st + l15] = si[st]; } }
    }
}
__device__ __forceinline__ void phase_s5_carry(const Frame& F, KP p) {
    float* E = (float*)(F.ws + WS_AUX + AUX_S5E);
    for (int gt = F.vcu * NTHREADS + F.tid; gt < BATCH * SG * SP; gt += F.G * NTHREADS) {
        const int pl = gt & 63, bg = gt >> 6, g = bg & 63;
        const float dt = expf(gin(p, 14)[g]); const float are = gin(p, 7)[g * SP + pl], aim = gin(p, 8)[g * SP + pl];
        const float mag = expf(dt * are); float ar = mag * cosf(dt * aim), ai = mag * sinf(dt * aim);
#pragma unroll
        for (int q = 0; q < 8; ++q) { const float nr = ar * ar - ai * ai, ni = 2.0f * ar * ai; ar = nr; ai = ni; }
        float cr = 0.f, ci = 0.f;
        for (int n = 0; n < S5NC; ++n) { float* Eu = E + ((size_t)bg * S5NC + n) * 128; const float er = Eu[pl], ei = Eu[64 + pl];
            Eu[pl] = cr; Eu[64 + pl] = ci;
            const float nr = ar * cr - ai * ci + er, ni = ar * ci + ai * cr + ei; cr = nr; ci = ni; }
    }
}

constexpr int NPHASES = 34;
#ifndef PROBE_DRY14
#define PROBE_DRY14 0
#endif
#ifndef PROBE_DRY17
#define PROBE_DRY17 0
#endif
#ifndef PH_MASK
#define PH_MASK 0xFFFFFFFFu
#endif
#define PHT(t) ((PH_MASK >> (t)) & 1u)
constexpr int PLAN_OFF = 64;
__device__ __forceinline__ void moe_plan(const Frame& F, int layer) {
    volatile LAS int* tstart = (volatile LAS int*)(F.MISC + PLAN_OFF); volatile LAS int* cnts = tstart + 72;
    __syncthreads();
    if (F.wave == 0) {
        const unsigned* cnt = (const unsigned*)(F.ws + WS_CTL) + CW_CNT + layer * NE * 64;
        const int c = (int)__hip_atomic_load(cnt + F.lane * 64, __ATOMIC_RELAXED, __HIP_MEMORY_SCOPE_AGENT);
        int v = (c + 255) >> 8;
#pragma unroll
        for (int o = 1; o < 64; o <<= 1) { const int nb = __builtin_amdgcn_ds_bpermute((F.lane - o) << 2, v); if (F.lane >= o) v += nb; }
        tstart[F.lane + 1] = v; cnts[F.lane] = c;
        if (F.lane == 0) tstart[0] = 0;
        if (F.lane == 63) { tstart[65] = v + T / 256; cnts[64] = T; }
    }
    __syncthreads();
}
template <bool GATH> struct MoeSched2 {
    static constexpr bool GATHER = GATH, UNIFORMIZE = true, FP8 = true;
    static constexpr int ncol = GATH ? 2 : 4, K = GATH ? D / 2 : ED / 2;
    const volatile LAS int* tstart; const volatile LAS int* cnts; int ntiles, G, c, lane;
    const char* Abase; const char* Wbase; const int* lists;
    __device__ __forceinline__ bool next(int i, pg8::UnitG& u) const {
        const int nwg = ntiles * ncol; const long L = (long)i * G + c; if (L >= nwg) return false;
        int wgid = (int)L; { const int q = nwg / 8, r = nwg % 8, xcd = wgid % 8, off = wgid / 8; wgid = (xcd < r ? xcd * (q + 1) : r * (q + 1) + (xcd - r) * q) + off; }
        const int tile = wgid / ncol, pn = wgid % ncol;
        int ln; { unsigned o2 = ~0u; asm volatile("" : "+s"(o2)); ln = (int)__builtin_amdgcn_mbcnt_hi(o2, __builtin_amdgcn_mbcnt_lo(o2, 0u)); }
        const int ta = tstart[ln], tb = tstart[ln + 1];
        const unsigned long long mm = __ballot(ta <= tile && tile < tb);
        const int e = mm ? (int)__builtin_ctzll(mm) : 64;
        const int ts = __builtin_amdgcn_readfirstlane((int)tstart[e]), ce = __builtin_amdgcn_readfirstlane((int)cnts[e]);
        const int lt = tile - ts; int valid = ce - lt * 256; valid = valid > 256 ? 256 : valid;
        u.gshift = 0; u.aux = e;
        if (GATH) {
            u.B = Wbase + (size_t)e * WMOE_E_BYTES + (size_t)pn * 256 * K * 2;
            if (e < 64) { u.A = Abase; u.gidx = lists + (size_t)e * T + lt * 256; u.gcnt = valid; }
            else { u.A = Abase + (size_t)lt * 256 * K * 2; u.gidx = nullptr; u.gcnt = 0; }
            u.row0 = tile * 256; u.col0 = pn * 128;
        } else {
            u.B = Wbase + (size_t)e * WMOE_E_BYTES + (size_t)512 * 1024 * 2 + (size_t)pn * 256 * K * 2;
            u.A = Abase + (size_t)tile * 256 * K * 2; u.gidx = nullptr; u.gcnt = valid;
            u.row0 = tile * 256; u.col0 = pn * 256;
        }
        return true;
    }
};
__device__ __forceinline__ void phase_load_x(const Frame& F, KP p) {
    const float* xin = gin(p, 0); bf16* XB = (bf16*)(F.ws + WS_XB);
    for (size_t i = (size_t)F.vcu * NTHREADS + F.tid; i < (size_t)T * D / 8; i += (size_t)F.G * NTHREADS) {
        const f32x4 a = *(const f32x4*)(xin + i * 8), b = *(const f32x4*)(xin + i * 8 + 4);
        *(u32x4*)(XB + i * 8) = pack_bf16x8(a, b);
        u32x2 q8; q8.x = pk4_fp8(a[0], a[1], a[2], a[3]); q8.y = pk4_fp8(b[0], b[1], b[2], b[3]); *(u32x2*)((unsigned char*)(F.ws + WS_X) + i * 8) = q8; }
}

__global__ void __launch_bounds__(NTHREADS, 2) fwd_kernel(Params p_unused) {
    KP p0 = (KP)__builtin_amdgcn_kernarg_segment_ptr();
    extern __shared__ __attribute__((aligned(16))) unsigned char lds_raw[];
    Frame F0;
    F0.lds = (LAS unsigned char*)lds_raw; F0.MISC = (volatile LAS unsigned*)(F0.lds + MISC_OFF);
    F0.tid = threadIdx.x; F0.lane = F0.tid & 63; F0.wave = __builtin_amdgcn_readfirstlane(F0.tid >> 6);
    F0.G = gridDim.x; { const int bq = blockIdx.x; F0.vcu = (F0.G % 8 == 0) ? (bq % 8) * (F0.G / 8) + bq / 8 : bq; }
    F0.ws = p0->ws;
    const int bx0 = blockIdx.x;
    for (int u = F0.tid; u < (LDS_BYTES - MISC_OFF) / 4; u += NTHREADS) ((LAS unsigned*)(F0.lds + MISC_OFF))[u] = 0u;
    __syncthreads();
    XcdBarrier bar; bar.bar = (unsigned*)(p0->ws + WS_CTL) + CW_BAR; bar.x = 0; bar.st = nullptr;
    const int use_bar = p0->use_bar;
    if (use_bar) bar = xcd_barrier_post((unsigned*)(p0->ws + WS_CTL) + CW_BAR, F0.MISC + 8);
    const int lo = p0->ph_lo, hi = p0->ph_hi;
#define PHASE_BEGIN Frame F = F0; KP p = p0; { unsigned ones_ = ~0u; asm volatile("" : "+s"(ones_)); F.lane = (int)__builtin_amdgcn_mbcnt_hi(ones_, __builtin_amdgcn_mbcnt_lo(ones_, 0u)); } asm volatile("" : "+v"(F.lane)); F.tid = F.wave * 64 + F.lane; asm volatile("" : "+v"(F.tid));   GAS unsigned char* wsg_ = (GAS unsigned char*)F0.ws; asm volatile("" : "+s"(F.wave), "+s"(F.vcu), "+s"(F.G), "+s"(wsg_), "+s"(p)); \
    F.ws = (unsigned char*)wsg_; int bx = bx0; asm volatile("" : "+s"(bx)); unsigned char* ws = F.ws; (void)ws; (void)bx;
#pragma unroll 1
    for (int ph = lo; ph < hi; ++ph) {
        int layer = 0, type = 0;
        if (ph > 0) { layer = ph >= 26 ? 3 : (ph >= 18 ? 2 : (ph >= 9 ? 1 : 0)); const int q = ph - (layer == 3 ? 26 : (layer == 2 ? 18 : (layer == 1 ? 9 : 1))); const int kind = layer % 3;
            if (kind == 0) type = q < 4 ? 1 + q : 14 + (q - 4); else if (kind == 1) type = q < 5 ? 5 + q : 14 + (q - 5); else type = q < 4 ? 10 + q : 14 + (q - 4); }
        const int j = layer / 3;
#ifdef REPEAT_MASK
        const int nrep = ((REPEAT_MASK >> type) & 1u) ? 2 : 1;
#else
        const int nrep = 1;
#endif
#pragma unroll 1
        for (int rep = 0; rep < nrep; ++rep) {
        if (rep > 0 && use_bar) xcd_barrier(bar);
        if (PHT(0) && type == 0) { PHASE_BEGIN; phase_conv_mixers(F, p); phase_conv_moe(F, p, 0); phase_load_x(F, p); }
        else if (PHT(1) && type == 1) { PHASE_BEGIN; DenseSched8 S; S.init(ws + WS_X, ws + WS_ATT_IN_T + (size_t)j * ATT_IN * D, T, ATT_IN, D / 2, F.G, bx); EpiStoreBf16 E{(bf16*)(ws + WS_BIG), ATT_IN, WUP_INV, 0.08838834764831845f};
            pg8::gemm_phase(F.lds, F.tid, D / 2, S, E); }
        else if (PHT(2) && type == 2) { PHASE_BEGIN; phase_attn(F, bx); }
        else if (PHT(3) && type == 3) { PHASE_BEGIN; phase_attn_combine(F); }
        else if (PHT(4) && type == 4) { PHASE_BEGIN; DenseSched8 S; S.init(ws + WS_AUX + AUX_OB, ws + WS_ATT_OUT_T + (size_t)j * D * D, T, D, D / 2, F.G, bx); EpiResid E{(const bf16*)(ws + WS_XB), (bf16*)(ws + WS_Y), 1.0f / (A_SCALE * WUP_SCALE)};
            pg8::gemm_phase(F.lds, F.tid, D / 2, S, E); }
        else if (PHT(5) && type == 5) { PHASE_BEGIN; DenseSched8 S; S.init(ws + WS_X, ws + WS_RET_IN_T, T, RET_IN, D / 2, F.G, bx); EpiRetIn E{(bf16*)(ws + WS_BIG), RET_IN};
            pg8::gemm_phase(F.lds, F.tid, D / 2, S, E); }
        else if (PHT(6) && type == 6) { PHASE_BEGIN; phase_ret_u(F); }
        else if (PHT(7) && type == 7) { PHASE_BEGIN; phase_ret_scan(F); }
        else if (PHT(8) && type == 8) { PHASE_BEGIN; phase_ret_out(F, p); }
        else if (PHT(9) && type == 9) { PHASE_BEGIN; DenseSched8 S; S.init(ws + WS_BIG + BIG_YRET, ws + WS_RET_OUT_T, T, D, RET_V / 2, F.G, bx); EpiResid E{(const bf16*)(ws + WS_XB), (bf16*)(ws + WS_Y), 1.0f / (A_SCALE * WUP_SCALE)};
            pg8::gemm_phase(F.lds, F.tid, RET_V / 2, S, E); }
        else if (PHT(10) && type == 10) { PHASE_BEGIN; phase_s5_scan<false>(F, p); }
        else if (PHT(11) && type == 11) { PHASE_BEGIN; phase_s5_carry(F, p); }
        else if (PHT(12) && type == 12) { PHASE_BEGIN; phase_s5_scan<true>(F, p); }
        else if (PHT(13) && type == 13) { PHASE_BEGIN; DenseSched8 S; S.init(ws + WS_AUX, ws + WS_GLU_T, T, 2 * D, D / 2, F.G, bx); EpiGluResid E{(const bf16*)(ws + WS_XB), (bf16*)(ws + WS_Y), 1.0f / (A_SCALE * WUP_SCALE)};
            pg8::gemm_phase(F.lds, F.tid, D / 2, S, E); }
        else if (PHT(14) && type == 14) { PHASE_BEGIN; phase_lnr(F, p, layer, PROBE_DRY14 && true); if (PROBE_DRY14) { if (use_bar) xcd_barrier(bar); phase_lnr(F, p, layer, false); } }
        else if (PHT(15) && type == 15) { PHASE_BEGIN; moe_plan(F, layer);
            MoeSched2<true> S; S.tstart = (const volatile LAS int*)(F.MISC + PLAN_OFF); S.cnts = S.tstart + 72; S.ntiles = __builtin_amdgcn_readfirstlane((int)S.tstart[65]); S.G = F.G; S.c = bx; S.lane = F.lane;
            S.Abase = (const char*)(ws + WS_X); S.Wbase = (const char*)(ws + WS_WMOE); S.lists = (const int*)(ws + WS_LIST);
            EpiMoeUp E{(unsigned char*)(ws + WS_H)};
            pg8::gemm_phase(F.lds, F.tid, D / 2, S, E); }
        else if (PHT(16) && type == 16) { PHASE_BEGIN; moe_plan(F, layer);
            { MoeSched2<false> S; S.tstart = (const volatile LAS int*)(F.MISC + PLAN_OFF); S.cnts = S.tstart + 72; S.ntiles = __builtin_amdgcn_readfirstlane((int)S.tstart[64]); S.G = F.G; S.c = bx; S.lane = F.lane;
              S.Abase = (const char*)(ws + WS_H); S.Wbase = (const char*)(ws + WS_WMOE); S.lists = (const int*)(ws + WS_LIST);
              EpiStoreFp8 E{(unsigned char*)(ws + WS_BIG), D};
              pg8::gemm_phase(F.lds, F.tid, ED / 2, S, E); }
            { const int sh0 = __builtin_amdgcn_readfirstlane((int)((const volatile LAS int*)(F.MISC + PLAN_OFF))[64]);
              DenseSched8 S; S.init(ws + WS_H + (size_t)sh0 * 256 * ED, ws + WS_WMOE + (size_t)64 * WMOE_E_BYTES + (size_t)512 * 1024 * 2, T, D, ED / 2, F.G, bx); EpiResid8 E{(const bf16*)(ws + WS_XB), (bf16*)(ws + WS_Y), 1.0f / (H_SCALE * WUP_SCALE)};
              int tid2; { unsigned o2 = ~0u; asm volatile("" : "+s"(o2)); tid2 = F.wave * 64 + (int)__builtin_amdgcn_mbcnt_hi(o2, __builtin_amdgcn_mbcnt_lo(o2, 0u)); }
              pg8::gemm_phase(F.lds, tid2, ED / 2, S, E); } }
        else if (PHT(17) && type == 17) { PHASE_BEGIN; moe_plan(F, layer); if (PROBE_DRY17) { phase_combine(F, p, layer, true); if (use_bar) xcd_barrier(bar); } phase_combine(F, p, layer); if (layer + 1 < DEPTH) phase_conv_moe(F, p, layer + 1); }
        }
        if (use_bar && ph + 1 < hi) xcd_barrier(bar);
    }
}

#ifndef MK_PER_PHASE
#define MK_PER_PHASE 0
#endif
extern "C" void kernel_launch(void* const* d_in, const int* in_sizes, int n_in, void* d_out, int out_size, void* d_ws, size_t ws_size, hipStream_t stream) {
    static int grid = 0;
    if (grid == 0) {
        if (n_in != 26 || in_sizes[0] != T * D || out_size != T * D || ws_size < WS_END) { fprintf(stderr, "kernel_launch: unexpected shapes / workspace (n_in %d, in0 %d, out %d, ws %zu < %zu)\n", n_in, n_in > 0 ? in_sizes[0] : -1, out_size, ws_size, (size_t)WS_END); grid = -1; return; }
        int dev = 0, cus = 0, per_cu = 0;
        if (hipGetDevice(&dev) != hipSuccess || hipDeviceGetAttribute(&cus, hipDeviceAttributeMultiprocessorCount, dev) != hipSuccess) { grid = -1; return; }
        if (hipFuncSetAttribute((const void*)fwd_kernel, hipFuncAttributeMaxDynamicSharedMemorySize, LDS_BYTES) != hipSuccess) { fprintf(stderr, "kernel_launch: hipFuncSetAttribute failed\n"); grid = -1; return; }
        if (hipOccupancyMaxActiveBlocksPerMultiprocessor(&per_cu, (const void*)fwd_kernel, NTHREADS, LDS_BYTES) != hipSuccess || per_cu < 1) { fprintf(stderr, "kernel_launch: occupancy query says %d blocks per CU\n", per_cu); per_cu = 1; }
        (void)hipGetLastError();
        grid = cus;
    }
    if (grid < 0) return;
    (void)hipMemsetAsync((char*)d_ws + WS_CTL, 0, CTL_ZERO_BYTES, stream);
    Params p{};
    for (int i = 0; i < 26; ++i) p.in[i] = (const float*)d_in[i];
    p.out = (float*)d_out; p.ws = (unsigned char*)d_ws;
#if MK_PER_PHASE
    for (int k = 0; k < NPHASES; ++k) { p.ph_lo = k; p.ph_hi = k + 1; p.use_bar = 0; hipLaunchKernelGGL(fwd_kernel, dim3(grid), dim3(NTHREADS), LDS_BYTES, stream, p); }
#else
    p.ph_lo = 0; p.ph_hi = NPHASES; p.use_bar = 1;
    hipLaunchKernelGGL(fwd_kernel, dim3(grid), dim3(NTHREADS), LDS_BYTES, stream, p);
#endif
}
```

```cpp
#include <hip/hip_runtime.h>
#include <cstdio>
#include <cstdint>

#define LAS __attribute__((address_space(3)))
#define GAS __attribute__((address_space(1)))
typedef unsigned short bf16;
typedef short bf16x8 __attribute__((ext_vector_type(8)));
typedef short bf16x4 __attribute__((ext_vector_type(4)));
typedef float f32x4 __attribute__((ext_vector_type(4)));
typedef float f32x2 __attribute__((ext_vector_type(2)));
typedef unsigned u32x4 __attribute__((ext_vector_type(4)));
typedef unsigned u32x2 __attribute__((ext_vector_type(2)));
typedef GAS unsigned gu32;

constexpr int D = 1024, BATCH = 2, SEQ = 8192, T = BATCH * SEQ, DEPTH = 4;
constexpr int AH = 8, AHD = 128, ATT_IN = 9216;
constexpr int RH = 4, RDK = 256, RDV = 512, RET_IN = 6144, RET_V = 2048, RC = 128, RNC = SEQ / RC;
constexpr int SG = 64, SGC = 16, SP = 64;
constexpr int NE = 64, TOPK = 8, NEG = 8, ED = 256, NSLOT = 9;
constexpr float LN_EPS = 1e-5f;
constexpr float ALPHA = 1.6817928305074292f;
constexpr int NWAVES = 8, NTHREADS = 512;

__device__ __forceinline__ unsigned f2bf(float f) { unsigned u = __builtin_bit_cast(unsigned, f); return (u + 0x7fffu + ((u >> 16) & 1u)) >> 16; }
__device__ __forceinline__ unsigned pk2(float lo, float hi) { unsigned r; asm("s_nop 1\n\tv_cvt_pk_bf16_f32 %0, %1, %2" : "=v"(r) : "v"(lo), "v"(hi)); return r; }
__device__ __forceinline__ unsigned pk2sw(float lo, float hi) { return f2bf(lo) | (f2bf(hi) << 16); }
__device__ __forceinline__ unsigned pk2hw(float lo, float hi) { unsigned r; asm volatile("v_cvt_pk_bf16_f32 %0, %1, %2" : "=v"(r) : "v"(lo), "v"(hi)); return r; }
__device__ __forceinline__ float bf2f(unsigned b) { return __builtin_bit_cast(float, b << 16); }
__device__ __forceinline__ float bflo(unsigned w) { return __builtin_bit_cast(float, w << 16); }
__device__ __forceinline__ float bfhi(unsigned w) { return __builtin_bit_cast(float, w & 0xffff0000u); }
__device__ __forceinline__ float shx(float v, int m, int lane) { return __builtin_bit_cast(float, __builtin_amdgcn_ds_bpermute((lane ^ m) << 2, __builtin_bit_cast(int, v))); }
__device__ __forceinline__ int shx_i(int v, int m, int lane) { return __builtin_amdgcn_ds_bpermute((lane ^ m) << 2, v); }
__device__ __forceinline__ float rdl(float v, int src) { return __builtin_bit_cast(float, __builtin_amdgcn_readlane(__builtin_bit_cast(int, v), src)); }
template <int CTRL, int RM = 0xf, int BM = 0xf> __device__ __forceinline__ float dpp0(float v) { return __builtin_bit_cast(float, __builtin_amdgcn_update_dpp(0, __builtin_bit_cast(int, v), CTRL, RM, BM, true)); }
template <int CTRL, int RM = 0xf, int BM = 0xf> __device__ __forceinline__ float dppo(float old, float v) { return __builtin_bit_cast(float, __builtin_amdgcn_update_dpp(__builtin_bit_cast(int, old), __builtin_bit_cast(int, v), CTRL, RM, BM, false)); }
__device__ __forceinline__ float wave_sum(float v, int lane) {
    (void)lane;
    v += dpp0<0x111>(v); v += dpp0<0x112>(v); v += dpp0<0x114>(v); v += dpp0<0x118>(v);
    v += dpp0<0x142, 0xa>(v);
    v += dpp0<0x143, 0xc>(v);
    return rdl(v, 63);
}
__device__ __forceinline__ float max8(float v) {
    v = fmaxf(v, dppo<0xb1>(v, v)); v = fmaxf(v, dppo<0x4e>(v, v)); v = fmaxf(v, dppo<0x141>(v, v)); return v;
}
__device__ __forceinline__ float fsig(float x) { return __builtin_amdgcn_rcpf(1.0f + __expf(-x)); }
#define LDS_WAIT() asm volatile("s_waitcnt lgkmcnt(0)" ::: "memory")
#define VM_WAIT() asm volatile("s_waitcnt vmcnt(0)" ::: "memory")
__device__ __forceinline__ const char* rfl_ptr(const char* p) {
    unsigned long long v = (unsigned long long)p; unsigned lo = __builtin_amdgcn_readfirstlane((unsigned)v), hi = __builtin_amdgcn_readfirstlane((unsigned)(v >> 32));
    return (const char*)(((unsigned long long)hi << 32) | lo);
}
__device__ __forceinline__ bf16x8 row_frag(const LAS bf16* base, int ld, int row0, int col0, int lane) {
    return *(const LAS bf16x8*)(base + (row0 + (lane & 15)) * ld + col0 + 8 * (lane >> 4));
}
__device__ __forceinline__ bf16x4 tr4(const LAS bf16* addr) { return __builtin_amdgcn_ds_read_tr16_b64_v4i16((LAS bf16x4*)addr); }
__device__ __forceinline__ bf16x8 cat8(bf16x4 a, bf16x4 b) { bf16x8 r; r[0] = a[0]; r[1] = a[1]; r[2] = a[2]; r[3] = a[3]; r[4] = b[0]; r[5] = b[1]; r[6] = b[2]; r[7] = b[3]; return r; }
#define MFMA16(a, b, c) __builtin_amdgcn_mfma_f32_16x16x32_bf16((a), (b), (c), 0, 0, 0)
__device__ __forceinline__ bf16x8 pack8(f32x4 a, f32x4 b) {
    u32x4 w; w.x = pk2(a[0], a[1]); w.y = pk2(a[2], a[3]); w.z = pk2(b[0], b[1]); w.w = pk2(b[2], b[3]); return __builtin_bit_cast(bf16x8, w);
}

namespace pg8 {
typedef int v4i_t __attribute__((ext_vector_type(4)));
typedef int v8i_t __attribute__((ext_vector_type(8)));
constexpr int BM = 256, BK = 64, HALF = 128, HTB = HALF * BK * 2, STAGE_BYTES = 8 * HTB;
__device__ __forceinline__ int lds_byte(int r, int c) { const int st = (r >> 4) * 2 + (c >> 5), rr = r & 15, cc = c & 31, ob = rr * 64 + cc * 2; return st * 1024 + (ob ^ (((ob >> 9) & 1) << 5)); }
__device__ __forceinline__ void stage_rc(int b, int& R, int& C) { const int st = b / 1024, sb = b % 1024, swz = sb ^ (((sb >> 9) & 1) << 5); R = (st >> 1) * 16 + swz / 64; C = (st & 1) * 32 + (swz % 64) / 2; }
__device__ __forceinline__ int perm32(int rho) { const int n = rho >> 4, i = rho & 15; return 8 * (i >> 2) + 4 * n + (i & 3); }

struct UnitG {
    const char* A;
    const char* B;
    const int* gidx;
    int gcnt, gshift;
    int row0, col0;
    int aux;
};

__device__ __forceinline__ void uniformize(UnitG& u) { u.A = rfl_ptr(u.A); u.B = rfl_ptr(u.B); u.gidx = (const int*)rfl_ptr((const char*)u.gidx); u.gcnt = __builtin_amdgcn_readfirstlane(u.gcnt); u.gshift = __builtin_amdgcn_readfirstlane(u.gshift);
    u.row0 = __builtin_amdgcn_readfirstlane(u.row0); u.col0 = __builtin_amdgcn_readfirstlane(u.col0); u.aux = __builtin_amdgcn_readfirstlane(u.aux); }
template <class Epi, class Sched>
__device__ __forceinline__ void gemm_phase(LAS unsigned char* lds, const int tid, const int K, const Sched& S, const Epi& E) {
    constexpr bool F8 = Sched::FP8;
    constexpr bool GATHER = Sched::GATHER;
    const int wid = __builtin_amdgcn_readfirstlane(tid >> 6), lane = tid & 63, wr = wid >> 2, wc = wid & 3, fr = lane & 15, fq = lane >> 4;
    int nt = K / BK; asm volatile("" : "+s"(nt));
    constexpr bool P16 = Epi::PERM16;
    unsigned voffB[2], voffB1[2], vA[2][2];
#pragma unroll
    for (int i = 0; i < 2; ++i) { int R, C; stage_rc(tid * 16 + i * 8192, R, C); const int Rb = Epi::PERM ? ((R & ~31) + perm32(R & 31)) : R; voffB[i] = (unsigned)(Rb * K + C) * 2u; voffB1[i] = voffB[i]; vA[0][i] = (unsigned)(R * K + C) * 2u; vA[1][i] = vA[0][i];
        if constexpr (P16) { const int x = R & 31, src = 64 * (R >> 5) + 16 * ((x >> 2) & 3) + 4 * (x >> 4) + (x & 3); voffB[i] = (unsigned)(src * K + C) * 2u; voffB1[i] = (unsigned)((src + 8) * K + C) * 2u; } }
    const size_t kstep = (size_t)(BK * 2);
    const size_t hstep = (size_t)HALF * K * 2;
    const size_t hstepB = P16 ? 0 : hstep;
    const size_t hstepA = GATHER ? 0 : hstep;
    const size_t hstepB1 = P16 ? (size_t)8 * K * 2 : hstep, bstep = (size_t)(P16 ? 128 : 64) * K * 2, astep = (size_t)64 * K * 2;
    unsigned vB0 = voffB[0], vA0 = vA[0][0];
    const unsigned ldsw = (unsigned)wid * 1024u;
    const int aoff = lds_byte(wr * 64 + fr, fq * 8), boff = lds_byte(wc * 32 + fr, fq * 8);
    LAS u32x4* park = (LAS u32x4*)(lds + STAGE_BYTES) + tid;
#define PG8_SA(b, h) (((b) * 2 + (h)) * HTB)
#define PG8_SB(b, h) ((4 + (b) * 2 + (h)) * HTB)
#define PG8_STAGE(bufoff, gbase, voff) do { _Pragma("unroll") for (int _i = 0; _i < 2; ++_i) { asm volatile("" : "+v"((voff)[_i]));   \
        __builtin_amdgcn_global_load_lds((const unsigned*)((const char*)(gbase) + (voff)[_i]), (LAS unsigned*)(lds + (bufoff) + ldsw + _i * 8192), 16, 0, 0); } } while (0)
#define PG8_STAGEU(bufoff, gbase, v0, step1) do { asm volatile("" : "+v"(v0)); __builtin_amdgcn_global_load_lds((const unsigned*)((const char*)(gbase) + (v0)), (LAS unsigned*)(lds + (bufoff) + ldsw), 16, 0, 0); \
        asm volatile("" : "+v"(v0)); __builtin_amdgcn_global_load_lds((const unsigned*)((const char*)(gbase) + (step1) + (v0)), (LAS unsigned*)(lds + (bufoff) + ldsw + 8192), 16, 0, 0); } while (0)
#define PG8_STB(b, h, base) PG8_STAGEU(PG8_SB(b, h), (base) + (h) * hstepB1, vB0, bstep)
#define PG8_STA(b, h, base) do { if constexpr (GATHER) PG8_STAGE(PG8_SA(b, h), (base), vA[h]); else PG8_STAGEU(PG8_SA(b, h), (base) + (h) * hstep, vA0, astep); } while (0)
    constexpr int FKS = 1024;
#define PG8_LD2(p_) __builtin_shufflevector(*(const LAS v4i_t*)(p_), *(const LAS v4i_t*)((p_) + FKS), 0, 1, 2, 3, 4, 5, 6, 7)
#define PG8_LDA(dst, b, h) do { _Pragma("unroll") for (int m = 0; m < 4; ++m) dst[m] = PG8_LD2(lds + PG8_SA(b, h) + aoff + m * 2048); } while (0)
#define PG8_LDB(dst, b, h) do { _Pragma("unroll") for (int n = 0; n < 2; ++n) dst[n] = PG8_LD2(lds + PG8_SB(b, h) + boff + n * 2048); } while (0)
#define PG8_LO(v) __builtin_bit_cast(bf16x8, __builtin_shufflevector((v), (v), 0, 1, 2, 3))
#define PG8_HI(v) __builtin_bit_cast(bf16x8, __builtin_shufflevector((v), (v), 4, 5, 6, 7))
#define PG8_MMA(ai, bj, At, Bt) do { __builtin_amdgcn_s_setprio(1); _Pragma("unroll") for (int m = 0; m < 4; ++m) _Pragma("unroll") for (int n = 0; n < 2; ++n) { \
        if constexpr (F8) { acc[ai][bj][m][n] = __builtin_amdgcn_mfma_scale_f32_16x16x128_f8f6f4(Bt[n], At[m], acc[ai][bj][m][n], 0, 0, 0, 0x7F7F7F7F, 0, 0x7F7F7F7F); } \
        else { acc[ai][bj][m][n] = __builtin_amdgcn_mfma_f32_16x16x32_bf16(PG8_LO(Bt[n]), PG8_LO(At[m]), acc[ai][bj][m][n], 0, 0, 0); \
               acc[ai][bj][m][n] = __builtin_amdgcn_mfma_f32_16x16x32_bf16(PG8_HI(Bt[n]), PG8_HI(At[m]), acc[ai][bj][m][n], 0, 0, 0); } } __builtin_amdgcn_s_setprio(0); } while (0)
#define PG8_WAIT_V(n) asm volatile("s_waitcnt vmcnt(" #n ")" ::: "memory")
#define PG8_WAIT_L(n) asm volatile("s_waitcnt lgkmcnt(" #n ")" ::: "memory")
#define PG8_BAR __builtin_amdgcn_s_barrier()
#define PG8_SCHED __builtin_amdgcn_sched_barrier(0)
#define PG8_VOFF(u, v00, v01, v10, v11) do { int _R0, _C0, _R1, _C1; stage_rc(tid * 16, _R0, _C0); stage_rc(tid * 16 + 8192, _R1, _C1); int _r00 = _R0, _r01 = _R1, _r10 = HALF + _R0, _r11 = HALF + _R1; \
        if ((u).gidx) { const GAS int* _gp = (const GAS int*)(u).gidx; const int _gc = (u).gcnt;     \
            const int _a = _gp[_r00 < _gc ? _r00 : 0] >> (u).gshift, _b = _gp[_r01 < _gc ? _r01 : 0] >> (u).gshift, _c = _gp[_r10 < _gc ? _r10 : 0] >> (u).gshift, _d = _gp[_r11 < _gc ? _r11 : 0] >> (u).gshift; \
            _r00 = _a; _r01 = _b; _r10 = _c; _r11 = _d; } \
        v00 = (unsigned)(_r00 * K + _C0) * 2u; v01 = (unsigned)(_r01 * K + _C1) * 2u; v10 = (unsigned)(_r10 * K + _C0) * 2u; v11 = (unsigned)(_r11 * K + _C1) * 2u; } while (0)
    UnitG cur, nxt; int ui = 0;
    if (!S.next(0, cur)) return;
    if constexpr (Sched::UNIFORMIZE) uniformize(cur);
    f32x4 acc[2][2][4][2];
#pragma unroll
    for (int a = 0; a < 2; ++a)
#pragma unroll
        for (int b = 0; b < 2; ++b)
#pragma unroll
            for (int m = 0; m < 4; ++m)
#pragma unroll
                for (int n = 0; n < 2; ++n) acc[a][b][m][n] = (f32x4){0.f, 0.f, 0.f, 0.f};
    v8i_t At[4], B0[2], B1[2];
    if constexpr (GATHER) PG8_VOFF(cur, vA[0][0], vA[0][1], vA[1][0], vA[1][1]);
    const char* cA = cur.A; const char* cB = cur.B;
    PG8_STB(0, 0, cB); PG8_STB(0, 1, cB); PG8_STA(0, 0, cA); PG8_STA(0, 1, cA);
    if (wr == 1) PG8_BAR;
    PG8_WAIT_V(2); PG8_BAR;
    PG8_STB(1, 0, cB + kstep); PG8_STA(1, 0, cA + kstep); PG8_STB(1, 1, cB + kstep);
    PG8_WAIT_V(6); PG8_BAR;
    for (;;) {
        const bool has_next = S.next(ui + 1, nxt);
        if constexpr (Sched::UNIFORMIZE) { if (has_next) uniformize(nxt); }
        const char* nA = cA; const char* nB = cB;
        if (has_next) { nA = nxt.A; nB = nxt.B; }
        if constexpr (GATHER) { u32x4 pv; pv.x = vA[0][0]; pv.y = vA[0][1]; pv.z = vA[1][0]; pv.w = vA[1][1];
            if (has_next) PG8_VOFF(nxt, pv.x, pv.y, pv.z, pv.w);
            *park = pv; }
#pragma unroll 1
        for (int t = 0; t < nt; t += 2) {
            const bool last = (t == nt - 2);
            const char* a1 = cA + (size_t)(t + 1) * kstep;
            const char* a2 = last ? nA : cA + (size_t)(t + 2) * kstep; const char* b2 = last ? nB : cB + (size_t)(t + 2) * kstep;
            const char* a3 = a2 + kstep; const char* b3 = b2 + kstep;
            PG8_LDB(B0, 0, 0); PG8_LDB(B1, 0, 1); PG8_SCHED; PG8_LDA(At, 0, 0); PG8_STA(1, 1, a1);
            PG8_WAIT_V(8); PG8_WAIT_L(0); PG8_BAR; PG8_MMA(0, 0, At, B0); PG8_MMA(0, 1, At, B1); PG8_BAR; PG8_SCHED;
            if constexpr (GATHER) { if (last) { const u32x4 pv = *park; vA[0][0] = pv.x; vA[0][1] = pv.y; vA[1][0] = pv.z; vA[1][1] = pv.w; } }
            PG8_LDA(At, 0, 1); PG8_STB(0, 0, b2); PG8_STB(0, 1, b2); PG8_STA(0, 0, a2);
            PG8_WAIT_V(8); PG8_WAIT_L(0); PG8_BAR; PG8_MMA(1, 0, At, B0); PG8_MMA(1, 1, At, B1); PG8_BAR; PG8_SCHED;
            PG8_LDB(B0, 1, 0); PG8_LDB(B1, 1, 1); PG8_SCHED; PG8_LDA(At, 1, 0); PG8_STA(0, 1, a2);
            PG8_WAIT_V(8); PG8_WAIT_L(0); PG8_BAR; PG8_MMA(0, 0, At, B0); PG8_MMA(0, 1, At, B1); PG8_BAR; PG8_SCHED;
            PG8_LDA(At, 1, 1); PG8_STB(1, 0, b3); PG8_STB(1, 1, b3); PG8_STA(1, 0, a3);
            PG8_WAIT_V(8); PG8_WAIT_L(0); PG8_BAR; PG8_MMA(1, 0, At, B0); PG8_MMA(1, 1, At, B1); PG8_BAR; PG8_SCHED;
        }
        if (wr == 0) PG8_BAR;
        { int l2; { unsigned o2 = ~0u; asm volatile("" : "+s"(o2)); l2 = (int)__builtin_amdgcn_mbcnt_hi(o2, __builtin_amdgcn_mbcnt_lo(o2, 0u)); }
          E(acc, cur, wr, wc, l2 & 15, l2 >> 4); }
        if (!has_next) break;
#pragma unroll
        for (int a = 0; a < 2; ++a)
#pragma unroll
            for (int b = 0; b < 2; ++b)
#pragma unroll
                for (int m = 0; m < 4; ++m)
#pragma unroll
                    for (int n = 0; n < 2; ++n) acc[a][b][m][n] = (f32x4){0.f, 0.f, 0.f, 0.f};
        cur = nxt; cA = nA; cB = nB; ++ui;
        if (wr == 1) PG8_BAR;
    }
    PG8_WAIT_V(0);
    PG8_BAR;
#undef PG8_SA
#undef PG8_SB
#undef PG8_STAGE
#undef PG8_STAGEU
#undef PG8_STB
#undef PG8_STA
#undef PG8_LDA
#undef PG8_LDB
#undef PG8_LD2
#undef PG8_LO
#undef PG8_HI
#undef PG8_MMA
#undef PG8_WAIT_V
#undef PG8_WAIT_L
#undef PG8_BAR
#undef PG8_SCHED
#undef PG8_VOFF
}
}

constexpr size_t MiB = 1u << 20;
constexpr size_t WS_CTL = 0, CTL_ZERO_BYTES = 1 * MiB;
constexpr size_t WS_ATT_IN_T = 1 * MiB;
constexpr size_t WS_ATT_OUT_T = WS_ATT_IN_T + 36 * MiB;
constexpr size_t WS_RET_IN_T = WS_ATT_OUT_T + 4 * MiB;
constexpr size_t WS_RET_OUT_T = WS_RET_IN_T + 12 * MiB;
constexpr size_t WS_GLU_T = WS_RET_OUT_T + 4 * MiB;
constexpr size_t WS_RT_HI = WS_GLU_T + 4 * MiB;
constexpr size_t WS_RT_LO = WS_RT_HI + 512 * 1024;
constexpr size_t WS_WMOE = WS_RT_HI + 1 * MiB;
constexpr size_t WMOE_E_BYTES = (size_t)(512 * 1024 + 1024 * 256) * 2;
constexpr size_t WS_X = WS_WMOE + 98 * MiB;
constexpr size_t WS_Y = WS_X + 64 * MiB;
constexpr size_t WS_XB = WS_Y + 64 * MiB;
constexpr size_t WS_BIG = WS_XB + 32 * MiB;
constexpr size_t WS_AUX = WS_BIG + 288 * MiB;
constexpr size_t WS_H = WS_AUX + 160 * MiB;
constexpr size_t WS_LIST = WS_H + 80 * MiB;
constexpr size_t WS_TRASH = WS_LIST + 8 * MiB;
constexpr size_t WS_END = WS_TRASH + 1 * MiB;
static_assert(WS_END <= 1024 * MiB, "workspace map");
constexpr int CW_BAR = 4096;
constexpr int CW_CNT = 16384;
constexpr int CW_CHK = 65536;
constexpr int HROWS = 163840;

#define XB_TMO      128
#define XB_XCNT(j)  (256  + 64 * (j))
#define XB_XSUB(j)  (1280 + 64 * (j))
#define XB_XGEN(j)  (2304 + 64 * (j))
#define XB_TOP      3328
#define XB_TOPGEN   3392
#define XCD_BAR_WORDS 3456
#define XB_SPIN_CAP (1u << 20)
__device__ __forceinline__ unsigned xb_ld(unsigned* p)              { return __hip_atomic_load(p, __ATOMIC_RELAXED, __HIP_MEMORY_SCOPE_AGENT); }
__device__ __forceinline__ unsigned xb_add(unsigned* p, unsigned v) { return __hip_atomic_fetch_add(p, v, __ATOMIC_RELAXED, __HIP_MEMORY_SCOPE_AGENT); }
__device__ __forceinline__ unsigned xb_xcc_id() { return (unsigned)__builtin_amdgcn_s_getreg((3 << 11) | 20) & 0xFu; }
#define XB_SPIN(cond, bar) do { unsigned _sp = 0; while (cond) { __builtin_amdgcn_s_sleep(1); \
    if ((++_sp & 255u) == 0u) { if (xb_ld(&(bar)[XB_TMO])) break; if (_sp > XB_SPIN_CAP) { atomicAdd(&(bar)[XB_TMO], 1u); break; } } } } while (0)
struct XcdBarrier { unsigned* bar; unsigned x; volatile LAS unsigned* st; };
__device__ __forceinline__ XcdBarrier xcd_barrier_post(unsigned* bar, volatile LAS unsigned* st) {
    XcdBarrier b; b.bar = bar; b.x = xb_xcc_id(); b.st = st;
    if (threadIdx.x == 0) (void)xb_add(&bar[XB_XCNT(b.x)], 1u);
    return b;
}
__device__ __forceinline__ void xcd_barrier_complete(unsigned* bar, unsigned x, unsigned& nloc, unsigned& nx) {
    const unsigned G = gridDim.x * gridDim.y * gridDim.z;
    unsigned sum, cnt, mine, sp = 0u;
    for (;;) {
        sum = 0u; cnt = 0u; mine = 0u;
#pragma unroll
        for (unsigned j = 0; j < 16; ++j) { const unsigned c = xb_ld(&bar[XB_XCNT(j)]); sum += c; cnt += (c > 0u) ? 1u : 0u; mine = (j == x) ? c : mine; }
        if (sum == G) break;
        __builtin_amdgcn_s_sleep(1);
        if ((++sp & 255u) == 0u) { if (xb_ld(&bar[XB_TMO])) break; if (sp > XB_SPIN_CAP) { atomicAdd(&bar[XB_TMO], 1u); break; } }
    }
    nloc = mine > 0u ? mine : 1u; nx = cnt > 0u ? cnt : 1u;
}
__device__ __forceinline__ void xcd_barrier(const XcdBarrier& b) {
    asm volatile("s_waitcnt vmcnt(0)" ::: "memory");
    __syncthreads();
    if (threadIdx.x == 0) {
        unsigned* bar = b.bar;
        __builtin_amdgcn_s_waitcnt(0);
        unsigned nloc = b.st[0], nx = b.st[1];
        if (nloc == 0u) { xcd_barrier_complete(bar, b.x, nloc, nx); b.st[0] = nloc; b.st[1] = nx; }
        const unsigned old = xb_add(&bar[XB_XSUB(b.x)], 1u);
        const unsigned gen = old / nloc;
        if (old + 1u == (gen + 1u) * nloc) {
            __builtin_amdgcn_fence(__ATOMIC_RELEASE, "agent");
            asm volatile("s_waitcnt vmcnt(0)" ::: "memory");
            const unsigned og = xb_add(&bar[XB_TOP], 1u);
            const unsigned tg = og / nx;
            if (og + 1u == (tg + 1u) * nx) xb_add(&bar[XB_TOPGEN], 1u);
            else XB_SPIN(xb_ld(&bar[XB_TOPGEN]) == tg, bar);
            __builtin_amdgcn_fence(__ATOMIC_ACQUIRE, "agent");
            xb_add(&bar[XB_XGEN(b.x)], 1u);
            asm volatile("s_waitcnt vmcnt(0)" ::: "memory");
        } else {
            XB_SPIN(xb_ld(&bar[XB_XGEN(b.x)]) == gen, bar);
            __builtin_amdgcn_fence(__ATOMIC_ACQUIRE, "agent");
            asm volatile("s_waitcnt vmcnt(0)" ::: "memory");
        }
    }
    __syncthreads();
}

constexpr int RING_BYTES = 139264;
constexpr int MISC_OFF = RING_BYTES;
constexpr int LDS_BYTES = 147456;
struct Params {
    const float* in[26]; float* out; unsigned char* ws; int ph_lo, ph_hi; int use_bar, pad;
};
typedef const __attribute__((address_space(4))) Params* KP;
__device__ __forceinline__ const float* gin(KP p, int i) { return (const float*)(const GAS float*)p->in[i]; }
__device__ __forceinline__ float* gout(KP p) { return (float*)(GAS float*)p->out; }
struct Frame {
    LAS unsigned char* lds; volatile LAS unsigned* MISC;
    int tid, lane, wave, vcu, G;
    unsigned char* ws;
};

template <bool F8_ = false> struct DenseSchedT {
    static constexpr bool GATHER = false, UNIFORMIZE = false, FP8 = F8_;
    const char* A; const char* Bt; int K, nM, nN, nwg, G, c;
    __device__ __forceinline__ void init(const void* A_, const void* Bt_, int M, int N, int K_, int G_, int c_) { A = (const char*)A_; Bt = (const char*)Bt_; K = K_; nM = M / 256; nN = N / 256; nwg = nM * nN; G = G_; c = c_; }
    __device__ __forceinline__ bool next(int i, pg8::UnitG& u) const {
        const long L = (long)i * G + c; if (L >= nwg) return false;
        int wgid = (int)L; { const int q = nwg / 8, r = nwg % 8, xcd = wgid % 8, off = wgid / 8; wgid = (xcd < r ? xcd * (q + 1) : r * (q + 1) + (xcd - r) * q) + off; }
        const int nig = 8 * nN, gid = wgid / nig, fm = gid * 8, gsz = (nM - fm) < 8 ? (nM - fm) : 8;
        const int pm = fm + ((wgid % nig) % gsz), pn = (wgid % nig) / gsz;
        u.A = A + (size_t)pm * 256 * K * 2; u.B = Bt + (size_t)pn * 256 * K * 2; u.gidx = nullptr; u.gcnt = 0; u.gshift = 0; u.row0 = pm * 256; u.col0 = pn * 256; u.aux = 0; return true;
    }
};
typedef DenseSchedT<false> DenseSched; typedef DenseSchedT<true> DenseSched8;
__device__ __forceinline__ u32x4 pack_bf16x8(const f32x4& v0, const f32x4& v1) { u32x4 w; w.x = pk2hw(v0[0], v0[1]); w.y = pk2hw(v0[2], v0[3]); w.z = pk2hw(v1[0], v1[1]); w.w = pk2hw(v1[2], v1[3]); return w; }

__device__ __forceinline__ unsigned pk4_fp8(float a, float b, float c, float d) {
    a = fminf(fmaxf(a, -448.0f), 448.0f); b = fminf(fmaxf(b, -448.0f), 448.0f); c = fminf(fmaxf(c, -448.0f), 448.0f); d = fminf(fmaxf(d, -448.0f), 448.0f);
    int w = 0; w = __builtin_amdgcn_cvt_pk_fp8_f32(a, b, w, false); w = __builtin_amdgcn_cvt_pk_fp8_f32(c, d, w, true); return (unsigned)w; }
constexpr float WUP_SCALE = 32.0f, WUP_INV = 1.0f / 32.0f;
struct EpiStoreBf16 {
    static constexpr bool PERM = true, PERM16 = false;
    bf16* O; int ldc; float osc, qsc;
    __device__ __forceinline__ void operator()(const f32x4 (&acc)[2][2][4][2], const pg8::UnitG& u, int wr, int wc, int fr, int fq) const {
        const float sc = ((u.col0 % 3072) < 1024) ? osc * qsc : osc;
#pragma unroll
        for (int ai = 0; ai < 2; ++ai)
#pragma unroll
            for (int m = 0; m < 4; ++m) { bf16* rowp = O + (size_t)(u.row0 + ai * 128 + wr * 64 + m * 16 + fr) * ldc + u.col0 + wc * 32 + 8 * fq;
#pragma unroll
                for (int bj = 0; bj < 2; ++bj) *(u32x4*)(rowp + bj * 128) = pack_bf16x8(acc[ai][bj][m][0] * sc, acc[ai][bj][m][1] * sc); }
    }
};
constexpr float YEXP_SCALE = 32.0f, YEXP_INV = 1.0f / 32.0f;
constexpr float A_SCALE = 16.0f;
constexpr float H_SCALE = 16.0f;
struct EpiStoreFp8 {
    static constexpr bool PERM = false, PERM16 = true;
    unsigned char* O; int ldc;
    __device__ __forceinline__ void operator()(const f32x4 (&acc)[2][2][4][2], const pg8::UnitG& u, int wr, int wc, int fr, int fq) const {
#pragma unroll
        for (int ai = 0; ai < 2; ++ai)
#pragma unroll
            for (int m = 0; m < 4; ++m) { unsigned char* rowp = O + (size_t)(u.row0 + ai * 128 + wr * 64 + m * 16 + fr) * ldc + u.col0 + wc * 64 + 16 * fq;
                u32x4 w;
#pragma unroll
                for (int q = 0; q < 4; ++q) { f32x4 v = acc[ai][q >> 1][m][q & 1] * (YEXP_SCALE / (H_SCALE * WUP_SCALE));
#pragma unroll
                    for (int j = 0; j < 4; ++j) v[j] = fminf(fmaxf(v[j], -448.0f), 448.0f);
                    int d = 0; d = __builtin_amdgcn_cvt_pk_fp8_f32(v[0], v[1], d, false); d = __builtin_amdgcn_cvt_pk_fp8_f32(v[2], v[3], d, true); w[q] = (unsigned)d; }
                *(u32x4*)rowp = w; }
    }
};
struct EpiRetIn {
    static constexpr bool PERM = true, PERM16 = false;
    bf16* O; int ldc;
    __device__ __forceinline__ void operator()(const f32x4 (&acc)[2][2][4][2], const pg8::UnitG& u, int wr, int wc, int fr, int fq) const {
        float l2g = 0.f;
        float cs = WUP_INV;
        if (u.col0 < 2048) { const int h = (u.col0 & 1023) >> 8; const float g = 1.0f - exp2f(-5.0f - (float)h); l2g = log2f(g); if (u.col0 >= 1024) { l2g = -l2g; cs *= 0.0625f; } }
#pragma unroll
        for (int ai = 0; ai < 2; ++ai)
#pragma unroll
            for (int m = 0; m < 4; ++m) { const int row = u.row0 + ai * 128 + wr * 64 + m * 16 + fr; const float sc = exp2f(l2g * (float)(row & 127)) * cs;
                bf16* rowp = O + (size_t)row * ldc + u.col0 + wc * 32 + 8 * fq;
#pragma unroll
                for (int bj = 0; bj < 2; ++bj) *(u32x4*)(rowp + bj * 128) = pack_bf16x8(acc[ai][bj][m][0] * sc, acc[ai][bj][m][1] * sc); }
    }
};
__device__ __forceinline__ void unpack_bf16x8(const u32x4& w, f32x4& a, f32x4& b) { a[0] = bflo(w.x); a[1] = bfhi(w.x); a[2] = bflo(w.y); a[3] = bfhi(w.y); b[0] = bflo(w.z); b[1] = bfhi(w.z); b[2] = bflo(w.w); b[3] = bfhi(w.w); }
template <bool ALL16> struct EpiResidT {
    static constexpr bool PERM = true, PERM16 = false;
    const bf16* X; bf16* Y; float asc;
    __device__ __forceinline__ void operator()(const f32x4 (&acc)[2][2][4][2], const pg8::UnitG& u, int wr, int wc, int fr, int fq) const {
        constexpr int NB = ALL16 ? 1 : 2, PER = 2 / NB;
#pragma unroll
        for (int bt = 0; bt < NB; ++bt) {
            u32x4 xw[PER][4][2];
#pragma unroll
            for (int a2 = 0; a2 < PER; ++a2)
#pragma unroll
                for (int m = 0; m < 4; ++m) { const int ai = bt * PER + a2; const size_t off = (size_t)(u.row0 + ai * 128 + wr * 64 + m * 16 + fr) * D + u.col0 + wc * 32 + 8 * fq;
#pragma unroll
                    for (int bj = 0; bj < 2; ++bj) xw[a2][m][bj] = *(const u32x4*)(X + off + bj * 128); }
            asm volatile("" ::: "memory");
#pragma unroll
            for (int a2 = 0; a2 < PER; ++a2)
#pragma unroll
                for (int m = 0; m < 4; ++m) { const int ai = bt * PER + a2; const size_t off = (size_t)(u.row0 + ai * 128 + wr * 64 + m * 16 + fr) * D + u.col0 + wc * 32 + 8 * fq;
#pragma unroll
                    for (int bj = 0; bj < 2; ++bj) { f32x4 x0, x1; unpack_bf16x8(xw[a2][m][bj], x0, x1);
                        *(u32x4*)(Y + off + bj * 128) = pack_bf16x8(x0 * ALPHA + acc[ai][bj][m][0] * asc, x1 * ALPHA + acc[ai][bj][m][1] * asc); } }
            asm volatile("" ::: "memory");
        }
    }
};
typedef EpiResidT<true> EpiResid; typedef EpiResidT<false> EpiResid8;
struct EpiGluResid {
    static constexpr bool PERM = true, PERM16 = false;
    const bf16* X; bf16* Y; float asc;
    __device__ __forceinline__ void operator()(const f32x4 (&acc)[2][2][4][2], const pg8::UnitG& u, int wr, int wc, int fr, int fq) const {
        u32x4 xw[2][4];
#pragma unroll
        for (int ai = 0; ai < 2; ++ai)
#pragma unroll
            for (int m = 0; m < 4; ++m) { const size_t off = (size_t)(u.row0 + ai * 128 + wr * 64 + m * 16 + fr) * D + (u.col0 >> 1) + wc * 32 + 8 * fq; xw[ai][m] = *(const u32x4*)(X + off); }
        asm volatile("" ::: "memory");
#pragma unroll
        for (int ai = 0; ai < 2; ++ai)
#pragma unroll
            for (int m = 0; m < 4; ++m) { const size_t off = (size_t)(u.row0 + ai * 128 + wr * 64 + m * 16 + fr) * D + (u.col0 >> 1) + wc * 32 + 8 * fq;
                f32x4 x0, x1; unpack_bf16x8(xw[ai][m], x0, x1); f32x4 o0, o1;
#pragma unroll
                for (int j = 0; j < 4; ++j) { o0[j] = x0[j] * ALPHA + acc[ai][0][m][0][j] * asc * fsig(acc[ai][1][m][0][j] * asc); o1[j] = x1[j] * ALPHA + acc[ai][0][m][1][j] * asc * fsig(acc[ai][1][m][1][j] * asc); }
                *(u32x4*)(Y + off) = pack_bf16x8(o0, o1); }
    }
};
struct EpiMoeUp {
    static constexpr bool PERM = true, PERM16 = false;
    unsigned char* H;
    __device__ __forceinline__ void operator()(const f32x4 (&acc)[2][2][4][2], const pg8::UnitG& u, int wr, int wc, int fr, int fq) const {
        typedef unsigned u2_t __attribute__((ext_vector_type(2)));
#pragma unroll
        for (int ai = 0; ai < 2; ++ai) {
            u32x2 w8[4];
#pragma unroll
            for (int m = 0; m < 4; ++m) { f32x4 o[2];
#pragma unroll
                for (int n = 0; n < 2; ++n)
#pragma unroll
                    for (int j = 0; j < 4; ++j) { const float ga = acc[ai][0][m][n][j], ua = acc[ai][1][m][n][j];
                        o[n][j] = (ga * ua) * (WUP_INV * WUP_INV * H_SCALE) * __builtin_amdgcn_rcpf(1.0f + __builtin_amdgcn_exp2f(ga * (-WUP_INV * 1.4426950408889634f))); }
                w8[m].x = pk4_fp8(o[0][0], o[0][1], o[0][2], o[0][3]); w8[m].y = pk4_fp8(o[1][0], o[1][1], o[1][2], o[1][3]); }
            u32x4 s0, s1;
            { const u2_t a = __builtin_amdgcn_permlane16_swap(w8[0].x, w8[2].x, false, false), b = __builtin_amdgcn_permlane16_swap(w8[0].y, w8[2].y, false, false);
              s0.x = a.x; s0.y = b.x; s0.z = a.y; s0.w = b.y; }
            { const u2_t a = __builtin_amdgcn_permlane16_swap(w8[1].x, w8[3].x, false, false), b = __builtin_amdgcn_permlane16_swap(w8[1].y, w8[3].y, false, false);
              s1.x = a.x; s1.y = b.x; s1.z = a.y; s1.w = b.y; }
            const int mb = (fq & 1) ? 2 : 0;
            unsigned char* rowp = H + (size_t)(u.row0 + ai * 128 + wr * 64 + mb * 16 + fr) * ED + u.col0 + wc * 32 + 8 * (fq & 2);
            *(u32x4*)rowp = s0; *(u32x4*)(rowp + (size_t)16 * ED) = s1; }
    }
};

struct ConvD { const float* src; unsigned char* dst; unsigned char* dst2; int ldw, ldk, kind; };
__device__ __forceinline__ ConvD conv_mk8(const float* W, int ldw, unsigned char* WT, int ldk, int k0, int n0, int drow0) {
    ConvD d; d.src = W + (size_t)k0 * ldw + n0; d.dst = WT + (size_t)drow0 * ldk + k0; d.dst2 = nullptr; d.ldw = ldw; d.ldk = ldk; d.kind = 1; return d; }
__device__ __forceinline__ ConvD conv_mk16(const float* W, int ldw, bf16* WT, bf16* WTlo, int ldk, int k0, int n0, int drow0) {
    ConvD d; d.src = W + (size_t)k0 * ldw + n0; d.dst = (unsigned char*)(WT + (size_t)drow0 * ldk + k0); d.dst2 = WTlo ? (unsigned char*)(WTlo + (size_t)drow0 * ldk + k0) : nullptr; d.ldw = ldw; d.ldk = ldk * 2; d.kind = WTlo ? 2 : 0; return d; }
__device__ __forceinline__ void conv_load(const ConvD& d, int lane, f32x4 (&r)[8]) {
#pragma unroll
    for (int i = 0; i < 8; ++i) { const int kk = 8 * i + (lane >> 3), c4 = 4 * (lane & 7); r[i] = *(const f32x4*)(d.src + (size_t)kk * d.ldw + c4); }
}
template <bool HILO>
__device__ __forceinline__ void conv_finish(const ConvD& d, int lane, const f32x4 (&r)[8], LAS float* scr) {
    const float scale = (d.kind == 1) ? WUP_SCALE : 1.0f;
#pragma unroll
    for (int i = 0; i < 8; ++i) { const int kk = 8 * i + (lane >> 3), c4 = 4 * (lane & 7);
        scr[kk * 33 + c4] = r[i][0] * scale; scr[kk * 33 + c4 + 1] = r[i][1] * scale; scr[kk * 33 + c4 + 2] = r[i][2] * scale; scr[kk * 33 + c4 + 3] = r[i][3] * scale; }
    LDS_WAIT(); asm volatile("" ::: "memory");
    const int c = lane & 7;
#pragma unroll
    for (int j = 0; j < 4; ++j) { const int n = (lane >> 3) + 8 * j; const LAS float* s = scr + (8 * c) * 33 + n;
        float v[8];
#pragma unroll
        for (int q = 0; q < 8; ++q) v[q] = s[q * 33];
        if (d.kind == 1) { u32x2 o; o.x = pk4_fp8(v[0], v[1], v[2], v[3]); o.y = pk4_fp8(v[4], v[5], v[6], v[7]); *(u32x2*)(d.dst + (size_t)n * d.ldk + 8 * c) = o; }
        else { u32x4 o; o.x = pk2(v[0], v[1]); o.y = pk2(v[2], v[3]); o.z = pk2(v[4], v[5]); o.w = pk2(v[6], v[7]);
            *(u32x4*)(d.dst + (size_t)n * d.ldk + 16 * c) = o;
            if (HILO) { float rr[8];
#pragma unroll
                for (int q = 0; q < 8; ++q) rr[q] = v[q] - bf2f(f2bf(v[q]));
                u32x4 o2; o2.x = pk2(rr[0], rr[1]); o2.y = pk2(rr[2], rr[3]); o2.z = pk2(rr[4], rr[5]); o2.w = pk2(rr[6], rr[7]);
                *(u32x4*)(d.dst2 + (size_t)n * d.ldk + 16 * c) = o2; } } }
    LDS_WAIT(); asm volatile("" ::: "memory");
}
__device__ __forceinline__ void conv_dma(const ConvD& d, int lane, LAS float* buf) {
#pragma unroll
    for (int i = 0; i < 8; ++i) { const float* g = d.src + (size_t)(8 * i + (lane >> 3)) * d.ldw + 4 * ((lane & 7) ^ i);
        __builtin_amdgcn_global_load_lds((const unsigned*)g, (LAS unsigned*)(buf + i * 256), 16, 0, 0); }
}
__device__ __forceinline__ void conv_finish_lds(const ConvD& d, int lane, const LAS float* buf) {
    const float scale = (d.kind == 1) ? WUP_SCALE : 1.0f;
    const int c = lane & 7;
#pragma unroll
    for (int j = 0; j < 4; ++j) { const int n = (lane >> 3) + 8 * j; const LAS float* s = buf + (8 * c) * 32 + (((n >> 2) ^ c) & 7) * 4 + (n & 3);
        float v[8];
#pragma unroll
        for (int q = 0; q < 8; ++q) v[q] = s[q * 32] * scale;
        if (d.kind == 1) { u32x2 o; o.x = pk4_fp8(v[0], v[1], v[2], v[3]); o.y = pk4_fp8(v[4], v[5], v[6], v[7]); *(u32x2*)(d.dst + (size_t)n * d.ldk + 8 * c) = o; }
        else { u32x4 o; o.x = pk2(v[0], v[1]); o.y = pk2(v[2], v[3]); o.z = pk2(v[4], v[5]); o.w = pk2(v[6], v[7]); *(u32x4*)(d.dst + (size_t)n * d.ldk + 16 * c) = o; } }
    LDS_WAIT(); asm volatile("" ::: "memory");
}
#define CONV_RUN(NIT, DEC) do { int it_ = gw; if (it_ < (NIT)) { ConvD dc_ = DEC(it_); int par_ = 0; conv_dma(dc_, F.lane, scr); asm volatile("s_waitcnt vmcnt(0)" ::: "memory"); \
        for (; it_ < (NIT); it_ += NGW) { const int itn_ = (it_ + NGW < (NIT)) ? it_ + NGW : it_; const ConvD dn_ = DEC(itn_); conv_dma(dn_, F.lane, scr + (par_ ^ 1) * 2048);     \
            asm volatile("s_waitcnt vmcnt(12)" ::: "memory"); conv_finish_lds(dc_, F.lane, scr + par_ * 2048); dc_ = dn_; par_ ^= 1; } \
        asm volatile("s_waitcnt vmcnt(0)" ::: "memory"); } } while (0)
__device__ __forceinline__ ConvD conv_dec_mixers(KP p, unsigned char* ws, int it) {
    constexpr int I_AIN = 16 * 288, I_AOUT = 16 * 32, I_RIN = 16 * 192, I_ROUT = 32 * 32, I_GLU = 16 * 64, I_RT = 16 * 2;
    int r = it;
    if (r < 2 * I_AIN) { const int j = r / I_AIN; r %= I_AIN; const int kb = r / 288, nb = r % 288, n0 = nb * 32;
        return conv_mk8(gin(p, 1) + (size_t)j * D * ATT_IN, ATT_IN, (unsigned char*)(ws + WS_ATT_IN_T) + (size_t)j * ATT_IN * D, D, kb * 64, n0, n0); }
    r -= 2 * I_AIN;
    if (r < 2 * I_AOUT) { const int j = r / I_AOUT; r %= I_AOUT; const int kb = r / 32, nb = r % 32, n0 = nb * 32;
        return conv_mk8(gin(p, 2) + (size_t)j * D * D, D, (unsigned char*)(ws + WS_ATT_OUT_T) + (size_t)j * D * D, D, kb * 64, n0, n0); }
    r -= 2 * I_AOUT;
    if (r < I_RIN) { const int kb = r / 192, nb = r % 192, n0 = nb * 32;
        return conv_mk8(gin(p, 3), RET_IN, (unsigned char*)(ws + WS_RET_IN_T), D, kb * 64, n0, n0); }
    r -= I_RIN;
    if (r < I_ROUT) { const int kb = r / 32, nb = r % 32, n0 = nb * 32;
        return conv_mk8(gin(p, 6), D, (unsigned char*)(ws + WS_RET_OUT_T), RET_V, kb * 64, n0, n0); }
    r -= I_ROUT;
    if (r < I_GLU) { const int kb = r / 64, nb = r % 64, n0 = nb * 32; const int c = n0 & 1023, drow = (c >> 7) * 256 + (n0 >> 10) * 128 + (c & 127);
        return conv_mk8(gin(p, 15), 2 * D, (unsigned char*)(ws + WS_GLU_T), D, kb * 64, n0, drow); }
    r -= I_GLU;
    { const int l = r / I_RT; r %= I_RT; const int kb = r / 2, nb = r % 2, n0 = nb * 32;
        return conv_mk16(gin(p, 16) + (size_t)l * D * NE, NE, (bf16*)(ws + WS_RT_HI) + (size_t)l * NE * D, (bf16*)(ws + WS_RT_LO) + (size_t)l * NE * D, D, kb * 64, n0, n0); }
}
__device__ __forceinline__ ConvD conv_dec_moe(KP p, unsigned char* ws, int l, int it) {
    const int e = it / 384, r = it % 384, which = r >> 7, rr = r & 127;
    bf16* We = (bf16*)(ws + WS_WMOE + (size_t)e * WMOE_E_BYTES);
    if (which < 2) { const float* src = (e < 64) ? gin(p, 18 + which) + ((size_t)l * NE + e) * D * ED : gin(p, 21 + which) + (size_t)l * D * ED;
        const int kb = rr >> 3, nb = rr & 7, n0 = nb * 32; const int drow = (n0 >> 7) * 256 + which * 128 + (n0 & 127);
        return conv_mk8(src, ED, (unsigned char*)We, D, kb * 64, n0, drow); }
    const float* src = (e < 64) ? gin(p, 20) + ((size_t)l * NE + e) * ED * D : gin(p, 23) + (size_t)l * ED * D;
    const int kb = rr >> 5, nb = rr & 31, n0 = nb * 32;
    return conv_mk8(src, D, (unsigned char*)(We + 512 * 1024), ED, kb * 64, n0, n0);
}
__device__ __forceinline__ void phase_conv_mixers(const Frame& F, KP p) {
    LAS float* scr = (LAS float*)(F.lds + F.wave * 16384);
    const int gw = F.vcu * NWAVES + F.wave, NGW = F.G * NWAVES;
    constexpr int NMAIN = 2 * (16 * 288) + 2 * (16 * 32) + 16 * 192 + 32 * 32 + 16 * 64, NRT = 4 * (16 * 2);
    unsigned char* ws = F.ws;
#define CONV_DEC_MIX(i_) conv_dec_mixers(p, ws, (i_))
    CONV_RUN(NMAIN, CONV_DEC_MIX);
    for (int it = NMAIN + gw; it < NMAIN + NRT; it += NGW) { const ConvD d = conv_dec_mixers(p, ws, it); f32x4 r[8]; conv_load(d, F.lane, r); conv_finish<true>(d, F.lane, r, scr); }
#undef CONV_DEC_MIX
}
__device__ __forceinline__ void phase_conv_moe(const Frame& F, KP p, int l) {
    LAS float* scr = (LAS float*)(F.lds + F.wave * 16384);
    const int gw = F.vcu * NWAVES + F.wave, NGW = F.G * NWAVES;
    unsigned char* ws = F.ws;
#define CONV_DEC_MOE(i_) conv_dec_moe(p, ws, l, (i_))
    CONV_RUN(65 * 384, CONV_DEC_MOE);
#undef CONV_DEC_MOE
}

__device__ __forceinline__ void phase_lnr(const Frame& F, KP p, int layer, bool dry = false) {
    const bf16* Y = (const bf16*)(F.ws + WS_Y); bf16* XB = (bf16*)(F.ws + WS_XB); unsigned char* XB8 = (unsigned char*)(F.ws + WS_X);
    const float* lng = gin(p, 24) + (size_t)(layer * 2) * D; const float* lnb = gin(p, 25) + (size_t)(layer * 2) * D;
    const bf16* rthi = (const bf16*)(F.ws + WS_RT_HI) + (size_t)layer * NE * D; const bf16* rtlo = (const bf16*)(F.ws + WS_RT_LO) + (size_t)layer * NE * D;
    const float* rbias = gin(p, 17) + layer * NE;
    unsigned* cnt = (unsigned*)(F.ws + WS_CTL) + CW_CNT + layer * NE * 64;
    int* lists = (int*)(F.ws + WS_LIST); int* tokmap = (int*)(F.ws + WS_LIST + 4 * MiB); float* tokgate = (float*)(F.ws + WS_LIST + 5 * MiB);
    constexpr int XLD = 1032, MAXT = 8;
    LAS bf16* Xhi = (LAS bf16*)F.lds; LAS bf16* Xlo = Xhi + 16 * XLD;
    LAS float* part = (LAS float*)(F.lds + 2 * 16 * XLD * 2);
    LAS int* ent = (LAS int*)(part + 2 * 16 * 64);
    LAS int* hist = ent + MAXT * 16 * 8 * 2; LAS int* base = hist + 64;
    const int lane = F.lane, w = F.wave, g4 = lane >> 4, l15 = lane & 15;
    if (F.tid < 64) hist[F.tid] = 0;
    bf16x8 bhi[16], blo[16];
    { const int nt = w & 3, kh = w >> 2; const bf16* bh = rthi + (size_t)(16 * nt + l15) * D + 512 * kh + 8 * g4; const bf16* bl = rtlo + (size_t)(16 * nt + l15) * D + 512 * kh + 8 * g4;
#pragma unroll
        for (int ks = 0; ks < 16; ++ks) { bhi[ks] = *(const bf16x8*)(bh + 32 * ks); blo[ks] = *(const bf16x8*)(bl + 32 * ks); } }
    u32x4 ypre[2][2];
    if (F.vcu < T / 16) {
#pragma unroll
        for (int rr = 0; rr < 2; ++rr)
#pragma unroll
            for (int j = 0; j < 2; ++j) ypre[rr][j] = *(const u32x4*)(Y + (size_t)(F.vcu * 16 + 2 * w + rr) * D + 8 * lane + 512 * j); }
    int ntile = 0;
    for (int tile = F.vcu; tile < T / 16 && ntile < MAXT; tile += F.G, ++ntile) {
        const int t0 = tile * 16;
        u32x4 ycur[2][2];
#pragma unroll
        for (int rr = 0; rr < 2; ++rr)
#pragma unroll
            for (int j = 0; j < 2; ++j) ycur[rr][j] = ypre[rr][j];
        if (tile + F.G < T / 16) {
#pragma unroll
            for (int rr = 0; rr < 2; ++rr)
#pragma unroll
                for (int j = 0; j < 2; ++j) ypre[rr][j] = *(const u32x4*)(Y + (size_t)((tile + F.G) * 16 + 2 * w + rr) * D + 8 * lane + 512 * j); }
#pragma unroll
        for (int rr = 0; rr < 2; ++rr) {
            const int lr = 2 * w + rr; const size_t row = (size_t)(t0 + lr);
            f32x4 v[4]; float s = 0.f;
#pragma unroll
            for (int j = 0; j < 2; ++j) unpack_bf16x8(ycur[rr][j], v[2 * j], v[2 * j + 1]);
#pragma unroll
            for (int j = 0; j < 4; ++j) s += (v[j][0] + v[j][1]) + (v[j][2] + v[j][3]);
            const float mean = wave_sum(s, lane) * (1.f / D); float s2 = 0.f;
#pragma unroll
            for (int j = 0; j < 4; ++j) { v[j] = v[j] - mean; s2 += (v[j][0] * v[j][0] + v[j][1] * v[j][1]) + (v[j][2] * v[j][2] + v[j][3] * v[j][3]); }
            const float rstd = 1.0f / sqrtf(wave_sum(s2, lane) * (1.f / D) + LN_EPS);
#pragma unroll
            for (int j = 0; j < 2; ++j) { const f32x4 g0 = *(const f32x4*)(lng + 8 * lane + 512 * j), g1 = *(const f32x4*)(lng + 8 * lane + 512 * j + 4), b0 = *(const f32x4*)(lnb + 8 * lane + 512 * j), b1 = *(const f32x4*)(lnb + 8 * lane + 512 * j + 4);
                const f32x4 o0 = v[2 * j] * rstd * g0 + b0, o1 = v[2 * j + 1] * rstd * g1 + b1;
                const u32x4 hi = pack_bf16x8(o0, o1);
                *(u32x4*)(XB + row * D + 8 * lane + 512 * j) = hi;
                { u32x2 q8; q8.x = pk4_fp8(o0[0], o0[1], o0[2], o0[3]); q8.y = pk4_fp8(o1[0], o1[1], o1[2], o1[3]); *(u32x2*)(XB8 + row * D + 8 * lane + 512 * j) = q8; }
                f32x4 h0, h1; unpack_bf16x8(hi, h0, h1); const u32x4 lo = pack_bf16x8(o0 - h0, o1 - h1);
                *(LAS u32x4*)(Xhi + lr * XLD + 8 * lane + 512 * j) = hi; *(LAS u32x4*)(Xlo + lr * XLD + 8 * lane + 512 * j) = lo; }
        }
        __syncthreads();
        { const int nt = w & 3, kh = w >> 2; f32x4 a0 = (f32x4){0.f, 0.f, 0.f, 0.f}, a1 = a0, a2 = a0, a3 = a0, a4 = a0, a5 = a0;
#pragma unroll
            for (int ks = 0; ks < 16; ks += 2) { const int k0 = 512 * kh + 32 * ks;
                const bf16x8 ahi = row_frag(Xhi, XLD, 0, k0, lane), alo = row_frag(Xlo, XLD, 0, k0, lane), bhi2 = row_frag(Xhi, XLD, 0, k0 + 32, lane), blo2 = row_frag(Xlo, XLD, 0, k0 + 32, lane);
                a0 = MFMA16(ahi, bhi[ks], a0); a1 = MFMA16(alo, bhi[ks], a1); a2 = MFMA16(ahi, blo[ks], a2);
                a3 = MFMA16(bhi2, bhi[ks + 1], a3); a4 = MFMA16(blo2, bhi[ks + 1], a4); a5 = MFMA16(bhi2, blo[ks + 1], a5); }
            const f32x4 acc = ((a0 + a3) + (a1 + a4)) + (a2 + a5);
#pragma unroll
            for (int i = 0; i < 4; ++i) part[(kh * 16 + 4 * g4 + i) * 64 + 16 * nt + l15] = acc[i];
        }
        __syncthreads();
#pragma unroll
        for (int rr = 0; rr < 2; ++rr) {
            const int lt = ntile * 16 + 2 * w + rr;
            const float lg = part[(2 * w + rr) * 64 + lane] + part[(16 + 2 * w + rr) * 64 + lane];
            float sc = 1.0f / (1.0f + expf(-lg)); sc = (sc == sc) ? sc : 0.5f;
            const float sel = sc + rbias[lane];
            const float m1 = max8(sel);
            const unsigned long long eq = __ballot(sel == m1);
            const unsigned gm = (unsigned)(eq >> (lane & 56)) & 0xffu;
            const int first = (lane & 56) + __builtin_ctz(gm | 0x100u);
            const float m2 = max8((lane == first) ? -INFINITY : sel);
            const float gs = m1 + m2; const int mygrp = lane >> 3; int grank = 0;
#pragma unroll
            for (int gg = 0; gg < 8; ++gg) { const float o = rdl(gs, 8 * gg); grank += (o > gs || (o == gs && gg < mygrp)) ? 1 : 0; }
            const float mv = (grank < 4) ? sel : -INFINITY;
            unsigned key = __builtin_bit_cast(unsigned, mv); key = (key >> 31) ? ~key : (key | 0x80000000u); key = (key & ~63u) | (unsigned)(63 - lane);
            int r0 = 0, r1 = 0, r2 = 0, r3 = 0;
#pragma unroll
            for (int e2 = 0; e2 < 64; e2 += 4) { r0 += ((unsigned)__builtin_amdgcn_readlane((int)key, e2) > key) ? 1 : 0; r1 += ((unsigned)__builtin_amdgcn_readlane((int)key, e2 + 1) > key) ? 1 : 0;
                r2 += ((unsigned)__builtin_amdgcn_readlane((int)key, e2 + 2) > key) ? 1 : 0; r3 += ((unsigned)__builtin_amdgcn_readlane((int)key, e2 + 3) > key) ? 1 : 0; }
            const int rank = (r0 + r1) + (r2 + r3);
            const bool chosen = rank < TOPK;
            const float wsum = wave_sum(chosen ? sc : 0.f, lane);
            if (chosen) { const int lpos = __hip_atomic_fetch_add(hist + lane, 1, __ATOMIC_RELAXED, __HIP_MEMORY_SCOPE_WORKGROUP);
                ent[(lt * 8 + rank) * 2] = (lane << 16) | lpos; ent[(lt * 8 + rank) * 2 + 1] = __builtin_bit_cast(int, sc / wsum * 2.5f); }
        }
    }
    __syncthreads();
    if (dry) return;
    if (F.tid < 64) { const int hcount = hist[F.tid]; base[F.tid] = hcount ? (int)atomicAdd(cnt + F.tid * 64, (unsigned)hcount) : 0; }
    __syncthreads();
    for (int idx = F.tid; idx < ntile * 16 * 8; idx += NTHREADS) {
        const int ev = ent[idx * 2], gb = ent[idx * 2 + 1]; const int e = ev >> 16, pos = base[e] + (ev & 0xffff);
        const int lt = idx >> 3, rank = idx & 7, tok = (F.vcu + (lt >> 4) * F.G) * 16 + (lt & 15);
        lists[(size_t)e * T + pos] = tok; tokmap[tok * 8 + rank] = (e << 16) | pos; tokgate[tok * 8 + rank] = __builtin_bit_cast(float, gb);
    }
}

__device__ __forceinline__ void phase_combine(const Frame& F, KP p, int layer, bool dry = false) {
    bf16* XB = (bf16*)(F.ws + WS_XB); const unsigned char* yexp = (const unsigned char*)(F.ws + WS_BIG);
    const int* tokmap = (const int*)(F.ws + WS_LIST + 4 * MiB); const float* tokgate = (const float*)(F.ws + WS_LIST + 5 * MiB);
    const volatile LAS int* tstart = (const volatile LAS int*)(F.MISC + 64);
    const float* lng = gin(p, 24) + (size_t)(layer * 2 + 1) * D; const float* lnb = gin(p, 25) + (size_t)(layer * 2 + 1) * D;
    float* outp = gout(p); bf16* xbo = XB; if (dry) { outp = (float*)(F.ws + WS_AUX); xbo = (bf16*)(F.ws + WS_H); }
    const int lane = F.lane, gw = F.vcu * NWAVES + F.wave, NGW = F.G * NWAVES;
    const bf16* ysh = (const bf16*)(F.ws + WS_Y);
    f32x4 gv[4], bv[4];
#pragma unroll
    for (int j = 0; j < 4; ++j) { gv[j] = *(const f32x4*)(lng + 16 * lane + 4 * j); bv[j] = *(const f32x4*)(lnb + 16 * lane + 4 * j); }
    for (int row = gw; row < T; row += NGW) {
        const int mk = tokmap[row * 8 + (lane & 7)]; const float gk = tokgate[row * 8 + (lane & 7)] * YEXP_INV;
        const int rk = (int)tstart[mk >> 16] * 256 + (mk & 0xffff);
        f32x4 v[4];
#pragma unroll
        for (int j = 0; j < 2; ++j) { const u32x4 xw = *(const u32x4*)(ysh + (size_t)row * D + 16 * lane + 8 * j); unpack_bf16x8(xw, v[2 * j], v[2 * j + 1]); }
#pragma unroll
        for (int k = 0; k < TOPK; ++k) { const int r = __builtin_amdgcn_readlane(rk, k); const float g = rdl(gk, k);
            const u32x4 s = *(const u32x4*)(yexp + (size_t)r * D + 16 * lane);
#pragma unroll
            for (int j = 0; j < 4; ++j) { const f32x2 lo = __builtin_amdgcn_cvt_pk_f32_fp8((int)s[j], false), hi = __builtin_amdgcn_cvt_pk_f32_fp8((int)s[j], true);
                v[j][0] += g * lo[0]; v[j][1] += g * lo[1]; v[j][2] += g * hi[0]; v[j][3] += g * hi[1]; } }
        float s = 0.f;
#pragma unroll
        for (int j = 0; j < 4; ++j) s += (v[j][0] + v[j][1]) + (v[j][2] + v[j][3]);
        const float mean = wave_sum(s, lane) * (1.f / D); float s2 = 0.f;
#pragma unroll
        for (int j = 0; j < 4; ++j) { v[j] = v[j] - mean; s2 += (v[j][0] * v[j][0] + v[j][1] * v[j][1]) + (v[j][2] * v[j][2] + v[j][3] * v[j][3]); }
        const float rstd = 1.0f / sqrtf(wave_sum(s2, lane) * (1.f / D) + LN_EPS);
        f32x4 o[4];
#pragma unroll
        for (int j = 0; j < 4; ++j) o[j] = v[j] * rstd * gv[j] + bv[j];
        if (layer == DEPTH - 1 || dry) {
#pragma unroll
            for (int j = 0; j < 4; ++j) *(f32x4*)(outp + (size_t)row * D + 16 * lane + 4 * j) = o[j]; }
        if (layer != DEPTH - 1) { *(u32x4*)(xbo + (size_t)row * D + 16 * lane) = pack_bf16x8(o[0], o[1]); *(u32x4*)(xbo + (size_t)row * D + 16 * lane + 8) = pack_bf16x8(o[2], o[3]);
            if (!dry) { u32x4 q8; q8.x = pk4_fp8(o[0][0], o[0][1], o[0][2], o[0][3]); q8.y = pk4_fp8(o[1][0], o[1][1], o[1][2], o[1][3]); q8.z = pk4_fp8(o[2][0], o[2][1], o[2][2], o[2][3]); q8.w = pk4_fp8(o[3][0], o[3][1], o[3][2], o[3][3]);
                *(u32x4*)((unsigned char*)(F.ws + WS_X) + (size_t)row * D + 16 * lane) = q8; } }
    }
}

constexpr size_t AUX_OB = 96 * MiB, AUX_LSE = 128 * MiB;
__device__ __forceinline__ unsigned att_qoff(int R, int j, int qi, int g4) {
    const int h = R & 7, sbr = R >> 3, g = sbr >> 5, rem = sbr & 31, b = rem >> 4, rr_ = rem & 15;
    const int dsh = 2 * g, d = 1 << dsh, nrs = 4 - dsh, r = rr_ >> nrs, n = 4 * (rr_ & ((1 << nrs) - 1)) + j;
    const unsigned qrow = (unsigned)b * SEQ + (unsigned)(128 * n + qi) * (unsigned)d + (unsigned)r;
    return qrow * (unsigned)ATT_IN + (unsigned)(g * 3072 + h * 128 + 8 * g4);
}
__device__ __forceinline__ void phase_attn(const Frame& F, int bx) {
    const bf16* qkv = (const bf16*)(F.ws + WS_BIG); bf16* og = (bf16*)(F.ws + WS_AUX); float* lse = (float*)(F.ws + WS_AUX + AUX_LSE);
    constexpr int KLD = 136;
    LAS bf16* Ks = (LAS bf16*)F.lds; LAS bf16* Vs = Ks + 256 * KLD;
    const int lane = F.lane, w = F.wave, g4 = lane >> 4, l15 = lane & 15, qq = l15 >> 2, pp = lane & 3;
    u32x4 kc[4], vc[4];
    constexpr int NRUN = 768;
#define ATT_LOADBLK(KR, VR, nblk) do { _Pragma("unroll") for (int it = 0; it < 4; ++it) { const int idx = F.tid + 512 * it, c = idx >> 4, ch = idx & 15; int pos = 128 * (nblk) + c; pos = pos < 0 ? 0 : pos; \
            const unsigned so = (rowbase + (unsigned)pos * (unsigned)d + (unsigned)r) * (unsigned)ATT_IN + (unsigned)(g * 3072 + 1024 + h * 128 + ch * 8); KR[it] = *(const u32x4*)(qkv + so); VR[it] = *(const u32x4*)(qkv + so + 1024u); } } while (0)
#define ATT_STOREBLK(KR, VR, slot) do { _Pragma("unroll") for (int it = 0; it < 4; ++it) { const int idx = F.tid + 512 * it, c = idx >> 4, ch = idx & 15; \
            *(LAS u32x4*)(Ks + (128 * (slot) + c) * KLD + ch * 8) = KR[it]; *(LAS u32x4*)(Vs + (128 * (slot) + c) * KLD + ch * 8) = VR[it]; } } while (0)
    const int qi = 16 * w + l15;
    bf16x8 qf[4];
    if (bx < NRUN) { const unsigned qo = att_qoff(bx, 0, qi, g4);
#pragma unroll
        for (int s = 0; s < 4; ++s) qf[s] = *(const bf16x8*)(qkv + qo + 32 * s); }
    for (int R = bx; R < NRUN; R += F.G) {
        const int h = R & 7, sbr = R >> 3, g = sbr >> 5, rem = sbr & 31, b = rem >> 4, rr_ = rem & 15;
        const int dsh = 2 * g, d = 1 << dsh, nrs = 4 - dsh, r = rr_ >> nrs, n0 = 4 * (rr_ & ((1 << nrs) - 1)); const unsigned rowbase = (unsigned)b * SEQ;
        { u32x4 k0[4], v0[4]; ATT_LOADBLK(k0, v0, n0 - 1); ATT_LOADBLK(kc, vc, n0); ATT_STOREBLK(k0, v0, (n0 - 1) & 1); }
#pragma unroll 1
        for (int j = 0; j < 4; ++j) {
            const int n = n0 + j, cs = n & 1, ps = cs ^ 1;
            ATT_STOREBLK(kc, vc, cs);
            const unsigned qrow = rowbase + (unsigned)(128 * n + qi) * (unsigned)d + (unsigned)r;
            __syncthreads();
            if (j < 3) { ATT_LOADBLK(kc, vc, n + 1); }
            __builtin_amdgcn_sched_barrier(0);
            const int ws0 = (16 * w < 96) ? 16 * w : 96;
#define ATT_PROW(c0) (((c0) < 128) ? (128 * ps + (c0)) : (128 * cs + (c0) - 128))
            f32x4 sacc[10];
            {
                bf16x8 kfa[4], kfb[4];
#pragma unroll
                for (int s = 0; s < 4; ++s) kfa[s] = row_frag(Ks, KLD, ATT_PROW(ws0), 32 * s, lane);
#pragma unroll
                for (int t = 0; t < 10; t += 2) {
#pragma unroll
                    for (int s = 0; s < 4; ++s) kfb[s] = row_frag(Ks, KLD, ATT_PROW(ws0 + 16 * (t + 1)), 32 * s, lane);
                    __builtin_amdgcn_sched_barrier(0);
                    sacc[t] = (f32x4){0.f, 0.f, 0.f, 0.f};
#pragma unroll
                    for (int s = 0; s < 4; ++s) sacc[t] = MFMA16(kfa[s], qf[s], sacc[t]);
                    if (t + 2 < 10) {
#pragma unroll
                        for (int s = 0; s < 4; ++s) kfa[s] = row_frag(Ks, KLD, ATT_PROW(ws0 + 16 * (t + 2)), 32 * s, lane); }
                    __builtin_amdgcn_sched_barrier(0);
                    sacc[t + 1] = (f32x4){0.f, 0.f, 0.f, 0.f};
#pragma unroll
                    for (int s = 0; s < 4; ++s) sacc[t + 1] = MFMA16(kfb[s], qf[s], sacc[t + 1]);
                }
            }
            { const int Rn = (j < 3) ? R : ((R + F.G < NRUN) ? R + F.G : R), jn = (j < 3) ? j + 1 : 0; const unsigned qo = att_qoff(Rn, jn, qi, g4);
#pragma unroll
              for (int s = 0; s < 4; ++s) qf[s] = *(const bf16x8*)(qkv + qo + 32 * s); }
            const float slope = exp2f(-(float)(h + 1)) * (float)d;
            float mx = -INFINITY;
            int sbase = 128 + qi - ws0 - 4 * g4; asm volatile("" : "+v"(sbase));
            const float nsb = -slope * (float)sbase; const int kmin = (n > 0) ? sbase - 128 : ((sbase - 128 > 128 - ws0 - 4 * g4) ? sbase - 128 : 128 - ws0 - 4 * g4);
#pragma unroll
            for (int t = 0; t < 10; ++t)
#pragma unroll
                for (int i = 0; i < 4; ++i) { const int k = 16 * t + i;
                    const bool valid = (k <= sbase) && (k >= kmin);
                    const float v = valid ? __builtin_fmaf(slope, (float)k, sacc[t][i] + nsb) : -INFINITY; sacc[t][i] = v; mx = fmaxf(mx, v); }
            mx = fmaxf(mx, shx(mx, 16, lane)); mx = fmaxf(mx, shx(mx, 32, lane));
            float lsum = 0.f;
#pragma unroll
            for (int t = 0; t < 10; ++t)
#pragma unroll
                for (int i = 0; i < 4; ++i) { const float pv = __expf(sacc[t][i] - mx); sacc[t][i] = pv; lsum += pv; }
            lsum += shx(lsum, 16, lane); lsum += shx(lsum, 32, lane);
            bf16x8 pf[5];
#pragma unroll
            for (int kt = 0; kt < 5; ++kt) pf[kt] = pack8(sacc[2 * kt], sacc[2 * kt + 1]);
            f32x4 o[8];
            {
                const LAS bf16* vl = Vs + (4 * g4 + qq) * KLD + 32 * pp;
                bf16x4 va[10], vcc[10];
#pragma unroll
                for (int q = 0; q < 10; ++q) va[q] = tr4(vl + ATT_PROW(ws0 + 16 * q) * KLD);
#pragma unroll
                for (int et = 0; et < 8; et += 2) {
#pragma unroll
                    for (int q = 0; q < 10; ++q) vcc[q] = tr4(vl + ATT_PROW(ws0 + 16 * q) * KLD + 4 * (et + 1));
                    __builtin_amdgcn_sched_barrier(0);
                    o[et] = (f32x4){0.f, 0.f, 0.f, 0.f};
#pragma unroll
                    for (int kt = 0; kt < 5; ++kt) o[et] = MFMA16(cat8(va[2 * kt], va[2 * kt + 1]), pf[kt], o[et]);
                    if (et + 2 < 8) {
#pragma unroll
                        for (int q = 0; q < 10; ++q) va[q] = tr4(vl + ATT_PROW(ws0 + 16 * q) * KLD + 4 * (et + 2)); }
                    __builtin_amdgcn_sched_barrier(0);
                    o[et + 1] = (f32x4){0.f, 0.f, 0.f, 0.f};
#pragma unroll
                    for (int kt = 0; kt < 5; ++kt) o[et + 1] = MFMA16(cat8(vcc[2 * kt], vcc[2 * kt + 1]), pf[kt], o[et + 1]);
                }
            }
#undef ATT_PROW
            const float inv = 1.0f / lsum;
            bf16* orow = og + ((size_t)g * T + qrow) * D + h * 128 + 32 * g4;
#pragma unroll
            for (int e2 = 0; e2 < 4; ++e2) *(u32x4*)(orow + 8 * e2) = pack_bf16x8(o[2 * e2] * inv, o[2 * e2 + 1] * inv);
            if (g4 == 0) lse[((size_t)g * T + qrow) * AH + h] = mx + __logf(lsum);
            __syncthreads();
        }
    }
#undef ATT_LOADBLK
#undef ATT_STOREBLK
}
__device__ __forceinline__ void phase_attn_combine(const Frame& F) {
    const bf16* og = (const bf16*)(F.ws + WS_AUX); const float* lse = (const float*)(F.ws + WS_AUX + AUX_LSE); bf16* ob = (bf16*)(F.ws + WS_AUX + AUX_OB);
    const int lane = F.lane, gw = F.vcu * NWAVES + F.wave, NGW = F.G * NWAVES, h = lane >> 3;
    for (int row = gw; row < T; row += NGW) {
        const float l0 = lse[((size_t)0 * T + row) * AH + h], l1 = lse[((size_t)1 * T + row) * AH + h], l2 = lse[((size_t)2 * T + row) * AH + h];
        const float m = fmaxf(l0, fmaxf(l1, l2)); float w0 = __expf(l0 - m), w1 = __expf(l1 - m), w2 = __expf(l2 - m); const float inv = 1.0f / (w0 + w1 + w2); w0 *= inv; w1 *= inv; w2 *= inv;
        float a[16];
#pragma unroll
        for (int j = 0; j < 16; ++j) a[j] = 0.f;
#pragma unroll
        for (int g = 0; g < 3; ++g) { const float wg = (g == 0) ? w0 : (g == 1 ? w1 : w2);
#pragma unroll
            for (int q = 0; q < 2; ++q) { const u32x4 s = *(const u32x4*)(og + ((size_t)g * T + row) * D + 16 * lane + 8 * q);
                a[8 * q + 0] += wg * bflo(s.x); a[8 * q + 1] += wg * bfhi(s.x); a[8 * q + 2] += wg * bflo(s.y); a[8 * q + 3] += wg * bfhi(s.y);
                a[8 * q + 4] += wg * bflo(s.z); a[8 * q + 5] += wg * bfhi(s.z); a[8 * q + 6] += wg * bflo(s.w); a[8 * q + 7] += wg * bfhi(s.w); } }
        { u32x4 o;
#pragma unroll
          for (int q = 0; q < 4; ++q) o[q] = pk4_fp8(a[4 * q] * A_SCALE, a[4 * q + 1] * A_SCALE, a[4 * q + 2] * A_SCALE, a[4 * q + 3] * A_SCALE);
          *(u32x4*)((unsigned char*)ob + (size_t)row * D + 16 * lane) = o; }
    }
}

constexpr size_t BIG_YRET = 192 * MiB;
__device__ __forceinline__ void phase_ret_u(const Frame& F) {
    const bf16* proj = (const bf16*)(F.ws + WS_BIG); bf16* St = (bf16*)(F.ws + WS_AUX);
    constexpr int LD = 264;
    LAS bf16* Kt = (LAS bf16*)F.lds; LAS bf16* Vt = Kt + 128 * LD;
    const int lane = F.lane, w = F.wave, g4 = lane >> 4, l15 = lane & 15, qq = l15 >> 2, pp = lane & 3;
    u32x4 kr[8], vr[8];
#define RU_LOAD(u_) do { const int eh_ = (u_) & 1, h_ = ((u_) >> 1) & 3, n_ = ((u_) >> 3) & 63, b_ = (u_) >> 9; const char* pb_ = (const char*)(proj + ((size_t)b_ * SEQ + (size_t)n_ * RC) * RET_IN); \
        int t_ = F.tid; asm volatile("" : "+v"(t_)); unsigned off_ = (unsigned)(((t_ >> 5) * RET_IN + (t_ & 31) * 8) * 2); \
        _Pragma("unroll") for (int it = 0; it < 8; ++it) { asm volatile("" : "+v"(off_)); kr[it] = *(const u32x4*)(pb_ + (size_t)(1024 + h_ * 256 + it * 16 * RET_IN) * 2 + off_); \
            vr[it] = *(const u32x4*)(pb_ + (size_t)(2048 + h_ * 512 + eh_ * 256 + it * 16 * RET_IN) * 2 + off_); } } while (0)
    if (F.vcu < 1024) RU_LOAD(F.vcu);
    for (int u = F.vcu; u < 1024; u += F.G) {
        const int eh = u & 1, h = (u >> 1) & 3, n = (u >> 3) & 63, b = u >> 9;
        { int t_ = F.tid; asm volatile("" : "+v"(t_));
#pragma unroll
          for (int it = 0; it < 8; ++it) { const int idx = t_ + 512 * it, j = idx >> 5, ch = idx & 31; *(LAS u32x4*)(Kt + j * LD + ch * 8) = kr[it]; *(LAS u32x4*)(Vt + j * LD + ch * 8) = vr[it]; } }
        __syncthreads();
        f32x4 acc[16][2];
#pragma unroll
        for (int mt = 0; mt < 16; ++mt) { acc[mt][0] = (f32x4){0.f, 0.f, 0.f, 0.f}; acc[mt][1] = (f32x4){0.f, 0.f, 0.f, 0.f}; }
#pragma unroll
        for (int ks = 0; ks < 4; ++ks) {
            bf16x8 bfr[2];
#pragma unroll
            for (int nt = 0; nt < 2; ++nt) { const LAS bf16* a0 = Vt + (32 * ks + 8 * g4 + qq) * LD + 32 * w + 16 * nt + 4 * pp; bfr[nt] = cat8(tr4(a0), tr4(a0 + 4 * LD)); }
#pragma unroll
            for (int mt = 0; mt < 16; ++mt) { const LAS bf16* a0 = Kt + (32 * ks + 8 * g4 + qq) * LD + 128 * (mt >> 3) + 32 * pp + 4 * (mt & 7);
                const bf16x8 afr = cat8(tr4(a0), tr4(a0 + 4 * LD));
                acc[mt][0] = MFMA16(afr, bfr[0], acc[mt][0]); acc[mt][1] = MFMA16(afr, bfr[1], acc[mt][1]); }
        }
        { const int un = (u + F.G < 1024) ? u + F.G : u; RU_LOAD(un); }
        bf16* outb = St + ((size_t)((b * RH + h) * RNC + n)) * (RDV * RDK);
#pragma unroll
        for (int nt = 0; nt < 2; ++nt) { bf16* orow = outb + (size_t)(eh * 256 + 32 * w + 16 * nt + l15) * RDK + 32 * g4;
#pragma unroll
            for (int mh = 0; mh < 2; ++mh)
#pragma unroll
                for (int q = 0; q < 4; ++q) *(u32x4*)(orow + 128 * mh + 8 * q) = pack_bf16x8(acc[mh * 8 + 2 * q][nt], acc[mh * 8 + 2 * q + 1][nt]); }
        __syncthreads();
    }
#undef RU_LOAD
}
__device__ __forceinline__ void phase_ret_scan(const Frame& F) {
    bf16* St = (bf16*)(F.ws + WS_AUX);
    for (int gt = F.vcu * NTHREADS + F.tid; gt < 8 * 16384; gt += F.G * NTHREADS) {
        const int bh = gt >> 14, chunk = gt & 16383, h = bh & 3;
        const float g128 = exp2f(128.0f * log2f(1.0f - exp2f(-5.0f - (float)h)));
        bf16* base = St + (size_t)bh * RNC * (RDV * RDK) + (size_t)chunk * 8;
        float c[8];
#pragma unroll
        for (int j = 0; j < 8; ++j) c[j] = 0.f;
#pragma unroll 8
        for (int n = 0; n < RNC; ++n) { bf16* pn = base + (size_t)n * (RDV * RDK); const u32x4 uv = *(const u32x4*)pn;
            u32x4 o; o.x = pk2(c[0], c[1]); o.y = pk2(c[2], c[3]); o.z = pk2(c[4], c[5]); o.w = pk2(c[6], c[7]); *(u32x4*)pn = o;
            c[0] = g128 * (c[0] + bflo(uv.x)); c[1] = g128 * (c[1] + bfhi(uv.x)); c[2] = g128 * (c[2] + bflo(uv.y)); c[3] = g128 * (c[3] + bfhi(uv.y));
            c[4] = g128 * (c[4] + bflo(uv.z)); c[5] = g128 * (c[5] + bfhi(uv.z)); c[6] = g128 * (c[6] + bflo(uv.w)); c[7] = g128 * (c[7] + bfhi(uv.w)); }
    }
}
__device__ __forceinline__ void phase_ret_out(const Frame& F, KP p) {
    const bf16* proj = (const bf16*)(F.ws + WS_BIG); const bf16* St = (const bf16*)(F.ws + WS_AUX); bf16* yret = (bf16*)(F.ws + WS_BIG + BIG_YRET);
    const float* gng = gin(p, 4); const float* gnb = gin(p, 5);
    constexpr int LD = 264, VLD = 72, NSL = 8, ESL = 64;
    LAS bf16* Rs = (LAS bf16*)F.lds; LAS bf16* Vs = Rs + 128 * LD;
    const int w = F.wave;
#define RO_TID(t_) int t_ = F.tid; asm volatile("" : "+v"(t_))
#define RO_LD(base_, off_) (*(const u32x4*)((const char*)(base_) + (off_)))
    for (int u = F.vcu; u < 512; u += F.G) {
        const int h = u & 3, n = (u >> 2) & 63, b = u >> 8;
        const size_t row0 = (size_t)b * SEQ + (size_t)n * RC;
        const bf16* Sn = St + ((size_t)((b * RH + h) * RNC + n)) * (RDV * RDK);
        const char* pbase = (const char*)(proj + row0 * RET_IN);
        u32x4 pv[2], ps[4];
        bf16x8 qf[8];
        { RO_TID(t0); u32x4 kreg[8];
          unsigned koff = (unsigned)(((t0 >> 5) * RET_IN + (t0 & 31) * 8) * 2), qoff = (unsigned)(((16 * w + (t0 & 15)) * RET_IN + 8 * ((t0 & 63) >> 4)) * 2);
#pragma unroll
          for (int it = 0; it < 8; ++it) { asm volatile("" : "+v"(koff)); kreg[it] = RO_LD(pbase + (size_t)(1024 + h * 256 + it * 16 * RET_IN) * 2, koff); }
#pragma unroll
          for (int s = 0; s < 8; ++s) { asm volatile("" : "+v"(qoff)); qf[s] = __builtin_bit_cast(bf16x8, RO_LD(pbase + (size_t)(h * 256 + 32 * s) * 2, qoff)); }
#define RO_LOAD_SLICE(sl_) do { RO_TID(tl_); unsigned voff = (unsigned)(((tl_ >> 3) * RET_IN + (tl_ & 7) * 8) * 2), soff = (unsigned)(((tl_ >> 5) * RDK + (tl_ & 31) * 8) * 2); \
            _Pragma("unroll") for (int it = 0; it < 2; ++it) { asm volatile("" : "+v"(voff)); pv[it] = RO_LD(pbase + (size_t)(2048 + h * 512 + (sl_) * ESL + it * 64 * RET_IN) * 2, voff); } \
            _Pragma("unroll") for (int it = 0; it < 4; ++it) { asm volatile("" : "+v"(soff)); ps[it] = RO_LD((const char*)Sn + (size_t)(((sl_) * ESL + it * 16) * RDK) * 2, soff); } } while (0)
          RO_LOAD_SLICE(0);
#pragma unroll
          for (int it = 0; it < 8; ++it) { const int idx = t0 + 512 * it, j = idx >> 5, ch = idx & 31; *(LAS u32x4*)(Rs + j * LD + ch * 8) = kreg[it]; } }
        __syncthreads();
        bf16x8 pf[4];
        { RO_TID(t1); const int lane = t1 & 63, g4 = lane >> 4, irow = 16 * w + (lane & 15);
          f32x4 sacc[8];
#pragma unroll
            for (int jt = 0; jt < 8; ++jt) { sacc[jt] = (f32x4){0.f, 0.f, 0.f, 0.f};
                if (jt <= w) {
#pragma unroll
                    for (int s = 0; s < 8; ++s) sacc[jt] = MFMA16(row_frag(Rs, LD, 16 * jt, 32 * s, lane), qf[s], sacc[jt]);
#pragma unroll
                    for (int i = 0; i < 4; ++i) if (16 * jt + 4 * g4 + i > irow) sacc[jt][i] = 0.f; } }
#pragma unroll
            for (int kt = 0; kt < 4; ++kt) pf[kt] = pack8(sacc[2 * kt], sacc[2 * kt + 1]); }
        __syncthreads();
        u32x4 accp[NSL][2];
        float s1 = 0.f, s2 = 0.f;
#pragma unroll
        for (int sl = 0; sl < NSL; ++sl) {
            { RO_TID(t2);
#pragma unroll
              for (int it = 0; it < 2; ++it) { const int idx = t2 + 512 * it, j = idx >> 3, ch = idx & 7; *(LAS u32x4*)(Vs + j * VLD + ch * 8) = pv[it]; }
#pragma unroll
              for (int it = 0; it < 4; ++it) { const int idx = t2 + 512 * it, e = idx >> 5, ch = idx & 31; *(LAS u32x4*)(Rs + e * LD + ch * 8) = ps[it]; } }
            __syncthreads();
            if (sl + 1 < NSL) RO_LOAD_SLICE(sl + 1);
            RO_TID(t3); const int lane = t3 & 63, g4 = lane >> 4, qq = (lane & 15) >> 2, pp = lane & 3;
            f32x4 acc[4];
#pragma unroll
            for (int et = 0; et < 4; ++et) { f32x4 a = (f32x4){0.f, 0.f, 0.f, 0.f};
#pragma unroll
                for (int kt = 0; kt < 4; ++kt) if (2 * kt <= w) { const LAS bf16* a0 = Vs + (32 * kt + 4 * g4 + qq) * VLD + 16 * pp + 4 * et;
                    a = MFMA16(cat8(tr4(a0), tr4(a0 + 16 * VLD)), pf[kt], a); }
                const LAS bf16* srow = Rs + (16 * qq + 4 * et + pp) * LD + 8 * g4;
#pragma unroll
                for (int s = 0; s < 8; ++s) a = MFMA16(*(const LAS bf16x8*)(srow + 32 * s), qf[s], a);
                acc[et] = a; s1 += (a[0] + a[1]) + (a[2] + a[3]); s2 += (a[0] * a[0] + a[1] * a[1]) + (a[2] * a[2] + a[3] * a[3]);
                __builtin_amdgcn_sched_barrier(0); }
            accp[sl][0] = pack_bf16x8(acc[0], acc[1]); accp[sl][1] = pack_bf16x8(acc[2], acc[3]);
            __syncthreads();
        }
#undef RO_LOAD_SLICE
        RO_TID(t4); const int lane = t4 & 63, g4 = lane >> 4, irow = 16 * w + (lane & 15); const size_t qrow = row0 + irow;
        s1 += shx(s1, 16, lane); s1 += shx(s1, 32, lane); s2 += shx(s2, 16, lane); s2 += shx(s2, 32, lane);
        const float mean = s1 * (1.0f / RDV); const float var = fmaxf(s2 * (1.0f / RDV) - mean * mean, 0.f);
        const float rstd = 1.0f / sqrtf(var + LN_EPS);
        unsigned goff = (unsigned)((irow * RET_IN + 16 * g4) * 2);
#pragma unroll
        for (int sp = 0; sp < NSL; sp += 2) {
            u32x4 gq[2][2]; f32x4 gg[2][4], gb[2][4];
#pragma unroll
            for (int d2 = 0; d2 < 2; ++d2) { const int c0 = h * RDV + (sp + d2) * ESL + 16 * g4;
#pragma unroll
                for (int q = 0; q < 2; ++q) { asm volatile("" : "+v"(goff)); gq[d2][q] = RO_LD(pbase + (size_t)(4096 + h * RDV + (sp + d2) * ESL + 8 * q) * 2, goff); }
#pragma unroll
                for (int q = 0; q < 4; ++q) { gg[d2][q] = *(const f32x4*)(gng + c0 + 4 * q); gb[d2][q] = *(const f32x4*)(gnb + c0 + 4 * q); } }
#pragma unroll
            for (int d2 = 0; d2 < 2; ++d2) { const int c0 = h * RDV + (sp + d2) * ESL + 16 * g4; u32x4 o8;
#pragma unroll
                for (int q = 0; q < 2; ++q) { const u32x4 gw = gq[d2][q]; f32x4 a0, a1; unpack_bf16x8(accp[sp + d2][q], a0, a1);
                    f32x4 y0 = (a0 - mean) * rstd * gg[d2][2 * q] + gb[d2][2 * q], y1 = (a1 - mean) * rstd * gg[d2][2 * q + 1] + gb[d2][2 * q + 1];
                    const float gv[8] = {bflo(gw.x), bfhi(gw.x), bflo(gw.y), bfhi(gw.y), bflo(gw.z), bfhi(gw.z), bflo(gw.w), bfhi(gw.w)};
#pragma unroll
                    for (int j = 0; j < 4; ++j) { y0[j] *= gv[j] * fsig(gv[j]) * A_SCALE; y1[j] *= gv[4 + j] * fsig(gv[4 + j]) * A_SCALE; }
                    o8[2 * q] = pk4_fp8(y0[0], y0[1], y0[2], y0[3]); o8[2 * q + 1] = pk4_fp8(y1[0], y1[1], y1[2], y1[3]); }
                *(u32x4*)((unsigned char*)yret + qrow * RET_V + c0) = o8; }
        }
    }
#undef RO_LD
#undef RO_TID
}

constexpr size_t AUX_S5E = 64 * MiB;
constexpr int S5L = 256, S5NC = SEQ / S5L;
__device__ __forceinline__ void cmul_add(float& rr, float& ri, float ar, float ai, float xr, float xi, float cr, float ci) { rr = ar * xr - ai * xi + cr; ri = ar * xi + ai * xr + ci; }
template <bool OUT>
__device__ __forceinline__ void phase_s5_scan(const Frame& F, KP p) {
    const bf16* X = (const bf16*)(F.ws + WS_XB); float* E = (float*)(F.ws + WS_AUX + AUX_S5E); bf16* ybuf = (bf16*)(F.ws + WS_AUX);
    const int lane = F.lane, w = F.wave, g4 = lane >> 4, l15 = lane & 15;
    LAS bf16* ut = (LAS bf16*)(F.lds + w * 12288);
    LAS bf16* Hb = (LAS bf16*)(F.lds + w * 12288 + 4096);
    constexpr int HLD = 136;
    const int gw = F.vcu * NWAVES + w, NGW = F.G * NWAVES;
    const int up16 = (lane - 16) << 2, up32 = (lane - 32) << 2, last16 = (48 + l15) << 2;
    for (int unit = gw; unit < BATCH * SG * S5NC; unit += NGW) {
        const int n = unit & (S5NC - 1), g = (unit >> 5) & 63, b = unit >> 11;
        float a1r[4], a1i[4], a4r[4], a4i[4], a8r[4], a8i[4], pwr[4], pwi[4];
        bf16x8 bfrag[8];
        const float dt = expf(gin(p, 14)[g]);
#pragma unroll
        for (int st = 0; st < 4; ++st) { const int ps = 16 * st + l15;
            const float are = gin(p, 7)[g * SP + ps], aim = gin(p, 8)[g * SP + ps];
            const float mag = expf(dt * are); const float abr = mag * cosf(dt * aim), abi = mag * sinf(dt * aim);
            const float den = are * are + aim * aim;
            const float fre = ((abr - 1.0f) * are + abi * aim) / den, fim = (abi * are - (abr - 1.0f) * aim) / den;
            a1r[st] = abr; a1i[st] = abi; { float t2r, t2i; cmul_add(t2r, t2i, abr, abi, abr, abi, 0.f, 0.f); cmul_add(a4r[st], a4i[st], t2r, t2i, t2r, t2i, 0.f, 0.f); }
            cmul_add(a8r[st], a8i[st], a4r[st], a4i[st], a4r[st], a4i[st], 0.f, 0.f);
            float qr = 1.f, qi = 0.f;
            if (g4 & 1) { qr = a4r[st]; qi = a4i[st]; }
            if (g4 & 2) { float tr, ti; cmul_add(tr, ti, qr, qi, a8r[st], a8i[st], 0.f, 0.f); qr = tr; qi = ti; }
            pwr[st] = qr; pwi[st] = qi;
            const float* br = gin(p, 9) + ((size_t)g * SP + ps) * SGC + 8 * (g4 & 1); const float* bi = gin(p, 10) + ((size_t)g * SP + ps) * SGC + 8 * (g4 & 1);
            const f32x4 r0 = *(const f32x4*)br, r1 = *(const f32x4*)(br + 4), i0 = *(const f32x4*)bi, i1 = *(const f32x4*)(bi + 4);
            const float z = (g4 < 2) ? 1.0f : 0.0f; const float fr2 = fre * z, fi2 = fim * z;
            bfrag[st] = pack8(r0 * fr2 - i0 * fi2, r1 * fr2 - i1 * fi2); bfrag[st + 4] = pack8(i0 * fr2 + r0 * fi2, i1 * fr2 + r1 * fi2);
        }
        float sr[4], si[4];
        float* Eu = E + ((size_t)(b * SG + g) * S5NC + n) * 128;
        bf16x8 cf[4]; f32x4 dsk = (f32x4){0.f, 0.f, 0.f, 0.f};
#pragma unroll
        for (int st = 0; st < 4; ++st) { sr[st] = 0.f; si[st] = 0.f; }
        if (OUT) {
#pragma unroll
            for (int st = 0; st < 4; ++st) { sr[st] = Eu[16 * st + l15]; si[st] = Eu[64 + 16 * st + l15]; }
#pragma unroll
            for (int s = 0; s < 4; ++s) { const float* cp = (s < 2 ? gin(p, 11) : gin(p, 12)) + ((size_t)g * SGC + l15) * SP + 32 * (s & 1) + 8 * g4; const float sg = s < 2 ? 1.0f : -1.0f;
                const f32x4 c0 = *(const f32x4*)cp * sg, c1 = *(const f32x4*)(cp + 4) * sg; cf[s] = pack8(c0, c1); }
            dsk = *(const f32x4*)(gin(p, 13) + g * SGC + 4 * g4); }
        const size_t tok0 = (size_t)b * SEQ + (size_t)n * S5L;
        u32x4 pre[2];
        { const bf16* src = X + (tok0 + lane) * D + g * SGC; pre[0] = *(const u32x4*)src; pre[1] = *(const u32x4*)(src + 8); }
        for (int sub = 0; sub < S5L / 64; ++sub) {
            *(LAS u32x4*)(ut + lane * 16) = pre[0]; *(LAS u32x4*)(ut + lane * 16 + 8) = pre[1];
            if (sub + 1 < S5L / 64) { const bf16* src = X + (tok0 + (sub + 1) * 64 + lane) * D + g * SGC; pre[0] = *(const u32x4*)src; pre[1] = *(const u32x4*)(src + 8); }
            LDS_WAIT(); asm volatile("" ::: "memory");
#pragma unroll (OUT ? 1 : 4)
            for (int blk = 0; blk < 4; ++blk) {
                u32x4 uw = *(const LAS u32x4*)(ut + (blk * 16 + l15) * 16 + 8 * (g4 & 1));
                if (g4 >= 2) uw = (u32x4){0u, 0u, 0u, 0u};
                const bf16x8 ufr = __builtin_bit_cast(bf16x8, uw);
                f32x4 dr[4], di[4];
#pragma unroll
                for (int st = 0; st < 4; ++st) { dr[st] = MFMA16(ufr, bfrag[st], ((f32x4){0.f, 0.f, 0.f, 0.f})); di[st] = MFMA16(ufr, bfrag[st + 4], ((f32x4){0.f, 0.f, 0.f, 0.f})); }
                float vr[4], vi[4];
#pragma unroll
                for (int st = 0; st < 4; ++st) {
                    float hr = 0.f, hi = 0.f;
#pragma unroll
                    for (int i = 0; i < 4; ++i) { float nr, ni; cmul_add(nr, ni, a1r[st], a1i[st], hr, hi, dr[st][i], di[st][i]); hr = nr; hi = ni; dr[st][i] = hr; di[st][i] = hi; }
                    vr[st] = hr; vi[st] = hi; }
#define BPF(idx, v) __builtin_bit_cast(float, __builtin_amdgcn_ds_bpermute((idx), __builtin_bit_cast(int, (v))))
                { float xr[4], xi[4];
#pragma unroll
                  for (int st = 0; st < 4; ++st) { xr[st] = BPF(up16, vr[st]); xi[st] = BPF(up16, vi[st]); }
#pragma unroll
                  for (int st = 0; st < 4; ++st) { float tr, ti; cmul_add(tr, ti, a4r[st], a4i[st], xr[st], xi[st], vr[st], vi[st]); if (g4 >= 1) { vr[st] = tr; vi[st] = ti; } }
#pragma unroll
                  for (int st = 0; st < 4; ++st) { xr[st] = BPF(up32, vr[st]); xi[st] = BPF(up32, vi[st]); }
#pragma unroll
                  for (int st = 0; st < 4; ++st) { float tr, ti; cmul_add(tr, ti, a8r[st], a8i[st], xr[st], xi[st], vr[st], vi[st]); if (g4 >= 2) { vr[st] = tr; vi[st] = ti; } } }
                float er[4], ei[4], lr[4], li[4];
#pragma unroll
                for (int st = 0; st < 4; ++st) { if (OUT) { er[st] = BPF(up16, vr[st]); ei[st] = BPF(up16, vi[st]); } else { er[st] = 0.f; ei[st] = 0.f; } lr[st] = BPF(last16, vr[st]); li[st] = BPF(last16, vi[st]); }
#undef BPF
#pragma unroll
                for (int st = 0; st < 4; ++st) {
                    if (g4 == 0) { er[st] = 0.f; ei[st] = 0.f; }
                    if (OUT) { float s0r, s0i; cmul_add(s0r, s0i, pwr[st], pwi[st], sr[st], si[st], er[st], ei[st]);
#pragma unroll
                        for (int i = 0; i < 4; ++i) { float tr, ti; cmul_add(tr, ti, a1r[st], a1i[st], s0r, s0i, 0.f, 0.f); s0r = tr; s0i = ti; dr[st][i] += s0r; di[st][i] += s0i; } }
                    { float a16r, a16i; cmul_add(a16r, a16i, a8r[st], a8i[st], a8r[st], a8i[st], 0.f, 0.f); float tr, ti; cmul_add(tr, ti, a16r, a16i, sr[st], si[st], lr[st], li[st]); sr[st] = tr; si[st] = ti; }
                    if (OUT) {
#pragma unroll
                        for (int i = 0; i < 4; ++i) { const unsigned hw = pk2(dr[st][i], di[st][i]); Hb[(4 * g4 + i) * HLD + 16 * st + l15] = (bf16)hw; Hb[(4 * g4 + i) * HLD + 64 + 16 * st + l15] = (bf16)(hw >> 16); } }
                }
                if (OUT) {
                    LDS_WAIT(); asm volatile("" ::: "memory");
                    f32x4 ya = (f32x4){0.f, 0.f, 0.f, 0.f};
#pragma unroll
                    for (int s = 0; s < 4; ++s) ya = MFMA16(cf[s], row_frag(Hb, HLD, 0, 32 * s, lane), ya);
                    const u32x2 u2 = *(const LAS u32x2*)(ut + (blk * 16 + l15) * 16 + 4 * g4);
                    const f32x4 u4 = (f32x4){bflo(u2.x), bfhi(u2.x), bflo(u2.y), bfhi(u2.y)};
                    f32x4 y = ya + dsk * u4;
#pragma unroll
                    for (int j = 0; j < 4; ++j) { const float v = y[j]; y[j] = v * fsig(1.5957691216057308f * (v + 0.044715f * v * v * v)); }
                    *(unsigned*)((unsigned char*)ybuf + (size_t)(tok0 + sub * 64 + blk * 16 + l15) * D + g * SGC + 4 * g4) = pk4_fp8(y[0] * A_SCALE, y[1] * A_SCALE, y[2] * A_SCALE, y[3] * A_SCALE);
                    asm volatile("" ::: "memory"); }
            }
            LDS_WAIT(); asm volatile("" ::: "memory");
        }
        if (!OUT && g4 == 0) {
#pragma unroll
            for (int st = 0; st < 4; ++st) { Eu[16 * st + l15] = sr[st]; Eu[64 + 16 * st + l15] = si[st]; } }
    }
}
__device__ __forceinline__ void phase_s5_carry(const Frame& F, KP p) {
    float* E = (float*)(F.ws + WS_AUX + AUX_S5E);
    for (int gt = F.vcu * NTHREADS + F.tid; gt < BATCH * SG * SP; gt += F.G * NTHREADS) {
        const int pl = gt & 63, bg = gt >> 6, g = bg & 63;
        const float dt = expf(gin(p, 14)[g]); const float are = gin(p, 7)[g * SP + pl], aim = gin(p, 8)[g * SP + pl];
        const float mag = expf(dt * are); float ar = mag * cosf(dt * aim), ai = mag * sinf(dt * aim);
#pragma unroll
        for (int q = 0; q < 8; ++q) { const float nr = ar * ar - ai * ai, ni = 2.0f * ar * ai; ar = nr; ai = ni; }
        float cr = 0.f, ci = 0.f;
        for (int n = 0; n < S5NC; ++n) { float* Eu = E + ((size_t)bg * S5NC + n) * 128; const float er = Eu[pl], ei = Eu[64 + pl];
            Eu[pl] = cr; Eu[64 + pl] = ci;
            const float nr = ar * cr - ai * ci + er, ni = ar * ci + ai * cr + ei; cr = nr; ci = ni; }
    }
}

constexpr int NPHASES = 34;
#ifndef PROBE_DRY14
#define PROBE_DRY14 0
#endif
#ifndef PROBE_DRY17
#define PROBE_DRY17 0
#endif
#ifndef PH_MASK
#define PH_MASK 0xFFFFFFFFu
#endif
#define PHT(t) ((PH_MASK >> (t)) & 1u)
constexpr int PLAN_OFF = 64;
__device__ __forceinline__ void moe_plan(const Frame& F, int layer) {
    volatile LAS int* tstart = (volatile LAS int*)(F.MISC + PLAN_OFF); volatile LAS int* cnts = tstart + 72;
    __syncthreads();
    if (F.wave == 0) {
        const unsigned* cnt = (const unsigned*)(F.ws + WS_CTL) + CW_CNT + layer * NE * 64;
        const int c = (int)__hip_atomic_load(cnt + F.lane * 64, __ATOMIC_RELAXED, __HIP_MEMORY_SCOPE_AGENT);
        int v = (c + 255) >> 8;
#pragma unroll
        for (int o = 1; o < 64; o <<= 1) { const int nb = __builtin_amdgcn_ds_bpermute((F.lane - o) << 2, v); if (F.lane >= o) v += nb; }
        tstart[F.lane + 1] = v; cnts[F.lane] = c;
        if (F.lane == 0) tstart[0] = 0;
        if (F.lane == 63) { tstart[65] = v + T / 256; cnts[64] = T; }
    }
    __syncthreads();
}
template <bool GATH> struct MoeSched2 {
    static constexpr bool GATHER = GATH, UNIFORMIZE = true, FP8 = true;
    static constexpr int ncol = GATH ? 2 : 4, K = GATH ? D / 2 : ED / 2;
    const volatile LAS int* tstart; const volatile LAS int* cnts; int ntiles, G, c, lane;
    const char* Abase; const char* Wbase; const int* lists;
    __device__ __forceinline__ bool next(int i, pg8::UnitG& u) const {
        const int nwg = ntiles * ncol; const long L = (long)i * G + c; if (L >= nwg) return false;
        int wgid = (int)L; { const int q = nwg / 8, r = nwg % 8, xcd = wgid % 8, off = wgid / 8; wgid = (xcd < r ? xcd * (q + 1) : r * (q + 1) + (xcd - r) * q) + off; }
        const int tile = wgid / ncol, pn = wgid % ncol;
        int ln; { unsigned o2 = ~0u; asm volatile("" : "+s"(o2)); ln = (int)__builtin_amdgcn_mbcnt_hi(o2, __builtin_amdgcn_mbcnt_lo(o2, 0u)); }
        const int ta = tstart[ln], tb = tstart[ln + 1];
        const unsigned long long mm = __ballot(ta <= tile && tile < tb);
        const int e = mm ? (int)__builtin_ctzll(mm) : 64;
        const int ts = __builtin_amdgcn_readfirstlane((int)tstart[e]), ce = __builtin_amdgcn_readfirstlane((int)cnts[e]);
        const int lt = tile - ts; int valid = ce - lt * 256; valid = valid > 256 ? 256 : valid;
        u.gshift = 0; u.aux = e;
        if (GATH) {
            u.B = Wbase + (size_t)e * WMOE_E_BYTES + (size_t)pn * 256 * K * 2;
            if (e < 64) { u.A = Abase; u.gidx = lists + (size_t)e * T + lt * 256; u.gcnt = valid; }
            else { u.A = Abase + (size_t)lt * 256 * K * 2; u.gidx = nullptr; u.gcnt = 0; }
            u.row0 = tile * 256; u.col0 = pn * 128;
        } else {
            u.B = Wbase + (size_t)e * WMOE_E_BYTES + (size_t)512 * 1024 * 2 + (size_t)pn * 256 * K * 2;
            u.A = Abase + (size_t)tile * 256 * K * 2; u.gidx = nullptr; u.gcnt = valid;
            u.row0 = tile * 256; u.col0 = pn * 256;
        }
        return true;
    }
};
__device__ __forceinline__ void phase_load_x(const Frame& F, KP p) {
    const float* xin = gin(p, 0); bf16* XB = (bf16*)(F.ws + WS_XB);
    for (size_t i = (size_t)F.vcu * NTHREADS + F.tid; i < (size_t)T * D / 8; i += (size_t)F.G * NTHREADS) {
        const f32x4 a = *(const f32x4*)(xin + i * 8), b = *(const f32x4*)(xin + i * 8 + 4);
        *(u32x4*)(XB + i * 8) = pack_bf16x8(a, b);
        u32x2 q8; q8.x = pk4_fp8(a[0], a[1], a[2], a[3]); q8.y = pk4_fp8(b[0], b[1], b[2], b[3]); *(u32x2*)((unsigned char*)(F.ws + WS_X) + i * 8) = q8; }
}

__global__ void __launch_bounds__(NTHREADS, 2) fwd_kernel(Params p_unused) {
    KP p0 = (KP)__builtin_amdgcn_kernarg_segment_ptr();
    extern __shared__ __attribute__((aligned(16))) unsigned char lds_raw[];
    Frame F0;
    F0.lds = (LAS unsigned char*)lds_raw; F0.MISC = (volatile LAS unsigned*)(F0.lds + MISC_OFF);
    F0.tid = threadIdx.x; F0.lane = F0.tid & 63; F0.wave = __builtin_amdgcn_readfirstlane(F0.tid >> 6);
    F0.G = gridDim.x; { const int bq = blockIdx.x; F0.vcu = (F0.G % 8 == 0) ? (bq % 8) * (F0.G / 8) + bq / 8 : bq; }
    F0.ws = p0->ws;
    const int bx0 = blockIdx.x;
    for (int u = F0.tid; u < (LDS_BYTES - MISC_OFF) / 4; u += NTHREADS) ((LAS unsigned*)(F0.lds + MISC_OFF))[u] = 0u;
    __syncthreads();
    XcdBarrier bar; bar.bar = (unsigned*)(p0->ws + WS_CTL) + CW_BAR; bar.x = 0; bar.st = nullptr;
    const int use_bar = p0->use_bar;
    if (use_bar) bar = xcd_barrier_post((unsigned*)(p0->ws + WS_CTL) + CW_BAR, F0.MISC + 8);
    const int lo = p0->ph_lo, hi = p0->ph_hi;
#define PHASE_BEGIN Frame F = F0; KP p = p0; { unsigned ones_ = ~0u; asm volatile("" : "+s"(ones_)); F.lane = (int)__builtin_amdgcn_mbcnt_hi(ones_, __builtin_amdgcn_mbcnt_lo(ones_, 0u)); } asm volatile("" : "+v"(F.lane)); F.tid = F.wave * 64 + F.lane; asm volatile("" : "+v"(F.tid));   GAS unsigned char* wsg_ = (GAS unsigned char*)F0.ws; asm volatile("" : "+s"(F.wave), "+s"(F.vcu), "+s"(F.G), "+s"(wsg_), "+s"(p)); \
    F.ws = (unsigned char*)wsg_; int bx = bx0; asm volatile("" : "+s"(bx)); unsigned char* ws = F.ws; (void)ws; (void)bx;
#pragma unroll 1
    for (int ph = lo; ph < hi; ++ph) {
        int layer = 0, type = 0;
        if (ph > 0) { layer = ph >= 26 ? 3 : (ph >= 18 ? 2 : (ph >= 9 ? 1 : 0)); const int q = ph - (layer == 3 ? 26 : (layer == 2 ? 18 : (layer == 1 ? 9 : 1))); const int kind = layer % 3;
            if (kind == 0) type = q < 4 ? 1 + q : 14 + (q - 4); else if (kind == 1) type = q < 5 ? 5 + q : 14 + (q - 5); else type = q < 4 ? 10 + q : 14 + (q - 4); }
        const int j = layer / 3;
#ifdef REPEAT_MASK
        const int nrep = ((REPEAT_MASK >> type) & 1u) ? 2 : 1;
#else
        const int nrep = 1;
#endif
#pragma unroll 1
        for (int rep = 0; rep < nrep; ++rep) {
        if (rep > 0 && use_bar) xcd_barrier(bar);
        if (PHT(0) && type == 0) { PHASE_BEGIN; phase_conv_mixers(F, p); phase_conv_moe(F, p, 0); phase_load_x(F, p); }
        else if (PHT(1) && type == 1) { PHASE_BEGIN; DenseSched8 S; S.init(ws + WS_X, ws + WS_ATT_IN_T + (size_t)j * ATT_IN * D, T, ATT_IN, D / 2, F.G, bx); EpiStoreBf16 E{(bf16*)(ws + WS_BIG), ATT_IN, WUP_INV, 0.08838834764831845f};
            pg8::gemm_phase(F.lds, F.tid, D / 2, S, E); }
        else if (PHT(2) && type == 2) { PHASE_BEGIN; phase_attn(F, bx); }
        else if (PHT(3) && type == 3) { PHASE_BEGIN; phase_attn_combine(F); }
        else if (PHT(4) && type == 4) { PHASE_BEGIN; DenseSched8 S; S.init(ws + WS_AUX + AUX_OB, ws + WS_ATT_OUT_T + (size_t)j * D * D, T, D, D / 2, F.G, bx); EpiResid8 E{(const bf16*)(ws + WS_XB), (bf16*)(ws + WS_Y), 1.0f / (A_SCALE * WUP_SCALE)};
            pg8::gemm_phase(F.lds, F.tid, D / 2, S, E); }
        else if (PHT(5) && type == 5) { PHASE_BEGIN; DenseSched8 S; S.init(ws + WS_X, ws + WS_RET_IN_T, T, RET_IN, D / 2, F.G, bx); EpiRetIn E{(bf16*)(ws + WS_BIG), RET_IN};
            pg8::gemm_phase(F.lds, F.tid, D / 2, S, E); }
        else if (PHT(6) && type == 6) { PHASE_BEGIN; phase_ret_u(F); }
        else if (PHT(7) && type == 7) { PHASE_BEGIN; phase_ret_scan(F); }
        else if (PHT(8) && type == 8) { PHASE_BEGIN; phase_ret_out(F, p); }
        else if (PHT(9) && type == 9) { PHASE_BEGIN; DenseSched8 S; S.init(ws + WS_BIG + BIG_YRET, ws + WS_RET_OUT_T, T, D, RET_V / 2, F.G, bx); EpiResid8 E{(const bf16*)(ws + WS_XB), (bf16*)(ws + WS_Y), 1.0f / (A_SCALE * WUP_SCALE)};
            pg8::gemm_phase(F.lds, F.tid, RET_V / 2, S, E); }
        else if (PHT(10) && type == 10) { PHASE_BEGIN; phase_s5_scan<false>(F, p); }
        else if (PHT(11) && type == 11) { PHASE_BEGIN; phase_s5_carry(F, p); }
        else if (PHT(12) && type == 12) { PHASE_BEGIN; phase_s5_scan<true>(F, p); }
        else if (PHT(13) && type == 13) { PHASE_BEGIN; DenseSched8 S; S.init(ws + WS_AUX, ws + WS_GLU_T, T, 2 * D, D / 2, F.G, bx); EpiGluResid E{(const bf16*)(ws + WS_XB), (bf16*)(ws + WS_Y), 1.0f / (A_SCALE * WUP_SCALE)};
            pg8::gemm_phase(F.lds, F.tid, D / 2, S, E); }
        else if (PHT(14) && type == 14) { PHASE_BEGIN; phase_lnr(F, p, layer, PROBE_DRY14 && true); if (PROBE_DRY14) { if (use_bar) xcd_barrier(bar); phase_lnr(F, p, layer, false); } }
        else if (PHT(15) && type == 15) { PHASE_BEGIN; moe_plan(F, layer);
            MoeSched2<true> S; S.tstart = (const volatile LAS int*)(F.MISC + PLAN_OFF); S.cnts = S.tstart + 72; S.ntiles = __builtin_amdgcn_readfirstlane((int)S.tstart[65]); S.G = F.G; S.c = bx; S.lane = F.lane;
            S.Abase = (const char*)(ws + WS_X); S.Wbase = (const char*)(ws + WS_WMOE); S.lists = (const int*)(ws + WS_LIST);
            EpiMoeUp E{(unsigned char*)(ws + WS_H)};
            pg8::gemm_phase(F.lds, F.tid, D / 2, S, E); }
        else if (PHT(16) && type == 16) { PHASE_BEGIN; moe_plan(F, layer);
            { MoeSched2<false> S; S.tstart = (const volatile LAS int*)(F.MISC + PLAN_OFF); S.cnts = S.tstart + 72; S.ntiles = __builtin_amdgcn_readfirstlane((int)S.tstart[64]); S.G = F.G; S.c = bx; S.lane = F.lane;
              S.Abase = (const char*)(ws + WS_H); S.Wbase = (const char*)(ws + WS_WMOE); S.lists = (const int*)(ws + WS_LIST);
              EpiStoreFp8 E{(unsigned char*)(ws + WS_BIG), D};
              pg8::gemm_phase(F.lds, F.tid, ED / 2, S, E); }
            { const int sh0 = __builtin_amdgcn_readfirstlane((int)((const volatile LAS int*)(F.MISC + PLAN_OFF))[64]);
              DenseSched8 S; S.init(ws + WS_H + (size_t)sh0 * 256 * ED, ws + WS_WMOE + (size_t)64 * WMOE_E_BYTES + (size_t)512 * 1024 * 2, T, D, ED / 2, F.G, bx); EpiResid8 E{(const bf16*)(ws + WS_XB), (bf16*)(ws + WS_Y), 1.0f / (H_SCALE * WUP_SCALE)};
              int tid2; { unsigned o2 = ~0u; asm volatile("" : "+s"(o2)); tid2 = F.wave * 64 + (int)__builtin_amdgcn_mbcnt_hi(o2, __builtin_amdgcn_mbcnt_lo(o2, 0u)); }
              pg8::gemm_phase(F.lds, tid2, ED / 2, S, E); } }
        else if (PHT(17) && type == 17) { PHASE_BEGIN; moe_plan(F, layer); if (PROBE_DRY17) { phase_combine(F, p, layer, true); if (use_bar) xcd_barrier(bar); } phase_combine(F, p, layer); if (layer + 1 < DEPTH) phase_conv_moe(F, p, layer + 1); }
        }
        if (use_bar && ph + 1 < hi) xcd_barrier(bar);
    }
}

#ifndef MK_PER_PHASE
#define MK_PER_PHASE 0
#endif
extern "C" void kernel_launch(void* const* d_in, const int* in_sizes, int n_in, void* d_out, int out_size, void* d_ws, size_t ws_size, hipStream_t stream) {
    static int grid = 0;
    if (grid == 0) {
        if (n_in != 26 || in_sizes[0] != T * D || out_size != T * D || ws_size < WS_END) { fprintf(stderr, "kernel_launch: unexpected shapes / workspace (n_in %d, in0 %d, out %d, ws %zu < %zu)\n", n_in, n_in > 0 ? in_sizes[0] : -1, out_size, ws_size, (size_t)WS_END); grid = -1; return; }
        int dev = 0, cus = 0, per_cu = 0;
        if (hipGetDevice(&dev) != hipSuccess || hipDeviceGetAttribute(&cus, hipDeviceAttributeMultiprocessorCount, dev) != hipSuccess) { grid = -1; return; }
        if (hipFuncSetAttribute((const void*)fwd_kernel, hipFuncAttributeMaxDynamicSharedMemorySize, LDS_BYTES) != hipSuccess) { fprintf(stderr, "kernel_launch: hipFuncSetAttribute failed\n"); grid = -1; return; }
        if (hipOccupancyMaxActiveBlocksPerMultiprocessor(&per_cu, (const void*)fwd_kernel, NTHREADS, LDS_BYTES) != hipSuccess || per_cu < 1) { fprintf(stderr, "kernel_launch: occupancy query says %d blocks per CU\n", per_cu); per_cu = 1; }
        (void)hipGetLastError();
        grid = cus;
    }
    if (grid < 0) return;
    (void)hipMemsetAsync((char*)d_ws + WS_CTL, 0, CTL_ZERO_BYTES, stream);
    Params p{};
    for (int i = 0; i < 26; ++i) p.in[i] = (const float*)d_in[i];
    p.out = (float*)d_out; p.ws = (unsigned char*)d_ws;
#if MK_PER_PHASE
    for (int k = 0; k < NPHASES; ++k) { p.ph_lo = k; p.ph_hi = k + 1; p.use_bar = 0; hipLaunchKernelGGL(fwd_kernel, dim3(grid), dim3(NTHREADS), LDS_BYTES, stream, p); }
#else
    p.ph_lo = 0; p.ph_hi = NPHASES; p.use_bar = 1;
    hipLaunchKernelGGL(fwd_kernel, dim3(grid), dim3(NTHREADS), LDS_BYTES, stream, p);
#endif
}
```

```cpp
#include <hip/hip_runtime.h>
#include <cstdio>
#include <cstdint>

#define LAS __attribute__((address_space(3)))
#define GAS __attribute__((address_space(1)))
typedef unsigned short bf16;
typedef short bf16x8 __attribute__((ext_vector_type(8)));
typedef short bf16x4 __attribute__((ext_vector_type(4)));
typedef float f32x4 __attribute__((ext_vector_type(4)));
typedef float f32x2 __attribute__((ext_vector_type(2)));
typedef unsigned u32x4 __attribute__((ext_vector_type(4)));
typedef unsigned u32x2 __attribute__((ext_vector_type(2)));
typedef GAS unsigned gu32;

constexpr int D = 1024, BATCH = 2, SEQ = 8192, T = BATCH * SEQ, DEPTH = 4;
constexpr int AH = 8, AHD = 128, ATT_IN = 9216;
constexpr int RH = 4, RDK = 256, RDV = 512, RET_IN = 6144, RET_V = 2048, RC = 128, RNC = SEQ / RC;
constexpr int SG = 64, SGC = 16, SP = 64;
constexpr int NE = 64, TOPK = 8, NEG = 8, ED = 256, NSLOT = 9;
constexpr float LN_EPS = 1e-5f;
constexpr float ALPHA = 1.6817928305074292f;
constexpr int NWAVES = 8, NTHREADS = 512;

__device__ __forceinline__ unsigned f2bf(float f) { unsigned u = __builtin_bit_cast(unsigned, f); return (u + 0x7fffu + ((u >> 16) & 1u)) >> 16; }
__device__ __forceinline__ unsigned pk2(float lo, float hi) { unsigned r; asm("s_nop 1\n\tv_cvt_pk_bf16_f32 %0, %1, %2" : "=v"(r) : "v"(lo), "v"(hi)); return r; }
__device__ __forceinline__ unsigned pk2sw(float lo, float hi) { return f2bf(lo) | (f2bf(hi) << 16); }
__device__ __forceinline__ unsigned pk2hw(float lo, float hi) { unsigned r; asm volatile("v_cvt_pk_bf16_f32 %0, %1, %2" : "=v"(r) : "v"(lo), "v"(hi)); return r; }
__device__ __forceinline__ float bf2f(unsigned b) { return __builtin_bit_cast(float, b << 16); }
__device__ __forceinline__ float bflo(unsigned w) { return __builtin_bit_cast(float, w << 16); }
__device__ __forceinline__ float bfhi(unsigned w) { return __builtin_bit_cast(float, w & 0xffff0000u); }
__device__ __forceinline__ float shx(float v, int m, int lane) { return __builtin_bit_cast(float, __builtin_amdgcn_ds_bpermute((lane ^ m) << 2, __builtin_bit_cast(int, v))); }
__device__ __forceinline__ int shx_i(int v, int m, int lane) { return __builtin_amdgcn_ds_bpermute((lane ^ m) << 2, v); }
__device__ __forceinline__ float rdl(float v, int src) { return __builtin_bit_cast(float, __builtin_amdgcn_readlane(__builtin_bit_cast(int, v), src)); }
template <int CTRL, int RM = 0xf, int BM = 0xf> __device__ __forceinline__ float dpp0(float v) { return __builtin_bit_cast(float, __builtin_amdgcn_update_dpp(0, __builtin_bit_cast(int, v), CTRL, RM, BM, true)); }
template <int CTRL, int RM = 0xf, int BM = 0xf> __device__ __forceinline__ float dppo(float old, float v) { return __builtin_bit_cast(float, __builtin_amdgcn_update_dpp(__builtin_bit_cast(int, old), __builtin_bit_cast(int, v), CTRL, RM, BM, false)); }
__device__ __forceinline__ float wave_sum(float v, int lane) {
    (void)lane;
    v += dpp0<0x111>(v); v += dpp0<0x112>(v); v += dpp0<0x114>(v); v += dpp0<0x118>(v);
    v += dpp0<0x142, 0xa>(v);
    v += dpp0<0x143, 0xc>(v);
    return rdl(v, 63);
}
__device__ __forceinline__ unsigned wave_umax(unsigned v) {
#define WU_DPP(ctrl, rm) (unsigned)__builtin_amdgcn_update_dpp(0, (int)v, ctrl, rm, 0xf, true)
    { const unsigned t = WU_DPP(0x111, 0xf); v = v > t ? v : t; } { const unsigned t = WU_DPP(0x112, 0xf); v = v > t ? v : t; } { const unsigned t = WU_DPP(0x114, 0xf); v = v > t ? v : t; } { const unsigned t = WU_DPP(0x118, 0xf); v = v > t ? v : t; }
    { const unsigned t = WU_DPP(0x142, 0xa); v = v > t ? v : t; } { const unsigned t = WU_DPP(0x143, 0xc); v = v > t ? v : t; }
#undef WU_DPP
    return (unsigned)__builtin_amdgcn_readlane((int)v, 63);
}
__device__ __forceinline__ float max8(float v) {
    v = fmaxf(v, dppo<0xb1>(v, v)); v = fmaxf(v, dppo<0x4e>(v, v)); v = fmaxf(v, dppo<0x141>(v, v)); return v;
}
__device__ __forceinline__ float fsig(float x) { return __builtin_amdgcn_rcpf(1.0f + __expf(-x)); }
#define LDS_WAIT() asm volatile("s_waitcnt lgkmcnt(0)" ::: "memory")
#define VM_WAIT() asm volatile("s_waitcnt vmcnt(0)" ::: "memory")
__device__ __forceinline__ const char* rfl_ptr(const char* p) {
    unsigned long long v = (unsigned long long)p; unsigned lo = __builtin_amdgcn_readfirstlane((unsigned)v), hi = __builtin_amdgcn_readfirstlane((unsigned)(v >> 32));
    return (const char*)(((unsigned long long)hi << 32) | lo);
}
__device__ __forceinline__ bf16x8 row_frag(const LAS bf16* base, int ld, int row0, int col0, int lane) {
    return *(const LAS bf16x8*)(base + (row0 + (lane & 15)) * ld + col0 + 8 * (lane >> 4));
}
__device__ __forceinline__ bf16x4 tr4(const LAS bf16* addr) { return __builtin_amdgcn_ds_read_tr16_b64_v4i16((LAS bf16x4*)addr); }
__device__ __forceinline__ bf16x8 cat8(bf16x4 a, bf16x4 b) { bf16x8 r; r[0] = a[0]; r[1] = a[1]; r[2] = a[2]; r[3] = a[3]; r[4] = b[0]; r[5] = b[1]; r[6] = b[2]; r[7] = b[3]; return r; }
#define MFMA16(a, b, c) __builtin_amdgcn_mfma_f32_16x16x32_bf16((a), (b), (c), 0, 0, 0)
__device__ __forceinline__ bf16x8 pack8(f32x4 a, f32x4 b) {
    u32x4 w; w.x = pk2(a[0], a[1]); w.y = pk2(a[2], a[3]); w.z = pk2(b[0], b[1]); w.w = pk2(b[2], b[3]); return __builtin_bit_cast(bf16x8, w);
}

namespace pg8 {
typedef int v4i_t __attribute__((ext_vector_type(4)));
typedef int v8i_t __attribute__((ext_vector_type(8)));
constexpr int BM = 256, BK = 64, HALF = 128, HTB = HALF * BK * 2, STAGE_BYTES = 8 * HTB;
__device__ __forceinline__ int lds_byte(int r, int c) { const int st = (r >> 4) * 2 + (c >> 5), rr = r & 15, cc = c & 31, ob = rr * 64 + cc * 2; return st * 1024 + (ob ^ (((ob >> 9) & 1) << 5)); }
__device__ __forceinline__ void stage_rc(int b, int& R, int& C) { const int st = b / 1024, sb = b % 1024, swz = sb ^ (((sb >> 9) & 1) << 5); R = (st >> 1) * 16 + swz / 64; C = (st & 1) * 32 + (swz % 64) / 2; }
__device__ __forceinline__ int perm32(int rho) { const int n = rho >> 4, i = rho & 15; return 8 * (i >> 2) + 4 * n + (i & 3); }

struct UnitG {
    const char* A;
    const char* B;
    const int* gidx;
    int gcnt, gshift;
    int row0, col0;
    int aux;
};

__device__ __forceinline__ void uniformize(UnitG& u) { u.A = rfl_ptr(u.A); u.B = rfl_ptr(u.B); u.gidx = (const int*)rfl_ptr((const char*)u.gidx); u.gcnt = __builtin_amdgcn_readfirstlane(u.gcnt); u.gshift = __builtin_amdgcn_readfirstlane(u.gshift);
    u.row0 = __builtin_amdgcn_readfirstlane(u.row0); u.col0 = __builtin_amdgcn_readfirstlane(u.col0); u.aux = __builtin_amdgcn_readfirstlane(u.aux); }
template <class Epi, class Sched>
__device__ __forceinline__ void gemm_phase(LAS unsigned char* lds, const int tid, const int K, const Sched& S, const Epi& E) {
    constexpr bool F8 = Sched::FP8;
    constexpr bool GATHER = Sched::GATHER;
    const int wid = __builtin_amdgcn_readfirstlane(tid >> 6), lane = tid & 63, wr = wid >> 2, wc = wid & 3, fr = lane & 15, fq = lane >> 4;
    int nt = K / BK; asm volatile("" : "+s"(nt));
    constexpr bool P16 = Epi::PERM16;
    unsigned voffB[2], voffB1[2], vA[2][2];
#pragma unroll
    for (int i = 0; i < 2; ++i) { int R, C; stage_rc(tid * 16 + i * 8192, R, C); const int Rb = Epi::PERM ? ((R & ~31) + perm32(R & 31)) : R; voffB[i] = (unsigned)(Rb * K + C) * 2u; voffB1[i] = voffB[i]; vA[0][i] = (unsigned)(R * K + C) * 2u; vA[1][i] = vA[0][i];
        if constexpr (P16) { const int x = R & 31, src = 64 * (R >> 5) + 16 * ((x >> 2) & 3) + 4 * (x >> 4) + (x & 3); voffB[i] = (unsigned)(src * K + C) * 2u; voffB1[i] = (unsigned)((src + 8) * K + C) * 2u; } }
    const size_t kstep = (size_t)(BK * 2);
    const size_t hstep = (size_t)HALF * K * 2;
    const size_t hstepB = P16 ? 0 : hstep;
    const size_t hstepA = GATHER ? 0 : hstep;
    const size_t hstepB1 = P16 ? (size_t)8 * K * 2 : hstep, bstep = (size_t)(P16 ? 128 : 64) * K * 2, astep = (size_t)64 * K * 2;
    unsigned vB0 = voffB[0], vA0 = vA[0][0];
    const unsigned ldsw = (unsigned)wid * 1024u;
    const int aoff = lds_byte(wr * 64 + fr, fq * 8), boff = lds_byte(wc * 32 + fr, fq * 8);
    LAS u32x4* park = (LAS u32x4*)(lds + STAGE_BYTES) + tid;
#define PG8_SA(b, h) (((b) * 2 + (h)) * HTB)
#define PG8_SB(b, h) ((4 + (b) * 2 + (h)) * HTB)
#define PG8_STAGE(bufoff, gbase, voff) do { _Pragma("unroll") for (int _i = 0; _i < 2; ++_i) { asm volatile("" : "+v"((voff)[_i]));   \
        __builtin_amdgcn_global_load_lds((const unsigned*)((const char*)(gbase) + (voff)[_i]), (LAS unsigned*)(lds + (bufoff) + ldsw + _i * 8192), 16, 0, 0); } } while (0)
#define PG8_STAGEU(bufoff, gbase, v0, step1) do { asm volatile("" : "+v"(v0)); __builtin_amdgcn_global_load_lds((const unsigned*)((const char*)(gbase) + (v0)), (LAS unsigned*)(lds + (bufoff) + ldsw), 16, 0, 0); \
        asm volatile("" : "+v"(v0)); __builtin_amdgcn_global_load_lds((const unsigned*)((const char*)(gbase) + (step1) + (v0)), (LAS unsigned*)(lds + (bufoff) + ldsw + 8192), 16, 0, 0); } while (0)
#define PG8_STB(b, h, base) PG8_STAGEU(PG8_SB(b, h), (base) + (h) * hstepB1, vB0, bstep)
#define PG8_STA(b, h, base) do { if constexpr (GATHER) PG8_STAGE(PG8_SA(b, h), (base), vA[h]); else PG8_STAGEU(PG8_SA(b, h), (base) + (h) * hstep, vA0, astep); } while (0)
    constexpr int FKS = 1024;
#define PG8_LD2(p_) __builtin_shufflevector(*(const LAS v4i_t*)(p_), *(const LAS v4i_t*)((p_) + FKS), 0, 1, 2, 3, 4, 5, 6, 7)
#define PG8_LDA(dst, b, h) do { _Pragma("unroll") for (int m = 0; m < 4; ++m) dst[m] = PG8_LD2(lds + PG8_SA(b, h) + aoff + m * 2048); } while (0)
#define PG8_LDB(dst, b, h) do { _Pragma("unroll") for (int n = 0; n < 2; ++n) dst[n] = PG8_LD2(lds + PG8_SB(b, h) + boff + n * 2048); } while (0)
#define PG8_LO(v) __builtin_bit_cast(bf16x8, __builtin_shufflevector((v), (v), 0, 1, 2, 3))
#define PG8_HI(v) __builtin_bit_cast(bf16x8, __builtin_shufflevector((v), (v), 4, 5, 6, 7))
#define PG8_MMA(ai, bj, At, Bt) do { __builtin_amdgcn_s_setprio(1); _Pragma("unroll") for (int m = 0; m < 4; ++m) _Pragma("unroll") for (int n = 0; n < 2; ++n) { \
        if constexpr (F8) { acc[ai][bj][m][n] = __builtin_amdgcn_mfma_scale_f32_16x16x128_f8f6f4(Bt[n], At[m], acc[ai][bj][m][n], 0, 0, 0, 0x7F7F7F7F, 0, 0x7F7F7F7F); } \
        else { acc[ai][bj][m][n] = __builtin_amdgcn_mfma_f32_16x16x32_bf16(PG8_LO(Bt[n]), PG8_LO(At[m]), acc[ai][bj][m][n], 0, 0, 0); \
               acc[ai][bj][m][n] = __builtin_amdgcn_mfma_f32_16x16x32_bf16(PG8_HI(Bt[n]), PG8_HI(At[m]), acc[ai][bj][m][n], 0, 0, 0); } } __builtin_amdgcn_s_setprio(0); } while (0)
#define PG8_WAIT_V(n) asm volatile("s_waitcnt vmcnt(" #n ")" ::: "memory")
#define PG8_WAIT_L(n) asm volatile("s_waitcnt lgkmcnt(" #n ")" ::: "memory")
#define PG8_BAR __builtin_amdgcn_s_barrier()
#define PG8_SCHED __builtin_amdgcn_sched_barrier(0)
#define PG8_VOFF(u, v00, v01, v10, v11) do { int _R0, _C0, _R1, _C1; stage_rc(tid * 16, _R0, _C0); stage_rc(tid * 16 + 8192, _R1, _C1); int _r00 = _R0, _r01 = _R1, _r10 = HALF + _R0, _r11 = HALF + _R1; \
        if ((u).gidx) { const GAS int* _gp = (const GAS int*)(u).gidx; const int _gc = (u).gcnt;     \
            const int _a = _gp[_r00 < _gc ? _r00 : 0] >> (u).gshift, _b = _gp[_r01 < _gc ? _r01 : 0] >> (u).gshift, _c = _gp[_r10 < _gc ? _r10 : 0] >> (u).gshift, _d = _gp[_r11 < _gc ? _r11 : 0] >> (u).gshift; \
            _r00 = _a; _r01 = _b; _r10 = _c; _r11 = _d; } \
        v00 = (unsigned)(_r00 * K + _C0) * 2u; v01 = (unsigned)(_r01 * K + _C1) * 2u; v10 = (unsigned)(_r10 * K + _C0) * 2u; v11 = (unsigned)(_r11 * K + _C1) * 2u; } while (0)
    UnitG cur, nxt; int ui = 0;
    if (!S.next(0, cur)) return;
    if constexpr (Sched::UNIFORMIZE) uniformize(cur);
    f32x4 acc[2][2][4][2];
#pragma unroll
    for (int a = 0; a < 2; ++a)
#pragma unroll
        for (int b = 0; b < 2; ++b)
#pragma unroll
            for (int m = 0; m < 4; ++m)
#pragma unroll
                for (int n = 0; n < 2; ++n) acc[a][b][m][n] = (f32x4){0.f, 0.f, 0.f, 0.f};
    v8i_t At[4], B0[2], B1[2];
    if constexpr (GATHER) PG8_VOFF(cur, vA[0][0], vA[0][1], vA[1][0], vA[1][1]);
    const char* cA = cur.A; const char* cB = cur.B;
    PG8_STB(0, 0, cB); PG8_STB(0, 1, cB); PG8_STA(0, 0, cA); PG8_STA(0, 1, cA);
    if (wr == 1) PG8_BAR;
    PG8_WAIT_V(2); PG8_BAR;
    PG8_STB(1, 0, cB + kstep); PG8_STA(1, 0, cA + kstep); PG8_STB(1, 1, cB + kstep);
    PG8_WAIT_V(6); PG8_BAR;
    for (;;) {
        const bool has_next = S.next(ui + 1, nxt);
        if constexpr (Sched::UNIFORMIZE) { if (has_next) uniformize(nxt); }
        const char* nA = cA; const char* nB = cB;
        if (has_next) { nA = nxt.A; nB = nxt.B; }
        if constexpr (GATHER) { u32x4 pv; pv.x = vA[0][0]; pv.y = vA[0][1]; pv.z = vA[1][0]; pv.w = vA[1][1];
            if (has_next) PG8_VOFF(nxt, pv.x, pv.y, pv.z, pv.w);
            *park = pv; }
#pragma unroll 1
        for (int t = 0; t < nt; t += 2) {
            const bool last = (t == nt - 2);
            const char* a1 = cA + (size_t)(t + 1) * kstep;
            const char* a2 = last ? nA : cA + (size_t)(t + 2) * kstep; const char* b2 = last ? nB : cB + (size_t)(t + 2) * kstep;
            const char* a3 = a2 + kstep; const char* b3 = b2 + kstep;
            PG8_LDB(B0, 0, 0); PG8_LDB(B1, 0, 1); PG8_SCHED; PG8_LDA(At, 0, 0); PG8_STA(1, 1, a1);
            PG8_WAIT_V(8); PG8_WAIT_L(0); PG8_BAR; PG8_MMA(0, 0, At, B0); PG8_MMA(0, 1, At, B1); PG8_BAR; PG8_SCHED;
            if constexpr (GATHER) { if (last) { const u32x4 pv = *park; vA[0][0] = pv.x; vA[0][1] = pv.y; vA[1][0] = pv.z; vA[1][1] = pv.w; } }
            PG8_LDA(At, 0, 1); PG8_STB(0, 0, b2); PG8_STB(0, 1, b2); PG8_STA(0, 0, a2);
            PG8_WAIT_V(8); PG8_WAIT_L(0); PG8_BAR; PG8_MMA(1, 0, At, B0); PG8_MMA(1, 1, At, B1); PG8_BAR; PG8_SCHED;
            PG8_LDB(B0, 1, 0); PG8_LDB(B1, 1, 1); PG8_SCHED; PG8_LDA(At, 1, 0); PG8_STA(0, 1, a2);
            PG8_WAIT_V(8); PG8_WAIT_L(0); PG8_BAR; PG8_MMA(0, 0, At, B0); PG8_MMA(0, 1, At, B1); PG8_BAR; PG8_SCHED;
            PG8_LDA(At, 1, 1); PG8_STB(1, 0, b3); PG8_STB(1, 1, b3); PG8_STA(1, 0, a3);
            PG8_WAIT_V(8); PG8_WAIT_L(0); PG8_BAR; PG8_MMA(1, 0, At, B0); PG8_MMA(1, 1, At, B1); PG8_BAR; PG8_SCHED;
        }
        if (wr == 0) PG8_BAR;
        { int l2; { unsigned o2 = ~0u; asm volatile("" : "+s"(o2)); l2 = (int)__builtin_amdgcn_mbcnt_hi(o2, __builtin_amdgcn_mbcnt_lo(o2, 0u)); }
          E(acc, cur, wr, wc, l2 & 15, l2 >> 4); }
        if (!has_next) break;
#pragma unroll
        for (int a = 0; a < 2; ++a)
#pragma unroll
            for (int b = 0; b < 2; ++b)
#pragma unroll
                for (int m = 0; m < 4; ++m)
#pragma unroll
                    for (int n = 0; n < 2; ++n) acc[a][b][m][n] = (f32x4){0.f, 0.f, 0.f, 0.f};
        cur = nxt; cA = nA; cB = nB; ++ui;
        if (wr == 1) PG8_BAR;
    }
    PG8_WAIT_V(0);
    PG8_BAR;
#undef PG8_SA
#undef PG8_SB
#undef PG8_STAGE
#undef PG8_STAGEU
#undef PG8_STB
#undef PG8_STA
#undef PG8_LDA
#undef PG8_LDB
#undef PG8_LD2
#undef PG8_LO
#undef PG8_HI
#undef PG8_MMA
#undef PG8_WAIT_V
#undef PG8_WAIT_L
#undef PG8_BAR
#undef PG8_SCHED
#undef PG8_VOFF
}
}

constexpr size_t MiB = 1u << 20;
constexpr size_t WS_CTL = 0, CTL_ZERO_BYTES = 1 * MiB;
constexpr size_t WS_ATT_IN_T = 1 * MiB;
constexpr size_t WS_ATT_OUT_T = WS_ATT_IN_T + 36 * MiB;
constexpr size_t WS_RET_IN_T = WS_ATT_OUT_T + 4 * MiB;
constexpr size_t WS_RET_OUT_T = WS_RET_IN_T + 12 * MiB;
constexpr size_t WS_GLU_T = WS_RET_OUT_T + 4 * MiB;
constexpr size_t WS_RT_HI = WS_GLU_T + 4 * MiB;
constexpr size_t WS_RT_LO = WS_RT_HI + 512 * 1024;
constexpr size_t WS_WMOE = WS_RT_HI + 1 * MiB;
constexpr size_t WMOE_E_BYTES = (size_t)(512 * 1024 + 1024 * 256) * 2;
constexpr size_t WS_X = WS_WMOE + 98 * MiB;
constexpr size_t WS_Y = WS_X + 64 * MiB;
constexpr size_t WS_XB = WS_Y + 64 * MiB;
constexpr size_t WS_BIG = WS_XB + 32 * MiB;
constexpr size_t WS_AUX = WS_BIG + 288 * MiB;
constexpr size_t WS_H = WS_AUX + 160 * MiB;
constexpr size_t WS_LIST = WS_H + 80 * MiB;
constexpr size_t WS_TRASH = WS_LIST + 8 * MiB;
constexpr size_t WS_END = WS_TRASH + 1 * MiB;
static_assert(WS_END <= 1024 * MiB, "workspace map");
constexpr int CW_BAR = 4096;
constexpr int CW_CNT = 16384;
constexpr int CW_CHK = 65536;
constexpr int HROWS = 163840;

#define XB_TMO      128
#define XB_XCNT(j)  (256  + 64 * (j))
#define XB_XSUB(j)  (1280 + 64 * (j))
#define XB_XGEN(j)  (2304 + 64 * (j))
#define XB_TOP      3328
#define XB_TOPGEN   3392
#define XCD_BAR_WORDS 3456
#define XB_SPIN_CAP (1u << 20)
__device__ __forceinline__ unsigned xb_ld(unsigned* p)              { return __hip_atomic_load(p, __ATOMIC_RELAXED, __HIP_MEMORY_SCOPE_AGENT); }
__device__ __forceinline__ unsigned xb_add(unsigned* p, unsigned v) { return __hip_atomic_fetch_add(p, v, __ATOMIC_RELAXED, __HIP_MEMORY_SCOPE_AGENT); }
__device__ __forceinline__ unsigned xb_xcc_id() { return (unsigned)__builtin_amdgcn_s_getreg((3 << 11) | 20) & 0xFu; }
#define XB_SPIN(cond, bar) do { unsigned _sp = 0; while (cond) { __builtin_amdgcn_s_sleep(1); \
    if ((++_sp & 255u) == 0u) { if (xb_ld(&(bar)[XB_TMO])) break; if (_sp > XB_SPIN_CAP) { atomicAdd(&(bar)[XB_TMO], 1u); break; } } } } while (0)
struct XcdBarrier { unsigned* bar; unsigned x; volatile LAS unsigned* st; };
__device__ __forceinline__ XcdBarrier xcd_barrier_post(unsigned* bar, volatile LAS unsigned* st) {
    XcdBarrier b; b.bar = bar; b.x = xb_xcc_id(); b.st = st;
    if (threadIdx.x == 0) (void)xb_add(&bar[XB_XCNT(b.x)], 1u);
    return b;
}
__device__ __forceinline__ void xcd_barrier_complete(unsigned* bar, unsigned x, unsigned& nloc, unsigned& nx) {
    const unsigned G = gridDim.x * gridDim.y * gridDim.z;
    unsigned sum, cnt, mine, sp = 0u;
    for (;;) {
        sum = 0u; cnt = 0u; mine = 0u;
#pragma unroll
        for (unsigned j = 0; j < 16; ++j) { const unsigned c = xb_ld(&bar[XB_XCNT(j)]); sum += c; cnt += (c > 0u) ? 1u : 0u; mine = (j == x) ? c : mine; }
        if (sum == G) break;
        __builtin_amdgcn_s_sleep(1);
        if ((++sp & 255u) == 0u) { if (xb_ld(&bar[XB_TMO])) break; if (sp > XB_SPIN_CAP) { atomicAdd(&bar[XB_TMO], 1u); break; } }
    }
    nloc = mine > 0u ? mine : 1u; nx = cnt > 0u ? cnt : 1u;
}
__device__ __forceinline__ void xcd_barrier(const XcdBarrier& b) {
    asm volatile("s_waitcnt vmcnt(0)" ::: "memory");
    __syncthreads();
    if (threadIdx.x == 0) {
        unsigned* bar = b.bar;
        __builtin_amdgcn_s_waitcnt(0);
        unsigned nloc = b.st[0], nx = b.st[1];
        if (nloc == 0u) { xcd_barrier_complete(bar, b.x, nloc, nx); b.st[0] = nloc; b.st[1] = nx; }
        const unsigned old = xb_add(&bar[XB_XSUB(b.x)], 1u);
        const unsigned gen = old / nloc;
        if (old + 1u == (gen + 1u) * nloc) {
            __builtin_amdgcn_fence(__ATOMIC_RELEASE, "agent");
            asm volatile("s_waitcnt vmcnt(0)" ::: "memory");
            const unsigned og = xb_add(&bar[XB_TOP], 1u);
            const unsigned tg = og / nx;
            if (og + 1u == (tg + 1u) * nx) xb_add(&bar[XB_TOPGEN], 1u);
            else XB_SPIN(xb_ld(&bar[XB_TOPGEN]) == tg, bar);
            __builtin_amdgcn_fence(__ATOMIC_ACQUIRE, "agent");
            xb_add(&bar[XB_XGEN(b.x)], 1u);
            asm volatile("s_waitcnt vmcnt(0)" ::: "memory");
        } else {
            XB_SPIN(xb_ld(&bar[XB_XGEN(b.x)]) == gen, bar);
            __builtin_amdgcn_fence(__ATOMIC_ACQUIRE, "agent");
            asm volatile("s_waitcnt vmcnt(0)" ::: "memory");
        }
    }
    __syncthreads();
}

constexpr int RING_BYTES = 139264;
constexpr int MISC_OFF = RING_BYTES;
constexpr int LDS_BYTES = 147456;
struct Params {
    const float* in[26]; float* out; unsigned char* ws; int ph_lo, ph_hi; int use_bar, pad;
};
typedef const __attribute__((address_space(4))) Params* KP;
__device__ __forceinline__ const float* gin(KP p, int i) { return (const float*)(const GAS float*)p->in[i]; }
__device__ __forceinline__ float* gout(KP p) { return (float*)(GAS float*)p->out; }
struct Frame {
    LAS unsigned char* lds; volatile LAS unsigned* MISC;
    int tid, lane, wave, vcu, G;
    unsigned char* ws;
};

template <bool F8_ = false> struct DenseSchedT {
    static constexpr bool GATHER = false, UNIFORMIZE = false, FP8 = F8_;
    const char* A; const char* Bt; int K, nM, nN, nwg, G, c;
    __device__ __forceinline__ void init(const void* A_, const void* Bt_, int M, int N, int K_, int G_, int c_) { A = (const char*)A_; Bt = (const char*)Bt_; K = K_; nM = M / 256; nN = N / 256; nwg = nM * nN; G = G_; c = c_; }
    __device__ __forceinline__ bool next(int i, pg8::UnitG& u) const {
        const long L = (long)i * G + c; if (L >= nwg) return false;
        int wgid = (int)L; { const int q = nwg / 8, r = nwg % 8, xcd = wgid % 8, off = wgid / 8; wgid = (xcd < r ? xcd * (q + 1) : r * (q + 1) + (xcd - r) * q) + off; }
        const int nig = 8 * nN, gid = wgid / nig, fm = gid * 8, gsz = (nM - fm) < 8 ? (nM - fm) : 8;
        const int pm = fm + ((wgid % nig) % gsz), pn = (wgid % nig) / gsz;
        u.A = A + (size_t)pm * 256 * K * 2; u.B = Bt + (size_t)pn * 256 * K * 2; u.gidx = nullptr; u.gcnt = 0; u.gshift = 0; u.row0 = pm * 256; u.col0 = pn * 256; u.aux = 0; return true;
    }
};
typedef DenseSchedT<false> DenseSched; typedef DenseSchedT<true> DenseSched8;
__device__ __forceinline__ u32x4 pack_bf16x8(const f32x4& v0, const f32x4& v1) { u32x4 w; w.x = pk2hw(v0[0], v0[1]); w.y = pk2hw(v0[2], v0[3]); w.z = pk2hw(v1[0], v1[1]); w.w = pk2hw(v1[2], v1[3]); return w; }

__device__ __forceinline__ unsigned pk4_fp8(float a, float b, float c, float d) {
    a = fminf(fmaxf(a, -448.0f), 448.0f); b = fminf(fmaxf(b, -448.0f), 448.0f); c = fminf(fmaxf(c, -448.0f), 448.0f); d = fminf(fmaxf(d, -448.0f), 448.0f);
    int w = 0; w = __builtin_amdgcn_cvt_pk_fp8_f32(a, b, w, false); w = __builtin_amdgcn_cvt_pk_fp8_f32(c, d, w, true); return (unsigned)w; }
constexpr float WUP_SCALE = 32.0f, WUP_INV = 1.0f / 32.0f;
struct EpiStoreBf16 {
    static constexpr bool PERM = true, PERM16 = false;
    bf16* O; int ldc; float osc, qsc;
    __device__ __forceinline__ void operator()(const f32x4 (&acc)[2][2][4][2], const pg8::UnitG& u, int wr, int wc, int fr, int fq) const {
        const float sc = ((u.col0 % 3072) < 1024) ? osc * qsc : osc;
#pragma unroll
        for (int ai = 0; ai < 2; ++ai)
#pragma unroll
            for (int m = 0; m < 4; ++m) { bf16* rowp = O + (size_t)(u.row0 + ai * 128 + wr * 64 + m * 16 + fr) * ldc + u.col0 + wc * 32 + 8 * fq;
#pragma unroll
                for (int bj = 0; bj < 2; ++bj) *(u32x4*)(rowp + bj * 128) = pack_bf16x8(acc[ai][bj][m][0] * sc, acc[ai][bj][m][1] * sc); }
    }
};
constexpr float YEXP_SCALE = 32.0f, YEXP_INV = 1.0f / 32.0f;
constexpr float A_SCALE = 16.0f;
constexpr float H_SCALE = 16.0f;
struct EpiStoreFp8 {
    static constexpr bool PERM = false, PERM16 = true;
    unsigned char* O; int ldc;
    __device__ __forceinline__ void operator()(const f32x4 (&acc)[2][2][4][2], const pg8::UnitG& u, int wr, int wc, int fr, int fq) const {
#pragma unroll
        for (int ai = 0; ai < 2; ++ai)
#pragma unroll
            for (int m = 0; m < 4; ++m) { unsigned char* rowp = O + (size_t)(u.row0 + ai * 128 + wr * 64 + m * 16 + fr) * ldc + u.col0 + wc * 64 + 16 * fq;
                u32x4 w;
#pragma unroll
                for (int q = 0; q < 4; ++q) { f32x4 v = acc[ai][q >> 1][m][q & 1] * (YEXP_SCALE / (H_SCALE * WUP_SCALE));
#pragma unroll
                    for (int j = 0; j < 4; ++j) v[j] = fminf(fmaxf(v[j], -448.0f), 448.0f);
                    int d = 0; d = __builtin_amdgcn_cvt_pk_fp8_f32(v[0], v[1], d, false); d = __builtin_amdgcn_cvt_pk_fp8_f32(v[2], v[3], d, true); w[q] = (unsigned)d; }
                *(u32x4*)rowp = w; }
    }
};
struct EpiRetIn {
    static constexpr bool PERM = true, PERM16 = false;
    bf16* O; int ldc;
    __device__ __forceinline__ void operator()(const f32x4 (&acc)[2][2][4][2], const pg8::UnitG& u, int wr, int wc, int fr, int fq) const {
        float l2g = 0.f;
        float cs = WUP_INV;
        if (u.col0 < 2048) { const int h = (u.col0 & 1023) >> 8; const float g = 1.0f - exp2f(-5.0f - (float)h); l2g = log2f(g); if (u.col0 >= 1024) { l2g = -l2g; cs *= 0.0625f; } }
#pragma unroll
        for (int ai = 0; ai < 2; ++ai)
#pragma unroll
            for (int m = 0; m < 4; ++m) { const int row = u.row0 + ai * 128 + wr * 64 + m * 16 + fr; const float sc = exp2f(l2g * (float)(row & 127)) * cs;
                bf16* rowp = O + (size_t)row * ldc + u.col0 + wc * 32 + 8 * fq;
#pragma unroll
                for (int bj = 0; bj < 2; ++bj) *(u32x4*)(rowp + bj * 128) = pack_bf16x8(acc[ai][bj][m][0] * sc, acc[ai][bj][m][1] * sc); }
    }
};
__device__ __forceinline__ void unpack_bf16x8(const u32x4& w, f32x4& a, f32x4& b) { a[0] = bflo(w.x); a[1] = bfhi(w.x); a[2] = bflo(w.y); a[3] = bfhi(w.y); b[0] = bflo(w.z); b[1] = bfhi(w.z); b[2] = bflo(w.w); b[3] = bfhi(w.w); }
template <bool ALL16> struct EpiResidT {
    static constexpr bool PERM = true, PERM16 = false;
    const bf16* X; bf16* Y; float asc;
    __device__ __forceinline__ void operator()(const f32x4 (&acc)[2][2][4][2], const pg8::UnitG& u, int wr, int wc, int fr, int fq) const {
        constexpr int NB = ALL16 ? 1 : 2, PER = 2 / NB;
#pragma unroll
        for (int bt = 0; bt < NB; ++bt) {
            u32x4 xw[PER][4][2];
#pragma unroll
            for (int a2 = 0; a2 < PER; ++a2)
#pragma unroll
                for (int m = 0; m < 4; ++m) { const int ai = bt * PER + a2; const size_t off = (size_t)(u.row0 + ai * 128 + wr * 64 + m * 16 + fr) * D + u.col0 + wc * 32 + 8 * fq;
#pragma unroll
                    for (int bj = 0; bj < 2; ++bj) xw[a2][m][bj] = *(const u32x4*)(X + off + bj * 128); }
            asm volatile("" ::: "memory");
#pragma unroll
            for (int a2 = 0; a2 < PER; ++a2)
#pragma unroll
                for (int m = 0; m < 4; ++m) { const int ai = bt * PER + a2; const size_t off = (size_t)(u.row0 + ai * 128 + wr * 64 + m * 16 + fr) * D + u.col0 + wc * 32 + 8 * fq;
#pragma unroll
                    for (int bj = 0; bj < 2; ++bj) { f32x4 x0, x1; unpack_bf16x8(xw[a2][m][bj], x0, x1);
                        *(u32x4*)(Y + off + bj * 128) = pack_bf16x8(x0 * ALPHA + acc[ai][bj][m][0] * asc, x1 * ALPHA + acc[ai][bj][m][1] * asc); } }
            asm volatile("" ::: "memory");
        }
    }
};
typedef EpiResidT<true> EpiResid; typedef EpiResidT<false> EpiResid8;
struct EpiGluResid {
    static constexpr bool PERM = true, PERM16 = false;
    const bf16* X; bf16* Y; float asc;
    __device__ __forceinline__ void operator()(const f32x4 (&acc)[2][2][4][2], const pg8::UnitG& u, int wr, int wc, int fr, int fq) const {
        u32x4 xw[2][4];
#pragma unroll
        for (int ai = 0; ai < 2; ++ai)
#pragma unroll
            for (int m = 0; m < 4; ++m) { const size_t off = (size_t)(u.row0 + ai * 128 + wr * 64 + m * 16 + fr) * D + (u.col0 >> 1) + wc * 32 + 8 * fq; xw[ai][m] = *(const u32x4*)(X + off); }
        asm volatile("" ::: "memory");
#pragma unroll
        for (int ai = 0; ai < 2; ++ai)
#pragma unroll
            for (int m = 0; m < 4; ++m) { const size_t off = (size_t)(u.row0 + ai * 128 + wr * 64 + m * 16 + fr) * D + (u.col0 >> 1) + wc * 32 + 8 * fq;
                f32x4 x0, x1; unpack_bf16x8(xw[ai][m], x0, x1); f32x4 o0, o1;
#pragma unroll
                for (int j = 0; j < 4; ++j) { o0[j] = x0[j] * ALPHA + acc[ai][0][m][0][j] * asc * fsig(acc[ai][1][m][0][j] * asc); o1[j] = x1[j] * ALPHA + acc[ai][0][m][1][j] * asc * fsig(acc[ai][1][m][1][j] * asc); }
                *(u32x4*)(Y + off) = pack_bf16x8(o0, o1); }
    }
};
struct EpiMoeUp {
    static constexpr bool PERM = true, PERM16 = false;
    unsigned char* H;
    __device__ __forceinline__ void operator()(const f32x4 (&acc)[2][2][4][2], const pg8::UnitG& u, int wr, int wc, int fr, int fq) const {
        typedef unsigned u2_t __attribute__((ext_vector_type(2)));
#pragma unroll
        for (int ai = 0; ai < 2; ++ai) {
            u32x2 w8[4];
#pragma unroll
            for (int m = 0; m < 4; ++m) { f32x4 o[2];
#pragma unroll
                for (int n = 0; n < 2; ++n)
#pragma unroll
                    for (int j = 0; j < 4; ++j) { const float ga = acc[ai][0][m][n][j], ua = acc[ai][1][m][n][j];
                        o[n][j] = (ga * ua) * (WUP_INV * WUP_INV * H_SCALE) * __builtin_amdgcn_rcpf(1.0f + __builtin_amdgcn_exp2f(ga * (-WUP_INV * 1.4426950408889634f))); }
                w8[m].x = pk4_fp8(o[0][0], o[0][1], o[0][2], o[0][3]); w8[m].y = pk4_fp8(o[1][0], o[1][1], o[1][2], o[1][3]); }
            u32x4 s0, s1;
            { const u2_t a = __builtin_amdgcn_permlane16_swap(w8[0].x, w8[2].x, false, false), b = __builtin_amdgcn_permlane16_swap(w8[0].y, w8[2].y, false, false);
              s0.x = a.x; s0.y = b.x; s0.z = a.y; s0.w = b.y; }
            { const u2_t a = __builtin_amdgcn_permlane16_swap(w8[1].x, w8[3].x, false, false), b = __builtin_amdgcn_permlane16_swap(w8[1].y, w8[3].y, false, false);
              s1.x = a.x; s1.y = b.x; s1.z = a.y; s1.w = b.y; }
            const int mb = (fq & 1) ? 2 : 0;
            unsigned char* rowp = H + (size_t)(u.row0 + ai * 128 + wr * 64 + mb * 16 + fr) * ED + u.col0 + wc * 32 + 8 * (fq & 2);
            *(u32x4*)rowp = s0; *(u32x4*)(rowp + (size_t)16 * ED) = s1; }
    }
};

struct ConvD { const float* src; unsigned char* dst; unsigned char* dst2; int ldw, ldk, kind; };
__device__ __forceinline__ ConvD conv_mk8(const float* W, int ldw, unsigned char* WT, int ldk, int k0, int n0, int drow0) {
    ConvD d; d.src = W + (size_t)k0 * ldw + n0; d.dst = WT + (size_t)drow0 * ldk + k0; d.dst2 = nullptr; d.ldw = ldw; d.ldk = ldk; d.kind = 1; return d; }
__device__ __forceinline__ ConvD conv_mk16(const float* W, int ldw, bf16* WT, bf16* WTlo, int ldk, int k0, int n0, int drow0) {
    ConvD d; d.src = W + (size_t)k0 * ldw + n0; d.dst = (unsigned char*)(WT + (size_t)drow0 * ldk + k0); d.dst2 = WTlo ? (unsigned char*)(WTlo + (size_t)drow0 * ldk + k0) : nullptr; d.ldw = ldw; d.ldk = ldk * 2; d.kind = WTlo ? 2 : 0; return d; }
__device__ __forceinline__ void conv_load(const ConvD& d, int lane, f32x4 (&r)[8]) {
#pragma unroll
    for (int i = 0; i < 8; ++i) { const int kk = 8 * i + (lane >> 3), c4 = 4 * (lane & 7); r[i] = *(const f32x4*)(d.src + (size_t)kk * d.ldw + c4); }
}
template <bool HILO>
__device__ __forceinline__ void conv_finish(const ConvD& d, int lane, const f32x4 (&r)[8], LAS float* scr) {
    const float scale = (d.kind == 1) ? WUP_SCALE : 1.0f;
#pragma unroll
    for (int i = 0; i < 8; ++i) { const int kk = 8 * i + (lane >> 3), c4 = 4 * (lane & 7);
        scr[kk * 33 + c4] = r[i][0] * scale; scr[kk * 33 + c4 + 1] = r[i][1] * scale; scr[kk * 33 + c4 + 2] = r[i][2] * scale; scr[kk * 33 + c4 + 3] = r[i][3] * scale; }
    LDS_WAIT(); asm volatile("" ::: "memory");
    const int c = lane & 7;
#pragma unroll
    for (int j = 0; j < 4; ++j) { const int n = (lane >> 3) + 8 * j; const LAS float* s = scr + (8 * c) * 33 + n;
        float v[8];
#pragma unroll
        for (int q = 0; q < 8; ++q) v[q] = s[q * 33];
        if (d.kind == 1) { u32x2 o; o.x = pk4_fp8(v[0], v[1], v[2], v[3]); o.y = pk4_fp8(v[4], v[5], v[6], v[7]); *(u32x2*)(d.dst + (size_t)n * d.ldk + 8 * c) = o; }
        else { u32x4 o; o.x = pk2(v[0], v[1]); o.y = pk2(v[2], v[3]); o.z = pk2(v[4], v[5]); o.w = pk2(v[6], v[7]);
            *(u32x4*)(d.dst + (size_t)n * d.ldk + 16 * c) = o;
            if (HILO) { float rr[8];
#pragma unroll
                for (int q = 0; q < 8; ++q) rr[q] = v[q] - bf2f(f2bf(v[q]));
                u32x4 o2; o2.x = pk2(rr[0], rr[1]); o2.y = pk2(rr[2], rr[3]); o2.z = pk2(rr[4], rr[5]); o2.w = pk2(rr[6], rr[7]);
                *(u32x4*)(d.dst2 + (size_t)n * d.ldk + 16 * c) = o2; } } }
    LDS_WAIT(); asm volatile("" ::: "memory");
}
__device__ __forceinline__ void conv_dma(const ConvD& d, int lane, LAS float* buf) {
#pragma unroll
    for (int i = 0; i < 8; ++i) { const float* g = d.src + (size_t)(8 * i + (lane >> 3)) * d.ldw + 4 * ((lane & 7) ^ i);
        __builtin_amdgcn_global_load_lds((const unsigned*)g, (LAS unsigned*)(buf + i * 256), 16, 0, 0); }
}
__device__ __forceinline__ void conv_finish_lds(const ConvD& d, int lane, const LAS float* buf) {
    const float scale = (d.kind == 1) ? WUP_SCALE : 1.0f;
    const int c = lane & 7;
#pragma unroll
    for (int j = 0; j < 4; ++j) { const int n = (lane >> 3) + 8 * j; const LAS float* s = buf + (8 * c) * 32 + (((n >> 2) ^ c) & 7) * 4 + (n & 3);
        float v[8];
#pragma unroll
        for (int q = 0; q < 8; ++q) v[q] = s[q * 32] * scale;
        if (d.kind == 1) { u32x2 o; o.x = pk4_fp8(v[0], v[1], v[2], v[3]); o.y = pk4_fp8(v[4], v[5], v[6], v[7]); *(u32x2*)(d.dst + (size_t)n * d.ldk + 8 * c) = o; }
        else { u32x4 o; o.x = pk2(v[0], v[1]); o.y = pk2(v[2], v[3]); o.z = pk2(v[4], v[5]); o.w = pk2(v[6], v[7]); *(u32x4*)(d.dst + (size_t)n * d.ldk + 16 * c) = o; } }
    LDS_WAIT(); asm volatile("" ::: "memory");
}
#define CONV_RUN(NIT, DEC) do { int it_ = gw; if (it_ < (NIT)) { ConvD dc_ = DEC(it_); int par_ = 0; conv_dma(dc_, F.lane, scr); asm volatile("s_waitcnt vmcnt(0)" ::: "memory"); \
        for (; it_ < (NIT); it_ += NGW) { const int itn_ = (it_ + NGW < (NIT)) ? it_ + NGW : it_; const ConvD dn_ = DEC(itn_); conv_dma(dn_, F.lane, scr + (par_ ^ 1) * 2048);     \
            asm volatile("s_waitcnt vmcnt(12)" ::: "memory"); conv_finish_lds(dc_, F.lane, scr + par_ * 2048); dc_ = dn_; par_ ^= 1; } \
        asm volatile("s_waitcnt vmcnt(0)" ::: "memory"); } } while (0)
__device__ __forceinline__ ConvD conv_dec_mixers(KP p, unsigned char* ws, int it) {
    constexpr int I_AIN = 16 * 288, I_AOUT = 16 * 32, I_RIN = 16 * 192, I_ROUT = 32 * 32, I_GLU = 16 * 64, I_RT = 16 * 2;
    int r = it;
    if (r < 2 * I_AIN) { const int j = r / I_AIN; r %= I_AIN; const int kb = r / 288, nb = r % 288, n0 = nb * 32;
        return conv_mk8(gin(p, 1) + (size_t)j * D * ATT_IN, ATT_IN, (unsigned char*)(ws + WS_ATT_IN_T) + (size_t)j * ATT_IN * D, D, kb * 64, n0, n0); }
    r -= 2 * I_AIN;
    if (r < 2 * I_AOUT) { const int j = r / I_AOUT; r %= I_AOUT; const int kb = r / 32, nb = r % 32, n0 = nb * 32;
        return conv_mk8(gin(p, 2) + (size_t)j * D * D, D, (unsigned char*)(ws + WS_ATT_OUT_T) + (size_t)j * D * D, D, kb * 64, n0, n0); }
    r -= 2 * I_AOUT;
    if (r < I_RIN) { const int kb = r / 192, nb = r % 192, n0 = nb * 32;
        return conv_mk8(gin(p, 3), RET_IN, (unsigned char*)(ws + WS_RET_IN_T), D, kb * 64, n0, n0); }
    r -= I_RIN;
    if (r < I_ROUT) { const int kb = r / 32, nb = r % 32, n0 = nb * 32;
        return conv_mk8(gin(p, 6), D, (unsigned char*)(ws + WS_RET_OUT_T), RET_V, kb * 64, n0, n0); }
    r -= I_ROUT;
    if (r < I_GLU) { const int kb = r / 64, nb = r % 64, n0 = nb * 32; const int c = n0 & 1023, drow = (c >> 7) * 256 + (n0 >> 10) * 128 + (c & 127);
        return conv_mk8(gin(p, 15), 2 * D, (unsigned char*)(ws + WS_GLU_T), D, kb * 64, n0, drow); }
    r -= I_GLU;
    { const int l = r / I_RT; r %= I_RT; const int kb = r / 2, nb = r % 2, n0 = nb * 32;
        return conv_mk16(gin(p, 16) + (size_t)l * D * NE, NE, (bf16*)(ws + WS_RT_HI) + (size_t)l * NE * D, (bf16*)(ws + WS_RT_LO) + (size_t)l * NE * D, D, kb * 64, n0, n0); }
}
__device__ __forceinline__ ConvD conv_dec_moe(KP p, unsigned char* ws, int l, int it) {
    const int e = it / 384, r = it % 384, which = r >> 7, rr = r & 127;
    bf16* We = (bf16*)(ws + WS_WMOE + (size_t)e * WMOE_E_BYTES);
    if (which < 2) { const float* src = (e < 64) ? gin(p, 18 + which) + ((size_t)l * NE + e) * D * ED : gin(p, 21 + which) + (size_t)l * D * ED;
        const int kb = rr >> 3, nb = rr & 7, n0 = nb * 32; const int drow = (n0 >> 7) * 256 + which * 128 + (n0 & 127);
        return conv_mk8(src, ED, (unsigned char*)We, D, kb * 64, n0, drow); }
    const float* src = (e < 64) ? gin(p, 20) + ((size_t)l * NE + e) * ED * D : gin(p, 23) + (size_t)l * ED * D;
    const int kb = rr >> 5, nb = rr & 31, n0 = nb * 32;
    return conv_mk8(src, D, (unsigned char*)(We + 512 * 1024), ED, kb * 64, n0, n0);
}
__device__ __forceinline__ void phase_conv_mixers(const Frame& F, KP p) {
    LAS float* scr = (LAS float*)(F.lds + F.wave * 16384);
    const int gw = F.vcu * NWAVES + F.wave, NGW = F.G * NWAVES;
    constexpr int NMAIN = 2 * (16 * 288) + 2 * (16 * 32) + 16 * 192 + 32 * 32 + 16 * 64, NRT = 4 * (16 * 2);
    unsigned char* ws = F.ws;
#define CONV_DEC_MIX(i_) conv_dec_mixers(p, ws, (i_))
    CONV_RUN(NMAIN, CONV_DEC_MIX);
    for (int it = NMAIN + gw; it < NMAIN + NRT; it += NGW) { const ConvD d = conv_dec_mixers(p, ws, it); f32x4 r[8]; conv_load(d, F.lane, r); conv_finish<true>(d, F.lane, r, scr); }
#undef CONV_DEC_MIX
}
__device__ __forceinline__ void phase_conv_moe(const Frame& F, KP p, int l) {
    LAS float* scr = (LAS float*)(F.lds + F.wave * 16384);
    const int gw = F.vcu * NWAVES + F.wave, NGW = F.G * NWAVES;
    unsigned char* ws = F.ws;
#define CONV_DEC_MOE(i_) conv_dec_moe(p, ws, l, (i_))
    CONV_RUN(65 * 384, CONV_DEC_MOE);
#undef CONV_DEC_MOE
}

__device__ __forceinline__ void phase_lnr(const Frame& F, KP p, int layer, bool dry = false) {
    const bf16* Y = (const bf16*)(F.ws + WS_Y); bf16* XB = (bf16*)(F.ws + WS_XB); unsigned char* XB8 = (unsigned char*)(F.ws + WS_X);
    const float* lng = gin(p, 24) + (size_t)(layer * 2) * D; const float* lnb = gin(p, 25) + (size_t)(layer * 2) * D;
    const bf16* rthi = (const bf16*)(F.ws + WS_RT_HI) + (size_t)layer * NE * D; const bf16* rtlo = (const bf16*)(F.ws + WS_RT_LO) + (size_t)layer * NE * D;
    const float* rbias = gin(p, 17) + layer * NE;
    unsigned* cnt = (unsigned*)(F.ws + WS_CTL) + CW_CNT + layer * NE * 64;
    int* lists = (int*)(F.ws + WS_LIST); int* tokmap = (int*)(F.ws + WS_LIST + 4 * MiB); float* tokgate = (float*)(F.ws + WS_LIST + 5 * MiB);
    constexpr int XLD = 1032, MAXT = 8;
    LAS bf16* Xhi = (LAS bf16*)F.lds; LAS bf16* Xlo = Xhi + 16 * XLD;
    LAS float* part = (LAS float*)(F.lds + 2 * 16 * XLD * 2);
    LAS int* ent = (LAS int*)(part + 2 * 16 * 64);
    LAS int* hist = ent + MAXT * 16 * 8 * 2; LAS int* base = hist + 64;
    const int lane = F.lane, w = F.wave, g4 = lane >> 4, l15 = lane & 15;
    if (F.tid < 64) hist[F.tid] = 0;
    bf16x8 bhi[16], blo[16];
    { const int nt = w & 3, kh = w >> 2; const bf16* bh = rthi + (size_t)(16 * nt + l15) * D + 512 * kh + 8 * g4; const bf16* bl = rtlo + (size_t)(16 * nt + l15) * D + 512 * kh + 8 * g4;
#pragma unroll
        for (int ks = 0; ks < 16; ++ks) { bhi[ks] = *(const bf16x8*)(bh + 32 * ks); blo[ks] = *(const bf16x8*)(bl + 32 * ks); } }
    u32x4 ypre[2][2];
    if (F.vcu < T / 16) {
#pragma unroll
        for (int rr = 0; rr < 2; ++rr)
#pragma unroll
            for (int j = 0; j < 2; ++j) ypre[rr][j] = *(const u32x4*)(Y + (size_t)(F.vcu * 16 + 2 * w + rr) * D + 8 * lane + 512 * j); }
    int ntile = 0;
    for (int tile = F.vcu; tile < T / 16 && ntile < MAXT; tile += F.G, ++ntile) {
        const int t0 = tile * 16;
        u32x4 ycur[2][2];
#pragma unroll
        for (int rr = 0; rr < 2; ++rr)
#pragma unroll
            for (int j = 0; j < 2; ++j) ycur[rr][j] = ypre[rr][j];
        if (tile + F.G < T / 16) {
#pragma unroll
            for (int rr = 0; rr < 2; ++rr)
#pragma unroll
                for (int j = 0; j < 2; ++j) ypre[rr][j] = *(const u32x4*)(Y + (size_t)((tile + F.G) * 16 + 2 * w + rr) * D + 8 * lane + 512 * j); }
#pragma unroll
        for (int rr = 0; rr < 2; ++rr) {
            const int lr = 2 * w + rr; const size_t row = (size_t)(t0 + lr);
            f32x4 v[4]; float s = 0.f;
#pragma unroll
            for (int j = 0; j < 2; ++j) unpack_bf16x8(ycur[rr][j], v[2 * j], v[2 * j + 1]);
#pragma unroll
            for (int j = 0; j < 4; ++j) s += (v[j][0] + v[j][1]) + (v[j][2] + v[j][3]);
            const float mean = wave_sum(s, lane) * (1.f / D); float s2 = 0.f;
#pragma unroll
            for (int j = 0; j < 4; ++j) { v[j] = v[j] - mean; s2 += (v[j][0] * v[j][0] + v[j][1] * v[j][1]) + (v[j][2] * v[j][2] + v[j][3] * v[j][3]); }
            const float rstd = 1.0f / sqrtf(wave_sum(s2, lane) * (1.f / D) + LN_EPS);
#pragma unroll
            for (int j = 0; j < 2; ++j) { const f32x4 g0 = *(const f32x4*)(lng + 8 * lane + 512 * j), g1 = *(const f32x4*)(lng + 8 * lane + 512 * j + 4), b0 = *(const f32x4*)(lnb + 8 * lane + 512 * j), b1 = *(const f32x4*)(lnb + 8 * lane + 512 * j + 4);
                const f32x4 o0 = v[2 * j] * rstd * g0 + b0, o1 = v[2 * j + 1] * rstd * g1 + b1;
                const u32x4 hi = pack_bf16x8(o0, o1);
                *(u32x4*)(XB + row * D + 8 * lane + 512 * j) = hi;
                { u32x2 q8; q8.x = pk4_fp8(o0[0], o0[1], o0[2], o0[3]); q8.y = pk4_fp8(o1[0], o1[1], o1[2], o1[3]); *(u32x2*)(XB8 + row * D + 8 * lane + 512 * j) = q8; }
                f32x4 h0, h1; unpack_bf16x8(hi, h0, h1); const u32x4 lo = pack_bf16x8(o0 - h0, o1 - h1);
                *(LAS u32x4*)(Xhi + lr * XLD + 8 * lane + 512 * j) = hi; *(LAS u32x4*)(Xlo + lr * XLD + 8 * lane + 512 * j) = lo; }
        }
        __syncthreads();
        { const int nt = w & 3, kh = w >> 2; f32x4 a0 = (f32x4){0.f, 0.f, 0.f, 0.f}, a1 = a0, a2 = a0, a3 = a0, a4 = a0, a5 = a0;
#pragma unroll
            for (int ks = 0; ks < 16; ks += 2) { const int k0 = 512 * kh + 32 * ks;
                const bf16x8 ahi = row_frag(Xhi, XLD, 0, k0, lane), alo = row_frag(Xlo, XLD, 0, k0, lane), bhi2 = row_frag(Xhi, XLD, 0, k0 + 32, lane), blo2 = row_frag(Xlo, XLD, 0, k0 + 32, lane);
                a0 = MFMA16(ahi, bhi[ks], a0); a1 = MFMA16(alo, bhi[ks], a1); a2 = MFMA16(ahi, blo[ks], a2);
                a3 = MFMA16(bhi2, bhi[ks + 1], a3); a4 = MFMA16(blo2, bhi[ks + 1], a4); a5 = MFMA16(bhi2, blo[ks + 1], a5); }
            const f32x4 acc = ((a0 + a3) + (a1 + a4)) + (a2 + a5);
#pragma unroll
            for (int i = 0; i < 4; ++i) part[(kh * 16 + 4 * g4 + i) * 64 + 16 * nt + l15] = acc[i];
        }
        __syncthreads();
#pragma unroll
        for (int rr = 0; rr < 2; ++rr) {
            const int lt = ntile * 16 + 2 * w + rr;
            const float lg = part[(2 * w + rr) * 64 + lane] + part[(16 + 2 * w + rr) * 64 + lane];
            float sc = fsig(lg); sc = (sc == sc) ? sc : 0.5f;
            const float sel = sc + rbias[lane];
            const float m1 = max8(sel);
            const unsigned long long eq = __ballot(sel == m1);
            const unsigned gm = (unsigned)(eq >> (lane & 56)) & 0xffu;
            const int first = (lane & 56) + __builtin_ctz(gm | 0x100u);
            const float m2 = max8((lane == first) ? -INFINITY : sel);
            const float gs = m1 + m2; const int mygrp = lane >> 3; int grank = 0;
#pragma unroll
            for (int gg = 0; gg < 8; ++gg) { const float o = rdl(gs, 8 * gg); grank += (o > gs || (o == gs && gg < mygrp)) ? 1 : 0; }
            const float mv = (grank < 4) ? sel : -INFINITY;
            unsigned key = __builtin_bit_cast(unsigned, mv); key = (key >> 31) ? ~key : (key | 0x80000000u); key = (key & ~63u) | (unsigned)(63 - lane);
            int rank = 64; { unsigned kw = key;
#pragma unroll
                for (int r = 0; r < TOPK; ++r) { const unsigned m = wave_umax(kw); if (kw == m) { rank = r; kw = 0u; } } }
            const bool chosen = rank < TOPK;
            const float wsum = wave_sum(chosen ? sc : 0.f, lane);
            if (chosen) { const int lpos = __hip_atomic_fetch_add(hist + lane, 1, __ATOMIC_RELAXED, __HIP_MEMORY_SCOPE_WORKGROUP);
                ent[(lt * 8 + rank) * 2] = (lane << 16) | lpos; ent[(lt * 8 + rank) * 2 + 1] = __builtin_bit_cast(int, sc * __builtin_amdgcn_rcpf(wsum) * 2.5f); }
        }
    }
    __syncthreads();
    if (dry) return;
    if (F.tid < 64) { const int hcount = hist[F.tid]; base[F.tid] = hcount ? (int)atomicAdd(cnt + F.tid * 64, (unsigned)hcount) : 0; }
    __syncthreads();
    for (int idx = F.tid; idx < ntile * 16 * 8; idx += NTHREADS) {
        const int ev = ent[idx * 2], gb = ent[idx * 2 + 1]; const int e = ev >> 16, pos = base[e] + (ev & 0xffff);
        const int lt = idx >> 3, rank = idx & 7, tok = (F.vcu + (lt >> 4) * F.G) * 16 + (lt & 15);
        lists[(size_t)e * T + pos] = tok; tokmap[tok * 8 + rank] = (e << 16) | pos; tokgate[tok * 8 + rank] = __builtin_bit_cast(float, gb);
    }
}

__device__ __forceinline__ void phase_combine(const Frame& F, KP p, int layer, bool dry = false) {
    bf16* XB = (bf16*)(F.ws + WS_XB); const unsigned char* yexp = (const unsigned char*)(F.ws + WS_BIG);
    const int* tokmap = (const int*)(F.ws + WS_LIST + 4 * MiB); const float* tokgate = (const float*)(F.ws + WS_LIST + 5 * MiB);
    const volatile LAS int* tstart = (const volatile LAS int*)(F.MISC + 64);
    const float* lng = gin(p, 24) + (size_t)(layer * 2 + 1) * D; const float* lnb = gin(p, 25) + (size_t)(layer * 2 + 1) * D;
    float* outp = gout(p); bf16* xbo = XB; if (dry) { outp = (float*)(F.ws + WS_AUX); xbo = (bf16*)(F.ws + WS_H); }
    const int lane = F.lane, gw = F.vcu * NWAVES + F.wave, NGW = F.G * NWAVES;
    const bf16* ysh = (const bf16*)(F.ws + WS_Y);
    f32x4 gv[4], bv[4];
#pragma unroll
    for (int j = 0; j < 4; ++j) { gv[j] = *(const f32x4*)(lng + 16 * lane + 4 * j); bv[j] = *(const f32x4*)(lnb + 16 * lane + 4 * j); }
    for (int row = gw; row < T; row += NGW) {
        const int mk = tokmap[row * 8 + (lane & 7)]; const float gk = tokgate[row * 8 + (lane & 7)] * YEXP_INV;
        const int rk = (int)tstart[mk >> 16] * 256 + (mk & 0xffff);
        f32x4 v[4];
#pragma unroll
        for (int j = 0; j < 2; ++j) { const u32x4 xw = *(const u32x4*)(ysh + (size_t)row * D + 16 * lane + 8 * j); unpack_bf16x8(xw, v[2 * j], v[2 * j + 1]); }
#pragma unroll
        for (int k = 0; k < TOPK; ++k) { const int r = __builtin_amdgcn_readlane(rk, k); const float g = rdl(gk, k);
            const u32x4 s = *(const u32x4*)(yexp + (size_t)r * D + 16 * lane);
#pragma unroll
            for (int j = 0; j < 4; ++j) { const f32x2 lo = __builtin_amdgcn_cvt_pk_f32_fp8((int)s[j], false), hi = __builtin_amdgcn_cvt_pk_f32_fp8((int)s[j], true);
                v[j][0] += g * lo[0]; v[j][1] += g * lo[1]; v[j][2] += g * hi[0]; v[j][3] += g * hi[1]; } }
        float s = 0.f;
#pragma unroll
        for (int j = 0; j < 4; ++j) s += (v[j][0] + v[j][1]) + (v[j][2] + v[j][3]);
        const float mean = wave_sum(s, lane) * (1.f / D); float s2 = 0.f;
#pragma unroll
        for (int j = 0; j < 4; ++j) { v[j] = v[j] - mean; s2 += (v[j][0] * v[j][0] + v[j][1] * v[j][1]) + (v[j][2] * v[j][2] + v[j][3] * v[j][3]); }
        const float rstd = 1.0f / sqrtf(wave_sum(s2, lane) * (1.f / D) + LN_EPS);
        f32x4 o[4];
#pragma unroll
        for (int j = 0; j < 4; ++j) o[j] = v[j] * rstd * gv[j] + bv[j];
        if (layer == DEPTH - 1 || dry) {
#pragma unroll
            for (int j = 0; j < 4; ++j) *(f32x4*)(outp + (size_t)row * D + 16 * lane + 4 * j) = o[j]; }
        if (layer != DEPTH - 1) { *(u32x4*)(xbo + (size_t)row * D + 16 * lane) = pack_bf16x8(o[0], o[1]); *(u32x4*)(xbo + (size_t)row * D + 16 * lane + 8) = pack_bf16x8(o[2], o[3]);
            if (!dry) { u32x4 q8; q8.x = pk4_fp8(o[0][0], o[0][1], o[0][2], o[0][3]); q8.y = pk4_fp8(o[1][0], o[1][1], o[1][2], o[1][3]); q8.z = pk4_fp8(o[2][0], o[2][1], o[2][2], o[2][3]); q8.w = pk4_fp8(o[3][0], o[3][1], o[3][2], o[3][3]);
                *(u32x4*)((unsigned char*)(F.ws + WS_X) + (size_t)row * D + 16 * lane) = q8; } }
    }
}

constexpr size_t AUX_OB = 96 * MiB, AUX_LSE = 128 * MiB;
__device__ __forceinline__ unsigned att_qoff(int R, int j, int qi, int g4) {
    const int h = R & 7, sbr = R >> 3, g = sbr >> 5, rem = sbr & 31, b = rem >> 4, rr_ = rem & 15;
    const int dsh = 2 * g, d = 1 << dsh, nrs = 4 - dsh, r = rr_ >> nrs, n = 4 * (rr_ & ((1 << nrs) - 1)) + j;
    const unsigned qrow = (unsigned)b * SEQ + (unsigned)(128 * n + qi) * (unsigned)d + (unsigned)r;
    return qrow * (unsigned)ATT_IN + (unsigned)(g * 3072 + h * 128 + 8 * g4);
}
__device__ __forceinline__ void phase_attn(const Frame& F, int bx) {
    const bf16* qkv = (const bf16*)(F.ws + WS_BIG); bf16* og = (bf16*)(F.ws + WS_AUX); float* lse = (float*)(F.ws + WS_AUX + AUX_LSE);
    constexpr int KLD = 136;
    LAS bf16* Ks = (LAS bf16*)F.lds; LAS bf16* Vs = Ks + 256 * KLD;
    const int lane = F.lane, w = F.wave, g4 = lane >> 4, l15 = lane & 15, qq = l15 >> 2, pp = lane & 3;
    u32x4 kc[4], vc[4];
    constexpr int NRUN = 768;
#define ATT_LOADBLK(KR, VR, nblk) do { _Pragma("unroll") for (int it = 0; it < 4; ++it) { const int idx = F.tid + 512 * it, c = idx >> 4, ch = idx & 15; int pos = 128 * (nblk) + c; pos = pos < 0 ? 0 : pos; \
            const unsigned so = (rowbase + (unsigned)pos * (unsigned)d + (unsigned)r) * (unsigned)ATT_IN + (unsigned)(g * 3072 + 1024 + h * 128 + ch * 8); KR[it] = *(const u32x4*)(qkv + so); VR[it] = *(const u32x4*)(qkv + so + 1024u); } } while (0)
#define ATT_STOREBLK(KR, VR, slot) do { _Pragma("unroll") for (int it = 0; it < 4; ++it) { const int idx = F.tid + 512 * it, c = idx >> 4, ch = idx & 15; \
            *(LAS u32x4*)(Ks + (128 * (slot) + c) * KLD + ch * 8) = KR[it]; *(LAS u32x4*)(Vs + (128 * (slot) + c) * KLD + ch * 8) = VR[it]; } } while (0)
    const int qi = 16 * w + l15;
    bf16x8 qf[4];
    if (bx < NRUN) { const unsigned qo = att_qoff(bx, 0, qi, g4);
#pragma unroll
        for (int s = 0; s < 4; ++s) qf[s] = *(const bf16x8*)(qkv + qo + 32 * s); }
    for (int R = bx; R < NRUN; R += F.G) {
        const int h = R & 7, sbr = R >> 3, g = sbr >> 5, rem = sbr & 31, b = rem >> 4, rr_ = rem & 15;
        const int dsh = 2 * g, d = 1 << dsh, nrs = 4 - dsh, r = rr_ >> nrs, n0 = 4 * (rr_ & ((1 << nrs) - 1)); const unsigned rowbase = (unsigned)b * SEQ;
        { u32x4 k0[4], v0[4]; ATT_LOADBLK(k0, v0, n0 - 1); ATT_LOADBLK(kc, vc, n0); ATT_STOREBLK(k0, v0, (n0 - 1) & 1); }
#pragma unroll 1
        for (int j = 0; j < 4; ++j) {
            const int n = n0 + j, cs = n & 1, ps = cs ^ 1;
            ATT_STOREBLK(kc, vc, cs);
            const unsigned qrow = rowbase + (unsigned)(128 * n + qi) * (unsigned)d + (unsigned)r;
            __syncthreads();
            if (j < 3) { ATT_LOADBLK(kc, vc, n + 1); }
            __builtin_amdgcn_sched_barrier(0);
            const int ws0 = (16 * w < 96) ? 16 * w : 96;
#define ATT_PROW(c0) (((c0) < 128) ? (128 * ps + (c0)) : (128 * cs + (c0) - 128))
            f32x4 sacc[10];
            {
                bf16x8 kfa[4], kfb[4];
#pragma unroll
                for (int s = 0; s < 4; ++s) kfa[s] = row_frag(Ks, KLD, ATT_PROW(ws0), 32 * s, lane);
#pragma unroll
                for (int t = 0; t < 10; t += 2) {
#pragma unroll
                    for (int s = 0; s < 4; ++s) kfb[s] = row_frag(Ks, KLD, ATT_PROW(ws0 + 16 * (t + 1)), 32 * s, lane);
                    __builtin_amdgcn_sched_barrier(0);
                    sacc[t] = (f32x4){0.f, 0.f, 0.f, 0.f};
#pragma unroll
                    for (int s = 0; s < 4; ++s) sacc[t] = MFMA16(kfa[s], qf[s], sacc[t]);
                    if (t + 2 < 10) {
#pragma unroll
                        for (int s = 0; s < 4; ++s) kfa[s] = row_frag(Ks, KLD, ATT_PROW(ws0 + 16 * (t + 2)), 32 * s, lane); }
                    __builtin_amdgcn_sched_barrier(0);
                    sacc[t + 1] = (f32x4){0.f, 0.f, 0.f, 0.f};
#pragma unroll
                    for (int s = 0; s < 4; ++s) sacc[t + 1] = MFMA16(kfb[s], qf[s], sacc[t + 1]);
                }
            }
            { const int Rn = (j < 3) ? R : ((R + F.G < NRUN) ? R + F.G : R), jn = (j < 3) ? j + 1 : 0; const unsigned qo = att_qoff(Rn, jn, qi, g4);
#pragma unroll
              for (int s = 0; s < 4; ++s) qf[s] = *(const bf16x8*)(qkv + qo + 32 * s); }
            const float slope = exp2f(-(float)(h + 1)) * (float)d;
            float mx = -INFINITY;
            int sbase = 128 + qi - ws0 - 4 * g4; asm volatile("" : "+v"(sbase));
            const float nsb = -slope * (float)sbase; const int kmin = (n > 0) ? sbase - 128 : ((sbase - 128 > 128 - ws0 - 4 * g4) ? sbase - 128 : 128 - ws0 - 4 * g4);
#pragma unroll
            for (int t = 0; t < 10; ++t)
#pragma unroll
                for (int i = 0; i < 4; ++i) { const int k = 16 * t + i;
                    const bool valid = (k <= sbase) && (k >= kmin);
                    const float v = valid ? __builtin_fmaf(slope, (float)k, sacc[t][i] + nsb) : -INFINITY; sacc[t][i] = v; mx = fmaxf(mx, v); }
            mx = fmaxf(mx, shx(mx, 16, lane)); mx = fmaxf(mx, shx(mx, 32, lane));
            float lsum = 0.f;
#pragma unroll
            for (int t = 0; t < 10; ++t)
#pragma unroll
                for (int i = 0; i < 4; ++i) { const float pv = __expf(sacc[t][i] - mx); sacc[t][i] = pv; lsum += pv; }
            lsum += shx(lsum, 16, lane); lsum += shx(lsum, 32, lane);
            bf16x8 pf[5];
#pragma unroll
            for (int kt = 0; kt < 5; ++kt) pf[kt] = pack8(sacc[2 * kt], sacc[2 * kt + 1]);
            f32x4 o[8];
            {
                const LAS bf16* vl = Vs + (4 * g4 + qq) * KLD + 32 * pp;
                bf16x4 va[10], vcc[10];
#pragma unroll
                for (int q = 0; q < 10; ++q) va[q] = tr4(vl + ATT_PROW(ws0 + 16 * q) * KLD);
#pragma unroll
                for (int et = 0; et < 8; et += 2) {
#pragma unroll
                    for (int q = 0; q < 10; ++q) vcc[q] = tr4(vl + ATT_PROW(ws0 + 16 * q) * KLD + 4 * (et + 1));
                    __builtin_amdgcn_sched_barrier(0);
                    o[et] = (f32x4){0.f, 0.f, 0.f, 0.f};
#pragma unroll
                    for (int kt = 0; kt < 5; ++kt) o[et] = MFMA16(cat8(va[2 * kt], va[2 * kt + 1]), pf[kt], o[et]);
                    if (et + 2 < 8) {
#pragma unroll
                        for (int q = 0; q < 10; ++q) va[q] = tr4(vl + ATT_PROW(ws0 + 16 * q) * KLD + 4 * (et + 2)); }
                    __builtin_amdgcn_sched_barrier(0);
                    o[et + 1] = (f32x4){0.f, 0.f, 0.f, 0.f};
#pragma unroll
                    for (int kt = 0; kt < 5; ++kt) o[et + 1] = MFMA16(cat8(vcc[2 * kt], vcc[2 * kt + 1]), pf[kt], o[et + 1]);
                }
            }
#undef ATT_PROW
            const float inv = 1.0f / lsum;
            bf16* orow = og + ((size_t)g * T + qrow) * D + h * 128 + 32 * g4;
#pragma unroll
            for (int e2 = 0; e2 < 4; ++e2) *(u32x4*)(orow + 8 * e2) = pack_bf16x8(o[2 * e2] * inv, o[2 * e2 + 1] * inv);
            if (g4 == 0) lse[((size_t)g * T + qrow) * AH + h] = mx + __logf(lsum);
            __syncthreads();
        }
    }
#undef ATT_LOADBLK
#undef ATT_STOREBLK
}
__device__ __forceinline__ void phase_attn_combine(const Frame& F) {
    const bf16* og = (const bf16*)(F.ws + WS_AUX); const float* lse = (const float*)(F.ws + WS_AUX + AUX_LSE); bf16* ob = (bf16*)(F.ws + WS_AUX + AUX_OB);
    const int lane = F.lane, gw = F.vcu * NWAVES + F.wave, NGW = F.G * NWAVES, h = lane >> 3;
    for (int row = gw; row < T; row += NGW) {
        const float l0 = lse[((size_t)0 * T + row) * AH + h], l1 = lse[((size_t)1 * T + row) * AH + h], l2 = lse[((size_t)2 * T + row) * AH + h];
        const float m = fmaxf(l0, fmaxf(l1, l2)); float w0 = __expf(l0 - m), w1 = __expf(l1 - m), w2 = __expf(l2 - m); const float inv = 1.0f / (w0 + w1 + w2); w0 *= inv; w1 *= inv; w2 *= inv;
        float a[16];
#pragma unroll
        for (int j = 0; j < 16; ++j) a[j] = 0.f;
#pragma unroll
        for (int g = 0; g < 3; ++g) { const float wg = (g == 0) ? w0 : (g == 1 ? w1 : w2);
#pragma unroll
            for (int q = 0; q < 2; ++q) { const u32x4 s = *(const u32x4*)(og + ((size_t)g * T + row) * D + 16 * lane + 8 * q);
                a[8 * q + 0] += wg * bflo(s.x); a[8 * q + 1] += wg * bfhi(s.x); a[8 * q + 2] += wg * bflo(s.y); a[8 * q + 3] += wg * bfhi(s.y);
                a[8 * q + 4] += wg * bflo(s.z); a[8 * q + 5] += wg * bfhi(s.z); a[8 * q + 6] += wg * bflo(s.w); a[8 * q + 7] += wg * bfhi(s.w); } }
        { u32x4 o;
#pragma unroll
          for (int q = 0; q < 4; ++q) o[q] = pk4_fp8(a[4 * q] * A_SCALE, a[4 * q + 1] * A_SCALE, a[4 * q + 2] * A_SCALE, a[4 * q + 3] * A_SCALE);
          *(u32x4*)((unsigned char*)ob + (size_t)row * D + 16 * lane) = o; }
    }
}

constexpr size_t BIG_YRET = 192 * MiB;
__device__ __forceinline__ void phase_ret_u(const Frame& F) {
    const bf16* proj = (const bf16*)(F.ws + WS_BIG); bf16* St = (bf16*)(F.ws + WS_AUX);
    constexpr int LD = 264;
    LAS bf16* Kt = (LAS bf16*)F.lds; LAS bf16* Vt = Kt + 128 * LD;
    const int lane = F.lane, w = F.wave, g4 = lane >> 4, l15 = lane & 15, qq = l15 >> 2, pp = lane & 3;
    u32x4 kr[8], vr[8];
#define RU_LOAD(u_) do { const int eh_ = (u_) & 1, h_ = ((u_) >> 1) & 3, n_ = ((u_) >> 3) & 63, b_ = (u_) >> 9; const char* pb_ = (const char*)(proj + ((size_t)b_ * SEQ + (size_t)n_ * RC) * RET_IN); \
        int t_ = F.tid; asm volatile("" : "+v"(t_)); unsigned off_ = (unsigned)(((t_ >> 5) * RET_IN + (t_ & 31) * 8) * 2); \
        _Pragma("unroll") for (int it = 0; it < 8; ++it) { asm volatile("" : "+v"(off_)); kr[it] = *(const u32x4*)(pb_ + (size_t)(1024 + h_ * 256 + it * 16 * RET_IN) * 2 + off_); \
            vr[it] = *(const u32x4*)(pb_ + (size_t)(2048 + h_ * 512 + eh_ * 256 + it * 16 * RET_IN) * 2 + off_); } } while (0)
    if (F.vcu < 1024) RU_LOAD(F.vcu);
    for (int u = F.vcu; u < 1024; u += F.G) {
        const int eh = u & 1, h = (u >> 1) & 3, n = (u >> 3) & 63, b = u >> 9;
        { int t_ = F.tid; asm volatile("" : "+v"(t_));
#pragma unroll
          for (int it = 0; it < 8; ++it) { const int idx = t_ + 512 * it, j = idx >> 5, ch = idx & 31; *(LAS u32x4*)(Kt + j * LD + ch * 8) = kr[it]; *(LAS u32x4*)(Vt + j * LD + ch * 8) = vr[it]; } }
        __syncthreads();
        f32x4 acc[16][2];
#pragma unroll
        for (int mt = 0; mt < 16; ++mt) { acc[mt][0] = (f32x4){0.f, 0.f, 0.f, 0.f}; acc[mt][1] = (f32x4){0.f, 0.f, 0.f, 0.f}; }
#pragma unroll
        for (int ks = 0; ks < 4; ++ks) {
            bf16x8 bfr[2];
#pragma unroll
            for (int nt = 0; nt < 2; ++nt) { const LAS bf16* a0 = Vt + (32 * ks + 8 * g4 + qq) * LD + 32 * w + 16 * nt + 4 * pp; bfr[nt] = cat8(tr4(a0), tr4(a0 + 4 * LD)); }
#pragma unroll
            for (int mt = 0; mt < 16; ++mt) { const LAS bf16* a0 = Kt + (32 * ks + 8 * g4 + qq) * LD + 128 * (mt >> 3) + 32 * pp + 4 * (mt & 7);
                const bf16x8 afr = cat8(tr4(a0), tr4(a0 + 4 * LD));
                acc[mt][0] = MFMA16(afr, bfr[0], acc[mt][0]); acc[mt][1] = MFMA16(afr, bfr[1], acc[mt][1]); }
        }
        { const int un = (u + F.G < 1024) ? u + F.G : u; RU_LOAD(un); }
        bf16* outb = St + ((size_t)((b * RH + h) * RNC + n)) * (RDV * RDK);
#pragma unroll
        for (int nt = 0; nt < 2; ++nt) { bf16* orow = outb + (size_t)(eh * 256 + 32 * w + 16 * nt + l15) * RDK + 32 * g4;
#pragma unroll
            for (int mh = 0; mh < 2; ++mh)
#pragma unroll
                for (int q = 0; q < 4; ++q) *(u32x4*)(orow + 128 * mh + 8 * q) = pack_bf16x8(acc[mh * 8 + 2 * q][nt], acc[mh * 8 + 2 * q + 1][nt]); }
        __syncthreads();
    }
#undef RU_LOAD
}
__device__ __forceinline__ void phase_ret_scan(const Frame& F) {
    bf16* St = (bf16*)(F.ws + WS_AUX);
    for (int gt = F.vcu * NTHREADS + F.tid; gt < 8 * 16384; gt += F.G * NTHREADS) {
        const int bh = gt >> 14, chunk = gt & 16383, h = bh & 3;
        const float g128 = exp2f(128.0f * log2f(1.0f - exp2f(-5.0f - (float)h)));
        bf16* base = St + (size_t)bh * RNC * (RDV * RDK) + (size_t)chunk * 8;
        float c[8];
#pragma unroll
        for (int j = 0; j < 8; ++j) c[j] = 0.f;
#pragma unroll 8
        for (int n = 0; n < RNC; ++n) { bf16* pn = base + (size_t)n * (RDV * RDK); const u32x4 uv = *(const u32x4*)pn;
            u32x4 o; o.x = pk2(c[0], c[1]); o.y = pk2(c[2], c[3]); o.z = pk2(c[4], c[5]); o.w = pk2(c[6], c[7]); *(u32x4*)pn = o;
            c[0] = g128 * (c[0] + bflo(uv.x)); c[1] = g128 * (c[1] + bfhi(uv.x)); c[2] = g128 * (c[2] + bflo(uv.y)); c[3] = g128 * (c[3] + bfhi(uv.y));
            c[4] = g128 * (c[4] + bflo(uv.z)); c[5] = g128 * (c[5] + bfhi(uv.z)); c[6] = g128 * (c[6] + bflo(uv.w)); c[7] = g128 * (c[7] + bfhi(uv.w)); }
    }
}
__device__ __forceinline__ void phase_ret_out(const Frame& F, KP p) {
    const bf16* proj = (const bf16*)(F.ws + WS_BIG); const bf16* St = (const bf16*)(F.ws + WS_AUX); bf16* yret = (bf16*)(F.ws + WS_BIG + BIG_YRET);
    const float* gng = gin(p, 4); const float* gnb = gin(p, 5);
    constexpr int LD = 264, VLD = 72, NSL = 8, ESL = 64;
    LAS bf16* Rs = (LAS bf16*)F.lds; LAS bf16* Vs = Rs + 128 * LD;
    const int w = F.wave;
#define RO_TID(t_) int t_ = F.tid; asm volatile("" : "+v"(t_))
#define RO_LD(base_, off_) (*(const u32x4*)((const char*)(base_) + (off_)))
    for (int u = F.vcu; u < 512; u += F.G) {
        const int h = u & 3, n = (u >> 2) & 63, b = u >> 8;
        const size_t row0 = (size_t)b * SEQ + (size_t)n * RC;
        const bf16* Sn = St + ((size_t)((b * RH + h) * RNC + n)) * (RDV * RDK);
        const char* pbase = (const char*)(proj + row0 * RET_IN);
        u32x4 pv[2], ps[4];
        bf16x8 qf[8];
        { RO_TID(t0); u32x4 kreg[8];
          unsigned koff = (unsigned)(((t0 >> 5) * RET_IN + (t0 & 31) * 8) * 2), qoff = (unsigned)(((16 * w + (t0 & 15)) * RET_IN + 8 * ((t0 & 63) >> 4)) * 2);
#pragma unroll
          for (int it = 0; it < 8; ++it) { asm volatile("" : "+v"(koff)); kreg[it] = RO_LD(pbase + (size_t)(1024 + h * 256 + it * 16 * RET_IN) * 2, koff); }
#pragma unroll
          for (int s = 0; s < 8; ++s) { asm volatile("" : "+v"(qoff)); qf[s] = __builtin_bit_cast(bf16x8, RO_LD(pbase + (size_t)(h * 256 + 32 * s) * 2, qoff)); }
#define RO_LOAD_SLICE(sl_) do { RO_TID(tl_); unsigned voff = (unsigned)(((tl_ >> 3) * RET_IN + (tl_ & 7) * 8) * 2), soff = (unsigned)(((tl_ >> 5) * RDK + (tl_ & 31) * 8) * 2); \
            _Pragma("unroll") for (int it = 0; it < 2; ++it) { asm volatile("" : "+v"(voff)); pv[it] = RO_LD(pbase + (size_t)(2048 + h * 512 + (sl_) * ESL + it * 64 * RET_IN) * 2, voff); } \
            _Pragma("unroll") for (int it = 0; it < 4; ++it) { asm volatile("" : "+v"(soff)); ps[it] = RO_LD((const char*)Sn + (size_t)(((sl_) * ESL + it * 16) * RDK) * 2, soff); } } while (0)
          RO_LOAD_SLICE(0);
#pragma unroll
          for (int it = 0; it < 8; ++it) { const int idx = t0 + 512 * it, j = idx >> 5, ch = idx & 31; *(LAS u32x4*)(Rs + j * LD + ch * 8) = kreg[it]; } }
        __syncthreads();
        bf16x8 pf[4];
        { RO_TID(t1); const int lane = t1 & 63, g4 = lane >> 4, irow = 16 * w + (lane & 15);
          f32x4 sacc[8];
#pragma unroll
            for (int jt = 0; jt < 8; ++jt) { sacc[jt] = (f32x4){0.f, 0.f, 0.f, 0.f};
                if (jt <= w) {
#pragma unroll
                    for (int s = 0; s < 8; ++s) sacc[jt] = MFMA16(row_frag(Rs, LD, 16 * jt, 32 * s, lane), qf[s], sacc[jt]);
#pragma unroll
                    for (int i = 0; i < 4; ++i) if (16 * jt + 4 * g4 + i > irow) sacc[jt][i] = 0.f; } }
#pragma unroll
            for (int kt = 0; kt < 4; ++kt) pf[kt] = pack8(sacc[2 * kt], sacc[2 * kt + 1]); }
        __syncthreads();
        u32x4 accp[NSL][2];
        float s1 = 0.f, s2 = 0.f;
#pragma unroll
        for (int sl = 0; sl < NSL; ++sl) {
            { RO_TID(t2);
#pragma unroll
              for (int it = 0; it < 2; ++it) { const int idx = t2 + 512 * it, j = idx >> 3, ch = idx & 7; *(LAS u32x4*)(Vs + j * VLD + ch * 8) = pv[it]; }
#pragma unroll
              for (int it = 0; it < 4; ++it) { const int idx = t2 + 512 * it, e = idx >> 5, ch = idx & 31; *(LAS u32x4*)(Rs + e * LD + ch * 8) = ps[it]; } }
            __syncthreads();
            if (sl + 1 < NSL) RO_LOAD_SLICE(sl + 1);
            RO_TID(t3); const int lane = t3 & 63, g4 = lane >> 4, qq = (lane & 15) >> 2, pp = lane & 3;
            f32x4 acc[4];
#pragma unroll
            for (int et = 0; et < 4; ++et) { f32x4 a = (f32x4){0.f, 0.f, 0.f, 0.f};
#pragma unroll
                for (int kt = 0; kt < 4; ++kt) if (2 * kt <= w) { const LAS bf16* a0 = Vs + (32 * kt + 4 * g4 + qq) * VLD + 16 * pp + 4 * et;
                    a = MFMA16(cat8(tr4(a0), tr4(a0 + 16 * VLD)), pf[kt], a); }
                const LAS bf16* srow = Rs + (16 * qq + 4 * et + pp) * LD + 8 * g4;
#pragma unroll
                for (int s = 0; s < 8; ++s) a = MFMA16(*(const LAS bf16x8*)(srow + 32 * s), qf[s], a);
                acc[et] = a; s1 += (a[0] + a[1]) + (a[2] + a[3]); s2 += (a[0] * a[0] + a[1] * a[1]) + (a[2] * a[2] + a[3] * a[3]);
                __builtin_amdgcn_sched_barrier(0); }
            accp[sl][0] = pack_bf16x8(acc[0], acc[1]); accp[sl][1] = pack_bf16x8(acc[2], acc[3]);
            __syncthreads();
        }
#undef RO_LOAD_SLICE
        RO_TID(t4); const int lane = t4 & 63, g4 = lane >> 4, irow = 16 * w + (lane & 15); const size_t qrow = row0 + irow;
        s1 += shx(s1, 16, lane); s1 += shx(s1, 32, lane); s2 += shx(s2, 16, lane); s2 += shx(s2, 32, lane);
        const float mean = s1 * (1.0f / RDV); const float var = fmaxf(s2 * (1.0f / RDV) - mean * mean, 0.f);
        const float rstd = 1.0f / sqrtf(var + LN_EPS);
        unsigned goff = (unsigned)((irow * RET_IN + 16 * g4) * 2);
#pragma unroll
        for (int sp = 0; sp < NSL; sp += 2) {
            u32x4 gq[2][2]; f32x4 gg[2][4], gb[2][4];
#pragma unroll
            for (int d2 = 0; d2 < 2; ++d2) { const int c0 = h * RDV + (sp + d2) * ESL + 16 * g4;
#pragma unroll
                for (int q = 0; q < 2; ++q) { asm volatile("" : "+v"(goff)); gq[d2][q] = RO_LD(pbase + (size_t)(4096 + h * RDV + (sp + d2) * ESL + 8 * q) * 2, goff); }
#pragma unroll
                for (int q = 0; q < 4; ++q) { gg[d2][q] = *(const f32x4*)(gng + c0 + 4 * q); gb[d2][q] = *(const f32x4*)(gnb + c0 + 4 * q); } }
#pragma unroll
            for (int d2 = 0; d2 < 2; ++d2) { const int c0 = h * RDV + (sp + d2) * ESL + 16 * g4; u32x4 o8;
#pragma unroll
                for (int q = 0; q < 2; ++q) { const u32x4 gw = gq[d2][q]; f32x4 a0, a1; unpack_bf16x8(accp[sp + d2][q], a0, a1);
                    f32x4 y0 = (a0 - mean) * rstd * gg[d2][2 * q] + gb[d2][2 * q], y1 = (a1 - mean) * rstd * gg[d2][2 * q + 1] + gb[d2][2 * q + 1];
                    const float gv[8] = {bflo(gw.x), bfhi(gw.x), bflo(gw.y), bfhi(gw.y), bflo(gw.z), bfhi(gw.z), bflo(gw.w), bfhi(gw.w)};
#pragma unroll
                    for (int j = 0; j < 4; ++j) { y0[j] *= gv[j] * fsig(gv[j]) * A_SCALE; y1[j] *= gv[4 + j] * fsig(gv[4 + j]) * A_SCALE; }
                    o8[2 * q] = pk4_fp8(y0[0], y0[1], y0[2], y0[3]); o8[2 * q + 1] = pk4_fp8(y1[0], y1[1], y1[2], y1[3]); }
                *(u32x4*)((unsigned char*)yret + qrow * RET_V + c0) = o8; }
        }
    }
#undef RO_LD
#undef RO_TID
}

constexpr size_t AUX_S5E = 64 * MiB;
constexpr int S5L = 256, S5NC = SEQ / S5L;
__device__ __forceinline__ void cmul_add(float& rr, float& ri, float ar, float ai, float xr, float xi, float cr, float ci) { rr = ar * xr - ai * xi + cr; ri = ar * xi + ai * xr + ci; }
template <bool OUT>
__device__ __forceinline__ void phase_s5_scan(const Frame& F, KP p) {
    const bf16* X = (const bf16*)(F.ws + WS_XB); float* E = (float*)(F.ws + WS_AUX + AUX_S5E); bf16* ybuf = (bf16*)(F.ws + WS_AUX);
    const int lane = F.lane, w = F.wave, g4 = lane >> 4, l15 = lane & 15;
    LAS bf16* ut = (LAS bf16*)(F.lds + w * 12288);
    LAS bf16* Hb = (LAS bf16*)(F.lds + w * 12288 + 4096);
    constexpr int HLD = 136;
    const int gw = F.vcu * NWAVES + w, NGW = F.G * NWAVES;
    const int up16 = (lane - 16) << 2, up32 = (lane - 32) << 2, last16 = (48 + l15) << 2;
    for (int unit = gw; unit < BATCH * SG * S5NC; unit += NGW) {
        const int n = unit & (S5NC - 1), g = (unit >> 5) & 63, b = unit >> 11;
        float a1r[4], a1i[4], a4r[4], a4i[4], a8r[4], a8i[4], pwr[4], pwi[4];
        bf16x8 bfrag[8];
        const float dt = expf(gin(p, 14)[g]);
#pragma unroll
        for (int st = 0; st < 4; ++st) { const int ps = 16 * st + l15;
            const float are = gin(p, 7)[g * SP + ps], aim = gin(p, 8)[g * SP + ps];
            const float mag = expf(dt * are); const float abr = mag * cosf(dt * aim), abi = mag * sinf(dt * aim);
            const float den = are * are + aim * aim;
            const float fre = ((abr - 1.0f) * are + abi * aim) / den, fim = (abi * are - (abr - 1.0f) * aim) / den;
            a1r[st] = abr; a1i[st] = abi; { float t2r, t2i; cmul_add(t2r, t2i, abr, abi, abr, abi, 0.f, 0.f); cmul_add(a4r[st], a4i[st], t2r, t2i, t2r, t2i, 0.f, 0.f); }
            cmul_add(a8r[st], a8i[st], a4r[st], a4i[st], a4r[st], a4i[st], 0.f, 0.f);
            float qr = 1.f, qi = 0.f;
            if (g4 & 1) { qr = a4r[st]; qi = a4i[st]; }
            if (g4 & 2) { float tr, ti; cmul_add(tr, ti, qr, qi, a8r[st], a8i[st], 0.f, 0.f); qr = tr; qi = ti; }
            pwr[st] = qr; pwi[st] = qi;
            const float* br = gin(p, 9) + ((size_t)g * SP + ps) * SGC + 8 * (g4 & 1); const float* bi = gin(p, 10) + ((size_t)g * SP + ps) * SGC + 8 * (g4 & 1);
            const f32x4 r0 = *(const f32x4*)br, r1 = *(const f32x4*)(br + 4), i0 = *(const f32x4*)bi, i1 = *(const f32x4*)(bi + 4);
            const float z = (g4 < 2) ? 1.0f : 0.0f; const float fr2 = fre * z, fi2 = fim * z;
            bfrag[st] = pack8(r0 * fr2 - i0 * fi2, r1 * fr2 - i1 * fi2); bfrag[st + 4] = pack8(i0 * fr2 + r0 * fi2, i1 * fr2 + r1 * fi2);
        }
        float sr[4], si[4];
        float* Eu = E + ((size_t)(b * SG + g) * S5NC + n) * 128;
        bf16x8 cf[4]; f32x4 dsk = (f32x4){0.f, 0.f, 0.f, 0.f};
#pragma unroll
        for (int st = 0; st < 4; ++st) { sr[st] = 0.f; si[st] = 0.f; }
        if (OUT) {
#pragma unroll
            for (int st = 0; st < 4; ++st) { sr[st] = Eu[16 * st + l15]; si[st] = Eu[64 + 16 * st + l15]; }
#pragma unroll
            for (int s = 0; s < 4; ++s) { const float* cp = (s < 2 ? gin(p, 11) : gin(p, 12)) + ((size_t)g * SGC + l15) * SP + 32 * (s & 1) + 8 * g4; const float sg = s < 2 ? 1.0f : -1.0f;
                const f32x4 c0 = *(const f32x4*)cp * sg, c1 = *(const f32x4*)(cp + 4) * sg; cf[s] = pack8(c0, c1); }
            dsk = *(const f32x4*)(gin(p, 13) + g * SGC + 4 * g4); }
        const size_t tok0 = (size_t)b * SEQ + (size_t)n * S5L;
        u32x4 pre[2];
        { const bf16* src = X + (tok0 + lane) * D + g * SGC; pre[0] = *(const u32x4*)src; pre[1] = *(const u32x4*)(src + 8); }
        for (int sub = 0; sub < S5L / 64; ++sub) {
            *(LAS u32x4*)(ut + lane * 16) = pre[0]; *(LAS u32x4*)(ut + lane * 16 + 8) = pre[1];
            if (sub + 1 < S5L / 64) { const bf16* src = X + (tok0 + (sub + 1) * 64 + lane) * D + g * SGC; pre[0] = *(const u32x4*)src; pre[1] = *(const u32x4*)(src + 8); }
            LDS_WAIT(); asm volatile("" ::: "memory");
#pragma unroll (OUT ? 1 : 4)
            for (int blk = 0; blk < 4; ++blk) {
                u32x4 uw = *(const LAS u32x4*)(ut + (blk * 16 + l15) * 16 + 8 * (g4 & 1));
                if (g4 >= 2) uw = (u32x4){0u, 0u, 0u, 0u};
                const bf16x8 ufr = __builtin_bit_cast(bf16x8, uw);
                f32x4 dr[4], di[4];
#pragma unroll
                for (int st = 0; st < 4; ++st) { dr[st] = MFMA16(ufr, bfrag[st], ((f32x4){0.f, 0.f, 0.f, 0.f})); di[st] = MFMA16(ufr, bfrag[st + 4], ((f32x4){0.f, 0.f, 0.f, 0.f})); }
                float vr[4], vi[4];
#pragma unroll
                for (int st = 0; st < 4; ++st) {
                    float hr = 0.f, hi = 0.f;
#pragma unroll
                    for (int i = 0; i < 4; ++i) { float nr, ni; cmul_add(nr, ni, a1r[st], a1i[st], hr, hi, dr[st][i], di[st][i]); hr = nr; hi = ni; dr[st][i] = hr; di[st][i] = hi; }
                    vr[st] = hr; vi[st] = hi; }
#define BPF(idx, v) __builtin_bit_cast(float, __builtin_amdgcn_ds_bpermute((idx), __builtin_bit_cast(int, (v))))
                { float xr[4], xi[4];
#pragma unroll
                  for (int st = 0; st < 4; ++st) { xr[st] = BPF(up16, vr[st]); xi[st] = BPF(up16, vi[st]); }
#pragma unroll
                  for (int st = 0; st < 4; ++st) { float tr, ti; cmul_add(tr, ti, a4r[st], a4i[st], xr[st], xi[st], vr[st], vi[st]); if (g4 >= 1) { vr[st] = tr; vi[st] = ti; } }
#pragma unroll
                  for (int st = 0; st < 4; ++st) { xr[st] = BPF(up32, vr[st]); xi[st] = BPF(up32, vi[st]); }
#pragma unroll
                  for (int st = 0; st < 4; ++st) { float tr, ti; cmul_add(tr, ti, a8r[st], a8i[st], xr[st], xi[st], vr[st], vi[st]); if (g4 >= 2) { vr[st] = tr; vi[st] = ti; } } }
                float er[4], ei[4], lr[4], li[4];
#pragma unroll
                for (int st = 0; st < 4; ++st) { if (OUT) { er[st] = BPF(up16, vr[st]); ei[st] = BPF(up16, vi[st]); } else { er[st] = 0.f; ei[st] = 0.f; } lr[st] = BPF(last16, vr[st]); li[st] = BPF(last16, vi[st]); }
#undef BPF
#pragma unroll
                for (int st = 0; st < 4; ++st) {
                    if (g4 == 0) { er[st] = 0.f; ei[st] = 0.f; }
                    if (OUT) { float s0r, s0i; cmul_add(s0r, s0i, pwr[st], pwi[st], sr[st], si[st], er[st], ei[st]);
#pragma unroll
                        for (int i = 0; i < 4; ++i) { float tr, ti; cmul_add(tr, ti, a1r[st], a1i[st], s0r, s0i, 0.f, 0.f); s0r = tr; s0i = ti; dr[st][i] += s0r; di[st][i] += s0i; } }
                    { float a16r, a16i; cmul_add(a16r, a16i, a8r[st], a8i[st], a8r[st], a8i[st], 0.f, 0.f); float tr, ti; cmul_add(tr, ti, a16r, a16i, sr[st], si[st], lr[st], li[st]); sr[st] = tr; si[st] = ti; }
                    if (OUT) {
#pragma unroll
                        for (int i = 0; i < 4; ++i) { const unsigned hw = pk2(dr[st][i], di[st][i]); Hb[(4 * g4 + i) * HLD + 16 * st + l15] = (bf16)hw; Hb[(4 * g4 + i) * HLD + 64 + 16 * st + l15] = (bf16)(hw >> 16); } }
                }
                if (OUT) {
                    LDS_WAIT(); asm volatile("" ::: "memory");
                    f32x4 ya = (f32x4){0.f, 0.f, 0.f, 0.f};
#pragma unroll
                    for (int s = 0; s < 4; ++s) ya = MFMA16(cf[s], row_frag(Hb, HLD, 0, 32 * s, lane), ya);
                    const u32x2 u2 = *(const LAS u32x2*)(ut + (blk * 16 + l15) * 16 + 4 * g4);
                    const f32x4 u4 = (f32x4){bflo(u2.x), bfhi(u2.x), bflo(u2.y), bfhi(u2.y)};
                    f32x4 y = ya + dsk * u4;
#pragma unroll
                    for (int j = 0; j < 4; ++j) { const float v = y[j]; y[j] = v * fsig(1.5957691216057308f * (v + 0.044715f * v * v * v)); }
                    *(unsigned*)((unsigned char*)ybuf + (size_t)(tok0 + sub * 64 + blk * 16 + l15) * D + g * SGC + 4 * g4) = pk4_fp8(y[0] * A_SCALE, y[1] * A_SCALE, y[2] * A_SCALE, y[3] * A_SCALE);
                    asm volatile("" ::: "memory"); }
            }
            LDS_WAIT(); asm volatile("" ::: "memory");
        }
        if (!OUT && g4 == 0) {
#pragma unroll
            for (int st = 0; st < 4; ++st) { Eu[16 * st + l15] = sr[st]; Eu[64 + 16 * st + l15] = si[st]; } }
    }
}
__device__ __forceinline__ void phase_s5_carry(const Frame& F, KP p) {
    float* E = (float*)(F.ws + WS_AUX + AUX_S5E);
    for (int gt = F.vcu * NTHREADS + F.tid; gt < BATCH * SG * SP; gt += F.G * NTHREADS) {
        const int pl = gt & 63, bg = gt >> 6, g = bg & 63;
        const float dt = expf(gin(p, 14)[g]); const float are = gin(p, 7)[g * SP + pl], aim = gin(p, 8)[g * SP + pl];
        const float mag = expf(dt * are); float ar = mag * cosf(dt * aim), ai = mag * sinf(dt * aim);
#pragma unroll
        for (int q = 0; q < 8; ++q) { const float nr = ar * ar - ai * ai, ni = 2.0f * ar * ai; ar = nr; ai = ni; }
        float cr = 0.f, ci = 0.f;
        for (int n = 0; n < S5NC; ++n) { float* Eu = E + ((size_t)bg * S5NC + n) * 128; const float er = Eu[pl], ei = Eu[64 + pl];
            Eu[pl] = cr; Eu[64 + pl] = ci;
            const float nr = ar * cr - ai * ci + er, ni = ar * ci + ai * cr + ei; cr = nr; ci = ni; }
    }
}

constexpr int NPHASES = 34;
#ifndef PROBE_DRY14
#define PROBE_DRY14 0
#endif
#ifndef PROBE_DRY17
#define PROBE_DRY17 0
#endif
#ifndef PH_MASK
#define PH_MASK 0xFFFFFFFFu
#endif
#define PHT(t) ((PH_MASK >> (t)) & 1u)
constexpr int PLAN_OFF = 64;
__device__ __forceinline__ void moe_plan(const Frame& F, int layer) {
    volatile LAS int* tstart = (volatile LAS int*)(F.MISC + PLAN_OFF); volatile LAS int* cnts = tstart + 72;
    __syncthreads();
    if (F.wave == 0) {
        const unsigned* cnt = (const unsigned*)(F.ws + WS_CTL) + CW_CNT + layer * NE * 64;
        const int c = (int)__hip_atomic_load(cnt + F.lane * 64, __ATOMIC_RELAXED, __HIP_MEMORY_SCOPE_AGENT);
        int v = (c + 255) >> 8;
#pragma unroll
        for (int o = 1; o < 64; o <<= 1) { const int nb = __builtin_amdgcn_ds_bpermute((F.lane - o) << 2, v); if (F.lane >= o) v += nb; }
        tstart[F.lane + 1] = v; cnts[F.lane] = c;
        if (F.lane == 0) tstart[0] = 0;
        if (F.lane == 63) { tstart[65] = v + T / 256; cnts[64] = T; }
    }
    __syncthreads();
}
template <bool GATH> struct MoeSched2 {
    static constexpr bool GATHER = GATH, UNIFORMIZE = true, FP8 = true;
    static constexpr int ncol = GATH ? 2 : 4, K = GATH ? D / 2 : ED / 2;
    const volatile LAS int* tstart; const volatile LAS int* cnts; int ntiles, G, c, lane;
    const char* Abase; const char* Wbase; const int* lists;
    __device__ __forceinline__ bool next(int i, pg8::UnitG& u) const {
        const int nwg = ntiles * ncol; const long L = (long)i * G + c; if (L >= nwg) return false;
        int wgid = (int)L; { const int q = nwg / 8, r = nwg % 8, xcd = wgid % 8, off = wgid / 8; wgid = (xcd < r ? xcd * (q + 1) : r * (q + 1) + (xcd - r) * q) + off; }
        const int tile = wgid / ncol, pn = wgid % ncol;
        int ln; { unsigned o2 = ~0u; asm volatile("" : "+s"(o2)); ln = (int)__builtin_amdgcn_mbcnt_hi(o2, __builtin_amdgcn_mbcnt_lo(o2, 0u)); }
        const int ta = tstart[ln], tb = tstart[ln + 1];
        const unsigned long long mm = __ballot(ta <= tile && tile < tb);
        const int e = mm ? (int)__builtin_ctzll(mm) : 64;
        const int ts = __builtin_amdgcn_readfirstlane((int)tstart[e]), ce = __builtin_amdgcn_readfirstlane((int)cnts[e]);
        const int lt = tile - ts; int valid = ce - lt * 256; valid = valid > 256 ? 256 : valid;
        u.gshift = 0; u.aux = e;
        if (GATH) {
            u.B = Wbase + (size_t)e * WMOE_E_BYTES + (size_t)pn * 256 * K * 2;
            if (e < 64) { u.A = Abase; u.gidx = lists + (size_t)e * T + lt * 256; u.gcnt = valid; }
            else { u.A = Abase + (size_t)lt * 256 * K * 2; u.gidx = nullptr; u.gcnt = 0; }
            u.row0 = tile * 256; u.col0 = pn * 128;
        } else {
            u.B = Wbase + (size_t)e * WMOE_E_BYTES + (size_t)512 * 1024 * 2 + (size_t)pn * 256 * K * 2;
            u.A = Abase + (size_t)tile * 256 * K * 2; u.gidx = nullptr; u.gcnt = valid;
            u.row0 = tile * 256; u.col0 = pn * 256;
        }
        return true;
    }
};
__device__ __forceinline__ void phase_load_x(const Frame& F, KP p) {
    const float* xin = gin(p, 0); bf16* XB = (bf16*)(F.ws + WS_XB);
    for (size_t i = (size_t)F.vcu * NTHREADS + F.tid; i < (size_t)T * D / 8; i += (size_t)F.G * NTHREADS) {
        const f32x4 a = *(const f32x4*)(xin + i * 8), b = *(const f32x4*)(xin + i * 8 + 4);
        *(u32x4*)(XB + i * 8) = pack_bf16x8(a, b);
        u32x2 q8; q8.x = pk4_fp8(a[0], a[1], a[2], a[3]); q8.y = pk4_fp8(b[0], b[1], b[2], b[3]); *(u32x2*)((unsigned char*)(F.ws + WS_X) + i * 8) = q8; }
}

__global__ void __launch_bounds__(NTHREADS, 2) fwd_kernel(Params p_unused) {
    KP p0 = (KP)__builtin_amdgcn_kernarg_segment_ptr();
    extern __shared__ __attribute__((aligned(16))) unsigned char lds_raw[];
    Frame F0;
    F0.lds = (LAS unsigned char*)lds_raw; F0.MISC = (volatile LAS unsigned*)(F0.lds + MISC_OFF);
    F0.tid = threadIdx.x; F0.lane = F0.tid & 63; F0.wave = __builtin_amdgcn_readfirstlane(F0.tid >> 6);
    F0.G = gridDim.x; { const int bq = blockIdx.x; F0.vcu = (F0.G % 8 == 0) ? (bq % 8) * (F0.G / 8) + bq / 8 : bq; }
    F0.ws = p0->ws;
    const int bx0 = blockIdx.x;
    for (int u = F0.tid; u < (LDS_BYTES - MISC_OFF) / 4; u += NTHREADS) ((LAS unsigned*)(F0.lds + MISC_OFF))[u] = 0u;
    __syncthreads();
    XcdBarrier bar; bar.bar = (unsigned*)(p0->ws + WS_CTL) + CW_BAR; bar.x = 0; bar.st = nullptr;
    const int use_bar = p0->use_bar;
    if (use_bar) bar = xcd_barrier_post((unsigned*)(p0->ws + WS_CTL) + CW_BAR, F0.MISC + 8);
    const int lo = p0->ph_lo, hi = p0->ph_hi;
#define PHASE_BEGIN Frame F = F0; KP p = p0; { unsigned ones_ = ~0u; asm volatile("" : "+s"(ones_)); F.lane = (int)__builtin_amdgcn_mbcnt_hi(ones_, __builtin_amdgcn_mbcnt_lo(ones_, 0u)); } asm volatile("" : "+v"(F.lane)); F.tid = F.wave * 64 + F.lane; asm volatile("" : "+v"(F.tid));   GAS unsigned char* wsg_ = (GAS unsigned char*)F0.ws; asm volatile("" : "+s"(F.wave), "+s"(F.vcu), "+s"(F.G), "+s"(wsg_), "+s"(p)); \
    F.ws = (unsigned char*)wsg_; int bx = bx0; asm volatile("" : "+s"(bx)); unsigned char* ws = F.ws; (void)ws; (void)bx;
#pragma unroll 1
    for (int ph = lo; ph < hi; ++ph) {
        int layer = 0, type = 0;
        if (ph > 0) { layer = ph >= 26 ? 3 : (ph >= 18 ? 2 : (ph >= 9 ? 1 : 0)); const int q = ph - (layer == 3 ? 26 : (layer == 2 ? 18 : (layer == 1 ? 9 : 1))); const int kind = layer % 3;
            if (kind == 0) type = q < 4 ? 1 + q : 14 + (q - 4); else if (kind == 1) type = q < 5 ? 5 + q : 14 + (q - 5); else type = q < 4 ? 10 + q : 14 + (q - 4); }
        const int j = layer / 3;
#ifdef REPEAT_MASK
        const int nrep = ((REPEAT_MASK >> type) & 1u) ? 2 : 1;
#else
        const int nrep = 1;
#endif
#pragma unroll 1
        for (int rep = 0; rep < nrep; ++rep) {
        if (rep > 0 && use_bar) xcd_barrier(bar);
        if (PHT(0) && type == 0) { PHASE_BEGIN; phase_conv_mixers(F, p); phase_conv_moe(F, p, 0); phase_load_x(F, p); }
        else if (PHT(1) && type == 1) { PHASE_BEGIN; DenseSched8 S; S.init(ws + WS_X, ws + WS_ATT_IN_T + (size_t)j * ATT_IN * D, T, ATT_IN, D / 2, F.G, bx); EpiStoreBf16 E{(bf16*)(ws + WS_BIG), ATT_IN, WUP_INV, 0.08838834764831845f};
            pg8::gemm_phase(F.lds, F.tid, D / 2, S, E); }
        else if (PHT(2) && type == 2) { PHASE_BEGIN; phase_attn(F, bx); }
        else if (PHT(3) && type == 3) { PHASE_BEGIN; phase_attn_combine(F); }
        else if (PHT(4) && type == 4) { PHASE_BEGIN; DenseSched8 S; S.init(ws + WS_AUX + AUX_OB, ws + WS_ATT_OUT_T + (size_t)j * D * D, T, D, D / 2, F.G, bx); EpiResid8 E{(const bf16*)(ws + WS_XB), (bf16*)(ws + WS_Y), 1.0f / (A_SCALE * WUP_SCALE)};
            pg8::gemm_phase(F.lds, F.tid, D / 2, S, E); }
        else if (PHT(5) && type == 5) { PHASE_BEGIN; DenseSched8 S; S.init(ws + WS_X, ws + WS_RET_IN_T, T, RET_IN, D / 2, F.G, bx); EpiRetIn E{(bf16*)(ws + WS_BIG), RET_IN};
            pg8::gemm_phase(F.lds, F.tid, D / 2, S, E); }
        else if (PHT(6) && type == 6) { PHASE_BEGIN; phase_ret_u(F); }
        else if (PHT(7) && type == 7) { PHASE_BEGIN; phase_ret_scan(F); }
        else if (PHT(8) && type == 8) { PHASE_BEGIN; phase_ret_out(F, p); }
        else if (PHT(9) && type == 9) { PHASE_BEGIN; DenseSched8 S; S.init(ws + WS_BIG + BIG_YRET, ws + WS_RET_OUT_T, T, D, RET_V / 2, F.G, bx); EpiResid8 E{(const bf16*)(ws + WS_XB), (bf16*)(ws + WS_Y), 1.0f / (A_SCALE * WUP_SCALE)};
            pg8::gemm_phase(F.lds, F.tid, RET_V / 2, S, E); }
        else if (PHT(10) && type == 10) { PHASE_BEGIN; phase_s5_scan<false>(F, p); }
        else if (PHT(11) && type == 11) { PHASE_BEGIN; phase_s5_carry(F, p); }
        else if (PHT(12) && type == 12) { PHASE_BEGIN; phase_s5_scan<true>(F, p); }
        else if (PHT(13) && type == 13) { PHASE_BEGIN; DenseSched8 S; S.init(ws + WS_AUX, ws + WS_GLU_T, T, 2 * D, D / 2, F.G, bx); EpiGluResid E{(const bf16*)(ws + WS_XB), (bf16*)(ws + WS_Y), 1.0f / (A_SCALE * WUP_SCALE)};
            pg8::gemm_phase(F.lds, F.tid, D / 2, S, E); }
        else if (PHT(14) && type == 14) { PHASE_BEGIN; phase_lnr(F, p, layer, PROBE_DRY14 && true); if (PROBE_DRY14) { if (use_bar) xcd_barrier(bar); phase_lnr(F, p, layer, false); } }
        else if (PHT(15) && type == 15) { PHASE_BEGIN; moe_plan(F, layer);
            MoeSched2<true> S; S.tstart = (const volatile LAS int*)(F.MISC + PLAN_OFF); S.cnts = S.tstart + 72; S.ntiles = __builtin_amdgcn_readfirstlane((int)S.tstart[65]); S.G = F.G; S.c = bx; S.lane = F.lane;
            S.Abase = (const char*)(ws + WS_X); S.Wbase = (const char*)(ws + WS_WMOE); S.lists = (const int*)(ws + WS_LIST);
            EpiMoeUp E{(unsigned char*)(ws + WS_H)};
            pg8::gemm_phase(F.lds, F.tid, D / 2, S, E); }
        else if (PHT(16) && type == 16) { PHASE_BEGIN; moe_plan(F, layer);
            { MoeSched2<false> S; S.tstart = (const volatile LAS int*)(F.MISC + PLAN_OFF); S.cnts = S.tstart + 72; S.ntiles = __builtin_amdgcn_readfirstlane((int)S.tstart[64]); S.G = F.G; S.c = bx; S.lane = F.lane;
              S.Abase = (const char*)(ws + WS_H); S.Wbase = (const char*)(ws + WS_WMOE); S.lists = (const int*)(ws + WS_LIST);
              EpiStoreFp8 E{(unsigned char*)(ws + WS_BIG), D};
              pg8::gemm_phase(F.lds, F.tid, ED / 2, S, E); }
            { const int sh0 = __builtin_amdgcn_readfirstlane((int)((const volatile LAS int*)(F.MISC + PLAN_OFF))[64]);
              DenseSched8 S; S.init(ws + WS_H + (size_t)sh0 * 256 * ED, ws + WS_WMOE + (size_t)64 * WMOE_E_BYTES + (size_t)512 * 1024 * 2, T, D, ED / 2, F.G, bx); EpiResid8 E{(const bf16*)(ws + WS_XB), (bf16*)(ws + WS_Y), 1.0f / (H_SCALE * WUP_SCALE)};
              int tid2; { unsigned o2 = ~0u; asm volatile("" : "+s"(o2)); tid2 = F.wave * 64 + (int)__builtin_amdgcn_mbcnt_hi(o2, __builtin_amdgcn_mbcnt_lo(o2, 0u)); }
              pg8::gemm_phase(F.lds, tid2, ED / 2, S, E); } }
        else if (PHT(17) && type == 17) { PHASE_BEGIN; moe_plan(F, layer); if (PROBE_DRY17) { phase_combine(F, p, layer, true); if (use_bar) xcd_barrier(bar); } phase_combine(F, p, layer); if (layer + 1 < DEPTH) phase_conv_moe(F, p, layer + 1); }
        }
        if (use_bar && ph + 1 < hi) xcd_barrier(bar);
    }
}

#ifndef MK_PER_PHASE
#define MK_PER_PHASE 0
#endif
extern "C" void kernel_launch(void* const* d_in, const int* in_sizes, int n_in, void* d_out, int out_size, void* d_ws, size_t ws_size, hipStream_t stream) {
    static int grid = 0;
    if (grid == 0) {
        if (n_in != 26 || in_sizes[0] != T * D || out_size != T * D || ws_size < WS_END) { fprintf(stderr, "kernel_launch: unexpected shapes / workspace (n_in %d, in0 %d, out %d, ws %zu < %zu)\n", n_in, n_in > 0 ? in_sizes[0] : -1, out_size, ws_size, (size_t)WS_END); grid = -1; return; }
        int dev = 0, cus = 0, per_cu = 0;
        if (hipGetDevice(&dev) != hipSuccess || hipDeviceGetAttribute(&cus, hipDeviceAttributeMultiprocessorCount, dev) != hipSuccess) { grid = -1; return; }
        if (hipFuncSetAttribute((const void*)fwd_kernel, hipFuncAttributeMaxDynamicSharedMemorySize, LDS_BYTES) != hipSuccess) { fprintf(stderr, "kernel_launch: hipFuncSetAttribute failed\n"); grid = -1; return; }
        if (hipOccupancyMaxActiveBlocksPerMultiprocessor(&per_cu, (const void*)fwd_kernel, NTHREADS, LDS_BYTES) != hipSuccess || per_cu < 1) { fprintf(stderr, "kernel_launch: occupancy query says %d blocks per CU\n", per_cu); per_cu = 1; }
        (void)hipGetLastError();
        grid = cus;
    }
    if (grid < 0) return;
    (void)hipMemsetAsync((char*)d_ws + WS_CTL, 0, CTL_ZERO_BYTES, stream);
    Params p{};
    for (int i = 0; i < 26; ++i) p.in[i] = (const float*)d_in[i];
    p.out = (float*)d_out; p.ws = (unsigned char*)d_ws;
#if MK_PER_PHASE
    for (int k = 0; k < NPHASES; ++k) { p.ph_lo = k; p.ph_hi = k + 1; p.use_bar = 0; hipLaunchKernelGGL(fwd_kernel, dim3(grid), dim3(NTHREADS), LDS_BYTES, stream, p); }
#else
    p.ph_lo = 0; p.ph_hi = NPHASES; p.use_bar = 1;
    hipLaunchKernelGGL(fwd_kernel, dim3(grid), dim3(NTHREADS), LDS_BYTES, stream, p);
#endif
}
```

```cpp
#include <hip/hip_runtime.h>
#include <cstdio>
#include <cstdint>

#define LAS __attribute__((address_space(3)))
#define GAS __attribute__((address_space(1)))
typedef unsigned short bf16;
typedef short bf16x8 __attribute__((ext_vector_type(8)));
typedef short bf16x4 __attribute__((ext_vector_type(4)));
typedef float f32x4 __attribute__((ext_vector_type(4)));
typedef float f32x2 __attribute__((ext_vector_type(2)));
typedef unsigned u32x4 __attribute__((ext_vector_type(4)));
typedef unsigned u32x2 __attribute__((ext_vector_type(2)));
typedef GAS unsigned gu32;

constexpr int D = 1024, BATCH = 2, SEQ = 8192, T = BATCH * SEQ, DEPTH = 4;
constexpr int AH = 8, AHD = 128, ATT_IN = 9216;
constexpr int RH = 4, RDK = 256, RDV = 512, RET_IN = 6144, RET_V = 2048, RC = 128, RNC = SEQ / RC;
constexpr int SG = 64, SGC = 16, SP = 64;
constexpr int NE = 64, TOPK = 8, NEG = 8, ED = 256, NSLOT = 9;
constexpr float LN_EPS = 1e-5f;
constexpr float ALPHA = 1.6817928305074292f;
constexpr int NWAVES = 8, NTHREADS = 512;

__device__ __forceinline__ unsigned f2bf(float f) { unsigned u = __builtin_bit_cast(unsigned, f); return (u + 0x7fffu + ((u >> 16) & 1u)) >> 16; }
__device__ __forceinline__ unsigned pk2(float lo, float hi) { unsigned r; asm("s_nop 1\n\tv_cvt_pk_bf16_f32 %0, %1, %2" : "=v"(r) : "v"(lo), "v"(hi)); return r; }
__device__ __forceinline__ unsigned pk2sw(float lo, float hi) { return f2bf(lo) | (f2bf(hi) << 16); }
__device__ __forceinline__ unsigned pk2hw(float lo, float hi) { unsigned r; asm volatile("v_cvt_pk_bf16_f32 %0, %1, %2" : "=v"(r) : "v"(lo), "v"(hi)); return r; }
__device__ __forceinline__ float bf2f(unsigned b) { return __builtin_bit_cast(float, b << 16); }
__device__ __forceinline__ float bflo(unsigned w) { return __builtin_bit_cast(float, w << 16); }
__device__ __forceinline__ float bfhi(unsigned w) { return __builtin_bit_cast(float, w & 0xffff0000u); }
__device__ __forceinline__ float shx(float v, int m, int lane) { return __builtin_bit_cast(float, __builtin_amdgcn_ds_bpermute((lane ^ m) << 2, __builtin_bit_cast(int, v))); }
__device__ __forceinline__ int shx_i(int v, int m, int lane) { return __builtin_amdgcn_ds_bpermute((lane ^ m) << 2, v); }
__device__ __forceinline__ float rdl(float v, int src) { return __builtin_bit_cast(float, __builtin_amdgcn_readlane(__builtin_bit_cast(int, v), src)); }
template <int CTRL, int RM = 0xf, int BM = 0xf> __device__ __forceinline__ float dpp0(float v) { return __builtin_bit_cast(float, __builtin_amdgcn_update_dpp(0, __builtin_bit_cast(int, v), CTRL, RM, BM, true)); }
template <int CTRL, int RM = 0xf, int BM = 0xf> __device__ __forceinline__ float dppo(float old, float v) { return __builtin_bit_cast(float, __builtin_amdgcn_update_dpp(__builtin_bit_cast(int, old), __builtin_bit_cast(int, v), CTRL, RM, BM, false)); }
__device__ __forceinline__ float wave_sum(float v, int lane) {
    (void)lane;
    v += dpp0<0x111>(v); v += dpp0<0x112>(v); v += dpp0<0x114>(v); v += dpp0<0x118>(v);
    v += dpp0<0x142, 0xa>(v);
    v += dpp0<0x143, 0xc>(v);
    return rdl(v, 63);
}
__device__ __forceinline__ unsigned wave_umax(unsigned v) {
#define WU_DPP(ctrl, rm) (unsigned)__builtin_amdgcn_update_dpp(0, (int)v, ctrl, rm, 0xf, true)
    { const unsigned t = WU_DPP(0x111, 0xf); v = v > t ? v : t; } { const unsigned t = WU_DPP(0x112, 0xf); v = v > t ? v : t; } { const unsigned t = WU_DPP(0x114, 0xf); v = v > t ? v : t; } { const unsigned t = WU_DPP(0x118, 0xf); v = v > t ? v : t; }
    { const unsigned t = WU_DPP(0x142, 0xa); v = v > t ? v : t; } { const unsigned t = WU_DPP(0x143, 0xc); v = v > t ? v : t; }
#undef WU_DPP
    return (unsigned)__builtin_amdgcn_readlane((int)v, 63);
}
__device__ __forceinline__ float max8(float v) {
    v = fmaxf(v, dppo<0xb1>(v, v)); v = fmaxf(v, dppo<0x4e>(v, v)); v = fmaxf(v, dppo<0x141>(v, v)); return v;
}
__device__ __forceinline__ float fsig(float x) { return __builtin_amdgcn_rcpf(1.0f + __expf(-x)); }
#define LDS_WAIT() asm volatile("s_waitcnt lgkmcnt(0)" ::: "memory")
#define VM_WAIT() asm volatile("s_waitcnt vmcnt(0)" ::: "memory")
__device__ __forceinline__ const char* rfl_ptr(const char* p) {
    unsigned long long v = (unsigned long long)p; unsigned lo = __builtin_amdgcn_readfirstlane((unsigned)v), hi = __builtin_amdgcn_readfirstlane((unsigned)(v >> 32));
    return (const char*)(((unsigned long long)hi << 32) | lo);
}
__device__ __forceinline__ bf16x8 row_frag(const LAS bf16* base, int ld, int row0, int col0, int lane) {
    return *(const LAS bf16x8*)(base + (row0 + (lane & 15)) * ld + col0 + 8 * (lane >> 4));
}
__device__ __forceinline__ bf16x4 tr4(const LAS bf16* addr) { return __builtin_amdgcn_ds_read_tr16_b64_v4i16((LAS bf16x4*)addr); }
__device__ __forceinline__ bf16x8 cat8(bf16x4 a, bf16x4 b) { bf16x8 r; r[0] = a[0]; r[1] = a[1]; r[2] = a[2]; r[3] = a[3]; r[4] = b[0]; r[5] = b[1]; r[6] = b[2]; r[7] = b[3]; return r; }
#define MFMA16(a, b, c) __builtin_amdgcn_mfma_f32_16x16x32_bf16((a), (b), (c), 0, 0, 0)
__device__ __forceinline__ bf16x8 pack8(f32x4 a, f32x4 b) {
    u32x4 w; w.x = pk2(a[0], a[1]); w.y = pk2(a[2], a[3]); w.z = pk2(b[0], b[1]); w.w = pk2(b[2], b[3]); return __builtin_bit_cast(bf16x8, w);
}

namespace pg8 {
typedef int v4i_t __attribute__((ext_vector_type(4)));
typedef int v8i_t __attribute__((ext_vector_type(8)));
constexpr int BM = 256, BK = 64, HALF = 128, HTB = HALF * BK * 2, STAGE_BYTES = 8 * HTB;
__device__ __forceinline__ int lds_byte(int r, int c) { const int st = (r >> 4) * 2 + (c >> 5), rr = r & 15, cc = c & 31, ob = rr * 64 + cc * 2; return st * 1024 + (ob ^ (((ob >> 9) & 1) << 5)); }
__device__ __forceinline__ void stage_rc(int b, int& R, int& C) { const int st = b / 1024, sb = b % 1024, swz = sb ^ (((sb >> 9) & 1) << 5); R = (st >> 1) * 16 + swz / 64; C = (st & 1) * 32 + (swz % 64) / 2; }
__device__ __forceinline__ int perm32(int rho) { const int n = rho >> 4, i = rho & 15; return 8 * (i >> 2) + 4 * n + (i & 3); }

struct UnitG {
    const char* A;
    const char* B;
    const int* gidx;
    int gcnt, gshift;
    int row0, col0;
    int aux;
};

__device__ __forceinline__ void uniformize(UnitG& u) { u.A = rfl_ptr(u.A); u.B = rfl_ptr(u.B); u.gidx = (const int*)rfl_ptr((const char*)u.gidx); u.gcnt = __builtin_amdgcn_readfirstlane(u.gcnt); u.gshift = __builtin_amdgcn_readfirstlane(u.gshift);
    u.row0 = __builtin_amdgcn_readfirstlane(u.row0); u.col0 = __builtin_amdgcn_readfirstlane(u.col0); u.aux = __builtin_amdgcn_readfirstlane(u.aux); }
template <class Epi, class Sched>
__device__ __forceinline__ void gemm_phase(LAS unsigned char* lds, const int tid, const int K, const Sched& S, const Epi& E) {
    constexpr bool F8 = Sched::FP8;
    constexpr bool GATHER = Sched::GATHER;
    const int wid = __builtin_amdgcn_readfirstlane(tid >> 6), lane = tid & 63, wr = wid >> 2, wc = wid & 3, fr = lane & 15, fq = lane >> 4;
    int nt = K / BK; asm volatile("" : "+s"(nt));
    constexpr bool P16 = Epi::PERM16;
    unsigned voffB[2], voffB1[2], vA[2][2];
#pragma unroll
    for (int i = 0; i < 2; ++i) { int R, C; stage_rc(tid * 16 + i * 8192, R, C); const int Rb = Epi::PERM ? ((R & ~31) + perm32(R & 31)) : R; voffB[i] = (unsigned)(Rb * K + C) * 2u; voffB1[i] = voffB[i]; vA[0][i] = (unsigned)(R * K + C) * 2u; vA[1][i] = vA[0][i];
        if constexpr (P16) { const int x = R & 31, src = 64 * (R >> 5) + 16 * ((x >> 2) & 3) + 4 * (x >> 4) + (x & 3); voffB[i] = (unsigned)(src * K + C) * 2u; voffB1[i] = (unsigned)((src + 8) * K + C) * 2u; } }
    const size_t kstep = (size_t)(BK * 2);
    const size_t hstep = (size_t)HALF * K * 2;
    const size_t hstepB = P16 ? 0 : hstep;
    const size_t hstepA = GATHER ? 0 : hstep;
    const size_t hstepB1 = P16 ? (size_t)8 * K * 2 : hstep, bstep = (size_t)(P16 ? 128 : 64) * K * 2, astep = (size_t)64 * K * 2;
    unsigned vB0 = voffB[0], vA0 = vA[0][0];
    const unsigned ldsw = (unsigned)wid * 1024u;
    const int aoff = lds_byte(wr * 64 + fr, fq * 8), boff = lds_byte(wc * 32 + fr, fq * 8);
    LAS u32x4* park = (LAS u32x4*)(lds + STAGE_BYTES) + tid;
#define PG8_SA(b, h) (((b) * 2 + (h)) * HTB)
#define PG8_SB(b, h) ((4 + (b) * 2 + (h)) * HTB)
#define PG8_STAGE(bufoff, gbase, voff) do { _Pragma("unroll") for (int _i = 0; _i < 2; ++_i) { asm volatile("" : "+v"((voff)[_i]));   \
        __builtin_amdgcn_global_load_lds((const unsigned*)((const char*)(gbase) + (voff)[_i]), (LAS unsigned*)(lds + (bufoff) + ldsw + _i * 8192), 16, 0, 0); } } while (0)
#define PG8_STAGEU(bufoff, gbase, v0, step1) do { asm volatile("" : "+v"(v0)); __builtin_amdgcn_global_load_lds((const unsigned*)((const char*)(gbase) + (v0)), (LAS unsigned*)(lds + (bufoff) + ldsw), 16, 0, 0); \
        asm volatile("" : "+v"(v0)); __builtin_amdgcn_global_load_lds((const unsigned*)((const char*)(gbase) + (step1) + (v0)), (LAS unsigned*)(lds + (bufoff) + ldsw + 8192), 16, 0, 0); } while (0)
#define PG8_STB(b, h, base) PG8_STAGEU(PG8_SB(b, h), (base) + (h) * hstepB1, vB0, bstep)
#define PG8_STA(b, h, base) do { if constexpr (GATHER) PG8_STAGE(PG8_SA(b, h), (base), vA[h]); else PG8_STAGEU(PG8_SA(b, h), (base) + (h) * hstep, vA0, astep); } while (0)
    constexpr int FKS = 1024;
#define PG8_LD2(p_) __builtin_shufflevector(*(const LAS v4i_t*)(p_), *(const LAS v4i_t*)((p_) + FKS), 0, 1, 2, 3, 4, 5, 6, 7)
#define PG8_LDA(dst, b, h) do { _Pragma("unroll") for (int m = 0; m < 4; ++m) dst[m] = PG8_LD2(lds + PG8_SA(b, h) + aoff + m * 2048); } while (0)
#define PG8_LDB(dst, b, h) do { _Pragma("unroll") for (int n = 0; n < 2; ++n) dst[n] = PG8_LD2(lds + PG8_SB(b, h) + boff + n * 2048); } while (0)
#define PG8_LO(v) __builtin_bit_cast(bf16x8, __builtin_shufflevector((v), (v), 0, 1, 2, 3))
#define PG8_HI(v) __builtin_bit_cast(bf16x8, __builtin_shufflevector((v), (v), 4, 5, 6, 7))
#define PG8_MMA(ai, bj, At, Bt) do { __builtin_amdgcn_s_setprio(1); _Pragma("unroll") for (int m = 0; m < 4; ++m) _Pragma("unroll") for (int n = 0; n < 2; ++n) { \
        if constexpr (F8) { acc[ai][bj][m][n] = __builtin_amdgcn_mfma_scale_f32_16x16x128_f8f6f4(Bt[n], At[m], acc[ai][bj][m][n], 0, 0, 0, 0x7F7F7F7F, 0, 0x7F7F7F7F); } \
        else { acc[ai][bj][m][n] = __builtin_amdgcn_mfma_f32_16x16x32_bf16(PG8_LO(Bt[n]), PG8_LO(At[m]), acc[ai][bj][m][n], 0, 0, 0); \
               acc[ai][bj][m][n] = __builtin_amdgcn_mfma_f32_16x16x32_bf16(PG8_HI(Bt[n]), PG8_HI(At[m]), acc[ai][bj][m][n], 0, 0, 0); } } __builtin_amdgcn_s_setprio(0); } while (0)
#define PG8_WAIT_V(n) asm volatile("s_waitcnt vmcnt(" #n ")" ::: "memory")
#define PG8_WAIT_L(n) asm volatile("s_waitcnt lgkmcnt(" #n ")" ::: "memory")
#define PG8_BAR __builtin_amdgcn_s_barrier()
#define PG8_SCHED __builtin_amdgcn_sched_barrier(0)
#define PG8_VOFF(u, v00, v01, v10, v11) do { int _R0, _C0, _R1, _C1; stage_rc(tid * 16, _R0, _C0); stage_rc(tid * 16 + 8192, _R1, _C1); int _r00 = _R0, _r01 = _R1, _r10 = HALF + _R0, _r11 = HALF + _R1; \
        if ((u).gidx) { const GAS int* _gp = (const GAS int*)(u).gidx; const int _gc = (u).gcnt;     \
            const int _a = _gp[_r00 < _gc ? _r00 : 0] >> (u).gshift, _b = _gp[_r01 < _gc ? _r01 : 0] >> (u).gshift, _c = _gp[_r10 < _gc ? _r10 : 0] >> (u).gshift, _d = _gp[_r11 < _gc ? _r11 : 0] >> (u).gshift; \
            _r00 = _a; _r01 = _b; _r10 = _c; _r11 = _d; } \
        v00 = (unsigned)(_r00 * K + _C0) * 2u; v01 = (unsigned)(_r01 * K + _C1) * 2u; v10 = (unsigned)(_r10 * K + _C0) * 2u; v11 = (unsigned)(_r11 * K + _C1) * 2u; } while (0)
    UnitG cur, nxt; int ui = 0;
    if (!S.next(0, cur)) return;
    if constexpr (Sched::UNIFORMIZE) uniformize(cur);
    f32x4 acc[2][2][4][2];
#pragma unroll
    for (int a = 0; a < 2; ++a)
#pragma unroll
        for (int b = 0; b < 2; ++b)
#pragma unroll
            for (int m = 0; m < 4; ++m)
#pragma unroll
                for (int n = 0; n < 2; ++n) acc[a][b][m][n] = (f32x4){0.f, 0.f, 0.f, 0.f};
    v8i_t At[4], B0[2], B1[2];
    if constexpr (GATHER) PG8_VOFF(cur, vA[0][0], vA[0][1], vA[1][0], vA[1][1]);
    const char* cA = cur.A; const char* cB = cur.B;
    PG8_STB(0, 0, cB); PG8_STB(0, 1, cB); PG8_STA(0, 0, cA); PG8_STA(0, 1, cA);
    if (wr == 1) PG8_BAR;
    PG8_WAIT_V(2); PG8_BAR;
    PG8_STB(1, 0, cB + kstep); PG8_STA(1, 0, cA + kstep); PG8_STB(1, 1, cB + kstep);
    PG8_WAIT_V(6); PG8_BAR;
    for (;;) {
        const bool has_next = S.next(ui + 1, nxt);
        if constexpr (Sched::UNIFORMIZE) { if (has_next) uniformize(nxt); }
        const char* nA = cA; const char* nB = cB;
        if (has_next) { nA = nxt.A; nB = nxt.B; }
        if constexpr (GATHER) { u32x4 pv; pv.x = vA[0][0]; pv.y = vA[0][1]; pv.z = vA[1][0]; pv.w = vA[1][1];
            if (has_next) PG8_VOFF(nxt, pv.x, pv.y, pv.z, pv.w);
            *park = pv; }
#pragma unroll 1
        for (int t = 0; t < nt; t += 2) {
            const bool last = (t == nt - 2);
            const char* a1 = cA + (size_t)(t + 1) * kstep;
            const char* a2 = last ? nA : cA + (size_t)(t + 2) * kstep; const char* b2 = last ? nB : cB + (size_t)(t + 2) * kstep;
            const char* a3 = a2 + kstep; const char* b3 = b2 + kstep;
            PG8_LDB(B0, 0, 0); PG8_LDB(B1, 0, 1); PG8_SCHED; PG8_LDA(At, 0, 0); PG8_STA(1, 1, a1);
            PG8_WAIT_V(8); PG8_WAIT_L(0); PG8_BAR; PG8_MMA(0, 0, At, B0); PG8_MMA(0, 1, At, B1); PG8_BAR; PG8_SCHED;
            if constexpr (GATHER) { if (last) { const u32x4 pv = *park; vA[0][0] = pv.x; vA[0][1] = pv.y; vA[1][0] = pv.z; vA[1][1] = pv.w; } }
            PG8_LDA(At, 0, 1); PG8_STB(0, 0, b2); PG8_STB(0, 1, b2); PG8_STA(0, 0, a2);
            PG8_WAIT_V(8); PG8_WAIT_L(0); PG8_BAR; PG8_MMA(1, 0, At, B0); PG8_MMA(1, 1, At, B1); PG8_BAR; PG8_SCHED;
            PG8_LDB(B0, 1, 0); PG8_LDB(B1, 1, 1); PG8_SCHED; PG8_LDA(At, 1, 0); PG8_STA(0, 1, a2);
            PG8_WAIT_V(8); PG8_WAIT_L(0); PG8_BAR; PG8_MMA(0, 0, At, B0); PG8_MMA(0, 1, At, B1); PG8_BAR; PG8_SCHED;
            PG8_LDA(At, 1, 1); PG8_STB(1, 0, b3); PG8_STB(1, 1, b3); PG8_STA(1, 0, a3);
            PG8_WAIT_V(8); PG8_WAIT_L(0); PG8_BAR; PG8_MMA(1, 0, At, B0); PG8_MMA(1, 1, At, B1); PG8_BAR; PG8_SCHED;
        }
        if (wr == 0) PG8_BAR;
        { int l2; { unsigned o2 = ~0u; asm volatile("" : "+s"(o2)); l2 = (int)__builtin_amdgcn_mbcnt_hi(o2, __builtin_amdgcn_mbcnt_lo(o2, 0u)); }
          E(acc, cur, wr, wc, l2 & 15, l2 >> 4); }
        if (!has_next) break;
#pragma unroll
        for (int a = 0; a < 2; ++a)
#pragma unroll
            for (int b = 0; b < 2; ++b)
#pragma unroll
                for (int m = 0; m < 4; ++m)
#pragma unroll
                    for (int n = 0; n < 2; ++n) acc[a][b][m][n] = (f32x4){0.f, 0.f, 0.f, 0.f};
        cur = nxt; cA = nA; cB = nB; ++ui;
        if (wr == 1) PG8_BAR;
    }
    PG8_WAIT_V(0);
    PG8_BAR;
#undef PG8_SA
#undef PG8_SB
#undef PG8_STAGE
#undef PG8_STAGEU
#undef PG8_STB
#undef PG8_STA
#undef PG8_LDA
#undef PG8_LDB
#undef PG8_LD2
#undef PG8_LO
#undef PG8_HI
#undef PG8_MMA
#undef PG8_WAIT_V
#undef PG8_WAIT_L
#undef PG8_BAR
#undef PG8_SCHED
#undef PG8_VOFF
}
}

constexpr size_t MiB = 1u << 20;
constexpr size_t WS_CTL = 0, CTL_ZERO_BYTES = 1 * MiB;
constexpr size_t WS_ATT_IN_T = 1 * MiB;
constexpr size_t WS_ATT_OUT_T = WS_ATT_IN_T + 36 * MiB;
constexpr size_t WS_RET_IN_T = WS_ATT_OUT_T + 4 * MiB;
constexpr size_t WS_RET_OUT_T = WS_RET_IN_T + 12 * MiB;
constexpr size_t WS_GLU_T = WS_RET_OUT_T + 4 * MiB;
constexpr size_t WS_RT_HI = WS_GLU_T + 4 * MiB;
constexpr size_t WS_RT_LO = WS_RT_HI + 512 * 1024;
constexpr size_t WS_WMOE = WS_RT_HI + 1 * MiB;
constexpr size_t WMOE_E_BYTES = (size_t)(512 * 1024 + 1024 * 256) * 2;
constexpr size_t WS_X = WS_WMOE + 98 * MiB;
constexpr size_t WS_Y = WS_X + 64 * MiB;
constexpr size_t WS_XB = WS_Y + 64 * MiB;
constexpr size_t WS_BIG = WS_XB + 32 * MiB;
constexpr size_t WS_AUX = WS_BIG + 288 * MiB;
constexpr size_t WS_H = WS_AUX + 160 * MiB;
constexpr size_t WS_LIST = WS_H + 80 * MiB;
constexpr size_t WS_TRASH = WS_LIST + 8 * MiB;
constexpr size_t WS_END = WS_TRASH + 1 * MiB;
static_assert(WS_END <= 1024 * MiB, "workspace map");
constexpr int CW_BAR = 4096;
constexpr int CW_CNT = 16384;
constexpr int CW_CHK = 65536;
constexpr int HROWS = 163840;

#define XB_TMO      128
#define XB_XCNT(j)  (256  + 64 * (j))
#define XB_XSUB(j)  (1280 + 64 * (j))
#define XB_XGEN(j)  (2304 + 64 * (j))
#define XB_TOP      3328
#define XB_TOPGEN   3392
#define XCD_BAR_WORDS 3456
#define XB_SPIN_CAP (1u << 20)
__device__ __forceinline__ unsigned xb_ld(unsigned* p)              { return __hip_atomic_load(p, __ATOMIC_RELAXED, __HIP_MEMORY_SCOPE_AGENT); }
__device__ __forceinline__ unsigned xb_add(unsigned* p, unsigned v) { return __hip_atomic_fetch_add(p, v, __ATOMIC_RELAXED, __HIP_MEMORY_SCOPE_AGENT); }
__device__ __forceinline__ unsigned xb_xcc_id() { return (unsigned)__builtin_amdgcn_s_getreg((3 << 11) | 20) & 0xFu; }
#define XB_SPIN(cond, bar) do { unsigned _sp = 0; while (cond) { __builtin_amdgcn_s_sleep(1); \
    if ((++_sp & 255u) == 0u) { if (xb_ld(&(bar)[XB_TMO])) break; if (_sp > XB_SPIN_CAP) { atomicAdd(&(bar)[XB_TMO], 1u); break; } } } } while (0)
struct XcdBarrier { unsigned* bar; unsigned x; volatile LAS unsigned* st; };
__device__ __forceinline__ XcdBarrier xcd_barrier_post(unsigned* bar, volatile LAS unsigned* st) {
    XcdBarrier b; b.bar = bar; b.x = xb_xcc_id(); b.st = st;
    if (threadIdx.x == 0) (void)xb_add(&bar[XB_XCNT(b.x)], 1u);
    return b;
}
__device__ __forceinline__ void xcd_barrier_complete(unsigned* bar, unsigned x, unsigned& nloc, unsigned& nx) {
    const unsigned G = gridDim.x * gridDim.y * gridDim.z;
    unsigned sum, cnt, mine, sp = 0u;
    for (;;) {
        sum = 0u; cnt = 0u; mine = 0u;
#pragma unroll
        for (unsigned j = 0; j < 16; ++j) { const unsigned c = xb_ld(&bar[XB_XCNT(j)]); sum += c; cnt += (c > 0u) ? 1u : 0u; mine = (j == x) ? c : mine; }
        if (sum == G) break;
        __builtin_amdgcn_s_sleep(1);
        if ((++sp & 255u) == 0u) { if (xb_ld(&bar[XB_TMO])) break; if (sp > XB_SPIN_CAP) { atomicAdd(&bar[XB_TMO], 1u); break; } }
    }
    nloc = mine > 0u ? mine : 1u; nx = cnt > 0u ? cnt : 1u;
}
__device__ __forceinline__ void xcd_barrier(const XcdBarrier& b) {
    asm volatile("s_waitcnt vmcnt(0)" ::: "memory");
    __syncthreads();
    if (threadIdx.x == 0) {
        unsigned* bar = b.bar;
        __builtin_amdgcn_s_waitcnt(0);
        unsigned nloc = b.st[0], nx = b.st[1];
        if (nloc == 0u) { xcd_barrier_complete(bar, b.x, nloc, nx); b.st[0] = nloc; b.st[1] = nx; }
        const unsigned old = xb_add(&bar[XB_XSUB(b.x)], 1u);
        const unsigned gen = old / nloc;
        if (old + 1u == (gen + 1u) * nloc) {
            __builtin_amdgcn_fence(__ATOMIC_RELEASE, "agent");
            asm volatile("s_waitcnt vmcnt(0)" ::: "memory");
            const unsigned og = xb_add(&bar[XB_TOP], 1u);
            const unsigned tg = og / nx;
            if (og + 1u == (tg + 1u) * nx) xb_add(&bar[XB_TOPGEN], 1u);
            else XB_SPIN(xb_ld(&bar[XB_TOPGEN]) == tg, bar);
            __builtin_amdgcn_fence(__ATOMIC_ACQUIRE, "agent");
            xb_add(&bar[XB_XGEN(b.x)], 1u);
            asm volatile("s_waitcnt vmcnt(0)" ::: "memory");
        } else {
            XB_SPIN(xb_ld(&bar[XB_XGEN(b.x)]) == gen, bar);
            __builtin_amdgcn_fence(__ATOMIC_ACQUIRE, "agent");
            asm volatile("s_waitcnt vmcnt(0)" ::: "memory");
        }
    }
    __syncthreads();
}

constexpr int RING_BYTES = 139264;
constexpr int MISC_OFF = RING_BYTES;
constexpr int LDS_BYTES = 147456;
struct Params {
    const float* in[26]; float* out; unsigned char* ws; int ph_lo, ph_hi; int use_bar, pad;
};
typedef const __attribute__((address_space(4))) Params* KP;
__device__ __forceinline__ const float* gin(KP p, int i) { return (const float*)(const GAS float*)p->in[i]; }
__device__ __forceinline__ float* gout(KP p) { return (float*)(GAS float*)p->out; }
struct Frame {
    LAS unsigned char* lds; volatile LAS unsigned* MISC;
    int tid, lane, wave, vcu, G;
    unsigned char* ws;
};

template <bool F8_ = false> struct DenseSchedT {
    static constexpr bool GATHER = false, UNIFORMIZE = false, FP8 = F8_;
    const char* A; const char* Bt; int K, nM, nN, nwg, G, c;
    __device__ __forceinline__ void init(const void* A_, const void* Bt_, int M, int N, int K_, int G_, int c_) { A = (const char*)A_; Bt = (const char*)Bt_; K = K_; nM = M / 256; nN = N / 256; nwg = nM * nN; G = G_; c = c_; }
    __device__ __forceinline__ bool next(int i, pg8::UnitG& u) const {
        const long L = (long)i * G + c; if (L >= nwg) return false;
        int wgid = (int)L; { const int q = nwg / 8, r = nwg % 8, xcd = wgid % 8, off = wgid / 8; wgid = (xcd < r ? xcd * (q + 1) : r * (q + 1) + (xcd - r) * q) + off; }
        const int nig = 8 * nN, gid = wgid / nig, fm = gid * 8, gsz = (nM - fm) < 8 ? (nM - fm) : 8;
        const int pm = fm + ((wgid % nig) % gsz), pn = (wgid % nig) / gsz;
        u.A = A + (size_t)pm * 256 * K * 2; u.B = Bt + (size_t)pn * 256 * K * 2; u.gidx = nullptr; u.gcnt = 0; u.gshift = 0; u.row0 = pm * 256; u.col0 = pn * 256; u.aux = 0; return true;
    }
};
typedef DenseSchedT<false> DenseSched; typedef DenseSchedT<true> DenseSched8;
__device__ __forceinline__ u32x4 pack_bf16x8(const f32x4& v0, const f32x4& v1) { u32x4 w; w.x = pk2hw(v0[0], v0[1]); w.y = pk2hw(v0[2], v0[3]); w.z = pk2hw(v1[0], v1[1]); w.w = pk2hw(v1[2], v1[3]); return w; }

__device__ __forceinline__ unsigned pk4_fp8(float a, float b, float c, float d) {
    a = fminf(fmaxf(a, -448.0f), 448.0f); b = fminf(fmaxf(b, -448.0f), 448.0f); c = fminf(fmaxf(c, -448.0f), 448.0f); d = fminf(fmaxf(d, -448.0f), 448.0f);
    int w = 0; w = __builtin_amdgcn_cvt_pk_fp8_f32(a, b, w, false); w = __builtin_amdgcn_cvt_pk_fp8_f32(c, d, w, true); return (unsigned)w; }
constexpr float WUP_SCALE = 32.0f, WUP_INV = 1.0f / 32.0f;
struct EpiStoreBf16 {
    static constexpr bool PERM = true, PERM16 = false;
    bf16* O; int ldc; float osc, qsc;
    __device__ __forceinline__ void operator()(const f32x4 (&acc)[2][2][4][2], const pg8::UnitG& u, int wr, int wc, int fr, int fq) const {
        const float sc = ((u.col0 % 3072) < 1024) ? osc * qsc : osc;
#pragma unroll
        for (int ai = 0; ai < 2; ++ai)
#pragma unroll
            for (int m = 0; m < 4; ++m) { bf16* rowp = O + (size_t)(u.row0 + ai * 128 + wr * 64 + m * 16 + fr) * ldc + u.col0 + wc * 32 + 8 * fq;
#pragma unroll
                for (int bj = 0; bj < 2; ++bj) *(u32x4*)(rowp + bj * 128) = pack_bf16x8(acc[ai][bj][m][0] * sc, acc[ai][bj][m][1] * sc); }
    }
};
constexpr float YEXP_SCALE = 32.0f, YEXP_INV = 1.0f / 32.0f;
constexpr float A_SCALE = 16.0f;
constexpr float H_SCALE = 16.0f;
constexpr float Q8_SCALE = 64.0f, KV8_SCALE = 16.0f;
struct EpiStoreQkv8 {
    static constexpr bool PERM = false, PERM16 = true;
    unsigned char* O; int ldc;
    __device__ __forceinline__ void operator()(const f32x4 (&acc)[2][2][4][2], const pg8::UnitG& u, int wr, int wc, int fr, int fq) const {
        const float sc = ((u.col0 % 3072) < 1024) ? WUP_INV * 0.08838834764831845f * Q8_SCALE : WUP_INV * KV8_SCALE;
#pragma unroll
        for (int ai = 0; ai < 2; ++ai)
#pragma unroll
            for (int m = 0; m < 4; ++m) { unsigned char* rowp = O + (size_t)(u.row0 + ai * 128 + wr * 64 + m * 16 + fr) * ldc + u.col0 + wc * 64 + 16 * fq;
                u32x4 w;
#pragma unroll
                for (int q = 0; q < 4; ++q) { const f32x4 v = acc[ai][q >> 1][m][q & 1] * sc; w[q] = pk4_fp8(v[0], v[1], v[2], v[3]); }
                *(u32x4*)rowp = w; }
    }
};
struct EpiStoreFp8 {
    static constexpr bool PERM = false, PERM16 = true;
    unsigned char* O; int ldc;
    __device__ __forceinline__ void operator()(const f32x4 (&acc)[2][2][4][2], const pg8::UnitG& u, int wr, int wc, int fr, int fq) const {
#pragma unroll
        for (int ai = 0; ai < 2; ++ai)
#pragma unroll
            for (int m = 0; m < 4; ++m) { unsigned char* rowp = O + (size_t)(u.row0 + ai * 128 + wr * 64 + m * 16 + fr) * ldc + u.col0 + wc * 64 + 16 * fq;
                u32x4 w;
#pragma unroll
                for (int q = 0; q < 4; ++q) { f32x4 v = acc[ai][q >> 1][m][q & 1] * (YEXP_SCALE / (H_SCALE * WUP_SCALE));
#pragma unroll
                    for (int j = 0; j < 4; ++j) v[j] = fminf(fmaxf(v[j], -448.0f), 448.0f);
                    int d = 0; d = __builtin_amdgcn_cvt_pk_fp8_f32(v[0], v[1], d, false); d = __builtin_amdgcn_cvt_pk_fp8_f32(v[2], v[3], d, true); w[q] = (unsigned)d; }
                *(u32x4*)rowp = w; }
    }
};
struct EpiRetIn {
    static constexpr bool PERM = true, PERM16 = false;
    bf16* O; int ldc;
    __device__ __forceinline__ void operator()(const f32x4 (&acc)[2][2][4][2], const pg8::UnitG& u, int wr, int wc, int fr, int fq) const {
        float l2g = 0.f;
        float cs = WUP_INV;
        if (u.col0 < 2048) { const int h = (u.col0 & 1023) >> 8; const float g = 1.0f - exp2f(-5.0f - (float)h); l2g = log2f(g); if (u.col0 >= 1024) { l2g = -l2g; cs *= 0.0625f; } }
#pragma unroll
        for (int ai = 0; ai < 2; ++ai)
#pragma unroll
            for (int m = 0; m < 4; ++m) { const int row = u.row0 + ai * 128 + wr * 64 + m * 16 + fr; const float sc = exp2f(l2g * (float)(row & 127)) * cs;
                bf16* rowp = O + (size_t)row * ldc + u.col0 + wc * 32 + 8 * fq;
#pragma unroll
                for (int bj = 0; bj < 2; ++bj) *(u32x4*)(rowp + bj * 128) = pack_bf16x8(acc[ai][bj][m][0] * sc, acc[ai][bj][m][1] * sc); }
    }
};
__device__ __forceinline__ void unpack_bf16x8(const u32x4& w, f32x4& a, f32x4& b) { a[0] = bflo(w.x); a[1] = bfhi(w.x); a[2] = bflo(w.y); a[3] = bfhi(w.y); b[0] = bflo(w.z); b[1] = bfhi(w.z); b[2] = bflo(w.w); b[3] = bfhi(w.w); }
template <bool ALL16> struct EpiResidT {
    static constexpr bool PERM = true, PERM16 = false;
    const bf16* X; bf16* Y; float asc;
    __device__ __forceinline__ void operator()(const f32x4 (&acc)[2][2][4][2], const pg8::UnitG& u, int wr, int wc, int fr, int fq) const {
        constexpr int NB = ALL16 ? 1 : 2, PER = 2 / NB;
#pragma unroll
        for (int bt = 0; bt < NB; ++bt) {
            u32x4 xw[PER][4][2];
#pragma unroll
            for (int a2 = 0; a2 < PER; ++a2)
#pragma unroll
                for (int m = 0; m < 4; ++m) { const int ai = bt * PER + a2; const size_t off = (size_t)(u.row0 + ai * 128 + wr * 64 + m * 16 + fr) * D + u.col0 + wc * 32 + 8 * fq;
#pragma unroll
                    for (int bj = 0; bj < 2; ++bj) xw[a2][m][bj] = *(const u32x4*)(X + off + bj * 128); }
            asm volatile("" ::: "memory");
#pragma unroll
            for (int a2 = 0; a2 < PER; ++a2)
#pragma unroll
                for (int m = 0; m < 4; ++m) { const int ai = bt * PER + a2; const size_t off = (size_t)(u.row0 + ai * 128 + wr * 64 + m * 16 + fr) * D + u.col0 + wc * 32 + 8 * fq;
#pragma unroll
                    for (int bj = 0; bj < 2; ++bj) { f32x4 x0, x1; unpack_bf16x8(xw[a2][m][bj], x0, x1);
                        *(u32x4*)(Y + off + bj * 128) = pack_bf16x8(x0 * ALPHA + acc[ai][bj][m][0] * asc, x1 * ALPHA + acc[ai][bj][m][1] * asc); } }
            asm volatile("" ::: "memory");
        }
    }
};
typedef EpiResidT<true> EpiResid; typedef EpiResidT<false> EpiResid8;
struct EpiGluResid {
    static constexpr bool PERM = true, PERM16 = false;
    const bf16* X; bf16* Y; float asc;
    __device__ __forceinline__ void operator()(const f32x4 (&acc)[2][2][4][2], const pg8::UnitG& u, int wr, int wc, int fr, int fq) const {
        u32x4 xw[2][4];
#pragma unroll
        for (int ai = 0; ai < 2; ++ai)
#pragma unroll
            for (int m = 0; m < 4; ++m) { const size_t off = (size_t)(u.row0 + ai * 128 + wr * 64 + m * 16 + fr) * D + (u.col0 >> 1) + wc * 32 + 8 * fq; xw[ai][m] = *(const u32x4*)(X + off); }
        asm volatile("" ::: "memory");
#pragma unroll
        for (int ai = 0; ai < 2; ++ai)
#pragma unroll
            for (int m = 0; m < 4; ++m) { const size_t off = (size_t)(u.row0 + ai * 128 + wr * 64 + m * 16 + fr) * D + (u.col0 >> 1) + wc * 32 + 8 * fq;
                f32x4 x0, x1; unpack_bf16x8(xw[ai][m], x0, x1); f32x4 o0, o1;
#pragma unroll
                for (int j = 0; j < 4; ++j) { o0[j] = x0[j] * ALPHA + acc[ai][0][m][0][j] * asc * fsig(acc[ai][1][m][0][j] * asc); o1[j] = x1[j] * ALPHA + acc[ai][0][m][1][j] * asc * fsig(acc[ai][1][m][1][j] * asc); }
                *(u32x4*)(Y + off) = pack_bf16x8(o0, o1); }
    }
};
struct EpiMoeUp {
    static constexpr bool PERM = true, PERM16 = false;
    unsigned char* H;
    __device__ __forceinline__ void operator()(const f32x4 (&acc)[2][2][4][2], const pg8::UnitG& u, int wr, int wc, int fr, int fq) const {
        typedef unsigned u2_t __attribute__((ext_vector_type(2)));
#pragma unroll
        for (int ai = 0; ai < 2; ++ai) {
            u32x2 w8[4];
#pragma unroll
            for (int m = 0; m < 4; ++m) { f32x4 o[2];
#pragma unroll
                for (int n = 0; n < 2; ++n)
#pragma unroll
                    for (int j = 0; j < 4; ++j) { const float ga = acc[ai][0][m][n][j], ua = acc[ai][1][m][n][j];
                        o[n][j] = (ga * ua) * (WUP_INV * WUP_INV * H_SCALE) * __builtin_amdgcn_rcpf(1.0f + __builtin_amdgcn_exp2f(ga * (-WUP_INV * 1.4426950408889634f))); }
                w8[m].x = pk4_fp8(o[0][0], o[0][1], o[0][2], o[0][3]); w8[m].y = pk4_fp8(o[1][0], o[1][1], o[1][2], o[1][3]); }
            u32x4 s0, s1;
            { const u2_t a = __builtin_amdgcn_permlane16_swap(w8[0].x, w8[2].x, false, false), b = __builtin_amdgcn_permlane16_swap(w8[0].y, w8[2].y, false, false);
              s0.x = a.x; s0.y = b.x; s0.z = a.y; s0.w = b.y; }
            { const u2_t a = __builtin_amdgcn_permlane16_swap(w8[1].x, w8[3].x, false, false), b = __builtin_amdgcn_permlane16_swap(w8[1].y, w8[3].y, false, false);
              s1.x = a.x; s1.y = b.x; s1.z = a.y; s1.w = b.y; }
            const int mb = (fq & 1) ? 2 : 0;
            unsigned char* rowp = H + (size_t)(u.row0 + ai * 128 + wr * 64 + mb * 16 + fr) * ED + u.col0 + wc * 32 + 8 * (fq & 2);
            *(u32x4*)rowp = s0; *(u32x4*)(rowp + (size_t)16 * ED) = s1; }
    }
};

struct ConvD { const float* src; unsigned char* dst; unsigned char* dst2; int ldw, ldk, kind; };
__device__ __forceinline__ ConvD conv_mk8(const float* W, int ldw, unsigned char* WT, int ldk, int k0, int n0, int drow0) {
    ConvD d; d.src = W + (size_t)k0 * ldw + n0; d.dst = WT + (size_t)drow0 * ldk + k0; d.dst2 = nullptr; d.ldw = ldw; d.ldk = ldk; d.kind = 1; return d; }
__device__ __forceinline__ ConvD conv_mk16(const float* W, int ldw, bf16* WT, bf16* WTlo, int ldk, int k0, int n0, int drow0) {
    ConvD d; d.src = W + (size_t)k0 * ldw + n0; d.dst = (unsigned char*)(WT + (size_t)drow0 * ldk + k0); d.dst2 = WTlo ? (unsigned char*)(WTlo + (size_t)drow0 * ldk + k0) : nullptr; d.ldw = ldw; d.ldk = ldk * 2; d.kind = WTlo ? 2 : 0; return d; }
__device__ __forceinline__ void conv_load(const ConvD& d, int lane, f32x4 (&r)[8]) {
#pragma unroll
    for (int i = 0; i < 8; ++i) { const int kk = 8 * i + (lane >> 3), c4 = 4 * (lane & 7); r[i] = *(const f32x4*)(d.src + (size_t)kk * d.ldw + c4); }
}
template <bool HILO>
__device__ __forceinline__ void conv_finish(const ConvD& d, int lane, const f32x4 (&r)[8], LAS float* scr) {
    const float scale = (d.kind == 1) ? WUP_SCALE : 1.0f;
#pragma unroll
    for (int i = 0; i < 8; ++i) { const int kk = 8 * i + (lane >> 3), c4 = 4 * (lane & 7);
        scr[kk * 33 + c4] = r[i][0] * scale; scr[kk * 33 + c4 + 1] = r[i][1] * scale; scr[kk * 33 + c4 + 2] = r[i][2] * scale; scr[kk * 33 + c4 + 3] = r[i][3] * scale; }
    LDS_WAIT(); asm volatile("" ::: "memory");
    const int c = lane & 7;
#pragma unroll
    for (int j = 0; j < 4; ++j) { const int n = (lane >> 3) + 8 * j; const LAS float* s = scr + (8 * c) * 33 + n;
        float v[8];
#pragma unroll
        for (int q = 0; q < 8; ++q) v[q] = s[q * 33];
        if (d.kind == 1) { u32x2 o; o.x = pk4_fp8(v[0], v[1], v[2], v[3]); o.y = pk4_fp8(v[4], v[5], v[6], v[7]); *(u32x2*)(d.dst + (size_t)n * d.ldk + 8 * c) = o; }
        else { u32x4 o; o.x = pk2(v[0], v[1]); o.y = pk2(v[2], v[3]); o.z = pk2(v[4], v[5]); o.w = pk2(v[6], v[7]);
            *(u32x4*)(d.dst + (size_t)n * d.ldk + 16 * c) = o;
            if (HILO) { float rr[8];
#pragma unroll
                for (int q = 0; q < 8; ++q) rr[q] = v[q] - bf2f(f2bf(v[q]));
                u32x4 o2; o2.x = pk2(rr[0], rr[1]); o2.y = pk2(rr[2], rr[3]); o2.z = pk2(rr[4], rr[5]); o2.w = pk2(rr[6], rr[7]);
                *(u32x4*)(d.dst2 + (size_t)n * d.ldk + 16 * c) = o2; } } }
    LDS_WAIT(); asm volatile("" ::: "memory");
}
__device__ __forceinline__ void conv_dma(const ConvD& d, int lane, LAS float* buf) {
#pragma unroll
    for (int i = 0; i < 8; ++i) { const float* g = d.src + (size_t)(8 * i + (lane >> 3)) * d.ldw + 4 * ((lane & 7) ^ i);
        __builtin_amdgcn_global_load_lds((const unsigned*)g, (LAS unsigned*)(buf + i * 256), 16, 0, 0); }
}
__device__ __forceinline__ void conv_finish_lds(const ConvD& d, int lane, const LAS float* buf) {
    const float scale = (d.kind == 1) ? WUP_SCALE : 1.0f;
    const int c = lane & 7;
#pragma unroll
    for (int j = 0; j < 4; ++j) { const int n = (lane >> 3) + 8 * j; const LAS float* s = buf + (8 * c) * 32 + (((n >> 2) ^ c) & 7) * 4 + (n & 3);
        float v[8];
#pragma unroll
        for (int q = 0; q < 8; ++q) v[q] = s[q * 32] * scale;
        if (d.kind == 1) { u32x2 o; o.x = pk4_fp8(v[0], v[1], v[2], v[3]); o.y = pk4_fp8(v[4], v[5], v[6], v[7]); *(u32x2*)(d.dst + (size_t)n * d.ldk + 8 * c) = o; }
        else { u32x4 o; o.x = pk2(v[0], v[1]); o.y = pk2(v[2], v[3]); o.z = pk2(v[4], v[5]); o.w = pk2(v[6], v[7]); *(u32x4*)(d.dst + (size_t)n * d.ldk + 16 * c) = o; } }
    LDS_WAIT(); asm volatile("" ::: "memory");
}
#define CONV_RUN(NIT, DEC) do { int it_ = gw; if (it_ < (NIT)) { ConvD dc_ = DEC(it_); int par_ = 0; conv_dma(dc_, F.lane, scr); asm volatile("s_waitcnt vmcnt(0)" ::: "memory"); \
        for (; it_ < (NIT); it_ += NGW) { const int itn_ = (it_ + NGW < (NIT)) ? it_ + NGW : it_; const ConvD dn_ = DEC(itn_); conv_dma(dn_, F.lane, scr + (par_ ^ 1) * 2048);     \
            asm volatile("s_waitcnt vmcnt(12)" ::: "memory"); conv_finish_lds(dc_, F.lane, scr + par_ * 2048); dc_ = dn_; par_ ^= 1; } \
        asm volatile("s_waitcnt vmcnt(0)" ::: "memory"); } } while (0)
__device__ __forceinline__ ConvD conv_dec_mixers(KP p, unsigned char* ws, int it) {
    constexpr int I_AIN = 16 * 288, I_AOUT = 16 * 32, I_RIN = 16 * 192, I_ROUT = 32 * 32, I_GLU = 16 * 64, I_RT = 16 * 2;
    int r = it;
    if (r < 2 * I_AIN) { const int j = r / I_AIN; r %= I_AIN; const int kb = r / 288, nb = r % 288, n0 = nb * 32;
        return conv_mk8(gin(p, 1) + (size_t)j * D * ATT_IN, ATT_IN, (unsigned char*)(ws + WS_ATT_IN_T) + (size_t)j * ATT_IN * D, D, kb * 64, n0, n0); }
    r -= 2 * I_AIN;
    if (r < 2 * I_AOUT) { const int j = r / I_AOUT; r %= I_AOUT; const int kb = r / 32, nb = r % 32, n0 = nb * 32;
        return conv_mk8(gin(p, 2) + (size_t)j * D * D, D, (unsigned char*)(ws + WS_ATT_OUT_T) + (size_t)j * D * D, D, kb * 64, n0, n0); }
    r -= 2 * I_AOUT;
    if (r < I_RIN) { const int kb = r / 192, nb = r % 192, n0 = nb * 32;
        return conv_mk8(gin(p, 3), RET_IN, (unsigned char*)(ws + WS_RET_IN_T), D, kb * 64, n0, n0); }
    r -= I_RIN;
    if (r < I_ROUT) { const int kb = r / 32, nb = r % 32, n0 = nb * 32;
        return conv_mk8(gin(p, 6), D, (unsigned char*)(ws + WS_RET_OUT_T), RET_V, kb * 64, n0, n0); }
    r -= I_ROUT;
    if (r < I_GLU) { const int kb = r / 64, nb = r % 64, n0 = nb * 32; const int c = n0 & 1023, drow = (c >> 7) * 256 + (n0 >> 10) * 128 + (c & 127);
        return conv_mk8(gin(p, 15), 2 * D, (unsigned char*)(ws + WS_GLU_T), D, kb * 64, n0, drow); }
    r -= I_GLU;
    { const int l = r / I_RT; r %= I_RT; const int kb = r / 2, nb = r % 2, n0 = nb * 32;
        return conv_mk16(gin(p, 16) + (size_t)l * D * NE, NE, (bf16*)(ws + WS_RT_HI) + (size_t)l * NE * D, (bf16*)(ws + WS_RT_LO) + (size_t)l * NE * D, D, kb * 64, n0, n0); }
}
__device__ __forceinline__ ConvD conv_dec_moe(KP p, unsigned char* ws, int l, int it) {
    const int e = it / 384, r = it % 384, which = r >> 7, rr = r & 127;
    bf16* We = (bf16*)(ws + WS_WMOE + (size_t)e * WMOE_E_BYTES);
    if (which < 2) { const float* src = (e < 64) ? gin(p, 18 + which) + ((size_t)l * NE + e) * D * ED : gin(p, 21 + which) + (size_t)l * D * ED;
        const int kb = rr >> 3, nb = rr & 7, n0 = nb * 32; const int drow = (n0 >> 7) * 256 + which * 128 + (n0 & 127);
        return conv_mk8(src, ED, (unsigned char*)We, D, kb * 64, n0, drow); }
    const float* src = (e < 64) ? gin(p, 20) + ((size_t)l * NE + e) * ED * D : gin(p, 23) + (size_t)l * ED * D;
    const int kb = rr >> 5, nb = rr & 31, n0 = nb * 32;
    return conv_mk8(src, D, (unsigned char*)(We + 512 * 1024), ED, kb * 64, n0, n0);
}
__device__ __forceinline__ void phase_conv_mixers(const Frame& F, KP p) {
    LAS float* scr = (LAS float*)(F.lds + F.wave * 16384);
    const int gw = F.vcu * NWAVES + F.wave, NGW = F.G * NWAVES;
    constexpr int NMAIN = 2 * (16 * 288) + 2 * (16 * 32) + 16 * 192 + 32 * 32 + 16 * 64, NRT = 4 * (16 * 2);
    unsigned char* ws = F.ws;
#define CONV_DEC_MIX(i_) conv_dec_mixers(p, ws, (i_))
    CONV_RUN(NMAIN, CONV_DEC_MIX);
    for (int it = NMAIN + gw; it < NMAIN + NRT; it += NGW) { const ConvD d = conv_dec_mixers(p, ws, it); f32x4 r[8]; conv_load(d, F.lane, r); conv_finish<true>(d, F.lane, r, scr); }
#undef CONV_DEC_MIX
}
__device__ __forceinline__ void phase_conv_moe(const Frame& F, KP p, int l) {
    LAS float* scr = (LAS float*)(F.lds + F.wave * 16384);
    const int gw = F.vcu * NWAVES + F.wave, NGW = F.G * NWAVES;
    unsigned char* ws = F.ws;
#define CONV_DEC_MOE(i_) conv_dec_moe(p, ws, l, (i_))
    CONV_RUN(65 * 384, CONV_DEC_MOE);
#undef CONV_DEC_MOE
}

__device__ __forceinline__ void phase_lnr(const Frame& F, KP p, int layer, bool dry = false) {
    const bf16* Y = (const bf16*)(F.ws + WS_Y); bf16* XB = (bf16*)(F.ws + WS_XB); unsigned char* XB8 = (unsigned char*)(F.ws + WS_X);
    const float* lng = gin(p, 24) + (size_t)(layer * 2) * D; const float* lnb = gin(p, 25) + (size_t)(layer * 2) * D;
    const bf16* rthi = (const bf16*)(F.ws + WS_RT_HI) + (size_t)layer * NE * D; const bf16* rtlo = (const bf16*)(F.ws + WS_RT_LO) + (size_t)layer * NE * D;
    const float* rbias = gin(p, 17) + layer * NE;
    unsigned* cnt = (unsigned*)(F.ws + WS_CTL) + CW_CNT + layer * NE * 64;
    int* lists = (int*)(F.ws + WS_LIST); int* tokmap = (int*)(F.ws + WS_LIST + 4 * MiB); float* tokgate = (float*)(F.ws + WS_LIST + 5 * MiB);
    constexpr int XLD = 1032, MAXT = 8;
    LAS bf16* Xhi = (LAS bf16*)F.lds; LAS bf16* Xlo = Xhi + 16 * XLD;
    LAS float* part = (LAS float*)(F.lds + 2 * 16 * XLD * 2);
    LAS int* ent = (LAS int*)(part + 2 * 16 * 64);
    LAS int* hist = ent + MAXT * 16 * 8 * 2; LAS int* base = hist + 64;
    const int lane = F.lane, w = F.wave, g4 = lane >> 4, l15 = lane & 15;
    if (F.tid < 64) hist[F.tid] = 0;
    bf16x8 bhi[16], blo[16];
    { const int nt = w & 3, kh = w >> 2; const bf16* bh = rthi + (size_t)(16 * nt + l15) * D + 512 * kh + 8 * g4; const bf16* bl = rtlo + (size_t)(16 * nt + l15) * D + 512 * kh + 8 * g4;
#pragma unroll
        for (int ks = 0; ks < 16; ++ks) { bhi[ks] = *(const bf16x8*)(bh + 32 * ks); blo[ks] = *(const bf16x8*)(bl + 32 * ks); } }
    u32x4 ypre[2][2];
    if (F.vcu < T / 16) {
#pragma unroll
        for (int rr = 0; rr < 2; ++rr)
#pragma unroll
            for (int j = 0; j < 2; ++j) ypre[rr][j] = *(const u32x4*)(Y + (size_t)(F.vcu * 16 + 2 * w + rr) * D + 8 * lane + 512 * j); }
    int ntile = 0;
    for (int tile = F.vcu; tile < T / 16 && ntile < MAXT; tile += F.G, ++ntile) {
        const int t0 = tile * 16;
        u32x4 ycur[2][2];
#pragma unroll
        for (int rr = 0; rr < 2; ++rr)
#pragma unroll
            for (int j = 0; j < 2; ++j) ycur[rr][j] = ypre[rr][j];
        if (tile + F.G < T / 16) {
#pragma unroll
            for (int rr = 0; rr < 2; ++rr)
#pragma unroll
                for (int j = 0; j < 2; ++j) ypre[rr][j] = *(const u32x4*)(Y + (size_t)((tile + F.G) * 16 + 2 * w + rr) * D + 8 * lane + 512 * j); }
#pragma unroll
        for (int rr = 0; rr < 2; ++rr) {
            const int lr = 2 * w + rr; const size_t row = (size_t)(t0 + lr);
            f32x4 v[4]; float s = 0.f;
#pragma unroll
            for (int j = 0; j < 2; ++j) unpack_bf16x8(ycur[rr][j], v[2 * j], v[2 * j + 1]);
#pragma unroll
            for (int j = 0; j < 4; ++j) s += (v[j][0] + v[j][1]) + (v[j][2] + v[j][3]);
            const float mean = wave_sum(s, lane) * (1.f / D); float s2 = 0.f;
#pragma unroll
            for (int j = 0; j < 4; ++j) { v[j] = v[j] - mean; s2 += (v[j][0] * v[j][0] + v[j][1] * v[j][1]) + (v[j][2] * v[j][2] + v[j][3] * v[j][3]); }
            const float rstd = 1.0f / sqrtf(wave_sum(s2, lane) * (1.f / D) + LN_EPS);
#pragma unroll
            for (int j = 0; j < 2; ++j) { const f32x4 g0 = *(const f32x4*)(lng + 8 * lane + 512 * j), g1 = *(const f32x4*)(lng + 8 * lane + 512 * j + 4), b0 = *(const f32x4*)(lnb + 8 * lane + 512 * j), b1 = *(const f32x4*)(lnb + 8 * lane + 512 * j + 4);
                const f32x4 o0 = v[2 * j] * rstd * g0 + b0, o1 = v[2 * j + 1] * rstd * g1 + b1;
                const u32x4 hi = pack_bf16x8(o0, o1);
                *(u32x4*)(XB + row * D + 8 * lane + 512 * j) = hi;
                { u32x2 q8; q8.x = pk4_fp8(o0[0], o0[1], o0[2], o0[3]); q8.y = pk4_fp8(o1[0], o1[1], o1[2], o1[3]); *(u32x2*)(XB8 + row * D + 8 * lane + 512 * j) = q8; }
                f32x4 h0, h1; unpack_bf16x8(hi, h0, h1); const u32x4 lo = pack_bf16x8(o0 - h0, o1 - h1);
                *(LAS u32x4*)(Xhi + lr * XLD + 8 * lane + 512 * j) = hi; *(LAS u32x4*)(Xlo + lr * XLD + 8 * lane + 512 * j) = lo; }
        }
        __syncthreads();
        { const int nt = w & 3, kh = w >> 2; f32x4 a0 = (f32x4){0.f, 0.f, 0.f, 0.f}, a1 = a0, a2 = a0, a3 = a0, a4 = a0, a5 = a0;
#pragma unroll
            for (int ks = 0; ks < 16; ks += 2) { const int k0 = 512 * kh + 32 * ks;
                const bf16x8 ahi = row_frag(Xhi, XLD, 0, k0, lane), alo = row_frag(Xlo, XLD, 0, k0, lane), bhi2 = row_frag(Xhi, XLD, 0, k0 + 32, lane), blo2 = row_frag(Xlo, XLD, 0, k0 + 32, lane);
                a0 = MFMA16(ahi, bhi[ks], a0); a1 = MFMA16(alo, bhi[ks], a1); a2 = MFMA16(ahi, blo[ks], a2);
                a3 = MFMA16(bhi2, bhi[ks + 1], a3); a4 = MFMA16(blo2, bhi[ks + 1], a4); a5 = MFMA16(bhi2, blo[ks + 1], a5); }
            const f32x4 acc = ((a0 + a3) + (a1 + a4)) + (a2 + a5);
#pragma unroll
            for (int i = 0; i < 4; ++i) part[(kh * 16 + 4 * g4 + i) * 64 + 16 * nt + l15] = acc[i];
        }
        __syncthreads();
#pragma unroll
        for (int rr = 0; rr < 2; ++rr) {
            const int lt = ntile * 16 + 2 * w + rr;
            const float lg = part[(2 * w + rr) * 64 + lane] + part[(16 + 2 * w + rr) * 64 + lane];
            float sc = fsig(lg); sc = (sc == sc) ? sc : 0.5f;
            const float sel = sc + rbias[lane];
            const float m1 = max8(sel);
            const unsigned long long eq = __ballot(sel == m1);
            const unsigned gm = (unsigned)(eq >> (lane & 56)) & 0xffu;
            const int first = (lane & 56) + __builtin_ctz(gm | 0x100u);
            const float m2 = max8((lane == first) ? -INFINITY : sel);
            const float gs = m1 + m2; const int mygrp = lane >> 3; int grank = 0;
#pragma unroll
            for (int gg = 0; gg < 8; ++gg) { const float o = rdl(gs, 8 * gg); grank += (o > gs || (o == gs && gg < mygrp)) ? 1 : 0; }
            const float mv = (grank < 4) ? sel : -INFINITY;
            unsigned key = __builtin_bit_cast(unsigned, mv); key = (key >> 31) ? ~key : (key | 0x80000000u); key = (key & ~63u) | (unsigned)(63 - lane);
            int rank = 64; { unsigned kw = key;
#pragma unroll
                for (int r = 0; r < TOPK; ++r) { const unsigned m = wave_umax(kw); if (kw == m) { rank = r; kw = 0u; } } }
            const bool chosen = rank < TOPK;
            const float wsum = wave_sum(chosen ? sc : 0.f, lane);
            if (chosen) { const int lpos = __hip_atomic_fetch_add(hist + lane, 1, __ATOMIC_RELAXED, __HIP_MEMORY_SCOPE_WORKGROUP);
                ent[(lt * 8 + rank) * 2] = (lane << 16) | lpos; ent[(lt * 8 + rank) * 2 + 1] = __builtin_bit_cast(int, sc * __builtin_amdgcn_rcpf(wsum) * 2.5f); }
        }
    }
    __syncthreads();
    if (dry) return;
    if (F.tid < 64) { const int hcount = hist[F.tid]; base[F.tid] = hcount ? (int)atomicAdd(cnt + F.tid * 64, (unsigned)hcount) : 0; }
    __syncthreads();
    for (int idx = F.tid; idx < ntile * 16 * 8; idx += NTHREADS) {
        const int ev = ent[idx * 2], gb = ent[idx * 2 + 1]; const int e = ev >> 16, pos = base[e] + (ev & 0xffff);
        const int lt = idx >> 3, rank = idx & 7, tok = (F.vcu + (lt >> 4) * F.G) * 16 + (lt & 15);
        lists[(size_t)e * T + pos] = tok; tokmap[tok * 8 + rank] = (e << 16) | pos; tokgate[tok * 8 + rank] = __builtin_bit_cast(float, gb);
    }
}

__device__ __forceinline__ void phase_combine(const Frame& F, KP p, int layer, bool dry = false) {
    bf16* XB = (bf16*)(F.ws + WS_XB); const unsigned char* yexp = (const unsigned char*)(F.ws + WS_BIG);
    const int* tokmap = (const int*)(F.ws + WS_LIST + 4 * MiB); const float* tokgate = (const float*)(F.ws + WS_LIST + 5 * MiB);
    const volatile LAS int* tstart = (const volatile LAS int*)(F.MISC + 64);
    const float* lng = gin(p, 24) + (size_t)(layer * 2 + 1) * D; const float* lnb = gin(p, 25) + (size_t)(layer * 2 + 1) * D;
    float* outp = gout(p); bf16* xbo = XB; if (dry) { outp = (float*)(F.ws + WS_AUX); xbo = (bf16*)(F.ws + WS_H); }
    const int lane = F.lane, gw = F.vcu * NWAVES + F.wave, NGW = F.G * NWAVES;
    const bf16* ysh = (const bf16*)(F.ws + WS_Y);
    f32x4 gv[4], bv[4];
#pragma unroll
    for (int j = 0; j < 4; ++j) { gv[j] = *(const f32x4*)(lng + 16 * lane + 4 * j); bv[j] = *(const f32x4*)(lnb + 16 * lane + 4 * j); }
    for (int row = gw; row < T; row += NGW) {
        const int mk = tokmap[row * 8 + (lane & 7)]; const float gk = tokgate[row * 8 + (lane & 7)] * YEXP_INV;
        const int rk = (int)tstart[mk >> 16] * 256 + (mk & 0xffff);
        f32x4 v[4];
#pragma unroll
        for (int j = 0; j < 2; ++j) { const u32x4 xw = *(const u32x4*)(ysh + (size_t)row * D + 16 * lane + 8 * j); unpack_bf16x8(xw, v[2 * j], v[2 * j + 1]); }
#pragma unroll
        for (int k = 0; k < TOPK; ++k) { const int r = __builtin_amdgcn_readlane(rk, k); const float g = rdl(gk, k);
            const u32x4 s = *(const u32x4*)(yexp + (size_t)r * D + 16 * lane);
#pragma unroll
            for (int j = 0; j < 4; ++j) { const f32x2 lo = __builtin_amdgcn_cvt_pk_f32_fp8((int)s[j], false), hi = __builtin_amdgcn_cvt_pk_f32_fp8((int)s[j], true);
                v[j][0] += g * lo[0]; v[j][1] += g * lo[1]; v[j][2] += g * hi[0]; v[j][3] += g * hi[1]; } }
        float s = 0.f;
#pragma unroll
        for (int j = 0; j < 4; ++j) s += (v[j][0] + v[j][1]) + (v[j][2] + v[j][3]);
        const float mean = wave_sum(s, lane) * (1.f / D); float s2 = 0.f;
#pragma unroll
        for (int j = 0; j < 4; ++j) { v[j] = v[j] - mean; s2 += (v[j][0] * v[j][0] + v[j][1] * v[j][1]) + (v[j][2] * v[j][2] + v[j][3] * v[j][3]); }
        const float rstd = 1.0f / sqrtf(wave_sum(s2, lane) * (1.f / D) + LN_EPS);
        f32x4 o[4];
#pragma unroll
        for (int j = 0; j < 4; ++j) o[j] = v[j] * rstd * gv[j] + bv[j];
        if (layer == DEPTH - 1 || dry) {
#pragma unroll
            for (int j = 0; j < 4; ++j) *(f32x4*)(outp + (size_t)row * D + 16 * lane + 4 * j) = o[j]; }
        if (layer != DEPTH - 1) { *(u32x4*)(xbo + (size_t)row * D + 16 * lane) = pack_bf16x8(o[0], o[1]); *(u32x4*)(xbo + (size_t)row * D + 16 * lane + 8) = pack_bf16x8(o[2], o[3]);
            if (!dry) { u32x4 q8; q8.x = pk4_fp8(o[0][0], o[0][1], o[0][2], o[0][3]); q8.y = pk4_fp8(o[1][0], o[1][1], o[1][2], o[1][3]); q8.z = pk4_fp8(o[2][0], o[2][1], o[2][2], o[2][3]); q8.w = pk4_fp8(o[3][0], o[3][1], o[3][2], o[3][3]);
                *(u32x4*)((unsigned char*)(F.ws + WS_X) + (size_t)row * D + 16 * lane) = q8; } }
    }
}

constexpr size_t AUX_OB = 96 * MiB, AUX_LSE = 128 * MiB;
__device__ __forceinline__ unsigned att_qoff(int R, int j, int qi, int g4) {
    const int h = R & 7, sbr = R >> 3, g = sbr >> 5, rem = sbr & 31, b = rem >> 4, rr_ = rem & 15;
    const int dsh = 2 * g, d = 1 << dsh, nrs = 4 - dsh, r = rr_ >> nrs, n = 4 * (rr_ & ((1 << nrs) - 1)) + j;
    const unsigned qrow = (unsigned)b * SEQ + (unsigned)(128 * n + qi) * (unsigned)d + (unsigned)r;
    return qrow * (unsigned)ATT_IN + (unsigned)(g * 3072 + h * 128 + 8 * g4);
}
__device__ __forceinline__ void phase_attn(const Frame& F, int bx) {
    const unsigned char* qkv = (const unsigned char*)(F.ws + WS_BIG); bf16* og = (bf16*)(F.ws + WS_AUX); float* lse = (float*)(F.ws + WS_AUX + AUX_LSE);
    constexpr int KLD = 136;
    LAS bf16* Ks = (LAS bf16*)F.lds; LAS bf16* Vs = Ks + 256 * KLD;
    const int lane = F.lane, w = F.wave, g4 = lane >> 4, l15 = lane & 15, qq = l15 >> 2, pp = lane & 3;
    u32x4 kc[2], vc[2];
    constexpr int NRUN = 768;
#define ATT_CVT8(lo_, hi_) ({ const f32x2 a_ = __builtin_amdgcn_cvt_pk_f32_fp8((int)(lo_), false), b_ = __builtin_amdgcn_cvt_pk_f32_fp8((int)(lo_), true), c_ = __builtin_amdgcn_cvt_pk_f32_fp8((int)(hi_), false), d_ = __builtin_amdgcn_cvt_pk_f32_fp8((int)(hi_), true); \
        u32x4 r_; r_.x = pk2(a_[0], a_[1]); r_.y = pk2(b_[0], b_[1]); r_.z = pk2(c_[0], c_[1]); r_.w = pk2(d_[0], d_[1]); r_; })
#define ATT_LOADBLK(KR, VR, nblk) do { _Pragma("unroll") for (int it = 0; it < 2; ++it) { const int idx = F.tid + 512 * it, c = idx >> 3, ch = idx & 7; int pos = 128 * (nblk) + c; pos = pos < 0 ? 0 : pos; \
            const unsigned so = (rowbase + (unsigned)pos * (unsigned)d + (unsigned)r) * (unsigned)ATT_IN + (unsigned)(g * 3072 + 1024 + h * 128 + ch * 16); KR[it] = *(const u32x4*)(qkv + so); VR[it] = *(const u32x4*)(qkv + so + 1024u); } } while (0)
#define ATT_STOREBLK(KR, VR, slot) do { _Pragma("unroll") for (int it = 0; it < 2; ++it) { const int idx = F.tid + 512 * it, c = idx >> 3, ch = idx & 7; \
            *(LAS u32x4*)(Ks + (128 * (slot) + c) * KLD + ch * 16) = ATT_CVT8(KR[it].x, KR[it].y); *(LAS u32x4*)(Ks + (128 * (slot) + c) * KLD + ch * 16 + 8) = ATT_CVT8(KR[it].z, KR[it].w); \
            *(LAS u32x4*)(Vs + (128 * (slot) + c) * KLD + ch * 16) = ATT_CVT8(VR[it].x, VR[it].y); *(LAS u32x4*)(Vs + (128 * (slot) + c) * KLD + ch * 16 + 8) = ATT_CVT8(VR[it].z, VR[it].w); } } while (0)
    const int qi = 16 * w + l15;
    u32x2 qraw[4];
    if (bx < NRUN) { const unsigned qo = att_qoff(bx, 0, qi, g4);
#pragma unroll
        for (int s = 0; s < 4; ++s) qraw[s] = *(const u32x2*)(qkv + qo + 32 * s); }
    for (int R = bx; R < NRUN; R += F.G) {
        const int h = R & 7, sbr = R >> 3, g = sbr >> 5, rem = sbr & 31, b = rem >> 4, rr_ = rem & 15;
        const int dsh = 2 * g, d = 1 << dsh, nrs = 4 - dsh, r = rr_ >> nrs, n0 = 4 * (rr_ & ((1 << nrs) - 1)); const unsigned rowbase = (unsigned)b * SEQ;
        { u32x4 k0[2], v0[2]; ATT_LOADBLK(k0, v0, n0 - 1); ATT_LOADBLK(kc, vc, n0); ATT_STOREBLK(k0, v0, (n0 - 1) & 1); }
#pragma unroll 1
        for (int j = 0; j < 4; ++j) {
            const int n = n0 + j, cs = n & 1, ps = cs ^ 1;
            ATT_STOREBLK(kc, vc, cs);
            const unsigned qrow = rowbase + (unsigned)(128 * n + qi) * (unsigned)d + (unsigned)r;
            bf16x8 qf[4];
#pragma unroll
            for (int s = 0; s < 4; ++s) qf[s] = __builtin_bit_cast(bf16x8, ATT_CVT8(qraw[s].x, qraw[s].y));
            __syncthreads();
            if (j < 3) { ATT_LOADBLK(kc, vc, n + 1); }
            __builtin_amdgcn_sched_barrier(0);
            const int ws0 = (16 * w < 96) ? 16 * w : 96;
#define ATT_PROW(c0) (((c0) < 128) ? (128 * ps + (c0)) : (128 * cs + (c0) - 128))
            f32x4 sacc[10];
            {
                bf16x8 kfa[4], kfb[4];
#pragma unroll
                for (int s = 0; s < 4; ++s) kfa[s] = row_frag(Ks, KLD, ATT_PROW(ws0), 32 * s, lane);
#pragma unroll
                for (int t = 0; t < 10; t += 2) {
#pragma unroll
                    for (int s = 0; s < 4; ++s) kfb[s] = row_frag(Ks, KLD, ATT_PROW(ws0 + 16 * (t + 1)), 32 * s, lane);
                    __builtin_amdgcn_sched_barrier(0);
                    sacc[t] = (f32x4){0.f, 0.f, 0.f, 0.f};
#pragma unroll
                    for (int s = 0; s < 4; ++s) sacc[t] = MFMA16(kfa[s], qf[s], sacc[t]);
                    if (t + 2 < 10) {
#pragma unroll
                        for (int s = 0; s < 4; ++s) kfa[s] = row_frag(Ks, KLD, ATT_PROW(ws0 + 16 * (t + 2)), 32 * s, lane); }
                    __builtin_amdgcn_sched_barrier(0);
                    sacc[t + 1] = (f32x4){0.f, 0.f, 0.f, 0.f};
#pragma unroll
                    for (int s = 0; s < 4; ++s) sacc[t + 1] = MFMA16(kfb[s], qf[s], sacc[t + 1]);
                }
            }
            { const int Rn = (j < 3) ? R : ((R + F.G < NRUN) ? R + F.G : R), jn = (j < 3) ? j + 1 : 0; const unsigned qo = att_qoff(Rn, jn, qi, g4);
#pragma unroll
              for (int s = 0; s < 4; ++s) qraw[s] = *(const u32x2*)(qkv + qo + 32 * s); }
            const float slope = exp2f(-(float)(h + 1)) * (float)d;
            float mx = -INFINITY;
            int sbase = 128 + qi - ws0 - 4 * g4; asm volatile("" : "+v"(sbase));
            const float nsb = -slope * (float)sbase; const int kmin = (n > 0) ? sbase - 128 : ((sbase - 128 > 128 - ws0 - 4 * g4) ? sbase - 128 : 128 - ws0 - 4 * g4);
#pragma unroll
            for (int t = 0; t < 10; ++t)
#pragma unroll
                for (int i = 0; i < 4; ++i) { const int k = 16 * t + i;
                    const bool valid = (k <= sbase) && (k >= kmin);
                    const float v = valid ? __builtin_fmaf(slope, (float)k, __builtin_fmaf(sacc[t][i], 1.0f / (Q8_SCALE * KV8_SCALE), nsb)) : -INFINITY; sacc[t][i] = v; mx = fmaxf(mx, v); }
            mx = fmaxf(mx, shx(mx, 16, lane)); mx = fmaxf(mx, shx(mx, 32, lane));
            float lsum = 0.f;
#pragma unroll
            for (int t = 0; t < 10; ++t)
#pragma unroll
                for (int i = 0; i < 4; ++i) { const float pv = __expf(sacc[t][i] - mx); sacc[t][i] = pv; lsum += pv; }
            lsum += shx(lsum, 16, lane); lsum += shx(lsum, 32, lane);
            bf16x8 pf[5];
#pragma unroll
            for (int kt = 0; kt < 5; ++kt) pf[kt] = pack8(sacc[2 * kt], sacc[2 * kt + 1]);
            f32x4 o[8];
            {
                const LAS bf16* vl = Vs + (4 * g4 + qq) * KLD + 32 * pp;
                bf16x4 va[10], vcc[10];
#pragma unroll
                for (int q = 0; q < 10; ++q) va[q] = tr4(vl + ATT_PROW(ws0 + 16 * q) * KLD);
#pragma unroll
                for (int et = 0; et < 8; et += 2) {
#pragma unroll
                    for (int q = 0; q < 10; ++q) vcc[q] = tr4(vl + ATT_PROW(ws0 + 16 * q) * KLD + 4 * (et + 1));
                    __builtin_amdgcn_sched_barrier(0);
                    o[et] = (f32x4){0.f, 0.f, 0.f, 0.f};
#pragma unroll
                    for (int kt = 0; kt < 5; ++kt) o[et] = MFMA16(cat8(va[2 * kt], va[2 * kt + 1]), pf[kt], o[et]);
                    if (et + 2 < 8) {
#pragma unroll
                        for (int q = 0; q < 10; ++q) va[q] = tr4(vl + ATT_PROW(ws0 + 16 * q) * KLD + 4 * (et + 2)); }
                    __builtin_amdgcn_sched_barrier(0);
                    o[et + 1] = (f32x4){0.f, 0.f, 0.f, 0.f};
#pragma unroll
                    for (int kt = 0; kt < 5; ++kt) o[et + 1] = MFMA16(cat8(vcc[2 * kt], vcc[2 * kt + 1]), pf[kt], o[et + 1]);
                }
            }
#undef ATT_PROW
            const float inv = (1.0f / KV8_SCALE) / lsum;
            bf16* orow = og + ((size_t)g * T + qrow) * D + h * 128 + 32 * g4;
#pragma unroll
            for (int e2 = 0; e2 < 4; ++e2) *(u32x4*)(orow + 8 * e2) = pack_bf16x8(o[2 * e2] * inv, o[2 * e2 + 1] * inv);
            if (g4 == 0) lse[((size_t)g * T + qrow) * AH + h] = mx + __logf(lsum);
            __syncthreads();
        }
    }
#undef ATT_LOADBLK
#undef ATT_CVT8
#undef ATT_STOREBLK
}
__device__ __forceinline__ void phase_attn_combine(const Frame& F) {
    const bf16* og = (const bf16*)(F.ws + WS_AUX); const float* lse = (const float*)(F.ws + WS_AUX + AUX_LSE); bf16* ob = (bf16*)(F.ws + WS_AUX + AUX_OB);
    const int lane = F.lane, gw = F.vcu * NWAVES + F.wave, NGW = F.G * NWAVES, h = lane >> 3;
    for (int row = gw; row < T; row += NGW) {
        const float l0 = lse[((size_t)0 * T + row) * AH + h], l1 = lse[((size_t)1 * T + row) * AH + h], l2 = lse[((size_t)2 * T + row) * AH + h];
        const float m = fmaxf(l0, fmaxf(l1, l2)); float w0 = __expf(l0 - m), w1 = __expf(l1 - m), w2 = __expf(l2 - m); const float inv = 1.0f / (w0 + w1 + w2); w0 *= inv; w1 *= inv; w2 *= inv;
        float a[16];
#pragma unroll
        for (int j = 0; j < 16; ++j) a[j] = 0.f;
#pragma unroll
        for (int g = 0; g < 3; ++g) { const float wg = (g == 0) ? w0 : (g == 1 ? w1 : w2);
#pragma unroll
            for (int q = 0; q < 2; ++q) { const u32x4 s = *(const u32x4*)(og + ((size_t)g * T + row) * D + 16 * lane + 8 * q);
                a[8 * q + 0] += wg * bflo(s.x); a[8 * q + 1] += wg * bfhi(s.x); a[8 * q + 2] += wg * bflo(s.y); a[8 * q + 3] += wg * bfhi(s.y);
                a[8 * q + 4] += wg * bflo(s.z); a[8 * q + 5] += wg * bfhi(s.z); a[8 * q + 6] += wg * bflo(s.w); a[8 * q + 7] += wg * bfhi(s.w); } }
        { u32x4 o;
#pragma unroll
          for (int q = 0; q < 4; ++q) o[q] = pk4_fp8(a[4 * q] * A_SCALE, a[4 * q + 1] * A_SCALE, a[4 * q + 2] * A_SCALE, a[4 * q + 3] * A_SCALE);
          *(u32x4*)((unsigned char*)ob + (size_t)row * D + 16 * lane) = o; }
    }
}

constexpr size_t BIG_YRET = 192 * MiB;
__device__ __forceinline__ void phase_ret_u(const Frame& F) {
    const bf16* proj = (const bf16*)(F.ws + WS_BIG); bf16* St = (bf16*)(F.ws + WS_AUX);
    constexpr int LD = 264;
    LAS bf16* Kt = (LAS bf16*)F.lds; LAS bf16* Vt = Kt + 128 * LD;
    const int lane = F.lane, w = F.wave, g4 = lane >> 4, l15 = lane & 15, qq = l15 >> 2, pp = lane & 3;
    u32x4 kr[8], vr[8];
#define RU_LOAD(u_) do { const int eh_ = (u_) & 1, h_ = ((u_) >> 1) & 3, n_ = ((u_) >> 3) & 63, b_ = (u_) >> 9; const char* pb_ = (const char*)(proj + ((size_t)b_ * SEQ + (size_t)n_ * RC) * RET_IN); \
        int t_ = F.tid; asm volatile("" : "+v"(t_)); unsigned off_ = (unsigned)(((t_ >> 5) * RET_IN + (t_ & 31) * 8) * 2); \
        _Pragma("unroll") for (int it = 0; it < 8; ++it) { asm volatile("" : "+v"(off_)); kr[it] = *(const u32x4*)(pb_ + (size_t)(1024 + h_ * 256 + it * 16 * RET_IN) * 2 + off_); \
            vr[it] = *(const u32x4*)(pb_ + (size_t)(2048 + h_ * 512 + eh_ * 256 + it * 16 * RET_IN) * 2 + off_); } } while (0)
    if (F.vcu < 1024) RU_LOAD(F.vcu);
    for (int u = F.vcu; u < 1024; u += F.G) {
        const int eh = u & 1, h = (u >> 1) & 3, n = (u >> 3) & 63, b = u >> 9;
        { int t_ = F.tid; asm volatile("" : "+v"(t_));
#pragma unroll
          for (int it = 0; it < 8; ++it) { const int idx = t_ + 512 * it, j = idx >> 5, ch = idx & 31; *(LAS u32x4*)(Kt + j * LD + ch * 8) = kr[it]; *(LAS u32x4*)(Vt + j * LD + ch * 8) = vr[it]; } }
        __syncthreads();
        f32x4 acc[16][2];
#pragma unroll
        for (int mt = 0; mt < 16; ++mt) { acc[mt][0] = (f32x4){0.f, 0.f, 0.f, 0.f}; acc[mt][1] = (f32x4){0.f, 0.f, 0.f, 0.f}; }
#pragma unroll
        for (int ks = 0; ks < 4; ++ks) {
            bf16x8 bfr[2];
#pragma unroll
            for (int nt = 0; nt < 2; ++nt) { const LAS bf16* a0 = Vt + (32 * ks + 8 * g4 + qq) * LD + 32 * w + 16 * nt + 4 * pp; bfr[nt] = cat8(tr4(a0), tr4(a0 + 4 * LD)); }
#pragma unroll
            for (int mt = 0; mt < 16; ++mt) { const LAS bf16* a0 = Kt + (32 * ks + 8 * g4 + qq) * LD + 128 * (mt >> 3) + 32 * pp + 4 * (mt & 7);
                const bf16x8 afr = cat8(tr4(a0), tr4(a0 + 4 * LD));
                acc[mt][0] = MFMA16(afr, bfr[0], acc[mt][0]); acc[mt][1] = MFMA16(afr, bfr[1], acc[mt][1]); }
        }
        { const int un = (u + F.G < 1024) ? u + F.G : u; RU_LOAD(un); }
        bf16* outb = St + ((size_t)((b * RH + h) * RNC + n)) * (RDV * RDK);
#pragma unroll
        for (int nt = 0; nt < 2; ++nt) { bf16* orow = outb + (size_t)(eh * 256 + 32 * w + 16 * nt + l15) * RDK + 32 * g4;
#pragma unroll
            for (int mh = 0; mh < 2; ++mh)
#pragma unroll
                for (int q = 0; q < 4; ++q) *(u32x4*)(orow + 128 * mh + 8 * q) = pack_bf16x8(acc[mh * 8 + 2 * q][nt], acc[mh * 8 + 2 * q + 1][nt]); }
        __syncthreads();
    }
#undef RU_LOAD
}
__device__ __forceinline__ void phase_ret_scan(const Frame& F) {
    bf16* St = (bf16*)(F.ws + WS_AUX);
    for (int gt = F.vcu * NTHREADS + F.tid; gt < 8 * 16384; gt += F.G * NTHREADS) {
        const int bh = gt >> 14, chunk = gt & 16383, h = bh & 3;
        const float g128 = exp2f(128.0f * log2f(1.0f - exp2f(-5.0f - (float)h)));
        bf16* base = St + (size_t)bh * RNC * (RDV * RDK) + (size_t)chunk * 8;
        float c[8];
#pragma unroll
        for (int j = 0; j < 8; ++j) c[j] = 0.f;
#pragma unroll 8
        for (int n = 0; n < RNC; ++n) { bf16* pn = base + (size_t)n * (RDV * RDK); const u32x4 uv = *(const u32x4*)pn;
            u32x4 o; o.x = pk2(c[0], c[1]); o.y = pk2(c[2], c[3]); o.z = pk2(c[4], c[5]); o.w = pk2(c[6], c[7]); *(u32x4*)pn = o;
            c[0] = g128 * (c[0] + bflo(uv.x)); c[1] = g128 * (c[1] + bfhi(uv.x)); c[2] = g128 * (c[2] + bflo(uv.y)); c[3] = g128 * (c[3] + bfhi(uv.y));
            c[4] = g128 * (c[4] + bflo(uv.z)); c[5] = g128 * (c[5] + bfhi(uv.z)); c[6] = g128 * (c[6] + bflo(uv.w)); c[7] = g128 * (c[7] + bfhi(uv.w)); }
    }
}
__device__ __forceinline__ void phase_ret_out(const Frame& F, KP p) {
    const bf16* proj = (const bf16*)(F.ws + WS_BIG); const bf16* St = (const bf16*)(F.ws + WS_AUX); bf16* yret = (bf16*)(F.ws + WS_BIG + BIG_YRET);
    const float* gng = gin(p, 4); const float* gnb = gin(p, 5);
    constexpr int LD = 264, VLD = 72, NSL = 8, ESL = 64;
    LAS bf16* Rs = (LAS bf16*)F.lds; LAS bf16* Vs = Rs + 128 * LD;
    const int w = F.wave;
#define RO_TID(t_) int t_ = F.tid; asm volatile("" : "+v"(t_))
#define RO_LD(base_, off_) (*(const u32x4*)((const char*)(base_) + (off_)))
    for (int u = F.vcu; u < 512; u += F.G) {
        const int h = u & 3, n = (u >> 2) & 63, b = u >> 8;
        const size_t row0 = (size_t)b * SEQ + (size_t)n * RC;
        const bf16* Sn = St + ((size_t)((b * RH + h) * RNC + n)) * (RDV * RDK);
        const char* pbase = (const char*)(proj + row0 * RET_IN);
        u32x4 pv[2], ps[4];
        bf16x8 qf[8];
        { RO_TID(t0); u32x4 kreg[8];
          unsigned koff = (unsigned)(((t0 >> 5) * RET_IN + (t0 & 31) * 8) * 2), qoff = (unsigned)(((16 * w + (t0 & 15)) * RET_IN + 8 * ((t0 & 63) >> 4)) * 2);
#pragma unroll
          for (int it = 0; it < 8; ++it) { asm volatile("" : "+v"(koff)); kreg[it] = RO_LD(pbase + (size_t)(1024 + h * 256 + it * 16 * RET_IN) * 2, koff); }
#pragma unroll
          for (int s = 0; s < 8; ++s) { asm volatile("" : "+v"(qoff)); qf[s] = __builtin_bit_cast(bf16x8, RO_LD(pbase + (size_t)(h * 256 + 32 * s) * 2, qoff)); }
#define RO_LOAD_SLICE(sl_) do { RO_TID(tl_); unsigned voff = (unsigned)(((tl_ >> 3) * RET_IN + (tl_ & 7) * 8) * 2), soff = (unsigned)(((tl_ >> 5) * RDK + (tl_ & 31) * 8) * 2); \
            _Pragma("unroll") for (int it = 0; it < 2; ++it) { asm volatile("" : "+v"(voff)); pv[it] = RO_LD(pbase + (size_t)(2048 + h * 512 + (sl_) * ESL + it * 64 * RET_IN) * 2, voff); } \
            _Pragma("unroll") for (int it = 0; it < 4; ++it) { asm volatile("" : "+v"(soff)); ps[it] = RO_LD((const char*)Sn + (size_t)(((sl_) * ESL + it * 16) * RDK) * 2, soff); } } while (0)
          RO_LOAD_SLICE(0);
#pragma unroll
          for (int it = 0; it < 8; ++it) { const int idx = t0 + 512 * it, j = idx >> 5, ch = idx & 31; *(LAS u32x4*)(Rs + j * LD + ch * 8) = kreg[it]; } }
        __syncthreads();
        bf16x8 pf[4];
        { RO_TID(t1); const int lane = t1 & 63, g4 = lane >> 4, irow = 16 * w + (lane & 15);
          f32x4 sacc[8];
#pragma unroll
            for (int jt = 0; jt < 8; ++jt) { sacc[jt] = (f32x4){0.f, 0.f, 0.f, 0.f};
                if (jt <= w) {
#pragma unroll
                    for (int s = 0; s < 8; ++s) sacc[jt] = MFMA16(row_frag(Rs, LD, 16 * jt, 32 * s, lane), qf[s], sacc[jt]);
#pragma unroll
                    for (int i = 0; i < 4; ++i) if (16 * jt + 4 * g4 + i > irow) sacc[jt][i] = 0.f; } }
#pragma unroll
            for (int kt = 0; kt < 4; ++kt) pf[kt] = pack8(sacc[2 * kt], sacc[2 * kt + 1]); }
        __syncthreads();
        u32x4 accp[NSL][2];
        float s1 = 0.f, s2 = 0.f;
#pragma unroll
        for (int sl = 0; sl < NSL; ++sl) {
            { RO_TID(t2);
#pragma unroll
              for (int it = 0; it < 2; ++it) { const int idx = t2 + 512 * it, j = idx >> 3, ch = idx & 7; *(LAS u32x4*)(Vs + j * VLD + ch * 8) = pv[it]; }
#pragma unroll
              for (int it = 0; it < 4; ++it) { const int idx = t2 + 512 * it, e = idx >> 5, ch = idx & 31; *(LAS u32x4*)(Rs + e * LD + ch * 8) = ps[it]; } }
            __syncthreads();
            if (sl + 1 < NSL) RO_LOAD_SLICE(sl + 1);
            RO_TID(t3); const int lane = t3 & 63, g4 = lane >> 4, qq = (lane & 15) >> 2, pp = lane & 3;
            f32x4 acc[4];
#pragma unroll
            for (int et = 0; et < 4; ++et) { f32x4 a = (f32x4){0.f, 0.f, 0.f, 0.f};
#pragma unroll
                for (int kt = 0; kt < 4; ++kt) if (2 * kt <= w) { const LAS bf16* a0 = Vs + (32 * kt + 4 * g4 + qq) * VLD + 16 * pp + 4 * et;
                    a = MFMA16(cat8(tr4(a0), tr4(a0 + 16 * VLD)), pf[kt], a); }
                const LAS bf16* srow = Rs + (16 * qq + 4 * et + pp) * LD + 8 * g4;
#pragma unroll
                for (int s = 0; s < 8; ++s) a = MFMA16(*(const LAS bf16x8*)(srow + 32 * s), qf[s], a);
                acc[et] = a; s1 += (a[0] + a[1]) + (a[2] + a[3]); s2 += (a[0] * a[0] + a[1] * a[1]) + (a[2] * a[2] + a[3] * a[3]);
                __builtin_amdgcn_sched_barrier(0); }
            accp[sl][0] = pack_bf16x8(acc[0], acc[1]); accp[sl][1] = pack_bf16x8(acc[2], acc[3]);
            __syncthreads();
        }
#undef RO_LOAD_SLICE
        RO_TID(t4); const int lane = t4 & 63, g4 = lane >> 4, irow = 16 * w + (lane & 15); const size_t qrow = row0 + irow;
        s1 += shx(s1, 16, lane); s1 += shx(s1, 32, lane); s2 += shx(s2, 16, lane); s2 += shx(s2, 32, lane);
        const float mean = s1 * (1.0f / RDV); const float var = fmaxf(s2 * (1.0f / RDV) - mean * mean, 0.f);
        const float rstd = 1.0f / sqrtf(var + LN_EPS);
        unsigned goff = (unsigned)((irow * RET_IN + 16 * g4) * 2);
#pragma unroll
        for (int sp = 0; sp < NSL; sp += 2) {
            u32x4 gq[2][2]; f32x4 gg[2][4], gb[2][4];
#pragma unroll
            for (int d2 = 0; d2 < 2; ++d2) { const int c0 = h * RDV + (sp + d2) * ESL + 16 * g4;
#pragma unroll
                for (int q = 0; q < 2; ++q) { asm volatile("" : "+v"(goff)); gq[d2][q] = RO_LD(pbase + (size_t)(4096 + h * RDV + (sp + d2) * ESL + 8 * q) * 2, goff); }
#pragma unroll
                for (int q = 0; q < 4; ++q) { gg[d2][q] = *(const f32x4*)(gng + c0 + 4 * q); gb[d2][q] = *(const f32x4*)(gnb + c0 + 4 * q); } }
#pragma unroll
            for (int d2 = 0; d2 < 2; ++d2) { const int c0 = h * RDV + (sp + d2) * ESL + 16 * g4; u32x4 o8;
#pragma unroll
                for (int q = 0; q < 2; ++q) { const u32x4 gw = gq[d2][q]; f32x4 a0, a1; unpack_bf16x8(accp[sp + d2][q], a0, a1);
                    f32x4 y0 = (a0 - mean) * rstd * gg[d2][2 * q] + gb[d2][2 * q], y1 = (a1 - mean) * rstd * gg[d2][2 * q + 1] + gb[d2][2 * q + 1];
                    const float gv[8] = {bflo(gw.x), bfhi(gw.x), bflo(gw.y), bfhi(gw.y), bflo(gw.z), bfhi(gw.z), bflo(gw.w), bfhi(gw.w)};
#pragma unroll
                    for (int j = 0; j < 4; ++j) { y0[j] *= gv[j] * fsig(gv[j]) * A_SCALE; y1[j] *= gv[4 + j] * fsig(gv[4 + j]) * A_SCALE; }
                    o8[2 * q] = pk4_fp8(y0[0], y0[1], y0[2], y0[3]); o8[2 * q + 1] = pk4_fp8(y1[0], y1[1], y1[2], y1[3]); }
                *(u32x4*)((unsigned char*)yret + qrow * RET_V + c0) = o8; }
        }
    }
#undef RO_LD
#undef RO_TID
}

constexpr size_t AUX_S5E = 64 * MiB;
constexpr int S5L = 256, S5NC = SEQ / S5L;
__device__ __forceinline__ void cmul_add(float& rr, float& ri, float ar, float ai, float xr, float xi, float cr, float ci) { rr = ar * xr - ai * xi + cr; ri = ar * xi + ai * xr + ci; }
template <bool OUT>
__device__ __forceinline__ void phase_s5_scan(const Frame& F, KP p) {
    const bf16* X = (const bf16*)(F.ws + WS_XB); float* E = (float*)(F.ws + WS_AUX + AUX_S5E); bf16* ybuf = (bf16*)(F.ws + WS_AUX);
    const int lane = F.lane, w = F.wave, g4 = lane >> 4, l15 = lane & 15;
    LAS bf16* ut = (LAS bf16*)(F.lds + w * 12288);
    LAS bf16* Hb = (LAS bf16*)(F.lds + w * 12288 + 4096);
    constexpr int HLD = 136;
    const int gw = F.vcu * NWAVES + w, NGW = F.G * NWAVES;
    const int up16 = (lane - 16) << 2, up32 = (lane - 32) << 2, last16 = (48 + l15) << 2;
    for (int unit = gw; unit < BATCH * SG * S5NC; unit += NGW) {
        const int n = unit & (S5NC - 1), g = (unit >> 5) & 63, b = unit >> 11;
        float a1r[4], a1i[4], a4r[4], a4i[4], a8r[4], a8i[4], pwr[4], pwi[4];
        bf16x8 bfrag[8];
        const float dt = expf(gin(p, 14)[g]);
#pragma unroll
        for (int st = 0; st < 4; ++st) { const int ps = 16 * st + l15;
            const float are = gin(p, 7)[g * SP + ps], aim = gin(p, 8)[g * SP + ps];
            const float mag = expf(dt * are); const float abr = mag * cosf(dt * aim), abi = mag * sinf(dt * aim);
            const float den = are * are + aim * aim;
            const float fre = ((abr - 1.0f) * are + abi * aim) / den, fim = (abi * are - (abr - 1.0f) * aim) / den;
            a1r[st] = abr; a1i[st] = abi; { float t2r, t2i; cmul_add(t2r, t2i, abr, abi, abr, abi, 0.f, 0.f); cmul_add(a4r[st], a4i[st], t2r, t2i, t2r, t2i, 0.f, 0.f); }
            cmul_add(a8r[st], a8i[st], a4r[st], a4i[st], a4r[st], a4i[st], 0.f, 0.f);
            float qr = 1.f, qi = 0.f;
            if (g4 & 1) { qr = a4r[st]; qi = a4i[st]; }
            if (g4 & 2) { float tr, ti; cmul_add(tr, ti, qr, qi, a8r[st], a8i[st], 0.f, 0.f); qr = tr; qi = ti; }
            pwr[st] = qr; pwi[st] = qi;
            const float* br = gin(p, 9) + ((size_t)g * SP + ps) * SGC + 8 * (g4 & 1); const float* bi = gin(p, 10) + ((size_t)g * SP + ps) * SGC + 8 * (g4 & 1);
            const f32x4 r0 = *(const f32x4*)br, r1 = *(const f32x4*)(br + 4), i0 = *(const f32x4*)bi, i1 = *(const f32x4*)(bi + 4);
            const float z = (g4 < 2) ? 1.0f : 0.0f; const float fr2 = fre * z, fi2 = fim * z;
            bfrag[st] = pack8(r0 * fr2 - i0 * fi2, r1 * fr2 - i1 * fi2); bfrag[st + 4] = pack8(i0 * fr2 + r0 * fi2, i1 * fr2 + r1 * fi2);
        }
        float sr[4], si[4];
        float* Eu = E + ((size_t)(b * SG + g) * S5NC + n) * 128;
        bf16x8 cf[4]; f32x4 dsk = (f32x4){0.f, 0.f, 0.f, 0.f};
#pragma unroll
        for (int st = 0; st < 4; ++st) { sr[st] = 0.f; si[st] = 0.f; }
        if (OUT) {
#pragma unroll
            for (int st = 0; st < 4; ++st) { sr[st] = Eu[16 * st + l15]; si[st] = Eu[64 + 16 * st + l15]; }
#pragma unroll
            for (int s = 0; s < 4; ++s) { const float* cp = (s < 2 ? gin(p, 11) : gin(p, 12)) + ((size_t)g * SGC + l15) * SP + 32 * (s & 1) + 8 * g4; const float sg = s < 2 ? 1.0f : -1.0f;
                const f32x4 c0 = *(const f32x4*)cp * sg, c1 = *(const f32x4*)(cp + 4) * sg; cf[s] = pack8(c0, c1); }
            dsk = *(const f32x4*)(gin(p, 13) + g * SGC + 4 * g4); }
        const size_t tok0 = (size_t)b * SEQ + (size_t)n * S5L;
        u32x4 pre[2];
        { const bf16* src = X + (tok0 + lane) * D + g * SGC; pre[0] = *(const u32x4*)src; pre[1] = *(const u32x4*)(src + 8); }
        for (int sub = 0; sub < S5L / 64; ++sub) {
            *(LAS u32x4*)(ut + lane * 16) = pre[0]; *(LAS u32x4*)(ut + lane * 16 + 8) = pre[1];
            if (sub + 1 < S5L / 64) { const bf16* src = X + (tok0 + (sub + 1) * 64 + lane) * D + g * SGC; pre[0] = *(const u32x4*)src; pre[1] = *(const u32x4*)(src + 8); }
            LDS_WAIT(); asm volatile("" ::: "memory");
#pragma unroll (OUT ? 1 : 4)
            for (int blk = 0; blk < 4; ++blk) {
                u32x4 uw = *(const LAS u32x4*)(ut + (blk * 16 + l15) * 16 + 8 * (g4 & 1));
                if (g4 >= 2) uw = (u32x4){0u, 0u, 0u, 0u};
                const bf16x8 ufr = __builtin_bit_cast(bf16x8, uw);
                f32x4 dr[4], di[4];
#pragma unroll
                for (int st = 0; st < 4; ++st) { dr[st] = MFMA16(ufr, bfrag[st], ((f32x4){0.f, 0.f, 0.f, 0.f})); di[st] = MFMA16(ufr, bfrag[st + 4], ((f32x4){0.f, 0.f, 0.f, 0.f})); }
                float vr[4], vi[4];
#pragma unroll
                for (int st = 0; st < 4; ++st) {
                    float hr = 0.f, hi = 0.f;
#pragma unroll
                    for (int i = 0; i < 4; ++i) { float nr, ni; cmul_add(nr, ni, a1r[st], a1i[st], hr, hi, dr[st][i], di[st][i]); hr = nr; hi = ni; dr[st][i] = hr; di[st][i] = hi; }
                    vr[st] = hr; vi[st] = hi; }
#define BPF(idx, v) __builtin_bit_cast(float, __builtin_amdgcn_ds_bpermute((idx), __builtin_bit_cast(int, (v))))
                { float xr[4], xi[4];
#pragma unroll
                  for (int st = 0; st < 4; ++st) { xr[st] = BPF(up16, vr[st]); xi[st] = BPF(up16, vi[st]); }
#pragma unroll
                  for (int st = 0; st < 4; ++st) { float tr, ti; cmul_add(tr, ti, a4r[st], a4i[st], xr[st], xi[st], vr[st], vi[st]); if (g4 >= 1) { vr[st] = tr; vi[st] = ti; } }
#pragma unroll
                  for (int st = 0; st < 4; ++st) { xr[st] = BPF(up32, vr[st]); xi[st] = BPF(up32, vi[st]); }
#pragma unroll
                  for (int st = 0; st < 4; ++st) { float tr, ti; cmul_add(tr, ti, a8r[st], a8i[st], xr[st], xi[st], vr[st], vi[st]); if (g4 >= 2) { vr[st] = tr; vi[st] = ti; } } }
                float er[4], ei[4], lr[4], li[4];
#pragma unroll
                for (int st = 0; st < 4; ++st) { if (OUT) { er[st] = BPF(up16, vr[st]); ei[st] = BPF(up16, vi[st]); } else { er[st] = 0.f; ei[st] = 0.f; } lr[st] = BPF(last16, vr[st]); li[st] = BPF(last16, vi[st]); }
#undef BPF
#pragma unroll
                for (int st = 0; st < 4; ++st) {
                    if (g4 == 0) { er[st] = 0.f; ei[st] = 0.f; }
                    if (OUT) { float s0r, s0i; cmul_add(s0r, s0i, pwr[st], pwi[st], sr[st], si[st], er[st], ei[st]);
#pragma unroll
                        for (int i = 0; i < 4; ++i) { float tr, ti; cmul_add(tr, ti, a1r[st], a1i[st], s0r, s0i, 0.f, 0.f); s0r = tr; s0i = ti; dr[st][i] += s0r; di[st][i] += s0i; } }
                    { float a16r, a16i; cmul_add(a16r, a16i, a8r[st], a8i[st], a8r[st], a8i[st], 0.f, 0.f); float tr, ti; cmul_add(tr, ti, a16r, a16i, sr[st], si[st], lr[st], li[st]); sr[st] = tr; si[st] = ti; }
                    if (OUT) {
#pragma unroll
                        for (int i = 0; i < 4; ++i) { const unsigned hw = pk2(dr[st][i], di[st][i]); Hb[(4 * g4 + i) * HLD + 16 * st + l15] = (bf16)hw; Hb[(4 * g4 + i) * HLD + 64 + 16 * st + l15] = (bf16)(hw >> 16); } }
                }
                if (OUT) {
                    LDS_WAIT(); asm volatile("" ::: "memory");
                    f32x4 ya = (f32x4){0.f, 0.f, 0.f, 0.f};
#pragma unroll
                    for (int s = 0; s < 4; ++s) ya = MFMA16(cf[s], row_frag(Hb, HLD, 0, 32 * s, lane), ya);
                    const u32x2 u2 = *(const LAS u32x2*)(ut + (blk * 16 + l15) * 16 + 4 * g4);
                    const f32x4 u4 = (f32x4){bflo(u2.x), bfhi(u2.x), bflo(u2.y), bfhi(u2.y)};
                    f32x4 y = ya + dsk * u4;
#pragma unroll
                    for (int j = 0; j < 4; ++j) { const float v = y[j]; y[j] = v * fsig(1.5957691216057308f * (v + 0.044715f * v * v * v)); }
                    *(unsigned*)((unsigned char*)ybuf + (size_t)(tok0 + sub * 64 + blk * 16 + l15) * D + g * SGC + 4 * g4) = pk4_fp8(y[0] * A_SCALE, y[1] * A_SCALE, y[2] * A_SCALE, y[3] * A_SCALE);
                    asm volatile("" ::: "memory"); }
            }
            LDS_WAIT(); asm volatile("" ::: "memory");
        }
        if (!OUT && g4 == 0) {
#pragma unroll
            for (int st = 0; st < 4; ++st) { Eu[16 * st + l15] = sr[st]; Eu[64 + 16 * st + l15] = si[st]; } }
    }
}
__device__ __forceinline__ void phase_s5_carry(const Frame& F, KP p) {
    float* E = (float*)(F.ws + WS_AUX + AUX_S5E);
    for (int gt = F.vcu * NTHREADS + F.tid; gt < BATCH * SG * SP; gt += F.G * NTHREADS) {
        const int pl = gt & 63, bg = gt >> 6, g = bg & 63;
        const float dt = expf(gin(p, 14)[g]); const float are = gin(p, 7)[g * SP + pl], aim = gin(p, 8)[g * SP + pl];
        const float mag = expf(dt * are); float ar = mag * cosf(dt * aim), ai = mag * sinf(dt * aim);
#pragma unroll
        for (int q = 0; q < 8; ++q) { const float nr = ar * ar - ai * ai, ni = 2.0f * ar * ai; ar = nr; ai = ni; }
        float cr = 0.f, ci = 0.f;
        for (int n = 0; n < S5NC; ++n) { float* Eu = E + ((size_t)bg * S5NC + n) * 128; const float er = Eu[pl], ei = Eu[64 + pl];
            Eu[pl] = cr; Eu[64 + pl] = ci;
            const float nr = ar * cr - ai * ci + er, ni = ar * ci + ai * cr + ei; cr = nr; ci = ni; }
    }
}

constexpr int NPHASES = 34;
#ifndef PROBE_DRY14
#define PROBE_DRY14 0
#endif
#ifndef PROBE_DRY17
#define PROBE_DRY17 0
#endif
#ifndef PH_MASK
#define PH_MASK 0xFFFFFFFFu
#endif
#define PHT(t) ((PH_MASK >> (t)) & 1u)
constexpr int PLAN_OFF = 64;
__device__ __forceinline__ void moe_plan(const Frame& F, int layer) {
    volatile LAS int* tstart = (volatile LAS int*)(F.MISC + PLAN_OFF); volatile LAS int* cnts = tstart + 72;
    __syncthreads();
    if (F.wave == 0) {
        const unsigned* cnt = (const unsigned*)(F.ws + WS_CTL) + CW_CNT + layer * NE * 64;
        const int c = (int)__hip_atomic_load(cnt + F.lane * 64, __ATOMIC_RELAXED, __HIP_MEMORY_SCOPE_AGENT);
        int v = (c + 255) >> 8;
#pragma unroll
        for (int o = 1; o < 64; o <<= 1) { const int nb = __builtin_amdgcn_ds_bpermute((F.lane - o) << 2, v); if (F.lane >= o) v += nb; }
        tstart[F.lane + 1] = v; cnts[F.lane] = c;
        if (F.lane == 0) tstart[0] = 0;
        if (F.lane == 63) { tstart[65] = v + T / 256; cnts[64] = T; }
    }
    __syncthreads();
}
template <bool GATH> struct MoeSched2 {
    static constexpr bool GATHER = GATH, UNIFORMIZE = true, FP8 = true;
    static constexpr int ncol = GATH ? 2 : 4, K = GATH ? D / 2 : ED / 2;
    const volatile LAS int* tstart; const volatile LAS int* cnts; int ntiles, G, c, lane;
    const char* Abase; const char* Wbase; const int* lists;
    __device__ __forceinline__ bool next(int i, pg8::UnitG& u) const {
        const int nwg = ntiles * ncol; const long L = (long)i * G + c; if (L >= nwg) return false;
        int wgid = (int)L; { const int q = nwg / 8, r = nwg % 8, xcd = wgid % 8, off = wgid / 8; wgid = (xcd < r ? xcd * (q + 1) : r * (q + 1) + (xcd - r) * q) + off; }
        const int tile = wgid / ncol, pn = wgid % ncol;
        int ln; { unsigned o2 = ~0u; asm volatile("" : "+s"(o2)); ln = (int)__builtin_amdgcn_mbcnt_hi(o2, __builtin_amdgcn_mbcnt_lo(o2, 0u)); }
        const int ta = tstart[ln], tb = tstart[ln + 1];
        const unsigned long long mm = __ballot(ta <= tile && tile < tb);
        const int e = mm ? (int)__builtin_ctzll(mm) : 64;
        const int ts = __builtin_amdgcn_readfirstlane((int)tstart[e]), ce = __builtin_amdgcn_readfirstlane((int)cnts[e]);
        const int lt = tile - ts; int valid = ce - lt * 256; valid = valid > 256 ? 256 : valid;
        u.gshift = 0; u.aux = e;
        if (GATH) {
            u.B = Wbase + (size_t)e * WMOE_E_BYTES + (size_t)pn * 256 * K * 2;
            if (e < 64) { u.A = Abase; u.gidx = lists + (size_t)e * T + lt * 256; u.gcnt = valid; }
            else { u.A = Abase + (size_t)lt * 256 * K * 2; u.gidx = nullptr; u.gcnt = 0; }
            u.row0 = tile * 256; u.col0 = pn * 128;
        } else {
            u.B = Wbase + (size_t)e * WMOE_E_BYTES + (size_t)512 * 1024 * 2 + (size_t)pn * 256 * K * 2;
            u.A = Abase + (size_t)tile * 256 * K * 2; u.gidx = nullptr; u.gcnt = valid;
            u.row0 = tile * 256; u.col0 = pn * 256;
        }
        return true;
    }
};
__device__ __forceinline__ void phase_load_x(const Frame& F, KP p) {
    const float* xin = gin(p, 0); bf16* XB = (bf16*)(F.ws + WS_XB);
    for (size_t i = (size_t)F.vcu * NTHREADS + F.tid; i < (size_t)T * D / 8; i += (size_t)F.G * NTHREADS) {
        const f32x4 a = *(const f32x4*)(xin + i * 8), b = *(const f32x4*)(xin + i * 8 + 4);
        *(u32x4*)(XB + i * 8) = pack_bf16x8(a, b);
        u32x2 q8; q8.x = pk4_fp8(a[0], a[1], a[2], a[3]); q8.y = pk4_fp8(b[0], b[1], b[2], b[3]); *(u32x2*)((unsigned char*)(F.ws + WS_X) + i * 8) = q8; }
}

__global__ void __launch_bounds__(NTHREADS, 2) fwd_kernel(Params p_unused) {
    KP p0 = (KP)__builtin_amdgcn_kernarg_segment_ptr();
    extern __shared__ __attribute__((aligned(16))) unsigned char lds_raw[];
    Frame F0;
    F0.lds = (LAS unsigned char*)lds_raw; F0.MISC = (volatile LAS unsigned*)(F0.lds + MISC_OFF);
    F0.tid = threadIdx.x; F0.lane = F0.tid & 63; F0.wave = __builtin_amdgcn_readfirstlane(F0.tid >> 6);
    F0.G = gridDim.x; { const int bq = blockIdx.x; F0.vcu = (F0.G % 8 == 0) ? (bq % 8) * (F0.G / 8) + bq / 8 : bq; }
    F0.ws = p0->ws;
    const int bx0 = blockIdx.x;
    for (int u = F0.tid; u < (LDS_BYTES - MISC_OFF) / 4; u += NTHREADS) ((LAS unsigned*)(F0.lds + MISC_OFF))[u] = 0u;
    __syncthreads();
    XcdBarrier bar; bar.bar = (unsigned*)(p0->ws + WS_CTL) + CW_BAR; bar.x = 0; bar.st = nullptr;
    const int use_bar = p0->use_bar;
    if (use_bar) bar = xcd_barrier_post((unsigned*)(p0->ws + WS_CTL) + CW_BAR, F0.MISC + 8);
    const int lo = p0->ph_lo, hi = p0->ph_hi;
#define PHASE_BEGIN Frame F = F0; KP p = p0; { unsigned ones_ = ~0u; asm volatile("" : "+s"(ones_)); F.lane = (int)__builtin_amdgcn_mbcnt_hi(ones_, __builtin_amdgcn_mbcnt_lo(ones_, 0u)); } asm volatile("" : "+v"(F.lane)); F.tid = F.wave * 64 + F.lane; asm volatile("" : "+v"(F.tid));   GAS unsigned char* wsg_ = (GAS unsigned char*)F0.ws; asm volatile("" : "+s"(F.wave), "+s"(F.vcu), "+s"(F.G), "+s"(wsg_), "+s"(p)); \
    F.ws = (unsigned char*)wsg_; int bx = bx0; asm volatile("" : "+s"(bx)); unsigned char* ws = F.ws; (void)ws; (void)bx;
#pragma unroll 1
    for (int ph = lo; ph < hi; ++ph) {
        int layer = 0, type = 0;
        if (ph > 0) { layer = ph >= 26 ? 3 : (ph >= 18 ? 2 : (ph >= 9 ? 1 : 0)); const int q = ph - (layer == 3 ? 26 : (layer == 2 ? 18 : (layer == 1 ? 9 : 1))); const int kind = layer % 3;
            if (kind == 0) type = q < 4 ? 1 + q : 14 + (q - 4); else if (kind == 1) type = q < 5 ? 5 + q : 14 + (q - 5); else type = q < 4 ? 10 + q : 14 + (q - 4); }
        const int j = layer / 3;
#ifdef REPEAT_MASK
        const int nrep = ((REPEAT_MASK >> type) & 1u) ? 2 : 1;
#else
        const int nrep = 1;
#endif
#pragma unroll 1
        for (int rep = 0; rep < nrep; ++rep) {
        if (rep > 0 && use_bar) xcd_barrier(bar);
        if (PHT(0) && type == 0) { PHASE_BEGIN; phase_conv_mixers(F, p); phase_conv_moe(F, p, 0); phase_load_x(F, p); }
        else if (PHT(1) && type == 1) { PHASE_BEGIN; DenseSched8 S; S.init(ws + WS_X, ws + WS_ATT_IN_T + (size_t)j * ATT_IN * D, T, ATT_IN, D / 2, F.G, bx); EpiStoreQkv8 E{(unsigned char*)(ws + WS_BIG), ATT_IN};
            pg8::gemm_phase(F.lds, F.tid, D / 2, S, E); }
        else if (PHT(2) && type == 2) { PHASE_BEGIN; phase_attn(F, bx); }
        else if (PHT(3) && type == 3) { PHASE_BEGIN; phase_attn_combine(F); }
        else if (PHT(4) && type == 4) { PHASE_BEGIN; DenseSched8 S; S.init(ws + WS_AUX + AUX_OB, ws + WS_ATT_OUT_T + (size_t)j * D * D, T, D, D / 2, F.G, bx); EpiResid8 E{(const bf16*)(ws + WS_XB), (bf16*)(ws + WS_Y), 1.0f / (A_SCALE * WUP_SCALE)};
            pg8::gemm_phase(F.lds, F.tid, D / 2, S, E); }
        else if (PHT(5) && type == 5) { PHASE_BEGIN; DenseSched8 S; S.init(ws + WS_X, ws + WS_RET_IN_T, T, RET_IN, D / 2, F.G, bx); EpiRetIn E{(bf16*)(ws + WS_BIG), RET_IN};
            pg8::gemm_phase(F.lds, F.tid, D / 2, S, E); }
        else if (PHT(6) && type == 6) { PHASE_BEGIN; phase_ret_u(F); }
        else if (PHT(7) && type == 7) { PHASE_BEGIN; phase_ret_scan(F); }
        else if (PHT(8) && type == 8) { PHASE_BEGIN; phase_ret_out(F, p); }
        else if (PHT(9) && type == 9) { PHASE_BEGIN; DenseSched8 S; S.init(ws + WS_BIG + BIG_YRET, ws + WS_RET_OUT_T, T, D, RET_V / 2, F.G, bx); EpiResid8 E{(const bf16*)(ws + WS_XB), (bf16*)(ws + WS_Y), 1.0f / (A_SCALE * WUP_SCALE)};
            pg8::gemm_phase(F.lds, F.tid, RET_V / 2, S, E); }
        else if (PHT(10) && type == 10) { PHASE_BEGIN; phase_s5_scan<false>(F, p); }
        else if (PHT(11) && type == 11) { PHASE_BEGIN; phase_s5_carry(F, p); }
        else if (PHT(12) && type == 12) { PHASE_BEGIN; phase_s5_scan<true>(F, p); }
        else if (PHT(13) && type == 13) { PHASE_BEGIN; DenseSched8 S; S.init(ws + WS_AUX, ws + WS_GLU_T, T, 2 * D, D / 2, F.G, bx); EpiGluResid E{(const bf16*)(ws + WS_XB), (bf16*)(ws + WS_Y), 1.0f / (A_SCALE * WUP_SCALE)};
            pg8::gemm_phase(F.lds, F.tid, D / 2, S, E); }
        else if (PHT(14) && type == 14) { PHASE_BEGIN; phase_lnr(F, p, layer, PROBE_DRY14 && true); if (PROBE_DRY14) { if (use_bar) xcd_barrier(bar); phase_lnr(F, p, layer, false); } }
        else if (PHT(15) && type == 15) { PHASE_BEGIN; moe_plan(F, layer);
            MoeSched2<true> S; S.tstart = (const volatile LAS int*)(F.MISC + PLAN_OFF); S.cnts = S.tstart + 72; S.ntiles = __builtin_amdgcn_readfirstlane((int)S.tstart[65]); S.G = F.G; S.c = bx; S.lane = F.lane;
            S.Abase = (const char*)(ws + WS_X); S.Wbase = (const char*)(ws + WS_WMOE); S.lists = (const int*)(ws + WS_LIST);
            EpiMoeUp E{(unsigned char*)(ws + WS_H)};
            pg8::gemm_phase(F.lds, F.tid, D / 2, S, E); }
        else if (PHT(16) && type == 16) { PHASE_BEGIN; moe_plan(F, layer);
            { MoeSched2<false> S; S.tstart = (const volatile LAS int*)(F.MISC + PLAN_OFF); S.cnts = S.tstart + 72; S.ntiles = __builtin_amdgcn_readfirstlane((int)S.tstart[64]); S.G = F.G; S.c = bx; S.lane = F.lane;
              S.Abase = (const char*)(ws + WS_H); S.Wbase = (const char*)(ws + WS_WMOE); S.lists = (const int*)(ws + WS_LIST);
              EpiStoreFp8 E{(unsigned char*)(ws + WS_BIG), D};
              pg8::gemm_phase(F.lds, F.tid, ED / 2, S, E); }
            { const int sh0 = __builtin_amdgcn_readfirstlane((int)((const volatile LAS int*)(F.MISC + PLAN_OFF))[64]);
              DenseSched8 S; S.init(ws + WS_H + (size_t)sh0 * 256 * ED, ws + WS_WMOE + (size_t)64 * WMOE_E_BYTES + (size_t)512 * 1024 * 2, T, D, ED / 2, F.G, bx); EpiResid8 E{(const bf16*)(ws + WS_XB), (bf16*)(ws + WS_Y), 1.0f / (H_SCALE * WUP_SCALE)};
              int tid2; { unsigned o2 = ~0u; asm volatile("" : "+s"(o2)); tid2 = F.wave * 64 + (int)__builtin_amdgcn_mbcnt_hi(o2, __builtin_amdgcn_mbcnt_lo(o2, 0u)); }
              pg8::gemm_phase(F.lds, tid2, ED / 2, S, E); } }
        else if (PHT(17) && type == 17) { PHASE_BEGIN; moe_plan(F, layer); if (PROBE_DRY17) { phase_combine(F, p, layer, true); if (use_bar) xcd_barrier(bar); } phase_combine(F, p, layer); if (layer + 1 < DEPTH) phase_conv_moe(F, p, layer + 1); }
        }
        if (use_bar && ph + 1 < hi) xcd_barrier(bar);
    }
}

#ifndef MK_PER_PHASE
#define MK_PER_PHASE 0
#endif
extern "C" void kernel_launch(void* const* d_in, const int* in_sizes, int n_in, void* d_out, int out_size, void* d_ws, size_t ws_size, hipStream_t stream) {
    static int grid = 0;
    if (grid == 0) {
        if (n_in != 26 || in_sizes[0] != T * D || out_size != T * D || ws_size < WS_END) { fprintf(stderr, "kernel_launch: unexpected shapes / workspace (n_in %d, in0 %d, out %d, ws %zu < %zu)\n", n_in, n_in > 0 ? in_sizes[0] : -1, out_size, ws_size, (size_t)WS_END); grid = -1; return; }
        int dev = 0, cus = 0, per_cu = 0;
        if (hipGetDevice(&dev) != hipSuccess || hipDeviceGetAttribute(&cus, hipDeviceAttributeMultiprocessorCount, dev) != hipSuccess) { grid = -1; return; }
        if (hipFuncSetAttribute((const void*)fwd_kernel, hipFuncAttributeMaxDynamicSharedMemorySize, LDS_BYTES) != hipSuccess) { fprintf(stderr, "kernel_launch: hipFuncSetAttribute failed\n"); grid = -1; return; }
        if (hipOccupancyMaxActiveBlocksPerMultiprocessor(&per_cu, (const void*)fwd_kernel, NTHREADS, LDS_BYTES) != hipSuccess || per_cu < 1) { fprintf(stderr, "kernel_launch: occupancy query says %d blocks per CU\n", per_cu); per_cu = 1; }
        (void)hipGetLastError();
        grid = cus;
    }
    if (grid < 0) return;
    (void)hipMemsetAsync((char*)d_ws + WS_CTL, 0, CTL_ZERO_BYTES, stream);
    Params p{};
    for (int i = 0; i < 26; ++i) p.in[i] = (const float*)d_in[i];
    p.out = (float*)d_out; p.ws = (unsigned char*)d_ws;
#if MK_PER_PHASE
    for (int k = 0; k < NPHASES; ++k) { p.ph_lo = k; p.ph_hi = k + 1; p.use_bar = 0; hipLaunchKernelGGL(fwd_kernel, dim3(grid), dim3(NTHREADS), LDS_BYTES, stream, p); }
#else
    p.ph_lo = 0; p.ph_hi = NPHASES; p.use_bar = 1;
    hipLaunchKernelGGL(fwd_kernel, dim3(grid), dim3(NTHREADS), LDS_BYTES, stream, p);
#endif
}
```

```cpp
#include <hip/hip_runtime.h>
#include <cstdio>
#include <cstdint>

#define LAS __attribute__((address_space(3)))
#define GAS __attribute__((address_space(1)))
typedef unsigned short bf16;
typedef short bf16x8 __attribute__((ext_vector_type(8)));
typedef short bf16x4 __attribute__((ext_vector_type(4)));
typedef float f32x4 __attribute__((ext_vector_type(4)));
typedef float f32x2 __attribute__((ext_vector_type(2)));
typedef unsigned u32x4 __attribute__((ext_vector_type(4)));
typedef unsigned u32x2 __attribute__((ext_vector_type(2)));
typedef GAS unsigned gu32;

constexpr int D = 1024, BATCH = 2, SEQ = 8192, T = BATCH * SEQ, DEPTH = 4;
constexpr int AH = 8, AHD = 128, ATT_IN = 9216;
constexpr int RH = 4, RDK = 256, RDV = 512, RET_IN = 6144, RET_V = 2048, RC = 128, RNC = SEQ / RC;
constexpr int SG = 64, SGC = 16, SP = 64;
constexpr int NE = 64, TOPK = 8, NEG = 8, ED = 256, NSLOT = 9;
constexpr float LN_EPS = 1e-5f;
constexpr float ALPHA = 1.6817928305074292f;
constexpr int NWAVES = 8, NTHREADS = 512;

__device__ __forceinline__ unsigned f2bf(float f) { unsigned u = __builtin_bit_cast(unsigned, f); return (u + 0x7fffu + ((u >> 16) & 1u)) >> 16; }
__device__ __forceinline__ unsigned pk2(float lo, float hi) { unsigned r; asm("s_nop 1\n\tv_cvt_pk_bf16_f32 %0, %1, %2" : "=v"(r) : "v"(lo), "v"(hi)); return r; }
__device__ __forceinline__ unsigned pk2sw(float lo, float hi) { return f2bf(lo) | (f2bf(hi) << 16); }
__device__ __forceinline__ unsigned pk2hw(float lo, float hi) { unsigned r; asm volatile("v_cvt_pk_bf16_f32 %0, %1, %2" : "=v"(r) : "v"(lo), "v"(hi)); return r; }
__device__ __forceinline__ float bf2f(unsigned b) { return __builtin_bit_cast(float, b << 16); }
__device__ __forceinline__ float bflo(unsigned w) { return __builtin_bit_cast(float, w << 16); }
__device__ __forceinline__ float bfhi(unsigned w) { return __builtin_bit_cast(float, w & 0xffff0000u); }
__device__ __forceinline__ float shx(float v, int m, int lane) { return __builtin_bit_cast(float, __builtin_amdgcn_ds_bpermute((lane ^ m) << 2, __builtin_bit_cast(int, v))); }
__device__ __forceinline__ int shx_i(int v, int m, int lane) { return __builtin_amdgcn_ds_bpermute((lane ^ m) << 2, v); }
__device__ __forceinline__ float rdl(float v, int src) { return __builtin_bit_cast(float, __builtin_amdgcn_readlane(__builtin_bit_cast(int, v), src)); }
template <int CTRL, int RM = 0xf, int BM = 0xf> __device__ __forceinline__ float dpp0(float v) { return __builtin_bit_cast(float, __builtin_amdgcn_update_dpp(0, __builtin_bit_cast(int, v), CTRL, RM, BM, true)); }
template <int CTRL, int RM = 0xf, int BM = 0xf> __device__ __forceinline__ float dppo(float old, float v) { return __builtin_bit_cast(float, __builtin_amdgcn_update_dpp(__builtin_bit_cast(int, old), __builtin_bit_cast(int, v), CTRL, RM, BM, false)); }
__device__ __forceinline__ float wave_sum(float v, int lane) {
    (void)lane;
    v += dpp0<0x111>(v); v += dpp0<0x112>(v); v += dpp0<0x114>(v); v += dpp0<0x118>(v);
    v += dpp0<0x142, 0xa>(v);
    v += dpp0<0x143, 0xc>(v);
    return rdl(v, 63);
}
__device__ __forceinline__ unsigned wave_umax(unsigned v) {
#define WU_DPP(ctrl, rm) (unsigned)__builtin_amdgcn_update_dpp(0, (int)v, ctrl, rm, 0xf, true)
    { const unsigned t = WU_DPP(0x111, 0xf); v = v > t ? v : t; } { const unsigned t = WU_DPP(0x112, 0xf); v = v > t ? v : t; } { const unsigned t = WU_DPP(0x114, 0xf); v = v > t ? v : t; } { const unsigned t = WU_DPP(0x118, 0xf); v = v > t ? v : t; }
    { const unsigned t = WU_DPP(0x142, 0xa); v = v > t ? v : t; } { const unsigned t = WU_DPP(0x143, 0xc); v = v > t ? v : t; }
#undef WU_DPP
    return (unsigned)__builtin_amdgcn_readlane((int)v, 63);
}
__device__ __forceinline__ float max8(float v) {
    v = fmaxf(v, dppo<0xb1>(v, v)); v = fmaxf(v, dppo<0x4e>(v, v)); v = fmaxf(v, dppo<0x141>(v, v)); return v;
}
__device__ __forceinline__ float fsig(float x) { return __builtin_amdgcn_rcpf(1.0f + __expf(-x)); }
#define LDS_WAIT() asm volatile("s_waitcnt lgkmcnt(0)" ::: "memory")
#define VM_WAIT() asm volatile("s_waitcnt vmcnt(0)" ::: "memory")
__device__ __forceinline__ const char* rfl_ptr(const char* p) {
    unsigned long long v = (unsigned long long)p; unsigned lo = __builtin_amdgcn_readfirstlane((unsigned)v), hi = __builtin_amdgcn_readfirstlane((unsigned)(v >> 32));
    return (const char*)(((unsigned long long)hi << 32) | lo);
}
__device__ __forceinline__ bf16x8 row_frag(const LAS bf16* base, int ld, int row0, int col0, int lane) {
    return *(const LAS bf16x8*)(base + (row0 + (lane & 15)) * ld + col0 + 8 * (lane >> 4));
}
__device__ __forceinline__ bf16x4 tr4(const LAS bf16* addr) { return __builtin_amdgcn_ds_read_tr16_b64_v4i16((LAS bf16x4*)addr); }
__device__ __forceinline__ bf16x8 cat8(bf16x4 a, bf16x4 b) { bf16x8 r; r[0] = a[0]; r[1] = a[1]; r[2] = a[2]; r[3] = a[3]; r[4] = b[0]; r[5] = b[1]; r[6] = b[2]; r[7] = b[3]; return r; }
#define MFMA16(a, b, c) __builtin_amdgcn_mfma_f32_16x16x32_bf16((a), (b), (c), 0, 0, 0)
__device__ __forceinline__ bf16x8 pack8(f32x4 a, f32x4 b) {
    u32x4 w; w.x = pk2(a[0], a[1]); w.y = pk2(a[2], a[3]); w.z = pk2(b[0], b[1]); w.w = pk2(b[2], b[3]); return __builtin_bit_cast(bf16x8, w);
}

namespace pg8 {
typedef int v4i_t __attribute__((ext_vector_type(4)));
typedef int v8i_t __attribute__((ext_vector_type(8)));
constexpr int BM = 256, BK = 64, HALF = 128, HTB = HALF * BK * 2, STAGE_BYTES = 8 * HTB;
__device__ __forceinline__ int lds_byte(int r, int c) { const int st = (r >> 4) * 2 + (c >> 5), rr = r & 15, cc = c & 31, ob = rr * 64 + cc * 2; return st * 1024 + (ob ^ (((ob >> 9) & 1) << 5)); }
__device__ __forceinline__ void stage_rc(int b, int& R, int& C) { const int st = b / 1024, sb = b % 1024, swz = sb ^ (((sb >> 9) & 1) << 5); R = (st >> 1) * 16 + swz / 64; C = (st & 1) * 32 + (swz % 64) / 2; }
__device__ __forceinline__ int perm32(int rho) { const int n = rho >> 4, i = rho & 15; return 8 * (i >> 2) + 4 * n + (i & 3); }

struct UnitG {
    const char* A;
    const char* B;
    const int* gidx;
    int gcnt, gshift;
    int row0, col0;
    int aux;
};

__device__ __forceinline__ void uniformize(UnitG& u) { u.A = rfl_ptr(u.A); u.B = rfl_ptr(u.B); u.gidx = (const int*)rfl_ptr((const char*)u.gidx); u.gcnt = __builtin_amdgcn_readfirstlane(u.gcnt); u.gshift = __builtin_amdgcn_readfirstlane(u.gshift);
    u.row0 = __builtin_amdgcn_readfirstlane(u.row0); u.col0 = __builtin_amdgcn_readfirstlane(u.col0); u.aux = __builtin_amdgcn_readfirstlane(u.aux); }
template <class Epi, class Sched>
__device__ __forceinline__ void gemm_phase(LAS unsigned char* lds, const int tid, const int K, const Sched& S, const Epi& E) {
    constexpr bool F8 = Sched::FP8;
    constexpr bool GATHER = Sched::GATHER;
    const int wid = __builtin_amdgcn_readfirstlane(tid >> 6), lane = tid & 63, wr = wid >> 2, wc = wid & 3, fr = lane & 15, fq = lane >> 4;
    int nt = K / BK; asm volatile("" : "+s"(nt));
    constexpr bool P16 = Epi::PERM16;
    unsigned voffB[2], voffB1[2], vA[2][2];
#pragma unroll
    for (int i = 0; i < 2; ++i) { int R, C; stage_rc(tid * 16 + i * 8192, R, C); const int Rb = Epi::PERM ? ((R & ~31) + perm32(R & 31)) : R; voffB[i] = (unsigned)(Rb * K + C) * 2u; voffB1[i] = voffB[i]; vA[0][i] = (unsigned)(R * K + C) * 2u; vA[1][i] = vA[0][i];
        if constexpr (P16) { const int x = R & 31, src = 64 * (R >> 5) + 16 * ((x >> 2) & 3) + 4 * (x >> 4) + (x & 3); voffB[i] = (unsigned)(src * K + C) * 2u; voffB1[i] = (unsigned)((src + 8) * K + C) * 2u; } }
    const size_t kstep = (size_t)(BK * 2);
    const size_t hstep = (size_t)HALF * K * 2;
    const size_t hstepB = P16 ? 0 : hstep;
    const size_t hstepA = GATHER ? 0 : hstep;
    const size_t hstepB1 = P16 ? (size_t)8 * K * 2 : hstep, bstep = (size_t)(P16 ? 128 : 64) * K * 2, astep = (size_t)64 * K * 2;
    unsigned vB0 = voffB[0], vA0 = vA[0][0];
    const unsigned ldsw = (unsigned)wid * 1024u;
    const int aoff = lds_byte(wr * 64 + fr, fq * 8), boff = lds_byte(wc * 32 + fr, fq * 8);
    LAS u32x4* park = (LAS u32x4*)(lds + STAGE_BYTES) + tid;
#define PG8_SA(b, h) (((b) * 2 + (h)) * HTB)
#define PG8_SB(b, h) ((4 + (b) * 2 + (h)) * HTB)
#define PG8_STAGE(bufoff, gbase, voff) do { _Pragma("unroll") for (int _i = 0; _i < 2; ++_i) { asm volatile("" : "+v"((voff)[_i]));   \
        __builtin_amdgcn_global_load_lds((const unsigned*)((const char*)(gbase) + (voff)[_i]), (LAS unsigned*)(lds + (bufoff) + ldsw + _i * 8192), 16, 0, 0); } } while (0)
#define PG8_STAGEU(bufoff, gbase, v0, step1) do { asm volatile("" : "+v"(v0)); __builtin_amdgcn_global_load_lds((const unsigned*)((const char*)(gbase) + (v0)), (LAS unsigned*)(lds + (bufoff) + ldsw), 16, 0, 0); \
        asm volatile("" : "+v"(v0)); __builtin_amdgcn_global_load_lds((const unsigned*)((const char*)(gbase) + (step1) + (v0)), (LAS unsigned*)(lds + (bufoff) + ldsw + 8192), 16, 0, 0); } while (0)
#define PG8_STB(b, h, base) PG8_STAGEU(PG8_SB(b, h), (base) + (h) * hstepB1, vB0, bstep)
#define PG8_STA(b, h, base) do { if constexpr (GATHER) PG8_STAGE(PG8_SA(b, h), (base), vA[h]); else PG8_STAGEU(PG8_SA(b, h), (base) + (h) * hstep, vA0, astep); } while (0)
    constexpr int FKS = 1024;
#define PG8_LD2(p_) __builtin_shufflevector(*(const LAS v4i_t*)(p_), *(const LAS v4i_t*)((p_) + FKS), 0, 1, 2, 3, 4, 5, 6, 7)
#define PG8_LDA(dst, b, h) do { _Pragma("unroll") for (int m = 0; m < 4; ++m) dst[m] = PG8_LD2(lds + PG8_SA(b, h) + aoff + m * 2048); } while (0)
#define PG8_LDB(dst, b, h) do { _Pragma("unroll") for (int n = 0; n < 2; ++n) dst[n] = PG8_LD2(lds + PG8_SB(b, h) + boff + n * 2048); } while (0)
#define PG8_LO(v) __builtin_bit_cast(bf16x8, __builtin_shufflevector((v), (v), 0, 1, 2, 3))
#define PG8_HI(v) __builtin_bit_cast(bf16x8, __builtin_shufflevector((v), (v), 4, 5, 6, 7))
#define PG8_MMA(ai, bj, At, Bt) do { __builtin_amdgcn_s_setprio(1); _Pragma("unroll") for (int m = 0; m < 4; ++m) _Pragma("unroll") for (int n = 0; n < 2; ++n) { \
        if constexpr (F8) { acc[ai][bj][m][n] = __builtin_amdgcn_mfma_scale_f32_16x16x128_f8f6f4(Bt[n], At[m], acc[ai][bj][m][n], 0, 0, 0, 0x7F7F7F7F, 0, 0x7F7F7F7F); } \
        else { acc[ai][bj][m][n] = __builtin_amdgcn_mfma_f32_16x16x32_bf16(PG8_LO(Bt[n]), PG8_LO(At[m]), acc[ai][bj][m][n], 0, 0, 0); \
               acc[ai][bj][m][n] = __builtin_amdgcn_mfma_f32_16x16x32_bf16(PG8_HI(Bt[n]), PG8_HI(At[m]), acc[ai][bj][m][n], 0, 0, 0); } } __builtin_amdgcn_s_setprio(0); } while (0)
#define PG8_WAIT_V(n) asm volatile("s_waitcnt vmcnt(" #n ")" ::: "memory")
#define PG8_WAIT_L(n) asm volatile("s_waitcnt lgkmcnt(" #n ")" ::: "memory")
#define PG8_BAR __builtin_amdgcn_s_barrier()
#define PG8_SCHED __builtin_amdgcn_sched_barrier(0)
#define PG8_VOFF(u, v00, v01, v10, v11) do { int _R0, _C0, _R1, _C1; stage_rc(tid * 16, _R0, _C0); stage_rc(tid * 16 + 8192, _R1, _C1); int _r00 = _R0, _r01 = _R1, _r10 = HALF + _R0, _r11 = HALF + _R1; \
        if ((u).gidx) { const GAS int* _gp = (const GAS int*)(u).gidx; const int _gc = (u).gcnt;     \
            const int _a = _gp[_r00 < _gc ? _r00 : 0] >> (u).gshift, _b = _gp[_r01 < _gc ? _r01 : 0] >> (u).gshift, _c = _gp[_r10 < _gc ? _r10 : 0] >> (u).gshift, _d = _gp[_r11 < _gc ? _r11 : 0] >> (u).gshift; \
            _r00 = _a; _r01 = _b; _r10 = _c; _r11 = _d; } \
        v00 = (unsigned)(_r00 * K + _C0) * 2u; v01 = (unsigned)(_r01 * K + _C1) * 2u; v10 = (unsigned)(_r10 * K + _C0) * 2u; v11 = (unsigned)(_r11 * K + _C1) * 2u; } while (0)
    UnitG cur, nxt; int ui = 0;
    if (!S.next(0, cur)) return;
    if constexpr (Sched::UNIFORMIZE) uniformize(cur);
    f32x4 acc[2][2][4][2];
#pragma unroll
    for (int a = 0; a < 2; ++a)
#pragma unroll
        for (int b = 0; b < 2; ++b)
#pragma unroll
            for (int m = 0; m < 4; ++m)
#pragma unroll
                for (int n = 0; n < 2; ++n) acc[a][b][m][n] = (f32x4){0.f, 0.f, 0.f, 0.f};
    v8i_t At[4], B0[2], B1[2];
    if constexpr (GATHER) PG8_VOFF(cur, vA[0][0], vA[0][1], vA[1][0], vA[1][1]);
    const char* cA = cur.A; const char* cB = cur.B;
    PG8_STB(0, 0, cB); PG8_STB(0, 1, cB); PG8_STA(0, 0, cA); PG8_STA(0, 1, cA);
    if (wr == 1) PG8_BAR;
    PG8_WAIT_V(2); PG8_BAR;
    PG8_STB(1, 0, cB + kstep); PG8_STA(1, 0, cA + kstep); PG8_STB(1, 1, cB + kstep);
    PG8_WAIT_V(6); PG8_BAR;
    for (;;) {
        const bool has_next = S.next(ui + 1, nxt);
        if constexpr (Sched::UNIFORMIZE) { if (has_next) uniformize(nxt); }
        const char* nA = cA; const char* nB = cB;
        if (has_next) { nA = nxt.A; nB = nxt.B; }
        if constexpr (GATHER) { u32x4 pv; pv.x = vA[0][0]; pv.y = vA[0][1]; pv.z = vA[1][0]; pv.w = vA[1][1];
            if (has_next) PG8_VOFF(nxt, pv.x, pv.y, pv.z, pv.w);
            *park = pv; }
#pragma unroll 1
        for (int t = 0; t < nt; t += 2) {
            const bool last = (t == nt - 2);
            const char* a1 = cA + (size_t)(t + 1) * kstep;
            const char* a2 = last ? nA : cA + (size_t)(t + 2) * kstep; const char* b2 = last ? nB : cB + (size_t)(t + 2) * kstep;
            const char* a3 = a2 + kstep; const char* b3 = b2 + kstep;
            PG8_LDB(B0, 0, 0); PG8_LDB(B1, 0, 1); PG8_SCHED; PG8_LDA(At, 0, 0); PG8_STA(1, 1, a1);
            PG8_WAIT_V(8); PG8_WAIT_L(0); PG8_BAR; PG8_MMA(0, 0, At, B0); PG8_MMA(0, 1, At, B1); PG8_BAR; PG8_SCHED;
            if constexpr (GATHER) { if (last) { const u32x4 pv = *park; vA[0][0] = pv.x; vA[0][1] = pv.y; vA[1][0] = pv.z; vA[1][1] = pv.w; } }
            PG8_LDA(At, 0, 1); PG8_STB(0, 0, b2); PG8_STB(0, 1, b2); PG8_STA(0, 0, a2);
            PG8_WAIT_V(8); PG8_WAIT_L(0); PG8_BAR; PG8_MMA(1, 0, At, B0); PG8_MMA(1, 1, At, B1); PG8_BAR; PG8_SCHED;
            PG8_LDB(B0, 1, 0); PG8_LDB(B1, 1, 1); PG8_SCHED; PG8_LDA(At, 1, 0); PG8_STA(0, 1, a2);
            PG8_WAIT_V(8); PG8_WAIT_L(0); PG8_BAR; PG8_MMA(0, 0, At, B0); PG8_MMA(0, 1, At, B1); PG8_BAR; PG8_SCHED;
            PG8_LDA(At, 1, 1); PG8_STB(1, 0, b3); PG8_STB(1, 1, b3); PG8_STA(1, 0, a3);
            PG8_WAIT_V(8); PG8_WAIT_L(0); PG8_BAR; PG8_MMA(1, 0, At, B0); PG8_MMA(1, 1, At, B1); PG8_BAR; PG8_SCHED;
        }
        if (wr == 0) PG8_BAR;
        { int l2; { unsigned o2 = ~0u; asm volatile("" : "+s"(o2)); l2 = (int)__builtin_amdgcn_mbcnt_hi(o2, __builtin_amdgcn_mbcnt_lo(o2, 0u)); }
          E(acc, cur, wr, wc, l2 & 15, l2 >> 4); }
        if (!has_next) break;
#pragma unroll
        for (int a = 0; a < 2; ++a)
#pragma unroll
            for (int b = 0; b < 2; ++b)
#pragma unroll
                for (int m = 0; m < 4; ++m)
#pragma unroll
                    for (int n = 0; n < 2; ++n) acc[a][b][m][n] = (f32x4){0.f, 0.f, 0.f, 0.f};
        cur = nxt; cA = nA; cB = nB; ++ui;
        if (wr == 1) PG8_BAR;
    }
    PG8_WAIT_V(0);
    PG8_BAR;
#undef PG8_SA
#undef PG8_SB
#undef PG8_STAGE
#undef PG8_STAGEU
#undef PG8_STB
#undef PG8_STA
#undef PG8_LDA
#undef PG8_LDB
#undef PG8_LD2
#undef PG8_LO
#undef PG8_HI
#undef PG8_MMA
#undef PG8_WAIT_V
#undef PG8_WAIT_L
#undef PG8_BAR
#undef PG8_SCHED
#undef PG8_VOFF
}
}

constexpr size_t MiB = 1u << 20;
constexpr size_t WS_CTL = 0, CTL_ZERO_BYTES = 1 * MiB;
constexpr size_t WS_ATT_IN_T = 1 * MiB;
constexpr size_t WS_ATT_OUT_T = WS_ATT_IN_T + 36 * MiB;
constexpr size_t WS_RET_IN_T = WS_ATT_OUT_T + 4 * MiB;
constexpr size_t WS_RET_OUT_T = WS_RET_IN_T + 12 * MiB;
constexpr size_t WS_GLU_T = WS_RET_OUT_T + 4 * MiB;
constexpr size_t WS_RT_HI = WS_GLU_T + 4 * MiB;
constexpr size_t WS_RT_LO = WS_RT_HI + 512 * 1024;
constexpr size_t WS_WMOE = WS_RT_HI + 1 * MiB;
constexpr size_t WMOE_E_BYTES = (size_t)(512 * 1024 + 1024 * 256) * 2;
constexpr size_t WS_X = WS_WMOE + 98 * MiB;
constexpr size_t WS_Y = WS_X + 64 * MiB;
constexpr size_t WS_XB = WS_Y + 64 * MiB;
constexpr size_t WS_BIG = WS_XB + 32 * MiB;
constexpr size_t WS_AUX = WS_BIG + 288 * MiB;
constexpr size_t WS_H = WS_AUX + 160 * MiB;
constexpr size_t WS_LIST = WS_H + 80 * MiB;
constexpr size_t WS_TRASH = WS_LIST + 8 * MiB;
constexpr size_t WS_END = WS_TRASH + 1 * MiB;
static_assert(WS_END <= 1024 * MiB, "workspace map");
constexpr int CW_BAR = 4096;
constexpr int CW_CNT = 16384;
constexpr int CW_CHK = 65536;
constexpr int HROWS = 163840;

#define XB_TMO      128
#define XB_XCNT(j)  (256  + 64 * (j))
#define XB_XSUB(j)  (1280 + 64 * (j))
#define XB_XGEN(j)  (2304 + 64 * (j))
#define XB_TOP      3328
#define XB_TOPGEN   3392
#define XCD_BAR_WORDS 3456
#define XB_SPIN_CAP (1u << 20)
__device__ __forceinline__ unsigned xb_ld(unsigned* p)              { return __hip_atomic_load(p, __ATOMIC_RELAXED, __HIP_MEMORY_SCOPE_AGENT); }
__device__ __forceinline__ unsigned xb_add(unsigned* p, unsigned v) { return __hip_atomic_fetch_add(p, v, __ATOMIC_RELAXED, __HIP_MEMORY_SCOPE_AGENT); }
__device__ __forceinline__ unsigned xb_xcc_id() { return (unsigned)__builtin_amdgcn_s_getreg((3 << 11) | 20) & 0xFu; }
#define XB_SPIN(cond, bar) do { unsigned _sp = 0; while (cond) { __builtin_amdgcn_s_sleep(1); \
    if ((++_sp & 255u) == 0u) { if (xb_ld(&(bar)[XB_TMO])) break; if (_sp > XB_SPIN_CAP) { atomicAdd(&(bar)[XB_TMO], 1u); break; } } } } while (0)
struct XcdBarrier { unsigned* bar; unsigned x; volatile LAS unsigned* st; };
__device__ __forceinline__ XcdBarrier xcd_barrier_post(unsigned* bar, volatile LAS unsigned* st) {
    XcdBarrier b; b.bar = bar; b.x = xb_xcc_id(); b.st = st;
    if (threadIdx.x == 0) (void)xb_add(&bar[XB_XCNT(b.x)], 1u);
    return b;
}
__device__ __forceinline__ void xcd_barrier_complete(unsigned* bar, unsigned x, unsigned& nloc, unsigned& nx) {
    const unsigned G = gridDim.x * gridDim.y * gridDim.z;
    unsigned sum, cnt, mine, sp = 0u;
    for (;;) {
        sum = 0u; cnt = 0u; mine = 0u;
#pragma unroll
        for (unsigned j = 0; j < 16; ++j) { const unsigned c = xb_ld(&bar[XB_XCNT(j)]); sum += c; cnt += (c > 0u) ? 1u : 0u; mine = (j == x) ? c : mine; }
        if (sum == G) break;
        __builtin_amdgcn_s_sleep(1);
        if ((++sp & 255u) == 0u) { if (xb_ld(&bar[XB_TMO])) break; if (sp > XB_SPIN_CAP) { atomicAdd(&bar[XB_TMO], 1u); break; } }
    }
    nloc = mine > 0u ? mine : 1u; nx = cnt > 0u ? cnt : 1u;
}
__device__ __forceinline__ void xcd_barrier(const XcdBarrier& b) {
    asm volatile("s_waitcnt vmcnt(0)" ::: "memory");
    __syncthreads();
    if (threadIdx.x == 0) {
        unsigned* bar = b.bar;
        __builtin_amdgcn_s_waitcnt(0);
        unsigned nloc = b.st[0], nx = b.st[1];
        if (nloc == 0u) { xcd_barrier_complete(bar, b.x, nloc, nx); b.st[0] = nloc; b.st[1] = nx; }
        const unsigned old = xb_add(&bar[XB_XSUB(b.x)], 1u);
        const unsigned gen = old / nloc;
        if (old + 1u == (gen + 1u) * nloc) {
            __builtin_amdgcn_fence(__ATOMIC_RELEASE, "agent");
            asm volatile("s_waitcnt vmcnt(0)" ::: "memory");
            const unsigned og = xb_add(&bar[XB_TOP], 1u);
            const unsigned tg = og / nx;
            if (og + 1u == (tg + 1u) * nx) xb_add(&bar[XB_TOPGEN], 1u);
            else XB_SPIN(xb_ld(&bar[XB_TOPGEN]) == tg, bar);
            __builtin_amdgcn_fence(__ATOMIC_ACQUIRE, "agent");
            xb_add(&bar[XB_XGEN(b.x)], 1u);
            asm volatile("s_waitcnt vmcnt(0)" ::: "memory");
        } else {
            XB_SPIN(xb_ld(&bar[XB_XGEN(b.x)]) == gen, bar);
            __builtin_amdgcn_fence(__ATOMIC_ACQUIRE, "agent");
            asm volatile("s_waitcnt vmcnt(0)" ::: "memory");
        }
    }
    __syncthreads();
}

constexpr int RING_BYTES = 139264;
constexpr int MISC_OFF = RING_BYTES;
constexpr int LDS_BYTES = 147456;
struct Params {
    const float* in[26]; float* out; unsigned char* ws; int ph_lo, ph_hi; int use_bar, pad;
};
typedef const __attribute__((address_space(4))) Params* KP;
__device__ __forceinline__ const float* gin(KP p, int i) { return (const float*)(const GAS float*)p->in[i]; }
__device__ __forceinline__ float* gout(KP p) { return (float*)(GAS float*)p->out; }
struct Frame {
    LAS unsigned char* lds; volatile LAS unsigned* MISC;
    int tid, lane, wave, vcu, G;
    unsigned char* ws;
};

template <bool F8_ = false> struct DenseSchedT {
    static constexpr bool GATHER = false, UNIFORMIZE = false, FP8 = F8_;
    const char* A; const char* Bt; int K, nM, nN, nwg, G, c;
    __device__ __forceinline__ void init(const void* A_, const void* Bt_, int M, int N, int K_, int G_, int c_) { A = (const char*)A_; Bt = (const char*)Bt_; K = K_; nM = M / 256; nN = N / 256; nwg = nM * nN; G = G_; c = c_; }
    __device__ __forceinline__ bool next(int i, pg8::UnitG& u) const {
        const long L = (long)i * G + c; if (L >= nwg) return false;
        int wgid = (int)L; { const int q = nwg / 8, r = nwg % 8, xcd = wgid % 8, off = wgid / 8; wgid = (xcd < r ? xcd * (q + 1) : r * (q + 1) + (xcd - r) * q) + off; }
        const int nig = 8 * nN, gid = wgid / nig, fm = gid * 8, gsz = (nM - fm) < 8 ? (nM - fm) : 8;
        const int pm = fm + ((wgid % nig) % gsz), pn = (wgid % nig) / gsz;
        u.A = A + (size_t)pm * 256 * K * 2; u.B = Bt + (size_t)pn * 256 * K * 2; u.gidx = nullptr; u.gcnt = 0; u.gshift = 0; u.row0 = pm * 256; u.col0 = pn * 256; u.aux = 0; return true;
    }
};
typedef DenseSchedT<false> DenseSched; typedef DenseSchedT<true> DenseSched8;
__device__ __forceinline__ u32x4 pack_bf16x8(const f32x4& v0, const f32x4& v1) { u32x4 w; w.x = pk2hw(v0[0], v0[1]); w.y = pk2hw(v0[2], v0[3]); w.z = pk2hw(v1[0], v1[1]); w.w = pk2hw(v1[2], v1[3]); return w; }

__device__ __forceinline__ unsigned pk4_fp8(float a, float b, float c, float d) {
    a = fminf(fmaxf(a, -448.0f), 448.0f); b = fminf(fmaxf(b, -448.0f), 448.0f); c = fminf(fmaxf(c, -448.0f), 448.0f); d = fminf(fmaxf(d, -448.0f), 448.0f);
    int w = 0; w = __builtin_amdgcn_cvt_pk_fp8_f32(a, b, w, false); w = __builtin_amdgcn_cvt_pk_fp8_f32(c, d, w, true); return (unsigned)w; }
constexpr float WUP_SCALE = 32.0f, WUP_INV = 1.0f / 32.0f;
struct EpiStoreBf16 {
    static constexpr bool PERM = true, PERM16 = false;
    bf16* O; int ldc; float osc, qsc;
    __device__ __forceinline__ void operator()(const f32x4 (&acc)[2][2][4][2], const pg8::UnitG& u, int wr, int wc, int fr, int fq) const {
        const float sc = ((u.col0 % 3072) < 1024) ? osc * qsc : osc;
#pragma unroll
        for (int ai = 0; ai < 2; ++ai)
#pragma unroll
            for (int m = 0; m < 4; ++m) { bf16* rowp = O + (size_t)(u.row0 + ai * 128 + wr * 64 + m * 16 + fr) * ldc + u.col0 + wc * 32 + 8 * fq;
#pragma unroll
                for (int bj = 0; bj < 2; ++bj) *(u32x4*)(rowp + bj * 128) = pack_bf16x8(acc[ai][bj][m][0] * sc, acc[ai][bj][m][1] * sc); }
    }
};
constexpr float YEXP_SCALE = 32.0f, YEXP_INV = 1.0f / 32.0f;
constexpr float A_SCALE = 16.0f;
constexpr float H_SCALE = 16.0f;
constexpr float Q8_SCALE = 64.0f, KV8_SCALE = 16.0f;
struct EpiStoreQkv8 {
    static constexpr bool PERM = false, PERM16 = true;
    unsigned char* O; int ldc;
    __device__ __forceinline__ void operator()(const f32x4 (&acc)[2][2][4][2], const pg8::UnitG& u, int wr, int wc, int fr, int fq) const {
        const float sc = ((u.col0 % 3072) < 1024) ? WUP_INV * 0.08838834764831845f * Q8_SCALE : WUP_INV * KV8_SCALE;
#pragma unroll
        for (int ai = 0; ai < 2; ++ai)
#pragma unroll
            for (int m = 0; m < 4; ++m) { unsigned char* rowp = O + (size_t)(u.row0 + ai * 128 + wr * 64 + m * 16 + fr) * ldc + u.col0 + wc * 64 + 16 * fq;
                u32x4 w;
#pragma unroll
                for (int q = 0; q < 4; ++q) { const f32x4 v = acc[ai][q >> 1][m][q & 1] * sc; w[q] = pk4_fp8(v[0], v[1], v[2], v[3]); }
                *(u32x4*)rowp = w; }
    }
};
struct EpiStoreFp8 {
    static constexpr bool PERM = false, PERM16 = true;
    unsigned char* O; int ldc;
    __device__ __forceinline__ void operator()(const f32x4 (&acc)[2][2][4][2], const pg8::UnitG& u, int wr, int wc, int fr, int fq) const {
#pragma unroll
        for (int ai = 0; ai < 2; ++ai)
#pragma unroll
            for (int m = 0; m < 4; ++m) { unsigned char* rowp = O + (size_t)(u.row0 + ai * 128 + wr * 64 + m * 16 + fr) * ldc + u.col0 + wc * 64 + 16 * fq;
                u32x4 w;
#pragma unroll
                for (int q = 0; q < 4; ++q) { f32x4 v = acc[ai][q >> 1][m][q & 1] * (YEXP_SCALE / (H_SCALE * WUP_SCALE));
#pragma unroll
                    for (int j = 0; j < 4; ++j) v[j] = fminf(fmaxf(v[j], -448.0f), 448.0f);
                    int d = 0; d = __builtin_amdgcn_cvt_pk_fp8_f32(v[0], v[1], d, false); d = __builtin_amdgcn_cvt_pk_fp8_f32(v[2], v[3], d, true); w[q] = (unsigned)d; }
                *(u32x4*)rowp = w; }
    }
};
constexpr float RQ_SCALE = 16.0f, RK_SCALE = 8.0f, RV_SCALE = 16.0f;
struct EpiRetIn {
    static constexpr bool PERM = false, PERM16 = true;
    unsigned char* O; int ldc;
    __device__ __forceinline__ void operator()(const f32x4 (&acc)[2][2][4][2], const pg8::UnitG& u, int wr, int wc, int fr, int fq) const {
        float l2g = 0.f;
        float cs = WUP_INV * RV_SCALE;
        if (u.col0 < 2048) { const int h = (u.col0 & 1023) >> 8; const float g = 1.0f - exp2f(-5.0f - (float)h); l2g = log2f(g); cs = WUP_INV * RQ_SCALE; if (u.col0 >= 1024) { l2g = -l2g; cs = WUP_INV * 0.0625f * RK_SCALE; } }
#pragma unroll
        for (int ai = 0; ai < 2; ++ai)
#pragma unroll
            for (int m = 0; m < 4; ++m) { const int row = u.row0 + ai * 128 + wr * 64 + m * 16 + fr; const float sc = exp2f(l2g * (float)(row & 127)) * cs;
                unsigned char* rowp = O + (size_t)row * ldc + u.col0 + wc * 64 + 16 * fq; u32x4 w;
#pragma unroll
                for (int q = 0; q < 4; ++q) { const f32x4 v = acc[ai][q >> 1][m][q & 1] * sc; w[q] = pk4_fp8(v[0], v[1], v[2], v[3]); }
                *(u32x4*)rowp = w; }
    }
};
__device__ __forceinline__ u32x4 cvt8_bf16(unsigned lo, unsigned hi) {
    const f32x2 a = __builtin_amdgcn_cvt_pk_f32_fp8((int)lo, false), b = __builtin_amdgcn_cvt_pk_f32_fp8((int)lo, true), c = __builtin_amdgcn_cvt_pk_f32_fp8((int)hi, false), d = __builtin_amdgcn_cvt_pk_f32_fp8((int)hi, true);
    u32x4 r; r.x = pk2(a[0], a[1]); r.y = pk2(b[0], b[1]); r.z = pk2(c[0], c[1]); r.w = pk2(d[0], d[1]); return r; }
__device__ __forceinline__ void unpack_bf16x8(const u32x4& w, f32x4& a, f32x4& b) { a[0] = bflo(w.x); a[1] = bfhi(w.x); a[2] = bflo(w.y); a[3] = bfhi(w.y); b[0] = bflo(w.z); b[1] = bfhi(w.z); b[2] = bflo(w.w); b[3] = bfhi(w.w); }
template <bool ALL16> struct EpiResidT {
    static constexpr bool PERM = true, PERM16 = false;
    const bf16* X; bf16* Y; float asc;
    __device__ __forceinline__ void operator()(const f32x4 (&acc)[2][2][4][2], const pg8::UnitG& u, int wr, int wc, int fr, int fq) const {
        constexpr int NB = ALL16 ? 1 : 2, PER = 2 / NB;
#pragma unroll
        for (int bt = 0; bt < NB; ++bt) {
            u32x4 xw[PER][4][2];
#pragma unroll
            for (int a2 = 0; a2 < PER; ++a2)
#pragma unroll
                for (int m = 0; m < 4; ++m) { const int ai = bt * PER + a2; const size_t off = (size_t)(u.row0 + ai * 128 + wr * 64 + m * 16 + fr) * D + u.col0 + wc * 32 + 8 * fq;
#pragma unroll
                    for (int bj = 0; bj < 2; ++bj) xw[a2][m][bj] = *(const u32x4*)(X + off + bj * 128); }
            asm volatile("" ::: "memory");
#pragma unroll
            for (int a2 = 0; a2 < PER; ++a2)
#pragma unroll
                for (int m = 0; m < 4; ++m) { const int ai = bt * PER + a2; const size_t off = (size_t)(u.row0 + ai * 128 + wr * 64 + m * 16 + fr) * D + u.col0 + wc * 32 + 8 * fq;
#pragma unroll
                    for (int bj = 0; bj < 2; ++bj) { f32x4 x0, x1; unpack_bf16x8(xw[a2][m][bj], x0, x1);
                        *(u32x4*)(Y + off + bj * 128) = pack_bf16x8(x0 * ALPHA + acc[ai][bj][m][0] * asc, x1 * ALPHA + acc[ai][bj][m][1] * asc); } }
            asm volatile("" ::: "memory");
        }
    }
};
typedef EpiResidT<true> EpiResid; typedef EpiResidT<false> EpiResid8;
struct EpiGluResid {
    static constexpr bool PERM = true, PERM16 = false;
    const bf16* X; bf16* Y; float asc;
    __device__ __forceinline__ void operator()(const f32x4 (&acc)[2][2][4][2], const pg8::UnitG& u, int wr, int wc, int fr, int fq) const {
        u32x4 xw[2][4];
#pragma unroll
        for (int ai = 0; ai < 2; ++ai)
#pragma unroll
            for (int m = 0; m < 4; ++m) { const size_t off = (size_t)(u.row0 + ai * 128 + wr * 64 + m * 16 + fr) * D + (u.col0 >> 1) + wc * 32 + 8 * fq; xw[ai][m] = *(const u32x4*)(X + off); }
        asm volatile("" ::: "memory");
#pragma unroll
        for (int ai = 0; ai < 2; ++ai)
#pragma unroll
            for (int m = 0; m < 4; ++m) { const size_t off = (size_t)(u.row0 + ai * 128 + wr * 64 + m * 16 + fr) * D + (u.col0 >> 1) + wc * 32 + 8 * fq;
                f32x4 x0, x1; unpack_bf16x8(xw[ai][m], x0, x1); f32x4 o0, o1;
#pragma unroll
                for (int j = 0; j < 4; ++j) { o0[j] = x0[j] * ALPHA + acc[ai][0][m][0][j] * asc * fsig(acc[ai][1][m][0][j] * asc); o1[j] = x1[j] * ALPHA + acc[ai][0][m][1][j] * asc * fsig(acc[ai][1][m][1][j] * asc); }
                *(u32x4*)(Y + off) = pack_bf16x8(o0, o1); }
    }
};
struct EpiMoeUp {
    static constexpr bool PERM = true, PERM16 = false;
    unsigned char* H;
    __device__ __forceinline__ void operator()(const f32x4 (&acc)[2][2][4][2], const pg8::UnitG& u, int wr, int wc, int fr, int fq) const {
        typedef unsigned u2_t __attribute__((ext_vector_type(2)));
#pragma unroll
        for (int ai = 0; ai < 2; ++ai) {
            u32x2 w8[4];
#pragma unroll
            for (int m = 0; m < 4; ++m) { f32x4 o[2];
#pragma unroll
                for (int n = 0; n < 2; ++n)
#pragma unroll
                    for (int j = 0; j < 4; ++j) { const float ga = acc[ai][0][m][n][j], ua = acc[ai][1][m][n][j];
                        o[n][j] = (ga * ua) * (WUP_INV * WUP_INV * H_SCALE) * __builtin_amdgcn_rcpf(1.0f + __builtin_amdgcn_exp2f(ga * (-WUP_INV * 1.4426950408889634f))); }
                w8[m].x = pk4_fp8(o[0][0], o[0][1], o[0][2], o[0][3]); w8[m].y = pk4_fp8(o[1][0], o[1][1], o[1][2], o[1][3]); }
            u32x4 s0, s1;
            { const u2_t a = __builtin_amdgcn_permlane16_swap(w8[0].x, w8[2].x, false, false), b = __builtin_amdgcn_permlane16_swap(w8[0].y, w8[2].y, false, false);
              s0.x = a.x; s0.y = b.x; s0.z = a.y; s0.w = b.y; }
            { const u2_t a = __builtin_amdgcn_permlane16_swap(w8[1].x, w8[3].x, false, false), b = __builtin_amdgcn_permlane16_swap(w8[1].y, w8[3].y, false, false);
              s1.x = a.x; s1.y = b.x; s1.z = a.y; s1.w = b.y; }
            const int mb = (fq & 1) ? 2 : 0;
            unsigned char* rowp = H + (size_t)(u.row0 + ai * 128 + wr * 64 + mb * 16 + fr) * ED + u.col0 + wc * 32 + 8 * (fq & 2);
            *(u32x4*)rowp = s0; *(u32x4*)(rowp + (size_t)16 * ED) = s1; }
    }
};

struct ConvD { const float* src; unsigned char* dst; unsigned char* dst2; int ldw, ldk, kind; };
__device__ __forceinline__ ConvD conv_mk8(const float* W, int ldw, unsigned char* WT, int ldk, int k0, int n0, int drow0) {
    ConvD d; d.src = W + (size_t)k0 * ldw + n0; d.dst = WT + (size_t)drow0 * ldk + k0; d.dst2 = nullptr; d.ldw = ldw; d.ldk = ldk; d.kind = 1; return d; }
__device__ __forceinline__ ConvD conv_mk16(const float* W, int ldw, bf16* WT, bf16* WTlo, int ldk, int k0, int n0, int drow0) {
    ConvD d; d.src = W + (size_t)k0 * ldw + n0; d.dst = (unsigned char*)(WT + (size_t)drow0 * ldk + k0); d.dst2 = WTlo ? (unsigned char*)(WTlo + (size_t)drow0 * ldk + k0) : nullptr; d.ldw = ldw; d.ldk = ldk * 2; d.kind = WTlo ? 2 : 0; return d; }
__device__ __forceinline__ void conv_load(const ConvD& d, int lane, f32x4 (&r)[8]) {
#pragma unroll
    for (int i = 0; i < 8; ++i) { const int kk = 8 * i + (lane >> 3), c4 = 4 * (lane & 7); r[i] = *(const f32x4*)(d.src + (size_t)kk * d.ldw + c4); }
}
template <bool HILO>
__device__ __forceinline__ void conv_finish(const ConvD& d, int lane, const f32x4 (&r)[8], LAS float* scr) {
    const float scale = (d.kind == 1) ? WUP_SCALE : 1.0f;
#pragma unroll
    for (int i = 0; i < 8; ++i) { const int kk = 8 * i + (lane >> 3), c4 = 4 * (lane & 7);
        scr[kk * 33 + c4] = r[i][0] * scale; scr[kk * 33 + c4 + 1] = r[i][1] * scale; scr[kk * 33 + c4 + 2] = r[i][2] * scale; scr[kk * 33 + c4 + 3] = r[i][3] * scale; }
    LDS_WAIT(); asm volatile("" ::: "memory");
    const int c = lane & 7;
#pragma unroll
    for (int j = 0; j < 4; ++j) { const int n = (lane >> 3) + 8 * j; const LAS float* s = scr + (8 * c) * 33 + n;
        float v[8];
#pragma unroll
        for (int q = 0; q < 8; ++q) v[q] = s[q * 33];
        if (d.kind == 1) { u32x2 o; o.x = pk4_fp8(v[0], v[1], v[2], v[3]); o.y = pk4_fp8(v[4], v[5], v[6], v[7]); *(u32x2*)(d.dst + (size_t)n * d.ldk + 8 * c) = o; }
        else { u32x4 o; o.x = pk2(v[0], v[1]); o.y = pk2(v[2], v[3]); o.z = pk2(v[4], v[5]); o.w = pk2(v[6], v[7]);
            *(u32x4*)(d.dst + (size_t)n * d.ldk + 16 * c) = o;
            if (HILO) { float rr[8];
#pragma unroll
                for (int q = 0; q < 8; ++q) rr[q] = v[q] - bf2f(f2bf(v[q]));
                u32x4 o2; o2.x = pk2(rr[0], rr[1]); o2.y = pk2(rr[2], rr[3]); o2.z = pk2(rr[4], rr[5]); o2.w = pk2(rr[6], rr[7]);
                *(u32x4*)(d.dst2 + (size_t)n * d.ldk + 16 * c) = o2; } } }
    LDS_WAIT(); asm volatile("" ::: "memory");
}
__device__ __forceinline__ void conv_dma(const ConvD& d, int lane, LAS float* buf) {
#pragma unroll
    for (int i = 0; i < 8; ++i) { const float* g = d.src + (size_t)(8 * i + (lane >> 3)) * d.ldw + 4 * ((lane & 7) ^ i);
        __builtin_amdgcn_global_load_lds((const unsigned*)g, (LAS unsigned*)(buf + i * 256), 16, 0, 0); }
}
__device__ __forceinline__ void conv_finish_lds(const ConvD& d, int lane, const LAS float* buf) {
    const float scale = (d.kind == 1) ? WUP_SCALE : 1.0f;
    const int c = lane & 7;
#pragma unroll
    for (int j = 0; j < 4; ++j) { const int n = (lane >> 3) + 8 * j; const LAS float* s = buf + (8 * c) * 32 + (((n >> 2) ^ c) & 7) * 4 + (n & 3);
        float v[8];
#pragma unroll
        for (int q = 0; q < 8; ++q) v[q] = s[q * 32] * scale;
        if (d.kind == 1) { u32x2 o; o.x = pk4_fp8(v[0], v[1], v[2], v[3]); o.y = pk4_fp8(v[4], v[5], v[6], v[7]); *(u32x2*)(d.dst + (size_t)n * d.ldk + 8 * c) = o; }
        else { u32x4 o; o.x = pk2(v[0], v[1]); o.y = pk2(v[2], v[3]); o.z = pk2(v[4], v[5]); o.w = pk2(v[6], v[7]); *(u32x4*)(d.dst + (size_t)n * d.ldk + 16 * c) = o; } }
    LDS_WAIT(); asm volatile("" ::: "memory");
}
#define CONV_RUN(NIT, DEC) do { int it_ = gw; if (it_ < (NIT)) { ConvD dc_ = DEC(it_); int par_ = 0; conv_dma(dc_, F.lane, scr); asm volatile("s_waitcnt vmcnt(0)" ::: "memory"); \
        for (; it_ < (NIT); it_ += NGW) { const int itn_ = (it_ + NGW < (NIT)) ? it_ + NGW : it_; const ConvD dn_ = DEC(itn_); conv_dma(dn_, F.lane, scr + (par_ ^ 1) * 2048);     \
            asm volatile("s_waitcnt vmcnt(12)" ::: "memory"); conv_finish_lds(dc_, F.lane, scr + par_ * 2048); dc_ = dn_; par_ ^= 1; } \
        asm volatile("s_waitcnt vmcnt(0)" ::: "memory"); } } while (0)
__device__ __forceinline__ ConvD conv_dec_mixers(KP p, unsigned char* ws, int it) {
    constexpr int I_AIN = 16 * 288, I_AOUT = 16 * 32, I_RIN = 16 * 192, I_ROUT = 32 * 32, I_GLU = 16 * 64, I_RT = 16 * 2;
    int r = it;
    if (r < 2 * I_AIN) { const int j = r / I_AIN; r %= I_AIN; const int kb = r / 288, nb = r % 288, n0 = nb * 32;
        return conv_mk8(gin(p, 1) + (size_t)j * D * ATT_IN, ATT_IN, (unsigned char*)(ws + WS_ATT_IN_T) + (size_t)j * ATT_IN * D, D, kb * 64, n0, n0); }
    r -= 2 * I_AIN;
    if (r < 2 * I_AOUT) { const int j = r / I_AOUT; r %= I_AOUT; const int kb = r / 32, nb = r % 32, n0 = nb * 32;
        return conv_mk8(gin(p, 2) + (size_t)j * D * D, D, (unsigned char*)(ws + WS_ATT_OUT_T) + (size_t)j * D * D, D, kb * 64, n0, n0); }
    r -= 2 * I_AOUT;
    if (r < I_RIN) { const int kb = r / 192, nb = r % 192, n0 = nb * 32;
        return conv_mk8(gin(p, 3), RET_IN, (unsigned char*)(ws + WS_RET_IN_T), D, kb * 64, n0, n0); }
    r -= I_RIN;
    if (r < I_ROUT) { const int kb = r / 32, nb = r % 32, n0 = nb * 32;
        return conv_mk8(gin(p, 6), D, (unsigned char*)(ws + WS_RET_OUT_T), RET_V, kb * 64, n0, n0); }
    r -= I_ROUT;
    if (r < I_GLU) { const int kb = r / 64, nb = r % 64, n0 = nb * 32; const int c = n0 & 1023, drow = (c >> 7) * 256 + (n0 >> 10) * 128 + (c & 127);
        return conv_mk8(gin(p, 15), 2 * D, (unsigned char*)(ws + WS_GLU_T), D, kb * 64, n0, drow); }
    r -= I_GLU;
    { const int l = r / I_RT; r %= I_RT; const int kb = r / 2, nb = r % 2, n0 = nb * 32;
        return conv_mk16(gin(p, 16) + (size_t)l * D * NE, NE, (bf16*)(ws + WS_RT_HI) + (size_t)l * NE * D, (bf16*)(ws + WS_RT_LO) + (size_t)l * NE * D, D, kb * 64, n0, n0); }
}
__device__ __forceinline__ ConvD conv_dec_moe(KP p, unsigned char* ws, int l, int it) {
    const int e = it / 384, r = it % 384, which = r >> 7, rr = r & 127;
    bf16* We = (bf16*)(ws + WS_WMOE + (size_t)e * WMOE_E_BYTES);
    if (which < 2) { const float* src = (e < 64) ? gin(p, 18 + which) + ((size_t)l * NE + e) * D * ED : gin(p, 21 + which) + (size_t)l * D * ED;
        const int kb = rr >> 3, nb = rr & 7, n0 = nb * 32; const int drow = (n0 >> 7) * 256 + which * 128 + (n0 & 127);
        return conv_mk8(src, ED, (unsigned char*)We, D, kb * 64, n0, drow); }
    const float* src = (e < 64) ? gin(p, 20) + ((size_t)l * NE + e) * ED * D : gin(p, 23) + (size_t)l * ED * D;
    const int kb = rr >> 5, nb = rr & 31, n0 = nb * 32;
    return conv_mk8(src, D, (unsigned char*)(We + 512 * 1024), ED, kb * 64, n0, n0);
}
__device__ __forceinline__ void phase_conv_mixers(const Frame& F, KP p) {
    LAS float* scr = (LAS float*)(F.lds + F.wave * 16384);
    const int gw = F.vcu * NWAVES + F.wave, NGW = F.G * NWAVES;
    constexpr int NMAIN = 2 * (16 * 288) + 2 * (16 * 32) + 16 * 192 + 32 * 32 + 16 * 64, NRT = 4 * (16 * 2);
    unsigned char* ws = F.ws;
#define CONV_DEC_MIX(i_) conv_dec_mixers(p, ws, (i_))
    CONV_RUN(NMAIN, CONV_DEC_MIX);
    for (int it = NMAIN + gw; it < NMAIN + NRT; it += NGW) { const ConvD d = conv_dec_mixers(p, ws, it); f32x4 r[8]; conv_load(d, F.lane, r); conv_finish<true>(d, F.lane, r, scr); }
#undef CONV_DEC_MIX
}
__device__ __forceinline__ void phase_conv_moe(const Frame& F, KP p, int l) {
    LAS float* scr = (LAS float*)(F.lds + F.wave * 16384);
    const int gw = F.vcu * NWAVES + F.wave, NGW = F.G * NWAVES;
    unsigned char* ws = F.ws;
#define CONV_DEC_MOE(i_) conv_dec_moe(p, ws, l, (i_))
    CONV_RUN(65 * 384, CONV_DEC_MOE);
#undef CONV_DEC_MOE
}

__device__ __forceinline__ void phase_lnr(const Frame& F, KP p, int layer, bool dry = false) {
    const bf16* Y = (const bf16*)(F.ws + WS_Y); bf16* XB = (bf16*)(F.ws + WS_XB); unsigned char* XB8 = (unsigned char*)(F.ws + WS_X);
    const float* lng = gin(p, 24) + (size_t)(layer * 2) * D; const float* lnb = gin(p, 25) + (size_t)(layer * 2) * D;
    const bf16* rthi = (const bf16*)(F.ws + WS_RT_HI) + (size_t)layer * NE * D; const bf16* rtlo = (const bf16*)(F.ws + WS_RT_LO) + (size_t)layer * NE * D;
    const float* rbias = gin(p, 17) + layer * NE;
    unsigned* cnt = (unsigned*)(F.ws + WS_CTL) + CW_CNT + layer * NE * 64;
    int* lists = (int*)(F.ws + WS_LIST); int* tokmap = (int*)(F.ws + WS_LIST + 4 * MiB); float* tokgate = (float*)(F.ws + WS_LIST + 5 * MiB);
    constexpr int XLD = 1032, MAXT = 8;
    LAS bf16* Xhi = (LAS bf16*)F.lds; LAS bf16* Xlo = Xhi + 16 * XLD;
    LAS float* part = (LAS float*)(F.lds + 2 * 16 * XLD * 2);
    LAS int* ent = (LAS int*)(part + 2 * 16 * 64);
    LAS int* hist = ent + MAXT * 16 * 8 * 2; LAS int* base = hist + 64;
    const int lane = F.lane, w = F.wave, g4 = lane >> 4, l15 = lane & 15;
    if (F.tid < 64) hist[F.tid] = 0;
    bf16x8 bhi[16], blo[16];
    { const int nt = w & 3, kh = w >> 2; const bf16* bh = rthi + (size_t)(16 * nt + l15) * D + 512 * kh + 8 * g4; const bf16* bl = rtlo + (size_t)(16 * nt + l15) * D + 512 * kh + 8 * g4;
#pragma unroll
        for (int ks = 0; ks < 16; ++ks) { bhi[ks] = *(const bf16x8*)(bh + 32 * ks); blo[ks] = *(const bf16x8*)(bl + 32 * ks); } }
    u32x4 ypre[2][2];
    if (F.vcu < T / 16) {
#pragma unroll
        for (int rr = 0; rr < 2; ++rr)
#pragma unroll
            for (int j = 0; j < 2; ++j) ypre[rr][j] = *(const u32x4*)(Y + (size_t)(F.vcu * 16 + 2 * w + rr) * D + 8 * lane + 512 * j); }
    int ntile = 0;
    for (int tile = F.vcu; tile < T / 16 && ntile < MAXT; tile += F.G, ++ntile) {
        const int t0 = tile * 16;
        u32x4 ycur[2][2];
#pragma unroll
        for (int rr = 0; rr < 2; ++rr)
#pragma unroll
            for (int j = 0; j < 2; ++j) ycur[rr][j] = ypre[rr][j];
        if (tile + F.G < T / 16) {
#pragma unroll
            for (int rr = 0; rr < 2; ++rr)
#pragma unroll
                for (int j = 0; j < 2; ++j) ypre[rr][j] = *(const u32x4*)(Y + (size_t)((tile + F.G) * 16 + 2 * w + rr) * D + 8 * lane + 512 * j); }
#pragma unroll
        for (int rr = 0; rr < 2; ++rr) {
            const int lr = 2 * w + rr; const size_t row = (size_t)(t0 + lr);
            f32x4 v[4]; float s = 0.f;
#pragma unroll
            for (int j = 0; j < 2; ++j) unpack_bf16x8(ycur[rr][j], v[2 * j], v[2 * j + 1]);
#pragma unroll
            for (int j = 0; j < 4; ++j) s += (v[j][0] + v[j][1]) + (v[j][2] + v[j][3]);
            const float mean = wave_sum(s, lane) * (1.f / D); float s2 = 0.f;
#pragma unroll
            for (int j = 0; j < 4; ++j) { v[j] = v[j] - mean; s2 += (v[j][0] * v[j][0] + v[j][1] * v[j][1]) + (v[j][2] * v[j][2] + v[j][3] * v[j][3]); }
            const float rstd = 1.0f / sqrtf(wave_sum(s2, lane) * (1.f / D) + LN_EPS);
#pragma unroll
            for (int j = 0; j < 2; ++j) { const f32x4 g0 = *(const f32x4*)(lng + 8 * lane + 512 * j), g1 = *(const f32x4*)(lng + 8 * lane + 512 * j + 4), b0 = *(const f32x4*)(lnb + 8 * lane + 512 * j), b1 = *(const f32x4*)(lnb + 8 * lane + 512 * j + 4);
                const f32x4 o0 = v[2 * j] * rstd * g0 + b0, o1 = v[2 * j + 1] * rstd * g1 + b1;
                const u32x4 hi = pack_bf16x8(o0, o1);
                *(u32x4*)(XB + row * D + 8 * lane + 512 * j) = hi;
                { u32x2 q8; q8.x = pk4_fp8(o0[0], o0[1], o0[2], o0[3]); q8.y = pk4_fp8(o1[0], o1[1], o1[2], o1[3]); *(u32x2*)(XB8 + row * D + 8 * lane + 512 * j) = q8; }
                f32x4 h0, h1; unpack_bf16x8(hi, h0, h1); const u32x4 lo = pack_bf16x8(o0 - h0, o1 - h1);
                *(LAS u32x4*)(Xhi + lr * XLD + 8 * lane + 512 * j) = hi; *(LAS u32x4*)(Xlo + lr * XLD + 8 * lane + 512 * j) = lo; }
        }
        __syncthreads();
        { const int nt = w & 3, kh = w >> 2; f32x4 a0 = (f32x4){0.f, 0.f, 0.f, 0.f}, a1 = a0, a2 = a0, a3 = a0, a4 = a0, a5 = a0;
#pragma unroll
            for (int ks = 0; ks < 16; ks += 2) { const int k0 = 512 * kh + 32 * ks;
                const bf16x8 ahi = row_frag(Xhi, XLD, 0, k0, lane), alo = row_frag(Xlo, XLD, 0, k0, lane), bhi2 = row_frag(Xhi, XLD, 0, k0 + 32, lane), blo2 = row_frag(Xlo, XLD, 0, k0 + 32, lane);
                a0 = MFMA16(ahi, bhi[ks], a0); a1 = MFMA16(alo, bhi[ks], a1); a2 = MFMA16(ahi, blo[ks], a2);
                a3 = MFMA16(bhi2, bhi[ks + 1], a3); a4 = MFMA16(blo2, bhi[ks + 1], a4); a5 = MFMA16(bhi2, blo[ks + 1], a5); }
            const f32x4 acc = ((a0 + a3) + (a1 + a4)) + (a2 + a5);
#pragma unroll
            for (int i = 0; i < 4; ++i) part[(kh * 16 + 4 * g4 + i) * 64 + 16 * nt + l15] = acc[i];
        }
        __syncthreads();
#pragma unroll
        for (int rr = 0; rr < 2; ++rr) {
            const int lt = ntile * 16 + 2 * w + rr;
            const float lg = part[(2 * w + rr) * 64 + lane] + part[(16 + 2 * w + rr) * 64 + lane];
            float sc = fsig(lg); sc = (sc == sc) ? sc : 0.5f;
            const float sel = sc + rbias[lane];
            const float m1 = max8(sel);
            const unsigned long long eq = __ballot(sel == m1);
            const unsigned gm = (unsigned)(eq >> (lane & 56)) & 0xffu;
            const int first = (lane & 56) + __builtin_ctz(gm | 0x100u);
            const float m2 = max8((lane == first) ? -INFINITY : sel);
            const float gs = m1 + m2; const int mygrp = lane >> 3; int grank = 0;
#pragma unroll
            for (int gg = 0; gg < 8; ++gg) { const float o = rdl(gs, 8 * gg); grank += (o > gs || (o == gs && gg < mygrp)) ? 1 : 0; }
            const float mv = (grank < 4) ? sel : -INFINITY;
            unsigned key = __builtin_bit_cast(unsigned, mv); key = (key >> 31) ? ~key : (key | 0x80000000u); key = (key & ~63u) | (unsigned)(63 - lane);
            int rank = 64; { unsigned kw = key;
#pragma unroll
                for (int r = 0; r < TOPK; ++r) { const unsigned m = wave_umax(kw); if (kw == m) { rank = r; kw = 0u; } } }
            const bool chosen = rank < TOPK;
            const float wsum = wave_sum(chosen ? sc : 0.f, lane);
            if (chosen) { const int lpos = __hip_atomic_fetch_add(hist + lane, 1, __ATOMIC_RELAXED, __HIP_MEMORY_SCOPE_WORKGROUP);
                ent[(lt * 8 + rank) * 2] = (lane << 16) | lpos; ent[(lt * 8 + rank) * 2 + 1] = __builtin_bit_cast(int, sc * __builtin_amdgcn_rcpf(wsum) * 2.5f); }
        }
    }
    __syncthreads();
    if (dry) return;
    if (F.tid < 64) { const int hcount = hist[F.tid]; base[F.tid] = hcount ? (int)atomicAdd(cnt + F.tid * 64, (unsigned)hcount) : 0; }
    __syncthreads();
    for (int idx = F.tid; idx < ntile * 16 * 8; idx += NTHREADS) {
        const int ev = ent[idx * 2], gb = ent[idx * 2 + 1]; const int e = ev >> 16, pos = base[e] + (ev & 0xffff);
        const int lt = idx >> 3, rank = idx & 7, tok = (F.vcu + (lt >> 4) * F.G) * 16 + (lt & 15);
        lists[(size_t)e * T + pos] = tok; tokmap[tok * 8 + rank] = (e << 16) | pos; tokgate[tok * 8 + rank] = __builtin_bit_cast(float, gb);
    }
}

__device__ __forceinline__ void phase_combine(const Frame& F, KP p, int layer, bool dry = false) {
    bf16* XB = (bf16*)(F.ws + WS_XB); const unsigned char* yexp = (const unsigned char*)(F.ws + WS_BIG);
    const int* tokmap = (const int*)(F.ws + WS_LIST + 4 * MiB); const float* tokgate = (const float*)(F.ws + WS_LIST + 5 * MiB);
    const volatile LAS int* tstart = (const volatile LAS int*)(F.MISC + 64);
    const float* lng = gin(p, 24) + (size_t)(layer * 2 + 1) * D; const float* lnb = gin(p, 25) + (size_t)(layer * 2 + 1) * D;
    float* outp = gout(p); bf16* xbo = XB; if (dry) { outp = (float*)(F.ws + WS_AUX); xbo = (bf16*)(F.ws + WS_H); }
    const int lane = F.lane, gw = F.vcu * NWAVES + F.wave, NGW = F.G * NWAVES;
    const bf16* ysh = (const bf16*)(F.ws + WS_Y);
    f32x4 gv[4], bv[4];
#pragma unroll
    for (int j = 0; j < 4; ++j) { gv[j] = *(const f32x4*)(lng + 16 * lane + 4 * j); bv[j] = *(const f32x4*)(lnb + 16 * lane + 4 * j); }
    for (int row = gw; row < T; row += NGW) {
        const int mk = tokmap[row * 8 + (lane & 7)]; const float gk = tokgate[row * 8 + (lane & 7)] * YEXP_INV;
        const int rk = (int)tstart[mk >> 16] * 256 + (mk & 0xffff);
        f32x4 v[4];
#pragma unroll
        for (int j = 0; j < 2; ++j) { const u32x4 xw = *(const u32x4*)(ysh + (size_t)row * D + 16 * lane + 8 * j); unpack_bf16x8(xw, v[2 * j], v[2 * j + 1]); }
#pragma unroll
        for (int k = 0; k < TOPK; ++k) { const int r = __builtin_amdgcn_readlane(rk, k); const float g = rdl(gk, k);
            const u32x4 s = *(const u32x4*)(yexp + (size_t)r * D + 16 * lane);
#pragma unroll
            for (int j = 0; j < 4; ++j) { const f32x2 lo = __builtin_amdgcn_cvt_pk_f32_fp8((int)s[j], false), hi = __builtin_amdgcn_cvt_pk_f32_fp8((int)s[j], true);
                v[j][0] += g * lo[0]; v[j][1] += g * lo[1]; v[j][2] += g * hi[0]; v[j][3] += g * hi[1]; } }
        float s = 0.f;
#pragma unroll
        for (int j = 0; j < 4; ++j) s += (v[j][0] + v[j][1]) + (v[j][2] + v[j][3]);
        const float mean = wave_sum(s, lane) * (1.f / D); float s2 = 0.f;
#pragma unroll
        for (int j = 0; j < 4; ++j) { v[j] = v[j] - mean; s2 += (v[j][0] * v[j][0] + v[j][1] * v[j][1]) + (v[j][2] * v[j][2] + v[j][3] * v[j][3]); }
        const float rstd = 1.0f / sqrtf(wave_sum(s2, lane) * (1.f / D) + LN_EPS);
        f32x4 o[4];
#pragma unroll
        for (int j = 0; j < 4; ++j) o[j] = v[j] * rstd * gv[j] + bv[j];
        if (layer == DEPTH - 1 || dry) {
#pragma unroll
            for (int j = 0; j < 4; ++j) *(f32x4*)(outp + (size_t)row * D + 16 * lane + 4 * j) = o[j]; }
        if (layer != DEPTH - 1) { *(u32x4*)(xbo + (size_t)row * D + 16 * lane) = pack_bf16x8(o[0], o[1]); *(u32x4*)(xbo + (size_t)row * D + 16 * lane + 8) = pack_bf16x8(o[2], o[3]);
            if (!dry) { u32x4 q8; q8.x = pk4_fp8(o[0][0], o[0][1], o[0][2], o[0][3]); q8.y = pk4_fp8(o[1][0], o[1][1], o[1][2], o[1][3]); q8.z = pk4_fp8(o[2][0], o[2][1], o[2][2], o[2][3]); q8.w = pk4_fp8(o[3][0], o[3][1], o[3][2], o[3][3]);
                *(u32x4*)((unsigned char*)(F.ws + WS_X) + (size_t)row * D + 16 * lane) = q8; } }
    }
}

constexpr size_t AUX_OB = 96 * MiB, AUX_LSE = 128 * MiB;
__device__ __forceinline__ unsigned att_qoff(int R, int j, int qi, int g4) {
    const int h = R & 7, sbr = R >> 3, g = sbr >> 5, rem = sbr & 31, b = rem >> 4, rr_ = rem & 15;
    const int dsh = 2 * g, d = 1 << dsh, nrs = 4 - dsh, r = rr_ >> nrs, n = 4 * (rr_ & ((1 << nrs) - 1)) + j;
    const unsigned qrow = (unsigned)b * SEQ + (unsigned)(128 * n + qi) * (unsigned)d + (unsigned)r;
    return qrow * (unsigned)ATT_IN + (unsigned)(g * 3072 + h * 128 + 8 * g4);
}
__device__ __forceinline__ void phase_attn(const Frame& F, int bx) {
    const unsigned char* qkv = (const unsigned char*)(F.ws + WS_BIG); bf16* og = (bf16*)(F.ws + WS_AUX); float* lse = (float*)(F.ws + WS_AUX + AUX_LSE);
    constexpr int KLD = 136;
    LAS bf16* Ks = (LAS bf16*)F.lds; LAS bf16* Vs = Ks + 256 * KLD;
    const int lane = F.lane, w = F.wave, g4 = lane >> 4, l15 = lane & 15, qq = l15 >> 2, pp = lane & 3;
    u32x4 kc[2], vc[2];
    constexpr int NRUN = 768;
#define ATT_CVT8(lo_, hi_) ({ const f32x2 a_ = __builtin_amdgcn_cvt_pk_f32_fp8((int)(lo_), false), b_ = __builtin_amdgcn_cvt_pk_f32_fp8((int)(lo_), true), c_ = __builtin_amdgcn_cvt_pk_f32_fp8((int)(hi_), false), d_ = __builtin_amdgcn_cvt_pk_f32_fp8((int)(hi_), true); \
        u32x4 r_; r_.x = pk2(a_[0], a_[1]); r_.y = pk2(b_[0], b_[1]); r_.z = pk2(c_[0], c_[1]); r_.w = pk2(d_[0], d_[1]); r_; })
#define ATT_LOADBLK(KR, VR, nblk) do { _Pragma("unroll") for (int it = 0; it < 2; ++it) { const int idx = F.tid + 512 * it, c = idx >> 3, ch = idx & 7; int pos = 128 * (nblk) + c; pos = pos < 0 ? 0 : pos; \
            const unsigned so = (rowbase + (unsigned)pos * (unsigned)d + (unsigned)r) * (unsigned)ATT_IN + (unsigned)(g * 3072 + 1024 + h * 128 + ch * 16); KR[it] = *(const u32x4*)(qkv + so); VR[it] = *(const u32x4*)(qkv + so + 1024u); } } while (0)
#define ATT_STOREBLK(KR, VR, slot) do { _Pragma("unroll") for (int it = 0; it < 2; ++it) { const int idx = F.tid + 512 * it, c = idx >> 3, ch = idx & 7; \
            *(LAS u32x4*)(Ks + (128 * (slot) + c) * KLD + ch * 16) = ATT_CVT8(KR[it].x, KR[it].y); *(LAS u32x4*)(Ks + (128 * (slot) + c) * KLD + ch * 16 + 8) = ATT_CVT8(KR[it].z, KR[it].w); \
            *(LAS u32x4*)(Vs + (128 * (slot) + c) * KLD + ch * 16) = ATT_CVT8(VR[it].x, VR[it].y); *(LAS u32x4*)(Vs + (128 * (slot) + c) * KLD + ch * 16 + 8) = ATT_CVT8(VR[it].z, VR[it].w); } } while (0)
    const int qi = 16 * w + l15;
    u32x2 qraw[4];
    if (bx < NRUN) { const unsigned qo = att_qoff(bx, 0, qi, g4);
#pragma unroll
        for (int s = 0; s < 4; ++s) qraw[s] = *(const u32x2*)(qkv + qo + 32 * s); }
    for (int R = bx; R < NRUN; R += F.G) {
        const int h = R & 7, sbr = R >> 3, g = sbr >> 5, rem = sbr & 31, b = rem >> 4, rr_ = rem & 15;
        const int dsh = 2 * g, d = 1 << dsh, nrs = 4 - dsh, r = rr_ >> nrs, n0 = 4 * (rr_ & ((1 << nrs) - 1)); const unsigned rowbase = (unsigned)b * SEQ;
        { u32x4 k0[2], v0[2]; ATT_LOADBLK(k0, v0, n0 - 1); ATT_LOADBLK(kc, vc, n0); ATT_STOREBLK(k0, v0, (n0 - 1) & 1); }
#pragma unroll 1
        for (int j = 0; j < 4; ++j) {
            const int n = n0 + j, cs = n & 1, ps = cs ^ 1;
            ATT_STOREBLK(kc, vc, cs);
            const unsigned qrow = rowbase + (unsigned)(128 * n + qi) * (unsigned)d + (unsigned)r;
            bf16x8 qf[4];
#pragma unroll
            for (int s = 0; s < 4; ++s) qf[s] = __builtin_bit_cast(bf16x8, ATT_CVT8(qraw[s].x, qraw[s].y));
            __syncthreads();
            if (j < 3) { ATT_LOADBLK(kc, vc, n + 1); }
            __builtin_amdgcn_sched_barrier(0);
            const int ws0 = (16 * w < 96) ? 16 * w : 96;
#define ATT_PROW(c0) (((c0) < 128) ? (128 * ps + (c0)) : (128 * cs + (c0) - 128))
            f32x4 sacc[10];
            {
                bf16x8 kfa[4], kfb[4];
#pragma unroll
                for (int s = 0; s < 4; ++s) kfa[s] = row_frag(Ks, KLD, ATT_PROW(ws0), 32 * s, lane);
#pragma unroll
                for (int t = 0; t < 10; t += 2) {
#pragma unroll
                    for (int s = 0; s < 4; ++s) kfb[s] = row_frag(Ks, KLD, ATT_PROW(ws0 + 16 * (t + 1)), 32 * s, lane);
                    __builtin_amdgcn_sched_barrier(0);
                    sacc[t] = (f32x4){0.f, 0.f, 0.f, 0.f};
#pragma unroll
                    for (int s = 0; s < 4; ++s) sacc[t] = MFMA16(kfa[s], qf[s], sacc[t]);
                    if (t + 2 < 10) {
#pragma unroll
                        for (int s = 0; s < 4; ++s) kfa[s] = row_frag(Ks, KLD, ATT_PROW(ws0 + 16 * (t + 2)), 32 * s, lane); }
                    __builtin_amdgcn_sched_barrier(0);
                    sacc[t + 1] = (f32x4){0.f, 0.f, 0.f, 0.f};
#pragma unroll
                    for (int s = 0; s < 4; ++s) sacc[t + 1] = MFMA16(kfb[s], qf[s], sacc[t + 1]);
                }
            }
            { const int Rn = (j < 3) ? R : ((R + F.G < NRUN) ? R + F.G : R), jn = (j < 3) ? j + 1 : 0; const unsigned qo = att_qoff(Rn, jn, qi, g4);
#pragma unroll
              for (int s = 0; s < 4; ++s) qraw[s] = *(const u32x2*)(qkv + qo + 32 * s); }
            const float slope = exp2f(-(float)(h + 1)) * (float)d;
            float mx = -INFINITY;
            int sbase = 128 + qi - ws0 - 4 * g4; asm volatile("" : "+v"(sbase));
            const float nsb = -slope * (float)sbase; const int kmin = (n > 0) ? sbase - 128 : ((sbase - 128 > 128 - ws0 - 4 * g4) ? sbase - 128 : 128 - ws0 - 4 * g4);
#pragma unroll
            for (int t = 0; t < 10; ++t)
#pragma unroll
                for (int i = 0; i < 4; ++i) { const int k = 16 * t + i;
                    const bool valid = (k <= sbase) && (k >= kmin);
                    const float v = valid ? __builtin_fmaf(slope, (float)k, __builtin_fmaf(sacc[t][i], 1.0f / (Q8_SCALE * KV8_SCALE), nsb)) : -INFINITY; sacc[t][i] = v; mx = fmaxf(mx, v); }
            mx = fmaxf(mx, shx(mx, 16, lane)); mx = fmaxf(mx, shx(mx, 32, lane));
            float lsum = 0.f;
#pragma unroll
            for (int t = 0; t < 10; ++t)
#pragma unroll
                for (int i = 0; i < 4; ++i) { const float pv = __expf(sacc[t][i] - mx); sacc[t][i] = pv; lsum += pv; }
            lsum += shx(lsum, 16, lane); lsum += shx(lsum, 32, lane);
            bf16x8 pf[5];
#pragma unroll
            for (int kt = 0; kt < 5; ++kt) pf[kt] = pack8(sacc[2 * kt], sacc[2 * kt + 1]);
            f32x4 o[8];
            {
                const LAS bf16* vl = Vs + (4 * g4 + qq) * KLD + 32 * pp;
                bf16x4 va[10], vcc[10];
#pragma unroll
                for (int q = 0; q < 10; ++q) va[q] = tr4(vl + ATT_PROW(ws0 + 16 * q) * KLD);
#pragma unroll
                for (int et = 0; et < 8; et += 2) {
#pragma unroll
                    for (int q = 0; q < 10; ++q) vcc[q] = tr4(vl + ATT_PROW(ws0 + 16 * q) * KLD + 4 * (et + 1));
                    __builtin_amdgcn_sched_barrier(0);
                    o[et] = (f32x4){0.f, 0.f, 0.f, 0.f};
#pragma unroll
                    for (int kt = 0; kt < 5; ++kt) o[et] = MFMA16(cat8(va[2 * kt], va[2 * kt + 1]), pf[kt], o[et]);
                    if (et + 2 < 8) {
#pragma unroll
                        for (int q = 0; q < 10; ++q) va[q] = tr4(vl + ATT_PROW(ws0 + 16 * q) * KLD + 4 * (et + 2)); }
                    __builtin_amdgcn_sched_barrier(0);
                    o[et + 1] = (f32x4){0.f, 0.f, 0.f, 0.f};
#pragma unroll
                    for (int kt = 0; kt < 5; ++kt) o[et + 1] = MFMA16(cat8(vcc[2 * kt], vcc[2 * kt + 1]), pf[kt], o[et + 1]);
                }
            }
#undef ATT_PROW
            const float inv = (1.0f / KV8_SCALE) / lsum;
            bf16* orow = og + ((size_t)g * T + qrow) * D + h * 128 + 32 * g4;
#pragma unroll
            for (int e2 = 0; e2 < 4; ++e2) *(u32x4*)(orow + 8 * e2) = pack_bf16x8(o[2 * e2] * inv, o[2 * e2 + 1] * inv);
            if (g4 == 0) lse[((size_t)g * T + qrow) * AH + h] = mx + __logf(lsum);
            __syncthreads();
        }
    }
#undef ATT_LOADBLK
#undef ATT_CVT8
#undef ATT_STOREBLK
}
__device__ __forceinline__ void phase_attn_combine(const Frame& F) {
    const bf16* og = (const bf16*)(F.ws + WS_AUX); const float* lse = (const float*)(F.ws + WS_AUX + AUX_LSE); bf16* ob = (bf16*)(F.ws + WS_AUX + AUX_OB);
    const int lane = F.lane, gw = F.vcu * NWAVES + F.wave, NGW = F.G * NWAVES, h = lane >> 3;
    for (int row = gw; row < T; row += NGW) {
        const float l0 = lse[((size_t)0 * T + row) * AH + h], l1 = lse[((size_t)1 * T + row) * AH + h], l2 = lse[((size_t)2 * T + row) * AH + h];
        const float m = fmaxf(l0, fmaxf(l1, l2)); float w0 = __expf(l0 - m), w1 = __expf(l1 - m), w2 = __expf(l2 - m); const float inv = 1.0f / (w0 + w1 + w2); w0 *= inv; w1 *= inv; w2 *= inv;
        float a[16];
#pragma unroll
        for (int j = 0; j < 16; ++j) a[j] = 0.f;
#pragma unroll
        for (int g = 0; g < 3; ++g) { const float wg = (g == 0) ? w0 : (g == 1 ? w1 : w2);
#pragma unroll
            for (int q = 0; q < 2; ++q) { const u32x4 s = *(const u32x4*)(og + ((size_t)g * T + row) * D + 16 * lane + 8 * q);
                a[8 * q + 0] += wg * bflo(s.x); a[8 * q + 1] += wg * bfhi(s.x); a[8 * q + 2] += wg * bflo(s.y); a[8 * q + 3] += wg * bfhi(s.y);
                a[8 * q + 4] += wg * bflo(s.z); a[8 * q + 5] += wg * bfhi(s.z); a[8 * q + 6] += wg * bflo(s.w); a[8 * q + 7] += wg * bfhi(s.w); } }
        { u32x4 o;
#pragma unroll
          for (int q = 0; q < 4; ++q) o[q] = pk4_fp8(a[4 * q] * A_SCALE, a[4 * q + 1] * A_SCALE, a[4 * q + 2] * A_SCALE, a[4 * q + 3] * A_SCALE);
          *(u32x4*)((unsigned char*)ob + (size_t)row * D + 16 * lane) = o; }
    }
}

constexpr size_t BIG_YRET = 192 * MiB;
__device__ __forceinline__ void phase_ret_u(const Frame& F) {
    const unsigned char* proj = (const unsigned char*)(F.ws + WS_BIG); bf16* St = (bf16*)(F.ws + WS_AUX);
    constexpr int LD = 264;
    LAS bf16* Kt = (LAS bf16*)F.lds; LAS bf16* Vt = Kt + 128 * LD;
    const int lane = F.lane, w = F.wave, g4 = lane >> 4, l15 = lane & 15, qq = l15 >> 2, pp = lane & 3;
    u32x4 kr[4], vr[4];
#define RU_LOAD(u_) do { const int eh_ = (u_) & 1, h_ = ((u_) >> 1) & 3, n_ = ((u_) >> 3) & 63, b_ = (u_) >> 9; const char* pb_ = (const char*)(proj + ((size_t)b_ * SEQ + (size_t)n_ * RC) * RET_IN); \
        int t_ = F.tid; asm volatile("" : "+v"(t_)); unsigned off_ = (unsigned)((t_ >> 4) * RET_IN + (t_ & 15) * 16); \
        _Pragma("unroll") for (int it = 0; it < 4; ++it) { asm volatile("" : "+v"(off_)); kr[it] = *(const u32x4*)(pb_ + (size_t)(1024 + h_ * 256 + it * 32 * RET_IN) + off_); \
            vr[it] = *(const u32x4*)(pb_ + (size_t)(2048 + h_ * 512 + eh_ * 256 + it * 32 * RET_IN) + off_); } } while (0)
    if (F.vcu < 1024) RU_LOAD(F.vcu);
    for (int u = F.vcu; u < 1024; u += F.G) {
        const int eh = u & 1, h = (u >> 1) & 3, n = (u >> 3) & 63, b = u >> 9;
        { int t_ = F.tid; asm volatile("" : "+v"(t_));
#pragma unroll
          for (int it = 0; it < 4; ++it) { const int idx = t_ + 512 * it, j = idx >> 4, ch = idx & 15;
              *(LAS u32x4*)(Kt + j * LD + ch * 16) = cvt8_bf16(kr[it].x, kr[it].y); *(LAS u32x4*)(Kt + j * LD + ch * 16 + 8) = cvt8_bf16(kr[it].z, kr[it].w);
              *(LAS u32x4*)(Vt + j * LD + ch * 16) = cvt8_bf16(vr[it].x, vr[it].y); *(LAS u32x4*)(Vt + j * LD + ch * 16 + 8) = cvt8_bf16(vr[it].z, vr[it].w); } }
        __syncthreads();
        f32x4 acc[16][2];
#pragma unroll
        for (int mt = 0; mt < 16; ++mt) { acc[mt][0] = (f32x4){0.f, 0.f, 0.f, 0.f}; acc[mt][1] = (f32x4){0.f, 0.f, 0.f, 0.f}; }
#pragma unroll
        for (int ks = 0; ks < 4; ++ks) {
            bf16x8 bfr[2];
#pragma unroll
            for (int nt = 0; nt < 2; ++nt) { const LAS bf16* a0 = Vt + (32 * ks + 8 * g4 + qq) * LD + 32 * w + 16 * nt + 4 * pp; bfr[nt] = cat8(tr4(a0), tr4(a0 + 4 * LD)); }
#pragma unroll
            for (int mt = 0; mt < 16; ++mt) { const LAS bf16* a0 = Kt + (32 * ks + 8 * g4 + qq) * LD + 128 * (mt >> 3) + 32 * pp + 4 * (mt & 7);
                const bf16x8 afr = cat8(tr4(a0), tr4(a0 + 4 * LD));
                acc[mt][0] = MFMA16(afr, bfr[0], acc[mt][0]); acc[mt][1] = MFMA16(afr, bfr[1], acc[mt][1]); }
        }
        { const int un = (u + F.G < 1024) ? u + F.G : u; RU_LOAD(un); }
        bf16* outb = St + ((size_t)((b * RH + h) * RNC + n)) * (RDV * RDK);
#pragma unroll
        for (int nt = 0; nt < 2; ++nt) { bf16* orow = outb + (size_t)(eh * 256 + 32 * w + 16 * nt + l15) * RDK + 32 * g4;
#pragma unroll
            for (int mh = 0; mh < 2; ++mh)
#pragma unroll
                for (int q = 0; q < 4; ++q) *(u32x4*)(orow + 128 * mh + 8 * q) = pack_bf16x8(acc[mh * 8 + 2 * q][nt] * (1.0f / (RK_SCALE * RV_SCALE)), acc[mh * 8 + 2 * q + 1][nt] * (1.0f / (RK_SCALE * RV_SCALE))); }
        __syncthreads();
    }
#undef RU_LOAD
}
__device__ __forceinline__ void phase_ret_scan(const Frame& F) {
    bf16* St = (bf16*)(F.ws + WS_AUX);
    for (int gt = F.vcu * NTHREADS + F.tid; gt < 8 * 16384; gt += F.G * NTHREADS) {
        const int bh = gt >> 14, chunk = gt & 16383, h = bh & 3;
        const float g128 = exp2f(128.0f * log2f(1.0f - exp2f(-5.0f - (float)h)));
        bf16* base = St + (size_t)bh * RNC * (RDV * RDK) + (size_t)chunk * 8;
        float c[8];
#pragma unroll
        for (int j = 0; j < 8; ++j) c[j] = 0.f;
#pragma unroll 8
        for (int n = 0; n < RNC; ++n) { bf16* pn = base + (size_t)n * (RDV * RDK); const u32x4 uv = *(const u32x4*)pn;
            u32x4 o; o.x = pk2(c[0], c[1]); o.y = pk2(c[2], c[3]); o.z = pk2(c[4], c[5]); o.w = pk2(c[6], c[7]); *(u32x4*)pn = o;
            c[0] = g128 * (c[0] + bflo(uv.x)); c[1] = g128 * (c[1] + bfhi(uv.x)); c[2] = g128 * (c[2] + bflo(uv.y)); c[3] = g128 * (c[3] + bfhi(uv.y));
            c[4] = g128 * (c[4] + bflo(uv.z)); c[5] = g128 * (c[5] + bfhi(uv.z)); c[6] = g128 * (c[6] + bflo(uv.w)); c[7] = g128 * (c[7] + bfhi(uv.w)); }
    }
}
__device__ __forceinline__ void phase_ret_out(const Frame& F, KP p) {
    const unsigned char* proj = (const unsigned char*)(F.ws + WS_BIG); const bf16* St = (const bf16*)(F.ws + WS_AUX); bf16* yret = (bf16*)(F.ws + WS_BIG + BIG_YRET);
    const float* gng = gin(p, 4); const float* gnb = gin(p, 5);
    constexpr int LD = 264, VLD = 72, NSL = 8, ESL = 64;
    LAS bf16* Rs = (LAS bf16*)F.lds; LAS bf16* Vs = Rs + 128 * LD;
    const int w = F.wave;
#define RO_TID(t_) int t_ = F.tid; asm volatile("" : "+v"(t_))
#define RO_LD(base_, off_) (*(const u32x4*)((const char*)(base_) + (off_)))
    for (int u = F.vcu; u < 512; u += F.G) {
        const int h = u & 3, n = (u >> 2) & 63, b = u >> 8;
        const size_t row0 = (size_t)b * SEQ + (size_t)n * RC;
        const bf16* Sn = St + ((size_t)((b * RH + h) * RNC + n)) * (RDV * RDK);
        const char* pbase = (const char*)(proj + row0 * RET_IN);
        u32x4 pv[1], ps[4];
        bf16x8 qf[8];
        { RO_TID(t0); u32x4 kreg[4]; u32x2 qraw[8];
          unsigned koff = (unsigned)((t0 >> 4) * RET_IN + (t0 & 15) * 16), qoff = (unsigned)((16 * w + (t0 & 15)) * RET_IN + 8 * ((t0 & 63) >> 4));
#pragma unroll
          for (int it = 0; it < 4; ++it) { asm volatile("" : "+v"(koff)); kreg[it] = RO_LD(pbase + (size_t)(1024 + h * 256 + it * 32 * RET_IN), koff); }
#pragma unroll
          for (int s = 0; s < 8; ++s) { asm volatile("" : "+v"(qoff)); qraw[s] = *(const u32x2*)(pbase + (size_t)(h * 256 + 32 * s) + qoff); }
#define RO_LOAD_SLICE(sl_) do { RO_TID(tl_); unsigned voff = (unsigned)((tl_ >> 2) * RET_IN + (tl_ & 3) * 16), soff = (unsigned)(((tl_ >> 5) * RDK + (tl_ & 31) * 8) * 2); \
            asm volatile("" : "+v"(voff)); pv[0] = RO_LD(pbase + (size_t)(2048 + h * 512 + (sl_) * ESL), voff); \
            _Pragma("unroll") for (int it = 0; it < 4; ++it) { asm volatile("" : "+v"(soff)); ps[it] = RO_LD((const char*)Sn + (size_t)(((sl_) * ESL + it * 16) * RDK) * 2, soff); } } while (0)
          RO_LOAD_SLICE(0);
#pragma unroll
          for (int it = 0; it < 4; ++it) { const int idx = t0 + 512 * it, j = idx >> 4, ch = idx & 15;
              *(LAS u32x4*)(Rs + j * LD + ch * 16) = cvt8_bf16(kreg[it].x, kreg[it].y); *(LAS u32x4*)(Rs + j * LD + ch * 16 + 8) = cvt8_bf16(kreg[it].z, kreg[it].w); }
#pragma unroll
          for (int s = 0; s < 8; ++s) qf[s] = __builtin_bit_cast(bf16x8, cvt8_bf16(qraw[s].x, qraw[s].y)); }
        __syncthreads();
        bf16x8 pf[4];
        { RO_TID(t1); const int lane = t1 & 63, g4 = lane >> 4, irow = 16 * w + (lane & 15);
          f32x4 sacc[8];
#pragma unroll
            for (int jt = 0; jt < 8; ++jt) { sacc[jt] = (f32x4){0.f, 0.f, 0.f, 0.f};
                if (jt <= w) {
#pragma unroll
                    for (int s = 0; s < 8; ++s) sacc[jt] = MFMA16(row_frag(Rs, LD, 16 * jt, 32 * s, lane), qf[s], sacc[jt]);
#pragma unroll
                    for (int i = 0; i < 4; ++i) if (16 * jt + 4 * g4 + i > irow) sacc[jt][i] = 0.f; } }
#pragma unroll
            for (int kt = 0; kt < 4; ++kt) pf[kt] = pack8(sacc[2 * kt] * (1.0f / (RQ_SCALE * RK_SCALE)), sacc[2 * kt + 1] * (1.0f / (RQ_SCALE * RK_SCALE))); }
        __syncthreads();
        u32x4 accp[NSL][2];
        float s1 = 0.f, s2 = 0.f;
#pragma unroll
        for (int sl = 0; sl < NSL; ++sl) {
            { RO_TID(t2);
              { const int j = t2 >> 2, ch = t2 & 3; *(LAS u32x4*)(Vs + j * VLD + ch * 16) = cvt8_bf16(pv[0].x, pv[0].y); *(LAS u32x4*)(Vs + j * VLD + ch * 16 + 8) = cvt8_bf16(pv[0].z, pv[0].w); }
#pragma unroll
              for (int it = 0; it < 4; ++it) { const int idx = t2 + 512 * it, e = idx >> 5, ch = idx & 31; *(LAS u32x4*)(Rs + e * LD + ch * 8) = ps[it]; } }
            __syncthreads();
            if (sl + 1 < NSL) RO_LOAD_SLICE(sl + 1);
            RO_TID(t3); const int lane = t3 & 63, g4 = lane >> 4, qq = (lane & 15) >> 2, pp = lane & 3;
            f32x4 acc[4];
#pragma unroll
            for (int et = 0; et < 4; ++et) { f32x4 a = (f32x4){0.f, 0.f, 0.f, 0.f};
#pragma unroll
                for (int kt = 0; kt < 4; ++kt) if (2 * kt <= w) { const LAS bf16* a0 = Vs + (32 * kt + 4 * g4 + qq) * VLD + 16 * pp + 4 * et;
                    a = MFMA16(cat8(tr4(a0), tr4(a0 + 16 * VLD)), pf[kt], a); }
                const LAS bf16* srow = Rs + (16 * qq + 4 * et + pp) * LD + 8 * g4;
#pragma unroll
                for (int s = 0; s < 8; ++s) a = MFMA16(*(const LAS bf16x8*)(srow + 32 * s), qf[s], a);
                a = a * (1.0f / RV_SCALE);
                acc[et] = a; s1 += (a[0] + a[1]) + (a[2] + a[3]); s2 += (a[0] * a[0] + a[1] * a[1]) + (a[2] * a[2] + a[3] * a[3]);
                __builtin_amdgcn_sched_barrier(0); }
            accp[sl][0] = pack_bf16x8(acc[0], acc[1]); accp[sl][1] = pack_bf16x8(acc[2], acc[3]);
            __syncthreads();
        }
#undef RO_LOAD_SLICE
        RO_TID(t4); const int lane = t4 & 63, g4 = lane >> 4, irow = 16 * w + (lane & 15); const size_t qrow = row0 + irow;
        s1 += shx(s1, 16, lane); s1 += shx(s1, 32, lane); s2 += shx(s2, 16, lane); s2 += shx(s2, 32, lane);
        const float mean = s1 * (1.0f / RDV); const float var = fmaxf(s2 * (1.0f / RDV) - mean * mean, 0.f);
        const float rstd = 1.0f / sqrtf(var + LN_EPS);
        unsigned goff = (unsigned)(irow * RET_IN + 16 * g4);
#pragma unroll
        for (int sp = 0; sp < NSL; sp += 2) {
            u32x4 gq[2]; f32x4 gg[2][4], gb[2][4];
#pragma unroll
            for (int d2 = 0; d2 < 2; ++d2) { const int c0 = h * RDV + (sp + d2) * ESL + 16 * g4;
                asm volatile("" : "+v"(goff)); gq[d2] = RO_LD(pbase + (size_t)(4096 + h * RDV + (sp + d2) * ESL), goff);
#pragma unroll
                for (int q = 0; q < 4; ++q) { gg[d2][q] = *(const f32x4*)(gng + c0 + 4 * q); gb[d2][q] = *(const f32x4*)(gnb + c0 + 4 * q); } }
#pragma unroll
            for (int d2 = 0; d2 < 2; ++d2) { const int c0 = h * RDV + (sp + d2) * ESL + 16 * g4; u32x4 o8;
#pragma unroll
                for (int q = 0; q < 2; ++q) { f32x4 a0, a1; unpack_bf16x8(accp[sp + d2][q], a0, a1);
                    f32x4 y0 = (a0 - mean) * rstd * gg[d2][2 * q] + gb[d2][2 * q], y1 = (a1 - mean) * rstd * gg[d2][2 * q + 1] + gb[d2][2 * q + 1];
                    const f32x2 g0 = __builtin_amdgcn_cvt_pk_f32_fp8((int)gq[d2][2 * q], false), g1 = __builtin_amdgcn_cvt_pk_f32_fp8((int)gq[d2][2 * q], true), g2 = __builtin_amdgcn_cvt_pk_f32_fp8((int)gq[d2][2 * q + 1], false), g3 = __builtin_amdgcn_cvt_pk_f32_fp8((int)gq[d2][2 * q + 1], true);
                    const float gv[8] = {g0[0] * (1.0f / RV_SCALE), g0[1] * (1.0f / RV_SCALE), g1[0] * (1.0f / RV_SCALE), g1[1] * (1.0f / RV_SCALE), g2[0] * (1.0f / RV_SCALE), g2[1] * (1.0f / RV_SCALE), g3[0] * (1.0f / RV_SCALE), g3[1] * (1.0f / RV_SCALE)};
#pragma unroll
                    for (int j = 0; j < 4; ++j) { y0[j] *= gv[j] * fsig(gv[j]) * A_SCALE; y1[j] *= gv[4 + j] * fsig(gv[4 + j]) * A_SCALE; }
                    o8[2 * q] = pk4_fp8(y0[0], y0[1], y0[2], y0[3]); o8[2 * q + 1] = pk4_fp8(y1[0], y1[1], y1[2], y1[3]); }
                *(u32x4*)((unsigned char*)yret + qrow * RET_V + c0) = o8; }
        }
    }
#undef RO_LD
#undef RO_TID
}

constexpr size_t AUX_S5E = 64 * MiB;
constexpr int S5L = 256, S5NC = SEQ / S5L;
__device__ __forceinline__ void cmul_add(float& rr, float& ri, float ar, float ai, float xr, float xi, float cr, float ci) { rr = ar * xr - ai * xi + cr; ri = ar * xi + ai * xr + ci; }
template <bool OUT>
__device__ __forceinline__ void phase_s5_scan(const Frame& F, KP p) {
    const bf16* X = (const bf16*)(F.ws + WS_XB); float* E = (float*)(F.ws + WS_AUX + AUX_S5E); bf16* ybuf = (bf16*)(F.ws + WS_AUX);
    const int lane = F.lane, w = F.wave, g4 = lane >> 4, l15 = lane & 15;
    LAS bf16* ut = (LAS bf16*)(F.lds + w * 12288);
    LAS bf16* Hb = (LAS bf16*)(F.lds + w * 12288 + 4096);
    constexpr int HLD = 136;
    const int gw = F.vcu * NWAVES + w, NGW = F.G * NWAVES;
    const int up16 = (lane - 16) << 2, up32 = (lane - 32) << 2, last16 = (48 + l15) << 2;
    for (int unit = gw; unit < BATCH * SG * S5NC; unit += NGW) {
        const int n = unit & (S5NC - 1), g = (unit >> 5) & 63, b = unit >> 11;
        float a1r[4], a1i[4], a4r[4], a4i[4], a8r[4], a8i[4], pwr[4], pwi[4];
        bf16x8 bfrag[8];
        const float dt = expf(gin(p, 14)[g]);
#pragma unroll
        for (int st = 0; st < 4; ++st) { const int ps = 16 * st + l15;
            const float are = gin(p, 7)[g * SP + ps], aim = gin(p, 8)[g * SP + ps];
            const float mag = expf(dt * are); const float abr = mag * cosf(dt * aim), abi = mag * sinf(dt * aim);
            const float den = are * are + aim * aim;
            const float fre = ((abr - 1.0f) * are + abi * aim) / den, fim = (abi * are - (abr - 1.0f) * aim) / den;
            a1r[st] = abr; a1i[st] = abi; { float t2r, t2i; cmul_add(t2r, t2i, abr, abi, abr, abi, 0.f, 0.f); cmul_add(a4r[st], a4i[st], t2r, t2i, t2r, t2i, 0.f, 0.f); }
            cmul_add(a8r[st], a8i[st], a4r[st], a4i[st], a4r[st], a4i[st], 0.f, 0.f);
            float qr = 1.f, qi = 0.f;
            if (g4 & 1) { qr = a4r[st]; qi = a4i[st]; }
            if (g4 & 2) { float tr, ti; cmul_add(tr, ti, qr, qi, a8r[st], a8i[st], 0.f, 0.f); qr = tr; qi = ti; }
            pwr[st] = qr; pwi[st] = qi;
            const float* br = gin(p, 9) + ((size_t)g * SP + ps) * SGC + 8 * (g4 & 1); const float* bi = gin(p, 10) + ((size_t)g * SP + ps) * SGC + 8 * (g4 & 1);
            const f32x4 r0 = *(const f32x4*)br, r1 = *(const f32x4*)(br + 4), i0 = *(const f32x4*)bi, i1 = *(const f32x4*)(bi + 4);
            const float z = (g4 < 2) ? 1.0f : 0.0f; const float fr2 = fre * z, fi2 = fim * z;
            bfrag[st] = pack8(r0 * fr2 - i0 * fi2, r1 * fr2 - i1 * fi2); bfrag[st + 4] = pack8(i0 * fr2 + r0 * fi2, i1 * fr2 + r1 * fi2);
        }
        float sr[4], si[4];
        float* Eu = E + ((size_t)(b * SG + g) * S5NC + n) * 128;
        bf16x8 cf[4]; f32x4 dsk = (f32x4){0.f, 0.f, 0.f, 0.f};
#pragma unroll
        for (int st = 0; st < 4; ++st) { sr[st] = 0.f; si[st] = 0.f; }
        if (OUT) {
#pragma unroll
            for (int st = 0; st < 4; ++st) { sr[st] = Eu[16 * st + l15]; si[st] = Eu[64 + 16 * st + l15]; }
#pragma unroll
            for (int s = 0; s < 4; ++s) { const float* cp = (s < 2 ? gin(p, 11) : gin(p, 12)) + ((size_t)g * SGC + l15) * SP + 32 * (s & 1) + 8 * g4; const float sg = s < 2 ? 1.0f : -1.0f;
                const f32x4 c0 = *(const f32x4*)cp * sg, c1 = *(const f32x4*)(cp + 4) * sg; cf[s] = pack8(c0, c1); }
            dsk = *(const f32x4*)(gin(p, 13) + g * SGC + 4 * g4); }
        const size_t tok0 = (size_t)b * SEQ + (size_t)n * S5L;
        u32x4 pre[2];
        { const bf16* src = X + (tok0 + lane) * D + g * SGC; pre[0] = *(const u32x4*)src; pre[1] = *(const u32x4*)(src + 8); }
        for (int sub = 0; sub < S5L / 64; ++sub) {
            *(LAS u32x4*)(ut + lane * 16) = pre[0]; *(LAS u32x4*)(ut + lane * 16 + 8) = pre[1];
            if (sub + 1 < S5L / 64) { const bf16* src = X + (tok0 + (sub + 1) * 64 + lane) * D + g * SGC; pre[0] = *(const u32x4*)src; pre[1] = *(const u32x4*)(src + 8); }
            LDS_WAIT(); asm volatile("" ::: "memory");
#pragma unroll (OUT ? 1 : 4)
            for (int blk = 0; blk < 4; ++blk) {
                u32x4 uw = *(const LAS u32x4*)(ut + (blk * 16 + l15) * 16 + 8 * (g4 & 1));
                if (g4 >= 2) uw = (u32x4){0u, 0u, 0u, 0u};
                const bf16x8 ufr = __builtin_bit_cast(bf16x8, uw);
                f32x4 dr[4], di[4];
#pragma unroll
                for (int st = 0; st < 4; ++st) { dr[st] = MFMA16(ufr, bfrag[st], ((f32x4){0.f, 0.f, 0.f, 0.f})); di[st] = MFMA16(ufr, bfrag[st + 4], ((f32x4){0.f, 0.f, 0.f, 0.f})); }
                float vr[4], vi[4];
#pragma unroll
                for (int st = 0; st < 4; ++st) {
                    float hr = 0.f, hi = 0.f;
#pragma unroll
                    for (int i = 0; i < 4; ++i) { float nr, ni; cmul_add(nr, ni, a1r[st], a1i[st], hr, hi, dr[st][i], di[st][i]); hr = nr; hi = ni; dr[st][i] = hr; di[st][i] = hi; }
                    vr[st] = hr; vi[st] = hi; }
#define BPF(idx, v) __builtin_bit_cast(float, __builtin_amdgcn_ds_bpermute((idx), __builtin_bit_cast(int, (v))))
                { float xr[4], xi[4];
#pragma unroll
                  for (int st = 0; st < 4; ++st) { xr[st] = BPF(up16, vr[st]); xi[st] = BPF(up16, vi[st]); }
#pragma unroll
                  for (int st = 0; st < 4; ++st) { float tr, ti; cmul_add(tr, ti, a4r[st], a4i[st], xr[st], xi[st], vr[st], vi[st]); if (g4 >= 1) { vr[st] = tr; vi[st] = ti; } }
#pragma unroll
                  for (int st = 0; st < 4; ++st) { xr[st] = BPF(up32, vr[st]); xi[st] = BPF(up32, vi[st]); }
#pragma unroll
                  for (int st = 0; st < 4; ++st) { float tr, ti; cmul_add(tr, ti, a8r[st], a8i[st], xr[st], xi[st], vr[st], vi[st]); if (g4 >= 2) { vr[st] = tr; vi[st] = ti; } } }
                float er[4], ei[4], lr[4], li[4];
#pragma unroll
                for (int st = 0; st < 4; ++st) { if (OUT) { er[st] = BPF(up16, vr[st]); ei[st] = BPF(up16, vi[st]); } else { er[st] = 0.f; ei[st] = 0.f; } lr[st] = BPF(last16, vr[st]); li[st] = BPF(last16, vi[st]); }
#undef BPF
#pragma unroll
                for (int st = 0; st < 4; ++st) {
                    if (g4 == 0) { er[st] = 0.f; ei[st] = 0.f; }
                    if (OUT) { float s0r, s0i; cmul_add(s0r, s0i, pwr[st], pwi[st], sr[st], si[st], er[st], ei[st]);
#pragma unroll
                        for (int i = 0; i < 4; ++i) { float tr, ti; cmul_add(tr, ti, a1r[st], a1i[st], s0r, s0i, 0.f, 0.f); s0r = tr; s0i = ti; dr[st][i] += s0r; di[st][i] += s0i; } }
                    { float a16r, a16i; cmul_add(a16r, a16i, a8r[st], a8i[st], a8r[st], a8i[st], 0.f, 0.f); float tr, ti; cmul_add(tr, ti, a16r, a16i, sr[st], si[st], lr[st], li[st]); sr[st] = tr; si[st] = ti; }
                    if (OUT) {
#pragma unroll
                        for (int i = 0; i < 4; ++i) { const unsigned hw = pk2(dr[st][i], di[st][i]); Hb[(4 * g4 + i) * HLD + 16 * st + l15] = (bf16)hw; Hb[(4 * g4 + i) * HLD + 64 + 16 * st + l15] = (bf16)(hw >> 16); } }
                }
                if (OUT) {
                    LDS_WAIT(); asm volatile("" ::: "memory");
                    f32x4 ya = (f32x4){0.f, 0.f, 0.f, 0.f};
#pragma unroll
                    for (int s = 0; s < 4; ++s) ya = MFMA16(cf[s], row_frag(Hb, HLD, 0, 32 * s, lane), ya);
                    const u32x2 u2 = *(const LAS u32x2*)(ut + (blk * 16 + l15) * 16 + 4 * g4);
                    const f32x4 u4 = (f32x4){bflo(u2.x), bfhi(u2.x), bflo(u2.y), bfhi(u2.y)};
                    f32x4 y = ya + dsk * u4;
#pragma unroll
                    for (int j = 0; j < 4; ++j) { const float v = y[j]; y[j] = v * fsig(1.5957691216057308f * (v + 0.044715f * v * v * v)); }
                    *(unsigned*)((unsigned char*)ybuf + (size_t)(tok0 + sub * 64 + blk * 16 + l15) * D + g * SGC + 4 * g4) = pk4_fp8(y[0] * A_SCALE, y[1] * A_SCALE, y[2] * A_SCALE, y[3] * A_SCALE);
                    asm volatile("" ::: "memory"); }
            }
            LDS_WAIT(); asm volatile("" ::: "memory");
        }
        if (!OUT && g4 == 0) {
#pragma unroll
            for (int st = 0; st < 4; ++st) { Eu[16 * st + l15] = sr[st]; Eu[64 + 16 * st + l15] = si[st]; } }
    }
}
__device__ __forceinline__ void phase_s5_carry(const Frame& F, KP p) {
    float* E = (float*)(F.ws + WS_AUX + AUX_S5E);
    for (int gt = F.vcu * NTHREADS + F.tid; gt < BATCH * SG * SP; gt += F.G * NTHREADS) {
        const int pl = gt & 63, bg = gt >> 6, g = bg & 63;
        const float dt = expf(gin(p, 14)[g]); const float are = gin(p, 7)[g * SP + pl], aim = gin(p, 8)[g * SP + pl];
        const float mag = expf(dt * are); float ar = mag * cosf(dt * aim), ai = mag * sinf(dt * aim);
#pragma unroll
        for (int q = 0; q < 8; ++q) { const float nr = ar * ar - ai * ai, ni = 2.0f * ar * ai; ar = nr; ai = ni; }
        float cr = 0.f, ci = 0.f;
        for (int n = 0; n < S5NC; ++n) { float* Eu = E + ((size_t)bg * S5NC + n) * 128; const float er = Eu[pl], ei = Eu[64 + pl];
            Eu[pl] = cr; Eu[64 + pl] = ci;
            const float nr = ar * cr - ai * ci + er, ni = ar * ci + ai * cr + ei; cr = nr; ci = ni; }
    }
}

constexpr int NPHASES = 34;
#ifndef PROBE_DRY14
#define PROBE_DRY14 0
#endif
#ifndef PROBE_DRY17
#define PROBE_DRY17 0
#endif
#ifndef PH_MASK
#define PH_MASK 0xFFFFFFFFu
#endif
#define PHT(t) ((PH_MASK >> (t)) & 1u)
constexpr int PLAN_OFF = 64;
__device__ __forceinline__ void moe_plan(const Frame& F, int layer) {
    volatile LAS int* tstart = (volatile LAS int*)(F.MISC + PLAN_OFF); volatile LAS int* cnts = tstart + 72;
    __syncthreads();
    if (F.wave == 0) {
        const unsigned* cnt = (const unsigned*)(F.ws + WS_CTL) + CW_CNT + layer * NE * 64;
        const int c = (int)__hip_atomic_load(cnt + F.lane * 64, __ATOMIC_RELAXED, __HIP_MEMORY_SCOPE_AGENT);
        int v = (c + 255) >> 8;
#pragma unroll
        for (int o = 1; o < 64; o <<= 1) { const int nb = __builtin_amdgcn_ds_bpermute((F.lane - o) << 2, v); if (F.lane >= o) v += nb; }
        tstart[F.lane + 1] = v; cnts[F.lane] = c;
        if (F.lane == 0) tstart[0] = 0;
        if (F.lane == 63) { tstart[65] = v + T / 256; cnts[64] = T; }
    }
    __syncthreads();
}
template <bool GATH> struct MoeSched2 {
    static constexpr bool GATHER = GATH, UNIFORMIZE = true, FP8 = true;
    static constexpr int ncol = GATH ? 2 : 4, K = GATH ? D / 2 : ED / 2;
    const volatile LAS int* tstart; const volatile LAS int* cnts; int ntiles, G, c, lane;
    const char* Abase; const char* Wbase; const int* lists;
    __device__ __forceinline__ bool next(int i, pg8::UnitG& u) const {
        const int nwg = ntiles * ncol; const long L = (long)i * G + c; if (L >= nwg) return false;
        int wgid = (int)L; { const int q = nwg / 8, r = nwg % 8, xcd = wgid % 8, off = wgid / 8; wgid = (xcd < r ? xcd * (q + 1) : r * (q + 1) + (xcd - r) * q) + off; }
        const int tile = wgid / ncol, pn = wgid % ncol;
        int ln; { unsigned o2 = ~0u; asm volatile("" : "+s"(o2)); ln = (int)__builtin_amdgcn_mbcnt_hi(o2, __builtin_amdgcn_mbcnt_lo(o2, 0u)); }
        const int ta = tstart[ln], tb = tstart[ln + 1];
        const unsigned long long mm = __ballot(ta <= tile && tile < tb);
        const int e = mm ? (int)__builtin_ctzll(mm) : 64;
        const int ts = __builtin_amdgcn_readfirstlane((int)tstart[e]), ce = __builtin_amdgcn_readfirstlane((int)cnts[e]);
        const int lt = tile - ts; int valid = ce - lt * 256; valid = valid > 256 ? 256 : valid;
        u.gshift = 0; u.aux = e;
        if (GATH) {
            u.B = Wbase + (size_t)e * WMOE_E_BYTES + (size_t)pn * 256 * K * 2;
            if (e < 64) { u.A = Abase; u.gidx = lists + (size_t)e * T + lt * 256; u.gcnt = valid; }
            else { u.A = Abase + (size_t)lt * 256 * K * 2; u.gidx = nullptr; u.gcnt = 0; }
            u.row0 = tile * 256; u.col0 = pn * 128;
        } else {
            u.B = Wbase + (size_t)e * WMOE_E_BYTES + (size_t)512 * 1024 * 2 + (size_t)pn * 256 * K * 2;
            u.A = Abase + (size_t)tile * 256 * K * 2; u.gidx = nullptr; u.gcnt = valid;
            u.row0 = tile * 256; u.col0 = pn * 256;
        }
        return true;
    }
};
__device__ __forceinline__ void phase_load_x(const Frame& F, KP p) {
    const float* xin = gin(p, 0); bf16* XB = (bf16*)(F.ws + WS_XB);
    for (size_t i = (size_t)F.vcu * NTHREADS + F.tid; i < (size_t)T * D / 8; i += (size_t)F.G * NTHREADS) {
        const f32x4 a = *(const f32x4*)(xin + i * 8), b = *(const f32x4*)(xin + i * 8 + 4);
        *(u32x4*)(XB + i * 8) = pack_bf16x8(a, b);
        u32x2 q8; q8.x = pk4_fp8(a[0], a[1], a[2], a[3]); q8.y = pk4_fp8(b[0], b[1], b[2], b[3]); *(u32x2*)((unsigned char*)(F.ws + WS_X) + i * 8) = q8; }
}

__global__ void __launch_bounds__(NTHREADS, 2) fwd_kernel(Params p_unused) {
    KP p0 = (KP)__builtin_amdgcn_kernarg_segment_ptr();
    extern __shared__ __attribute__((aligned(16))) unsigned char lds_raw[];
    Frame F0;
    F0.lds = (LAS unsigned char*)lds_raw; F0.MISC = (volatile LAS unsigned*)(F0.lds + MISC_OFF);
    F0.tid = threadIdx.x; F0.lane = F0.tid & 63; F0.wave = __builtin_amdgcn_readfirstlane(F0.tid >> 6);
    F0.G = gridDim.x; { const int bq = blockIdx.x; F0.vcu = (F0.G % 8 == 0) ? (bq % 8) * (F0.G / 8) + bq / 8 : bq; }
    F0.ws = p0->ws;
    const int bx0 = blockIdx.x;
    for (int u = F0.tid; u < (LDS_BYTES - MISC_OFF) / 4; u += NTHREADS) ((LAS unsigned*)(F0.lds + MISC_OFF))[u] = 0u;
    __syncthreads();
    XcdBarrier bar; bar.bar = (unsigned*)(p0->ws + WS_CTL) + CW_BAR; bar.x = 0; bar.st = nullptr;
    const int use_bar = p0->use_bar;
    if (use_bar) bar = xcd_barrier_post((unsigned*)(p0->ws + WS_CTL) + CW_BAR, F0.MISC + 8);
    const int lo = p0->ph_lo, hi = p0->ph_hi;
#define PHASE_BEGIN Frame F = F0; KP p = p0; { unsigned ones_ = ~0u; asm volatile("" : "+s"(ones_)); F.lane = (int)__builtin_amdgcn_mbcnt_hi(ones_, __builtin_amdgcn_mbcnt_lo(ones_, 0u)); } asm volatile("" : "+v"(F.lane)); F.tid = F.wave * 64 + F.lane; asm volatile("" : "+v"(F.tid));   GAS unsigned char* wsg_ = (GAS unsigned char*)F0.ws; asm volatile("" : "+s"(F.wave), "+s"(F.vcu), "+s"(F.G), "+s"(wsg_), "+s"(p)); \
    F.ws = (unsigned char*)wsg_; int bx = bx0; asm volatile("" : "+s"(bx)); unsigned char* ws = F.ws; (void)ws; (void)bx;
#pragma unroll 1
    for (int ph = lo; ph < hi; ++ph) {
        int layer = 0, type = 0;
        if (ph > 0) { layer = ph >= 26 ? 3 : (ph >= 18 ? 2 : (ph >= 9 ? 1 : 0)); const int q = ph - (layer == 3 ? 26 : (layer == 2 ? 18 : (layer == 1 ? 9 : 1))); const int kind = layer % 3;
            if (kind == 0) type = q < 4 ? 1 + q : 14 + (q - 4); else if (kind == 1) type = q < 5 ? 5 + q : 14 + (q - 5); else type = q < 4 ? 10 + q : 14 + (q - 4); }
        const int j = layer / 3;
#ifdef REPEAT_MASK
        const int nrep = ((REPEAT_MASK >> type) & 1u) ? 2 : 1;
#else
        const int nrep = 1;
#endif
#pragma unroll 1
        for (int rep = 0; rep < nrep; ++rep) {
        if (rep > 0 && use_bar) xcd_barrier(bar);
        if (PHT(0) && type == 0) { PHASE_BEGIN; phase_conv_mixers(F, p); phase_conv_moe(F, p, 0); phase_load_x(F, p); }
        else if (PHT(1) && type == 1) { PHASE_BEGIN; DenseSched8 S; S.init(ws + WS_X, ws + WS_ATT_IN_T + (size_t)j * ATT_IN * D, T, ATT_IN, D / 2, F.G, bx); EpiStoreQkv8 E{(unsigned char*)(ws + WS_BIG), ATT_IN};
            pg8::gemm_phase(F.lds, F.tid, D / 2, S, E); }
        else if (PHT(2) && type == 2) { PHASE_BEGIN; phase_attn(F, bx); }
        else if (PHT(3) && type == 3) { PHASE_BEGIN; phase_attn_combine(F); }
        else if (PHT(4) && type == 4) { PHASE_BEGIN; DenseSched8 S; S.init(ws + WS_AUX + AUX_OB, ws + WS_ATT_OUT_T + (size_t)j * D * D, T, D, D / 2, F.G, bx); EpiResid8 E{(const bf16*)(ws + WS_XB), (bf16*)(ws + WS_Y), 1.0f / (A_SCALE * WUP_SCALE)};
            pg8::gemm_phase(F.lds, F.tid, D / 2, S, E); }
        else if (PHT(5) && type == 5) { PHASE_BEGIN; DenseSched8 S; S.init(ws + WS_X, ws + WS_RET_IN_T, T, RET_IN, D / 2, F.G, bx); EpiRetIn E{(unsigned char*)(ws + WS_BIG), RET_IN};
            pg8::gemm_phase(F.lds, F.tid, D / 2, S, E); }
        else if (PHT(6) && type == 6) { PHASE_BEGIN; phase_ret_u(F); }
        else if (PHT(7) && type == 7) { PHASE_BEGIN; phase_ret_scan(F); }
        else if (PHT(8) && type == 8) { PHASE_BEGIN; phase_ret_out(F, p); }
        else if (PHT(9) && type == 9) { PHASE_BEGIN; DenseSched8 S; S.init(ws + WS_BIG + BIG_YRET, ws + WS_RET_OUT_T, T, D, RET_V / 2, F.G, bx); EpiResid8 E{(const bf16*)(ws + WS_XB), (bf16*)(ws + WS_Y), 1.0f / (A_SCALE * WUP_SCALE)};
            pg8::gemm_phase(F.lds, F.tid, RET_V / 2, S, E); }
        else if (PHT(10) && type == 10) { PHASE_BEGIN; phase_s5_scan<false>(F, p); }
        else if (PHT(11) && type == 11) { PHASE_BEGIN; phase_s5_carry(F, p); }
        else if (PHT(12) && type == 12) { PHASE_BEGIN; phase_s5_scan<true>(F, p); }
        else if (PHT(13) && type == 13) { PHASE_BEGIN; DenseSched8 S; S.init(ws + WS_AUX, ws + WS_GLU_T, T, 2 * D, D / 2, F.G, bx); EpiGluResid E{(const bf16*)(ws + WS_XB), (bf16*)(ws + WS_Y), 1.0f / (A_SCALE * WUP_SCALE)};
            pg8::gemm_phase(F.lds, F.tid, D / 2, S, E); }
        else if (PHT(14) && type == 14) { PHASE_BEGIN; phase_lnr(F, p, layer, PROBE_DRY14 && true); if (PROBE_DRY14) { if (use_bar) xcd_barrier(bar); phase_lnr(F, p, layer, false); } }
        else if (PHT(15) && type == 15) { PHASE_BEGIN; moe_plan(F, layer);
            MoeSched2<true> S; S.tstart = (const volatile LAS int*)(F.MISC + PLAN_OFF); S.cnts = S.tstart + 72; S.ntiles = __builtin_amdgcn_readfirstlane((int)S.tstart[65]); S.G = F.G; S.c = bx; S.lane = F.lane;
            S.Abase = (const char*)(ws + WS_X); S.Wbase = (const char*)(ws + WS_WMOE); S.lists = (const int*)(ws + WS_LIST);
            EpiMoeUp E{(unsigned char*)(ws + WS_H)};
            pg8::gemm_phase(F.lds, F.tid, D / 2, S, E); }
        else if (PHT(16) && type == 16) { PHASE_BEGIN; moe_plan(F, layer);
            { MoeSched2<false> S; S.tstart = (const volatile LAS int*)(F.MISC + PLAN_OFF); S.cnts = S.tstart + 72; S.ntiles = __builtin_amdgcn_readfirstlane((int)S.tstart[64]); S.G = F.G; S.c = bx; S.lane = F.lane;
              S.Abase = (const char*)(ws + WS_H); S.Wbase = (const char*)(ws + WS_WMOE); S.lists = (const int*)(ws + WS_LIST);
              EpiStoreFp8 E{(unsigned char*)(ws + WS_BIG), D};
              pg8::gemm_phase(F.lds, F.tid, ED / 2, S, E); }
            { const int sh0 = __builtin_amdgcn_readfirstlane((int)((const volatile LAS int*)(F.MISC + PLAN_OFF))[64]);
              DenseSched8 S; S.init(ws + WS_H + (size_t)sh0 * 256 * ED, ws + WS_WMOE + (size_t)64 * WMOE_E_BYTES + (size_t)512 * 1024 * 2, T, D, ED / 2, F.G, bx); EpiResid8 E{(const bf16*)(ws + WS_XB), (bf16*)(ws + WS_Y), 1.0f / (H_SCALE * WUP_SCALE)};
              int tid2; { unsigned o2 = ~0u; asm volatile("" : "+s"(o2)); tid2 = F.wave * 64 + (int)__builtin_amdgcn_mbcnt_hi(o2, __builtin_amdgcn_mbcnt_lo(o2, 0u)); }
              pg8::gemm_phase(F.lds, tid2, ED / 2, S, E); } }
        else if (PHT(17) && type == 17) { PHASE_BEGIN; moe_plan(F, layer); if (PROBE_DRY17) { phase_combine(F, p, layer, true); if (use_bar) xcd_barrier(bar); } phase_combine(F, p, layer); if (layer + 1 < DEPTH) phase_conv_moe(F, p, layer + 1); }
        }
        if (use_bar && ph + 1 < hi) xcd_barrier(bar);
    }
}

#ifndef MK_PER_PHASE
#define MK_PER_PHASE 0
#endif
extern "C" void kernel_launch(void* const* d_in, const int* in_sizes, int n_in, void* d_out, int out_size, void* d_ws, size_t ws_size, hipStream_t stream) {
    static int grid = 0;
    if (grid == 0) {
        if (n_in != 26 || in_sizes[0] != T * D || out_size != T * D || ws_size < WS_END) { fprintf(stderr, "kernel_launch: unexpected shapes / workspace (n_in %d, in0 %d, out %d, ws %zu < %zu)\n", n_in, n_in > 0 ? in_sizes[0] : -1, out_size, ws_size, (size_t)WS_END); grid = -1; return; }
        int dev = 0, cus = 0, per_cu = 0;
        if (hipGetDevice(&dev) != hipSuccess || hipDeviceGetAttribute(&cus, hipDeviceAttributeMultiprocessorCount, dev) != hipSuccess) { grid = -1; return; }
        if (hipFuncSetAttribute((const void*)fwd_kernel, hipFuncAttributeMaxDynamicSharedMemorySize, LDS_BYTES) != hipSuccess) { fprintf(stderr, "kernel_launch: hipFuncSetAttribute failed\n"); grid = -1; return; }
        if (hipOccupancyMaxActiveBlocksPerMultiprocessor(&per_cu, (const void*)fwd_kernel, NTHREADS, LDS_BYTES) != hipSuccess || per_cu < 1) { fprintf(stderr, "kernel_launch: occupancy query says %d blocks per CU\n", per_cu); per_cu = 1; }
        (void)hipGetLastError();
        grid = cus;
    }
    if (grid < 0) return;
    (void)hipMemsetAsync((char*)d_ws + WS_CTL, 0, CTL_ZERO_BYTES, stream);
    Params p{};
    for (int i = 0; i < 26; ++i) p.in[i] = (const float*)d_in[i];
    p.out = (float*)d_out; p.ws = (unsigned char*)d_ws;
#if MK_PER_PHASE
    for (int k = 0; k < NPHASES; ++k) { p.ph_lo = k; p.ph_hi = k + 1; p.use_bar = 0; hipLaunchKernelGGL(fwd_kernel, dim3(grid), dim3(NTHREADS), LDS_BYTES, stream, p); }
#else
    p.ph_lo = 0; p.ph_hi = NPHASES; p.use_bar = 1;
    hipLaunchKernelGGL(fwd_kernel, dim3(grid), dim3(NTHREADS), LDS_BYTES, stream, p);
#endif
}
```

```cpp
#include <hip/hip_runtime.h>
#include <cstdio>
#include <cstdint>

#define LAS __attribute__((address_space(3)))
#define GAS __attribute__((address_space(1)))
typedef unsigned short bf16;
typedef short bf16x8 __attribute__((ext_vector_type(8)));
typedef short bf16x4 __attribute__((ext_vector_type(4)));
typedef float f32x4 __attribute__((ext_vector_type(4)));
typedef float f32x2 __attribute__((ext_vector_type(2)));
typedef unsigned u32x4 __attribute__((ext_vector_type(4)));
typedef unsigned u32x2 __attribute__((ext_vector_type(2)));
typedef GAS unsigned gu32;

constexpr int D = 1024, BATCH = 2, SEQ = 8192, T = BATCH * SEQ, DEPTH = 4;
constexpr int AH = 8, AHD = 128, ATT_IN = 9216;
constexpr int RH = 4, RDK = 256, RDV = 512, RET_IN = 6144, RET_V = 2048, RC = 128, RNC = SEQ / RC;
constexpr int SG = 64, SGC = 16, SP = 64;
constexpr int NE = 64, TOPK = 8, NEG = 8, ED = 256, NSLOT = 9;
constexpr float LN_EPS = 1e-5f;
constexpr float ALPHA = 1.6817928305074292f;
constexpr int NWAVES = 8, NTHREADS = 512;

__device__ __forceinline__ unsigned f2bf(float f) { unsigned u = __builtin_bit_cast(unsigned, f); return (u + 0x7fffu + ((u >> 16) & 1u)) >> 16; }
__device__ __forceinline__ unsigned pk2(float lo, float hi) { unsigned r; asm("s_nop 1\n\tv_cvt_pk_bf16_f32 %0, %1, %2" : "=v"(r) : "v"(lo), "v"(hi)); return r; }
__device__ __forceinline__ unsigned pk2sw(float lo, float hi) { return f2bf(lo) | (f2bf(hi) << 16); }
__device__ __forceinline__ unsigned pk2hw(float lo, float hi) { unsigned r; asm volatile("v_cvt_pk_bf16_f32 %0, %1, %2" : "=v"(r) : "v"(lo), "v"(hi)); return r; }
__device__ __forceinline__ float bf2f(unsigned b) { return __builtin_bit_cast(float, b << 16); }
__device__ __forceinline__ float bflo(unsigned w) { return __builtin_bit_cast(float, w << 16); }
__device__ __forceinline__ float bfhi(unsigned w) { return __builtin_bit_cast(float, w & 0xffff0000u); }
__device__ __forceinline__ float shx(float v, int m, int lane) { return __builtin_bit_cast(float, __builtin_amdgcn_ds_bpermute((lane ^ m) << 2, __builtin_bit_cast(int, v))); }
__device__ __forceinline__ int shx_i(int v, int m, int lane) { return __builtin_amdgcn_ds_bpermute((lane ^ m) << 2, v); }
__device__ __forceinline__ float rdl(float v, int src) { return __builtin_bit_cast(float, __builtin_amdgcn_readlane(__builtin_bit_cast(int, v), src)); }
template <int CTRL, int RM = 0xf, int BM = 0xf> __device__ __forceinline__ float dpp0(float v) { return __builtin_bit_cast(float, __builtin_amdgcn_update_dpp(0, __builtin_bit_cast(int, v), CTRL, RM, BM, true)); }
template <int CTRL, int RM = 0xf, int BM = 0xf> __device__ __forceinline__ float dppo(float old, float v) { return __builtin_bit_cast(float, __builtin_amdgcn_update_dpp(__builtin_bit_cast(int, old), __builtin_bit_cast(int, v), CTRL, RM, BM, false)); }
__device__ __forceinline__ float wave_sum(float v, int lane) {
    (void)lane;
    v += dpp0<0x111>(v); v += dpp0<0x112>(v); v += dpp0<0x114>(v); v += dpp0<0x118>(v);
    v += dpp0<0x142, 0xa>(v);
    v += dpp0<0x143, 0xc>(v);
    return rdl(v, 63);
}
__device__ __forceinline__ unsigned wave_umax(unsigned v) {
#define WU_DPP(ctrl, rm) (unsigned)__builtin_amdgcn_update_dpp(0, (int)v, ctrl, rm, 0xf, true)
    { const unsigned t = WU_DPP(0x111, 0xf); v = v > t ? v : t; } { const unsigned t = WU_DPP(0x112, 0xf); v = v > t ? v : t; } { const unsigned t = WU_DPP(0x114, 0xf); v = v > t ? v : t; } { const unsigned t = WU_DPP(0x118, 0xf); v = v > t ? v : t; }
    { const unsigned t = WU_DPP(0x142, 0xa); v = v > t ? v : t; } { const unsigned t = WU_DPP(0x143, 0xc); v = v > t ? v : t; }
#undef WU_DPP
    return (unsigned)__builtin_amdgcn_readlane((int)v, 63);
}
__device__ __forceinline__ float max8(float v) {
    v = fmaxf(v, dppo<0xb1>(v, v)); v = fmaxf(v, dppo<0x4e>(v, v)); v = fmaxf(v, dppo<0x141>(v, v)); return v;
}
__device__ __forceinline__ float fsig(float x) { return __builtin_amdgcn_rcpf(1.0f + __expf(-x)); }
#define LDS_WAIT() asm volatile("s_waitcnt lgkmcnt(0)" ::: "memory")
#define VM_WAIT() asm volatile("s_waitcnt vmcnt(0)" ::: "memory")
__device__ __forceinline__ const char* rfl_ptr(const char* p) {
    unsigned long long v = (unsigned long long)p; unsigned lo = __builtin_amdgcn_readfirstlane((unsigned)v), hi = __builtin_amdgcn_readfirstlane((unsigned)(v >> 32));
    return (const char*)(((unsigned long long)hi << 32) | lo);
}
__device__ __forceinline__ bf16x8 row_frag(const LAS bf16* base, int ld, int row0, int col0, int lane) {
    return *(const LAS bf16x8*)(base + (row0 + (lane & 15)) * ld + col0 + 8 * (lane >> 4));
}
__device__ __forceinline__ bf16x4 tr4(const LAS bf16* addr) { return __builtin_amdgcn_ds_read_tr16_b64_v4i16((LAS bf16x4*)addr); }
__device__ __forceinline__ bf16x8 cat8(bf16x4 a, bf16x4 b) { bf16x8 r; r[0] = a[0]; r[1] = a[1]; r[2] = a[2]; r[3] = a[3]; r[4] = b[0]; r[5] = b[1]; r[6] = b[2]; r[7] = b[3]; return r; }
#define MFMA16(a, b, c) __builtin_amdgcn_mfma_f32_16x16x32_bf16((a), (b), (c), 0, 0, 0)
__device__ __forceinline__ bf16x8 pack8(f32x4 a, f32x4 b) {
    u32x4 w; w.x = pk2(a[0], a[1]); w.y = pk2(a[2], a[3]); w.z = pk2(b[0], b[1]); w.w = pk2(b[2], b[3]); return __builtin_bit_cast(bf16x8, w);
}

namespace pg8 {
typedef int v4i_t __attribute__((ext_vector_type(4)));
typedef int v8i_t __attribute__((ext_vector_type(8)));
constexpr int BM = 256, BK = 64, HALF = 128, HTB = HALF * BK * 2, STAGE_BYTES = 8 * HTB;
__device__ __forceinline__ int lds_byte(int r, int c) { const int st = (r >> 4) * 2 + (c >> 5), rr = r & 15, cc = c & 31, ob = rr * 64 + cc * 2; return st * 1024 + (ob ^ (((ob >> 9) & 1) << 5)); }
__device__ __forceinline__ void stage_rc(int b, int& R, int& C) { const int st = b / 1024, sb = b % 1024, swz = sb ^ (((sb >> 9) & 1) << 5); R = (st >> 1) * 16 + swz / 64; C = (st & 1) * 32 + (swz % 64) / 2; }
__device__ __forceinline__ int perm32(int rho) { const int n = rho >> 4, i = rho & 15; return 8 * (i >> 2) + 4 * n + (i & 3); }

struct UnitG {
    const char* A;
    const char* B;
    const int* gidx;
    int gcnt, gshift;
    int row0, col0;
    int aux;
};

__device__ __forceinline__ void uniformize(UnitG& u) { u.A = rfl_ptr(u.A); u.B = rfl_ptr(u.B); u.gidx = (const int*)rfl_ptr((const char*)u.gidx); u.gcnt = __builtin_amdgcn_readfirstlane(u.gcnt); u.gshift = __builtin_amdgcn_readfirstlane(u.gshift);
    u.row0 = __builtin_amdgcn_readfirstlane(u.row0); u.col0 = __builtin_amdgcn_readfirstlane(u.col0); u.aux = __builtin_amdgcn_readfirstlane(u.aux); }
template <class Epi, class Sched>
__device__ __forceinline__ void gemm_phase(LAS unsigned char* lds, const int tid, const int K, const Sched& S, const Epi& E) {
    constexpr bool F8 = Sched::FP8;
    constexpr bool GATHER = Sched::GATHER;
    const int wid = __builtin_amdgcn_readfirstlane(tid >> 6), lane = tid & 63, wr = wid >> 2, wc = wid & 3, fr = lane & 15, fq = lane >> 4;
    int nt = K / BK; asm volatile("" : "+s"(nt));
    constexpr bool P16 = Epi::PERM16;
    unsigned voffB[2], voffB1[2], vA[2][2];
#pragma unroll
    for (int i = 0; i < 2; ++i) { int R, C; stage_rc(tid * 16 + i * 8192, R, C); const int Rb = Epi::PERM ? ((R & ~31) + perm32(R & 31)) : R; voffB[i] = (unsigned)(Rb * K + C) * 2u; voffB1[i] = voffB[i]; vA[0][i] = (unsigned)(R * K + C) * 2u; vA[1][i] = vA[0][i];
        if constexpr (P16) { const int x = R & 31, src = 64 * (R >> 5) + 16 * ((x >> 2) & 3) + 4 * (x >> 4) + (x & 3); voffB[i] = (unsigned)(src * K + C) * 2u; voffB1[i] = (unsigned)((src + 8) * K + C) * 2u; } }
    const size_t kstep = (size_t)(BK * 2);
    const size_t hstep = (size_t)HALF * K * 2;
    const size_t hstepB = P16 ? 0 : hstep;
    const size_t hstepA = GATHER ? 0 : hstep;
    const size_t hstepB1 = P16 ? (size_t)8 * K * 2 : hstep, bstep = (size_t)(P16 ? 128 : 64) * K * 2, astep = (size_t)64 * K * 2;
    unsigned vB0 = voffB[0], vA0 = vA[0][0];
    const unsigned ldsw = (unsigned)wid * 1024u;
    const int aoff = lds_byte(wr * 64 + fr, fq * 8), boff = lds_byte(wc * 32 + fr, fq * 8);
    LAS u32x4* park = (LAS u32x4*)(lds + STAGE_BYTES) + tid;
#define PG8_SA(b, h) (((b) * 2 + (h)) * HTB)
#define PG8_SB(b, h) ((4 + (b) * 2 + (h)) * HTB)
#define PG8_STAGE(bufoff, gbase, voff) do { _Pragma("unroll") for (int _i = 0; _i < 2; ++_i) { asm volatile("" : "+v"((voff)[_i]));   \
        __builtin_amdgcn_global_load_lds((const unsigned*)((const char*)(gbase) + (voff)[_i]), (LAS unsigned*)(lds + (bufoff) + ldsw + _i * 8192), 16, 0, 0); } } while (0)
#define PG8_STAGEU(bufoff, gbase, v0, step1) do { asm volatile("" : "+v"(v0)); __builtin_amdgcn_global_load_lds((const unsigned*)((const char*)(gbase) + (v0)), (LAS unsigned*)(lds + (bufoff) + ldsw), 16, 0, 0); \
        asm volatile("" : "+v"(v0)); __builtin_amdgcn_global_load_lds((const unsigned*)((const char*)(gbase) + (step1) + (v0)), (LAS unsigned*)(lds + (bufoff) + ldsw + 8192), 16, 0, 0); } while (0)
#define PG8_STB(b, h, base) PG8_STAGEU(PG8_SB(b, h), (base) + (h) * hstepB1, vB0, bstep)
#define PG8_STA(b, h, base) do { if constexpr (GATHER) PG8_STAGE(PG8_SA(b, h), (base), vA[h]); else PG8_STAGEU(PG8_SA(b, h), (base) + (h) * hstep, vA0, astep); } while (0)
    constexpr int FKS = 1024;
#define PG8_LD2(p_) __builtin_shufflevector(*(const LAS v4i_t*)(p_), *(const LAS v4i_t*)((p_) + FKS), 0, 1, 2, 3, 4, 5, 6, 7)
#define PG8_LDA(dst, b, h) do { _Pragma("unroll") for (int m = 0; m < 4; ++m) dst[m] = PG8_LD2(lds + PG8_SA(b, h) + aoff + m * 2048); } while (0)
#define PG8_LDB(dst, b, h) do { _Pragma("unroll") for (int n = 0; n < 2; ++n) dst[n] = PG8_LD2(lds + PG8_SB(b, h) + boff + n * 2048); } while (0)
#define PG8_LO(v) __builtin_bit_cast(bf16x8, __builtin_shufflevector((v), (v), 0, 1, 2, 3))
#define PG8_HI(v) __builtin_bit_cast(bf16x8, __builtin_shufflevector((v), (v), 4, 5, 6, 7))
#define PG8_MMA(ai, bj, At, Bt) do { __builtin_amdgcn_s_setprio(1); _Pragma("unroll") for (int m = 0; m < 4; ++m) _Pragma("unroll") for (int n = 0; n < 2; ++n) { \
        if constexpr (F8) { acc[ai][bj][m][n] = __builtin_amdgcn_mfma_scale_f32_16x16x128_f8f6f4(Bt[n], At[m], acc[ai][bj][m][n], 0, 0, 0, 0x7F7F7F7F, 0, 0x7F7F7F7F); } \
        else { acc[ai][bj][m][n] = __builtin_amdgcn_mfma_f32_16x16x32_bf16(PG8_LO(Bt[n]), PG8_LO(At[m]), acc[ai][bj][m][n], 0, 0, 0); \
               acc[ai][bj][m][n] = __builtin_amdgcn_mfma_f32_16x16x32_bf16(PG8_HI(Bt[n]), PG8_HI(At[m]), acc[ai][bj][m][n], 0, 0, 0); } } __builtin_amdgcn_s_setprio(0); } while (0)
#define PG8_WAIT_V(n) asm volatile("s_waitcnt vmcnt(" #n ")" ::: "memory")
#define PG8_WAIT_L(n) asm volatile("s_waitcnt lgkmcnt(" #n ")" ::: "memory")
#define PG8_BAR __builtin_amdgcn_s_barrier()
#define PG8_SCHED __builtin_amdgcn_sched_barrier(0)
#define PG8_VOFF(u, v00, v01, v10, v11) do { int _R0, _C0, _R1, _C1; stage_rc(tid * 16, _R0, _C0); stage_rc(tid * 16 + 8192, _R1, _C1); int _r00 = _R0, _r01 = _R1, _r10 = HALF + _R0, _r11 = HALF + _R1; \
        if ((u).gidx) { const GAS int* _gp = (const GAS int*)(u).gidx; const int _gc = (u).gcnt;     \
            const int _a = _gp[_r00 < _gc ? _r00 : 0] >> (u).gshift, _b = _gp[_r01 < _gc ? _r01 : 0] >> (u).gshift, _c = _gp[_r10 < _gc ? _r10 : 0] >> (u).gshift, _d = _gp[_r11 < _gc ? _r11 : 0] >> (u).gshift; \
            _r00 = _a; _r01 = _b; _r10 = _c; _r11 = _d; } \
        v00 = (unsigned)(_r00 * K + _C0) * 2u; v01 = (unsigned)(_r01 * K + _C1) * 2u; v10 = (unsigned)(_r10 * K + _C0) * 2u; v11 = (unsigned)(_r11 * K + _C1) * 2u; } while (0)
    UnitG cur, nxt; int ui = 0;
    if (!S.next(0, cur)) return;
    if constexpr (Sched::UNIFORMIZE) uniformize(cur);
    f32x4 acc[2][2][4][2];
#pragma unroll
    for (int a = 0; a < 2; ++a)
#pragma unroll
        for (int b = 0; b < 2; ++b)
#pragma unroll
            for (int m = 0; m < 4; ++m)
#pragma unroll
                for (int n = 0; n < 2; ++n) acc[a][b][m][n] = (f32x4){0.f, 0.f, 0.f, 0.f};
    v8i_t At[4], B0[2], B1[2];
    if constexpr (GATHER) PG8_VOFF(cur, vA[0][0], vA[0][1], vA[1][0], vA[1][1]);
    const char* cA = cur.A; const char* cB = cur.B;
    PG8_STB(0, 0, cB); PG8_STB(0, 1, cB); PG8_STA(0, 0, cA); PG8_STA(0, 1, cA);
    if (wr == 1) PG8_BAR;
    PG8_WAIT_V(2); PG8_BAR;
    PG8_STB(1, 0, cB + kstep); PG8_STA(1, 0, cA + kstep); PG8_STB(1, 1, cB + kstep);
    PG8_WAIT_V(6); PG8_BAR;
    for (;;) {
        const bool has_next = S.next(ui + 1, nxt);
        if constexpr (Sched::UNIFORMIZE) { if (has_next) uniformize(nxt); }
        const char* nA = cA; const char* nB = cB;
        if (has_next) { nA = nxt.A; nB = nxt.B; }
        if constexpr (GATHER) { u32x4 pv; pv.x = vA[0][0]; pv.y = vA[0][1]; pv.z = vA[1][0]; pv.w = vA[1][1];
            if (has_next) PG8_VOFF(nxt, pv.x, pv.y, pv.z, pv.w);
            *park = pv; }
#pragma unroll 1
        for (int t = 0; t < nt; t += 2) {
            const bool last = (t == nt - 2);
            const char* a1 = cA + (size_t)(t + 1) * kstep;
            const char* a2 = last ? nA : cA + (size_t)(t + 2) * kstep; const char* b2 = last ? nB : cB + (size_t)(t + 2) * kstep;
            const char* a3 = a2 + kstep; const char* b3 = b2 + kstep;
            PG8_LDB(B0, 0, 0); PG8_LDB(B1, 0, 1); PG8_SCHED; PG8_LDA(At, 0, 0); PG8_STA(1, 1, a1);
            PG8_WAIT_V(8); PG8_WAIT_L(0); PG8_BAR; PG8_MMA(0, 0, At, B0); PG8_MMA(0, 1, At, B1); PG8_BAR; PG8_SCHED;
            if constexpr (GATHER) { if (last) { const u32x4 pv = *park; vA[0][0] = pv.x; vA[0][1] = pv.y; vA[1][0] = pv.z; vA[1][1] = pv.w; } }
            PG8_LDA(At, 0, 1); PG8_STB(0, 0, b2); PG8_STB(0, 1, b2); PG8_STA(0, 0, a2);
            PG8_WAIT_V(8); PG8_WAIT_L(0); PG8_BAR; PG8_MMA(1, 0, At, B0); PG8_MMA(1, 1, At, B1); PG8_BAR; PG8_SCHED;
            PG8_LDB(B0, 1, 0); PG8_LDB(B1, 1, 1); PG8_SCHED; PG8_LDA(At, 1, 0); PG8_STA(0, 1, a2);
            PG8_WAIT_V(8); PG8_WAIT_L(0); PG8_BAR; PG8_MMA(0, 0, At, B0); PG8_MMA(0, 1, At, B1); PG8_BAR; PG8_SCHED;
            PG8_LDA(At, 1, 1); PG8_STB(1, 0, b3); PG8_STB(1, 1, b3); PG8_STA(1, 0, a3);
            PG8_WAIT_V(8); PG8_WAIT_L(0); PG8_BAR; PG8_MMA(1, 0, At, B0); PG8_MMA(1, 1, At, B1); PG8_BAR; PG8_SCHED;
        }
        if (wr == 0) PG8_BAR;
        { int l2; { unsigned o2 = ~0u; asm volatile("" : "+s"(o2)); l2 = (int)__builtin_amdgcn_mbcnt_hi(o2, __builtin_amdgcn_mbcnt_lo(o2, 0u)); }
          E(acc, cur, wr, wc, l2 & 15, l2 >> 4); }
        if (!has_next) break;
#pragma unroll
        for (int a = 0; a < 2; ++a)
#pragma unroll
            for (int b = 0; b < 2; ++b)
#pragma unroll
                for (int m = 0; m < 4; ++m)
#pragma unroll
                    for (int n = 0; n < 2; ++n) acc[a][b][m][n] = (f32x4){0.f, 0.f, 0.f, 0.f};
        cur = nxt; cA = nA; cB = nB; ++ui;
        if (wr == 1) PG8_BAR;
    }
    PG8_WAIT_V(0);
    PG8_BAR;
#undef PG8_SA
#undef PG8_SB
#undef PG8_STAGE
#undef PG8_STAGEU
#undef PG8_STB
#undef PG8_STA
#undef PG8_LDA
#undef PG8_LDB
#undef PG8_LD2
#undef PG8_LO
#undef PG8_HI
#undef PG8_MMA
#undef PG8_WAIT_V
#undef PG8_WAIT_L
#undef PG8_BAR
#undef PG8_SCHED
#undef PG8_VOFF
}
}

constexpr size_t MiB = 1u << 20;
constexpr size_t WS_CTL = 0, CTL_ZERO_BYTES = 1 * MiB;
constexpr size_t WS_ATT_IN_T = 1 * MiB;
constexpr size_t WS_ATT_OUT_T = WS_ATT_IN_T + 36 * MiB;
constexpr size_t WS_RET_IN_T = WS_ATT_OUT_T + 4 * MiB;
constexpr size_t WS_RET_OUT_T = WS_RET_IN_T + 12 * MiB;
constexpr size_t WS_GLU_T = WS_RET_OUT_T + 4 * MiB;
constexpr size_t WS_RT_HI = WS_GLU_T + 4 * MiB;
constexpr size_t WS_RT_LO = WS_RT_HI + 512 * 1024;
constexpr size_t WS_WMOE = WS_RT_HI + 1 * MiB;
constexpr size_t WMOE_E_BYTES = (size_t)(512 * 1024 + 1024 * 256) * 2;
constexpr size_t WS_X = WS_WMOE + 98 * MiB;
constexpr size_t WS_Y = WS_X + 64 * MiB;
constexpr size_t WS_XB = WS_Y + 64 * MiB;
constexpr size_t WS_BIG = WS_XB + 32 * MiB;
constexpr size_t WS_AUX = WS_BIG + 288 * MiB;
constexpr size_t WS_H = WS_AUX + 160 * MiB;
constexpr size_t WS_LIST = WS_H + 80 * MiB;
constexpr size_t WS_TRASH = WS_LIST + 8 * MiB;
constexpr size_t WS_END = WS_TRASH + 1 * MiB;
static_assert(WS_END <= 1024 * MiB, "workspace map");
constexpr int CW_BAR = 4096;
constexpr int CW_CNT = 16384;
constexpr int CW_CHK = 65536;
constexpr int HROWS = 163840;

#define XB_TMO      128
#define XB_XCNT(j)  (256  + 64 * (j))
#define XB_XSUB(j)  (1280 + 64 * (j))
#define XB_XGEN(j)  (2304 + 64 * (j))
#define XB_TOP      3328
#define XB_TOPGEN   3392
#define XCD_BAR_WORDS 3456
#define XB_SPIN_CAP (1u << 20)
__device__ __forceinline__ unsigned xb_ld(unsigned* p)              { return __hip_atomic_load(p, __ATOMIC_RELAXED, __HIP_MEMORY_SCOPE_AGENT); }
__device__ __forceinline__ unsigned xb_add(unsigned* p, unsigned v) { return __hip_atomic_fetch_add(p, v, __ATOMIC_RELAXED, __HIP_MEMORY_SCOPE_AGENT); }
__device__ __forceinline__ unsigned xb_xcc_id() { return (unsigned)__builtin_amdgcn_s_getreg((3 << 11) | 20) & 0xFu; }
#define XB_SPIN(cond, bar) do { unsigned _sp = 0; while (cond) { __builtin_amdgcn_s_sleep(1); \
    if ((++_sp & 255u) == 0u) { if (xb_ld(&(bar)[XB_TMO])) break; if (_sp > XB_SPIN_CAP) { atomicAdd(&(bar)[XB_TMO], 1u); break; } } } } while (0)
struct XcdBarrier { unsigned* bar; unsigned x; volatile LAS unsigned* st; };
__device__ __forceinline__ XcdBarrier xcd_barrier_post(unsigned* bar, volatile LAS unsigned* st) {
    XcdBarrier b; b.bar = bar; b.x = xb_xcc_id(); b.st = st;
    if (threadIdx.x == 0) (void)xb_add(&bar[XB_XCNT(b.x)], 1u);
    return b;
}
__device__ __forceinline__ void xcd_barrier_complete(unsigned* bar, unsigned x, unsigned& nloc, unsigned& nx) {
    const unsigned G = gridDim.x * gridDim.y * gridDim.z;
    unsigned sum, cnt, mine, sp = 0u;
    for (;;) {
        sum = 0u; cnt = 0u; mine = 0u;
#pragma unroll
        for (unsigned j = 0; j < 16; ++j) { const unsigned c = xb_ld(&bar[XB_XCNT(j)]); sum += c; cnt += (c > 0u) ? 1u : 0u; mine = (j == x) ? c : mine; }
        if (sum == G) break;
        __builtin_amdgcn_s_sleep(1);
        if ((++sp & 255u) == 0u) { if (xb_ld(&bar[XB_TMO])) break; if (sp > XB_SPIN_CAP) { atomicAdd(&bar[XB_TMO], 1u); break; } }
    }
    nloc = mine > 0u ? mine : 1u; nx = cnt > 0u ? cnt : 1u;
}
__device__ __forceinline__ void xcd_barrier(const XcdBarrier& b) {
    asm volatile("s_waitcnt vmcnt(0)" ::: "memory");
    __syncthreads();
    if (threadIdx.x == 0) {
        unsigned* bar = b.bar;
        __builtin_amdgcn_s_waitcnt(0);
        unsigned nloc = b.st[0], nx = b.st[1];
        if (nloc == 0u) { xcd_barrier_complete(bar, b.x, nloc, nx); b.st[0] = nloc; b.st[1] = nx; }
        const unsigned old = xb_add(&bar[XB_XSUB(b.x)], 1u);
        const unsigned gen = old / nloc;
        if (old + 1u == (gen + 1u) * nloc) {
            __builtin_amdgcn_fence(__ATOMIC_RELEASE, "agent");
            asm volatile("s_waitcnt vmcnt(0)" ::: "memory");
            const unsigned og = xb_add(&bar[XB_TOP], 1u);
            const unsigned tg = og / nx;
            if (og + 1u == (tg + 1u) * nx) xb_add(&bar[XB_TOPGEN], 1u);
            else XB_SPIN(xb_ld(&bar[XB_TOPGEN]) == tg, bar);
            __builtin_amdgcn_fence(__ATOMIC_ACQUIRE, "agent");
            xb_add(&bar[XB_XGEN(b.x)], 1u);
            asm volatile("s_waitcnt vmcnt(0)" ::: "memory");
        } else {
            XB_SPIN(xb_ld(&bar[XB_XGEN(b.x)]) == gen, bar);
            __builtin_amdgcn_fence(__ATOMIC_ACQUIRE, "agent");
            asm volatile("s_waitcnt vmcnt(0)" ::: "memory");
        }
    }
    __syncthreads();
}

constexpr int RING_BYTES = 139264;
constexpr int MISC_OFF = RING_BYTES;
constexpr int LDS_BYTES = 147456;
struct Params {
    const float* in[26]; float* out; unsigned char* ws; int ph_lo, ph_hi; int use_bar, pad;
};
typedef const __attribute__((address_space(4))) Params* KP;
__device__ __forceinline__ const float* gin(KP p, int i) { return (const float*)(const GAS float*)p->in[i]; }
__device__ __forceinline__ float* gout(KP p) { return (float*)(GAS float*)p->out; }
struct Frame {
    LAS unsigned char* lds; volatile LAS unsigned* MISC;
    int tid, lane, wave, vcu, G;
    unsigned char* ws;
};

template <bool F8_ = false> struct DenseSchedT {
    static constexpr bool GATHER = false, UNIFORMIZE = false, FP8 = F8_;
    const char* A; const char* Bt; int K, nM, nN, nwg, G, c;
    __device__ __forceinline__ void init(const void* A_, const void* Bt_, int M, int N, int K_, int G_, int c_) { A = (const char*)A_; Bt = (const char*)Bt_; K = K_; nM = M / 256; nN = N / 256; nwg = nM * nN; G = G_; c = c_; }
    __device__ __forceinline__ bool next(int i, pg8::UnitG& u) const {
        const long L = (long)i * G + c; if (L >= nwg) return false;
        int wgid = (int)L; { const int q = nwg / 8, r = nwg % 8, xcd = wgid % 8, off = wgid / 8; wgid = (xcd < r ? xcd * (q + 1) : r * (q + 1) + (xcd - r) * q) + off; }
        const int nig = 8 * nN, gid = wgid / nig, fm = gid * 8, gsz = (nM - fm) < 8 ? (nM - fm) : 8;
        const int pm = fm + ((wgid % nig) % gsz), pn = (wgid % nig) / gsz;
        u.A = A + (size_t)pm * 256 * K * 2; u.B = Bt + (size_t)pn * 256 * K * 2; u.gidx = nullptr; u.gcnt = 0; u.gshift = 0; u.row0 = pm * 256; u.col0 = pn * 256; u.aux = 0; return true;
    }
};
typedef DenseSchedT<false> DenseSched; typedef DenseSchedT<true> DenseSched8;
__device__ __forceinline__ u32x4 pack_bf16x8(const f32x4& v0, const f32x4& v1) { u32x4 w; w.x = pk2hw(v0[0], v0[1]); w.y = pk2hw(v0[2], v0[3]); w.z = pk2hw(v1[0], v1[1]); w.w = pk2hw(v1[2], v1[3]); return w; }

__device__ __forceinline__ unsigned pk4_fp8(float a, float b, float c, float d) {
    a = fminf(fmaxf(a, -448.0f), 448.0f); b = fminf(fmaxf(b, -448.0f), 448.0f); c = fminf(fmaxf(c, -448.0f), 448.0f); d = fminf(fmaxf(d, -448.0f), 448.0f);
    int w = 0; w = __builtin_amdgcn_cvt_pk_fp8_f32(a, b, w, false); w = __builtin_amdgcn_cvt_pk_fp8_f32(c, d, w, true); return (unsigned)w; }
constexpr float WUP_SCALE = 32.0f, WUP_INV = 1.0f / 32.0f;
struct EpiStoreBf16 {
    static constexpr bool PERM = true, PERM16 = false;
    bf16* O; int ldc; float osc, qsc;
    __device__ __forceinline__ void operator()(const f32x4 (&acc)[2][2][4][2], const pg8::UnitG& u, int wr, int wc, int fr, int fq) const {
        const float sc = ((u.col0 % 3072) < 1024) ? osc * qsc : osc;
#pragma unroll
        for (int ai = 0; ai < 2; ++ai)
#pragma unroll
            for (int m = 0; m < 4; ++m) { bf16* rowp = O + (size_t)(u.row0 + ai * 128 + wr * 64 + m * 16 + fr) * ldc + u.col0 + wc * 32 + 8 * fq;
#pragma unroll
                for (int bj = 0; bj < 2; ++bj) *(u32x4*)(rowp + bj * 128) = pack_bf16x8(acc[ai][bj][m][0] * sc, acc[ai][bj][m][1] * sc); }
    }
};
constexpr float YEXP_SCALE = 32.0f, YEXP_INV = 1.0f / 32.0f;
constexpr float A_SCALE = 16.0f;
constexpr float H_SCALE = 16.0f;
constexpr float Q8_SCALE = 64.0f, KV8_SCALE = 16.0f;
struct EpiStoreQkv8 {
    static constexpr bool PERM = false, PERM16 = true;
    unsigned char* O; int ldc;
    __device__ __forceinline__ void operator()(const f32x4 (&acc)[2][2][4][2], const pg8::UnitG& u, int wr, int wc, int fr, int fq) const {
        const float sc = ((u.col0 % 3072) < 1024) ? WUP_INV * 0.08838834764831845f * Q8_SCALE : WUP_INV * KV8_SCALE;
#pragma unroll
        for (int ai = 0; ai < 2; ++ai)
#pragma unroll
            for (int m = 0; m < 4; ++m) { unsigned char* rowp = O + (size_t)(u.row0 + ai * 128 + wr * 64 + m * 16 + fr) * ldc + u.col0 + wc * 64 + 16 * fq;
                u32x4 w;
#pragma unroll
                for (int q = 0; q < 4; ++q) { const f32x4 v = acc[ai][q >> 1][m][q & 1] * sc; w[q] = pk4_fp8(v[0], v[1], v[2], v[3]); }
                *(u32x4*)rowp = w; }
    }
};
struct EpiStoreFp8 {
    static constexpr bool PERM = false, PERM16 = true;
    unsigned char* O; int ldc;
    __device__ __forceinline__ void operator()(const f32x4 (&acc)[2][2][4][2], const pg8::UnitG& u, int wr, int wc, int fr, int fq) const {
#pragma unroll
        for (int ai = 0; ai < 2; ++ai)
#pragma unroll
            for (int m = 0; m < 4; ++m) { unsigned char* rowp = O + (size_t)(u.row0 + ai * 128 + wr * 64 + m * 16 + fr) * ldc + u.col0 + wc * 64 + 16 * fq;
                u32x4 w;
#pragma unroll
                for (int q = 0; q < 4; ++q) { f32x4 v = acc[ai][q >> 1][m][q & 1] * (YEXP_SCALE / (H_SCALE * WUP_SCALE));
#pragma unroll
                    for (int j = 0; j < 4; ++j) v[j] = fminf(fmaxf(v[j], -448.0f), 448.0f);
                    int d = 0; d = __builtin_amdgcn_cvt_pk_fp8_f32(v[0], v[1], d, false); d = __builtin_amdgcn_cvt_pk_fp8_f32(v[2], v[3], d, true); w[q] = (unsigned)d; }
                *(u32x4*)rowp = w; }
    }
};
constexpr float RS_SCALE = 4.0f;
constexpr float RQ_SCALE = 16.0f, RK_SCALE = 8.0f, RV_SCALE = 16.0f;
struct EpiRetIn {
    static constexpr bool PERM = false, PERM16 = true;
    unsigned char* O; int ldc;
    __device__ __forceinline__ void operator()(const f32x4 (&acc)[2][2][4][2], const pg8::UnitG& u, int wr, int wc, int fr, int fq) const {
        float l2g = 0.f;
        float cs = WUP_INV * RV_SCALE;
        if (u.col0 < 2048) { const int h = (u.col0 & 1023) >> 8; const float g = 1.0f - exp2f(-5.0f - (float)h); l2g = log2f(g); cs = WUP_INV * RQ_SCALE; if (u.col0 >= 1024) { l2g = -l2g; cs = WUP_INV * 0.0625f * RK_SCALE; } }
#pragma unroll
        for (int ai = 0; ai < 2; ++ai)
#pragma unroll
            for (int m = 0; m < 4; ++m) { const int row = u.row0 + ai * 128 + wr * 64 + m * 16 + fr; const float sc = exp2f(l2g * (float)(row & 127)) * cs;
                unsigned char* rowp = O + (size_t)row * ldc + u.col0 + wc * 64 + 16 * fq; u32x4 w;
#pragma unroll
                for (int q = 0; q < 4; ++q) { const f32x4 v = acc[ai][q >> 1][m][q & 1] * sc; w[q] = pk4_fp8(v[0], v[1], v[2], v[3]); }
                *(u32x4*)rowp = w; }
    }
};
__device__ __forceinline__ u32x4 cvt8_bf16(unsigned lo, unsigned hi) {
    const f32x2 a = __builtin_amdgcn_cvt_pk_f32_fp8((int)lo, false), b = __builtin_amdgcn_cvt_pk_f32_fp8((int)lo, true), c = __builtin_amdgcn_cvt_pk_f32_fp8((int)hi, false), d = __builtin_amdgcn_cvt_pk_f32_fp8((int)hi, true);
    u32x4 r; r.x = pk2(a[0], a[1]); r.y = pk2(b[0], b[1]); r.z = pk2(c[0], c[1]); r.w = pk2(d[0], d[1]); return r; }
__device__ __forceinline__ void unpack_bf16x8(const u32x4& w, f32x4& a, f32x4& b) { a[0] = bflo(w.x); a[1] = bfhi(w.x); a[2] = bflo(w.y); a[3] = bfhi(w.y); b[0] = bflo(w.z); b[1] = bfhi(w.z); b[2] = bflo(w.w); b[3] = bfhi(w.w); }
template <bool ALL16> struct EpiResidT {
    static constexpr bool PERM = true, PERM16 = false;
    const bf16* X; bf16* Y; float asc;
    __device__ __forceinline__ void operator()(const f32x4 (&acc)[2][2][4][2], const pg8::UnitG& u, int wr, int wc, int fr, int fq) const {
        constexpr int NB = ALL16 ? 1 : 2, PER = 2 / NB;
#pragma unroll
        for (int bt = 0; bt < NB; ++bt) {
            u32x4 xw[PER][4][2];
#pragma unroll
            for (int a2 = 0; a2 < PER; ++a2)
#pragma unroll
                for (int m = 0; m < 4; ++m) { const int ai = bt * PER + a2; const size_t off = (size_t)(u.row0 + ai * 128 + wr * 64 + m * 16 + fr) * D + u.col0 + wc * 32 + 8 * fq;
#pragma unroll
                    for (int bj = 0; bj < 2; ++bj) xw[a2][m][bj] = *(const u32x4*)(X + off + bj * 128); }
            asm volatile("" ::: "memory");
#pragma unroll
            for (int a2 = 0; a2 < PER; ++a2)
#pragma unroll
                for (int m = 0; m < 4; ++m) { const int ai = bt * PER + a2; const size_t off = (size_t)(u.row0 + ai * 128 + wr * 64 + m * 16 + fr) * D + u.col0 + wc * 32 + 8 * fq;
#pragma unroll
                    for (int bj = 0; bj < 2; ++bj) { f32x4 x0, x1; unpack_bf16x8(xw[a2][m][bj], x0, x1);
                        *(u32x4*)(Y + off + bj * 128) = pack_bf16x8(x0 * ALPHA + acc[ai][bj][m][0] * asc, x1 * ALPHA + acc[ai][bj][m][1] * asc); } }
            asm volatile("" ::: "memory");
        }
    }
};
typedef EpiResidT<true> EpiResid; typedef EpiResidT<false> EpiResid8;
struct EpiGluResid {
    static constexpr bool PERM = true, PERM16 = false;
    const bf16* X; bf16* Y; float asc;
    __device__ __forceinline__ void operator()(const f32x4 (&acc)[2][2][4][2], const pg8::UnitG& u, int wr, int wc, int fr, int fq) const {
        u32x4 xw[2][4];
#pragma unroll
        for (int ai = 0; ai < 2; ++ai)
#pragma unroll
            for (int m = 0; m < 4; ++m) { const size_t off = (size_t)(u.row0 + ai * 128 + wr * 64 + m * 16 + fr) * D + (u.col0 >> 1) + wc * 32 + 8 * fq; xw[ai][m] = *(const u32x4*)(X + off); }
        asm volatile("" ::: "memory");
#pragma unroll
        for (int ai = 0; ai < 2; ++ai)
#pragma unroll
            for (int m = 0; m < 4; ++m) { const size_t off = (size_t)(u.row0 + ai * 128 + wr * 64 + m * 16 + fr) * D + (u.col0 >> 1) + wc * 32 + 8 * fq;
                f32x4 x0, x1; unpack_bf16x8(xw[ai][m], x0, x1); f32x4 o0, o1;
#pragma unroll
                for (int j = 0; j < 4; ++j) { o0[j] = x0[j] * ALPHA + acc[ai][0][m][0][j] * asc * fsig(acc[ai][1][m][0][j] * asc); o1[j] = x1[j] * ALPHA + acc[ai][0][m][1][j] * asc * fsig(acc[ai][1][m][1][j] * asc); }
                *(u32x4*)(Y + off) = pack_bf16x8(o0, o1); }
    }
};
struct EpiMoeUp {
    static constexpr bool PERM = true, PERM16 = false;
    unsigned char* H;
    __device__ __forceinline__ void operator()(const f32x4 (&acc)[2][2][4][2], const pg8::UnitG& u, int wr, int wc, int fr, int fq) const {
        typedef unsigned u2_t __attribute__((ext_vector_type(2)));
#pragma unroll
        for (int ai = 0; ai < 2; ++ai) {
            u32x2 w8[4];
#pragma unroll
            for (int m = 0; m < 4; ++m) { f32x4 o[2];
#pragma unroll
                for (int n = 0; n < 2; ++n)
#pragma unroll
                    for (int j = 0; j < 4; ++j) { const float ga = acc[ai][0][m][n][j], ua = acc[ai][1][m][n][j];
                        o[n][j] = (ga * ua) * (WUP_INV * WUP_INV * H_SCALE) * __builtin_amdgcn_rcpf(1.0f + __builtin_amdgcn_exp2f(ga * (-WUP_INV * 1.4426950408889634f))); }
                w8[m].x = pk4_fp8(o[0][0], o[0][1], o[0][2], o[0][3]); w8[m].y = pk4_fp8(o[1][0], o[1][1], o[1][2], o[1][3]); }
            u32x4 s0, s1;
            { const u2_t a = __builtin_amdgcn_permlane16_swap(w8[0].x, w8[2].x, false, false), b = __builtin_amdgcn_permlane16_swap(w8[0].y, w8[2].y, false, false);
              s0.x = a.x; s0.y = b.x; s0.z = a.y; s0.w = b.y; }
            { const u2_t a = __builtin_amdgcn_permlane16_swap(w8[1].x, w8[3].x, false, false), b = __builtin_amdgcn_permlane16_swap(w8[1].y, w8[3].y, false, false);
              s1.x = a.x; s1.y = b.x; s1.z = a.y; s1.w = b.y; }
            const int mb = (fq & 1) ? 2 : 0;
            unsigned char* rowp = H + (size_t)(u.row0 + ai * 128 + wr * 64 + mb * 16 + fr) * ED + u.col0 + wc * 32 + 8 * (fq & 2);
            *(u32x4*)rowp = s0; *(u32x4*)(rowp + (size_t)16 * ED) = s1; }
    }
};

struct ConvD { const float* src; unsigned char* dst; unsigned char* dst2; int ldw, ldk, kind; };
__device__ __forceinline__ ConvD conv_mk8(const float* W, int ldw, unsigned char* WT, int ldk, int k0, int n0, int drow0) {
    ConvD d; d.src = W + (size_t)k0 * ldw + n0; d.dst = WT + (size_t)drow0 * ldk + k0; d.dst2 = nullptr; d.ldw = ldw; d.ldk = ldk; d.kind = 1; return d; }
__device__ __forceinline__ ConvD conv_mk16(const float* W, int ldw, bf16* WT, bf16* WTlo, int ldk, int k0, int n0, int drow0) {
    ConvD d; d.src = W + (size_t)k0 * ldw + n0; d.dst = (unsigned char*)(WT + (size_t)drow0 * ldk + k0); d.dst2 = WTlo ? (unsigned char*)(WTlo + (size_t)drow0 * ldk + k0) : nullptr; d.ldw = ldw; d.ldk = ldk * 2; d.kind = WTlo ? 2 : 0; return d; }
__device__ __forceinline__ void conv_load(const ConvD& d, int lane, f32x4 (&r)[8]) {
#pragma unroll
    for (int i = 0; i < 8; ++i) { const int kk = 8 * i + (lane >> 3), c4 = 4 * (lane & 7); r[i] = *(const f32x4*)(d.src + (size_t)kk * d.ldw + c4); }
}
template <bool HILO>
__device__ __forceinline__ void conv_finish(const ConvD& d, int lane, const f32x4 (&r)[8], LAS float* scr) {
    const float scale = (d.kind == 1) ? WUP_SCALE : 1.0f;
#pragma unroll
    for (int i = 0; i < 8; ++i) { const int kk = 8 * i + (lane >> 3), c4 = 4 * (lane & 7);
        scr[kk * 33 + c4] = r[i][0] * scale; scr[kk * 33 + c4 + 1] = r[i][1] * scale; scr[kk * 33 + c4 + 2] = r[i][2] * scale; scr[kk * 33 + c4 + 3] = r[i][3] * scale; }
    LDS_WAIT(); asm volatile("" ::: "memory");
    const int c = lane & 7;
#pragma unroll
    for (int j = 0; j < 4; ++j) { const int n = (lane >> 3) + 8 * j; const LAS float* s = scr + (8 * c) * 33 + n;
        float v[8];
#pragma unroll
        for (int q = 0; q < 8; ++q) v[q] = s[q * 33];
        if (d.kind == 1) { u32x2 o; o.x = pk4_fp8(v[0], v[1], v[2], v[3]); o.y = pk4_fp8(v[4], v[5], v[6], v[7]); *(u32x2*)(d.dst + (size_t)n * d.ldk + 8 * c) = o; }
        else { u32x4 o; o.x = pk2(v[0], v[1]); o.y = pk2(v[2], v[3]); o.z = pk2(v[4], v[5]); o.w = pk2(v[6], v[7]);
            *(u32x4*)(d.dst + (size_t)n * d.ldk + 16 * c) = o;
            if (HILO) { float rr[8];
#pragma unroll
                for (int q = 0; q < 8; ++q) rr[q] = v[q] - bf2f(f2bf(v[q]));
                u32x4 o2; o2.x = pk2(rr[0], rr[1]); o2.y = pk2(rr[2], rr[3]); o2.z = pk2(rr[4], rr[5]); o2.w = pk2(rr[6], rr[7]);
                *(u32x4*)(d.dst2 + (size_t)n * d.ldk + 16 * c) = o2; } } }
    LDS_WAIT(); asm volatile("" ::: "memory");
}
__device__ __forceinline__ void conv_dma(const ConvD& d, int lane, LAS float* buf) {
#pragma unroll
    for (int i = 0; i < 8; ++i) { const float* g = d.src + (size_t)(8 * i + (lane >> 3)) * d.ldw + 4 * ((lane & 7) ^ i);
        __builtin_amdgcn_global_load_lds((const unsigned*)g, (LAS unsigned*)(buf + i * 256), 16, 0, 0); }
}
__device__ __forceinline__ void conv_finish_lds(const ConvD& d, int lane, const LAS float* buf) {
    const float scale = (d.kind == 1) ? WUP_SCALE : 1.0f;
    const int c = lane & 7;
#pragma unroll
    for (int j = 0; j < 4; ++j) { const int n = (lane >> 3) + 8 * j; const LAS float* s = buf + (8 * c) * 32 + (((n >> 2) ^ c) & 7) * 4 + (n & 3);
        float v[8];
#pragma unroll
        for (int q = 0; q < 8; ++q) v[q] = s[q * 32] * scale;
        if (d.kind == 1) { u32x2 o; o.x = pk4_fp8(v[0], v[1], v[2], v[3]); o.y = pk4_fp8(v[4], v[5], v[6], v[7]); *(u32x2*)(d.dst + (size_t)n * d.ldk + 8 * c) = o; }
        else { u32x4 o; o.x = pk2(v[0], v[1]); o.y = pk2(v[2], v[3]); o.z = pk2(v[4], v[5]); o.w = pk2(v[6], v[7]); *(u32x4*)(d.dst + (size_t)n * d.ldk + 16 * c) = o; } }
    LDS_WAIT(); asm volatile("" ::: "memory");
}
#define CONV_RUN(NIT, DEC) do { int it_ = gw; if (it_ < (NIT)) { ConvD dc_ = DEC(it_); int par_ = 0; conv_dma(dc_, F.lane, scr); asm volatile("s_waitcnt vmcnt(0)" ::: "memory"); \
        for (; it_ < (NIT); it_ += NGW) { const int itn_ = (it_ + NGW < (NIT)) ? it_ + NGW : it_; const ConvD dn_ = DEC(itn_); conv_dma(dn_, F.lane, scr + (par_ ^ 1) * 2048);     \
            asm volatile("s_waitcnt vmcnt(12)" ::: "memory"); conv_finish_lds(dc_, F.lane, scr + par_ * 2048); dc_ = dn_; par_ ^= 1; } \
        asm volatile("s_waitcnt vmcnt(0)" ::: "memory"); } } while (0)
__device__ __forceinline__ ConvD conv_dec_mixers(KP p, unsigned char* ws, int it) {
    constexpr int I_AIN = 16 * 288, I_AOUT = 16 * 32, I_RIN = 16 * 192, I_ROUT = 32 * 32, I_GLU = 16 * 64, I_RT = 16 * 2;
    int r = it;
    if (r < 2 * I_AIN) { const int j = r / I_AIN; r %= I_AIN; const int kb = r / 288, nb = r % 288, n0 = nb * 32;
        return conv_mk8(gin(p, 1) + (size_t)j * D * ATT_IN, ATT_IN, (unsigned char*)(ws + WS_ATT_IN_T) + (size_t)j * ATT_IN * D, D, kb * 64, n0, n0); }
    r -= 2 * I_AIN;
    if (r < 2 * I_AOUT) { const int j = r / I_AOUT; r %= I_AOUT; const int kb = r / 32, nb = r % 32, n0 = nb * 32;
        return conv_mk8(gin(p, 2) + (size_t)j * D * D, D, (unsigned char*)(ws + WS_ATT_OUT_T) + (size_t)j * D * D, D, kb * 64, n0, n0); }
    r -= 2 * I_AOUT;
    if (r < I_RIN) { const int kb = r / 192, nb = r % 192, n0 = nb * 32;
        return conv_mk8(gin(p, 3), RET_IN, (unsigned char*)(ws + WS_RET_IN_T), D, kb * 64, n0, n0); }
    r -= I_RIN;
    if (r < I_ROUT) { const int kb = r / 32, nb = r % 32, n0 = nb * 32;
        return conv_mk8(gin(p, 6), D, (unsigned char*)(ws + WS_RET_OUT_T), RET_V, kb * 64, n0, n0); }
    r -= I_ROUT;
    if (r < I_GLU) { const int kb = r / 64, nb = r % 64, n0 = nb * 32; const int c = n0 & 1023, drow = (c >> 7) * 256 + (n0 >> 10) * 128 + (c & 127);
        return conv_mk8(gin(p, 15), 2 * D, (unsigned char*)(ws + WS_GLU_T), D, kb * 64, n0, drow); }
    r -= I_GLU;
    { const int l = r / I_RT; r %= I_RT; const int kb = r / 2, nb = r % 2, n0 = nb * 32;
        return conv_mk16(gin(p, 16) + (size_t)l * D * NE, NE, (bf16*)(ws + WS_RT_HI) + (size_t)l * NE * D, (bf16*)(ws + WS_RT_LO) + (size_t)l * NE * D, D, kb * 64, n0, n0); }
}
__device__ __forceinline__ ConvD conv_dec_moe(KP p, unsigned char* ws, int l, int it) {
    const int e = it / 384, r = it % 384, which = r >> 7, rr = r & 127;
    bf16* We = (bf16*)(ws + WS_WMOE + (size_t)e * WMOE_E_BYTES);
    if (which < 2) { const float* src = (e < 64) ? gin(p, 18 + which) + ((size_t)l * NE + e) * D * ED : gin(p, 21 + which) + (size_t)l * D * ED;
        const int kb = rr >> 3, nb = rr & 7, n0 = nb * 32; const int drow = (n0 >> 7) * 256 + which * 128 + (n0 & 127);
        return conv_mk8(src, ED, (unsigned char*)We, D, kb * 64, n0, drow); }
    const float* src = (e < 64) ? gin(p, 20) + ((size_t)l * NE + e) * ED * D : gin(p, 23) + (size_t)l * ED * D;
    const int kb = rr >> 5, nb = rr & 31, n0 = nb * 32;
    return conv_mk8(src, D, (unsigned char*)(We + 512 * 1024), ED, kb * 64, n0, n0);
}
__device__ __forceinline__ void phase_conv_mixers(const Frame& F, KP p) {
    LAS float* scr = (LAS float*)(F.lds + F.wave * 16384);
    const int gw = F.vcu * NWAVES + F.wave, NGW = F.G * NWAVES;
    constexpr int NMAIN = 2 * (16 * 288) + 2 * (16 * 32) + 16 * 192 + 32 * 32 + 16 * 64, NRT = 4 * (16 * 2);
    unsigned char* ws = F.ws;
#define CONV_DEC_MIX(i_) conv_dec_mixers(p, ws, (i_))
    CONV_RUN(NMAIN, CONV_DEC_MIX);
    for (int it = NMAIN + gw; it < NMAIN + NRT; it += NGW) { const ConvD d = conv_dec_mixers(p, ws, it); f32x4 r[8]; conv_load(d, F.lane, r); conv_finish<true>(d, F.lane, r, scr); }
#undef CONV_DEC_MIX
}
__device__ __forceinline__ void phase_conv_moe(const Frame& F, KP p, int l) {
    LAS float* scr = (LAS float*)(F.lds + F.wave * 16384);
    const int gw = F.vcu * NWAVES + F.wave, NGW = F.G * NWAVES;
    unsigned char* ws = F.ws;
#define CONV_DEC_MOE(i_) conv_dec_moe(p, ws, l, (i_))
    CONV_RUN(65 * 384, CONV_DEC_MOE);
#undef CONV_DEC_MOE
}

__device__ __forceinline__ void phase_lnr(const Frame& F, KP p, int layer, bool dry = false) {
    const bf16* Y = (const bf16*)(F.ws + WS_Y); bf16* XB = (bf16*)(F.ws + WS_XB); unsigned char* XB8 = (unsigned char*)(F.ws + WS_X);
    const float* lng = gin(p, 24) + (size_t)(layer * 2) * D; const float* lnb = gin(p, 25) + (size_t)(layer * 2) * D;
    const bf16* rthi = (const bf16*)(F.ws + WS_RT_HI) + (size_t)layer * NE * D; const bf16* rtlo = (const bf16*)(F.ws + WS_RT_LO) + (size_t)layer * NE * D;
    const float* rbias = gin(p, 17) + layer * NE;
    unsigned* cnt = (unsigned*)(F.ws + WS_CTL) + CW_CNT + layer * NE * 64;
    int* lists = (int*)(F.ws + WS_LIST); int* tokmap = (int*)(F.ws + WS_LIST + 4 * MiB); float* tokgate = (float*)(F.ws + WS_LIST + 5 * MiB);
    constexpr int XLD = 1032, MAXT = 8;
    LAS bf16* Xhi = (LAS bf16*)F.lds; LAS bf16* Xlo = Xhi + 16 * XLD;
    LAS float* part = (LAS float*)(F.lds + 2 * 16 * XLD * 2);
    LAS int* ent = (LAS int*)(part + 2 * 16 * 64);
    LAS int* hist = ent + MAXT * 16 * 8 * 2; LAS int* base = hist + 64;
    const int lane = F.lane, w = F.wave, g4 = lane >> 4, l15 = lane & 15;
    if (F.tid < 64) hist[F.tid] = 0;
    bf16x8 bhi[16], blo[16];
    { const int nt = w & 3, kh = w >> 2; const bf16* bh = rthi + (size_t)(16 * nt + l15) * D + 512 * kh + 8 * g4; const bf16* bl = rtlo + (size_t)(16 * nt + l15) * D + 512 * kh + 8 * g4;
#pragma unroll
        for (int ks = 0; ks < 16; ++ks) { bhi[ks] = *(const bf16x8*)(bh + 32 * ks); blo[ks] = *(const bf16x8*)(bl + 32 * ks); } }
    u32x4 ypre[2][2];
    if (F.vcu < T / 16) {
#pragma unroll
        for (int rr = 0; rr < 2; ++rr)
#pragma unroll
            for (int j = 0; j < 2; ++j) ypre[rr][j] = *(const u32x4*)(Y + (size_t)(F.vcu * 16 + 2 * w + rr) * D + 8 * lane + 512 * j); }
    int ntile = 0;
    for (int tile = F.vcu; tile < T / 16 && ntile < MAXT; tile += F.G, ++ntile) {
        const int t0 = tile * 16;
        u32x4 ycur[2][2];
#pragma unroll
        for (int rr = 0; rr < 2; ++rr)
#pragma unroll
            for (int j = 0; j < 2; ++j) ycur[rr][j] = ypre[rr][j];
        if (tile + F.G < T / 16) {
#pragma unroll
            for (int rr = 0; rr < 2; ++rr)
#pragma unroll
                for (int j = 0; j < 2; ++j) ypre[rr][j] = *(const u32x4*)(Y + (size_t)((tile + F.G) * 16 + 2 * w + rr) * D + 8 * lane + 512 * j); }
#pragma unroll
        for (int rr = 0; rr < 2; ++rr) {
            const int lr = 2 * w + rr; const size_t row = (size_t)(t0 + lr);
            f32x4 v[4]; float s = 0.f;
#pragma unroll
            for (int j = 0; j < 2; ++j) unpack_bf16x8(ycur[rr][j], v[2 * j], v[2 * j + 1]);
#pragma unroll
            for (int j = 0; j < 4; ++j) s += (v[j][0] + v[j][1]) + (v[j][2] + v[j][3]);
            const float mean = wave_sum(s, lane) * (1.f / D); float s2 = 0.f;
#pragma unroll
            for (int j = 0; j < 4; ++j) { v[j] = v[j] - mean; s2 += (v[j][0] * v[j][0] + v[j][1] * v[j][1]) + (v[j][2] * v[j][2] + v[j][3] * v[j][3]); }
            const float rstd = 1.0f / sqrtf(wave_sum(s2, lane) * (1.f / D) + LN_EPS);
#pragma unroll
            for (int j = 0; j < 2; ++j) { const f32x4 g0 = *(const f32x4*)(lng + 8 * lane + 512 * j), g1 = *(const f32x4*)(lng + 8 * lane + 512 * j + 4), b0 = *(const f32x4*)(lnb + 8 * lane + 512 * j), b1 = *(const f32x4*)(lnb + 8 * lane + 512 * j + 4);
                const f32x4 o0 = v[2 * j] * rstd * g0 + b0, o1 = v[2 * j + 1] * rstd * g1 + b1;
                const u32x4 hi = pack_bf16x8(o0, o1);
                *(u32x4*)(XB + row * D + 8 * lane + 512 * j) = hi;
                { u32x2 q8; q8.x = pk4_fp8(o0[0], o0[1], o0[2], o0[3]); q8.y = pk4_fp8(o1[0], o1[1], o1[2], o1[3]); *(u32x2*)(XB8 + row * D + 8 * lane + 512 * j) = q8; }
                f32x4 h0, h1; unpack_bf16x8(hi, h0, h1); const u32x4 lo = pack_bf16x8(o0 - h0, o1 - h1);
                *(LAS u32x4*)(Xhi + lr * XLD + 8 * lane + 512 * j) = hi; *(LAS u32x4*)(Xlo + lr * XLD + 8 * lane + 512 * j) = lo; }
        }
        __syncthreads();
        { const int nt = w & 3, kh = w >> 2; f32x4 a0 = (f32x4){0.f, 0.f, 0.f, 0.f}, a1 = a0, a2 = a0, a3 = a0, a4 = a0, a5 = a0;
#pragma unroll
            for (int ks = 0; ks < 16; ks += 2) { const int k0 = 512 * kh + 32 * ks;
                const bf16x8 ahi = row_frag(Xhi, XLD, 0, k0, lane), alo = row_frag(Xlo, XLD, 0, k0, lane), bhi2 = row_frag(Xhi, XLD, 0, k0 + 32, lane), blo2 = row_frag(Xlo, XLD, 0, k0 + 32, lane);
                a0 = MFMA16(ahi, bhi[ks], a0); a1 = MFMA16(alo, bhi[ks], a1); a2 = MFMA16(ahi, blo[ks], a2);
                a3 = MFMA16(bhi2, bhi[ks + 1], a3); a4 = MFMA16(blo2, bhi[ks + 1], a4); a5 = MFMA16(bhi2, blo[ks + 1], a5); }
            const f32x4 acc = ((a0 + a3) + (a1 + a4)) + (a2 + a5);
#pragma unroll
            for (int i = 0; i < 4; ++i) part[(kh * 16 + 4 * g4 + i) * 64 + 16 * nt + l15] = acc[i];
        }
        __syncthreads();
#pragma unroll
        for (int rr = 0; rr < 2; ++rr) {
            const int lt = ntile * 16 + 2 * w + rr;
            const float lg = part[(2 * w + rr) * 64 + lane] + part[(16 + 2 * w + rr) * 64 + lane];
            float sc = fsig(lg); sc = (sc == sc) ? sc : 0.5f;
            const float sel = sc + rbias[lane];
            const float m1 = max8(sel);
            const unsigned long long eq = __ballot(sel == m1);
            const unsigned gm = (unsigned)(eq >> (lane & 56)) & 0xffu;
            const int first = (lane & 56) + __builtin_ctz(gm | 0x100u);
            const float m2 = max8((lane == first) ? -INFINITY : sel);
            const float gs = m1 + m2; const int mygrp = lane >> 3; int grank = 0;
#pragma unroll
            for (int gg = 0; gg < 8; ++gg) { const float o = rdl(gs, 8 * gg); grank += (o > gs || (o == gs && gg < mygrp)) ? 1 : 0; }
            const float mv = (grank < 4) ? sel : -INFINITY;
            unsigned key = __builtin_bit_cast(unsigned, mv); key = (key >> 31) ? ~key : (key | 0x80000000u); key = (key & ~63u) | (unsigned)(63 - lane);
            int rank = 64; { unsigned kw = key;
#pragma unroll
                for (int r = 0; r < TOPK; ++r) { const unsigned m = wave_umax(kw); if (kw == m) { rank = r; kw = 0u; } } }
            const bool chosen = rank < TOPK;
            const float wsum = wave_sum(chosen ? sc : 0.f, lane);
            if (chosen) { const int lpos = __hip_atomic_fetch_add(hist + lane, 1, __ATOMIC_RELAXED, __HIP_MEMORY_SCOPE_WORKGROUP);
                ent[(lt * 8 + rank) * 2] = (lane << 16) | lpos; ent[(lt * 8 + rank) * 2 + 1] = __builtin_bit_cast(int, sc * __builtin_amdgcn_rcpf(wsum) * 2.5f); }
        }
    }
    __syncthreads();
    if (dry) return;
    if (F.tid < 64) { const int hcount = hist[F.tid]; base[F.tid] = hcount ? (int)atomicAdd(cnt + F.tid * 64, (unsigned)hcount) : 0; }
    __syncthreads();
    for (int idx = F.tid; idx < ntile * 16 * 8; idx += NTHREADS) {
        const int ev = ent[idx * 2], gb = ent[idx * 2 + 1]; const int e = ev >> 16, pos = base[e] + (ev & 0xffff);
        const int lt = idx >> 3, rank = idx & 7, tok = (F.vcu + (lt >> 4) * F.G) * 16 + (lt & 15);
        lists[(size_t)e * T + pos] = tok; tokmap[tok * 8 + rank] = (e << 16) | pos; tokgate[tok * 8 + rank] = __builtin_bit_cast(float, gb);
    }
}

__device__ __forceinline__ void phase_combine(const Frame& F, KP p, int layer, bool dry = false) {
    bf16* XB = (bf16*)(F.ws + WS_XB); const unsigned char* yexp = (const unsigned char*)(F.ws + WS_BIG);
    const int* tokmap = (const int*)(F.ws + WS_LIST + 4 * MiB); const float* tokgate = (const float*)(F.ws + WS_LIST + 5 * MiB);
    const volatile LAS int* tstart = (const volatile LAS int*)(F.MISC + 64);
    const float* lng = gin(p, 24) + (size_t)(layer * 2 + 1) * D; const float* lnb = gin(p, 25) + (size_t)(layer * 2 + 1) * D;
    float* outp = gout(p); bf16* xbo = XB; if (dry) { outp = (float*)(F.ws + WS_AUX); xbo = (bf16*)(F.ws + WS_H); }
    const int lane = F.lane, gw = F.vcu * NWAVES + F.wave, NGW = F.G * NWAVES;
    const bf16* ysh = (const bf16*)(F.ws + WS_Y);
    f32x4 gv[4], bv[4];
#pragma unroll
    for (int j = 0; j < 4; ++j) { gv[j] = *(const f32x4*)(lng + 16 * lane + 4 * j); bv[j] = *(const f32x4*)(lnb + 16 * lane + 4 * j); }
    for (int row = gw; row < T; row += NGW) {
        const int mk = tokmap[row * 8 + (lane & 7)]; const float gk = tokgate[row * 8 + (lane & 7)] * YEXP_INV;
        const int rk = (int)tstart[mk >> 16] * 256 + (mk & 0xffff);
        f32x4 v[4];
#pragma unroll
        for (int j = 0; j < 2; ++j) { const u32x4 xw = *(const u32x4*)(ysh + (size_t)row * D + 16 * lane + 8 * j); unpack_bf16x8(xw, v[2 * j], v[2 * j + 1]); }
#pragma unroll
        for (int k = 0; k < TOPK; ++k) { const int r = __builtin_amdgcn_readlane(rk, k); const float g = rdl(gk, k);
            const u32x4 s = *(const u32x4*)(yexp + (size_t)r * D + 16 * lane);
#pragma unroll
            for (int j = 0; j < 4; ++j) { const f32x2 lo = __builtin_amdgcn_cvt_pk_f32_fp8((int)s[j], false), hi = __builtin_amdgcn_cvt_pk_f32_fp8((int)s[j], true);
                v[j][0] += g * lo[0]; v[j][1] += g * lo[1]; v[j][2] += g * hi[0]; v[j][3] += g * hi[1]; } }
        float s = 0.f;
#pragma unroll
        for (int j = 0; j < 4; ++j) s += (v[j][0] + v[j][1]) + (v[j][2] + v[j][3]);
        const float mean = wave_sum(s, lane) * (1.f / D); float s2 = 0.f;
#pragma unroll
        for (int j = 0; j < 4; ++j) { v[j] = v[j] - mean; s2 += (v[j][0] * v[j][0] + v[j][1] * v[j][1]) + (v[j][2] * v[j][2] + v[j][3] * v[j][3]); }
        const float rstd = 1.0f / sqrtf(wave_sum(s2, lane) * (1.f / D) + LN_EPS);
        f32x4 o[4];
#pragma unroll
        for (int j = 0; j < 4; ++j) o[j] = v[j] * rstd * gv[j] + bv[j];
        if (layer == DEPTH - 1 || dry) {
#pragma unroll
            for (int j = 0; j < 4; ++j) *(f32x4*)(outp + (size_t)row * D + 16 * lane + 4 * j) = o[j]; }
        if (layer != DEPTH - 1) { *(u32x4*)(xbo + (size_t)row * D + 16 * lane) = pack_bf16x8(o[0], o[1]); *(u32x4*)(xbo + (size_t)row * D + 16 * lane + 8) = pack_bf16x8(o[2], o[3]);
            if (!dry) { u32x4 q8; q8.x = pk4_fp8(o[0][0], o[0][1], o[0][2], o[0][3]); q8.y = pk4_fp8(o[1][0], o[1][1], o[1][2], o[1][3]); q8.z = pk4_fp8(o[2][0], o[2][1], o[2][2], o[2][3]); q8.w = pk4_fp8(o[3][0], o[3][1], o[3][2], o[3][3]);
                *(u32x4*)((unsigned char*)(F.ws + WS_X) + (size_t)row * D + 16 * lane) = q8; } }
    }
}

constexpr size_t AUX_OB = 96 * MiB, AUX_LSE = 128 * MiB;
__device__ __forceinline__ unsigned att_qoff(int R, int j, int qi, int g4) {
    const int h = R & 7, sbr = R >> 3, g = sbr >> 5, rem = sbr & 31, b = rem >> 4, rr_ = rem & 15;
    const int dsh = 2 * g, d = 1 << dsh, nrs = 4 - dsh, r = rr_ >> nrs, n = 4 * (rr_ & ((1 << nrs) - 1)) + j;
    const unsigned qrow = (unsigned)b * SEQ + (unsigned)(128 * n + qi) * (unsigned)d + (unsigned)r;
    return qrow * (unsigned)ATT_IN + (unsigned)(g * 3072 + h * 128 + 8 * g4);
}
__device__ __forceinline__ void phase_attn(const Frame& F, int bx) {
    const unsigned char* qkv = (const unsigned char*)(F.ws + WS_BIG); bf16* og = (bf16*)(F.ws + WS_AUX); float* lse = (float*)(F.ws + WS_AUX + AUX_LSE);
    constexpr int KLD = 136;
    LAS bf16* Ks = (LAS bf16*)F.lds; LAS bf16* Vs = Ks + 256 * KLD;
    const int lane = F.lane, w = F.wave, g4 = lane >> 4, l15 = lane & 15, qq = l15 >> 2, pp = lane & 3;
    u32x4 kc[2], vc[2];
    constexpr int NRUN = 768;
#define ATT_CVT8(lo_, hi_) ({ const f32x2 a_ = __builtin_amdgcn_cvt_pk_f32_fp8((int)(lo_), false), b_ = __builtin_amdgcn_cvt_pk_f32_fp8((int)(lo_), true), c_ = __builtin_amdgcn_cvt_pk_f32_fp8((int)(hi_), false), d_ = __builtin_amdgcn_cvt_pk_f32_fp8((int)(hi_), true); \
        u32x4 r_; r_.x = pk2(a_[0], a_[1]); r_.y = pk2(b_[0], b_[1]); r_.z = pk2(c_[0], c_[1]); r_.w = pk2(d_[0], d_[1]); r_; })
#define ATT_LOADBLK(KR, VR, nblk) do { _Pragma("unroll") for (int it = 0; it < 2; ++it) { const int idx = F.tid + 512 * it, c = idx >> 3, ch = idx & 7; int pos = 128 * (nblk) + c; pos = pos < 0 ? 0 : pos; \
            const unsigned so = (rowbase + (unsigned)pos * (unsigned)d + (unsigned)r) * (unsigned)ATT_IN + (unsigned)(g * 3072 + 1024 + h * 128 + ch * 16); KR[it] = *(const u32x4*)(qkv + so); VR[it] = *(const u32x4*)(qkv + so + 1024u); } } while (0)
#define ATT_STOREBLK(KR, VR, slot) do { _Pragma("unroll") for (int it = 0; it < 2; ++it) { const int idx = F.tid + 512 * it, c = idx >> 3, ch = idx & 7; \
            *(LAS u32x4*)(Ks + (128 * (slot) + c) * KLD + ch * 16) = ATT_CVT8(KR[it].x, KR[it].y); *(LAS u32x4*)(Ks + (128 * (slot) + c) * KLD + ch * 16 + 8) = ATT_CVT8(KR[it].z, KR[it].w); \
            *(LAS u32x4*)(Vs + (128 * (slot) + c) * KLD + ch * 16) = ATT_CVT8(VR[it].x, VR[it].y); *(LAS u32x4*)(Vs + (128 * (slot) + c) * KLD + ch * 16 + 8) = ATT_CVT8(VR[it].z, VR[it].w); } } while (0)
    const int qi = 16 * w + l15;
    u32x2 qraw[4];
    if (bx < NRUN) { const unsigned qo = att_qoff(bx, 0, qi, g4);
#pragma unroll
        for (int s = 0; s < 4; ++s) qraw[s] = *(const u32x2*)(qkv + qo + 32 * s); }
    for (int R = bx; R < NRUN; R += F.G) {
        const int h = R & 7, sbr = R >> 3, g = sbr >> 5, rem = sbr & 31, b = rem >> 4, rr_ = rem & 15;
        const int dsh = 2 * g, d = 1 << dsh, nrs = 4 - dsh, r = rr_ >> nrs, n0 = 4 * (rr_ & ((1 << nrs) - 1)); const unsigned rowbase = (unsigned)b * SEQ;
        { u32x4 k0[2], v0[2]; ATT_LOADBLK(k0, v0, n0 - 1); ATT_LOADBLK(kc, vc, n0); ATT_STOREBLK(k0, v0, (n0 - 1) & 1); }
#pragma unroll 1
        for (int j = 0; j < 4; ++j) {
            const int n = n0 + j, cs = n & 1, ps = cs ^ 1;
            ATT_STOREBLK(kc, vc, cs);
            const unsigned qrow = rowbase + (unsigned)(128 * n + qi) * (unsigned)d + (unsigned)r;
            bf16x8 qf[4];
#pragma unroll
            for (int s = 0; s < 4; ++s) qf[s] = __builtin_bit_cast(bf16x8, ATT_CVT8(qraw[s].x, qraw[s].y));
            __syncthreads();
            if (j < 3) { ATT_LOADBLK(kc, vc, n + 1); }
            __builtin_amdgcn_sched_barrier(0);
            const int ws0 = (16 * w < 96) ? 16 * w : 96;
#define ATT_PROW(c0) (((c0) < 128) ? (128 * ps + (c0)) : (128 * cs + (c0) - 128))
            f32x4 sacc[10];
            {
                bf16x8 kfa[4], kfb[4];
#pragma unroll
                for (int s = 0; s < 4; ++s) kfa[s] = row_frag(Ks, KLD, ATT_PROW(ws0), 32 * s, lane);
#pragma unroll
                for (int t = 0; t < 10; t += 2) {
#pragma unroll
                    for (int s = 0; s < 4; ++s) kfb[s] = row_frag(Ks, KLD, ATT_PROW(ws0 + 16 * (t + 1)), 32 * s, lane);
                    __builtin_amdgcn_sched_barrier(0);
                    sacc[t] = (f32x4){0.f, 0.f, 0.f, 0.f};
#pragma unroll
                    for (int s = 0; s < 4; ++s) sacc[t] = MFMA16(kfa[s], qf[s], sacc[t]);
                    if (t + 2 < 10) {
#pragma unroll
                        for (int s = 0; s < 4; ++s) kfa[s] = row_frag(Ks, KLD, ATT_PROW(ws0 + 16 * (t + 2)), 32 * s, lane); }
                    __builtin_amdgcn_sched_barrier(0);
                    sacc[t + 1] = (f32x4){0.f, 0.f, 0.f, 0.f};
#pragma unroll
                    for (int s = 0; s < 4; ++s) sacc[t + 1] = MFMA16(kfb[s], qf[s], sacc[t + 1]);
                }
            }
            { const int Rn = (j < 3) ? R : ((R + F.G < NRUN) ? R + F.G : R), jn = (j < 3) ? j + 1 : 0; const unsigned qo = att_qoff(Rn, jn, qi, g4);
#pragma unroll
              for (int s = 0; s < 4; ++s) qraw[s] = *(const u32x2*)(qkv + qo + 32 * s); }
            const float slope = exp2f(-(float)(h + 1)) * (float)d;
            float mx = -INFINITY;
            int sbase = 128 + qi - ws0 - 4 * g4; asm volatile("" : "+v"(sbase));
            const float nsb = -slope * (float)sbase; const int kmin = (n > 0) ? sbase - 128 : ((sbase - 128 > 128 - ws0 - 4 * g4) ? sbase - 128 : 128 - ws0 - 4 * g4);
#pragma unroll
            for (int t = 0; t < 10; ++t)
#pragma unroll
                for (int i = 0; i < 4; ++i) { const int k = 16 * t + i;
                    const bool valid = (k <= sbase) && (k >= kmin);
                    const float v = valid ? __builtin_fmaf(slope, (float)k, __builtin_fmaf(sacc[t][i], 1.0f / (Q8_SCALE * KV8_SCALE), nsb)) : -INFINITY; sacc[t][i] = v; mx = fmaxf(mx, v); }
            mx = fmaxf(mx, shx(mx, 16, lane)); mx = fmaxf(mx, shx(mx, 32, lane));
            float lsum = 0.f;
#pragma unroll
            for (int t = 0; t < 10; ++t)
#pragma unroll
                for (int i = 0; i < 4; ++i) { const float pv = __expf(sacc[t][i] - mx); sacc[t][i] = pv; lsum += pv; }
            lsum += shx(lsum, 16, lane); lsum += shx(lsum, 32, lane);
            bf16x8 pf[5];
#pragma unroll
            for (int kt = 0; kt < 5; ++kt) pf[kt] = pack8(sacc[2 * kt], sacc[2 * kt + 1]);
            f32x4 o[8];
            {
                const LAS bf16* vl = Vs + (4 * g4 + qq) * KLD + 32 * pp;
                bf16x4 va[10], vcc[10];
#pragma unroll
                for (int q = 0; q < 10; ++q) va[q] = tr4(vl + ATT_PROW(ws0 + 16 * q) * KLD);
#pragma unroll
                for (int et = 0; et < 8; et += 2) {
#pragma unroll
                    for (int q = 0; q < 10; ++q) vcc[q] = tr4(vl + ATT_PROW(ws0 + 16 * q) * KLD + 4 * (et + 1));
                    __builtin_amdgcn_sched_barrier(0);
                    o[et] = (f32x4){0.f, 0.f, 0.f, 0.f};
#pragma unroll
                    for (int kt = 0; kt < 5; ++kt) o[et] = MFMA16(cat8(va[2 * kt], va[2 * kt + 1]), pf[kt], o[et]);
                    if (et + 2 < 8) {
#pragma unroll
                        for (int q = 0; q < 10; ++q) va[q] = tr4(vl + ATT_PROW(ws0 + 16 * q) * KLD + 4 * (et + 2)); }
                    __builtin_amdgcn_sched_barrier(0);
                    o[et + 1] = (f32x4){0.f, 0.f, 0.f, 0.f};
#pragma unroll
                    for (int kt = 0; kt < 5; ++kt) o[et + 1] = MFMA16(cat8(vcc[2 * kt], vcc[2 * kt + 1]), pf[kt], o[et + 1]);
                }
            }
#undef ATT_PROW
            const float inv = (1.0f / KV8_SCALE) / lsum;
            bf16* orow = og + ((size_t)g * T + qrow) * D + h * 128 + 32 * g4;
#pragma unroll
            for (int e2 = 0; e2 < 4; ++e2) *(u32x4*)(orow + 8 * e2) = pack_bf16x8(o[2 * e2] * inv, o[2 * e2 + 1] * inv);
            if (g4 == 0) lse[((size_t)g * T + qrow) * AH + h] = mx + __logf(lsum);
            __syncthreads();
        }
    }
#undef ATT_LOADBLK
#undef ATT_CVT8
#undef ATT_STOREBLK
}
__device__ __forceinline__ void phase_attn_combine(const Frame& F) {
    const bf16* og = (const bf16*)(F.ws + WS_AUX); const float* lse = (const float*)(F.ws + WS_AUX + AUX_LSE); bf16* ob = (bf16*)(F.ws + WS_AUX + AUX_OB);
    const int lane = F.lane, gw = F.vcu * NWAVES + F.wave, NGW = F.G * NWAVES, h = lane >> 3;
    for (int row = gw; row < T; row += NGW) {
        const float l0 = lse[((size_t)0 * T + row) * AH + h], l1 = lse[((size_t)1 * T + row) * AH + h], l2 = lse[((size_t)2 * T + row) * AH + h];
        const float m = fmaxf(l0, fmaxf(l1, l2)); float w0 = __expf(l0 - m), w1 = __expf(l1 - m), w2 = __expf(l2 - m); const float inv = 1.0f / (w0 + w1 + w2); w0 *= inv; w1 *= inv; w2 *= inv;
        float a[16];
#pragma unroll
        for (int j = 0; j < 16; ++j) a[j] = 0.f;
#pragma unroll
        for (int g = 0; g < 3; ++g) { const float wg = (g == 0) ? w0 : (g == 1 ? w1 : w2);
#pragma unroll
            for (int q = 0; q < 2; ++q) { const u32x4 s = *(const u32x4*)(og + ((size_t)g * T + row) * D + 16 * lane + 8 * q);
                a[8 * q + 0] += wg * bflo(s.x); a[8 * q + 1] += wg * bfhi(s.x); a[8 * q + 2] += wg * bflo(s.y); a[8 * q + 3] += wg * bfhi(s.y);
                a[8 * q + 4] += wg * bflo(s.z); a[8 * q + 5] += wg * bfhi(s.z); a[8 * q + 6] += wg * bflo(s.w); a[8 * q + 7] += wg * bfhi(s.w); } }
        { u32x4 o;
#pragma unroll
          for (int q = 0; q < 4; ++q) o[q] = pk4_fp8(a[4 * q] * A_SCALE, a[4 * q + 1] * A_SCALE, a[4 * q + 2] * A_SCALE, a[4 * q + 3] * A_SCALE);
          *(u32x4*)((unsigned char*)ob + (size_t)row * D + 16 * lane) = o; }
    }
}

constexpr size_t BIG_YRET = 192 * MiB;
__device__ __forceinline__ void phase_ret_u(const Frame& F) {
    const unsigned char* proj = (const unsigned char*)(F.ws + WS_BIG); unsigned char* St = (unsigned char*)(F.ws + WS_AUX);
    constexpr int LD = 264;
    LAS bf16* Kt = (LAS bf16*)F.lds; LAS bf16* Vt = Kt + 128 * LD;
    const int lane = F.lane, w = F.wave, g4 = lane >> 4, l15 = lane & 15, qq = l15 >> 2, pp = lane & 3;
    u32x4 kr[4], vr[4];
#define RU_LOAD(u_) do { const int eh_ = (u_) & 1, h_ = ((u_) >> 1) & 3, n_ = ((u_) >> 3) & 63, b_ = (u_) >> 9; const char* pb_ = (const char*)(proj + ((size_t)b_ * SEQ + (size_t)n_ * RC) * RET_IN); \
        int t_ = F.tid; asm volatile("" : "+v"(t_)); unsigned off_ = (unsigned)((t_ >> 4) * RET_IN + (t_ & 15) * 16); \
        _Pragma("unroll") for (int it = 0; it < 4; ++it) { asm volatile("" : "+v"(off_)); kr[it] = *(const u32x4*)(pb_ + (size_t)(1024 + h_ * 256 + it * 32 * RET_IN) + off_); \
            vr[it] = *(const u32x4*)(pb_ + (size_t)(2048 + h_ * 512 + eh_ * 256 + it * 32 * RET_IN) + off_); } } while (0)
    if (F.vcu < 1024) RU_LOAD(F.vcu);
    for (int u = F.vcu; u < 1024; u += F.G) {
        const int eh = u & 1, h = (u >> 1) & 3, n = (u >> 3) & 63, b = u >> 9;
        { int t_ = F.tid; asm volatile("" : "+v"(t_));
#pragma unroll
          for (int it = 0; it < 4; ++it) { const int idx = t_ + 512 * it, j = idx >> 4, ch = idx & 15;
              *(LAS u32x4*)(Kt + j * LD + ch * 16) = cvt8_bf16(kr[it].x, kr[it].y); *(LAS u32x4*)(Kt + j * LD + ch * 16 + 8) = cvt8_bf16(kr[it].z, kr[it].w);
              *(LAS u32x4*)(Vt + j * LD + ch * 16) = cvt8_bf16(vr[it].x, vr[it].y); *(LAS u32x4*)(Vt + j * LD + ch * 16 + 8) = cvt8_bf16(vr[it].z, vr[it].w); } }
        __syncthreads();
        f32x4 acc[16][2];
#pragma unroll
        for (int mt = 0; mt < 16; ++mt) { acc[mt][0] = (f32x4){0.f, 0.f, 0.f, 0.f}; acc[mt][1] = (f32x4){0.f, 0.f, 0.f, 0.f}; }
#pragma unroll
        for (int ks = 0; ks < 4; ++ks) {
            bf16x8 bfr[2];
#pragma unroll
            for (int nt = 0; nt < 2; ++nt) { const LAS bf16* a0 = Vt + (32 * ks + 8 * g4 + qq) * LD + 32 * w + 16 * nt + 4 * pp; bfr[nt] = cat8(tr4(a0), tr4(a0 + 4 * LD)); }
#pragma unroll
            for (int mt = 0; mt < 16; ++mt) { const LAS bf16* a0 = Kt + (32 * ks + 8 * g4 + qq) * LD + 128 * (mt >> 3) + 32 * pp + 4 * (mt & 7);
                const bf16x8 afr = cat8(tr4(a0), tr4(a0 + 4 * LD));
                acc[mt][0] = MFMA16(afr, bfr[0], acc[mt][0]); acc[mt][1] = MFMA16(afr, bfr[1], acc[mt][1]); }
        }
        { const int un = (u + F.G < 1024) ? u + F.G : u; RU_LOAD(un); }
        unsigned char* outb = St + ((size_t)((b * RH + h) * RNC + n)) * (RDV * RDK);
#pragma unroll
        for (int nt = 0; nt < 2; ++nt) { unsigned char* orow = outb + (size_t)(eh * 256 + 32 * w + 16 * nt + l15) * RDK + 32 * g4;
#pragma unroll
            for (int mh = 0; mh < 2; ++mh)
#pragma unroll
                for (int q2 = 0; q2 < 2; ++q2) { u32x4 o;
#pragma unroll
                    for (int k = 0; k < 4; ++k) { const f32x4 v = acc[mh * 8 + 4 * q2 + k][nt] * (RS_SCALE / (RK_SCALE * RV_SCALE)); o[k] = pk4_fp8(v[0], v[1], v[2], v[3]); }
                    *(u32x4*)(orow + 128 * mh + 16 * q2) = o; } }
        __syncthreads();
    }
#undef RU_LOAD
}
__device__ __forceinline__ void phase_ret_scan(const Frame& F) {
    unsigned char* St = (unsigned char*)(F.ws + WS_AUX);
    for (int gt = F.vcu * NTHREADS + F.tid; gt < 8 * 8192; gt += F.G * NTHREADS) {
        const int bh = gt >> 13, chunk = gt & 8191, h = bh & 3;
        const float g128 = exp2f(128.0f * log2f(1.0f - exp2f(-5.0f - (float)h)));
        unsigned char* base = St + (size_t)bh * RNC * (RDV * RDK) + (size_t)chunk * 16;
        float c[16];
#pragma unroll
        for (int j = 0; j < 16; ++j) c[j] = 0.f;
#pragma unroll 8
        for (int n = 0; n < RNC; ++n) { unsigned char* pn = base + (size_t)n * (RDV * RDK); const u32x4 uv = *(const u32x4*)pn;
            u32x4 o;
#pragma unroll
            for (int k = 0; k < 4; ++k) o[k] = pk4_fp8(c[4 * k], c[4 * k + 1], c[4 * k + 2], c[4 * k + 3]);
            *(u32x4*)pn = o;
#pragma unroll
            for (int k = 0; k < 4; ++k) { const f32x2 lo = __builtin_amdgcn_cvt_pk_f32_fp8((int)uv[k], false), hi = __builtin_amdgcn_cvt_pk_f32_fp8((int)uv[k], true);
                c[4 * k] = g128 * (c[4 * k] + lo[0]); c[4 * k + 1] = g128 * (c[4 * k + 1] + lo[1]); c[4 * k + 2] = g128 * (c[4 * k + 2] + hi[0]); c[4 * k + 3] = g128 * (c[4 * k + 3] + hi[1]); } }
    }
}
__device__ __forceinline__ void phase_ret_out(const Frame& F, KP p) {
    const unsigned char* proj = (const unsigned char*)(F.ws + WS_BIG); const unsigned char* St = (const unsigned char*)(F.ws + WS_AUX); bf16* yret = (bf16*)(F.ws + WS_BIG + BIG_YRET);
    const float* gng = gin(p, 4); const float* gnb = gin(p, 5);
    constexpr int LD = 264, VLD = 72, NSL = 8, ESL = 64;
    LAS bf16* Rs = (LAS bf16*)F.lds; LAS bf16* Vs = Rs + 128 * LD;
    const int w = F.wave;
#define RO_TID(t_) int t_ = F.tid; asm volatile("" : "+v"(t_))
#define RO_LD(base_, off_) (*(const u32x4*)((const char*)(base_) + (off_)))
    for (int u = F.vcu; u < 512; u += F.G) {
        const int h = u & 3, n = (u >> 2) & 63, b = u >> 8;
        const size_t row0 = (size_t)b * SEQ + (size_t)n * RC;
        const unsigned char* Sn = St + ((size_t)((b * RH + h) * RNC + n)) * (RDV * RDK);
        const char* pbase = (const char*)(proj + row0 * RET_IN);
        u32x4 pv[1], ps[2];
        bf16x8 qf[8];
        { RO_TID(t0); u32x4 kreg[4]; u32x2 qraw[8];
          unsigned koff = (unsigned)((t0 >> 4) * RET_IN + (t0 & 15) * 16), qoff = (unsigned)((16 * w + (t0 & 15)) * RET_IN + 8 * ((t0 & 63) >> 4));
#pragma unroll
          for (int it = 0; it < 4; ++it) { asm volatile("" : "+v"(koff)); kreg[it] = RO_LD(pbase + (size_t)(1024 + h * 256 + it * 32 * RET_IN), koff); }
#pragma unroll
          for (int s = 0; s < 8; ++s) { asm volatile("" : "+v"(qoff)); qraw[s] = *(const u32x2*)(pbase + (size_t)(h * 256 + 32 * s) + qoff); }
#define RO_LOAD_SLICE(sl_) do { RO_TID(tl_); unsigned voff = (unsigned)((tl_ >> 2) * RET_IN + (tl_ & 3) * 16), soff = (unsigned)((tl_ >> 4) * RDK + (tl_ & 15) * 16); \
            asm volatile("" : "+v"(voff)); pv[0] = RO_LD(pbase + (size_t)(2048 + h * 512 + (sl_) * ESL), voff); \
            _Pragma("unroll") for (int it = 0; it < 2; ++it) { asm volatile("" : "+v"(soff)); ps[it] = RO_LD((const char*)Sn + (size_t)(((sl_) * ESL + it * 32) * RDK), soff); } } while (0)
          RO_LOAD_SLICE(0);
#pragma unroll
          for (int it = 0; it < 4; ++it) { const int idx = t0 + 512 * it, j = idx >> 4, ch = idx & 15;
              *(LAS u32x4*)(Rs + j * LD + ch * 16) = cvt8_bf16(kreg[it].x, kreg[it].y); *(LAS u32x4*)(Rs + j * LD + ch * 16 + 8) = cvt8_bf16(kreg[it].z, kreg[it].w); }
#pragma unroll
          for (int s = 0; s < 8; ++s) qf[s] = __builtin_bit_cast(bf16x8, cvt8_bf16(qraw[s].x, qraw[s].y)); }
        __syncthreads();
        bf16x8 pf[4];
        { RO_TID(t1); const int lane = t1 & 63, g4 = lane >> 4, irow = 16 * w + (lane & 15);
          f32x4 sacc[8];
#pragma unroll
            for (int jt = 0; jt < 8; ++jt) { sacc[jt] = (f32x4){0.f, 0.f, 0.f, 0.f};
                if (jt <= w) {
#pragma unroll
                    for (int s = 0; s < 8; ++s) sacc[jt] = MFMA16(row_frag(Rs, LD, 16 * jt, 32 * s, lane), qf[s], sacc[jt]);
#pragma unroll
                    for (int i = 0; i < 4; ++i) if (16 * jt + 4 * g4 + i > irow) sacc[jt][i] = 0.f; } }
#pragma unroll
            for (int kt = 0; kt < 4; ++kt) pf[kt] = pack8(sacc[2 * kt] * (RS_SCALE / (RQ_SCALE * RK_SCALE)), sacc[2 * kt + 1] * (RS_SCALE / (RQ_SCALE * RK_SCALE))); }
        __syncthreads();
        u32x4 accp[NSL][2];
        float s1 = 0.f, s2 = 0.f;
#pragma unroll
        for (int sl = 0; sl < NSL; ++sl) {
            { RO_TID(t2);
              { const int j = t2 >> 2, ch = t2 & 3; *(LAS u32x4*)(Vs + j * VLD + ch * 16) = cvt8_bf16(pv[0].x, pv[0].y); *(LAS u32x4*)(Vs + j * VLD + ch * 16 + 8) = cvt8_bf16(pv[0].z, pv[0].w); }
#pragma unroll
              for (int it = 0; it < 2; ++it) { const int idx = t2 + 512 * it, e = idx >> 4, ch = idx & 15; *(LAS u32x4*)(Rs + e * LD + ch * 16) = cvt8_bf16(ps[it].x, ps[it].y); *(LAS u32x4*)(Rs + e * LD + ch * 16 + 8) = cvt8_bf16(ps[it].z, ps[it].w); } }
            __syncthreads();
            if (sl + 1 < NSL) RO_LOAD_SLICE(sl + 1);
            RO_TID(t3); const int lane = t3 & 63, g4 = lane >> 4, qq = (lane & 15) >> 2, pp = lane & 3;
            f32x4 acc[4];
#pragma unroll
            for (int et = 0; et < 4; ++et) { f32x4 a = (f32x4){0.f, 0.f, 0.f, 0.f};
#pragma unroll
                for (int kt = 0; kt < 4; ++kt) if (2 * kt <= w) { const LAS bf16* a0 = Vs + (32 * kt + 4 * g4 + qq) * VLD + 16 * pp + 4 * et;
                    a = MFMA16(cat8(tr4(a0), tr4(a0 + 16 * VLD)), pf[kt], a); }
                const LAS bf16* srow = Rs + (16 * qq + 4 * et + pp) * LD + 8 * g4;
#pragma unroll
                for (int s = 0; s < 8; ++s) a = MFMA16(*(const LAS bf16x8*)(srow + 32 * s), qf[s], a);
                a = a * (1.0f / (RV_SCALE * RS_SCALE));
                acc[et] = a; s1 += (a[0] + a[1]) + (a[2] + a[3]); s2 += (a[0] * a[0] + a[1] * a[1]) + (a[2] * a[2] + a[3] * a[3]);
                __builtin_amdgcn_sched_barrier(0); }
            accp[sl][0] = pack_bf16x8(acc[0], acc[1]); accp[sl][1] = pack_bf16x8(acc[2], acc[3]);
            __syncthreads();
        }
#undef RO_LOAD_SLICE
        RO_TID(t4); const int lane = t4 & 63, g4 = lane >> 4, irow = 16 * w + (lane & 15); const size_t qrow = row0 + irow;
        s1 += shx(s1, 16, lane); s1 += shx(s1, 32, lane); s2 += shx(s2, 16, lane); s2 += shx(s2, 32, lane);
        const float mean = s1 * (1.0f / RDV); const float var = fmaxf(s2 * (1.0f / RDV) - mean * mean, 0.f);
        const float rstd = 1.0f / sqrtf(var + LN_EPS);
        unsigned goff = (unsigned)(irow * RET_IN + 16 * g4);
#pragma unroll
        for (int sp = 0; sp < NSL; sp += 2) {
            u32x4 gq[2]; f32x4 gg[2][4], gb[2][4];
#pragma unroll
            for (int d2 = 0; d2 < 2; ++d2) { const int c0 = h * RDV + (sp + d2) * ESL + 16 * g4;
                asm volatile("" : "+v"(goff)); gq[d2] = RO_LD(pbase + (size_t)(4096 + h * RDV + (sp + d2) * ESL), goff);
#pragma unroll
                for (int q = 0; q < 4; ++q) { gg[d2][q] = *(const f32x4*)(gng + c0 + 4 * q); gb[d2][q] = *(const f32x4*)(gnb + c0 + 4 * q); } }
#pragma unroll
            for (int d2 = 0; d2 < 2; ++d2) { const int c0 = h * RDV + (sp + d2) * ESL + 16 * g4; u32x4 o8;
#pragma unroll
                for (int q = 0; q < 2; ++q) { f32x4 a0, a1; unpack_bf16x8(accp[sp + d2][q], a0, a1);
                    f32x4 y0 = (a0 - mean) * rstd * gg[d2][2 * q] + gb[d2][2 * q], y1 = (a1 - mean) * rstd * gg[d2][2 * q + 1] + gb[d2][2 * q + 1];
                    const f32x2 g0 = __builtin_amdgcn_cvt_pk_f32_fp8((int)gq[d2][2 * q], false), g1 = __builtin_amdgcn_cvt_pk_f32_fp8((int)gq[d2][2 * q], true), g2 = __builtin_amdgcn_cvt_pk_f32_fp8((int)gq[d2][2 * q + 1], false), g3 = __builtin_amdgcn_cvt_pk_f32_fp8((int)gq[d2][2 * q + 1], true);
                    const float gv[8] = {g0[0] * (1.0f / RV_SCALE), g0[1] * (1.0f / RV_SCALE), g1[0] * (1.0f / RV_SCALE), g1[1] * (1.0f / RV_SCALE), g2[0] * (1.0f / RV_SCALE), g2[1] * (1.0f / RV_SCALE), g3[0] * (1.0f / RV_SCALE), g3[1] * (1.0f / RV_SCALE)};
#pragma unroll
                    for (int j = 0; j < 4; ++j) { y0[j] *= gv[j] * fsig(gv[j]) * A_SCALE; y1[j] *= gv[4 + j] * fsig(gv[4 + j]) * A_SCALE; }
                    o8[2 * q] = pk4_fp8(y0[0], y0[1], y0[2], y0[3]); o8[2 * q + 1] = pk4_fp8(y1[0], y1[1], y1[2], y1[3]); }
                *(u32x4*)((unsigned char*)yret + qrow * RET_V + c0) = o8; }
        }
    }
#undef RO_LD
#undef RO_TID
}

constexpr size_t AUX_S5E = 64 * MiB;
constexpr int S5L = 256, S5NC = SEQ / S5L;
__device__ __forceinline__ void cmul_add(float& rr, float& ri, float ar, float ai, float xr, float xi, float cr, float ci) { rr = ar * xr - ai * xi + cr; ri = ar * xi + ai * xr + ci; }
template <bool OUT>
__device__ __forceinline__ void phase_s5_scan(const Frame& F, KP p) {
    const bf16* X = (const bf16*)(F.ws + WS_XB); float* E = (float*)(F.ws + WS_AUX + AUX_S5E); bf16* ybuf = (bf16*)(F.ws + WS_AUX);
    const int lane = F.lane, w = F.wave, g4 = lane >> 4, l15 = lane & 15;
    LAS bf16* ut = (LAS bf16*)(F.lds + w * 12288);
    LAS bf16* Hb = (LAS bf16*)(F.lds + w * 12288 + 4096);
    constexpr int HLD = 136;
    const int gw = F.vcu * NWAVES + w, NGW = F.G * NWAVES;
    const int up16 = (lane - 16) << 2, up32 = (lane - 32) << 2, last16 = (48 + l15) << 2;
    for (int unit = gw; unit < BATCH * SG * S5NC; unit += NGW) {
        const int n = unit & (S5NC - 1), g = (unit >> 5) & 63, b = unit >> 11;
        float a1r[4], a1i[4], a4r[4], a4i[4], a8r[4], a8i[4], pwr[4], pwi[4];
        bf16x8 bfrag[8];
        const float dt = expf(gin(p, 14)[g]);
#pragma unroll
        for (int st = 0; st < 4; ++st) { const int ps = 16 * st + l15;
            const float are = gin(p, 7)[g * SP + ps], aim = gin(p, 8)[g * SP + ps];
            const float mag = expf(dt * are); const float abr = mag * cosf(dt * aim), abi = mag * sinf(dt * aim);
            const float den = are * are + aim * aim;
            const float fre = ((abr - 1.0f) * are + abi * aim) / den, fim = (abi * are - (abr - 1.0f) * aim) / den;
            a1r[st] = abr; a1i[st] = abi; { float t2r, t2i; cmul_add(t2r, t2i, abr, abi, abr, abi, 0.f, 0.f); cmul_add(a4r[st], a4i[st], t2r, t2i, t2r, t2i, 0.f, 0.f); }
            cmul_add(a8r[st], a8i[st], a4r[st], a4i[st], a4r[st], a4i[st], 0.f, 0.f);
            float qr = 1.f, qi = 0.f;
            if (g4 & 1) { qr = a4r[st]; qi = a4i[st]; }
            if (g4 & 2) { float tr, ti; cmul_add(tr, ti, qr, qi, a8r[st], a8i[st], 0.f, 0.f); qr = tr; qi = ti; }
            pwr[st] = qr; pwi[st] = qi;
            const float* br = gin(p, 9) + ((size_t)g * SP + ps) * SGC + 8 * (g4 & 1); const float* bi = gin(p, 10) + ((size_t)g * SP + ps) * SGC + 8 * (g4 & 1);
            const f32x4 r0 = *(const f32x4*)br, r1 = *(const f32x4*)(br + 4), i0 = *(const f32x4*)bi, i1 = *(const f32x4*)(bi + 4);
            const float z = (g4 < 2) ? 1.0f : 0.0f; const float fr2 = fre * z, fi2 = fim * z;
            bfrag[st] = pack8(r0 * fr2 - i0 * fi2, r1 * fr2 - i1 * fi2); bfrag[st + 4] = pack8(i0 * fr2 + r0 * fi2, i1 * fr2 + r1 * fi2);
        }
        float sr[4], si[4];
        float* Eu = E + ((size_t)(b * SG + g) * S5NC + n) * 128;
        bf16x8 cf[4]; f32x4 dsk = (f32x4){0.f, 0.f, 0.f, 0.f};
#pragma unroll
        for (int st = 0; st < 4; ++st) { sr[st] = 0.f; si[st] = 0.f; }
        if (OUT) {
#pragma unroll
            for (int st = 0; st < 4; ++st) { sr[st] = Eu[16 * st + l15]; si[st] = Eu[64 + 16 * st + l15]; }
#pragma unroll
            for (int s = 0; s < 4; ++s) { const float* cp = (s < 2 ? gin(p, 11) : gin(p, 12)) + ((size_t)g * SGC + l15) * SP + 32 * (s & 1) + 8 * g4; const float sg = s < 2 ? 1.0f : -1.0f;
                const f32x4 c0 = *(const f32x4*)cp * sg, c1 = *(const f32x4*)(cp + 4) * sg; cf[s] = pack8(c0, c1); }
            dsk = *(const f32x4*)(gin(p, 13) + g * SGC + 4 * g4); }
        const size_t tok0 = (size_t)b * SEQ + (size_t)n * S5L;
        u32x4 pre[2];
        { const bf16* src = X + (tok0 + lane) * D + g * SGC; pre[0] = *(const u32x4*)src; pre[1] = *(const u32x4*)(src + 8); }
        for (int sub = 0; sub < S5L / 64; ++sub) {
            *(LAS u32x4*)(ut + lane * 16) = pre[0]; *(LAS u32x4*)(ut + lane * 16 + 8) = pre[1];
            if (sub + 1 < S5L / 64) { const bf16* src = X + (tok0 + (sub + 1) * 64 + lane) * D + g * SGC; pre[0] = *(const u32x4*)src; pre[1] = *(const u32x4*)(src + 8); }
            LDS_WAIT(); asm volatile("" ::: "memory");
#pragma unroll (OUT ? 1 : 4)
            for (int blk = 0; blk < 4; ++blk) {
                u32x4 uw = *(const LAS u32x4*)(ut + (blk * 16 + l15) * 16 + 8 * (g4 & 1));
                if (g4 >= 2) uw = (u32x4){0u, 0u, 0u, 0u};
                const bf16x8 ufr = __builtin_bit_cast(bf16x8, uw);
                f32x4 dr[4], di[4];
#pragma unroll
                for (int st = 0; st < 4; ++st) { dr[st] = MFMA16(ufr, bfrag[st], ((f32x4){0.f, 0.f, 0.f, 0.f})); di[st] = MFMA16(ufr, bfrag[st + 4], ((f32x4){0.f, 0.f, 0.f, 0.f})); }
                float vr[4], vi[4];
#pragma unroll
                for (int st = 0; st < 4; ++st) {
                    float hr = 0.f, hi = 0.f;
#pragma unroll
                    for (int i = 0; i < 4; ++i) { float nr, ni; cmul_add(nr, ni, a1r[st], a1i[st], hr, hi, dr[st][i], di[st][i]); hr = nr; hi = ni; dr[st][i] = hr; di[st][i] = hi; }
                    vr[st] = hr; vi[st] = hi; }
#define BPF(idx, v) __builtin_bit_cast(float, __builtin_amdgcn_ds_bpermute((idx), __builtin_bit_cast(int, (v))))
                { float xr[4], xi[4];
#pragma unroll
                  for (int st = 0; st < 4; ++st) { xr[st] = BPF(up16, vr[st]); xi[st] = BPF(up16, vi[st]); }
#pragma unroll
                  for (int st = 0; st < 4; ++st) { float tr, ti; cmul_add(tr, ti, a4r[st], a4i[st], xr[st], xi[st], vr[st], vi[st]); if (g4 >= 1) { vr[st] = tr; vi[st] = ti; } }
#pragma unroll
                  for (int st = 0; st < 4; ++st) { xr[st] = BPF(up32, vr[st]); xi[st] = BPF(up32, vi[st]); }
#pragma unroll
                  for (int st = 0; st < 4; ++st) { float tr, ti; cmul_add(tr, ti, a8r[st], a8i[st], xr[st], xi[st], vr[st], vi[st]); if (g4 >= 2) { vr[st] = tr; vi[st] = ti; } } }
                float er[4], ei[4], lr[4], li[4];
#pragma unroll
                for (int st = 0; st < 4; ++st) { if (OUT) { er[st] = BPF(up16, vr[st]); ei[st] = BPF(up16, vi[st]); } else { er[st] = 0.f; ei[st] = 0.f; } lr[st] = BPF(last16, vr[st]); li[st] = BPF(last16, vi[st]); }
#undef BPF
#pragma unroll
                for (int st = 0; st < 4; ++st) {
                    if (g4 == 0) { er[st] = 0.f; ei[st] = 0.f; }
                    if (OUT) { float s0r, s0i; cmul_add(s0r, s0i, pwr[st], pwi[st], sr[st], si[st], er[st], ei[st]);
#pragma unroll
                        for (int i = 0; i < 4; ++i) { float tr, ti; cmul_add(tr, ti, a1r[st], a1i[st], s0r, s0i, 0.f, 0.f); s0r = tr; s0i = ti; dr[st][i] += s0r; di[st][i] += s0i; } }
                    { float a16r, a16i; cmul_add(a16r, a16i, a8r[st], a8i[st], a8r[st], a8i[st], 0.f, 0.f); float tr, ti; cmul_add(tr, ti, a16r, a16i, sr[st], si[st], lr[st], li[st]); sr[st] = tr; si[st] = ti; }
                    if (OUT) {
#pragma unroll
                        for (int i = 0; i < 4; ++i) { const unsigned hw = pk2(dr[st][i], di[st][i]); Hb[(4 * g4 + i) * HLD + 16 * st + l15] = (bf16)hw; Hb[(4 * g4 + i) * HLD + 64 + 16 * st + l15] = (bf16)(hw >> 16); } }
                }
                if (OUT) {
                    LDS_WAIT(); asm volatile("" ::: "memory");
                    f32x4 ya = (f32x4){0.f, 0.f, 0.f, 0.f};
#pragma unroll
                    for (int s = 0; s < 4; ++s) ya = MFMA16(cf[s], row_frag(Hb, HLD, 0, 32 * s, lane), ya);
                    const u32x2 u2 = *(const LAS u32x2*)(ut + (blk * 16 + l15) * 16 + 4 * g4);
                    const f32x4 u4 = (f32x4){bflo(u2.x), bfhi(u2.x), bflo(u2.y), bfhi(u2.y)};
                    f32x4 y = ya + dsk * u4;
#pragma unroll
                    for (int j = 0; j < 4; ++j) { const float v = y[j]; y[j] = v * fsig(1.5957691216057308f * (v + 0.044715f * v * v * v)); }
                    *(unsigned*)((unsigned char*)ybuf + (size_t)(tok0 + sub * 64 + blk * 16 + l15) * D + g * SGC + 4 * g4) = pk4_fp8(y[0] * A_SCALE, y[1] * A_SCALE, y[2] * A_SCALE, y[3] * A_SCALE);
                    asm volatile("" ::: "memory"); }
            }
            LDS_WAIT(); asm volatile("" ::: "memory");
        }
        if (!OUT && g4 == 0) {
#pragma unroll
            for (int st = 0; st < 4; ++st) { Eu[16 * st + l15] = sr[st]; Eu[64 + 16 * st + l15] = si[st]; } }
    }
}
__device__ __forceinline__ void phase_s5_carry(const Frame& F, KP p) {
    float* E = (float*)(F.ws + WS_AUX + AUX_S5E);
    for (int gt = F.vcu * NTHREADS + F.tid; gt < BATCH * SG * SP; gt += F.G * NTHREADS) {
        const int pl = gt & 63, bg = gt >> 6, g = bg & 63;
        const float dt = expf(gin(p, 14)[g]); const float are = gin(p, 7)[g * SP + pl], aim = gin(p, 8)[g * SP + pl];
        const float mag = expf(dt * are); float ar = mag * cosf(dt * aim), ai = mag * sinf(dt * aim);
#pragma unroll
        for (int q = 0; q < 8; ++q) { const float nr = ar * ar - ai * ai, ni = 2.0f * ar * ai; ar = nr; ai = ni; }
        float cr = 0.f, ci = 0.f;
        for (int n = 0; n < S5NC; ++n) { float* Eu = E + ((size_t)bg * S5NC + n) * 128; const float er = Eu[pl], ei = Eu[64 + pl];
            Eu[pl] = cr; Eu[64 + pl] = ci;
            const float nr = ar * cr - ai * ci + er, ni = ar * ci + ai * cr + ei; cr = nr; ci = ni; }
    }
}

constexpr int NPHASES = 34;
#ifndef PROBE_DRY14
#define PROBE_DRY14 0
#endif
#ifndef PROBE_DRY17
#define PROBE_DRY17 0
#endif
#ifndef PH_MASK
#define PH_MASK 0xFFFFFFFFu
#endif
#define PHT(t) ((PH_MASK >> (t)) & 1u)
constexpr int PLAN_OFF = 64;
__device__ __forceinline__ void moe_plan(const Frame& F, int layer) {
    volatile LAS int* tstart = (volatile LAS int*)(F.MISC + PLAN_OFF); volatile LAS int* cnts = tstart + 72;
    __syncthreads();
    if (F.wave == 0) {
        const unsigned* cnt = (const unsigned*)(F.ws + WS_CTL) + CW_CNT + layer * NE * 64;
        const int c = (int)__hip_atomic_load(cnt + F.lane * 64, __ATOMIC_RELAXED, __HIP_MEMORY_SCOPE_AGENT);
        int v = (c + 255) >> 8;
#pragma unroll
        for (int o = 1; o < 64; o <<= 1) { const int nb = __builtin_amdgcn_ds_bpermute((F.lane - o) << 2, v); if (F.lane >= o) v += nb; }
        tstart[F.lane + 1] = v; cnts[F.lane] = c;
        if (F.lane == 0) tstart[0] = 0;
        if (F.lane == 63) { tstart[65] = v + T / 256; cnts[64] = T; }
    }
    __syncthreads();
}
template <bool GATH> struct MoeSched2 {
    static constexpr bool GATHER = GATH, UNIFORMIZE = true, FP8 = true;
    static constexpr int ncol = GATH ? 2 : 4, K = GATH ? D / 2 : ED / 2;
    const volatile LAS int* tstart; const volatile LAS int* cnts; int ntiles, G, c, lane;
    const char* Abase; const char* Wbase; const int* lists;
    __device__ __forceinline__ bool next(int i, pg8::UnitG& u) const {
        const int nwg = ntiles * ncol; const long L = (long)i * G + c; if (L >= nwg) return false;
        int wgid = (int)L; { const int q = nwg / 8, r = nwg % 8, xcd = wgid % 8, off = wgid / 8; wgid = (xcd < r ? xcd * (q + 1) : r * (q + 1) + (xcd - r) * q) + off; }
        const int tile = wgid / ncol, pn = wgid % ncol;
        int ln; { unsigned o2 = ~0u; asm volatile("" : "+s"(o2)); ln = (int)__builtin_amdgcn_mbcnt_hi(o2, __builtin_amdgcn_mbcnt_lo(o2, 0u)); }
        const int ta = tstart[ln], tb = tstart[ln + 1];
        const unsigned long long mm = __ballot(ta <= tile && tile < tb);
        const int e = mm ? (int)__builtin_ctzll(mm) : 64;
        const int ts = __builtin_amdgcn_readfirstlane((int)tstart[e]), ce = __builtin_amdgcn_readfirstlane((int)cnts[e]);
        const int lt = tile - ts; int valid = ce - lt * 256; valid = valid > 256 ? 256 : valid;
        u.gshift = 0; u.aux = e;
        if (GATH) {
            u.B = Wbase + (size_t)e * WMOE_E_BYTES + (size_t)pn * 256 * K * 2;
            if (e < 64) { u.A = Abase; u.gidx = lists + (size_t)e * T + lt * 256; u.gcnt = valid; }
            else { u.A = Abase + (size_t)lt * 256 * K * 2; u.gidx = nullptr; u.gcnt = 0; }
            u.row0 = tile * 256; u.col0 = pn * 128;
        } else {
            u.B = Wbase + (size_t)e * WMOE_E_BYTES + (size_t)512 * 1024 * 2 + (size_t)pn * 256 * K * 2;
            u.A = Abase + (size_t)tile * 256 * K * 2; u.gidx = nullptr; u.gcnt = valid;
            u.row0 = tile * 256; u.col0 = pn * 256;
        }
        return true;
    }
};
__device__ __forceinline__ void phase_load_x(const Frame& F, KP p) {
    const float* xin = gin(p, 0); bf16* XB = (bf16*)(F.ws + WS_XB);
    for (size_t i = (size_t)F.vcu * NTHREADS + F.tid; i < (size_t)T * D / 8; i += (size_t)F.G * NTHREADS) {
        const f32x4 a = *(const f32x4*)(xin + i * 8), b = *(const f32x4*)(xin + i * 8 + 4);
        *(u32x4*)(XB + i * 8) = pack_bf16x8(a, b);
        u32x2 q8; q8.x = pk4_fp8(a[0], a[1], a[2], a[3]); q8.y = pk4_fp8(b[0], b[1], b[2], b[3]); *(u32x2*)((unsigned char*)(F.ws + WS_X) + i * 8) = q8; }
}

__global__ void __launch_bounds__(NTHREADS, 2) fwd_kernel(Params p_unused) {
    KP p0 = (KP)__builtin_amdgcn_kernarg_segment_ptr();
    extern __shared__ __attribute__((aligned(16))) unsigned char lds_raw[];
    Frame F0;
    F0.lds = (LAS unsigned char*)lds_raw; F0.MISC = (volatile LAS unsigned*)(F0.lds + MISC_OFF);
    F0.tid = threadIdx.x; F0.lane = F0.tid & 63; F0.wave = __builtin_amdgcn_readfirstlane(F0.tid >> 6);
    F0.G = gridDim.x; { const int bq = blockIdx.x; F0.vcu = (F0.G % 8 == 0) ? (bq % 8) * (F0.G / 8) + bq / 8 : bq; }
    F0.ws = p0->ws;
    const int bx0 = blockIdx.x;
    for (int u = F0.tid; u < (LDS_BYTES - MISC_OFF) / 4; u += NTHREADS) ((LAS unsigned*)(F0.lds + MISC_OFF))[u] = 0u;
    __syncthreads();
    XcdBarrier bar; bar.bar = (unsigned*)(p0->ws + WS_CTL) + CW_BAR; bar.x = 0; bar.st = nullptr;
    const int use_bar = p0->use_bar;
    if (use_bar) bar = xcd_barrier_post((unsigned*)(p0->ws + WS_CTL) + CW_BAR, F0.MISC + 8);
    const int lo = p0->ph_lo, hi = p0->ph_hi;
#define PHASE_BEGIN Frame F = F0; KP p = p0; { unsigned ones_ = ~0u; asm volatile("" : "+s"(ones_)); F.lane = (int)__builtin_amdgcn_mbcnt_hi(ones_, __builtin_amdgcn_mbcnt_lo(ones_, 0u)); } asm volatile("" : "+v"(F.lane)); F.tid = F.wave * 64 + F.lane; asm volatile("" : "+v"(F.tid));   GAS unsigned char* wsg_ = (GAS unsigned char*)F0.ws; asm volatile("" : "+s"(F.wave), "+s"(F.vcu), "+s"(F.G), "+s"(wsg_), "+s"(p)); \
    F.ws = (unsigned char*)wsg_; int bx = bx0; asm volatile("" : "+s"(bx)); unsigned char* ws = F.ws; (void)ws; (void)bx;
#pragma unroll 1
    for (int ph = lo; ph < hi; ++ph) {
        int layer = 0, type = 0;
        if (ph > 0) { layer = ph >= 26 ? 3 : (ph >= 18 ? 2 : (ph >= 9 ? 1 : 0)); const int q = ph - (layer == 3 ? 26 : (layer == 2 ? 18 : (layer == 1 ? 9 : 1))); const int kind = layer % 3;
            if (kind == 0) type = q < 4 ? 1 + q : 14 + (q - 4); else if (kind == 1) type = q < 5 ? 5 + q : 14 + (q - 5); else type = q < 4 ? 10 + q : 14 + (q - 4); }
        const int j = layer / 3;
#ifdef REPEAT_MASK
        const int nrep = ((REPEAT_MASK >> type) & 1u) ? 2 : 1;
#else
        const int nrep = 1;
#endif
#pragma unroll 1
        for (int rep = 0; rep < nrep; ++rep) {
        if (rep > 0 && use_bar) xcd_barrier(bar);
        if (PHT(0) && type == 0) { PHASE_BEGIN; phase_conv_mixers(F, p); phase_conv_moe(F, p, 0); phase_load_x(F, p); }
        else if (PHT(1) && type == 1) { PHASE_BEGIN; DenseSched8 S; S.init(ws + WS_X, ws + WS_ATT_IN_T + (size_t)j * ATT_IN * D, T, ATT_IN, D / 2, F.G, bx); EpiStoreQkv8 E{(unsigned char*)(ws + WS_BIG), ATT_IN};
            pg8::gemm_phase(F.lds, F.tid, D / 2, S, E); }
        else if (PHT(2) && type == 2) { PHASE_BEGIN; phase_attn(F, bx); }
        else if (PHT(3) && type == 3) { PHASE_BEGIN; phase_attn_combine(F); }
        else if (PHT(4) && type == 4) { PHASE_BEGIN; DenseSched8 S; S.init(ws + WS_AUX + AUX_OB, ws + WS_ATT_OUT_T + (size_t)j * D * D, T, D, D / 2, F.G, bx); EpiResid8 E{(const bf16*)(ws + WS_XB), (bf16*)(ws + WS_Y), 1.0f / (A_SCALE * WUP_SCALE)};
            pg8::gemm_phase(F.lds, F.tid, D / 2, S, E); }
        else if (PHT(5) && type == 5) { PHASE_BEGIN; DenseSched8 S; S.init(ws + WS_X, ws + WS_RET_IN_T, T, RET_IN, D / 2, F.G, bx); EpiRetIn E{(unsigned char*)(ws + WS_BIG), RET_IN};
            pg8::gemm_phase(F.lds, F.tid, D / 2, S, E); }
        else if (PHT(6) && type == 6) { PHASE_BEGIN; phase_ret_u(F); }
        else if (PHT(7) && type == 7) { PHASE_BEGIN; phase_ret_scan(F); }
        else if (PHT(8) && type == 8) { PHASE_BEGIN; phase_ret_out(F, p); }
        else if (PHT(9) && type == 9) { PHASE_BEGIN; DenseSched8 S; S.init(ws + WS_BIG + BIG_YRET, ws + WS_RET_OUT_T, T, D, RET_V / 2, F.G, bx); EpiResid8 E{(const bf16*)(ws + WS_XB), (bf16*)(ws + WS_Y), 1.0f / (A_SCALE * WUP_SCALE)};
            pg8::gemm_phase(F.lds, F.tid, RET_V / 2, S, E); }
        else if (PHT(10) && type == 10) { PHASE_BEGIN; phase_s5_scan<false>(F, p); }
        else if (PHT(11) && type == 11) { PHASE_BEGIN; phase_s5_carry(F, p); }
        else if (PHT(12) && type == 12) { PHASE_BEGIN; phase_s5_scan<true>(F, p); }
        else if (PHT(13) && type == 13) { PHASE_BEGIN; DenseSched8 S; S.init(ws + WS_AUX, ws + WS_GLU_T, T, 2 * D, D / 2, F.G, bx); EpiGluResid E{(const bf16*)(ws + WS_XB), (bf16*)(ws + WS_Y), 1.0f / (A_SCALE * WUP_SCALE)};
            pg8::gemm_phase(F.lds, F.tid, D / 2, S, E); }
        else if (PHT(14) && type == 14) { PHASE_BEGIN; phase_lnr(F, p, layer, PROBE_DRY14 && true); if (PROBE_DRY14) { if (use_bar) xcd_barrier(bar); phase_lnr(F, p, layer, false); } }
        else if (PHT(15) && type == 15) { PHASE_BEGIN; moe_plan(F, layer);
            MoeSched2<true> S; S.tstart = (const volatile LAS int*)(F.MISC + PLAN_OFF); S.cnts = S.tstart + 72; S.ntiles = __builtin_amdgcn_readfirstlane((int)S.tstart[65]); S.G = F.G; S.c = bx; S.lane = F.lane;
            S.Abase = (const char*)(ws + WS_X); S.Wbase = (const char*)(ws + WS_WMOE); S.lists = (const int*)(ws + WS_LIST);
            EpiMoeUp E{(unsigned char*)(ws + WS_H)};
            pg8::gemm_phase(F.lds, F.tid, D / 2, S, E); }
        else if (PHT(16) && type == 16) { PHASE_BEGIN; moe_plan(F, layer);
            { MoeSched2<false> S; S.tstart = (const volatile LAS int*)(F.MISC + PLAN_OFF); S.cnts = S.tstart + 72; S.ntiles = __builtin_amdgcn_readfirstlane((int)S.tstart[64]); S.G = F.G; S.c = bx; S.lane = F.lane;
              S.Abase = (const char*)(ws + WS_H); S.Wbase = (const char*)(ws + WS_WMOE); S.lists = (const int*)(ws + WS_LIST);
              EpiStoreFp8 E{(unsigned char*)(ws + WS_BIG), D};
              pg8::gemm_phase(F.lds, F.tid, ED / 2, S, E); }
            { const int sh0 = __builtin_amdgcn_readfirstlane((int)((const volatile LAS int*)(F.MISC + PLAN_OFF))[64]);
              DenseSched8 S; S.init(ws + WS_H + (size_t)sh0 * 256 * ED, ws + WS_WMOE + (size_t)64 * WMOE_E_BYTES + (size_t)512 * 1024 * 2, T, D, ED / 2, F.G, bx); EpiResid8 E{(const bf16*)(ws + WS_XB), (bf16*)(ws + WS_Y), 1.0f / (H_SCALE * WUP_SCALE)};
              int tid2; { unsigned o2 = ~0u; asm volatile("" : "+s"(o2)); tid2 = F.wave * 64 + (int)__builtin_amdgcn_mbcnt_hi(o2, __builtin_amdgcn_mbcnt_lo(o2, 0u)); }
              pg8::gemm_phase(F.lds, tid2, ED / 2, S, E); } }
        else if (PHT(17) && type == 17) { PHASE_BEGIN; moe_plan(F, layer); if (PROBE_DRY17) { phase_combine(F, p, layer, true); if (use_bar) xcd_barrier(bar); } phase_combine(F, p, layer); if (layer + 1 < DEPTH) phase_conv_moe(F, p, layer + 1); }
        }
        if (use_bar && ph + 1 < hi) xcd_barrier(bar);
    }
}

#ifndef MK_PER_PHASE
#define MK_PER_PHASE 0
#endif
extern "C" void kernel_launch(void* const* d_in, const int* in_sizes, int n_in, void* d_out, int out_size, void* d_ws, size_t ws_size, hipStream_t stream) {
    static int grid = 0;
    if (grid == 0) {
        if (n_in != 26 || in_sizes[0] != T * D || out_size != T * D || ws_size < WS_END) { fprintf(stderr, "kernel_launch: unexpected shapes / workspace (n_in %d, in0 %d, out %d, ws %zu < %zu)\n", n_in, n_in > 0 ? in_sizes[0] : -1, out_size, ws_size, (size_t)WS_END); grid = -1; return; }
        int dev = 0, cus = 0, per_cu = 0;
        if (hipGetDevice(&dev) != hipSuccess || hipDeviceGetAttribute(&cus, hipDeviceAttributeMultiprocessorCount, dev) != hipSuccess) { grid = -1; return; }
        if (hipFuncSetAttribute((const void*)fwd_kernel, hipFuncAttributeMaxDynamicSharedMemorySize, LDS_BYTES) != hipSuccess) { fprintf(stderr, "kernel_launch: hipFuncSetAttribute failed\n"); grid = -1; return; }
        if (hipOccupancyMaxActiveBlocksPerMultiprocessor(&per_cu, (const void*)fwd_kernel, NTHREADS, LDS_BYTES) != hipSuccess || per_cu < 1) { fprintf(stderr, "kernel_launch: occupancy query says %d blocks per CU\n", per_cu); per_cu = 1; }
        (void)hipGetLastError();
        grid = cus;
    }
    if (grid < 0) return;
    (void)hipMemsetAsync((char*)d_ws + WS_CTL, 0, CTL_ZERO_BYTES, stream);
    Params p{};
    for (int i = 0; i < 26; ++i) p.in[i] = (const float*)d_in[i];
    p.out = (float*)d_out; p.ws = (unsigned char*)d_ws;
#if MK_PER_PHASE
    for (int k = 0; k < NPHASES; ++k) { p.ph_lo = k; p.ph_hi = k + 1; p.use_bar = 0; hipLaunchKernelGGL(fwd_kernel, dim3(grid), dim3(NTHREADS), LDS_BYTES, stream, p); }
#else
    p.ph_lo = 0; p.ph_hi = NPHASES; p.use_bar = 1;
    hipLaunchKernelGGL(fwd_kernel, dim3(grid), dim3(NTHREADS), LDS_BYTES, stream, p);
#endif
}
```

```cpp
#include <hip/hip_runtime.h>
#include <cstdio>
#include <cstdint>

#define LAS __attribute__((address_space(3)))
#define GAS __attribute__((address_space(1)))
typedef unsigned short bf16;
typedef short bf16x8 __attribute__((ext_vector_type(8)));
typedef short bf16x4 __attribute__((ext_vector_type(4)));
typedef float f32x4 __attribute__((ext_vector_type(4)));
typedef float f32x2 __attribute__((ext_vector_type(2)));
typedef unsigned u32x4 __attribute__((ext_vector_type(4)));
typedef unsigned u32x2 __attribute__((ext_vector_type(2)));
typedef GAS unsigned gu32;

constexpr int D = 1024, BATCH = 2, SEQ = 8192, T = BATCH * SEQ, DEPTH = 4;
constexpr int AH = 8, AHD = 128, ATT_IN = 9216;
constexpr int RH = 4, RDK = 256, RDV = 512, RET_IN = 6144, RET_V = 2048, RC = 128, RNC = SEQ / RC;
constexpr int SG = 64, SGC = 16, SP = 64;
constexpr int NE = 64, TOPK = 8, NEG = 8, ED = 256, NSLOT = 9;
constexpr float LN_EPS = 1e-5f;
constexpr float ALPHA = 1.6817928305074292f;
constexpr int NWAVES = 8, NTHREADS = 512;

__device__ __forceinline__ unsigned f2bf(float f) { unsigned u = __builtin_bit_cast(unsigned, f); return (u + 0x7fffu + ((u >> 16) & 1u)) >> 16; }
__device__ __forceinline__ unsigned pk2(float lo, float hi) { unsigned r; asm("s_nop 1\n\tv_cvt_pk_bf16_f32 %0, %1, %2" : "=v"(r) : "v"(lo), "v"(hi)); return r; }
__device__ __forceinline__ unsigned pk2sw(float lo, float hi) { return f2bf(lo) | (f2bf(hi) << 16); }
__device__ __forceinline__ unsigned pk2hw(float lo, float hi) { unsigned r; asm volatile("v_cvt_pk_bf16_f32 %0, %1, %2" : "=v"(r) : "v"(lo), "v"(hi)); return r; }
__device__ __forceinline__ float bf2f(unsigned b) { return __builtin_bit_cast(float, b << 16); }
__device__ __forceinline__ float bflo(unsigned w) { return __builtin_bit_cast(float, w << 16); }
__device__ __forceinline__ float bfhi(unsigned w) { return __builtin_bit_cast(float, w & 0xffff0000u); }
__device__ __forceinline__ float shx(float v, int m, int lane) { return __builtin_bit_cast(float, __builtin_amdgcn_ds_bpermute((lane ^ m) << 2, __builtin_bit_cast(int, v))); }
__device__ __forceinline__ int shx_i(int v, int m, int lane) { return __builtin_amdgcn_ds_bpermute((lane ^ m) << 2, v); }
__device__ __forceinline__ float rdl(float v, int src) { return __builtin_bit_cast(float, __builtin_amdgcn_readlane(__builtin_bit_cast(int, v), src)); }
template <int CTRL, int RM = 0xf, int BM = 0xf> __device__ __forceinline__ float dpp0(float v) { return __builtin_bit_cast(float, __builtin_amdgcn_update_dpp(0, __builtin_bit_cast(int, v), CTRL, RM, BM, true)); }
template <int CTRL, int RM = 0xf, int BM = 0xf> __device__ __forceinline__ float dppo(float old, float v) { return __builtin_bit_cast(float, __builtin_amdgcn_update_dpp(__builtin_bit_cast(int, old), __builtin_bit_cast(int, v), CTRL, RM, BM, false)); }
__device__ __forceinline__ float wave_sum(float v, int lane) {
    (void)lane;
    v += dpp0<0x111>(v); v += dpp0<0x112>(v); v += dpp0<0x114>(v); v += dpp0<0x118>(v);
    v += dpp0<0x142, 0xa>(v);
    v += dpp0<0x143, 0xc>(v);
    return rdl(v, 63);
}
__device__ __forceinline__ unsigned wave_umax(unsigned v) {
#define WU_DPP(ctrl, rm) (unsigned)__builtin_amdgcn_update_dpp(0, (int)v, ctrl, rm, 0xf, true)
    { const unsigned t = WU_DPP(0x111, 0xf); v = v > t ? v : t; } { const unsigned t = WU_DPP(0x112, 0xf); v = v > t ? v : t; } { const unsigned t = WU_DPP(0x114, 0xf); v = v > t ? v : t; } { const unsigned t = WU_DPP(0x118, 0xf); v = v > t ? v : t; }
    { const unsigned t = WU_DPP(0x142, 0xa); v = v > t ? v : t; } { const unsigned t = WU_DPP(0x143, 0xc); v = v > t ? v : t; }
#undef WU_DPP
    return (unsigned)__builtin_amdgcn_readlane((int)v, 63);
}
__device__ __forceinline__ float max8(float v) {
    v = fmaxf(v, dppo<0xb1>(v, v)); v = fmaxf(v, dppo<0x4e>(v, v)); v = fmaxf(v, dppo<0x141>(v, v)); return v;
}
__device__ __forceinline__ float fsig(float x) { return __builtin_amdgcn_rcpf(1.0f + __expf(-x)); }
#define LDS_WAIT() asm volatile("s_waitcnt lgkmcnt(0)" ::: "memory")
#define VM_WAIT() asm volatile("s_waitcnt vmcnt(0)" ::: "memory")
__device__ __forceinline__ const char* rfl_ptr(const char* p) {
    unsigned long long v = (unsigned long long)p; unsigned lo = __builtin_amdgcn_readfirstlane((unsigned)v), hi = __builtin_amdgcn_readfirstlane((unsigned)(v >> 32));
    return (const char*)(((unsigned long long)hi << 32) | lo);
}
__device__ __forceinline__ bf16x8 row_frag(const LAS bf16* base, int ld, int row0, int col0, int lane) {
    return *(const LAS bf16x8*)(base + (row0 + (lane & 15)) * ld + col0 + 8 * (lane >> 4));
}
__device__ __forceinline__ bf16x4 tr4(const LAS bf16* addr) { return __builtin_amdgcn_ds_read_tr16_b64_v4i16((LAS bf16x4*)addr); }
__device__ __forceinline__ bf16x8 cat8(bf16x4 a, bf16x4 b) { bf16x8 r; r[0] = a[0]; r[1] = a[1]; r[2] = a[2]; r[3] = a[3]; r[4] = b[0]; r[5] = b[1]; r[6] = b[2]; r[7] = b[3]; return r; }
#define MFMA16(a, b, c) __builtin_amdgcn_mfma_f32_16x16x32_bf16((a), (b), (c), 0, 0, 0)
__device__ __forceinline__ bf16x8 pack8(f32x4 a, f32x4 b) {
    u32x4 w; w.x = pk2(a[0], a[1]); w.y = pk2(a[2], a[3]); w.z = pk2(b[0], b[1]); w.w = pk2(b[2], b[3]); return __builtin_bit_cast(bf16x8, w);
}

namespace pg8 {
typedef int v4i_t __attribute__((ext_vector_type(4)));
typedef int v8i_t __attribute__((ext_vector_type(8)));
constexpr int BM = 256, BK = 64, HALF = 128, HTB = HALF * BK * 2, STAGE_BYTES = 8 * HTB;
__device__ __forceinline__ int lds_byte(int r, int c) { const int st = (r >> 4) * 2 + (c >> 5), rr = r & 15, cc = c & 31, ob = rr * 64 + cc * 2; return st * 1024 + (ob ^ (((ob >> 9) & 1) << 5)); }
__device__ __forceinline__ void stage_rc(int b, int& R, int& C) { const int st = b / 1024, sb = b % 1024, swz = sb ^ (((sb >> 9) & 1) << 5); R = (st >> 1) * 16 + swz / 64; C = (st & 1) * 32 + (swz % 64) / 2; }
__device__ __forceinline__ int perm32(int rho) { const int n = rho >> 4, i = rho & 15; return 8 * (i >> 2) + 4 * n + (i & 3); }

struct UnitG {
    const char* A;
    const char* B;
    const int* gidx;
    int gcnt, gshift;
    int row0, col0;
    int aux;
};

__device__ __forceinline__ void uniformize(UnitG& u) { u.A = rfl_ptr(u.A); u.B = rfl_ptr(u.B); u.gidx = (const int*)rfl_ptr((const char*)u.gidx); u.gcnt = __builtin_amdgcn_readfirstlane(u.gcnt); u.gshift = __builtin_amdgcn_readfirstlane(u.gshift);
    u.row0 = __builtin_amdgcn_readfirstlane(u.row0); u.col0 = __builtin_amdgcn_readfirstlane(u.col0); u.aux = __builtin_amdgcn_readfirstlane(u.aux); }
template <class Epi, class Sched>
__device__ __forceinline__ void gemm_phase(LAS unsigned char* lds, const int tid, const int K, const Sched& S, const Epi& E) {
    constexpr bool F8 = Sched::FP8;
    constexpr bool GATHER = Sched::GATHER;
    const int wid = __builtin_amdgcn_readfirstlane(tid >> 6), lane = tid & 63, wr = wid >> 2, wc = wid & 3, fr = lane & 15, fq = lane >> 4;
    int nt = K / BK; asm volatile("" : "+s"(nt));
    constexpr bool P16 = Epi::PERM16;
    unsigned voffB[2], voffB1[2], vA[2][2];
#pragma unroll
    for (int i = 0; i < 2; ++i) { int R, C; stage_rc(tid * 16 + i * 8192, R, C); const int Rb = Epi::PERM ? ((R & ~31) + perm32(R & 31)) : R; voffB[i] = (unsigned)(Rb * K + C) * 2u; voffB1[i] = voffB[i]; vA[0][i] = (unsigned)(R * K + C) * 2u; vA[1][i] = vA[0][i];
        if constexpr (P16) { const int x = R & 31, src = 64 * (R >> 5) + 16 * ((x >> 2) & 3) + 4 * (x >> 4) + (x & 3); voffB[i] = (unsigned)(src * K + C) * 2u; voffB1[i] = (unsigned)((src + 8) * K + C) * 2u; } }
    const size_t kstep = (size_t)(BK * 2);
    const size_t hstep = (size_t)HALF * K * 2;
    const size_t hstepB = P16 ? 0 : hstep;
    const size_t hstepA = GATHER ? 0 : hstep;
    const size_t hstepB1 = P16 ? (size_t)8 * K * 2 : hstep, bstep = (size_t)(P16 ? 128 : 64) * K * 2, astep = (size_t)64 * K * 2;
    unsigned vB0 = voffB[0], vA0 = vA[0][0];
    const unsigned ldsw = (unsigned)wid * 1024u;
    const int aoff = lds_byte(wr * 64 + fr, fq * 8), boff = lds_byte(wc * 32 + fr, fq * 8);
    LAS u32x4* park = (LAS u32x4*)(lds + STAGE_BYTES) + tid;
#define PG8_SA(b, h) (((b) * 2 + (h)) * HTB)
#define PG8_SB(b, h) ((4 + (b) * 2 + (h)) * HTB)
#define PG8_STAGE(bufoff, gbase, voff) do { _Pragma("unroll") for (int _i = 0; _i < 2; ++_i) { asm volatile("" : "+v"((voff)[_i]));   \
        __builtin_amdgcn_global_load_lds((const unsigned*)((const char*)(gbase) + (voff)[_i]), (LAS unsigned*)(lds + (bufoff) + ldsw + _i * 8192), 16, 0, 0); } } while (0)
#define PG8_STAGEU(bufoff, gbase, v0, step1) do { asm volatile("" : "+v"(v0)); __builtin_amdgcn_global_load_lds((const unsigned*)((const char*)(gbase) + (v0)), (LAS unsigned*)(lds + (bufoff) + ldsw), 16, 0, 0); \
        asm volatile("" : "+v"(v0)); __builtin_amdgcn_global_load_lds((const unsigned*)((const char*)(gbase) + (step1) + (v0)), (LAS unsigned*)(lds + (bufoff) + ldsw + 8192), 16, 0, 0); } while (0)
#define PG8_STB(b, h, base) PG8_STAGEU(PG8_SB(b, h), (base) + (h) * hstepB1, vB0, bstep)
#define PG8_STA(b, h, base) do { if constexpr (GATHER) PG8_STAGE(PG8_SA(b, h), (base), vA[h]); else PG8_STAGEU(PG8_SA(b, h), (base) + (h) * hstep, vA0, astep); } while (0)
    constexpr int FKS = 1024;
#define PG8_LD2(p_) __builtin_shufflevector(*(const LAS v4i_t*)(p_), *(const LAS v4i_t*)((p_) + FKS), 0, 1, 2, 3, 4, 5, 6, 7)
#define PG8_LDA(dst, b, h) do { _Pragma("unroll") for (int m = 0; m < 4; ++m) dst[m] = PG8_LD2(lds + PG8_SA(b, h) + aoff + m * 2048); } while (0)
#define PG8_LDB(dst, b, h) do { _Pragma("unroll") for (int n = 0; n < 2; ++n) dst[n] = PG8_LD2(lds + PG8_SB(b, h) + boff + n * 2048); } while (0)
#define PG8_LO(v) __builtin_bit_cast(bf16x8, __builtin_shufflevector((v), (v), 0, 1, 2, 3))
#define PG8_HI(v) __builtin_bit_cast(bf16x8, __builtin_shufflevector((v), (v), 4, 5, 6, 7))
#define PG8_MMA(ai, bj, At, Bt) do { __builtin_amdgcn_s_setprio(1); _Pragma("unroll") for (int m = 0; m < 4; ++m) _Pragma("unroll") for (int n = 0; n < 2; ++n) { \
        if constexpr (F8) { acc[ai][bj][m][n] = __builtin_amdgcn_mfma_scale_f32_16x16x128_f8f6f4(Bt[n], At[m], acc[ai][bj][m][n], 0, 0, 0, 0x7F7F7F7F, 0, 0x7F7F7F7F); } \
        else { acc[ai][bj][m][n] = __builtin_amdgcn_mfma_f32_16x16x32_bf16(PG8_LO(Bt[n]), PG8_LO(At[m]), acc[ai][bj][m][n], 0, 0, 0); \
               acc[ai][bj][m][n] = __builtin_amdgcn_mfma_f32_16x16x32_bf16(PG8_HI(Bt[n]), PG8_HI(At[m]), acc[ai][bj][m][n], 0, 0, 0); } } __builtin_amdgcn_s_setprio(0); } while (0)
#define PG8_WAIT_V(n) asm volatile("s_waitcnt vmcnt(" #n ")" ::: "memory")
#define PG8_WAIT_L(n) asm volatile("s_waitcnt lgkmcnt(" #n ")" ::: "memory")
#define PG8_BAR __builtin_amdgcn_s_barrier()
#define PG8_SCHED __builtin_amdgcn_sched_barrier(0)
#define PG8_VOFF(u, v00, v01, v10, v11) do { int _R0, _C0, _R1, _C1; stage_rc(tid * 16, _R0, _C0); stage_rc(tid * 16 + 8192, _R1, _C1); int _r00 = _R0, _r01 = _R1, _r10 = HALF + _R0, _r11 = HALF + _R1; \
        if ((u).gidx) { const GAS int* _gp = (const GAS int*)(u).gidx; const int _gc = (u).gcnt;     \
            const int _a = _gp[_r00 < _gc ? _r00 : 0] >> (u).gshift, _b = _gp[_r01 < _gc ? _r01 : 0] >> (u).gshift, _c = _gp[_r10 < _gc ? _r10 : 0] >> (u).gshift, _d = _gp[_r11 < _gc ? _r11 : 0] >> (u).gshift; \
            _r00 = _a; _r01 = _b; _r10 = _c; _r11 = _d; } \
        v00 = (unsigned)(_r00 * K + _C0) * 2u; v01 = (unsigned)(_r01 * K + _C1) * 2u; v10 = (unsigned)(_r10 * K + _C0) * 2u; v11 = (unsigned)(_r11 * K + _C1) * 2u; } while (0)
    UnitG cur, nxt; int ui = 0;
    if (!S.next(0, cur)) return;
    if constexpr (Sched::UNIFORMIZE) uniformize(cur);
    f32x4 acc[2][2][4][2];
#pragma unroll
    for (int a = 0; a < 2; ++a)
#pragma unroll
        for (int b = 0; b < 2; ++b)
#pragma unroll
            for (int m = 0; m < 4; ++m)
#pragma unroll
                for (int n = 0; n < 2; ++n) acc[a][b][m][n] = (f32x4){0.f, 0.f, 0.f, 0.f};
    v8i_t At[4], B0[2], B1[2];
    if constexpr (GATHER) PG8_VOFF(cur, vA[0][0], vA[0][1], vA[1][0], vA[1][1]);
    const char* cA = cur.A; const char* cB = cur.B;
    PG8_STB(0, 0, cB); PG8_STB(0, 1, cB); PG8_STA(0, 0, cA); PG8_STA(0, 1, cA);
    if (wr == 1) PG8_BAR;
    PG8_WAIT_V(2); PG8_BAR;
    PG8_STB(1, 0, cB + kstep); PG8_STA(1, 0, cA + kstep); PG8_STB(1, 1, cB + kstep);
    PG8_WAIT_V(6); PG8_BAR;
    for (;;) {
        const bool has_next = S.next(ui + 1, nxt);
        if constexpr (Sched::UNIFORMIZE) { if (has_next) uniformize(nxt); }
        const char* nA = cA; const char* nB = cB;
        if (has_next) { nA = nxt.A; nB = nxt.B; }
        if constexpr (GATHER) { u32x4 pv; pv.x = vA[0][0]; pv.y = vA[0][1]; pv.z = vA[1][0]; pv.w = vA[1][1];
            if (has_next) PG8_VOFF(nxt, pv.x, pv.y, pv.z, pv.w);
            *park = pv; }
#pragma unroll 1
        for (int t = 0; t < nt; t += 2) {
            const bool last = (t == nt - 2);
            const char* a1 = cA + (size_t)(t + 1) * kstep;
            const char* a2 = last ? nA : cA + (size_t)(t + 2) * kstep; const char* b2 = last ? nB : cB + (size_t)(t + 2) * kstep;
            const char* a3 = a2 + kstep; const char* b3 = b2 + kstep;
            PG8_LDB(B0, 0, 0); PG8_LDB(B1, 0, 1); PG8_SCHED; PG8_LDA(At, 0, 0); PG8_STA(1, 1, a1);
            PG8_WAIT_V(8); PG8_WAIT_L(0); PG8_BAR; PG8_MMA(0, 0, At, B0); PG8_MMA(0, 1, At, B1); PG8_BAR; PG8_SCHED;
            if constexpr (GATHER) { if (last) { const u32x4 pv = *park; vA[0][0] = pv.x; vA[0][1] = pv.y; vA[1][0] = pv.z; vA[1][1] = pv.w; } }
            PG8_LDA(At, 0, 1); PG8_STB(0, 0, b2); PG8_STB(0, 1, b2); PG8_STA(0, 0, a2);
            PG8_WAIT_V(8); PG8_WAIT_L(0); PG8_BAR; PG8_MMA(1, 0, At, B0); PG8_MMA(1, 1, At, B1); PG8_BAR; PG8_SCHED;
            PG8_LDB(B0, 1, 0); PG8_LDB(B1, 1, 1); PG8_SCHED; PG8_LDA(At, 1, 0); PG8_STA(0, 1, a2);
            PG8_WAIT_V(8); PG8_WAIT_L(0); PG8_BAR; PG8_MMA(0, 0, At, B0); PG8_MMA(0, 1, At, B1); PG8_BAR; PG8_SCHED;
            PG8_LDA(At, 1, 1); PG8_STB(1, 0, b3); PG8_STB(1, 1, b3); PG8_STA(1, 0, a3);
            PG8_WAIT_V(8); PG8_WAIT_L(0); PG8_BAR; PG8_MMA(1, 0, At, B0); PG8_MMA(1, 1, At, B1); PG8_BAR; PG8_SCHED;
        }
        if (wr == 0) PG8_BAR;
        { int l2; { unsigned o2 = ~0u; asm volatile("" : "+s"(o2)); l2 = (int)__builtin_amdgcn_mbcnt_hi(o2, __builtin_amdgcn_mbcnt_lo(o2, 0u)); }
          E(acc, cur, wr, wc, l2 & 15, l2 >> 4); }
        if (!has_next) break;
#pragma unroll
        for (int a = 0; a < 2; ++a)
#pragma unroll
            for (int b = 0; b < 2; ++b)
#pragma unroll
                for (int m = 0; m < 4; ++m)
#pragma unroll
                    for (int n = 0; n < 2; ++n) acc[a][b][m][n] = (f32x4){0.f, 0.f, 0.f, 0.f};
        cur = nxt; cA = nA; cB = nB; ++ui;
        if (wr == 1) PG8_BAR;
    }
    PG8_WAIT_V(0);
    PG8_BAR;
#undef PG8_SA
#undef PG8_SB
#undef PG8_STAGE
#undef PG8_STAGEU
#undef PG8_STB
#undef PG8_STA
#undef PG8_LDA
#undef PG8_LDB
#undef PG8_LD2
#undef PG8_LO
#undef PG8_HI
#undef PG8_MMA
#undef PG8_WAIT_V
#undef PG8_WAIT_L
#undef PG8_BAR
#undef PG8_SCHED
#undef PG8_VOFF
}
}

constexpr size_t MiB = 1u << 20;
constexpr size_t WS_CTL = 0, CTL_ZERO_BYTES = 1 * MiB;
constexpr size_t WS_ATT_IN_T = 1 * MiB;
constexpr size_t WS_ATT_OUT_T = WS_ATT_IN_T + 36 * MiB;
constexpr size_t WS_RET_IN_T = WS_ATT_OUT_T + 4 * MiB;
constexpr size_t WS_RET_OUT_T = WS_RET_IN_T + 12 * MiB;
constexpr size_t WS_GLU_T = WS_RET_OUT_T + 4 * MiB;
constexpr size_t WS_RT_HI = WS_GLU_T + 4 * MiB;
constexpr size_t WS_RT_LO = WS_RT_HI + 512 * 1024;
constexpr size_t WS_WMOE = WS_RT_HI + 1 * MiB;
constexpr size_t WMOE_E_BYTES = (size_t)(512 * 1024 + 1024 * 256) * 2;
constexpr size_t WS_X = WS_WMOE + 98 * MiB;
constexpr size_t WS_Y = WS_X + 64 * MiB;
constexpr size_t WS_XB = WS_Y + 64 * MiB;
constexpr size_t WS_BIG = WS_XB + 32 * MiB;
constexpr size_t WS_AUX = WS_BIG + 288 * MiB;
constexpr size_t WS_H = WS_AUX + 160 * MiB;
constexpr size_t WS_LIST = WS_H + 80 * MiB;
constexpr size_t WS_TRASH = WS_LIST + 8 * MiB;
constexpr size_t WS_END = WS_TRASH + 1 * MiB;
static_assert(WS_END <= 1024 * MiB, "workspace map");
constexpr int CW_BAR = 4096;
constexpr int CW_CNT = 16384;
constexpr int CW_CHK = 65536;
constexpr int HROWS = 163840;

#define XB_TMO      128
#define XB_XCNT(j)  (256  + 64 * (j))
#define XB_XSUB(j)  (1280 + 64 * (j))
#define XB_XGEN(j)  (2304 + 64 * (j))
#define XB_TOP      3328
#define XB_TOPGEN   3392
#define XCD_BAR_WORDS 3456
#define XB_SPIN_CAP (1u << 20)
__device__ __forceinline__ unsigned xb_ld(unsigned* p)              { return __hip_atomic_load(p, __ATOMIC_RELAXED, __HIP_MEMORY_SCOPE_AGENT); }
__device__ __forceinline__ unsigned xb_add(unsigned* p, unsigned v) { return __hip_atomic_fetch_add(p, v, __ATOMIC_RELAXED, __HIP_MEMORY_SCOPE_AGENT); }
__device__ __forceinline__ unsigned xb_xcc_id() { return (unsigned)__builtin_amdgcn_s_getreg((3 << 11) | 20) & 0xFu; }
#define XB_SPIN(cond, bar) do { unsigned _sp = 0; while (cond) { __builtin_amdgcn_s_sleep(1); \
    if ((++_sp & 255u) == 0u) { if (xb_ld(&(bar)[XB_TMO])) break; if (_sp > XB_SPIN_CAP) { atomicAdd(&(bar)[XB_TMO], 1u); break; } } } } while (0)
struct XcdBarrier { unsigned* bar; unsigned x; volatile LAS unsigned* st; };
__device__ __forceinline__ XcdBarrier xcd_barrier_post(unsigned* bar, volatile LAS unsigned* st) {
    XcdBarrier b; b.bar = bar; b.x = xb_xcc_id(); b.st = st;
    if (threadIdx.x == 0) (void)xb_add(&bar[XB_XCNT(b.x)], 1u);
    return b;
}
__device__ __forceinline__ void xcd_barrier_complete(unsigned* bar, unsigned x, unsigned& nloc, unsigned& nx) {
    const unsigned G = gridDim.x * gridDim.y * gridDim.z;
    unsigned sum, cnt, mine, sp = 0u;
    for (;;) {
        sum = 0u; cnt = 0u; mine = 0u;
#pragma unroll
        for (unsigned j = 0; j < 16; ++j) { const unsigned c = xb_ld(&bar[XB_XCNT(j)]); sum += c; cnt += (c > 0u) ? 1u : 0u; mine = (j == x) ? c : mine; }
        if (sum == G) break;
        __builtin_amdgcn_s_sleep(1);
        if ((++sp & 255u) == 0u) { if (xb_ld(&bar[XB_TMO])) break; if (sp > XB_SPIN_CAP) { atomicAdd(&bar[XB_TMO], 1u); break; } }
    }
    nloc = mine > 0u ? mine : 1u; nx = cnt > 0u ? cnt : 1u;
}
__device__ __forceinline__ void xcd_barrier(const XcdBarrier& b) {
    asm volatile("s_waitcnt vmcnt(0)" ::: "memory");
    __syncthreads();
    if (threadIdx.x == 0) {
        unsigned* bar = b.bar;
        __builtin_amdgcn_s_waitcnt(0);
        unsigned nloc = b.st[0], nx = b.st[1];
        if (nloc == 0u) { xcd_barrier_complete(bar, b.x, nloc, nx); b.st[0] = nloc; b.st[1] = nx; }
        const unsigned old = xb_add(&bar[XB_XSUB(b.x)], 1u);
        const unsigned gen = old / nloc;
        if (old + 1u == (gen + 1u) * nloc) {
            __builtin_amdgcn_fence(__ATOMIC_RELEASE, "agent");
            asm volatile("s_waitcnt vmcnt(0)" ::: "memory");
            const unsigned og = xb_add(&bar[XB_TOP], 1u);
            const unsigned tg = og / nx;
            if (og + 1u == (tg + 1u) * nx) xb_add(&bar[XB_TOPGEN], 1u);
            else XB_SPIN(xb_ld(&bar[XB_TOPGEN]) == tg, bar);
            __builtin_amdgcn_fence(__ATOMIC_ACQUIRE, "agent");
            xb_add(&bar[XB_XGEN(b.x)], 1u);
            asm volatile("s_waitcnt vmcnt(0)" ::: "memory");
        } else {
            XB_SPIN(xb_ld(&bar[XB_XGEN(b.x)]) == gen, bar);
            __builtin_amdgcn_fence(__ATOMIC_ACQUIRE, "agent");
            asm volatile("s_waitcnt vmcnt(0)" ::: "memory");
        }
    }
    __syncthreads();
}

constexpr int RING_BYTES = 139264;
constexpr int MISC_OFF = RING_BYTES;
constexpr int LDS_BYTES = 147456;
struct Params {
    const float* in[26]; float* out; unsigned char* ws; int ph_lo, ph_hi; int use_bar, pad;
};
typedef const __attribute__((address_space(4))) Params* KP;
__device__ __forceinline__ const float* gin(KP p, int i) { return (const float*)(const GAS float*)p->in[i]; }
__device__ __forceinline__ float* gout(KP p) { return (float*)(GAS float*)p->out; }
struct Frame {
    LAS unsigned char* lds; volatile LAS unsigned* MISC;
    int tid, lane, wave, vcu, G;
    unsigned char* ws;
};

template <bool F8_ = false> struct DenseSchedT {
    static constexpr bool GATHER = false, UNIFORMIZE = false, FP8 = F8_;
    const char* A; const char* Bt; int K, nM, nN, nwg, G, c;
    __device__ __forceinline__ void init(const void* A_, const void* Bt_, int M, int N, int K_, int G_, int c_) { A = (const char*)A_; Bt = (const char*)Bt_; K = K_; nM = M / 256; nN = N / 256; nwg = nM * nN; G = G_; c = c_; }
    __device__ __forceinline__ bool next(int i, pg8::UnitG& u) const {
        const long L = (long)i * G + c; if (L >= nwg) return false;
        int wgid = (int)L; { const int q = nwg / 8, r = nwg % 8, xcd = wgid % 8, off = wgid / 8; wgid = (xcd < r ? xcd * (q + 1) : r * (q + 1) + (xcd - r) * q) + off; }
        const int nig = 8 * nN, gid = wgid / nig, fm = gid * 8, gsz = (nM - fm) < 8 ? (nM - fm) : 8;
        const int pm = fm + ((wgid % nig) % gsz), pn = (wgid % nig) / gsz;
        u.A = A + (size_t)pm * 256 * K * 2; u.B = Bt + (size_t)pn * 256 * K * 2; u.gidx = nullptr; u.gcnt = 0; u.gshift = 0; u.row0 = pm * 256; u.col0 = pn * 256; u.aux = 0; return true;
    }
};
typedef DenseSchedT<false> DenseSched; typedef DenseSchedT<true> DenseSched8;
__device__ __forceinline__ u32x4 pack_bf16x8(const f32x4& v0, const f32x4& v1) { u32x4 w; w.x = pk2hw(v0[0], v0[1]); w.y = pk2hw(v0[2], v0[3]); w.z = pk2hw(v1[0], v1[1]); w.w = pk2hw(v1[2], v1[3]); return w; }

__device__ __forceinline__ unsigned pk4_fp8(float a, float b, float c, float d) {
    a = fminf(fmaxf(a, -448.0f), 448.0f); b = fminf(fmaxf(b, -448.0f), 448.0f); c = fminf(fmaxf(c, -448.0f), 448.0f); d = fminf(fmaxf(d, -448.0f), 448.0f);
    int w = 0; w = __builtin_amdgcn_cvt_pk_fp8_f32(a, b, w, false); w = __builtin_amdgcn_cvt_pk_fp8_f32(c, d, w, true); return (unsigned)w; }
constexpr float WUP_SCALE = 32.0f, WUP_INV = 1.0f / 32.0f;
struct EpiStoreBf16 {
    static constexpr bool PERM = true, PERM16 = false;
    bf16* O; int ldc; float osc, qsc;
    __device__ __forceinline__ void operator()(const f32x4 (&acc)[2][2][4][2], const pg8::UnitG& u, int wr, int wc, int fr, int fq) const {
        const float sc = ((u.col0 % 3072) < 1024) ? osc * qsc : osc;
#pragma unroll
        for (int ai = 0; ai < 2; ++ai)
#pragma unroll
            for (int m = 0; m < 4; ++m) { bf16* rowp = O + (size_t)(u.row0 + ai * 128 + wr * 64 + m * 16 + fr) * ldc + u.col0 + wc * 32 + 8 * fq;
#pragma unroll
                for (int bj = 0; bj < 2; ++bj) *(u32x4*)(rowp + bj * 128) = pack_bf16x8(acc[ai][bj][m][0] * sc, acc[ai][bj][m][1] * sc); }
    }
};
constexpr float YEXP_SCALE = 32.0f, YEXP_INV = 1.0f / 32.0f;
constexpr float A_SCALE = 16.0f;
constexpr float H_SCALE = 16.0f;
constexpr float OG_SCALE = 16.0f;
constexpr float Q8_SCALE = 64.0f, KV8_SCALE = 16.0f;
struct EpiStoreQkv8 {
    static constexpr bool PERM = false, PERM16 = true;
    unsigned char* O; int ldc;
    __device__ __forceinline__ void operator()(const f32x4 (&acc)[2][2][4][2], const pg8::UnitG& u, int wr, int wc, int fr, int fq) const {
        const float sc = ((u.col0 % 3072) < 1024) ? WUP_INV * 0.08838834764831845f * Q8_SCALE : WUP_INV * KV8_SCALE;
#pragma unroll
        for (int ai = 0; ai < 2; ++ai)
#pragma unroll
            for (int m = 0; m < 4; ++m) { unsigned char* rowp = O + (size_t)(u.row0 + ai * 128 + wr * 64 + m * 16 + fr) * ldc + u.col0 + wc * 64 + 16 * fq;
                u32x4 w;
#pragma unroll
                for (int q = 0; q < 4; ++q) { const f32x4 v = acc[ai][q >> 1][m][q & 1] * sc; w[q] = pk4_fp8(v[0], v[1], v[2], v[3]); }
                *(u32x4*)rowp = w; }
    }
};
struct EpiStoreFp8 {
    static constexpr bool PERM = false, PERM16 = true;
    unsigned char* O; int ldc;
    __device__ __forceinline__ void operator()(const f32x4 (&acc)[2][2][4][2], const pg8::UnitG& u, int wr, int wc, int fr, int fq) const {
#pragma unroll
        for (int ai = 0; ai < 2; ++ai)
#pragma unroll
            for (int m = 0; m < 4; ++m) { unsigned char* rowp = O + (size_t)(u.row0 + ai * 128 + wr * 64 + m * 16 + fr) * ldc + u.col0 + wc * 64 + 16 * fq;
                u32x4 w;
#pragma unroll
                for (int q = 0; q < 4; ++q) { f32x4 v = acc[ai][q >> 1][m][q & 1] * (YEXP_SCALE / (H_SCALE * WUP_SCALE));
#pragma unroll
                    for (int j = 0; j < 4; ++j) v[j] = fminf(fmaxf(v[j], -448.0f), 448.0f);
                    int d = 0; d = __builtin_amdgcn_cvt_pk_fp8_f32(v[0], v[1], d, false); d = __builtin_amdgcn_cvt_pk_fp8_f32(v[2], v[3], d, true); w[q] = (unsigned)d; }
                *(u32x4*)rowp = w; }
    }
};
constexpr float RS_SCALE = 4.0f;
constexpr float RQ_SCALE = 16.0f, RK_SCALE = 8.0f, RV_SCALE = 16.0f;
struct EpiRetIn {
    static constexpr bool PERM = false, PERM16 = true;
    unsigned char* O; int ldc;
    __device__ __forceinline__ void operator()(const f32x4 (&acc)[2][2][4][2], const pg8::UnitG& u, int wr, int wc, int fr, int fq) const {
        float l2g = 0.f;
        float cs = WUP_INV * RV_SCALE;
        if (u.col0 < 2048) { const int h = (u.col0 & 1023) >> 8; const float g = 1.0f - exp2f(-5.0f - (float)h); l2g = log2f(g); cs = WUP_INV * RQ_SCALE; if (u.col0 >= 1024) { l2g = -l2g; cs = WUP_INV * 0.0625f * RK_SCALE; } }
#pragma unroll
        for (int ai = 0; ai < 2; ++ai)
#pragma unroll
            for (int m = 0; m < 4; ++m) { const int row = u.row0 + ai * 128 + wr * 64 + m * 16 + fr; const float sc = exp2f(l2g * (float)(row & 127)) * cs;
                unsigned char* rowp = O + (size_t)row * ldc + u.col0 + wc * 64 + 16 * fq; u32x4 w;
#pragma unroll
                for (int q = 0; q < 4; ++q) { const f32x4 v = acc[ai][q >> 1][m][q & 1] * sc; w[q] = pk4_fp8(v[0], v[1], v[2], v[3]); }
                *(u32x4*)rowp = w; }
    }
};
__device__ __forceinline__ u32x4 cvt8_bf16(unsigned lo, unsigned hi) {
    const f32x2 a = __builtin_amdgcn_cvt_pk_f32_fp8((int)lo, false), b = __builtin_amdgcn_cvt_pk_f32_fp8((int)lo, true), c = __builtin_amdgcn_cvt_pk_f32_fp8((int)hi, false), d = __builtin_amdgcn_cvt_pk_f32_fp8((int)hi, true);
    u32x4 r; r.x = pk2(a[0], a[1]); r.y = pk2(b[0], b[1]); r.z = pk2(c[0], c[1]); r.w = pk2(d[0], d[1]); return r; }
__device__ __forceinline__ void unpack_bf16x8(const u32x4& w, f32x4& a, f32x4& b) { a[0] = bflo(w.x); a[1] = bfhi(w.x); a[2] = bflo(w.y); a[3] = bfhi(w.y); b[0] = bflo(w.z); b[1] = bfhi(w.z); b[2] = bflo(w.w); b[3] = bfhi(w.w); }
template <bool ALL16> struct EpiResidT {
    static constexpr bool PERM = true, PERM16 = false;
    const bf16* X; bf16* Y; float asc;
    __device__ __forceinline__ void operator()(const f32x4 (&acc)[2][2][4][2], const pg8::UnitG& u, int wr, int wc, int fr, int fq) const {
        constexpr int NB = ALL16 ? 1 : 2, PER = 2 / NB;
#pragma unroll
        for (int bt = 0; bt < NB; ++bt) {
            u32x4 xw[PER][4][2];
#pragma unroll
            for (int a2 = 0; a2 < PER; ++a2)
#pragma unroll
                for (int m = 0; m < 4; ++m) { const int ai = bt * PER + a2; const size_t off = (size_t)(u.row0 + ai * 128 + wr * 64 + m * 16 + fr) * D + u.col0 + wc * 32 + 8 * fq;
#pragma unroll
                    for (int bj = 0; bj < 2; ++bj) xw[a2][m][bj] = *(const u32x4*)(X + off + bj * 128); }
            asm volatile("" ::: "memory");
#pragma unroll
            for (int a2 = 0; a2 < PER; ++a2)
#pragma unroll
                for (int m = 0; m < 4; ++m) { const int ai = bt * PER + a2; const size_t off = (size_t)(u.row0 + ai * 128 + wr * 64 + m * 16 + fr) * D + u.col0 + wc * 32 + 8 * fq;
#pragma unroll
                    for (int bj = 0; bj < 2; ++bj) { f32x4 x0, x1; unpack_bf16x8(xw[a2][m][bj], x0, x1);
                        *(u32x4*)(Y + off + bj * 128) = pack_bf16x8(x0 * ALPHA + acc[ai][bj][m][0] * asc, x1 * ALPHA + acc[ai][bj][m][1] * asc); } }
            asm volatile("" ::: "memory");
        }
    }
};
typedef EpiResidT<true> EpiResid; typedef EpiResidT<false> EpiResid8;
struct EpiGluResid {
    static constexpr bool PERM = true, PERM16 = false;
    const bf16* X; bf16* Y; float asc;
    __device__ __forceinline__ void operator()(const f32x4 (&acc)[2][2][4][2], const pg8::UnitG& u, int wr, int wc, int fr, int fq) const {
        u32x4 xw[2][4];
#pragma unroll
        for (int ai = 0; ai < 2; ++ai)
#pragma unroll
            for (int m = 0; m < 4; ++m) { const size_t off = (size_t)(u.row0 + ai * 128 + wr * 64 + m * 16 + fr) * D + (u.col0 >> 1) + wc * 32 + 8 * fq; xw[ai][m] = *(const u32x4*)(X + off); }
        asm volatile("" ::: "memory");
#pragma unroll
        for (int ai = 0; ai < 2; ++ai)
#pragma unroll
            for (int m = 0; m < 4; ++m) { const size_t off = (size_t)(u.row0 + ai * 128 + wr * 64 + m * 16 + fr) * D + (u.col0 >> 1) + wc * 32 + 8 * fq;
                f32x4 x0, x1; unpack_bf16x8(xw[ai][m], x0, x1); f32x4 o0, o1;
#pragma unroll
                for (int j = 0; j < 4; ++j) { o0[j] = x0[j] * ALPHA + acc[ai][0][m][0][j] * asc * fsig(acc[ai][1][m][0][j] * asc); o1[j] = x1[j] * ALPHA + acc[ai][0][m][1][j] * asc * fsig(acc[ai][1][m][1][j] * asc); }
                *(u32x4*)(Y + off) = pack_bf16x8(o0, o1); }
    }
};
struct EpiMoeUp {
    static constexpr bool PERM = true, PERM16 = false;
    unsigned char* H;
    __device__ __forceinline__ void operator()(const f32x4 (&acc)[2][2][4][2], const pg8::UnitG& u, int wr, int wc, int fr, int fq) const {
        typedef unsigned u2_t __attribute__((ext_vector_type(2)));
#pragma unroll
        for (int ai = 0; ai < 2; ++ai) {
            u32x2 w8[4];
#pragma unroll
            for (int m = 0; m < 4; ++m) { f32x4 o[2];
#pragma unroll
                for (int n = 0; n < 2; ++n)
#pragma unroll
                    for (int j = 0; j < 4; ++j) { const float ga = acc[ai][0][m][n][j], ua = acc[ai][1][m][n][j];
                        o[n][j] = (ga * ua) * (WUP_INV * WUP_INV * H_SCALE) * __builtin_amdgcn_rcpf(1.0f + __builtin_amdgcn_exp2f(ga * (-WUP_INV * 1.4426950408889634f))); }
                w8[m].x = pk4_fp8(o[0][0], o[0][1], o[0][2], o[0][3]); w8[m].y = pk4_fp8(o[1][0], o[1][1], o[1][2], o[1][3]); }
            u32x4 s0, s1;
            { const u2_t a = __builtin_amdgcn_permlane16_swap(w8[0].x, w8[2].x, false, false), b = __builtin_amdgcn_permlane16_swap(w8[0].y, w8[2].y, false, false);
              s0.x = a.x; s0.y = b.x; s0.z = a.y; s0.w = b.y; }
            { const u2_t a = __builtin_amdgcn_permlane16_swap(w8[1].x, w8[3].x, false, false), b = __builtin_amdgcn_permlane16_swap(w8[1].y, w8[3].y, false, false);
              s1.x = a.x; s1.y = b.x; s1.z = a.y; s1.w = b.y; }
            const int mb = (fq & 1) ? 2 : 0;
            unsigned char* rowp = H + (size_t)(u.row0 + ai * 128 + wr * 64 + mb * 16 + fr) * ED + u.col0 + wc * 32 + 8 * (fq & 2);
            *(u32x4*)rowp = s0; *(u32x4*)(rowp + (size_t)16 * ED) = s1; }
    }
};

struct ConvD { const float* src; unsigned char* dst; unsigned char* dst2; int ldw, ldk, kind; };
__device__ __forceinline__ ConvD conv_mk8(const float* W, int ldw, unsigned char* WT, int ldk, int k0, int n0, int drow0) {
    ConvD d; d.src = W + (size_t)k0 * ldw + n0; d.dst = WT + (size_t)drow0 * ldk + k0; d.dst2 = nullptr; d.ldw = ldw; d.ldk = ldk; d.kind = 1; return d; }
__device__ __forceinline__ ConvD conv_mk16(const float* W, int ldw, bf16* WT, bf16* WTlo, int ldk, int k0, int n0, int drow0) {
    ConvD d; d.src = W + (size_t)k0 * ldw + n0; d.dst = (unsigned char*)(WT + (size_t)drow0 * ldk + k0); d.dst2 = WTlo ? (unsigned char*)(WTlo + (size_t)drow0 * ldk + k0) : nullptr; d.ldw = ldw; d.ldk = ldk * 2; d.kind = WTlo ? 2 : 0; return d; }
__device__ __forceinline__ void conv_load(const ConvD& d, int lane, f32x4 (&r)[8]) {
#pragma unroll
    for (int i = 0; i < 8; ++i) { const int kk = 8 * i + (lane >> 3), c4 = 4 * (lane & 7); r[i] = *(const f32x4*)(d.src + (size_t)kk * d.ldw + c4); }
}
template <bool HILO>
__device__ __forceinline__ void conv_finish(const ConvD& d, int lane, const f32x4 (&r)[8], LAS float* scr) {
    const float scale = (d.kind == 1) ? WUP_SCALE : 1.0f;
#pragma unroll
    for (int i = 0; i < 8; ++i) { const int kk = 8 * i + (lane >> 3), c4 = 4 * (lane & 7);
        scr[kk * 33 + c4] = r[i][0] * scale; scr[kk * 33 + c4 + 1] = r[i][1] * scale; scr[kk * 33 + c4 + 2] = r[i][2] * scale; scr[kk * 33 + c4 + 3] = r[i][3] * scale; }
    LDS_WAIT(); asm volatile("" ::: "memory");
    const int c = lane & 7;
#pragma unroll
    for (int j = 0; j < 4; ++j) { const int n = (lane >> 3) + 8 * j; const LAS float* s = scr + (8 * c) * 33 + n;
        float v[8];
#pragma unroll
        for (int q = 0; q < 8; ++q) v[q] = s[q * 33];
        if (d.kind == 1) { u32x2 o; o.x = pk4_fp8(v[0], v[1], v[2], v[3]); o.y = pk4_fp8(v[4], v[5], v[6], v[7]); *(u32x2*)(d.dst + (size_t)n * d.ldk + 8 * c) = o; }
        else { u32x4 o; o.x = pk2(v[0], v[1]); o.y = pk2(v[2], v[3]); o.z = pk2(v[4], v[5]); o.w = pk2(v[6], v[7]);
            *(u32x4*)(d.dst + (size_t)n * d.ldk + 16 * c) = o;
            if (HILO) { float rr[8];
#pragma unroll
                for (int q = 0; q < 8; ++q) rr[q] = v[q] - bf2f(f2bf(v[q]));
                u32x4 o2; o2.x = pk2(rr[0], rr[1]); o2.y = pk2(rr[2], rr[3]); o2.z = pk2(rr[4], rr[5]); o2.w = pk2(rr[6], rr[7]);
                *(u32x4*)(d.dst2 + (size_t)n * d.ldk + 16 * c) = o2; } } }
    LDS_WAIT(); asm volatile("" ::: "memory");
}
__device__ __forceinline__ void conv_dma(const ConvD& d, int lane, LAS float* buf) {
#pragma unroll
    for (int i = 0; i < 8; ++i) { const float* g = d.src + (size_t)(8 * i + (lane >> 3)) * d.ldw + 4 * ((lane & 7) ^ i);
        __builtin_amdgcn_global_load_lds((const unsigned*)g, (LAS unsigned*)(buf + i * 256), 16, 0, 0); }
}
__device__ __forceinline__ void conv_finish_lds(const ConvD& d, int lane, const LAS float* buf) {
    const float scale = (d.kind == 1) ? WUP_SCALE : 1.0f;
    const int c = lane & 7;
#pragma unroll
    for (int j = 0; j < 4; ++j) { const int n = (lane >> 3) + 8 * j; const LAS float* s = buf + (8 * c) * 32 + (((n >> 2) ^ c) & 7) * 4 + (n & 3);
        float v[8];
#pragma unroll
        for (int q = 0; q < 8; ++q) v[q] = s[q * 32] * scale;
        if (d.kind == 1) { u32x2 o; o.x = pk4_fp8(v[0], v[1], v[2], v[3]); o.y = pk4_fp8(v[4], v[5], v[6], v[7]); *(u32x2*)(d.dst + (size_t)n * d.ldk + 8 * c) = o; }
        else { u32x4 o; o.x = pk2(v[0], v[1]); o.y = pk2(v[2], v[3]); o.z = pk2(v[4], v[5]); o.w = pk2(v[6], v[7]); *(u32x4*)(d.dst + (size_t)n * d.ldk + 16 * c) = o; } }
    LDS_WAIT(); asm volatile("" ::: "memory");
}
#define CONV_RUN(NIT, DEC) do { int it_ = gw; if (it_ < (NIT)) { ConvD dc_ = DEC(it_); int par_ = 0; conv_dma(dc_, F.lane, scr); asm volatile("s_waitcnt vmcnt(0)" ::: "memory"); \
        for (; it_ < (NIT); it_ += NGW) { const int itn_ = (it_ + NGW < (NIT)) ? it_ + NGW : it_; const ConvD dn_ = DEC(itn_); conv_dma(dn_, F.lane, scr + (par_ ^ 1) * 2048);     \
            asm volatile("s_waitcnt vmcnt(12)" ::: "memory"); conv_finish_lds(dc_, F.lane, scr + par_ * 2048); dc_ = dn_; par_ ^= 1; } \
        asm volatile("s_waitcnt vmcnt(0)" ::: "memory"); } } while (0)
__device__ __forceinline__ ConvD conv_dec_mixers(KP p, unsigned char* ws, int it) {
    constexpr int I_AIN = 16 * 288, I_AOUT = 16 * 32, I_RIN = 16 * 192, I_ROUT = 32 * 32, I_GLU = 16 * 64, I_RT = 16 * 2;
    int r = it;
    if (r < 2 * I_AIN) { const int j = r / I_AIN; r %= I_AIN; const int kb = r / 288, nb = r % 288, n0 = nb * 32;
        return conv_mk8(gin(p, 1) + (size_t)j * D * ATT_IN, ATT_IN, (unsigned char*)(ws + WS_ATT_IN_T) + (size_t)j * ATT_IN * D, D, kb * 64, n0, n0); }
    r -= 2 * I_AIN;
    if (r < 2 * I_AOUT) { const int j = r / I_AOUT; r %= I_AOUT; const int kb = r / 32, nb = r % 32, n0 = nb * 32;
        return conv_mk8(gin(p, 2) + (size_t)j * D * D, D, (unsigned char*)(ws + WS_ATT_OUT_T) + (size_t)j * D * D, D, kb * 64, n0, n0); }
    r -= 2 * I_AOUT;
    if (r < I_RIN) { const int kb = r / 192, nb = r % 192, n0 = nb * 32;
        return conv_mk8(gin(p, 3), RET_IN, (unsigned char*)(ws + WS_RET_IN_T), D, kb * 64, n0, n0); }
    r -= I_RIN;
    if (r < I_ROUT) { const int kb = r / 32, nb = r % 32, n0 = nb * 32;
        return conv_mk8(gin(p, 6), D, (unsigned char*)(ws + WS_RET_OUT_T), RET_V, kb * 64, n0, n0); }
    r -= I_ROUT;
    if (r < I_GLU) { const int kb = r / 64, nb = r % 64, n0 = nb * 32; const int c = n0 & 1023, drow = (c >> 7) * 256 + (n0 >> 10) * 128 + (c & 127);
        return conv_mk8(gin(p, 15), 2 * D, (unsigned char*)(ws + WS_GLU_T), D, kb * 64, n0, drow); }
    r -= I_GLU;
    { const int l = r / I_RT; r %= I_RT; const int kb = r / 2, nb = r % 2, n0 = nb * 32;
        return conv_mk16(gin(p, 16) + (size_t)l * D * NE, NE, (bf16*)(ws + WS_RT_HI) + (size_t)l * NE * D, (bf16*)(ws + WS_RT_LO) + (size_t)l * NE * D, D, kb * 64, n0, n0); }
}
__device__ __forceinline__ ConvD conv_dec_moe(KP p, unsigned char* ws, int l, int it) {
    const int e = it / 384, r = it % 384, which = r >> 7, rr = r & 127;
    bf16* We = (bf16*)(ws + WS_WMOE + (size_t)e * WMOE_E_BYTES);
    if (which < 2) { const float* src = (e < 64) ? gin(p, 18 + which) + ((size_t)l * NE + e) * D * ED : gin(p, 21 + which) + (size_t)l * D * ED;
        const int kb = rr >> 3, nb = rr & 7, n0 = nb * 32; const int drow = (n0 >> 7) * 256 + which * 128 + (n0 & 127);
        return conv_mk8(src, ED, (unsigned char*)We, D, kb * 64, n0, drow); }
    const float* src = (e < 64) ? gin(p, 20) + ((size_t)l * NE + e) * ED * D : gin(p, 23) + (size_t)l * ED * D;
    const int kb = rr >> 5, nb = rr & 31, n0 = nb * 32;
    return conv_mk8(src, D, (unsigned char*)(We + 512 * 1024), ED, kb * 64, n0, n0);
}
__device__ __forceinline__ void phase_conv_mixers(const Frame& F, KP p) {
    LAS float* scr = (LAS float*)(F.lds + F.wave * 16384);
    const int gw = F.vcu * NWAVES + F.wave, NGW = F.G * NWAVES;
    constexpr int NMAIN = 2 * (16 * 288) + 2 * (16 * 32) + 16 * 192 + 32 * 32 + 16 * 64, NRT = 4 * (16 * 2);
    unsigned char* ws = F.ws;
#define CONV_DEC_MIX(i_) conv_dec_mixers(p, ws, (i_))
    CONV_RUN(NMAIN, CONV_DEC_MIX);
    for (int it = NMAIN + gw; it < NMAIN + NRT; it += NGW) { const ConvD d = conv_dec_mixers(p, ws, it); f32x4 r[8]; conv_load(d, F.lane, r); conv_finish<true>(d, F.lane, r, scr); }
#undef CONV_DEC_MIX
}
__device__ __forceinline__ void phase_conv_moe(const Frame& F, KP p, int l) {
    LAS float* scr = (LAS float*)(F.lds + F.wave * 16384);
    const int gw = F.vcu * NWAVES + F.wave, NGW = F.G * NWAVES;
    unsigned char* ws = F.ws;
#define CONV_DEC_MOE(i_) conv_dec_moe(p, ws, l, (i_))
    CONV_RUN(65 * 384, CONV_DEC_MOE);
#undef CONV_DEC_MOE
}

__device__ __forceinline__ void phase_lnr(const Frame& F, KP p, int layer, bool dry = false) {
    const bf16* Y = (const bf16*)(F.ws + WS_Y); bf16* XB = (bf16*)(F.ws + WS_XB); unsigned char* XB8 = (unsigned char*)(F.ws + WS_X);
    const float* lng = gin(p, 24) + (size_t)(layer * 2) * D; const float* lnb = gin(p, 25) + (size_t)(layer * 2) * D;
    const bf16* rthi = (const bf16*)(F.ws + WS_RT_HI) + (size_t)layer * NE * D; const bf16* rtlo = (const bf16*)(F.ws + WS_RT_LO) + (size_t)layer * NE * D;
    const float* rbias = gin(p, 17) + layer * NE;
    unsigned* cnt = (unsigned*)(F.ws + WS_CTL) + CW_CNT + layer * NE * 64;
    int* lists = (int*)(F.ws + WS_LIST); int* tokmap = (int*)(F.ws + WS_LIST + 4 * MiB); float* tokgate = (float*)(F.ws + WS_LIST + 5 * MiB);
    constexpr int XLD = 1032, MAXT = 8;
    LAS bf16* Xhi = (LAS bf16*)F.lds; LAS bf16* Xlo = Xhi + 16 * XLD;
    LAS float* part = (LAS float*)(F.lds + 2 * 16 * XLD * 2);
    LAS int* ent = (LAS int*)(part + 2 * 16 * 64);
    LAS int* hist = ent + MAXT * 16 * 8 * 2; LAS int* base = hist + 64;
    const int lane = F.lane, w = F.wave, g4 = lane >> 4, l15 = lane & 15;
    if (F.tid < 64) hist[F.tid] = 0;
    bf16x8 bhi[16], blo[16];
    { const int nt = w & 3, kh = w >> 2; const bf16* bh = rthi + (size_t)(16 * nt + l15) * D + 512 * kh + 8 * g4; const bf16* bl = rtlo + (size_t)(16 * nt + l15) * D + 512 * kh + 8 * g4;
#pragma unroll
        for (int ks = 0; ks < 16; ++ks) { bhi[ks] = *(const bf16x8*)(bh + 32 * ks); blo[ks] = *(const bf16x8*)(bl + 32 * ks); } }
    u32x4 ypre[2][2];
    if (F.vcu < T / 16) {
#pragma unroll
        for (int rr = 0; rr < 2; ++rr)
#pragma unroll
            for (int j = 0; j < 2; ++j) ypre[rr][j] = *(const u32x4*)(Y + (size_t)(F.vcu * 16 + 2 * w + rr) * D + 8 * lane + 512 * j); }
    int ntile = 0;
    for (int tile = F.vcu; tile < T / 16 && ntile < MAXT; tile += F.G, ++ntile) {
        const int t0 = tile * 16;
        u32x4 ycur[2][2];
#pragma unroll
        for (int rr = 0; rr < 2; ++rr)
#pragma unroll
            for (int j = 0; j < 2; ++j) ycur[rr][j] = ypre[rr][j];
        if (tile + F.G < T / 16) {
#pragma unroll
            for (int rr = 0; rr < 2; ++rr)
#pragma unroll
                for (int j = 0; j < 2; ++j) ypre[rr][j] = *(const u32x4*)(Y + (size_t)((tile + F.G) * 16 + 2 * w + rr) * D + 8 * lane + 512 * j); }
#pragma unroll
        for (int rr = 0; rr < 2; ++rr) {
            const int lr = 2 * w + rr; const size_t row = (size_t)(t0 + lr);
            f32x4 v[4]; float s = 0.f;
#pragma unroll
            for (int j = 0; j < 2; ++j) unpack_bf16x8(ycur[rr][j], v[2 * j], v[2 * j + 1]);
#pragma unroll
            for (int j = 0; j < 4; ++j) s += (v[j][0] + v[j][1]) + (v[j][2] + v[j][3]);
            const float mean = wave_sum(s, lane) * (1.f / D); float s2 = 0.f;
#pragma unroll
            for (int j = 0; j < 4; ++j) { v[j] = v[j] - mean; s2 += (v[j][0] * v[j][0] + v[j][1] * v[j][1]) + (v[j][2] * v[j][2] + v[j][3] * v[j][3]); }
            const float rstd = 1.0f / sqrtf(wave_sum(s2, lane) * (1.f / D) + LN_EPS);
#pragma unroll
            for (int j = 0; j < 2; ++j) { const f32x4 g0 = *(const f32x4*)(lng + 8 * lane + 512 * j), g1 = *(const f32x4*)(lng + 8 * lane + 512 * j + 4), b0 = *(const f32x4*)(lnb + 8 * lane + 512 * j), b1 = *(const f32x4*)(lnb + 8 * lane + 512 * j + 4);
                const f32x4 o0 = v[2 * j] * rstd * g0 + b0, o1 = v[2 * j + 1] * rstd * g1 + b1;
                const u32x4 hi = pack_bf16x8(o0, o1);
                *(u32x4*)(XB + row * D + 8 * lane + 512 * j) = hi;
                { u32x2 q8; q8.x = pk4_fp8(o0[0], o0[1], o0[2], o0[3]); q8.y = pk4_fp8(o1[0], o1[1], o1[2], o1[3]); *(u32x2*)(XB8 + row * D + 8 * lane + 512 * j) = q8; }
                f32x4 h0, h1; unpack_bf16x8(hi, h0, h1); const u32x4 lo = pack_bf16x8(o0 - h0, o1 - h1);
                *(LAS u32x4*)(Xhi + lr * XLD + 8 * lane + 512 * j) = hi; *(LAS u32x4*)(Xlo + lr * XLD + 8 * lane + 512 * j) = lo; }
        }
        __syncthreads();
        { const int nt = w & 3, kh = w >> 2; f32x4 a0 = (f32x4){0.f, 0.f, 0.f, 0.f}, a1 = a0, a2 = a0, a3 = a0, a4 = a0, a5 = a0;
#pragma unroll
            for (int ks = 0; ks < 16; ks += 2) { const int k0 = 512 * kh + 32 * ks;
                const bf16x8 ahi = row_frag(Xhi, XLD, 0, k0, lane), alo = row_frag(Xlo, XLD, 0, k0, lane), bhi2 = row_frag(Xhi, XLD, 0, k0 + 32, lane), blo2 = row_frag(Xlo, XLD, 0, k0 + 32, lane);
                a0 = MFMA16(ahi, bhi[ks], a0); a1 = MFMA16(alo, bhi[ks], a1); a2 = MFMA16(ahi, blo[ks], a2);
                a3 = MFMA16(bhi2, bhi[ks + 1], a3); a4 = MFMA16(blo2, bhi[ks + 1], a4); a5 = MFMA16(bhi2, blo[ks + 1], a5); }
            const f32x4 acc = ((a0 + a3) + (a1 + a4)) + (a2 + a5);
#pragma unroll
            for (int i = 0; i < 4; ++i) part[(kh * 16 + 4 * g4 + i) * 64 + 16 * nt + l15] = acc[i];
        }
        __syncthreads();
#pragma unroll
        for (int rr = 0; rr < 2; ++rr) {
            const int lt = ntile * 16 + 2 * w + rr;
            const float lg = part[(2 * w + rr) * 64 + lane] + part[(16 + 2 * w + rr) * 64 + lane];
            float sc = fsig(lg); sc = (sc == sc) ? sc : 0.5f;
            const float sel = sc + rbias[lane];
            const float m1 = max8(sel);
            const unsigned long long eq = __ballot(sel == m1);
            const unsigned gm = (unsigned)(eq >> (lane & 56)) & 0xffu;
            const int first = (lane & 56) + __builtin_ctz(gm | 0x100u);
            const float m2 = max8((lane == first) ? -INFINITY : sel);
            const float gs = m1 + m2; const int mygrp = lane >> 3; int grank = 0;
#pragma unroll
            for (int gg = 0; gg < 8; ++gg) { const float o = rdl(gs, 8 * gg); grank += (o > gs || (o == gs && gg < mygrp)) ? 1 : 0; }
            const float mv = (grank < 4) ? sel : -INFINITY;
            unsigned key = __builtin_bit_cast(unsigned, mv); key = (key >> 31) ? ~key : (key | 0x80000000u); key = (key & ~63u) | (unsigned)(63 - lane);
            int rank = 64; { unsigned kw = key;
#pragma unroll
                for (int r = 0; r < TOPK; ++r) { const unsigned m = wave_umax(kw); if (kw == m) { rank = r; kw = 0u; } } }
            const bool chosen = rank < TOPK;
            const float wsum = wave_sum(chosen ? sc : 0.f, lane);
            if (chosen) { const int lpos = __hip_atomic_fetch_add(hist + lane, 1, __ATOMIC_RELAXED, __HIP_MEMORY_SCOPE_WORKGROUP);
                ent[(lt * 8 + rank) * 2] = (lane << 16) | lpos; ent[(lt * 8 + rank) * 2 + 1] = __builtin_bit_cast(int, sc * __builtin_amdgcn_rcpf(wsum) * 2.5f); }
        }
    }
    __syncthreads();
    if (dry) return;
    if (F.tid < 64) { const int hcount = hist[F.tid]; base[F.tid] = hcount ? (int)atomicAdd(cnt + F.tid * 64, (unsigned)hcount) : 0; }
    __syncthreads();
    for (int idx = F.tid; idx < ntile * 16 * 8; idx += NTHREADS) {
        const int ev = ent[idx * 2], gb = ent[idx * 2 + 1]; const int e = ev >> 16, pos = base[e] + (ev & 0xffff);
        const int lt = idx >> 3, rank = idx & 7, tok = (F.vcu + (lt >> 4) * F.G) * 16 + (lt & 15);
        lists[(size_t)e * T + pos] = tok; tokmap[tok * 8 + rank] = (e << 16) | pos; tokgate[tok * 8 + rank] = __builtin_bit_cast(float, gb);
    }
}

__device__ __forceinline__ void phase_combine(const Frame& F, KP p, int layer, bool dry = false) {
    bf16* XB = (bf16*)(F.ws + WS_XB); const unsigned char* yexp = (const unsigned char*)(F.ws + WS_BIG);
    const int* tokmap = (const int*)(F.ws + WS_LIST + 4 * MiB); const float* tokgate = (const float*)(F.ws + WS_LIST + 5 * MiB);
    const volatile LAS int* tstart = (const volatile LAS int*)(F.MISC + 64);
    const float* lng = gin(p, 24) + (size_t)(layer * 2 + 1) * D; const float* lnb = gin(p, 25) + (size_t)(layer * 2 + 1) * D;
    float* outp = gout(p); bf16* xbo = XB; if (dry) { outp = (float*)(F.ws + WS_AUX); xbo = (bf16*)(F.ws + WS_H); }
    const int lane = F.lane, gw = F.vcu * NWAVES + F.wave, NGW = F.G * NWAVES;
    const bf16* ysh = (const bf16*)(F.ws + WS_Y);
    f32x4 gv[4], bv[4];
#pragma unroll
    for (int j = 0; j < 4; ++j) { gv[j] = *(const f32x4*)(lng + 16 * lane + 4 * j); bv[j] = *(const f32x4*)(lnb + 16 * lane + 4 * j); }
    for (int row = gw; row < T; row += NGW) {
        const int mk = tokmap[row * 8 + (lane & 7)]; const float gk = tokgate[row * 8 + (lane & 7)] * YEXP_INV;
        const int rk = (int)tstart[mk >> 16] * 256 + (mk & 0xffff);
        f32x4 v[4];
#pragma unroll
        for (int j = 0; j < 2; ++j) { const u32x4 xw = *(const u32x4*)(ysh + (size_t)row * D + 16 * lane + 8 * j); unpack_bf16x8(xw, v[2 * j], v[2 * j + 1]); }
#pragma unroll
        for (int k = 0; k < TOPK; ++k) { const int r = __builtin_amdgcn_readlane(rk, k); const float g = rdl(gk, k);
            const u32x4 s = *(const u32x4*)(yexp + (size_t)r * D + 16 * lane);
#pragma unroll
            for (int j = 0; j < 4; ++j) { const f32x2 lo = __builtin_amdgcn_cvt_pk_f32_fp8((int)s[j], false), hi = __builtin_amdgcn_cvt_pk_f32_fp8((int)s[j], true);
                v[j][0] += g * lo[0]; v[j][1] += g * lo[1]; v[j][2] += g * hi[0]; v[j][3] += g * hi[1]; } }
        float s = 0.f;
#pragma unroll
        for (int j = 0; j < 4; ++j) s += (v[j][0] + v[j][1]) + (v[j][2] + v[j][3]);
        const float mean = wave_sum(s, lane) * (1.f / D); float s2 = 0.f;
#pragma unroll
        for (int j = 0; j < 4; ++j) { v[j] = v[j] - mean; s2 += (v[j][0] * v[j][0] + v[j][1] * v[j][1]) + (v[j][2] * v[j][2] + v[j][3] * v[j][3]); }
        const float rstd = 1.0f / sqrtf(wave_sum(s2, lane) * (1.f / D) + LN_EPS);
        f32x4 o[4];
#pragma unroll
        for (int j = 0; j < 4; ++j) o[j] = v[j] * rstd * gv[j] + bv[j];
        if (layer == DEPTH - 1 || dry) {
#pragma unroll
            for (int j = 0; j < 4; ++j) *(f32x4*)(outp + (size_t)row * D + 16 * lane + 4 * j) = o[j]; }
        if (layer != DEPTH - 1) { *(u32x4*)(xbo + (size_t)row * D + 16 * lane) = pack_bf16x8(o[0], o[1]); *(u32x4*)(xbo + (size_t)row * D + 16 * lane + 8) = pack_bf16x8(o[2], o[3]);
            if (!dry) { u32x4 q8; q8.x = pk4_fp8(o[0][0], o[0][1], o[0][2], o[0][3]); q8.y = pk4_fp8(o[1][0], o[1][1], o[1][2], o[1][3]); q8.z = pk4_fp8(o[2][0], o[2][1], o[2][2], o[2][3]); q8.w = pk4_fp8(o[3][0], o[3][1], o[3][2], o[3][3]);
                *(u32x4*)((unsigned char*)(F.ws + WS_X) + (size_t)row * D + 16 * lane) = q8; } }
    }
}

constexpr size_t AUX_OB = 96 * MiB, AUX_LSE = 128 * MiB;
__device__ __forceinline__ unsigned att_qoff(int R, int j, int qi, int g4) {
    const int h = R & 7, sbr = R >> 3, g = sbr >> 5, rem = sbr & 31, b = rem >> 4, rr_ = rem & 15;
    const int dsh = 2 * g, d = 1 << dsh, nrs = 4 - dsh, r = rr_ >> nrs, n = 4 * (rr_ & ((1 << nrs) - 1)) + j;
    const unsigned qrow = (unsigned)b * SEQ + (unsigned)(128 * n + qi) * (unsigned)d + (unsigned)r;
    return qrow * (unsigned)ATT_IN + (unsigned)(g * 3072 + h * 128 + 8 * g4);
}
__device__ __forceinline__ void phase_attn(const Frame& F, int bx) {
    const unsigned char* qkv = (const unsigned char*)(F.ws + WS_BIG); bf16* og = (bf16*)(F.ws + WS_AUX); float* lse = (float*)(F.ws + WS_AUX + AUX_LSE);
    constexpr int KLD = 136;
    LAS bf16* Ks = (LAS bf16*)F.lds; LAS bf16* Vs = Ks + 256 * KLD;
    const int lane = F.lane, w = F.wave, g4 = lane >> 4, l15 = lane & 15, qq = l15 >> 2, pp = lane & 3;
    u32x4 kc[2], vc[2];
    constexpr int NRUN = 768;
#define ATT_CVT8(lo_, hi_) ({ const f32x2 a_ = __builtin_amdgcn_cvt_pk_f32_fp8((int)(lo_), false), b_ = __builtin_amdgcn_cvt_pk_f32_fp8((int)(lo_), true), c_ = __builtin_amdgcn_cvt_pk_f32_fp8((int)(hi_), false), d_ = __builtin_amdgcn_cvt_pk_f32_fp8((int)(hi_), true); \
        u32x4 r_; r_.x = pk2(a_[0], a_[1]); r_.y = pk2(b_[0], b_[1]); r_.z = pk2(c_[0], c_[1]); r_.w = pk2(d_[0], d_[1]); r_; })
#define ATT_LOADBLK(KR, VR, nblk) do { _Pragma("unroll") for (int it = 0; it < 2; ++it) { const int idx = F.tid + 512 * it, c = idx >> 3, ch = idx & 7; int pos = 128 * (nblk) + c; pos = pos < 0 ? 0 : pos; \
            const unsigned so = (rowbase + (unsigned)pos * (unsigned)d + (unsigned)r) * (unsigned)ATT_IN + (unsigned)(g * 3072 + 1024 + h * 128 + ch * 16); KR[it] = *(const u32x4*)(qkv + so); VR[it] = *(const u32x4*)(qkv + so + 1024u); } } while (0)
#define ATT_STOREBLK(KR, VR, slot) do { _Pragma("unroll") for (int it = 0; it < 2; ++it) { const int idx = F.tid + 512 * it, c = idx >> 3, ch = idx & 7; \
            *(LAS u32x4*)(Ks + (128 * (slot) + c) * KLD + ch * 16) = ATT_CVT8(KR[it].x, KR[it].y); *(LAS u32x4*)(Ks + (128 * (slot) + c) * KLD + ch * 16 + 8) = ATT_CVT8(KR[it].z, KR[it].w); \
            *(LAS u32x4*)(Vs + (128 * (slot) + c) * KLD + ch * 16) = ATT_CVT8(VR[it].x, VR[it].y); *(LAS u32x4*)(Vs + (128 * (slot) + c) * KLD + ch * 16 + 8) = ATT_CVT8(VR[it].z, VR[it].w); } } while (0)
    const int qi = 16 * w + l15;
    u32x2 qraw[4];
    if (bx < NRUN) { const unsigned qo = att_qoff(bx, 0, qi, g4);
#pragma unroll
        for (int s = 0; s < 4; ++s) qraw[s] = *(const u32x2*)(qkv + qo + 32 * s); }
    for (int R = bx; R < NRUN; R += F.G) {
        const int h = R & 7, sbr = R >> 3, g = sbr >> 5, rem = sbr & 31, b = rem >> 4, rr_ = rem & 15;
        const int dsh = 2 * g, d = 1 << dsh, nrs = 4 - dsh, r = rr_ >> nrs, n0 = 4 * (rr_ & ((1 << nrs) - 1)); const unsigned rowbase = (unsigned)b * SEQ;
        { u32x4 k0[2], v0[2]; ATT_LOADBLK(k0, v0, n0 - 1); ATT_LOADBLK(kc, vc, n0); ATT_STOREBLK(k0, v0, (n0 - 1) & 1); }
#pragma unroll 1
        for (int j = 0; j < 4; ++j) {
            const int n = n0 + j, cs = n & 1, ps = cs ^ 1;
            ATT_STOREBLK(kc, vc, cs);
            const unsigned qrow = rowbase + (unsigned)(128 * n + qi) * (unsigned)d + (unsigned)r;
            bf16x8 qf[4];
#pragma unroll
            for (int s = 0; s < 4; ++s) qf[s] = __builtin_bit_cast(bf16x8, ATT_CVT8(qraw[s].x, qraw[s].y));
            __syncthreads();
            if (j < 3) { ATT_LOADBLK(kc, vc, n + 1); }
            __builtin_amdgcn_sched_barrier(0);
            const int ws0 = (16 * w < 96) ? 16 * w : 96;
#define ATT_PROW(c0) (((c0) < 128) ? (128 * ps + (c0)) : (128 * cs + (c0) - 128))
            f32x4 sacc[10];
            {
                bf16x8 kfa[4], kfb[4];
#pragma unroll
                for (int s = 0; s < 4; ++s) kfa[s] = row_frag(Ks, KLD, ATT_PROW(ws0), 32 * s, lane);
#pragma unroll
                for (int t = 0; t < 10; t += 2) {
#pragma unroll
                    for (int s = 0; s < 4; ++s) kfb[s] = row_frag(Ks, KLD, ATT_PROW(ws0 + 16 * (t + 1)), 32 * s, lane);
                    __builtin_amdgcn_sched_barrier(0);
                    sacc[t] = (f32x4){0.f, 0.f, 0.f, 0.f};
#pragma unroll
                    for (int s = 0; s < 4; ++s) sacc[t] = MFMA16(kfa[s], qf[s], sacc[t]);
                    if (t + 2 < 10) {
#pragma unroll
                        for (int s = 0; s < 4; ++s) kfa[s] = row_frag(Ks, KLD, ATT_PROW(ws0 + 16 * (t + 2)), 32 * s, lane); }
                    __builtin_amdgcn_sched_barrier(0);
                    sacc[t + 1] = (f32x4){0.f, 0.f, 0.f, 0.f};
#pragma unroll
                    for (int s = 0; s < 4; ++s) sacc[t + 1] = MFMA16(kfb[s], qf[s], sacc[t + 1]);
                }
            }
            { const int Rn = (j < 3) ? R : ((R + F.G < NRUN) ? R + F.G : R), jn = (j < 3) ? j + 1 : 0; const unsigned qo = att_qoff(Rn, jn, qi, g4);
#pragma unroll
              for (int s = 0; s < 4; ++s) qraw[s] = *(const u32x2*)(qkv + qo + 32 * s); }
            const float slope = exp2f(-(float)(h + 1)) * (float)d;
            float mx = -INFINITY;
            int sbase = 128 + qi - ws0 - 4 * g4; asm volatile("" : "+v"(sbase));
            const float nsb = -slope * (float)sbase; const int kmin = (n > 0) ? sbase - 128 : ((sbase - 128 > 128 - ws0 - 4 * g4) ? sbase - 128 : 128 - ws0 - 4 * g4);
#pragma unroll
            for (int t = 0; t < 10; ++t)
#pragma unroll
                for (int i = 0; i < 4; ++i) { const int k = 16 * t + i;
                    const bool valid = (k <= sbase) && (k >= kmin);
                    const float v = valid ? __builtin_fmaf(slope, (float)k, __builtin_fmaf(sacc[t][i], 1.0f / (Q8_SCALE * KV8_SCALE), nsb)) : -INFINITY; sacc[t][i] = v; mx = fmaxf(mx, v); }
            mx = fmaxf(mx, shx(mx, 16, lane)); mx = fmaxf(mx, shx(mx, 32, lane));
            float lsum = 0.f;
#pragma unroll
            for (int t = 0; t < 10; ++t)
#pragma unroll
                for (int i = 0; i < 4; ++i) { const float pv = __expf(sacc[t][i] - mx); sacc[t][i] = pv; lsum += pv; }
            lsum += shx(lsum, 16, lane); lsum += shx(lsum, 32, lane);
            bf16x8 pf[5];
#pragma unroll
            for (int kt = 0; kt < 5; ++kt) pf[kt] = pack8(sacc[2 * kt], sacc[2 * kt + 1]);
            f32x4 o[8];
            {
                const LAS bf16* vl = Vs + (4 * g4 + qq) * KLD + 32 * pp;
                bf16x4 va[10], vcc[10];
#pragma unroll
                for (int q = 0; q < 10; ++q) va[q] = tr4(vl + ATT_PROW(ws0 + 16 * q) * KLD);
#pragma unroll
                for (int et = 0; et < 8; et += 2) {
#pragma unroll
                    for (int q = 0; q < 10; ++q) vcc[q] = tr4(vl + ATT_PROW(ws0 + 16 * q) * KLD + 4 * (et + 1));
                    __builtin_amdgcn_sched_barrier(0);
                    o[et] = (f32x4){0.f, 0.f, 0.f, 0.f};
#pragma unroll
                    for (int kt = 0; kt < 5; ++kt) o[et] = MFMA16(cat8(va[2 * kt], va[2 * kt + 1]), pf[kt], o[et]);
                    if (et + 2 < 8) {
#pragma unroll
                        for (int q = 0; q < 10; ++q) va[q] = tr4(vl + ATT_PROW(ws0 + 16 * q) * KLD + 4 * (et + 2)); }
                    __builtin_amdgcn_sched_barrier(0);
                    o[et + 1] = (f32x4){0.f, 0.f, 0.f, 0.f};
#pragma unroll
                    for (int kt = 0; kt < 5; ++kt) o[et + 1] = MFMA16(cat8(vcc[2 * kt], vcc[2 * kt + 1]), pf[kt], o[et + 1]);
                }
            }
#undef ATT_PROW
            const float inv = (1.0f / KV8_SCALE) / lsum;
            unsigned char* orow = (unsigned char*)og + ((size_t)g * T + qrow) * D + h * 128 + 32 * g4;
#pragma unroll
            for (int k2 = 0; k2 < 2; ++k2) { u32x4 w8;
#pragma unroll
                for (int q = 0; q < 4; ++q) { const f32x4 v = o[4 * k2 + q] * (inv * OG_SCALE); w8[q] = pk4_fp8(v[0], v[1], v[2], v[3]); }
                *(u32x4*)(orow + 16 * k2) = w8; }
            if (g4 == 0) lse[((size_t)g * T + qrow) * AH + h] = mx + __logf(lsum);
            __syncthreads();
        }
    }
#undef ATT_LOADBLK
#undef ATT_CVT8
#undef ATT_STOREBLK
}
__device__ __forceinline__ void phase_attn_combine(const Frame& F) {
    const bf16* og = (const bf16*)(F.ws + WS_AUX); const float* lse = (const float*)(F.ws + WS_AUX + AUX_LSE); bf16* ob = (bf16*)(F.ws + WS_AUX + AUX_OB);
    const int lane = F.lane, gw = F.vcu * NWAVES + F.wave, NGW = F.G * NWAVES, h = lane >> 3;
    for (int row = gw; row < T; row += NGW) {
        const float l0 = lse[((size_t)0 * T + row) * AH + h], l1 = lse[((size_t)1 * T + row) * AH + h], l2 = lse[((size_t)2 * T + row) * AH + h];
        const float m = fmaxf(l0, fmaxf(l1, l2)); float w0 = __expf(l0 - m), w1 = __expf(l1 - m), w2 = __expf(l2 - m); const float inv = 1.0f / (w0 + w1 + w2); w0 *= inv; w1 *= inv; w2 *= inv;
        float a[16];
#pragma unroll
        for (int j = 0; j < 16; ++j) a[j] = 0.f;
#pragma unroll
        for (int g = 0; g < 3; ++g) { const float wg = ((g == 0) ? w0 : (g == 1 ? w1 : w2)) * (1.0f / OG_SCALE);
            const u32x4 s8 = *(const u32x4*)((const unsigned char*)og + ((size_t)g * T + row) * D + 16 * lane);
#pragma unroll
            for (int q = 0; q < 4; ++q) { const f32x2 lo = __builtin_amdgcn_cvt_pk_f32_fp8((int)s8[q], false), hi = __builtin_amdgcn_cvt_pk_f32_fp8((int)s8[q], true);
                a[4 * q] += wg * lo[0]; a[4 * q + 1] += wg * lo[1]; a[4 * q + 2] += wg * hi[0]; a[4 * q + 3] += wg * hi[1]; } }
        { u32x4 o;
#pragma unroll
          for (int q = 0; q < 4; ++q) o[q] = pk4_fp8(a[4 * q] * A_SCALE, a[4 * q + 1] * A_SCALE, a[4 * q + 2] * A_SCALE, a[4 * q + 3] * A_SCALE);
          *(u32x4*)((unsigned char*)ob + (size_t)row * D + 16 * lane) = o; }
    }
}

constexpr size_t BIG_YRET = 192 * MiB;
__device__ __forceinline__ void phase_ret_u(const Frame& F) {
    const unsigned char* proj = (const unsigned char*)(F.ws + WS_BIG); unsigned char* St = (unsigned char*)(F.ws + WS_AUX);
    constexpr int LD = 264;
    LAS bf16* Kt = (LAS bf16*)F.lds; LAS bf16* Vt = Kt + 128 * LD;
    const int lane = F.lane, w = F.wave, g4 = lane >> 4, l15 = lane & 15, qq = l15 >> 2, pp = lane & 3;
    u32x4 kr[4], vr[4];
#define RU_LOAD(u_) do { const int eh_ = (u_) & 1, h_ = ((u_) >> 1) & 3, n_ = ((u_) >> 3) & 63, b_ = (u_) >> 9; const char* pb_ = (const char*)(proj + ((size_t)b_ * SEQ + (size_t)n_ * RC) * RET_IN); \
        int t_ = F.tid; asm volatile("" : "+v"(t_)); unsigned off_ = (unsigned)((t_ >> 4) * RET_IN + (t_ & 15) * 16); \
        _Pragma("unroll") for (int it = 0; it < 4; ++it) { asm volatile("" : "+v"(off_)); kr[it] = *(const u32x4*)(pb_ + (size_t)(1024 + h_ * 256 + it * 32 * RET_IN) + off_); \
            vr[it] = *(const u32x4*)(pb_ + (size_t)(2048 + h_ * 512 + eh_ * 256 + it * 32 * RET_IN) + off_); } } while (0)
    if (F.vcu < 1024) RU_LOAD(F.vcu);
    for (int u = F.vcu; u < 1024; u += F.G) {
        const int eh = u & 1, h = (u >> 1) & 3, n = (u >> 3) & 63, b = u >> 9;
        { int t_ = F.tid; asm volatile("" : "+v"(t_));
#pragma unroll
          for (int it = 0; it < 4; ++it) { const int idx = t_ + 512 * it, j = idx >> 4, ch = idx & 15;
              *(LAS u32x4*)(Kt + j * LD + ch * 16) = cvt8_bf16(kr[it].x, kr[it].y); *(LAS u32x4*)(Kt + j * LD + ch * 16 + 8) = cvt8_bf16(kr[it].z, kr[it].w);
              *(LAS u32x4*)(Vt + j * LD + ch * 16) = cvt8_bf16(vr[it].x, vr[it].y); *(LAS u32x4*)(Vt + j * LD + ch * 16 + 8) = cvt8_bf16(vr[it].z, vr[it].w); } }
        __syncthreads();
        f32x4 acc[16][2];
#pragma unroll
        for (int mt = 0; mt < 16; ++mt) { acc[mt][0] = (f32x4){0.f, 0.f, 0.f, 0.f}; acc[mt][1] = (f32x4){0.f, 0.f, 0.f, 0.f}; }
#pragma unroll
        for (int ks = 0; ks < 4; ++ks) {
            bf16x8 bfr[2];
#pragma unroll
            for (int nt = 0; nt < 2; ++nt) { const LAS bf16* a0 = Vt + (32 * ks + 8 * g4 + qq) * LD + 32 * w + 16 * nt + 4 * pp; bfr[nt] = cat8(tr4(a0), tr4(a0 + 4 * LD)); }
#pragma unroll
            for (int mt = 0; mt < 16; ++mt) { const LAS bf16* a0 = Kt + (32 * ks + 8 * g4 + qq) * LD + 128 * (mt >> 3) + 32 * pp + 4 * (mt & 7);
                const bf16x8 afr = cat8(tr4(a0), tr4(a0 + 4 * LD));
                acc[mt][0] = MFMA16(afr, bfr[0], acc[mt][0]); acc[mt][1] = MFMA16(afr, bfr[1], acc[mt][1]); }
        }
        { const int un = (u + F.G < 1024) ? u + F.G : u; RU_LOAD(un); }
        unsigned char* outb = St + ((size_t)((b * RH + h) * RNC + n)) * (RDV * RDK);
#pragma unroll
        for (int nt = 0; nt < 2; ++nt) { unsigned char* orow = outb + (size_t)(eh * 256 + 32 * w + 16 * nt + l15) * RDK + 32 * g4;
#pragma unroll
            for (int mh = 0; mh < 2; ++mh)
#pragma unroll
                for (int q2 = 0; q2 < 2; ++q2) { u32x4 o;
#pragma unroll
                    for (int k = 0; k < 4; ++k) { const f32x4 v = acc[mh * 8 + 4 * q2 + k][nt] * (RS_SCALE / (RK_SCALE * RV_SCALE)); o[k] = pk4_fp8(v[0], v[1], v[2], v[3]); }
                    *(u32x4*)(orow + 128 * mh + 16 * q2) = o; } }
        __syncthreads();
    }
#undef RU_LOAD
}
__device__ __forceinline__ void phase_ret_scan(const Frame& F) {
    unsigned char* St = (unsigned char*)(F.ws + WS_AUX);
    for (int gt = F.vcu * NTHREADS + F.tid; gt < 8 * 8192; gt += F.G * NTHREADS) {
        const int bh = gt >> 13, chunk = gt & 8191, h = bh & 3;
        const float g128 = exp2f(128.0f * log2f(1.0f - exp2f(-5.0f - (float)h)));
        unsigned char* base = St + (size_t)bh * RNC * (RDV * RDK) + (size_t)chunk * 16;
        float c[16];
#pragma unroll
        for (int j = 0; j < 16; ++j) c[j] = 0.f;
#pragma unroll 8
        for (int n = 0; n < RNC; ++n) { unsigned char* pn = base + (size_t)n * (RDV * RDK); const u32x4 uv = *(const u32x4*)pn;
            u32x4 o;
#pragma unroll
            for (int k = 0; k < 4; ++k) o[k] = pk4_fp8(c[4 * k], c[4 * k + 1], c[4 * k + 2], c[4 * k + 3]);
            *(u32x4*)pn = o;
#pragma unroll
            for (int k = 0; k < 4; ++k) { const f32x2 lo = __builtin_amdgcn_cvt_pk_f32_fp8((int)uv[k], false), hi = __builtin_amdgcn_cvt_pk_f32_fp8((int)uv[k], true);
                c[4 * k] = g128 * (c[4 * k] + lo[0]); c[4 * k + 1] = g128 * (c[4 * k + 1] + lo[1]); c[4 * k + 2] = g128 * (c[4 * k + 2] + hi[0]); c[4 * k + 3] = g128 * (c[4 * k + 3] + hi[1]); } }
    }
}
__device__ __forceinline__ void phase_ret_out(const Frame& F, KP p) {
    const unsigned char* proj = (const unsigned char*)(F.ws + WS_BIG); const unsigned char* St = (const unsigned char*)(F.ws + WS_AUX); bf16* yret = (bf16*)(F.ws + WS_BIG + BIG_YRET);
    const float* gng = gin(p, 4); const float* gnb = gin(p, 5);
    constexpr int LD = 264, VLD = 72, NSL = 8, ESL = 64;
    LAS bf16* Rs = (LAS bf16*)F.lds; LAS bf16* Vs = Rs + 128 * LD;
    const int w = F.wave;
#define RO_TID(t_) int t_ = F.tid; asm volatile("" : "+v"(t_))
#define RO_LD(base_, off_) (*(const u32x4*)((const char*)(base_) + (off_)))
    for (int u = F.vcu; u < 512; u += F.G) {
        const int h = u & 3, n = (u >> 2) & 63, b = u >> 8;
        const size_t row0 = (size_t)b * SEQ + (size_t)n * RC;
        const unsigned char* Sn = St + ((size_t)((b * RH + h) * RNC + n)) * (RDV * RDK);
        const char* pbase = (const char*)(proj + row0 * RET_IN);
        u32x4 pv[1], ps[2];
        bf16x8 qf[8];
        { RO_TID(t0); u32x4 kreg[4]; u32x2 qraw[8];
          unsigned koff = (unsigned)((t0 >> 4) * RET_IN + (t0 & 15) * 16), qoff = (unsigned)((16 * w + (t0 & 15)) * RET_IN + 8 * ((t0 & 63) >> 4));
#pragma unroll
          for (int it = 0; it < 4; ++it) { asm volatile("" : "+v"(koff)); kreg[it] = RO_LD(pbase + (size_t)(1024 + h * 256 + it * 32 * RET_IN), koff); }
#pragma unroll
          for (int s = 0; s < 8; ++s) { asm volatile("" : "+v"(qoff)); qraw[s] = *(const u32x2*)(pbase + (size_t)(h * 256 + 32 * s) + qoff); }
#define RO_LOAD_SLICE(sl_) do { RO_TID(tl_); unsigned voff = (unsigned)((tl_ >> 2) * RET_IN + (tl_ & 3) * 16), soff = (unsigned)((tl_ >> 4) * RDK + (tl_ & 15) * 16); \
            asm volatile("" : "+v"(voff)); pv[0] = RO_LD(pbase + (size_t)(2048 + h * 512 + (sl_) * ESL), voff); \
            _Pragma("unroll") for (int it = 0; it < 2; ++it) { asm volatile("" : "+v"(soff)); ps[it] = RO_LD((const char*)Sn + (size_t)(((sl_) * ESL + it * 32) * RDK), soff); } } while (0)
          RO_LOAD_SLICE(0);
#pragma unroll
          for (int it = 0; it < 4; ++it) { const int idx = t0 + 512 * it, j = idx >> 4, ch = idx & 15;
              *(LAS u32x4*)(Rs + j * LD + ch * 16) = cvt8_bf16(kreg[it].x, kreg[it].y); *(LAS u32x4*)(Rs + j * LD + ch * 16 + 8) = cvt8_bf16(kreg[it].z, kreg[it].w); }
#pragma unroll
          for (int s = 0; s < 8; ++s) qf[s] = __builtin_bit_cast(bf16x8, cvt8_bf16(qraw[s].x, qraw[s].y)); }
        __syncthreads();
        bf16x8 pf[4];
        { RO_TID(t1); const int lane = t1 & 63, g4 = lane >> 4, irow = 16 * w + (lane & 15);
          f32x4 sacc[8];
#pragma unroll
            for (int jt = 0; jt < 8; ++jt) { sacc[jt] = (f32x4){0.f, 0.f, 0.f, 0.f};
                if (jt <= w) {
#pragma unroll
                    for (int s = 0; s < 8; ++s) sacc[jt] = MFMA16(row_frag(Rs, LD, 16 * jt, 32 * s, lane), qf[s], sacc[jt]);
#pragma unroll
                    for (int i = 0; i < 4; ++i) if (16 * jt + 4 * g4 + i > irow) sacc[jt][i] = 0.f; } }
#pragma unroll
            for (int kt = 0; kt < 4; ++kt) pf[kt] = pack8(sacc[2 * kt] * (RS_SCALE / (RQ_SCALE * RK_SCALE)), sacc[2 * kt + 1] * (RS_SCALE / (RQ_SCALE * RK_SCALE))); }
        __syncthreads();
        u32x4 accp[NSL][2];
        float s1 = 0.f, s2 = 0.f;
#pragma unroll
        for (int sl = 0; sl < NSL; ++sl) {
            { RO_TID(t2);
              { const int j = t2 >> 2, ch = t2 & 3; *(LAS u32x4*)(Vs + j * VLD + ch * 16) = cvt8_bf16(pv[0].x, pv[0].y); *(LAS u32x4*)(Vs + j * VLD + ch * 16 + 8) = cvt8_bf16(pv[0].z, pv[0].w); }
#pragma unroll
              for (int it = 0; it < 2; ++it) { const int idx = t2 + 512 * it, e = idx >> 4, ch = idx & 15; *(LAS u32x4*)(Rs + e * LD + ch * 16) = cvt8_bf16(ps[it].x, ps[it].y); *(LAS u32x4*)(Rs + e * LD + ch * 16 + 8) = cvt8_bf16(ps[it].z, ps[it].w); } }
            __syncthreads();
            if (sl + 1 < NSL) RO_LOAD_SLICE(sl + 1);
            RO_TID(t3); const int lane = t3 & 63, g4 = lane >> 4, qq = (lane & 15) >> 2, pp = lane & 3;
            f32x4 acc[4];
#pragma unroll
            for (int et = 0; et < 4; ++et) { f32x4 a = (f32x4){0.f, 0.f, 0.f, 0.f};
#pragma unroll
                for (int kt = 0; kt < 4; ++kt) if (2 * kt <= w) { const LAS bf16* a0 = Vs + (32 * kt + 4 * g4 + qq) * VLD + 16 * pp + 4 * et;
                    a = MFMA16(cat8(tr4(a0), tr4(a0 + 16 * VLD)), pf[kt], a); }
                const LAS bf16* srow = Rs + (16 * qq + 4 * et + pp) * LD + 8 * g4;
#pragma unroll
                for (int s = 0; s < 8; ++s) a = MFMA16(*(const LAS bf16x8*)(srow + 32 * s), qf[s], a);
                a = a * (1.0f / (RV_SCALE * RS_SCALE));
                acc[et] = a; s1 += (a[0] + a[1]) + (a[2] + a[3]); s2 += (a[0] * a[0] + a[1] * a[1]) + (a[2] * a[2] + a[3] * a[3]);
                __builtin_amdgcn_sched_barrier(0); }
            accp[sl][0] = pack_bf16x8(acc[0], acc[1]); accp[sl][1] = pack_bf16x8(acc[2], acc[3]);
            __syncthreads();
        }
#undef RO_LOAD_SLICE
        RO_TID(t4); const int lane = t4 & 63, g4 = lane >> 4, irow = 16 * w + (lane & 15); const size_t qrow = row0 + irow;
        s1 += shx(s1, 16, lane); s1 += shx(s1, 32, lane); s2 += shx(s2, 16, lane); s2 += shx(s2, 32, lane);
        const float mean = s1 * (1.0f / RDV); const float var = fmaxf(s2 * (1.0f / RDV) - mean * mean, 0.f);
        const float rstd = 1.0f / sqrtf(var + LN_EPS);
        unsigned goff = (unsigned)(irow * RET_IN + 16 * g4);
#pragma unroll
        for (int sp = 0; sp < NSL; sp += 2) {
            u32x4 gq[2]; f32x4 gg[2][4], gb[2][4];
#pragma unroll
            for (int d2 = 0; d2 < 2; ++d2) { const int c0 = h * RDV + (sp + d2) * ESL + 16 * g4;
                asm volatile("" : "+v"(goff)); gq[d2] = RO_LD(pbase + (size_t)(4096 + h * RDV + (sp + d2) * ESL), goff);
#pragma unroll
                for (int q = 0; q < 4; ++q) { gg[d2][q] = *(const f32x4*)(gng + c0 + 4 * q); gb[d2][q] = *(const f32x4*)(gnb + c0 + 4 * q); } }
#pragma unroll
            for (int d2 = 0; d2 < 2; ++d2) { const int c0 = h * RDV + (sp + d2) * ESL + 16 * g4; u32x4 o8;
#pragma unroll
                for (int q = 0; q < 2; ++q) { f32x4 a0, a1; unpack_bf16x8(accp[sp + d2][q], a0, a1);
                    f32x4 y0 = (a0 - mean) * rstd * gg[d2][2 * q] + gb[d2][2 * q], y1 = (a1 - mean) * rstd * gg[d2][2 * q + 1] + gb[d2][2 * q + 1];
                    const f32x2 g0 = __builtin_amdgcn_cvt_pk_f32_fp8((int)gq[d2][2 * q], false), g1 = __builtin_amdgcn_cvt_pk_f32_fp8((int)gq[d2][2 * q], true), g2 = __builtin_amdgcn_cvt_pk_f32_fp8((int)gq[d2][2 * q + 1], false), g3 = __builtin_amdgcn_cvt_pk_f32_fp8((int)gq[d2][2 * q + 1], true);
                    const float gv[8] = {g0[0] * (1.0f / RV_SCALE), g0[1] * (1.0f / RV_SCALE), g1[0] * (1.0f / RV_SCALE), g1[1] * (1.0f / RV_SCALE), g2[0] * (1.0f / RV_SCALE), g2[1] * (1.0f / RV_SCALE), g3[0] * (1.0f / RV_SCALE), g3[1] * (1.0f / RV_SCALE)};
#pragma unroll
                    for (int j = 0; j < 4; ++j) { y0[j] *= gv[j] * fsig(gv[j]) * A_SCALE; y1[j] *= gv[4 + j] * fsig(gv[4 + j]) * A_SCALE; }
                    o8[2 * q] = pk4_fp8(y0[0], y0[1], y0[2], y0[3]); o8[2 * q + 1] = pk4_fp8(y1[0], y1[1], y1[2], y1[3]); }
                *(u32x4*)((unsigned char*)yret + qrow * RET_V + c0) = o8; }
        }
    }
#undef RO_LD
#undef RO_TID
}

constexpr size_t AUX_S5E = 64 * MiB;
constexpr int S5L = 256, S5NC = SEQ / S5L;
__device__ __forceinline__ void cmul_add(float& rr, float& ri, float ar, float ai, float xr, float xi, float cr, float ci) { rr = ar * xr - ai * xi + cr; ri = ar * xi + ai * xr + ci; }
template <bool OUT>
__device__ __forceinline__ void phase_s5_scan(const Frame& F, KP p) {
    const bf16* X = (const bf16*)(F.ws + WS_XB); float* E = (float*)(F.ws + WS_AUX + AUX_S5E); bf16* ybuf = (bf16*)(F.ws + WS_AUX);
    const int lane = F.lane, w = F.wave, g4 = lane >> 4, l15 = lane & 15;
    LAS bf16* ut = (LAS bf16*)(F.lds + w * 12288);
    LAS bf16* Hb = (LAS bf16*)(F.lds + w * 12288 + 4096);
    constexpr int HLD = 136;
    const int gw = F.vcu * NWAVES + w, NGW = F.G * NWAVES;
    const int up16 = (lane - 16) << 2, up32 = (lane - 32) << 2, last16 = (48 + l15) << 2;
    for (int unit = gw; unit < BATCH * SG * S5NC; unit += NGW) {
        const int n = unit & (S5NC - 1), g = (unit >> 5) & 63, b = unit >> 11;
        float a1r[4], a1i[4], a4r[4], a4i[4], a8r[4], a8i[4], pwr[4], pwi[4];
        bf16x8 bfrag[8];
        const float dt = expf(gin(p, 14)[g]);
#pragma unroll
        for (int st = 0; st < 4; ++st) { const int ps = 16 * st + l15;
            const float are = gin(p, 7)[g * SP + ps], aim = gin(p, 8)[g * SP + ps];
            const float mag = expf(dt * are); const float abr = mag * cosf(dt * aim), abi = mag * sinf(dt * aim);
            const float den = are * are + aim * aim;
            const float fre = ((abr - 1.0f) * are + abi * aim) / den, fim = (abi * are - (abr - 1.0f) * aim) / den;
            a1r[st] = abr; a1i[st] = abi; { float t2r, t2i; cmul_add(t2r, t2i, abr, abi, abr, abi, 0.f, 0.f); cmul_add(a4r[st], a4i[st], t2r, t2i, t2r, t2i, 0.f, 0.f); }
            cmul_add(a8r[st], a8i[st], a4r[st], a4i[st], a4r[st], a4i[st], 0.f, 0.f);
            float qr = 1.f, qi = 0.f;
            if (g4 & 1) { qr = a4r[st]; qi = a4i[st]; }
            if (g4 & 2) { float tr, ti; cmul_add(tr, ti, qr, qi, a8r[st], a8i[st], 0.f, 0.f); qr = tr; qi = ti; }
            pwr[st] = qr; pwi[st] = qi;
            const float* br = gin(p, 9) + ((size_t)g * SP + ps) * SGC + 8 * (g4 & 1); const float* bi = gin(p, 10) + ((size_t)g * SP + ps) * SGC + 8 * (g4 & 1);
            const f32x4 r0 = *(const f32x4*)br, r1 = *(const f32x4*)(br + 4), i0 = *(const f32x4*)bi, i1 = *(const f32x4*)(bi + 4);
            const float z = (g4 < 2) ? 1.0f : 0.0f; const float fr2 = fre * z, fi2 = fim * z;
            bfrag[st] = pack8(r0 * fr2 - i0 * fi2, r1 * fr2 - i1 * fi2); bfrag[st + 4] = pack8(i0 * fr2 + r0 * fi2, i1 * fr2 + r1 * fi2);
        }
        float sr[4], si[4];
        float* Eu = E + ((size_t)(b * SG + g) * S5NC + n) * 128;
        bf16x8 cf[4]; f32x4 dsk = (f32x4){0.f, 0.f, 0.f, 0.f};
#pragma unroll
        for (int st = 0; st < 4; ++st) { sr[st] = 0.f; si[st] = 0.f; }
        if (OUT) {
#pragma unroll
            for (int st = 0; st < 4; ++st) { sr[st] = Eu[16 * st + l15]; si[st] = Eu[64 + 16 * st + l15]; }
#pragma unroll
            for (int s = 0; s < 4; ++s) { const float* cp = (s < 2 ? gin(p, 11) : gin(p, 12)) + ((size_t)g * SGC + l15) * SP + 32 * (s & 1) + 8 * g4; const float sg = s < 2 ? 1.0f : -1.0f;
                const f32x4 c0 = *(const f32x4*)cp * sg, c1 = *(const f32x4*)(cp + 4) * sg; cf[s] = pack8(c0, c1); }
            dsk = *(const f32x4*)(gin(p, 13) + g * SGC + 4 * g4); }
        const size_t tok0 = (size_t)b * SEQ + (size_t)n * S5L;
        u32x4 pre[2];
        { const bf16* src = X + (tok0 + lane) * D + g * SGC; pre[0] = *(const u32x4*)src; pre[1] = *(const u32x4*)(src + 8); }
        for (int sub = 0; sub < S5L / 64; ++sub) {
            *(LAS u32x4*)(ut + lane * 16) = pre[0]; *(LAS u32x4*)(ut + lane * 16 + 8) = pre[1];
            if (sub + 1 < S5L / 64) { const bf16* src = X + (tok0 + (sub + 1) * 64 + lane) * D + g * SGC; pre[0] = *(const u32x4*)src; pre[1] = *(const u32x4*)(src + 8); }
            LDS_WAIT(); asm volatile("" ::: "memory");
#pragma unroll (OUT ? 1 : 4)
            for (int blk = 0; blk < 4; ++blk) {
                u32x4 uw = *(const LAS u32x4*)(ut + (blk * 16 + l15) * 16 + 8 * (g4 & 1));
                if (g4 >= 2) uw = (u32x4){0u, 0u, 0u, 0u};
                const bf16x8 ufr = __builtin_bit_cast(bf16x8, uw);
                f32x4 dr[4], di[4];
#pragma unroll
                for (int st = 0; st < 4; ++st) { dr[st] = MFMA16(ufr, bfrag[st], ((f32x4){0.f, 0.f, 0.f, 0.f})); di[st] = MFMA16(ufr, bfrag[st + 4], ((f32x4){0.f, 0.f, 0.f, 0.f})); }
                float vr[4], vi[4];
#pragma unroll
                for (int st = 0; st < 4; ++st) {
                    float hr = 0.f, hi = 0.f;
#pragma unroll
                    for (int i = 0; i < 4; ++i) { float nr, ni; cmul_add(nr, ni, a1r[st], a1i[st], hr, hi, dr[st][i], di[st][i]); hr = nr; hi = ni; dr[st][i] = hr; di[st][i] = hi; }
                    vr[st] = hr; vi[st] = hi; }
#define BPF(idx, v) __builtin_bit_cast(float, __builtin_amdgcn_ds_bpermute((idx), __builtin_bit_cast(int, (v))))
                { float xr[4], xi[4];
#pragma unroll
                  for (int st = 0; st < 4; ++st) { xr[st] = BPF(up16, vr[st]); xi[st] = BPF(up16, vi[st]); }
#pragma unroll
                  for (int st = 0; st < 4; ++st) { float tr, ti; cmul_add(tr, ti, a4r[st], a4i[st], xr[st], xi[st], vr[st], vi[st]); if (g4 >= 1) { vr[st] = tr; vi[st] = ti; } }
#pragma unroll
                  for (int st = 0; st < 4; ++st) { xr[st] = BPF(up32, vr[st]); xi[st] = BPF(up32, vi[st]); }
#pragma unroll
                  for (int st = 0; st < 4; ++st) { float tr, ti; cmul_add(tr, ti, a8r[st], a8i[st], xr[st], xi[st], vr[st], vi[st]); if (g4 >= 2) { vr[st] = tr; vi[st] = ti; } } }
                float er[4], ei[4], lr[4], li[4];
#pragma unroll
                for (int st = 0; st < 4; ++st) { if (OUT) { er[st] = BPF(up16, vr[st]); ei[st] = BPF(up16, vi[st]); } else { er[st] = 0.f; ei[st] = 0.f; } lr[st] = BPF(last16, vr[st]); li[st] = BPF(last16, vi[st]); }
#undef BPF
#pragma unroll
                for (int st = 0; st < 4; ++st) {
                    if (g4 == 0) { er[st] = 0.f; ei[st] = 0.f; }
                    if (OUT) { float s0r, s0i; cmul_add(s0r, s0i, pwr[st], pwi[st], sr[st], si[st], er[st], ei[st]);
#pragma unroll
                        for (int i = 0; i < 4; ++i) { float tr, ti; cmul_add(tr, ti, a1r[st], a1i[st], s0r, s0i, 0.f, 0.f); s0r = tr; s0i = ti; dr[st][i] += s0r; di[st][i] += s0i; } }
                    { float a16r, a16i; cmul_add(a16r, a16i, a8r[st], a8i[st], a8r[st], a8i[st], 0.f, 0.f); float tr, ti; cmul_add(tr, ti, a16r, a16i, sr[st], si[st], lr[st], li[st]); sr[st] = tr; si[st] = ti; }
                    if (OUT) {
#pragma unroll
                        for (int i = 0; i < 4; ++i) { const unsigned hw = pk2(dr[st][i], di[st][i]); Hb[(4 * g4 + i) * HLD + 16 * st + l15] = (bf16)hw; Hb[(4 * g4 + i) * HLD + 64 + 16 * st + l15] = (bf16)(hw >> 16); } }
                }
                if (OUT) {
                    LDS_WAIT(); asm volatile("" ::: "memory");
                    f32x4 ya = (f32x4){0.f, 0.f, 0.f, 0.f};
#pragma unroll
                    for (int s = 0; s < 4; ++s) ya = MFMA16(cf[s], row_frag(Hb, HLD, 0, 32 * s, lane), ya);
                    const u32x2 u2 = *(const LAS u32x2*)(ut + (blk * 16 + l15) * 16 + 4 * g4);
                    const f32x4 u4 = (f32x4){bflo(u2.x), bfhi(u2.x), bflo(u2.y), bfhi(u2.y)};
                    f32x4 y = ya + dsk * u4;
#pragma unroll
                    for (int j = 0; j < 4; ++j) { const float v = y[j]; y[j] = v * fsig(1.5957691216057308f * (v + 0.044715f * v * v * v)); }
                    *(unsigned*)((unsigned char*)ybuf + (size_t)(tok0 + sub * 64 + blk * 16 + l15) * D + g * SGC + 4 * g4) = pk4_fp8(y[0] * A_SCALE, y[1] * A_SCALE, y[2] * A_SCALE, y[3] * A_SCALE);
                    asm volatile("" ::: "memory"); }
            }
            LDS_WAIT(); asm volatile("" ::: "memory");
        }
        if (!OUT && g4 == 0) {
#pragma unroll
            for (int st = 0; st < 4; ++st) { Eu[16 * st + l15] = sr[st]; Eu[64 + 16 * st + l15] = si[st]; } }
    }
}
__device__ __forceinline__ void phase_s5_carry(const Frame& F, KP p) {
    float* E = (float*)(F.ws + WS_AUX + AUX_S5E);
    for (int gt = F.vcu * NTHREADS + F.tid; gt < BATCH * SG * SP; gt += F.G * NTHREADS) {
        const int pl = gt & 63, bg = gt >> 6, g = bg & 63;
        const float dt = expf(gin(p, 14)[g]); const float are = gin(p, 7)[g * SP + pl], aim = gin(p, 8)[g * SP + pl];
        const float mag = expf(dt * are); float ar = mag * cosf(dt * aim), ai = mag * sinf(dt * aim);
#pragma unroll
        for (int q = 0; q < 8; ++q) { const float nr = ar * ar - ai * ai, ni = 2.0f * ar * ai; ar = nr; ai = ni; }
        float cr = 0.f, ci = 0.f;
        for (int n = 0; n < S5NC; ++n) { float* Eu = E + ((size_t)bg * S5NC + n) * 128; const float er = Eu[pl], ei = Eu[64 + pl];
            Eu[pl] = cr; Eu[64 + pl] = ci;
            const float nr = ar * cr - ai * ci + er, ni = ar * ci + ai * cr + ei; cr = nr; ci = ni; }
    }
}

constexpr int NPHASES = 34;
#ifndef PROBE_DRY14
#define PROBE_DRY14 0
#endif
#ifndef PROBE_DRY17
#define PROBE_DRY17 0
#endif
#ifndef PH_MASK
#define PH_MASK 0xFFFFFFFFu
#endif
#define PHT(t) ((PH_MASK >> (t)) & 1u)
constexpr int PLAN_OFF = 64;
__device__ __forceinline__ void moe_plan(const Frame& F, int layer) {
    volatile LAS int* tstart = (volatile LAS int*)(F.MISC + PLAN_OFF); volatile LAS int* cnts = tstart + 72;
    __syncthreads();
    if (F.wave == 0) {
        const unsigned* cnt = (const unsigned*)(F.ws + WS_CTL) + CW_CNT + layer * NE * 64;
        const int c = (int)__hip_atomic_load(cnt + F.lane * 64, __ATOMIC_RELAXED, __HIP_MEMORY_SCOPE_AGENT);
        int v = (c + 255) >> 8;
#pragma unroll
        for (int o = 1; o < 64; o <<= 1) { const int nb = __builtin_amdgcn_ds_bpermute((F.lane - o) << 2, v); if (F.lane >= o) v += nb; }
        tstart[F.lane + 1] = v; cnts[F.lane] = c;
        if (F.lane == 0) tstart[0] = 0;
        if (F.lane == 63) { tstart[65] = v + T / 256; cnts[64] = T; }
    }
    __syncthreads();
}
template <bool GATH> struct MoeSched2 {
    static constexpr bool GATHER = GATH, UNIFORMIZE = true, FP8 = true;
    static constexpr int ncol = GATH ? 2 : 4, K = GATH ? D / 2 : ED / 2;
    const volatile LAS int* tstart; const volatile LAS int* cnts; int ntiles, G, c, lane;
    const char* Abase; const char* Wbase; const int* lists;
    __device__ __forceinline__ bool next(int i, pg8::UnitG& u) const {
        const int nwg = ntiles * ncol; const long L = (long)i * G + c; if (L >= nwg) return false;
        int wgid = (int)L; { const int q = nwg / 8, r = nwg % 8, xcd = wgid % 8, off = wgid / 8; wgid = (xcd < r ? xcd * (q + 1) : r * (q + 1) + (xcd - r) * q) + off; }
        const int tile = wgid / ncol, pn = wgid % ncol;
        int ln; { unsigned o2 = ~0u; asm volatile("" : "+s"(o2)); ln = (int)__builtin_amdgcn_mbcnt_hi(o2, __builtin_amdgcn_mbcnt_lo(o2, 0u)); }
        const int ta = tstart[ln], tb = tstart[ln + 1];
        const unsigned long long mm = __ballot(ta <= tile && tile < tb);
        const int e = mm ? (int)__builtin_ctzll(mm) : 64;
        const int ts = __builtin_amdgcn_readfirstlane((int)tstart[e]), ce = __builtin_amdgcn_readfirstlane((int)cnts[e]);
        const int lt = tile - ts; int valid = ce - lt * 256; valid = valid > 256 ? 256 : valid;
        u.gshift = 0; u.aux = e;
        if (GATH) {
            u.B = Wbase + (size_t)e * WMOE_E_BYTES + (size_t)pn * 256 * K * 2;
            if (e < 64) { u.A = Abase; u.gidx = lists + (size_t)e * T + lt * 256; u.gcnt = valid; }
            else { u.A = Abase + (size_t)lt * 256 * K * 2; u.gidx = nullptr; u.gcnt = 0; }
            u.row0 = tile * 256; u.col0 = pn * 128;
        } else {
            u.B = Wbase + (size_t)e * WMOE_E_BYTES + (size_t)512 * 1024 * 2 + (size_t)pn * 256 * K * 2;
            u.A = Abase + (size_t)tile * 256 * K * 2; u.gidx = nullptr; u.gcnt = valid;
            u.row0 = tile * 256; u.col0 = pn * 256;
        }
        return true;
    }
};
__device__ __forceinline__ void phase_load_x(const Frame& F, KP p) {
    const float* xin = gin(p, 0); bf16* XB = (bf16*)(F.ws + WS_XB);
    for (size_t i = (size_t)F.vcu * NTHREADS + F.tid; i < (size_t)T * D / 8; i += (size_t)F.G * NTHREADS) {
        const f32x4 a = *(const f32x4*)(xin + i * 8), b = *(const f32x4*)(xin + i * 8 + 4);
        *(u32x4*)(XB + i * 8) = pack_bf16x8(a, b);
        u32x2 q8; q8.x = pk4_fp8(a[0], a[1], a[2], a[3]); q8.y = pk4_fp8(b[0], b[1], b[2], b[3]); *(u32x2*)((unsigned char*)(F.ws + WS_X) + i * 8) = q8; }
}

__global__ void __launch_bounds__(NTHREADS, 2) fwd_kernel(Params p_unused) {
    KP p0 = (KP)__builtin_amdgcn_kernarg_segment_ptr();
    extern __shared__ __attribute__((aligned(16))) unsigned char lds_raw[];
    Frame F0;
    F0.lds = (LAS unsigned char*)lds_raw; F0.MISC = (volatile LAS unsigned*)(F0.lds + MISC_OFF);
    F0.tid = threadIdx.x; F0.lane = F0.tid & 63; F0.wave = __builtin_amdgcn_readfirstlane(F0.tid >> 6);
    F0.G = gridDim.x; { const int bq = blockIdx.x; F0.vcu = (F0.G % 8 == 0) ? (bq % 8) * (F0.G / 8) + bq / 8 : bq; }
    F0.ws = p0->ws;
    const int bx0 = blockIdx.x;
    for (int u = F0.tid; u < (LDS_BYTES - MISC_OFF) / 4; u += NTHREADS) ((LAS unsigned*)(F0.lds + MISC_OFF))[u] = 0u;
    __syncthreads();
    XcdBarrier bar; bar.bar = (unsigned*)(p0->ws + WS_CTL) + CW_BAR; bar.x = 0; bar.st = nullptr;
    const int use_bar = p0->use_bar;
    if (use_bar) bar = xcd_barrier_post((unsigned*)(p0->ws + WS_CTL) + CW_BAR, F0.MISC + 8);
    const int lo = p0->ph_lo, hi = p0->ph_hi;
#define PHASE_BEGIN Frame F = F0; KP p = p0; { unsigned ones_ = ~0u; asm volatile("" : "+s"(ones_)); F.lane = (int)__builtin_amdgcn_mbcnt_hi(ones_, __builtin_amdgcn_mbcnt_lo(ones_, 0u)); } asm volatile("" : "+v"(F.lane)); F.tid = F.wave * 64 + F.lane; asm volatile("" : "+v"(F.tid));   GAS unsigned char* wsg_ = (GAS unsigned char*)F0.ws; asm volatile("" : "+s"(F.wave), "+s"(F.vcu), "+s"(F.G), "+s"(wsg_), "+s"(p)); \
    F.ws = (unsigned char*)wsg_; int bx = bx0; asm volatile("" : "+s"(bx)); unsigned char* ws = F.ws; (void)ws; (void)bx;
#pragma unroll 1
    for (int ph = lo; ph < hi; ++ph) {
        int layer = 0, type = 0;
        if (ph > 0) { layer = ph >= 26 ? 3 : (ph >= 18 ? 2 : (ph >= 9 ? 1 : 0)); const int q = ph - (layer == 3 ? 26 : (layer == 2 ? 18 : (layer == 1 ? 9 : 1))); const int kind = layer % 3;
            if (kind == 0) type = q < 4 ? 1 + q : 14 + (q - 4); else if (kind == 1) type = q < 5 ? 5 + q : 14 + (q - 5); else type = q < 4 ? 10 + q : 14 + (q - 4); }
        const int j = layer / 3;
#ifdef REPEAT_MASK
        const int nrep = ((REPEAT_MASK >> type) & 1u) ? 2 : 1;
#else
        const int nrep = 1;
#endif
#pragma unroll 1
        for (int rep = 0; rep < nrep; ++rep) {
        if (rep > 0 && use_bar) xcd_barrier(bar);
        if (PHT(0) && type == 0) { PHASE_BEGIN; phase_conv_mixers(F, p); phase_conv_moe(F, p, 0); phase_load_x(F, p); }
        else if (PHT(1) && type == 1) { PHASE_BEGIN; DenseSched8 S; S.init(ws + WS_X, ws + WS_ATT_IN_T + (size_t)j * ATT_IN * D, T, ATT_IN, D / 2, F.G, bx); EpiStoreQkv8 E{(unsigned char*)(ws + WS_BIG), ATT_IN};
            pg8::gemm_phase(F.lds, F.tid, D / 2, S, E); }
        else if (PHT(2) && type == 2) { PHASE_BEGIN; phase_attn(F, bx); }
        else if (PHT(3) && type == 3) { PHASE_BEGIN; phase_attn_combine(F); }
        else if (PHT(4) && type == 4) { PHASE_BEGIN; DenseSched8 S; S.init(ws + WS_AUX + AUX_OB, ws + WS_ATT_OUT_T + (size_t)j * D * D, T, D, D / 2, F.G, bx); EpiResid8 E{(const bf16*)(ws + WS_XB), (bf16*)(ws + WS_Y), 1.0f / (A_SCALE * WUP_SCALE)};
            pg8::gemm_phase(F.lds, F.tid, D / 2, S, E); }
        else if (PHT(5) && type == 5) { PHASE_BEGIN; DenseSched8 S; S.init(ws + WS_X, ws + WS_RET_IN_T, T, RET_IN, D / 2, F.G, bx); EpiRetIn E{(unsigned char*)(ws + WS_BIG), RET_IN};
            pg8::gemm_phase(F.lds, F.tid, D / 2, S, E); }
        else if (PHT(6) && type == 6) { PHASE_BEGIN; phase_ret_u(F); }
        else if (PHT(7) && type == 7) { PHASE_BEGIN; phase_ret_scan(F); }
        else if (PHT(8) && type == 8) { PHASE_BEGIN; phase_ret_out(F, p); }
        else if (PHT(9) && type == 9) { PHASE_BEGIN; DenseSched8 S; S.init(ws + WS_BIG + BIG_YRET, ws + WS_RET_OUT_T, T, D, RET_V / 2, F.G, bx); EpiResid8 E{(const bf16*)(ws + WS_XB), (bf16*)(ws + WS_Y), 1.0f / (A_SCALE * WUP_SCALE)};
            pg8::gemm_phase(F.lds, F.tid, RET_V / 2, S, E); }
        else if (PHT(10) && type == 10) { PHASE_BEGIN; phase_s5_scan<false>(F, p); }
        else if (PHT(11) && type == 11) { PHASE_BEGIN; phase_s5_carry(F, p); }
        else if (PHT(12) && type == 12) { PHASE_BEGIN; phase_s5_scan<true>(F, p); }
        else if (PHT(13) && type == 13) { PHASE_BEGIN; DenseSched8 S; S.init(ws + WS_AUX, ws + WS_GLU_T, T, 2 * D, D / 2, F.G, bx); EpiGluResid E{(const bf16*)(ws + WS_XB), (bf16*)(ws + WS_Y), 1.0f / (A_SCALE * WUP_SCALE)};
            pg8::gemm_phase(F.lds, F.tid, D / 2, S, E); }
        else if (PHT(14) && type == 14) { PHASE_BEGIN; phase_lnr(F, p, layer, PROBE_DRY14 && true); if (PROBE_DRY14) { if (use_bar) xcd_barrier(bar); phase_lnr(F, p, layer, false); } }
        else if (PHT(15) && type == 15) { PHASE_BEGIN; moe_plan(F, layer);
            MoeSched2<true> S; S.tstart = (const volatile LAS int*)(F.MISC + PLAN_OFF); S.cnts = S.tstart + 72; S.ntiles = __builtin_amdgcn_readfirstlane((int)S.tstart[65]); S.G = F.G; S.c = bx; S.lane = F.lane;
            S.Abase = (const char*)(ws + WS_X); S.Wbase = (const char*)(ws + WS_WMOE); S.lists = (const int*)(ws + WS_LIST);
            EpiMoeUp E{(unsigned char*)(ws + WS_H)};
            pg8::gemm_phase(F.lds, F.tid, D / 2, S, E); }
        else if (PHT(16) && type == 16) { PHASE_BEGIN; moe_plan(F, layer);
            { MoeSched2<false> S; S.tstart = (const volatile LAS int*)(F.MISC + PLAN_OFF); S.cnts = S.tstart + 72; S.ntiles = __builtin_amdgcn_readfirstlane((int)S.tstart[64]); S.G = F.G; S.c = bx; S.lane = F.lane;
              S.Abase = (const char*)(ws + WS_H); S.Wbase = (const char*)(ws + WS_WMOE); S.lists = (const int*)(ws + WS_LIST);
              EpiStoreFp8 E{(unsigned char*)(ws + WS_BIG), D};
              pg8::gemm_phase(F.lds, F.tid, ED / 2, S, E); }
            { const int sh0 = __builtin_amdgcn_readfirstlane((int)((const volatile LAS int*)(F.MISC + PLAN_OFF))[64]);
              DenseSched8 S; S.init(ws + WS_H + (size_t)sh0 * 256 * ED, ws + WS_WMOE + (size_t)64 * WMOE_E_BYTES + (size_t)512 * 1024 * 2, T, D, ED / 2, F.G, bx); EpiResid8 E{(const bf16*)(ws + WS_XB), (bf16*)(ws + WS_Y), 1.0f / (H_SCALE * WUP_SCALE)};
              int tid2; { unsigned o2 = ~0u; asm volatile("" : "+s"(o2)); tid2 = F.wave * 64 + (int)__builtin_amdgcn_mbcnt_hi(o2, __builtin_amdgcn_mbcnt_lo(o2, 0u)); }
              pg8::gemm_phase(F.lds, tid2, ED / 2, S, E); } }
        else if (PHT(17) && type == 17) { PHASE_BEGIN; moe_plan(F, layer); if (PROBE_DRY17) { phase_combine(F, p, layer, true); if (use_bar) xcd_barrier(bar); } phase_combine(F, p, layer); if (layer + 1 < DEPTH) phase_conv_moe(F, p, layer + 1); }
        }
        if (use_bar && ph + 1 < hi) xcd_barrier(bar);
    }
}

#ifndef MK_PER_PHASE
#define MK_PER_PHASE 0
#endif
extern "C" void kernel_launch(void* const* d_in, const int* in_sizes, int n_in, void* d_out, int out_size, void* d_ws, size_t ws_size, hipStream_t stream) {
    static int grid = 0;
    if (grid == 0) {
        if (n_in != 26 || in_sizes[0] != T * D || out_size != T * D || ws_size < WS_END) { fprintf(stderr, "kernel_launch: unexpected shapes / workspace (n_in %d, in0 %d, out %d, ws %zu < %zu)\n", n_in, n_in > 0 ? in_sizes[0] : -1, out_size, ws_size, (size_t)WS_END); grid = -1; return; }
        int dev = 0, cus = 0, per_cu = 0;
        if (hipGetDevice(&dev) != hipSuccess || hipDeviceGetAttribute(&cus, hipDeviceAttributeMultiprocessorCount, dev) != hipSuccess) { grid = -1; return; }
        if (hipFuncSetAttribute((const void*)fwd_kernel, hipFuncAttributeMaxDynamicSharedMemorySize, LDS_BYTES) != hipSuccess) { fprintf(stderr, "kernel_launch: hipFuncSetAttribute failed\n"); grid = -1; return; }
        if (hipOccupancyMaxActiveBlocksPerMultiprocessor(&per_cu, (const void*)fwd_kernel, NTHREADS, LDS_BYTES) != hipSuccess || per_cu < 1) { fprintf(stderr, "kernel_launch: occupancy query says %d blocks per CU\n", per_cu); per_cu = 1; }
        (void)hipGetLastError();
        grid = cus;
    }
    if (grid < 0) return;
    (void)hipMemsetAsync((char*)d_ws + WS_CTL, 0, CTL_ZERO_BYTES, stream);
    Params p{};
    for (int i = 0; i < 26; ++i) p.in[i] = (const float*)d_in[i];
    p.out = (float*)d_out; p.ws = (unsigned char*)d_ws;
#if MK_PER_PHASE
    for (int k = 0; k < NPHASES; ++k) { p.ph_lo = k; p.ph_hi = k + 1; p.use_bar = 0; hipLaunchKernelGGL(fwd_kernel, dim3(grid), dim3(NTHREADS), LDS_BYTES, stream, p); }
#else
    p.ph_lo = 0; p.ph_hi = NPHASES; p.use_bar = 1;
    hipLaunchKernelGGL(fwd_kernel, dim3(grid), dim3(NTHREADS), LDS_BYTES, stream, p);
#endif
}
```

```cpp
#include <hip/hip_runtime.h>
#include <cstdio>
#include <cstdint>

#define LAS __attribute__((address_space(3)))
#define GAS __attribute__((address_space(1)))
typedef unsigned short bf16;
typedef short bf16x8 __attribute__((ext_vector_type(8)));
typedef short bf16x4 __attribute__((ext_vector_type(4)));
typedef float f32x4 __attribute__((ext_vector_type(4)));
typedef float f32x2 __attribute__((ext_vector_type(2)));
typedef unsigned u32x4 __attribute__((ext_vector_type(4)));
typedef unsigned u32x2 __attribute__((ext_vector_type(2)));
typedef GAS unsigned gu32;

constexpr int D = 1024, BATCH = 2, SEQ = 8192, T = BATCH * SEQ, DEPTH = 4;
constexpr int AH = 8, AHD = 128, ATT_IN = 9216;
constexpr int RH = 4, RDK = 256, RDV = 512, RET_IN = 6144, RET_V = 2048, RC = 128, RNC = SEQ / RC;
constexpr int SG = 64, SGC = 16, SP = 64;
constexpr int NE = 64, TOPK = 8, NEG = 8, ED = 256, NSLOT = 9;
constexpr float LN_EPS = 1e-5f;
constexpr float ALPHA = 1.6817928305074292f;
constexpr int NWAVES = 8, NTHREADS = 512;

__device__ __forceinline__ unsigned f2bf(float f) { unsigned u = __builtin_bit_cast(unsigned, f); return (u + 0x7fffu + ((u >> 16) & 1u)) >> 16; }
__device__ __forceinline__ unsigned pk2(float lo, float hi) { unsigned r; asm("s_nop 1\n\tv_cvt_pk_bf16_f32 %0, %1, %2" : "=v"(r) : "v"(lo), "v"(hi)); return r; }
__device__ __forceinline__ unsigned pk2sw(float lo, float hi) { return f2bf(lo) | (f2bf(hi) << 16); }
__device__ __forceinline__ unsigned pk2hw(float lo, float hi) { unsigned r; asm volatile("v_cvt_pk_bf16_f32 %0, %1, %2" : "=v"(r) : "v"(lo), "v"(hi)); return r; }
__device__ __forceinline__ float bf2f(unsigned b) { return __builtin_bit_cast(float, b << 16); }
__device__ __forceinline__ float bflo(unsigned w) { return __builtin_bit_cast(float, w << 16); }
__device__ __forceinline__ float bfhi(unsigned w) { return __builtin_bit_cast(float, w & 0xffff0000u); }
__device__ __forceinline__ float shx(float v, int m, int lane) { return __builtin_bit_cast(float, __builtin_amdgcn_ds_bpermute((lane ^ m) << 2, __builtin_bit_cast(int, v))); }
__device__ __forceinline__ int shx_i(int v, int m, int lane) { return __builtin_amdgcn_ds_bpermute((lane ^ m) << 2, v); }
__device__ __forceinline__ float rdl(float v, int src) { return __builtin_bit_cast(float, __builtin_amdgcn_readlane(__builtin_bit_cast(int, v), src)); }
template <int CTRL, int RM = 0xf, int BM = 0xf> __device__ __forceinline__ float dpp0(float v) { return __builtin_bit_cast(float, __builtin_amdgcn_update_dpp(0, __builtin_bit_cast(int, v), CTRL, RM, BM, true)); }
template <int CTRL, int RM = 0xf, int BM = 0xf> __device__ __forceinline__ float dppo(float old, float v) { return __builtin_bit_cast(float, __builtin_amdgcn_update_dpp(__builtin_bit_cast(int, old), __builtin_bit_cast(int, v), CTRL, RM, BM, false)); }
__device__ __forceinline__ float wave_sum(float v, int lane) {
    (void)lane;
    v += dpp0<0x111>(v); v += dpp0<0x112>(v); v += dpp0<0x114>(v); v += dpp0<0x118>(v);
    v += dpp0<0x142, 0xa>(v);
    v += dpp0<0x143, 0xc>(v);
    return rdl(v, 63);
}
__device__ __forceinline__ unsigned wave_umax(unsigned v) {
#define WU_DPP(ctrl, rm) (unsigned)__builtin_amdgcn_update_dpp(0, (int)v, ctrl, rm, 0xf, true)
    { const unsigned t = WU_DPP(0x111, 0xf); v = v > t ? v : t; } { const unsigned t = WU_DPP(0x112, 0xf); v = v > t ? v : t; } { const unsigned t = WU_DPP(0x114, 0xf); v = v > t ? v : t; } { const unsigned t = WU_DPP(0x118, 0xf); v = v > t ? v : t; }
    { const unsigned t = WU_DPP(0x142, 0xa); v = v > t ? v : t; } { const unsigned t = WU_DPP(0x143, 0xc); v = v > t ? v : t; }
#undef WU_DPP
    return (unsigned)__builtin_amdgcn_readlane((int)v, 63);
}
__device__ __forceinline__ float max8(float v) {
    v = fmaxf(v, dppo<0xb1>(v, v)); v = fmaxf(v, dppo<0x4e>(v, v)); v = fmaxf(v, dppo<0x141>(v, v)); return v;
}
__device__ __forceinline__ float fsig(float x) { return __builtin_amdgcn_rcpf(1.0f + __expf(-x)); }
#define LDS_WAIT() asm volatile("s_waitcnt lgkmcnt(0)" ::: "memory")
#define VM_WAIT() asm volatile("s_waitcnt vmcnt(0)" ::: "memory")
__device__ __forceinline__ const char* rfl_ptr(const char* p) {
    unsigned long long v = (unsigned long long)p; unsigned lo = __builtin_amdgcn_readfirstlane((unsigned)v), hi = __builtin_amdgcn_readfirstlane((unsigned)(v >> 32));
    return (const char*)(((unsigned long long)hi << 32) | lo);
}
__device__ __forceinline__ bf16x8 row_frag(const LAS bf16* base, int ld, int row0, int col0, int lane) {
    return *(const LAS bf16x8*)(base + (row0 + (lane & 15)) * ld + col0 + 8 * (lane >> 4));
}
__device__ __forceinline__ bf16x4 tr4(const LAS bf16* addr) { return __builtin_amdgcn_ds_read_tr16_b64_v4i16((LAS bf16x4*)addr); }
__device__ __forceinline__ bf16x8 cat8(bf16x4 a, bf16x4 b) { bf16x8 r; r[0] = a[0]; r[1] = a[1]; r[2] = a[2]; r[3] = a[3]; r[4] = b[0]; r[5] = b[1]; r[6] = b[2]; r[7] = b[3]; return r; }
#define MFMA16(a, b, c) __builtin_amdgcn_mfma_f32_16x16x32_bf16((a), (b), (c), 0, 0, 0)
__device__ __forceinline__ bf16x8 pack8(f32x4 a, f32x4 b) {
    u32x4 w; w.x = pk2(a[0], a[1]); w.y = pk2(a[2], a[3]); w.z = pk2(b[0], b[1]); w.w = pk2(b[2], b[3]); return __builtin_bit_cast(bf16x8, w);
}

namespace pg8 {
typedef int v4i_t __attribute__((ext_vector_type(4)));
typedef int v8i_t __attribute__((ext_vector_type(8)));
constexpr int BM = 256, BK = 64, HALF = 128, HTB = HALF * BK * 2, STAGE_BYTES = 8 * HTB;
__device__ __forceinline__ int lds_byte(int r, int c) { const int st = (r >> 4) * 2 + (c >> 5), rr = r & 15, cc = c & 31, ob = rr * 64 + cc * 2; return st * 1024 + (ob ^ (((ob >> 9) & 1) << 5)); }
__device__ __forceinline__ void stage_rc(int b, int& R, int& C) { const int st = b / 1024, sb = b % 1024, swz = sb ^ (((sb >> 9) & 1) << 5); R = (st >> 1) * 16 + swz / 64; C = (st & 1) * 32 + (swz % 64) / 2; }
__device__ __forceinline__ int perm32(int rho) { const int n = rho >> 4, i = rho & 15; return 8 * (i >> 2) + 4 * n + (i & 3); }

struct UnitG {
    const char* A;
    const char* B;
    const int* gidx;
    int gcnt, gshift;
    int row0, col0;
    int aux;
};

__device__ __forceinline__ void uniformize(UnitG& u) { u.A = rfl_ptr(u.A); u.B = rfl_ptr(u.B); u.gidx = (const int*)rfl_ptr((const char*)u.gidx); u.gcnt = __builtin_amdgcn_readfirstlane(u.gcnt); u.gshift = __builtin_amdgcn_readfirstlane(u.gshift);
    u.row0 = __builtin_amdgcn_readfirstlane(u.row0); u.col0 = __builtin_amdgcn_readfirstlane(u.col0); u.aux = __builtin_amdgcn_readfirstlane(u.aux); }
template <class Epi, class Sched>
__device__ __forceinline__ void gemm_phase(LAS unsigned char* lds, const int tid, const int K, const Sched& S, const Epi& E) {
    constexpr bool F8 = Sched::FP8;
    constexpr bool GATHER = Sched::GATHER;
    const int wid = __builtin_amdgcn_readfirstlane(tid >> 6), lane = tid & 63, wr = wid >> 2, wc = wid & 3, fr = lane & 15, fq = lane >> 4;
    int nt = K / BK; asm volatile("" : "+s"(nt));
    constexpr bool P16 = Epi::PERM16;
    unsigned voffB[2], voffB1[2], vA[2][2];
#pragma unroll
    for (int i = 0; i < 2; ++i) { int R, C; stage_rc(tid * 16 + i * 8192, R, C); const int Rb = Epi::PERM ? ((R & ~31) + perm32(R & 31)) : R; voffB[i] = (unsigned)(Rb * K + C) * 2u; voffB1[i] = voffB[i]; vA[0][i] = (unsigned)(R * K + C) * 2u; vA[1][i] = vA[0][i];
        if constexpr (P16) { const int x = R & 31, src = 64 * (R >> 5) + 16 * ((x >> 2) & 3) + 4 * (x >> 4) + (x & 3); voffB[i] = (unsigned)(src * K + C) * 2u; voffB1[i] = (unsigned)((src + 8) * K + C) * 2u; } }
    const size_t kstep = (size_t)(BK * 2);
    const size_t hstep = (size_t)HALF * K * 2;
    const size_t hstepB = P16 ? 0 : hstep;
    const size_t hstepA = GATHER ? 0 : hstep;
    const size_t hstepB1 = P16 ? (size_t)8 * K * 2 : hstep, bstep = (size_t)(P16 ? 128 : 64) * K * 2, astep = (size_t)64 * K * 2;
    unsigned vB0 = voffB[0], vA0 = vA[0][0];
    const unsigned ldsw = (unsigned)wid * 1024u;
    const int aoff = lds_byte(wr * 64 + fr, fq * 8), boff = lds_byte(wc * 32 + fr, fq * 8);
    LAS u32x4* park = (LAS u32x4*)(lds + STAGE_BYTES) + tid;
#define PG8_SA(b, h) (((b) * 2 + (h)) * HTB)
#define PG8_SB(b, h) ((4 + (b) * 2 + (h)) * HTB)
#define PG8_STAGE(bufoff, gbase, voff) do { _Pragma("unroll") for (int _i = 0; _i < 2; ++_i) { asm volatile("" : "+v"((voff)[_i]));   \
        __builtin_amdgcn_global_load_lds((const unsigned*)((const char*)(gbase) + (voff)[_i]), (LAS unsigned*)(lds + (bufoff) + ldsw + _i * 8192), 16, 0, 0); } } while (0)
#define PG8_STAGEU(bufoff, gbase, v0, step1) do { asm volatile("" : "+v"(v0)); __builtin_amdgcn_global_load_lds((const unsigned*)((const char*)(gbase) + (v0)), (LAS unsigned*)(lds + (bufoff) + ldsw), 16, 0, 0); \
        asm volatile("" : "+v"(v0)); __builtin_amdgcn_global_load_lds((const unsigned*)((const char*)(gbase) + (step1) + (v0)), (LAS unsigned*)(lds + (bufoff) + ldsw + 8192), 16, 0, 0); } while (0)
#define PG8_STB(b, h, base) PG8_STAGEU(PG8_SB(b, h), (base) + (h) * hstepB1, vB0, bstep)
#define PG8_STA(b, h, base) do { if constexpr (GATHER) PG8_STAGE(PG8_SA(b, h), (base), vA[h]); else PG8_STAGEU(PG8_SA(b, h), (base) + (h) * hstep, vA0, astep); } while (0)
    constexpr int FKS = 1024;
#define PG8_LD2(p_) __builtin_shufflevector(*(const LAS v4i_t*)(p_), *(const LAS v4i_t*)((p_) + FKS), 0, 1, 2, 3, 4, 5, 6, 7)
#define PG8_LDA(dst, b, h) do { _Pragma("unroll") for (int m = 0; m < 4; ++m) dst[m] = PG8_LD2(lds + PG8_SA(b, h) + aoff + m * 2048); } while (0)
#define PG8_LDB(dst, b, h) do { _Pragma("unroll") for (int n = 0; n < 2; ++n) dst[n] = PG8_LD2(lds + PG8_SB(b, h) + boff + n * 2048); } while (0)
#define PG8_LO(v) __builtin_bit_cast(bf16x8, __builtin_shufflevector((v), (v), 0, 1, 2, 3))
#define PG8_HI(v) __builtin_bit_cast(bf16x8, __builtin_shufflevector((v), (v), 4, 5, 6, 7))
#define PG8_MMA(ai, bj, At, Bt) do { __builtin_amdgcn_s_setprio(1); _Pragma("unroll") for (int m = 0; m < 4; ++m) _Pragma("unroll") for (int n = 0; n < 2; ++n) { \
        if constexpr (F8) { acc[ai][bj][m][n] = __builtin_amdgcn_mfma_scale_f32_16x16x128_f8f6f4(Bt[n], At[m], acc[ai][bj][m][n], 0, 0, 0, 0x7F7F7F7F, 0, 0x7F7F7F7F); } \
        else { acc[ai][bj][m][n] = __builtin_amdgcn_mfma_f32_16x16x32_bf16(PG8_LO(Bt[n]), PG8_LO(At[m]), acc[ai][bj][m][n], 0, 0, 0); \
               acc[ai][bj][m][n] = __builtin_amdgcn_mfma_f32_16x16x32_bf16(PG8_HI(Bt[n]), PG8_HI(At[m]), acc[ai][bj][m][n], 0, 0, 0); } } __builtin_amdgcn_s_setprio(0); } while (0)
#define PG8_WAIT_V(n) asm volatile("s_waitcnt vmcnt(" #n ")" ::: "memory")
#define PG8_WAIT_L(n) asm volatile("s_waitcnt lgkmcnt(" #n ")" ::: "memory")
#define PG8_BAR __builtin_amdgcn_s_barrier()
#define PG8_SCHED __builtin_amdgcn_sched_barrier(0)
#define PG8_VOFF(u, v00, v01, v10, v11) do { int _R0, _C0, _R1, _C1; stage_rc(tid * 16, _R0, _C0); stage_rc(tid * 16 + 8192, _R1, _C1); int _r00 = _R0, _r01 = _R1, _r10 = HALF + _R0, _r11 = HALF + _R1; \
        if ((u).gidx) { const GAS int* _gp = (const GAS int*)(u).gidx; const int _gc = (u).gcnt;     \
            const int _a = _gp[_r00 < _gc ? _r00 : 0] >> (u).gshift, _b = _gp[_r01 < _gc ? _r01 : 0] >> (u).gshift, _c = _gp[_r10 < _gc ? _r10 : 0] >> (u).gshift, _d = _gp[_r11 < _gc ? _r11 : 0] >> (u).gshift; \
            _r00 = _a; _r01 = _b; _r10 = _c; _r11 = _d; } \
        v00 = (unsigned)(_r00 * K + _C0) * 2u; v01 = (unsigned)(_r01 * K + _C1) * 2u; v10 = (unsigned)(_r10 * K + _C0) * 2u; v11 = (unsigned)(_r11 * K + _C1) * 2u; } while (0)
    UnitG cur, nxt; int ui = 0;
    if (!S.next(0, cur)) return;
    if constexpr (Sched::UNIFORMIZE) uniformize(cur);
    f32x4 acc[2][2][4][2];
#pragma unroll
    for (int a = 0; a < 2; ++a)
#pragma unroll
        for (int b = 0; b < 2; ++b)
#pragma unroll
            for (int m = 0; m < 4; ++m)
#pragma unroll
                for (int n = 0; n < 2; ++n) acc[a][b][m][n] = (f32x4){0.f, 0.f, 0.f, 0.f};
    v8i_t At[4], B0[2], B1[2];
    if constexpr (GATHER) PG8_VOFF(cur, vA[0][0], vA[0][1], vA[1][0], vA[1][1]);
    const char* cA = cur.A; const char* cB = cur.B;
    PG8_STB(0, 0, cB); PG8_STB(0, 1, cB); PG8_STA(0, 0, cA); PG8_STA(0, 1, cA);
    if (wr == 1) PG8_BAR;
    PG8_WAIT_V(2); PG8_BAR;
    PG8_STB(1, 0, cB + kstep); PG8_STA(1, 0, cA + kstep); PG8_STB(1, 1, cB + kstep);
    PG8_WAIT_V(6); PG8_BAR;
    for (;;) {
        const bool has_next = S.next(ui + 1, nxt);
        if constexpr (Sched::UNIFORMIZE) { if (has_next) uniformize(nxt); }
        const char* nA = cA; const char* nB = cB;
        if (has_next) { nA = nxt.A; nB = nxt.B; }
        if constexpr (GATHER) { u32x4 pv; pv.x = vA[0][0]; pv.y = vA[0][1]; pv.z = vA[1][0]; pv.w = vA[1][1];
            if (has_next) PG8_VOFF(nxt, pv.x, pv.y, pv.z, pv.w);
            *park = pv; }
        asm volatile(".p2align 6" ::: "memory");
#pragma unroll 1
        for (int t = 0; t < nt; t += 2) {
            const bool last = (t == nt - 2);
            const char* a1 = cA + (size_t)(t + 1) * kstep;
            const char* a2 = last ? nA : cA + (size_t)(t + 2) * kstep; const char* b2 = last ? nB : cB + (size_t)(t + 2) * kstep;
            const char* a3 = a2 + kstep; const char* b3 = b2 + kstep;
            PG8_LDB(B0, 0, 0); PG8_LDB(B1, 0, 1); PG8_SCHED; PG8_LDA(At, 0, 0); PG8_STA(1, 1, a1);
            PG8_WAIT_V(8); PG8_WAIT_L(0); PG8_BAR; PG8_MMA(0, 0, At, B0); PG8_MMA(0, 1, At, B1); PG8_BAR; PG8_SCHED;
            if constexpr (GATHER) { if (last) { const u32x4 pv = *park; vA[0][0] = pv.x; vA[0][1] = pv.y; vA[1][0] = pv.z; vA[1][1] = pv.w; } }
            PG8_LDA(At, 0, 1); PG8_STB(0, 0, b2); PG8_STB(0, 1, b2); PG8_STA(0, 0, a2);
            PG8_WAIT_V(8); PG8_WAIT_L(0); PG8_BAR; PG8_MMA(1, 0, At, B0); PG8_MMA(1, 1, At, B1); PG8_BAR; PG8_SCHED;
            PG8_LDB(B0, 1, 0); PG8_LDB(B1, 1, 1); PG8_SCHED; PG8_LDA(At, 1, 0); PG8_STA(0, 1, a2);
            PG8_WAIT_V(8); PG8_WAIT_L(0); PG8_BAR; PG8_MMA(0, 0, At, B0); PG8_MMA(0, 1, At, B1); PG8_BAR; PG8_SCHED;
            PG8_LDA(At, 1, 1); PG8_STB(1, 0, b3); PG8_STB(1, 1, b3); PG8_STA(1, 0, a3);
            PG8_WAIT_V(8); PG8_WAIT_L(0); PG8_BAR; PG8_MMA(1, 0, At, B0); PG8_MMA(1, 1, At, B1); PG8_BAR; PG8_SCHED;
        }
        if (wr == 0) PG8_BAR;
        { int l2; { unsigned o2 = ~0u; asm volatile("" : "+s"(o2)); l2 = (int)__builtin_amdgcn_mbcnt_hi(o2, __builtin_amdgcn_mbcnt_lo(o2, 0u)); }
          E(acc, cur, wr, wc, l2 & 15, l2 >> 4); }
        if (!has_next) break;
#pragma unroll
        for (int a = 0; a < 2; ++a)
#pragma unroll
            for (int b = 0; b < 2; ++b)
#pragma unroll
                for (int m = 0; m < 4; ++m)
#pragma unroll
                    for (int n = 0; n < 2; ++n) acc[a][b][m][n] = (f32x4){0.f, 0.f, 0.f, 0.f};
        cur = nxt; cA = nA; cB = nB; ++ui;
        if (wr == 1) PG8_BAR;
    }
    PG8_WAIT_V(0);
    PG8_BAR;
#undef PG8_SA
#undef PG8_SB
#undef PG8_STAGE
#undef PG8_STAGEU
#undef PG8_STB
#undef PG8_STA
#undef PG8_LDA
#undef PG8_LDB
#undef PG8_LD2
#undef PG8_LO
#undef PG8_HI
#undef PG8_MMA
#undef PG8_WAIT_V
#undef PG8_WAIT_L
#undef PG8_BAR
#undef PG8_SCHED
#undef PG8_VOFF
}
}

constexpr size_t MiB = 1u << 20;
constexpr size_t WS_CTL = 0, CTL_ZERO_BYTES = 1 * MiB;
constexpr size_t WS_ATT_IN_T = 1 * MiB;
constexpr size_t WS_ATT_OUT_T = WS_ATT_IN_T + 36 * MiB;
constexpr size_t WS_RET_IN_T = WS_ATT_OUT_T + 4 * MiB;
constexpr size_t WS_RET_OUT_T = WS_RET_IN_T + 12 * MiB;
constexpr size_t WS_GLU_T = WS_RET_OUT_T + 4 * MiB;
constexpr size_t WS_RT_HI = WS_GLU_T + 4 * MiB;
constexpr size_t WS_RT_LO = WS_RT_HI + 512 * 1024;
constexpr size_t WS_WMOE = WS_RT_HI + 1 * MiB;
constexpr size_t WMOE_E_BYTES = (size_t)(512 * 1024 + 1024 * 256) * 2;
constexpr size_t WS_X = WS_WMOE + 98 * MiB;
constexpr size_t WS_Y = WS_X + 64 * MiB;
constexpr size_t WS_XB = WS_Y + 64 * MiB;
constexpr size_t WS_BIG = WS_XB + 32 * MiB;
constexpr size_t WS_AUX = WS_BIG + 288 * MiB;
constexpr size_t WS_H = WS_AUX + 160 * MiB;
constexpr size_t WS_LIST = WS_H + 80 * MiB;
constexpr size_t WS_TRASH = WS_LIST + 8 * MiB;
constexpr size_t WS_END = WS_TRASH + 1 * MiB;
static_assert(WS_END <= 1024 * MiB, "workspace map");
constexpr int CW_BAR = 4096;
constexpr int CW_CNT = 16384;
constexpr int CW_CHK = 65536;
constexpr int HROWS = 163840;

#define XB_TMO      128
#define XB_XCNT(j)  (256  + 64 * (j))
#define XB_XSUB(j)  (1280 + 64 * (j))
#define XB_XGEN(j)  (2304 + 64 * (j))
#define XB_TOP      3328
#define XB_TOPGEN   3392
#define XCD_BAR_WORDS 3456
#define XB_SPIN_CAP (1u << 20)
__device__ __forceinline__ unsigned xb_ld(unsigned* p)              { return __hip_atomic_load(p, __ATOMIC_RELAXED, __HIP_MEMORY_SCOPE_AGENT); }
__device__ __forceinline__ unsigned xb_add(unsigned* p, unsigned v) { return __hip_atomic_fetch_add(p, v, __ATOMIC_RELAXED, __HIP_MEMORY_SCOPE_AGENT); }
__device__ __forceinline__ unsigned xb_xcc_id() { return (unsigned)__builtin_amdgcn_s_getreg((3 << 11) | 20) & 0xFu; }
#define XB_SPIN(cond, bar) do { unsigned _sp = 0; while (cond) { __builtin_amdgcn_s_sleep(1); \
    if ((++_sp & 255u) == 0u) { if (xb_ld(&(bar)[XB_TMO])) break; if (_sp > XB_SPIN_CAP) { atomicAdd(&(bar)[XB_TMO], 1u); break; } } } } while (0)
struct XcdBarrier { unsigned* bar; unsigned x; volatile LAS unsigned* st; };
__device__ __forceinline__ XcdBarrier xcd_barrier_post(unsigned* bar, volatile LAS unsigned* st) {
    XcdBarrier b; b.bar = bar; b.x = xb_xcc_id(); b.st = st;
    if (threadIdx.x == 0) (void)xb_add(&bar[XB_XCNT(b.x)], 1u);
    return b;
}
__device__ __forceinline__ void xcd_barrier_complete(unsigned* bar, unsigned x, unsigned& nloc, unsigned& nx) {
    const unsigned G = gridDim.x * gridDim.y * gridDim.z;
    unsigned sum, cnt, mine, sp = 0u;
    for (;;) {
        sum = 0u; cnt = 0u; mine = 0u;
#pragma unroll
        for (unsigned j = 0; j < 16; ++j) { const unsigned c = xb_ld(&bar[XB_XCNT(j)]); sum += c; cnt += (c > 0u) ? 1u : 0u; mine = (j == x) ? c : mine; }
        if (sum == G) break;
        __builtin_amdgcn_s_sleep(1);
        if ((++sp & 255u) == 0u) { if (xb_ld(&bar[XB_TMO])) break; if (sp > XB_SPIN_CAP) { atomicAdd(&bar[XB_TMO], 1u); break; } }
    }
    nloc = mine > 0u ? mine : 1u; nx = cnt > 0u ? cnt : 1u;
}
__device__ __forceinline__ void xcd_barrier(const XcdBarrier& b) {
    asm volatile("s_waitcnt vmcnt(0)" ::: "memory");
    __syncthreads();
    if (threadIdx.x == 0) {
        unsigned* bar = b.bar;
        __builtin_amdgcn_s_waitcnt(0);
        unsigned nloc = b.st[0], nx = b.st[1];
        if (nloc == 0u) { xcd_barrier_complete(bar, b.x, nloc, nx); b.st[0] = nloc; b.st[1] = nx; }
        const unsigned old = xb_add(&bar[XB_XSUB(b.x)], 1u);
        const unsigned gen = old / nloc;
        if (old + 1u == (gen + 1u) * nloc) {
            __builtin_amdgcn_fence(__ATOMIC_RELEASE, "agent");
            asm volatile("s_waitcnt vmcnt(0)" ::: "memory");
            const unsigned og = xb_add(&bar[XB_TOP], 1u);
            const unsigned tg = og / nx;
            if (og + 1u == (tg + 1u) * nx) xb_add(&bar[XB_TOPGEN], 1u);
            else XB_SPIN(xb_ld(&bar[XB_TOPGEN]) == tg, bar);
            __builtin_amdgcn_fence(__ATOMIC_ACQUIRE, "agent");
            xb_add(&bar[XB_XGEN(b.x)], 1u);
            asm volatile("s_waitcnt vmcnt(0)" ::: "memory");
        } else {
            XB_SPIN(xb_ld(&bar[XB_XGEN(b.x)]) == gen, bar);
            __builtin_amdgcn_fence(__ATOMIC_ACQUIRE, "agent");
            asm volatile("s_waitcnt vmcnt(0)" ::: "memory");
        }
    }
    __syncthreads();
}

constexpr int RING_BYTES = 139264;
constexpr int MISC_OFF = RING_BYTES;
constexpr int LDS_BYTES = 147456;
struct Params {
    const float* in[26]; float* out; unsigned char* ws; int ph_lo, ph_hi; int use_bar, pad;
};
typedef const __attribute__((address_space(4))) Params* KP;
__device__ __forceinline__ const float* gin(KP p, int i) { return (const float*)(const GAS float*)p->in[i]; }
__device__ __forceinline__ float* gout(KP p) { return (float*)(GAS float*)p->out; }
struct Frame {
    LAS unsigned char* lds; volatile LAS unsigned* MISC;
    int tid, lane, wave, vcu, G;
    unsigned char* ws;
};

template <bool F8_ = false> struct DenseSchedT {
    static constexpr bool GATHER = false, UNIFORMIZE = false, FP8 = F8_;
    const char* A; const char* Bt; int K, nM, nN, nwg, G, c;
    __device__ __forceinline__ void init(const void* A_, const void* Bt_, int M, int N, int K_, int G_, int c_) { A = (const char*)A_; Bt = (const char*)Bt_; K = K_; nM = M / 256; nN = N / 256; nwg = nM * nN; G = G_; c = c_; }
    __device__ __forceinline__ bool next(int i, pg8::UnitG& u) const {
        const long L = (long)i * G + c; if (L >= nwg) return false;
        int wgid = (int)L; { const int q = nwg / 8, r = nwg % 8, xcd = wgid % 8, off = wgid / 8; wgid = (xcd < r ? xcd * (q + 1) : r * (q + 1) + (xcd - r) * q) + off; }
        const int nig = 8 * nN, gid = wgid / nig, fm = gid * 8, gsz = (nM - fm) < 8 ? (nM - fm) : 8;
        const int pm = fm + ((wgid % nig) % gsz), pn = (wgid % nig) / gsz;
        u.A = A + (size_t)pm * 256 * K * 2; u.B = Bt + (size_t)pn * 256 * K * 2; u.gidx = nullptr; u.gcnt = 0; u.gshift = 0; u.row0 = pm * 256; u.col0 = pn * 256; u.aux = 0; return true;
    }
};
typedef DenseSchedT<false> DenseSched; typedef DenseSchedT<true> DenseSched8;
__device__ __forceinline__ u32x4 pack_bf16x8(const f32x4& v0, const f32x4& v1) { u32x4 w; w.x = pk2hw(v0[0], v0[1]); w.y = pk2hw(v0[2], v0[3]); w.z = pk2hw(v1[0], v1[1]); w.w = pk2hw(v1[2], v1[3]); return w; }

__device__ __forceinline__ unsigned pk4_fp8(float a, float b, float c, float d) {
    a = fminf(fmaxf(a, -448.0f), 448.0f); b = fminf(fmaxf(b, -448.0f), 448.0f); c = fminf(fmaxf(c, -448.0f), 448.0f); d = fminf(fmaxf(d, -448.0f), 448.0f);
    int w = 0; w = __builtin_amdgcn_cvt_pk_fp8_f32(a, b, w, false); w = __builtin_amdgcn_cvt_pk_fp8_f32(c, d, w, true); return (unsigned)w; }
constexpr float WUP_SCALE = 32.0f, WUP_INV = 1.0f / 32.0f;
struct EpiStoreBf16 {
    static constexpr bool PERM = true, PERM16 = false;
    bf16* O; int ldc; float osc, qsc;
    __device__ __forceinline__ void operator()(const f32x4 (&acc)[2][2][4][2], const pg8::UnitG& u, int wr, int wc, int fr, int fq) const {
        const float sc = ((u.col0 % 3072) < 1024) ? osc * qsc : osc;
#pragma unroll
        for (int ai = 0; ai < 2; ++ai)
#pragma unroll
            for (int m = 0; m < 4; ++m) { bf16* rowp = O + (size_t)(u.row0 + ai * 128 + wr * 64 + m * 16 + fr) * ldc + u.col0 + wc * 32 + 8 * fq;
#pragma unroll
                for (int bj = 0; bj < 2; ++bj) *(u32x4*)(rowp + bj * 128) = pack_bf16x8(acc[ai][bj][m][0] * sc, acc[ai][bj][m][1] * sc); }
    }
};
constexpr float YEXP_SCALE = 32.0f, YEXP_INV = 1.0f / 32.0f;
constexpr float A_SCALE = 16.0f;
constexpr float H_SCALE = 16.0f;
constexpr float OG_SCALE = 16.0f;
constexpr float Q8_SCALE = 64.0f, KV8_SCALE = 16.0f;
struct EpiStoreQkv8 {
    static constexpr bool PERM = false, PERM16 = true;
    unsigned char* O; int ldc;
    __device__ __forceinline__ void operator()(const f32x4 (&acc)[2][2][4][2], const pg8::UnitG& u, int wr, int wc, int fr, int fq) const {
        const float sc = ((u.col0 % 3072) < 1024) ? WUP_INV * 0.08838834764831845f * Q8_SCALE : WUP_INV * KV8_SCALE;
#pragma unroll
        for (int ai = 0; ai < 2; ++ai)
#pragma unroll
            for (int m = 0; m < 4; ++m) { unsigned char* rowp = O + (size_t)(u.row0 + ai * 128 + wr * 64 + m * 16 + fr) * ldc + u.col0 + wc * 64 + 16 * fq;
                u32x4 w;
#pragma unroll
                for (int q = 0; q < 4; ++q) { const f32x4 v = acc[ai][q >> 1][m][q & 1] * sc; w[q] = pk4_fp8(v[0], v[1], v[2], v[3]); }
                *(u32x4*)rowp = w; }
    }
};
struct EpiStoreFp8 {
    static constexpr bool PERM = false, PERM16 = true;
    unsigned char* O; int ldc;
    __device__ __forceinline__ void operator()(const f32x4 (&acc)[2][2][4][2], const pg8::UnitG& u, int wr, int wc, int fr, int fq) const {
#pragma unroll
        for (int ai = 0; ai < 2; ++ai)
#pragma unroll
            for (int m = 0; m < 4; ++m) { unsigned char* rowp = O + (size_t)(u.row0 + ai * 128 + wr * 64 + m * 16 + fr) * ldc + u.col0 + wc * 64 + 16 * fq;
                u32x4 w;
#pragma unroll
                for (int q = 0; q < 4; ++q) { f32x4 v = acc[ai][q >> 1][m][q & 1] * (YEXP_SCALE / (H_SCALE * WUP_SCALE));
#pragma unroll
                    for (int j = 0; j < 4; ++j) v[j] = fminf(fmaxf(v[j], -448.0f), 448.0f);
                    int d = 0; d = __builtin_amdgcn_cvt_pk_fp8_f32(v[0], v[1], d, false); d = __builtin_amdgcn_cvt_pk_fp8_f32(v[2], v[3], d, true); w[q] = (unsigned)d; }
                *(u32x4*)rowp = w; }
    }
};
constexpr float RS_SCALE = 4.0f;
constexpr float RQ_SCALE = 16.0f, RK_SCALE = 8.0f, RV_SCALE = 16.0f;
struct EpiRetIn {
    static constexpr bool PERM = false, PERM16 = true;
    unsigned char* O; int ldc;
    __device__ __forceinline__ void operator()(const f32x4 (&acc)[2][2][4][2], const pg8::UnitG& u, int wr, int wc, int fr, int fq) const {
        float l2g = 0.f;
        float cs = WUP_INV * RV_SCALE;
        if (u.col0 < 2048) { const int h = (u.col0 & 1023) >> 8; const float g = 1.0f - exp2f(-5.0f - (float)h); l2g = log2f(g); cs = WUP_INV * RQ_SCALE; if (u.col0 >= 1024) { l2g = -l2g; cs = WUP_INV * 0.0625f * RK_SCALE; } }
#pragma unroll
        for (int ai = 0; ai < 2; ++ai)
#pragma unroll
            for (int m = 0; m < 4; ++m) { const int row = u.row0 + ai * 128 + wr * 64 + m * 16 + fr; const float sc = exp2f(l2g * (float)(row & 127)) * cs;
                unsigned char* rowp = O + (size_t)row * ldc + u.col0 + wc * 64 + 16 * fq; u32x4 w;
#pragma unroll
                for (int q = 0; q < 4; ++q) { const f32x4 v = acc[ai][q >> 1][m][q & 1] * sc; w[q] = pk4_fp8(v[0], v[1], v[2], v[3]); }
                *(u32x4*)rowp = w; }
    }
};
__device__ __forceinline__ u32x4 cvt8_bf16(unsigned lo, unsigned hi) {
    const f32x2 a = __builtin_amdgcn_cvt_pk_f32_fp8((int)lo, false), b = __builtin_amdgcn_cvt_pk_f32_fp8((int)lo, true), c = __builtin_amdgcn_cvt_pk_f32_fp8((int)hi, false), d = __builtin_amdgcn_cvt_pk_f32_fp8((int)hi, true);
    u32x4 r; r.x = pk2(a[0], a[1]); r.y = pk2(b[0], b[1]); r.z = pk2(c[0], c[1]); r.w = pk2(d[0], d[1]); return r; }
__device__ __forceinline__ void unpack_bf16x8(const u32x4& w, f32x4& a, f32x4& b) { a[0] = bflo(w.x); a[1] = bfhi(w.x); a[2] = bflo(w.y); a[3] = bfhi(w.y); b[0] = bflo(w.z); b[1] = bfhi(w.z); b[2] = bflo(w.w); b[3] = bfhi(w.w); }
template <bool ALL16> struct EpiResidT {
    static constexpr bool PERM = true, PERM16 = false;
    const bf16* X; bf16* Y; float asc;
    __device__ __forceinline__ void operator()(const f32x4 (&acc)[2][2][4][2], const pg8::UnitG& u, int wr, int wc, int fr, int fq) const {
        constexpr int NB = ALL16 ? 1 : 2, PER = 2 / NB;
#pragma unroll
        for (int bt = 0; bt < NB; ++bt) {
            u32x4 xw[PER][4][2];
#pragma unroll
            for (int a2 = 0; a2 < PER; ++a2)
#pragma unroll
                for (int m = 0; m < 4; ++m) { const int ai = bt * PER + a2; const size_t off = (size_t)(u.row0 + ai * 128 + wr * 64 + m * 16 + fr) * D + u.col0 + wc * 32 + 8 * fq;
#pragma unroll
                    for (int bj = 0; bj < 2; ++bj) xw[a2][m][bj] = *(const u32x4*)(X + off + bj * 128); }
            asm volatile("" ::: "memory");
#pragma unroll
            for (int a2 = 0; a2 < PER; ++a2)
#pragma unroll
                for (int m = 0; m < 4; ++m) { const int ai = bt * PER + a2; const size_t off = (size_t)(u.row0 + ai * 128 + wr * 64 + m * 16 + fr) * D + u.col0 + wc * 32 + 8 * fq;
#pragma unroll
                    for (int bj = 0; bj < 2; ++bj) { f32x4 x0, x1; unpack_bf16x8(xw[a2][m][bj], x0, x1);
                        *(u32x4*)(Y + off + bj * 128) = pack_bf16x8(x0 * ALPHA + acc[ai][bj][m][0] * asc, x1 * ALPHA + acc[ai][bj][m][1] * asc); } }
            asm volatile("" ::: "memory");
        }
    }
};
typedef EpiResidT<true> EpiResid; typedef EpiResidT<false> EpiResid8;
struct EpiGluResid {
    static constexpr bool PERM = true, PERM16 = false;
    const bf16* X; bf16* Y; float asc;
    __device__ __forceinline__ void operator()(const f32x4 (&acc)[2][2][4][2], const pg8::UnitG& u, int wr, int wc, int fr, int fq) const {
        u32x4 xw[2][4];
#pragma unroll
        for (int ai = 0; ai < 2; ++ai)
#pragma unroll
            for (int m = 0; m < 4; ++m) { const size_t off = (size_t)(u.row0 + ai * 128 + wr * 64 + m * 16 + fr) * D + (u.col0 >> 1) + wc * 32 + 8 * fq; xw[ai][m] = *(const u32x4*)(X + off); }
        asm volatile("" ::: "memory");
#pragma unroll
        for (int ai = 0; ai < 2; ++ai)
#pragma unroll
            for (int m = 0; m < 4; ++m) { const size_t off = (size_t)(u.row0 + ai * 128 + wr * 64 + m * 16 + fr) * D + (u.col0 >> 1) + wc * 32 + 8 * fq;
                f32x4 x0, x1; unpack_bf16x8(xw[ai][m], x0, x1); f32x4 o0, o1;
#pragma unroll
                for (int j = 0; j < 4; ++j) { o0[j] = x0[j] * ALPHA + acc[ai][0][m][0][j] * asc * fsig(acc[ai][1][m][0][j] * asc); o1[j] = x1[j] * ALPHA + acc[ai][0][m][1][j] * asc * fsig(acc[ai][1][m][1][j] * asc); }
                *(u32x4*)(Y + off) = pack_bf16x8(o0, o1); }
    }
};
struct EpiMoeUp {
    static constexpr bool PERM = true, PERM16 = false;
    unsigned char* H;
    __device__ __forceinline__ void operator()(const f32x4 (&acc)[2][2][4][2], const pg8::UnitG& u, int wr, int wc, int fr, int fq) const {
        typedef unsigned u2_t __attribute__((ext_vector_type(2)));
#pragma unroll
        for (int ai = 0; ai < 2; ++ai) {
            u32x2 w8[4];
#pragma unroll
            for (int m = 0; m < 4; ++m) { f32x4 o[2];
#pragma unroll
                for (int n = 0; n < 2; ++n)
#pragma unroll
                    for (int j = 0; j < 4; ++j) { const float ga = acc[ai][0][m][n][j], ua = acc[ai][1][m][n][j];
                        o[n][j] = (ga * ua) * (WUP_INV * WUP_INV * H_SCALE) * __builtin_amdgcn_rcpf(1.0f + __builtin_amdgcn_exp2f(ga * (-WUP_INV * 1.4426950408889634f))); }
                w8[m].x = pk4_fp8(o[0][0], o[0][1], o[0][2], o[0][3]); w8[m].y = pk4_fp8(o[1][0], o[1][1], o[1][2], o[1][3]); }
            u32x4 s0, s1;
            { const u2_t a = __builtin_amdgcn_permlane16_swap(w8[0].x, w8[2].x, false, false), b = __builtin_amdgcn_permlane16_swap(w8[0].y, w8[2].y, false, false);
              s0.x = a.x; s0.y = b.x; s0.z = a.y; s0.w = b.y; }
            { const u2_t a = __builtin_amdgcn_permlane16_swap(w8[1].x, w8[3].x, false, false), b = __builtin_amdgcn_permlane16_swap(w8[1].y, w8[3].y, false, false);
              s1.x = a.x; s1.y = b.x; s1.z = a.y; s1.w = b.y; }
            const int mb = (fq & 1) ? 2 : 0;
            unsigned char* rowp = H + (size_t)(u.row0 + ai * 128 + wr * 64 + mb * 16 + fr) * ED + u.col0 + wc * 32 + 8 * (fq & 2);
            *(u32x4*)rowp = s0; *(u32x4*)(rowp + (size_t)16 * ED) = s1; }
    }
};

struct ConvD { const float* src; unsigned char* dst; unsigned char* dst2; int ldw, ldk, kind; };
__device__ __forceinline__ ConvD conv_mk8(const float* W, int ldw, unsigned char* WT, int ldk, int k0, int n0, int drow0) {
    ConvD d; d.src = W + (size_t)k0 * ldw + n0; d.dst = WT + (size_t)drow0 * ldk + k0; d.dst2 = nullptr; d.ldw = ldw; d.ldk = ldk; d.kind = 1; return d; }
__device__ __forceinline__ ConvD conv_mk16(const float* W, int ldw, bf16* WT, bf16* WTlo, int ldk, int k0, int n0, int drow0) {
    ConvD d; d.src = W + (size_t)k0 * ldw + n0; d.dst = (unsigned char*)(WT + (size_t)drow0 * ldk + k0); d.dst2 = WTlo ? (unsigned char*)(WTlo + (size_t)drow0 * ldk + k0) : nullptr; d.ldw = ldw; d.ldk = ldk * 2; d.kind = WTlo ? 2 : 0; return d; }
__device__ __forceinline__ void conv_load(const ConvD& d, int lane, f32x4 (&r)[8]) {
#pragma unroll
    for (int i = 0; i < 8; ++i) { const int kk = 8 * i + (lane >> 3), c4 = 4 * (lane & 7); r[i] = *(const f32x4*)(d.src + (size_t)kk * d.ldw + c4); }
}
template <bool HILO>
__device__ __forceinline__ void conv_finish(const ConvD& d, int lane, const f32x4 (&r)[8], LAS float* scr) {
    const float scale = (d.kind == 1) ? WUP_SCALE : 1.0f;
#pragma unroll
    for (int i = 0; i < 8; ++i) { const int kk = 8 * i + (lane >> 3), c4 = 4 * (lane & 7);
        scr[kk * 33 + c4] = r[i][0] * scale; scr[kk * 33 + c4 + 1] = r[i][1] * scale; scr[kk * 33 + c4 + 2] = r[i][2] * scale; scr[kk * 33 + c4 + 3] = r[i][3] * scale; }
    LDS_WAIT(); asm volatile("" ::: "memory");
    const int c = lane & 7;
#pragma unroll
    for (int j = 0; j < 4; ++j) { const int n = (lane >> 3) + 8 * j; const LAS float* s = scr + (8 * c) * 33 + n;
        float v[8];
#pragma unroll
        for (int q = 0; q < 8; ++q) v[q] = s[q * 33];
        if (d.kind == 1) { u32x2 o; o.x = pk4_fp8(v[0], v[1], v[2], v[3]); o.y = pk4_fp8(v[4], v[5], v[6], v[7]); *(u32x2*)(d.dst + (size_t)n * d.ldk + 8 * c) = o; }
        else { u32x4 o; o.x = pk2(v[0], v[1]); o.y = pk2(v[2], v[3]); o.z = pk2(v[4], v[5]); o.w = pk2(v[6], v[7]);
            *(u32x4*)(d.dst + (size_t)n * d.ldk + 16 * c) = o;
            if (HILO) { float rr[8];
#pragma unroll
                for (int q = 0; q < 8; ++q) rr[q] = v[q] - bf2f(f2bf(v[q]));
                u32x4 o2; o2.x = pk2(rr[0], rr[1]); o2.y = pk2(rr[2], rr[3]); o2.z = pk2(rr[4], rr[5]); o2.w = pk2(rr[6], rr[7]);
                *(u32x4*)(d.dst2 + (size_t)n * d.ldk + 16 * c) = o2; } } }
    LDS_WAIT(); asm volatile("" ::: "memory");
}
__device__ __forceinline__ void conv_dma(const ConvD& d, int lane, LAS float* buf) {
#pragma unroll
    for (int i = 0; i < 8; ++i) { const float* g = d.src + (size_t)(8 * i + (lane >> 3)) * d.ldw + 4 * ((lane & 7) ^ i);
        __builtin_amdgcn_global_load_lds((const unsigned*)g, (LAS unsigned*)(buf + i * 256), 16, 0, 2); }
}
__device__ __forceinline__ void conv_finish_lds(const ConvD& d, int lane, const LAS float* buf) {
    const float scale = (d.kind == 1) ? WUP_SCALE : 1.0f;
    const int c = lane & 7;
#pragma unroll
    for (int j = 0; j < 4; ++j) { const int n = (lane >> 3) + 8 * j; const LAS float* s = buf + (8 * c) * 32 + (((n >> 2) ^ c) & 7) * 4 + (n & 3);
        float v[8];
#pragma unroll
        for (int q = 0; q < 8; ++q) v[q] = s[q * 32] * scale;
        if (d.kind == 1) { u32x2 o; o.x = pk4_fp8(v[0], v[1], v[2], v[3]); o.y = pk4_fp8(v[4], v[5], v[6], v[7]); *(u32x2*)(d.dst + (size_t)n * d.ldk + 8 * c) = o; }
        else { u32x4 o; o.x = pk2(v[0], v[1]); o.y = pk2(v[2], v[3]); o.z = pk2(v[4], v[5]); o.w = pk2(v[6], v[7]); *(u32x4*)(d.dst + (size_t)n * d.ldk + 16 * c) = o; } }
    LDS_WAIT(); asm volatile("" ::: "memory");
}
#define CONV_RUN(NIT, DEC) do { int it_ = gw; if (it_ < (NIT)) { ConvD dc_ = DEC(it_); int par_ = 0; conv_dma(dc_, F.lane, scr); asm volatile("s_waitcnt vmcnt(0)" ::: "memory"); \
        for (; it_ < (NIT); it_ += NGW) { const int itn_ = (it_ + NGW < (NIT)) ? it_ + NGW : it_; const ConvD dn_ = DEC(itn_); conv_dma(dn_, F.lane, scr + (par_ ^ 1) * 2048);     \
            asm volatile("s_waitcnt vmcnt(12)" ::: "memory"); conv_finish_lds(dc_, F.lane, scr + par_ * 2048); dc_ = dn_; par_ ^= 1; } \
        asm volatile("s_waitcnt vmcnt(0)" ::: "memory"); } } while (0)
__device__ __forceinline__ ConvD conv_dec_mixers(KP p, unsigned char* ws, int it) {
    constexpr int I_AIN = 16 * 288, I_AOUT = 16 * 32, I_RIN = 16 * 192, I_ROUT = 32 * 32, I_GLU = 16 * 64, I_RT = 16 * 2;
    int r = it;
    if (r < 2 * I_AIN) { const int j = r / I_AIN; r %= I_AIN; const int kb = r / 288, nb = r % 288, n0 = nb * 32;
        return conv_mk8(gin(p, 1) + (size_t)j * D * ATT_IN, ATT_IN, (unsigned char*)(ws + WS_ATT_IN_T) + (size_t)j * ATT_IN * D, D, kb * 64, n0, n0); }
    r -= 2 * I_AIN;
    if (r < 2 * I_AOUT) { const int j = r / I_AOUT; r %= I_AOUT; const int kb = r / 32, nb = r % 32, n0 = nb * 32;
        return conv_mk8(gin(p, 2) + (size_t)j * D * D, D, (unsigned char*)(ws + WS_ATT_OUT_T) + (size_t)j * D * D, D, kb * 64, n0, n0); }
    r -= 2 * I_AOUT;
    if (r < I_RIN) { const int kb = r / 192, nb = r % 192, n0 = nb * 32;
        return conv_mk8(gin(p, 3), RET_IN, (unsigned char*)(ws + WS_RET_IN_T), D, kb * 64, n0, n0); }
    r -= I_RIN;
    if (r < I_ROUT) { const int kb = r / 32, nb = r % 32, n0 = nb * 32;
        return conv_mk8(gin(p, 6), D, (unsigned char*)(ws + WS_RET_OUT_T), RET_V, kb * 64, n0, n0); }
    r -= I_ROUT;
    if (r < I_GLU) { const int kb = r / 64, nb = r % 64, n0 = nb * 32; const int c = n0 & 1023, drow = (c >> 7) * 256 + (n0 >> 10) * 128 + (c & 127);
        return conv_mk8(gin(p, 15), 2 * D, (unsigned char*)(ws + WS_GLU_T), D, kb * 64, n0, drow); }
    r -= I_GLU;
    { const int l = r / I_RT; r %= I_RT; const int kb = r / 2, nb = r % 2, n0 = nb * 32;
        return conv_mk16(gin(p, 16) + (size_t)l * D * NE, NE, (bf16*)(ws + WS_RT_HI) + (size_t)l * NE * D, (bf16*)(ws + WS_RT_LO) + (size_t)l * NE * D, D, kb * 64, n0, n0); }
}
__device__ __forceinline__ ConvD conv_dec_moe(KP p, unsigned char* ws, int l, int it) {
    const int e = it / 384, r = it % 384, which = r >> 7, rr = r & 127;
    bf16* We = (bf16*)(ws + WS_WMOE + (size_t)e * WMOE_E_BYTES);
    if (which < 2) { const float* src = (e < 64) ? gin(p, 18 + which) + ((size_t)l * NE + e) * D * ED : gin(p, 21 + which) + (size_t)l * D * ED;
        const int kb = rr >> 3, nb = rr & 7, n0 = nb * 32; const int drow = (n0 >> 7) * 256 + which * 128 + (n0 & 127);
        return conv_mk8(src, ED, (unsigned char*)We, D, kb * 64, n0, drow); }
    const float* src = (e < 64) ? gin(p, 20) + ((size_t)l * NE + e) * ED * D : gin(p, 23) + (size_t)l * ED * D;
    const int kb = rr >> 5, nb = rr & 31, n0 = nb * 32;
    return conv_mk8(src, D, (unsigned char*)(We + 512 * 1024), ED, kb * 64, n0, n0);
}
__device__ __forceinline__ void phase_conv_mixers(const Frame& F, KP p, int sel) {
    LAS float* scr = (LAS float*)(F.lds + F.wave * 16384);
    const int gw = F.vcu * NWAVES + F.wave, NGW = F.G * NWAVES;
    constexpr int I_AIN = 16 * 288, I_AOUT = 16 * 32, I_RIN = 16 * 192, I_ROUT = 32 * 32, I_GLU = 16 * 64;
    constexpr int NMAIN = 2 * I_AIN + 2 * I_AOUT + I_RIN + I_ROUT + I_GLU, NRT = 4 * (16 * 2);
    unsigned char* ws = F.ws;
    int lo = 0;
#define CONV_DEC_MIX(i_) conv_dec_mixers(p, ws, lo + (i_))
    if (sel == 0) { lo = 0; CONV_RUN(I_AIN, CONV_DEC_MIX); lo = 2 * I_AIN; CONV_RUN(I_AOUT, CONV_DEC_MIX);
        for (int it = NMAIN + gw; it < NMAIN + NRT; it += NGW) { const ConvD d = conv_dec_mixers(p, ws, it); f32x4 r[8]; conv_load(d, F.lane, r); conv_finish<true>(d, F.lane, r, scr); } }
    else if (sel == 1) { lo = 2 * I_AIN + 2 * I_AOUT; CONV_RUN(I_RIN + I_ROUT, CONV_DEC_MIX); }
    else if (sel == 2) { lo = 2 * I_AIN + 2 * I_AOUT + I_RIN + I_ROUT; CONV_RUN(I_GLU, CONV_DEC_MIX); }
    else { lo = I_AIN; CONV_RUN(I_AIN, CONV_DEC_MIX); lo = 2 * I_AIN + I_AOUT; CONV_RUN(I_AOUT, CONV_DEC_MIX); }
#undef CONV_DEC_MIX
}
__device__ __forceinline__ void phase_conv_moe(const Frame& F, KP p, int l) {
    LAS float* scr = (LAS float*)(F.lds + F.wave * 16384);
    const int gw = F.vcu * NWAVES + F.wave, NGW = F.G * NWAVES;
    unsigned char* ws = F.ws;
#define CONV_DEC_MOE(i_) conv_dec_moe(p, ws, l, (i_))
    CONV_RUN(65 * 384, CONV_DEC_MOE);
#undef CONV_DEC_MOE
}

__device__ __forceinline__ void phase_lnr(const Frame& F, KP p, int layer, bool dry = false) {
    const bf16* Y = (const bf16*)(F.ws + WS_Y); bf16* XB = (bf16*)(F.ws + WS_XB); unsigned char* XB8 = (unsigned char*)(F.ws + WS_X);
    const float* lng = gin(p, 24) + (size_t)(layer * 2) * D; const float* lnb = gin(p, 25) + (size_t)(layer * 2) * D;
    const bf16* rthi = (const bf16*)(F.ws + WS_RT_HI) + (size_t)layer * NE * D; const bf16* rtlo = (const bf16*)(F.ws + WS_RT_LO) + (size_t)layer * NE * D;
    const float* rbias = gin(p, 17) + layer * NE;
    unsigned* cnt = (unsigned*)(F.ws + WS_CTL) + CW_CNT + layer * NE * 64;
    int* lists = (int*)(F.ws + WS_LIST); int* tokmap = (int*)(F.ws + WS_LIST + 4 * MiB); float* tokgate = (float*)(F.ws + WS_LIST + 5 * MiB);
    constexpr int XLD = 1032, MAXT = 8;
    LAS bf16* Xhi = (LAS bf16*)F.lds; LAS bf16* Xlo = Xhi + 16 * XLD;
    LAS float* part = (LAS float*)(F.lds + 2 * 16 * XLD * 2);
    LAS int* ent = (LAS int*)(part + 2 * 16 * 64);
    LAS int* hist = ent + MAXT * 16 * 8 * 2; LAS int* base = hist + 64;
    const int lane = F.lane, w = F.wave, g4 = lane >> 4, l15 = lane & 15;
    if (F.tid < 64) hist[F.tid] = 0;
    bf16x8 bhi[16], blo[16];
    { const int nt = w & 3, kh = w >> 2; const bf16* bh = rthi + (size_t)(16 * nt + l15) * D + 512 * kh + 8 * g4; const bf16* bl = rtlo + (size_t)(16 * nt + l15) * D + 512 * kh + 8 * g4;
#pragma unroll
        for (int ks = 0; ks < 16; ++ks) { bhi[ks] = *(const bf16x8*)(bh + 32 * ks); blo[ks] = *(const bf16x8*)(bl + 32 * ks); } }
    u32x4 ypre[2][2];
    if (F.vcu < T / 16) {
#pragma unroll
        for (int rr = 0; rr < 2; ++rr)
#pragma unroll
            for (int j = 0; j < 2; ++j) ypre[rr][j] = __builtin_nontemporal_load((const u32x4*)(Y + (size_t)(F.vcu * 16 + 2 * w + rr) * D + 8 * lane + 512 * j)); }
    int ntile = 0;
    for (int tile = F.vcu; tile < T / 16 && ntile < MAXT; tile += F.G, ++ntile) {
        const int t0 = tile * 16;
        u32x4 ycur[2][2];
#pragma unroll
        for (int rr = 0; rr < 2; ++rr)
#pragma unroll
            for (int j = 0; j < 2; ++j) ycur[rr][j] = ypre[rr][j];
        if (tile + F.G < T / 16) {
#pragma unroll
            for (int rr = 0; rr < 2; ++rr)
#pragma unroll
                for (int j = 0; j < 2; ++j) ypre[rr][j] = __builtin_nontemporal_load((const u32x4*)(Y + (size_t)((tile + F.G) * 16 + 2 * w + rr) * D + 8 * lane + 512 * j)); }
#pragma unroll
        for (int rr = 0; rr < 2; ++rr) {
            const int lr = 2 * w + rr; const size_t row = (size_t)(t0 + lr);
            f32x4 v[4]; float s = 0.f;
#pragma unroll
            for (int j = 0; j < 2; ++j) unpack_bf16x8(ycur[rr][j], v[2 * j], v[2 * j + 1]);
#pragma unroll
            for (int j = 0; j < 4; ++j) s += (v[j][0] + v[j][1]) + (v[j][2] + v[j][3]);
            const float mean = wave_sum(s, lane) * (1.f / D); float s2 = 0.f;
#pragma unroll
            for (int j = 0; j < 4; ++j) { v[j] = v[j] - mean; s2 += (v[j][0] * v[j][0] + v[j][1] * v[j][1]) + (v[j][2] * v[j][2] + v[j][3] * v[j][3]); }
            const float rstd = 1.0f / sqrtf(wave_sum(s2, lane) * (1.f / D) + LN_EPS);
#pragma unroll
            for (int j = 0; j < 2; ++j) { const f32x4 g0 = *(const f32x4*)(lng + 8 * lane + 512 * j), g1 = *(const f32x4*)(lng + 8 * lane + 512 * j + 4), b0 = *(const f32x4*)(lnb + 8 * lane + 512 * j), b1 = *(const f32x4*)(lnb + 8 * lane + 512 * j + 4);
                const f32x4 o0 = v[2 * j] * rstd * g0 + b0, o1 = v[2 * j + 1] * rstd * g1 + b1;
                const u32x4 hi = pack_bf16x8(o0, o1);
                *(u32x4*)(XB + row * D + 8 * lane + 512 * j) = hi;
                { u32x2 q8; q8.x = pk4_fp8(o0[0], o0[1], o0[2], o0[3]); q8.y = pk4_fp8(o1[0], o1[1], o1[2], o1[3]); *(u32x2*)(XB8 + row * D + 8 * lane + 512 * j) = q8; }
                f32x4 h0, h1; unpack_bf16x8(hi, h0, h1); const u32x4 lo = pack_bf16x8(o0 - h0, o1 - h1);
                *(LAS u32x4*)(Xhi + lr * XLD + 8 * lane + 512 * j) = hi; *(LAS u32x4*)(Xlo + lr * XLD + 8 * lane + 512 * j) = lo; }
        }
        __syncthreads();
        { const int nt = w & 3, kh = w >> 2; f32x4 a0 = (f32x4){0.f, 0.f, 0.f, 0.f}, a1 = a0, a2 = a0, a3 = a0, a4 = a0, a5 = a0;
#pragma unroll
            for (int ks = 0; ks < 16; ks += 2) { const int k0 = 512 * kh + 32 * ks;
                const bf16x8 ahi = row_frag(Xhi, XLD, 0, k0, lane), alo = row_frag(Xlo, XLD, 0, k0, lane), bhi2 = row_frag(Xhi, XLD, 0, k0 + 32, lane), blo2 = row_frag(Xlo, XLD, 0, k0 + 32, lane);
                a0 = MFMA16(ahi, bhi[ks], a0); a1 = MFMA16(alo, bhi[ks], a1); a2 = MFMA16(ahi, blo[ks], a2);
                a3 = MFMA16(bhi2, bhi[ks + 1], a3); a4 = MFMA16(blo2, bhi[ks + 1], a4); a5 = MFMA16(bhi2, blo[ks + 1], a5); }
            const f32x4 acc = ((a0 + a3) + (a1 + a4)) + (a2 + a5);
#pragma unroll
            for (int i = 0; i < 4; ++i) part[(kh * 16 + 4 * g4 + i) * 64 + 16 * nt + l15] = acc[i];
        }
        __syncthreads();
#pragma unroll
        for (int rr = 0; rr < 2; ++rr) {
            const int lt = ntile * 16 + 2 * w + rr;
            const float lg = part[(2 * w + rr) * 64 + lane] + part[(16 + 2 * w + rr) * 64 + lane];
            float sc = fsig(lg); sc = (sc == sc) ? sc : 0.5f;
            const float sel = sc + rbias[lane];
            const float m1 = max8(sel);
            const unsigned long long eq = __ballot(sel == m1);
            const unsigned gm = (unsigned)(eq >> (lane & 56)) & 0xffu;
            const int first = (lane & 56) + __builtin_ctz(gm | 0x100u);
            const float m2 = max8((lane == first) ? -INFINITY : sel);
            const float gs = m1 + m2; const int mygrp = lane >> 3; int grank = 0;
#pragma unroll
            for (int gg = 0; gg < 8; ++gg) { const float o = rdl(gs, 8 * gg); grank += (o > gs || (o == gs && gg < mygrp)) ? 1 : 0; }
            const float mv = (grank < 4) ? sel : -INFINITY;
            unsigned key = __builtin_bit_cast(unsigned, mv); key = (key >> 31) ? ~key : (key | 0x80000000u); key = (key & ~63u) | (unsigned)(63 - lane);
            int rank = 64; { unsigned kw = key;
#pragma unroll
                for (int r = 0; r < TOPK; ++r) { const unsigned m = wave_umax(kw); if (kw == m) { rank = r; kw = 0u; } } }
            const bool chosen = rank < TOPK;
            const float wsum = wave_sum(chosen ? sc : 0.f, lane);
            if (chosen) { const int lpos = __hip_atomic_fetch_add(hist + lane, 1, __ATOMIC_RELAXED, __HIP_MEMORY_SCOPE_WORKGROUP);
                ent[(lt * 8 + rank) * 2] = (lane << 16) | lpos; ent[(lt * 8 + rank) * 2 + 1] = __builtin_bit_cast(int, sc * __builtin_amdgcn_rcpf(wsum) * 2.5f); }
        }
    }
    __syncthreads();
    if (dry) return;
    if (F.tid < 64) { const int hcount = hist[F.tid]; base[F.tid] = hcount ? (int)atomicAdd(cnt + F.tid * 64, (unsigned)hcount) : 0; }
    __syncthreads();
    for (int idx = F.tid; idx < ntile * 16 * 8; idx += NTHREADS) {
        const int ev = ent[idx * 2], gb = ent[idx * 2 + 1]; const int e = ev >> 16, pos = base[e] + (ev & 0xffff);
        const int lt = idx >> 3, rank = idx & 7, tok = (F.vcu + (lt >> 4) * F.G) * 16 + (lt & 15);
        lists[(size_t)e * T + pos] = tok; tokmap[tok * 8 + rank] = (e << 16) | pos; tokgate[tok * 8 + rank] = __builtin_bit_cast(float, gb);
    }
}

__device__ __forceinline__ void phase_combine(const Frame& F, KP p, int layer, bool dry = false) {
    bf16* XB = (bf16*)(F.ws + WS_XB); const unsigned char* yexp = (const unsigned char*)(F.ws + WS_BIG);
    const int* tokmap = (const int*)(F.ws + WS_LIST + 4 * MiB); const float* tokgate = (const float*)(F.ws + WS_LIST + 5 * MiB);
    const volatile LAS int* tstart = (const volatile LAS int*)(F.MISC + 64);
    const float* lng = gin(p, 24) + (size_t)(layer * 2 + 1) * D; const float* lnb = gin(p, 25) + (size_t)(layer * 2 + 1) * D;
    float* outp = gout(p); bf16* xbo = XB; if (dry) { outp = (float*)(F.ws + WS_AUX); xbo = (bf16*)(F.ws + WS_H); }
    const int lane = F.lane, gw = F.vcu * NWAVES + F.wave, NGW = F.G * NWAVES;
    const bf16* ysh = (const bf16*)(F.ws + WS_Y);
    f32x4 gv[4], bv[4];
#pragma unroll
    for (int j = 0; j < 4; ++j) { gv[j] = *(const f32x4*)(lng + 16 * lane + 4 * j); bv[j] = *(const f32x4*)(lnb + 16 * lane + 4 * j); }
    for (int row = gw; row < T; row += NGW) {
        const int mk = tokmap[row * 8 + (lane & 7)]; const float gk = tokgate[row * 8 + (lane & 7)] * YEXP_INV;
        const int rk = (int)tstart[mk >> 16] * 256 + (mk & 0xffff);
        f32x4 v[4];
#pragma unroll
        for (int j = 0; j < 2; ++j) { const u32x4 xw = __builtin_nontemporal_load((const u32x4*)(ysh + (size_t)row * D + 16 * lane + 8 * j)); unpack_bf16x8(xw, v[2 * j], v[2 * j + 1]); }
#pragma unroll
        for (int k = 0; k < TOPK; ++k) { const int r = __builtin_amdgcn_readlane(rk, k); const float g = rdl(gk, k);
            const u32x4 s = __builtin_nontemporal_load((const u32x4*)(yexp + (size_t)r * D + 16 * lane));
#pragma unroll
            for (int j = 0; j < 4; ++j) { const f32x2 lo = __builtin_amdgcn_cvt_pk_f32_fp8((int)s[j], false), hi = __builtin_amdgcn_cvt_pk_f32_fp8((int)s[j], true);
                v[j][0] += g * lo[0]; v[j][1] += g * lo[1]; v[j][2] += g * hi[0]; v[j][3] += g * hi[1]; } }
        float s = 0.f;
#pragma unroll
        for (int j = 0; j < 4; ++j) s += (v[j][0] + v[j][1]) + (v[j][2] + v[j][3]);
        const float mean = wave_sum(s, lane) * (1.f / D); float s2 = 0.f;
#pragma unroll
        for (int j = 0; j < 4; ++j) { v[j] = v[j] - mean; s2 += (v[j][0] * v[j][0] + v[j][1] * v[j][1]) + (v[j][2] * v[j][2] + v[j][3] * v[j][3]); }
        const float rstd = 1.0f / sqrtf(wave_sum(s2, lane) * (1.f / D) + LN_EPS);
        f32x4 o[4];
#pragma unroll
        for (int j = 0; j < 4; ++j) o[j] = v[j] * rstd * gv[j] + bv[j];
        if (layer == DEPTH - 1 || dry) {
#pragma unroll
            for (int j = 0; j < 4; ++j) *(f32x4*)(outp + (size_t)row * D + 16 * lane + 4 * j) = o[j]; }
        if (layer != DEPTH - 1) { *(u32x4*)(xbo + (size_t)row * D + 16 * lane) = pack_bf16x8(o[0], o[1]); *(u32x4*)(xbo + (size_t)row * D + 16 * lane + 8) = pack_bf16x8(o[2], o[3]);
            if (!dry) { u32x4 q8; q8.x = pk4_fp8(o[0][0], o[0][1], o[0][2], o[0][3]); q8.y = pk4_fp8(o[1][0], o[1][1], o[1][2], o[1][3]); q8.z = pk4_fp8(o[2][0], o[2][1], o[2][2], o[2][3]); q8.w = pk4_fp8(o[3][0], o[3][1], o[3][2], o[3][3]);
                *(u32x4*)((unsigned char*)(F.ws + WS_X) + (size_t)row * D + 16 * lane) = q8; } }
    }
}

constexpr size_t AUX_OB = 96 * MiB, AUX_LSE = 128 * MiB;
__device__ __forceinline__ unsigned att_qoff(int R, int j, int qi, int g4) {
    const int h = R & 7, sbr = R >> 3, g = sbr >> 5, rem = sbr & 31, b = rem >> 4, rr_ = rem & 15;
    const int dsh = 2 * g, d = 1 << dsh, nrs = 4 - dsh, r = rr_ >> nrs, n = 4 * (rr_ & ((1 << nrs) - 1)) + j;
    const unsigned qrow = (unsigned)b * SEQ + (unsigned)(128 * n + qi) * (unsigned)d + (unsigned)r;
    return qrow * (unsigned)ATT_IN + (unsigned)(g * 3072 + h * 128 + 8 * g4);
}
__device__ __forceinline__ void phase_attn(const Frame& F, int bx) {
    const unsigned char* qkv = (const unsigned char*)(F.ws + WS_BIG); bf16* og = (bf16*)(F.ws + WS_AUX); float* lse = (float*)(F.ws + WS_AUX + AUX_LSE);
    constexpr int KLD = 136, KP = 128;
    LAS bf16* Ks = (LAS bf16*)F.lds; LAS bf16* Vs = Ks + 256 * KP;
    const int lane = F.lane, w = F.wave, g4 = lane >> 4, l15 = lane & 15, qq = l15 >> 2, pp = lane & 3;
    u32x4 kc[2], vc[2];
    constexpr int NRUN = 768;
#define ATT_CVT8(lo_, hi_) ({ const f32x2 a_ = __builtin_amdgcn_cvt_pk_f32_fp8((int)(lo_), false), b_ = __builtin_amdgcn_cvt_pk_f32_fp8((int)(lo_), true), c_ = __builtin_amdgcn_cvt_pk_f32_fp8((int)(hi_), false), d_ = __builtin_amdgcn_cvt_pk_f32_fp8((int)(hi_), true); \
        u32x4 r_; r_.x = pk2(a_[0], a_[1]); r_.y = pk2(b_[0], b_[1]); r_.z = pk2(c_[0], c_[1]); r_.w = pk2(d_[0], d_[1]); r_; })
#define ATT_LOADBLK(KR, VR, nblk) do { _Pragma("unroll") for (int it = 0; it < 2; ++it) { const int idx = F.tid + 512 * it, c = idx >> 3, ch = idx & 7; int pos = 128 * (nblk) + c; pos = pos < 0 ? 0 : pos; \
            const unsigned so = (rowbase + (unsigned)pos * (unsigned)d + (unsigned)r) * (unsigned)ATT_IN + (unsigned)(g * 3072 + 1024 + h * 128 + ch * 16); KR[it] = *(const u32x4*)(qkv + so); VR[it] = *(const u32x4*)(qkv + so + 1024u); } } while (0)
#define ATT_STOREBLK(KR, VR, slot) do { _Pragma("unroll") for (int it = 0; it < 2; ++it) { const int idx = F.tid + 512 * it, c = idx >> 3, ch = idx & 7; \
            *(LAS u32x4*)(Ks + (128 * (slot) + c) * KP + 8 * ((2 * ch) ^ (c & 15))) = ATT_CVT8(KR[it].x, KR[it].y); *(LAS u32x4*)(Ks + (128 * (slot) + c) * KP + 8 * ((2 * ch + 1) ^ (c & 15))) = ATT_CVT8(KR[it].z, KR[it].w); \
            *(LAS u32x4*)(Vs + (128 * (slot) + c) * KLD + ch * 16) = ATT_CVT8(VR[it].x, VR[it].y); *(LAS u32x4*)(Vs + (128 * (slot) + c) * KLD + ch * 16 + 8) = ATT_CVT8(VR[it].z, VR[it].w); } } while (0)
    const int qi = 16 * w + l15;
    u32x2 qraw[4];
    if (bx < NRUN) { const unsigned qo = att_qoff(bx, 0, qi, g4);
#pragma unroll
        for (int s = 0; s < 4; ++s) qraw[s] = *(const u32x2*)(qkv + qo + 32 * s); }
    for (int R = bx; R < NRUN; R += F.G) {
        const int h = R & 7, sbr = R >> 3, g = sbr >> 5, rem = sbr & 31, b = rem >> 4, rr_ = rem & 15;
        const int dsh = 2 * g, d = 1 << dsh, nrs = 4 - dsh, r = rr_ >> nrs, n0 = 4 * (rr_ & ((1 << nrs) - 1)); const unsigned rowbase = (unsigned)b * SEQ;
        { u32x4 k0[2], v0[2]; ATT_LOADBLK(k0, v0, n0 - 1); ATT_LOADBLK(kc, vc, n0); ATT_STOREBLK(k0, v0, (n0 - 1) & 1); }
#pragma unroll 1
        for (int j = 0; j < 4; ++j) {
            const int n = n0 + j, cs = n & 1, ps = cs ^ 1;
            ATT_STOREBLK(kc, vc, cs);
            const unsigned qrow = rowbase + (unsigned)(128 * n + qi) * (unsigned)d + (unsigned)r;
            bf16x8 qf[4];
#pragma unroll
            for (int s = 0; s < 4; ++s) qf[s] = __builtin_bit_cast(bf16x8, ATT_CVT8(qraw[s].x, qraw[s].y));
            __syncthreads();
            if (j < 3) { ATT_LOADBLK(kc, vc, n + 1); }
            __builtin_amdgcn_sched_barrier(0);
            const int ws0 = (16 * w < 96) ? 16 * w : 96;
#define ATT_PROW(c0) (((c0) < 128) ? (128 * ps + (c0)) : (128 * cs + (c0) - 128))
            f32x4 sacc[10];
            {
                bf16x8 kfa[4], kfb[4];
                const LAS bf16* kb[4];
#pragma unroll
                for (int k = 0; k < 4; ++k) kb[k] = Ks + l15 * KP + 8 * (g4 ^ (l15 & 3)) + 32 * (k ^ (l15 >> 2));
#define ATT_KFRAG(prow_, s_) (*(const LAS bf16x8*)(kb[s_] + (prow_) * KP))
#pragma unroll
                for (int s = 0; s < 4; ++s) kfa[s] = ATT_KFRAG(ATT_PROW(ws0), s);
#pragma unroll
                for (int t = 0; t < 10; t += 2) {
#pragma unroll
                    for (int s = 0; s < 4; ++s) kfb[s] = ATT_KFRAG(ATT_PROW(ws0 + 16 * (t + 1)), s);
                    __builtin_amdgcn_sched_barrier(0);
                    sacc[t] = (f32x4){0.f, 0.f, 0.f, 0.f};
#pragma unroll
                    for (int s = 0; s < 4; ++s) sacc[t] = MFMA16(kfa[s], qf[s], sacc[t]);
                    if (t + 2 < 10) {
#pragma unroll
                        for (int s = 0; s < 4; ++s) kfa[s] = ATT_KFRAG(ATT_PROW(ws0 + 16 * (t + 2)), s); }
                    __builtin_amdgcn_sched_barrier(0);
                    sacc[t + 1] = (f32x4){0.f, 0.f, 0.f, 0.f};
#pragma unroll
                    for (int s = 0; s < 4; ++s) sacc[t + 1] = MFMA16(kfb[s], qf[s], sacc[t + 1]);
                }
            }
            { const int Rn = (j < 3) ? R : ((R + F.G < NRUN) ? R + F.G : R), jn = (j < 3) ? j + 1 : 0; const unsigned qo = att_qoff(Rn, jn, qi, g4);
#pragma unroll
              for (int s = 0; s < 4; ++s) qraw[s] = *(const u32x2*)(qkv + qo + 32 * s); }
            const float slope = exp2f(-(float)(h + 1)) * (float)d * 1.4426950408889634f;
            float mx = -INFINITY;
            int sbase = 128 + qi - ws0 - 4 * g4; asm volatile("" : "+v"(sbase));
            const float nsb = -slope * (float)sbase; const int kmin = (n > 0) ? sbase - 128 : ((sbase - 128 > 128 - ws0 - 4 * g4) ? sbase - 128 : 128 - ws0 - 4 * g4);
#pragma unroll
            for (int t = 0; t < 10; ++t)
#pragma unroll
                for (int i = 0; i < 4; ++i) { const int k = 16 * t + i;
                    const bool valid = (k <= sbase) && (k >= kmin);
                    const float v = valid ? __builtin_fmaf(slope, (float)k, __builtin_fmaf(sacc[t][i], 1.4426950408889634f / (Q8_SCALE * KV8_SCALE), nsb)) : -INFINITY; sacc[t][i] = v; mx = fmaxf(mx, v); }
            mx = fmaxf(mx, shx(mx, 16, lane)); mx = fmaxf(mx, shx(mx, 32, lane));
            float lsum = 0.f;
#pragma unroll
            for (int t = 0; t < 10; ++t)
#pragma unroll
                for (int i = 0; i < 4; ++i) { const float pv = __builtin_amdgcn_exp2f(sacc[t][i] - mx); sacc[t][i] = pv; lsum += pv; }
            lsum += shx(lsum, 16, lane); lsum += shx(lsum, 32, lane);
            bf16x8 pf[5];
#pragma unroll
            for (int kt = 0; kt < 5; ++kt) pf[kt] = pack8(sacc[2 * kt], sacc[2 * kt + 1]);
            f32x4 o[8];
            {
                const LAS bf16* vl = Vs + (4 * g4 + qq) * KLD + 32 * pp;
                bf16x4 va[10], vcc[10];
#pragma unroll
                for (int q = 0; q < 10; ++q) va[q] = tr4(vl + ATT_PROW(ws0 + 16 * q) * KLD);
#pragma unroll
                for (int et = 0; et < 8; et += 2) {
#pragma unroll
                    for (int q = 0; q < 10; ++q) vcc[q] = tr4(vl + ATT_PROW(ws0 + 16 * q) * KLD + 4 * (et + 1));
                    __builtin_amdgcn_sched_barrier(0);
                    o[et] = (f32x4){0.f, 0.f, 0.f, 0.f};
#pragma unroll
                    for (int kt = 0; kt < 5; ++kt) o[et] = MFMA16(cat8(va[2 * kt], va[2 * kt + 1]), pf[kt], o[et]);
                    if (et + 2 < 8) {
#pragma unroll
                        for (int q = 0; q < 10; ++q) va[q] = tr4(vl + ATT_PROW(ws0 + 16 * q) * KLD + 4 * (et + 2)); }
                    __builtin_amdgcn_sched_barrier(0);
                    o[et + 1] = (f32x4){0.f, 0.f, 0.f, 0.f};
#pragma unroll
                    for (int kt = 0; kt < 5; ++kt) o[et + 1] = MFMA16(cat8(vcc[2 * kt], vcc[2 * kt + 1]), pf[kt], o[et + 1]);
                }
            }
#undef ATT_PROW
#undef ATT_KFRAG
            const float inv = (1.0f / KV8_SCALE) / lsum;
            unsigned char* orow = (unsigned char*)og + ((size_t)g * T + qrow) * D + h * 128 + 32 * g4;
#pragma unroll
            for (int k2 = 0; k2 < 2; ++k2) { u32x4 w8;
#pragma unroll
                for (int q = 0; q < 4; ++q) { const f32x4 v = o[4 * k2 + q] * (inv * OG_SCALE); w8[q] = pk4_fp8(v[0], v[1], v[2], v[3]); }
                *(u32x4*)(orow + 16 * k2) = w8; }
            if (g4 == 0) lse[((size_t)g * T + qrow) * AH + h] = mx * 0.6931471805599453f + __logf(lsum);
            __syncthreads();
        }
    }
#undef ATT_LOADBLK
#undef ATT_CVT8
#undef ATT_STOREBLK
}
__device__ __forceinline__ void phase_attn_combine(const Frame& F) {
    const bf16* og = (const bf16*)(F.ws + WS_AUX); const float* lse = (const float*)(F.ws + WS_AUX + AUX_LSE); bf16* ob = (bf16*)(F.ws + WS_AUX + AUX_OB);
    const int lane = F.lane, gw = F.vcu * NWAVES + F.wave, NGW = F.G * NWAVES, h = lane >> 3;
    for (int row = gw; row < T; row += NGW) {
        const float l0 = lse[((size_t)0 * T + row) * AH + h], l1 = lse[((size_t)1 * T + row) * AH + h], l2 = lse[((size_t)2 * T + row) * AH + h];
        const float m = fmaxf(l0, fmaxf(l1, l2)); float w0 = __expf(l0 - m), w1 = __expf(l1 - m), w2 = __expf(l2 - m); const float inv = 1.0f / (w0 + w1 + w2); w0 *= inv; w1 *= inv; w2 *= inv;
        float a[16];
#pragma unroll
        for (int j = 0; j < 16; ++j) a[j] = 0.f;
#pragma unroll
        for (int g = 0; g < 3; ++g) { const float wg = ((g == 0) ? w0 : (g == 1 ? w1 : w2)) * (1.0f / OG_SCALE);
            const u32x4 s8 = __builtin_nontemporal_load((const u32x4*)((const unsigned char*)og + ((size_t)g * T + row) * D + 16 * lane));
#pragma unroll
            for (int q = 0; q < 4; ++q) { const f32x2 lo = __builtin_amdgcn_cvt_pk_f32_fp8((int)s8[q], false), hi = __builtin_amdgcn_cvt_pk_f32_fp8((int)s8[q], true);
                a[4 * q] += wg * lo[0]; a[4 * q + 1] += wg * lo[1]; a[4 * q + 2] += wg * hi[0]; a[4 * q + 3] += wg * hi[1]; } }
        { u32x4 o;
#pragma unroll
          for (int q = 0; q < 4; ++q) o[q] = pk4_fp8(a[4 * q] * A_SCALE, a[4 * q + 1] * A_SCALE, a[4 * q + 2] * A_SCALE, a[4 * q + 3] * A_SCALE);
          *(u32x4*)((unsigned char*)ob + (size_t)row * D + 16 * lane) = o; }
    }
}

constexpr size_t BIG_YRET = 192 * MiB;
__device__ __forceinline__ void phase_ret_u(const Frame& F) {
    const unsigned char* proj = (const unsigned char*)(F.ws + WS_BIG); unsigned char* St = (unsigned char*)(F.ws + WS_AUX);
    constexpr int LD = 264;
    LAS bf16* Kt = (LAS bf16*)F.lds; LAS bf16* Vt = Kt + 128 * LD;
    const int lane = F.lane, w = F.wave, g4 = lane >> 4, l15 = lane & 15, qq = l15 >> 2, pp = lane & 3;
    u32x4 kr[4], vr[4];
#define RU_LOAD(u_) do { const int eh_ = (u_) & 1, h_ = ((u_) >> 1) & 3, n_ = ((u_) >> 3) & 63, b_ = (u_) >> 9; const char* pb_ = (const char*)(proj + ((size_t)b_ * SEQ + (size_t)n_ * RC) * RET_IN); \
        int t_ = F.tid; asm volatile("" : "+v"(t_)); unsigned off_ = (unsigned)((t_ >> 4) * RET_IN + (t_ & 15) * 16); \
        _Pragma("unroll") for (int it = 0; it < 4; ++it) { asm volatile("" : "+v"(off_)); kr[it] = *(const u32x4*)(pb_ + (size_t)(1024 + h_ * 256 + it * 32 * RET_IN) + off_); \
            vr[it] = *(const u32x4*)(pb_ + (size_t)(2048 + h_ * 512 + eh_ * 256 + it * 32 * RET_IN) + off_); } } while (0)
    if (F.vcu < 1024) RU_LOAD(F.vcu);
    for (int u = F.vcu; u < 1024; u += F.G) {
        const int eh = u & 1, h = (u >> 1) & 3, n = (u >> 3) & 63, b = u >> 9;
        { int t_ = F.tid; asm volatile("" : "+v"(t_));
#pragma unroll
          for (int it = 0; it < 4; ++it) { const int idx = t_ + 512 * it, j = idx >> 4, ch = idx & 15;
              *(LAS u32x4*)(Kt + j * LD + ch * 16) = cvt8_bf16(kr[it].x, kr[it].y); *(LAS u32x4*)(Kt + j * LD + ch * 16 + 8) = cvt8_bf16(kr[it].z, kr[it].w);
              *(LAS u32x4*)(Vt + j * LD + ch * 16) = cvt8_bf16(vr[it].x, vr[it].y); *(LAS u32x4*)(Vt + j * LD + ch * 16 + 8) = cvt8_bf16(vr[it].z, vr[it].w); } }
        __syncthreads();
        f32x4 acc[16][2];
#pragma unroll
        for (int mt = 0; mt < 16; ++mt) { acc[mt][0] = (f32x4){0.f, 0.f, 0.f, 0.f}; acc[mt][1] = (f32x4){0.f, 0.f, 0.f, 0.f}; }
#pragma unroll
        for (int ks = 0; ks < 4; ++ks) {
            bf16x8 bfr[2];
#pragma unroll
            for (int nt = 0; nt < 2; ++nt) { const LAS bf16* a0 = Vt + (32 * ks + 8 * g4 + qq) * LD + 32 * w + 16 * nt + 4 * pp; bfr[nt] = cat8(tr4(a0), tr4(a0 + 4 * LD)); }
#pragma unroll
            for (int mt = 0; mt < 16; ++mt) { const LAS bf16* a0 = Kt + (32 * ks + 8 * g4 + qq) * LD + 128 * (mt >> 3) + 32 * pp + 4 * (mt & 7);
                const bf16x8 afr = cat8(tr4(a0), tr4(a0 + 4 * LD));
                acc[mt][0] = MFMA16(afr, bfr[0], acc[mt][0]); acc[mt][1] = MFMA16(afr, bfr[1], acc[mt][1]); }
        }
        { const int un = (u + F.G < 1024) ? u + F.G : u; RU_LOAD(un); }
        unsigned char* outb = St + ((size_t)((b * RH + h) * RNC + n)) * (RDV * RDK);
#pragma unroll
        for (int nt = 0; nt < 2; ++nt) { unsigned char* orow = outb + (size_t)(eh * 256 + 32 * w + 16 * nt + l15) * RDK + 32 * g4;
#pragma unroll
            for (int mh = 0; mh < 2; ++mh)
#pragma unroll
                for (int q2 = 0; q2 < 2; ++q2) { u32x4 o;
#pragma unroll
                    for (int k = 0; k < 4; ++k) { const f32x4 v = acc[mh * 8 + 4 * q2 + k][nt] * (RS_SCALE / (RK_SCALE * RV_SCALE)); o[k] = pk4_fp8(v[0], v[1], v[2], v[3]); }
                    *(u32x4*)(orow + 128 * mh + 16 * q2) = o; } }
        __syncthreads();
    }
#undef RU_LOAD
}
__device__ __forceinline__ void phase_ret_scan(const Frame& F) {
    unsigned char* St = (unsigned char*)(F.ws + WS_AUX);
    for (int gt = F.vcu * NTHREADS + F.tid; gt < 8 * 8192; gt += F.G * NTHREADS) {
        const int bh = gt >> 13, chunk = gt & 8191, h = bh & 3;
        const float g128 = exp2f(128.0f * log2f(1.0f - exp2f(-5.0f - (float)h)));
        unsigned char* base = St + (size_t)bh * RNC * (RDV * RDK) + (size_t)chunk * 16;
        float c[16];
#pragma unroll
        for (int j = 0; j < 16; ++j) c[j] = 0.f;
#pragma unroll 8
        for (int n = 0; n < RNC; ++n) { unsigned char* pn = base + (size_t)n * (RDV * RDK); const u32x4 uv = *(const u32x4*)pn;
            u32x4 o;
#pragma unroll
            for (int k = 0; k < 4; ++k) o[k] = pk4_fp8(c[4 * k], c[4 * k + 1], c[4 * k + 2], c[4 * k + 3]);
            *(u32x4*)pn = o;
#pragma unroll
            for (int k = 0; k < 4; ++k) { const f32x2 lo = __builtin_amdgcn_cvt_pk_f32_fp8((int)uv[k], false), hi = __builtin_amdgcn_cvt_pk_f32_fp8((int)uv[k], true);
                c[4 * k] = g128 * (c[4 * k] + lo[0]); c[4 * k + 1] = g128 * (c[4 * k + 1] + lo[1]); c[4 * k + 2] = g128 * (c[4 * k + 2] + hi[0]); c[4 * k + 3] = g128 * (c[4 * k + 3] + hi[1]); } }
    }
}
__device__ __forceinline__ void phase_ret_out(const Frame& F, KP p) {
    const unsigned char* proj = (const unsigned char*)(F.ws + WS_BIG); const unsigned char* St = (const unsigned char*)(F.ws + WS_AUX); bf16* yret = (bf16*)(F.ws + WS_BIG + BIG_YRET);
    const float* gng = gin(p, 4); const float* gnb = gin(p, 5);
    constexpr int LD = 264, VLD = 72, NSL = 8, ESL = 64;
    LAS bf16* Rs = (LAS bf16*)F.lds; LAS bf16* Vs = Rs + 128 * LD;
    const int w = F.wave;
#define RO_TID(t_) int t_ = F.tid; asm volatile("" : "+v"(t_))
#define RO_LD(base_, off_) (*(const u32x4*)((const char*)(base_) + (off_)))
    for (int u = F.vcu; u < 512; u += F.G) {
        const int h = u & 3, n = (u >> 2) & 63, b = u >> 8;
        const size_t row0 = (size_t)b * SEQ + (size_t)n * RC;
        const unsigned char* Sn = St + ((size_t)((b * RH + h) * RNC + n)) * (RDV * RDK);
        const char* pbase = (const char*)(proj + row0 * RET_IN);
        u32x4 pv[1], ps[2];
        bf16x8 qf[8];
        { RO_TID(t0); u32x4 kreg[4]; u32x2 qraw[8];
          unsigned koff = (unsigned)((t0 >> 4) * RET_IN + (t0 & 15) * 16), qoff = (unsigned)((16 * w + (t0 & 15)) * RET_IN + 8 * ((t0 & 63) >> 4));
#pragma unroll
          for (int it = 0; it < 4; ++it) { asm volatile("" : "+v"(koff)); kreg[it] = RO_LD(pbase + (size_t)(1024 + h * 256 + it * 32 * RET_IN), koff); }
#pragma unroll
          for (int s = 0; s < 8; ++s) { asm volatile("" : "+v"(qoff)); qraw[s] = *(const u32x2*)(pbase + (size_t)(h * 256 + 32 * s) + qoff); }
#define RO_LOAD_SLICE(sl_) do { RO_TID(tl_); unsigned voff = (unsigned)((tl_ >> 2) * RET_IN + (tl_ & 3) * 16), soff = (unsigned)((tl_ >> 4) * RDK + (tl_ & 15) * 16); \
            asm volatile("" : "+v"(voff)); pv[0] = RO_LD(pbase + (size_t)(2048 + h * 512 + (sl_) * ESL), voff); \
            _Pragma("unroll") for (int it = 0; it < 2; ++it) { asm volatile("" : "+v"(soff)); ps[it] = RO_LD((const char*)Sn + (size_t)(((sl_) * ESL + it * 32) * RDK), soff); } } while (0)
          RO_LOAD_SLICE(0);
#pragma unroll
          for (int it = 0; it < 4; ++it) { const int idx = t0 + 512 * it, j = idx >> 4, ch = idx & 15;
              *(LAS u32x4*)(Rs + j * LD + ch * 16) = cvt8_bf16(kreg[it].x, kreg[it].y); *(LAS u32x4*)(Rs + j * LD + ch * 16 + 8) = cvt8_bf16(kreg[it].z, kreg[it].w); }
#pragma unroll
          for (int s = 0; s < 8; ++s) qf[s] = __builtin_bit_cast(bf16x8, cvt8_bf16(qraw[s].x, qraw[s].y)); }
        __syncthreads();
        bf16x8 pf[4];
        { RO_TID(t1); const int lane = t1 & 63, g4 = lane >> 4, irow = 16 * w + (lane & 15);
          f32x4 sacc[8];
#pragma unroll
            for (int jt = 0; jt < 8; ++jt) { sacc[jt] = (f32x4){0.f, 0.f, 0.f, 0.f};
                if (jt <= w) {
#pragma unroll
                    for (int s = 0; s < 8; ++s) sacc[jt] = MFMA16(row_frag(Rs, LD, 16 * jt, 32 * s, lane), qf[s], sacc[jt]);
#pragma unroll
                    for (int i = 0; i < 4; ++i) if (16 * jt + 4 * g4 + i > irow) sacc[jt][i] = 0.f; } }
#pragma unroll
            for (int kt = 0; kt < 4; ++kt) pf[kt] = pack8(sacc[2 * kt] * (RS_SCALE / (RQ_SCALE * RK_SCALE)), sacc[2 * kt + 1] * (RS_SCALE / (RQ_SCALE * RK_SCALE))); }
        __syncthreads();
        u32x4 accp[NSL][2];
        float s1 = 0.f, s2 = 0.f;
#pragma unroll
        for (int sl = 0; sl < NSL; ++sl) {
            { RO_TID(t2);
              { const int j = t2 >> 2, ch = t2 & 3; *(LAS u32x4*)(Vs + j * VLD + ch * 16) = cvt8_bf16(pv[0].x, pv[0].y); *(LAS u32x4*)(Vs + j * VLD + ch * 16 + 8) = cvt8_bf16(pv[0].z, pv[0].w); }
#pragma unroll
              for (int it = 0; it < 2; ++it) { const int idx = t2 + 512 * it, e = idx >> 4, ch = (idx & 15) ^ (2 * ((e >> 4) & 3));
                  *(LAS u32x4*)(Rs + e * LD + ch * 16) = cvt8_bf16(ps[it].x, ps[it].y); *(LAS u32x4*)(Rs + e * LD + ch * 16 + 8) = cvt8_bf16(ps[it].z, ps[it].w); } }
            __syncthreads();
            if (sl + 1 < NSL) RO_LOAD_SLICE(sl + 1);
            RO_TID(t3); const int lane = t3 & 63, g4 = lane >> 4, qq = (lane & 15) >> 2, pp = lane & 3;
            f32x4 acc[4];
            const LAS bf16* sb[4];
#pragma unroll
            for (int k = 0; k < 4; ++k) sb[k] = Rs + (16 * qq + pp) * LD + 8 * g4 + 32 * (k ^ qq);
#pragma unroll
            for (int et = 0; et < 4; ++et) { f32x4 a = (f32x4){0.f, 0.f, 0.f, 0.f};
#pragma unroll
                for (int kt = 0; kt < 4; ++kt) if (2 * kt <= w) { const LAS bf16* a0 = Vs + (32 * kt + 4 * g4 + qq) * VLD + 16 * pp + 4 * et;
                    a = MFMA16(cat8(tr4(a0), tr4(a0 + 16 * VLD)), pf[kt], a); }
#pragma unroll
                for (int s = 0; s < 8; ++s) a = MFMA16(*(const LAS bf16x8*)(sb[s & 3] + (4 * et) * LD + 32 * (s & 4)), qf[s], a);
                a = a * (1.0f / (RV_SCALE * RS_SCALE));
                acc[et] = a; s1 += (a[0] + a[1]) + (a[2] + a[3]); s2 += (a[0] * a[0] + a[1] * a[1]) + (a[2] * a[2] + a[3] * a[3]);
                __builtin_amdgcn_sched_barrier(0); }
            accp[sl][0] = pack_bf16x8(acc[0], acc[1]); accp[sl][1] = pack_bf16x8(acc[2], acc[3]);
            __syncthreads();
        }
#undef RO_LOAD_SLICE
        RO_TID(t4); const int lane = t4 & 63, g4 = lane >> 4, irow = 16 * w + (lane & 15); const size_t qrow = row0 + irow;
        s1 += shx(s1, 16, lane); s1 += shx(s1, 32, lane); s2 += shx(s2, 16, lane); s2 += shx(s2, 32, lane);
        const float mean = s1 * (1.0f / RDV); const float var = fmaxf(s2 * (1.0f / RDV) - mean * mean, 0.f);
        const float rstd = 1.0f / sqrtf(var + LN_EPS);
        unsigned goff = (unsigned)(irow * RET_IN + 16 * g4);
#pragma unroll
        for (int sp = 0; sp < NSL; sp += 2) {
            u32x4 gq[2]; f32x4 gg[2][4], gb[2][4];
#pragma unroll
            for (int d2 = 0; d2 < 2; ++d2) { const int c0 = h * RDV + (sp + d2) * ESL + 16 * g4;
                asm volatile("" : "+v"(goff)); gq[d2] = RO_LD(pbase + (size_t)(4096 + h * RDV + (sp + d2) * ESL), goff);
#pragma unroll
                for (int q = 0; q < 4; ++q) { gg[d2][q] = *(const f32x4*)(gng + c0 + 4 * q); gb[d2][q] = *(const f32x4*)(gnb + c0 + 4 * q); } }
#pragma unroll
            for (int d2 = 0; d2 < 2; ++d2) { const int c0 = h * RDV + (sp + d2) * ESL + 16 * g4; u32x4 o8;
#pragma unroll
                for (int q = 0; q < 2; ++q) { f32x4 a0, a1; unpack_bf16x8(accp[sp + d2][q], a0, a1);
                    f32x4 y0 = (a0 - mean) * rstd * gg[d2][2 * q] + gb[d2][2 * q], y1 = (a1 - mean) * rstd * gg[d2][2 * q + 1] + gb[d2][2 * q + 1];
                    const f32x2 g0 = __builtin_amdgcn_cvt_pk_f32_fp8((int)gq[d2][2 * q], false), g1 = __builtin_amdgcn_cvt_pk_f32_fp8((int)gq[d2][2 * q], true), g2 = __builtin_amdgcn_cvt_pk_f32_fp8((int)gq[d2][2 * q + 1], false), g3 = __builtin_amdgcn_cvt_pk_f32_fp8((int)gq[d2][2 * q + 1], true);
                    const float gv[8] = {g0[0] * (1.0f / RV_SCALE), g0[1] * (1.0f / RV_SCALE), g1[0] * (1.0f / RV_SCALE), g1[1] * (1.0f / RV_SCALE), g2[0] * (1.0f / RV_SCALE), g2[1] * (1.0f / RV_SCALE), g3[0] * (1.0f / RV_SCALE), g3[1] * (1.0f / RV_SCALE)};
#pragma unroll
                    for (int j = 0; j < 4; ++j) { y0[j] *= gv[j] * fsig(gv[j]) * A_SCALE; y1[j] *= gv[4 + j] * fsig(gv[4 + j]) * A_SCALE; }
                    o8[2 * q] = pk4_fp8(y0[0], y0[1], y0[2], y0[3]); o8[2 * q + 1] = pk4_fp8(y1[0], y1[1], y1[2], y1[3]); }
                *(u32x4*)((unsigned char*)yret + qrow * RET_V + c0) = o8; }
        }
    }
#undef RO_LD
#undef RO_TID
}

constexpr size_t AUX_S5E = 64 * MiB;
constexpr int S5L = 256, S5NC = SEQ / S5L;
__device__ __forceinline__ void cmul_add(float& rr, float& ri, float ar, float ai, float xr, float xi, float cr, float ci) { rr = ar * xr - ai * xi + cr; ri = ar * xi + ai * xr + ci; }
template <bool OUT>
__device__ __forceinline__ void phase_s5_scan(const Frame& F, KP p) {
    const bf16* X = (const bf16*)(F.ws + WS_XB); float* E = (float*)(F.ws + WS_AUX + AUX_S5E); bf16* ybuf = (bf16*)(F.ws + WS_AUX);
    const int lane = F.lane, w = F.wave, g4 = lane >> 4, l15 = lane & 15;
    LAS bf16* ut = (LAS bf16*)(F.lds + w * 12288);
    LAS bf16* Hb = (LAS bf16*)(F.lds + w * 12288 + 4096);
    constexpr int HLD = 136;
    const int gw = F.vcu * NWAVES + w, NGW = F.G * NWAVES;
    const int up16 = (lane - 16) << 2, up32 = (lane - 32) << 2, last16 = (48 + l15) << 2;
    for (int unit = gw; unit < BATCH * SG * S5NC; unit += NGW) {
        const int n = unit & (S5NC - 1), g = (unit >> 5) & 63, b = unit >> 11;
        float a1r[4], a1i[4], a4r[4], a4i[4], a8r[4], a8i[4], pwr[4], pwi[4];
        bf16x8 bfrag[8];
        const float dt = expf(gin(p, 14)[g]);
#pragma unroll
        for (int st = 0; st < 4; ++st) { const int ps = 16 * st + l15;
            const float are = gin(p, 7)[g * SP + ps], aim = gin(p, 8)[g * SP + ps];
            const float mag = expf(dt * are); const float abr = mag * cosf(dt * aim), abi = mag * sinf(dt * aim);
            const float den = are * are + aim * aim;
            const float fre = ((abr - 1.0f) * are + abi * aim) / den, fim = (abi * are - (abr - 1.0f) * aim) / den;
            a1r[st] = abr; a1i[st] = abi; { float t2r, t2i; cmul_add(t2r, t2i, abr, abi, abr, abi, 0.f, 0.f); cmul_add(a4r[st], a4i[st], t2r, t2i, t2r, t2i, 0.f, 0.f); }
            cmul_add(a8r[st], a8i[st], a4r[st], a4i[st], a4r[st], a4i[st], 0.f, 0.f);
            float qr = 1.f, qi = 0.f;
            if (g4 & 1) { qr = a4r[st]; qi = a4i[st]; }
            if (g4 & 2) { float tr, ti; cmul_add(tr, ti, qr, qi, a8r[st], a8i[st], 0.f, 0.f); qr = tr; qi = ti; }
            pwr[st] = qr; pwi[st] = qi;
            const float* br = gin(p, 9) + ((size_t)g * SP + ps) * SGC + 8 * (g4 & 1); const float* bi = gin(p, 10) + ((size_t)g * SP + ps) * SGC + 8 * (g4 & 1);
            const f32x4 r0 = *(const f32x4*)br, r1 = *(const f32x4*)(br + 4), i0 = *(const f32x4*)bi, i1 = *(const f32x4*)(bi + 4);
            const float z = (g4 < 2) ? 1.0f : 0.0f; const float fr2 = fre * z, fi2 = fim * z;
            bfrag[st] = pack8(r0 * fr2 - i0 * fi2, r1 * fr2 - i1 * fi2); bfrag[st + 4] = pack8(i0 * fr2 + r0 * fi2, i1 * fr2 + r1 * fi2);
        }
        float sr[4], si[4];
        float* Eu = E + ((size_t)(b * SG + g) * S5NC + n) * 128;
        bf16x8 cf[4]; f32x4 dsk = (f32x4){0.f, 0.f, 0.f, 0.f};
#pragma unroll
        for (int st = 0; st < 4; ++st) { sr[st] = 0.f; si[st] = 0.f; }
        if (OUT) {
#pragma unroll
            for (int st = 0; st < 4; ++st) { sr[st] = Eu[16 * st + l15]; si[st] = Eu[64 + 16 * st + l15]; }
#pragma unroll
            for (int s = 0; s < 4; ++s) { const float* cp = (s < 2 ? gin(p, 11) : gin(p, 12)) + ((size_t)g * SGC + l15) * SP + 32 * (s & 1) + 8 * g4; const float sg = s < 2 ? 1.0f : -1.0f;
                const f32x4 c0 = *(const f32x4*)cp * sg, c1 = *(const f32x4*)(cp + 4) * sg; cf[s] = pack8(c0, c1); }
            dsk = *(const f32x4*)(gin(p, 13) + g * SGC + 4 * g4); }
        const size_t tok0 = (size_t)b * SEQ + (size_t)n * S5L;
        u32x4 pre[2];
        { const bf16* src = X + (tok0 + lane) * D + g * SGC; pre[0] = *(const u32x4*)src; pre[1] = *(const u32x4*)(src + 8); }
        for (int sub = 0; sub < S5L / 64; ++sub) {
            *(LAS u32x4*)(ut + lane * 16) = pre[0]; *(LAS u32x4*)(ut + lane * 16 + 8) = pre[1];
            if (sub + 1 < S5L / 64) { const bf16* src = X + (tok0 + (sub + 1) * 64 + lane) * D + g * SGC; pre[0] = *(const u32x4*)src; pre[1] = *(const u32x4*)(src + 8); }
            LDS_WAIT(); asm volatile("" ::: "memory");
#pragma unroll (OUT ? 1 : 4)
            for (int blk = 0; blk < 4; ++blk) {
                u32x4 uw = *(const LAS u32x4*)(ut + (blk * 16 + l15) * 16 + 8 * (g4 & 1));
                if (g4 >= 2) uw = (u32x4){0u, 0u, 0u, 0u};
                const bf16x8 ufr = __builtin_bit_cast(bf16x8, uw);
                f32x4 dr[4], di[4];
#pragma unroll
                for (int st = 0; st < 4; ++st) { dr[st] = MFMA16(ufr, bfrag[st], ((f32x4){0.f, 0.f, 0.f, 0.f})); di[st] = MFMA16(ufr, bfrag[st + 4], ((f32x4){0.f, 0.f, 0.f, 0.f})); }
                float vr[4], vi[4];
#pragma unroll
                for (int st = 0; st < 4; ++st) {
                    float hr = 0.f, hi = 0.f;
#pragma unroll
                    for (int i = 0; i < 4; ++i) { float nr, ni; cmul_add(nr, ni, a1r[st], a1i[st], hr, hi, dr[st][i], di[st][i]); hr = nr; hi = ni; dr[st][i] = hr; di[st][i] = hi; }
                    vr[st] = hr; vi[st] = hi; }
#define BPF(idx, v) __builtin_bit_cast(float, __builtin_amdgcn_ds_bpermute((idx), __builtin_bit_cast(int, (v))))
                { float xr[4], xi[4];
#pragma unroll
                  for (int st = 0; st < 4; ++st) { xr[st] = BPF(up16, vr[st]); xi[st] = BPF(up16, vi[st]); }
#pragma unroll
                  for (int st = 0; st < 4; ++st) { float tr, ti; cmul_add(tr, ti, a4r[st], a4i[st], xr[st], xi[st], vr[st], vi[st]); if (g4 >= 1) { vr[st] = tr; vi[st] = ti; } }
#pragma unroll
                  for (int st = 0; st < 4; ++st) { xr[st] = BPF(up32, vr[st]); xi[st] = BPF(up32, vi[st]); }
#pragma unroll
                  for (int st = 0; st < 4; ++st) { float tr, ti; cmul_add(tr, ti, a8r[st], a8i[st], xr[st], xi[st], vr[st], vi[st]); if (g4 >= 2) { vr[st] = tr; vi[st] = ti; } } }
                float er[4], ei[4], lr[4], li[4];
#pragma unroll
                for (int st = 0; st < 4; ++st) { if (OUT) { er[st] = BPF(up16, vr[st]); ei[st] = BPF(up16, vi[st]); } else { er[st] = 0.f; ei[st] = 0.f; } lr[st] = BPF(last16, vr[st]); li[st] = BPF(last16, vi[st]); }
#undef BPF
#pragma unroll
                for (int st = 0; st < 4; ++st) {
                    if (g4 == 0) { er[st] = 0.f; ei[st] = 0.f; }
                    if (OUT) { float s0r, s0i; cmul_add(s0r, s0i, pwr[st], pwi[st], sr[st], si[st], er[st], ei[st]);
#pragma unroll
                        for (int i = 0; i < 4; ++i) { float tr, ti; cmul_add(tr, ti, a1r[st], a1i[st], s0r, s0i, 0.f, 0.f); s0r = tr; s0i = ti; dr[st][i] += s0r; di[st][i] += s0i; } }
                    { float a16r, a16i; cmul_add(a16r, a16i, a8r[st], a8i[st], a8r[st], a8i[st], 0.f, 0.f); float tr, ti; cmul_add(tr, ti, a16r, a16i, sr[st], si[st], lr[st], li[st]); sr[st] = tr; si[st] = ti; }
                    if (OUT) {
#pragma unroll
                        for (int i = 0; i < 4; ++i) { const unsigned hw = pk2(dr[st][i], di[st][i]); Hb[(4 * g4 + i) * HLD + 16 * st + l15] = (bf16)hw; Hb[(4 * g4 + i) * HLD + 64 + 16 * st + l15] = (bf16)(hw >> 16); } }
                }
                if (OUT) {
                    LDS_WAIT(); asm volatile("" ::: "memory");
                    f32x4 ya = (f32x4){0.f, 0.f, 0.f, 0.f};
#pragma unroll
                    for (int s = 0; s < 4; ++s) ya = MFMA16(cf[s], row_frag(Hb, HLD, 0, 32 * s, lane), ya);
                    const u32x2 u2 = *(const LAS u32x2*)(ut + (blk * 16 + l15) * 16 + 4 * g4);
                    const f32x4 u4 = (f32x4){bflo(u2.x), bfhi(u2.x), bflo(u2.y), bfhi(u2.y)};
                    f32x4 y = ya + dsk * u4;
#pragma unroll
                    for (int j = 0; j < 4; ++j) { const float v = y[j]; y[j] = v * fsig(1.5957691216057308f * (v + 0.044715f * v * v * v)); }
                    *(unsigned*)((unsigned char*)ybuf + (size_t)(tok0 + sub * 64 + blk * 16 + l15) * D + g * SGC + 4 * g4) = pk4_fp8(y[0] * A_SCALE, y[1] * A_SCALE, y[2] * A_SCALE, y[3] * A_SCALE);
                    asm volatile("" ::: "memory"); }
            }
            LDS_WAIT(); asm volatile("" ::: "memory");
        }
        if (!OUT && g4 == 0) {
#pragma unroll
            for (int st = 0; st < 4; ++st) { Eu[16 * st + l15] = sr[st]; Eu[64 + 16 * st + l15] = si[st]; } }
    }
}
__device__ __forceinline__ void phase_s5_carry(const Frame& F, KP p) {
    float* E = (float*)(F.ws + WS_AUX + AUX_S5E);
    for (int gt = F.vcu * NTHREADS + F.tid; gt < BATCH * SG * SP; gt += F.G * NTHREADS) {
        const int pl = gt & 63, bg = gt >> 6, g = bg & 63;
        const float dt = expf(gin(p, 14)[g]); const float are = gin(p, 7)[g * SP + pl], aim = gin(p, 8)[g * SP + pl];
        const float mag = expf(dt * are); float ar = mag * cosf(dt * aim), ai = mag * sinf(dt * aim);
#pragma unroll
        for (int q = 0; q < 8; ++q) { const float nr = ar * ar - ai * ai, ni = 2.0f * ar * ai; ar = nr; ai = ni; }
        float cr = 0.f, ci = 0.f;
        for (int n = 0; n < S5NC; ++n) { float* Eu = E + ((size_t)bg * S5NC + n) * 128; const float er = Eu[pl], ei = Eu[64 + pl];
            Eu[pl] = cr; Eu[64 + pl] = ci;
            const float nr = ar * cr - ai * ci + er, ni = ar * ci + ai * cr + ei; cr = nr; ci = ni; }
    }
}

constexpr int NPHASES = 34;
#ifndef PROBE_DRY14
#define PROBE_DRY14 0
#endif
#ifndef PROBE_DRY17
#define PROBE_DRY17 0
#endif
#ifndef PH_MASK
#define PH_MASK 0xFFFFFFFFu
#endif
#define PHT(t) ((PH_MASK >> (t)) & 1u)
constexpr int PLAN_OFF = 64;
__device__ __forceinline__ void moe_plan(const Frame& F, int layer) {
    volatile LAS int* tstart = (volatile LAS int*)(F.MISC + PLAN_OFF); volatile LAS int* cnts = tstart + 72;
    __syncthreads();
    if (F.wave == 0) {
        const unsigned* cnt = (const unsigned*)(F.ws + WS_CTL) + CW_CNT + layer * NE * 64;
        const int c = (int)__hip_atomic_load(cnt + F.lane * 64, __ATOMIC_RELAXED, __HIP_MEMORY_SCOPE_AGENT);
        int v = (c + 255) >> 8;
#pragma unroll
        for (int o = 1; o < 64; o <<= 1) { const int nb = __builtin_amdgcn_ds_bpermute((F.lane - o) << 2, v); if (F.lane >= o) v += nb; }
        tstart[F.lane + 1] = v; cnts[F.lane] = c;
        if (F.lane == 0) tstart[0] = 0;
        if (F.lane == 63) { tstart[65] = v + T / 256; cnts[64] = T; }
    }
    __syncthreads();
}
template <bool GATH> struct MoeSched2 {
    static constexpr bool GATHER = GATH, UNIFORMIZE = true, FP8 = true;
    static constexpr int ncol = GATH ? 2 : 4, K = GATH ? D / 2 : ED / 2;
    const volatile LAS int* tstart; const volatile LAS int* cnts; int ntiles, G, c, lane;
    const char* Abase; const char* Wbase; const int* lists;
    __device__ __forceinline__ bool next(int i, pg8::UnitG& u) const {
        const int nwg = ntiles * ncol; const long L = (long)i * G + c; if (L >= nwg) return false;
        int wgid = (int)L; { const int q = nwg / 8, r = nwg % 8, xcd = wgid % 8, off = wgid / 8; wgid = (xcd < r ? xcd * (q + 1) : r * (q + 1) + (xcd - r) * q) + off; }
        const int tile = wgid / ncol, pn = wgid % ncol;
        int ln; { unsigned o2 = ~0u; asm volatile("" : "+s"(o2)); ln = (int)__builtin_amdgcn_mbcnt_hi(o2, __builtin_amdgcn_mbcnt_lo(o2, 0u)); }
        const int ta = tstart[ln], tb = tstart[ln + 1];
        const unsigned long long mm = __ballot(ta <= tile && tile < tb);
        const int e = mm ? (int)__builtin_ctzll(mm) : 64;
        const int ts = __builtin_amdgcn_readfirstlane((int)tstart[e]), ce = __builtin_amdgcn_readfirstlane((int)cnts[e]);
        const int lt = tile - ts; int valid = ce - lt * 256; valid = valid > 256 ? 256 : valid;
        u.gshift = 0; u.aux = e;
        if (GATH) {
            u.B = Wbase + (size_t)e * WMOE_E_BYTES + (size_t)pn * 256 * K * 2;
            if (e < 64) { u.A = Abase; u.gidx = lists + (size_t)e * T + lt * 256; u.gcnt = valid; }
            else { u.A = Abase + (size_t)lt * 256 * K * 2; u.gidx = nullptr; u.gcnt = 0; }
            u.row0 = tile * 256; u.col0 = pn * 128;
        } else {
            u.B = Wbase + (size_t)e * WMOE_E_BYTES + (size_t)512 * 1024 * 2 + (size_t)pn * 256 * K * 2;
            u.A = Abase + (size_t)tile * 256 * K * 2; u.gidx = nullptr; u.gcnt = valid;
            u.row0 = tile * 256; u.col0 = pn * 256;
        }
        return true;
    }
};
__device__ __forceinline__ void phase_load_x(const Frame& F, KP p) {
    const float* xin = gin(p, 0); bf16* XB = (bf16*)(F.ws + WS_XB);
    for (size_t i = (size_t)F.vcu * NTHREADS + F.tid; i < (size_t)T * D / 8; i += (size_t)F.G * NTHREADS) {
        const f32x4 a = __builtin_nontemporal_load((const f32x4*)(xin + i * 8)), b = __builtin_nontemporal_load((const f32x4*)(xin + i * 8 + 4));
        *(u32x4*)(XB + i * 8) = pack_bf16x8(a, b);
        u32x2 q8; q8.x = pk4_fp8(a[0], a[1], a[2], a[3]); q8.y = pk4_fp8(b[0], b[1], b[2], b[3]); *(u32x2*)((unsigned char*)(F.ws + WS_X) + i * 8) = q8; }
}

__global__ void __launch_bounds__(NTHREADS, 2) fwd_kernel(Params p_unused) {
    KP p0 = (KP)__builtin_amdgcn_kernarg_segment_ptr();
    extern __shared__ __attribute__((aligned(16))) unsigned char lds_raw[];
    Frame F0;
    F0.lds = (LAS unsigned char*)lds_raw; F0.MISC = (volatile LAS unsigned*)(F0.lds + MISC_OFF);
    F0.tid = threadIdx.x; F0.lane = F0.tid & 63; F0.wave = __builtin_amdgcn_readfirstlane(F0.tid >> 6);
    F0.G = gridDim.x; { const int bq = blockIdx.x; F0.vcu = (F0.G % 8 == 0) ? (bq % 8) * (F0.G / 8) + bq / 8 : bq; }
    F0.ws = p0->ws;
    const int bx0 = blockIdx.x;
    for (int u = F0.tid; u < (LDS_BYTES - MISC_OFF) / 4; u += NTHREADS) ((LAS unsigned*)(F0.lds + MISC_OFF))[u] = 0u;
    __syncthreads();
    XcdBarrier bar; bar.bar = (unsigned*)(p0->ws + WS_CTL) + CW_BAR; bar.x = 0; bar.st = nullptr;
    const int use_bar = p0->use_bar;
    if (use_bar) bar = xcd_barrier_post((unsigned*)(p0->ws + WS_CTL) + CW_BAR, F0.MISC + 8);
    const int lo = p0->ph_lo, hi = p0->ph_hi;
#define PHASE_BEGIN Frame F = F0; KP p = p0; { unsigned ones_ = ~0u; asm volatile("" : "+s"(ones_)); F.lane = (int)__builtin_amdgcn_mbcnt_hi(ones_, __builtin_amdgcn_mbcnt_lo(ones_, 0u)); } asm volatile("" : "+v"(F.lane)); F.tid = F.wave * 64 + F.lane; asm volatile("" : "+v"(F.tid));   GAS unsigned char* wsg_ = (GAS unsigned char*)F0.ws; asm volatile("" : "+s"(F.wave), "+s"(F.vcu), "+s"(F.G), "+s"(wsg_), "+s"(p)); \
    F.ws = (unsigned char*)wsg_; int bx = bx0; asm volatile("" : "+s"(bx)); unsigned char* ws = F.ws; (void)ws; (void)bx;
#pragma unroll 1
    for (int ph = lo; ph < hi; ++ph) {
        int layer = 0, type = 0;
        if (ph > 0) { layer = ph >= 26 ? 3 : (ph >= 18 ? 2 : (ph >= 9 ? 1 : 0)); const int q = ph - (layer == 3 ? 26 : (layer == 2 ? 18 : (layer == 1 ? 9 : 1))); const int kind = layer % 3;
            if (kind == 0) type = q < 4 ? 1 + q : 14 + (q - 4); else if (kind == 1) type = q < 5 ? 5 + q : 14 + (q - 5); else type = q < 4 ? 10 + q : 14 + (q - 4); }
        const int j = layer / 3;
#ifdef REPEAT_MASK
        const int nrep = ((REPEAT_MASK >> type) & 1u) ? 2 : 1;
#else
        const int nrep = 1;
#endif
#pragma unroll 1
        for (int rep = 0; rep < nrep; ++rep) {
        if (rep > 0 && use_bar) xcd_barrier(bar);
        if (PHT(0) && type == 0) { PHASE_BEGIN; phase_conv_mixers(F, p, 0); phase_load_x(F, p); }
        else if (PHT(1) && type == 1) { PHASE_BEGIN; DenseSched8 S; S.init(ws + WS_X, ws + WS_ATT_IN_T + (size_t)j * ATT_IN * D, T, ATT_IN, D / 2, F.G, bx); EpiStoreQkv8 E{(unsigned char*)(ws + WS_BIG), ATT_IN};
            pg8::gemm_phase(F.lds, F.tid, D / 2, S, E); }
        else if (PHT(2) && type == 2) { PHASE_BEGIN; phase_attn(F, bx); }
        else if (PHT(3) && type == 3) { PHASE_BEGIN; phase_attn_combine(F); }
        else if (PHT(4) && type == 4) { PHASE_BEGIN; DenseSched8 S; S.init(ws + WS_AUX + AUX_OB, ws + WS_ATT_OUT_T + (size_t)j * D * D, T, D, D / 2, F.G, bx); EpiResid8 E{(const bf16*)(ws + WS_XB), (bf16*)(ws + WS_Y), 1.0f / (A_SCALE * WUP_SCALE)};
            pg8::gemm_phase(F.lds, F.tid, D / 2, S, E); }
        else if (PHT(5) && type == 5) { PHASE_BEGIN; DenseSched8 S; S.init(ws + WS_X, ws + WS_RET_IN_T, T, RET_IN, D / 2, F.G, bx); EpiRetIn E{(unsigned char*)(ws + WS_BIG), RET_IN};
            pg8::gemm_phase(F.lds, F.tid, D / 2, S, E); }
        else if (PHT(6) && type == 6) { PHASE_BEGIN; phase_ret_u(F); }
        else if (PHT(7) && type == 7) { PHASE_BEGIN; phase_ret_scan(F); }
        else if (PHT(8) && type == 8) { PHASE_BEGIN; phase_ret_out(F, p); }
        else if (PHT(9) && type == 9) { PHASE_BEGIN; DenseSched8 S; S.init(ws + WS_BIG + BIG_YRET, ws + WS_RET_OUT_T, T, D, RET_V / 2, F.G, bx); EpiResid8 E{(const bf16*)(ws + WS_XB), (bf16*)(ws + WS_Y), 1.0f / (A_SCALE * WUP_SCALE)};
            pg8::gemm_phase(F.lds, F.tid, RET_V / 2, S, E); }
        else if (PHT(10) && type == 10) { PHASE_BEGIN; phase_s5_scan<false>(F, p); }
        else if (PHT(11) && type == 11) { PHASE_BEGIN; phase_s5_carry(F, p); }
        else if (PHT(12) && type == 12) { PHASE_BEGIN; phase_s5_scan<true>(F, p); }
        else if (PHT(13) && type == 13) { PHASE_BEGIN; DenseSched8 S; S.init(ws + WS_AUX, ws + WS_GLU_T, T, 2 * D, D / 2, F.G, bx); EpiGluResid E{(const bf16*)(ws + WS_XB), (bf16*)(ws + WS_Y), 1.0f / (A_SCALE * WUP_SCALE)};
            pg8::gemm_phase(F.lds, F.tid, D / 2, S, E); }
        else if (PHT(14) && type == 14) { PHASE_BEGIN; phase_lnr(F, p, layer, PROBE_DRY14 && true); if (PROBE_DRY14) { if (use_bar) xcd_barrier(bar); phase_lnr(F, p, layer, false); }
            __syncthreads(); phase_conv_moe(F, p, layer); }
        else if (PHT(15) && type == 15) { PHASE_BEGIN; moe_plan(F, layer);
            MoeSched2<true> S; S.tstart = (const volatile LAS int*)(F.MISC + PLAN_OFF); S.cnts = S.tstart + 72; S.ntiles = __builtin_amdgcn_readfirstlane((int)S.tstart[65]); S.G = F.G; S.c = bx; S.lane = F.lane;
            S.Abase = (const char*)(ws + WS_X); S.Wbase = (const char*)(ws + WS_WMOE); S.lists = (const int*)(ws + WS_LIST);
            EpiMoeUp E{(unsigned char*)(ws + WS_H)};
            pg8::gemm_phase(F.lds, F.tid, D / 2, S, E); }
        else if (PHT(16) && type == 16) { PHASE_BEGIN; moe_plan(F, layer);
            { MoeSched2<false> S; S.tstart = (const volatile LAS int*)(F.MISC + PLAN_OFF); S.cnts = S.tstart + 72; S.ntiles = __builtin_amdgcn_readfirstlane((int)S.tstart[64]); S.G = F.G; S.c = bx; S.lane = F.lane;
              S.Abase = (const char*)(ws + WS_H); S.Wbase = (const char*)(ws + WS_WMOE); S.lists = (const int*)(ws + WS_LIST);
              EpiStoreFp8 E{(unsigned char*)(ws + WS_BIG), D};
              pg8::gemm_phase(F.lds, F.tid, ED / 2, S, E); }
            { const int sh0 = __builtin_amdgcn_readfirstlane((int)((const volatile LAS int*)(F.MISC + PLAN_OFF))[64]);
              DenseSched8 S; S.init(ws + WS_H + (size_t)sh0 * 256 * ED, ws + WS_WMOE + (size_t)64 * WMOE_E_BYTES + (size_t)512 * 1024 * 2, T, D, ED / 2, F.G, bx); EpiResid8 E{(const bf16*)(ws + WS_XB), (bf16*)(ws + WS_Y), 1.0f / (H_SCALE * WUP_SCALE)};
              int tid2; { unsigned o2 = ~0u; asm volatile("" : "+s"(o2)); tid2 = F.wave * 64 + (int)__builtin_amdgcn_mbcnt_hi(o2, __builtin_amdgcn_mbcnt_lo(o2, 0u)); }
              pg8::gemm_phase(F.lds, tid2, ED / 2, S, E); } }
        else if (PHT(17) && type == 17) { PHASE_BEGIN; moe_plan(F, layer); if (PROBE_DRY17) { phase_combine(F, p, layer, true); if (use_bar) xcd_barrier(bar); } phase_combine(F, p, layer); if (layer + 1 < DEPTH) { __syncthreads(); phase_conv_mixers(F, p, (layer + 1) % 3 == 0 ? 3 : (layer + 1) % 3); } }
        }
        if (use_bar && ph + 1 < hi) xcd_barrier(bar);
    }
}

#ifndef MK_PER_PHASE
#define MK_PER_PHASE 0
#endif
extern "C" void kernel_launch(void* const* d_in, const int* in_sizes, int n_in, void* d_out, int out_size, void* d_ws, size_t ws_size, hipStream_t stream) {
    static int grid = 0;
    if (grid == 0) {
        if (n_in != 26 || in_sizes[0] != T * D || out_size != T * D || ws_size < WS_END) { fprintf(stderr, "kernel_launch: unexpected shapes / workspace (n_in %d, in0 %d, out %d, ws %zu < %zu)\n", n_in, n_in > 0 ? in_sizes[0] : -1, out_size, ws_size, (size_t)WS_END); grid = -1; return; }
        int dev = 0, cus = 0, per_cu = 0;
        if (hipGetDevice(&dev) != hipSuccess || hipDeviceGetAttribute(&cus, hipDeviceAttributeMultiprocessorCount, dev) != hipSuccess) { grid = -1; return; }
        if (hipFuncSetAttribute((const void*)fwd_kernel, hipFuncAttributeMaxDynamicSharedMemorySize, LDS_BYTES) != hipSuccess) { fprintf(stderr, "kernel_launch: hipFuncSetAttribute failed\n"); grid = -1; return; }
        if (hipOccupancyMaxActiveBlocksPerMultiprocessor(&per_cu, (const void*)fwd_kernel, NTHREADS, LDS_BYTES) != hipSuccess || per_cu < 1) { fprintf(stderr, "kernel_launch: occupancy query says %d blocks per CU\n", per_cu); per_cu = 1; }
        (void)hipGetLastError();
        grid = cus;
    }
    if (grid < 0) return;
    (void)hipMemsetAsync((char*)d_ws + WS_CTL, 0, CTL_ZERO_BYTES, stream);
    Params p{};
    for (int i = 0; i < 26; ++i) p.in[i] = (const float*)d_in[i];
    p.out = (float*)d_out; p.ws = (unsigned char*)d_ws;
#if MK_PER_PHASE
    for (int k = 0; k < NPHASES; ++k) { p.ph_lo = k; p.ph_hi = k + 1; p.use_bar = 0; hipLaunchKernelGGL(fwd_kernel, dim3(grid), dim3(NTHREADS), LDS_BYTES, stream, p); }
#else
    p.ph_lo = 0; p.ph_hi = NPHASES; p.use_bar = 1;
    hipLaunchKernelGGL(fwd_kernel, dim3(grid), dim3(NTHREADS), LDS_BYTES, stream, p);
#endif
}
```
